# Optimizing an MI355X kernel written in HIP

```python
import math
import jax, jax.numpy as jnp
from jax import lax
import numpy as np

D_MODEL = 1024
BATCH = 8
SEQ = 4096
DEPTH = 2

N_MIXERS = 2
EPS = 1e-6
ML_HEADS = 8
ML_DQK = D_MODEL // (2 * ML_HEADS)
ML_DV = D_MODEL // ML_HEADS
ML_CHUNK = 64
ML_FGATE_BIAS_LO = 3.0
ML_FGATE_BIAS_HI = 6.0
ML_M_INIT = -1e30
DA_HEADS = 8
DA_DHEAD = D_MODEL // (2 * DA_HEADS)
DA_DV = 2 * DA_DHEAD
ROPE_THETA = 500000.0
ROPE_DIM = DA_DHEAD // 4
Q_BLOCK = 128
PEER_HEADS = 8
N_KEYS = 128
N_EXPERTS = N_KEYS * N_KEYS
PEER_TOPK = 16
PEER_DQ = 256
PEER_DHALF = PEER_DQ // 2
PEER_CHUNK = 128

ML_IN_COLS = 2 * ML_HEADS * ML_DQK + 2 * ML_HEADS * ML_DV + 4 * ML_HEADS
DA_IN_COLS = 2 * DA_HEADS * DA_DHEAD * 2 + DA_HEADS * DA_DV

kernel_name = "hybrid_mlstm_diffattn_peer"


def rmsnorm(x, g):
    xf = x.astype(jnp.float32)
    y = xf * lax.rsqrt(jnp.mean(xf * xf, axis=-1, keepdims=True) + EPS)
    return (y * g.astype(jnp.float32)).astype(x.dtype)


def partial_rope(x, positions):
    half = ROPE_DIM // 2
    inv = ROPE_THETA ** (-jnp.arange(half, dtype=jnp.float32) * 2.0 / ROPE_DIM)
    ang = positions.astype(jnp.float32)[..., None] * inv
    cos = jnp.cos(ang)[:, :, None, None, :]
    sin = jnp.sin(ang)[:, :, None, None, :]
    xf = x.astype(jnp.float32)
    x1, x2, rest = xf[..., :half], xf[..., half:ROPE_DIM], xf[..., ROPE_DIM:]
    out = jnp.concatenate([x1 * cos - x2 * sin, x2 * cos + x1 * sin, rest], axis=-1)
    return out.astype(x.dtype)


def mlstm_chunkwise(q, k, v, log_i, log_f):
    B, H, S, dk = q.shape
    dv = v.shape[-1]
    L = ML_CHUNK
    nc = S // L
    q = q.reshape(B, H, nc, L, dk) * (dk ** -0.5)
    k = k.reshape(B, H, nc, L, dk)
    v = v.reshape(B, H, nc, L, dv)
    li = log_i.reshape(B, H, nc, L)
    lf = log_f.reshape(B, H, nc, L)
    b = jnp.cumsum(lf, axis=-1)
    bL = b[..., -1]
    a = bL[..., None] - b + li
    m_loc = jnp.max(a, axis=-1)
    w = jnp.exp(a - m_loc[..., None])
    C_loc = jnp.einsum('bhcs,bhcsv,bhcsk->bhcvk', w, v, k)
    n_loc = jnp.einsum('bhcs,bhcsk->bhck', w, k)

    def step(carry, xs):
        C, n, m = carry
        bL_c, m_loc_c, C_loc_c, n_loc_c = xs
        m_new = jnp.maximum(bL_c + m, m_loc_c)
        sp = jnp.exp(bL_c + m - m_new)
        sl = jnp.exp(m_loc_c - m_new)
        C_new = sp[..., None, None] * C + sl[..., None, None] * C_loc_c
        n_new = sp[..., None] * n + sl[..., None] * n_loc_c
        return (C_new, n_new, m_new), (C, n, m)

    init = (jnp.zeros((B, H, dv, dk), jnp.float32),
            jnp.zeros((B, H, dk), jnp.float32),
            jnp.full((B, H), ML_M_INIT, jnp.float32))
    xs = (jnp.moveaxis(bL, 2, 0), jnp.moveaxis(m_loc, 2, 0),
          jnp.moveaxis(C_loc, 2, 0), jnp.moveaxis(n_loc, 2, 0))
    _, (C_prev, n_prev, m_prev) = lax.scan(step, init, xs)
    C_prev = jnp.moveaxis(C_prev, 0, 2)
    n_prev = jnp.moveaxis(n_prev, 0, 2)
    m_prev = jnp.moveaxis(m_prev, 0, 2)

    mask = jnp.tril(jnp.ones((L, L), dtype=bool))
    D = b[..., :, None] - b[..., None, :] + li[..., None, :]
    D = jnp.where(mask, D, -jnp.inf)
    g = b + m_prev[..., None]
    m_t = jnp.maximum(g, jnp.max(D, axis=-1))
    Sqk = jnp.einsum('bhctd,bhcsd->bhcts', q, k) * jnp.exp(D - m_t[..., None])
    inter = jnp.exp(g - m_t)
    num = (jnp.einsum('bhcts,bhcsv->bhctv', Sqk, v)
           + inter[..., None] * jnp.einsum('bhcvk,bhctk->bhctv', C_prev, q))
    den = jnp.sum(Sqk, axis=-1) + inter * jnp.einsum('bhck,bhctk->bhct', n_prev, q)
    h = num / jnp.maximum(jnp.abs(den), jnp.exp(-m_t))[..., None]
    return h.reshape(B, H, S, dv)


def mlstm_mixer(x, norm_g, w_in, b_gates, head_g, w_out):
    B, S, _ = x.shape
    h = rmsnorm(x, norm_g)
    proj = h @ w_in
    nq = ML_HEADS * ML_DQK
    nv = ML_HEADS * ML_DV
    q, k, v, o, gates = jnp.split(proj, [nq, 2 * nq, 2 * nq + nv, 2 * nq + 2 * nv], axis=-1)

    def heads(t, d):
        return t.reshape(B, S, ML_HEADS, d).transpose(0, 2, 1, 3).astype(jnp.float32)

    q, k, v = heads(q, ML_DQK), heads(k, ML_DQK), heads(v, ML_DV)
    gates = gates.astype(jnp.float32) + b_gates.astype(jnp.float32)
    gates = gates.reshape(B, S, 4, ML_HEADS).transpose(2, 0, 3, 1)
    i_fwd, f_fwd, i_bwd, f_bwd = gates[0], gates[1], gates[2], gates[3]
    h_fwd = mlstm_chunkwise(q, k, v, i_fwd, jax.nn.log_sigmoid(f_fwd))
    flip = lambda t: jnp.flip(t, axis=2)
    h_bwd = flip(mlstm_chunkwise(flip(q), flip(k), flip(v), flip(i_bwd),
                                 flip(jax.nn.log_sigmoid(f_bwd))))
    hs = (h_fwd + h_bwd).transpose(0, 2, 1, 3)
    hs = hs * lax.rsqrt(jnp.mean(hs * hs, axis=-1, keepdims=True) + EPS)
    hs = hs.reshape(B, S, D_MODEL) * head_g.astype(jnp.float32)
    hs = hs * jax.nn.sigmoid(o.astype(jnp.float32))
    return hs.astype(x.dtype) @ w_out


def diff_attn_mixer(x, positions, norm_g, w_qkv, q_g, k_g, lam_q1, lam_k1, lam_q2, lam_k2,
                    subln_g, w_out, lambda_init):
    B, S, _ = x.shape
    h = rmsnorm(x, norm_g)
    q, k, v = jnp.split(h @ w_qkv, 3, axis=-1)
    q = q.reshape(B, S, DA_HEADS, 2, DA_DHEAD)
    k = k.reshape(B, S, DA_HEADS, 2, DA_DHEAD)
    v = v.reshape(B, S, DA_HEADS, DA_DV).transpose(0, 2, 1, 3)
    q = partial_rope(rmsnorm(q, q_g), positions).transpose(0, 2, 3, 1, 4)
    k = partial_rope(rmsnorm(k, k_g), positions).transpose(0, 2, 3, 1, 4)
    lam = (jnp.exp(jnp.sum(lam_q1.astype(jnp.float32) * lam_k1.astype(jnp.float32)))
           - jnp.exp(jnp.sum(lam_q2.astype(jnp.float32) * lam_k2.astype(jnp.float32)))
           + lambda_init)
    scale = DA_DHEAD ** -0.5
    nb = S // Q_BLOCK
    qb = jnp.moveaxis(q.reshape(B, DA_HEADS, 2, nb, Q_BLOCK, DA_DHEAD), 3, 0)

    def attend(qblk):
        s = jnp.einsum('bhcqd,bhckd->bhcqk', qblk, k).astype(jnp.float32) * scale
        p = jax.nn.softmax(s, axis=-1)
        a = p[:, :, 0] - lam * p[:, :, 1]
        return jnp.einsum('bhqk,bhkv->bhqv', a.astype(v.dtype), v)

    o = lax.map(attend, qb)
    o = o.transpose(1, 0, 3, 2, 4).reshape(B, S, DA_HEADS, DA_DV)
    o = rmsnorm(o, subln_g) * (1.0 - lambda_init)
    return o.reshape(B, S, D_MODEL) @ w_out


def peer_ffn(x, norm_g, w_query, sub_keys, u_table, v_table):
    B, S, D = x.shape
    T = B * S
    h = rmsnorm(x, norm_g).reshape(T, D)
    q = (h @ w_query).reshape(T, PEER_HEADS, 2, PEER_DHALF)
    s = jnp.einsum('thpd,hpnd->thpn', q, sub_keys).astype(jnp.float32)
    vals, idx = lax.top_k(s, PEER_TOPK)
    cand = vals[:, :, 0, :, None] + vals[:, :, 1, None, :]
    cidx = idx[:, :, 0, :, None] * N_KEYS + idx[:, :, 1, None, :]
    cand = cand.reshape(T, PEER_HEADS, PEER_TOPK * PEER_TOPK)
    cidx = cidx.reshape(T, PEER_HEADS, PEER_TOPK * PEER_TOPK)
    top_s, pos = lax.top_k(cand, PEER_TOPK)
    experts = jnp.take_along_axis(cidx, pos, axis=-1)
    gates = jax.nn.softmax(top_s, axis=-1)
    nch = T // PEER_CHUNK
    E = PEER_HEADS * PEER_TOPK
    hc = h.reshape(nch, PEER_CHUNK, D)
    ec = experts.reshape(nch, PEER_CHUNK, E)
    gc = gates.reshape(nch, PEER_CHUNK, E)

    def block(args):
        hb, eb, gb = args
        ue = u_table[eb]
        act = jax.nn.gelu(jnp.einsum('td,ted->te', hb, ue), approximate=False)
        ve = v_table[eb]
        return jnp.einsum('te,ted->td', (gb * act.astype(jnp.float32)).astype(ve.dtype), ve)

    out = lax.map(block, (hc, ec, gc))
    return out.reshape(B, S, D).astype(x.dtype)


def setup_inputs(seed: int = 0) -> dict:
    key = jax.random.key(seed)
    ks = jax.random.split(key, 40)
    f32 = jnp.float32
    nrm = lambda k, shape, sc: jax.random.normal(k, shape, f32) * sc
    gain = lambda k, n: 1.0 + 0.02 * jax.random.normal(k, (n,), f32)
    fan = D_MODEL ** -0.5
    x = jax.random.normal(ks[0], (BATCH, SEQ, D_MODEL), f32)
    positions = (jnp.arange(SEQ, dtype=jnp.int32)[None, :]
                 + jax.random.randint(ks[1], (BATCH, 1), 0, 4096, dtype=jnp.int32))
    b_i = 0.1 * jax.random.normal(ks[4], (ML_HEADS,), f32)
    b_f = jnp.linspace(ML_FGATE_BIAS_LO, ML_FGATE_BIAS_HI, ML_HEADS, dtype=f32) + 0.1 * jax.random.normal(ks[5], (ML_HEADS,), f32)
    b_ib = 0.1 * jax.random.normal(ks[6], (ML_HEADS,), f32)
    b_fb = jnp.linspace(ML_FGATE_BIAS_LO, ML_FGATE_BIAS_HI, ML_HEADS, dtype=f32) + 0.1 * jax.random.normal(ks[7], (ML_HEADS,), f32)
    return {
        "x": x,
        "positions": positions,
        "l0_norm_mix": gain(ks[2], D_MODEL),
        "l0_w_in": nrm(ks[3], (D_MODEL, ML_IN_COLS), fan),
        "l0_b_gates": jnp.concatenate([b_i, b_f, b_ib, b_fb]),
        "l0_head_norm": gain(ks[8], D_MODEL),
        "l0_w_out": nrm(ks[9], (D_MODEL, D_MODEL), fan),
        "l0_norm_ffn": gain(ks[10], D_MODEL),
        "l0_peer_wq": nrm(ks[11], (D_MODEL, PEER_HEADS * PEER_DQ), fan),
        "l0_peer_keys": nrm(ks[12], (PEER_HEADS, 2, N_KEYS, PEER_DHALF), PEER_DHALF ** -0.5),
        "l0_peer_u": nrm(ks[13], (N_EXPERTS, D_MODEL), fan),
        "l0_peer_v": nrm(ks[14], (N_EXPERTS, D_MODEL), 0.25),
        "l1_norm_mix": gain(ks[15], D_MODEL),
        "l1_w_qkv": nrm(ks[16], (D_MODEL, DA_IN_COLS), fan),
        "l1_q_norm": gain(ks[17], DA_DHEAD),
        "l1_k_norm": gain(ks[18], DA_DHEAD),
        "l1_lambda_q1": nrm(ks[19], (DA_DHEAD,), 0.1),
        "l1_lambda_k1": nrm(ks[20], (DA_DHEAD,), 0.1),
        "l1_lambda_q2": nrm(ks[21], (DA_DHEAD,), 0.1),
        "l1_lambda_k2": nrm(ks[22], (DA_DHEAD,), 0.1),
        "l1_subln": gain(ks[23], DA_DV),
        "l1_w_out": nrm(ks[24], (D_MODEL, D_MODEL), fan),
        "l1_norm_ffn": gain(ks[25], D_MODEL),
        "l1_peer_wq": nrm(ks[26], (D_MODEL, PEER_HEADS * PEER_DQ), fan),
        "l1_peer_keys": nrm(ks[27], (PEER_HEADS, 2, N_KEYS, PEER_DHALF), PEER_DHALF ** -0.5),
        "l1_peer_u": nrm(ks[28], (N_EXPERTS, D_MODEL), fan),
        "l1_peer_v": nrm(ks[29], (N_EXPERTS, D_MODEL), 0.25),
    }


def reference(x, positions,
              l0_norm_mix, l0_w_in, l0_b_gates, l0_head_norm, l0_w_out,
              l0_norm_ffn, l0_peer_wq, l0_peer_keys, l0_peer_u, l0_peer_v,
              l1_norm_mix, l1_w_qkv, l1_q_norm, l1_k_norm,
              l1_lambda_q1, l1_lambda_k1, l1_lambda_q2, l1_lambda_k2, l1_subln, l1_w_out,
              l1_norm_ffn, l1_peer_wq, l1_peer_keys, l1_peer_u, l1_peer_v):
    mix_params = [
        (l0_norm_mix, l0_w_in, l0_b_gates, l0_head_norm, l0_w_out),
        (l1_norm_mix, l1_w_qkv, l1_q_norm, l1_k_norm, l1_lambda_q1, l1_lambda_k1,
         l1_lambda_q2, l1_lambda_k2, l1_subln, l1_w_out),
    ]
    ffn_params = [
        (l0_norm_ffn, l0_peer_wq, l0_peer_keys, l0_peer_u, l0_peer_v),
        (l1_norm_ffn, l1_peer_wq, l1_peer_keys, l1_peer_u, l1_peer_v),
    ]
    for i in range(DEPTH):
        if i % N_MIXERS == 0:
            x = x + mlstm_mixer(x, *mix_params[i])
        else:
            lambda_init = 0.8 - 0.6 * math.exp(-0.3 * i)
            x = x + diff_attn_mixer(x, positions, *mix_params[i], lambda_init=lambda_init)
        x = x + peer_ffn(x, *ffn_params[i])
    return x
```

```cpp
#include <hip/hip_runtime.h>
#include <hip/hip_bf16.h>
#include <cstdio>
#include <cstdint>
#include <cmath>
namespace pg8 {
#define PG8_LAS __attribute__((address_space(3)))
typedef unsigned short bf16_t;
typedef short bf16x8 __attribute__((ext_vector_type(8)));
typedef float f32x4 __attribute__((ext_vector_type(4)));
typedef unsigned u32x4 __attribute__((ext_vector_type(4)));
constexpr int BM = 256, BK = 64, HALF = 128, HTB = HALF * BK * 2  , STAGE_BYTES = 8 * HTB, NXCD = 8, WGM = 8;

__host__ __device__ __forceinline__ int lds_byte(int r, int c) { const int st = (r >> 4) * 2 + (c >> 5), rr = r & 15, cc = c & 31, ob = rr * 64 + cc * 2; return st * 1024 + (ob ^ (((ob >> 9) & 1) << 5)); }
__host__ __device__ __forceinline__ void stage_rc(int b, int& R, int& C) { const int st = b / 1024, sb = b % 1024, swz = sb ^ (((sb >> 9) & 1) << 5); R = (st >> 1) * 16 + swz / 64; C = (st & 1) * 32 + (swz % 64) / 2; }
__host__ __device__ __forceinline__ int perm32(int rho) { const int n = rho >> 4, i = rho & 15; return 8 * (i >> 2) + 4 * n + (i & 3); }

struct Unit { int pm, pn; };
struct Gemm { const bf16_t* A; const bf16_t* Bt; int M, N, K; };

struct StaticOrder {
    int nM, nN, nwg, G, c;
    __host__ __device__ void init(int M, int N, int G_, int c_) { nM = M / BM; nN = N / BM; nwg = nM * nN; G = G_; c = c_; }
    __host__ __device__ bool next(int i, Unit& u) const {
        const long L = (long)i * G + c; if (L >= nwg) return false;
        int wgid = (int)L; { const int q = nwg / NXCD, r = nwg % NXCD, xcd = wgid % NXCD, off = wgid / NXCD; wgid = (xcd < r ? xcd * (q + 1) : r * (q + 1) + (xcd - r) * q) + off; }
        const int nig = WGM * nN, gid = wgid / nig, fm = gid * WGM, gsz = (nM - fm) < WGM ? (nM - fm) : WGM;
        u.pm = fm + ((wgid % nig) % gsz); u.pn = (wgid % nig) / gsz; return true;
    }
    __device__ __forceinline__ void a_ready(const Unit&) const {}
    __device__ __forceinline__ void done(const Unit&) const {}
};
__device__ __forceinline__ unsigned cvt_pk_bf16(float lo, float hi) { unsigned r; asm volatile("v_cvt_pk_bf16_f32 %0, %1, %2" : "=v"(r) : "v"(lo), "v"(hi)); return r; }
typedef float f32x2 __attribute__((ext_vector_type(2)));
typedef unsigned u32x2 __attribute__((ext_vector_type(2)));
__device__ __forceinline__ u32x4 pack8(const f32x4 v0, const f32x4 v1) { u32x4 w; w.x = cvt_pk_bf16(v0[0], v0[1]); w.y = cvt_pk_bf16(v0[2], v0[3]); w.z = cvt_pk_bf16(v1[0], v1[1]); w.w = cvt_pk_bf16(v1[2], v1[3]); return w; }
struct EpiPlain {
    static constexpr bool PERM = true, AFTER_DRAIN = false;
    bf16_t* O; int ldc;
    __device__ __forceinline__ void operator()(const f32x4 (&acc)[2][2][4][2], const Unit& u, int wr, int wc, int fr, int fq) const {
        const int row0 = u.pm * BM + wr * 64 + fr, col0 = u.pn * BM + wc * 32 + 8 * fq;
#pragma unroll
        for (int ai = 0; ai < 2; ++ai)
#pragma unroll
            for (int m = 0; m < 4; ++m) { bf16_t* rowp = O + (size_t)(row0 + ai * HALF + m * 16) * ldc + col0;
#pragma unroll
                for (int bj = 0; bj < 2; ++bj) *(u32x4*)(rowp + bj * HALF) = pack8(acc[ai][bj][m][0], acc[ai][bj][m][1]); }
    }
};
struct EpiRes {
    static constexpr bool PERM = false, AFTER_DRAIN = false;
    const float* base; float* out;
    __device__ __forceinline__ void operator()(const f32x4 (&acc)[2][2][4][2], const Unit& u, int wr, int wc, int fr, int fq) const {
        const int col0 = u.pn * BM + wc * 32 + 4 * fq;
#pragma unroll
        for (int ai = 0; ai < 2; ++ai)
#pragma unroll
            for (int m = 0; m < 4; ++m) { const size_t off = (size_t)(u.pm * BM + ai * HALF + wr * 64 + m * 16 + fr) * 1024 + col0;
#pragma unroll
                for (int bj = 0; bj < 2; ++bj)
#pragma unroll
                    for (int n = 0; n < 2; ++n) { const f32x4 bs = *(const f32x4*)(base + off + bj * HALF + n * 16); *(f32x4*)(out + off + bj * HALF + n * 16) = bs + acc[ai][bj][m][n]; } }
    }
};
struct EpiInProj {
    static constexpr bool PERM = true, AFTER_DRAIN = false;
    bf16_t *Q, *Kk, *V, *OG; float* gates; const float* bg;
    __device__ __forceinline__ void operator()(const f32x4 (&acc)[2][2][4][2], const Unit& u, int wr, int wc, int fr, int fq) const {
        const int colt = u.pn * BM;
#pragma unroll
        for (int ai = 0; ai < 2; ++ai)
#pragma unroll
            for (int m = 0; m < 4; ++m) { const int row = u.pm * BM + ai * HALF + wr * 64 + m * 16 + fr, b = row >> 12, s = row & 4095;
#pragma unroll
                for (int bj = 0; bj < 2; ++bj) { const int cb = colt + bj * HALF + wc * 32 + 8 * fq; f32x4 v0 = acc[ai][bj][m][0], v1 = acc[ai][bj][m][1];
                    if (colt < 1024) { const bool isq = colt < 512; bf16_t* base = isq ? Q : Kk; const int c2 = cb & 511, head = c2 >> 6, d = c2 & 63;
                        if (isq) { v0 = v0 * 0.125f; v1 = v1 * 0.125f; }
                        *(u32x4*)(base + ((size_t)((b * 8 + head) * 4096 + s)) * 64 + d) = pack8(v0, v1); }
                    else if (colt < 2048) { const int c2 = cb - 1024, head = c2 >> 7, dv = c2 & 127; *(u32x4*)(V + ((size_t)((b * 8 + head) * 4096 + s)) * 128 + dv) = pack8(v0, v1); }
                    else if (colt < 3072) { *(u32x4*)(OG + (size_t)row * 1024 + (cb - 2048)) = pack8(v0, v1); }
                    else if (cb < 3104) { const int gi = cb - 3072; float* g = gates + (size_t)row * 32 + gi;
                        *(f32x4*)g = v0 + *(const f32x4*)(bg + gi); *(f32x4*)(g + 4) = v1 + *(const f32x4*)(bg + gi + 4); } } }
    }
};
struct EpiQKV {
    static constexpr bool PERM = true, AFTER_DRAIN = false;
    bf16_t *Q, *Kk, *V;
    __device__ __forceinline__ void operator()(const f32x4 (&acc)[2][2][4][2], const Unit& u, int wr, int wc, int fr, int fq) const {
        const int colt = u.pn * BM;
#pragma unroll
        for (int ai = 0; ai < 2; ++ai)
#pragma unroll
            for (int m = 0; m < 4; ++m) { const int row = u.pm * BM + ai * HALF + wr * 64 + m * 16 + fr, b = row >> 12, s = row & 4095;
#pragma unroll
                for (int bj = 0; bj < 2; ++bj) { const int cb = colt + bj * HALF + wc * 32 + 8 * fq; const u32x4 w = pack8(acc[ai][bj][m][0], acc[ai][bj][m][1]);
                    if (colt < 2048) { bf16_t* base = colt < 1024 ? Q : Kk; const int c2 = cb & 1023, head = c2 >> 7, c = (c2 >> 6) & 1, d = c2 & 63;
                        *(u32x4*)(base + ((size_t)(((b * 8 + head) * 2 + c) * 4096 + s)) * 64 + d) = w; }
                    else { const int c2 = cb - 2048, head = c2 >> 7, dv = c2 & 127; *(u32x4*)(V + ((size_t)((b * 8 + head) * 4096 + s)) * 128 + dv) = w; } } }
    }
};
template <class Epi, class Sched, bool ALIGN_EPI = false, bool SP2 = false>
__device__ __forceinline__ void gemm_phase(PG8_LAS unsigned char* lds, const Gemm g, const Sched& S, const Epi& E) {
    int tid_ = threadIdx.x; asm volatile("" : "+v"(tid_)); const int tid = tid_, wid = __builtin_amdgcn_readfirstlane(tid >> 6), lane = tid & 63, wr = wid >> 2, wc = wid & 3, fr = lane & 15, fq = lane >> 4;
    const int K = g.K, nt = K / BK;
    unsigned voffA[2], voffB[2];
#pragma unroll
    for (int i = 0; i < 2; ++i) { int R, C; stage_rc(tid * 16 + i * 8192, R, C); const int Rb = Epi::PERM ? ((R & ~31) + perm32(R & 31)) : R;
        voffA[i] = (unsigned)(R * K + C) * 2u; voffB[i] = (unsigned)(Rb * K + C) * 2u; }
    const size_t kstep = (size_t)(BK * 2);
    const size_t hstep = (size_t)HALF * K * 2;
    const size_t tstep = 2 * hstep;
    const unsigned ldsw = (unsigned)wid * 1024u;
    const int aoff = lds_byte(wr * 64 + fr, fq * 8), boff = lds_byte(wc * 32 + fr, fq * 8);
#define PG8_SA(b, h) (((b) * 2 + (h)) * HTB)
#define PG8_SB(b, h) ((4 + (b) * 2 + (h)) * HTB)
#define PG8_STAGE(bufoff, gbase, voff) do { _Pragma("unroll") for (int _i = 0; _i < 2; ++_i) \
        __builtin_amdgcn_global_load_lds((const unsigned*)((const char*)(gbase) + (voff)[_i]), (PG8_LAS unsigned*)(lds + (bufoff) + ldsw + _i * 8192), 16, 0, 0); } while (0)
#define PG8_LDA(dst, b, h) do { _Pragma("unroll") for (int m = 0; m < 4; ++m) _Pragma("unroll") for (int k = 0; k < 2; ++k) dst[m][k] = *(const PG8_LAS bf16x8*)(lds + PG8_SA(b, h) + aoff + m * 2048 + k * 1024); } while (0)
#define PG8_LDB(dst, b, h) do { _Pragma("unroll") for (int n = 0; n < 2; ++n) _Pragma("unroll") for (int k = 0; k < 2; ++k) dst[n][k] = *(const PG8_LAS bf16x8*)(lds + PG8_SB(b, h) + boff + n * 2048 + k * 1024); } while (0)
#define PG8_MMA(ai, bj, At, Bt) do { __builtin_amdgcn_s_setprio(1); _Pragma("unroll") for (int m = 0; m < 4; ++m) _Pragma("unroll") for (int n = 0; n < 2; ++n) _Pragma("unroll") for (int k = 0; k < 2; ++k) \
        acc[ai][bj][m][n] = __builtin_amdgcn_mfma_f32_16x16x32_bf16(Bt[n][k], At[m][k], acc[ai][bj][m][n], 0, 0, 0); __builtin_amdgcn_s_setprio(0); } while (0)
#define PG8_WAIT_V(n) asm volatile("s_waitcnt vmcnt(" #n ")" ::: "memory")
#define PG8_WAIT_L(n) asm volatile("s_waitcnt lgkmcnt(" #n ")" ::: "memory")
#define PG8_BAR __builtin_amdgcn_s_barrier()
#define PG8_SCHED __builtin_amdgcn_sched_barrier(0)
    Unit cur, nxt; int ui = 0;
    if (!S.next(0, cur)) return;
    f32x4 acc[2][2][4][2];
#pragma unroll
    for (int a = 0; a < 2; ++a)
#pragma unroll
        for (int b = 0; b < 2; ++b)
#pragma unroll
            for (int m = 0; m < 4; ++m)
#pragma unroll
                for (int n = 0; n < 2; ++n) acc[a][b][m][n] = (f32x4){0.f, 0.f, 0.f, 0.f};
    bf16x8 At[4][2], B0[2][2], B1[2][2];
    const char* cA = (const char*)g.A + (size_t)cur.pm * tstep; const char* cB = (const char*)g.Bt + (size_t)cur.pn * tstep;
    S.a_ready(cur);
    if constexpr (SP2) {
        PG8_STAGE(PG8_SB(0, 0), cB, voffB); PG8_STAGE(PG8_SB(0, 1), cB + hstep, voffB); PG8_STAGE(PG8_SA(0, 0), cA, voffA); PG8_STAGE(PG8_SA(0, 1), cA + hstep, voffA);
        if (wr == 1) PG8_BAR;
        PG8_WAIT_V(2); PG8_BAR;
        PG8_STAGE(PG8_SB(1, 0), cB + kstep, voffB); PG8_STAGE(PG8_SA(1, 0), cA + kstep, voffA); PG8_STAGE(PG8_SB(1, 1), cB + hstep + kstep, voffB);
        PG8_WAIT_V(6); PG8_BAR;
    } else {
        PG8_STAGE(PG8_SB(0, 0), cB, voffB); PG8_STAGE(PG8_SA(0, 0), cA, voffA); PG8_STAGE(PG8_SB(0, 1), cB + hstep, voffB); PG8_STAGE(PG8_SA(0, 1), cA + hstep, voffA);
        if (wr == 1) PG8_BAR;
        PG8_WAIT_V(4); PG8_BAR;
        PG8_STAGE(PG8_SB(1, 0), cB + kstep, voffB); PG8_STAGE(PG8_SA(1, 0), cA + kstep, voffA); PG8_STAGE(PG8_SB(1, 1), cB + hstep + kstep, voffB);
        PG8_WAIT_V(6); PG8_BAR;
    }
    for (;;) {
        const bool has_next = S.next(ui + 1, nxt);
        const char* nA = has_next ? (const char*)g.A + (size_t)nxt.pm * tstep : cA; const char* nB = has_next ? (const char*)g.Bt + (size_t)nxt.pn * tstep : cB;
        for (int t = 0; t < nt; t += 2) {
            const bool last = (t == nt - 2);
            const char* a1 = cA + (size_t)(t + 1) * kstep;
            const char* a2 = last ? nA : cA + (size_t)(t + 2) * kstep; const char* b2 = last ? nB : cB + (size_t)(t + 2) * kstep;
            const char* a3 = a2 + kstep; const char* b3 = b2 + kstep;
            if (last && has_next) S.a_ready(nxt);
            if constexpr (SP2) {
            PG8_LDB(B0, 0, 0); PG8_LDB(B1, 0, 1); PG8_SCHED; PG8_LDA(At, 0, 0); PG8_STAGE(PG8_SA(1, 1), a1 + hstep, voffA);
            PG8_WAIT_V(8); PG8_WAIT_L(0); PG8_BAR; PG8_MMA(0, 0, At, B0); PG8_MMA(0, 1, At, B1); PG8_BAR; PG8_SCHED;
            PG8_LDA(At, 0, 1); PG8_STAGE(PG8_SB(0, 0), b2, voffB); PG8_STAGE(PG8_SB(0, 1), b2 + hstep, voffB); PG8_STAGE(PG8_SA(0, 0), a2, voffA);
            PG8_WAIT_V(8); PG8_WAIT_L(0); PG8_BAR; PG8_MMA(1, 0, At, B0); PG8_MMA(1, 1, At, B1); PG8_BAR; PG8_SCHED;
            PG8_LDB(B0, 1, 0); PG8_LDB(B1, 1, 1); PG8_SCHED; PG8_LDA(At, 1, 0); PG8_STAGE(PG8_SA(0, 1), a2 + hstep, voffA);
            PG8_WAIT_V(8); PG8_WAIT_L(0); PG8_BAR; PG8_MMA(0, 0, At, B0); PG8_MMA(0, 1, At, B1); PG8_BAR; PG8_SCHED;
            PG8_LDA(At, 1, 1); PG8_STAGE(PG8_SB(1, 0), b3, voffB); PG8_STAGE(PG8_SB(1, 1), b3 + hstep, voffB); PG8_STAGE(PG8_SA(1, 0), a3, voffA);
            PG8_WAIT_V(8); PG8_WAIT_L(0); PG8_BAR; PG8_MMA(1, 0, At, B0); PG8_MMA(1, 1, At, B1); PG8_BAR; PG8_SCHED;
            } else {
            PG8_LDB(B0, 0, 0); PG8_SCHED; PG8_LDA(At, 0, 0); PG8_STAGE(PG8_SA(1, 1), a1 + hstep, voffA);
            PG8_WAIT_L(8); PG8_BAR; PG8_WAIT_L(0); PG8_MMA(0, 0, At, B0); PG8_BAR; PG8_SCHED;
            PG8_LDB(B1, 0, 1); PG8_STAGE(PG8_SB(0, 0), b2, voffB);
            PG8_BAR; PG8_WAIT_L(0); PG8_MMA(0, 1, At, B1); PG8_BAR;
            PG8_LDA(At, 0, 1); PG8_STAGE(PG8_SA(0, 0), a2, voffA);
            PG8_BAR; PG8_WAIT_L(0); PG8_MMA(1, 0, At, B0); PG8_BAR; PG8_SCHED;
            PG8_STAGE(PG8_SB(0, 1), b2 + hstep, voffB);
            PG8_WAIT_V(6); PG8_BAR; PG8_MMA(1, 1, At, B1); PG8_BAR;
            PG8_LDB(B0, 1, 0); PG8_SCHED; PG8_LDA(At, 1, 0); PG8_STAGE(PG8_SA(0, 1), a2 + hstep, voffA);
            PG8_WAIT_L(8); PG8_BAR; PG8_WAIT_L(0); PG8_MMA(0, 0, At, B0); PG8_BAR; PG8_SCHED;
            PG8_LDB(B1, 1, 1); PG8_STAGE(PG8_SB(1, 0), b3, voffB);
            PG8_BAR; PG8_WAIT_L(0); PG8_MMA(0, 1, At, B1); PG8_BAR;
            PG8_LDA(At, 1, 1); PG8_STAGE(PG8_SA(1, 0), a3, voffA);
            PG8_BAR; PG8_WAIT_L(0); PG8_MMA(1, 0, At, B0); PG8_BAR; PG8_SCHED;
            PG8_STAGE(PG8_SB(1, 1), b3 + hstep, voffB);
            PG8_WAIT_V(6); PG8_BAR; PG8_MMA(1, 1, At, B1); PG8_BAR;
            }
        }
        if constexpr (ALIGN_EPI) { if (wr == 0) PG8_BAR; }
        if constexpr (!Epi::AFTER_DRAIN) { E(acc, cur, wr, wc, fr, fq); S.done(cur); }
        if (!has_next) break;
#pragma unroll
        for (int a = 0; a < 2; ++a)
#pragma unroll
            for (int b = 0; b < 2; ++b)
#pragma unroll
                for (int m = 0; m < 4; ++m)
#pragma unroll
                    for (int n = 0; n < 2; ++n) acc[a][b][m][n] = (f32x4){0.f, 0.f, 0.f, 0.f};
        cur = nxt; cA = nA; cB = nB; ++ui;
        if constexpr (ALIGN_EPI) { if (wr == 1) PG8_BAR; }
    }
    PG8_WAIT_V(0);
    if constexpr (!ALIGN_EPI) { if (wr == 0) PG8_BAR; }
    PG8_BAR;
    if constexpr (Epi::AFTER_DRAIN) { E.fused(acc, cur, wr, wc, fr, fq, lds, wid, lane); S.done(cur); }
#undef PG8_SA
#undef PG8_SB
#undef PG8_STAGE
#undef PG8_LDA
#undef PG8_LDB
#undef PG8_MMA
#undef PG8_WAIT_V
#undef PG8_WAIT_L
#undef PG8_BAR
#undef PG8_SCHED
}
}
#define GAS __attribute__((address_space(1)))
#define LAS __attribute__((address_space(3)))
typedef unsigned short bf16;
typedef unsigned v4u __attribute__((ext_vector_type(4)));
typedef float f32x4 __attribute__((ext_vector_type(4)));
typedef short bf16x8 __attribute__((ext_vector_type(8)));
typedef GAS unsigned gu32;
typedef GAS unsigned long long gu64;
#define RLX_AGENT __ATOMIC_RELAXED, __HIP_MEMORY_SCOPE_AGENT
#define LDS_WAIT() asm volatile("s_waitcnt lgkmcnt(0)" ::: "memory")
#define VM_WAIT() asm volatile("s_waitcnt vmcnt(0)" ::: "memory")
__device__ __forceinline__ unsigned long long rt() { return __builtin_amdgcn_s_memrealtime(); }
__device__ __forceinline__ unsigned f2bf(float f) { unsigned u = __builtin_bit_cast(unsigned, f); return (u + 0x7fffu + ((u >> 16) & 1u)) >> 16; }
__device__ __forceinline__ unsigned pk2(float lo, float hi) { return f2bf(lo) | (f2bf(hi) << 16); }

#define XB_TMO      128
#define XB_XCNT(j)  (256  + 64 * (j))
#define XB_XSUB(j)  (1280 + 64 * (j))
#define XB_XGEN(j)  (2304 + 64 * (j))
#define XB_TOP      3328
#define XB_TOPGEN   3392
#define XCD_BAR_WORDS 3456
#define XB_SPIN_CAP (1u << 18)

__device__ __forceinline__ unsigned xb_ld(unsigned* p)              { return __hip_atomic_load(p, __ATOMIC_RELAXED, __HIP_MEMORY_SCOPE_AGENT); }
__device__ __forceinline__ unsigned xb_add(unsigned* p, unsigned v) { return __hip_atomic_fetch_add(p, v, __ATOMIC_RELAXED, __HIP_MEMORY_SCOPE_AGENT); }
__device__ __forceinline__ unsigned xb_xcc_id() { return (unsigned)__builtin_amdgcn_s_getreg((3 << 11) | 20) & 0xFu; }
#define XB_SPIN(cond, bar) do { unsigned _sp = 0; while (cond) { __builtin_amdgcn_s_sleep(1); \
    if ((++_sp & 255u) == 0u) { if (xb_ld(&(bar)[XB_TMO])) break; if (_sp > XB_SPIN_CAP) { atomicAdd(&(bar)[XB_TMO], 1u); break; } } } } while (0)

struct XcdBarrier {
    unsigned* bar; unsigned x;
    volatile LAS unsigned* st;
};

__device__ __forceinline__ XcdBarrier xcd_barrier_post(unsigned* bar, volatile LAS unsigned* st) {
    XcdBarrier b; b.bar = bar; b.x = xb_xcc_id(); b.st = st;
    if (threadIdx.x == 0) (void)xb_add(&bar[XB_XCNT(b.x)], 1u);
    return b;
}
__device__ __forceinline__ void xcd_barrier_complete(unsigned* bar, unsigned x, unsigned& nloc, unsigned& nx) {
    const unsigned G = gridDim.x * gridDim.y * gridDim.z;
    unsigned sum, cnt, mine, sp = 0u;
    for (;;) {
        sum = 0u; cnt = 0u; mine = 0u;
#pragma unroll
        for (unsigned j = 0; j < 16; ++j) { const unsigned c = xb_ld(&bar[XB_XCNT(j)]); sum += c; cnt += (c > 0u) ? 1u : 0u; mine = (j == x) ? c : mine; }
        if (sum == G) break;
        __builtin_amdgcn_s_sleep(1);
        if ((++sp & 255u) == 0u) { if (xb_ld(&bar[XB_TMO])) break; if (sp > XB_SPIN_CAP) { atomicAdd(&bar[XB_TMO], 1u); break; } }
    }
    nloc = mine > 0u ? mine : 1u; nx = cnt > 0u ? cnt : 1u;
}

__device__ __forceinline__ void xcd_barrier(const XcdBarrier& b) {
    asm volatile("s_waitcnt vmcnt(0)" ::: "memory");
    __syncthreads();
    if (threadIdx.x == 0) {
        unsigned* bar = b.bar;
        __builtin_amdgcn_s_waitcnt(0);
        unsigned nloc = b.st[0], nx = b.st[1];
        if (nloc == 0u) { xcd_barrier_complete(bar, b.x, nloc, nx); b.st[0] = nloc; b.st[1] = nx; }
        const unsigned old = xb_add(&bar[XB_XSUB(b.x)], 1u);
        const unsigned gen = old / nloc;
        if (old + 1u == (gen + 1u) * nloc) {
            __builtin_amdgcn_fence(__ATOMIC_RELEASE, "agent");
            asm volatile("s_waitcnt vmcnt(0)" ::: "memory");
            const unsigned og = xb_add(&bar[XB_TOP], 1u);
            const unsigned tg = og / nx;
            if (og + 1u == (tg + 1u) * nx) xb_add(&bar[XB_TOPGEN], 1u);
            else XB_SPIN(xb_ld(&bar[XB_TOPGEN]) == tg, bar);
            __builtin_amdgcn_fence(__ATOMIC_ACQUIRE, "agent");
            xb_add(&bar[XB_XGEN(b.x)], 1u);
            asm volatile("s_waitcnt vmcnt(0)" ::: "memory");
        } else {
            XB_SPIN(xb_ld(&bar[XB_XGEN(b.x)]) == gen, bar);
            __builtin_amdgcn_fence(__ATOMIC_ACQUIRE, "agent");
            asm volatile("s_waitcnt vmcnt(0)" ::: "memory");
        }
    }
    __syncthreads();
}
constexpr int NWAVES = 8;
constexpr int T = 32768, D = 1024, SEQ = 4096;
constexpr float EPS = 1e-6f;
constexpr float LAMBDA_INIT = 0.35550906759f;
constexpr size_t MiB = 1u << 20;
constexpr size_t WS_CTL = 0, CTL_ZERO_BYTES = 1 * MiB;
constexpr size_t WS_ROPE = 1 * MiB;
constexpr size_t WS_WIN = 4 * MiB;
constexpr size_t WS_WO0 = 11 * MiB, WS_WQ0 = 13 * MiB, WS_KEY0 = 17 * MiB, WS_WQKV = 18 * MiB, WS_WO1 = 24 * MiB, WS_WQ1 = 26 * MiB, WS_KEY1 = 30 * MiB;
constexpr size_t WS_U0 = 32 * MiB, WS_V0T = 64 * MiB;
constexpr size_t WS_B0 = 96 * MiB;
constexpr size_t WS_R1 = 160 * MiB, WS_R2 = 224 * MiB, WS_R3 = 288 * MiB, WS_R4 = 352 * MiB, WS_R5 = 416 * MiB, WS_GATES = 480 * MiB;
constexpr size_t WS_END = 484 * MiB;
constexpr int CW_BAR = 4096;
constexpr int LDS_BYTES = 147456, MISC_OFF = LDS_BYTES - 128;

typedef float f32x16 __attribute__((ext_vector_type(16)));
typedef unsigned u32x2 __attribute__((ext_vector_type(2)));
typedef __bf16 bf16x2_t __attribute__((ext_vector_type(2)));
__device__ __forceinline__ float bf_lo(unsigned w) { return __uint_as_float(w << 16); }
__device__ __forceinline__ float bf_hi(unsigned w) { return __uint_as_float(w & 0xffff0000u); }
__device__ __forceinline__ float dot2(unsigned a, unsigned b, float c) { return __builtin_amdgcn_fdot2_f32_bf16(__builtin_bit_cast(bf16x2_t, a), __builtin_bit_cast(bf16x2_t, b), c, false); }
__device__ __forceinline__ float wave_sum(float v) {
#pragma unroll
    for (int o = 1; o < 64; o <<= 1) v += __shfl_xor(v, o);
    return v;
}
__device__ __forceinline__ f32x4 mfma16(bf16x8 a, bf16x8 b, f32x4 c) { return __builtin_amdgcn_mfma_f32_16x16x32_bf16(a, b, c, 0, 0, 0); }
__device__ __forceinline__ f32x16 mfma32(bf16x8 a, bf16x8 b, f32x16 c) { return __builtin_amdgcn_mfma_f32_32x32x16_bf16(a, b, c, 0, 0, 0); }
__device__ __forceinline__ u32x2 pack4(float a, float b, float c, float d) { u32x2 r; r.x = pk2(a, b); r.y = pk2(c, d); return r; }

__device__ __forceinline__ void p0_transpose_item(const float* W, int K, int N, bf16* WT, LAS float* scr, int item, int lane) {
    const int nblk = N / 32, kb = item / nblk, nb = item % nblk, k0 = 64 * kb, n0 = 32 * nb;
#pragma unroll 8
    for (int i = 0; i < 32; ++i) { const int kk = 2 * i + (lane >> 5); scr[kk * 33 + (lane & 31)] = W[(size_t)(k0 + kk) * N + n0 + (lane & 31)]; }
    LDS_WAIT(); asm volatile("" ::: "memory");
    const int c = lane & 7;
#pragma unroll
    for (int j = 0; j < 4; ++j) { const int n = (lane >> 3) + 8 * j; const LAS float* s = scr + (8 * c) * 33 + n;
        v4u o; o.x = pk2(s[0 * 33], s[1 * 33]); o.y = pk2(s[2 * 33], s[3 * 33]); o.z = pk2(s[4 * 33], s[5 * 33]); o.w = pk2(s[6 * 33], s[7 * 33]);
        *(v4u*)(WT + (size_t)(n0 + n) * K + k0 + 8 * c) = o; }
    LDS_WAIT(); asm volatile("" ::: "memory");
}
__device__ __forceinline__ void cvt_range(const float* src, bf16* dst, size_t n, size_t gtid, size_t gthreads) {
    for (size_t i = gtid * 8; i < n; i += gthreads * 8) {
        const f32x4 a = *(const f32x4*)(src + i), b = *(const f32x4*)(src + i + 4);
        v4u o; o.x = pk2(a.x, a.y); o.y = pk2(a.z, a.w); o.z = pk2(b.x, b.y); o.w = pk2(b.z, b.w);
        *(v4u*)(dst + i) = o; }
}
__device__ __forceinline__ void rms_row_to_bf16(const float* xrow, const float* g, bf16* orow, int lane) {
    const f32x4* xr = (const f32x4*)xrow + lane; const f32x4* gr = (const f32x4*)g + lane;
    f32x4 v[4]; float s = 0.f;
#pragma unroll
    for (int j = 0; j < 4; ++j) { v[j] = xr[64 * j]; s += (v[j].x * v[j].x + v[j].y * v[j].y) + (v[j].z * v[j].z + v[j].w * v[j].w); }
    const float rstd = rsqrtf(wave_sum(s) * (1.f / 1024.f) + EPS);
    unsigned long long* o8 = (unsigned long long*)orow + lane;
#pragma unroll
    for (int j = 0; j < 4; ++j) { const f32x4 gg = gr[64 * j];
        o8[64 * j] = (unsigned long long)pk2(v[j].x * rstd * gg.x, v[j].y * rstd * gg.y) | ((unsigned long long)pk2(v[j].z * rstd * gg.z, v[j].w * rstd * gg.w) << 32); }
}
__device__ __forceinline__ void rms_pass(const float* X, const float* g, bf16* XN, int gw, int NGW, int lane) {
    for (int m = gw; m < T; m += NGW) rms_row_to_bf16(X + (size_t)m * D, g, XN + (size_t)m * D, lane);
}

__device__ __forceinline__ float logsigmoid_f(float f) { return fminf(f, 0.f) - log1pf(__expf(-fabsf(f))); }
#define ML_LOAD(ci_) do { const size_t r_ = rowbase + (size_t)(ci_) * 64 + lane; \
    rq = *(const v4u*)(Q0 + r_ * 64 + 8 * w); rk = *(const v4u*)(K0 + r_ * 64 + 8 * w); rv0 = *(const v4u*)(V0 + r_ * 128 + 16 * w); rv1 = *(const v4u*)(V0 + r_ * 128 + 16 * w + 8); \
    const size_t gm_ = ((size_t)b * 4096 + (size_t)(ci_) * 64 + jr) * 32; rli = GATES[gm_ + (dir ? 16 : 0) + h]; rf = GATES[gm_ + (dir ? 24 : 8) + h]; } while (0)
__device__ __forceinline__ void mlstm_phase(LAS unsigned char* lds, const bf16* Q0, const bf16* K0, const bf16* V0, const float* GATES, bf16* HF, bf16* HB) {
    const int bx = blockIdx.x;
    if ((bx >> 3) & 1) return;
    const int seq = (bx >> 4) * 8 + (bx & 7);
    const int dir = seq & 1, bh = seq >> 1, b = bh >> 3, h = bh & 7;
    int tid_ = threadIdx.x; asm volatile("" : "+v"(tid_)); const int tid = tid_, lane = tid & 63, w = __builtin_amdgcn_readfirstlane(tid >> 6), fr = lane & 15, fq = lane >> 4;
    LAS bf16* Qs = (LAS bf16*)(lds); LAS bf16* Ks = (LAS bf16*)(lds + 9216); LAS bf16* Kwt = (LAS bf16*)(lds + 18432); LAS bf16* Ps = (LAS bf16*)(lds + 27648);
    LAS bf16* Vt = (LAS bf16*)(lds + 36864 + w * 2304); LAS bf16* Cs = (LAS bf16*)(lds + 55296 + w * 2304); LAS bf16* nb = (LAS bf16*)(lds + 73728 + w * 128);
    LAS float* gc = (LAS float*)(lds + 74752 + w * 1280); LAS float* gM = gc + 64; LAS float* gI = gc + 128; LAS float* gE = gc + 192; LAS float* gW = gc + 256;
    for (int i = lane; i < 2304 / 4; i += 64) ((LAS unsigned*)Cs)[i] = 0u;
    if (lane < 32) ((LAS unsigned*)nb)[lane] = 0u;
    f32x4 Cacc[4], Nacc[4];
#pragma unroll
    for (int i = 0; i < 4; ++i) { Cacc[i] = (f32x4){0.f, 0.f, 0.f, 0.f}; Nacc[i] = (f32x4){0.f, 0.f, 0.f, 0.f}; }
    float m = -1e30f;
    bf16* Hout = dir ? HB : HF;
    const size_t rowbase = (size_t)bh * 4096;
    const int jr = dir ? 63 - lane : lane;
    v4u rq, rk, rv0, rv1; float rli, rf;
    ML_LOAD(dir ? 63 : 0);
    const bf16x8 ones = (bf16x8){0x3F80, 0x3F80, 0x3F80, 0x3F80, 0x3F80, 0x3F80, 0x3F80, 0x3F80};
    const f32x4 z4 = (f32x4){0.f, 0.f, 0.f, 0.f};
#pragma unroll 1
    for (int step = 0; step < 64; ++step) {
        const int ci = dir ? 63 - step : step;
        const float lf = logsigmoid_f(rf);
        float bcs = lf;
#pragma unroll
        for (int d = 1; d < 64; d <<= 1) { const float t = __shfl_up(bcs, d); if (lane >= d) bcs += t; }
        const float c = rli - bcs;
        float pm = c;
#pragma unroll
        for (int d = 1; d < 64; d <<= 1) { const float t = __shfl_up(pm, d); if (lane >= d) pm = fmaxf(pm, t); }
        const float M = fmaxf(m, pm);
        const float bL = __shfl(bcs, 63), Mlast = __shfl(M, 63);
        gc[jr] = c; gM[jr] = M; gI[jr] = __expf(m - M); gE[jr] = __expf(-(bcs + M)); gW[jr] = __expf(c - Mlast);
        const float sp = __expf(m - Mlast), m_new = bL + Mlast;
        const float wr_ = gW[lane];
        *(LAS v4u*)(Qs + lane * 72 + 8 * w) = rq; *(LAS v4u*)(Ks + lane * 72 + 8 * w) = rk;
#pragma unroll
        for (int i = 0; i < 4; ++i) { const unsigned kw = rk[i]; Kwt[(8 * w + 2 * i) * 72 + lane] = (bf16)f2bf(bf_lo(kw) * wr_); Kwt[(8 * w + 2 * i + 1) * 72 + lane] = (bf16)f2bf(bf_hi(kw) * wr_); }
#pragma unroll
        for (int i = 0; i < 4; ++i) { Vt[(2 * i) * 72 + lane] = (bf16)(rv0[i] & 0xffffu); Vt[(2 * i + 1) * 72 + lane] = (bf16)(rv0[i] >> 16);
                                      Vt[(8 + 2 * i) * 72 + lane] = (bf16)(rv1[i] & 0xffffu); Vt[(9 + 2 * i) * 72 + lane] = (bf16)(rv1[i] >> 16); }
        __syncthreads();
        if (step < 63) ML_LOAD(dir ? 62 - step : step + 1);
        {
            const int st = w >> 1;
            const bf16x8 a0 = *(const LAS bf16x8*)(Ks + (16 * st + fr) * 72 + 8 * fq), a1 = *(const LAS bf16x8*)(Ks + (16 * st + fr) * 72 + 32 + 8 * fq);
#pragma unroll
            for (int u = 0; u < 2; ++u) { const int tt = 2 * (w & 1) + u;
                const bf16x8 b0 = *(const LAS bf16x8*)(Qs + (16 * tt + fr) * 72 + 8 * fq), b1 = *(const LAS bf16x8*)(Qs + (16 * tt + fr) * 72 + 32 + 8 * fq);
                f32x4 acc = mfma16(a0, b0, z4); acc = mfma16(a1, b1, acc);
                const int t = 16 * tt + fr; const float Mt = gM[t]; float pv[4];
#pragma unroll
                for (int i = 0; i < 4; ++i) { const int s = 16 * st + 4 * fq + i; const bool valid = dir ? (s >= t) : (s <= t); const float e = __expf(gc[s] - Mt); pv[i] = valid ? acc[i] * e : 0.f; }
                *(LAS u32x2*)(Ps + t * 72 + 16 * st + 4 * fq) = pack4(pv[0], pv[1], pv[2], pv[3]); }
        }
        __syncthreads();
        const bf16x8 aV0 = *(const LAS bf16x8*)(Vt + fr * 72 + 8 * fq), aV1 = *(const LAS bf16x8*)(Vt + fr * 72 + 32 + 8 * fq);
        {
            const bf16x8 aC0 = *(const LAS bf16x8*)(Cs + fr * 72 + 8 * fq), aC1 = *(const LAS bf16x8*)(Cs + fr * 72 + 32 + 8 * fq);
            const bf16x8 aN0 = *(const LAS bf16x8*)(nb + 8 * fq), aN1 = *(const LAS bf16x8*)(nb + 32 + 8 * fq);
#pragma unroll
            for (int tt = 0; tt < 4; ++tt) {
                const bf16x8 bP0 = *(const LAS bf16x8*)(Ps + (16 * tt + fr) * 72 + 8 * fq), bP1 = *(const LAS bf16x8*)(Ps + (16 * tt + fr) * 72 + 32 + 8 * fq);
                const bf16x8 bQ0 = *(const LAS bf16x8*)(Qs + (16 * tt + fr) * 72 + 8 * fq), bQ1 = *(const LAS bf16x8*)(Qs + (16 * tt + fr) * 72 + 32 + 8 * fq);
                f32x4 acc1 = mfma16(aV0, bP0, z4); acc1 = mfma16(aV1, bP1, acc1);
                f32x4 acc2 = mfma16(aC0, bQ0, z4); acc2 = mfma16(aC1, bQ1, acc2);
                f32x4 d1 = mfma16(ones, bP0, z4); d1 = mfma16(ones, bP1, d1);
                f32x4 d2 = mfma16(aN0, bQ0, z4); d2 = mfma16(aN1, bQ1, d2);
                const int t = 16 * tt + fr; const float it = gI[t], en = gE[t];
                const float den = d1[0] + it * d2[0]; const float inv = 1.f / fmaxf(fabsf(den), en);
                *(u32x2*)(Hout + ((size_t)b * 4096 + (size_t)ci * 64 + t) * 1024 + h * 128 + 16 * w + 4 * fq) =
                    pack4((acc1[0] + it * acc2[0]) * inv, (acc1[1] + it * acc2[1]) * inv, (acc1[2] + it * acc2[2]) * inv, (acc1[3] + it * acc2[3]) * inv);
            }
        }
#pragma unroll
        for (int dt = 0; dt < 4; ++dt) { Cacc[dt] = Cacc[dt] * sp; Nacc[dt] = Nacc[dt] * sp;
            const bf16x8 aK0 = *(const LAS bf16x8*)(Kwt + (16 * dt + fr) * 72 + 8 * fq), aK1 = *(const LAS bf16x8*)(Kwt + (16 * dt + fr) * 72 + 32 + 8 * fq);
            Cacc[dt] = mfma16(aK0, aV0, Cacc[dt]); Cacc[dt] = mfma16(aK1, aV1, Cacc[dt]);
            Nacc[dt] = mfma16(aK0, ones, Nacc[dt]); Nacc[dt] = mfma16(aK1, ones, Nacc[dt]); }
#pragma unroll
        for (int dt = 0; dt < 4; ++dt) { *(LAS u32x2*)(Cs + fr * 72 + 16 * dt + 4 * fq) = pack4(Cacc[dt][0], Cacc[dt][1], Cacc[dt][2], Cacc[dt][3]);
                                         *(LAS u32x2*)(nb + 16 * dt + 4 * fq) = pack4(Nacc[dt][0], Nacc[dt][1], Nacc[dt][2], Nacc[dt][3]); }
        m = m_new;
        __syncthreads();
    }
}
#undef ML_LOAD

__device__ __forceinline__ void hs_pass(const bf16* HF, const bf16* HB, const bf16* OG, const float* hg, bf16* HS, int gw, int NGW, int lane) {
    for (int m = gw; m < T; m += NGW) {
        const size_t off = (size_t)m * 1024 + 16 * lane;
        const v4u f0 = *(const v4u*)(HF + off), f1 = *(const v4u*)(HF + off + 8), b0 = *(const v4u*)(HB + off), b1 = *(const v4u*)(HB + off + 8), o0 = *(const v4u*)(OG + off), o1 = *(const v4u*)(OG + off + 8);
        float x[16], og[16];
#pragma unroll
        for (int i = 0; i < 4; ++i) { x[2 * i] = bf_lo(f0[i]) + bf_lo(b0[i]); x[2 * i + 1] = bf_hi(f0[i]) + bf_hi(b0[i]); x[8 + 2 * i] = bf_lo(f1[i]) + bf_lo(b1[i]); x[9 + 2 * i] = bf_hi(f1[i]) + bf_hi(b1[i]);
                                      og[2 * i] = bf_lo(o0[i]); og[2 * i + 1] = bf_hi(o0[i]); og[8 + 2 * i] = bf_lo(o1[i]); og[9 + 2 * i] = bf_hi(o1[i]); }
        float ss = 0.f;
#pragma unroll
        for (int i = 0; i < 16; ++i) ss += x[i] * x[i];
        ss += __shfl_xor(ss, 1); ss += __shfl_xor(ss, 2); ss += __shfl_xor(ss, 4);
        const float rstd = rsqrtf(ss * (1.f / 128.f) + EPS);
        float y[16];
#pragma unroll
        for (int i = 0; i < 16; ++i) y[i] = x[i] * rstd * hg[16 * lane + i] * (1.f / (1.f + __expf(-og[i])));
        v4u w0, w1;
#pragma unroll
        for (int i = 0; i < 4; ++i) { w0[i] = pk2(y[2 * i], y[2 * i + 1]); w1[i] = pk2(y[8 + 2 * i], y[9 + 2 * i]); }
        *(v4u*)(HS + off) = w0; *(v4u*)(HS + off + 8) = w1;
    }
}

#define TK_INSERT(v, x) do { float c_ = (x); _Pragma("unroll") for (int j_ = 0; j_ < 16; ++j_) { const float h_ = fmaxf(v[j_], c_); c_ = fminf(v[j_], c_); v[j_] = h_; } } while (0)
__device__ __forceinline__ void peer_topk_phase(int vcu, const bf16* PQ, const bf16* KEYS, int* EXPERTS, float* GATESP) {
    int tid_ = threadIdx.x; asm volatile("" : "+v"(tid_)); const int tid = tid_, lane = tid & 63, w = __builtin_amdgcn_readfirstlane(tid >> 6), r32 = lane & 31, hi = lane >> 5;
    const int t = vcu * 128 + (w & 3) * 32 + r32, hg = w >> 2;
    const float NINF = -INFINITY;
#pragma unroll 1
    for (int hh = 0; hh < 4; ++hh) {
        const int head = hg * 4 + hh;
        float L0[16], L1[16];
#pragma unroll
        for (int j = 0; j < 16; ++j) { L0[j] = 0.f; L1[j] = 0.f; }
#pragma unroll 1
        for (int p = 0; p < 2; ++p) {
            const int hp = head * 2 + p;
            bf16x8 bq[8];
#pragma unroll
            for (int ks = 0; ks < 8; ++ks) bq[ks] = *(const bf16x8*)(PQ + (size_t)t * 2048 + head * 256 + p * 128 + ks * 16 + 8 * hi);
            f32x16 acc[4];
#pragma unroll
            for (int nt = 0; nt < 4; ++nt) {
#pragma unroll
                for (int r = 0; r < 16; ++r) acc[nt][r] = 0.f;
#pragma unroll
                for (int ks = 0; ks < 8; ++ks) { const bf16x8 a = *(const bf16x8*)(KEYS + ((size_t)(hp * 128 + nt * 32 + r32)) * 128 + ks * 16 + 8 * hi); acc[nt] = mfma32(a, bq[ks], acc[nt]); }
            }
            float v[16];
#pragma unroll
            for (int j = 0; j < 16; ++j) v[j] = NINF;
#pragma unroll
            for (int nt = 0; nt < 4; ++nt)
#pragma unroll
                for (int r = 0; r < 16; ++r) { const int n = nt * 32 + (r & 3) + 8 * (r >> 2) + 4 * hi;
                    const float x = __uint_as_float((__float_as_uint(acc[nt][r]) & ~0x7Fu) | (unsigned)(127 - n)); TK_INSERT(v, x); }
            float wv[16];
#pragma unroll
            for (int j = 0; j < 16; ++j) wv[j] = __shfl_xor(v[j], 32);
#pragma unroll
            for (int j = 0; j < 16; ++j) TK_INSERT(v, wv[j]);
            if (p == 0) {
#pragma unroll
                for (int j = 0; j < 16; ++j) L0[j] = v[j];
            } else {
#pragma unroll
                for (int j = 0; j < 16; ++j) L1[j] = v[j];
            }
        }
        float tv[16];
#pragma unroll
        for (int j = 0; j < 16; ++j) tv[j] = NINF;
        unsigned IA[4] = {0u, 0u, 0u, 0u}, IB[4] = {0u, 0u, 0u, 0u};
#pragma unroll
        for (int i = 0; i < 16; ++i) { IA[i >> 2] |= (127u - (__float_as_uint(L0[i]) & 0x7Fu)) << (8 * (i & 3)); IB[i >> 2] |= (127u - (__float_as_uint(L1[i]) & 0x7Fu)) << (8 * (i & 3)); }
#pragma unroll
        for (int i = 0; i < 16; ++i) {
            const float va = __uint_as_float(__float_as_uint(L0[i]) & ~0x7Fu);
#pragma unroll
            for (int j = 0; j < 16; ++j) if ((i + 1) * (j + 1) <= 16) {
                const float vb = __uint_as_float(__float_as_uint(L1[j]) & ~0x7Fu);
                const float key = __uint_as_float((__float_as_uint(va + vb) & ~0xFFu) | (unsigned)(255 - (i * 16 + j)));
                TK_INSERT(tv, key);
            }
        }
        int ti[16];
#pragma unroll
        for (int j = 0; j < 16; ++j) { const unsigned kb = __float_as_uint(tv[j]); const unsigned flat = 255u - (kb & 0xFFu); const unsigned fi = flat >> 4, fj = flat & 15u;
            const unsigned ra = (fi < 8u) ? ((fi < 4u) ? IA[0] : IA[1]) : ((fi < 12u) ? IA[2] : IA[3]);
            const unsigned rb = (fj < 8u) ? ((fj < 4u) ? IB[0] : IB[1]) : ((fj < 12u) ? IB[2] : IB[3]);
            ti[j] = (int)(((ra >> (8u * (fi & 3u))) & 0xFFu) * 128u + ((rb >> (8u * (fj & 3u))) & 0xFFu));
            tv[j] = __uint_as_float(kb & ~0xFFu); }
        float e[16], sum = 0.f;
#pragma unroll
        for (int j = 0; j < 16; ++j) { e[j] = __expf(tv[j] - tv[0]); sum += e[j]; }
        const float inv = 1.f / sum;
        if (hi == 0) { int* ep = EXPERTS + (size_t)t * 128 + head * 16;
#pragma unroll
            for (int j = 0; j < 4; ++j) *(v4u*)(ep + 4 * j) = (v4u){(unsigned)ti[4 * j], (unsigned)ti[4 * j + 1], (unsigned)ti[4 * j + 2], (unsigned)ti[4 * j + 3]}; }
        else { float* gp = GATESP + (size_t)t * 128 + head * 16;
#pragma unroll
            for (int j = 0; j < 4; ++j) *(f32x4*)(gp + 4 * j) = (f32x4){e[4 * j] * inv, e[4 * j + 1] * inv, e[4 * j + 2] * inv, e[4 * j + 3] * inv}; }
    }
}

#define RED_STEP(N, S) do { const bool up_ = (lane & (S)) != 0; _Pragma("unroll") for (int j_ = 0; j_ < (N); ++j_) { const float a_ = p[j_], b_ = p[j_ + (N)]; const float send_ = up_ ? a_ : b_, keep_ = up_ ? b_ : a_; p[j_] = keep_ + __shfl_xor(send_, (S)); } } while (0)
template <bool NEXT_NORM>
__device__ __forceinline__ void peer_gather_phase(int vcu, const bf16* HN, const int* EXPERTS, const float* GATESP, const bf16* U, const bf16* Vtab, float* X, const float* gnext, bf16* XN) {
    int tid_ = threadIdx.x; asm volatile("" : "+v"(tid_)); const int tid = tid_, lane = tid & 63, w = __builtin_amdgcn_readfirstlane(tid >> 6);
#pragma unroll 1
    for (int i = 0; i < 16; ++i) {
        const int t = vcu * 128 + w * 16 + i;
        const v4u hA = *(const v4u*)(HN + (size_t)t * 1024 + 8 * lane), hB = *(const v4u*)(HN + (size_t)t * 1024 + 512 + 8 * lane);
        float o[16];
#pragma unroll
        for (int k = 0; k < 16; ++k) o[k] = 0.f;
#pragma unroll 1
        for (int half = 0; half < 2; ++half) {
            const int ev = EXPERTS[(size_t)t * 128 + half * 64 + lane]; const float gv = GATESP[(size_t)t * 128 + half * 64 + lane];
            float p[64];
#pragma unroll
            for (int j = 0; j < 64; ++j) {
                const int e = __builtin_amdgcn_readlane(ev, j);
                const v4u* row = (const v4u*)(U + (size_t)e * 1024);
                const v4u a = row[lane], bb = row[64 + lane];
                float acc = dot2(a.x, hA.x, 0.f); acc = dot2(a.y, hA.y, acc); acc = dot2(a.z, hA.z, acc); acc = dot2(a.w, hA.w, acc);
                acc = dot2(bb.x, hB.x, acc); acc = dot2(bb.y, hB.y, acc); acc = dot2(bb.z, hB.z, acc); acc = dot2(bb.w, hB.w, acc);
                p[j] = acc;
            }
            RED_STEP(32, 32); RED_STEP(16, 16); RED_STEP(8, 8); RED_STEP(4, 4); RED_STEP(2, 2); RED_STEP(1, 1);
            const float act = p[0];
            const float coef = gv * (0.5f * act * (1.f + erff(act * 0.70710678118f)));
#pragma unroll
            for (int j = 0; j < 64; ++j) {
                const int e = __builtin_amdgcn_readlane(ev, j);
                const float c = __uint_as_float(__builtin_amdgcn_readlane(__float_as_uint(coef), j));
                const v4u* row = (const v4u*)(Vtab + (size_t)e * 1024);
                const v4u a = row[lane], bb = row[64 + lane];
#pragma unroll
                for (int k = 0; k < 4; ++k) { o[2 * k] += c * bf_lo(a[k]); o[2 * k + 1] += c * bf_hi(a[k]); o[8 + 2 * k] += c * bf_lo(bb[k]); o[9 + 2 * k] += c * bf_hi(bb[k]); }
            }
        }
        float* xr = X + (size_t)t * 1024;
        f32x4 x0 = *(const f32x4*)(xr + 8 * lane), x1 = *(const f32x4*)(xr + 8 * lane + 4), x2 = *(const f32x4*)(xr + 512 + 8 * lane), x3 = *(const f32x4*)(xr + 512 + 8 * lane + 4);
        x0 += (f32x4){o[0], o[1], o[2], o[3]}; x1 += (f32x4){o[4], o[5], o[6], o[7]}; x2 += (f32x4){o[8], o[9], o[10], o[11]}; x3 += (f32x4){o[12], o[13], o[14], o[15]};
        *(f32x4*)(xr + 8 * lane) = x0; *(f32x4*)(xr + 8 * lane + 4) = x1; *(f32x4*)(xr + 512 + 8 * lane) = x2; *(f32x4*)(xr + 512 + 8 * lane + 4) = x3;
        if (NEXT_NORM) {
            float ss = (x0.x * x0.x + x0.y * x0.y) + (x0.z * x0.z + x0.w * x0.w) + (x1.x * x1.x + x1.y * x1.y) + (x1.z * x1.z + x1.w * x1.w)
                     + (x2.x * x2.x + x2.y * x2.y) + (x2.z * x2.z + x2.w * x2.w) + (x3.x * x3.x + x3.y * x3.y) + (x3.z * x3.z + x3.w * x3.w);
            const float rstd = rsqrtf(wave_sum(ss) * (1.f / 1024.f) + EPS);
            const f32x4 g0 = *(const f32x4*)(gnext + 8 * lane), g1 = *(const f32x4*)(gnext + 8 * lane + 4), g2 = *(const f32x4*)(gnext + 512 + 8 * lane), g3 = *(const f32x4*)(gnext + 512 + 8 * lane + 4);
            v4u wa, wb;
            wa.x = pk2(x0.x * rstd * g0.x, x0.y * rstd * g0.y); wa.y = pk2(x0.z * rstd * g0.z, x0.w * rstd * g0.w); wa.z = pk2(x1.x * rstd * g1.x, x1.y * rstd * g1.y); wa.w = pk2(x1.z * rstd * g1.z, x1.w * rstd * g1.w);
            wb.x = pk2(x2.x * rstd * g2.x, x2.y * rstd * g2.y); wb.y = pk2(x2.z * rstd * g2.z, x2.w * rstd * g2.w); wb.z = pk2(x3.x * rstd * g3.x, x3.y * rstd * g3.y); wb.w = pk2(x3.z * rstd * g3.z, x3.w * rstd * g3.w);
            *(v4u*)(XN + (size_t)t * 1024 + 8 * lane) = wa; *(v4u*)(XN + (size_t)t * 1024 + 512 + 8 * lane) = wb;
        }
    }
}

__device__ __forceinline__ void qknorm_rope_pass(bf16* Q1, bf16* K1, const float* qg, const float* kg, const float* rope, size_t gtid, size_t gthreads) {
    const size_t NROWS = (size_t)2 * 64 * 2 * 4096;
    for (size_t id = gtid; id < NROWS * 8; id += gthreads) {
        const size_t rowg = id >> 3; const int part = (int)(id & 7);
        const bool isk = rowg >= NROWS / 2; const size_t row = isk ? rowg - NROWS / 2 : rowg;
        bf16* ptr = (isk ? K1 : Q1) + row * 64 + part * 8; const float* g = (isk ? kg : qg) + part * 8;
        const int s = (int)(row & 4095); const int bh = (int)(row >> 13); const int bidx = bh >> 3; const size_t mtok = (size_t)bidx * 4096 + s;
        const v4u raw = *(const v4u*)ptr;
        float x[8];
#pragma unroll
        for (int i = 0; i < 4; ++i) { x[2 * i] = bf_lo(raw[i]); x[2 * i + 1] = bf_hi(raw[i]); }
        float ss = 0.f;
#pragma unroll
        for (int i = 0; i < 8; ++i) ss += x[i] * x[i];
        ss += __shfl_xor(ss, 1); ss += __shfl_xor(ss, 2); ss += __shfl_xor(ss, 4);
        const float rstd = rsqrtf(ss * (1.f / 64.f) + EPS);
        float y[8], other[8];
#pragma unroll
        for (int i = 0; i < 8; ++i) y[i] = x[i] * rstd * g[i];
#pragma unroll
        for (int i = 0; i < 8; ++i) other[i] = __shfl_xor(y[i], 1);
        if (part < 2) { const float* cs = rope + mtok * 16;
#pragma unroll
            for (int i = 0; i < 8; ++i) { const float co = cs[i], si = cs[8 + i]; y[i] = (part == 0) ? (y[i] * co - other[i] * si) : (y[i] * co + other[i] * si); } }
        const float sc = isk ? 1.f : (0.125f * 1.44269504089f);
        v4u o;
#pragma unroll
        for (int i = 0; i < 4; ++i) o[i] = pk2(y[2 * i] * sc, y[2 * i + 1] * sc);
        *(v4u*)ptr = o;
    }
}

#define AT_LOAD(kt_) do { _Pragma("unroll") for (int i_ = 0; i_ < 2; ++i_) { rK[i_] = *(const v4u*)(K1 + ((size_t)((bh * 2 + i_) * 4096 + (kt_) * 64 + (tid >> 3))) * 64 + (tid & 7) * 8); \
        rV[i_] = *(const v4u*)(V1 + ((size_t)(bh * 4096 + (kt_) * 64 + lane)) * 128 + (2 * w + i_) * 8); } } while (0)
#define AT_WRITE(buf_) do { _Pragma("unroll") for (int i_ = 0; i_ < 2; ++i_) { *(LAS v4u*)(lds + (buf_) * 35840 + i_ * 9216 + ((tid >> 3) * 72 + (tid & 7) * 8) * 2) = rK[i_]; \
        LAS bf16* vt_ = (LAS bf16*)(lds + (buf_) * 35840 + 18432) + ((2 * w + i_) * 8) * 68 + lane; \
        _Pragma("unroll") for (int e_ = 0; e_ < 4; ++e_) { vt_[(2 * e_) * 68] = (bf16)(rV[i_][e_] & 0xffffu); vt_[(2 * e_ + 1) * 68] = (bf16)(rV[i_][e_] >> 16); } } } while (0)
__device__ __forceinline__ void attn_phase(LAS unsigned char* lds, int vcu, const bf16* Q1, const bf16* K1, const bf16* V1, bf16* O, const float* qg, const float* kg,
                                           const float* lq1, const float* lk1, const float* lq2, const float* lk2, const float* subln) {
    int tid_ = threadIdx.x; asm volatile("" : "+v"(tid_)); const int tid = tid_, lane = tid & 63, w = __builtin_amdgcn_readfirstlane(tid >> 6), r32 = lane & 31, hi = lane >> 5, qt = w & 3, c = w >> 2;
    float s1 = 0.f, s2 = 0.f, mq = 0.f, mk = 0.f;
    for (int i = 0; i < 64; ++i) { s1 += lq1[i] * lk1[i]; s2 += lq2[i] * lk2[i]; mq = fmaxf(mq, fabsf(qg[i])); mk = fmaxf(mk, fabsf(kg[i])); }
    const float lam = expf(s1) - expf(s2) + LAMBDA_INIT;
    const float offs = 8.f * mq * mk * 1.44269504089f * 1.02f + 0.25f;
    f32x16 cinit;
#pragma unroll
    for (int r = 0; r < 16; ++r) cinit[r] = -offs;
    LAS float* lbuf = (LAS float*)(lds + 135168 + w * 128);
    LAS float* Obuf = (LAS float*)lds;
#pragma unroll 1
    for (int ui = 0; ui < 8; ++ui) {
        const int uid = vcu * 8 + ui, bh = uid >> 5, qb = uid & 31, b = bh >> 3, h = bh & 7;
        bf16x8 bq[4];
#pragma unroll
        for (int ks = 0; ks < 4; ++ks) bq[ks] = *(const bf16x8*)(Q1 + ((size_t)((bh * 2 + c) * 4096 + qb * 128 + qt * 32 + r32)) * 64 + ks * 16 + 8 * hi);
        f32x16 Oa[4];
#pragma unroll
        for (int db = 0; db < 4; ++db)
#pragma unroll
            for (int r = 0; r < 16; ++r) Oa[db][r] = 0.f;
        float lsum = 0.f;
        v4u rK[2], rV[2];
        AT_LOAD(0); AT_WRITE(0); AT_LOAD(1);
        __syncthreads();
#pragma unroll 1
        for (int kt = 0; kt < 64; ++kt) {
            const int buf = kt & 1;
            if (kt + 1 < 64) AT_WRITE(buf ^ 1);
            if (kt + 2 < 64) AT_LOAD(kt + 2);
            const LAS bf16* Kc = (const LAS bf16*)(lds + buf * 35840 + c * 9216);
            const LAS bf16* Vt = (const LAS bf16*)(lds + buf * 35840 + 18432);
            f32x16 p0 = cinit, p1 = cinit;
#pragma unroll
            for (int ks = 0; ks < 4; ++ks) { const bf16x8 a0 = *(const LAS bf16x8*)(Kc + r32 * 72 + ks * 16 + 8 * hi), a1 = *(const LAS bf16x8*)(Kc + (32 + r32) * 72 + ks * 16 + 8 * hi);
                p0 = mfma32(a0, bq[ks], p0); p1 = mfma32(a1, bq[ks], p1); }
            float ls = 0.f;
#pragma unroll
            for (int r = 0; r < 16; ++r) { p0[r] = __builtin_amdgcn_exp2f(p0[r]); p1[r] = __builtin_amdgcn_exp2f(p1[r]); ls += p0[r] + p1[r]; }
            lsum += ls;
            bf16x8 pa[4];
            { v4u t0, t1, t2, t3;
#pragma unroll
              for (int k = 0; k < 4; ++k) { t0[k] = pk2(p0[2 * k], p0[2 * k + 1]); t1[k] = pk2(p0[8 + 2 * k], p0[9 + 2 * k]); t2[k] = pk2(p1[2 * k], p1[2 * k + 1]); t3[k] = pk2(p1[8 + 2 * k], p1[9 + 2 * k]); }
              pa[0] = __builtin_bit_cast(bf16x8, t0); pa[1] = __builtin_bit_cast(bf16x8, t1); pa[2] = __builtin_bit_cast(bf16x8, t2); pa[3] = __builtin_bit_cast(bf16x8, t3); }
#pragma unroll
            for (int sp_ = 0; sp_ < 4; ++sp_)
#pragma unroll
                for (int db = 0; db < 4; ++db) { const LAS bf16* vp = Vt + (32 * db + r32) * 68 + 16 * sp_ + 4 * hi;
                    const u32x2 lo = *(const LAS u32x2*)vp, hh = *(const LAS u32x2*)(vp + 8);
                    const v4u vv = (v4u){lo.x, lo.y, hh.x, hh.y};
                    Oa[db] = mfma32(pa[sp_], __builtin_bit_cast(bf16x8, vv), Oa[db]); }
            __syncthreads();
        }
        lsum += __shfl_xor(lsum, 32);
        lbuf[r32] = lsum;
#pragma unroll
        for (int r = 0; r < 16; ++r) { const int qrow = (r & 3) + 8 * (r >> 2) + 4 * hi; const float inv = 1.f / lbuf[qrow];
#pragma unroll
            for (int db = 0; db < 4; ++db) Obuf[(c * 128 + qt * 32 + qrow) * 132 + 32 * db + r32] = Oa[db][r] * inv; }
        __syncthreads();
        { const int row = tid >> 2, qd = tid & 3;
          float dv[32]; float ss = 0.f;
#pragma unroll
          for (int k = 0; k < 8; ++k) { const f32x4 o0 = *(const LAS f32x4*)(Obuf + row * 132 + qd * 32 + 4 * k), o1 = *(const LAS f32x4*)(Obuf + (128 + row) * 132 + qd * 32 + 4 * k);
#pragma unroll
              for (int e = 0; e < 4; ++e) { const float d = o0[e] - lam * o1[e]; dv[4 * k + e] = d; ss += d * d; } }
          ss += __shfl_xor(ss, 1); ss += __shfl_xor(ss, 2);
          const float rstd = rsqrtf(ss * (1.f / 128.f) + EPS) * (1.f - LAMBDA_INIT);
          bf16* op = O + ((size_t)b * 4096 + qb * 128 + row) * 1024 + h * 128 + qd * 32;
#pragma unroll
          for (int k = 0; k < 4; ++k) { v4u o;
#pragma unroll
              for (int e = 0; e < 4; ++e) o[e] = pk2(dv[8 * k + 2 * e] * rstd * subln[qd * 32 + 8 * k + 2 * e], dv[8 * k + 2 * e + 1] * rstd * subln[qd * 32 + 8 * k + 2 * e + 1]);
              *(v4u*)(op + 8 * k) = o; } }
        __syncthreads();
    }
}
#undef AT_LOAD
#undef AT_WRITE
struct Args { const void* in[27]; float* out; unsigned char* ws; };
#define KARG(i) ({ const void* p_; asm volatile("s_load_dwordx2 %0, %1, %2\n\ts_waitcnt lgkmcnt(0)" : "=s"(p_) : "s"(__builtin_amdgcn_kernarg_segment_ptr()), "i"(8 * (i))); p_; })
#define KIN(i) ((const float*)KARG(i))
#define KOUT() ((float*)KARG(27))
#define KWS() ((unsigned char*)KARG(28))
#define WSP(T_, off) ((T_*)(KWS() + (off)))
__global__ void __launch_bounds__(NWAVES * 64, 2) mk_fwd(Args args) {
    extern __shared__ __attribute__((aligned(16))) unsigned char lds_raw[];
    LAS unsigned char* lds = (LAS unsigned char*)lds_raw;
    const int G = gridDim.x, bx = blockIdx.x;
    const int vcu = (G % 8 == 0) ? (bx % 8) * (G / 8) + bx / 8 : bx;
#define PH_IDS() int tid_ = threadIdx.x; asm volatile("" : "+v"(tid_)); const int tid = tid_, lane = tid & 63, wave = __builtin_amdgcn_readfirstlane(tid >> 6); \
    const int gw = vcu * NWAVES + wave, NGW = G * NWAVES; const size_t gtid = (size_t)vcu * (NWAVES * 64) + tid, gthreads = (size_t)G * (NWAVES * 64); (void)lane; (void)gw; (void)NGW; (void)gtid; (void)gthreads
    if (threadIdx.x < 32) ((LAS unsigned*)(lds + MISC_OFF))[threadIdx.x] = 0u;
    __syncthreads();
    (void)xcd_barrier_post((unsigned*)(WSP(gu32, WS_CTL) + CW_BAR), (volatile LAS unsigned*)(lds + MISC_OFF) + 8);
#define GRID_BAR() do { XcdBarrier b_; b_.bar = (unsigned*)(WSP(gu32, WS_CTL) + CW_BAR); b_.x = xb_xcc_id(); b_.st = (volatile LAS unsigned*)(lds + MISC_OFF) + 8; xcd_barrier(b_); } while (0)

    {
        PH_IDS();
        LAS float* scr = (LAS float*)(lds + wave * 16384);
        constexpr int I0 = 16 * 97, I1 = 16 * 32, I2 = 16 * 64, I3 = 16 * 96, I4 = 16 * 32, I5 = 16 * 64, NITEMS = I0 + I1 + I2 + I3 + I4 + I5;
        for (int it = gw; it < NITEMS; it += NGW) {
            int r = it;
            if (r < I0) { p0_transpose_item(KIN(3), 1024, 3104, WSP(bf16, WS_WIN), scr, r, lane); continue; } r -= I0;
            if (r < I1) { p0_transpose_item(KIN(6), 1024, 1024, WSP(bf16, WS_WO0), scr, r, lane); continue; } r -= I1;
            if (r < I2) { p0_transpose_item(KIN(8), 1024, 2048, WSP(bf16, WS_WQ0), scr, r, lane); continue; } r -= I2;
            if (r < I3) { p0_transpose_item(KIN(13), 1024, 3072, WSP(bf16, WS_WQKV), scr, r, lane); continue; } r -= I3;
            if (r < I4) { p0_transpose_item(KIN(21), 1024, 1024, WSP(bf16, WS_WO1), scr, r, lane); continue; } r -= I4;
            p0_transpose_item(KIN(23), 1024, 2048, WSP(bf16, WS_WQ1), scr, r, lane);
        }
        { bf16* WIN = WSP(bf16, WS_WIN); for (size_t i = gtid * 8; i < (size_t)224 * 1024; i += gthreads * 8) *(v4u*)(WIN + (size_t)3104 * 1024 + i) = (v4u){0u, 0u, 0u, 0u}; }
        cvt_range(KIN(9), WSP(bf16, WS_KEY0), (size_t)262144, gtid, gthreads);
        cvt_range(KIN(24), WSP(bf16, WS_KEY1), (size_t)262144, gtid, gthreads);
        cvt_range(KIN(10), WSP(bf16, WS_U0), (size_t)16384 * 1024, gtid, gthreads);
        cvt_range(KIN(11), WSP(bf16, WS_V0T), (size_t)16384 * 1024, gtid, gthreads);
        rms_pass(KIN(0), KIN(2), WSP(bf16, WS_B0), gw, NGW, lane);
        { const int* positions = (const int*)KARG(1); float* ROPE = WSP(float, WS_ROPE);
          for (size_t id = gtid; id < (size_t)T * 8; id += gthreads) { const size_t mtok = id >> 3; const int i = (int)(id & 7);
            const float inv = powf(500000.0f, -(float)i * 2.0f / 16.0f); const float ang = (float)positions[mtok] * inv;
            float sn, cs; sincosf(ang, &sn, &cs); ROPE[mtok * 16 + i] = cs; ROPE[mtok * 16 + 8 + i] = sn; } }
    }
    GRID_BAR();
    {
        unsigned char* ws = KWS();
        pg8::Gemm g{(const bf16*)(ws + WS_B0), (const bf16*)(ws + WS_WIN), T, 3328, 1024}; pg8::StaticOrder S; S.init(T, 3328, G, bx);
        pg8::EpiInProj E{(bf16*)(ws + WS_R1), (bf16*)(ws + WS_R1 + 32 * MiB), (bf16*)(ws + WS_R2), (bf16*)(ws + WS_R3), (float*)(ws + WS_GATES), KIN(4)};
        pg8::gemm_phase<pg8::EpiInProj, pg8::StaticOrder, true, true>(lds, g, S, E);
    }
    GRID_BAR();
    { unsigned char* ws = KWS(); mlstm_phase(lds, (const bf16*)(ws + WS_R1), (const bf16*)(ws + WS_R1 + 32 * MiB), (const bf16*)(ws + WS_R2), (const float*)(ws + WS_GATES), (bf16*)(ws + WS_R4), (bf16*)(ws + WS_R5)); }
    GRID_BAR();
    { PH_IDS(); unsigned char* ws = KWS(); hs_pass((const bf16*)(ws + WS_R4), (const bf16*)(ws + WS_R5), (const bf16*)(ws + WS_R3), KIN(5), (bf16*)(ws + WS_B0), gw, NGW, lane); }
    { PH_IDS(); cvt_range(KIN(25), WSP(bf16, WS_R1), (size_t)16384 * 1024, gtid, gthreads);
      cvt_range(KIN(26), WSP(bf16, WS_R1 + 32 * MiB), (size_t)16384 * 1024, gtid, gthreads); }
    GRID_BAR();
#pragma unroll 1
    for (int L = 0; L < 2; ++L) {
        if (L == 1) {
            {
                unsigned char* ws = KWS();
                pg8::Gemm g{(const bf16*)(ws + WS_B0), (const bf16*)(ws + WS_WQKV), T, 3072, 1024}; pg8::StaticOrder S; S.init(T, 3072, G, bx);
                pg8::EpiQKV E{(bf16*)(ws + WS_R2), (bf16*)(ws + WS_R3), (bf16*)(ws + WS_R4)};
                pg8::gemm_phase<pg8::EpiQKV, pg8::StaticOrder, true, true>(lds, g, S, E);
            }
            GRID_BAR();
            { PH_IDS(); unsigned char* ws = KWS(); qknorm_rope_pass((bf16*)(ws + WS_R2), (bf16*)(ws + WS_R3), KIN(14), KIN(15), (const float*)(ws + WS_ROPE), gtid, gthreads); }
            GRID_BAR();
            { unsigned char* ws = KWS(); attn_phase(lds, vcu, (const bf16*)(ws + WS_R2), (const bf16*)(ws + WS_R3), (const bf16*)(ws + WS_R4), (bf16*)(ws + WS_B0), KIN(14), KIN(15), KIN(16), KIN(17), KIN(18), KIN(19), KIN(20)); }
            GRID_BAR();
        }
        {
            unsigned char* ws = KWS(); float* out = KOUT();
            pg8::Gemm g{(const bf16*)(ws + WS_B0), (const bf16*)(ws + (L ? WS_WO1 : WS_WO0)), T, 1024, 1024}; pg8::StaticOrder S; S.init(T, 1024, G, bx);
            pg8::EpiRes E{L ? (const float*)out : KIN(0), out};
            pg8::gemm_phase<pg8::EpiRes, pg8::StaticOrder, true, true>(lds, g, S, E);
        }
        GRID_BAR();
        { PH_IDS(); rms_pass(KOUT(), L ? KIN(22) : KIN(7), WSP(bf16, WS_B0), gw, NGW, lane); }
        GRID_BAR();
        {
            unsigned char* ws = KWS();
            pg8::Gemm g{(const bf16*)(ws + WS_B0), (const bf16*)(ws + (L ? WS_WQ1 : WS_WQ0)), T, 2048, 1024}; pg8::StaticOrder S; S.init(T, 2048, G, bx);
            pg8::EpiPlain E{(bf16*)(ws + WS_R2), 2048};
            pg8::gemm_phase<pg8::EpiPlain, pg8::StaticOrder, true, true>(lds, g, S, E);
        }
        GRID_BAR();
        { unsigned char* ws = KWS(); peer_topk_phase(vcu, (const bf16*)(ws + WS_R2), (const bf16*)(ws + (L ? WS_KEY1 : WS_KEY0)), (int*)(ws + WS_R4), (float*)(ws + WS_R4 + 16 * MiB)); }
        GRID_BAR();
        if (L == 0) { unsigned char* ws = KWS(); peer_gather_phase<true>(vcu, (const bf16*)(ws + WS_B0), (const int*)(ws + WS_R4), (const float*)(ws + WS_R4 + 16 * MiB), (const bf16*)(ws + WS_U0), (const bf16*)(ws + WS_V0T), KOUT(), KIN(12), (bf16*)(ws + WS_B0)); GRID_BAR(); }
        else { unsigned char* ws = KWS(); peer_gather_phase<false>(vcu, (const bf16*)(ws + WS_B0), (const int*)(ws + WS_R4), (const float*)(ws + WS_R4 + 16 * MiB), (const bf16*)(ws + WS_R1), (const bf16*)(ws + WS_R1 + 32 * MiB), KOUT(), nullptr, nullptr); }
    }
#undef GRID_BAR
}

extern "C" void kernel_launch(void* const* d_in, const int* in_sizes, int n_in, void* d_out, int out_size, void* d_ws, size_t ws_size, hipStream_t stream) {
    static int ready = 0;
    if (ready == 0) {
        if (n_in != 27 || out_size != T * D || ws_size < WS_END) { fprintf(stderr, "kernel_launch: unexpected problem (n_in %d, out %d, ws %zu)\n", n_in, out_size, ws_size); ready = -1; return; }
        if (hipFuncSetAttribute((const void*)mk_fwd, hipFuncAttributeMaxDynamicSharedMemorySize, LDS_BYTES) != hipSuccess) { fprintf(stderr, "kernel_launch: hipFuncSetAttribute failed\n"); ready = -1; return; }
        (void)hipGetLastError();
        ready = 1;
    }
    if (ready < 0) return;
    if (hipMemsetAsync((char*)d_ws + WS_CTL, 0, CTL_ZERO_BYTES, stream) != hipSuccess) { fprintf(stderr, "kernel_launch: memset failed\n"); return; }
    Args a{};
    for (int i = 0; i < 27; ++i) a.in[i] = d_in[i];
    a.out = (float*)d_out; a.ws = (unsigned char*)d_ws;
    hipLaunchKernelGGL(mk_fwd, dim3(256), dim3(NWAVES * 64), LDS_BYTES, stream, a);
}
```

```cpp
#include <hip/hip_runtime.h>
#include <hip/hip_bf16.h>
#include <cstdio>
#include <cstdint>
#include <cmath>
namespace pg8 {
#define PG8_LAS __attribute__((address_space(3)))
typedef unsigned short bf16_t;
typedef short bf16x8 __attribute__((ext_vector_type(8)));
typedef float f32x4 __attribute__((ext_vector_type(4)));
typedef unsigned u32x4 __attribute__((ext_vector_type(4)));
constexpr int BM = 256, BK = 64, HALF = 128, HTB = HALF * BK * 2  , STAGE_BYTES = 8 * HTB, NXCD = 8, WGM = 8;

__host__ __device__ __forceinline__ int lds_byte(int r, int c) { const int st = (r >> 4) * 2 + (c >> 5), rr = r & 15, cc = c & 31, ob = rr * 64 + cc * 2; return st * 1024 + (ob ^ (((ob >> 9) & 1) << 5)); }
__host__ __device__ __forceinline__ void stage_rc(int b, int& R, int& C) { const int st = b / 1024, sb = b % 1024, swz = sb ^ (((sb >> 9) & 1) << 5); R = (st >> 1) * 16 + swz / 64; C = (st & 1) * 32 + (swz % 64) / 2; }
__host__ __device__ __forceinline__ int perm32(int rho) { const int n = rho >> 4, i = rho & 15; return 8 * (i >> 2) + 4 * n + (i & 3); }

struct Unit { int pm, pn; };
struct Gemm { const bf16_t* A; const bf16_t* Bt; int M, N, K; };

struct StaticOrder {
    int nM, nN, nwg, G, c;
    __host__ __device__ void init(int M, int N, int G_, int c_) { nM = M / BM; nN = N / BM; nwg = nM * nN; G = G_; c = c_; }
    __host__ __device__ bool next(int i, Unit& u) const {
        const long L = (long)i * G + c; if (L >= nwg) return false;
        int wgid = (int)L; { const int q = nwg / NXCD, r = nwg % NXCD, xcd = wgid % NXCD, off = wgid / NXCD; wgid = (xcd < r ? xcd * (q + 1) : r * (q + 1) + (xcd - r) * q) + off; }
        const int nig = WGM * nN, gid = wgid / nig, fm = gid * WGM, gsz = (nM - fm) < WGM ? (nM - fm) : WGM;
        u.pm = fm + ((wgid % nig) % gsz); u.pn = (wgid % nig) / gsz; return true;
    }
    __device__ __forceinline__ void a_ready(const Unit&) const {}
    __device__ __forceinline__ void done(const Unit&) const {}
};
__device__ __forceinline__ unsigned cvt_pk_bf16(float lo, float hi) { unsigned r; asm volatile("v_cvt_pk_bf16_f32 %0, %1, %2" : "=v"(r) : "v"(lo), "v"(hi)); return r; }
typedef float f32x2 __attribute__((ext_vector_type(2)));
typedef unsigned u32x2 __attribute__((ext_vector_type(2)));
__device__ __forceinline__ u32x4 pack8(const f32x4 v0, const f32x4 v1) { u32x4 w; w.x = cvt_pk_bf16(v0[0], v0[1]); w.y = cvt_pk_bf16(v0[2], v0[3]); w.z = cvt_pk_bf16(v1[0], v1[1]); w.w = cvt_pk_bf16(v1[2], v1[3]); return w; }
struct EpiPlain {
    static constexpr bool PERM = true, AFTER_DRAIN = false;
    bf16_t* O; int ldc;
    __device__ __forceinline__ void operator()(const f32x4 (&acc)[2][2][4][2], const Unit& u, int wr, int wc, int fr, int fq) const {
        const int row0 = u.pm * BM + wr * 64 + fr, col0 = u.pn * BM + wc * 32 + 8 * fq;
#pragma unroll
        for (int ai = 0; ai < 2; ++ai)
#pragma unroll
            for (int m = 0; m < 4; ++m) { bf16_t* rowp = O + (size_t)(row0 + ai * HALF + m * 16) * ldc + col0;
#pragma unroll
                for (int bj = 0; bj < 2; ++bj) *(u32x4*)(rowp + bj * HALF) = pack8(acc[ai][bj][m][0], acc[ai][bj][m][1]); }
    }
};
struct EpiRes {
    static constexpr bool PERM = false, AFTER_DRAIN = false;
    const float* base; float* out;
    __device__ __forceinline__ void operator()(const f32x4 (&acc)[2][2][4][2], const Unit& u, int wr, int wc, int fr, int fq) const {
        const int col0 = u.pn * BM + wc * 32 + 4 * fq;
#pragma unroll
        for (int ai = 0; ai < 2; ++ai)
#pragma unroll
            for (int m = 0; m < 4; ++m) { const size_t off = (size_t)(u.pm * BM + ai * HALF + wr * 64 + m * 16 + fr) * 1024 + col0;
#pragma unroll
                for (int bj = 0; bj < 2; ++bj)
#pragma unroll
                    for (int n = 0; n < 2; ++n) { const f32x4 bs = *(const f32x4*)(base + off + bj * HALF + n * 16); *(f32x4*)(out + off + bj * HALF + n * 16) = bs + acc[ai][bj][m][n]; } }
    }
};
struct EpiInProj {
    static constexpr bool PERM = true, AFTER_DRAIN = false;
    bf16_t *Q, *Kk, *V, *OG; float* gates; const float* bg;
    __device__ __forceinline__ void operator()(const f32x4 (&acc)[2][2][4][2], const Unit& u, int wr, int wc, int fr, int fq) const {
        const int colt = u.pn * BM;
#pragma unroll
        for (int ai = 0; ai < 2; ++ai)
#pragma unroll
            for (int m = 0; m < 4; ++m) { const int row = u.pm * BM + ai * HALF + wr * 64 + m * 16 + fr, b = row >> 12, s = row & 4095;
#pragma unroll
                for (int bj = 0; bj < 2; ++bj) { const int cb = colt + bj * HALF + wc * 32 + 8 * fq; f32x4 v0 = acc[ai][bj][m][0], v1 = acc[ai][bj][m][1];
                    if (colt < 1024) { const bool isq = colt < 512; bf16_t* base = isq ? Q : Kk; const int c2 = cb & 511, head = c2 >> 6, d = c2 & 63;
                        if (isq) { v0 = v0 * 0.125f; v1 = v1 * 0.125f; }
                        *(u32x4*)(base + ((size_t)((b * 8 + head) * 4096 + s)) * 64 + d) = pack8(v0, v1); }
                    else if (colt < 2048) { const int c2 = cb - 1024, head = c2 >> 7, dv = c2 & 127; *(u32x4*)(V + ((size_t)((b * 8 + head) * 4096 + s)) * 128 + dv) = pack8(v0, v1); }
                    else if (colt < 3072) { *(u32x4*)(OG + (size_t)row * 1024 + (cb - 2048)) = pack8(v0, v1); }
                    else if (cb < 3104) { const int gi = cb - 3072; float* g = gates + (size_t)row * 32 + gi;
                        *(f32x4*)g = v0 + *(const f32x4*)(bg + gi); *(f32x4*)(g + 4) = v1 + *(const f32x4*)(bg + gi + 4); } } }
    }
};
struct EpiQKV {
    static constexpr bool PERM = true, AFTER_DRAIN = false;
    bf16_t *Q, *Kk, *V;
    __device__ __forceinline__ void operator()(const f32x4 (&acc)[2][2][4][2], const Unit& u, int wr, int wc, int fr, int fq) const {
        const int colt = u.pn * BM;
#pragma unroll
        for (int ai = 0; ai < 2; ++ai)
#pragma unroll
            for (int m = 0; m < 4; ++m) { const int row = u.pm * BM + ai * HALF + wr * 64 + m * 16 + fr, b = row >> 12, s = row & 4095;
#pragma unroll
                for (int bj = 0; bj < 2; ++bj) { const int cb = colt + bj * HALF + wc * 32 + 8 * fq; const u32x4 w = pack8(acc[ai][bj][m][0], acc[ai][bj][m][1]);
                    if (colt < 2048) { bf16_t* base = colt < 1024 ? Q : Kk; const int c2 = cb & 1023, head = c2 >> 7, c = (c2 >> 6) & 1, d = c2 & 63;
                        *(u32x4*)(base + ((size_t)(((b * 8 + head) * 2 + c) * 4096 + s)) * 64 + d) = w; }
                    else { const int c2 = cb - 2048, head = c2 >> 7, dv = c2 & 127; *(u32x4*)(V + ((size_t)((b * 8 + head) * 4096 + s)) * 128 + dv) = w; } } }
    }
};
template <class Epi, class Sched, bool ALIGN_EPI = false, bool SP2 = false>
__device__ __forceinline__ void gemm_phase(PG8_LAS unsigned char* lds, const Gemm g, const Sched& S, const Epi& E) {
    int tid_ = threadIdx.x; asm volatile("" : "+v"(tid_)); const int tid = tid_, wid = __builtin_amdgcn_readfirstlane(tid >> 6), lane = tid & 63, wr = wid >> 2, wc = wid & 3, fr = lane & 15, fq = lane >> 4;
    const int K = g.K, nt = K / BK;
    unsigned voffA[2], voffB[2];
#pragma unroll
    for (int i = 0; i < 2; ++i) { int R, C; stage_rc(tid * 16 + i * 8192, R, C); const int Rb = Epi::PERM ? ((R & ~31) + perm32(R & 31)) : R;
        voffA[i] = (unsigned)(R * K + C) * 2u; voffB[i] = (unsigned)(Rb * K + C) * 2u; }
    const size_t kstep = (size_t)(BK * 2);
    const size_t hstep = (size_t)HALF * K * 2;
    const size_t tstep = 2 * hstep;
    const unsigned ldsw = (unsigned)wid * 1024u;
    const int aoff = lds_byte(wr * 64 + fr, fq * 8), boff = lds_byte(wc * 32 + fr, fq * 8);
#define PG8_SA(b, h) (((b) * 2 + (h)) * HTB)
#define PG8_SB(b, h) ((4 + (b) * 2 + (h)) * HTB)
#define PG8_STAGE(bufoff, gbase, voff) do { _Pragma("unroll") for (int _i = 0; _i < 2; ++_i) \
        __builtin_amdgcn_global_load_lds((const unsigned*)((const char*)(gbase) + (voff)[_i]), (PG8_LAS unsigned*)(lds + (bufoff) + ldsw + _i * 8192), 16, 0, 0); } while (0)
#define PG8_LDA(dst, b, h) do { _Pragma("unroll") for (int m = 0; m < 4; ++m) _Pragma("unroll") for (int k = 0; k < 2; ++k) dst[m][k] = *(const PG8_LAS bf16x8*)(lds + PG8_SA(b, h) + aoff + m * 2048 + k * 1024); } while (0)
#define PG8_LDB(dst, b, h) do { _Pragma("unroll") for (int n = 0; n < 2; ++n) _Pragma("unroll") for (int k = 0; k < 2; ++k) dst[n][k] = *(const PG8_LAS bf16x8*)(lds + PG8_SB(b, h) + boff + n * 2048 + k * 1024); } while (0)
#define PG8_MMA(ai, bj, At, Bt) do { __builtin_amdgcn_s_setprio(1); _Pragma("unroll") for (int m = 0; m < 4; ++m) _Pragma("unroll") for (int n = 0; n < 2; ++n) _Pragma("unroll") for (int k = 0; k < 2; ++k) \
        acc[ai][bj][m][n] = __builtin_amdgcn_mfma_f32_16x16x32_bf16(Bt[n][k], At[m][k], acc[ai][bj][m][n], 0, 0, 0); __builtin_amdgcn_s_setprio(0); } while (0)
#define PG8_WAIT_V(n) asm volatile("s_waitcnt vmcnt(" #n ")" ::: "memory")
#define PG8_WAIT_L(n) asm volatile("s_waitcnt lgkmcnt(" #n ")" ::: "memory")
#define PG8_BAR __builtin_amdgcn_s_barrier()
#define PG8_SCHED __builtin_amdgcn_sched_barrier(0)
    Unit cur, nxt; int ui = 0;
    if (!S.next(0, cur)) return;
    f32x4 acc[2][2][4][2];
#pragma unroll
    for (int a = 0; a < 2; ++a)
#pragma unroll
        for (int b = 0; b < 2; ++b)
#pragma unroll
            for (int m = 0; m < 4; ++m)
#pragma unroll
                for (int n = 0; n < 2; ++n) acc[a][b][m][n] = (f32x4){0.f, 0.f, 0.f, 0.f};
    bf16x8 At[4][2], B0[2][2], B1[2][2];
    const char* cA = (const char*)g.A + (size_t)cur.pm * tstep; const char* cB = (const char*)g.Bt + (size_t)cur.pn * tstep;
    S.a_ready(cur);
    if constexpr (SP2) {
        PG8_STAGE(PG8_SB(0, 0), cB, voffB); PG8_STAGE(PG8_SB(0, 1), cB + hstep, voffB); PG8_STAGE(PG8_SA(0, 0), cA, voffA); PG8_STAGE(PG8_SA(0, 1), cA + hstep, voffA);
        if (wr == 1) PG8_BAR;
        PG8_WAIT_V(2); PG8_BAR;
        PG8_STAGE(PG8_SB(1, 0), cB + kstep, voffB); PG8_STAGE(PG8_SA(1, 0), cA + kstep, voffA); PG8_STAGE(PG8_SB(1, 1), cB + hstep + kstep, voffB);
        PG8_WAIT_V(6); PG8_BAR;
    } else {
        PG8_STAGE(PG8_SB(0, 0), cB, voffB); PG8_STAGE(PG8_SA(0, 0), cA, voffA); PG8_STAGE(PG8_SB(0, 1), cB + hstep, voffB); PG8_STAGE(PG8_SA(0, 1), cA + hstep, voffA);
        if (wr == 1) PG8_BAR;
        PG8_WAIT_V(4); PG8_BAR;
        PG8_STAGE(PG8_SB(1, 0), cB + kstep, voffB); PG8_STAGE(PG8_SA(1, 0), cA + kstep, voffA); PG8_STAGE(PG8_SB(1, 1), cB + hstep + kstep, voffB);
        PG8_WAIT_V(6); PG8_BAR;
    }
    for (;;) {
        const bool has_next = S.next(ui + 1, nxt);
        const char* nA = has_next ? (const char*)g.A + (size_t)nxt.pm * tstep : cA; const char* nB = has_next ? (const char*)g.Bt + (size_t)nxt.pn * tstep : cB;
        for (int t = 0; t < nt; t += 2) {
            const bool last = (t == nt - 2);
            const char* a1 = cA + (size_t)(t + 1) * kstep;
            const char* a2 = last ? nA : cA + (size_t)(t + 2) * kstep; const char* b2 = last ? nB : cB + (size_t)(t + 2) * kstep;
            const char* a3 = a2 + kstep; const char* b3 = b2 + kstep;
            if (last && has_next) S.a_ready(nxt);
            if constexpr (SP2) {
            PG8_LDB(B0, 0, 0); PG8_LDB(B1, 0, 1); PG8_SCHED; PG8_LDA(At, 0, 0); PG8_STAGE(PG8_SA(1, 1), a1 + hstep, voffA);
            PG8_WAIT_V(8); PG8_WAIT_L(0); PG8_BAR; PG8_MMA(0, 0, At, B0); PG8_MMA(0, 1, At, B1); PG8_BAR; PG8_SCHED;
            PG8_LDA(At, 0, 1); PG8_STAGE(PG8_SB(0, 0), b2, voffB); PG8_STAGE(PG8_SB(0, 1), b2 + hstep, voffB); PG8_STAGE(PG8_SA(0, 0), a2, voffA);
            PG8_WAIT_V(8); PG8_WAIT_L(0); PG8_BAR; PG8_MMA(1, 0, At, B0); PG8_MMA(1, 1, At, B1); PG8_BAR; PG8_SCHED;
            PG8_LDB(B0, 1, 0); PG8_LDB(B1, 1, 1); PG8_SCHED; PG8_LDA(At, 1, 0); PG8_STAGE(PG8_SA(0, 1), a2 + hstep, voffA);
            PG8_WAIT_V(8); PG8_WAIT_L(0); PG8_BAR; PG8_MMA(0, 0, At, B0); PG8_MMA(0, 1, At, B1); PG8_BAR; PG8_SCHED;
            PG8_LDA(At, 1, 1); PG8_STAGE(PG8_SB(1, 0), b3, voffB); PG8_STAGE(PG8_SB(1, 1), b3 + hstep, voffB); PG8_STAGE(PG8_SA(1, 0), a3, voffA);
            PG8_WAIT_V(8); PG8_WAIT_L(0); PG8_BAR; PG8_MMA(1, 0, At, B0); PG8_MMA(1, 1, At, B1); PG8_BAR; PG8_SCHED;
            } else {
            PG8_LDB(B0, 0, 0); PG8_SCHED; PG8_LDA(At, 0, 0); PG8_STAGE(PG8_SA(1, 1), a1 + hstep, voffA);
            PG8_WAIT_L(8); PG8_BAR; PG8_WAIT_L(0); PG8_MMA(0, 0, At, B0); PG8_BAR; PG8_SCHED;
            PG8_LDB(B1, 0, 1); PG8_STAGE(PG8_SB(0, 0), b2, voffB);
            PG8_BAR; PG8_WAIT_L(0); PG8_MMA(0, 1, At, B1); PG8_BAR;
            PG8_LDA(At, 0, 1); PG8_STAGE(PG8_SA(0, 0), a2, voffA);
            PG8_BAR; PG8_WAIT_L(0); PG8_MMA(1, 0, At, B0); PG8_BAR; PG8_SCHED;
            PG8_STAGE(PG8_SB(0, 1), b2 + hstep, voffB);
            PG8_WAIT_V(6); PG8_BAR; PG8_MMA(1, 1, At, B1); PG8_BAR;
            PG8_LDB(B0, 1, 0); PG8_SCHED; PG8_LDA(At, 1, 0); PG8_STAGE(PG8_SA(0, 1), a2 + hstep, voffA);
            PG8_WAIT_L(8); PG8_BAR; PG8_WAIT_L(0); PG8_MMA(0, 0, At, B0); PG8_BAR; PG8_SCHED;
            PG8_LDB(B1, 1, 1); PG8_STAGE(PG8_SB(1, 0), b3, voffB);
            PG8_BAR; PG8_WAIT_L(0); PG8_MMA(0, 1, At, B1); PG8_BAR;
            PG8_LDA(At, 1, 1); PG8_STAGE(PG8_SA(1, 0), a3, voffA);
            PG8_BAR; PG8_WAIT_L(0); PG8_MMA(1, 0, At, B0); PG8_BAR; PG8_SCHED;
            PG8_STAGE(PG8_SB(1, 1), b3 + hstep, voffB);
            PG8_WAIT_V(6); PG8_BAR; PG8_MMA(1, 1, At, B1); PG8_BAR;
            }
        }
        if constexpr (ALIGN_EPI) { if (wr == 0) PG8_BAR; }
        if constexpr (!Epi::AFTER_DRAIN) { E(acc, cur, wr, wc, fr, fq); S.done(cur); }
        if (!has_next) break;
#pragma unroll
        for (int a = 0; a < 2; ++a)
#pragma unroll
            for (int b = 0; b < 2; ++b)
#pragma unroll
                for (int m = 0; m < 4; ++m)
#pragma unroll
                    for (int n = 0; n < 2; ++n) acc[a][b][m][n] = (f32x4){0.f, 0.f, 0.f, 0.f};
        cur = nxt; cA = nA; cB = nB; ++ui;
        if constexpr (ALIGN_EPI) { if (wr == 1) PG8_BAR; }
    }
    PG8_WAIT_V(0);
    if constexpr (!ALIGN_EPI) { if (wr == 0) PG8_BAR; }
    PG8_BAR;
    if constexpr (Epi::AFTER_DRAIN) { E.fused(acc, cur, wr, wc, fr, fq, lds, wid, lane); S.done(cur); }
#undef PG8_SA
#undef PG8_SB
#undef PG8_STAGE
#undef PG8_LDA
#undef PG8_LDB
#undef PG8_MMA
#undef PG8_WAIT_V
#undef PG8_WAIT_L
#undef PG8_BAR
#undef PG8_SCHED
}
}
#define GAS __attribute__((address_space(1)))
#define LAS __attribute__((address_space(3)))
typedef unsigned short bf16;
typedef unsigned v4u __attribute__((ext_vector_type(4)));
typedef float f32x4 __attribute__((ext_vector_type(4)));
typedef short bf16x8 __attribute__((ext_vector_type(8)));
typedef GAS unsigned gu32;
typedef GAS unsigned long long gu64;
#define RLX_AGENT __ATOMIC_RELAXED, __HIP_MEMORY_SCOPE_AGENT
#define LDS_WAIT() asm volatile("s_waitcnt lgkmcnt(0)" ::: "memory")
#define VM_WAIT() asm volatile("s_waitcnt vmcnt(0)" ::: "memory")
__device__ __forceinline__ unsigned long long rt() { return __builtin_amdgcn_s_memrealtime(); }
__device__ __forceinline__ unsigned f2bf(float f) { unsigned u = __builtin_bit_cast(unsigned, f); return (u + 0x7fffu + ((u >> 16) & 1u)) >> 16; }
__device__ __forceinline__ unsigned pk2(float lo, float hi) { return f2bf(lo) | (f2bf(hi) << 16); }

#define XB_TMO      128
#define XB_XCNT(j)  (256  + 64 * (j))
#define XB_XSUB(j)  (1280 + 64 * (j))
#define XB_XGEN(j)  (2304 + 64 * (j))
#define XB_TOP      3328
#define XB_TOPGEN   3392
#define XCD_BAR_WORDS 3456
#define XB_SPIN_CAP (1u << 18)

__device__ __forceinline__ unsigned xb_ld(unsigned* p)              { return __hip_atomic_load(p, __ATOMIC_RELAXED, __HIP_MEMORY_SCOPE_AGENT); }
__device__ __forceinline__ unsigned xb_add(unsigned* p, unsigned v) { return __hip_atomic_fetch_add(p, v, __ATOMIC_RELAXED, __HIP_MEMORY_SCOPE_AGENT); }
__device__ __forceinline__ unsigned xb_xcc_id() { return (unsigned)__builtin_amdgcn_s_getreg((3 << 11) | 20) & 0xFu; }
#define XB_SPIN(cond, bar) do { unsigned _sp = 0; while (cond) { __builtin_amdgcn_s_sleep(1); \
    if ((++_sp & 255u) == 0u) { if (xb_ld(&(bar)[XB_TMO])) break; if (_sp > XB_SPIN_CAP) { atomicAdd(&(bar)[XB_TMO], 1u); break; } } } } while (0)

struct XcdBarrier {
    unsigned* bar; unsigned x;
    volatile LAS unsigned* st;
};

__device__ __forceinline__ XcdBarrier xcd_barrier_post(unsigned* bar, volatile LAS unsigned* st) {
    XcdBarrier b; b.bar = bar; b.x = xb_xcc_id(); b.st = st;
    if (threadIdx.x == 0) (void)xb_add(&bar[XB_XCNT(b.x)], 1u);
    return b;
}
__device__ __forceinline__ void xcd_barrier_complete(unsigned* bar, unsigned x, unsigned& nloc, unsigned& nx) {
    const unsigned G = gridDim.x * gridDim.y * gridDim.z;
    unsigned sum, cnt, mine, sp = 0u;
    for (;;) {
        sum = 0u; cnt = 0u; mine = 0u;
#pragma unroll
        for (unsigned j = 0; j < 16; ++j) { const unsigned c = xb_ld(&bar[XB_XCNT(j)]); sum += c; cnt += (c > 0u) ? 1u : 0u; mine = (j == x) ? c : mine; }
        if (sum == G) break;
        __builtin_amdgcn_s_sleep(1);
        if ((++sp & 255u) == 0u) { if (xb_ld(&bar[XB_TMO])) break; if (sp > XB_SPIN_CAP) { atomicAdd(&bar[XB_TMO], 1u); break; } }
    }
    nloc = mine > 0u ? mine : 1u; nx = cnt > 0u ? cnt : 1u;
}

__device__ __forceinline__ void xcd_barrier(const XcdBarrier& b) {
    asm volatile("s_waitcnt vmcnt(0)" ::: "memory");
    __syncthreads();
    if (threadIdx.x == 0) {
        unsigned* bar = b.bar;
        __builtin_amdgcn_s_waitcnt(0);
        unsigned nloc = b.st[0], nx = b.st[1];
        if (nloc == 0u) { xcd_barrier_complete(bar, b.x, nloc, nx); b.st[0] = nloc; b.st[1] = nx; }
        const unsigned old = xb_add(&bar[XB_XSUB(b.x)], 1u);
        const unsigned gen = old / nloc;
        if (old + 1u == (gen + 1u) * nloc) {
            __builtin_amdgcn_fence(__ATOMIC_RELEASE, "agent");
            asm volatile("s_waitcnt vmcnt(0)" ::: "memory");
            const unsigned og = xb_add(&bar[XB_TOP], 1u);
            const unsigned tg = og / nx;
            if (og + 1u == (tg + 1u) * nx) xb_add(&bar[XB_TOPGEN], 1u);
            else XB_SPIN(xb_ld(&bar[XB_TOPGEN]) == tg, bar);
            __builtin_amdgcn_fence(__ATOMIC_ACQUIRE, "agent");
            xb_add(&bar[XB_XGEN(b.x)], 1u);
            asm volatile("s_waitcnt vmcnt(0)" ::: "memory");
        } else {
            XB_SPIN(xb_ld(&bar[XB_XGEN(b.x)]) == gen, bar);
            __builtin_amdgcn_fence(__ATOMIC_ACQUIRE, "agent");
            asm volatile("s_waitcnt vmcnt(0)" ::: "memory");
        }
    }
    __syncthreads();
}
constexpr int NWAVES = 8;
constexpr int T = 32768, D = 1024, SEQ = 4096;
constexpr float EPS = 1e-6f;
constexpr float LAMBDA_INIT = 0.35550906759f;
constexpr size_t MiB = 1u << 20;
constexpr size_t WS_CTL = 0, CTL_ZERO_BYTES = 1 * MiB;
constexpr size_t WS_ROPE = 1 * MiB;
constexpr size_t WS_WIN = 4 * MiB;
constexpr size_t WS_WO0 = 11 * MiB, WS_WQ0 = 13 * MiB, WS_KEY0 = 17 * MiB, WS_WQKV = 18 * MiB, WS_WO1 = 24 * MiB, WS_WQ1 = 26 * MiB, WS_KEY1 = 30 * MiB;
constexpr size_t WS_SC = 31 * MiB;
constexpr size_t WS_U0 = 32 * MiB, WS_V0T = 48 * MiB, WS_U1 = 64 * MiB, WS_V1T = 80 * MiB;
constexpr size_t WS_B0 = 96 * MiB;
constexpr size_t WS_R1 = 160 * MiB, WS_R2 = 224 * MiB, WS_R3 = 288 * MiB, WS_R4 = 352 * MiB, WS_R5 = 416 * MiB, WS_GATES = 480 * MiB;
constexpr size_t WS_END = 484 * MiB;
constexpr int CW_BAR = 4096;
constexpr int LDS_BYTES = 147456, MISC_OFF = LDS_BYTES - 128;

typedef float f32x16 __attribute__((ext_vector_type(16)));
typedef unsigned u32x2 __attribute__((ext_vector_type(2)));
typedef __bf16 bf16x2_t __attribute__((ext_vector_type(2)));
__device__ __forceinline__ float bf_lo(unsigned w) { return __uint_as_float(w << 16); }
__device__ __forceinline__ float bf_hi(unsigned w) { return __uint_as_float(w & 0xffff0000u); }
__device__ __forceinline__ float dot2(unsigned a, unsigned b, float c) { return __builtin_amdgcn_fdot2_f32_bf16(__builtin_bit_cast(bf16x2_t, a), __builtin_bit_cast(bf16x2_t, b), c, false); }
__device__ __forceinline__ float wave_sum(float v) {
#pragma unroll
    for (int o = 1; o < 64; o <<= 1) v += __shfl_xor(v, o);
    return v;
}
__device__ __forceinline__ f32x4 mfma16(bf16x8 a, bf16x8 b, f32x4 c) { return __builtin_amdgcn_mfma_f32_16x16x32_bf16(a, b, c, 0, 0, 0); }
__device__ __forceinline__ f32x16 mfma32(bf16x8 a, bf16x8 b, f32x16 c) { return __builtin_amdgcn_mfma_f32_32x32x16_bf16(a, b, c, 0, 0, 0); }
__device__ __forceinline__ u32x2 pack4(float a, float b, float c, float d) { u32x2 r; r.x = pk2(a, b); r.y = pk2(c, d); return r; }

__device__ __forceinline__ void p0_transpose_item(const float* W, int K, int N, bf16* WT, LAS float* scr, int item, int lane) {
    const int nblk = N / 32, kb = item / nblk, nb = item % nblk, k0 = 64 * kb, n0 = 32 * nb;
#pragma unroll 8
    for (int i = 0; i < 32; ++i) { const int kk = 2 * i + (lane >> 5); scr[kk * 33 + (lane & 31)] = W[(size_t)(k0 + kk) * N + n0 + (lane & 31)]; }
    LDS_WAIT(); asm volatile("" ::: "memory");
    const int c = lane & 7;
#pragma unroll
    for (int j = 0; j < 4; ++j) { const int n = (lane >> 3) + 8 * j; const LAS float* s = scr + (8 * c) * 33 + n;
        v4u o; o.x = pk2(s[0 * 33], s[1 * 33]); o.y = pk2(s[2 * 33], s[3 * 33]); o.z = pk2(s[4 * 33], s[5 * 33]); o.w = pk2(s[6 * 33], s[7 * 33]);
        *(v4u*)(WT + (size_t)(n0 + n) * K + k0 + 8 * c) = o; }
    LDS_WAIT(); asm volatile("" ::: "memory");
}
__device__ __forceinline__ void cvt_range(const float* src, bf16* dst, size_t n, size_t gtid, size_t gthreads) {
    for (size_t i = gtid * 8; i < n; i += gthreads * 8) {
        const f32x4 a = *(const f32x4*)(src + i), b = *(const f32x4*)(src + i + 4);
        v4u o; o.x = pk2(a.x, a.y); o.y = pk2(a.z, a.w); o.z = pk2(b.x, b.y); o.w = pk2(b.z, b.w);
        *(v4u*)(dst + i) = o; }
}
__device__ __forceinline__ void rms_row_to_bf16(const float* xrow, const float* g, bf16* orow, int lane) {
    const f32x4* xr = (const f32x4*)xrow + lane; const f32x4* gr = (const f32x4*)g + lane;
    f32x4 v[4]; float s = 0.f;
#pragma unroll
    for (int j = 0; j < 4; ++j) { v[j] = xr[64 * j]; s += (v[j].x * v[j].x + v[j].y * v[j].y) + (v[j].z * v[j].z + v[j].w * v[j].w); }
    const float rstd = rsqrtf(wave_sum(s) * (1.f / 1024.f) + EPS);
    unsigned long long* o8 = (unsigned long long*)orow + lane;
#pragma unroll
    for (int j = 0; j < 4; ++j) { const f32x4 gg = gr[64 * j];
        o8[64 * j] = (unsigned long long)pk2(v[j].x * rstd * gg.x, v[j].y * rstd * gg.y) | ((unsigned long long)pk2(v[j].z * rstd * gg.z, v[j].w * rstd * gg.w) << 32); }
}
__device__ __forceinline__ void rms_pass(const float* X, const float* g, bf16* XN, int gw, int NGW, int lane) {
    for (int m = gw; m < T; m += NGW) rms_row_to_bf16(X + (size_t)m * D, g, XN + (size_t)m * D, lane);
}

__device__ __forceinline__ float logsigmoid_f(float f) { return fminf(f, 0.f) - log1pf(__expf(-fabsf(f))); }
#define ML_LOAD(ci_) do { const size_t r_ = rowbase + (size_t)(ci_) * 64 + lane; \
    rq = *(const v4u*)(Q0 + r_ * 64 + 8 * w); rk = *(const v4u*)(K0 + r_ * 64 + 8 * w); rv0 = *(const v4u*)(V0 + r_ * 128 + 16 * w); rv1 = *(const v4u*)(V0 + r_ * 128 + 16 * w + 8); \
    const size_t gm_ = ((size_t)b * 4096 + (size_t)(ci_) * 64 + jr) * 32; rli = GATES[gm_ + (dir ? 16 : 0) + h]; rf = GATES[gm_ + (dir ? 24 : 8) + h]; } while (0)
__device__ __forceinline__ void mlstm_phase(LAS unsigned char* lds, const bf16* Q0, const bf16* K0, const bf16* V0, const float* GATES, bf16* HF, bf16* HB) {
    const int bx = blockIdx.x;
    if ((bx >> 3) & 1) return;
    const int seq = (bx >> 4) * 8 + (bx & 7);
    const int dir = seq & 1, bh = seq >> 1, b = bh >> 3, h = bh & 7;
    int tid_ = threadIdx.x; asm volatile("" : "+v"(tid_)); const int tid = tid_, lane = tid & 63, w = __builtin_amdgcn_readfirstlane(tid >> 6), fr = lane & 15, fq = lane >> 4;
    LAS bf16* Qs = (LAS bf16*)(lds); LAS bf16* Ks = (LAS bf16*)(lds + 9216); LAS bf16* Kwt = (LAS bf16*)(lds + 18432); LAS bf16* Ps = (LAS bf16*)(lds + 27648);
    LAS bf16* Vt = (LAS bf16*)(lds + 36864 + w * 2304); LAS bf16* Cs = (LAS bf16*)(lds + 55296 + w * 2304); LAS bf16* nb = (LAS bf16*)(lds + 73728 + w * 128);
    LAS float* gc = (LAS float*)(lds + 74752 + w * 1280); LAS float* gM = gc + 64; LAS float* gI = gc + 128; LAS float* gE = gc + 192; LAS float* gW = gc + 256;
    for (int i = lane; i < 2304 / 4; i += 64) ((LAS unsigned*)Cs)[i] = 0u;
    if (lane < 32) ((LAS unsigned*)nb)[lane] = 0u;
    f32x4 Cacc[4], Nacc[4];
#pragma unroll
    for (int i = 0; i < 4; ++i) { Cacc[i] = (f32x4){0.f, 0.f, 0.f, 0.f}; Nacc[i] = (f32x4){0.f, 0.f, 0.f, 0.f}; }
    float m = -1e30f;
    bf16* Hout = dir ? HB : HF;
    const size_t rowbase = (size_t)bh * 4096;
    const int jr = dir ? 63 - lane : lane;
    v4u rq, rk, rv0, rv1; float rli, rf;
    ML_LOAD(dir ? 63 : 0);
    const bf16x8 ones = (bf16x8){0x3F80, 0x3F80, 0x3F80, 0x3F80, 0x3F80, 0x3F80, 0x3F80, 0x3F80};
    const f32x4 z4 = (f32x4){0.f, 0.f, 0.f, 0.f};
#pragma unroll 1
    for (int step = 0; step < 64; ++step) {
        const int ci = dir ? 63 - step : step;
        const float lf = logsigmoid_f(rf);
        float bcs = lf;
#pragma unroll
        for (int d = 1; d < 64; d <<= 1) { const float t = __shfl_up(bcs, d); if (lane >= d) bcs += t; }
        const float c = rli - bcs;
        float pm = c;
#pragma unroll
        for (int d = 1; d < 64; d <<= 1) { const float t = __shfl_up(pm, d); if (lane >= d) pm = fmaxf(pm, t); }
        const float M = fmaxf(m, pm);
        const float bL = __shfl(bcs, 63), Mlast = __shfl(M, 63);
        gc[jr] = c; gM[jr] = M; gI[jr] = __expf(m - M); gE[jr] = __expf(-(bcs + M)); gW[jr] = __expf(c - Mlast);
        const float sp = __expf(m - Mlast), m_new = bL + Mlast;
        const float wr_ = gW[lane];
        *(LAS v4u*)(Qs + lane * 72 + 8 * w) = rq; *(LAS v4u*)(Ks + lane * 72 + 8 * w) = rk;
#pragma unroll
        for (int i = 0; i < 4; ++i) { const unsigned kw = rk[i]; Kwt[(8 * w + 2 * i) * 72 + lane] = (bf16)f2bf(bf_lo(kw) * wr_); Kwt[(8 * w + 2 * i + 1) * 72 + lane] = (bf16)f2bf(bf_hi(kw) * wr_); }
#pragma unroll
        for (int i = 0; i < 4; ++i) { Vt[(2 * i) * 72 + lane] = (bf16)(rv0[i] & 0xffffu); Vt[(2 * i + 1) * 72 + lane] = (bf16)(rv0[i] >> 16);
                                      Vt[(8 + 2 * i) * 72 + lane] = (bf16)(rv1[i] & 0xffffu); Vt[(9 + 2 * i) * 72 + lane] = (bf16)(rv1[i] >> 16); }
        __syncthreads();
        if (step < 63) ML_LOAD(dir ? 62 - step : step + 1);
        {
            const int st = w >> 1;
            const bf16x8 a0 = *(const LAS bf16x8*)(Ks + (16 * st + fr) * 72 + 8 * fq), a1 = *(const LAS bf16x8*)(Ks + (16 * st + fr) * 72 + 32 + 8 * fq);
#pragma unroll
            for (int u = 0; u < 2; ++u) { const int tt = 2 * (w & 1) + u;
                const bf16x8 b0 = *(const LAS bf16x8*)(Qs + (16 * tt + fr) * 72 + 8 * fq), b1 = *(const LAS bf16x8*)(Qs + (16 * tt + fr) * 72 + 32 + 8 * fq);
                f32x4 acc = mfma16(a0, b0, z4); acc = mfma16(a1, b1, acc);
                const int t = 16 * tt + fr; const float Mt = gM[t]; float pv[4];
#pragma unroll
                for (int i = 0; i < 4; ++i) { const int s = 16 * st + 4 * fq + i; const bool valid = dir ? (s >= t) : (s <= t); const float e = __expf(gc[s] - Mt); pv[i] = valid ? acc[i] * e : 0.f; }
                *(LAS u32x2*)(Ps + t * 72 + 16 * st + 4 * fq) = pack4(pv[0], pv[1], pv[2], pv[3]); }
        }
        __syncthreads();
        const bf16x8 aV0 = *(const LAS bf16x8*)(Vt + fr * 72 + 8 * fq), aV1 = *(const LAS bf16x8*)(Vt + fr * 72 + 32 + 8 * fq);
        {
            const bf16x8 aC0 = *(const LAS bf16x8*)(Cs + fr * 72 + 8 * fq), aC1 = *(const LAS bf16x8*)(Cs + fr * 72 + 32 + 8 * fq);
            const bf16x8 aN0 = *(const LAS bf16x8*)(nb + 8 * fq), aN1 = *(const LAS bf16x8*)(nb + 32 + 8 * fq);
#pragma unroll
            for (int tt = 0; tt < 4; ++tt) {
                const bf16x8 bP0 = *(const LAS bf16x8*)(Ps + (16 * tt + fr) * 72 + 8 * fq), bP1 = *(const LAS bf16x8*)(Ps + (16 * tt + fr) * 72 + 32 + 8 * fq);
                const bf16x8 bQ0 = *(const LAS bf16x8*)(Qs + (16 * tt + fr) * 72 + 8 * fq), bQ1 = *(const LAS bf16x8*)(Qs + (16 * tt + fr) * 72 + 32 + 8 * fq);
                f32x4 acc1 = mfma16(aV0, bP0, z4); acc1 = mfma16(aV1, bP1, acc1);
                f32x4 acc2 = mfma16(aC0, bQ0, z4); acc2 = mfma16(aC1, bQ1, acc2);
                f32x4 d1 = mfma16(ones, bP0, z4); d1 = mfma16(ones, bP1, d1);
                f32x4 d2 = mfma16(aN0, bQ0, z4); d2 = mfma16(aN1, bQ1, d2);
                const int t = 16 * tt + fr; const float it = gI[t], en = gE[t];
                const float den = d1[0] + it * d2[0]; const float inv = 1.f / fmaxf(fabsf(den), en);
                *(u32x2*)(Hout + ((size_t)b * 4096 + (size_t)ci * 64 + t) * 1024 + h * 128 + 16 * w + 4 * fq) =
                    pack4((acc1[0] + it * acc2[0]) * inv, (acc1[1] + it * acc2[1]) * inv, (acc1[2] + it * acc2[2]) * inv, (acc1[3] + it * acc2[3]) * inv);
            }
        }
#pragma unroll
        for (int dt = 0; dt < 4; ++dt) { Cacc[dt] = Cacc[dt] * sp; Nacc[dt] = Nacc[dt] * sp;
            const bf16x8 aK0 = *(const LAS bf16x8*)(Kwt + (16 * dt + fr) * 72 + 8 * fq), aK1 = *(const LAS bf16x8*)(Kwt + (16 * dt + fr) * 72 + 32 + 8 * fq);
            Cacc[dt] = mfma16(aK0, aV0, Cacc[dt]); Cacc[dt] = mfma16(aK1, aV1, Cacc[dt]);
            Nacc[dt] = mfma16(aK0, ones, Nacc[dt]); Nacc[dt] = mfma16(aK1, ones, Nacc[dt]); }
#pragma unroll
        for (int dt = 0; dt < 4; ++dt) { *(LAS u32x2*)(Cs + fr * 72 + 16 * dt + 4 * fq) = pack4(Cacc[dt][0], Cacc[dt][1], Cacc[dt][2], Cacc[dt][3]);
                                         *(LAS u32x2*)(nb + 16 * dt + 4 * fq) = pack4(Nacc[dt][0], Nacc[dt][1], Nacc[dt][2], Nacc[dt][3]); }
        m = m_new;
        __syncthreads();
    }
}
#undef ML_LOAD

__device__ __forceinline__ void hs_pass(const bf16* HF, const bf16* HB, const bf16* OG, const float* hg, bf16* HS, int gw, int NGW, int lane) {
    for (int m = gw; m < T; m += NGW) {
        const size_t off = (size_t)m * 1024 + 16 * lane;
        const v4u f0 = *(const v4u*)(HF + off), f1 = *(const v4u*)(HF + off + 8), b0 = *(const v4u*)(HB + off), b1 = *(const v4u*)(HB + off + 8), o0 = *(const v4u*)(OG + off), o1 = *(const v4u*)(OG + off + 8);
        float x[16], og[16];
#pragma unroll
        for (int i = 0; i < 4; ++i) { x[2 * i] = bf_lo(f0[i]) + bf_lo(b0[i]); x[2 * i + 1] = bf_hi(f0[i]) + bf_hi(b0[i]); x[8 + 2 * i] = bf_lo(f1[i]) + bf_lo(b1[i]); x[9 + 2 * i] = bf_hi(f1[i]) + bf_hi(b1[i]);
                                      og[2 * i] = bf_lo(o0[i]); og[2 * i + 1] = bf_hi(o0[i]); og[8 + 2 * i] = bf_lo(o1[i]); og[9 + 2 * i] = bf_hi(o1[i]); }
        float ss = 0.f;
#pragma unroll
        for (int i = 0; i < 16; ++i) ss += x[i] * x[i];
        ss += __shfl_xor(ss, 1); ss += __shfl_xor(ss, 2); ss += __shfl_xor(ss, 4);
        const float rstd = rsqrtf(ss * (1.f / 128.f) + EPS);
        float y[16];
#pragma unroll
        for (int i = 0; i < 16; ++i) y[i] = x[i] * rstd * hg[16 * lane + i] * (1.f / (1.f + __expf(-og[i])));
        v4u w0, w1;
#pragma unroll
        for (int i = 0; i < 4; ++i) { w0[i] = pk2(y[2 * i], y[2 * i + 1]); w1[i] = pk2(y[8 + 2 * i], y[9 + 2 * i]); }
        *(v4u*)(HS + off) = w0; *(v4u*)(HS + off + 8) = w1;
    }
}

#define TK_INSERT(v, x) do { float c_ = (x); _Pragma("unroll") for (int j_ = 0; j_ < 16; ++j_) { const float h_ = fmaxf(v[j_], c_); c_ = fminf(v[j_], c_); v[j_] = h_; } } while (0)
__device__ __forceinline__ void peer_topk_phase(int vcu, const bf16* PQ, const bf16* KEYS, int* EXPERTS, float* GATESP) {
    int tid_ = threadIdx.x; asm volatile("" : "+v"(tid_)); const int tid = tid_, lane = tid & 63, w = __builtin_amdgcn_readfirstlane(tid >> 6), r32 = lane & 31, hi = lane >> 5;
    const int t = vcu * 128 + (w & 3) * 32 + r32, hg = w >> 2;
    const float NINF = -INFINITY;
#pragma unroll 1
    for (int hh = 0; hh < 4; ++hh) {
        const int head = hg * 4 + hh;
        float L0[16], L1[16];
#pragma unroll
        for (int j = 0; j < 16; ++j) { L0[j] = 0.f; L1[j] = 0.f; }
#pragma unroll 1
        for (int p = 0; p < 2; ++p) {
            const int hp = head * 2 + p;
            bf16x8 bq[8];
#pragma unroll
            for (int ks = 0; ks < 8; ++ks) bq[ks] = *(const bf16x8*)(PQ + (size_t)t * 2048 + head * 256 + p * 128 + ks * 16 + 8 * hi);
            f32x16 acc[4];
#pragma unroll
            for (int nt = 0; nt < 4; ++nt) {
#pragma unroll
                for (int r = 0; r < 16; ++r) acc[nt][r] = 0.f;
#pragma unroll
                for (int ks = 0; ks < 8; ++ks) { const bf16x8 a = *(const bf16x8*)(KEYS + ((size_t)(hp * 128 + nt * 32 + r32)) * 128 + ks * 16 + 8 * hi); acc[nt] = mfma32(a, bq[ks], acc[nt]); }
            }
            float v[16];
#pragma unroll
            for (int j = 0; j < 16; ++j) v[j] = NINF;
#pragma unroll
            for (int nt = 0; nt < 4; ++nt)
#pragma unroll
                for (int r = 0; r < 16; ++r) { const int n = nt * 32 + (r & 3) + 8 * (r >> 2) + 4 * hi;
                    const float x = __uint_as_float((__float_as_uint(acc[nt][r]) & ~0x7Fu) | (unsigned)(127 - n)); TK_INSERT(v, x); }
            float wv[16];
#pragma unroll
            for (int j = 0; j < 16; ++j) wv[j] = __shfl_xor(v[j], 32);
#pragma unroll
            for (int j = 0; j < 16; ++j) TK_INSERT(v, wv[j]);
            if (p == 0) {
#pragma unroll
                for (int j = 0; j < 16; ++j) L0[j] = v[j];
            } else {
#pragma unroll
                for (int j = 0; j < 16; ++j) L1[j] = v[j];
            }
        }
        float tv[16];
#pragma unroll
        for (int j = 0; j < 16; ++j) tv[j] = NINF;
        unsigned IA[4] = {0u, 0u, 0u, 0u}, IB[4] = {0u, 0u, 0u, 0u};
#pragma unroll
        for (int i = 0; i < 16; ++i) { IA[i >> 2] |= (127u - (__float_as_uint(L0[i]) & 0x7Fu)) << (8 * (i & 3)); IB[i >> 2] |= (127u - (__float_as_uint(L1[i]) & 0x7Fu)) << (8 * (i & 3)); }
#pragma unroll
        for (int i = 0; i < 16; ++i) {
            const float va = __uint_as_float(__float_as_uint(L0[i]) & ~0x7Fu);
#pragma unroll
            for (int j = 0; j < 16; ++j) if ((i + 1) * (j + 1) <= 16) {
                const float vb = __uint_as_float(__float_as_uint(L1[j]) & ~0x7Fu);
                const float key = __uint_as_float((__float_as_uint(va + vb) & ~0xFFu) | (unsigned)(255 - (i * 16 + j)));
                TK_INSERT(tv, key);
            }
        }
        int ti[16];
#pragma unroll
        for (int j = 0; j < 16; ++j) { const unsigned kb = __float_as_uint(tv[j]); const unsigned flat = 255u - (kb & 0xFFu); const unsigned fi = flat >> 4, fj = flat & 15u;
            const unsigned ra = (fi < 8u) ? ((fi < 4u) ? IA[0] : IA[1]) : ((fi < 12u) ? IA[2] : IA[3]);
            const unsigned rb = (fj < 8u) ? ((fj < 4u) ? IB[0] : IB[1]) : ((fj < 12u) ? IB[2] : IB[3]);
            ti[j] = (int)(((ra >> (8u * (fi & 3u))) & 0xFFu) * 128u + ((rb >> (8u * (fj & 3u))) & 0xFFu));
            tv[j] = __uint_as_float(kb & ~0xFFu); }
        float e[16], sum = 0.f;
#pragma unroll
        for (int j = 0; j < 16; ++j) { e[j] = __expf(tv[j] - tv[0]); sum += e[j]; }
        const float inv = 1.f / sum;
        if (hi == 0) { int* ep = EXPERTS + (size_t)t * 128 + head * 16;
#pragma unroll
            for (int j = 0; j < 4; ++j) *(v4u*)(ep + 4 * j) = (v4u){(unsigned)ti[4 * j], (unsigned)ti[4 * j + 1], (unsigned)ti[4 * j + 2], (unsigned)ti[4 * j + 3]}; }
        else { float* gp = GATESP + (size_t)t * 128 + head * 16;
#pragma unroll
            for (int j = 0; j < 4; ++j) *(f32x4*)(gp + 4 * j) = (f32x4){e[4 * j] * inv, e[4 * j + 1] * inv, e[4 * j + 2] * inv, e[4 * j + 3] * inv}; }
    }
}

__device__ __forceinline__ float cvt_ub0(unsigned x) { float r; asm("v_cvt_f32_ubyte0 %0, %1" : "=v"(r) : "v"(x)); return r; }
__device__ __forceinline__ float cvt_ub1(unsigned x) { float r; asm("v_cvt_f32_ubyte1 %0, %1" : "=v"(r) : "v"(x)); return r; }
__device__ __forceinline__ float cvt_ub2(unsigned x) { float r; asm("v_cvt_f32_ubyte2 %0, %1" : "=v"(r) : "v"(x)); return r; }
__device__ __forceinline__ float cvt_ub3(unsigned x) { float r; asm("v_cvt_f32_ubyte3 %0, %1" : "=v"(r) : "v"(x)); return r; }
__device__ __forceinline__ void quant_rows(const float* src, unsigned char* dst, float* scale, int nrows, int offs, int gw, int NGW, int lane) {
    for (int r = gw; r < nrows; r += NGW) {
        const f32x4* sp = (const f32x4*)(src + (size_t)r * 1024) + 4 * lane;
        f32x4 v[4]; float am = 0.f;
#pragma unroll
        for (int j = 0; j < 4; ++j) { v[j] = sp[j]; am = fmaxf(am, fmaxf(fmaxf(fabsf(v[j].x), fabsf(v[j].y)), fmaxf(fabsf(v[j].z), fabsf(v[j].w)))); }
#pragma unroll
        for (int o = 1; o < 64; o <<= 1) am = fmaxf(am, __shfl_xor(am, o));
        const float inv = am > 0.f ? 127.f / am : 0.f;
        v4u w;
#pragma unroll
        for (int j = 0; j < 4; ++j) { const int q0 = (int)rintf(v[j].x * inv) + offs, q1 = (int)rintf(v[j].y * inv) + offs, q2 = (int)rintf(v[j].z * inv) + offs, q3 = (int)rintf(v[j].w * inv) + offs;
            w[j] = (unsigned)(q0 & 0xff) | ((unsigned)(q1 & 0xff) << 8) | ((unsigned)(q2 & 0xff) << 16) | ((unsigned)(q3 & 0xff) << 24); }
        *(v4u*)(dst + (size_t)r * 1024 + 16 * lane) = w;
        if (lane == 0) scale[r] = am * (1.f / 127.f);
    }
}

#define RED_STEP(N, S) do { const bool up_ = (lane & (S)) != 0; _Pragma("unroll") for (int j_ = 0; j_ < (N); ++j_) { const int a_ = p[j_], b_ = p[j_ + (N)]; const int send_ = up_ ? a_ : b_, keep_ = up_ ? b_ : a_; p[j_] = keep_ + __shfl_xor(send_, (S)); } } while (0)
template <bool NEXT_NORM>
__device__ __forceinline__ void peer_gather_phase(bool dry, int vcu, const bf16* HN, const int* EXPERTS, const float* GATESP, const unsigned char* U, const float* SU, const unsigned char* Vtab, const float* SV,
                                                  float* X, const float* gnext, bf16* XN) {
    int tid_ = threadIdx.x; asm volatile("" : "+v"(tid_)); const int tid = tid_, lane = tid & 63, w = __builtin_amdgcn_readfirstlane(tid >> 6);
#pragma unroll 1
    for (int i = 0; i < 16; ++i) {
        const int t = vcu * 128 + w * 16 + i;
        const v4u h0 = *(const v4u*)(HN + (size_t)t * 1024 + 16 * lane), h1 = *(const v4u*)(HN + (size_t)t * 1024 + 16 * lane + 8);
        float hf[16]; float am = 0.f;
#pragma unroll
        for (int k = 0; k < 4; ++k) { hf[2 * k] = bf_lo(h0[k]); hf[2 * k + 1] = bf_hi(h0[k]); hf[8 + 2 * k] = bf_lo(h1[k]); hf[9 + 2 * k] = bf_hi(h1[k]); }
#pragma unroll
        for (int k = 0; k < 16; ++k) am = fmaxf(am, fabsf(hf[k]));
#pragma unroll
        for (int o = 1; o < 64; o <<= 1) am = fmaxf(am, __shfl_xor(am, o));
        const float hinv = am > 0.f ? 127.f / am : 0.f, sh = am * (1.f / 127.f);
        int hq[4];
#pragma unroll
        for (int k = 0; k < 4; ++k) hq[k] = (int)(((unsigned)((int)rintf(hf[4 * k] * hinv) & 0xff)) | ((unsigned)((int)rintf(hf[4 * k + 1] * hinv) & 0xff) << 8) | ((unsigned)((int)rintf(hf[4 * k + 2] * hinv) & 0xff) << 16) | ((unsigned)((int)rintf(hf[4 * k + 3] * hinv) & 0xff) << 24));
        float o[16];
#pragma unroll
        for (int k = 0; k < 16; ++k) o[k] = 0.f;
        float csum = 0.f;
#pragma unroll 1
        for (int half = 0; half < 2; ++half) {
            const int ev = EXPERTS[(size_t)t * 128 + half * 64 + lane]; const float gv = GATESP[(size_t)t * 128 + half * 64 + lane];
            const float su = SU[ev], sv = SV[ev];
            int p[64];
#pragma unroll
            for (int j = 0; j < 64; ++j) {
                const int e = __builtin_amdgcn_readlane(ev, j);
                const v4u a = *((const v4u*)(U + (size_t)e * 1024) + lane);
                int d = __builtin_amdgcn_sdot4((int)a.x, hq[0], 0, false); d = __builtin_amdgcn_sdot4((int)a.y, hq[1], d, false); d = __builtin_amdgcn_sdot4((int)a.z, hq[2], d, false); d = __builtin_amdgcn_sdot4((int)a.w, hq[3], d, false);
                p[j] = d;
            }
            RED_STEP(32, 32); RED_STEP(16, 16); RED_STEP(8, 8); RED_STEP(4, 4); RED_STEP(2, 2); RED_STEP(1, 1);
            const float act = (float)p[0] * (sh * su);
            const float coef = gv * (0.5f * act * (1.f + erff(act * 0.70710678118f))) * sv;
            csum += coef;
#pragma unroll
            for (int j = 0; j < 64; ++j) {
                const int e = __builtin_amdgcn_readlane(ev, j);
                const float c = __uint_as_float(__builtin_amdgcn_readlane(__float_as_uint(coef), j));
                const v4u a = *((const v4u*)(Vtab + (size_t)e * 1024) + lane);
#pragma unroll
                for (int k = 0; k < 4; ++k) { o[4 * k] += c * cvt_ub0(a[k]); o[4 * k + 1] += c * cvt_ub1(a[k]); o[4 * k + 2] += c * cvt_ub2(a[k]); o[4 * k + 3] += c * cvt_ub3(a[k]); }
            }
        }
        const float corr = 128.f * wave_sum(csum);
        float* xr = X + (size_t)t * 1024 + 16 * lane;
        f32x4 xv[4];
#pragma unroll
        for (int k = 0; k < 4; ++k) { xv[k] = *(const f32x4*)(xr + 4 * k); xv[k] += (f32x4){o[4 * k] - corr, o[4 * k + 1] - corr, o[4 * k + 2] - corr, o[4 * k + 3] - corr}; }
        if (!dry) {
#pragma unroll
            for (int k = 0; k < 4; ++k) *(f32x4*)(xr + 4 * k) = xv[k]; }
        if (NEXT_NORM && !dry) {
            float ss = 0.f;
#pragma unroll
            for (int k = 0; k < 4; ++k) ss += (xv[k].x * xv[k].x + xv[k].y * xv[k].y) + (xv[k].z * xv[k].z + xv[k].w * xv[k].w);
            const float rstd = rsqrtf(wave_sum(ss) * (1.f / 1024.f) + EPS);
            v4u wa, wb;
#pragma unroll
            for (int k = 0; k < 4; ++k) { const f32x4 g = *(const f32x4*)(gnext + 16 * lane + 4 * k); const unsigned lo = pk2(xv[k].x * rstd * g.x, xv[k].y * rstd * g.y), hi2 = pk2(xv[k].z * rstd * g.z, xv[k].w * rstd * g.w);
                if (k < 2) { wa[2 * k] = lo; wa[2 * k + 1] = hi2; } else { wb[2 * (k - 2)] = lo; wb[2 * (k - 2) + 1] = hi2; } }
            *(v4u*)(XN + (size_t)t * 1024 + 16 * lane) = wa; *(v4u*)(XN + (size_t)t * 1024 + 16 * lane + 8) = wb;
        }
    }
}

__device__ __forceinline__ void qknorm_rope_pass(bf16* Q1, bf16* K1, const float* qg, const float* kg, const float* rope, size_t gtid, size_t gthreads) {
    const size_t NROWS = (size_t)2 * 64 * 2 * 4096;
    for (size_t id = gtid; id < NROWS * 8; id += gthreads) {
        const size_t rowg = id >> 3; const int part = (int)(id & 7);
        const bool isk = rowg >= NROWS / 2; const size_t row = isk ? rowg - NROWS / 2 : rowg;
        bf16* ptr = (isk ? K1 : Q1) + row * 64 + part * 8; const float* g = (isk ? kg : qg) + part * 8;
        const int s = (int)(row & 4095); const int bh = (int)(row >> 13); const int bidx = bh >> 3; const size_t mtok = (size_t)bidx * 4096 + s;
        const v4u raw = *(const v4u*)ptr;
        float x[8];
#pragma unroll
        for (int i = 0; i < 4; ++i) { x[2 * i] = bf_lo(raw[i]); x[2 * i + 1] = bf_hi(raw[i]); }
        float ss = 0.f;
#pragma unroll
        for (int i = 0; i < 8; ++i) ss += x[i] * x[i];
        ss += __shfl_xor(ss, 1); ss += __shfl_xor(ss, 2); ss += __shfl_xor(ss, 4);
        const float rstd = rsqrtf(ss * (1.f / 64.f) + EPS);
        float y[8], other[8];
#pragma unroll
        for (int i = 0; i < 8; ++i) y[i] = x[i] * rstd * g[i];
#pragma unroll
        for (int i = 0; i < 8; ++i) other[i] = __shfl_xor(y[i], 1);
        if (part < 2) { const float* cs = rope + mtok * 16;
#pragma unroll
            for (int i = 0; i < 8; ++i) { const float co = cs[i], si = cs[8 + i]; y[i] = (part == 0) ? (y[i] * co - other[i] * si) : (y[i] * co + other[i] * si); } }
        const float sc = isk ? 1.f : (0.125f * 1.44269504089f);
        v4u o;
#pragma unroll
        for (int i = 0; i < 4; ++i) o[i] = pk2(y[2 * i] * sc, y[2 * i + 1] * sc);
        *(v4u*)ptr = o;
    }
}

#define AT_LOAD(kt_) do { _Pragma("unroll") for (int i_ = 0; i_ < 2; ++i_) { rK[i_] = *(const v4u*)(K1 + ((size_t)((bh * 2 + i_) * 4096 + (kt_) * 64 + (tid >> 3))) * 64 + (tid & 7) * 8); \
        rV[i_] = *(const v4u*)(V1 + ((size_t)(bh * 4096 + (kt_) * 64 + lane)) * 128 + (2 * w + i_) * 8); } } while (0)
#define AT_WRITE(buf_) do { _Pragma("unroll") for (int i_ = 0; i_ < 2; ++i_) { *(LAS v4u*)(lds + (buf_) * 35840 + i_ * 9216 + ((tid >> 3) * 72 + (tid & 7) * 8) * 2) = rK[i_]; \
        LAS bf16* vt_ = (LAS bf16*)(lds + (buf_) * 35840 + 18432) + ((2 * w + i_) * 8) * 68 + lane; \
        _Pragma("unroll") for (int e_ = 0; e_ < 4; ++e_) { vt_[(2 * e_) * 68] = (bf16)(rV[i_][e_] & 0xffffu); vt_[(2 * e_ + 1) * 68] = (bf16)(rV[i_][e_] >> 16); } } } while (0)
__device__ __forceinline__ void attn_phase(LAS unsigned char* lds, int vcu, const bf16* Q1, const bf16* K1, const bf16* V1, bf16* O, const float* qg, const float* kg,
                                           const float* lq1, const float* lk1, const float* lq2, const float* lk2, const float* subln) {
    int tid_ = threadIdx.x; asm volatile("" : "+v"(tid_)); const int tid = tid_, lane = tid & 63, w = __builtin_amdgcn_readfirstlane(tid >> 6), r32 = lane & 31, hi = lane >> 5, qt = w & 3, c = w >> 2;
    float s1 = 0.f, s2 = 0.f, mq = 0.f, mk = 0.f;
    for (int i = 0; i < 64; ++i) { s1 += lq1[i] * lk1[i]; s2 += lq2[i] * lk2[i]; mq = fmaxf(mq, fabsf(qg[i])); mk = fmaxf(mk, fabsf(kg[i])); }
    const float lam = expf(s1) - expf(s2) + LAMBDA_INIT;
    const float offs = 8.f * mq * mk * 1.44269504089f * 1.02f + 0.25f;
    f32x16 cinit;
#pragma unroll
    for (int r = 0; r < 16; ++r) cinit[r] = -offs;
    LAS float* lbuf = (LAS float*)(lds + 135168 + w * 128);
    LAS float* Obuf = (LAS float*)lds;
#pragma unroll 1
    for (int ui = 0; ui < 8; ++ui) {
        const int uid = vcu * 8 + ui, bh = uid >> 5, qb = uid & 31, b = bh >> 3, h = bh & 7;
        bf16x8 bq[4];
#pragma unroll
        for (int ks = 0; ks < 4; ++ks) bq[ks] = *(const bf16x8*)(Q1 + ((size_t)((bh * 2 + c) * 4096 + qb * 128 + qt * 32 + r32)) * 64 + ks * 16 + 8 * hi);
        f32x16 Oa[4];
#pragma unroll
        for (int db = 0; db < 4; ++db)
#pragma unroll
            for (int r = 0; r < 16; ++r) Oa[db][r] = 0.f;
        float lsum = 0.f;
        v4u rK[2], rV[2];
        AT_LOAD(0); AT_WRITE(0); AT_LOAD(1);
        __syncthreads();
#pragma unroll 1
        for (int kt = 0; kt < 64; ++kt) {
            const int buf = kt & 1;
            if (kt + 1 < 64) AT_WRITE(buf ^ 1);
            if (kt + 2 < 64) AT_LOAD(kt + 2);
            const LAS bf16* Kc = (const LAS bf16*)(lds + buf * 35840 + c * 9216);
            const LAS bf16* Vt = (const LAS bf16*)(lds + buf * 35840 + 18432);
            f32x16 p0 = cinit, p1 = cinit;
#pragma unroll
            for (int ks = 0; ks < 4; ++ks) { const bf16x8 a0 = *(const LAS bf16x8*)(Kc + r32 * 72 + ks * 16 + 8 * hi), a1 = *(const LAS bf16x8*)(Kc + (32 + r32) * 72 + ks * 16 + 8 * hi);
                p0 = mfma32(a0, bq[ks], p0); p1 = mfma32(a1, bq[ks], p1); }
            float ls = 0.f;
#pragma unroll
            for (int r = 0; r < 16; ++r) { p0[r] = __builtin_amdgcn_exp2f(p0[r]); p1[r] = __builtin_amdgcn_exp2f(p1[r]); ls += p0[r] + p1[r]; }
            lsum += ls;
            bf16x8 pa[4];
            { v4u t0, t1, t2, t3;
#pragma unroll
              for (int k = 0; k < 4; ++k) { t0[k] = pk2(p0[2 * k], p0[2 * k + 1]); t1[k] = pk2(p0[8 + 2 * k], p0[9 + 2 * k]); t2[k] = pk2(p1[2 * k], p1[2 * k + 1]); t3[k] = pk2(p1[8 + 2 * k], p1[9 + 2 * k]); }
              pa[0] = __builtin_bit_cast(bf16x8, t0); pa[1] = __builtin_bit_cast(bf16x8, t1); pa[2] = __builtin_bit_cast(bf16x8, t2); pa[3] = __builtin_bit_cast(bf16x8, t3); }
#pragma unroll
            for (int sp_ = 0; sp_ < 4; ++sp_)
#pragma unroll
                for (int db = 0; db < 4; ++db) { const LAS bf16* vp = Vt + (32 * db + r32) * 68 + 16 * sp_ + 4 * hi;
                    const u32x2 lo = *(const LAS u32x2*)vp, hh = *(const LAS u32x2*)(vp + 8);
                    const v4u vv = (v4u){lo.x, lo.y, hh.x, hh.y};
                    Oa[db] = mfma32(pa[sp_], __builtin_bit_cast(bf16x8, vv), Oa[db]); }
            __syncthreads();
        }
        lsum += __shfl_xor(lsum, 32);
        lbuf[r32] = lsum;
#pragma unroll
        for (int r = 0; r < 16; ++r) { const int qrow = (r & 3) + 8 * (r >> 2) + 4 * hi; const float inv = 1.f / lbuf[qrow];
#pragma unroll
            for (int db = 0; db < 4; ++db) Obuf[(c * 128 + qt * 32 + qrow) * 132 + 32 * db + r32] = Oa[db][r] * inv; }
        __syncthreads();
        { const int row = tid >> 2, qd = tid & 3;
          float dv[32]; float ss = 0.f;
#pragma unroll
          for (int k = 0; k < 8; ++k) { const f32x4 o0 = *(const LAS f32x4*)(Obuf + row * 132 + qd * 32 + 4 * k), o1 = *(const LAS f32x4*)(Obuf + (128 + row) * 132 + qd * 32 + 4 * k);
#pragma unroll
              for (int e = 0; e < 4; ++e) { const float d = o0[e] - lam * o1[e]; dv[4 * k + e] = d; ss += d * d; } }
          ss += __shfl_xor(ss, 1); ss += __shfl_xor(ss, 2);
          const float rstd = rsqrtf(ss * (1.f / 128.f) + EPS) * (1.f - LAMBDA_INIT);
          bf16* op = O + ((size_t)b * 4096 + qb * 128 + row) * 1024 + h * 128 + qd * 32;
#pragma unroll
          for (int k = 0; k < 4; ++k) { v4u o;
#pragma unroll
              for (int e = 0; e < 4; ++e) o[e] = pk2(dv[8 * k + 2 * e] * rstd * subln[qd * 32 + 8 * k + 2 * e], dv[8 * k + 2 * e + 1] * rstd * subln[qd * 32 + 8 * k + 2 * e + 1]);
              *(v4u*)(op + 8 * k) = o; } }
        __syncthreads();
    }
}
#undef AT_LOAD
#undef AT_WRITE
struct Args { const void* in[27]; float* out; unsigned char* ws; };
#define KARG(i) ({ const void* p_; asm volatile("s_load_dwordx2 %0, %1, %2\n\ts_waitcnt lgkmcnt(0)" : "=s"(p_) : "s"(__builtin_amdgcn_kernarg_segment_ptr()), "i"(8 * (i))); p_; })
#define KIN(i) ((const float*)KARG(i))
#define KOUT() ((float*)KARG(27))
#define KWS() ((unsigned char*)KARG(28))
#define WSP(T_, off) ((T_*)(KWS() + (off)))
__global__ void __launch_bounds__(NWAVES * 64, 2) mk_fwd(Args args) {
    extern __shared__ __attribute__((aligned(16))) unsigned char lds_raw[];
    LAS unsigned char* lds = (LAS unsigned char*)lds_raw;
    const int G = gridDim.x, bx = blockIdx.x;
    const int vcu = (G % 8 == 0) ? (bx % 8) * (G / 8) + bx / 8 : bx;
#define PH_IDS() int tid_ = threadIdx.x; asm volatile("" : "+v"(tid_)); const int tid = tid_, lane = tid & 63, wave = __builtin_amdgcn_readfirstlane(tid >> 6); \
    const int gw = vcu * NWAVES + wave, NGW = G * NWAVES; const size_t gtid = (size_t)vcu * (NWAVES * 64) + tid, gthreads = (size_t)G * (NWAVES * 64); (void)lane; (void)gw; (void)NGW; (void)gtid; (void)gthreads
    if (threadIdx.x < 32) ((LAS unsigned*)(lds + MISC_OFF))[threadIdx.x] = 0u;
    __syncthreads();
    (void)xcd_barrier_post((unsigned*)(WSP(gu32, WS_CTL) + CW_BAR), (volatile LAS unsigned*)(lds + MISC_OFF) + 8);
#define STAMP() do {} while (0)
#ifndef PROBE_DUP
#define PROBE_DUP 0
#endif
#define REPS(bit) _Pragma("unroll 1") for (int rep_ = 0; rep_ < 1 + ((PROBE_DUP >> (bit)) & 1); ++rep_)
#define GRID_BAR() do { XcdBarrier b_; b_.bar = (unsigned*)(WSP(gu32, WS_CTL) + CW_BAR); b_.x = xb_xcc_id(); b_.st = (volatile LAS unsigned*)(lds + MISC_OFF) + 8; xcd_barrier(b_); STAMP(); } while (0)

    REPS(5) {
        PH_IDS();
        LAS float* scr = (LAS float*)(lds + wave * 16384);
        constexpr int I0 = 16 * 97, I1 = 16 * 32, I2 = 16 * 64, I3 = 16 * 96, I4 = 16 * 32, I5 = 16 * 64, NITEMS = I0 + I1 + I2 + I3 + I4 + I5;
        for (int it = gw; it < NITEMS; it += NGW) {
            int r = it;
            if (r < I0) { p0_transpose_item(KIN(3), 1024, 3104, WSP(bf16, WS_WIN), scr, r, lane); continue; } r -= I0;
            if (r < I1) { p0_transpose_item(KIN(6), 1024, 1024, WSP(bf16, WS_WO0), scr, r, lane); continue; } r -= I1;
            if (r < I2) { p0_transpose_item(KIN(8), 1024, 2048, WSP(bf16, WS_WQ0), scr, r, lane); continue; } r -= I2;
            if (r < I3) { p0_transpose_item(KIN(13), 1024, 3072, WSP(bf16, WS_WQKV), scr, r, lane); continue; } r -= I3;
            if (r < I4) { p0_transpose_item(KIN(21), 1024, 1024, WSP(bf16, WS_WO1), scr, r, lane); continue; } r -= I4;
            p0_transpose_item(KIN(23), 1024, 2048, WSP(bf16, WS_WQ1), scr, r, lane);
        }
        { bf16* WIN = WSP(bf16, WS_WIN); for (size_t i = gtid * 8; i < (size_t)224 * 1024; i += gthreads * 8) *(v4u*)(WIN + (size_t)3104 * 1024 + i) = (v4u){0u, 0u, 0u, 0u}; }
        cvt_range(KIN(9), WSP(bf16, WS_KEY0), (size_t)262144, gtid, gthreads);
        cvt_range(KIN(24), WSP(bf16, WS_KEY1), (size_t)262144, gtid, gthreads);
        quant_rows(KIN(10), WSP(unsigned char, WS_U0), WSP(float, WS_SC), 16384, 0, gw, NGW, lane);
        quant_rows(KIN(11), WSP(unsigned char, WS_V0T), WSP(float, WS_SC + 65536), 16384, 128, gw, NGW, lane);
        quant_rows(KIN(25), WSP(unsigned char, WS_U1), WSP(float, WS_SC + 2 * 65536), 16384, 0, gw, NGW, lane);
        quant_rows(KIN(26), WSP(unsigned char, WS_V1T), WSP(float, WS_SC + 3 * 65536), 16384, 128, gw, NGW, lane);
        rms_pass(KIN(0), KIN(2), WSP(bf16, WS_B0), gw, NGW, lane);
        { const int* positions = (const int*)KARG(1); float* ROPE = WSP(float, WS_ROPE);
          for (size_t id = gtid; id < (size_t)T * 8; id += gthreads) { const size_t mtok = id >> 3; const int i = (int)(id & 7);
            const float inv = powf(500000.0f, -(float)i * 2.0f / 16.0f); const float ang = (float)positions[mtok] * inv;
            float sn, cs; sincosf(ang, &sn, &cs); ROPE[mtok * 16 + i] = cs; ROPE[mtok * 16 + 8 + i] = sn; } }
    }
    GRID_BAR();
    REPS(3) {
        unsigned char* ws = KWS();
        pg8::Gemm g{(const bf16*)(ws + WS_B0), (const bf16*)(ws + WS_WIN), T, 3328, 1024}; pg8::StaticOrder S; S.init(T, 3328, G, bx);
        pg8::EpiInProj E{(bf16*)(ws + WS_R1), (bf16*)(ws + WS_R1 + 32 * MiB), (bf16*)(ws + WS_R2), (bf16*)(ws + WS_R3), (float*)(ws + WS_GATES), KIN(4)};
        pg8::gemm_phase<pg8::EpiInProj, pg8::StaticOrder, true, true>(lds, g, S, E);
    }
    GRID_BAR();
    REPS(2) { unsigned char* ws = KWS(); mlstm_phase(lds, (const bf16*)(ws + WS_R1), (const bf16*)(ws + WS_R1 + 32 * MiB), (const bf16*)(ws + WS_R2), (const float*)(ws + WS_GATES), (bf16*)(ws + WS_R4), (bf16*)(ws + WS_R5)); }
    GRID_BAR();
    { PH_IDS(); unsigned char* ws = KWS(); hs_pass((const bf16*)(ws + WS_R4), (const bf16*)(ws + WS_R5), (const bf16*)(ws + WS_R3), KIN(5), (bf16*)(ws + WS_B0), gw, NGW, lane); }
    GRID_BAR();
#pragma unroll 1
    for (int L = 0; L < 2; ++L) {
        if (L == 1) {
            REPS(3) {
                unsigned char* ws = KWS();
                pg8::Gemm g{(const bf16*)(ws + WS_B0), (const bf16*)(ws + WS_WQKV), T, 3072, 1024}; pg8::StaticOrder S; S.init(T, 3072, G, bx);
                pg8::EpiQKV E{(bf16*)(ws + WS_R2), (bf16*)(ws + WS_R3), (bf16*)(ws + WS_R4)};
                pg8::gemm_phase<pg8::EpiQKV, pg8::StaticOrder, true, true>(lds, g, S, E);
            }
            GRID_BAR();
            { PH_IDS(); unsigned char* ws = KWS(); qknorm_rope_pass((bf16*)(ws + WS_R2), (bf16*)(ws + WS_R3), KIN(14), KIN(15), (const float*)(ws + WS_ROPE), gtid, gthreads); }
            GRID_BAR();
            REPS(0) { unsigned char* ws = KWS(); attn_phase(lds, vcu, (const bf16*)(ws + WS_R2), (const bf16*)(ws + WS_R3), (const bf16*)(ws + WS_R4), (bf16*)(ws + WS_B0), KIN(14), KIN(15), KIN(16), KIN(17), KIN(18), KIN(19), KIN(20)); }
            GRID_BAR();
        }
        _Pragma("unroll 1") for (int rep_ = 0; rep_ < 1 + ((L == 0) ? ((PROBE_DUP >> 3) & 1) : 0); ++rep_) {
            unsigned char* ws = KWS(); float* out = KOUT();
            pg8::Gemm g{(const bf16*)(ws + WS_B0), (const bf16*)(ws + (L ? WS_WO1 : WS_WO0)), T, 1024, 1024}; pg8::StaticOrder S; S.init(T, 1024, G, bx);
            pg8::EpiRes E{L ? (const float*)out : KIN(0), out};
            pg8::gemm_phase<pg8::EpiRes, pg8::StaticOrder, true, true>(lds, g, S, E);
        }
        GRID_BAR();
        { PH_IDS(); rms_pass(KOUT(), L ? KIN(22) : KIN(7), WSP(bf16, WS_B0), gw, NGW, lane); }
        GRID_BAR();
        REPS(3) {
            unsigned char* ws = KWS();
            pg8::Gemm g{(const bf16*)(ws + WS_B0), (const bf16*)(ws + (L ? WS_WQ1 : WS_WQ0)), T, 2048, 1024}; pg8::StaticOrder S; S.init(T, 2048, G, bx);
            pg8::EpiPlain E{(bf16*)(ws + WS_R2), 2048};
            pg8::gemm_phase<pg8::EpiPlain, pg8::StaticOrder, true, true>(lds, g, S, E);
        }
        GRID_BAR();
        REPS(4) { unsigned char* ws = KWS(); peer_topk_phase(vcu, (const bf16*)(ws + WS_R2), (const bf16*)(ws + (L ? WS_KEY1 : WS_KEY0)), (int*)(ws + WS_R4), (float*)(ws + WS_R4 + 16 * MiB)); }
        GRID_BAR();
        if (L == 0) { unsigned char* ws = KWS();
            if ((PROBE_DUP >> 1) & 1) peer_gather_phase<true>(gridDim.y == 1, vcu, (const bf16*)(ws + WS_B0), (const int*)(ws + WS_R4), (const float*)(ws + WS_R4 + 16 * MiB), ws + WS_U0, (const float*)(ws + WS_SC), ws + WS_V0T, (const float*)(ws + WS_SC + 65536), KOUT(), KIN(12), (bf16*)(ws + WS_B0));
            peer_gather_phase<true>(false, vcu, (const bf16*)(ws + WS_B0), (const int*)(ws + WS_R4), (const float*)(ws + WS_R4 + 16 * MiB), ws + WS_U0, (const float*)(ws + WS_SC), ws + WS_V0T, (const float*)(ws + WS_SC + 65536), KOUT(), KIN(12), (bf16*)(ws + WS_B0)); GRID_BAR(); }
        else { unsigned char* ws = KWS(); peer_gather_phase<false>(false, vcu, (const bf16*)(ws + WS_B0), (const int*)(ws + WS_R4), (const float*)(ws + WS_R4 + 16 * MiB), ws + WS_U1, (const float*)(ws + WS_SC + 2 * 65536), ws + WS_V1T, (const float*)(ws + WS_SC + 3 * 65536), KOUT(), nullptr, nullptr); }
    }
#undef GRID_BAR
}

extern "C" void kernel_launch(void* const* d_in, const int* in_sizes, int n_in, void* d_out, int out_size, void* d_ws, size_t ws_size, hipStream_t stream) {
    static int ready = 0;
    if (ready == 0) {
        if (n_in != 27 || out_size != T * D || ws_size < WS_END) { fprintf(stderr, "kernel_launch: unexpected problem (n_in %d, out %d, ws %zu)\n", n_in, out_size, ws_size); ready = -1; return; }
        if (hipFuncSetAttribute((const void*)mk_fwd, hipFuncAttributeMaxDynamicSharedMemorySize, LDS_BYTES) != hipSuccess) { fprintf(stderr, "kernel_launch: hipFuncSetAttribute failed\n"); ready = -1; return; }
        (void)hipGetLastError();
        ready = 1;
    }
    if (ready < 0) return;
    if (hipMemsetAsync((char*)d_ws + WS_CTL, 0, CTL_ZERO_BYTES, stream) != hipSuccess) { fprintf(stderr, "kernel_launch: memset failed\n"); return; }
    Args a{};
    for (int i = 0; i < 27; ++i) a.in[i] = d_in[i];
    a.out = (float*)d_out; a.ws = (unsigned char*)d_ws;
    hipLaunchKernelGGL(mk_fwd, dim3(256), dim3(NWAVES * 64), LDS_BYTES, stream, a);
}
```

```cpp
#include <hip/hip_runtime.h>
#include <hip/hip_bf16.h>
#include <cstdio>
#include <cstdint>
#include <cmath>
namespace pg8 {
#define PG8_LAS __attribute__((address_space(3)))
typedef unsigned short bf16_t;
typedef short bf16x8 __attribute__((ext_vector_type(8)));
typedef float f32x4 __attribute__((ext_vector_type(4)));
typedef unsigned u32x4 __attribute__((ext_vector_type(4)));
constexpr int BM = 256, BK = 64, HALF = 128, HTB = HALF * BK * 2  , STAGE_BYTES = 8 * HTB, NXCD = 8, WGM = 8;

__host__ __device__ __forceinline__ int lds_byte(int r, int c) { const int st = (r >> 4) * 2 + (c >> 5), rr = r & 15, cc = c & 31, ob = rr * 64 + cc * 2; return st * 1024 + (ob ^ (((ob >> 9) & 1) << 5)); }
__host__ __device__ __forceinline__ void stage_rc(int b, int& R, int& C) { const int st = b / 1024, sb = b % 1024, swz = sb ^ (((sb >> 9) & 1) << 5); R = (st >> 1) * 16 + swz / 64; C = (st & 1) * 32 + (swz % 64) / 2; }
__host__ __device__ __forceinline__ int perm32(int rho) { const int n = rho >> 4, i = rho & 15; return 8 * (i >> 2) + 4 * n + (i & 3); }

struct Unit { int pm, pn; };
struct Gemm { const bf16_t* A; const bf16_t* Bt; int M, N, K; };

struct StaticOrder {
    int nM, nN, nwg, G, c;
    __host__ __device__ void init(int M, int N, int G_, int c_) { nM = M / BM; nN = N / BM; nwg = nM * nN; G = G_; c = c_; }
    __host__ __device__ bool next(int i, Unit& u) const {
        const long L = (long)i * G + c; if (L >= nwg) return false;
        int wgid = (int)L; { const int q = nwg / NXCD, r = nwg % NXCD, xcd = wgid % NXCD, off = wgid / NXCD; wgid = (xcd < r ? xcd * (q + 1) : r * (q + 1) + (xcd - r) * q) + off; }
        const int nig = WGM * nN, gid = wgid / nig, fm = gid * WGM, gsz = (nM - fm) < WGM ? (nM - fm) : WGM;
        u.pm = fm + ((wgid % nig) % gsz); u.pn = (wgid % nig) / gsz; return true;
    }
    __device__ __forceinline__ void a_ready(const Unit&) const {}
    __device__ __forceinline__ void done(const Unit&) const {}
};
__device__ __forceinline__ unsigned cvt_pk_bf16(float lo, float hi) { unsigned r; asm volatile("v_cvt_pk_bf16_f32 %0, %1, %2" : "=v"(r) : "v"(lo), "v"(hi)); return r; }
typedef float f32x2 __attribute__((ext_vector_type(2)));
typedef unsigned u32x2 __attribute__((ext_vector_type(2)));
__device__ __forceinline__ u32x4 pack8(const f32x4 v0, const f32x4 v1) { u32x4 w; w.x = cvt_pk_bf16(v0[0], v0[1]); w.y = cvt_pk_bf16(v0[2], v0[3]); w.z = cvt_pk_bf16(v1[0], v1[1]); w.w = cvt_pk_bf16(v1[2], v1[3]); return w; }
struct EpiPlain {
    static constexpr bool PERM = true, AFTER_DRAIN = false;
    bf16_t* O; int ldc;
    __device__ __forceinline__ void operator()(const f32x4 (&acc)[2][2][4][2], const Unit& u, int wr, int wc, int fr, int fq) const {
        const int row0 = u.pm * BM + wr * 64 + fr, col0 = u.pn * BM + wc * 32 + 8 * fq;
#pragma unroll
        for (int ai = 0; ai < 2; ++ai)
#pragma unroll
            for (int m = 0; m < 4; ++m) { bf16_t* rowp = O + (size_t)(row0 + ai * HALF + m * 16) * ldc + col0;
#pragma unroll
                for (int bj = 0; bj < 2; ++bj) *(u32x4*)(rowp + bj * HALF) = pack8(acc[ai][bj][m][0], acc[ai][bj][m][1]); }
    }
};
struct EpiRes {
    static constexpr bool PERM = false, AFTER_DRAIN = false;
    const float* base; float* out;
    __device__ __forceinline__ void operator()(const f32x4 (&acc)[2][2][4][2], const Unit& u, int wr, int wc, int fr, int fq) const {
        const int col0 = u.pn * BM + wc * 32 + 4 * fq;
#pragma unroll
        for (int ai = 0; ai < 2; ++ai)
#pragma unroll
            for (int m = 0; m < 4; ++m) { const size_t off = (size_t)(u.pm * BM + ai * HALF + wr * 64 + m * 16 + fr) * 1024 + col0;
#pragma unroll
                for (int bj = 0; bj < 2; ++bj)
#pragma unroll
                    for (int n = 0; n < 2; ++n) { const f32x4 bs = *(const f32x4*)(base + off + bj * HALF + n * 16); *(f32x4*)(out + off + bj * HALF + n * 16) = bs + acc[ai][bj][m][n]; } }
    }
};
struct EpiInProj {
    static constexpr bool PERM = true, AFTER_DRAIN = false;
    bf16_t *Q, *Kk, *V, *OG; float* gates; const float* bg;
    __device__ __forceinline__ void operator()(const f32x4 (&acc)[2][2][4][2], const Unit& u, int wr, int wc, int fr, int fq) const {
        const int colt = u.pn * BM;
#pragma unroll
        for (int ai = 0; ai < 2; ++ai)
#pragma unroll
            for (int m = 0; m < 4; ++m) { const int row = u.pm * BM + ai * HALF + wr * 64 + m * 16 + fr, b = row >> 12, s = row & 4095;
#pragma unroll
                for (int bj = 0; bj < 2; ++bj) { const int cb = colt + bj * HALF + wc * 32 + 8 * fq; f32x4 v0 = acc[ai][bj][m][0], v1 = acc[ai][bj][m][1];
                    if (colt < 1024) { const bool isq = colt < 512; bf16_t* base = isq ? Q : Kk; const int c2 = cb & 511, head = c2 >> 6, d = c2 & 63;
                        if (isq) { v0 = v0 * 0.125f; v1 = v1 * 0.125f; }
                        *(u32x4*)(base + ((size_t)((b * 8 + head) * 4096 + s)) * 64 + d) = pack8(v0, v1); }
                    else if (colt < 2048) { const int c2 = cb - 1024, head = c2 >> 7, dv = c2 & 127; *(u32x4*)(V + ((size_t)((b * 8 + head) * 4096 + s)) * 128 + dv) = pack8(v0, v1); }
                    else if (colt < 3072) { *(u32x4*)(OG + (size_t)row * 1024 + (cb - 2048)) = pack8(v0, v1); }
                    else if (cb < 3104) { const int gi = cb - 3072; float* g = gates + (size_t)row * 32 + gi;
                        *(f32x4*)g = v0 + *(const f32x4*)(bg + gi); *(f32x4*)(g + 4) = v1 + *(const f32x4*)(bg + gi + 4); } } }
    }
};
struct EpiQKV {
    static constexpr bool PERM = true, AFTER_DRAIN = false;
    bf16_t *Q, *Kk, *V;
    __device__ __forceinline__ void operator()(const f32x4 (&acc)[2][2][4][2], const Unit& u, int wr, int wc, int fr, int fq) const {
        const int colt = u.pn * BM;
#pragma unroll
        for (int ai = 0; ai < 2; ++ai)
#pragma unroll
            for (int m = 0; m < 4; ++m) { const int row = u.pm * BM + ai * HALF + wr * 64 + m * 16 + fr, b = row >> 12, s = row & 4095;
#pragma unroll
                for (int bj = 0; bj < 2; ++bj) { const int cb = colt + bj * HALF + wc * 32 + 8 * fq; const u32x4 w = pack8(acc[ai][bj][m][0], acc[ai][bj][m][1]);
                    if (colt < 2048) { bf16_t* base = colt < 1024 ? Q : Kk; const int c2 = cb & 1023, head = c2 >> 7, c = (c2 >> 6) & 1, d = c2 & 63;
                        *(u32x4*)(base + ((size_t)(((b * 8 + head) * 2 + c) * 4096 + s)) * 64 + d) = w; }
                    else { const int c2 = cb - 2048, head = c2 >> 7, dv = c2 & 127; *(u32x4*)(V + ((size_t)((b * 8 + head) * 4096 + s)) * 128 + dv) = w; } } }
    }
};
template <class Epi, class Sched, bool ALIGN_EPI = false, bool SP2 = false>
__device__ __forceinline__ void gemm_phase(PG8_LAS unsigned char* lds, const Gemm g, const Sched& S, const Epi& E) {
    int tid_ = threadIdx.x; asm volatile("" : "+v"(tid_)); const int tid = tid_, wid = __builtin_amdgcn_readfirstlane(tid >> 6), lane = tid & 63, wr = wid >> 2, wc = wid & 3, fr = lane & 15, fq = lane >> 4;
    const int K = g.K, nt = K / BK;
    unsigned voffA[2], voffB[2];
#pragma unroll
    for (int i = 0; i < 2; ++i) { int R, C; stage_rc(tid * 16 + i * 8192, R, C); const int Rb = Epi::PERM ? ((R & ~31) + perm32(R & 31)) : R;
        voffA[i] = (unsigned)(R * K + C) * 2u; voffB[i] = (unsigned)(Rb * K + C) * 2u; }
    const size_t kstep = (size_t)(BK * 2);
    const size_t hstep = (size_t)HALF * K * 2;
    const size_t tstep = 2 * hstep;
    const unsigned ldsw = (unsigned)wid * 1024u;
    const int aoff = lds_byte(wr * 64 + fr, fq * 8), boff = lds_byte(wc * 32 + fr, fq * 8);
#define PG8_SA(b, h) (((b) * 2 + (h)) * HTB)
#define PG8_SB(b, h) ((4 + (b) * 2 + (h)) * HTB)
#define PG8_STAGE(bufoff, gbase, voff) do { _Pragma("unroll") for (int _i = 0; _i < 2; ++_i) \
        __builtin_amdgcn_global_load_lds((const unsigned*)((const char*)(gbase) + (voff)[_i]), (PG8_LAS unsigned*)(lds + (bufoff) + ldsw + _i * 8192), 16, 0, 0); } while (0)
#define PG8_LDA(dst, b, h) do { _Pragma("unroll") for (int m = 0; m < 4; ++m) _Pragma("unroll") for (int k = 0; k < 2; ++k) dst[m][k] = *(const PG8_LAS bf16x8*)(lds + PG8_SA(b, h) + aoff + m * 2048 + k * 1024); } while (0)
#define PG8_LDB(dst, b, h) do { _Pragma("unroll") for (int n = 0; n < 2; ++n) _Pragma("unroll") for (int k = 0; k < 2; ++k) dst[n][k] = *(const PG8_LAS bf16x8*)(lds + PG8_SB(b, h) + boff + n * 2048 + k * 1024); } while (0)
#define PG8_MMA(ai, bj, At, Bt) do { __builtin_amdgcn_s_setprio(1); _Pragma("unroll") for (int m = 0; m < 4; ++m) _Pragma("unroll") for (int n = 0; n < 2; ++n) _Pragma("unroll") for (int k = 0; k < 2; ++k) \
        acc[ai][bj][m][n] = __builtin_amdgcn_mfma_f32_16x16x32_bf16(Bt[n][k], At[m][k], acc[ai][bj][m][n], 0, 0, 0); __builtin_amdgcn_s_setprio(0); } while (0)
#define PG8_WAIT_V(n) asm volatile("s_waitcnt vmcnt(" #n ")" ::: "memory")
#define PG8_WAIT_L(n) asm volatile("s_waitcnt lgkmcnt(" #n ")" ::: "memory")
#define PG8_BAR __builtin_amdgcn_s_barrier()
#define PG8_SCHED __builtin_amdgcn_sched_barrier(0)
    Unit cur, nxt; int ui = 0;
    if (!S.next(0, cur)) return;
    f32x4 acc[2][2][4][2];
#pragma unroll
    for (int a = 0; a < 2; ++a)
#pragma unroll
        for (int b = 0; b < 2; ++b)
#pragma unroll
            for (int m = 0; m < 4; ++m)
#pragma unroll
                for (int n = 0; n < 2; ++n) acc[a][b][m][n] = (f32x4){0.f, 0.f, 0.f, 0.f};
    bf16x8 At[4][2], B0[2][2], B1[2][2];
    const char* cA = (const char*)g.A + (size_t)cur.pm * tstep; const char* cB = (const char*)g.Bt + (size_t)cur.pn * tstep;
    S.a_ready(cur);
    if constexpr (SP2) {
        PG8_STAGE(PG8_SB(0, 0), cB, voffB); PG8_STAGE(PG8_SB(0, 1), cB + hstep, voffB); PG8_STAGE(PG8_SA(0, 0), cA, voffA); PG8_STAGE(PG8_SA(0, 1), cA + hstep, voffA);
        if (wr == 1) PG8_BAR;
        PG8_WAIT_V(2); PG8_BAR;
        PG8_STAGE(PG8_SB(1, 0), cB + kstep, voffB); PG8_STAGE(PG8_SA(1, 0), cA + kstep, voffA); PG8_STAGE(PG8_SB(1, 1), cB + hstep + kstep, voffB);
        PG8_WAIT_V(6); PG8_BAR;
    } else {
        PG8_STAGE(PG8_SB(0, 0), cB, voffB); PG8_STAGE(PG8_SA(0, 0), cA, voffA); PG8_STAGE(PG8_SB(0, 1), cB + hstep, voffB); PG8_STAGE(PG8_SA(0, 1), cA + hstep, voffA);
        if (wr == 1) PG8_BAR;
        PG8_WAIT_V(4); PG8_BAR;
        PG8_STAGE(PG8_SB(1, 0), cB + kstep, voffB); PG8_STAGE(PG8_SA(1, 0), cA + kstep, voffA); PG8_STAGE(PG8_SB(1, 1), cB + hstep + kstep, voffB);
        PG8_WAIT_V(6); PG8_BAR;
    }
    for (;;) {
        const bool has_next = S.next(ui + 1, nxt);
        const char* nA = has_next ? (const char*)g.A + (size_t)nxt.pm * tstep : cA; const char* nB = has_next ? (const char*)g.Bt + (size_t)nxt.pn * tstep : cB;
        for (int t = 0; t < nt; t += 2) {
            const bool last = (t == nt - 2);
            const char* a1 = cA + (size_t)(t + 1) * kstep;
            const char* a2 = last ? nA : cA + (size_t)(t + 2) * kstep; const char* b2 = last ? nB : cB + (size_t)(t + 2) * kstep;
            const char* a3 = a2 + kstep; const char* b3 = b2 + kstep;
            if (last && has_next) S.a_ready(nxt);
            if constexpr (SP2) {
            PG8_LDB(B0, 0, 0); PG8_LDB(B1, 0, 1); PG8_SCHED; PG8_LDA(At, 0, 0); PG8_STAGE(PG8_SA(1, 1), a1 + hstep, voffA);
            PG8_WAIT_V(8); PG8_WAIT_L(0); PG8_BAR; PG8_MMA(0, 0, At, B0); PG8_MMA(0, 1, At, B1); PG8_BAR; PG8_SCHED;
            PG8_LDA(At, 0, 1); PG8_STAGE(PG8_SB(0, 0), b2, voffB); PG8_STAGE(PG8_SB(0, 1), b2 + hstep, voffB); PG8_STAGE(PG8_SA(0, 0), a2, voffA);
            PG8_WAIT_V(8); PG8_WAIT_L(0); PG8_BAR; PG8_MMA(1, 0, At, B0); PG8_MMA(1, 1, At, B1); PG8_BAR; PG8_SCHED;
            PG8_LDB(B0, 1, 0); PG8_LDB(B1, 1, 1); PG8_SCHED; PG8_LDA(At, 1, 0); PG8_STAGE(PG8_SA(0, 1), a2 + hstep, voffA);
            PG8_WAIT_V(8); PG8_WAIT_L(0); PG8_BAR; PG8_MMA(0, 0, At, B0); PG8_MMA(0, 1, At, B1); PG8_BAR; PG8_SCHED;
            PG8_LDA(At, 1, 1); PG8_STAGE(PG8_SB(1, 0), b3, voffB); PG8_STAGE(PG8_SB(1, 1), b3 + hstep, voffB); PG8_STAGE(PG8_SA(1, 0), a3, voffA);
            PG8_WAIT_V(8); PG8_WAIT_L(0); PG8_BAR; PG8_MMA(1, 0, At, B0); PG8_MMA(1, 1, At, B1); PG8_BAR; PG8_SCHED;
            } else {
            PG8_LDB(B0, 0, 0); PG8_SCHED; PG8_LDA(At, 0, 0); PG8_STAGE(PG8_SA(1, 1), a1 + hstep, voffA);
            PG8_WAIT_L(8); PG8_BAR; PG8_WAIT_L(0); PG8_MMA(0, 0, At, B0); PG8_BAR; PG8_SCHED;
            PG8_LDB(B1, 0, 1); PG8_STAGE(PG8_SB(0, 0), b2, voffB);
            PG8_BAR; PG8_WAIT_L(0); PG8_MMA(0, 1, At, B1); PG8_BAR;
            PG8_LDA(At, 0, 1); PG8_STAGE(PG8_SA(0, 0), a2, voffA);
            PG8_BAR; PG8_WAIT_L(0); PG8_MMA(1, 0, At, B0); PG8_BAR; PG8_SCHED;
            PG8_STAGE(PG8_SB(0, 1), b2 + hstep, voffB);
            PG8_WAIT_V(6); PG8_BAR; PG8_MMA(1, 1, At, B1); PG8_BAR;
            PG8_LDB(B0, 1, 0); PG8_SCHED; PG8_LDA(At, 1, 0); PG8_STAGE(PG8_SA(0, 1), a2 + hstep, voffA);
            PG8_WAIT_L(8); PG8_BAR; PG8_WAIT_L(0); PG8_MMA(0, 0, At, B0); PG8_BAR; PG8_SCHED;
            PG8_LDB(B1, 1, 1); PG8_STAGE(PG8_SB(1, 0), b3, voffB);
            PG8_BAR; PG8_WAIT_L(0); PG8_MMA(0, 1, At, B1); PG8_BAR;
            PG8_LDA(At, 1, 1); PG8_STAGE(PG8_SA(1, 0), a3, voffA);
            PG8_BAR; PG8_WAIT_L(0); PG8_MMA(1, 0, At, B0); PG8_BAR; PG8_SCHED;
            PG8_STAGE(PG8_SB(1, 1), b3 + hstep, voffB);
            PG8_WAIT_V(6); PG8_BAR; PG8_MMA(1, 1, At, B1); PG8_BAR;
            }
        }
        if constexpr (ALIGN_EPI) { if (wr == 0) PG8_BAR; }
        if constexpr (!Epi::AFTER_DRAIN) { E(acc, cur, wr, wc, fr, fq); S.done(cur); }
        if (!has_next) break;
#pragma unroll
        for (int a = 0; a < 2; ++a)
#pragma unroll
            for (int b = 0; b < 2; ++b)
#pragma unroll
                for (int m = 0; m < 4; ++m)
#pragma unroll
                    for (int n = 0; n < 2; ++n) acc[a][b][m][n] = (f32x4){0.f, 0.f, 0.f, 0.f};
        cur = nxt; cA = nA; cB = nB; ++ui;
        if constexpr (ALIGN_EPI) { if (wr == 1) PG8_BAR; }
    }
    PG8_WAIT_V(0);
    if constexpr (!ALIGN_EPI) { if (wr == 0) PG8_BAR; }
    PG8_BAR;
    if constexpr (Epi::AFTER_DRAIN) { E.fused(acc, cur, wr, wc, fr, fq, lds, wid, lane); S.done(cur); }
#undef PG8_SA
#undef PG8_SB
#undef PG8_STAGE
#undef PG8_LDA
#undef PG8_LDB
#undef PG8_MMA
#undef PG8_WAIT_V
#undef PG8_WAIT_L
#undef PG8_BAR
#undef PG8_SCHED
}
}
#define GAS __attribute__((address_space(1)))
#define LAS __attribute__((address_space(3)))
typedef unsigned short bf16;
typedef unsigned v4u __attribute__((ext_vector_type(4)));
typedef float f32x4 __attribute__((ext_vector_type(4)));
typedef short bf16x8 __attribute__((ext_vector_type(8)));
typedef GAS unsigned gu32;
typedef GAS unsigned long long gu64;
#define RLX_AGENT __ATOMIC_RELAXED, __HIP_MEMORY_SCOPE_AGENT
#define LDS_WAIT() asm volatile("s_waitcnt lgkmcnt(0)" ::: "memory")
#define VM_WAIT() asm volatile("s_waitcnt vmcnt(0)" ::: "memory")
__device__ __forceinline__ unsigned long long rt() { return __builtin_amdgcn_s_memrealtime(); }
__device__ __forceinline__ unsigned f2bf(float f) { unsigned u = __builtin_bit_cast(unsigned, f); return (u + 0x7fffu + ((u >> 16) & 1u)) >> 16; }
__device__ __forceinline__ unsigned pk2(float lo, float hi) { return f2bf(lo) | (f2bf(hi) << 16); }

#define XB_TMO      128
#define XB_XCNT(j)  (256  + 64 * (j))
#define XB_XSUB(j)  (1280 + 64 * (j))
#define XB_XGEN(j)  (2304 + 64 * (j))
#define XB_TOP      3328
#define XB_TOPGEN   3392
#define XCD_BAR_WORDS 3456
#define XB_SPIN_CAP (1u << 18)

__device__ __forceinline__ unsigned xb_ld(unsigned* p)              { return __hip_atomic_load(p, __ATOMIC_RELAXED, __HIP_MEMORY_SCOPE_AGENT); }
__device__ __forceinline__ unsigned xb_add(unsigned* p, unsigned v) { return __hip_atomic_fetch_add(p, v, __ATOMIC_RELAXED, __HIP_MEMORY_SCOPE_AGENT); }
__device__ __forceinline__ unsigned xb_xcc_id() { return (unsigned)__builtin_amdgcn_s_getreg((3 << 11) | 20) & 0xFu; }
#define XB_SPIN(cond, bar) do { unsigned _sp = 0; while (cond) { __builtin_amdgcn_s_sleep(1); \
    if ((++_sp & 255u) == 0u) { if (xb_ld(&(bar)[XB_TMO])) break; if (_sp > XB_SPIN_CAP) { atomicAdd(&(bar)[XB_TMO], 1u); break; } } } } while (0)

struct XcdBarrier {
    unsigned* bar; unsigned x;
    volatile LAS unsigned* st;
};

__device__ __forceinline__ XcdBarrier xcd_barrier_post(unsigned* bar, volatile LAS unsigned* st) {
    XcdBarrier b; b.bar = bar; b.x = xb_xcc_id(); b.st = st;
    if (threadIdx.x == 0) (void)xb_add(&bar[XB_XCNT(b.x)], 1u);
    return b;
}
__device__ __forceinline__ void xcd_barrier_complete(unsigned* bar, unsigned x, unsigned& nloc, unsigned& nx) {
    const unsigned G = gridDim.x * gridDim.y * gridDim.z;
    unsigned sum, cnt, mine, sp = 0u;
    for (;;) {
        sum = 0u; cnt = 0u; mine = 0u;
#pragma unroll
        for (unsigned j = 0; j < 16; ++j) { const unsigned c = xb_ld(&bar[XB_XCNT(j)]); sum += c; cnt += (c > 0u) ? 1u : 0u; mine = (j == x) ? c : mine; }
        if (sum == G) break;
        __builtin_amdgcn_s_sleep(1);
        if ((++sp & 255u) == 0u) { if (xb_ld(&bar[XB_TMO])) break; if (sp > XB_SPIN_CAP) { atomicAdd(&bar[XB_TMO], 1u); break; } }
    }
    nloc = mine > 0u ? mine : 1u; nx = cnt > 0u ? cnt : 1u;
}

__device__ __forceinline__ void xcd_barrier(const XcdBarrier& b) {
    asm volatile("s_waitcnt vmcnt(0)" ::: "memory");
    __syncthreads();
    if (threadIdx.x == 0) {
        unsigned* bar = b.bar;
        __builtin_amdgcn_s_waitcnt(0);
        unsigned nloc = b.st[0], nx = b.st[1];
        if (nloc == 0u) { xcd_barrier_complete(bar, b.x, nloc, nx); b.st[0] = nloc; b.st[1] = nx; }
        const unsigned old = xb_add(&bar[XB_XSUB(b.x)], 1u);
        const unsigned gen = old / nloc;
        if (old + 1u == (gen + 1u) * nloc) {
            __builtin_amdgcn_fence(__ATOMIC_RELEASE, "agent");
            asm volatile("s_waitcnt vmcnt(0)" ::: "memory");
            const unsigned og = xb_add(&bar[XB_TOP], 1u);
            const unsigned tg = og / nx;
            if (og + 1u == (tg + 1u) * nx) xb_add(&bar[XB_TOPGEN], 1u);
            else XB_SPIN(xb_ld(&bar[XB_TOPGEN]) == tg, bar);
            __builtin_amdgcn_fence(__ATOMIC_ACQUIRE, "agent");
            xb_add(&bar[XB_XGEN(b.x)], 1u);
            asm volatile("s_waitcnt vmcnt(0)" ::: "memory");
        } else {
            XB_SPIN(xb_ld(&bar[XB_XGEN(b.x)]) == gen, bar);
            __builtin_amdgcn_fence(__ATOMIC_ACQUIRE, "agent");
            asm volatile("s_waitcnt vmcnt(0)" ::: "memory");
        }
    }
    __syncthreads();
}
constexpr int NWAVES = 8;
constexpr int T = 32768, D = 1024, SEQ = 4096;
constexpr float EPS = 1e-6f;
constexpr float LAMBDA_INIT = 0.35550906759f;
constexpr size_t MiB = 1u << 20;
constexpr size_t WS_CTL = 0, CTL_ZERO_BYTES = 1 * MiB;
constexpr size_t WS_ROPE = 1 * MiB;
constexpr size_t WS_WIN = 4 * MiB;
constexpr size_t WS_WO0 = 11 * MiB, WS_WQ0 = 13 * MiB, WS_KEY0 = 17 * MiB, WS_WQKV = 18 * MiB, WS_WO1 = 24 * MiB, WS_WQ1 = 26 * MiB, WS_KEY1 = 30 * MiB;
constexpr size_t WS_SC = 31 * MiB;
constexpr size_t WS_U0 = 32 * MiB, WS_V0T = 48 * MiB, WS_U1 = 64 * MiB, WS_V1T = 80 * MiB;
constexpr size_t WS_B0 = 96 * MiB;
constexpr size_t WS_R1 = 160 * MiB, WS_R2 = 224 * MiB, WS_R3 = 288 * MiB, WS_R4 = 352 * MiB, WS_R5 = 416 * MiB, WS_GATES = 480 * MiB;
constexpr size_t WS_END = 484 * MiB;
constexpr int CW_BAR = 4096;
constexpr int LDS_BYTES = 147456, MISC_OFF = LDS_BYTES - 128;

typedef float f32x16 __attribute__((ext_vector_type(16)));
typedef unsigned u32x2 __attribute__((ext_vector_type(2)));
typedef __bf16 bf16x2_t __attribute__((ext_vector_type(2)));
__device__ __forceinline__ float bf_lo(unsigned w) { return __uint_as_float(w << 16); }
__device__ __forceinline__ float bf_hi(unsigned w) { return __uint_as_float(w & 0xffff0000u); }
__device__ __forceinline__ float dot2(unsigned a, unsigned b, float c) { return __builtin_amdgcn_fdot2_f32_bf16(__builtin_bit_cast(bf16x2_t, a), __builtin_bit_cast(bf16x2_t, b), c, false); }
__device__ __forceinline__ float wave_sum(float v) {
#pragma unroll
    for (int o = 1; o < 64; o <<= 1) v += __shfl_xor(v, o);
    return v;
}
__device__ __forceinline__ f32x4 mfma16(bf16x8 a, bf16x8 b, f32x4 c) { return __builtin_amdgcn_mfma_f32_16x16x32_bf16(a, b, c, 0, 0, 0); }
__device__ __forceinline__ f32x16 mfma32(bf16x8 a, bf16x8 b, f32x16 c) { return __builtin_amdgcn_mfma_f32_32x32x16_bf16(a, b, c, 0, 0, 0); }
__device__ __forceinline__ u32x2 pack4(float a, float b, float c, float d) { u32x2 r; r.x = pk2(a, b); r.y = pk2(c, d); return r; }

__device__ __forceinline__ void p0_transpose_item(const float* W, int K, int N, bf16* WT, LAS float* scr, int item, int lane) {
    const int nblk = N / 32, kb = item / nblk, nb = item % nblk, k0 = 64 * kb, n0 = 32 * nb;
#pragma unroll 8
    for (int i = 0; i < 32; ++i) { const int kk = 2 * i + (lane >> 5); scr[kk * 33 + (lane & 31)] = W[(size_t)(k0 + kk) * N + n0 + (lane & 31)]; }
    LDS_WAIT(); asm volatile("" ::: "memory");
    const int c = lane & 7;
#pragma unroll
    for (int j = 0; j < 4; ++j) { const int n = (lane >> 3) + 8 * j; const LAS float* s = scr + (8 * c) * 33 + n;
        v4u o; o.x = pk2(s[0 * 33], s[1 * 33]); o.y = pk2(s[2 * 33], s[3 * 33]); o.z = pk2(s[4 * 33], s[5 * 33]); o.w = pk2(s[6 * 33], s[7 * 33]);
        *(v4u*)(WT + (size_t)(n0 + n) * K + k0 + 8 * c) = o; }
    LDS_WAIT(); asm volatile("" ::: "memory");
}
__device__ __forceinline__ void cvt_range(const float* src, bf16* dst, size_t n, size_t gtid, size_t gthreads) {
    for (size_t i = gtid * 8; i < n; i += gthreads * 8) {
        const f32x4 a = *(const f32x4*)(src + i), b = *(const f32x4*)(src + i + 4);
        v4u o; o.x = pk2(a.x, a.y); o.y = pk2(a.z, a.w); o.z = pk2(b.x, b.y); o.w = pk2(b.z, b.w);
        *(v4u*)(dst + i) = o; }
}
__device__ __forceinline__ void rms_row_to_bf16(const float* xrow, const float* g, bf16* orow, int lane) {
    const f32x4* xr = (const f32x4*)xrow + lane; const f32x4* gr = (const f32x4*)g + lane;
    f32x4 v[4]; float s = 0.f;
#pragma unroll
    for (int j = 0; j < 4; ++j) { v[j] = xr[64 * j]; s += (v[j].x * v[j].x + v[j].y * v[j].y) + (v[j].z * v[j].z + v[j].w * v[j].w); }
    const float rstd = rsqrtf(wave_sum(s) * (1.f / 1024.f) + EPS);
    unsigned long long* o8 = (unsigned long long*)orow + lane;
#pragma unroll
    for (int j = 0; j < 4; ++j) { const f32x4 gg = gr[64 * j];
        o8[64 * j] = (unsigned long long)pk2(v[j].x * rstd * gg.x, v[j].y * rstd * gg.y) | ((unsigned long long)pk2(v[j].z * rstd * gg.z, v[j].w * rstd * gg.w) << 32); }
}
__device__ __forceinline__ void rms_pass(const float* X, const float* g, bf16* XN, int gw, int NGW, int lane) {
    for (int m = gw; m < T; m += NGW) rms_row_to_bf16(X + (size_t)m * D, g, XN + (size_t)m * D, lane);
}

__device__ __forceinline__ float logsigmoid_f(float f) { return fminf(f, 0.f) - log1pf(__expf(-fabsf(f))); }
#define ML_LOAD(ci_) do { const size_t r_ = rowbase + (size_t)(ci_) * 64 + lane; \
    rq = *(const v4u*)(Q0 + r_ * 64 + 8 * w); rk = *(const v4u*)(K0 + r_ * 64 + 8 * w); rv0 = *(const v4u*)(V0 + r_ * 128 + 16 * w); rv1 = *(const v4u*)(V0 + r_ * 128 + 16 * w + 8); \
    const size_t gm_ = ((size_t)b * 4096 + (size_t)(ci_) * 64 + jr) * 32; rli = GATES[gm_ + (dir ? 16 : 0) + h]; rf = GATES[gm_ + (dir ? 24 : 8) + h]; } while (0)
__device__ __forceinline__ void mlstm_phase(LAS unsigned char* lds, const bf16* Q0, const bf16* K0, const bf16* V0, const float* GATES, bf16* HF, bf16* HB) {
    const int bx = blockIdx.x;
    if ((bx >> 3) & 1) return;
    const int seq = (bx >> 4) * 8 + (bx & 7);
    const int dir = seq & 1, bh = seq >> 1, b = bh >> 3, h = bh & 7;
    int tid_ = threadIdx.x; asm volatile("" : "+v"(tid_)); const int tid = tid_, lane = tid & 63, w = __builtin_amdgcn_readfirstlane(tid >> 6), fr = lane & 15, fq = lane >> 4;
    LAS bf16* Qs = (LAS bf16*)(lds); LAS bf16* Ks = (LAS bf16*)(lds + 9216); LAS bf16* Kwt = (LAS bf16*)(lds + 18432); LAS bf16* Ps = (LAS bf16*)(lds + 27648);
    LAS bf16* Vt = (LAS bf16*)(lds + 36864 + w * 2304); LAS bf16* Cs = (LAS bf16*)(lds + 55296 + w * 2304); LAS bf16* nb = (LAS bf16*)(lds + 73728 + w * 128);
    LAS float* gc = (LAS float*)(lds + 74752 + w * 1280); LAS float* gM = gc + 64; LAS float* gI = gc + 128; LAS float* gE = gc + 192; LAS float* gW = gc + 256;
    for (int i = lane; i < 2304 / 4; i += 64) ((LAS unsigned*)Cs)[i] = 0u;
    if (lane < 32) ((LAS unsigned*)nb)[lane] = 0u;
    f32x4 Cacc[4], Nacc[4];
#pragma unroll
    for (int i = 0; i < 4; ++i) { Cacc[i] = (f32x4){0.f, 0.f, 0.f, 0.f}; Nacc[i] = (f32x4){0.f, 0.f, 0.f, 0.f}; }
    float m = -1e30f;
    bf16* Hout = dir ? HB : HF;
    const size_t rowbase = (size_t)bh * 4096;
    const int jr = dir ? 63 - lane : lane;
    v4u rq, rk, rv0, rv1; float rli, rf;
    ML_LOAD(dir ? 63 : 0);
    const bf16x8 ones = (bf16x8){0x3F80, 0x3F80, 0x3F80, 0x3F80, 0x3F80, 0x3F80, 0x3F80, 0x3F80};
    const f32x4 z4 = (f32x4){0.f, 0.f, 0.f, 0.f};
#pragma unroll 1
    for (int step = 0; step < 64; ++step) {
        const int ci = dir ? 63 - step : step;
        const float lf = logsigmoid_f(rf);
        float bcs = lf;
#pragma unroll
        for (int d = 1; d < 64; d <<= 1) { const float t = __shfl_up(bcs, d); if (lane >= d) bcs += t; }
        const float c = rli - bcs;
        float pm = c;
#pragma unroll
        for (int d = 1; d < 64; d <<= 1) { const float t = __shfl_up(pm, d); if (lane >= d) pm = fmaxf(pm, t); }
        const float M = fmaxf(m, pm);
        const float bL = __shfl(bcs, 63), Mlast = __shfl(M, 63);
        gc[jr] = c; gM[jr] = M; gI[jr] = __expf(m - M); gE[jr] = __expf(-(bcs + M)); gW[jr] = __expf(c - Mlast);
        const float sp = __expf(m - Mlast), m_new = bL + Mlast;
        const float wr_ = gW[lane];
        *(LAS v4u*)(Qs + lane * 72 + 8 * w) = rq; *(LAS v4u*)(Ks + lane * 72 + 8 * w) = rk;
#pragma unroll
        for (int i = 0; i < 4; ++i) { const unsigned kw = rk[i]; Kwt[(8 * w + 2 * i) * 72 + lane] = (bf16)f2bf(bf_lo(kw) * wr_); Kwt[(8 * w + 2 * i + 1) * 72 + lane] = (bf16)f2bf(bf_hi(kw) * wr_); }
#pragma unroll
        for (int i = 0; i < 4; ++i) { Vt[(2 * i) * 72 + lane] = (bf16)(rv0[i] & 0xffffu); Vt[(2 * i + 1) * 72 + lane] = (bf16)(rv0[i] >> 16);
                                      Vt[(8 + 2 * i) * 72 + lane] = (bf16)(rv1[i] & 0xffffu); Vt[(9 + 2 * i) * 72 + lane] = (bf16)(rv1[i] >> 16); }
        __syncthreads();
        if (step < 63) ML_LOAD(dir ? 62 - step : step + 1);
        {
            const int st = w >> 1;
            const bf16x8 a0 = *(const LAS bf16x8*)(Ks + (16 * st + fr) * 72 + 8 * fq), a1 = *(const LAS bf16x8*)(Ks + (16 * st + fr) * 72 + 32 + 8 * fq);
#pragma unroll
            for (int u = 0; u < 2; ++u) { const int tt = 2 * (w & 1) + u;
                const bf16x8 b0 = *(const LAS bf16x8*)(Qs + (16 * tt + fr) * 72 + 8 * fq), b1 = *(const LAS bf16x8*)(Qs + (16 * tt + fr) * 72 + 32 + 8 * fq);
                f32x4 acc = mfma16(a0, b0, z4); acc = mfma16(a1, b1, acc);
                const int t = 16 * tt + fr; const float Mt = gM[t]; float pv[4];
#pragma unroll
                for (int i = 0; i < 4; ++i) { const int s = 16 * st + 4 * fq + i; const bool valid = dir ? (s >= t) : (s <= t); const float e = __expf(gc[s] - Mt); pv[i] = valid ? acc[i] * e : 0.f; }
                *(LAS u32x2*)(Ps + t * 72 + 16 * st + 4 * fq) = pack4(pv[0], pv[1], pv[2], pv[3]); }
        }
        __syncthreads();
        const bf16x8 aV0 = *(const LAS bf16x8*)(Vt + fr * 72 + 8 * fq), aV1 = *(const LAS bf16x8*)(Vt + fr * 72 + 32 + 8 * fq);
        {
            const bf16x8 aC0 = *(const LAS bf16x8*)(Cs + fr * 72 + 8 * fq), aC1 = *(const LAS bf16x8*)(Cs + fr * 72 + 32 + 8 * fq);
            const bf16x8 aN0 = *(const LAS bf16x8*)(nb + 8 * fq), aN1 = *(const LAS bf16x8*)(nb + 32 + 8 * fq);
#pragma unroll
            for (int tt = 0; tt < 4; ++tt) {
                const bf16x8 bP0 = *(const LAS bf16x8*)(Ps + (16 * tt + fr) * 72 + 8 * fq), bP1 = *(const LAS bf16x8*)(Ps + (16 * tt + fr) * 72 + 32 + 8 * fq);
                const bf16x8 bQ0 = *(const LAS bf16x8*)(Qs + (16 * tt + fr) * 72 + 8 * fq), bQ1 = *(const LAS bf16x8*)(Qs + (16 * tt + fr) * 72 + 32 + 8 * fq);
                f32x4 acc1 = mfma16(aV0, bP0, z4); acc1 = mfma16(aV1, bP1, acc1);
                f32x4 acc2 = mfma16(aC0, bQ0, z4); acc2 = mfma16(aC1, bQ1, acc2);
                f32x4 d1 = mfma16(ones, bP0, z4); d1 = mfma16(ones, bP1, d1);
                f32x4 d2 = mfma16(aN0, bQ0, z4); d2 = mfma16(aN1, bQ1, d2);
                const int t = 16 * tt + fr; const float it = gI[t], en = gE[t];
                const float den = d1[0] + it * d2[0]; const float inv = 1.f / fmaxf(fabsf(den), en);
                *(u32x2*)(Hout + ((size_t)b * 4096 + (size_t)ci * 64 + t) * 1024 + h * 128 + 16 * w + 4 * fq) =
                    pack4((acc1[0] + it * acc2[0]) * inv, (acc1[1] + it * acc2[1]) * inv, (acc1[2] + it * acc2[2]) * inv, (acc1[3] + it * acc2[3]) * inv);
            }
        }
#pragma unroll
        for (int dt = 0; dt < 4; ++dt) { Cacc[dt] = Cacc[dt] * sp; Nacc[dt] = Nacc[dt] * sp;
            const bf16x8 aK0 = *(const LAS bf16x8*)(Kwt + (16 * dt + fr) * 72 + 8 * fq), aK1 = *(const LAS bf16x8*)(Kwt + (16 * dt + fr) * 72 + 32 + 8 * fq);
            Cacc[dt] = mfma16(aK0, aV0, Cacc[dt]); Cacc[dt] = mfma16(aK1, aV1, Cacc[dt]);
            Nacc[dt] = mfma16(aK0, ones, Nacc[dt]); Nacc[dt] = mfma16(aK1, ones, Nacc[dt]); }
#pragma unroll
        for (int dt = 0; dt < 4; ++dt) { *(LAS u32x2*)(Cs + fr * 72 + 16 * dt + 4 * fq) = pack4(Cacc[dt][0], Cacc[dt][1], Cacc[dt][2], Cacc[dt][3]);
                                         *(LAS u32x2*)(nb + 16 * dt + 4 * fq) = pack4(Nacc[dt][0], Nacc[dt][1], Nacc[dt][2], Nacc[dt][3]); }
        m = m_new;
        __syncthreads();
    }
}
#undef ML_LOAD

__device__ __forceinline__ void hs_pass(const bf16* HF, const bf16* HB, const bf16* OG, const float* hg, bf16* HS, int gw, int NGW, int lane) {
    for (int m = gw; m < T; m += NGW) {
        const size_t off = (size_t)m * 1024 + 16 * lane;
        const v4u f0 = *(const v4u*)(HF + off), f1 = *(const v4u*)(HF + off + 8), b0 = *(const v4u*)(HB + off), b1 = *(const v4u*)(HB + off + 8), o0 = *(const v4u*)(OG + off), o1 = *(const v4u*)(OG + off + 8);
        float x[16], og[16];
#pragma unroll
        for (int i = 0; i < 4; ++i) { x[2 * i] = bf_lo(f0[i]) + bf_lo(b0[i]); x[2 * i + 1] = bf_hi(f0[i]) + bf_hi(b0[i]); x[8 + 2 * i] = bf_lo(f1[i]) + bf_lo(b1[i]); x[9 + 2 * i] = bf_hi(f1[i]) + bf_hi(b1[i]);
                                      og[2 * i] = bf_lo(o0[i]); og[2 * i + 1] = bf_hi(o0[i]); og[8 + 2 * i] = bf_lo(o1[i]); og[9 + 2 * i] = bf_hi(o1[i]); }
        float ss = 0.f;
#pragma unroll
        for (int i = 0; i < 16; ++i) ss += x[i] * x[i];
        ss += __shfl_xor(ss, 1); ss += __shfl_xor(ss, 2); ss += __shfl_xor(ss, 4);
        const float rstd = rsqrtf(ss * (1.f / 128.f) + EPS);
        float y[16];
#pragma unroll
        for (int i = 0; i < 16; ++i) y[i] = x[i] * rstd * hg[16 * lane + i] * (1.f / (1.f + __expf(-og[i])));
        v4u w0, w1;
#pragma unroll
        for (int i = 0; i < 4; ++i) { w0[i] = pk2(y[2 * i], y[2 * i + 1]); w1[i] = pk2(y[8 + 2 * i], y[9 + 2 * i]); }
        *(v4u*)(HS + off) = w0; *(v4u*)(HS + off + 8) = w1;
    }
}

#define TK_INSERT(v, x) do { float c_ = (x); _Pragma("unroll") for (int j_ = 0; j_ < 16; ++j_) { const float h_ = fmaxf(v[j_], c_); c_ = fminf(v[j_], c_); v[j_] = h_; } } while (0)
__device__ __forceinline__ void peer_topk_phase(int vcu, const bf16* PQ, const bf16* KEYS, int* EXPERTS, float* GATESP) {
    int tid_ = threadIdx.x; asm volatile("" : "+v"(tid_)); const int tid = tid_, lane = tid & 63, w = __builtin_amdgcn_readfirstlane(tid >> 6), r32 = lane & 31, hi = lane >> 5;
    const int t = vcu * 128 + (w & 3) * 32 + r32, hg = w >> 2;
    const float NINF = -INFINITY;
#pragma unroll 1
    for (int hh = 0; hh < 4; ++hh) {
        const int head = hg * 4 + hh;
        float L0[16], L1[16];
#pragma unroll
        for (int j = 0; j < 16; ++j) { L0[j] = 0.f; L1[j] = 0.f; }
#pragma unroll 1
        for (int p = 0; p < 2; ++p) {
            const int hp = head * 2 + p;
            bf16x8 bq[8];
#pragma unroll
            for (int ks = 0; ks < 8; ++ks) bq[ks] = *(const bf16x8*)(PQ + (size_t)t * 2048 + head * 256 + p * 128 + ks * 16 + 8 * hi);
            f32x16 acc[4];
#pragma unroll
            for (int nt = 0; nt < 4; ++nt) {
#pragma unroll
                for (int r = 0; r < 16; ++r) acc[nt][r] = 0.f;
#pragma unroll
                for (int ks = 0; ks < 8; ++ks) { const bf16x8 a = *(const bf16x8*)(KEYS + ((size_t)(hp * 128 + nt * 32 + r32)) * 128 + ks * 16 + 8 * hi); acc[nt] = mfma32(a, bq[ks], acc[nt]); }
            }
            float v[16];
#pragma unroll
            for (int j = 0; j < 16; ++j) v[j] = NINF;
#pragma unroll
            for (int nt = 0; nt < 4; ++nt)
#pragma unroll
                for (int r = 0; r < 16; ++r) { const int n = nt * 32 + (r & 3) + 8 * (r >> 2) + 4 * hi;
                    const float x = __uint_as_float((__float_as_uint(acc[nt][r]) & ~0x7Fu) | (unsigned)(127 - n)); TK_INSERT(v, x); }
            float wv[16];
#pragma unroll
            for (int j = 0; j < 16; ++j) wv[j] = __shfl_xor(v[j], 32);
#pragma unroll
            for (int j = 0; j < 16; ++j) TK_INSERT(v, wv[j]);
            if (p == 0) {
#pragma unroll
                for (int j = 0; j < 16; ++j) L0[j] = v[j];
            } else {
#pragma unroll
                for (int j = 0; j < 16; ++j) L1[j] = v[j];
            }
        }
        float tv[16];
#pragma unroll
        for (int j = 0; j < 16; ++j) tv[j] = NINF;
        unsigned IA[4] = {0u, 0u, 0u, 0u}, IB[4] = {0u, 0u, 0u, 0u};
#pragma unroll
        for (int i = 0; i < 16; ++i) { IA[i >> 2] |= (127u - (__float_as_uint(L0[i]) & 0x7Fu)) << (8 * (i & 3)); IB[i >> 2] |= (127u - (__float_as_uint(L1[i]) & 0x7Fu)) << (8 * (i & 3)); }
#pragma unroll
        for (int i = 0; i < 16; ++i) {
            const float va = __uint_as_float(__float_as_uint(L0[i]) & ~0x7Fu);
#pragma unroll
            for (int j = 0; j < 16; ++j) if ((i + 1) * (j + 1) <= 16) {
                const float vb = __uint_as_float(__float_as_uint(L1[j]) & ~0x7Fu);
                const float key = __uint_as_float((__float_as_uint(va + vb) & ~0xFFu) | (unsigned)(255 - (i * 16 + j)));
                TK_INSERT(tv, key);
            }
        }
        int ti[16];
#pragma unroll
        for (int j = 0; j < 16; ++j) { const unsigned kb = __float_as_uint(tv[j]); const unsigned flat = 255u - (kb & 0xFFu); const unsigned fi = flat >> 4, fj = flat & 15u;
            const unsigned ra = (fi < 8u) ? ((fi < 4u) ? IA[0] : IA[1]) : ((fi < 12u) ? IA[2] : IA[3]);
            const unsigned rb = (fj < 8u) ? ((fj < 4u) ? IB[0] : IB[1]) : ((fj < 12u) ? IB[2] : IB[3]);
            ti[j] = (int)(((ra >> (8u * (fi & 3u))) & 0xFFu) * 128u + ((rb >> (8u * (fj & 3u))) & 0xFFu));
            tv[j] = __uint_as_float(kb & ~0xFFu); }
        float e[16], sum = 0.f;
#pragma unroll
        for (int j = 0; j < 16; ++j) { e[j] = __expf(tv[j] - tv[0]); sum += e[j]; }
        const float inv = 1.f / sum;
        if (hi == 0) { int* ep = EXPERTS + (size_t)t * 128 + head * 16;
#pragma unroll
            for (int j = 0; j < 4; ++j) *(v4u*)(ep + 4 * j) = (v4u){(unsigned)ti[4 * j], (unsigned)ti[4 * j + 1], (unsigned)ti[4 * j + 2], (unsigned)ti[4 * j + 3]}; }
        else { float* gp = GATESP + (size_t)t * 128 + head * 16;
#pragma unroll
            for (int j = 0; j < 4; ++j) *(f32x4*)(gp + 4 * j) = (f32x4){e[4 * j] * inv, e[4 * j + 1] * inv, e[4 * j + 2] * inv, e[4 * j + 3] * inv}; }
    }
}

__device__ __forceinline__ float cvt_ub0(unsigned x) { float r; asm("v_cvt_f32_ubyte0 %0, %1" : "=v"(r) : "v"(x)); return r; }
__device__ __forceinline__ float cvt_ub1(unsigned x) { float r; asm("v_cvt_f32_ubyte1 %0, %1" : "=v"(r) : "v"(x)); return r; }
__device__ __forceinline__ float cvt_ub2(unsigned x) { float r; asm("v_cvt_f32_ubyte2 %0, %1" : "=v"(r) : "v"(x)); return r; }
__device__ __forceinline__ float cvt_ub3(unsigned x) { float r; asm("v_cvt_f32_ubyte3 %0, %1" : "=v"(r) : "v"(x)); return r; }
__device__ __forceinline__ void quant_rows(const float* src, unsigned char* dst, float* scale, int nrows, int offs, int gw, int NGW, int lane) {
    for (int r = gw; r < nrows; r += NGW) {
        const f32x4* sp = (const f32x4*)(src + (size_t)r * 1024) + 4 * lane;
        f32x4 v[4]; float am = 0.f;
#pragma unroll
        for (int j = 0; j < 4; ++j) { v[j] = sp[j]; am = fmaxf(am, fmaxf(fmaxf(fabsf(v[j].x), fabsf(v[j].y)), fmaxf(fabsf(v[j].z), fabsf(v[j].w)))); }
#pragma unroll
        for (int o = 1; o < 64; o <<= 1) am = fmaxf(am, __shfl_xor(am, o));
        const float inv = am > 0.f ? 127.f / am : 0.f;
        v4u w;
#pragma unroll
        for (int j = 0; j < 4; ++j) { const int q0 = (int)rintf(v[j].x * inv) + offs, q1 = (int)rintf(v[j].y * inv) + offs, q2 = (int)rintf(v[j].z * inv) + offs, q3 = (int)rintf(v[j].w * inv) + offs;
            w[j] = (unsigned)(q0 & 0xff) | ((unsigned)(q1 & 0xff) << 8) | ((unsigned)(q2 & 0xff) << 16) | ((unsigned)(q3 & 0xff) << 24); }
        *(v4u*)(dst + (size_t)r * 1024 + 16 * lane) = w;
        if (lane == 0) scale[r] = am * (1.f / 127.f);
    }
}

#define RED_STEP(N, S) do { const bool up_ = (lane & (S)) != 0; _Pragma("unroll") for (int j_ = 0; j_ < (N); ++j_) { const int a_ = p[j_], b_ = p[j_ + (N)]; const int send_ = up_ ? a_ : b_, keep_ = up_ ? b_ : a_; p[j_] = keep_ + __shfl_xor(send_, (S)); } } while (0)
#define G_SB() __builtin_amdgcn_sched_barrier(0)
#define G_LOAD(buf, tab, jb) do { _Pragma("unroll") for (int jj_ = 0; jj_ < 8; ++jj_) { const int e_ = __builtin_amdgcn_readlane(ev, (jb) + jj_); buf[jj_] = __builtin_amdgcn_raw_buffer_load_b128(rs_##tab, (int)voff, e_ << 10, 0); } } while (0)
#define U_COMP(buf, jb) do { _Pragma("unroll") for (int jj_ = 0; jj_ < 8; ++jj_) { int d_ = __builtin_amdgcn_sdot4((int)buf[jj_].x, hq[0], 0, false); d_ = __builtin_amdgcn_sdot4((int)buf[jj_].y, hq[1], d_, false); \
    d_ = __builtin_amdgcn_sdot4((int)buf[jj_].z, hq[2], d_, false); d_ = __builtin_amdgcn_sdot4((int)buf[jj_].w, hq[3], d_, false); p[(jb) + jj_] = d_; } } while (0)
#define RED16(dst) do { RED_STEP(8, 8); RED_STEP(4, 4); RED_STEP(2, 2); RED_STEP(1, 1); int s_ = p[0]; s_ += __shfl_xor(s_, 16); s_ += __shfl_xor(s_, 32); dst = s_; } while (0)
#define V_DW(o0, o1, o2, o3, wd, cs) do { float t0_, t1_, t2_, t3_; asm volatile("v_cvt_f32_ubyte0 %4, %8\n\tv_cvt_f32_ubyte1 %5, %8\n\tv_cvt_f32_ubyte2 %6, %8\n\tv_cvt_f32_ubyte3 %7, %8\n\tv_fmac_f32 %0, %9, %4\n\tv_fmac_f32 %1, %9, %5\n\tv_fmac_f32 %2, %9, %6\n\tv_fmac_f32 %3, %9, %7" \
    : "+v"(o0), "+v"(o1), "+v"(o2), "+v"(o3), "=&v"(t0_), "=&v"(t1_), "=&v"(t2_), "=&v"(t3_) : "v"(wd), "s"(cs)); } while (0)
#define V_COMP(buf, jb) do { _Pragma("unroll") for (int jj_ = 0; jj_ < 8; ++jj_) { const float c_ = __uint_as_float(__builtin_amdgcn_readlane(__float_as_uint(coef), (jb) + jj_)); \
    V_DW(o[0], o[1], o[2], o[3], buf[jj_].x, c_); V_DW(o[4], o[5], o[6], o[7], buf[jj_].y, c_); V_DW(o[8], o[9], o[10], o[11], buf[jj_].z, c_); V_DW(o[12], o[13], o[14], o[15], buf[jj_].w, c_); } } while (0)
template <bool NEXT_NORM>
__device__ __forceinline__ void peer_gather_phase(bool dry, int vcu, const bf16* HN, const int* EXPERTS, const float* GATESP, const unsigned char* U, const float* SU, const unsigned char* Vtab, const float* SV,
                                                  float* X, const float* gnext, bf16* XN) {
    int tid_ = threadIdx.x; asm volatile("" : "+v"(tid_)); const int tid = tid_, lane = tid & 63, w = __builtin_amdgcn_readfirstlane(tid >> 6);
    const __amdgpu_buffer_rsrc_t rs_U = __builtin_amdgcn_make_buffer_rsrc((void*)U, (short)0, 16384 * 1024, 0x00020000), rs_Vtab = __builtin_amdgcn_make_buffer_rsrc((void*)Vtab, (short)0, 16384 * 1024, 0x00020000);
    const unsigned voff = (unsigned)lane * 16u;
#pragma unroll 1
    for (int i = 0; i < 16; ++i) {
        const int t = vcu * 128 + w * 16 + i;
        const v4u h0 = *(const v4u*)(HN + (size_t)t * 1024 + 16 * lane), h1 = *(const v4u*)(HN + (size_t)t * 1024 + 16 * lane + 8);
        float hf[16]; float am = 0.f;
#pragma unroll
        for (int k = 0; k < 4; ++k) { hf[2 * k] = bf_lo(h0[k]); hf[2 * k + 1] = bf_hi(h0[k]); hf[8 + 2 * k] = bf_lo(h1[k]); hf[9 + 2 * k] = bf_hi(h1[k]); }
#pragma unroll
        for (int k = 0; k < 16; ++k) am = fmaxf(am, fabsf(hf[k]));
#pragma unroll
        for (int o = 1; o < 64; o <<= 1) am = fmaxf(am, __shfl_xor(am, o));
        const float hinv = am > 0.f ? 127.f / am : 0.f, sh = am * (1.f / 127.f);
        int hq[4];
#pragma unroll
        for (int k = 0; k < 4; ++k) hq[k] = (int)(((unsigned)((int)rintf(hf[4 * k] * hinv) & 0xff)) | ((unsigned)((int)rintf(hf[4 * k + 1] * hinv) & 0xff) << 8) | ((unsigned)((int)rintf(hf[4 * k + 2] * hinv) & 0xff) << 16) | ((unsigned)((int)rintf(hf[4 * k + 3] * hinv) & 0xff) << 24));
        float o[16];
#pragma unroll
        for (int k = 0; k < 16; ++k) o[k] = 0.f;
        float csum = 0.f;
#pragma unroll 1
        for (int half = 0; half < 2; ++half) {
            const int ev = EXPERTS[(size_t)t * 128 + half * 64 + lane]; const float gv = GATESP[(size_t)t * 128 + half * 64 + lane];
            const float su = SU[ev], sv = SV[ev];
            int p[16], r0, r1, r2, r3;
            v4u A[8], B[8], C[8];
            G_LOAD(A, U, 0); G_LOAD(B, U, 8); G_SB();
            G_LOAD(C, U, 16); G_SB(); U_COMP(A, 0); G_SB();
            G_LOAD(A, U, 24); G_SB(); U_COMP(B, 8); RED16(r0); G_SB();
            G_LOAD(B, U, 32); G_SB(); U_COMP(C, 0); G_SB();
            G_LOAD(C, U, 40); G_SB(); U_COMP(A, 8); RED16(r1); G_SB();
            G_LOAD(A, U, 48); G_SB(); U_COMP(B, 0); G_SB();
            G_LOAD(B, U, 56); G_SB(); U_COMP(C, 8); RED16(r2); G_SB();
            G_LOAD(C, Vtab, 0); G_SB(); U_COMP(A, 0); G_SB();
            G_LOAD(A, Vtab, 8); G_SB(); U_COMP(B, 8); RED16(r3); G_SB();
            const int lg = lane >> 4; const int dsel = lg == 0 ? r0 : (lg == 1 ? r1 : (lg == 2 ? r2 : r3));
            const float act = (float)dsel * (sh * su);
            const float coef = gv * (0.5f * act * (1.f + erff(act * 0.70710678118f))) * sv;
            csum += coef;
            G_SB();
            G_LOAD(B, Vtab, 16); G_SB(); V_COMP(C, 0); G_SB();
            G_LOAD(C, Vtab, 24); G_SB(); V_COMP(A, 8); G_SB();
            G_LOAD(A, Vtab, 32); G_SB(); V_COMP(B, 16); G_SB();
            G_LOAD(B, Vtab, 40); G_SB(); V_COMP(C, 24); G_SB();
            G_LOAD(C, Vtab, 48); G_SB(); V_COMP(A, 32); G_SB();
            G_LOAD(A, Vtab, 56); G_SB(); V_COMP(B, 40); G_SB();
            V_COMP(C, 48); G_SB(); V_COMP(A, 56); G_SB();
        }
        const float corr = 128.f * wave_sum(csum);
        float* xr = X + (size_t)t * 1024 + 16 * lane;
        f32x4 xv[4];
#pragma unroll
        for (int k = 0; k < 4; ++k) { xv[k] = *(const f32x4*)(xr + 4 * k); xv[k] += (f32x4){o[4 * k] - corr, o[4 * k + 1] - corr, o[4 * k + 2] - corr, o[4 * k + 3] - corr}; }
        if (!dry) {
#pragma unroll
            for (int k = 0; k < 4; ++k) *(f32x4*)(xr + 4 * k) = xv[k]; }
        if (NEXT_NORM && !dry) {
            float ss = 0.f;
#pragma unroll
            for (int k = 0; k < 4; ++k) ss += (xv[k].x * xv[k].x + xv[k].y * xv[k].y) + (xv[k].z * xv[k].z + xv[k].w * xv[k].w);
            const float rstd = rsqrtf(wave_sum(ss) * (1.f / 1024.f) + EPS);
            v4u wa, wb;
#pragma unroll
            for (int k = 0; k < 4; ++k) { const f32x4 g = *(const f32x4*)(gnext + 16 * lane + 4 * k); const unsigned lo = pk2(xv[k].x * rstd * g.x, xv[k].y * rstd * g.y), hi2 = pk2(xv[k].z * rstd * g.z, xv[k].w * rstd * g.w);
                if (k < 2) { wa[2 * k] = lo; wa[2 * k + 1] = hi2; } else { wb[2 * (k - 2)] = lo; wb[2 * (k - 2) + 1] = hi2; } }
            *(v4u*)(XN + (size_t)t * 1024 + 16 * lane) = wa; *(v4u*)(XN + (size_t)t * 1024 + 16 * lane + 8) = wb;
        }
    }
}

__device__ __forceinline__ void qknorm_rope_pass(bf16* Q1, bf16* K1, const float* qg, const float* kg, const float* rope, size_t gtid, size_t gthreads) {
    const size_t NROWS = (size_t)2 * 64 * 2 * 4096;
    for (size_t id = gtid; id < NROWS * 8; id += gthreads) {
        const size_t rowg = id >> 3; const int part = (int)(id & 7);
        const bool isk = rowg >= NROWS / 2; const size_t row = isk ? rowg - NROWS / 2 : rowg;
        bf16* ptr = (isk ? K1 : Q1) + row * 64 + part * 8; const float* g = (isk ? kg : qg) + part * 8;
        const int s = (int)(row & 4095); const int bh = (int)(row >> 13); const int bidx = bh >> 3; const size_t mtok = (size_t)bidx * 4096 + s;
        const v4u raw = *(const v4u*)ptr;
        float x[8];
#pragma unroll
        for (int i = 0; i < 4; ++i) { x[2 * i] = bf_lo(raw[i]); x[2 * i + 1] = bf_hi(raw[i]); }
        float ss = 0.f;
#pragma unroll
        for (int i = 0; i < 8; ++i) ss += x[i] * x[i];
        ss += __shfl_xor(ss, 1); ss += __shfl_xor(ss, 2); ss += __shfl_xor(ss, 4);
        const float rstd = rsqrtf(ss * (1.f / 64.f) + EPS);
        float y[8], other[8];
#pragma unroll
        for (int i = 0; i < 8; ++i) y[i] = x[i] * rstd * g[i];
#pragma unroll
        for (int i = 0; i < 8; ++i) other[i] = __shfl_xor(y[i], 1);
        if (part < 2) { const float* cs = rope + mtok * 16;
#pragma unroll
            for (int i = 0; i < 8; ++i) { const float co = cs[i], si = cs[8 + i]; y[i] = (part == 0) ? (y[i] * co - other[i] * si) : (y[i] * co + other[i] * si); } }
        const float sc = isk ? 1.f : (0.125f * 1.44269504089f);
        v4u o;
#pragma unroll
        for (int i = 0; i < 4; ++i) o[i] = pk2(y[2 * i] * sc, y[2 * i + 1] * sc);
        *(v4u*)ptr = o;
    }
}

#define AT_LOAD(kt_) do { _Pragma("unroll") for (int i_ = 0; i_ < 2; ++i_) { rK[i_] = *(const v4u*)(K1 + ((size_t)((bh * 2 + i_) * 4096 + (kt_) * 64 + (tid >> 3))) * 64 + (tid & 7) * 8); \
        rV[i_] = *(const v4u*)(V1 + ((size_t)(bh * 4096 + (kt_) * 64 + lane)) * 128 + (2 * w + i_) * 8); } } while (0)
#define AT_WRITE(buf_) do { _Pragma("unroll") for (int i_ = 0; i_ < 2; ++i_) { *(LAS v4u*)(lds + (buf_) * 35840 + i_ * 9216 + ((tid >> 3) * 72 + (tid & 7) * 8) * 2) = rK[i_]; \
        LAS bf16* vt_ = (LAS bf16*)(lds + (buf_) * 35840 + 18432) + ((2 * w + i_) * 8) * 68 + lane; \
        _Pragma("unroll") for (int e_ = 0; e_ < 4; ++e_) { vt_[(2 * e_) * 68] = (bf16)(rV[i_][e_] & 0xffffu); vt_[(2 * e_ + 1) * 68] = (bf16)(rV[i_][e_] >> 16); } } } while (0)
__device__ __forceinline__ void attn_phase(LAS unsigned char* lds, int vcu, const bf16* Q1, const bf16* K1, const bf16* V1, bf16* O, const float* qg, const float* kg,
                                           const float* lq1, const float* lk1, const float* lq2, const float* lk2, const float* subln) {
    int tid_ = threadIdx.x; asm volatile("" : "+v"(tid_)); const int tid = tid_, lane = tid & 63, w = __builtin_amdgcn_readfirstlane(tid >> 6), r32 = lane & 31, hi = lane >> 5, qt = w & 3, c = w >> 2;
    float s1 = 0.f, s2 = 0.f, mq = 0.f, mk = 0.f;
    for (int i = 0; i < 64; ++i) { s1 += lq1[i] * lk1[i]; s2 += lq2[i] * lk2[i]; mq = fmaxf(mq, fabsf(qg[i])); mk = fmaxf(mk, fabsf(kg[i])); }
    const float lam = expf(s1) - expf(s2) + LAMBDA_INIT;
    const float offs = 8.f * mq * mk * 1.44269504089f * 1.02f + 0.25f;
    f32x16 cinit;
#pragma unroll
    for (int r = 0; r < 16; ++r) cinit[r] = -offs;
    LAS float* lbuf = (LAS float*)(lds + 135168 + w * 128);
    LAS float* Obuf = (LAS float*)lds;
#pragma unroll 1
    for (int ui = 0; ui < 8; ++ui) {
        const int uid = vcu * 8 + ui, bh = uid >> 5, qb = uid & 31, b = bh >> 3, h = bh & 7;
        bf16x8 bq[4];
#pragma unroll
        for (int ks = 0; ks < 4; ++ks) bq[ks] = *(const bf16x8*)(Q1 + ((size_t)((bh * 2 + c) * 4096 + qb * 128 + qt * 32 + r32)) * 64 + ks * 16 + 8 * hi);
        f32x16 Oa[4];
#pragma unroll
        for (int db = 0; db < 4; ++db)
#pragma unroll
            for (int r = 0; r < 16; ++r) Oa[db][r] = 0.f;
        float lsum = 0.f;
        v4u rK[2], rV[2];
        AT_LOAD(0); AT_WRITE(0); AT_LOAD(1);
        __syncthreads();
#pragma unroll 1
        for (int kt = 0; kt < 64; ++kt) {
            const int buf = kt & 1;
            if (kt + 1 < 64) AT_WRITE(buf ^ 1);
            if (kt + 2 < 64) AT_LOAD(kt + 2);
            const LAS bf16* Kc = (const LAS bf16*)(lds + buf * 35840 + c * 9216);
            const LAS bf16* Vt = (const LAS bf16*)(lds + buf * 35840 + 18432);
            f32x16 p0 = cinit, p1 = cinit;
#pragma unroll
            for (int ks = 0; ks < 4; ++ks) { const bf16x8 a0 = *(const LAS bf16x8*)(Kc + r32 * 72 + ks * 16 + 8 * hi), a1 = *(const LAS bf16x8*)(Kc + (32 + r32) * 72 + ks * 16 + 8 * hi);
                p0 = mfma32(a0, bq[ks], p0); p1 = mfma32(a1, bq[ks], p1); }
            float ls = 0.f;
#pragma unroll
            for (int r = 0; r < 16; ++r) { p0[r] = __builtin_amdgcn_exp2f(p0[r]); p1[r] = __builtin_amdgcn_exp2f(p1[r]); ls += p0[r] + p1[r]; }
            lsum += ls;
            bf16x8 pa[4];
            { v4u t0, t1, t2, t3;
#pragma unroll
              for (int k = 0; k < 4; ++k) { t0[k] = pk2(p0[2 * k], p0[2 * k + 1]); t1[k] = pk2(p0[8 + 2 * k], p0[9 + 2 * k]); t2[k] = pk2(p1[2 * k], p1[2 * k + 1]); t3[k] = pk2(p1[8 + 2 * k], p1[9 + 2 * k]); }
              pa[0] = __builtin_bit_cast(bf16x8, t0); pa[1] = __builtin_bit_cast(bf16x8, t1); pa[2] = __builtin_bit_cast(bf16x8, t2); pa[3] = __builtin_bit_cast(bf16x8, t3); }
#pragma unroll
            for (int sp_ = 0; sp_ < 4; ++sp_)
#pragma unroll
                for (int db = 0; db < 4; ++db) { const LAS bf16* vp = Vt + (32 * db + r32) * 68 + 16 * sp_ + 4 * hi;
                    const u32x2 lo = *(const LAS u32x2*)vp, hh = *(const LAS u32x2*)(vp + 8);
                    const v4u vv = (v4u){lo.x, lo.y, hh.x, hh.y};
                    Oa[db] = mfma32(pa[sp_], __builtin_bit_cast(bf16x8, vv), Oa[db]); }
            __syncthreads();
        }
        lsum += __shfl_xor(lsum, 32);
        lbuf[r32] = lsum;
#pragma unroll
        for (int r = 0; r < 16; ++r) { const int qrow = (r & 3) + 8 * (r >> 2) + 4 * hi; const float inv = 1.f / lbuf[qrow];
#pragma unroll
            for (int db = 0; db < 4; ++db) Obuf[(c * 128 + qt * 32 + qrow) * 132 + 32 * db + r32] = Oa[db][r] * inv; }
        __syncthreads();
        { const int row = tid >> 2, qd = tid & 3;
          float dv[32]; float ss = 0.f;
#pragma unroll
          for (int k = 0; k < 8; ++k) { const f32x4 o0 = *(const LAS f32x4*)(Obuf + row * 132 + qd * 32 + 4 * k), o1 = *(const LAS f32x4*)(Obuf + (128 + row) * 132 + qd * 32 + 4 * k);
#pragma unroll
              for (int e = 0; e < 4; ++e) { const float d = o0[e] - lam * o1[e]; dv[4 * k + e] = d; ss += d * d; } }
          ss += __shfl_xor(ss, 1); ss += __shfl_xor(ss, 2);
          const float rstd = rsqrtf(ss * (1.f / 128.f) + EPS) * (1.f - LAMBDA_INIT);
          bf16* op = O + ((size_t)b * 4096 + qb * 128 + row) * 1024 + h * 128 + qd * 32;
#pragma unroll
          for (int k = 0; k < 4; ++k) { v4u o;
#pragma unroll
              for (int e = 0; e < 4; ++e) o[e] = pk2(dv[8 * k + 2 * e] * rstd * subln[qd * 32 + 8 * k + 2 * e], dv[8 * k + 2 * e + 1] * rstd * subln[qd * 32 + 8 * k + 2 * e + 1]);
              *(v4u*)(op + 8 * k) = o; } }
        __syncthreads();
    }
}
#undef AT_LOAD
#undef AT_WRITE
struct Args { const void* in[27]; float* out; unsigned char* ws; };
#define KARG(i) ({ GAS const void* p_; asm volatile("s_load_dwordx2 %0, %1, %2\n\ts_waitcnt lgkmcnt(0)" : "=s"(p_) : "s"(__builtin_amdgcn_kernarg_segment_ptr()), "i"(8 * (i))); (const void*)p_; })
#define KIN(i) ((const float*)KARG(i))
#define KOUT() ((float*)KARG(27))
#define KWS() ((unsigned char*)KARG(28))
#define WSP(T_, off) ((T_*)(KWS() + (off)))
__global__ void __launch_bounds__(NWAVES * 64, 2) mk_fwd(Args args) {
    extern __shared__ __attribute__((aligned(16))) unsigned char lds_raw[];
    LAS unsigned char* lds = (LAS unsigned char*)lds_raw;
    const int G = gridDim.x, bx = blockIdx.x;
    const int vcu = (G % 8 == 0) ? (bx % 8) * (G / 8) + bx / 8 : bx;
#define PH_IDS() int tid_ = threadIdx.x; asm volatile("" : "+v"(tid_)); const int tid = tid_, lane = tid & 63, wave = __builtin_amdgcn_readfirstlane(tid >> 6); \
    const int gw = vcu * NWAVES + wave, NGW = G * NWAVES; const size_t gtid = (size_t)vcu * (NWAVES * 64) + tid, gthreads = (size_t)G * (NWAVES * 64); (void)lane; (void)gw; (void)NGW; (void)gtid; (void)gthreads
    if (threadIdx.x < 32) ((LAS unsigned*)(lds + MISC_OFF))[threadIdx.x] = 0u;
    __syncthreads();
    (void)xcd_barrier_post((unsigned*)(WSP(gu32, WS_CTL) + CW_BAR), (volatile LAS unsigned*)(lds + MISC_OFF) + 8);
#define STAMP() do {} while (0)
#ifndef PROBE_DUP
#define PROBE_DUP 0
#endif
#define REPS(bit) _Pragma("unroll 1") for (int rep_ = 0; rep_ < 1 + ((PROBE_DUP >> (bit)) & 1); ++rep_)
#define GRID_BAR() do { XcdBarrier b_; b_.bar = (unsigned*)(WSP(gu32, WS_CTL) + CW_BAR); b_.x = xb_xcc_id(); b_.st = (volatile LAS unsigned*)(lds + MISC_OFF) + 8; xcd_barrier(b_); STAMP(); } while (0)

    REPS(5) {
        PH_IDS();
        LAS float* scr = (LAS float*)(lds + wave * 16384);
        constexpr int I0 = 16 * 97, I1 = 16 * 32, I2 = 16 * 64, I3 = 16 * 96, I4 = 16 * 32, I5 = 16 * 64, NITEMS = I0 + I1 + I2 + I3 + I4 + I5;
        for (int it = gw; it < NITEMS; it += NGW) {
            int r = it;
            if (r < I0) { p0_transpose_item(KIN(3), 1024, 3104, WSP(bf16, WS_WIN), scr, r, lane); continue; } r -= I0;
            if (r < I1) { p0_transpose_item(KIN(6), 1024, 1024, WSP(bf16, WS_WO0), scr, r, lane); continue; } r -= I1;
            if (r < I2) { p0_transpose_item(KIN(8), 1024, 2048, WSP(bf16, WS_WQ0), scr, r, lane); continue; } r -= I2;
            if (r < I3) { p0_transpose_item(KIN(13), 1024, 3072, WSP(bf16, WS_WQKV), scr, r, lane); continue; } r -= I3;
            if (r < I4) { p0_transpose_item(KIN(21), 1024, 1024, WSP(bf16, WS_WO1), scr, r, lane); continue; } r -= I4;
            p0_transpose_item(KIN(23), 1024, 2048, WSP(bf16, WS_WQ1), scr, r, lane);
        }
        { bf16* WIN = WSP(bf16, WS_WIN); for (size_t i = gtid * 8; i < (size_t)224 * 1024; i += gthreads * 8) *(v4u*)(WIN + (size_t)3104 * 1024 + i) = (v4u){0u, 0u, 0u, 0u}; }
        cvt_range(KIN(9), WSP(bf16, WS_KEY0), (size_t)262144, gtid, gthreads);
        cvt_range(KIN(24), WSP(bf16, WS_KEY1), (size_t)262144, gtid, gthreads);
        quant_rows(KIN(10), WSP(unsigned char, WS_U0), WSP(float, WS_SC), 16384, 0, gw, NGW, lane);
        quant_rows(KIN(11), WSP(unsigned char, WS_V0T), WSP(float, WS_SC + 65536), 16384, 128, gw, NGW, lane);
        quant_rows(KIN(25), WSP(unsigned char, WS_U1), WSP(float, WS_SC + 2 * 65536), 16384, 0, gw, NGW, lane);
        quant_rows(KIN(26), WSP(unsigned char, WS_V1T), WSP(float, WS_SC + 3 * 65536), 16384, 128, gw, NGW, lane);
        rms_pass(KIN(0), KIN(2), WSP(bf16, WS_B0), gw, NGW, lane);
        { const int* positions = (const int*)KARG(1); float* ROPE = WSP(float, WS_ROPE);
          for (size_t id = gtid; id < (size_t)T * 8; id += gthreads) { const size_t mtok = id >> 3; const int i = (int)(id & 7);
            const float inv = powf(500000.0f, -(float)i * 2.0f / 16.0f); const float ang = (float)positions[mtok] * inv;
            float sn, cs; sincosf(ang, &sn, &cs); ROPE[mtok * 16 + i] = cs; ROPE[mtok * 16 + 8 + i] = sn; } }
    }
    GRID_BAR();
    REPS(3) {
        unsigned char* ws = KWS();
        pg8::Gemm g{(const bf16*)(ws + WS_B0), (const bf16*)(ws + WS_WIN), T, 3328, 1024}; pg8::StaticOrder S; S.init(T, 3328, G, bx);
        pg8::EpiInProj E{(bf16*)(ws + WS_R1), (bf16*)(ws + WS_R1 + 32 * MiB), (bf16*)(ws + WS_R2), (bf16*)(ws + WS_R3), (float*)(ws + WS_GATES), KIN(4)};
        pg8::gemm_phase<pg8::EpiInProj, pg8::StaticOrder, true, true>(lds, g, S, E);
    }
    GRID_BAR();
    REPS(2) { unsigned char* ws = KWS(); mlstm_phase(lds, (const bf16*)(ws + WS_R1), (const bf16*)(ws + WS_R1 + 32 * MiB), (const bf16*)(ws + WS_R2), (const float*)(ws + WS_GATES), (bf16*)(ws + WS_R4), (bf16*)(ws + WS_R5)); }
    GRID_BAR();
    { PH_IDS(); unsigned char* ws = KWS(); hs_pass((const bf16*)(ws + WS_R4), (const bf16*)(ws + WS_R5), (const bf16*)(ws + WS_R3), KIN(5), (bf16*)(ws + WS_B0), gw, NGW, lane); }
    GRID_BAR();
#pragma unroll 1
    for (int L = 0; L < 2; ++L) {
        if (L == 1) {
            REPS(3) {
                unsigned char* ws = KWS();
                pg8::Gemm g{(const bf16*)(ws + WS_B0), (const bf16*)(ws + WS_WQKV), T, 3072, 1024}; pg8::StaticOrder S; S.init(T, 3072, G, bx);
                pg8::EpiQKV E{(bf16*)(ws + WS_R2), (bf16*)(ws + WS_R3), (bf16*)(ws + WS_R4)};
                pg8::gemm_phase<pg8::EpiQKV, pg8::StaticOrder, true, true>(lds, g, S, E);
            }
            GRID_BAR();
            { PH_IDS(); unsigned char* ws = KWS(); qknorm_rope_pass((bf16*)(ws + WS_R2), (bf16*)(ws + WS_R3), KIN(14), KIN(15), (const float*)(ws + WS_ROPE), gtid, gthreads); }
            GRID_BAR();
            REPS(0) { unsigned char* ws = KWS(); attn_phase(lds, vcu, (const bf16*)(ws + WS_R2), (const bf16*)(ws + WS_R3), (const bf16*)(ws + WS_R4), (bf16*)(ws + WS_B0), KIN(14), KIN(15), KIN(16), KIN(17), KIN(18), KIN(19), KIN(20)); }
            GRID_BAR();
        }
        _Pragma("unroll 1") for (int rep_ = 0; rep_ < 1 + ((L == 0) ? ((PROBE_DUP >> 3) & 1) : 0); ++rep_) {
            unsigned char* ws = KWS(); float* out = KOUT();
            pg8::Gemm g{(const bf16*)(ws + WS_B0), (const bf16*)(ws + (L ? WS_WO1 : WS_WO0)), T, 1024, 1024}; pg8::StaticOrder S; S.init(T, 1024, G, bx);
            pg8::EpiRes E{L ? (const float*)out : KIN(0), out};
            pg8::gemm_phase<pg8::EpiRes, pg8::StaticOrder, true, true>(lds, g, S, E);
        }
        GRID_BAR();
        { PH_IDS(); rms_pass(KOUT(), L ? KIN(22) : KIN(7), WSP(bf16, WS_B0), gw, NGW, lane); }
        GRID_BAR();
        REPS(3) {
            unsigned char* ws = KWS();
            pg8::Gemm g{(const bf16*)(ws + WS_B0), (const bf16*)(ws + (L ? WS_WQ1 : WS_WQ0)), T, 2048, 1024}; pg8::StaticOrder S; S.init(T, 2048, G, bx);
            pg8::EpiPlain E{(bf16*)(ws + WS_R2), 2048};
            pg8::gemm_phase<pg8::EpiPlain, pg8::StaticOrder, true, true>(lds, g, S, E);
        }
        GRID_BAR();
        REPS(4) { unsigned char* ws = KWS(); peer_topk_phase(vcu, (const bf16*)(ws + WS_R2), (const bf16*)(ws + (L ? WS_KEY1 : WS_KEY0)), (int*)(ws + WS_R4), (float*)(ws + WS_R4 + 16 * MiB)); }
        GRID_BAR();
        if (L == 0) { unsigned char* ws = KWS();
            if ((PROBE_DUP >> 1) & 1) peer_gather_phase<true>(gridDim.y == 1, vcu, (const bf16*)(ws + WS_B0), (const int*)(ws + WS_R4), (const float*)(ws + WS_R4 + 16 * MiB), ws + WS_U0, (const float*)(ws + WS_SC), ws + WS_V0T, (const float*)(ws + WS_SC + 65536), KOUT(), KIN(12), (bf16*)(ws + WS_B0));
            peer_gather_phase<true>(false, vcu, (const bf16*)(ws + WS_B0), (const int*)(ws + WS_R4), (const float*)(ws + WS_R4 + 16 * MiB), ws + WS_U0, (const float*)(ws + WS_SC), ws + WS_V0T, (const float*)(ws + WS_SC + 65536), KOUT(), KIN(12), (bf16*)(ws + WS_B0)); GRID_BAR(); }
        else { unsigned char* ws = KWS(); peer_gather_phase<false>(false, vcu, (const bf16*)(ws + WS_B0), (const int*)(ws + WS_R4), (const float*)(ws + WS_R4 + 16 * MiB), ws + WS_U1, (const float*)(ws + WS_SC + 2 * 65536), ws + WS_V1T, (const float*)(ws + WS_SC + 3 * 65536), KOUT(), nullptr, nullptr); }
    }
#undef GRID_BAR
}

extern "C" void kernel_launch(void* const* d_in, const int* in_sizes, int n_in, void* d_out, int out_size, void* d_ws, size_t ws_size, hipStream_t stream) {
    static int ready = 0;
    if (ready == 0) {
        if (n_in != 27 || out_size != T * D || ws_size < WS_END) { fprintf(stderr, "kernel_launch: unexpected problem (n_in %d, out %d, ws %zu)\n", n_in, out_size, ws_size); ready = -1; return; }
        if (hipFuncSetAttribute((const void*)mk_fwd, hipFuncAttributeMaxDynamicSharedMemorySize, LDS_BYTES) != hipSuccess) { fprintf(stderr, "kernel_launch: hipFuncSetAttribute failed\n"); ready = -1; return; }
        (void)hipGetLastError();
        ready = 1;
    }
    if (ready < 0) return;
    if (hipMemsetAsync((char*)d_ws + WS_CTL, 0, CTL_ZERO_BYTES, stream) != hipSuccess) { fprintf(stderr, "kernel_launch: memset failed\n"); return; }
    Args a{};
    for (int i = 0; i < 27; ++i) a.in[i] = d_in[i];
    a.out = (float*)d_out; a.ws = (unsigned char*)d_ws;
    hipLaunchKernelGGL(mk_fwd, dim3(256), dim3(NWAVES * 64), LDS_BYTES, stream, a);
}
```

```cpp
#include <hip/hip_runtime.h>
#include <hip/hip_bf16.h>
#include <cstdio>
#include <cstdint>
#include <cmath>
namespace pg8 {
#define PG8_LAS __attribute__((address_space(3)))
typedef unsigned short bf16_t;
typedef short bf16x8 __attribute__((ext_vector_type(8)));
typedef float f32x4 __attribute__((ext_vector_type(4)));
typedef unsigned u32x4 __attribute__((ext_vector_type(4)));
constexpr int BM = 256, BK = 64, HALF = 128, HTB = HALF * BK * 2  , STAGE_BYTES = 8 * HTB, NXCD = 8, WGM = 8;

__host__ __device__ __forceinline__ int lds_byte(int r, int c) { const int st = (r >> 4) * 2 + (c >> 5), rr = r & 15, cc = c & 31, ob = rr * 64 + cc * 2; return st * 1024 + (ob ^ (((ob >> 9) & 1) << 5)); }
__host__ __device__ __forceinline__ void stage_rc(int b, int& R, int& C) { const int st = b / 1024, sb = b % 1024, swz = sb ^ (((sb >> 9) & 1) << 5); R = (st >> 1) * 16 + swz / 64; C = (st & 1) * 32 + (swz % 64) / 2; }
__host__ __device__ __forceinline__ int perm32(int rho) { const int n = rho >> 4, i = rho & 15; return 8 * (i >> 2) + 4 * n + (i & 3); }

struct Unit { int pm, pn; };
struct Gemm { const bf16_t* A; const bf16_t* Bt; int M, N, K; };

struct StaticOrder {
    int nM, nN, nwg, G, c;
    __host__ __device__ void init(int M, int N, int G_, int c_) { nM = M / BM; nN = N / BM; nwg = nM * nN; G = G_; c = c_; }
    __host__ __device__ bool next(int i, Unit& u) const {
        const long L = (long)i * G + c; if (L >= nwg) return false;
        int wgid = (int)L; { const int q = nwg / NXCD, r = nwg % NXCD, xcd = wgid % NXCD, off = wgid / NXCD; wgid = (xcd < r ? xcd * (q + 1) : r * (q + 1) + (xcd - r) * q) + off; }
        const int nig = WGM * nN, gid = wgid / nig, fm = gid * WGM, gsz = (nM - fm) < WGM ? (nM - fm) : WGM;
        u.pm = fm + ((wgid % nig) % gsz); u.pn = (wgid % nig) / gsz; return true;
    }
    __device__ __forceinline__ void a_ready(const Unit&) const {}
    __device__ __forceinline__ void done(const Unit&) const {}
};
__device__ __forceinline__ unsigned cvt_pk_bf16(float lo, float hi) { unsigned r; asm volatile("v_cvt_pk_bf16_f32 %0, %1, %2" : "=v"(r) : "v"(lo), "v"(hi)); return r; }
typedef float f32x2 __attribute__((ext_vector_type(2)));
typedef unsigned u32x2 __attribute__((ext_vector_type(2)));
__device__ __forceinline__ u32x4 pack8(const f32x4 v0, const f32x4 v1) { u32x4 w; w.x = cvt_pk_bf16(v0[0], v0[1]); w.y = cvt_pk_bf16(v0[2], v0[3]); w.z = cvt_pk_bf16(v1[0], v1[1]); w.w = cvt_pk_bf16(v1[2], v1[3]); return w; }
struct EpiPlain {
    static constexpr bool PERM = true, AFTER_DRAIN = false;
    bf16_t* O; int ldc;
    __device__ __forceinline__ void operator()(const f32x4 (&acc)[2][2][4][2], const Unit& u, int wr, int wc, int fr, int fq) const {
        const int row0 = u.pm * BM + wr * 64 + fr, col0 = u.pn * BM + wc * 32 + 8 * fq;
#pragma unroll
        for (int ai = 0; ai < 2; ++ai)
#pragma unroll
            for (int m = 0; m < 4; ++m) { bf16_t* rowp = O + (size_t)(row0 + ai * HALF + m * 16) * ldc + col0;
#pragma unroll
                for (int bj = 0; bj < 2; ++bj) *(u32x4*)(rowp + bj * HALF) = pack8(acc[ai][bj][m][0], acc[ai][bj][m][1]); }
    }
};
struct EpiRes {
    static constexpr bool PERM = false, AFTER_DRAIN = false;
    const float* base; float* out;
    __device__ __forceinline__ void operator()(const f32x4 (&acc)[2][2][4][2], const Unit& u, int wr, int wc, int fr, int fq) const {
        const int col0 = u.pn * BM + wc * 32 + 4 * fq;
#pragma unroll
        for (int ai = 0; ai < 2; ++ai)
#pragma unroll
            for (int m = 0; m < 4; ++m) { const size_t off = (size_t)(u.pm * BM + ai * HALF + wr * 64 + m * 16 + fr) * 1024 + col0;
#pragma unroll
                for (int bj = 0; bj < 2; ++bj)
#pragma unroll
                    for (int n = 0; n < 2; ++n) { const f32x4 bs = *(const f32x4*)(base + off + bj * HALF + n * 16); *(f32x4*)(out + off + bj * HALF + n * 16) = bs + acc[ai][bj][m][n]; } }
    }
};
struct EpiInProj {
    static constexpr bool PERM = true, AFTER_DRAIN = false;
    bf16_t *Q, *Kk, *V, *OG; float* gates; const float* bg;
    __device__ __forceinline__ void operator()(const f32x4 (&acc)[2][2][4][2], const Unit& u, int wr, int wc, int fr, int fq) const {
        const int colt = u.pn * BM;
#pragma unroll
        for (int ai = 0; ai < 2; ++ai)
#pragma unroll
            for (int m = 0; m < 4; ++m) { const int row = u.pm * BM + ai * HALF + wr * 64 + m * 16 + fr, b = row >> 12, s = row & 4095;
#pragma unroll
                for (int bj = 0; bj < 2; ++bj) { const int cb = colt + bj * HALF + wc * 32 + 8 * fq; f32x4 v0 = acc[ai][bj][m][0], v1 = acc[ai][bj][m][1];
                    if (colt < 1024) { const bool isq = colt < 512; bf16_t* base = isq ? Q : Kk; const int c2 = cb & 511, head = c2 >> 6, d = c2 & 63;
                        if (isq) { v0 = v0 * 0.125f; v1 = v1 * 0.125f; }
                        *(u32x4*)(base + ((size_t)((b * 8 + head) * 4096 + s)) * 64 + d) = pack8(v0, v1); }
                    else if (colt < 2048) { const int c2 = cb - 1024, head = c2 >> 7, dv = c2 & 127; *(u32x4*)(V + ((size_t)((b * 8 + head) * 4096 + s)) * 128 + dv) = pack8(v0, v1); }
                    else if (colt < 3072) { *(u32x4*)(OG + (size_t)row * 1024 + (cb - 2048)) = pack8(v0, v1); }
                    else if (cb < 3104) { const int gi = cb - 3072; float* g = gates + (size_t)row * 32 + gi;
                        *(f32x4*)g = v0 + *(const f32x4*)(bg + gi); *(f32x4*)(g + 4) = v1 + *(const f32x4*)(bg + gi + 4); } } }
    }
};
struct EpiQKV {
    static constexpr bool PERM = true, AFTER_DRAIN = false;
    bf16_t *Q, *Kk, *V;
    __device__ __forceinline__ void operator()(const f32x4 (&acc)[2][2][4][2], const Unit& u, int wr, int wc, int fr, int fq) const {
        const int colt = u.pn * BM;
#pragma unroll
        for (int ai = 0; ai < 2; ++ai)
#pragma unroll
            for (int m = 0; m < 4; ++m) { const int row = u.pm * BM + ai * HALF + wr * 64 + m * 16 + fr, b = row >> 12, s = row & 4095;
#pragma unroll
                for (int bj = 0; bj < 2; ++bj) { const int cb = colt + bj * HALF + wc * 32 + 8 * fq; const u32x4 w = pack8(acc[ai][bj][m][0], acc[ai][bj][m][1]);
                    if (colt < 2048) { bf16_t* base = colt < 1024 ? Q : Kk; const int c2 = cb & 1023, head = c2 >> 7, c = (c2 >> 6) & 1, d = c2 & 63;
                        *(u32x4*)(base + ((size_t)(((b * 8 + head) * 2 + c) * 4096 + s)) * 64 + d) = w; }
                    else { const int c2 = cb - 2048, head = c2 >> 7, dv = c2 & 127; *(u32x4*)(V + ((size_t)((b * 8 + head) * 4096 + s)) * 128 + dv) = w; } } }
    }
};
template <class Epi, class Sched, bool ALIGN_EPI = false, bool SP2 = false>
__device__ __forceinline__ void gemm_phase(PG8_LAS unsigned char* lds, const Gemm g, const Sched& S, const Epi& E) {
    int tid_ = threadIdx.x; asm volatile("" : "+v"(tid_)); const int tid = tid_, wid = __builtin_amdgcn_readfirstlane(tid >> 6), lane = tid & 63, wr = wid >> 2, wc = wid & 3, fr = lane & 15, fq = lane >> 4;
    const int K = g.K, nt = K / BK;
    unsigned voffA[2], voffB[2];
#pragma unroll
    for (int i = 0; i < 2; ++i) { int R, C; stage_rc(tid * 16 + i * 8192, R, C); const int Rb = Epi::PERM ? ((R & ~31) + perm32(R & 31)) : R;
        voffA[i] = (unsigned)(R * K + C) * 2u; voffB[i] = (unsigned)(Rb * K + C) * 2u; }
    const size_t kstep = (size_t)(BK * 2);
    const size_t hstep = (size_t)HALF * K * 2;
    const size_t tstep = 2 * hstep;
    const unsigned ldsw = (unsigned)wid * 1024u;
    const int aoff = lds_byte(wr * 64 + fr, fq * 8), boff = lds_byte(wc * 32 + fr, fq * 8);
#define PG8_SA(b, h) (((b) * 2 + (h)) * HTB)
#define PG8_SB(b, h) ((4 + (b) * 2 + (h)) * HTB)
#define PG8_STAGE(bufoff, gbase, voff) do { _Pragma("unroll") for (int _i = 0; _i < 2; ++_i) \
        __builtin_amdgcn_global_load_lds((const unsigned*)((const char*)(gbase) + (voff)[_i]), (PG8_LAS unsigned*)(lds + (bufoff) + ldsw + _i * 8192), 16, 0, 0); } while (0)
#define PG8_LDA(dst, b, h) do { _Pragma("unroll") for (int m = 0; m < 4; ++m) _Pragma("unroll") for (int k = 0; k < 2; ++k) dst[m][k] = *(const PG8_LAS bf16x8*)(lds + PG8_SA(b, h) + aoff + m * 2048 + k * 1024); } while (0)
#define PG8_LDB(dst, b, h) do { _Pragma("unroll") for (int n = 0; n < 2; ++n) _Pragma("unroll") for (int k = 0; k < 2; ++k) dst[n][k] = *(const PG8_LAS bf16x8*)(lds + PG8_SB(b, h) + boff + n * 2048 + k * 1024); } while (0)
#define PG8_MMA(ai, bj, At, Bt) do { __builtin_amdgcn_s_setprio(1); _Pragma("unroll") for (int m = 0; m < 4; ++m) _Pragma("unroll") for (int n = 0; n < 2; ++n) _Pragma("unroll") for (int k = 0; k < 2; ++k) \
        acc[ai][bj][m][n] = __builtin_amdgcn_mfma_f32_16x16x32_bf16(Bt[n][k], At[m][k], acc[ai][bj][m][n], 0, 0, 0); __builtin_amdgcn_s_setprio(0); } while (0)
#define PG8_WAIT_V(n) asm volatile("s_waitcnt vmcnt(" #n ")" ::: "memory")
#define PG8_WAIT_L(n) asm volatile("s_waitcnt lgkmcnt(" #n ")" ::: "memory")
#define PG8_BAR __builtin_amdgcn_s_barrier()
#define PG8_SCHED __builtin_amdgcn_sched_barrier(0)
    Unit cur, nxt; int ui = 0;
    if (!S.next(0, cur)) return;
    f32x4 acc[2][2][4][2];
#pragma unroll
    for (int a = 0; a < 2; ++a)
#pragma unroll
        for (int b = 0; b < 2; ++b)
#pragma unroll
            for (int m = 0; m < 4; ++m)
#pragma unroll
                for (int n = 0; n < 2; ++n) acc[a][b][m][n] = (f32x4){0.f, 0.f, 0.f, 0.f};
    bf16x8 At[4][2], B0[2][2], B1[2][2];
    const char* cA = (const char*)g.A + (size_t)cur.pm * tstep; const char* cB = (const char*)g.Bt + (size_t)cur.pn * tstep;
    S.a_ready(cur);
    if constexpr (SP2) {
        PG8_STAGE(PG8_SB(0, 0), cB, voffB); PG8_STAGE(PG8_SB(0, 1), cB + hstep, voffB); PG8_STAGE(PG8_SA(0, 0), cA, voffA); PG8_STAGE(PG8_SA(0, 1), cA + hstep, voffA);
        if (wr == 1) PG8_BAR;
        PG8_WAIT_V(2); PG8_BAR;
        PG8_STAGE(PG8_SB(1, 0), cB + kstep, voffB); PG8_STAGE(PG8_SA(1, 0), cA + kstep, voffA); PG8_STAGE(PG8_SB(1, 1), cB + hstep + kstep, voffB);
        PG8_WAIT_V(6); PG8_BAR;
    } else {
        PG8_STAGE(PG8_SB(0, 0), cB, voffB); PG8_STAGE(PG8_SA(0, 0), cA, voffA); PG8_STAGE(PG8_SB(0, 1), cB + hstep, voffB); PG8_STAGE(PG8_SA(0, 1), cA + hstep, voffA);
        if (wr == 1) PG8_BAR;
        PG8_WAIT_V(4); PG8_BAR;
        PG8_STAGE(PG8_SB(1, 0), cB + kstep, voffB); PG8_STAGE(PG8_SA(1, 0), cA + kstep, voffA); PG8_STAGE(PG8_SB(1, 1), cB + hstep + kstep, voffB);
        PG8_WAIT_V(6); PG8_BAR;
    }
    for (;;) {
        const bool has_next = S.next(ui + 1, nxt);
        const char* nA = has_next ? (const char*)g.A + (size_t)nxt.pm * tstep : cA; const char* nB = has_next ? (const char*)g.Bt + (size_t)nxt.pn * tstep : cB;
        for (int t = 0; t < nt; t += 2) {
            const bool last = (t == nt - 2);
            const char* a1 = cA + (size_t)(t + 1) * kstep;
            const char* a2 = last ? nA : cA + (size_t)(t + 2) * kstep; const char* b2 = last ? nB : cB + (size_t)(t + 2) * kstep;
            const char* a3 = a2 + kstep; const char* b3 = b2 + kstep;
            if (last && has_next) S.a_ready(nxt);
            if constexpr (SP2) {
            PG8_LDB(B0, 0, 0); PG8_LDB(B1, 0, 1); PG8_SCHED; PG8_LDA(At, 0, 0); PG8_STAGE(PG8_SA(1, 1), a1 + hstep, voffA);
            PG8_WAIT_V(8); PG8_WAIT_L(0); PG8_BAR; PG8_MMA(0, 0, At, B0); PG8_MMA(0, 1, At, B1); PG8_BAR; PG8_SCHED;
            PG8_LDA(At, 0, 1); PG8_STAGE(PG8_SB(0, 0), b2, voffB); PG8_STAGE(PG8_SB(0, 1), b2 + hstep, voffB); PG8_STAGE(PG8_SA(0, 0), a2, voffA);
            PG8_WAIT_V(8); PG8_WAIT_L(0); PG8_BAR; PG8_MMA(1, 0, At, B0); PG8_MMA(1, 1, At, B1); PG8_BAR; PG8_SCHED;
            PG8_LDB(B0, 1, 0); PG8_LDB(B1, 1, 1); PG8_SCHED; PG8_LDA(At, 1, 0); PG8_STAGE(PG8_SA(0, 1), a2 + hstep, voffA);
            PG8_WAIT_V(8); PG8_WAIT_L(0); PG8_BAR; PG8_MMA(0, 0, At, B0); PG8_MMA(0, 1, At, B1); PG8_BAR; PG8_SCHED;
            PG8_LDA(At, 1, 1); PG8_STAGE(PG8_SB(1, 0), b3, voffB); PG8_STAGE(PG8_SB(1, 1), b3 + hstep, voffB); PG8_STAGE(PG8_SA(1, 0), a3, voffA);
            PG8_WAIT_V(8); PG8_WAIT_L(0); PG8_BAR; PG8_MMA(1, 0, At, B0); PG8_MMA(1, 1, At, B1); PG8_BAR; PG8_SCHED;
            } else {
            PG8_LDB(B0, 0, 0); PG8_SCHED; PG8_LDA(At, 0, 0); PG8_STAGE(PG8_SA(1, 1), a1 + hstep, voffA);
            PG8_WAIT_L(8); PG8_BAR; PG8_WAIT_L(0); PG8_MMA(0, 0, At, B0); PG8_BAR; PG8_SCHED;
            PG8_LDB(B1, 0, 1); PG8_STAGE(PG8_SB(0, 0), b2, voffB);
            PG8_BAR; PG8_WAIT_L(0); PG8_MMA(0, 1, At, B1); PG8_BAR;
            PG8_LDA(At, 0, 1); PG8_STAGE(PG8_SA(0, 0), a2, voffA);
            PG8_BAR; PG8_WAIT_L(0); PG8_MMA(1, 0, At, B0); PG8_BAR; PG8_SCHED;
            PG8_STAGE(PG8_SB(0, 1), b2 + hstep, voffB);
            PG8_WAIT_V(6); PG8_BAR; PG8_MMA(1, 1, At, B1); PG8_BAR;
            PG8_LDB(B0, 1, 0); PG8_SCHED; PG8_LDA(At, 1, 0); PG8_STAGE(PG8_SA(0, 1), a2 + hstep, voffA);
            PG8_WAIT_L(8); PG8_BAR; PG8_WAIT_L(0); PG8_MMA(0, 0, At, B0); PG8_BAR; PG8_SCHED;
            PG8_LDB(B1, 1, 1); PG8_STAGE(PG8_SB(1, 0), b3, voffB);
            PG8_BAR; PG8_WAIT_L(0); PG8_MMA(0, 1, At, B1); PG8_BAR;
            PG8_LDA(At, 1, 1); PG8_STAGE(PG8_SA(1, 0), a3, voffA);
            PG8_BAR; PG8_WAIT_L(0); PG8_MMA(1, 0, At, B0); PG8_BAR; PG8_SCHED;
            PG8_STAGE(PG8_SB(1, 1), b3 + hstep, voffB);
            PG8_WAIT_V(6); PG8_BAR; PG8_MMA(1, 1, At, B1); PG8_BAR;
            }
        }
        if constexpr (ALIGN_EPI) { if (wr == 0) PG8_BAR; }
        if constexpr (!Epi::AFTER_DRAIN) { E(acc, cur, wr, wc, fr, fq); S.done(cur); }
        if (!has_next) break;
#pragma unroll
        for (int a = 0; a < 2; ++a)
#pragma unroll
            for (int b = 0; b < 2; ++b)
#pragma unroll
                for (int m = 0; m < 4; ++m)
#pragma unroll
                    for (int n = 0; n < 2; ++n) acc[a][b][m][n] = (f32x4){0.f, 0.f, 0.f, 0.f};
        cur = nxt; cA = nA; cB = nB; ++ui;
        if constexpr (ALIGN_EPI) { if (wr == 1) PG8_BAR; }
    }
    PG8_WAIT_V(0);
    if constexpr (!ALIGN_EPI) { if (wr == 0) PG8_BAR; }
    PG8_BAR;
    if constexpr (Epi::AFTER_DRAIN) { E.fused(acc, cur, wr, wc, fr, fq, lds, wid, lane); S.done(cur); }
#undef PG8_SA
#undef PG8_SB
#undef PG8_STAGE
#undef PG8_LDA
#undef PG8_LDB
#undef PG8_MMA
#undef PG8_WAIT_V
#undef PG8_WAIT_L
#undef PG8_BAR
#undef PG8_SCHED
}
}
#define GAS __attribute__((address_space(1)))
#define LAS __attribute__((address_space(3)))
typedef unsigned short bf16;
typedef unsigned v4u __attribute__((ext_vector_type(4)));
typedef float f32x4 __attribute__((ext_vector_type(4)));
typedef short bf16x8 __attribute__((ext_vector_type(8)));
typedef GAS unsigned gu32;
typedef GAS unsigned long long gu64;
#define RLX_AGENT __ATOMIC_RELAXED, __HIP_MEMORY_SCOPE_AGENT
#define LDS_WAIT() asm volatile("s_waitcnt lgkmcnt(0)" ::: "memory")
#define VM_WAIT() asm volatile("s_waitcnt vmcnt(0)" ::: "memory")
__device__ __forceinline__ unsigned long long rt() { return __builtin_amdgcn_s_memrealtime(); }
typedef float f32x2_cv __attribute__((ext_vector_type(2))); typedef __bf16 bf16x2_cv __attribute__((ext_vector_type(2)));
__device__ __forceinline__ unsigned pk2(float lo, float hi) { const f32x2_cv v = {lo, hi}; const bf16x2_cv b = __builtin_convertvector(v, bf16x2_cv); return __builtin_bit_cast(unsigned, b); }
__device__ __forceinline__ unsigned f2bf(float f) { return pk2(f, 0.f) & 0xffffu; }

#define XB_TMO      128
#define XB_XCNT(j)  (256  + 64 * (j))
#define XB_XSUB(j)  (1280 + 64 * (j))
#define XB_XGEN(j)  (2304 + 64 * (j))
#define XB_TOP      3328
#define XB_TOPGEN   3392
#define XCD_BAR_WORDS 3456
#define XB_SPIN_CAP (1u << 18)

__device__ __forceinline__ unsigned xb_ld(unsigned* p)              { return __hip_atomic_load(p, __ATOMIC_RELAXED, __HIP_MEMORY_SCOPE_AGENT); }
__device__ __forceinline__ unsigned xb_add(unsigned* p, unsigned v) { return __hip_atomic_fetch_add(p, v, __ATOMIC_RELAXED, __HIP_MEMORY_SCOPE_AGENT); }
__device__ __forceinline__ unsigned xb_xcc_id() { return (unsigned)__builtin_amdgcn_s_getreg((3 << 11) | 20) & 0xFu; }
#define XB_SPIN(cond, bar) do { unsigned _sp = 0; while (cond) { __builtin_amdgcn_s_sleep(1); \
    if ((++_sp & 255u) == 0u) { if (xb_ld(&(bar)[XB_TMO])) break; if (_sp > XB_SPIN_CAP) { atomicAdd(&(bar)[XB_TMO], 1u); break; } } } } while (0)

struct XcdBarrier {
    unsigned* bar; unsigned x;
    volatile LAS unsigned* st;
};

__device__ __forceinline__ XcdBarrier xcd_barrier_post(unsigned* bar, volatile LAS unsigned* st) {
    XcdBarrier b; b.bar = bar; b.x = xb_xcc_id(); b.st = st;
    if (threadIdx.x == 0) (void)xb_add(&bar[XB_XCNT(b.x)], 1u);
    return b;
}
__device__ __forceinline__ void xcd_barrier_complete(unsigned* bar, unsigned x, unsigned& nloc, unsigned& nx) {
    const unsigned G = gridDim.x * gridDim.y * gridDim.z;
    unsigned sum, cnt, mine, sp = 0u;
    for (;;) {
        sum = 0u; cnt = 0u; mine = 0u;
#pragma unroll
        for (unsigned j = 0; j < 16; ++j) { const unsigned c = xb_ld(&bar[XB_XCNT(j)]); sum += c; cnt += (c > 0u) ? 1u : 0u; mine = (j == x) ? c : mine; }
        if (sum == G) break;
        __builtin_amdgcn_s_sleep(1);
        if ((++sp & 255u) == 0u) { if (xb_ld(&bar[XB_TMO])) break; if (sp > XB_SPIN_CAP) { atomicAdd(&bar[XB_TMO], 1u); break; } }
    }
    nloc = mine > 0u ? mine : 1u; nx = cnt > 0u ? cnt : 1u;
}

__device__ __forceinline__ void xcd_barrier(const XcdBarrier& b) {
    asm volatile("s_waitcnt vmcnt(0)" ::: "memory");
    __syncthreads();
    if (threadIdx.x == 0) {
        unsigned* bar = b.bar;
        __builtin_amdgcn_s_waitcnt(0);
        unsigned nloc = b.st[0], nx = b.st[1];
        if (nloc == 0u) { xcd_barrier_complete(bar, b.x, nloc, nx); b.st[0] = nloc; b.st[1] = nx; }
        const unsigned old = xb_add(&bar[XB_XSUB(b.x)], 1u);
        const unsigned gen = old / nloc;
        if (old + 1u == (gen + 1u) * nloc) {
            __builtin_amdgcn_fence(__ATOMIC_RELEASE, "agent");
            asm volatile("s_waitcnt vmcnt(0)" ::: "memory");
            const unsigned og = xb_add(&bar[XB_TOP], 1u);
            const unsigned tg = og / nx;
            if (og + 1u == (tg + 1u) * nx) xb_add(&bar[XB_TOPGEN], 1u);
            else XB_SPIN(xb_ld(&bar[XB_TOPGEN]) == tg, bar);
            __builtin_amdgcn_fence(__ATOMIC_ACQUIRE, "agent");
            xb_add(&bar[XB_XGEN(b.x)], 1u);
            asm volatile("s_waitcnt vmcnt(0)" ::: "memory");
        } else {
            XB_SPIN(xb_ld(&bar[XB_XGEN(b.x)]) == gen, bar);
            __builtin_amdgcn_fence(__ATOMIC_ACQUIRE, "agent");
            asm volatile("s_waitcnt vmcnt(0)" ::: "memory");
        }
    }
    __syncthreads();
}
constexpr int NWAVES = 8;
constexpr int T = 32768, D = 1024, SEQ = 4096;
constexpr float EPS = 1e-6f;
constexpr float LAMBDA_INIT = 0.35550906759f;
constexpr size_t MiB = 1u << 20;
constexpr size_t WS_CTL = 0, CTL_ZERO_BYTES = 1 * MiB;
constexpr size_t WS_ROPE = 1 * MiB;
constexpr size_t WS_WIN = 4 * MiB;
constexpr size_t WS_WO0 = 11 * MiB, WS_WQ0 = 13 * MiB, WS_KEY0 = 17 * MiB, WS_WQKV = 18 * MiB, WS_WO1 = 24 * MiB, WS_WQ1 = 26 * MiB, WS_KEY1 = 30 * MiB;
constexpr size_t WS_SC = 31 * MiB;
constexpr size_t WS_U0 = 32 * MiB, WS_V0T = 48 * MiB, WS_U1 = 64 * MiB, WS_V1T = 80 * MiB;
constexpr size_t WS_B0 = 96 * MiB;
constexpr size_t WS_R1 = 160 * MiB, WS_R2 = 224 * MiB, WS_R3 = 288 * MiB, WS_R4 = 352 * MiB, WS_R5 = 416 * MiB, WS_GATES = 480 * MiB;
constexpr size_t WS_END = 484 * MiB;
constexpr int CW_BAR = 4096;
constexpr int LDS_BYTES = 147456, MISC_OFF = LDS_BYTES - 128;

typedef float f32x16 __attribute__((ext_vector_type(16)));
typedef unsigned u32x2 __attribute__((ext_vector_type(2)));
typedef __bf16 bf16x2_t __attribute__((ext_vector_type(2)));
__device__ __forceinline__ float bf_lo(unsigned w) { return __uint_as_float(w << 16); }
__device__ __forceinline__ float bf_hi(unsigned w) { return __uint_as_float(w & 0xffff0000u); }
__device__ __forceinline__ float dot2(unsigned a, unsigned b, float c) { return __builtin_amdgcn_fdot2_f32_bf16(__builtin_bit_cast(bf16x2_t, a), __builtin_bit_cast(bf16x2_t, b), c, false); }
__device__ __forceinline__ float wave_sum(float v) {
#pragma unroll
    for (int o = 1; o < 64; o <<= 1) v += __shfl_xor(v, o);
    return v;
}
__device__ __forceinline__ f32x4 mfma16(bf16x8 a, bf16x8 b, f32x4 c) { return __builtin_amdgcn_mfma_f32_16x16x32_bf16(a, b, c, 0, 0, 0); }
__device__ __forceinline__ f32x16 mfma32(bf16x8 a, bf16x8 b, f32x16 c) { return __builtin_amdgcn_mfma_f32_32x32x16_bf16(a, b, c, 0, 0, 0); }
__device__ __forceinline__ u32x2 pack4(float a, float b, float c, float d) { u32x2 r; r.x = pk2(a, b); r.y = pk2(c, d); return r; }

__device__ __forceinline__ void p0_transpose_item(const float* W, int K, int N, bf16* WT, LAS float* scr, int item, int lane) {
    const int nblk = N / 32, kb = item / nblk, nb = item % nblk, k0 = 64 * kb, n0 = 32 * nb;
#pragma unroll 8
    for (int i = 0; i < 32; ++i) { const int kk = 2 * i + (lane >> 5); scr[kk * 33 + (lane & 31)] = W[(size_t)(k0 + kk) * N + n0 + (lane & 31)]; }
    LDS_WAIT(); asm volatile("" ::: "memory");
    const int c = lane & 7;
#pragma unroll
    for (int j = 0; j < 4; ++j) { const int n = (lane >> 3) + 8 * j; const LAS float* s = scr + (8 * c) * 33 + n;
        v4u o; o.x = pk2(s[0 * 33], s[1 * 33]); o.y = pk2(s[2 * 33], s[3 * 33]); o.z = pk2(s[4 * 33], s[5 * 33]); o.w = pk2(s[6 * 33], s[7 * 33]);
        *(v4u*)(WT + (size_t)(n0 + n) * K + k0 + 8 * c) = o; }
    LDS_WAIT(); asm volatile("" ::: "memory");
}
__device__ __forceinline__ void cvt_range(const float* src, bf16* dst, size_t n, size_t gtid, size_t gthreads) {
    for (size_t i = gtid * 8; i < n; i += gthreads * 8) {
        const f32x4 a = *(const f32x4*)(src + i), b = *(const f32x4*)(src + i + 4);
        v4u o; o.x = pk2(a.x, a.y); o.y = pk2(a.z, a.w); o.z = pk2(b.x, b.y); o.w = pk2(b.z, b.w);
        *(v4u*)(dst + i) = o; }
}
__device__ __forceinline__ void rms_row_to_bf16(const float* xrow, const float* g, bf16* orow, int lane) {
    const f32x4* xr = (const f32x4*)xrow + lane; const f32x4* gr = (const f32x4*)g + lane;
    f32x4 v[4]; float s = 0.f;
#pragma unroll
    for (int j = 0; j < 4; ++j) { v[j] = xr[64 * j]; s += (v[j].x * v[j].x + v[j].y * v[j].y) + (v[j].z * v[j].z + v[j].w * v[j].w); }
    const float rstd = rsqrtf(wave_sum(s) * (1.f / 1024.f) + EPS);
    unsigned long long* o8 = (unsigned long long*)orow + lane;
#pragma unroll
    for (int j = 0; j < 4; ++j) { const f32x4 gg = gr[64 * j];
        o8[64 * j] = (unsigned long long)pk2(v[j].x * rstd * gg.x, v[j].y * rstd * gg.y) | ((unsigned long long)pk2(v[j].z * rstd * gg.z, v[j].w * rstd * gg.w) << 32); }
}
__device__ __forceinline__ void rms_pass(const float* X, const float* g, bf16* XN, int gw, int NGW, int lane) {
    for (int m = gw; m < T; m += NGW) rms_row_to_bf16(X + (size_t)m * D, g, XN + (size_t)m * D, lane);
}

__device__ __forceinline__ float logsigmoid_f(float f) { return fminf(f, 0.f) - log1pf(__expf(-fabsf(f))); }
#define ML_LOAD(ci_) do { const size_t r_ = rowbase + (size_t)(ci_) * 64 + lane; \
    rq = *(const v4u*)(Q0 + r_ * 64 + 8 * w); rk = *(const v4u*)(K0 + r_ * 64 + 8 * w); rv0 = *(const v4u*)(V0 + r_ * 128 + 16 * w); rv1 = *(const v4u*)(V0 + r_ * 128 + 16 * w + 8); \
    const size_t gm_ = ((size_t)b * 4096 + (size_t)(ci_) * 64 + jr) * 32; rli = GATES[gm_ + (dir ? 16 : 0) + h]; rf = GATES[gm_ + (dir ? 24 : 8) + h]; } while (0)
__device__ __forceinline__ void mlstm_phase(LAS unsigned char* lds, const bf16* Q0, const bf16* K0, const bf16* V0, const float* GATES, bf16* HF, bf16* HB) {
    const int bx = blockIdx.x;
    if ((bx >> 3) & 1) return;
    const int seq = (bx >> 4) * 8 + (bx & 7);
    const int dir = seq & 1, bh = seq >> 1, b = bh >> 3, h = bh & 7;
    int tid_ = threadIdx.x; asm volatile("" : "+v"(tid_)); const int tid = tid_, lane = tid & 63, w = __builtin_amdgcn_readfirstlane(tid >> 6), fr = lane & 15, fq = lane >> 4;
    LAS bf16* Qs = (LAS bf16*)(lds); LAS bf16* Ks = (LAS bf16*)(lds + 9216); LAS bf16* Kwt = (LAS bf16*)(lds + 18432); LAS bf16* Ps = (LAS bf16*)(lds + 27648);
    LAS bf16* Vt = (LAS bf16*)(lds + 36864 + w * 2304); LAS bf16* Cs = (LAS bf16*)(lds + 55296 + w * 2304); LAS bf16* nb = (LAS bf16*)(lds + 73728 + w * 128);
    LAS float* gc = (LAS float*)(lds + 74752 + w * 1280); LAS float* gM = gc + 64; LAS float* gI = gc + 128; LAS float* gE = gc + 192; LAS float* gW = gc + 256;
    for (int i = lane; i < 2304 / 4; i += 64) ((LAS unsigned*)Cs)[i] = 0u;
    if (lane < 32) ((LAS unsigned*)nb)[lane] = 0u;
    f32x4 Cacc[4], Nacc[4];
#pragma unroll
    for (int i = 0; i < 4; ++i) { Cacc[i] = (f32x4){0.f, 0.f, 0.f, 0.f}; Nacc[i] = (f32x4){0.f, 0.f, 0.f, 0.f}; }
    float m = -1e30f;
    bf16* Hout = dir ? HB : HF;
    const size_t rowbase = (size_t)bh * 4096;
    const int jr = dir ? 63 - lane : lane;
    v4u rq, rk, rv0, rv1; float rli, rf;
    ML_LOAD(dir ? 63 : 0);
    const bf16x8 ones = (bf16x8){0x3F80, 0x3F80, 0x3F80, 0x3F80, 0x3F80, 0x3F80, 0x3F80, 0x3F80};
    const f32x4 z4 = (f32x4){0.f, 0.f, 0.f, 0.f};
#pragma unroll 1
    for (int step = 0; step < 64; ++step) {
        const int ci = dir ? 63 - step : step;
        const float lf = logsigmoid_f(rf);
        float bcs = lf;
#pragma unroll
        for (int d = 1; d < 64; d <<= 1) { const float t = __shfl_up(bcs, d); if (lane >= d) bcs += t; }
        const float c = rli - bcs;
        float pm = c;
#pragma unroll
        for (int d = 1; d < 64; d <<= 1) { const float t = __shfl_up(pm, d); if (lane >= d) pm = fmaxf(pm, t); }
        const float M = fmaxf(m, pm);
        const float bL = __shfl(bcs, 63), Mlast = __shfl(M, 63);
        gc[jr] = c; gM[jr] = M; gI[jr] = __expf(m - M); gE[jr] = __expf(-(bcs + M)); gW[jr] = __expf(c - Mlast);
        const float sp = __expf(m - Mlast), m_new = bL + Mlast;
        const float wr_ = gW[lane];
        *(LAS v4u*)(Qs + lane * 72 + 8 * w) = rq; *(LAS v4u*)(Ks + lane * 72 + 8 * w) = rk;
#pragma unroll
        for (int i = 0; i < 4; ++i) { const unsigned kw = rk[i]; Kwt[(8 * w + 2 * i) * 72 + lane] = (bf16)f2bf(bf_lo(kw) * wr_); Kwt[(8 * w + 2 * i + 1) * 72 + lane] = (bf16)f2bf(bf_hi(kw) * wr_); }
#pragma unroll
        for (int i = 0; i < 4; ++i) { Vt[(2 * i) * 72 + lane] = (bf16)(rv0[i] & 0xffffu); Vt[(2 * i + 1) * 72 + lane] = (bf16)(rv0[i] >> 16);
                                      Vt[(8 + 2 * i) * 72 + lane] = (bf16)(rv1[i] & 0xffffu); Vt[(9 + 2 * i) * 72 + lane] = (bf16)(rv1[i] >> 16); }
        __syncthreads();
        if (step < 63) ML_LOAD(dir ? 62 - step : step + 1);
        {
            const int st = w >> 1;
            const bf16x8 a0 = *(const LAS bf16x8*)(Ks + (16 * st + fr) * 72 + 8 * fq), a1 = *(const LAS bf16x8*)(Ks + (16 * st + fr) * 72 + 32 + 8 * fq);
#pragma unroll
            for (int u = 0; u < 2; ++u) { const int tt = 2 * (w & 1) + u;
                const bf16x8 b0 = *(const LAS bf16x8*)(Qs + (16 * tt + fr) * 72 + 8 * fq), b1 = *(const LAS bf16x8*)(Qs + (16 * tt + fr) * 72 + 32 + 8 * fq);
                f32x4 acc = mfma16(a0, b0, z4); acc = mfma16(a1, b1, acc);
                const int t = 16 * tt + fr; const float Mt = gM[t]; float pv[4];
#pragma unroll
                for (int i = 0; i < 4; ++i) { const int s = 16 * st + 4 * fq + i; const bool valid = dir ? (s >= t) : (s <= t); const float e = __expf(gc[s] - Mt); pv[i] = valid ? acc[i] * e : 0.f; }
                *(LAS u32x2*)(Ps + t * 72 + 16 * st + 4 * fq) = pack4(pv[0], pv[1], pv[2], pv[3]); }
        }
        __syncthreads();
        const bf16x8 aV0 = *(const LAS bf16x8*)(Vt + fr * 72 + 8 * fq), aV1 = *(const LAS bf16x8*)(Vt + fr * 72 + 32 + 8 * fq);
        {
            const bf16x8 aC0 = *(const LAS bf16x8*)(Cs + fr * 72 + 8 * fq), aC1 = *(const LAS bf16x8*)(Cs + fr * 72 + 32 + 8 * fq);
            const bf16x8 aN0 = *(const LAS bf16x8*)(nb + 8 * fq), aN1 = *(const LAS bf16x8*)(nb + 32 + 8 * fq);
#pragma unroll
            for (int tt = 0; tt < 4; ++tt) {
                const bf16x8 bP0 = *(const LAS bf16x8*)(Ps + (16 * tt + fr) * 72 + 8 * fq), bP1 = *(const LAS bf16x8*)(Ps + (16 * tt + fr) * 72 + 32 + 8 * fq);
                const bf16x8 bQ0 = *(const LAS bf16x8*)(Qs + (16 * tt + fr) * 72 + 8 * fq), bQ1 = *(const LAS bf16x8*)(Qs + (16 * tt + fr) * 72 + 32 + 8 * fq);
                f32x4 acc1 = mfma16(aV0, bP0, z4); acc1 = mfma16(aV1, bP1, acc1);
                f32x4 acc2 = mfma16(aC0, bQ0, z4); acc2 = mfma16(aC1, bQ1, acc2);
                f32x4 d1 = mfma16(ones, bP0, z4); d1 = mfma16(ones, bP1, d1);
                f32x4 d2 = mfma16(aN0, bQ0, z4); d2 = mfma16(aN1, bQ1, d2);
                const int t = 16 * tt + fr; const float it = gI[t], en = gE[t];
                const float den = d1[0] + it * d2[0]; const float inv = 1.f / fmaxf(fabsf(den), en);
                *(u32x2*)(Hout + ((size_t)b * 4096 + (size_t)ci * 64 + t) * 1024 + h * 128 + 16 * w + 4 * fq) =
                    pack4((acc1[0] + it * acc2[0]) * inv, (acc1[1] + it * acc2[1]) * inv, (acc1[2] + it * acc2[2]) * inv, (acc1[3] + it * acc2[3]) * inv);
            }
        }
#pragma unroll
        for (int dt = 0; dt < 4; ++dt) { Cacc[dt] = Cacc[dt] * sp; Nacc[dt] = Nacc[dt] * sp;
            const bf16x8 aK0 = *(const LAS bf16x8*)(Kwt + (16 * dt + fr) * 72 + 8 * fq), aK1 = *(const LAS bf16x8*)(Kwt + (16 * dt + fr) * 72 + 32 + 8 * fq);
            Cacc[dt] = mfma16(aK0, aV0, Cacc[dt]); Cacc[dt] = mfma16(aK1, aV1, Cacc[dt]);
            Nacc[dt] = mfma16(aK0, ones, Nacc[dt]); Nacc[dt] = mfma16(aK1, ones, Nacc[dt]); }
#pragma unroll
        for (int dt = 0; dt < 4; ++dt) { *(LAS u32x2*)(Cs + fr * 72 + 16 * dt + 4 * fq) = pack4(Cacc[dt][0], Cacc[dt][1], Cacc[dt][2], Cacc[dt][3]);
                                         *(LAS u32x2*)(nb + 16 * dt + 4 * fq) = pack4(Nacc[dt][0], Nacc[dt][1], Nacc[dt][2], Nacc[dt][3]); }
        m = m_new;
        __syncthreads();
    }
}
#undef ML_LOAD

__device__ __forceinline__ void hs_pass(const bf16* HF, const bf16* HB, const bf16* OG, const float* hg, bf16* HS, int gw, int NGW, int lane) {
    for (int m = gw; m < T; m += NGW) {
        const size_t off = (size_t)m * 1024 + 16 * lane;
        const v4u f0 = *(const v4u*)(HF + off), f1 = *(const v4u*)(HF + off + 8), b0 = *(const v4u*)(HB + off), b1 = *(const v4u*)(HB + off + 8), o0 = *(const v4u*)(OG + off), o1 = *(const v4u*)(OG + off + 8);
        float x[16], og[16];
#pragma unroll
        for (int i = 0; i < 4; ++i) { x[2 * i] = bf_lo(f0[i]) + bf_lo(b0[i]); x[2 * i + 1] = bf_hi(f0[i]) + bf_hi(b0[i]); x[8 + 2 * i] = bf_lo(f1[i]) + bf_lo(b1[i]); x[9 + 2 * i] = bf_hi(f1[i]) + bf_hi(b1[i]);
                                      og[2 * i] = bf_lo(o0[i]); og[2 * i + 1] = bf_hi(o0[i]); og[8 + 2 * i] = bf_lo(o1[i]); og[9 + 2 * i] = bf_hi(o1[i]); }
        float ss = 0.f;
#pragma unroll
        for (int i = 0; i < 16; ++i) ss += x[i] * x[i];
        ss += __shfl_xor(ss, 1); ss += __shfl_xor(ss, 2); ss += __shfl_xor(ss, 4);
        const float rstd = rsqrtf(ss * (1.f / 128.f) + EPS);
        float y[16];
#pragma unroll
        for (int i = 0; i < 16; ++i) y[i] = x[i] * rstd * hg[16 * lane + i] * (1.f / (1.f + __expf(-og[i])));
        v4u w0, w1;
#pragma unroll
        for (int i = 0; i < 4; ++i) { w0[i] = pk2(y[2 * i], y[2 * i + 1]); w1[i] = pk2(y[8 + 2 * i], y[9 + 2 * i]); }
        *(v4u*)(HS + off) = w0; *(v4u*)(HS + off + 8) = w1;
    }
}

#define TK_INSERT(v, x) do { float c_ = (x); _Pragma("unroll") for (int j_ = 0; j_ < 16; ++j_) { const float h_ = fmaxf(v[j_], c_); c_ = fminf(v[j_], c_); v[j_] = h_; } } while (0)
__device__ __forceinline__ void peer_topk_phase(int vcu, const bf16* PQ, const bf16* KEYS, int* EXPERTS, float* GATESP) {
    int tid_ = threadIdx.x; asm volatile("" : "+v"(tid_)); const int tid = tid_, lane = tid & 63, w = __builtin_amdgcn_readfirstlane(tid >> 6), r32 = lane & 31, hi = lane >> 5;
    const int t = vcu * 128 + (w & 3) * 32 + r32, hg = w >> 2;
    const float NINF = -INFINITY;
#pragma unroll 1
    for (int hh = 0; hh < 4; ++hh) {
        const int head = hg * 4 + hh;
        float L0[16], L1[16];
#pragma unroll
        for (int j = 0; j < 16; ++j) { L0[j] = 0.f; L1[j] = 0.f; }
#pragma unroll 1
        for (int p = 0; p < 2; ++p) {
            const int hp = head * 2 + p;
            bf16x8 bq[8];
#pragma unroll
            for (int ks = 0; ks < 8; ++ks) bq[ks] = *(const bf16x8*)(PQ + (size_t)t * 2048 + head * 256 + p * 128 + ks * 16 + 8 * hi);
            f32x16 acc[4];
#pragma unroll
            for (int nt = 0; nt < 4; ++nt) {
#pragma unroll
                for (int r = 0; r < 16; ++r) acc[nt][r] = 0.f;
#pragma unroll
                for (int ks = 0; ks < 8; ++ks) { const bf16x8 a = *(const bf16x8*)(KEYS + ((size_t)(hp * 128 + nt * 32 + r32)) * 128 + ks * 16 + 8 * hi); acc[nt] = mfma32(a, bq[ks], acc[nt]); }
            }
            float v[16];
#pragma unroll
            for (int j = 0; j < 16; ++j) v[j] = NINF;
#pragma unroll
            for (int nt = 0; nt < 4; ++nt)
#pragma unroll
                for (int r = 0; r < 16; ++r) { const int n = nt * 32 + (r & 3) + 8 * (r >> 2) + 4 * hi;
                    const float x = __uint_as_float((__float_as_uint(acc[nt][r]) & ~0x7Fu) | (unsigned)(127 - n)); TK_INSERT(v, x); }
            float wv[16];
#pragma unroll
            for (int j = 0; j < 16; ++j) wv[j] = __shfl_xor(v[j], 32);
#pragma unroll
            for (int j = 0; j < 16; ++j) TK_INSERT(v, wv[j]);
            if (p == 0) {
#pragma unroll
                for (int j = 0; j < 16; ++j) L0[j] = v[j];
            } else {
#pragma unroll
                for (int j = 0; j < 16; ++j) L1[j] = v[j];
            }
        }
        float tv[16];
#pragma unroll
        for (int j = 0; j < 16; ++j) tv[j] = NINF;
        unsigned IA[4] = {0u, 0u, 0u, 0u}, IB[4] = {0u, 0u, 0u, 0u};
#pragma unroll
        for (int i = 0; i < 16; ++i) { IA[i >> 2] |= (127u - (__float_as_uint(L0[i]) & 0x7Fu)) << (8 * (i & 3)); IB[i >> 2] |= (127u - (__float_as_uint(L1[i]) & 0x7Fu)) << (8 * (i & 3)); }
#pragma unroll
        for (int i = 0; i < 16; ++i) {
            const float va = __uint_as_float(__float_as_uint(L0[i]) & ~0x7Fu);
#pragma unroll
            for (int j = 0; j < 16; ++j) if ((i + 1) * (j + 1) <= 16) {
                const float vb = __uint_as_float(__float_as_uint(L1[j]) & ~0x7Fu);
                const float key = __uint_as_float((__float_as_uint(va + vb) & ~0xFFu) | (unsigned)(255 - (i * 16 + j)));
                TK_INSERT(tv, key);
            }
        }
        int ti[16];
#pragma unroll
        for (int j = 0; j < 16; ++j) { const unsigned kb = __float_as_uint(tv[j]); const unsigned flat = 255u - (kb & 0xFFu); const unsigned fi = flat >> 4, fj = flat & 15u;
            const unsigned ra = (fi < 8u) ? ((fi < 4u) ? IA[0] : IA[1]) : ((fi < 12u) ? IA[2] : IA[3]);
            const unsigned rb = (fj < 8u) ? ((fj < 4u) ? IB[0] : IB[1]) : ((fj < 12u) ? IB[2] : IB[3]);
            ti[j] = (int)(((ra >> (8u * (fi & 3u))) & 0xFFu) * 128u + ((rb >> (8u * (fj & 3u))) & 0xFFu));
            tv[j] = __uint_as_float(kb & ~0xFFu); }
        float e[16], sum = 0.f;
#pragma unroll
        for (int j = 0; j < 16; ++j) { e[j] = __expf(tv[j] - tv[0]); sum += e[j]; }
        const float inv = 1.f / sum;
        if (hi == 0) { int* ep = EXPERTS + (size_t)t * 128 + head * 16;
#pragma unroll
            for (int j = 0; j < 4; ++j) *(v4u*)(ep + 4 * j) = (v4u){(unsigned)ti[4 * j], (unsigned)ti[4 * j + 1], (unsigned)ti[4 * j + 2], (unsigned)ti[4 * j + 3]}; }
        else { float* gp = GATESP + (size_t)t * 128 + head * 16;
#pragma unroll
            for (int j = 0; j < 4; ++j) *(f32x4*)(gp + 4 * j) = (f32x4){e[4 * j] * inv, e[4 * j + 1] * inv, e[4 * j + 2] * inv, e[4 * j + 3] * inv}; }
    }
}

__device__ __forceinline__ float cvt_ub0(unsigned x) { float r; asm("v_cvt_f32_ubyte0 %0, %1" : "=v"(r) : "v"(x)); return r; }
__device__ __forceinline__ float cvt_ub1(unsigned x) { float r; asm("v_cvt_f32_ubyte1 %0, %1" : "=v"(r) : "v"(x)); return r; }
__device__ __forceinline__ float cvt_ub2(unsigned x) { float r; asm("v_cvt_f32_ubyte2 %0, %1" : "=v"(r) : "v"(x)); return r; }
__device__ __forceinline__ float cvt_ub3(unsigned x) { float r; asm("v_cvt_f32_ubyte3 %0, %1" : "=v"(r) : "v"(x)); return r; }
__device__ __forceinline__ void quant4_rows(const float* src, unsigned char* dst, float* scale, int nrows, int gw, int NGW, int lane) {
    for (int r = gw; r < nrows; r += NGW) {
        const f32x4* sp = (const f32x4*)(src + (size_t)r * 1024) + 4 * lane;
        f32x4 v[4]; float am = 0.f, ss = 0.f;
#pragma unroll
        for (int j = 0; j < 4; ++j) { v[j] = sp[j]; am = fmaxf(am, fmaxf(fmaxf(fabsf(v[j].x), fabsf(v[j].y)), fmaxf(fabsf(v[j].z), fabsf(v[j].w)))); ss += (v[j].x * v[j].x + v[j].y * v[j].y) + (v[j].z * v[j].z + v[j].w * v[j].w); }
#pragma unroll
        for (int o = 1; o < 64; o <<= 1) { am = fmaxf(am, __shfl_xor(am, o)); ss += __shfl_xor(ss, o); }
        const float step = fminf(am * (1.f / 7.5f), 0.3352f * sqrtf(ss * (1.f / 1024.f)));
        const float inv = step > 0.f ? 1.f / step : 0.f;
        unsigned q[16];
#pragma unroll
        for (int j = 0; j < 4; ++j) { q[4 * j] = (unsigned)fminf(fmaxf(rintf(v[j].x * inv + 7.5f), 0.f), 15.f); q[4 * j + 1] = (unsigned)fminf(fmaxf(rintf(v[j].y * inv + 7.5f), 0.f), 15.f);
                                      q[4 * j + 2] = (unsigned)fminf(fmaxf(rintf(v[j].z * inv + 7.5f), 0.f), 15.f); q[4 * j + 3] = (unsigned)fminf(fmaxf(rintf(v[j].w * inv + 7.5f), 0.f), 15.f); }
        u32x2 w;
        w.x = (q[0] | (q[4] << 4)) | ((q[1] | (q[5] << 4)) << 8) | ((q[2] | (q[6] << 4)) << 16) | ((q[3] | (q[7] << 4)) << 24);
        w.y = (q[8] | (q[12] << 4)) | ((q[9] | (q[13] << 4)) << 8) | ((q[10] | (q[14] << 4)) << 16) | ((q[11] | (q[15] << 4)) << 24);
        *(u32x2*)(dst + (size_t)r * 512 + 8 * lane) = w;
        if (lane == 0) scale[r] = step;
    }
}

#define RED_STEP(N, S) do { const bool up_ = (lane & (S)) != 0; _Pragma("unroll") for (int j_ = 0; j_ < (N); ++j_) { const int a_ = p[j_], b_ = p[j_ + (N)]; const int send_ = up_ ? a_ : b_, keep_ = up_ ? b_ : a_; p[j_] = keep_ + __shfl_xor(send_, (S)); } } while (0)
#define RED16(dst) do { RED_STEP(8, 8); RED_STEP(4, 4); RED_STEP(2, 2); RED_STEP(1, 1); int s_ = p[0]; s_ += __shfl_xor(s_, 16); s_ += __shfl_xor(s_, 32); dst = s_; } while (0)
#define G_SB() __builtin_amdgcn_sched_barrier(0)
#define G_LOAD(buf, tab, evec, jb) do { _Pragma("unroll") for (int jj_ = 0; jj_ < 16; ++jj_) { const int e_ = __builtin_amdgcn_readlane(evec, (jb) + jj_); buf[jj_] = __builtin_amdgcn_raw_buffer_load_b64(rs_##tab, (int)voff, e_ << 9, 0); } } while (0)
#define U_COMP(buf) do { _Pragma("unroll") for (int jj_ = 0; jj_ < 16; ++jj_) { const unsigned w0_ = buf[jj_].x, w1_ = buf[jj_].y; \
    int d_ = __builtin_amdgcn_sdot4((int)(w0_ & 0x0F0F0F0Fu), hq[0], 0, false); d_ = __builtin_amdgcn_sdot4((int)((w0_ >> 4) & 0x0F0F0F0Fu), hq[1], d_, false); \
    d_ = __builtin_amdgcn_sdot4((int)(w1_ & 0x0F0F0F0Fu), hq[2], d_, false); d_ = __builtin_amdgcn_sdot4((int)((w1_ >> 4) & 0x0F0F0F0Fu), hq[3], d_, false); p[jj_] = d_; } } while (0)
#define V_DW(o0, o1, o2, o3, wd, cs) do { float t0_, t1_, t2_, t3_; asm volatile("v_cvt_f32_ubyte0 %4, %8\n\tv_cvt_f32_ubyte1 %5, %8\n\tv_cvt_f32_ubyte2 %6, %8\n\tv_cvt_f32_ubyte3 %7, %8\n\tv_fmac_f32 %0, %9, %4\n\tv_fmac_f32 %1, %9, %5\n\tv_fmac_f32 %2, %9, %6\n\tv_fmac_f32 %3, %9, %7" \
    : "+v"(o0), "+v"(o1), "+v"(o2), "+v"(o3), "=&v"(t0_), "=&v"(t1_), "=&v"(t2_), "=&v"(t3_) : "v"(wd), "s"(cs)); } while (0)
#define V_COMP(buf, cvec, jb) do { _Pragma("unroll") for (int jj_ = 0; jj_ < 16; ++jj_) { const float c_ = __uint_as_float(__builtin_amdgcn_readlane(__float_as_uint(cvec), (jb) + jj_)); const unsigned w0_ = buf[jj_].x, w1_ = buf[jj_].y; \
    V_DW(o[0], o[1], o[2], o[3], w0_ & 0x0F0F0F0Fu, c_); V_DW(o[4], o[5], o[6], o[7], (w0_ >> 4) & 0x0F0F0F0Fu, c_); V_DW(o[8], o[9], o[10], o[11], w1_ & 0x0F0F0F0Fu, c_); V_DW(o[12], o[13], o[14], o[15], (w1_ >> 4) & 0x0F0F0F0Fu, c_); } } while (0)
template <bool NEXT_NORM>
__device__ __forceinline__ void peer_gather_phase(bool dry, int vcu, const bf16* HN, const int* EXPERTS, const float* GATESP, const unsigned char* U, const float* SU, const unsigned char* Vtab, const float* SV,
                                                  float* X, const float* gnext, bf16* XN) {
    int tid_ = threadIdx.x; asm volatile("" : "+v"(tid_)); const int tid = tid_, lane = tid & 63, w = __builtin_amdgcn_readfirstlane(tid >> 6);
    const __amdgpu_buffer_rsrc_t rs_U = __builtin_amdgcn_make_buffer_rsrc((void*)U, (short)0, 16384 * 512, 0x00020000), rs_Vtab = __builtin_amdgcn_make_buffer_rsrc((void*)Vtab, (short)0, 16384 * 512, 0x00020000);
    const unsigned voff = (unsigned)lane * 8u;
    const int lg = lane >> 4;
#pragma unroll 1
    for (int i = 0; i < 16; ++i) {
        const int t = vcu * 128 + w * 16 + i;
        const int ev0 = EXPERTS[(size_t)t * 128 + lane], ev1 = EXPERTS[(size_t)t * 128 + 64 + lane];
        const float gv0 = GATESP[(size_t)t * 128 + lane], gv1 = GATESP[(size_t)t * 128 + 64 + lane];
        const v4u h0 = *(const v4u*)(HN + (size_t)t * 1024 + 16 * lane), h1 = *(const v4u*)(HN + (size_t)t * 1024 + 16 * lane + 8);
        float hf[16]; float am = 0.f;
#pragma unroll
        for (int k = 0; k < 4; ++k) { hf[2 * k] = bf_lo(h0[k]); hf[2 * k + 1] = bf_hi(h0[k]); hf[8 + 2 * k] = bf_lo(h1[k]); hf[9 + 2 * k] = bf_hi(h1[k]); }
#pragma unroll
        for (int k = 0; k < 16; ++k) am = fmaxf(am, fabsf(hf[k]));
#pragma unroll
        for (int o = 1; o < 64; o <<= 1) am = fmaxf(am, __shfl_xor(am, o));
        const float hinv = am > 0.f ? 127.f / am : 0.f, sh = am * (1.f / 127.f);
        int hq[4]; int hs = 0;
#pragma unroll
        for (int k = 0; k < 4; ++k) { const int q0 = (int)rintf(hf[4 * k] * hinv), q1 = (int)rintf(hf[4 * k + 1] * hinv), q2 = (int)rintf(hf[4 * k + 2] * hinv), q3 = (int)rintf(hf[4 * k + 3] * hinv); hs += (q0 + q1) + (q2 + q3);
            hq[k] = (int)(((unsigned)(q0 & 0xff)) | ((unsigned)(q1 & 0xff) << 8) | ((unsigned)(q2 & 0xff) << 16) | ((unsigned)(q3 & 0xff) << 24)); }
#pragma unroll
        for (int o = 1; o < 64; o <<= 1) hs += __shfl_xor(hs, o);
        const float hoff = 7.5f * (float)hs;
        const float su0 = SU[ev0], su1 = SU[ev1], sv0 = SV[ev0], sv1 = SV[ev1];
        float o[16];
#pragma unroll
        for (int k = 0; k < 16; ++k) o[k] = 0.f;
        int p[16], r0, r1, r2, r3, r4, r5, r6, r7;
        u32x2 A[16], B[16], C[16];
        G_LOAD(A, U, ev0, 0); G_LOAD(B, U, ev0, 16); G_SB();
        G_LOAD(C, U, ev0, 32); G_SB(); U_COMP(A); RED16(r0); G_SB();
        G_LOAD(A, U, ev0, 48); G_SB(); U_COMP(B); RED16(r1); G_SB();
        G_LOAD(B, U, ev1, 0); G_SB(); U_COMP(C); RED16(r2); G_SB();
        G_LOAD(C, U, ev1, 16); G_SB(); U_COMP(A); RED16(r3); G_SB();
        G_LOAD(A, U, ev1, 32); G_SB(); U_COMP(B); RED16(r4); G_SB();
        G_LOAD(B, U, ev1, 48); G_SB(); U_COMP(C); RED16(r5); G_SB();
        G_LOAD(C, Vtab, ev0, 0); G_SB(); U_COMP(A); RED16(r6); G_SB();
        G_LOAD(A, Vtab, ev0, 16); G_SB(); U_COMP(B); RED16(r7); G_SB();
        const int d0 = lg == 0 ? r0 : (lg == 1 ? r1 : (lg == 2 ? r2 : r3)), d1 = lg == 0 ? r4 : (lg == 1 ? r5 : (lg == 2 ? r6 : r7));
        float act0 = ((float)d0 - hoff) * (sh * su0), act1 = ((float)d1 - hoff) * (sh * su1);
#ifdef PROBE_NOFFN
        const float coef0 = 0.f * act0, coef1 = 0.f * act1;
#else
        const float coef0 = gv0 * (0.5f * act0 * (1.f + erff(act0 * 0.70710678118f))) * sv0, coef1 = gv1 * (0.5f * act1 * (1.f + erff(act1 * 0.70710678118f))) * sv1;
#endif
        G_SB();
        G_LOAD(B, Vtab, ev0, 32); G_SB(); V_COMP(C, coef0, 0); G_SB();
        G_LOAD(C, Vtab, ev0, 48); G_SB(); V_COMP(A, coef0, 16); G_SB();
        G_LOAD(A, Vtab, ev1, 0); G_SB(); V_COMP(B, coef0, 32); G_SB();
        G_LOAD(B, Vtab, ev1, 16); G_SB(); V_COMP(C, coef0, 48); G_SB();
        G_LOAD(C, Vtab, ev1, 32); G_SB(); V_COMP(A, coef1, 0); G_SB();
        G_LOAD(A, Vtab, ev1, 48); G_SB(); V_COMP(B, coef1, 16); G_SB();
        V_COMP(C, coef1, 32); G_SB(); V_COMP(A, coef1, 48); G_SB();
        const float corr = 7.5f * wave_sum(coef0 + coef1);
        float* xr = X + (size_t)t * 1024 + 16 * lane;
        f32x4 xv[4];
#pragma unroll
        for (int k = 0; k < 4; ++k) { xv[k] = *(const f32x4*)(xr + 4 * k); xv[k] += (f32x4){o[4 * k] - corr, o[4 * k + 1] - corr, o[4 * k + 2] - corr, o[4 * k + 3] - corr}; }
        if (!dry) {
#pragma unroll
            for (int k = 0; k < 4; ++k) *(f32x4*)(xr + 4 * k) = xv[k]; }
        if (NEXT_NORM && !dry) {
            float ss = 0.f;
#pragma unroll
            for (int k = 0; k < 4; ++k) ss += (xv[k].x * xv[k].x + xv[k].y * xv[k].y) + (xv[k].z * xv[k].z + xv[k].w * xv[k].w);
            const float rstd = rsqrtf(wave_sum(ss) * (1.f / 1024.f) + EPS);
            v4u wa, wb;
#pragma unroll
            for (int k = 0; k < 4; ++k) { const f32x4 g = *(const f32x4*)(gnext + 16 * lane + 4 * k); const unsigned lo = pk2(xv[k].x * rstd * g.x, xv[k].y * rstd * g.y), hi2 = pk2(xv[k].z * rstd * g.z, xv[k].w * rstd * g.w);
                if (k < 2) { wa[2 * k] = lo; wa[2 * k + 1] = hi2; } else { wb[2 * (k - 2)] = lo; wb[2 * (k - 2) + 1] = hi2; } }
            *(v4u*)(XN + (size_t)t * 1024 + 16 * lane) = wa; *(v4u*)(XN + (size_t)t * 1024 + 16 * lane + 8) = wb;
        }
    }
}

__device__ __forceinline__ void qknorm_rope_pass(bf16* Q1, bf16* K1, const float* qg, const float* kg, const float* rope, size_t gtid, size_t gthreads) {
    const size_t NROWS = (size_t)2 * 64 * 2 * 4096;
    for (size_t id = gtid; id < NROWS * 8; id += gthreads) {
        const size_t rowg = id >> 3; const int part = (int)(id & 7);
        const bool isk = rowg >= NROWS / 2; const size_t row = isk ? rowg - NROWS / 2 : rowg;
        bf16* ptr = (isk ? K1 : Q1) + row * 64 + part * 8; const float* g = (isk ? kg : qg) + part * 8;
        const int s = (int)(row & 4095); const int bh = (int)(row >> 13); const int bidx = bh >> 3; const size_t mtok = (size_t)bidx * 4096 + s;
        const v4u raw = *(const v4u*)ptr;
        float x[8];
#pragma unroll
        for (int i = 0; i < 4; ++i) { x[2 * i] = bf_lo(raw[i]); x[2 * i + 1] = bf_hi(raw[i]); }
        float ss = 0.f;
#pragma unroll
        for (int i = 0; i < 8; ++i) ss += x[i] * x[i];
        ss += __shfl_xor(ss, 1); ss += __shfl_xor(ss, 2); ss += __shfl_xor(ss, 4);
        const float rstd = rsqrtf(ss * (1.f / 64.f) + EPS);
        float y[8], other[8];
#pragma unroll
        for (int i = 0; i < 8; ++i) y[i] = x[i] * rstd * g[i];
#pragma unroll
        for (int i = 0; i < 8; ++i) other[i] = __shfl_xor(y[i], 1);
        if (part < 2) { const float* cs = rope + mtok * 16;
#pragma unroll
            for (int i = 0; i < 8; ++i) { const float co = cs[i], si = cs[8 + i]; y[i] = (part == 0) ? (y[i] * co - other[i] * si) : (y[i] * co + other[i] * si); } }
        const float sc = isk ? 1.f : (0.125f * 1.44269504089f);
        v4u o;
#pragma unroll
        for (int i = 0; i < 4; ++i) o[i] = pk2(y[2 * i] * sc, y[2 * i + 1] * sc);
        *(v4u*)ptr = o;
    }
}

#define AT_LOAD(kt_) do { _Pragma("unroll") for (int i_ = 0; i_ < 2; ++i_) { rK[i_] = *(const v4u*)(K1 + ((size_t)((bh * 2 + i_) * 4096 + (kt_) * 64 + (tid >> 3))) * 64 + (tid & 7) * 8); \
        rV[i_] = *(const v4u*)(V1 + ((size_t)(bh * 4096 + (kt_) * 64 + lane)) * 128 + (2 * w + i_) * 8); } } while (0)
#define AT_WRITE(buf_) do { _Pragma("unroll") for (int i_ = 0; i_ < 2; ++i_) { *(LAS v4u*)(lds + (buf_) * 35840 + i_ * 9216 + ((tid >> 3) * 72 + (tid & 7) * 8) * 2) = rK[i_]; \
        LAS bf16* vt_ = (LAS bf16*)(lds + (buf_) * 35840 + 18432) + ((2 * w + i_) * 8) * 68 + lane; \
        _Pragma("unroll") for (int e_ = 0; e_ < 4; ++e_) { vt_[(2 * e_) * 68] = (bf16)(rV[i_][e_] & 0xffffu); vt_[(2 * e_ + 1) * 68] = (bf16)(rV[i_][e_] >> 16); } } } while (0)
__device__ __forceinline__ void attn_phase(LAS unsigned char* lds, int vcu, const bf16* Q1, const bf16* K1, const bf16* V1, bf16* O, const float* qg, const float* kg,
                                           const float* lq1, const float* lk1, const float* lq2, const float* lk2, const float* subln) {
    int tid_ = threadIdx.x; asm volatile("" : "+v"(tid_)); const int tid = tid_, lane = tid & 63, w = __builtin_amdgcn_readfirstlane(tid >> 6), r32 = lane & 31, hi = lane >> 5, qt = w & 3, c = w >> 2;
    float s1 = 0.f, s2 = 0.f, mq = 0.f, mk = 0.f;
    for (int i = 0; i < 64; ++i) { s1 += lq1[i] * lk1[i]; s2 += lq2[i] * lk2[i]; mq = fmaxf(mq, fabsf(qg[i])); mk = fmaxf(mk, fabsf(kg[i])); }
    const float lam = expf(s1) - expf(s2) + LAMBDA_INIT;
    const float offs = 8.f * mq * mk * 1.44269504089f * 1.02f + 0.25f;
    f32x16 cinit;
#pragma unroll
    for (int r = 0; r < 16; ++r) cinit[r] = -offs;
    LAS float* lbuf = (LAS float*)(lds + 135168 + w * 128);
    LAS float* Obuf = (LAS float*)lds;
#pragma unroll 1
    for (int ui = 0; ui < 8; ++ui) {
        const int uid = vcu * 8 + ui, bh = uid >> 5, qb = uid & 31, b = bh >> 3, h = bh & 7;
        bf16x8 bq[4];
#pragma unroll
        for (int ks = 0; ks < 4; ++ks) bq[ks] = *(const bf16x8*)(Q1 + ((size_t)((bh * 2 + c) * 4096 + qb * 128 + qt * 32 + r32)) * 64 + ks * 16 + 8 * hi);
        f32x16 Oa[4];
#pragma unroll
        for (int db = 0; db < 4; ++db)
#pragma unroll
            for (int r = 0; r < 16; ++r) Oa[db][r] = 0.f;
        float lsum = 0.f;
        v4u rK[2], rV[2];
        AT_LOAD(0); AT_WRITE(0); AT_LOAD(1);
        __syncthreads();
#pragma unroll 1
        for (int kt = 0; kt < 64; ++kt) {
            const int buf = kt & 1;
            if (kt + 1 < 64) AT_WRITE(buf ^ 1);
            if (kt + 2 < 64) AT_LOAD(kt + 2);
            const LAS bf16* Kc = (const LAS bf16*)(lds + buf * 35840 + c * 9216);
            const LAS bf16* Vt = (const LAS bf16*)(lds + buf * 35840 + 18432);
            f32x16 p0 = cinit, p1 = cinit;
#pragma unroll
            for (int ks = 0; ks < 4; ++ks) { const bf16x8 a0 = *(const LAS bf16x8*)(Kc + r32 * 72 + ks * 16 + 8 * hi), a1 = *(const LAS bf16x8*)(Kc + (32 + r32) * 72 + ks * 16 + 8 * hi);
                p0 = mfma32(a0, bq[ks], p0); p1 = mfma32(a1, bq[ks], p1); }
            float ls = 0.f;
#pragma unroll
            for (int r = 0; r < 16; ++r) { p0[r] = __builtin_amdgcn_exp2f(p0[r]); p1[r] = __builtin_amdgcn_exp2f(p1[r]); ls += p0[r] + p1[r]; }
            lsum += ls;
            bf16x8 pa[4];
            { v4u t0, t1, t2, t3;
#pragma unroll
              for (int k = 0; k < 4; ++k) { t0[k] = pk2(p0[2 * k], p0[2 * k + 1]); t1[k] = pk2(p0[8 + 2 * k], p0[9 + 2 * k]); t2[k] = pk2(p1[2 * k], p1[2 * k + 1]); t3[k] = pk2(p1[8 + 2 * k], p1[9 + 2 * k]); }
              pa[0] = __builtin_bit_cast(bf16x8, t0); pa[1] = __builtin_bit_cast(bf16x8, t1); pa[2] = __builtin_bit_cast(bf16x8, t2); pa[3] = __builtin_bit_cast(bf16x8, t3); }
#pragma unroll
            for (int sp_ = 0; sp_ < 4; ++sp_)
#pragma unroll
                for (int db = 0; db < 4; ++db) { const LAS bf16* vp = Vt + (32 * db + r32) * 68 + 16 * sp_ + 4 * hi;
                    const u32x2 lo = *(const LAS u32x2*)vp, hh = *(const LAS u32x2*)(vp + 8);
                    const v4u vv = (v4u){lo.x, lo.y, hh.x, hh.y};
                    Oa[db] = mfma32(pa[sp_], __builtin_bit_cast(bf16x8, vv), Oa[db]); }
            __syncthreads();
        }
        lsum += __shfl_xor(lsum, 32);
        lbuf[r32] = lsum;
#pragma unroll
        for (int r = 0; r < 16; ++r) { const int qrow = (r & 3) + 8 * (r >> 2) + 4 * hi; const float inv = 1.f / lbuf[qrow];
#pragma unroll
            for (int db = 0; db < 4; ++db) Obuf[(c * 128 + qt * 32 + qrow) * 132 + 32 * db + r32] = Oa[db][r] * inv; }
        __syncthreads();
        { const int row = tid >> 2, qd = tid & 3;
          float dv[32]; float ss = 0.f;
#pragma unroll
          for (int k = 0; k < 8; ++k) { const f32x4 o0 = *(const LAS f32x4*)(Obuf + row * 132 + qd * 32 + 4 * k), o1 = *(const LAS f32x4*)(Obuf + (128 + row) * 132 + qd * 32 + 4 * k);
#pragma unroll
              for (int e = 0; e < 4; ++e) { const float d = o0[e] - lam * o1[e]; dv[4 * k + e] = d; ss += d * d; } }
          ss += __shfl_xor(ss, 1); ss += __shfl_xor(ss, 2);
          const float rstd = rsqrtf(ss * (1.f / 128.f) + EPS) * (1.f - LAMBDA_INIT);
          bf16* op = O + ((size_t)b * 4096 + qb * 128 + row) * 1024 + h * 128 + qd * 32;
#pragma unroll
          for (int k = 0; k < 4; ++k) { v4u o;
#pragma unroll
              for (int e = 0; e < 4; ++e) o[e] = pk2(dv[8 * k + 2 * e] * rstd * subln[qd * 32 + 8 * k + 2 * e], dv[8 * k + 2 * e + 1] * rstd * subln[qd * 32 + 8 * k + 2 * e + 1]);
              *(v4u*)(op + 8 * k) = o; } }
        __syncthreads();
    }
}
#undef AT_LOAD
#undef AT_WRITE
struct Args { const void* in[27]; float* out; unsigned char* ws; };
#define KARG(i) ({ GAS const void* p_; asm volatile("s_load_dwordx2 %0, %1, %2\n\ts_waitcnt lgkmcnt(0)" : "=s"(p_) : "s"(__builtin_amdgcn_kernarg_segment_ptr()), "i"(8 * (i))); (const void*)p_; })
#define KIN(i) ((const float*)KARG(i))
#define KOUT() ((float*)KARG(27))
#define KWS() ((unsigned char*)KARG(28))
#define WSP(T_, off) ((T_*)(KWS() + (off)))
__global__ void __launch_bounds__(NWAVES * 64, 2) mk_fwd(Args args) {
    extern __shared__ __attribute__((aligned(16))) unsigned char lds_raw[];
    LAS unsigned char* lds = (LAS unsigned char*)lds_raw;
    const int G = gridDim.x, bx = blockIdx.x;
    const int vcu = (G % 8 == 0) ? (bx % 8) * (G / 8) + bx / 8 : bx;
#define PH_IDS() int tid_ = threadIdx.x; asm volatile("" : "+v"(tid_)); const int tid = tid_, lane = tid & 63, wave = __builtin_amdgcn_readfirstlane(tid >> 6); \
    const int gw = vcu * NWAVES + wave, NGW = G * NWAVES; const size_t gtid = (size_t)vcu * (NWAVES * 64) + tid, gthreads = (size_t)G * (NWAVES * 64); (void)lane; (void)gw; (void)NGW; (void)gtid; (void)gthreads
    if (threadIdx.x < 32) ((LAS unsigned*)(lds + MISC_OFF))[threadIdx.x] = 0u;
    __syncthreads();
    (void)xcd_barrier_post((unsigned*)(WSP(gu32, WS_CTL) + CW_BAR), (volatile LAS unsigned*)(lds + MISC_OFF) + 8);
#define STAMP() do {} while (0)
#ifndef PROBE_DUP
#define PROBE_DUP 0
#endif
#define REPS(bit) _Pragma("unroll 1") for (int rep_ = 0; rep_ < 1 + ((PROBE_DUP >> (bit)) & 1); ++rep_)
#define GRID_BAR() do { XcdBarrier b_; b_.bar = (unsigned*)(WSP(gu32, WS_CTL) + CW_BAR); b_.x = xb_xcc_id(); b_.st = (volatile LAS unsigned*)(lds + MISC_OFF) + 8; xcd_barrier(b_); STAMP(); } while (0)

    REPS(5) {
        PH_IDS();
        LAS float* scr = (LAS float*)(lds + wave * 16384);
        constexpr int I0 = 16 * 97, I1 = 16 * 32, I2 = 16 * 64, I3 = 16 * 96, I4 = 16 * 32, I5 = 16 * 64, NITEMS = I0 + I1 + I2 + I3 + I4 + I5;
        for (int it = gw; it < NITEMS; it += NGW) {
            int r = it;
            if (r < I0) { p0_transpose_item(KIN(3), 1024, 3104, WSP(bf16, WS_WIN), scr, r, lane); continue; } r -= I0;
            if (r < I1) { p0_transpose_item(KIN(6), 1024, 1024, WSP(bf16, WS_WO0), scr, r, lane); continue; } r -= I1;
            if (r < I2) { p0_transpose_item(KIN(8), 1024, 2048, WSP(bf16, WS_WQ0), scr, r, lane); continue; } r -= I2;
            if (r < I3) { p0_transpose_item(KIN(13), 1024, 3072, WSP(bf16, WS_WQKV), scr, r, lane); continue; } r -= I3;
            if (r < I4) { p0_transpose_item(KIN(21), 1024, 1024, WSP(bf16, WS_WO1), scr, r, lane); continue; } r -= I4;
            p0_transpose_item(KIN(23), 1024, 2048, WSP(bf16, WS_WQ1), scr, r, lane);
        }
        { bf16* WIN = WSP(bf16, WS_WIN); for (size_t i = gtid * 8; i < (size_t)224 * 1024; i += gthreads * 8) *(v4u*)(WIN + (size_t)3104 * 1024 + i) = (v4u){0u, 0u, 0u, 0u}; }
        cvt_range(KIN(9), WSP(bf16, WS_KEY0), (size_t)262144, gtid, gthreads);
        cvt_range(KIN(24), WSP(bf16, WS_KEY1), (size_t)262144, gtid, gthreads);
        quant4_rows(KIN(10), WSP(unsigned char, WS_U0), WSP(float, WS_SC), 16384, gw, NGW, lane);
        quant4_rows(KIN(11), WSP(unsigned char, WS_V0T), WSP(float, WS_SC + 65536), 16384, gw, NGW, lane);
        quant4_rows(KIN(25), WSP(unsigned char, WS_U1), WSP(float, WS_SC + 2 * 65536), 16384, gw, NGW, lane);
        quant4_rows(KIN(26), WSP(unsigned char, WS_V1T), WSP(float, WS_SC + 3 * 65536), 16384, gw, NGW, lane);
        rms_pass(KIN(0), KIN(2), WSP(bf16, WS_B0), gw, NGW, lane);
        { const int* positions = (const int*)KARG(1); float* ROPE = WSP(float, WS_ROPE);
          for (size_t id = gtid; id < (size_t)T * 8; id += gthreads) { const size_t mtok = id >> 3; const int i = (int)(id & 7);
            const float inv = powf(500000.0f, -(float)i * 2.0f / 16.0f); const float ang = (float)positions[mtok] * inv;
            float sn, cs; sincosf(ang, &sn, &cs); ROPE[mtok * 16 + i] = cs; ROPE[mtok * 16 + 8 + i] = sn; } }
    }
    GRID_BAR();
    REPS(3) {
        unsigned char* ws = KWS();
        pg8::Gemm g{(const bf16*)(ws + WS_B0), (const bf16*)(ws + WS_WIN), T, 3328, 1024}; pg8::StaticOrder S; S.init(T, 3328, G, bx);
        pg8::EpiInProj E{(bf16*)(ws + WS_R1), (bf16*)(ws + WS_R1 + 32 * MiB), (bf16*)(ws + WS_R2), (bf16*)(ws + WS_R3), (float*)(ws + WS_GATES), KIN(4)};
        pg8::gemm_phase<pg8::EpiInProj, pg8::StaticOrder, true, true>(lds, g, S, E);
    }
    GRID_BAR();
    REPS(2) { unsigned char* ws = KWS(); mlstm_phase(lds, (const bf16*)(ws + WS_R1), (const bf16*)(ws + WS_R1 + 32 * MiB), (const bf16*)(ws + WS_R2), (const float*)(ws + WS_GATES), (bf16*)(ws + WS_R4), (bf16*)(ws + WS_R5)); }
    GRID_BAR();
    { PH_IDS(); unsigned char* ws = KWS(); hs_pass((const bf16*)(ws + WS_R4), (const bf16*)(ws + WS_R5), (const bf16*)(ws + WS_R3), KIN(5), (bf16*)(ws + WS_B0), gw, NGW, lane); }
    GRID_BAR();
#pragma unroll 1
    for (int L = 0; L < 2; ++L) {
        if (L == 1) {
            REPS(3) {
                unsigned char* ws = KWS();
                pg8::Gemm g{(const bf16*)(ws + WS_B0), (const bf16*)(ws + WS_WQKV), T, 3072, 1024}; pg8::StaticOrder S; S.init(T, 3072, G, bx);
                pg8::EpiQKV E{(bf16*)(ws + WS_R2), (bf16*)(ws + WS_R3), (bf16*)(ws + WS_R4)};
                pg8::gemm_phase<pg8::EpiQKV, pg8::StaticOrder, true, true>(lds, g, S, E);
            }
            GRID_BAR();
            { PH_IDS(); unsigned char* ws = KWS(); qknorm_rope_pass((bf16*)(ws + WS_R2), (bf16*)(ws + WS_R3), KIN(14), KIN(15), (const float*)(ws + WS_ROPE), gtid, gthreads); }
            GRID_BAR();
            REPS(0) { unsigned char* ws = KWS(); attn_phase(lds, vcu, (const bf16*)(ws + WS_R2), (const bf16*)(ws + WS_R3), (const bf16*)(ws + WS_R4), (bf16*)(ws + WS_B0), KIN(14), KIN(15), KIN(16), KIN(17), KIN(18), KIN(19), KIN(20)); }
            GRID_BAR();
        }
        _Pragma("unroll 1") for (int rep_ = 0; rep_ < 1 + ((L == 0) ? ((PROBE_DUP >> 3) & 1) : 0); ++rep_) {
            unsigned char* ws = KWS(); float* out = KOUT();
            pg8::Gemm g{(const bf16*)(ws + WS_B0), (const bf16*)(ws + (L ? WS_WO1 : WS_WO0)), T, 1024, 1024}; pg8::StaticOrder S; S.init(T, 1024, G, bx);
            pg8::EpiRes E{L ? (const float*)out : KIN(0), out};
            pg8::gemm_phase<pg8::EpiRes, pg8::StaticOrder, true, true>(lds, g, S, E);
        }
        GRID_BAR();
        { PH_IDS(); rms_pass(KOUT(), L ? KIN(22) : KIN(7), WSP(bf16, WS_B0), gw, NGW, lane); }
        GRID_BAR();
        REPS(3) {
            unsigned char* ws = KWS();
            pg8::Gemm g{(const bf16*)(ws + WS_B0), (const bf16*)(ws + (L ? WS_WQ1 : WS_WQ0)), T, 2048, 1024}; pg8::StaticOrder S; S.init(T, 2048, G, bx);
            pg8::EpiPlain E{(bf16*)(ws + WS_R2), 2048};
            pg8::gemm_phase<pg8::EpiPlain, pg8::StaticOrder, true, true>(lds, g, S, E);
        }
        GRID_BAR();
        REPS(4) { unsigned char* ws = KWS(); peer_topk_phase(vcu, (const bf16*)(ws + WS_R2), (const bf16*)(ws + (L ? WS_KEY1 : WS_KEY0)), (int*)(ws + WS_R4), (float*)(ws + WS_R4 + 16 * MiB)); }
        GRID_BAR();
        if (L == 0) { unsigned char* ws = KWS();
            if ((PROBE_DUP >> 1) & 1) peer_gather_phase<true>(gridDim.y == 1, vcu, (const bf16*)(ws + WS_B0), (const int*)(ws + WS_R4), (const float*)(ws + WS_R4 + 16 * MiB), ws + WS_U0, (const float*)(ws + WS_SC), ws + WS_V0T, (const float*)(ws + WS_SC + 65536), KOUT(), KIN(12), (bf16*)(ws + WS_B0));
            peer_gather_phase<true>(false, vcu, (const bf16*)(ws + WS_B0), (const int*)(ws + WS_R4), (const float*)(ws + WS_R4 + 16 * MiB), ws + WS_U0, (const float*)(ws + WS_SC), ws + WS_V0T, (const float*)(ws + WS_SC + 65536), KOUT(), KIN(12), (bf16*)(ws + WS_B0)); GRID_BAR(); }
        else { unsigned char* ws = KWS(); peer_gather_phase<false>(false, vcu, (const bf16*)(ws + WS_B0), (const int*)(ws + WS_R4), (const float*)(ws + WS_R4 + 16 * MiB), ws + WS_U1, (const float*)(ws + WS_SC + 2 * 65536), ws + WS_V1T, (const float*)(ws + WS_SC + 3 * 65536), KOUT(), nullptr, nullptr); }
    }
#undef GRID_BAR
}

extern "C" void kernel_launch(void* const* d_in, const int* in_sizes, int n_in, void* d_out, int out_size, void* d_ws, size_t ws_size, hipStream_t stream) {
    static int ready = 0;
    if (ready == 0) {
        if (n_in != 27 || out_size != T * D || ws_size < WS_END) { fprintf(stderr, "kernel_launch: unexpected problem (n_in %d, out %d, ws %zu)\n", n_in, out_size, ws_size); ready = -1; return; }
        if (hipFuncSetAttribute((const void*)mk_fwd, hipFuncAttributeMaxDynamicSharedMemorySize, LDS_BYTES) != hipSuccess) { fprintf(stderr, "kernel_launch: hipFuncSetAttribute failed\n"); ready = -1; return; }
        (void)hipGetLastError();
        ready = 1;
    }
    if (ready < 0) return;
    if (hipMemsetAsync((char*)d_ws + WS_CTL, 0, CTL_ZERO_BYTES, stream) != hipSuccess) { fprintf(stderr, "kernel_launch: memset failed\n"); return; }
    Args a{};
    for (int i = 0; i < 27; ++i) a.in[i] = d_in[i];
    a.out = (float*)d_out; a.ws = (unsigned char*)d_ws;
    hipLaunchKernelGGL(mk_fwd, dim3(256), dim3(NWAVES * 64), LDS_BYTES, stream, a);
}
```

```cpp
#include <hip/hip_runtime.h>
#include <hip/hip_bf16.h>
#include <cstdio>
#include <cstdint>
#include <cmath>
namespace pg8 {
#define PG8_LAS __attribute__((address_space(3)))
typedef unsigned short bf16_t;
typedef short bf16x8 __attribute__((ext_vector_type(8)));
typedef float f32x4 __attribute__((ext_vector_type(4)));
typedef unsigned u32x4 __attribute__((ext_vector_type(4)));
constexpr int BM = 256, BK = 64, HALF = 128, HTB = HALF * BK * 2  , STAGE_BYTES = 8 * HTB, NXCD = 8, WGM = 8;

__host__ __device__ __forceinline__ int lds_byte(int r, int c) { const int st = (r >> 4) * 2 + (c >> 5), rr = r & 15, cc = c & 31, ob = rr * 64 + cc * 2; return st * 1024 + (ob ^ (((ob >> 9) & 1) << 5)); }
__host__ __device__ __forceinline__ void stage_rc(int b, int& R, int& C) { const int st = b / 1024, sb = b % 1024, swz = sb ^ (((sb >> 9) & 1) << 5); R = (st >> 1) * 16 + swz / 64; C = (st & 1) * 32 + (swz % 64) / 2; }
__host__ __device__ __forceinline__ int perm32(int rho) { const int n = rho >> 4, i = rho & 15; return 8 * (i >> 2) + 4 * n + (i & 3); }

struct Unit { int pm, pn; };
struct Gemm { const bf16_t* A; const bf16_t* Bt; int M, N, K; };

struct StaticOrder {
    int nM, nN, nwg, G, c;
    __host__ __device__ void init(int M, int N, int G_, int c_) { nM = M / BM; nN = N / BM; nwg = nM * nN; G = G_; c = c_; }
    __host__ __device__ bool next(int i, Unit& u) const {
        const long L = (long)i * G + c; if (L >= nwg) return false;
        int wgid = (int)L; { const int q = nwg / NXCD, r = nwg % NXCD, xcd = wgid % NXCD, off = wgid / NXCD; wgid = (xcd < r ? xcd * (q + 1) : r * (q + 1) + (xcd - r) * q) + off; }
        const int nig = WGM * nN, gid = wgid / nig, fm = gid * WGM, gsz = (nM - fm) < WGM ? (nM - fm) : WGM;
        u.pm = fm + ((wgid % nig) % gsz); u.pn = (wgid % nig) / gsz; return true;
    }
    __device__ __forceinline__ void a_ready(const Unit&) const {}
    __device__ __forceinline__ void done(const Unit&) const {}
};
__device__ __forceinline__ unsigned cvt_pk_bf16(float lo, float hi) { unsigned r; asm volatile("v_cvt_pk_bf16_f32 %0, %1, %2" : "=v"(r) : "v"(lo), "v"(hi)); return r; }
typedef float f32x2 __attribute__((ext_vector_type(2)));
typedef unsigned u32x2 __attribute__((ext_vector_type(2)));
__device__ __forceinline__ u32x4 pack8(const f32x4 v0, const f32x4 v1) { u32x4 w; w.x = cvt_pk_bf16(v0[0], v0[1]); w.y = cvt_pk_bf16(v0[2], v0[3]); w.z = cvt_pk_bf16(v1[0], v1[1]); w.w = cvt_pk_bf16(v1[2], v1[3]); return w; }
struct EpiPlain {
    static constexpr bool PERM = true, AFTER_DRAIN = false;
    bf16_t* O; int ldc;
    __device__ __forceinline__ void operator()(const f32x4 (&acc)[2][2][4][2], const Unit& u, int wr, int wc, int fr, int fq) const {
        const int row0 = u.pm * BM + wr * 64 + fr, col0 = u.pn * BM + wc * 32 + 8 * fq;
#pragma unroll
        for (int ai = 0; ai < 2; ++ai)
#pragma unroll
            for (int m = 0; m < 4; ++m) { bf16_t* rowp = O + (size_t)(row0 + ai * HALF + m * 16) * ldc + col0;
#pragma unroll
                for (int bj = 0; bj < 2; ++bj) *(u32x4*)(rowp + bj * HALF) = pack8(acc[ai][bj][m][0], acc[ai][bj][m][1]); }
    }
};
struct EpiRes {
    static constexpr bool PERM = false, AFTER_DRAIN = false;
    const float* base; float* out;
    __device__ __forceinline__ void operator()(const f32x4 (&acc)[2][2][4][2], const Unit& u, int wr, int wc, int fr, int fq) const {
        const int col0 = u.pn * BM + wc * 32 + 4 * fq;
#pragma unroll
        for (int ai = 0; ai < 2; ++ai)
#pragma unroll
            for (int m = 0; m < 4; ++m) { const size_t off = (size_t)(u.pm * BM + ai * HALF + wr * 64 + m * 16 + fr) * 1024 + col0;
#pragma unroll
                for (int bj = 0; bj < 2; ++bj)
#pragma unroll
                    for (int n = 0; n < 2; ++n) { const f32x4 bs = *(const f32x4*)(base + off + bj * HALF + n * 16); *(f32x4*)(out + off + bj * HALF + n * 16) = bs + acc[ai][bj][m][n]; } }
    }
};
struct EpiInProj {
    static constexpr bool PERM = true, AFTER_DRAIN = false;
    bf16_t *Q, *Kk, *V, *OG; float* gates; const float* bg;
    __device__ __forceinline__ void operator()(const f32x4 (&acc)[2][2][4][2], const Unit& u, int wr, int wc, int fr, int fq) const {
        const int colt = u.pn * BM;
#pragma unroll
        for (int ai = 0; ai < 2; ++ai)
#pragma unroll
            for (int m = 0; m < 4; ++m) { const int row = u.pm * BM + ai * HALF + wr * 64 + m * 16 + fr, b = row >> 12, s = row & 4095;
#pragma unroll
                for (int bj = 0; bj < 2; ++bj) { const int cb = colt + bj * HALF + wc * 32 + 8 * fq; f32x4 v0 = acc[ai][bj][m][0], v1 = acc[ai][bj][m][1];
                    if (colt < 1024) { const bool isq = colt < 512; bf16_t* base = isq ? Q : Kk; const int c2 = cb & 511, head = c2 >> 6, d = c2 & 63;
                        if (isq) { v0 = v0 * 0.125f; v1 = v1 * 0.125f; }
                        *(u32x4*)(base + ((size_t)((b * 8 + head) * 4096 + s)) * 64 + d) = pack8(v0, v1); }
                    else if (colt < 2048) { const int c2 = cb - 1024, head = c2 >> 7, dv = c2 & 127; *(u32x4*)(V + ((size_t)((b * 8 + head) * 4096 + s)) * 128 + dv) = pack8(v0, v1); }
                    else if (colt < 3072) { *(u32x4*)(OG + (size_t)row * 1024 + (cb - 2048)) = pack8(v0, v1); }
                    else if (cb < 3104) { const int gi = cb - 3072; float* g = gates + (size_t)row * 32 + gi;
                        *(f32x4*)g = v0 + *(const f32x4*)(bg + gi); *(f32x4*)(g + 4) = v1 + *(const f32x4*)(bg + gi + 4); } } }
    }
};
struct EpiQKV {
    static constexpr bool PERM = true, AFTER_DRAIN = false;
    bf16_t *Q, *Kk, *V;
    __device__ __forceinline__ void operator()(const f32x4 (&acc)[2][2][4][2], const Unit& u, int wr, int wc, int fr, int fq) const {
        const int colt = u.pn * BM;
#pragma unroll
        for (int ai = 0; ai < 2; ++ai)
#pragma unroll
            for (int m = 0; m < 4; ++m) { const int row = u.pm * BM + ai * HALF + wr * 64 + m * 16 + fr, b = row >> 12, s = row & 4095;
#pragma unroll
                for (int bj = 0; bj < 2; ++bj) { const int cb = colt + bj * HALF + wc * 32 + 8 * fq; const u32x4 w = pack8(acc[ai][bj][m][0], acc[ai][bj][m][1]);
                    if (colt < 2048) { bf16_t* base = colt < 1024 ? Q : Kk; const int c2 = cb & 1023, head = c2 >> 7, c = (c2 >> 6) & 1, d = c2 & 63;
                        *(u32x4*)(base + ((size_t)(((b * 8 + head) * 2 + c) * 4096 + s)) * 64 + d) = w; }
                    else { const int c2 = cb - 2048, head = c2 >> 7, dv = c2 & 127; *(u32x4*)(V + ((size_t)((b * 8 + head) * 4096 + s)) * 128 + dv) = w; } } }
    }
};
template <class Epi, class Sched, bool ALIGN_EPI = false, bool SP2 = false>
__device__ __forceinline__ void gemm_phase(PG8_LAS unsigned char* lds, const Gemm g, const Sched& S, const Epi& E, const int wv) {
    int ln_; asm volatile("v_mbcnt_lo_u32_b32 %0, -1, 0\n\tv_mbcnt_hi_u32_b32 %0, -1, %0" : "=v"(ln_)); const int tid = wv * 64 + ln_, wid = wv, lane = tid & 63, wr = wid >> 2, wc = wid & 3, fr = lane & 15, fq = lane >> 4;
    const int K = g.K, nt = K / BK;
    unsigned voffA[2], voffB[2];
#pragma unroll
    for (int i = 0; i < 2; ++i) { int R, C; stage_rc(tid * 16 + i * 8192, R, C); const int Rb = Epi::PERM ? ((R & ~31) + perm32(R & 31)) : R;
        voffA[i] = (unsigned)(R * K + C) * 2u; voffB[i] = (unsigned)(Rb * K + C) * 2u; }
    const size_t kstep = (size_t)(BK * 2);
    const size_t hstep = (size_t)HALF * K * 2;
    const size_t tstep = 2 * hstep;
    const unsigned ldsw = (unsigned)wid * 1024u;
    const int aoff = lds_byte(wr * 64 + fr, fq * 8), boff = lds_byte(wc * 32 + fr, fq * 8);
#define PG8_SA(b, h) (((b) * 2 + (h)) * HTB)
#define PG8_SB(b, h) ((4 + (b) * 2 + (h)) * HTB)
#define PG8_STAGE(bufoff, gbase, voff) do { _Pragma("unroll") for (int _i = 0; _i < 2; ++_i) \
        __builtin_amdgcn_global_load_lds((const unsigned*)((const char*)(gbase) + (voff)[_i]), (PG8_LAS unsigned*)(lds + (bufoff) + ldsw + _i * 8192), 16, 0, 0); } while (0)
#define PG8_LDA(dst, b, h) do { _Pragma("unroll") for (int m = 0; m < 4; ++m) _Pragma("unroll") for (int k = 0; k < 2; ++k) dst[m][k] = *(const PG8_LAS bf16x8*)(lds + PG8_SA(b, h) + aoff + m * 2048 + k * 1024); } while (0)
#define PG8_LDB(dst, b, h) do { _Pragma("unroll") for (int n = 0; n < 2; ++n) _Pragma("unroll") for (int k = 0; k < 2; ++k) dst[n][k] = *(const PG8_LAS bf16x8*)(lds + PG8_SB(b, h) + boff + n * 2048 + k * 1024); } while (0)
#define PG8_MMA(ai, bj, At, Bt) do { __builtin_amdgcn_s_setprio(1); _Pragma("unroll") for (int m = 0; m < 4; ++m) _Pragma("unroll") for (int n = 0; n < 2; ++n) _Pragma("unroll") for (int k = 0; k < 2; ++k) \
        acc[ai][bj][m][n] = __builtin_amdgcn_mfma_f32_16x16x32_bf16(Bt[n][k], At[m][k], acc[ai][bj][m][n], 0, 0, 0); __builtin_amdgcn_s_setprio(0); } while (0)
#define PG8_WAIT_V(n) asm volatile("s_waitcnt vmcnt(" #n ")" ::: "memory")
#define PG8_WAIT_L(n) asm volatile("s_waitcnt lgkmcnt(" #n ")" ::: "memory")
#define PG8_BAR __builtin_amdgcn_s_barrier()
#define PG8_SCHED __builtin_amdgcn_sched_barrier(0)
    Unit cur, nxt; int ui = 0;
    if (!S.next(0, cur)) return;
    f32x4 acc[2][2][4][2];
#pragma unroll
    for (int a = 0; a < 2; ++a)
#pragma unroll
        for (int b = 0; b < 2; ++b)
#pragma unroll
            for (int m = 0; m < 4; ++m)
#pragma unroll
                for (int n = 0; n < 2; ++n) acc[a][b][m][n] = (f32x4){0.f, 0.f, 0.f, 0.f};
    bf16x8 At[4][2], B0[2][2], B1[2][2];
    const char* cA = (const char*)g.A + (size_t)cur.pm * tstep; const char* cB = (const char*)g.Bt + (size_t)cur.pn * tstep;
    S.a_ready(cur);
    if constexpr (SP2) {
        PG8_STAGE(PG8_SB(0, 0), cB, voffB); PG8_STAGE(PG8_SB(0, 1), cB + hstep, voffB); PG8_STAGE(PG8_SA(0, 0), cA, voffA); PG8_STAGE(PG8_SA(0, 1), cA + hstep, voffA);
        if (wr == 1) PG8_BAR;
        PG8_WAIT_V(2); PG8_BAR;
        PG8_STAGE(PG8_SB(1, 0), cB + kstep, voffB); PG8_STAGE(PG8_SA(1, 0), cA + kstep, voffA); PG8_STAGE(PG8_SB(1, 1), cB + hstep + kstep, voffB);
        PG8_WAIT_V(6); PG8_BAR;
    } else {
        PG8_STAGE(PG8_SB(0, 0), cB, voffB); PG8_STAGE(PG8_SA(0, 0), cA, voffA); PG8_STAGE(PG8_SB(0, 1), cB + hstep, voffB); PG8_STAGE(PG8_SA(0, 1), cA + hstep, voffA);
        if (wr == 1) PG8_BAR;
        PG8_WAIT_V(4); PG8_BAR;
        PG8_STAGE(PG8_SB(1, 0), cB + kstep, voffB); PG8_STAGE(PG8_SA(1, 0), cA + kstep, voffA); PG8_STAGE(PG8_SB(1, 1), cB + hstep + kstep, voffB);
        PG8_WAIT_V(6); PG8_BAR;
    }
    for (;;) {
        const bool has_next = S.next(ui + 1, nxt);
        const char* nA = has_next ? (const char*)g.A + (size_t)nxt.pm * tstep : cA; const char* nB = has_next ? (const char*)g.Bt + (size_t)nxt.pn * tstep : cB;
        for (int t = 0; t < nt; t += 2) {
            const bool last = (t == nt - 2);
            const char* a1 = cA + (size_t)(t + 1) * kstep;
            const char* a2 = last ? nA : cA + (size_t)(t + 2) * kstep; const char* b2 = last ? nB : cB + (size_t)(t + 2) * kstep;
            const char* a3 = a2 + kstep; const char* b3 = b2 + kstep;
            if (last && has_next) S.a_ready(nxt);
            if constexpr (SP2) {
            PG8_LDB(B0, 0, 0); PG8_LDB(B1, 0, 1); PG8_SCHED; PG8_LDA(At, 0, 0); PG8_STAGE(PG8_SA(1, 1), a1 + hstep, voffA);
            PG8_WAIT_V(8); PG8_WAIT_L(0); PG8_BAR; PG8_MMA(0, 0, At, B0); PG8_MMA(0, 1, At, B1); PG8_BAR; PG8_SCHED;
            PG8_LDA(At, 0, 1); PG8_STAGE(PG8_SB(0, 0), b2, voffB); PG8_STAGE(PG8_SB(0, 1), b2 + hstep, voffB); PG8_STAGE(PG8_SA(0, 0), a2, voffA);
            PG8_WAIT_V(8); PG8_WAIT_L(0); PG8_BAR; PG8_MMA(1, 0, At, B0); PG8_MMA(1, 1, At, B1); PG8_BAR; PG8_SCHED;
            PG8_LDB(B0, 1, 0); PG8_LDB(B1, 1, 1); PG8_SCHED; PG8_LDA(At, 1, 0); PG8_STAGE(PG8_SA(0, 1), a2 + hstep, voffA);
            PG8_WAIT_V(8); PG8_WAIT_L(0); PG8_BAR; PG8_MMA(0, 0, At, B0); PG8_MMA(0, 1, At, B1); PG8_BAR; PG8_SCHED;
            PG8_LDA(At, 1, 1); PG8_STAGE(PG8_SB(1, 0), b3, voffB); PG8_STAGE(PG8_SB(1, 1), b3 + hstep, voffB); PG8_STAGE(PG8_SA(1, 0), a3, voffA);
            PG8_WAIT_V(8); PG8_WAIT_L(0); PG8_BAR; PG8_MMA(1, 0, At, B0); PG8_MMA(1, 1, At, B1); PG8_BAR; PG8_SCHED;
            } else {
            PG8_LDB(B0, 0, 0); PG8_SCHED; PG8_LDA(At, 0, 0); PG8_STAGE(PG8_SA(1, 1), a1 + hstep, voffA);
            PG8_WAIT_L(8); PG8_BAR; PG8_WAIT_L(0); PG8_MMA(0, 0, At, B0); PG8_BAR; PG8_SCHED;
            PG8_LDB(B1, 0, 1); PG8_STAGE(PG8_SB(0, 0), b2, voffB);
            PG8_BAR; PG8_WAIT_L(0); PG8_MMA(0, 1, At, B1); PG8_BAR;
            PG8_LDA(At, 0, 1); PG8_STAGE(PG8_SA(0, 0), a2, voffA);
            PG8_BAR; PG8_WAIT_L(0); PG8_MMA(1, 0, At, B0); PG8_BAR; PG8_SCHED;
            PG8_STAGE(PG8_SB(0, 1), b2 + hstep, voffB);
            PG8_WAIT_V(6); PG8_BAR; PG8_MMA(1, 1, At, B1); PG8_BAR;
            PG8_LDB(B0, 1, 0); PG8_SCHED; PG8_LDA(At, 1, 0); PG8_STAGE(PG8_SA(0, 1), a2 + hstep, voffA);
            PG8_WAIT_L(8); PG8_BAR; PG8_WAIT_L(0); PG8_MMA(0, 0, At, B0); PG8_BAR; PG8_SCHED;
            PG8_LDB(B1, 1, 1); PG8_STAGE(PG8_SB(1, 0), b3, voffB);
            PG8_BAR; PG8_WAIT_L(0); PG8_MMA(0, 1, At, B1); PG8_BAR;
            PG8_LDA(At, 1, 1); PG8_STAGE(PG8_SA(1, 0), a3, voffA);
            PG8_BAR; PG8_WAIT_L(0); PG8_MMA(1, 0, At, B0); PG8_BAR; PG8_SCHED;
            PG8_STAGE(PG8_SB(1, 1), b3 + hstep, voffB);
            PG8_WAIT_V(6); PG8_BAR; PG8_MMA(1, 1, At, B1); PG8_BAR;
            }
        }
        if constexpr (ALIGN_EPI) { if (wr == 0) PG8_BAR; }
        if constexpr (!Epi::AFTER_DRAIN) { E(acc, cur, wr, wc, fr, fq); S.done(cur); }
        if (!has_next) break;
#pragma unroll
        for (int a = 0; a < 2; ++a)
#pragma unroll
            for (int b = 0; b < 2; ++b)
#pragma unroll
                for (int m = 0; m < 4; ++m)
#pragma unroll
                    for (int n = 0; n < 2; ++n) acc[a][b][m][n] = (f32x4){0.f, 0.f, 0.f, 0.f};
        cur = nxt; cA = nA; cB = nB; ++ui;
        if constexpr (ALIGN_EPI) { if (wr == 1) PG8_BAR; }
    }
    PG8_WAIT_V(0);
    if constexpr (!ALIGN_EPI) { if (wr == 0) PG8_BAR; }
    PG8_BAR;
    if constexpr (Epi::AFTER_DRAIN) { E.fused(acc, cur, wr, wc, fr, fq, lds, wid, lane); S.done(cur); }
#undef PG8_SA
#undef PG8_SB
#undef PG8_STAGE
#undef PG8_LDA
#undef PG8_LDB
#undef PG8_MMA
#undef PG8_WAIT_V
#undef PG8_WAIT_L
#undef PG8_BAR
#undef PG8_SCHED
}
}
#define GAS __attribute__((address_space(1)))
#define LAS __attribute__((address_space(3)))
typedef unsigned short bf16;
typedef unsigned v4u __attribute__((ext_vector_type(4)));
typedef float f32x4 __attribute__((ext_vector_type(4)));
typedef short bf16x8 __attribute__((ext_vector_type(8)));
typedef GAS unsigned gu32;
typedef GAS unsigned long long gu64;
#define RLX_AGENT __ATOMIC_RELAXED, __HIP_MEMORY_SCOPE_AGENT
#define LDS_WAIT() asm volatile("s_waitcnt lgkmcnt(0)" ::: "memory")
#define VM_WAIT() asm volatile("s_waitcnt vmcnt(0)" ::: "memory")
__device__ __forceinline__ unsigned long long rt() { return __builtin_amdgcn_s_memrealtime(); }
typedef float f32x2_cv __attribute__((ext_vector_type(2))); typedef __bf16 bf16x2_cv __attribute__((ext_vector_type(2)));
__device__ __forceinline__ unsigned pk2(float lo, float hi) { const f32x2_cv v = {lo, hi}; const bf16x2_cv b = __builtin_convertvector(v, bf16x2_cv); return __builtin_bit_cast(unsigned, b); }
__device__ __forceinline__ unsigned f2bf(float f) { return pk2(f, 0.f) & 0xffffu; }

#define XB_TMO      128
#define XB_XCNT(j)  (256  + 64 * (j))
#define XB_XSUB(j)  (1280 + 64 * (j))
#define XB_XGEN(j)  (2304 + 64 * (j))
#define XB_TOP      3328
#define XB_TOPGEN   3392
#define XCD_BAR_WORDS 3456
#define XB_SPIN_CAP (1u << 18)

__device__ __forceinline__ unsigned xb_ld(unsigned* p)              { return __hip_atomic_load(p, __ATOMIC_RELAXED, __HIP_MEMORY_SCOPE_AGENT); }
__device__ __forceinline__ unsigned xb_add(unsigned* p, unsigned v) { return __hip_atomic_fetch_add(p, v, __ATOMIC_RELAXED, __HIP_MEMORY_SCOPE_AGENT); }
__device__ __forceinline__ unsigned xb_xcc_id() { return (unsigned)__builtin_amdgcn_s_getreg((3 << 11) | 20) & 0xFu; }
#define XB_SPIN(cond, bar) do { unsigned _sp = 0; while (cond) { __builtin_amdgcn_s_sleep(1); \
    if ((++_sp & 255u) == 0u) { if (xb_ld(&(bar)[XB_TMO])) break; if (_sp > XB_SPIN_CAP) { atomicAdd(&(bar)[XB_TMO], 1u); break; } } } } while (0)

struct XcdBarrier {
    unsigned* bar; unsigned x;
    volatile LAS unsigned* st;
};

__device__ __forceinline__ XcdBarrier xcd_barrier_post(unsigned* bar, volatile LAS unsigned* st) {
    XcdBarrier b; b.bar = bar; b.x = xb_xcc_id(); b.st = st;
    if (threadIdx.x == 0) (void)xb_add(&bar[XB_XCNT(b.x)], 1u);
    return b;
}
__device__ __forceinline__ void xcd_barrier_complete(unsigned* bar, unsigned x, unsigned& nloc, unsigned& nx) {
    const unsigned G = gridDim.x * gridDim.y * gridDim.z;
    unsigned sum, cnt, mine, sp = 0u;
    for (;;) {
        sum = 0u; cnt = 0u; mine = 0u;
#pragma unroll
        for (unsigned j = 0; j < 16; ++j) { const unsigned c = xb_ld(&bar[XB_XCNT(j)]); sum += c; cnt += (c > 0u) ? 1u : 0u; mine = (j == x) ? c : mine; }
        if (sum == G) break;
        __builtin_amdgcn_s_sleep(1);
        if ((++sp & 255u) == 0u) { if (xb_ld(&bar[XB_TMO])) break; if (sp > XB_SPIN_CAP) { atomicAdd(&bar[XB_TMO], 1u); break; } }
    }
    nloc = mine > 0u ? mine : 1u; nx = cnt > 0u ? cnt : 1u;
}

__device__ __forceinline__ void xcd_barrier(const XcdBarrier& b) {
    asm volatile("s_waitcnt vmcnt(0)" ::: "memory");
    __syncthreads();
    if (threadIdx.x == 0) {
        unsigned* bar = b.bar;
        __builtin_amdgcn_s_waitcnt(0);
        unsigned nloc = b.st[0], nx = b.st[1];
        if (nloc == 0u) { xcd_barrier_complete(bar, b.x, nloc, nx); b.st[0] = nloc; b.st[1] = nx; }
        const unsigned old = xb_add(&bar[XB_XSUB(b.x)], 1u);
        const unsigned gen = old / nloc;
        if (old + 1u == (gen + 1u) * nloc) {
            __builtin_amdgcn_fence(__ATOMIC_RELEASE, "agent");
            asm volatile("s_waitcnt vmcnt(0)" ::: "memory");
            const unsigned og = xb_add(&bar[XB_TOP], 1u);
            const unsigned tg = og / nx;
            if (og + 1u == (tg + 1u) * nx) xb_add(&bar[XB_TOPGEN], 1u);
            else XB_SPIN(xb_ld(&bar[XB_TOPGEN]) == tg, bar);
            __builtin_amdgcn_fence(__ATOMIC_ACQUIRE, "agent");
            xb_add(&bar[XB_XGEN(b.x)], 1u);
            asm volatile("s_waitcnt vmcnt(0)" ::: "memory");
        } else {
            XB_SPIN(xb_ld(&bar[XB_XGEN(b.x)]) == gen, bar);
            __builtin_amdgcn_fence(__ATOMIC_ACQUIRE, "agent");
            asm volatile("s_waitcnt vmcnt(0)" ::: "memory");
        }
    }
    __syncthreads();
}
constexpr int NWAVES = 8;
constexpr int T = 32768, D = 1024, SEQ = 4096;
constexpr float EPS = 1e-6f;
constexpr float LAMBDA_INIT = 0.35550906759f;
constexpr size_t MiB = 1u << 20;
constexpr size_t WS_CTL = 0, CTL_ZERO_BYTES = 1 * MiB;
constexpr size_t WS_ROPE = 1 * MiB;
constexpr size_t WS_WIN = 4 * MiB;
constexpr size_t WS_WO0 = 11 * MiB, WS_WQ0 = 13 * MiB, WS_KEY0 = 17 * MiB, WS_WQKV = 18 * MiB, WS_WO1 = 24 * MiB, WS_WQ1 = 26 * MiB, WS_KEY1 = 30 * MiB;
constexpr size_t WS_SC = 31 * MiB;
constexpr size_t WS_U0 = 32 * MiB, WS_V0T = 48 * MiB, WS_U1 = 64 * MiB, WS_V1T = 80 * MiB;
constexpr size_t WS_B0 = 96 * MiB;
constexpr size_t WS_R1 = 160 * MiB, WS_R2 = 224 * MiB, WS_R3 = 288 * MiB, WS_R4 = 352 * MiB, WS_R5 = 416 * MiB, WS_GATES = 480 * MiB;
constexpr size_t WS_END = 484 * MiB;
constexpr int CW_BAR = 4096;
constexpr int LDS_BYTES = 147456, MISC_OFF = LDS_BYTES - 128;

typedef float f32x16 __attribute__((ext_vector_type(16)));
typedef unsigned u32x2 __attribute__((ext_vector_type(2)));
typedef __bf16 bf16x2_t __attribute__((ext_vector_type(2)));
__device__ __forceinline__ float bf_lo(unsigned w) { return __uint_as_float(w << 16); }
__device__ __forceinline__ float bf_hi(unsigned w) { return __uint_as_float(w & 0xffff0000u); }
__device__ __forceinline__ float dot2(unsigned a, unsigned b, float c) { return __builtin_amdgcn_fdot2_f32_bf16(__builtin_bit_cast(bf16x2_t, a), __builtin_bit_cast(bf16x2_t, b), c, false); }
__device__ __forceinline__ float shx(float v, int lane, int m) { return __uint_as_float((unsigned)__builtin_amdgcn_ds_bpermute((lane ^ m) << 2, (int)__float_as_uint(v))); }
__device__ __forceinline__ int shxi(int v, int lane, int m) { return __builtin_amdgcn_ds_bpermute((lane ^ m) << 2, v); }
__device__ __forceinline__ float wave_sum(float v, int lane) {
#pragma unroll
    for (int o = 1; o < 64; o <<= 1) v += shx(v, lane, o);
    return v;
}
__device__ __forceinline__ f32x4 mfma16(bf16x8 a, bf16x8 b, f32x4 c) { return __builtin_amdgcn_mfma_f32_16x16x32_bf16(a, b, c, 0, 0, 0); }
__device__ __forceinline__ f32x16 mfma32(bf16x8 a, bf16x8 b, f32x16 c) { return __builtin_amdgcn_mfma_f32_32x32x16_bf16(a, b, c, 0, 0, 0); }
__device__ __forceinline__ u32x2 pack4(float a, float b, float c, float d) { u32x2 r; r.x = pk2(a, b); r.y = pk2(c, d); return r; }

__device__ __forceinline__ void p0_transpose_item(const float* W, int K, int N, bf16* WT, LAS float* scr, int item, int lane) {
    const int nblk = N / 32, kb = item / nblk, nb = item % nblk, k0 = 64 * kb, n0 = 32 * nb;
#pragma unroll 8
    for (int i = 0; i < 32; ++i) { const int kk = 2 * i + (lane >> 5); scr[kk * 33 + (lane & 31)] = W[(size_t)(k0 + kk) * N + n0 + (lane & 31)]; }
    LDS_WAIT(); asm volatile("" ::: "memory");
    const int c = lane & 7;
#pragma unroll
    for (int j = 0; j < 4; ++j) { const int n = (lane >> 3) + 8 * j; const LAS float* s = scr + (8 * c) * 33 + n;
        v4u o; o.x = pk2(s[0 * 33], s[1 * 33]); o.y = pk2(s[2 * 33], s[3 * 33]); o.z = pk2(s[4 * 33], s[5 * 33]); o.w = pk2(s[6 * 33], s[7 * 33]);
        *(v4u*)(WT + (size_t)(n0 + n) * K + k0 + 8 * c) = o; }
    LDS_WAIT(); asm volatile("" ::: "memory");
}
__device__ __forceinline__ void cvt_range(const float* src, bf16* dst, size_t n, size_t gtid, size_t gthreads) {
    for (size_t i = gtid * 8; i < n; i += gthreads * 8) {
        const f32x4 a = *(const f32x4*)(src + i), b = *(const f32x4*)(src + i + 4);
        v4u o; o.x = pk2(a.x, a.y); o.y = pk2(a.z, a.w); o.z = pk2(b.x, b.y); o.w = pk2(b.z, b.w);
        *(v4u*)(dst + i) = o; }
}
__device__ __forceinline__ void rms_row_to_bf16(const float* xrow, const float* g, bf16* orow, int lane) {
    const f32x4* xr = (const f32x4*)xrow + lane; const f32x4* gr = (const f32x4*)g + lane;
    f32x4 v[4]; float s = 0.f;
#pragma unroll
    for (int j = 0; j < 4; ++j) { v[j] = xr[64 * j]; s += (v[j].x * v[j].x + v[j].y * v[j].y) + (v[j].z * v[j].z + v[j].w * v[j].w); }
    const float rstd = rsqrtf(wave_sum(s, lane) * (1.f / 1024.f) + EPS);
    unsigned long long* o8 = (unsigned long long*)orow + lane;
#pragma unroll
    for (int j = 0; j < 4; ++j) { const f32x4 gg = gr[64 * j];
        o8[64 * j] = (unsigned long long)pk2(v[j].x * rstd * gg.x, v[j].y * rstd * gg.y) | ((unsigned long long)pk2(v[j].z * rstd * gg.z, v[j].w * rstd * gg.w) << 32); }
}
__device__ __forceinline__ void rms_pass(const float* X, const float* g, bf16* XN, int gw, int NGW, int lane) {
    for (int m = gw; m < T; m += NGW) rms_row_to_bf16(X + (size_t)m * D, g, XN + (size_t)m * D, lane);
}

__device__ __forceinline__ float logsigmoid_f(float f) { return fminf(f, 0.f) - log1pf(__expf(-fabsf(f))); }
#define ML_LOAD(ci_) do { const size_t r_ = rowbase + (size_t)(ci_) * 64 + lane; \
    rq = *(const v4u*)(Q0 + r_ * 64 + 8 * w); rk = *(const v4u*)(K0 + r_ * 64 + 8 * w); rv0 = *(const v4u*)(V0 + r_ * 128 + 16 * w); rv1 = *(const v4u*)(V0 + r_ * 128 + 16 * w + 8); \
    const size_t gm_ = ((size_t)b * 4096 + (size_t)(ci_) * 64 + jr) * 32; rli = GATES[gm_ + (dir ? 16 : 0) + h]; rf = GATES[gm_ + (dir ? 24 : 8) + h]; } while (0)
__device__ __forceinline__ void mlstm_phase(const int wv, LAS unsigned char* lds, const bf16* Q0, const bf16* K0, const bf16* V0, const float* GATES, bf16* HF, bf16* HB) {
    const int bx = blockIdx.x;
    if ((bx >> 3) & 1) return;
    const int seq = (bx >> 4) * 8 + (bx & 7);
    const int dir = seq & 1, bh = seq >> 1, b = bh >> 3, h = bh & 7;
    int ln_; asm volatile("v_mbcnt_lo_u32_b32 %0, -1, 0\n\tv_mbcnt_hi_u32_b32 %0, -1, %0" : "=v"(ln_)); const int tid = wv * 64 + ln_, lane = tid & 63, w = wv, fr = lane & 15, fq = lane >> 4;
    LAS bf16* Qs = (LAS bf16*)(lds); LAS bf16* Ks = (LAS bf16*)(lds + 9216); LAS bf16* Kwt = (LAS bf16*)(lds + 18432); LAS bf16* Ps = (LAS bf16*)(lds + 27648);
    LAS bf16* Vt = (LAS bf16*)(lds + 36864 + w * 2304); LAS bf16* Cs = (LAS bf16*)(lds + 55296 + w * 2304); LAS bf16* nb = (LAS bf16*)(lds + 73728 + w * 128);
    LAS float* gc = (LAS float*)(lds + 74752 + w * 1280); LAS float* gM = gc + 64; LAS float* gI = gc + 128; LAS float* gE = gc + 192; LAS float* gW = gc + 256;
    for (int i = lane; i < 2304 / 4; i += 64) ((LAS unsigned*)Cs)[i] = 0u;
    if (lane < 32) ((LAS unsigned*)nb)[lane] = 0u;
    f32x4 Cacc[4], Nacc[4];
#pragma unroll
    for (int i = 0; i < 4; ++i) { Cacc[i] = (f32x4){0.f, 0.f, 0.f, 0.f}; Nacc[i] = (f32x4){0.f, 0.f, 0.f, 0.f}; }
    float m = -1e30f;
    bf16* Hout = dir ? HB : HF;
    const size_t rowbase = (size_t)bh * 4096;
    const int jr = dir ? 63 - lane : lane;
    v4u rq, rk, rv0, rv1; float rli, rf;
    ML_LOAD(dir ? 63 : 0);
    const bf16x8 ones = (bf16x8){0x3F80, 0x3F80, 0x3F80, 0x3F80, 0x3F80, 0x3F80, 0x3F80, 0x3F80};
    const f32x4 z4 = (f32x4){0.f, 0.f, 0.f, 0.f};
#pragma unroll 1
    for (int step = 0; step < 64; ++step) {
        const int ci = dir ? 63 - step : step;
        const float lf = logsigmoid_f(rf);
        float bcs = lf;
#pragma unroll
        for (int d = 1; d < 64; d <<= 1) { const float t = __uint_as_float((unsigned)__builtin_amdgcn_ds_bpermute((lane - d) << 2, (int)__float_as_uint(bcs))); if (lane >= d) bcs += t; }
        const float c = rli - bcs;
        float pm = c;
#pragma unroll
        for (int d = 1; d < 64; d <<= 1) { const float t = __uint_as_float((unsigned)__builtin_amdgcn_ds_bpermute((lane - d) << 2, (int)__float_as_uint(pm))); if (lane >= d) pm = fmaxf(pm, t); }
        const float M = fmaxf(m, pm);
        const float bL = __uint_as_float((unsigned)__builtin_amdgcn_readlane((int)__float_as_uint(bcs), 63)), Mlast = __uint_as_float((unsigned)__builtin_amdgcn_readlane((int)__float_as_uint(M), 63));
        gc[jr] = c; gM[jr] = M; gI[jr] = __expf(m - M); gE[jr] = __expf(-(bcs + M)); gW[jr] = __expf(c - Mlast);
        const float sp = __expf(m - Mlast), m_new = bL + Mlast;
        const float wr_ = gW[lane];
        *(LAS v4u*)(Qs + lane * 72 + 8 * w) = rq; *(LAS v4u*)(Ks + lane * 72 + 8 * w) = rk;
#pragma unroll
        for (int i = 0; i < 4; ++i) { const unsigned kw = rk[i]; Kwt[(8 * w + 2 * i) * 72 + lane] = (bf16)f2bf(bf_lo(kw) * wr_); Kwt[(8 * w + 2 * i + 1) * 72 + lane] = (bf16)f2bf(bf_hi(kw) * wr_); }
#pragma unroll
        for (int i = 0; i < 4; ++i) { Vt[(2 * i) * 72 + lane] = (bf16)(rv0[i] & 0xffffu); Vt[(2 * i + 1) * 72 + lane] = (bf16)(rv0[i] >> 16);
                                      Vt[(8 + 2 * i) * 72 + lane] = (bf16)(rv1[i] & 0xffffu); Vt[(9 + 2 * i) * 72 + lane] = (bf16)(rv1[i] >> 16); }
        __syncthreads();
        if (step < 63) ML_LOAD(dir ? 62 - step : step + 1);
        {
            const int st = w >> 1;
            const bf16x8 a0 = *(const LAS bf16x8*)(Ks + (16 * st + fr) * 72 + 8 * fq), a1 = *(const LAS bf16x8*)(Ks + (16 * st + fr) * 72 + 32 + 8 * fq);
#pragma unroll
            for (int u = 0; u < 2; ++u) { const int tt = 2 * (w & 1) + u;
                const bf16x8 b0 = *(const LAS bf16x8*)(Qs + (16 * tt + fr) * 72 + 8 * fq), b1 = *(const LAS bf16x8*)(Qs + (16 * tt + fr) * 72 + 32 + 8 * fq);
                f32x4 acc = mfma16(a0, b0, z4); acc = mfma16(a1, b1, acc);
                const int t = 16 * tt + fr; const float Mt = gM[t]; float pv[4];
#pragma unroll
                for (int i = 0; i < 4; ++i) { const int s = 16 * st + 4 * fq + i; const bool valid = dir ? (s >= t) : (s <= t); const float e = __expf(gc[s] - Mt); pv[i] = valid ? acc[i] * e : 0.f; }
                *(LAS u32x2*)(Ps + t * 72 + 16 * st + 4 * fq) = pack4(pv[0], pv[1], pv[2], pv[3]); }
        }
        __syncthreads();
        const bf16x8 aV0 = *(const LAS bf16x8*)(Vt + fr * 72 + 8 * fq), aV1 = *(const LAS bf16x8*)(Vt + fr * 72 + 32 + 8 * fq);
        {
            const bf16x8 aC0 = *(const LAS bf16x8*)(Cs + fr * 72 + 8 * fq), aC1 = *(const LAS bf16x8*)(Cs + fr * 72 + 32 + 8 * fq);
            const bf16x8 aN0 = *(const LAS bf16x8*)(nb + 8 * fq), aN1 = *(const LAS bf16x8*)(nb + 32 + 8 * fq);
#pragma unroll
            for (int tt = 0; tt < 4; ++tt) {
                const bf16x8 bP0 = *(const LAS bf16x8*)(Ps + (16 * tt + fr) * 72 + 8 * fq), bP1 = *(const LAS bf16x8*)(Ps + (16 * tt + fr) * 72 + 32 + 8 * fq);
                const bf16x8 bQ0 = *(const LAS bf16x8*)(Qs + (16 * tt + fr) * 72 + 8 * fq), bQ1 = *(const LAS bf16x8*)(Qs + (16 * tt + fr) * 72 + 32 + 8 * fq);
                f32x4 acc1 = mfma16(aV0, bP0, z4); acc1 = mfma16(aV1, bP1, acc1);
                f32x4 acc2 = mfma16(aC0, bQ0, z4); acc2 = mfma16(aC1, bQ1, acc2);
                f32x4 d1 = mfma16(ones, bP0, z4); d1 = mfma16(ones, bP1, d1);
                f32x4 d2 = mfma16(aN0, bQ0, z4); d2 = mfma16(aN1, bQ1, d2);
                const int t = 16 * tt + fr; const float it = gI[t], en = gE[t];
                const float den = d1[0] + it * d2[0]; const float inv = 1.f / fmaxf(fabsf(den), en);
                *(u32x2*)(Hout + ((size_t)b * 4096 + (size_t)ci * 64 + t) * 1024 + h * 128 + 16 * w + 4 * fq) =
                    pack4((acc1[0] + it * acc2[0]) * inv, (acc1[1] + it * acc2[1]) * inv, (acc1[2] + it * acc2[2]) * inv, (acc1[3] + it * acc2[3]) * inv);
            }
        }
#pragma unroll
        for (int dt = 0; dt < 4; ++dt) { Cacc[dt] = Cacc[dt] * sp; Nacc[dt] = Nacc[dt] * sp;
            const bf16x8 aK0 = *(const LAS bf16x8*)(Kwt + (16 * dt + fr) * 72 + 8 * fq), aK1 = *(const LAS bf16x8*)(Kwt + (16 * dt + fr) * 72 + 32 + 8 * fq);
            Cacc[dt] = mfma16(aK0, aV0, Cacc[dt]); Cacc[dt] = mfma16(aK1, aV1, Cacc[dt]);
            Nacc[dt] = mfma16(aK0, ones, Nacc[dt]); Nacc[dt] = mfma16(aK1, ones, Nacc[dt]); }
#pragma unroll
        for (int dt = 0; dt < 4; ++dt) { *(LAS u32x2*)(Cs + fr * 72 + 16 * dt + 4 * fq) = pack4(Cacc[dt][0], Cacc[dt][1], Cacc[dt][2], Cacc[dt][3]);
                                         *(LAS u32x2*)(nb + 16 * dt + 4 * fq) = pack4(Nacc[dt][0], Nacc[dt][1], Nacc[dt][2], Nacc[dt][3]); }
        m = m_new;
        __syncthreads();
    }
}
#undef ML_LOAD

__device__ __forceinline__ void hs_pass(const bf16* HF, const bf16* HB, const bf16* OG, const float* hg, bf16* HS, int gw, int NGW, int lane) {
    for (int m = gw; m < T; m += NGW) {
        const size_t off = (size_t)m * 1024 + 16 * lane;
        const v4u f0 = *(const v4u*)(HF + off), f1 = *(const v4u*)(HF + off + 8), b0 = *(const v4u*)(HB + off), b1 = *(const v4u*)(HB + off + 8), o0 = *(const v4u*)(OG + off), o1 = *(const v4u*)(OG + off + 8);
        float x[16], og[16];
#pragma unroll
        for (int i = 0; i < 4; ++i) { x[2 * i] = bf_lo(f0[i]) + bf_lo(b0[i]); x[2 * i + 1] = bf_hi(f0[i]) + bf_hi(b0[i]); x[8 + 2 * i] = bf_lo(f1[i]) + bf_lo(b1[i]); x[9 + 2 * i] = bf_hi(f1[i]) + bf_hi(b1[i]);
                                      og[2 * i] = bf_lo(o0[i]); og[2 * i + 1] = bf_hi(o0[i]); og[8 + 2 * i] = bf_lo(o1[i]); og[9 + 2 * i] = bf_hi(o1[i]); }
        float ss = 0.f;
#pragma unroll
        for (int i = 0; i < 16; ++i) ss += x[i] * x[i];
        ss += shx(ss, lane, 1); ss += shx(ss, lane, 2); ss += shx(ss, lane, 4);
        const float rstd = rsqrtf(ss * (1.f / 128.f) + EPS);
        float y[16];
#pragma unroll
        for (int i = 0; i < 16; ++i) y[i] = x[i] * rstd * hg[16 * lane + i] * (1.f / (1.f + __expf(-og[i])));
        v4u w0, w1;
#pragma unroll
        for (int i = 0; i < 4; ++i) { w0[i] = pk2(y[2 * i], y[2 * i + 1]); w1[i] = pk2(y[8 + 2 * i], y[9 + 2 * i]); }
        *(v4u*)(HS + off) = w0; *(v4u*)(HS + off + 8) = w1;
    }
}

#define TK_INSERT(v, x) do { float c_ = (x); _Pragma("unroll") for (int j_ = 0; j_ < 16; ++j_) { const float h_ = fmaxf(v[j_], c_); c_ = fminf(v[j_], c_); v[j_] = h_; } } while (0)
__device__ __forceinline__ void peer_topk_phase(const int wv, int vcu, const bf16* PQ, const bf16* KEYS, int* EXPERTS, float* GATESP) {
    int ln_; asm volatile("v_mbcnt_lo_u32_b32 %0, -1, 0\n\tv_mbcnt_hi_u32_b32 %0, -1, %0" : "=v"(ln_)); const int tid = wv * 64 + ln_, lane = tid & 63, w = wv, r32 = lane & 31, hi = lane >> 5;
    const int t = vcu * 128 + (w & 3) * 32 + r32, hg = w >> 2;
    const float NINF = -INFINITY;
#pragma unroll 1
    for (int hh = 0; hh < 4; ++hh) {
        const int head = hg * 4 + hh;
        float L0[16], L1[16];
#pragma unroll
        for (int j = 0; j < 16; ++j) { L0[j] = 0.f; L1[j] = 0.f; }
#pragma unroll 1
        for (int p = 0; p < 2; ++p) {
            const int hp = head * 2 + p;
            bf16x8 bq[8];
#pragma unroll
            for (int ks = 0; ks < 8; ++ks) bq[ks] = *(const bf16x8*)(PQ + (size_t)t * 2048 + head * 256 + p * 128 + ks * 16 + 8 * hi);
            f32x16 acc[4];
#pragma unroll
            for (int nt = 0; nt < 4; ++nt) {
#pragma unroll
                for (int r = 0; r < 16; ++r) acc[nt][r] = 0.f;
#pragma unroll
                for (int ks = 0; ks < 8; ++ks) { const bf16x8 a = *(const bf16x8*)(KEYS + ((size_t)(hp * 128 + nt * 32 + r32)) * 128 + ks * 16 + 8 * hi); acc[nt] = mfma32(a, bq[ks], acc[nt]); }
            }
            float v[16];
#pragma unroll
            for (int j = 0; j < 16; ++j) v[j] = NINF;
#pragma unroll
            for (int nt = 0; nt < 4; ++nt)
#pragma unroll
                for (int r = 0; r < 16; ++r) { const int n = nt * 32 + (r & 3) + 8 * (r >> 2) + 4 * hi;
                    const float x = __uint_as_float((__float_as_uint(acc[nt][r]) & ~0x7Fu) | (unsigned)(127 - n)); TK_INSERT(v, x); }
            float wv[16];
#pragma unroll
            for (int j = 0; j < 16; ++j) wv[j] = shx(v[j], lane, 32);
#pragma unroll
            for (int j = 0; j < 16; ++j) TK_INSERT(v, wv[j]);
            if (p == 0) {
#pragma unroll
                for (int j = 0; j < 16; ++j) L0[j] = v[j];
            } else {
#pragma unroll
                for (int j = 0; j < 16; ++j) L1[j] = v[j];
            }
        }
        float tv[16];
#pragma unroll
        for (int j = 0; j < 16; ++j) tv[j] = NINF;
        unsigned IA[4] = {0u, 0u, 0u, 0u}, IB[4] = {0u, 0u, 0u, 0u};
#pragma unroll
        for (int i = 0; i < 16; ++i) { IA[i >> 2] |= (127u - (__float_as_uint(L0[i]) & 0x7Fu)) << (8 * (i & 3)); IB[i >> 2] |= (127u - (__float_as_uint(L1[i]) & 0x7Fu)) << (8 * (i & 3)); }
#pragma unroll
        for (int i = 0; i < 16; ++i) {
            const float va = __uint_as_float(__float_as_uint(L0[i]) & ~0x7Fu);
#pragma unroll
            for (int j = 0; j < 16; ++j) if ((i + 1) * (j + 1) <= 16) {
                const float vb = __uint_as_float(__float_as_uint(L1[j]) & ~0x7Fu);
                const float key = __uint_as_float((__float_as_uint(va + vb) & ~0xFFu) | (unsigned)(255 - (i * 16 + j)));
                TK_INSERT(tv, key);
            }
        }
        int ti[16];
#pragma unroll
        for (int j = 0; j < 16; ++j) { const unsigned kb = __float_as_uint(tv[j]); const unsigned flat = 255u - (kb & 0xFFu); const unsigned fi = flat >> 4, fj = flat & 15u;
            const unsigned ra = (fi < 8u) ? ((fi < 4u) ? IA[0] : IA[1]) : ((fi < 12u) ? IA[2] : IA[3]);
            const unsigned rb = (fj < 8u) ? ((fj < 4u) ? IB[0] : IB[1]) : ((fj < 12u) ? IB[2] : IB[3]);
            ti[j] = (int)(((ra >> (8u * (fi & 3u))) & 0xFFu) * 128u + ((rb >> (8u * (fj & 3u))) & 0xFFu));
            tv[j] = __uint_as_float(kb & ~0xFFu); }
        float e[16], sum = 0.f;
#pragma unroll
        for (int j = 0; j < 16; ++j) { e[j] = __expf(tv[j] - tv[0]); sum += e[j]; }
        const float inv = 1.f / sum;
        if (hi == 0) { int* ep = EXPERTS + (size_t)t * 128 + head * 16;
#pragma unroll
            for (int j = 0; j < 4; ++j) *(v4u*)(ep + 4 * j) = (v4u){(unsigned)ti[4 * j], (unsigned)ti[4 * j + 1], (unsigned)ti[4 * j + 2], (unsigned)ti[4 * j + 3]}; }
        else { float* gp = GATESP + (size_t)t * 128 + head * 16;
#pragma unroll
            for (int j = 0; j < 4; ++j) *(f32x4*)(gp + 4 * j) = (f32x4){e[4 * j] * inv, e[4 * j + 1] * inv, e[4 * j + 2] * inv, e[4 * j + 3] * inv}; }
    }
}

__device__ __forceinline__ float cvt_ub0(unsigned x) { float r; asm("v_cvt_f32_ubyte0 %0, %1" : "=v"(r) : "v"(x)); return r; }
__device__ __forceinline__ float cvt_ub1(unsigned x) { float r; asm("v_cvt_f32_ubyte1 %0, %1" : "=v"(r) : "v"(x)); return r; }
__device__ __forceinline__ float cvt_ub2(unsigned x) { float r; asm("v_cvt_f32_ubyte2 %0, %1" : "=v"(r) : "v"(x)); return r; }
__device__ __forceinline__ float cvt_ub3(unsigned x) { float r; asm("v_cvt_f32_ubyte3 %0, %1" : "=v"(r) : "v"(x)); return r; }
__device__ __forceinline__ void quant4_rows(const float* src, unsigned char* dst, float* scale, int nrows, int gw, int NGW, int lane) {
    for (int r = gw; r < nrows; r += NGW) {
        const f32x4* sp = (const f32x4*)(src + (size_t)r * 1024) + 4 * lane;
        f32x4 v[4]; float am = 0.f, ss = 0.f;
#pragma unroll
        for (int j = 0; j < 4; ++j) { v[j] = sp[j]; am = fmaxf(am, fmaxf(fmaxf(fabsf(v[j].x), fabsf(v[j].y)), fmaxf(fabsf(v[j].z), fabsf(v[j].w)))); ss += (v[j].x * v[j].x + v[j].y * v[j].y) + (v[j].z * v[j].z + v[j].w * v[j].w); }
#pragma unroll
        for (int o = 1; o < 64; o <<= 1) { am = fmaxf(am, shx(am, lane, o)); ss += shx(ss, lane, o); }
        const float step = fminf(am * (1.f / 7.5f), 0.3352f * sqrtf(ss * (1.f / 1024.f)));
        const float inv = step > 0.f ? 1.f / step : 0.f;
        unsigned q[16];
#pragma unroll
        for (int j = 0; j < 4; ++j) { q[4 * j] = (unsigned)fminf(fmaxf(rintf(v[j].x * inv + 7.5f), 0.f), 15.f); q[4 * j + 1] = (unsigned)fminf(fmaxf(rintf(v[j].y * inv + 7.5f), 0.f), 15.f);
                                      q[4 * j + 2] = (unsigned)fminf(fmaxf(rintf(v[j].z * inv + 7.5f), 0.f), 15.f); q[4 * j + 3] = (unsigned)fminf(fmaxf(rintf(v[j].w * inv + 7.5f), 0.f), 15.f); }
        u32x2 w;
        w.x = (q[0] | (q[4] << 4)) | ((q[1] | (q[5] << 4)) << 8) | ((q[2] | (q[6] << 4)) << 16) | ((q[3] | (q[7] << 4)) << 24);
        w.y = (q[8] | (q[12] << 4)) | ((q[9] | (q[13] << 4)) << 8) | ((q[10] | (q[14] << 4)) << 16) | ((q[11] | (q[15] << 4)) << 24);
        *(u32x2*)(dst + (size_t)r * 512 + 8 * lane) = w;
        if (lane == 0) scale[r] = step;
    }
}

#define RED_STEP(N, S) do { const bool up_ = (lane & (S)) != 0; _Pragma("unroll") for (int j_ = 0; j_ < (N); ++j_) { const int a_ = p[j_], b_ = p[j_ + (N)]; const int send_ = up_ ? a_ : b_, keep_ = up_ ? b_ : a_; p[j_] = keep_ + shxi(send_, lane, (S)); } } while (0)
#define RED16(dst) do { RED_STEP(8, 8); RED_STEP(4, 4); RED_STEP(2, 2); RED_STEP(1, 1); int s_ = p[0]; s_ += shxi(s_, lane, 16); s_ += shxi(s_, lane, 32); dst = s_; } while (0)
#define G_SB() __builtin_amdgcn_sched_barrier(0)
#define G_LOAD(buf, tab, evec, jb) do { _Pragma("unroll") for (int jj_ = 0; jj_ < 16; ++jj_) { const int e_ = __builtin_amdgcn_readlane(evec, (jb) + jj_); buf[jj_] = __builtin_amdgcn_raw_buffer_load_b64(rs_##tab, (int)voff, e_ << 9, 0); } } while (0)
#define U_COMP(buf) do { _Pragma("unroll") for (int jj_ = 0; jj_ < 16; ++jj_) { const unsigned w0_ = buf[jj_].x, w1_ = buf[jj_].y; \
    int d_ = __builtin_amdgcn_sdot4((int)(w0_ & 0x0F0F0F0Fu), hq[0], 0, false); d_ = __builtin_amdgcn_sdot4((int)((w0_ >> 4) & 0x0F0F0F0Fu), hq[1], d_, false); \
    d_ = __builtin_amdgcn_sdot4((int)(w1_ & 0x0F0F0F0Fu), hq[2], d_, false); d_ = __builtin_amdgcn_sdot4((int)((w1_ >> 4) & 0x0F0F0F0Fu), hq[3], d_, false); p[jj_] = d_; } } while (0)
#define V_DW(o0, o1, o2, o3, wd, cs) do { float t0_, t1_, t2_, t3_; asm volatile("v_cvt_f32_ubyte0 %4, %8\n\tv_cvt_f32_ubyte1 %5, %8\n\tv_cvt_f32_ubyte2 %6, %8\n\tv_cvt_f32_ubyte3 %7, %8\n\tv_fmac_f32 %0, %9, %4\n\tv_fmac_f32 %1, %9, %5\n\tv_fmac_f32 %2, %9, %6\n\tv_fmac_f32 %3, %9, %7" \
    : "+v"(o0), "+v"(o1), "+v"(o2), "+v"(o3), "=&v"(t0_), "=&v"(t1_), "=&v"(t2_), "=&v"(t3_) : "v"(wd), "s"(cs)); } while (0)
#define V_COMP(buf, cvec, jb) do { _Pragma("unroll") for (int jj_ = 0; jj_ < 16; ++jj_) { const float c_ = __uint_as_float(__builtin_amdgcn_readlane(__float_as_uint(cvec), (jb) + jj_)); const unsigned w0_ = buf[jj_].x, w1_ = buf[jj_].y; \
    V_DW(o[0], o[1], o[2], o[3], w0_ & 0x0F0F0F0Fu, c_); V_DW(o[4], o[5], o[6], o[7], (w0_ >> 4) & 0x0F0F0F0Fu, c_); V_DW(o[8], o[9], o[10], o[11], w1_ & 0x0F0F0F0Fu, c_); V_DW(o[12], o[13], o[14], o[15], (w1_ >> 4) & 0x0F0F0F0Fu, c_); } } while (0)
template <bool NEXT_NORM>
__device__ __forceinline__ void peer_gather_phase(const int wv, bool dry, int vcu, const bf16* HN, const int* EXPERTS, const float* GATESP, const unsigned char* U, const float* SU, const unsigned char* Vtab, const float* SV,
                                                  float* X, const float* gnext, bf16* XN) {
    int ln_; asm volatile("v_mbcnt_lo_u32_b32 %0, -1, 0\n\tv_mbcnt_hi_u32_b32 %0, -1, %0" : "=v"(ln_)); const int tid = wv * 64 + ln_, lane = tid & 63, w = wv;
    const __amdgpu_buffer_rsrc_t rs_U = __builtin_amdgcn_make_buffer_rsrc((void*)U, (short)0, 16384 * 512, 0x00020000), rs_Vtab = __builtin_amdgcn_make_buffer_rsrc((void*)Vtab, (short)0, 16384 * 512, 0x00020000);
    const unsigned voff = (unsigned)lane * 8u;
    const int lg = lane >> 4;
#pragma unroll 1
    for (int i = 0; i < 16; ++i) {
        const int t = vcu * 128 + w * 16 + i;
        const int ev0 = EXPERTS[(size_t)t * 128 + lane], ev1 = EXPERTS[(size_t)t * 128 + 64 + lane];
        const float gv0 = GATESP[(size_t)t * 128 + lane], gv1 = GATESP[(size_t)t * 128 + 64 + lane];
        const v4u h0 = *(const v4u*)(HN + (size_t)t * 1024 + 16 * lane), h1 = *(const v4u*)(HN + (size_t)t * 1024 + 16 * lane + 8);
        float hf[16]; float am = 0.f;
#pragma unroll
        for (int k = 0; k < 4; ++k) { hf[2 * k] = bf_lo(h0[k]); hf[2 * k + 1] = bf_hi(h0[k]); hf[8 + 2 * k] = bf_lo(h1[k]); hf[9 + 2 * k] = bf_hi(h1[k]); }
#pragma unroll
        for (int k = 0; k < 16; ++k) am = fmaxf(am, fabsf(hf[k]));
#pragma unroll
        for (int o = 1; o < 64; o <<= 1) am = fmaxf(am, shx(am, lane, o));
        const float hinv = am > 0.f ? 127.f / am : 0.f, sh = am * (1.f / 127.f);
        int hq[4]; int hs = 0;
#pragma unroll
        for (int k = 0; k < 4; ++k) { const int q0 = (int)rintf(hf[4 * k] * hinv), q1 = (int)rintf(hf[4 * k + 1] * hinv), q2 = (int)rintf(hf[4 * k + 2] * hinv), q3 = (int)rintf(hf[4 * k + 3] * hinv); hs += (q0 + q1) + (q2 + q3);
            hq[k] = (int)(((unsigned)(q0 & 0xff)) | ((unsigned)(q1 & 0xff) << 8) | ((unsigned)(q2 & 0xff) << 16) | ((unsigned)(q3 & 0xff) << 24)); }
#pragma unroll
        for (int o = 1; o < 64; o <<= 1) hs += shxi(hs, lane, o);
        const float hoff = 7.5f * (float)hs;
        const float su0 = SU[ev0], su1 = SU[ev1], sv0 = SV[ev0], sv1 = SV[ev1];
        float o[16];
#pragma unroll
        for (int k = 0; k < 16; ++k) o[k] = 0.f;
        int p[16], r0, r1, r2, r3, r4, r5, r6, r7;
        u32x2 A[16], B[16], C[16];
        G_LOAD(A, U, ev0, 0); G_LOAD(B, U, ev0, 16); G_SB();
        G_LOAD(C, U, ev0, 32); G_SB(); U_COMP(A); RED16(r0); G_SB();
        G_LOAD(A, U, ev0, 48); G_SB(); U_COMP(B); RED16(r1); G_SB();
        G_LOAD(B, U, ev1, 0); G_SB(); U_COMP(C); RED16(r2); G_SB();
        G_LOAD(C, U, ev1, 16); G_SB(); U_COMP(A); RED16(r3); G_SB();
        G_LOAD(A, U, ev1, 32); G_SB(); U_COMP(B); RED16(r4); G_SB();
        G_LOAD(B, U, ev1, 48); G_SB(); U_COMP(C); RED16(r5); G_SB();
        G_LOAD(C, Vtab, ev0, 0); G_SB(); U_COMP(A); RED16(r6); G_SB();
        G_LOAD(A, Vtab, ev0, 16); G_SB(); U_COMP(B); RED16(r7); G_SB();
        const int d0 = lg == 0 ? r0 : (lg == 1 ? r1 : (lg == 2 ? r2 : r3)), d1 = lg == 0 ? r4 : (lg == 1 ? r5 : (lg == 2 ? r6 : r7));
        float act0 = ((float)d0 - hoff) * (sh * su0), act1 = ((float)d1 - hoff) * (sh * su1);
#ifdef PROBE_NOFFN
        const float coef0 = 0.f * act0, coef1 = 0.f * act1;
#else
        const float coef0 = gv0 * (0.5f * act0 * (1.f + erff(act0 * 0.70710678118f))) * sv0, coef1 = gv1 * (0.5f * act1 * (1.f + erff(act1 * 0.70710678118f))) * sv1;
#endif
        G_SB();
        G_LOAD(B, Vtab, ev0, 32); G_SB(); V_COMP(C, coef0, 0); G_SB();
        G_LOAD(C, Vtab, ev0, 48); G_SB(); V_COMP(A, coef0, 16); G_SB();
        G_LOAD(A, Vtab, ev1, 0); G_SB(); V_COMP(B, coef0, 32); G_SB();
        G_LOAD(B, Vtab, ev1, 16); G_SB(); V_COMP(C, coef0, 48); G_SB();
        G_LOAD(C, Vtab, ev1, 32); G_SB(); V_COMP(A, coef1, 0); G_SB();
        G_LOAD(A, Vtab, ev1, 48); G_SB(); V_COMP(B, coef1, 16); G_SB();
        V_COMP(C, coef1, 32); G_SB(); V_COMP(A, coef1, 48); G_SB();
        const float corr = 7.5f * wave_sum(coef0 + coef1, lane);
        float* xr = X + (size_t)t * 1024 + 16 * lane;
        f32x4 xv[4];
#pragma unroll
        for (int k = 0; k < 4; ++k) { xv[k] = *(const f32x4*)(xr + 4 * k); xv[k] += (f32x4){o[4 * k] - corr, o[4 * k + 1] - corr, o[4 * k + 2] - corr, o[4 * k + 3] - corr}; }
        if (!dry) {
#pragma unroll
            for (int k = 0; k < 4; ++k) *(f32x4*)(xr + 4 * k) = xv[k]; }
        if (NEXT_NORM && !dry) {
            float ss = 0.f;
#pragma unroll
            for (int k = 0; k < 4; ++k) ss += (xv[k].x * xv[k].x + xv[k].y * xv[k].y) + (xv[k].z * xv[k].z + xv[k].w * xv[k].w);
            const float rstd = rsqrtf(wave_sum(ss, lane) * (1.f / 1024.f) + EPS);
            v4u wa, wb;
#pragma unroll
            for (int k = 0; k < 4; ++k) { const f32x4 g = *(const f32x4*)(gnext + 16 * lane + 4 * k); const unsigned lo = pk2(xv[k].x * rstd * g.x, xv[k].y * rstd * g.y), hi2 = pk2(xv[k].z * rstd * g.z, xv[k].w * rstd * g.w);
                if (k < 2) { wa[2 * k] = lo; wa[2 * k + 1] = hi2; } else { wb[2 * (k - 2)] = lo; wb[2 * (k - 2) + 1] = hi2; } }
            *(v4u*)(XN + (size_t)t * 1024 + 16 * lane) = wa; *(v4u*)(XN + (size_t)t * 1024 + 16 * lane + 8) = wb;
        }
    }
}

__device__ __forceinline__ void qknorm_rope_pass(bf16* Q1, bf16* K1, const float* qg, const float* kg, const float* rope, size_t gtid, size_t gthreads) {
    const size_t NROWS = (size_t)2 * 64 * 2 * 4096;
    const int lane = (int)(gtid & 63);
    for (size_t id = gtid; id < NROWS * 8; id += gthreads) {
        const size_t rowg = id >> 3; const int part = (int)(id & 7);
        const bool isk = rowg >= NROWS / 2; const size_t row = isk ? rowg - NROWS / 2 : rowg;
        bf16* ptr = (isk ? K1 : Q1) + row * 64 + part * 8; const float* g = (isk ? kg : qg) + part * 8;
        const int s = (int)(row & 4095); const int bh = (int)(row >> 13); const int bidx = bh >> 3; const size_t mtok = (size_t)bidx * 4096 + s;
        const v4u raw = *(const v4u*)ptr;
        float x[8];
#pragma unroll
        for (int i = 0; i < 4; ++i) { x[2 * i] = bf_lo(raw[i]); x[2 * i + 1] = bf_hi(raw[i]); }
        float ss = 0.f;
#pragma unroll
        for (int i = 0; i < 8; ++i) ss += x[i] * x[i];
        ss += shx(ss, lane, 1); ss += shx(ss, lane, 2); ss += shx(ss, lane, 4);
        const float rstd = rsqrtf(ss * (1.f / 64.f) + EPS);
        float y[8], other[8];
#pragma unroll
        for (int i = 0; i < 8; ++i) y[i] = x[i] * rstd * g[i];
#pragma unroll
        for (int i = 0; i < 8; ++i) other[i] = shx(y[i], lane, 1);
        if (part < 2) { const float* cs = rope + mtok * 16;
#pragma unroll
            for (int i = 0; i < 8; ++i) { const float co = cs[i], si = cs[8 + i]; y[i] = (part == 0) ? (y[i] * co - other[i] * si) : (y[i] * co + other[i] * si); } }
        const float sc = isk ? 1.f : (0.125f * 1.44269504089f);
        v4u o;
#pragma unroll
        for (int i = 0; i < 4; ++i) o[i] = pk2(y[2 * i] * sc, y[2 * i + 1] * sc);
        *(v4u*)ptr = o;
    }
}

__device__ __forceinline__ void glds16(const void* gsrc, unsigned lds_dst) { unsigned keep;
    asm volatile("s_mov_b32 %0, m0\n\ts_mov_b32 m0, %2\n\ts_nop 0\n\tglobal_load_lds_dwordx4 %1, off\n\ts_mov_b32 m0, %0" : "=&s"(keep) : "v"(gsrc), "s"(lds_dst) : "memory"); }
#define AT_WAIT_BAR() asm volatile("s_waitcnt vmcnt(0) lgkmcnt(0)\n\ts_barrier" ::: "memory")
#define AT_DMA(kt_, slot_) do { \
    _Pragma("unroll") for (int i_ = 0; i_ < 2; ++i_) { const int row_ = 8 * w + (lane >> 3), ch_ = (lane & 7) ^ ((row_ >> 1) & 7); \
        glds16(K1 + ((size_t)((bh * 2 + i_) * 4096 + (kt_) * 64 + row_)) * 64 + ch_ * 8, (unsigned)__builtin_amdgcn_readfirstlane((int)(ldsb + (slot_) * 32768 + i_ * 8192 + w * 1024))); } \
    _Pragma("unroll") for (int i_ = 0; i_ < 2; ++i_) { const int row_ = 8 * w + 4 * i_ + (lane >> 4), ch_ = (lane & 15) ^ ((row_ & 3) << 2); \
        glds16(V1 + ((size_t)(bh * 4096 + (kt_) * 64 + row_)) * 128 + ch_ * 8, (unsigned)__builtin_amdgcn_readfirstlane((int)(ldsb + (slot_) * 32768 + 16384 + w * 2048 + i_ * 1024))); } } while (0)
typedef short v4i16_t __attribute__((ext_vector_type(4)));
__device__ __forceinline__ bf16x8 vtr8(const LAS bf16* p) {
    const v4i16_t lo = __builtin_amdgcn_ds_read_tr16_b64_v4i16((LAS v4i16_t*)p), hi = __builtin_amdgcn_ds_read_tr16_b64_v4i16((LAS v4i16_t*)(p + 8 * 128));
    return (bf16x8){lo[0], lo[1], lo[2], lo[3], hi[0], hi[1], hi[2], hi[3]};
}
template <bool OFFS>
__device__ __forceinline__ void attn_units(const int wv, LAS unsigned char* lds, int vcu, const bf16* Q1, const bf16* K1, const bf16* V1, bf16* O, const float* subln, float lam, float offs) {
    int ln_; asm volatile("v_mbcnt_lo_u32_b32 %0, -1, 0\n\tv_mbcnt_hi_u32_b32 %0, -1, %0" : "=v"(ln_)); const int tid = wv * 64 + ln_, lane = tid & 63, w = wv, r32 = lane & 31, hi = lane >> 5, qt = w & 3, c = w >> 2;
    LAS float* lbuf = (LAS float*)(lds + 135168 + w * 128);
    LAS float* Obuf = (LAS float*)lds;
    const unsigned ldsb = (unsigned)(uintptr_t)lds;
#pragma unroll 1
    for (int ui = 0; ui < 8; ++ui) {
        const int uid = vcu * 8 + ui, bh = uid >> 5, qb = uid & 31, b = bh >> 3, h = bh & 7;
        bf16x8 bq[4];
#pragma unroll
        for (int ks = 0; ks < 4; ++ks) bq[ks] = *(const bf16x8*)(Q1 + ((size_t)((bh * 2 + c) * 4096 + qb * 128 + qt * 32 + r32)) * 64 + ks * 16 + 8 * hi);
        f32x16 Oa[4];
#pragma unroll
        for (int db = 0; db < 4; ++db)
#pragma unroll
            for (int r = 0; r < 16; ++r) Oa[db][r] = 0.f;
        float lsum = 0.f;
        AT_DMA(0, 0); AT_DMA(1, 1);
        AT_WAIT_BAR();
        const int kx0 = (r32 >> 1) & 7, kx1 = ((32 + r32) >> 1) & 7;
        const int vrow = 4 * hi + ((lane >> 2) & 3), vg = (lane >> 4) & 1, vp = lane & 3;
        f32x16 s0, s1;
        { const LAS unsigned char* Kc = lds + c * 8192;
#pragma unroll
          for (int r = 0; r < 16; ++r) { s0[r] = 0.f; s1[r] = 0.f; }
#pragma unroll
          for (int ks = 0; ks < 4; ++ks) { const bf16x8 a0 = *(const LAS bf16x8*)(Kc + r32 * 128 + (((2 * ks + hi) ^ kx0) << 4)), a1 = *(const LAS bf16x8*)(Kc + (32 + r32) * 128 + (((2 * ks + hi) ^ kx1) << 4));
              s0 = mfma32(a0, bq[ks], s0); s1 = mfma32(a1, bq[ks], s1); } }
        int b0 = 0, b1 = 1, b2 = 2;
#pragma unroll 1
        for (int kt = 0; kt < 64; ++kt) {
            if (kt + 2 < 64) AT_DMA(kt + 2, b2);
            const LAS unsigned char* Kc = lds + b1 * 32768 + c * 8192;
            const LAS unsigned char* Vb = lds + b0 * 32768 + 16384 + vrow * 256 + 8 * (vp & 1);
            f32x16 n0, n1;
#pragma unroll
            for (int r = 0; r < 16; ++r) { n0[r] = 0.f; n1[r] = 0.f; }
            bf16x8 ka[8];
#define AT_KLD(ks_) do { ka[2 * (ks_)] = *(const LAS bf16x8*)(Kc + r32 * 128 + (((2 * (ks_) + hi) ^ kx0) << 4)); ka[2 * (ks_) + 1] = *(const LAS bf16x8*)(Kc + (32 + r32) * 128 + (((2 * (ks_) + hi) ^ kx1) << 4)); } while (0)
            AT_KLD(0); AT_KLD(1);
            __builtin_amdgcn_sched_barrier(0);
#pragma unroll
            for (int ks = 0; ks < 4; ++ks) {
                n0 = mfma32(ka[2 * ks], bq[ks], n0);
#pragma unroll
                for (int r = 0; r < 4; ++r) s0[4 * ks + r] = __builtin_amdgcn_exp2f(OFFS ? s0[4 * ks + r] - offs : s0[4 * ks + r]);
                __builtin_amdgcn_sched_barrier(0);
                n1 = mfma32(ka[2 * ks + 1], bq[ks], n1);
                if (ks < 2) AT_KLD(ks + 2);
#pragma unroll
                for (int r = 0; r < 4; ++r) s1[4 * ks + r] = __builtin_amdgcn_exp2f(OFFS ? s1[4 * ks + r] - offs : s1[4 * ks + r]);
                __builtin_amdgcn_sched_barrier(0);
            }
#undef AT_KLD
            bf16x8 pa[4]; bf16x8 vf[4], vn[4];
#pragma unroll
            for (int db = 0; db < 4; ++db) vf[db] = vtr8((const LAS bf16*)(Vb + (((4 * db + 2 * vg + (vp >> 1)) ^ ((vrow & 3) << 2)) << 4)));
            float ls = 0.f;
            { v4u t0;
#pragma unroll
              for (int k = 0; k < 4; ++k) { t0[k] = pk2(s0[2 * k], s0[2 * k + 1]); ls += s0[2 * k] + s0[2 * k + 1]; }
              pa[0] = __builtin_bit_cast(bf16x8, t0); }
            __builtin_amdgcn_sched_barrier(0);
#pragma unroll
            for (int sp_ = 0; sp_ < 4; ++sp_) {
                if (sp_ < 3) {
#pragma unroll
                    for (int db = 0; db < 4; ++db) vn[db] = vtr8((const LAS bf16*)(Vb + (16 * (sp_ + 1)) * 256 + (((4 * db + 2 * vg + (vp >> 1)) ^ ((vrow & 3) << 2)) << 4)));
                }
#pragma unroll
                for (int db = 0; db < 4; ++db) Oa[db] = mfma32(pa[sp_], vf[db], Oa[db]);
                if (sp_ < 3) { v4u t0;
#pragma unroll
                    for (int k = 0; k < 4; ++k) { const float x0 = (sp_ == 0) ? s0[8 + 2 * k] : (sp_ == 1 ? s1[2 * k] : s1[8 + 2 * k]), x1 = (sp_ == 0) ? s0[9 + 2 * k] : (sp_ == 1 ? s1[2 * k + 1] : s1[9 + 2 * k]); t0[k] = pk2(x0, x1); ls += x0 + x1; }
                    pa[sp_ + 1] = __builtin_bit_cast(bf16x8, t0); }
                __builtin_amdgcn_sched_barrier(0);
                if (sp_ < 3) {
#pragma unroll
                    for (int db = 0; db < 4; ++db) vf[db] = vn[db];
                }
            }
            lsum += ls;
            s0 = n0; s1 = n1;
            { const int tb = b0; b0 = b1; b1 = b2; b2 = tb; }
            AT_WAIT_BAR();
        }
        lsum += shx(lsum, lane, 32);
        lbuf[r32] = lsum;
#pragma unroll
        for (int r = 0; r < 16; ++r) { const int qrow = (r & 3) + 8 * (r >> 2) + 4 * hi; const float inv = 1.f / lbuf[qrow];
#pragma unroll
            for (int db = 0; db < 4; ++db) Obuf[(c * 128 + qt * 32 + qrow) * 132 + 32 * db + r32] = Oa[db][r] * inv; }
        __syncthreads();
        { const int row = tid >> 2, qd = tid & 3;
          float dv[32]; float ss = 0.f;
#pragma unroll
          for (int k = 0; k < 8; ++k) { const f32x4 o0 = *(const LAS f32x4*)(Obuf + row * 132 + qd * 32 + 4 * k), o1 = *(const LAS f32x4*)(Obuf + (128 + row) * 132 + qd * 32 + 4 * k);
#pragma unroll
              for (int e = 0; e < 4; ++e) { const float d = o0[e] - lam * o1[e]; dv[4 * k + e] = d; ss += d * d; } }
          ss += shx(ss, lane, 1); ss += shx(ss, lane, 2);
          const float rstd = rsqrtf(ss * (1.f / 128.f) + EPS) * (1.f - LAMBDA_INIT);
          bf16* op = O + ((size_t)b * 4096 + qb * 128 + row) * 1024 + h * 128 + qd * 32;
#pragma unroll
          for (int k = 0; k < 4; ++k) { v4u o;
#pragma unroll
              for (int e = 0; e < 4; ++e) o[e] = pk2(dv[8 * k + 2 * e] * rstd * subln[qd * 32 + 8 * k + 2 * e], dv[8 * k + 2 * e + 1] * rstd * subln[qd * 32 + 8 * k + 2 * e + 1]);
              *(v4u*)(op + 8 * k) = o; } }
        __syncthreads();
    }
}
__device__ __forceinline__ void attn_phase(const int wv, LAS unsigned char* lds, int vcu, const bf16* Q1, const bf16* K1, const bf16* V1, bf16* O, const float* qg, const float* kg,
                                           const float* lq1, const float* lk1, const float* lq2, const float* lk2, const float* subln) {
    float s1 = 0.f, s2 = 0.f, mq = 0.f, mk = 0.f;
    for (int i = 0; i < 64; ++i) { s1 += lq1[i] * lk1[i]; s2 += lq2[i] * lk2[i]; mq = fmaxf(mq, fabsf(qg[i])); mk = fmaxf(mk, fabsf(kg[i])); }
    const float lam = expf(s1) - expf(s2) + LAMBDA_INIT;
    const float offs = 8.f * mq * mk * 1.44269504089f * 1.02f + 0.25f;
    if (offs < 24.f) attn_units<false>(wv, lds, vcu, Q1, K1, V1, O, subln, lam, 0.f);
    else attn_units<true>(wv, lds, vcu, Q1, K1, V1, O, subln, lam, offs);
}
#undef AT_LOAD
#undef AT_WRITE
struct Args { const void* in[27]; float* out; unsigned char* ws; };
#define KARG(i) ({ GAS const void* p_; asm volatile("s_load_dwordx2 %0, %1, %2\n\ts_waitcnt lgkmcnt(0)" : "=s"(p_) : "s"(__builtin_amdgcn_kernarg_segment_ptr()), "i"(8 * (i))); (const void*)p_; })
#define KIN(i) ((const float*)KARG(i))
#define KOUT() ((float*)KARG(27))
#define KWS() ((unsigned char*)KARG(28))
#define WSP(T_, off) ((T_*)(KWS() + (off)))
__global__ void __launch_bounds__(NWAVES * 64, 2) mk_fwd(Args args) {
    extern __shared__ __attribute__((aligned(16))) unsigned char lds_raw[];
    LAS unsigned char* lds = (LAS unsigned char*)lds_raw;
    const int G = gridDim.x, bx = blockIdx.x;
    const int wv = __builtin_amdgcn_readfirstlane((int)(threadIdx.x >> 6));
    const int vcu = (G % 8 == 0) ? (bx % 8) * (G / 8) + bx / 8 : bx;
#define PH_IDS() int ln_; asm volatile("v_mbcnt_lo_u32_b32 %0, -1, 0\n\tv_mbcnt_hi_u32_b32 %0, -1, %0" : "=v"(ln_)); const int lane = ln_, wave = wv, tid = wv * 64 + ln_; \
    const int gw = vcu * NWAVES + wave, NGW = G * NWAVES; const size_t gtid = (size_t)vcu * (NWAVES * 64) + tid, gthreads = (size_t)G * (NWAVES * 64); (void)lane; (void)gw; (void)NGW; (void)gtid; (void)gthreads
    if (threadIdx.x < 32) ((LAS unsigned*)(lds + MISC_OFF))[threadIdx.x] = 0u;
    __syncthreads();
    (void)xcd_barrier_post((unsigned*)(WSP(gu32, WS_CTL) + CW_BAR), (volatile LAS unsigned*)(lds + MISC_OFF) + 8);
#define STAMP() do {} while (0)
#ifndef PROBE_DUP
#define PROBE_DUP 0
#endif
#define REPS(bit) _Pragma("unroll 1") for (int rep_ = 0; rep_ < 1 + ((PROBE_DUP >> (bit)) & 1); ++rep_)
#define GRID_BAR1() do { XcdBarrier b_; b_.bar = (unsigned*)(WSP(gu32, WS_CTL) + CW_BAR); b_.x = xb_xcc_id(); b_.st = (volatile LAS unsigned*)(lds + MISC_OFF) + 8; xcd_barrier(b_); } while (0)
#define GRID_BAR() do { GRID_BAR1(); if ((PROBE_DUP >> 9) & 1) GRID_BAR1(); } while (0)

    REPS(5) {
        PH_IDS();
        LAS float* scr = (LAS float*)(lds + wave * 16384);
        constexpr int I0 = 16 * 97, I1 = 16 * 32, I2 = 16 * 64, I3 = 16 * 96, I4 = 16 * 32, I5 = 16 * 64, NITEMS = I0 + I1 + I2 + I3 + I4 + I5;
        for (int it = gw; it < NITEMS; it += NGW) {
            int r = it;
            if (r < I0) { p0_transpose_item(KIN(3), 1024, 3104, WSP(bf16, WS_WIN), scr, r, lane); continue; } r -= I0;
            if (r < I1) { p0_transpose_item(KIN(6), 1024, 1024, WSP(bf16, WS_WO0), scr, r, lane); continue; } r -= I1;
            if (r < I2) { p0_transpose_item(KIN(8), 1024, 2048, WSP(bf16, WS_WQ0), scr, r, lane); continue; } r -= I2;
            if (r < I3) { p0_transpose_item(KIN(13), 1024, 3072, WSP(bf16, WS_WQKV), scr, r, lane); continue; } r -= I3;
            if (r < I4) { p0_transpose_item(KIN(21), 1024, 1024, WSP(bf16, WS_WO1), scr, r, lane); continue; } r -= I4;
            p0_transpose_item(KIN(23), 1024, 2048, WSP(bf16, WS_WQ1), scr, r, lane);
        }
        { bf16* WIN = WSP(bf16, WS_WIN); for (size_t i = gtid * 8; i < (size_t)224 * 1024; i += gthreads * 8) *(v4u*)(WIN + (size_t)3104 * 1024 + i) = (v4u){0u, 0u, 0u, 0u}; }
        cvt_range(KIN(9), WSP(bf16, WS_KEY0), (size_t)262144, gtid, gthreads);
        cvt_range(KIN(24), WSP(bf16, WS_KEY1), (size_t)262144, gtid, gthreads);
        quant4_rows(KIN(10), WSP(unsigned char, WS_U0), WSP(float, WS_SC), 16384, gw, NGW, lane);
        quant4_rows(KIN(11), WSP(unsigned char, WS_V0T), WSP(float, WS_SC + 65536), 16384, gw, NGW, lane);
        quant4_rows(KIN(25), WSP(unsigned char, WS_U1), WSP(float, WS_SC + 2 * 65536), 16384, gw, NGW, lane);
        quant4_rows(KIN(26), WSP(unsigned char, WS_V1T), WSP(float, WS_SC + 3 * 65536), 16384, gw, NGW, lane);
        rms_pass(KIN(0), KIN(2), WSP(bf16, WS_B0), gw, NGW, lane);
        { const int* positions = (const int*)KARG(1); float* ROPE = WSP(float, WS_ROPE);
          for (size_t id = gtid; id < (size_t)T * 8; id += gthreads) { const size_t mtok = id >> 3; const int i = (int)(id & 7);
            const float inv = powf(500000.0f, -(float)i * 2.0f / 16.0f); const float ang = (float)positions[mtok] * inv;
            float sn, cs; sincosf(ang, &sn, &cs); ROPE[mtok * 16 + i] = cs; ROPE[mtok * 16 + 8 + i] = sn; } }
    }
    GRID_BAR();
    REPS(3) {
        unsigned char* ws = KWS();
        pg8::Gemm g{(const bf16*)(ws + WS_B0), (const bf16*)(ws + WS_WIN), T, 3328, 1024}; pg8::StaticOrder S; S.init(T, 3328, G, bx);
        pg8::EpiInProj E{(bf16*)(ws + WS_R1), (bf16*)(ws + WS_R1 + 32 * MiB), (bf16*)(ws + WS_R2), (bf16*)(ws + WS_R3), (float*)(ws + WS_GATES), KIN(4)};
        pg8::gemm_phase<pg8::EpiInProj, pg8::StaticOrder, true, true>(lds, g, S, E, wv);
    }
    GRID_BAR();
    REPS(2) { unsigned char* ws = KWS(); mlstm_phase(wv, lds, (const bf16*)(ws + WS_R1), (const bf16*)(ws + WS_R1 + 32 * MiB), (const bf16*)(ws + WS_R2), (const float*)(ws + WS_GATES), (bf16*)(ws + WS_R4), (bf16*)(ws + WS_R5)); }
    GRID_BAR();
    REPS(6) { PH_IDS(); unsigned char* ws = KWS(); hs_pass((const bf16*)(ws + WS_R4), (const bf16*)(ws + WS_R5), (const bf16*)(ws + WS_R3), KIN(5), (bf16*)(ws + WS_B0), gw, NGW, lane); }
    GRID_BAR();
#pragma unroll 1
    for (int L = 0; L < 2; ++L) {
        if (L == 1) {
            REPS(3) {
                unsigned char* ws = KWS();
                pg8::Gemm g{(const bf16*)(ws + WS_B0), (const bf16*)(ws + WS_WQKV), T, 3072, 1024}; pg8::StaticOrder S; S.init(T, 3072, G, bx);
                pg8::EpiQKV E{(bf16*)(ws + WS_R2), (bf16*)(ws + WS_R3), (bf16*)(ws + WS_R4)};
                pg8::gemm_phase<pg8::EpiQKV, pg8::StaticOrder, true, true>(lds, g, S, E, wv);
            }
            GRID_BAR();
            { PH_IDS(); unsigned char* ws = KWS(); qknorm_rope_pass((bf16*)(ws + WS_R2), (bf16*)(ws + WS_R3), KIN(14), KIN(15), (const float*)(ws + WS_ROPE), gtid, gthreads); }
            GRID_BAR();
            REPS(0) { unsigned char* ws = KWS(); attn_phase(wv, lds, vcu, (const bf16*)(ws + WS_R2), (const bf16*)(ws + WS_R3), (const bf16*)(ws + WS_R4), (bf16*)(ws + WS_B0), KIN(14), KIN(15), KIN(16), KIN(17), KIN(18), KIN(19), KIN(20)); }
            GRID_BAR();
        }
        _Pragma("unroll 1") for (int rep_ = 0; rep_ < 1 + ((L == 0) ? ((PROBE_DUP >> 3) & 1) : 0); ++rep_) {
            unsigned char* ws = KWS(); float* out = KOUT();
            pg8::Gemm g{(const bf16*)(ws + WS_B0), (const bf16*)(ws + (L ? WS_WO1 : WS_WO0)), T, 1024, 1024}; pg8::StaticOrder S; S.init(T, 1024, G, bx);
            pg8::EpiRes E{L ? (const float*)out : KIN(0), out};
            pg8::gemm_phase<pg8::EpiRes, pg8::StaticOrder, true, true>(lds, g, S, E, wv);
        }
        GRID_BAR();
        REPS(7) { PH_IDS(); rms_pass(KOUT(), L ? KIN(22) : KIN(7), WSP(bf16, WS_B0), gw, NGW, lane); }
        GRID_BAR();
        REPS(3) {
            unsigned char* ws = KWS();
            pg8::Gemm g{(const bf16*)(ws + WS_B0), (const bf16*)(ws + (L ? WS_WQ1 : WS_WQ0)), T, 2048, 1024}; pg8::StaticOrder S; S.init(T, 2048, G, bx);
            pg8::EpiPlain E{(bf16*)(ws + WS_R2), 2048};
            pg8::gemm_phase<pg8::EpiPlain, pg8::StaticOrder, true, true>(lds, g, S, E, wv);
        }
        GRID_BAR();
        REPS(4) { unsigned char* ws = KWS(); peer_topk_phase(wv, vcu, (const bf16*)(ws + WS_R2), (const bf16*)(ws + (L ? WS_KEY1 : WS_KEY0)), (int*)(ws + WS_R4), (float*)(ws + WS_R4 + 16 * MiB)); }
        GRID_BAR();
        if (L == 0) { unsigned char* ws = KWS();
            if ((PROBE_DUP >> 1) & 1) peer_gather_phase<true>(wv, gridDim.y == 1, vcu, (const bf16*)(ws + WS_B0), (const int*)(ws + WS_R4), (const float*)(ws + WS_R4 + 16 * MiB), ws + WS_U0, (const float*)(ws + WS_SC), ws + WS_V0T, (const float*)(ws + WS_SC + 65536), KOUT(), KIN(12), (bf16*)(ws + WS_B0));
            peer_gather_phase<true>(wv, false, vcu, (const bf16*)(ws + WS_B0), (const int*)(ws + WS_R4), (const float*)(ws + WS_R4 + 16 * MiB), ws + WS_U0, (const float*)(ws + WS_SC), ws + WS_V0T, (const float*)(ws + WS_SC + 65536), KOUT(), KIN(12), (bf16*)(ws + WS_B0)); GRID_BAR(); }
        else { unsigned char* ws = KWS(); peer_gather_phase<false>(wv, false, vcu, (const bf16*)(ws + WS_B0), (const int*)(ws + WS_R4), (const float*)(ws + WS_R4 + 16 * MiB), ws + WS_U1, (const float*)(ws + WS_SC + 2 * 65536), ws + WS_V1T, (const float*)(ws + WS_SC + 3 * 65536), KOUT(), nullptr, nullptr); }
    }
#undef GRID_BAR
}

extern "C" void kernel_launch(void* const* d_in, const int* in_sizes, int n_in, void* d_out, int out_size, void* d_ws, size_t ws_size, hipStream_t stream) {
    static int ready = 0;
    if (ready == 0) {
        if (n_in != 27 || out_size != T * D || ws_size < WS_END) { fprintf(stderr, "kernel_launch: unexpected problem (n_in %d, out %d, ws %zu)\n", n_in, out_size, ws_size); ready = -1; return; }
        if (hipFuncSetAttribute((const void*)mk_fwd, hipFuncAttributeMaxDynamicSharedMemorySize, LDS_BYTES) != hipSuccess) { fprintf(stderr, "kernel_launch: hipFuncSetAttribute failed\n"); ready = -1; return; }
        (void)hipGetLastError();
        ready = 1;
    }
    if (ready < 0) return;
    if (hipMemsetAsync((char*)d_ws + WS_CTL, 0, CTL_ZERO_BYTES, stream) != hipSuccess) { fprintf(stderr, "kernel_launch: memset failed\n"); return; }
    Args a{};
    for (int i = 0; i < 27; ++i) a.in[i] = d_in[i];
    a.out = (float*)d_out; a.ws = (unsigned char*)d_ws;
    hipLaunchKernelGGL(mk_fwd, dim3(256), dim3(NWAVES * 64), LDS_BYTES, stream, a);
}
```

```cpp
#include <hip/hip_runtime.h>
#include <hip/hip_bf16.h>
#include <cstdio>
#include <cstdint>
#include <cmath>
namespace pg8 {
#define PG8_LAS __attribute__((address_space(3)))
typedef unsigned short bf16_t;
typedef short bf16x8 __attribute__((ext_vector_type(8)));
typedef float f32x4 __attribute__((ext_vector_type(4)));
typedef unsigned u32x4 __attribute__((ext_vector_type(4)));
constexpr int BM = 256, BK = 64, HALF = 128, HTB = HALF * BK * 2  , STAGE_BYTES = 8 * HTB, NXCD = 8, WGM = 8;

__host__ __device__ __forceinline__ int lds_byte(int r, int c) { const int st = (r >> 4) * 2 + (c >> 5), rr = r & 15, cc = c & 31, ob = rr * 64 + cc * 2; return st * 1024 + (ob ^ (((ob >> 9) & 1) << 5)); }
__host__ __device__ __forceinline__ void stage_rc(int b, int& R, int& C) { const int st = b / 1024, sb = b % 1024, swz = sb ^ (((sb >> 9) & 1) << 5); R = (st >> 1) * 16 + swz / 64; C = (st & 1) * 32 + (swz % 64) / 2; }
__host__ __device__ __forceinline__ int perm32(int rho) { const int n = rho >> 4, i = rho & 15; return 8 * (i >> 2) + 4 * n + (i & 3); }

struct Unit { int pm, pn; };
struct Gemm { const bf16_t* A; const bf16_t* Bt; int M, N, K; };

struct StaticOrder {
    int nM, nN, nwg, G, c;
    __host__ __device__ void init(int M, int N, int G_, int c_) { nM = M / BM; nN = N / BM; nwg = nM * nN; G = G_; c = c_; }
    __host__ __device__ bool next(int i, Unit& u) const {
        const long L = (long)i * G + c; if (L >= nwg) return false;
        int wgid = (int)L; { const int q = nwg / NXCD, r = nwg % NXCD, xcd = wgid % NXCD, off = wgid / NXCD; wgid = (xcd < r ? xcd * (q + 1) : r * (q + 1) + (xcd - r) * q) + off; }
        const int nig = WGM * nN, gid = wgid / nig, fm = gid * WGM, gsz = (nM - fm) < WGM ? (nM - fm) : WGM;
        u.pm = fm + ((wgid % nig) % gsz); u.pn = (wgid % nig) / gsz; return true;
    }
    __device__ __forceinline__ void a_ready(const Unit&) const {}
    __device__ __forceinline__ void done(const Unit&) const {}
};
__device__ __forceinline__ unsigned cvt_pk_bf16(float lo, float hi) { unsigned r; asm volatile("v_cvt_pk_bf16_f32 %0, %1, %2" : "=v"(r) : "v"(lo), "v"(hi)); return r; }
typedef float f32x2 __attribute__((ext_vector_type(2)));
typedef unsigned u32x2 __attribute__((ext_vector_type(2)));
__device__ __forceinline__ u32x4 pack8(const f32x4 v0, const f32x4 v1) { u32x4 w; w.x = cvt_pk_bf16(v0[0], v0[1]); w.y = cvt_pk_bf16(v0[2], v0[3]); w.z = cvt_pk_bf16(v1[0], v1[1]); w.w = cvt_pk_bf16(v1[2], v1[3]); return w; }
struct EpiPlain {
    static constexpr bool PERM = true, AFTER_DRAIN = false;
    bf16_t* O; int ldc;
    __device__ __forceinline__ void operator()(const f32x4 (&acc)[2][2][4][2], const Unit& u, int wr, int wc, int fr, int fq) const {
        const int row0 = u.pm * BM + wr * 64 + fr, col0 = u.pn * BM + wc * 32 + 8 * fq;
#pragma unroll
        for (int ai = 0; ai < 2; ++ai)
#pragma unroll
            for (int m = 0; m < 4; ++m) { bf16_t* rowp = O + (size_t)(row0 + ai * HALF + m * 16) * ldc + col0;
#pragma unroll
                for (int bj = 0; bj < 2; ++bj) *(u32x4*)(rowp + bj * HALF) = pack8(acc[ai][bj][m][0], acc[ai][bj][m][1]); }
    }
};
struct EpiRes {
    static constexpr bool PERM = false, AFTER_DRAIN = false;
    const float* base; float* out;
    __device__ __forceinline__ void operator()(const f32x4 (&acc)[2][2][4][2], const Unit& u, int wr, int wc, int fr, int fq) const {
        const int col0 = u.pn * BM + wc * 32 + 4 * fq;
#pragma unroll
        for (int ai = 0; ai < 2; ++ai)
#pragma unroll
            for (int m = 0; m < 4; ++m) { const size_t off = (size_t)(u.pm * BM + ai * HALF + wr * 64 + m * 16 + fr) * 1024 + col0;
#pragma unroll
                for (int bj = 0; bj < 2; ++bj)
#pragma unroll
                    for (int n = 0; n < 2; ++n) { const f32x4 bs = *(const f32x4*)(base + off + bj * HALF + n * 16); *(f32x4*)(out + off + bj * HALF + n * 16) = bs + acc[ai][bj][m][n]; } }
    }
};
struct EpiInProj {
    static constexpr bool PERM = true, AFTER_DRAIN = false;
    bf16_t *Q, *Kk, *V, *OG; float* gates; const float* bg;
    __device__ __forceinline__ void operator()(const f32x4 (&acc)[2][2][4][2], const Unit& u, int wr, int wc, int fr, int fq) const {
        const int colt = u.pn * BM;
#pragma unroll
        for (int ai = 0; ai < 2; ++ai)
#pragma unroll
            for (int m = 0; m < 4; ++m) { const int row = u.pm * BM + ai * HALF + wr * 64 + m * 16 + fr, b = row >> 12, s = row & 4095;
#pragma unroll
                for (int bj = 0; bj < 2; ++bj) { const int cb = colt + bj * HALF + wc * 32 + 8 * fq; f32x4 v0 = acc[ai][bj][m][0], v1 = acc[ai][bj][m][1];
                    if (colt < 1024) { const bool isq = colt < 512; bf16_t* base = isq ? Q : Kk; const int c2 = cb & 511, head = c2 >> 6, d = c2 & 63;
                        if (isq) { v0 = v0 * 0.125f; v1 = v1 * 0.125f; }
                        *(u32x4*)(base + ((size_t)((b * 8 + head) * 4096 + s)) * 64 + d) = pack8(v0, v1); }
                    else if (colt < 2048) { const int c2 = cb - 1024, head = c2 >> 7, dv = c2 & 127; *(u32x4*)(V + ((size_t)((b * 8 + head) * 4096 + s)) * 128 + dv) = pack8(v0, v1); }
                    else if (colt < 3072) { *(u32x4*)(OG + (size_t)row * 1024 + (cb - 2048)) = pack8(v0, v1); }
                    else if (cb < 3104) { const int gi = cb - 3072; float* g = gates + (size_t)row * 32 + gi;
                        *(f32x4*)g = v0 + *(const f32x4*)(bg + gi); *(f32x4*)(g + 4) = v1 + *(const f32x4*)(bg + gi + 4); } } }
    }
};
struct EpiQKV {
    static constexpr bool PERM = true, AFTER_DRAIN = false;
    bf16_t *Q, *Kk, *V;
    __device__ __forceinline__ void operator()(const f32x4 (&acc)[2][2][4][2], const Unit& u, int wr, int wc, int fr, int fq) const {
        const int colt = u.pn * BM;
#pragma unroll
        for (int ai = 0; ai < 2; ++ai)
#pragma unroll
            for (int m = 0; m < 4; ++m) { const int row = u.pm * BM + ai * HALF + wr * 64 + m * 16 + fr, b = row >> 12, s = row & 4095;
#pragma unroll
                for (int bj = 0; bj < 2; ++bj) { const int cb = colt + bj * HALF + wc * 32 + 8 * fq; const u32x4 w = pack8(acc[ai][bj][m][0], acc[ai][bj][m][1]);
                    if (colt < 2048) { bf16_t* base = colt < 1024 ? Q : Kk; const int c2 = cb & 1023, head = c2 >> 7, c = (c2 >> 6) & 1, d = c2 & 63;
                        *(u32x4*)(base + ((size_t)(((b * 8 + head) * 2 + c) * 4096 + s)) * 64 + d) = w; }
                    else { const int c2 = cb - 2048, head = c2 >> 7, dv = c2 & 127; *(u32x4*)(V + ((size_t)((b * 8 + head) * 4096 + s)) * 128 + dv) = w; } } }
    }
};
template <class Epi, class Sched, bool ALIGN_EPI = false, bool SP2 = false>
__device__ __forceinline__ void gemm_phase(PG8_LAS unsigned char* lds, const Gemm g, const Sched& S, const Epi& E, const int wv) {
    int ln_; asm volatile("v_mbcnt_lo_u32_b32 %0, -1, 0\n\tv_mbcnt_hi_u32_b32 %0, -1, %0" : "=v"(ln_)); const int tid = wv * 64 + ln_, wid = wv, lane = tid & 63, wr = wid >> 2, wc = wid & 3, fr = lane & 15, fq = lane >> 4;
    const int K = g.K, nt = K / BK;
    unsigned voffA[2], voffB[2];
#pragma unroll
    for (int i = 0; i < 2; ++i) { int R, C; stage_rc(tid * 16 + i * 8192, R, C); const int Rb = Epi::PERM ? ((R & ~31) + perm32(R & 31)) : R;
        voffA[i] = (unsigned)(R * K + C) * 2u; voffB[i] = (unsigned)(Rb * K + C) * 2u; }
    const size_t kstep = (size_t)(BK * 2);
    const size_t hstep = (size_t)HALF * K * 2;
    const size_t tstep = 2 * hstep;
    const unsigned ldsw = (unsigned)wid * 1024u;
    const int aoff = lds_byte(wr * 64 + fr, fq * 8), boff = lds_byte(wc * 32 + fr, fq * 8);
#define PG8_SA(b, h) (((b) * 2 + (h)) * HTB)
#define PG8_SB(b, h) ((4 + (b) * 2 + (h)) * HTB)
#define PG8_STAGE(bufoff, gbase, voff) do { _Pragma("unroll") for (int _i = 0; _i < 2; ++_i) \
        __builtin_amdgcn_global_load_lds((const unsigned*)((const char*)(gbase) + (voff)[_i]), (PG8_LAS unsigned*)(lds + (bufoff) + ldsw + _i * 8192), 16, 0, 0); } while (0)
#define PG8_LDA(dst, b, h) do { _Pragma("unroll") for (int m = 0; m < 4; ++m) _Pragma("unroll") for (int k = 0; k < 2; ++k) dst[m][k] = *(const PG8_LAS bf16x8*)(lds + PG8_SA(b, h) + aoff + m * 2048 + k * 1024); } while (0)
#define PG8_LDB(dst, b, h) do { _Pragma("unroll") for (int n = 0; n < 2; ++n) _Pragma("unroll") for (int k = 0; k < 2; ++k) dst[n][k] = *(const PG8_LAS bf16x8*)(lds + PG8_SB(b, h) + boff + n * 2048 + k * 1024); } while (0)
#define PG8_MMA(ai, bj, At, Bt) do { __builtin_amdgcn_s_setprio(1); _Pragma("unroll") for (int m = 0; m < 4; ++m) _Pragma("unroll") for (int n = 0; n < 2; ++n) _Pragma("unroll") for (int k = 0; k < 2; ++k) \
        acc[ai][bj][m][n] = __builtin_amdgcn_mfma_f32_16x16x32_bf16(Bt[n][k], At[m][k], acc[ai][bj][m][n], 0, 0, 0); __builtin_amdgcn_s_setprio(0); } while (0)
#define PG8_WAIT_V(n) asm volatile("s_waitcnt vmcnt(" #n ")" ::: "memory")
#define PG8_WAIT_L(n) asm volatile("s_waitcnt lgkmcnt(" #n ")" ::: "memory")
#define PG8_BAR __builtin_amdgcn_s_barrier()
#define PG8_SCHED __builtin_amdgcn_sched_barrier(0)
    Unit cur, nxt; int ui = 0;
    if (!S.next(0, cur)) return;
    f32x4 acc[2][2][4][2];
#pragma unroll
    for (int a = 0; a < 2; ++a)
#pragma unroll
        for (int b = 0; b < 2; ++b)
#pragma unroll
            for (int m = 0; m < 4; ++m)
#pragma unroll
                for (int n = 0; n < 2; ++n) acc[a][b][m][n] = (f32x4){0.f, 0.f, 0.f, 0.f};
    bf16x8 At[4][2], B0[2][2], B1[2][2];
    const char* cA = (const char*)g.A + (size_t)cur.pm * tstep; const char* cB = (const char*)g.Bt + (size_t)cur.pn * tstep;
    S.a_ready(cur);
    if constexpr (SP2) {
        PG8_STAGE(PG8_SB(0, 0), cB, voffB); PG8_STAGE(PG8_SB(0, 1), cB + hstep, voffB); PG8_STAGE(PG8_SA(0, 0), cA, voffA); PG8_STAGE(PG8_SA(0, 1), cA + hstep, voffA);
        if (wr == 1) PG8_BAR;
        PG8_WAIT_V(2); PG8_BAR;
        PG8_STAGE(PG8_SB(1, 0), cB + kstep, voffB); PG8_STAGE(PG8_SA(1, 0), cA + kstep, voffA); PG8_STAGE(PG8_SB(1, 1), cB + hstep + kstep, voffB);
        PG8_WAIT_V(6); PG8_BAR;
    } else {
        PG8_STAGE(PG8_SB(0, 0), cB, voffB); PG8_STAGE(PG8_SA(0, 0), cA, voffA); PG8_STAGE(PG8_SB(0, 1), cB + hstep, voffB); PG8_STAGE(PG8_SA(0, 1), cA + hstep, voffA);
        if (wr == 1) PG8_BAR;
        PG8_WAIT_V(4); PG8_BAR;
        PG8_STAGE(PG8_SB(1, 0), cB + kstep, voffB); PG8_STAGE(PG8_SA(1, 0), cA + kstep, voffA); PG8_STAGE(PG8_SB(1, 1), cB + hstep + kstep, voffB);
        PG8_WAIT_V(6); PG8_BAR;
    }
    for (;;) {
        const bool has_next = S.next(ui + 1, nxt);
        const char* nA = has_next ? (const char*)g.A + (size_t)nxt.pm * tstep : cA; const char* nB = has_next ? (const char*)g.Bt + (size_t)nxt.pn * tstep : cB;
        for (int t = 0; t < nt; t += 2) {
            const bool last = (t == nt - 2);
            const char* a1 = cA + (size_t)(t + 1) * kstep;
            const char* a2 = last ? nA : cA + (size_t)(t + 2) * kstep; const char* b2 = last ? nB : cB + (size_t)(t + 2) * kstep;
            const char* a3 = a2 + kstep; const char* b3 = b2 + kstep;
            if (last && has_next) S.a_ready(nxt);
            if constexpr (SP2) {
            PG8_LDB(B0, 0, 0); PG8_LDB(B1, 0, 1); PG8_SCHED; PG8_LDA(At, 0, 0); PG8_STAGE(PG8_SA(1, 1), a1 + hstep, voffA);
            PG8_WAIT_V(8); PG8_WAIT_L(0); PG8_BAR; PG8_MMA(0, 0, At, B0); PG8_MMA(0, 1, At, B1); PG8_BAR; PG8_SCHED;
            PG8_LDA(At, 0, 1); PG8_STAGE(PG8_SB(0, 0), b2, voffB); PG8_STAGE(PG8_SB(0, 1), b2 + hstep, voffB); PG8_STAGE(PG8_SA(0, 0), a2, voffA);
            PG8_WAIT_V(8); PG8_WAIT_L(0); PG8_BAR; PG8_MMA(1, 0, At, B0); PG8_MMA(1, 1, At, B1); PG8_BAR; PG8_SCHED;
            PG8_LDB(B0, 1, 0); PG8_LDB(B1, 1, 1); PG8_SCHED; PG8_LDA(At, 1, 0); PG8_STAGE(PG8_SA(0, 1), a2 + hstep, voffA);
            PG8_WAIT_V(8); PG8_WAIT_L(0); PG8_BAR; PG8_MMA(0, 0, At, B0); PG8_MMA(0, 1, At, B1); PG8_BAR; PG8_SCHED;
            PG8_LDA(At, 1, 1); PG8_STAGE(PG8_SB(1, 0), b3, voffB); PG8_STAGE(PG8_SB(1, 1), b3 + hstep, voffB); PG8_STAGE(PG8_SA(1, 0), a3, voffA);
            PG8_WAIT_V(8); PG8_WAIT_L(0); PG8_BAR; PG8_MMA(1, 0, At, B0); PG8_MMA(1, 1, At, B1); PG8_BAR; PG8_SCHED;
            } else {
            PG8_LDB(B0, 0, 0); PG8_SCHED; PG8_LDA(At, 0, 0); PG8_STAGE(PG8_SA(1, 1), a1 + hstep, voffA);
            PG8_WAIT_L(8); PG8_BAR; PG8_WAIT_L(0); PG8_MMA(0, 0, At, B0); PG8_BAR; PG8_SCHED;
            PG8_LDB(B1, 0, 1); PG8_STAGE(PG8_SB(0, 0), b2, voffB);
            PG8_BAR; PG8_WAIT_L(0); PG8_MMA(0, 1, At, B1); PG8_BAR;
            PG8_LDA(At, 0, 1); PG8_STAGE(PG8_SA(0, 0), a2, voffA);
            PG8_BAR; PG8_WAIT_L(0); PG8_MMA(1, 0, At, B0); PG8_BAR; PG8_SCHED;
            PG8_STAGE(PG8_SB(0, 1), b2 + hstep, voffB);
            PG8_WAIT_V(6); PG8_BAR; PG8_MMA(1, 1, At, B1); PG8_BAR;
            PG8_LDB(B0, 1, 0); PG8_SCHED; PG8_LDA(At, 1, 0); PG8_STAGE(PG8_SA(0, 1), a2 + hstep, voffA);
            PG8_WAIT_L(8); PG8_BAR; PG8_WAIT_L(0); PG8_MMA(0, 0, At, B0); PG8_BAR; PG8_SCHED;
            PG8_LDB(B1, 1, 1); PG8_STAGE(PG8_SB(1, 0), b3, voffB);
            PG8_BAR; PG8_WAIT_L(0); PG8_MMA(0, 1, At, B1); PG8_BAR;
            PG8_LDA(At, 1, 1); PG8_STAGE(PG8_SA(1, 0), a3, voffA);
            PG8_BAR; PG8_WAIT_L(0); PG8_MMA(1, 0, At, B0); PG8_BAR; PG8_SCHED;
            PG8_STAGE(PG8_SB(1, 1), b3 + hstep, voffB);
            PG8_WAIT_V(6); PG8_BAR; PG8_MMA(1, 1, At, B1); PG8_BAR;
            }
        }
        if constexpr (ALIGN_EPI) { if (wr == 0) PG8_BAR; }
        if constexpr (!Epi::AFTER_DRAIN) { E(acc, cur, wr, wc, fr, fq); S.done(cur); }
        if (!has_next) break;
#pragma unroll
        for (int a = 0; a < 2; ++a)
#pragma unroll
            for (int b = 0; b < 2; ++b)
#pragma unroll
                for (int m = 0; m < 4; ++m)
#pragma unroll
                    for (int n = 0; n < 2; ++n) acc[a][b][m][n] = (f32x4){0.f, 0.f, 0.f, 0.f};
        cur = nxt; cA = nA; cB = nB; ++ui;
        if constexpr (ALIGN_EPI) { if (wr == 1) PG8_BAR; }
    }
    PG8_WAIT_V(0);
    if constexpr (!ALIGN_EPI) { if (wr == 0) PG8_BAR; }
    PG8_BAR;
    if constexpr (Epi::AFTER_DRAIN) { E.fused(acc, cur, wr, wc, fr, fq, lds, wid, lane); S.done(cur); }
#undef PG8_SA
#undef PG8_SB
#undef PG8_STAGE
#undef PG8_LDA
#undef PG8_LDB
#undef PG8_MMA
#undef PG8_WAIT_V
#undef PG8_WAIT_L
#undef PG8_BAR
#undef PG8_SCHED
}
}
#define GAS __attribute__((address_space(1)))
#define LAS __attribute__((address_space(3)))
typedef unsigned short bf16;
typedef unsigned v4u __attribute__((ext_vector_type(4)));
typedef float f32x4 __attribute__((ext_vector_type(4)));
typedef short bf16x8 __attribute__((ext_vector_type(8)));
typedef GAS unsigned gu32;
typedef GAS unsigned long long gu64;
#define RLX_AGENT __ATOMIC_RELAXED, __HIP_MEMORY_SCOPE_AGENT
#define LDS_WAIT() asm volatile("s_waitcnt lgkmcnt(0)" ::: "memory")
#define VM_WAIT() asm volatile("s_waitcnt vmcnt(0)" ::: "memory")
__device__ __forceinline__ unsigned long long rt() { return __builtin_amdgcn_s_memrealtime(); }
typedef float f32x2_cv __attribute__((ext_vector_type(2))); typedef __bf16 bf16x2_cv __attribute__((ext_vector_type(2)));
__device__ __forceinline__ unsigned pk2(float lo, float hi) { const f32x2_cv v = {lo, hi}; const bf16x2_cv b = __builtin_convertvector(v, bf16x2_cv); return __builtin_bit_cast(unsigned, b); }
__device__ __forceinline__ unsigned f2bf(float f) { return pk2(f, 0.f) & 0xffffu; }

#define XB_TMO      128
#define XB_XCNT(j)  (256  + 64 * (j))
#define XB_XSUB(j)  (1280 + 64 * (j))
#define XB_XGEN(j)  (2304 + 64 * (j))
#define XB_TOP      3328
#define XB_TOPGEN   3392
#define XCD_BAR_WORDS 3456
#define XB_SPIN_CAP (1u << 18)

__device__ __forceinline__ unsigned xb_ld(unsigned* p)              { return __hip_atomic_load(p, __ATOMIC_RELAXED, __HIP_MEMORY_SCOPE_AGENT); }
__device__ __forceinline__ unsigned xb_add(unsigned* p, unsigned v) { return __hip_atomic_fetch_add(p, v, __ATOMIC_RELAXED, __HIP_MEMORY_SCOPE_AGENT); }
__device__ __forceinline__ unsigned xb_xcc_id() { return (unsigned)__builtin_amdgcn_s_getreg((3 << 11) | 20) & 0xFu; }
#define XB_SPIN(cond, bar) do { unsigned _sp = 0; while (cond) { __builtin_amdgcn_s_sleep(1); \
    if ((++_sp & 255u) == 0u) { if (xb_ld(&(bar)[XB_TMO])) break; if (_sp > XB_SPIN_CAP) { atomicAdd(&(bar)[XB_TMO], 1u); break; } } } } while (0)

struct XcdBarrier {
    unsigned* bar; unsigned x;
    volatile LAS unsigned* st;
};

__device__ __forceinline__ XcdBarrier xcd_barrier_post(unsigned* bar, volatile LAS unsigned* st) {
    XcdBarrier b; b.bar = bar; b.x = xb_xcc_id(); b.st = st;
    if (threadIdx.x == 0) (void)xb_add(&bar[XB_XCNT(b.x)], 1u);
    return b;
}
__device__ __forceinline__ void xcd_barrier_complete(unsigned* bar, unsigned x, unsigned& nloc, unsigned& nx) {
    const unsigned G = gridDim.x * gridDim.y * gridDim.z;
    unsigned sum, cnt, mine, sp = 0u;
    for (;;) {
        sum = 0u; cnt = 0u; mine = 0u;
#pragma unroll
        for (unsigned j = 0; j < 16; ++j) { const unsigned c = xb_ld(&bar[XB_XCNT(j)]); sum += c; cnt += (c > 0u) ? 1u : 0u; mine = (j == x) ? c : mine; }
        if (sum == G) break;
        __builtin_amdgcn_s_sleep(1);
        if ((++sp & 255u) == 0u) { if (xb_ld(&bar[XB_TMO])) break; if (sp > XB_SPIN_CAP) { atomicAdd(&bar[XB_TMO], 1u); break; } }
    }
    nloc = mine > 0u ? mine : 1u; nx = cnt > 0u ? cnt : 1u;
}

__device__ __forceinline__ void xcd_barrier(const XcdBarrier& b) {
    asm volatile("s_waitcnt vmcnt(0)" ::: "memory");
    __syncthreads();
    if (threadIdx.x == 0) {
        unsigned* bar = b.bar;
        __builtin_amdgcn_s_waitcnt(0);
        unsigned nloc = b.st[0], nx = b.st[1];
        if (nloc == 0u) { xcd_barrier_complete(bar, b.x, nloc, nx); b.st[0] = nloc; b.st[1] = nx; }
        const unsigned old = xb_add(&bar[XB_XSUB(b.x)], 1u);
        const unsigned gen = old / nloc;
        if (old + 1u == (gen + 1u) * nloc) {
            __builtin_amdgcn_fence(__ATOMIC_RELEASE, "agent");
            asm volatile("s_waitcnt vmcnt(0)" ::: "memory");
            const unsigned og = xb_add(&bar[XB_TOP], 1u);
            const unsigned tg = og / nx;
            if (og + 1u == (tg + 1u) * nx) xb_add(&bar[XB_TOPGEN], 1u);
            else XB_SPIN(xb_ld(&bar[XB_TOPGEN]) == tg, bar);
            __builtin_amdgcn_fence(__ATOMIC_ACQUIRE, "agent");
            xb_add(&bar[XB_XGEN(b.x)], 1u);
            asm volatile("s_waitcnt vmcnt(0)" ::: "memory");
        } else {
            XB_SPIN(xb_ld(&bar[XB_XGEN(b.x)]) == gen, bar);
            __builtin_amdgcn_fence(__ATOMIC_ACQUIRE, "agent");
            asm volatile("s_waitcnt vmcnt(0)" ::: "memory");
        }
    }
    __syncthreads();
}
constexpr int NWAVES = 8;
constexpr int T = 32768, D = 1024, SEQ = 4096;
constexpr float EPS = 1e-6f;
constexpr float LAMBDA_INIT = 0.35550906759f;
constexpr size_t MiB = 1u << 20;
constexpr size_t WS_CTL = 0, CTL_ZERO_BYTES = 1 * MiB;
constexpr size_t WS_ROPE = 1 * MiB;
constexpr size_t WS_WIN = 4 * MiB;
constexpr size_t WS_WO0 = 11 * MiB, WS_WQ0 = 13 * MiB, WS_KEY0 = 17 * MiB, WS_WQKV = 18 * MiB, WS_WO1 = 24 * MiB, WS_WQ1 = 26 * MiB, WS_KEY1 = 30 * MiB;
constexpr size_t WS_SC = 31 * MiB;
constexpr size_t WS_U0 = 32 * MiB, WS_V0T = 48 * MiB, WS_U1 = 64 * MiB, WS_V1T = 80 * MiB;
constexpr size_t WS_B0 = 96 * MiB;
constexpr size_t WS_R1 = 160 * MiB, WS_R2 = 224 * MiB, WS_R3 = 288 * MiB, WS_R4 = 352 * MiB, WS_R5 = 416 * MiB, WS_GATES = 480 * MiB;
constexpr size_t WS_END = 484 * MiB;
constexpr int CW_BAR = 4096;
constexpr int LDS_BYTES = 147456, MISC_OFF = LDS_BYTES - 128;

typedef float f32x16 __attribute__((ext_vector_type(16)));
typedef unsigned u32x2 __attribute__((ext_vector_type(2)));
typedef __bf16 bf16x2_t __attribute__((ext_vector_type(2)));
__device__ __forceinline__ float bf_lo(unsigned w) { return __uint_as_float(w << 16); }
__device__ __forceinline__ float bf_hi(unsigned w) { return __uint_as_float(w & 0xffff0000u); }
__device__ __forceinline__ float dot2(unsigned a, unsigned b, float c) { return __builtin_amdgcn_fdot2_f32_bf16(__builtin_bit_cast(bf16x2_t, a), __builtin_bit_cast(bf16x2_t, b), c, false); }
__device__ __forceinline__ float shx(float v, int lane, int m) { return __uint_as_float((unsigned)__builtin_amdgcn_ds_bpermute((lane ^ m) << 2, (int)__float_as_uint(v))); }
__device__ __forceinline__ int shxi(int v, int lane, int m) { return __builtin_amdgcn_ds_bpermute((lane ^ m) << 2, v); }
__device__ __forceinline__ float wave_sum(float v, int lane) {
#pragma unroll
    for (int o = 1; o < 64; o <<= 1) v += shx(v, lane, o);
    return v;
}
__device__ __forceinline__ f32x4 mfma16(bf16x8 a, bf16x8 b, f32x4 c) { return __builtin_amdgcn_mfma_f32_16x16x32_bf16(a, b, c, 0, 0, 0); }
__device__ __forceinline__ f32x16 mfma32(bf16x8 a, bf16x8 b, f32x16 c) { return __builtin_amdgcn_mfma_f32_32x32x16_bf16(a, b, c, 0, 0, 0); }
__device__ __forceinline__ u32x2 pack4(float a, float b, float c, float d) { u32x2 r; r.x = pk2(a, b); r.y = pk2(c, d); return r; }

__device__ __forceinline__ void p0_transpose_item(const float* W, int K, int N, bf16* WT, LAS float* scr, int item, int lane) {
    const int nblk = N / 32, kb = item / nblk, nb = item % nblk, k0 = 64 * kb, n0 = 32 * nb;
#pragma unroll 8
    for (int i = 0; i < 32; ++i) { const int kk = 2 * i + (lane >> 5); scr[kk * 33 + (lane & 31)] = W[(size_t)(k0 + kk) * N + n0 + (lane & 31)]; }
    LDS_WAIT(); asm volatile("" ::: "memory");
    const int c = lane & 7;
#pragma unroll
    for (int j = 0; j < 4; ++j) { const int n = (lane >> 3) + 8 * j; const LAS float* s = scr + (8 * c) * 33 + n;
        v4u o; o.x = pk2(s[0 * 33], s[1 * 33]); o.y = pk2(s[2 * 33], s[3 * 33]); o.z = pk2(s[4 * 33], s[5 * 33]); o.w = pk2(s[6 * 33], s[7 * 33]);
        *(v4u*)(WT + (size_t)(n0 + n) * K + k0 + 8 * c) = o; }
    LDS_WAIT(); asm volatile("" ::: "memory");
}
__device__ __forceinline__ void cvt_range(const float* src, bf16* dst, size_t n, size_t gtid, size_t gthreads) {
    for (size_t i = gtid * 8; i < n; i += gthreads * 8) {
        const f32x4 a = *(const f32x4*)(src + i), b = *(const f32x4*)(src + i + 4);
        v4u o; o.x = pk2(a.x, a.y); o.y = pk2(a.z, a.w); o.z = pk2(b.x, b.y); o.w = pk2(b.z, b.w);
        *(v4u*)(dst + i) = o; }
}
__device__ __forceinline__ void rms_row_to_bf16(const float* xrow, const float* g, bf16* orow, int lane) {
    const f32x4* xr = (const f32x4*)xrow + lane; const f32x4* gr = (const f32x4*)g + lane;
    f32x4 v[4]; float s = 0.f;
#pragma unroll
    for (int j = 0; j < 4; ++j) { v[j] = xr[64 * j]; s += (v[j].x * v[j].x + v[j].y * v[j].y) + (v[j].z * v[j].z + v[j].w * v[j].w); }
    const float rstd = rsqrtf(wave_sum(s, lane) * (1.f / 1024.f) + EPS);
    unsigned long long* o8 = (unsigned long long*)orow + lane;
#pragma unroll
    for (int j = 0; j < 4; ++j) { const f32x4 gg = gr[64 * j];
        o8[64 * j] = (unsigned long long)pk2(v[j].x * rstd * gg.x, v[j].y * rstd * gg.y) | ((unsigned long long)pk2(v[j].z * rstd * gg.z, v[j].w * rstd * gg.w) << 32); }
}
__device__ __forceinline__ void rms_pass(const float* X, const float* g, bf16* XN, int gw, int NGW, int lane) {
    for (int m = gw; m < T; m += NGW) rms_row_to_bf16(X + (size_t)m * D, g, XN + (size_t)m * D, lane);
}

__device__ __forceinline__ float logsigmoid_f(float f) { return fminf(f, 0.f) - log1pf(__expf(-fabsf(f))); }
#define ML_LOAD(ci_) do { const size_t r_ = rowbase + (size_t)(ci_) * 64 + lane; \
    rq = *(const v4u*)(Q0 + r_ * 64 + 8 * w); rk = *(const v4u*)(K0 + r_ * 64 + 8 * w); rv0 = *(const v4u*)(V0 + r_ * 128 + 16 * w); rv1 = *(const v4u*)(V0 + r_ * 128 + 16 * w + 8); \
    const size_t gm_ = ((size_t)b * 4096 + (size_t)(ci_) * 64 + jr) * 32; rli = GATES[gm_ + (dir ? 16 : 0) + h]; rf = GATES[gm_ + (dir ? 24 : 8) + h]; } while (0)
__device__ __forceinline__ void mlstm_phase(const int wv, LAS unsigned char* lds, const bf16* Q0, const bf16* K0, const bf16* V0, const float* GATES, bf16* HF, bf16* HB) {
    const int bx = blockIdx.x;
    if ((bx >> 3) & 1) return;
    const int seq = (bx >> 4) * 8 + (bx & 7);
    const int dir = seq & 1, bh = seq >> 1, b = bh >> 3, h = bh & 7;
    int ln_; asm volatile("v_mbcnt_lo_u32_b32 %0, -1, 0\n\tv_mbcnt_hi_u32_b32 %0, -1, %0" : "=v"(ln_)); const int tid = wv * 64 + ln_, lane = tid & 63, w = wv, fr = lane & 15, fq = lane >> 4;
    LAS bf16* Qs = (LAS bf16*)(lds); LAS bf16* Ks = (LAS bf16*)(lds + 9216); LAS bf16* Kwt = (LAS bf16*)(lds + 18432); LAS bf16* Ps = (LAS bf16*)(lds + 27648);
    LAS bf16* Vt = (LAS bf16*)(lds + 36864 + w * 2304); LAS bf16* Cs = (LAS bf16*)(lds + 55296 + w * 2304); LAS bf16* nb = (LAS bf16*)(lds + 73728 + w * 128);
    LAS float* gc = (LAS float*)(lds + 74752 + w * 1280); LAS float* gM = gc + 64; LAS float* gI = gc + 128; LAS float* gE = gc + 192; LAS float* gW = gc + 256;
    for (int i = lane; i < 2304 / 4; i += 64) ((LAS unsigned*)Cs)[i] = 0u;
    if (lane < 32) ((LAS unsigned*)nb)[lane] = 0u;
    f32x4 Cacc[4], Nacc[4];
#pragma unroll
    for (int i = 0; i < 4; ++i) { Cacc[i] = (f32x4){0.f, 0.f, 0.f, 0.f}; Nacc[i] = (f32x4){0.f, 0.f, 0.f, 0.f}; }
    float m = -1e30f;
    bf16* Hout = dir ? HB : HF;
    const size_t rowbase = (size_t)bh * 4096;
    const int jr = dir ? 63 - lane : lane;
    v4u rq, rk, rv0, rv1; float rli, rf;
    ML_LOAD(dir ? 63 : 0);
    const bf16x8 ones = (bf16x8){0x3F80, 0x3F80, 0x3F80, 0x3F80, 0x3F80, 0x3F80, 0x3F80, 0x3F80};
    const f32x4 z4 = (f32x4){0.f, 0.f, 0.f, 0.f};
#pragma unroll 1
    for (int step = 0; step < 64; ++step) {
        const int ci = dir ? 63 - step : step;
        const float lf = logsigmoid_f(rf);
        float bcs = lf;
#pragma unroll
        for (int d = 1; d < 64; d <<= 1) { const float t = __uint_as_float((unsigned)__builtin_amdgcn_ds_bpermute((lane - d) << 2, (int)__float_as_uint(bcs))); if (lane >= d) bcs += t; }
        const float c = rli - bcs;
        float pm = c;
#pragma unroll
        for (int d = 1; d < 64; d <<= 1) { const float t = __uint_as_float((unsigned)__builtin_amdgcn_ds_bpermute((lane - d) << 2, (int)__float_as_uint(pm))); if (lane >= d) pm = fmaxf(pm, t); }
        const float M = fmaxf(m, pm);
        const float bL = __uint_as_float((unsigned)__builtin_amdgcn_readlane((int)__float_as_uint(bcs), 63)), Mlast = __uint_as_float((unsigned)__builtin_amdgcn_readlane((int)__float_as_uint(M), 63));
        gc[jr] = c; gM[jr] = M; gI[jr] = __expf(m - M); gE[jr] = __expf(-(bcs + M)); gW[jr] = __expf(c - Mlast);
        const float sp = __expf(m - Mlast), m_new = bL + Mlast;
        const float wr_ = gW[lane];
        *(LAS v4u*)(Qs + lane * 72 + 8 * w) = rq; *(LAS v4u*)(Ks + lane * 72 + 8 * w) = rk;
#pragma unroll
        for (int i = 0; i < 4; ++i) { const unsigned kw = rk[i]; Kwt[(8 * w + 2 * i) * 72 + lane] = (bf16)f2bf(bf_lo(kw) * wr_); Kwt[(8 * w + 2 * i + 1) * 72 + lane] = (bf16)f2bf(bf_hi(kw) * wr_); }
#pragma unroll
        for (int i = 0; i < 4; ++i) { Vt[(2 * i) * 72 + lane] = (bf16)(rv0[i] & 0xffffu); Vt[(2 * i + 1) * 72 + lane] = (bf16)(rv0[i] >> 16);
                                      Vt[(8 + 2 * i) * 72 + lane] = (bf16)(rv1[i] & 0xffffu); Vt[(9 + 2 * i) * 72 + lane] = (bf16)(rv1[i] >> 16); }
        __syncthreads();
        if (step < 63) ML_LOAD(dir ? 62 - step : step + 1);
        {
            const int st = w >> 1;
            const bf16x8 a0 = *(const LAS bf16x8*)(Ks + (16 * st + fr) * 72 + 8 * fq), a1 = *(const LAS bf16x8*)(Ks + (16 * st + fr) * 72 + 32 + 8 * fq);
#pragma unroll
            for (int u = 0; u < 2; ++u) { const int tt = 2 * (w & 1) + u;
                const bf16x8 b0 = *(const LAS bf16x8*)(Qs + (16 * tt + fr) * 72 + 8 * fq), b1 = *(const LAS bf16x8*)(Qs + (16 * tt + fr) * 72 + 32 + 8 * fq);
                f32x4 acc = mfma16(a0, b0, z4); acc = mfma16(a1, b1, acc);
                const int t = 16 * tt + fr; const float Mt = gM[t]; float pv[4];
#pragma unroll
                for (int i = 0; i < 4; ++i) { const int s = 16 * st + 4 * fq + i; const bool valid = dir ? (s >= t) : (s <= t); const float e = __expf(gc[s] - Mt); pv[i] = valid ? acc[i] * e : 0.f; }
                *(LAS u32x2*)(Ps + t * 72 + 16 * st + 4 * fq) = pack4(pv[0], pv[1], pv[2], pv[3]); }
        }
        __syncthreads();
        const bf16x8 aV0 = *(const LAS bf16x8*)(Vt + fr * 72 + 8 * fq), aV1 = *(const LAS bf16x8*)(Vt + fr * 72 + 32 + 8 * fq);
        {
            const bf16x8 aC0 = *(const LAS bf16x8*)(Cs + fr * 72 + 8 * fq), aC1 = *(const LAS bf16x8*)(Cs + fr * 72 + 32 + 8 * fq);
            const bf16x8 aN0 = *(const LAS bf16x8*)(nb + 8 * fq), aN1 = *(const LAS bf16x8*)(nb + 32 + 8 * fq);
#pragma unroll
            for (int tt = 0; tt < 4; ++tt) {
                const bf16x8 bP0 = *(const LAS bf16x8*)(Ps + (16 * tt + fr) * 72 + 8 * fq), bP1 = *(const LAS bf16x8*)(Ps + (16 * tt + fr) * 72 + 32 + 8 * fq);
                const bf16x8 bQ0 = *(const LAS bf16x8*)(Qs + (16 * tt + fr) * 72 + 8 * fq), bQ1 = *(const LAS bf16x8*)(Qs + (16 * tt + fr) * 72 + 32 + 8 * fq);
                f32x4 acc1 = mfma16(aV0, bP0, z4); acc1 = mfma16(aV1, bP1, acc1);
                f32x4 acc2 = mfma16(aC0, bQ0, z4); acc2 = mfma16(aC1, bQ1, acc2);
                f32x4 d1 = mfma16(ones, bP0, z4); d1 = mfma16(ones, bP1, d1);
                f32x4 d2 = mfma16(aN0, bQ0, z4); d2 = mfma16(aN1, bQ1, d2);
                const int t = 16 * tt + fr; const float it = gI[t], en = gE[t];
                const float den = d1[0] + it * d2[0]; const float inv = 1.f / fmaxf(fabsf(den), en);
                *(u32x2*)(Hout + ((size_t)b * 4096 + (size_t)ci * 64 + t) * 1024 + h * 128 + 16 * w + 4 * fq) =
                    pack4((acc1[0] + it * acc2[0]) * inv, (acc1[1] + it * acc2[1]) * inv, (acc1[2] + it * acc2[2]) * inv, (acc1[3] + it * acc2[3]) * inv);
            }
        }
#pragma unroll
        for (int dt = 0; dt < 4; ++dt) { Cacc[dt] = Cacc[dt] * sp; Nacc[dt] = Nacc[dt] * sp;
            const bf16x8 aK0 = *(const LAS bf16x8*)(Kwt + (16 * dt + fr) * 72 + 8 * fq), aK1 = *(const LAS bf16x8*)(Kwt + (16 * dt + fr) * 72 + 32 + 8 * fq);
            Cacc[dt] = mfma16(aK0, aV0, Cacc[dt]); Cacc[dt] = mfma16(aK1, aV1, Cacc[dt]);
            Nacc[dt] = mfma16(aK0, ones, Nacc[dt]); Nacc[dt] = mfma16(aK1, ones, Nacc[dt]); }
#pragma unroll
        for (int dt = 0; dt < 4; ++dt) { *(LAS u32x2*)(Cs + fr * 72 + 16 * dt + 4 * fq) = pack4(Cacc[dt][0], Cacc[dt][1], Cacc[dt][2], Cacc[dt][3]);
                                         *(LAS u32x2*)(nb + 16 * dt + 4 * fq) = pack4(Nacc[dt][0], Nacc[dt][1], Nacc[dt][2], Nacc[dt][3]); }
        m = m_new;
        __syncthreads();
    }
}
#undef ML_LOAD

__device__ __forceinline__ void hs_pass(const bf16* HF, const bf16* HB, const bf16* OG, const float* hg, bf16* HS, int gw, int NGW, int lane) {
    for (int m = gw; m < T; m += NGW) {
        const size_t off = (size_t)m * 1024 + 16 * lane;
        const v4u f0 = *(const v4u*)(HF + off), f1 = *(const v4u*)(HF + off + 8), b0 = *(const v4u*)(HB + off), b1 = *(const v4u*)(HB + off + 8), o0 = *(const v4u*)(OG + off), o1 = *(const v4u*)(OG + off + 8);
        float x[16], og[16];
#pragma unroll
        for (int i = 0; i < 4; ++i) { x[2 * i] = bf_lo(f0[i]) + bf_lo(b0[i]); x[2 * i + 1] = bf_hi(f0[i]) + bf_hi(b0[i]); x[8 + 2 * i] = bf_lo(f1[i]) + bf_lo(b1[i]); x[9 + 2 * i] = bf_hi(f1[i]) + bf_hi(b1[i]);
                                      og[2 * i] = bf_lo(o0[i]); og[2 * i + 1] = bf_hi(o0[i]); og[8 + 2 * i] = bf_lo(o1[i]); og[9 + 2 * i] = bf_hi(o1[i]); }
        float ss = 0.f;
#pragma unroll
        for (int i = 0; i < 16; ++i) ss += x[i] * x[i];
        ss += shx(ss, lane, 1); ss += shx(ss, lane, 2); ss += shx(ss, lane, 4);
        const float rstd = rsqrtf(ss * (1.f / 128.f) + EPS);
        float y[16];
#pragma unroll
        for (int i = 0; i < 16; ++i) y[i] = x[i] * rstd * hg[16 * lane + i] * (1.f / (1.f + __expf(-og[i])));
        v4u w0, w1;
#pragma unroll
        for (int i = 0; i < 4; ++i) { w0[i] = pk2(y[2 * i], y[2 * i + 1]); w1[i] = pk2(y[8 + 2 * i], y[9 + 2 * i]); }
        *(v4u*)(HS + off) = w0; *(v4u*)(HS + off + 8) = w1;
    }
}

#define TK_INSERT(v, x) do { float c_ = (x); _Pragma("unroll") for (int j_ = 0; j_ < 16; ++j_) { const float h_ = fmaxf(v[j_], c_); c_ = fminf(v[j_], c_); v[j_] = h_; } } while (0)
__device__ __forceinline__ void peer_topk_phase(const int wv, int vcu, const bf16* PQ, const bf16* KEYS, int* EXPERTS, float* GATESP) {
    int ln_; asm volatile("v_mbcnt_lo_u32_b32 %0, -1, 0\n\tv_mbcnt_hi_u32_b32 %0, -1, %0" : "=v"(ln_)); const int tid = wv * 64 + ln_, lane = tid & 63, w = wv, r32 = lane & 31, hi = lane >> 5;
    const int t = vcu * 128 + (w & 3) * 32 + r32, hg = w >> 2;
    const float NINF = -INFINITY;
#pragma unroll 1
    for (int hh = 0; hh < 4; ++hh) {
        const int head = hg * 4 + hh;
        float L0[16], L1[16];
#pragma unroll
        for (int j = 0; j < 16; ++j) { L0[j] = 0.f; L1[j] = 0.f; }
#pragma unroll 1
        for (int p = 0; p < 2; ++p) {
            const int hp = head * 2 + p;
            bf16x8 bq[8];
#pragma unroll
            for (int ks = 0; ks < 8; ++ks) bq[ks] = *(const bf16x8*)(PQ + (size_t)t * 2048 + head * 256 + p * 128 + ks * 16 + 8 * hi);
            f32x16 acc[4];
#pragma unroll
            for (int nt = 0; nt < 4; ++nt) {
#pragma unroll
                for (int r = 0; r < 16; ++r) acc[nt][r] = 0.f;
#pragma unroll
                for (int ks = 0; ks < 8; ++ks) { const bf16x8 a = *(const bf16x8*)(KEYS + ((size_t)(hp * 128 + nt * 32 + r32)) * 128 + ks * 16 + 8 * hi); acc[nt] = mfma32(a, bq[ks], acc[nt]); }
            }
            float v[16];
#pragma unroll
            for (int j = 0; j < 16; ++j) v[j] = NINF;
#pragma unroll
            for (int nt = 0; nt < 4; ++nt)
#pragma unroll
                for (int r = 0; r < 16; ++r) { const int n = nt * 32 + (r & 3) + 8 * (r >> 2) + 4 * hi;
                    const float x = __uint_as_float((__float_as_uint(acc[nt][r]) & ~0x7Fu) | (unsigned)(127 - n)); TK_INSERT(v, x); }
            float wv[16];
#pragma unroll
            for (int j = 0; j < 16; ++j) wv[j] = shx(v[j], lane, 32);
#pragma unroll
            for (int j = 0; j < 16; ++j) TK_INSERT(v, wv[j]);
            if (p == 0) {
#pragma unroll
                for (int j = 0; j < 16; ++j) L0[j] = v[j];
            } else {
#pragma unroll
                for (int j = 0; j < 16; ++j) L1[j] = v[j];
            }
        }
        float tv[16];
#pragma unroll
        for (int j = 0; j < 16; ++j) tv[j] = NINF;
        unsigned IA[4] = {0u, 0u, 0u, 0u}, IB[4] = {0u, 0u, 0u, 0u};
#pragma unroll
        for (int i = 0; i < 16; ++i) { IA[i >> 2] |= (127u - (__float_as_uint(L0[i]) & 0x7Fu)) << (8 * (i & 3)); IB[i >> 2] |= (127u - (__float_as_uint(L1[i]) & 0x7Fu)) << (8 * (i & 3)); }
#pragma unroll
        for (int i = 0; i < 16; ++i) {
            const float va = __uint_as_float(__float_as_uint(L0[i]) & ~0x7Fu);
#pragma unroll
            for (int j = 0; j < 16; ++j) if ((i + 1) * (j + 1) <= 16) {
                const float vb = __uint_as_float(__float_as_uint(L1[j]) & ~0x7Fu);
                const float key = __uint_as_float((__float_as_uint(va + vb) & ~0xFFu) | (unsigned)(255 - (i * 16 + j)));
                TK_INSERT(tv, key);
            }
        }
        int ti[16];
#pragma unroll
        for (int j = 0; j < 16; ++j) { const unsigned kb = __float_as_uint(tv[j]); const unsigned flat = 255u - (kb & 0xFFu); const unsigned fi = flat >> 4, fj = flat & 15u;
            const unsigned ra = (fi < 8u) ? ((fi < 4u) ? IA[0] : IA[1]) : ((fi < 12u) ? IA[2] : IA[3]);
            const unsigned rb = (fj < 8u) ? ((fj < 4u) ? IB[0] : IB[1]) : ((fj < 12u) ? IB[2] : IB[3]);
            ti[j] = (int)(((ra >> (8u * (fi & 3u))) & 0xFFu) * 128u + ((rb >> (8u * (fj & 3u))) & 0xFFu));
            tv[j] = __uint_as_float(kb & ~0xFFu); }
        float e[16], sum = 0.f;
#pragma unroll
        for (int j = 0; j < 16; ++j) { e[j] = __expf(tv[j] - tv[0]); sum += e[j]; }
        const float inv = 1.f / sum;
        if (hi == 0) { int* ep = EXPERTS + (size_t)t * 128 + head * 16;
#pragma unroll
            for (int j = 0; j < 4; ++j) *(v4u*)(ep + 4 * j) = (v4u){(unsigned)ti[4 * j], (unsigned)ti[4 * j + 1], (unsigned)ti[4 * j + 2], (unsigned)ti[4 * j + 3]}; }
        else { float* gp = GATESP + (size_t)t * 128 + head * 16;
#pragma unroll
            for (int j = 0; j < 4; ++j) *(f32x4*)(gp + 4 * j) = (f32x4){e[4 * j] * inv, e[4 * j + 1] * inv, e[4 * j + 2] * inv, e[4 * j + 3] * inv}; }
    }
}

__device__ __forceinline__ float cvt_ub0(unsigned x) { float r; asm("v_cvt_f32_ubyte0 %0, %1" : "=v"(r) : "v"(x)); return r; }
__device__ __forceinline__ float cvt_ub1(unsigned x) { float r; asm("v_cvt_f32_ubyte1 %0, %1" : "=v"(r) : "v"(x)); return r; }
__device__ __forceinline__ float cvt_ub2(unsigned x) { float r; asm("v_cvt_f32_ubyte2 %0, %1" : "=v"(r) : "v"(x)); return r; }
__device__ __forceinline__ float cvt_ub3(unsigned x) { float r; asm("v_cvt_f32_ubyte3 %0, %1" : "=v"(r) : "v"(x)); return r; }
__device__ __forceinline__ void quant4_rows(const float* src, unsigned char* dst, float* scale, int nrows, int gw, int NGW, int lane) {
    for (int r = gw; r < nrows; r += NGW) {
        const f32x4* sp = (const f32x4*)(src + (size_t)r * 1024) + 4 * lane;
        f32x4 v[4]; float am = 0.f, ss = 0.f;
#pragma unroll
        for (int j = 0; j < 4; ++j) { v[j] = sp[j]; am = fmaxf(am, fmaxf(fmaxf(fabsf(v[j].x), fabsf(v[j].y)), fmaxf(fabsf(v[j].z), fabsf(v[j].w)))); ss += (v[j].x * v[j].x + v[j].y * v[j].y) + (v[j].z * v[j].z + v[j].w * v[j].w); }
#pragma unroll
        for (int o = 1; o < 64; o <<= 1) { am = fmaxf(am, shx(am, lane, o)); ss += shx(ss, lane, o); }
        const float step = fminf(am * (1.f / 7.5f), 0.3352f * sqrtf(ss * (1.f / 1024.f)));
        const float inv = step > 0.f ? 1.f / step : 0.f;
        unsigned q[16];
#pragma unroll
        for (int j = 0; j < 4; ++j) { q[4 * j] = (unsigned)fminf(fmaxf(rintf(v[j].x * inv + 7.5f), 0.f), 15.f); q[4 * j + 1] = (unsigned)fminf(fmaxf(rintf(v[j].y * inv + 7.5f), 0.f), 15.f);
                                      q[4 * j + 2] = (unsigned)fminf(fmaxf(rintf(v[j].z * inv + 7.5f), 0.f), 15.f); q[4 * j + 3] = (unsigned)fminf(fmaxf(rintf(v[j].w * inv + 7.5f), 0.f), 15.f); }
        u32x2 w;
        w.x = (q[0] | (q[4] << 4)) | ((q[1] | (q[5] << 4)) << 8) | ((q[2] | (q[6] << 4)) << 16) | ((q[3] | (q[7] << 4)) << 24);
        w.y = (q[8] | (q[12] << 4)) | ((q[9] | (q[13] << 4)) << 8) | ((q[10] | (q[14] << 4)) << 16) | ((q[11] | (q[15] << 4)) << 24);
        *(u32x2*)(dst + (size_t)r * 512 + 8 * lane) = w;
        if (lane == 0) scale[r] = step;
    }
}

#define RED_STEP(N, S) do { const bool up_ = (lane & (S)) != 0; _Pragma("unroll") for (int j_ = 0; j_ < (N); ++j_) { const int a_ = p[j_], b_ = p[j_ + (N)]; const int send_ = up_ ? a_ : b_, keep_ = up_ ? b_ : a_; p[j_] = keep_ + shxi(send_, lane, (S)); } } while (0)
#define RED16(dst) do { RED_STEP(8, 8); RED_STEP(4, 4); RED_STEP(2, 2); RED_STEP(1, 1); int s_ = p[0]; s_ += shxi(s_, lane, 16); s_ += shxi(s_, lane, 32); dst = s_; } while (0)
#define G_SB() __builtin_amdgcn_sched_barrier(0)
#define G_LOAD(buf, tab, evec, jb) do { _Pragma("unroll") for (int jj_ = 0; jj_ < 16; ++jj_) { const int e_ = __builtin_amdgcn_readlane(evec, (jb) + jj_); buf[jj_] = __builtin_amdgcn_raw_buffer_load_b64(rs_##tab, (int)voff, e_ << 9, 0); } } while (0)
#define U_COMP(buf) do { _Pragma("unroll") for (int jj_ = 0; jj_ < 16; ++jj_) { const unsigned w0_ = buf[jj_].x, w1_ = buf[jj_].y; \
    int d_ = __builtin_amdgcn_sdot4((int)(w0_ & 0x0F0F0F0Fu), hq[0], 0, false); d_ = __builtin_amdgcn_sdot4((int)((w0_ >> 4) & 0x0F0F0F0Fu), hq[1], d_, false); \
    d_ = __builtin_amdgcn_sdot4((int)(w1_ & 0x0F0F0F0Fu), hq[2], d_, false); d_ = __builtin_amdgcn_sdot4((int)((w1_ >> 4) & 0x0F0F0F0Fu), hq[3], d_, false); p[jj_] = d_; } } while (0)
#define V_DW(o0, o1, o2, o3, wd, cs) do { float t0_, t1_, t2_, t3_; asm volatile("v_cvt_f32_ubyte0 %4, %8\n\tv_cvt_f32_ubyte1 %5, %8\n\tv_cvt_f32_ubyte2 %6, %8\n\tv_cvt_f32_ubyte3 %7, %8\n\tv_fmac_f32 %0, %9, %4\n\tv_fmac_f32 %1, %9, %5\n\tv_fmac_f32 %2, %9, %6\n\tv_fmac_f32 %3, %9, %7" \
    : "+v"(o0), "+v"(o1), "+v"(o2), "+v"(o3), "=&v"(t0_), "=&v"(t1_), "=&v"(t2_), "=&v"(t3_) : "v"(wd), "s"(cs)); } while (0)
#define V_COMP(buf, cvec, jb) do { _Pragma("unroll") for (int jj_ = 0; jj_ < 16; ++jj_) { const float c_ = __uint_as_float(__builtin_amdgcn_readlane(__float_as_uint(cvec), (jb) + jj_)); const unsigned w0_ = buf[jj_].x, w1_ = buf[jj_].y; \
    V_DW(o[0], o[1], o[2], o[3], w0_ & 0x0F0F0F0Fu, c_); V_DW(o[4], o[5], o[6], o[7], (w0_ >> 4) & 0x0F0F0F0Fu, c_); V_DW(o[8], o[9], o[10], o[11], w1_ & 0x0F0F0F0Fu, c_); V_DW(o[12], o[13], o[14], o[15], (w1_ >> 4) & 0x0F0F0F0Fu, c_); } } while (0)
template <bool NEXT_NORM>
__device__ __forceinline__ void peer_gather_phase(const int wv, bool dry, int vcu, const bf16* HN, const int* EXPERTS, const float* GATESP, const unsigned char* U, const float* SU, const unsigned char* Vtab, const float* SV,
                                                  float* X, const float* gnext, bf16* XN) {
    int ln_; asm volatile("v_mbcnt_lo_u32_b32 %0, -1, 0\n\tv_mbcnt_hi_u32_b32 %0, -1, %0" : "=v"(ln_)); const int tid = wv * 64 + ln_, lane = tid & 63, w = wv;
    const __amdgpu_buffer_rsrc_t rs_U = __builtin_amdgcn_make_buffer_rsrc((void*)U, (short)0, 16384 * 512, 0x00020000), rs_Vtab = __builtin_amdgcn_make_buffer_rsrc((void*)Vtab, (short)0, 16384 * 512, 0x00020000);
    const unsigned voff = (unsigned)lane * 8u;
    const int lg = lane >> 4;
#pragma unroll 1
    for (int i = 0; i < 16; ++i) {
        const int t = vcu * 128 + w * 16 + i;
        const int ev0 = EXPERTS[(size_t)t * 128 + lane], ev1 = EXPERTS[(size_t)t * 128 + 64 + lane];
        const float gv0 = GATESP[(size_t)t * 128 + lane], gv1 = GATESP[(size_t)t * 128 + 64 + lane];
        const v4u h0 = *(const v4u*)(HN + (size_t)t * 1024 + 16 * lane), h1 = *(const v4u*)(HN + (size_t)t * 1024 + 16 * lane + 8);
        float hf[16]; float am = 0.f;
#pragma unroll
        for (int k = 0; k < 4; ++k) { hf[2 * k] = bf_lo(h0[k]); hf[2 * k + 1] = bf_hi(h0[k]); hf[8 + 2 * k] = bf_lo(h1[k]); hf[9 + 2 * k] = bf_hi(h1[k]); }
#pragma unroll
        for (int k = 0; k < 16; ++k) am = fmaxf(am, fabsf(hf[k]));
#pragma unroll
        for (int o = 1; o < 64; o <<= 1) am = fmaxf(am, shx(am, lane, o));
        const float hinv = am > 0.f ? 127.f / am : 0.f, sh = am * (1.f / 127.f);
        int hq[4]; int hs = 0;
#pragma unroll
        for (int k = 0; k < 4; ++k) { const int q0 = (int)rintf(hf[4 * k] * hinv), q1 = (int)rintf(hf[4 * k + 1] * hinv), q2 = (int)rintf(hf[4 * k + 2] * hinv), q3 = (int)rintf(hf[4 * k + 3] * hinv); hs += (q0 + q1) + (q2 + q3);
            hq[k] = (int)(((unsigned)(q0 & 0xff)) | ((unsigned)(q1 & 0xff) << 8) | ((unsigned)(q2 & 0xff) << 16) | ((unsigned)(q3 & 0xff) << 24)); }
#pragma unroll
        for (int o = 1; o < 64; o <<= 1) hs += shxi(hs, lane, o);
        const float hoff = 7.5f * (float)hs;
        const float su0 = SU[ev0], su1 = SU[ev1], sv0 = SV[ev0], sv1 = SV[ev1];
        float o[16];
#pragma unroll
        for (int k = 0; k < 16; ++k) o[k] = 0.f;
        int p[16], r0, r1, r2, r3, r4, r5, r6, r7;
        u32x2 A[16], B[16], C[16];
        G_LOAD(A, U, ev0, 0); G_LOAD(B, U, ev0, 16); G_SB();
        G_LOAD(C, U, ev0, 32); G_SB(); U_COMP(A); RED16(r0); G_SB();
        G_LOAD(A, U, ev0, 48); G_SB(); U_COMP(B); RED16(r1); G_SB();
        G_LOAD(B, U, ev1, 0); G_SB(); U_COMP(C); RED16(r2); G_SB();
        G_LOAD(C, U, ev1, 16); G_SB(); U_COMP(A); RED16(r3); G_SB();
        G_LOAD(A, U, ev1, 32); G_SB(); U_COMP(B); RED16(r4); G_SB();
        G_LOAD(B, U, ev1, 48); G_SB(); U_COMP(C); RED16(r5); G_SB();
        G_LOAD(C, Vtab, ev0, 0); G_SB(); U_COMP(A); RED16(r6); G_SB();
        G_LOAD(A, Vtab, ev0, 16); G_SB(); U_COMP(B); RED16(r7); G_SB();
        const int d0 = lg == 0 ? r0 : (lg == 1 ? r1 : (lg == 2 ? r2 : r3)), d1 = lg == 0 ? r4 : (lg == 1 ? r5 : (lg == 2 ? r6 : r7));
        float act0 = ((float)d0 - hoff) * (sh * su0), act1 = ((float)d1 - hoff) * (sh * su1);
#ifdef PROBE_NOFFN
        const float coef0 = 0.f * act0, coef1 = 0.f * act1;
#else
        const float coef0 = gv0 * (0.5f * act0 * (1.f + erff(act0 * 0.70710678118f))) * sv0, coef1 = gv1 * (0.5f * act1 * (1.f + erff(act1 * 0.70710678118f))) * sv1;
#endif
        G_SB();
        G_LOAD(B, Vtab, ev0, 32); G_SB(); V_COMP(C, coef0, 0); G_SB();
        G_LOAD(C, Vtab, ev0, 48); G_SB(); V_COMP(A, coef0, 16); G_SB();
        G_LOAD(A, Vtab, ev1, 0); G_SB(); V_COMP(B, coef0, 32); G_SB();
        G_LOAD(B, Vtab, ev1, 16); G_SB(); V_COMP(C, coef0, 48); G_SB();
        G_LOAD(C, Vtab, ev1, 32); G_SB(); V_COMP(A, coef1, 0); G_SB();
        G_LOAD(A, Vtab, ev1, 48); G_SB(); V_COMP(B, coef1, 16); G_SB();
        V_COMP(C, coef1, 32); G_SB(); V_COMP(A, coef1, 48); G_SB();
        const float corr = 7.5f * wave_sum(coef0 + coef1, lane);
        float* xr = X + (size_t)t * 1024 + 16 * lane;
        f32x4 xv[4];
#pragma unroll
        for (int k = 0; k < 4; ++k) { xv[k] = *(const f32x4*)(xr + 4 * k); xv[k] += (f32x4){o[4 * k] - corr, o[4 * k + 1] - corr, o[4 * k + 2] - corr, o[4 * k + 3] - corr}; }
        if (!dry) {
#pragma unroll
            for (int k = 0; k < 4; ++k) *(f32x4*)(xr + 4 * k) = xv[k]; }
        if (NEXT_NORM && !dry) {
            float ss = 0.f;
#pragma unroll
            for (int k = 0; k < 4; ++k) ss += (xv[k].x * xv[k].x + xv[k].y * xv[k].y) + (xv[k].z * xv[k].z + xv[k].w * xv[k].w);
            const float rstd = rsqrtf(wave_sum(ss, lane) * (1.f / 1024.f) + EPS);
            v4u wa, wb;
#pragma unroll
            for (int k = 0; k < 4; ++k) { const f32x4 g = *(const f32x4*)(gnext + 16 * lane + 4 * k); const unsigned lo = pk2(xv[k].x * rstd * g.x, xv[k].y * rstd * g.y), hi2 = pk2(xv[k].z * rstd * g.z, xv[k].w * rstd * g.w);
                if (k < 2) { wa[2 * k] = lo; wa[2 * k + 1] = hi2; } else { wb[2 * (k - 2)] = lo; wb[2 * (k - 2) + 1] = hi2; } }
            *(v4u*)(XN + (size_t)t * 1024 + 16 * lane) = wa; *(v4u*)(XN + (size_t)t * 1024 + 16 * lane + 8) = wb;
        }
    }
}

__device__ __forceinline__ void rms_quant_pass(const float* X, const float* g, bf16* XN, unsigned char* HQ, float* SH, float* HS, int gw, int NGW, int lane) {
    for (int m = gw; m < T; m += NGW) {
        const f32x4* xr = (const f32x4*)(X + (size_t)m * D) + lane; const f32x4* gr = (const f32x4*)g + lane;
        f32x4 v[4]; float s = 0.f;
#pragma unroll
        for (int j = 0; j < 4; ++j) { v[j] = xr[64 * j]; s += (v[j].x * v[j].x + v[j].y * v[j].y) + (v[j].z * v[j].z + v[j].w * v[j].w); }
        const float rstd = rsqrtf(wave_sum(s, lane) * (1.f / 1024.f) + EPS);
        unsigned long long* o8 = (unsigned long long*)(XN + (size_t)m * D) + lane;
        float am = 0.f;
#pragma unroll
        for (int j = 0; j < 4; ++j) { const f32x4 gg = gr[64 * j]; v[j].x = v[j].x * rstd * gg.x; v[j].y = v[j].y * rstd * gg.y; v[j].z = v[j].z * rstd * gg.z; v[j].w = v[j].w * rstd * gg.w;
            o8[64 * j] = (unsigned long long)pk2(v[j].x, v[j].y) | ((unsigned long long)pk2(v[j].z, v[j].w) << 32);
            am = fmaxf(am, fmaxf(fmaxf(fabsf(v[j].x), fabsf(v[j].y)), fmaxf(fabsf(v[j].z), fabsf(v[j].w)))); }
#pragma unroll
        for (int o = 1; o < 64; o <<= 1) am = fmaxf(am, shx(am, lane, o));
        const float hinv = am > 0.f ? 127.f / am : 0.f;
        int hs = 0;
        unsigned* q4 = (unsigned*)(HQ + (size_t)m * D) + lane;
#pragma unroll
        for (int j = 0; j < 4; ++j) { const int q0 = (int)rintf(v[j].x * hinv), q1 = (int)rintf(v[j].y * hinv), q2 = (int)rintf(v[j].z * hinv), q3 = (int)rintf(v[j].w * hinv); hs += (q0 + q1) + (q2 + q3);
            q4[64 * j] = ((unsigned)(q0 & 0xff)) | ((unsigned)(q1 & 0xff) << 8) | ((unsigned)(q2 & 0xff) << 16) | ((unsigned)(q3 & 0xff) << 24); }
#pragma unroll
        for (int o = 1; o < 64; o <<= 1) hs += shxi(hs, lane, o);
        if (lane == 0) { SH[m] = am * (1.f / 127.f); HS[m] = (float)hs; }
    }
}
__device__ __forceinline__ int dpp_add_quad(int d) {
    d += __builtin_amdgcn_update_dpp(0, d, 0xB1, 0xF, 0xF, true);
    d += __builtin_amdgcn_update_dpp(0, d, 0x4E, 0xF, 0xF, true);
    return d;
}
__device__ __forceinline__ int dpp_add_oct(int d) {
    d += __builtin_amdgcn_update_dpp(0, d, 0xB1, 0xF, 0xF, true);
    d += __builtin_amdgcn_update_dpp(0, d, 0x4E, 0xF, 0xF, true);
    d += __builtin_amdgcn_update_dpp(0, d, 0x141, 0xF, 0xF, true);
    return d;
}
#define G1_IDS(E_, H0_, H1_, it_) do { const int t_ = t0 + ((it_) >> 1), hf_ = (it_) & 1; const v4u* ep_ = (const v4u*)(EXPERTS + (size_t)t_ * 128 + 16 * oct + 8 * hf_); const v4u ea_ = ep_[0], eb_ = ep_[1]; \
    E_[0] = (int)ea_.x; E_[1] = (int)ea_.y; E_[2] = (int)ea_.z; E_[3] = (int)ea_.w; E_[4] = (int)eb_.x; E_[5] = (int)eb_.y; E_[6] = (int)eb_.z; E_[7] = (int)eb_.w; \
    H0_ = *(const v4u*)(HQ + (size_t)t_ * 1024 + 256 * s + 32 * q8); H1_ = *(const v4u*)(HQ + (size_t)t_ * 1024 + 256 * s + 32 * q8 + 16); } while (0)
#define G1_ROWS(R_, E_) do { _Pragma("unroll") for (int j_ = 0; j_ < 8; ++j_) R_[j_] = __builtin_amdgcn_raw_buffer_load_b128(rs_U, (E_[j_] << 9) + soff, 0, 0); } while (0)
#define G1_COMP(R_, H0_, H1_, it_) do { int dd_[8]; _Pragma("unroll") for (int j_ = 0; j_ < 8; ++j_) { \
    int d_ = __builtin_amdgcn_sdot4((int)(R_[j_].x & 0x0F0F0F0Fu), (int)H0_.x, 0, false); d_ = __builtin_amdgcn_sdot4((int)((R_[j_].x >> 4) & 0x0F0F0F0Fu), (int)H0_.y, d_, false); \
    d_ = __builtin_amdgcn_sdot4((int)(R_[j_].y & 0x0F0F0F0Fu), (int)H0_.z, d_, false); d_ = __builtin_amdgcn_sdot4((int)((R_[j_].y >> 4) & 0x0F0F0F0Fu), (int)H0_.w, d_, false); \
    d_ = __builtin_amdgcn_sdot4((int)(R_[j_].z & 0x0F0F0F0Fu), (int)H1_.x, d_, false); d_ = __builtin_amdgcn_sdot4((int)((R_[j_].z >> 4) & 0x0F0F0F0Fu), (int)H1_.y, d_, false); \
    d_ = __builtin_amdgcn_sdot4((int)(R_[j_].w & 0x0F0F0F0Fu), (int)H1_.z, d_, false); d_ = __builtin_amdgcn_sdot4((int)((R_[j_].w >> 4) & 0x0F0F0F0Fu), (int)H1_.w, d_, false); \
    dd_[j_] = dpp_add_oct(d_); } \
    if (q8 == 0) { v4u* pp_ = (v4u*)(PART + ((size_t)s * T + t0 + ((it_) >> 1)) * 128 + 16 * oct + 8 * ((it_) & 1)); pp_[0] = (v4u){(unsigned)dd_[0], (unsigned)dd_[1], (unsigned)dd_[2], (unsigned)dd_[3]}; pp_[1] = (v4u){(unsigned)dd_[4], (unsigned)dd_[5], (unsigned)dd_[6], (unsigned)dd_[7]}; } } while (0)
__device__ __forceinline__ void peer_g1_phase(const int wv, int vcu, const unsigned char* HQ, const int* EXPERTS, const unsigned char* U, int* PART) {
    int ln_; asm volatile("v_mbcnt_lo_u32_b32 %0, -1, 0\n\tv_mbcnt_hi_u32_b32 %0, -1, %0" : "=v"(ln_)); const int lane = ln_, oct = lane >> 3, q8 = lane & 7;
    const int s = vcu >> 6;
    const __amdgpu_buffer_rsrc_t rs_U = __builtin_amdgcn_make_buffer_rsrc((void*)U, (short)0, 16384 * 512, 0x00020000);
    const int soff = 128 * s + 16 * q8;
    const int t0 = 512 * (vcu & 63) + 64 * wv;
    int eA[8], eB[8]; v4u rA[8], rB[8], hA0, hA1, hB0, hB1, hC0, hC1;
    G1_IDS(eA, hA0, hA1, 0); G1_ROWS(rA, eA); G1_IDS(eB, hB0, hB1, 1);
#pragma unroll 1
    for (int i = 0; i < 128; i += 2) {
        G1_ROWS(rB, eB); __builtin_amdgcn_sched_barrier(0);
        G1_IDS(eA, hC0, hC1, (i + 2) & 127); __builtin_amdgcn_sched_barrier(0);
        G1_COMP(rA, hA0, hA1, i); __builtin_amdgcn_sched_barrier(0);
        G1_ROWS(rA, eA); hA0 = hC0; hA1 = hC1; __builtin_amdgcn_sched_barrier(0);
        G1_IDS(eB, hC0, hC1, (i + 3) & 127); __builtin_amdgcn_sched_barrier(0);
        G1_COMP(rB, hB0, hB1, i + 1); __builtin_amdgcn_sched_barrier(0);
        hB0 = hC0; hB1 = hC1;
    }
}
__device__ __forceinline__ void peer_g1b_phase(const int* PART, const int* EXPERTS, const float* GATESP, const float* SU, const float* SV, const float* SH, const float* HS, unsigned char* COEFQ, float* SCT, float* CS, int gw, int NGW, int lane) {
    for (int t = gw; t < T; t += NGW) {
        const float sh = SH[t], hoff = 7.5f * HS[t];
        float cf[2]; float am = 0.f;
#pragma unroll
        for (int h2 = 0; h2 < 2; ++h2) {
            const size_t idx = (size_t)t * 128 + 64 * h2 + lane;
            int d = 0;
#pragma unroll
            for (int x = 0; x < 4; ++x) d += PART[(size_t)x * T * 128 + idx];
            const int ev = EXPERTS[idx];
            const float act = ((float)d - hoff) * (sh * SU[ev]);
            cf[h2] = GATESP[idx] * (0.5f * act * (1.f + erff(act * 0.70710678118f))) * SV[ev];
            am = fmaxf(am, fabsf(cf[h2]));
        }
#pragma unroll
        for (int o = 1; o < 64; o <<= 1) am = fmaxf(am, shx(am, lane, o));
        const float inv = am > 0.f ? 127.f / am : 0.f;
        const int q0 = (int)rintf(cf[0] * inv), q1 = (int)rintf(cf[1] * inv);
        COEFQ[(size_t)t * 128 + lane] = (unsigned char)(q0 & 0xff); COEFQ[(size_t)t * 128 + 64 + lane] = (unsigned char)(q1 & 0xff);
        int cs = q0 + q1;
#pragma unroll
        for (int o = 1; o < 64; o <<= 1) cs += shxi(cs, lane, o);
        if (lane == 0) { SCT[t] = am * (1.f / 127.f); CS[t] = (float)cs; }
    }
}
#define G2_IDS(E_, C_, it_) do { const int t_ = t0 + ((it_) >> 1), hf_ = (it_) & 1; const v4u* ep_ = (const v4u*)(EXPERTS + (size_t)t_ * 128 + 16 * oct + 8 * hf_); const v4u ea_ = ep_[0], eb_ = ep_[1]; \
    E_[0] = (int)ea_.x; E_[1] = (int)ea_.y; E_[2] = (int)ea_.z; E_[3] = (int)ea_.w; E_[4] = (int)eb_.x; E_[5] = (int)eb_.y; E_[6] = (int)eb_.z; E_[7] = (int)eb_.w; \
    C_ = *(const u32x2*)(COEFQ + (size_t)t_ * 128 + 16 * oct + 8 * hf_); } while (0)
#define G2_ROWS(R_, E_) do { _Pragma("unroll") for (int j_ = 0; j_ < 8; ++j_) R_[j_] = __builtin_amdgcn_raw_buffer_load_b128(rs_V, (E_[j_] << 9) + soff, 0, 0); } while (0)
#define G2_T4(ob, w0, w1, w2, w3, cq_) do { const unsigned a_ = __builtin_amdgcn_perm(w1, w0, 0x05010400u), b_ = __builtin_amdgcn_perm(w1, w0, 0x07030602u), c_ = __builtin_amdgcn_perm(w3, w2, 0x05010400u), d_ = __builtin_amdgcn_perm(w3, w2, 0x07030602u); \
    const unsigned y0_ = __builtin_amdgcn_perm(c_, a_, 0x05040100u), y1_ = __builtin_amdgcn_perm(c_, a_, 0x07060302u), y2_ = __builtin_amdgcn_perm(d_, b_, 0x05040100u), y3_ = __builtin_amdgcn_perm(d_, b_, 0x07060302u); \
    o[(ob)] = __builtin_amdgcn_sdot4((int)(y0_ & 0x0F0F0F0Fu), cq_, o[(ob)], false); o[(ob) + 4] = __builtin_amdgcn_sdot4((int)((y0_ >> 4) & 0x0F0F0F0Fu), cq_, o[(ob) + 4], false); \
    o[(ob) + 1] = __builtin_amdgcn_sdot4((int)(y1_ & 0x0F0F0F0Fu), cq_, o[(ob) + 1], false); o[(ob) + 5] = __builtin_amdgcn_sdot4((int)((y1_ >> 4) & 0x0F0F0F0Fu), cq_, o[(ob) + 5], false); \
    o[(ob) + 2] = __builtin_amdgcn_sdot4((int)(y2_ & 0x0F0F0F0Fu), cq_, o[(ob) + 2], false); o[(ob) + 6] = __builtin_amdgcn_sdot4((int)((y2_ >> 4) & 0x0F0F0F0Fu), cq_, o[(ob) + 6], false); \
    o[(ob) + 3] = __builtin_amdgcn_sdot4((int)(y3_ & 0x0F0F0F0Fu), cq_, o[(ob) + 3], false); o[(ob) + 7] = __builtin_amdgcn_sdot4((int)((y3_ >> 4) & 0x0F0F0F0Fu), cq_, o[(ob) + 7], false); } while (0)
#define G2_REDI(N, S) do { const bool up_ = (lane & (S)) != 0; _Pragma("unroll") for (int j_ = 0; j_ < (N); ++j_) { const int a_ = o[j_], b_ = o[j_ + (N)]; const int send_ = up_ ? a_ : b_, keep_ = up_ ? b_ : a_; o[j_] = keep_ + shxi(send_, lane, (S)); } } while (0)
#define G2_COMP(R_, C_, it_) do { int o[32]; _Pragma("unroll") for (int k_ = 0; k_ < 32; ++k_) o[k_] = 0; \
    G2_T4(0, R_[0].x, R_[1].x, R_[2].x, R_[3].x, (int)C_.x); G2_T4(8, R_[0].y, R_[1].y, R_[2].y, R_[3].y, (int)C_.x); G2_T4(16, R_[0].z, R_[1].z, R_[2].z, R_[3].z, (int)C_.x); G2_T4(24, R_[0].w, R_[1].w, R_[2].w, R_[3].w, (int)C_.x); \
    G2_T4(0, R_[4].x, R_[5].x, R_[6].x, R_[7].x, (int)C_.y); G2_T4(8, R_[4].y, R_[5].y, R_[6].y, R_[7].y, (int)C_.y); G2_T4(16, R_[4].z, R_[5].z, R_[6].z, R_[7].z, (int)C_.y); G2_T4(24, R_[4].w, R_[5].w, R_[6].w, R_[7].w, (int)C_.y); \
    G2_REDI(16, 8); G2_REDI(8, 16); G2_REDI(4, 32); \
    const int tt_ = t0 + ((it_) >> 1); const float sc_ = SCT[tt_], corr_ = ((it_) & 1) ? 0.f : 7.5f * CS[tt_]; f32x4* xp_ = (f32x4*)(X + (size_t)tt_ * 1024 + ocol); f32x4 xv_ = *xp_; \
    xv_.x += sc_ * ((float)o[0] - corr_); xv_.y += sc_ * ((float)o[1] - corr_); xv_.z += sc_ * ((float)o[2] - corr_); xv_.w += sc_ * ((float)o[3] - corr_); *xp_ = xv_; } while (0)
__device__ __forceinline__ void peer_g2_phase(const int wv, int vcu, const int* EXPERTS, const unsigned char* COEFQ, const float* SCT, const float* CS, const unsigned char* Vtab, float* X) {
    int ln_; asm volatile("v_mbcnt_lo_u32_b32 %0, -1, 0\n\tv_mbcnt_hi_u32_b32 %0, -1, %0" : "=v"(ln_)); const int lane = ln_, oct = lane >> 3, q8 = lane & 7;
    const int s = vcu >> 6;
    const __amdgpu_buffer_rsrc_t rs_V = __builtin_amdgcn_make_buffer_rsrc((void*)Vtab, (short)0, 16384 * 512, 0x00020000);
    const int soff = 128 * s + 16 * q8;
    const int ocol = 256 * s + 32 * q8 + 16 * ((lane >> 3) & 1) + 8 * ((lane >> 4) & 1) + 4 * ((lane >> 5) & 1);
    const int t0 = 512 * (vcu & 63) + 64 * wv;
    int eA[8], eB[8]; u32x2 cA, cB, cC; v4u rA[8], rB[8];
    G2_IDS(eA, cA, 0); G2_ROWS(rA, eA); G2_IDS(eB, cB, 1);
#pragma unroll 1
    for (int i = 0; i < 128; i += 2) {
        G2_ROWS(rB, eB); __builtin_amdgcn_sched_barrier(0);
        G2_IDS(eA, cC, (i + 2) & 127); __builtin_amdgcn_sched_barrier(0);
        G2_COMP(rA, cA, i); __builtin_amdgcn_sched_barrier(0);
        G2_ROWS(rA, eA); cA = cC; __builtin_amdgcn_sched_barrier(0);
        G2_IDS(eB, cC, (i + 3) & 127); __builtin_amdgcn_sched_barrier(0);
        G2_COMP(rB, cB, i + 1); __builtin_amdgcn_sched_barrier(0);
        cB = cC;
    }
}

__device__ __forceinline__ void qknorm_rope_pass(bf16* Q1, bf16* K1, const float* qg, const float* kg, const float* rope, size_t gtid, size_t gthreads) {
    const size_t NROWS = (size_t)2 * 64 * 2 * 4096;
    const int lane = (int)(gtid & 63);
    for (size_t id = gtid; id < NROWS * 8; id += gthreads) {
        const size_t rowg = id >> 3; const int part = (int)(id & 7);
        const bool isk = rowg >= NROWS / 2; const size_t row = isk ? rowg - NROWS / 2 : rowg;
        bf16* ptr = (isk ? K1 : Q1) + row * 64 + part * 8; const float* g = (isk ? kg : qg) + part * 8;
        const int s = (int)(row & 4095); const int bh = (int)(row >> 13); const int bidx = bh >> 3; const size_t mtok = (size_t)bidx * 4096 + s;
        const v4u raw = *(const v4u*)ptr;
        float x[8];
#pragma unroll
        for (int i = 0; i < 4; ++i) { x[2 * i] = bf_lo(raw[i]); x[2 * i + 1] = bf_hi(raw[i]); }
        float ss = 0.f;
#pragma unroll
        for (int i = 0; i < 8; ++i) ss += x[i] * x[i];
        ss += shx(ss, lane, 1); ss += shx(ss, lane, 2); ss += shx(ss, lane, 4);
        const float rstd = rsqrtf(ss * (1.f / 64.f) + EPS);
        float y[8], other[8];
#pragma unroll
        for (int i = 0; i < 8; ++i) y[i] = x[i] * rstd * g[i];
#pragma unroll
        for (int i = 0; i < 8; ++i) other[i] = shx(y[i], lane, 1);
        if (part < 2) { const float* cs = rope + mtok * 16;
#pragma unroll
            for (int i = 0; i < 8; ++i) { const float co = cs[i], si = cs[8 + i]; y[i] = (part == 0) ? (y[i] * co - other[i] * si) : (y[i] * co + other[i] * si); } }
        const float sc = isk ? 1.f : (0.125f * 1.44269504089f);
        v4u o;
#pragma unroll
        for (int i = 0; i < 4; ++i) o[i] = pk2(y[2 * i] * sc, y[2 * i + 1] * sc);
        *(v4u*)ptr = o;
    }
}

__device__ __forceinline__ void glds16(const void* gsrc, unsigned lds_dst) { unsigned keep;
    asm volatile("s_mov_b32 %0, m0\n\ts_mov_b32 m0, %2\n\ts_nop 0\n\tglobal_load_lds_dwordx4 %1, off\n\ts_mov_b32 m0, %0" : "=&s"(keep) : "v"(gsrc), "s"(lds_dst) : "memory"); }
#define AT_WAIT_BAR() asm volatile("s_waitcnt vmcnt(0) lgkmcnt(0)\n\ts_barrier" ::: "memory")
#define AT_DMA(kt_, slot_) do { \
    _Pragma("unroll") for (int i_ = 0; i_ < 2; ++i_) { const int row_ = 8 * w + (lane >> 3), ch_ = (lane & 7) ^ ((row_ >> 1) & 7); \
        glds16(K1 + ((size_t)((bh * 2 + i_) * 4096 + (kt_) * 64 + row_)) * 64 + ch_ * 8, (unsigned)__builtin_amdgcn_readfirstlane((int)(ldsb + (slot_) * 32768 + i_ * 8192 + w * 1024))); } \
    _Pragma("unroll") for (int i_ = 0; i_ < 2; ++i_) { const int row_ = 8 * w + 4 * i_ + (lane >> 4), ch_ = (lane & 15) ^ ((row_ & 3) << 2); \
        glds16(V1 + ((size_t)(bh * 4096 + (kt_) * 64 + row_)) * 128 + ch_ * 8, (unsigned)__builtin_amdgcn_readfirstlane((int)(ldsb + (slot_) * 32768 + 16384 + w * 2048 + i_ * 1024))); } } while (0)
typedef short v4i16_t __attribute__((ext_vector_type(4)));
__device__ __forceinline__ bf16x8 vtr8(const LAS bf16* p) {
    const v4i16_t lo = __builtin_amdgcn_ds_read_tr16_b64_v4i16((LAS v4i16_t*)p), hi = __builtin_amdgcn_ds_read_tr16_b64_v4i16((LAS v4i16_t*)(p + 8 * 128));
    return (bf16x8){lo[0], lo[1], lo[2], lo[3], hi[0], hi[1], hi[2], hi[3]};
}
template <bool OFFS>
__device__ __forceinline__ void attn_units(const int wv, LAS unsigned char* lds, int vcu, const bf16* Q1, const bf16* K1, const bf16* V1, bf16* O, const float* subln, float lam, float offs) {
    int ln_; asm volatile("v_mbcnt_lo_u32_b32 %0, -1, 0\n\tv_mbcnt_hi_u32_b32 %0, -1, %0" : "=v"(ln_)); const int tid = wv * 64 + ln_, lane = tid & 63, w = wv, r32 = lane & 31, hi = lane >> 5, qt = w & 3, c = w >> 2;
    LAS float* lbuf = (LAS float*)(lds + 135168 + w * 128);
    LAS float* Obuf = (LAS float*)lds;
    const unsigned ldsb = (unsigned)(uintptr_t)lds;
#pragma unroll 1
    for (int ui = 0; ui < 8; ++ui) {
        const int bh = (vcu >> 5) * 8 + ui, qb = vcu & 31, b = bh >> 3, h = bh & 7;
        bf16x8 bq[4];
#pragma unroll
        for (int ks = 0; ks < 4; ++ks) bq[ks] = *(const bf16x8*)(Q1 + ((size_t)((bh * 2 + c) * 4096 + qb * 128 + qt * 32 + r32)) * 64 + ks * 16 + 8 * hi);
        f32x16 Oa[4];
#pragma unroll
        for (int db = 0; db < 4; ++db)
#pragma unroll
            for (int r = 0; r < 16; ++r) Oa[db][r] = 0.f;
        float lsum = 0.f;
        AT_DMA(0, 0); AT_DMA(1, 1);
        AT_WAIT_BAR();
        const int kx0 = (r32 >> 1) & 7, kx1 = ((32 + r32) >> 1) & 7;
        const int vrow = 4 * hi + ((lane >> 2) & 3), vg = (lane >> 4) & 1, vp = lane & 3;
        f32x16 s0, s1;
        { const LAS unsigned char* Kc = lds + c * 8192;
#pragma unroll
          for (int r = 0; r < 16; ++r) { s0[r] = 0.f; s1[r] = 0.f; }
#pragma unroll
          for (int ks = 0; ks < 4; ++ks) { const bf16x8 a0 = *(const LAS bf16x8*)(Kc + r32 * 128 + (((2 * ks + hi) ^ kx0) << 4)), a1 = *(const LAS bf16x8*)(Kc + (32 + r32) * 128 + (((2 * ks + hi) ^ kx1) << 4));
              s0 = mfma32(a0, bq[ks], s0); s1 = mfma32(a1, bq[ks], s1); } }
        int b0 = 0, b1 = 1, b2 = 2;
#pragma unroll 1
        for (int kt = 0; kt < 64; ++kt) {
            if (kt + 2 < 64) AT_DMA(kt + 2, b2);
            const LAS unsigned char* Kc = lds + b1 * 32768 + c * 8192;
            const LAS unsigned char* Vb = lds + b0 * 32768 + 16384 + vrow * 256 + 8 * (vp & 1);
            f32x16 n0, n1;
#pragma unroll
            for (int r = 0; r < 16; ++r) { n0[r] = 0.f; n1[r] = 0.f; }
            bf16x8 ka[8];
#define AT_KLD(ks_) do { ka[2 * (ks_)] = *(const LAS bf16x8*)(Kc + r32 * 128 + (((2 * (ks_) + hi) ^ kx0) << 4)); ka[2 * (ks_) + 1] = *(const LAS bf16x8*)(Kc + (32 + r32) * 128 + (((2 * (ks_) + hi) ^ kx1) << 4)); } while (0)
            AT_KLD(0); AT_KLD(1);
            __builtin_amdgcn_sched_barrier(0);
#pragma unroll
            for (int ks = 0; ks < 4; ++ks) {
                n0 = mfma32(ka[2 * ks], bq[ks], n0);
#pragma unroll
                for (int r = 0; r < 4; ++r) s0[4 * ks + r] = __builtin_amdgcn_exp2f(OFFS ? s0[4 * ks + r] - offs : s0[4 * ks + r]);
                __builtin_amdgcn_sched_barrier(0);
                n1 = mfma32(ka[2 * ks + 1], bq[ks], n1);
                if (ks < 2) AT_KLD(ks + 2);
#pragma unroll
                for (int r = 0; r < 4; ++r) s1[4 * ks + r] = __builtin_amdgcn_exp2f(OFFS ? s1[4 * ks + r] - offs : s1[4 * ks + r]);
                __builtin_amdgcn_sched_barrier(0);
            }
#undef AT_KLD
            bf16x8 pa[4]; bf16x8 vf[4], vn[4];
#pragma unroll
            for (int db = 0; db < 4; ++db) vf[db] = vtr8((const LAS bf16*)(Vb + (((4 * db + 2 * vg + (vp >> 1)) ^ ((vrow & 3) << 2)) << 4)));
            float ls = 0.f;
            { v4u t0;
#pragma unroll
              for (int k = 0; k < 4; ++k) { t0[k] = pk2(s0[2 * k], s0[2 * k + 1]); ls += s0[2 * k] + s0[2 * k + 1]; }
              pa[0] = __builtin_bit_cast(bf16x8, t0); }
            __builtin_amdgcn_sched_barrier(0);
#pragma unroll
            for (int sp_ = 0; sp_ < 4; ++sp_) {
                if (sp_ < 3) {
#pragma unroll
                    for (int db = 0; db < 4; ++db) vn[db] = vtr8((const LAS bf16*)(Vb + (16 * (sp_ + 1)) * 256 + (((4 * db + 2 * vg + (vp >> 1)) ^ ((vrow & 3) << 2)) << 4)));
                }
#pragma unroll
                for (int db = 0; db < 4; ++db) Oa[db] = mfma32(pa[sp_], vf[db], Oa[db]);
                if (sp_ < 3) { v4u t0;
#pragma unroll
                    for (int k = 0; k < 4; ++k) { const float x0 = (sp_ == 0) ? s0[8 + 2 * k] : (sp_ == 1 ? s1[2 * k] : s1[8 + 2 * k]), x1 = (sp_ == 0) ? s0[9 + 2 * k] : (sp_ == 1 ? s1[2 * k + 1] : s1[9 + 2 * k]); t0[k] = pk2(x0, x1); ls += x0 + x1; }
                    pa[sp_ + 1] = __builtin_bit_cast(bf16x8, t0); }
                __builtin_amdgcn_sched_barrier(0);
                if (sp_ < 3) {
#pragma unroll
                    for (int db = 0; db < 4; ++db) vf[db] = vn[db];
                }
            }
            lsum += ls;
            s0 = n0; s1 = n1;
            { const int tb = b0; b0 = b1; b1 = b2; b2 = tb; }
            AT_WAIT_BAR();
        }
        lsum += shx(lsum, lane, 32);
        lbuf[r32] = lsum;
#pragma unroll
        for (int r = 0; r < 16; ++r) { const int qrow = (r & 3) + 8 * (r >> 2) + 4 * hi; const float inv = 1.f / lbuf[qrow];
#pragma unroll
            for (int db = 0; db < 4; ++db) Obuf[(c * 128 + qt * 32 + qrow) * 132 + 32 * db + r32] = Oa[db][r] * inv; }
        __syncthreads();
        { const int row = tid >> 2, qd = tid & 3;
          float dv[32]; float ss = 0.f;
#pragma unroll
          for (int k = 0; k < 8; ++k) { const f32x4 o0 = *(const LAS f32x4*)(Obuf + row * 132 + qd * 32 + 4 * k), o1 = *(const LAS f32x4*)(Obuf + (128 + row) * 132 + qd * 32 + 4 * k);
#pragma unroll
              for (int e = 0; e < 4; ++e) { const float d = o0[e] - lam * o1[e]; dv[4 * k + e] = d; ss += d * d; } }
          ss += shx(ss, lane, 1); ss += shx(ss, lane, 2);
          const float rstd = rsqrtf(ss * (1.f / 128.f) + EPS) * (1.f - LAMBDA_INIT);
          bf16* op = O + ((size_t)b * 4096 + qb * 128 + row) * 1024 + h * 128 + qd * 32;
#pragma unroll
          for (int k = 0; k < 4; ++k) { v4u o;
#pragma unroll
              for (int e = 0; e < 4; ++e) o[e] = pk2(dv[8 * k + 2 * e] * rstd * subln[qd * 32 + 8 * k + 2 * e], dv[8 * k + 2 * e + 1] * rstd * subln[qd * 32 + 8 * k + 2 * e + 1]);
              *(v4u*)(op + 8 * k) = o; } }
        __syncthreads();
    }
}
__device__ __forceinline__ void attn_phase(const int wv, LAS unsigned char* lds, int vcu, const bf16* Q1, const bf16* K1, const bf16* V1, bf16* O, const float* qg, const float* kg,
                                           const float* lq1, const float* lk1, const float* lq2, const float* lk2, const float* subln) {
    float s1 = 0.f, s2 = 0.f, mq = 0.f, mk = 0.f;
    for (int i = 0; i < 64; ++i) { s1 += lq1[i] * lk1[i]; s2 += lq2[i] * lk2[i]; mq = fmaxf(mq, fabsf(qg[i])); mk = fmaxf(mk, fabsf(kg[i])); }
    const float lam = expf(s1) - expf(s2) + LAMBDA_INIT;
    const float offs = 8.f * mq * mk * 1.44269504089f * 1.02f + 0.25f;
    if (offs < 24.f) attn_units<false>(wv, lds, vcu, Q1, K1, V1, O, subln, lam, 0.f);
    else attn_units<true>(wv, lds, vcu, Q1, K1, V1, O, subln, lam, offs);
}
#undef AT_LOAD
#undef AT_WRITE
struct Args { const void* in[27]; float* out; unsigned char* ws; };
#define KARG(i) ({ GAS const void* p_; asm volatile("s_load_dwordx2 %0, %1, %2\n\ts_waitcnt lgkmcnt(0)" : "=s"(p_) : "s"(__builtin_amdgcn_kernarg_segment_ptr()), "i"(8 * (i))); (const void*)p_; })
#define KIN(i) ((const float*)KARG(i))
#define KOUT() ((float*)KARG(27))
#define KWS() ((unsigned char*)KARG(28))
#define WSP(T_, off) ((T_*)(KWS() + (off)))
__global__ void __launch_bounds__(NWAVES * 64, 2) mk_fwd(Args args) {
    extern __shared__ __attribute__((aligned(16))) unsigned char lds_raw[];
    LAS unsigned char* lds = (LAS unsigned char*)lds_raw;
    const int G = gridDim.x, bx = blockIdx.x;
    const int wv = __builtin_amdgcn_readfirstlane((int)(threadIdx.x >> 6));
    const int vcu = (G % 8 == 0) ? (bx % 8) * (G / 8) + bx / 8 : bx;
#define PH_IDS() int ln_; asm volatile("v_mbcnt_lo_u32_b32 %0, -1, 0\n\tv_mbcnt_hi_u32_b32 %0, -1, %0" : "=v"(ln_)); const int lane = ln_, wave = wv, tid = wv * 64 + ln_; \
    const int gw = vcu * NWAVES + wave, NGW = G * NWAVES; const size_t gtid = (size_t)vcu * (NWAVES * 64) + tid, gthreads = (size_t)G * (NWAVES * 64); (void)lane; (void)gw; (void)NGW; (void)gtid; (void)gthreads
    if (threadIdx.x < 32) ((LAS unsigned*)(lds + MISC_OFF))[threadIdx.x] = 0u;
    __syncthreads();
    (void)xcd_barrier_post((unsigned*)(WSP(gu32, WS_CTL) + CW_BAR), (volatile LAS unsigned*)(lds + MISC_OFF) + 8);
#define STAMP() do {} while (0)
#ifndef PROBE_DUP
#define PROBE_DUP 0
#endif
#define REPS(bit) _Pragma("unroll 1") for (int rep_ = 0; rep_ < 1 + ((PROBE_DUP >> (bit)) & 1); ++rep_)
#define GRID_BAR1() do { XcdBarrier b_; b_.bar = (unsigned*)(WSP(gu32, WS_CTL) + CW_BAR); b_.x = xb_xcc_id(); b_.st = (volatile LAS unsigned*)(lds + MISC_OFF) + 8; xcd_barrier(b_); } while (0)
#define GRID_BAR() do { GRID_BAR1(); if ((PROBE_DUP >> 9) & 1) GRID_BAR1(); } while (0)

    REPS(5) {
        PH_IDS();
        LAS float* scr = (LAS float*)(lds + wave * 16384);
        constexpr int I0 = 16 * 97, I1 = 16 * 32, I2 = 16 * 64, I3 = 16 * 96, I4 = 16 * 32, I5 = 16 * 64, NITEMS = I0 + I1 + I2 + I3 + I4 + I5;
        for (int it = gw; it < NITEMS; it += NGW) {
            int r = it;
            if (r < I0) { p0_transpose_item(KIN(3), 1024, 3104, WSP(bf16, WS_WIN), scr, r, lane); continue; } r -= I0;
            if (r < I1) { p0_transpose_item(KIN(6), 1024, 1024, WSP(bf16, WS_WO0), scr, r, lane); continue; } r -= I1;
            if (r < I2) { p0_transpose_item(KIN(8), 1024, 2048, WSP(bf16, WS_WQ0), scr, r, lane); continue; } r -= I2;
            if (r < I3) { p0_transpose_item(KIN(13), 1024, 3072, WSP(bf16, WS_WQKV), scr, r, lane); continue; } r -= I3;
            if (r < I4) { p0_transpose_item(KIN(21), 1024, 1024, WSP(bf16, WS_WO1), scr, r, lane); continue; } r -= I4;
            p0_transpose_item(KIN(23), 1024, 2048, WSP(bf16, WS_WQ1), scr, r, lane);
        }
        { bf16* WIN = WSP(bf16, WS_WIN); for (size_t i = gtid * 8; i < (size_t)224 * 1024; i += gthreads * 8) *(v4u*)(WIN + (size_t)3104 * 1024 + i) = (v4u){0u, 0u, 0u, 0u}; }
        cvt_range(KIN(9), WSP(bf16, WS_KEY0), (size_t)262144, gtid, gthreads);
        cvt_range(KIN(24), WSP(bf16, WS_KEY1), (size_t)262144, gtid, gthreads);
        quant4_rows(KIN(10), WSP(unsigned char, WS_U0), WSP(float, WS_SC), 16384, gw, NGW, lane);
        quant4_rows(KIN(11), WSP(unsigned char, WS_V0T), WSP(float, WS_SC + 65536), 16384, gw, NGW, lane);
        quant4_rows(KIN(25), WSP(unsigned char, WS_U1), WSP(float, WS_SC + 2 * 65536), 16384, gw, NGW, lane);
        quant4_rows(KIN(26), WSP(unsigned char, WS_V1T), WSP(float, WS_SC + 3 * 65536), 16384, gw, NGW, lane);
        rms_pass(KIN(0), KIN(2), WSP(bf16, WS_B0), gw, NGW, lane);
        { const int* positions = (const int*)KARG(1); float* ROPE = WSP(float, WS_ROPE);
          for (size_t id = gtid; id < (size_t)T * 8; id += gthreads) { const size_t mtok = id >> 3; const int i = (int)(id & 7);
            const float inv = powf(500000.0f, -(float)i * 2.0f / 16.0f); const float ang = (float)positions[mtok] * inv;
            float sn, cs; sincosf(ang, &sn, &cs); ROPE[mtok * 16 + i] = cs; ROPE[mtok * 16 + 8 + i] = sn; } }
    }
    GRID_BAR();
    REPS(3) {
        unsigned char* ws = KWS();
        pg8::Gemm g{(const bf16*)(ws + WS_B0), (const bf16*)(ws + WS_WIN), T, 3328, 1024}; pg8::StaticOrder S; S.init(T, 3328, G, bx);
        pg8::EpiInProj E{(bf16*)(ws + WS_R1), (bf16*)(ws + WS_R1 + 32 * MiB), (bf16*)(ws + WS_R2), (bf16*)(ws + WS_R3), (float*)(ws + WS_GATES), KIN(4)};
        pg8::gemm_phase<pg8::EpiInProj, pg8::StaticOrder, true, true>(lds, g, S, E, wv);
    }
    GRID_BAR();
    REPS(2) { unsigned char* ws = KWS(); mlstm_phase(wv, lds, (const bf16*)(ws + WS_R1), (const bf16*)(ws + WS_R1 + 32 * MiB), (const bf16*)(ws + WS_R2), (const float*)(ws + WS_GATES), (bf16*)(ws + WS_R4), (bf16*)(ws + WS_R5)); }
    GRID_BAR();
    REPS(6) { PH_IDS(); unsigned char* ws = KWS(); hs_pass((const bf16*)(ws + WS_R4), (const bf16*)(ws + WS_R5), (const bf16*)(ws + WS_R3), KIN(5), (bf16*)(ws + WS_B0), gw, NGW, lane); }
    GRID_BAR();
#pragma unroll 1
    for (int L = 0; L < 2; ++L) {
        if (L == 1) {
            REPS(3) {
                unsigned char* ws = KWS();
                pg8::Gemm g{(const bf16*)(ws + WS_B0), (const bf16*)(ws + WS_WQKV), T, 3072, 1024}; pg8::StaticOrder S; S.init(T, 3072, G, bx);
                pg8::EpiQKV E{(bf16*)(ws + WS_R2), (bf16*)(ws + WS_R3), (bf16*)(ws + WS_R4)};
                pg8::gemm_phase<pg8::EpiQKV, pg8::StaticOrder, true, true>(lds, g, S, E, wv);
            }
            GRID_BAR();
            { PH_IDS(); unsigned char* ws = KWS(); qknorm_rope_pass((bf16*)(ws + WS_R2), (bf16*)(ws + WS_R3), KIN(14), KIN(15), (const float*)(ws + WS_ROPE), gtid, gthreads); }
            GRID_BAR();
            REPS(0) { unsigned char* ws = KWS(); attn_phase(wv, lds, vcu, (const bf16*)(ws + WS_R2), (const bf16*)(ws + WS_R3), (const bf16*)(ws + WS_R4), (bf16*)(ws + WS_B0), KIN(14), KIN(15), KIN(16), KIN(17), KIN(18), KIN(19), KIN(20)); }
            GRID_BAR();
        }
        _Pragma("unroll 1") for (int rep_ = 0; rep_ < 1 + ((L == 0) ? ((PROBE_DUP >> 3) & 1) : 0); ++rep_) {
            unsigned char* ws = KWS(); float* out = KOUT();
            pg8::Gemm g{(const bf16*)(ws + WS_B0), (const bf16*)(ws + (L ? WS_WO1 : WS_WO0)), T, 1024, 1024}; pg8::StaticOrder S; S.init(T, 1024, G, bx);
            pg8::EpiRes E{L ? (const float*)out : KIN(0), out};
            pg8::gemm_phase<pg8::EpiRes, pg8::StaticOrder, true, true>(lds, g, S, E, wv);
        }
        GRID_BAR();
        REPS(7) { PH_IDS(); unsigned char* ws = KWS(); rms_quant_pass(KOUT(), L ? KIN(22) : KIN(7), (bf16*)(ws + WS_B0), ws + WS_R5, (float*)(ws + WS_SC + 4 * 65536), (float*)(ws + WS_SC + 6 * 65536), gw, NGW, lane); }
        GRID_BAR();
        REPS(3) {
            unsigned char* ws = KWS();
            pg8::Gemm g{(const bf16*)(ws + WS_B0), (const bf16*)(ws + (L ? WS_WQ1 : WS_WQ0)), T, 2048, 1024}; pg8::StaticOrder S; S.init(T, 2048, G, bx);
            pg8::EpiPlain E{(bf16*)(ws + WS_R2), 2048};
            pg8::gemm_phase<pg8::EpiPlain, pg8::StaticOrder, true, true>(lds, g, S, E, wv);
        }
        GRID_BAR();
        REPS(4) { unsigned char* ws = KWS(); peer_topk_phase(wv, vcu, (const bf16*)(ws + WS_R2), (const bf16*)(ws + (L ? WS_KEY1 : WS_KEY0)), (int*)(ws + WS_R4), (float*)(ws + WS_R4 + 16 * MiB)); }
        GRID_BAR();
        REPS(1) { unsigned char* ws = KWS(); peer_g1_phase(wv, vcu, ws + WS_R5, (const int*)(ws + WS_R4), ws + (L ? WS_U1 : WS_U0), (int*)(ws + WS_R2)); }
        GRID_BAR();
        { PH_IDS(); unsigned char* ws = KWS(); const size_t so = L ? 2 * 65536 : 0;
          peer_g1b_phase((const int*)(ws + WS_R2), (const int*)(ws + WS_R4), (const float*)(ws + WS_R4 + 16 * MiB), (const float*)(ws + WS_SC + so), (const float*)(ws + WS_SC + so + 65536),
                         (const float*)(ws + WS_SC + 4 * 65536), (const float*)(ws + WS_SC + 6 * 65536), ws + WS_R4 + 32 * MiB, (float*)(ws + WS_SC + 10 * 65536), (float*)(ws + WS_SC + 8 * 65536), gw, NGW, lane); }
        GRID_BAR();
        { unsigned char* ws = KWS(); peer_g2_phase(wv, vcu, (const int*)(ws + WS_R4), ws + WS_R4 + 32 * MiB, (const float*)(ws + WS_SC + 10 * 65536), (const float*)(ws + WS_SC + 8 * 65536), ws + (L ? WS_V1T : WS_V0T), KOUT()); }
        if (L == 0) { GRID_BAR(); { PH_IDS(); rms_pass(KOUT(), KIN(12), WSP(bf16, WS_B0), gw, NGW, lane); } GRID_BAR(); }
    }
#undef GRID_BAR
}

extern "C" void kernel_launch(void* const* d_in, const int* in_sizes, int n_in, void* d_out, int out_size, void* d_ws, size_t ws_size, hipStream_t stream) {
    static int ready = 0;
    if (ready == 0) {
        if (n_in != 27 || out_size != T * D || ws_size < WS_END) { fprintf(stderr, "kernel_launch: unexpected problem (n_in %d, out %d, ws %zu)\n", n_in, out_size, ws_size); ready = -1; return; }
        if (hipFuncSetAttribute((const void*)mk_fwd, hipFuncAttributeMaxDynamicSharedMemorySize, LDS_BYTES) != hipSuccess) { fprintf(stderr, "kernel_launch: hipFuncSetAttribute failed\n"); ready = -1; return; }
        (void)hipGetLastError();
        ready = 1;
    }
    if (ready < 0) return;
    if (hipMemsetAsync((char*)d_ws + WS_CTL, 0, CTL_ZERO_BYTES, stream) != hipSuccess) { fprintf(stderr, "kernel_launch: memset failed\n"); return; }
    Args a{};
    for (int i = 0; i < 27; ++i) a.in[i] = d_in[i];
    a.out = (float*)d_out; a.ws = (unsigned char*)d_ws;
    hipLaunchKernelGGL(mk_fwd, dim3(256), dim3(NWAVES * 64), LDS_BYTES, stream, a);
}
```

```cpp
#include <hip/hip_runtime.h>
#include <hip/hip_bf16.h>
#include <cstdio>
#include <cstdint>
#include <cmath>
namespace pg8 {
#define PG8_LAS __attribute__((address_space(3)))
typedef unsigned short bf16_t;
typedef short bf16x8 __attribute__((ext_vector_type(8)));
typedef float f32x4 __attribute__((ext_vector_type(4)));
typedef unsigned u32x4 __attribute__((ext_vector_type(4)));
constexpr int BM = 256, BK = 64, HALF = 128, HTB = HALF * BK * 2  , STAGE_BYTES = 8 * HTB, NXCD = 8, WGM = 8;

__host__ __device__ __forceinline__ int lds_byte(int r, int c) { const int st = (r >> 4) * 2 + (c >> 5), rr = r & 15, cc = c & 31, ob = rr * 64 + cc * 2; return st * 1024 + (ob ^ (((ob >> 9) & 1) << 5)); }
__host__ __device__ __forceinline__ void stage_rc(int b, int& R, int& C) { const int st = b / 1024, sb = b % 1024, swz = sb ^ (((sb >> 9) & 1) << 5); R = (st >> 1) * 16 + swz / 64; C = (st & 1) * 32 + (swz % 64) / 2; }
__host__ __device__ __forceinline__ int perm32(int rho) { const int n = rho >> 4, i = rho & 15; return 8 * (i >> 2) + 4 * n + (i & 3); }

struct Unit { int pm, pn; };
struct Gemm { const bf16_t* A; const bf16_t* Bt; int M, N, K; };

struct StaticOrder {
    int nM, nN, nwg, G, c;
    __host__ __device__ void init(int M, int N, int G_, int c_) { nM = M / BM; nN = N / BM; nwg = nM * nN; G = G_; c = c_; }
    __host__ __device__ bool next(int i, Unit& u) const {
        const long L = (long)i * G + c; if (L >= nwg) return false;
        int wgid = (int)L; { const int q = nwg / NXCD, r = nwg % NXCD, xcd = wgid % NXCD, off = wgid / NXCD; wgid = (xcd < r ? xcd * (q + 1) : r * (q + 1) + (xcd - r) * q) + off; }
        const int nig = WGM * nN, gid = wgid / nig, fm = gid * WGM, gsz = (nM - fm) < WGM ? (nM - fm) : WGM;
        u.pm = fm + ((wgid % nig) % gsz); u.pn = (wgid % nig) / gsz; return true;
    }
    __device__ __forceinline__ void a_ready(const Unit&) const {}
    __device__ __forceinline__ void done(const Unit&) const {}
};
__device__ __forceinline__ unsigned cvt_pk_bf16(float lo, float hi) { unsigned r; asm volatile("v_cvt_pk_bf16_f32 %0, %1, %2" : "=v"(r) : "v"(lo), "v"(hi)); return r; }
typedef float f32x2 __attribute__((ext_vector_type(2)));
typedef unsigned u32x2 __attribute__((ext_vector_type(2)));
__device__ __forceinline__ u32x4 pack8(const f32x4 v0, const f32x4 v1) { u32x4 w; w.x = cvt_pk_bf16(v0[0], v0[1]); w.y = cvt_pk_bf16(v0[2], v0[3]); w.z = cvt_pk_bf16(v1[0], v1[1]); w.w = cvt_pk_bf16(v1[2], v1[3]); return w; }
struct EpiPlain {
    static constexpr bool PERM = true, AFTER_DRAIN = false;
    bf16_t* O; int ldc;
    __device__ __forceinline__ void operator()(const f32x4 (&acc)[2][2][4][2], const Unit& u, int wr, int wc, int fr, int fq) const {
        const int row0 = u.pm * BM + wr * 64 + fr, col0 = u.pn * BM + wc * 32 + 8 * fq;
#pragma unroll
        for (int ai = 0; ai < 2; ++ai)
#pragma unroll
            for (int m = 0; m < 4; ++m) { bf16_t* rowp = O + (size_t)(row0 + ai * HALF + m * 16) * ldc + col0;
#pragma unroll
                for (int bj = 0; bj < 2; ++bj) *(u32x4*)(rowp + bj * HALF) = pack8(acc[ai][bj][m][0], acc[ai][bj][m][1]); }
    }
};
struct EpiRes {
    static constexpr bool PERM = false, AFTER_DRAIN = false;
    const float* base; float* out;
    __device__ __forceinline__ void operator()(const f32x4 (&acc)[2][2][4][2], const Unit& u, int wr, int wc, int fr, int fq) const {
        const int col0 = u.pn * BM + wc * 32 + 4 * fq;
#pragma unroll
        for (int ai = 0; ai < 2; ++ai)
#pragma unroll
            for (int m = 0; m < 4; ++m) { const size_t off = (size_t)(u.pm * BM + ai * HALF + wr * 64 + m * 16 + fr) * 1024 + col0;
#pragma unroll
                for (int bj = 0; bj < 2; ++bj)
#pragma unroll
                    for (int n = 0; n < 2; ++n) { const f32x4 bs = *(const f32x4*)(base + off + bj * HALF + n * 16); *(f32x4*)(out + off + bj * HALF + n * 16) = bs + acc[ai][bj][m][n]; } }
    }
};
struct EpiInProj {
    static constexpr bool PERM = true, AFTER_DRAIN = false;
    bf16_t *Q, *Kk, *V, *OG; float* gates; const float* bg;
    __device__ __forceinline__ void operator()(const f32x4 (&acc)[2][2][4][2], const Unit& u, int wr, int wc, int fr, int fq) const {
        const int colt = u.pn * BM;
#pragma unroll
        for (int ai = 0; ai < 2; ++ai)
#pragma unroll
            for (int m = 0; m < 4; ++m) { const int row = u.pm * BM + ai * HALF + wr * 64 + m * 16 + fr, b = row >> 12, s = row & 4095;
#pragma unroll
                for (int bj = 0; bj < 2; ++bj) { const int cb = colt + bj * HALF + wc * 32 + 8 * fq; f32x4 v0 = acc[ai][bj][m][0], v1 = acc[ai][bj][m][1];
                    if (colt < 1024) { const bool isq = colt < 512; bf16_t* base = isq ? Q : Kk; const int c2 = cb & 511, head = c2 >> 6, d = c2 & 63;
                        if (isq) { v0 = v0 * 0.125f; v1 = v1 * 0.125f; }
                        *(u32x4*)(base + ((size_t)((b * 8 + head) * 4096 + s)) * 64 + d) = pack8(v0, v1); }
                    else if (colt < 2048) { const int c2 = cb - 1024, head = c2 >> 7, dv = c2 & 127; *(u32x4*)(V + ((size_t)((b * 8 + head) * 4096 + s)) * 128 + dv) = pack8(v0, v1); }
                    else if (colt < 3072) { *(u32x4*)(OG + (size_t)row * 1024 + (cb - 2048)) = pack8(v0, v1); }
                    else if (cb < 3104) { const int gi = cb - 3072; float* g = gates + (size_t)row * 32 + gi;
                        *(f32x4*)g = v0 + *(const f32x4*)(bg + gi); *(f32x4*)(g + 4) = v1 + *(const f32x4*)(bg + gi + 4); } } }
    }
};
struct EpiQKV {
    static constexpr bool PERM = true, AFTER_DRAIN = false;
    bf16_t *Q, *Kk, *V;
    __device__ __forceinline__ void operator()(const f32x4 (&acc)[2][2][4][2], const Unit& u, int wr, int wc, int fr, int fq) const {
        const int colt = u.pn * BM;
#pragma unroll
        for (int ai = 0; ai < 2; ++ai)
#pragma unroll
            for (int m = 0; m < 4; ++m) { const int row = u.pm * BM + ai * HALF + wr * 64 + m * 16 + fr, b = row >> 12, s = row & 4095;
#pragma unroll
                for (int bj = 0; bj < 2; ++bj) { const int cb = colt + bj * HALF + wc * 32 + 8 * fq; const u32x4 w = pack8(acc[ai][bj][m][0], acc[ai][bj][m][1]);
                    if (colt < 2048) { bf16_t* base = colt < 1024 ? Q : Kk; const int c2 = cb & 1023, head = c2 >> 7, c = (c2 >> 6) & 1, d = c2 & 63;
                        *(u32x4*)(base + ((size_t)(((b * 8 + head) * 2 + c) * 4096 + s)) * 64 + d) = w; }
                    else { const int c2 = cb - 2048, head = c2 >> 7, dv = c2 & 127; *(u32x4*)(V + ((size_t)((b * 8 + head) * 4096 + s)) * 128 + dv) = w; } } }
    }
};
template <class Epi, class Sched, bool ALIGN_EPI = false, bool SP2 = false>
__device__ __forceinline__ void gemm_phase(PG8_LAS unsigned char* lds, const Gemm g, const Sched& S, const Epi& E, const int wv) {
    int ln_; asm volatile("v_mbcnt_lo_u32_b32 %0, -1, 0\n\tv_mbcnt_hi_u32_b32 %0, -1, %0" : "=v"(ln_)); const int tid = wv * 64 + ln_, wid = wv, lane = tid & 63, wr = wid >> 2, wc = wid & 3, fr = lane & 15, fq = lane >> 4;
    const int K = g.K, nt = K / BK;
    unsigned voffA[2], voffB[2];
#pragma unroll
    for (int i = 0; i < 2; ++i) { int R, C; stage_rc(tid * 16 + i * 8192, R, C); const int Rb = Epi::PERM ? ((R & ~31) + perm32(R & 31)) : R;
        voffA[i] = (unsigned)(R * K + C) * 2u; voffB[i] = (unsigned)(Rb * K + C) * 2u; }
    const size_t kstep = (size_t)(BK * 2);
    const size_t hstep = (size_t)HALF * K * 2;
    const size_t tstep = 2 * hstep;
    const unsigned ldsw = (unsigned)wid * 1024u;
    const int aoff = lds_byte(wr * 64 + fr, fq * 8), boff = lds_byte(wc * 32 + fr, fq * 8);
#define PG8_SA(b, h) (((b) * 2 + (h)) * HTB)
#define PG8_SB(b, h) ((4 + (b) * 2 + (h)) * HTB)
#define PG8_STAGE(bufoff, gbase, voff) do { _Pragma("unroll") for (int _i = 0; _i < 2; ++_i) \
        __builtin_amdgcn_global_load_lds((const unsigned*)((const char*)(gbase) + (voff)[_i]), (PG8_LAS unsigned*)(lds + (bufoff) + ldsw + _i * 8192), 16, 0, 0); } while (0)
#define PG8_LDA(dst, b, h) do { _Pragma("unroll") for (int m = 0; m < 4; ++m) _Pragma("unroll") for (int k = 0; k < 2; ++k) dst[m][k] = *(const PG8_LAS bf16x8*)(lds + PG8_SA(b, h) + aoff + m * 2048 + k * 1024); } while (0)
#define PG8_LDB(dst, b, h) do { _Pragma("unroll") for (int n = 0; n < 2; ++n) _Pragma("unroll") for (int k = 0; k < 2; ++k) dst[n][k] = *(const PG8_LAS bf16x8*)(lds + PG8_SB(b, h) + boff + n * 2048 + k * 1024); } while (0)
#define PG8_MMA(ai, bj, At, Bt) do { __builtin_amdgcn_s_setprio(1); _Pragma("unroll") for (int m = 0; m < 4; ++m) _Pragma("unroll") for (int n = 0; n < 2; ++n) _Pragma("unroll") for (int k = 0; k < 2; ++k) \
        acc[ai][bj][m][n] = __builtin_amdgcn_mfma_f32_16x16x32_bf16(Bt[n][k], At[m][k], acc[ai][bj][m][n], 0, 0, 0); __builtin_amdgcn_s_setprio(0); } while (0)
#define PG8_WAIT_V(n) asm volatile("s_waitcnt vmcnt(" #n ")" ::: "memory")
#define PG8_WAIT_L(n) asm volatile("s_waitcnt lgkmcnt(" #n ")" ::: "memory")
#define PG8_BAR __builtin_amdgcn_s_barrier()
#define PG8_SCHED __builtin_amdgcn_sched_barrier(0)
    Unit cur, nxt; int ui = 0;
    if (!S.next(0, cur)) return;
    f32x4 acc[2][2][4][2];
#pragma unroll
    for (int a = 0; a < 2; ++a)
#pragma unroll
        for (int b = 0; b < 2; ++b)
#pragma unroll
            for (int m = 0; m < 4; ++m)
#pragma unroll
                for (int n = 0; n < 2; ++n) acc[a][b][m][n] = (f32x4){0.f, 0.f, 0.f, 0.f};
    bf16x8 At[4][2], B0[2][2], B1[2][2];
    const char* cA = (const char*)g.A + (size_t)cur.pm * tstep; const char* cB = (const char*)g.Bt + (size_t)cur.pn * tstep;
    S.a_ready(cur);
    if constexpr (SP2) {
        PG8_STAGE(PG8_SB(0, 0), cB, voffB); PG8_STAGE(PG8_SB(0, 1), cB + hstep, voffB); PG8_STAGE(PG8_SA(0, 0), cA, voffA); PG8_STAGE(PG8_SA(0, 1), cA + hstep, voffA);
        if (wr == 1) PG8_BAR;
        PG8_WAIT_V(2); PG8_BAR;
        PG8_STAGE(PG8_SB(1, 0), cB + kstep, voffB); PG8_STAGE(PG8_SA(1, 0), cA + kstep, voffA); PG8_STAGE(PG8_SB(1, 1), cB + hstep + kstep, voffB);
        PG8_WAIT_V(6); PG8_BAR;
    } else {
        PG8_STAGE(PG8_SB(0, 0), cB, voffB); PG8_STAGE(PG8_SA(0, 0), cA, voffA); PG8_STAGE(PG8_SB(0, 1), cB + hstep, voffB); PG8_STAGE(PG8_SA(0, 1), cA + hstep, voffA);
        if (wr == 1) PG8_BAR;
        PG8_WAIT_V(4); PG8_BAR;
        PG8_STAGE(PG8_SB(1, 0), cB + kstep, voffB); PG8_STAGE(PG8_SA(1, 0), cA + kstep, voffA); PG8_STAGE(PG8_SB(1, 1), cB + hstep + kstep, voffB);
        PG8_WAIT_V(6); PG8_BAR;
    }
    for (;;) {
        const bool has_next = S.next(ui + 1, nxt);
        const char* nA = has_next ? (const char*)g.A + (size_t)nxt.pm * tstep : cA; const char* nB = has_next ? (const char*)g.Bt + (size_t)nxt.pn * tstep : cB;
        for (int t = 0; t < nt; t += 2) {
            const bool last = (t == nt - 2);
            const char* a1 = cA + (size_t)(t + 1) * kstep;
            const char* a2 = last ? nA : cA + (size_t)(t + 2) * kstep; const char* b2 = last ? nB : cB + (size_t)(t + 2) * kstep;
            const char* a3 = a2 + kstep; const char* b3 = b2 + kstep;
            if (last && has_next) S.a_ready(nxt);
            if constexpr (SP2) {
            PG8_LDB(B0, 0, 0); PG8_LDB(B1, 0, 1); PG8_SCHED; PG8_LDA(At, 0, 0); PG8_STAGE(PG8_SA(1, 1), a1 + hstep, voffA);
            PG8_WAIT_V(8); PG8_WAIT_L(0); PG8_BAR; PG8_MMA(0, 0, At, B0); PG8_MMA(0, 1, At, B1); PG8_BAR; PG8_SCHED;
            PG8_LDA(At, 0, 1); PG8_STAGE(PG8_SB(0, 0), b2, voffB); PG8_STAGE(PG8_SB(0, 1), b2 + hstep, voffB); PG8_STAGE(PG8_SA(0, 0), a2, voffA);
            PG8_WAIT_V(8); PG8_WAIT_L(0); PG8_BAR; PG8_MMA(1, 0, At, B0); PG8_MMA(1, 1, At, B1); PG8_BAR; PG8_SCHED;
            PG8_LDB(B0, 1, 0); PG8_LDB(B1, 1, 1); PG8_SCHED; PG8_LDA(At, 1, 0); PG8_STAGE(PG8_SA(0, 1), a2 + hstep, voffA);
            PG8_WAIT_V(8); PG8_WAIT_L(0); PG8_BAR; PG8_MMA(0, 0, At, B0); PG8_MMA(0, 1, At, B1); PG8_BAR; PG8_SCHED;
            PG8_LDA(At, 1, 1); PG8_STAGE(PG8_SB(1, 0), b3, voffB); PG8_STAGE(PG8_SB(1, 1), b3 + hstep, voffB); PG8_STAGE(PG8_SA(1, 0), a3, voffA);
            PG8_WAIT_V(8); PG8_WAIT_L(0); PG8_BAR; PG8_MMA(1, 0, At, B0); PG8_MMA(1, 1, At, B1); PG8_BAR; PG8_SCHED;
            } else {
            PG8_LDB(B0, 0, 0); PG8_SCHED; PG8_LDA(At, 0, 0); PG8_STAGE(PG8_SA(1, 1), a1 + hstep, voffA);
            PG8_WAIT_L(8); PG8_BAR; PG8_WAIT_L(0); PG8_MMA(0, 0, At, B0); PG8_BAR; PG8_SCHED;
            PG8_LDB(B1, 0, 1); PG8_STAGE(PG8_SB(0, 0), b2, voffB);
            PG8_BAR; PG8_WAIT_L(0); PG8_MMA(0, 1, At, B1); PG8_BAR;
            PG8_LDA(At, 0, 1); PG8_STAGE(PG8_SA(0, 0), a2, voffA);
            PG8_BAR; PG8_WAIT_L(0); PG8_MMA(1, 0, At, B0); PG8_BAR; PG8_SCHED;
            PG8_STAGE(PG8_SB(0, 1), b2 + hstep, voffB);
            PG8_WAIT_V(6); PG8_BAR; PG8_MMA(1, 1, At, B1); PG8_BAR;
            PG8_LDB(B0, 1, 0); PG8_SCHED; PG8_LDA(At, 1, 0); PG8_STAGE(PG8_SA(0, 1), a2 + hstep, voffA);
            PG8_WAIT_L(8); PG8_BAR; PG8_WAIT_L(0); PG8_MMA(0, 0, At, B0); PG8_BAR; PG8_SCHED;
            PG8_LDB(B1, 1, 1); PG8_STAGE(PG8_SB(1, 0), b3, voffB);
            PG8_BAR; PG8_WAIT_L(0); PG8_MMA(0, 1, At, B1); PG8_BAR;
            PG8_LDA(At, 1, 1); PG8_STAGE(PG8_SA(1, 0), a3, voffA);
            PG8_BAR; PG8_WAIT_L(0); PG8_MMA(1, 0, At, B0); PG8_BAR; PG8_SCHED;
            PG8_STAGE(PG8_SB(1, 1), b3 + hstep, voffB);
            PG8_WAIT_V(6); PG8_BAR; PG8_MMA(1, 1, At, B1); PG8_BAR;
            }
        }
        if constexpr (ALIGN_EPI) { if (wr == 0) PG8_BAR; }
        if constexpr (!Epi::AFTER_DRAIN) { E(acc, cur, wr, wc, fr, fq); S.done(cur); }
        if (!has_next) break;
#pragma unroll
        for (int a = 0; a < 2; ++a)
#pragma unroll
            for (int b = 0; b < 2; ++b)
#pragma unroll
                for (int m = 0; m < 4; ++m)
#pragma unroll
                    for (int n = 0; n < 2; ++n) acc[a][b][m][n] = (f32x4){0.f, 0.f, 0.f, 0.f};
        cur = nxt; cA = nA; cB = nB; ++ui;
        if constexpr (ALIGN_EPI) { if (wr == 1) PG8_BAR; }
    }
    PG8_WAIT_V(0);
    if constexpr (!ALIGN_EPI) { if (wr == 0) PG8_BAR; }
    PG8_BAR;
    if constexpr (Epi::AFTER_DRAIN) { E.fused(acc, cur, wr, wc, fr, fq, lds, wid, lane); S.done(cur); }
#undef PG8_SA
#undef PG8_SB
#undef PG8_STAGE
#undef PG8_LDA
#undef PG8_LDB
#undef PG8_MMA
#undef PG8_WAIT_V
#undef PG8_WAIT_L
#undef PG8_BAR
#undef PG8_SCHED
}
}
#define GAS __attribute__((address_space(1)))
#define LAS __attribute__((address_space(3)))
typedef unsigned short bf16;
typedef unsigned v4u __attribute__((ext_vector_type(4)));
typedef float f32x4 __attribute__((ext_vector_type(4)));
typedef short bf16x8 __attribute__((ext_vector_type(8)));
typedef GAS unsigned gu32;
typedef GAS unsigned long long gu64;
#define RLX_AGENT __ATOMIC_RELAXED, __HIP_MEMORY_SCOPE_AGENT
#define LDS_WAIT() asm volatile("s_waitcnt lgkmcnt(0)" ::: "memory")
#define VM_WAIT() asm volatile("s_waitcnt vmcnt(0)" ::: "memory")
__device__ __forceinline__ unsigned long long rt() { return __builtin_amdgcn_s_memrealtime(); }
typedef float f32x2_cv __attribute__((ext_vector_type(2))); typedef __bf16 bf16x2_cv __attribute__((ext_vector_type(2)));
__device__ __forceinline__ unsigned pk2(float lo, float hi) { const f32x2_cv v = {lo, hi}; const bf16x2_cv b = __builtin_convertvector(v, bf16x2_cv); return __builtin_bit_cast(unsigned, b); }
__device__ __forceinline__ unsigned f2bf(float f) { return pk2(f, 0.f) & 0xffffu; }

#define XB_TMO      128
#define XB_XCNT(j)  (256  + 64 * (j))
#define XB_XSUB(j)  (1280 + 64 * (j))
#define XB_XGEN(j)  (2304 + 64 * (j))
#define XB_TOP      3328
#define XB_TOPGEN   3392
#define XCD_BAR_WORDS 3456
#define XB_SPIN_CAP (1u << 18)

__device__ __forceinline__ unsigned xb_ld(unsigned* p)              { return __hip_atomic_load(p, __ATOMIC_RELAXED, __HIP_MEMORY_SCOPE_AGENT); }
__device__ __forceinline__ unsigned xb_add(unsigned* p, unsigned v) { return __hip_atomic_fetch_add(p, v, __ATOMIC_RELAXED, __HIP_MEMORY_SCOPE_AGENT); }
__device__ __forceinline__ unsigned xb_xcc_id() { return (unsigned)__builtin_amdgcn_s_getreg((3 << 11) | 20) & 0xFu; }
#define XB_SPIN(cond, bar) do { unsigned _sp = 0; while (cond) { __builtin_amdgcn_s_sleep(1); \
    if ((++_sp & 255u) == 0u) { if (xb_ld(&(bar)[XB_TMO])) break; if (_sp > XB_SPIN_CAP) { atomicAdd(&(bar)[XB_TMO], 1u); break; } } } } while (0)

struct XcdBarrier {
    unsigned* bar; unsigned x;
    volatile LAS unsigned* st;
};

__device__ __forceinline__ XcdBarrier xcd_barrier_post(unsigned* bar, volatile LAS unsigned* st) {
    XcdBarrier b; b.bar = bar; b.x = xb_xcc_id(); b.st = st;
    if (threadIdx.x == 0) (void)xb_add(&bar[XB_XCNT(b.x)], 1u);
    return b;
}
__device__ __forceinline__ void xcd_barrier_complete(unsigned* bar, unsigned x, unsigned& nloc, unsigned& nx) {
    const unsigned G = gridDim.x * gridDim.y * gridDim.z;
    unsigned sum, cnt, mine, sp = 0u;
    for (;;) {
        sum = 0u; cnt = 0u; mine = 0u;
#pragma unroll
        for (unsigned j = 0; j < 16; ++j) { const unsigned c = xb_ld(&bar[XB_XCNT(j)]); sum += c; cnt += (c > 0u) ? 1u : 0u; mine = (j == x) ? c : mine; }
        if (sum == G) break;
        __builtin_amdgcn_s_sleep(1);
        if ((++sp & 255u) == 0u) { if (xb_ld(&bar[XB_TMO])) break; if (sp > XB_SPIN_CAP) { atomicAdd(&bar[XB_TMO], 1u); break; } }
    }
    nloc = mine > 0u ? mine : 1u; nx = cnt > 0u ? cnt : 1u;
}

__device__ __forceinline__ void xcd_barrier(const XcdBarrier& b) {
    asm volatile("s_waitcnt vmcnt(0)" ::: "memory");
    __syncthreads();
    if (threadIdx.x == 0) {
        unsigned* bar = b.bar;
        __builtin_amdgcn_s_waitcnt(0);
        unsigned nloc = b.st[0], nx = b.st[1];
        if (nloc == 0u) { xcd_barrier_complete(bar, b.x, nloc, nx); b.st[0] = nloc; b.st[1] = nx; }
        const unsigned old = xb_add(&bar[XB_XSUB(b.x)], 1u);
        const unsigned gen = old / nloc;
        if (old + 1u == (gen + 1u) * nloc) {
            __builtin_amdgcn_fence(__ATOMIC_RELEASE, "agent");
            asm volatile("s_waitcnt vmcnt(0)" ::: "memory");
            const unsigned og = xb_add(&bar[XB_TOP], 1u);
            const unsigned tg = og / nx;
            if (og + 1u == (tg + 1u) * nx) xb_add(&bar[XB_TOPGEN], 1u);
            else XB_SPIN(xb_ld(&bar[XB_TOPGEN]) == tg, bar);
            __builtin_amdgcn_fence(__ATOMIC_ACQUIRE, "agent");
            xb_add(&bar[XB_XGEN(b.x)], 1u);
            asm volatile("s_waitcnt vmcnt(0)" ::: "memory");
        } else {
            XB_SPIN(xb_ld(&bar[XB_XGEN(b.x)]) == gen, bar);
            __builtin_amdgcn_fence(__ATOMIC_ACQUIRE, "agent");
            asm volatile("s_waitcnt vmcnt(0)" ::: "memory");
        }
    }
    __syncthreads();
}
constexpr int NWAVES = 8;
constexpr int T = 32768, D = 1024, SEQ = 4096;
constexpr float EPS = 1e-6f;
constexpr float LAMBDA_INIT = 0.35550906759f;
constexpr size_t MiB = 1u << 20;
constexpr size_t WS_CTL = 0, CTL_ZERO_BYTES = 1 * MiB;
constexpr size_t WS_ROPE = 1 * MiB;
constexpr size_t WS_WIN = 4 * MiB;
constexpr size_t WS_WO0 = 11 * MiB, WS_WQ0 = 13 * MiB, WS_KEY0 = 17 * MiB, WS_WQKV = 18 * MiB, WS_WO1 = 24 * MiB, WS_WQ1 = 26 * MiB, WS_KEY1 = 30 * MiB;
constexpr size_t WS_SC = 31 * MiB;
constexpr size_t WS_U0 = 32 * MiB, WS_V0T = 48 * MiB, WS_U1 = 64 * MiB, WS_V1T = 80 * MiB;
constexpr size_t WS_B0 = 96 * MiB;
constexpr size_t WS_R1 = 160 * MiB, WS_R2 = 224 * MiB, WS_R3 = 288 * MiB, WS_R4 = 352 * MiB, WS_R5 = 416 * MiB, WS_GATES = 480 * MiB;
constexpr size_t WS_END = 484 * MiB;
constexpr int CW_BAR = 4096;
constexpr int LDS_BYTES = 147456, MISC_OFF = LDS_BYTES - 128;

typedef float f32x16 __attribute__((ext_vector_type(16)));
typedef unsigned u32x2 __attribute__((ext_vector_type(2)));
typedef __bf16 bf16x2_t __attribute__((ext_vector_type(2)));
__device__ __forceinline__ float bf_lo(unsigned w) { return __uint_as_float(w << 16); }
__device__ __forceinline__ float bf_hi(unsigned w) { return __uint_as_float(w & 0xffff0000u); }
__device__ __forceinline__ float dot2(unsigned a, unsigned b, float c) { return __builtin_amdgcn_fdot2_f32_bf16(__builtin_bit_cast(bf16x2_t, a), __builtin_bit_cast(bf16x2_t, b), c, false); }
__device__ __forceinline__ float shx(float v, int lane, int m) { return __uint_as_float((unsigned)__builtin_amdgcn_ds_bpermute((lane ^ m) << 2, (int)__float_as_uint(v))); }
__device__ __forceinline__ int shxi(int v, int lane, int m) { return __builtin_amdgcn_ds_bpermute((lane ^ m) << 2, v); }
__device__ __forceinline__ float wave_sum(float v, int lane) {
#pragma unroll
    for (int o = 1; o < 64; o <<= 1) v += shx(v, lane, o);
    return v;
}
__device__ __forceinline__ f32x4 mfma16(bf16x8 a, bf16x8 b, f32x4 c) { return __builtin_amdgcn_mfma_f32_16x16x32_bf16(a, b, c, 0, 0, 0); }
__device__ __forceinline__ f32x16 mfma32(bf16x8 a, bf16x8 b, f32x16 c) { return __builtin_amdgcn_mfma_f32_32x32x16_bf16(a, b, c, 0, 0, 0); }
__device__ __forceinline__ u32x2 pack4(float a, float b, float c, float d) { u32x2 r; r.x = pk2(a, b); r.y = pk2(c, d); return r; }

__device__ __forceinline__ void p0_transpose_item(const float* W, int K, int N, bf16* WT, LAS float* scr, int item, int lane) {
    const int nblk = N / 32, kb = item / nblk, nb = item % nblk, k0 = 64 * kb, n0 = 32 * nb;
#pragma unroll 8
    for (int i = 0; i < 32; ++i) { const int kk = 2 * i + (lane >> 5); scr[kk * 33 + (lane & 31)] = W[(size_t)(k0 + kk) * N + n0 + (lane & 31)]; }
    LDS_WAIT(); asm volatile("" ::: "memory");
    const int c = lane & 7;
#pragma unroll
    for (int j = 0; j < 4; ++j) { const int n = (lane >> 3) + 8 * j; const LAS float* s = scr + (8 * c) * 33 + n;
        v4u o; o.x = pk2(s[0 * 33], s[1 * 33]); o.y = pk2(s[2 * 33], s[3 * 33]); o.z = pk2(s[4 * 33], s[5 * 33]); o.w = pk2(s[6 * 33], s[7 * 33]);
        *(v4u*)(WT + (size_t)(n0 + n) * K + k0 + 8 * c) = o; }
    LDS_WAIT(); asm volatile("" ::: "memory");
}
__device__ __forceinline__ void cvt_range(const float* src, bf16* dst, size_t n, size_t gtid, size_t gthreads) {
    for (size_t i = gtid * 8; i < n; i += gthreads * 8) {
        const f32x4 a = *(const f32x4*)(src + i), b = *(const f32x4*)(src + i + 4);
        v4u o; o.x = pk2(a.x, a.y); o.y = pk2(a.z, a.w); o.z = pk2(b.x, b.y); o.w = pk2(b.z, b.w);
        *(v4u*)(dst + i) = o; }
}
__device__ __forceinline__ void rms_row_to_bf16(const float* xrow, const float* g, bf16* orow, int lane) {
    const f32x4* xr = (const f32x4*)xrow + lane; const f32x4* gr = (const f32x4*)g + lane;
    f32x4 v[4]; float s = 0.f;
#pragma unroll
    for (int j = 0; j < 4; ++j) { v[j] = xr[64 * j]; s += (v[j].x * v[j].x + v[j].y * v[j].y) + (v[j].z * v[j].z + v[j].w * v[j].w); }
    const float rstd = rsqrtf(wave_sum(s, lane) * (1.f / 1024.f) + EPS);
    unsigned long long* o8 = (unsigned long long*)orow + lane;
#pragma unroll
    for (int j = 0; j < 4; ++j) { const f32x4 gg = gr[64 * j];
        o8[64 * j] = (unsigned long long)pk2(v[j].x * rstd * gg.x, v[j].y * rstd * gg.y) | ((unsigned long long)pk2(v[j].z * rstd * gg.z, v[j].w * rstd * gg.w) << 32); }
}
__device__ __forceinline__ void rms_pass(const float* X, const float* g, bf16* XN, int gw, int NGW, int lane) {
    for (int m = gw; m < T; m += NGW) rms_row_to_bf16(X + (size_t)m * D, g, XN + (size_t)m * D, lane);
}

__device__ __forceinline__ float logsigmoid_f(float f) { return fminf(f, 0.f) - log1pf(__expf(-fabsf(f))); }
#define ML_LOAD(ci_) do { const size_t r_ = rowbase + (size_t)(ci_) * 64 + lane; \
    rq = *(const v4u*)(Q0 + r_ * 64 + 8 * w); rk = *(const v4u*)(K0 + r_ * 64 + 8 * w); rv0 = *(const v4u*)(V0 + r_ * 128 + 16 * w); rv1 = *(const v4u*)(V0 + r_ * 128 + 16 * w + 8); \
    const size_t gm_ = ((size_t)b * 4096 + (size_t)(ci_) * 64 + jr) * 32; rli = GATES[gm_ + (dir ? 16 : 0) + h]; rf = GATES[gm_ + (dir ? 24 : 8) + h]; } while (0)
__device__ __forceinline__ void mlstm_phase(const int wv, LAS unsigned char* lds, const bf16* Q0, const bf16* K0, const bf16* V0, const float* GATES, bf16* HF, bf16* HB) {
    const int bx = blockIdx.x;
    if ((bx >> 3) & 1) return;
    const int seq = (bx >> 4) * 8 + (bx & 7);
    const int dir = seq & 1, bh = seq >> 1, b = bh >> 3, h = bh & 7;
    int ln_; asm volatile("v_mbcnt_lo_u32_b32 %0, -1, 0\n\tv_mbcnt_hi_u32_b32 %0, -1, %0" : "=v"(ln_)); const int tid = wv * 64 + ln_, lane = tid & 63, w = wv, fr = lane & 15, fq = lane >> 4;
    LAS bf16* Qs = (LAS bf16*)(lds); LAS bf16* Ks = (LAS bf16*)(lds + 9216); LAS bf16* Kwt = (LAS bf16*)(lds + 18432); LAS bf16* Ps = (LAS bf16*)(lds + 27648);
    LAS bf16* Vt = (LAS bf16*)(lds + 36864 + w * 2304); LAS bf16* Cs = (LAS bf16*)(lds + 55296 + w * 2304); LAS bf16* nb = (LAS bf16*)(lds + 73728 + w * 128);
    LAS float* gc = (LAS float*)(lds + 74752 + w * 1280); LAS float* gM = gc + 64; LAS float* gI = gc + 128; LAS float* gE = gc + 192; LAS float* gW = gc + 256;
    for (int i = lane; i < 2304 / 4; i += 64) ((LAS unsigned*)Cs)[i] = 0u;
    if (lane < 32) ((LAS unsigned*)nb)[lane] = 0u;
    f32x4 Cacc[4], Nacc[4];
#pragma unroll
    for (int i = 0; i < 4; ++i) { Cacc[i] = (f32x4){0.f, 0.f, 0.f, 0.f}; Nacc[i] = (f32x4){0.f, 0.f, 0.f, 0.f}; }
    float m = -1e30f;
    bf16* Hout = dir ? HB : HF;
    const size_t rowbase = (size_t)bh * 4096;
    const int jr = dir ? 63 - lane : lane;
    v4u rq, rk, rv0, rv1; float rli, rf;
    ML_LOAD(dir ? 63 : 0);
    const bf16x8 ones = (bf16x8){0x3F80, 0x3F80, 0x3F80, 0x3F80, 0x3F80, 0x3F80, 0x3F80, 0x3F80};
    const f32x4 z4 = (f32x4){0.f, 0.f, 0.f, 0.f};
#pragma unroll 1
    for (int step = 0; step < 64; ++step) {
        const int ci = dir ? 63 - step : step;
        const float lf = logsigmoid_f(rf);
        float bcs = lf;
#pragma unroll
        for (int d = 1; d < 64; d <<= 1) { const float t = __uint_as_float((unsigned)__builtin_amdgcn_ds_bpermute((lane - d) << 2, (int)__float_as_uint(bcs))); if (lane >= d) bcs += t; }
        const float c = rli - bcs;
        float pm = c;
#pragma unroll
        for (int d = 1; d < 64; d <<= 1) { const float t = __uint_as_float((unsigned)__builtin_amdgcn_ds_bpermute((lane - d) << 2, (int)__float_as_uint(pm))); if (lane >= d) pm = fmaxf(pm, t); }
        const float M = fmaxf(m, pm);
        const float bL = __uint_as_float((unsigned)__builtin_amdgcn_readlane((int)__float_as_uint(bcs), 63)), Mlast = __uint_as_float((unsigned)__builtin_amdgcn_readlane((int)__float_as_uint(M), 63));
        gc[jr] = c; gM[jr] = M; gI[jr] = __expf(m - M); gE[jr] = __expf(-(bcs + M)); gW[jr] = __expf(c - Mlast);
        const float sp = __expf(m - Mlast), m_new = bL + Mlast;
        const float wr_ = gW[lane];
        *(LAS v4u*)(Qs + lane * 72 + 8 * w) = rq; *(LAS v4u*)(Ks + lane * 72 + 8 * w) = rk;
#pragma unroll
        for (int i = 0; i < 4; ++i) { const unsigned kw = rk[i]; Kwt[(8 * w + 2 * i) * 72 + lane] = (bf16)f2bf(bf_lo(kw) * wr_); Kwt[(8 * w + 2 * i + 1) * 72 + lane] = (bf16)f2bf(bf_hi(kw) * wr_); }
#pragma unroll
        for (int i = 0; i < 4; ++i) { Vt[(2 * i) * 72 + lane] = (bf16)(rv0[i] & 0xffffu); Vt[(2 * i + 1) * 72 + lane] = (bf16)(rv0[i] >> 16);
                                      Vt[(8 + 2 * i) * 72 + lane] = (bf16)(rv1[i] & 0xffffu); Vt[(9 + 2 * i) * 72 + lane] = (bf16)(rv1[i] >> 16); }
        __syncthreads();
        if (step < 63) ML_LOAD(dir ? 62 - step : step + 1);
        {
            const int st = w >> 1;
            const bf16x8 a0 = *(const LAS bf16x8*)(Ks + (16 * st + fr) * 72 + 8 * fq), a1 = *(const LAS bf16x8*)(Ks + (16 * st + fr) * 72 + 32 + 8 * fq);
#pragma unroll
            for (int u = 0; u < 2; ++u) { const int tt = 2 * (w & 1) + u;
                const bf16x8 b0 = *(const LAS bf16x8*)(Qs + (16 * tt + fr) * 72 + 8 * fq), b1 = *(const LAS bf16x8*)(Qs + (16 * tt + fr) * 72 + 32 + 8 * fq);
                f32x4 acc = mfma16(a0, b0, z4); acc = mfma16(a1, b1, acc);
                const int t = 16 * tt + fr; const float Mt = gM[t]; float pv[4];
#pragma unroll
                for (int i = 0; i < 4; ++i) { const int s = 16 * st + 4 * fq + i; const bool valid = dir ? (s >= t) : (s <= t); const float e = __expf(gc[s] - Mt); pv[i] = valid ? acc[i] * e : 0.f; }
                *(LAS u32x2*)(Ps + t * 72 + 16 * st + 4 * fq) = pack4(pv[0], pv[1], pv[2], pv[3]); }
        }
        __syncthreads();
        const bf16x8 aV0 = *(const LAS bf16x8*)(Vt + fr * 72 + 8 * fq), aV1 = *(const LAS bf16x8*)(Vt + fr * 72 + 32 + 8 * fq);
        {
            const bf16x8 aC0 = *(const LAS bf16x8*)(Cs + fr * 72 + 8 * fq), aC1 = *(const LAS bf16x8*)(Cs + fr * 72 + 32 + 8 * fq);
            const bf16x8 aN0 = *(const LAS bf16x8*)(nb + 8 * fq), aN1 = *(const LAS bf16x8*)(nb + 32 + 8 * fq);
#pragma unroll
            for (int tt = 0; tt < 4; ++tt) {
                const bf16x8 bP0 = *(const LAS bf16x8*)(Ps + (16 * tt + fr) * 72 + 8 * fq), bP1 = *(const LAS bf16x8*)(Ps + (16 * tt + fr) * 72 + 32 + 8 * fq);
                const bf16x8 bQ0 = *(const LAS bf16x8*)(Qs + (16 * tt + fr) * 72 + 8 * fq), bQ1 = *(const LAS bf16x8*)(Qs + (16 * tt + fr) * 72 + 32 + 8 * fq);
                f32x4 acc1 = mfma16(aV0, bP0, z4); acc1 = mfma16(aV1, bP1, acc1);
                f32x4 acc2 = mfma16(aC0, bQ0, z4); acc2 = mfma16(aC1, bQ1, acc2);
                f32x4 d1 = mfma16(ones, bP0, z4); d1 = mfma16(ones, bP1, d1);
                f32x4 d2 = mfma16(aN0, bQ0, z4); d2 = mfma16(aN1, bQ1, d2);
                const int t = 16 * tt + fr; const float it = gI[t], en = gE[t];
                const float den = d1[0] + it * d2[0]; const float inv = 1.f / fmaxf(fabsf(den), en);
                *(u32x2*)(Hout + ((size_t)b * 4096 + (size_t)ci * 64 + t) * 1024 + h * 128 + 16 * w + 4 * fq) =
                    pack4((acc1[0] + it * acc2[0]) * inv, (acc1[1] + it * acc2[1]) * inv, (acc1[2] + it * acc2[2]) * inv, (acc1[3] + it * acc2[3]) * inv);
            }
        }
#pragma unroll
        for (int dt = 0; dt < 4; ++dt) { Cacc[dt] = Cacc[dt] * sp; Nacc[dt] = Nacc[dt] * sp;
            const bf16x8 aK0 = *(const LAS bf16x8*)(Kwt + (16 * dt + fr) * 72 + 8 * fq), aK1 = *(const LAS bf16x8*)(Kwt + (16 * dt + fr) * 72 + 32 + 8 * fq);
            Cacc[dt] = mfma16(aK0, aV0, Cacc[dt]); Cacc[dt] = mfma16(aK1, aV1, Cacc[dt]);
            Nacc[dt] = mfma16(aK0, ones, Nacc[dt]); Nacc[dt] = mfma16(aK1, ones, Nacc[dt]); }
#pragma unroll
        for (int dt = 0; dt < 4; ++dt) { *(LAS u32x2*)(Cs + fr * 72 + 16 * dt + 4 * fq) = pack4(Cacc[dt][0], Cacc[dt][1], Cacc[dt][2], Cacc[dt][3]);
                                         *(LAS u32x2*)(nb + 16 * dt + 4 * fq) = pack4(Nacc[dt][0], Nacc[dt][1], Nacc[dt][2], Nacc[dt][3]); }
        m = m_new;
        __syncthreads();
    }
}
#undef ML_LOAD

__device__ __forceinline__ void hs_pass(const bf16* HF, const bf16* HB, const bf16* OG, const float* hg, bf16* HS, int gw, int NGW, int lane) {
    for (int m = gw; m < T; m += NGW) {
        const size_t off = (size_t)m * 1024 + 16 * lane;
        const v4u f0 = *(const v4u*)(HF + off), f1 = *(const v4u*)(HF + off + 8), b0 = *(const v4u*)(HB + off), b1 = *(const v4u*)(HB + off + 8), o0 = *(const v4u*)(OG + off), o1 = *(const v4u*)(OG + off + 8);
        float x[16], og[16];
#pragma unroll
        for (int i = 0; i < 4; ++i) { x[2 * i] = bf_lo(f0[i]) + bf_lo(b0[i]); x[2 * i + 1] = bf_hi(f0[i]) + bf_hi(b0[i]); x[8 + 2 * i] = bf_lo(f1[i]) + bf_lo(b1[i]); x[9 + 2 * i] = bf_hi(f1[i]) + bf_hi(b1[i]);
                                      og[2 * i] = bf_lo(o0[i]); og[2 * i + 1] = bf_hi(o0[i]); og[8 + 2 * i] = bf_lo(o1[i]); og[9 + 2 * i] = bf_hi(o1[i]); }
        float ss = 0.f;
#pragma unroll
        for (int i = 0; i < 16; ++i) ss += x[i] * x[i];
        ss += shx(ss, lane, 1); ss += shx(ss, lane, 2); ss += shx(ss, lane, 4);
        const float rstd = rsqrtf(ss * (1.f / 128.f) + EPS);
        float y[16];
#pragma unroll
        for (int i = 0; i < 16; ++i) y[i] = x[i] * rstd * hg[16 * lane + i] * (1.f / (1.f + __expf(-og[i])));
        v4u w0, w1;
#pragma unroll
        for (int i = 0; i < 4; ++i) { w0[i] = pk2(y[2 * i], y[2 * i + 1]); w1[i] = pk2(y[8 + 2 * i], y[9 + 2 * i]); }
        *(v4u*)(HS + off) = w0; *(v4u*)(HS + off + 8) = w1;
    }
}

#define TK_CE(a, b) do { const float h_ = fmaxf(a, b), l_ = fminf(a, b); a = h_; b = l_; } while (0)
#define BITONIC_MERGE16(x) do { _Pragma("unroll") for (int d_ = 8; d_ >= 1; d_ >>= 1) { _Pragma("unroll") for (int i_ = 0; i_ < 16; ++i_) if ((i_ & d_) == 0) TK_CE(x[i_], x[i_ + d_]); } } while (0)
#define BITONIC_SORT16(x) do { _Pragma("unroll") for (int k_ = 2; k_ <= 16; k_ <<= 1) { _Pragma("unroll") for (int d_ = k_ >> 1; d_ >= 1; d_ >>= 1) { _Pragma("unroll") for (int i_ = 0; i_ < 16; ++i_) { const int l_i = i_ ^ d_; \
    if (l_i > i_) { if ((i_ & k_) == 0 || k_ == 16) TK_CE(x[i_], x[l_i]); else TK_CE(x[l_i], x[i_]); } } } } } while (0)
#define TK_INSERT(v, x) do { float c_ = (x); _Pragma("unroll") for (int j_ = 0; j_ < 16; ++j_) { const float h_ = fmaxf(v[j_], c_); c_ = fminf(v[j_], c_); v[j_] = h_; } } while (0)
__device__ __forceinline__ void peer_topk_phase(const int wv, int vcu, const bf16* PQ, const bf16* KEYS, int* EXPERTS, float* GATESP) {
    int ln_; asm volatile("v_mbcnt_lo_u32_b32 %0, -1, 0\n\tv_mbcnt_hi_u32_b32 %0, -1, %0" : "=v"(ln_)); const int tid = wv * 64 + ln_, lane = tid & 63, w = wv, r32 = lane & 31, hi = lane >> 5;
    const int t = vcu * 128 + (w & 3) * 32 + r32, hg = w >> 2;
    const float NINF = -INFINITY;
#pragma unroll 1
    for (int hh = 0; hh < 4; ++hh) {
        const int head = hg * 4 + hh;
        float L0[16], L1[16];
#pragma unroll
        for (int j = 0; j < 16; ++j) { L0[j] = 0.f; L1[j] = 0.f; }
#pragma unroll 1
        for (int p = 0; p < 2; ++p) {
            const int hp = head * 2 + p;
            bf16x8 bq[8];
#pragma unroll
            for (int ks = 0; ks < 8; ++ks) bq[ks] = *(const bf16x8*)(PQ + (size_t)t * 2048 + head * 256 + p * 128 + ks * 16 + 8 * hi);
            f32x16 acc[4];
#pragma unroll
            for (int nt = 0; nt < 4; ++nt) {
#pragma unroll
                for (int r = 0; r < 16; ++r) acc[nt][r] = 0.f;
#pragma unroll
                for (int ks = 0; ks < 8; ++ks) { const bf16x8 a = *(const bf16x8*)(KEYS + ((size_t)(hp * 128 + nt * 32 + r32)) * 128 + ks * 16 + 8 * hi); acc[nt] = mfma32(a, bq[ks], acc[nt]); }
            }
            float v[16];
            {
                float blk[4][16];
#pragma unroll
                for (int nt = 0; nt < 4; ++nt)
#pragma unroll
                    for (int r = 0; r < 16; ++r) { const int n = nt * 32 + (r & 3) + 8 * (r >> 2) + 4 * hi; blk[nt][r] = __uint_as_float((__float_as_uint(acc[nt][r]) & ~0x7Fu) | (unsigned)(127 - n)); }
#pragma unroll
                for (int nt = 0; nt < 4; ++nt) BITONIC_SORT16(blk[nt]);
#pragma unroll
                for (int i = 0; i < 16; ++i) { blk[0][i] = fmaxf(blk[0][i], blk[1][15 - i]); blk[2][i] = fmaxf(blk[2][i], blk[3][15 - i]); }
                BITONIC_MERGE16(blk[0]); BITONIC_MERGE16(blk[2]);
#pragma unroll
                for (int i = 0; i < 16; ++i) v[i] = fmaxf(blk[0][i], blk[2][15 - i]);
                BITONIC_MERGE16(v);
            }
            {
                float wv_[16];
#pragma unroll
                for (int j = 0; j < 16; ++j) wv_[j] = shx(v[15 - j], lane, 32);
#pragma unroll
                for (int j = 0; j < 16; ++j) v[j] = fmaxf(v[j], wv_[j]);
                BITONIC_MERGE16(v);
            }
            if (p == 0) {
#pragma unroll
                for (int j = 0; j < 16; ++j) L0[j] = v[j];
            } else {
#pragma unroll
                for (int j = 0; j < 16; ++j) L1[j] = v[j];
            }
        }
        float tv[16];
        unsigned IA[4] = {0u, 0u, 0u, 0u}, IB[4] = {0u, 0u, 0u, 0u};
#pragma unroll
        for (int i = 0; i < 16; ++i) { IA[i >> 2] |= (127u - (__float_as_uint(L0[i]) & 0x7Fu)) << (8 * (i & 3)); IB[i >> 2] |= (127u - (__float_as_uint(L1[i]) & 0x7Fu)) << (8 * (i & 3)); }
        {
            float cb[4][16]; int cn = 0;
#pragma unroll
            for (int i = 0; i < 16; ++i) {
                const float va = __uint_as_float(__float_as_uint(L0[i]) & ~0x7Fu);
#pragma unroll
                for (int j = 0; j < 16; ++j) if ((i + 1) * (j + 1) <= 16) {
                    const float vb = __uint_as_float(__float_as_uint(L1[j]) & ~0x7Fu);
                    cb[cn >> 4][cn & 15] = __uint_as_float((__float_as_uint(va + vb) & ~0xFFu) | (unsigned)(255 - (i * 16 + j)));
                    ++cn;
                }
            }
#pragma unroll
            for (int c = 50; c < 64; ++c) cb[c >> 4][c & 15] = NINF;
#pragma unroll
            for (int nt = 0; nt < 4; ++nt) BITONIC_SORT16(cb[nt]);
#pragma unroll
            for (int i = 0; i < 16; ++i) { cb[0][i] = fmaxf(cb[0][i], cb[1][15 - i]); cb[2][i] = fmaxf(cb[2][i], cb[3][15 - i]); }
            BITONIC_MERGE16(cb[0]); BITONIC_MERGE16(cb[2]);
#pragma unroll
            for (int i = 0; i < 16; ++i) tv[i] = fmaxf(cb[0][i], cb[2][15 - i]);
            BITONIC_MERGE16(tv);
        }
        int ti[16];
#pragma unroll
        for (int j = 0; j < 16; ++j) { const unsigned kb = __float_as_uint(tv[j]); const unsigned flat = 255u - (kb & 0xFFu); const unsigned fi = flat >> 4, fj = flat & 15u;
            const unsigned ra = (fi < 8u) ? ((fi < 4u) ? IA[0] : IA[1]) : ((fi < 12u) ? IA[2] : IA[3]);
            const unsigned rb = (fj < 8u) ? ((fj < 4u) ? IB[0] : IB[1]) : ((fj < 12u) ? IB[2] : IB[3]);
            ti[j] = (int)(((ra >> (8u * (fi & 3u))) & 0xFFu) * 128u + ((rb >> (8u * (fj & 3u))) & 0xFFu));
            tv[j] = __uint_as_float(kb & ~0xFFu); }
        float e[16], sum = 0.f;
#pragma unroll
        for (int j = 0; j < 16; ++j) { e[j] = __expf(tv[j] - tv[0]); sum += e[j]; }
        const float inv = 1.f / sum;
        if (hi == 0) { int* ep = EXPERTS + (size_t)t * 128 + head * 16;
#pragma unroll
            for (int j = 0; j < 4; ++j) *(v4u*)(ep + 4 * j) = (v4u){(unsigned)ti[4 * j], (unsigned)ti[4 * j + 1], (unsigned)ti[4 * j + 2], (unsigned)ti[4 * j + 3]}; }
        else { float* gp = GATESP + (size_t)t * 128 + head * 16;
#pragma unroll
            for (int j = 0; j < 4; ++j) *(f32x4*)(gp + 4 * j) = (f32x4){e[4 * j] * inv, e[4 * j + 1] * inv, e[4 * j + 2] * inv, e[4 * j + 3] * inv}; }
    }
}

__device__ __forceinline__ float cvt_ub0(unsigned x) { float r; asm("v_cvt_f32_ubyte0 %0, %1" : "=v"(r) : "v"(x)); return r; }
__device__ __forceinline__ float cvt_ub1(unsigned x) { float r; asm("v_cvt_f32_ubyte1 %0, %1" : "=v"(r) : "v"(x)); return r; }
__device__ __forceinline__ float cvt_ub2(unsigned x) { float r; asm("v_cvt_f32_ubyte2 %0, %1" : "=v"(r) : "v"(x)); return r; }
__device__ __forceinline__ float cvt_ub3(unsigned x) { float r; asm("v_cvt_f32_ubyte3 %0, %1" : "=v"(r) : "v"(x)); return r; }
__device__ __forceinline__ void quant4_rows(const float* src, unsigned char* dst, float* scale, int nrows, int gw, int NGW, int lane) {
    for (int r = gw; r < nrows; r += NGW) {
        const f32x4* sp = (const f32x4*)(src + (size_t)r * 1024) + 4 * lane;
        f32x4 v[4]; float am = 0.f, ss = 0.f;
#pragma unroll
        for (int j = 0; j < 4; ++j) { v[j] = sp[j]; am = fmaxf(am, fmaxf(fmaxf(fabsf(v[j].x), fabsf(v[j].y)), fmaxf(fabsf(v[j].z), fabsf(v[j].w)))); ss += (v[j].x * v[j].x + v[j].y * v[j].y) + (v[j].z * v[j].z + v[j].w * v[j].w); }
#pragma unroll
        for (int o = 1; o < 64; o <<= 1) { am = fmaxf(am, shx(am, lane, o)); ss += shx(ss, lane, o); }
        const float step = fminf(am * (1.f / 7.5f), 0.3352f * sqrtf(ss * (1.f / 1024.f)));
        const float inv = step > 0.f ? 1.f / step : 0.f;
        unsigned q[16];
#pragma unroll
        for (int j = 0; j < 4; ++j) { q[4 * j] = (unsigned)fminf(fmaxf(rintf(v[j].x * inv + 7.5f), 0.f), 15.f); q[4 * j + 1] = (unsigned)fminf(fmaxf(rintf(v[j].y * inv + 7.5f), 0.f), 15.f);
                                      q[4 * j + 2] = (unsigned)fminf(fmaxf(rintf(v[j].z * inv + 7.5f), 0.f), 15.f); q[4 * j + 3] = (unsigned)fminf(fmaxf(rintf(v[j].w * inv + 7.5f), 0.f), 15.f); }
        u32x2 w;
        w.x = (q[0] | (q[4] << 4)) | ((q[1] | (q[5] << 4)) << 8) | ((q[2] | (q[6] << 4)) << 16) | ((q[3] | (q[7] << 4)) << 24);
        w.y = (q[8] | (q[12] << 4)) | ((q[9] | (q[13] << 4)) << 8) | ((q[10] | (q[14] << 4)) << 16) | ((q[11] | (q[15] << 4)) << 24);
        *(u32x2*)(dst + (size_t)r * 512 + 8 * lane) = w;
        if (lane == 0) scale[r] = step;
    }
}

#define RED_STEP(N, S) do { const bool up_ = (lane & (S)) != 0; _Pragma("unroll") for (int j_ = 0; j_ < (N); ++j_) { const int a_ = p[j_], b_ = p[j_ + (N)]; const int send_ = up_ ? a_ : b_, keep_ = up_ ? b_ : a_; p[j_] = keep_ + shxi(send_, lane, (S)); } } while (0)
#define RED16(dst) do { RED_STEP(8, 8); RED_STEP(4, 4); RED_STEP(2, 2); RED_STEP(1, 1); int s_ = p[0]; s_ += shxi(s_, lane, 16); s_ += shxi(s_, lane, 32); dst = s_; } while (0)
#define G_SB() __builtin_amdgcn_sched_barrier(0)
#define G_LOAD(buf, tab, evec, jb) do { _Pragma("unroll") for (int jj_ = 0; jj_ < 16; ++jj_) { const int e_ = __builtin_amdgcn_readlane(evec, (jb) + jj_); buf[jj_] = __builtin_amdgcn_raw_buffer_load_b64(rs_##tab, (int)voff, e_ << 9, 0); } } while (0)
#define U_COMP(buf) do { _Pragma("unroll") for (int jj_ = 0; jj_ < 16; ++jj_) { const unsigned w0_ = buf[jj_].x, w1_ = buf[jj_].y; \
    int d_ = __builtin_amdgcn_sdot4((int)(w0_ & 0x0F0F0F0Fu), hq[0], 0, false); d_ = __builtin_amdgcn_sdot4((int)((w0_ >> 4) & 0x0F0F0F0Fu), hq[1], d_, false); \
    d_ = __builtin_amdgcn_sdot4((int)(w1_ & 0x0F0F0F0Fu), hq[2], d_, false); d_ = __builtin_amdgcn_sdot4((int)((w1_ >> 4) & 0x0F0F0F0Fu), hq[3], d_, false); p[jj_] = d_; } } while (0)
#define V_DW(o0, o1, o2, o3, wd, cs) do { float t0_, t1_, t2_, t3_; asm volatile("v_cvt_f32_ubyte0 %4, %8\n\tv_cvt_f32_ubyte1 %5, %8\n\tv_cvt_f32_ubyte2 %6, %8\n\tv_cvt_f32_ubyte3 %7, %8\n\tv_fmac_f32 %0, %9, %4\n\tv_fmac_f32 %1, %9, %5\n\tv_fmac_f32 %2, %9, %6\n\tv_fmac_f32 %3, %9, %7" \
    : "+v"(o0), "+v"(o1), "+v"(o2), "+v"(o3), "=&v"(t0_), "=&v"(t1_), "=&v"(t2_), "=&v"(t3_) : "v"(wd), "s"(cs)); } while (0)
#define V_COMP(buf, cvec, jb) do { _Pragma("unroll") for (int jj_ = 0; jj_ < 16; ++jj_) { const float c_ = __uint_as_float(__builtin_amdgcn_readlane(__float_as_uint(cvec), (jb) + jj_)); const unsigned w0_ = buf[jj_].x, w1_ = buf[jj_].y; \
    V_DW(o[0], o[1], o[2], o[3], w0_ & 0x0F0F0F0Fu, c_); V_DW(o[4], o[5], o[6], o[7], (w0_ >> 4) & 0x0F0F0F0Fu, c_); V_DW(o[8], o[9], o[10], o[11], w1_ & 0x0F0F0F0Fu, c_); V_DW(o[12], o[13], o[14], o[15], (w1_ >> 4) & 0x0F0F0F0Fu, c_); } } while (0)
template <bool NEXT_NORM>
__device__ __forceinline__ void peer_gather_phase(const int wv, bool dry, int vcu, const bf16* HN, const int* EXPERTS, const float* GATESP, const unsigned char* U, const float* SU, const unsigned char* Vtab, const float* SV,
                                                  float* X, const float* gnext, bf16* XN) {
    int ln_; asm volatile("v_mbcnt_lo_u32_b32 %0, -1, 0\n\tv_mbcnt_hi_u32_b32 %0, -1, %0" : "=v"(ln_)); const int tid = wv * 64 + ln_, lane = tid & 63, w = wv;
    const __amdgpu_buffer_rsrc_t rs_U = __builtin_amdgcn_make_buffer_rsrc((void*)U, (short)0, 16384 * 512, 0x00020000), rs_Vtab = __builtin_amdgcn_make_buffer_rsrc((void*)Vtab, (short)0, 16384 * 512, 0x00020000);
    const unsigned voff = (unsigned)lane * 8u;
    const int lg = lane >> 4;
#pragma unroll 1
    for (int i = 0; i < 16; ++i) {
        const int t = vcu * 128 + w * 16 + i;
        const int ev0 = EXPERTS[(size_t)t * 128 + lane], ev1 = EXPERTS[(size_t)t * 128 + 64 + lane];
        const float gv0 = GATESP[(size_t)t * 128 + lane], gv1 = GATESP[(size_t)t * 128 + 64 + lane];
        const v4u h0 = *(const v4u*)(HN + (size_t)t * 1024 + 16 * lane), h1 = *(const v4u*)(HN + (size_t)t * 1024 + 16 * lane + 8);
        float hf[16]; float am = 0.f;
#pragma unroll
        for (int k = 0; k < 4; ++k) { hf[2 * k] = bf_lo(h0[k]); hf[2 * k + 1] = bf_hi(h0[k]); hf[8 + 2 * k] = bf_lo(h1[k]); hf[9 + 2 * k] = bf_hi(h1[k]); }
#pragma unroll
        for (int k = 0; k < 16; ++k) am = fmaxf(am, fabsf(hf[k]));
#pragma unroll
        for (int o = 1; o < 64; o <<= 1) am = fmaxf(am, shx(am, lane, o));
        const float hinv = am > 0.f ? 127.f / am : 0.f, sh = am * (1.f / 127.f);
        int hq[4]; int hs = 0;
#pragma unroll
        for (int k = 0; k < 4; ++k) { const int q0 = (int)rintf(hf[4 * k] * hinv), q1 = (int)rintf(hf[4 * k + 1] * hinv), q2 = (int)rintf(hf[4 * k + 2] * hinv), q3 = (int)rintf(hf[4 * k + 3] * hinv); hs += (q0 + q1) + (q2 + q3);
            hq[k] = (int)(((unsigned)(q0 & 0xff)) | ((unsigned)(q1 & 0xff) << 8) | ((unsigned)(q2 & 0xff) << 16) | ((unsigned)(q3 & 0xff) << 24)); }
#pragma unroll
        for (int o = 1; o < 64; o <<= 1) hs += shxi(hs, lane, o);
        const float hoff = 7.5f * (float)hs;
        const float su0 = SU[ev0], su1 = SU[ev1], sv0 = SV[ev0], sv1 = SV[ev1];
        float o[16];
#pragma unroll
        for (int k = 0; k < 16; ++k) o[k] = 0.f;
        int p[16], r0, r1, r2, r3, r4, r5, r6, r7;
        u32x2 A[16], B[16], C[16];
        G_LOAD(A, U, ev0, 0); G_LOAD(B, U, ev0, 16); G_SB();
        G_LOAD(C, U, ev0, 32); G_SB(); U_COMP(A); RED16(r0); G_SB();
        G_LOAD(A, U, ev0, 48); G_SB(); U_COMP(B); RED16(r1); G_SB();
        G_LOAD(B, U, ev1, 0); G_SB(); U_COMP(C); RED16(r2); G_SB();
        G_LOAD(C, U, ev1, 16); G_SB(); U_COMP(A); RED16(r3); G_SB();
        G_LOAD(A, U, ev1, 32); G_SB(); U_COMP(B); RED16(r4); G_SB();
        G_LOAD(B, U, ev1, 48); G_SB(); U_COMP(C); RED16(r5); G_SB();
        G_LOAD(C, Vtab, ev0, 0); G_SB(); U_COMP(A); RED16(r6); G_SB();
        G_LOAD(A, Vtab, ev0, 16); G_SB(); U_COMP(B); RED16(r7); G_SB();
        const int d0 = lg == 0 ? r0 : (lg == 1 ? r1 : (lg == 2 ? r2 : r3)), d1 = lg == 0 ? r4 : (lg == 1 ? r5 : (lg == 2 ? r6 : r7));
        float act0 = ((float)d0 - hoff) * (sh * su0), act1 = ((float)d1 - hoff) * (sh * su1);
#ifdef PROBE_NOFFN
        const float coef0 = 0.f * act0, coef1 = 0.f * act1;
#else
        const float coef0 = gv0 * (0.5f * act0 * (1.f + erff(act0 * 0.70710678118f))) * sv0, coef1 = gv1 * (0.5f * act1 * (1.f + erff(act1 * 0.70710678118f))) * sv1;
#endif
        G_SB();
        G_LOAD(B, Vtab, ev0, 32); G_SB(); V_COMP(C, coef0, 0); G_SB();
        G_LOAD(C, Vtab, ev0, 48); G_SB(); V_COMP(A, coef0, 16); G_SB();
        G_LOAD(A, Vtab, ev1, 0); G_SB(); V_COMP(B, coef0, 32); G_SB();
        G_LOAD(B, Vtab, ev1, 16); G_SB(); V_COMP(C, coef0, 48); G_SB();
        G_LOAD(C, Vtab, ev1, 32); G_SB(); V_COMP(A, coef1, 0); G_SB();
        G_LOAD(A, Vtab, ev1, 48); G_SB(); V_COMP(B, coef1, 16); G_SB();
        V_COMP(C, coef1, 32); G_SB(); V_COMP(A, coef1, 48); G_SB();
        const float corr = 7.5f * wave_sum(coef0 + coef1, lane);
        float* xr = X + (size_t)t * 1024 + 16 * lane;
        f32x4 xv[4];
#pragma unroll
        for (int k = 0; k < 4; ++k) { xv[k] = *(const f32x4*)(xr + 4 * k); xv[k] += (f32x4){o[4 * k] - corr, o[4 * k + 1] - corr, o[4 * k + 2] - corr, o[4 * k + 3] - corr}; }
        if (!dry) {
#pragma unroll
            for (int k = 0; k < 4; ++k) *(f32x4*)(xr + 4 * k) = xv[k]; }
        if (NEXT_NORM && !dry) {
            float ss = 0.f;
#pragma unroll
            for (int k = 0; k < 4; ++k) ss += (xv[k].x * xv[k].x + xv[k].y * xv[k].y) + (xv[k].z * xv[k].z + xv[k].w * xv[k].w);
            const float rstd = rsqrtf(wave_sum(ss, lane) * (1.f / 1024.f) + EPS);
            v4u wa, wb;
#pragma unroll
            for (int k = 0; k < 4; ++k) { const f32x4 g = *(const f32x4*)(gnext + 16 * lane + 4 * k); const unsigned lo = pk2(xv[k].x * rstd * g.x, xv[k].y * rstd * g.y), hi2 = pk2(xv[k].z * rstd * g.z, xv[k].w * rstd * g.w);
                if (k < 2) { wa[2 * k] = lo; wa[2 * k + 1] = hi2; } else { wb[2 * (k - 2)] = lo; wb[2 * (k - 2) + 1] = hi2; } }
            *(v4u*)(XN + (size_t)t * 1024 + 16 * lane) = wa; *(v4u*)(XN + (size_t)t * 1024 + 16 * lane + 8) = wb;
        }
    }
}

__device__ __forceinline__ void rms_quant_pass(const float* X, const float* g, bf16* XN, unsigned char* HQ, float* SH, float* HS, int gw, int NGW, int lane) {
    for (int m = gw; m < T; m += NGW) {
        const f32x4* xr = (const f32x4*)(X + (size_t)m * D) + lane; const f32x4* gr = (const f32x4*)g + lane;
        f32x4 v[4]; float s = 0.f;
#pragma unroll
        for (int j = 0; j < 4; ++j) { v[j] = xr[64 * j]; s += (v[j].x * v[j].x + v[j].y * v[j].y) + (v[j].z * v[j].z + v[j].w * v[j].w); }
        const float rstd = rsqrtf(wave_sum(s, lane) * (1.f / 1024.f) + EPS);
        unsigned long long* o8 = (unsigned long long*)(XN + (size_t)m * D) + lane;
        float am = 0.f;
#pragma unroll
        for (int j = 0; j < 4; ++j) { const f32x4 gg = gr[64 * j]; v[j].x = v[j].x * rstd * gg.x; v[j].y = v[j].y * rstd * gg.y; v[j].z = v[j].z * rstd * gg.z; v[j].w = v[j].w * rstd * gg.w;
            o8[64 * j] = (unsigned long long)pk2(v[j].x, v[j].y) | ((unsigned long long)pk2(v[j].z, v[j].w) << 32);
            am = fmaxf(am, fmaxf(fmaxf(fabsf(v[j].x), fabsf(v[j].y)), fmaxf(fabsf(v[j].z), fabsf(v[j].w)))); }
#pragma unroll
        for (int o = 1; o < 64; o <<= 1) am = fmaxf(am, shx(am, lane, o));
        const float hinv = am > 0.f ? 127.f / am : 0.f;
        int hs = 0;
        unsigned* q4 = (unsigned*)(HQ + (size_t)m * D) + lane;
#pragma unroll
        for (int j = 0; j < 4; ++j) { const int q0 = (int)rintf(v[j].x * hinv), q1 = (int)rintf(v[j].y * hinv), q2 = (int)rintf(v[j].z * hinv), q3 = (int)rintf(v[j].w * hinv); hs += (q0 + q1) + (q2 + q3);
            q4[64 * j] = ((unsigned)(q0 & 0xff)) | ((unsigned)(q1 & 0xff) << 8) | ((unsigned)(q2 & 0xff) << 16) | ((unsigned)(q3 & 0xff) << 24); }
#pragma unroll
        for (int o = 1; o < 64; o <<= 1) hs += shxi(hs, lane, o);
        if (lane == 0) { SH[m] = am * (1.f / 127.f); HS[m] = (float)hs; }
    }
}
__device__ __forceinline__ int dpp_add_quad(int d) {
    d += __builtin_amdgcn_update_dpp(0, d, 0xB1, 0xF, 0xF, true);
    d += __builtin_amdgcn_update_dpp(0, d, 0x4E, 0xF, 0xF, true);
    return d;
}
__device__ __forceinline__ int dpp_add_oct(int d) {
    d += __builtin_amdgcn_update_dpp(0, d, 0xB1, 0xF, 0xF, true);
    d += __builtin_amdgcn_update_dpp(0, d, 0x4E, 0xF, 0xF, true);
    d += __builtin_amdgcn_update_dpp(0, d, 0x141, 0xF, 0xF, true);
    return d;
}
#define G1_IDS(E_, H0_, H1_, it_) do { const int t_ = t0 + ((it_) >> 1), hf_ = (it_) & 1; const v4u* ep_ = (const v4u*)(EXPERTS + (size_t)t_ * 128 + 16 * oct + 8 * hf_); const v4u ea_ = ep_[0], eb_ = ep_[1]; \
    E_[0] = (int)ea_.x; E_[1] = (int)ea_.y; E_[2] = (int)ea_.z; E_[3] = (int)ea_.w; E_[4] = (int)eb_.x; E_[5] = (int)eb_.y; E_[6] = (int)eb_.z; E_[7] = (int)eb_.w; \
    H0_ = *(const v4u*)(HQ + (size_t)t_ * 1024 + 256 * s + 32 * q8); H1_ = *(const v4u*)(HQ + (size_t)t_ * 1024 + 256 * s + 32 * q8 + 16); } while (0)
#define G1_ROWS(R_, E_) do { _Pragma("unroll") for (int j_ = 0; j_ < 8; ++j_) R_[j_] = __builtin_amdgcn_raw_buffer_load_b128(rs_U, (E_[j_] << 9) + soff, 0, 0); } while (0)
#define G1_COMP(R_, H0_, H1_, it_) do { int dd_[8]; _Pragma("unroll") for (int j_ = 0; j_ < 8; ++j_) { \
    int d_ = __builtin_amdgcn_sdot4((int)(R_[j_].x & 0x0F0F0F0Fu), (int)H0_.x, 0, false); d_ = __builtin_amdgcn_sdot4((int)((R_[j_].x >> 4) & 0x0F0F0F0Fu), (int)H0_.y, d_, false); \
    d_ = __builtin_amdgcn_sdot4((int)(R_[j_].y & 0x0F0F0F0Fu), (int)H0_.z, d_, false); d_ = __builtin_amdgcn_sdot4((int)((R_[j_].y >> 4) & 0x0F0F0F0Fu), (int)H0_.w, d_, false); \
    d_ = __builtin_amdgcn_sdot4((int)(R_[j_].z & 0x0F0F0F0Fu), (int)H1_.x, d_, false); d_ = __builtin_amdgcn_sdot4((int)((R_[j_].z >> 4) & 0x0F0F0F0Fu), (int)H1_.y, d_, false); \
    d_ = __builtin_amdgcn_sdot4((int)(R_[j_].w & 0x0F0F0F0Fu), (int)H1_.z, d_, false); d_ = __builtin_amdgcn_sdot4((int)((R_[j_].w >> 4) & 0x0F0F0F0Fu), (int)H1_.w, d_, false); \
    dd_[j_] = dpp_add_oct(d_); } \
    if (q8 == 0) { v4u* pp_ = (v4u*)(PART + ((size_t)s * T + t0 + ((it_) >> 1)) * 128 + 16 * oct + 8 * ((it_) & 1)); pp_[0] = (v4u){(unsigned)dd_[0], (unsigned)dd_[1], (unsigned)dd_[2], (unsigned)dd_[3]}; pp_[1] = (v4u){(unsigned)dd_[4], (unsigned)dd_[5], (unsigned)dd_[6], (unsigned)dd_[7]}; } } while (0)
__device__ __forceinline__ void peer_g1_phase(const int wv, int vcu, const unsigned char* HQ, const int* EXPERTS, const unsigned char* U, int* PART) {
    int ln_; asm volatile("v_mbcnt_lo_u32_b32 %0, -1, 0\n\tv_mbcnt_hi_u32_b32 %0, -1, %0" : "=v"(ln_)); const int lane = ln_, oct = lane >> 3, q8 = lane & 7;
    const int s = vcu >> 6;
    const __amdgpu_buffer_rsrc_t rs_U = __builtin_amdgcn_make_buffer_rsrc((void*)U, (short)0, 16384 * 512, 0x00020000);
    const int soff = 128 * s + 16 * q8;
    const int t0 = 512 * (vcu & 63) + 64 * wv;
    int eA[8], eB[8]; v4u rA[8], rB[8], hA0, hA1, hB0, hB1, hC0, hC1;
    G1_IDS(eA, hA0, hA1, 0); G1_ROWS(rA, eA); G1_IDS(eB, hB0, hB1, 1);
#pragma unroll 1
    for (int i = 0; i < 128; i += 2) {
        G1_ROWS(rB, eB); __builtin_amdgcn_sched_barrier(0);
        G1_IDS(eA, hC0, hC1, (i + 2) & 127); __builtin_amdgcn_sched_barrier(0);
        G1_COMP(rA, hA0, hA1, i); __builtin_amdgcn_sched_barrier(0);
        G1_ROWS(rA, eA); hA0 = hC0; hA1 = hC1; __builtin_amdgcn_sched_barrier(0);
        G1_IDS(eB, hC0, hC1, (i + 3) & 127); __builtin_amdgcn_sched_barrier(0);
        G1_COMP(rB, hB0, hB1, i + 1); __builtin_amdgcn_sched_barrier(0);
        hB0 = hC0; hB1 = hC1;
    }
}
__device__ __forceinline__ void peer_g1b_phase(const int* PART, const int* EXPERTS, const float* GATESP, const float* SU, const float* SV, const float* SH, const float* HS, unsigned char* COEFQ, float* SCT, float* CS, int gw, int NGW, int lane) {
    for (int t = gw; t < T; t += NGW) {
        const float sh = SH[t], hoff = 7.5f * HS[t];
        float cf[2]; float am = 0.f;
#pragma unroll
        for (int h2 = 0; h2 < 2; ++h2) {
            const size_t idx = (size_t)t * 128 + 64 * h2 + lane;
            int d = 0;
#pragma unroll
            for (int x = 0; x < 4; ++x) d += PART[(size_t)x * T * 128 + idx];
            const int ev = EXPERTS[idx];
            const float act = ((float)d - hoff) * (sh * SU[ev]);
            cf[h2] = GATESP[idx] * (0.5f * act * (1.f + erff(act * 0.70710678118f))) * SV[ev];
            am = fmaxf(am, fabsf(cf[h2]));
        }
#pragma unroll
        for (int o = 1; o < 64; o <<= 1) am = fmaxf(am, shx(am, lane, o));
        const float inv = am > 0.f ? 127.f / am : 0.f;
        const int q0 = (int)rintf(cf[0] * inv), q1 = (int)rintf(cf[1] * inv);
        COEFQ[(size_t)t * 128 + lane] = (unsigned char)(q0 & 0xff); COEFQ[(size_t)t * 128 + 64 + lane] = (unsigned char)(q1 & 0xff);
        int cs = q0 + q1;
#pragma unroll
        for (int o = 1; o < 64; o <<= 1) cs += shxi(cs, lane, o);
        if (lane == 0) { SCT[t] = am * (1.f / 127.f); CS[t] = (float)cs; }
    }
}
#define G2_IDS(E_, C_, it_) do { const int t_ = t0 + ((it_) >> 1), hf_ = (it_) & 1; const v4u* ep_ = (const v4u*)(EXPERTS + (size_t)t_ * 128 + 16 * oct + 8 * hf_); const v4u ea_ = ep_[0], eb_ = ep_[1]; \
    E_[0] = (int)ea_.x; E_[1] = (int)ea_.y; E_[2] = (int)ea_.z; E_[3] = (int)ea_.w; E_[4] = (int)eb_.x; E_[5] = (int)eb_.y; E_[6] = (int)eb_.z; E_[7] = (int)eb_.w; \
    C_ = *(const u32x2*)(COEFQ + (size_t)t_ * 128 + 16 * oct + 8 * hf_); } while (0)
#define G2_ROWS(R_, E_) do { _Pragma("unroll") for (int j_ = 0; j_ < 8; ++j_) R_[j_] = __builtin_amdgcn_raw_buffer_load_b128(rs_V, (E_[j_] << 9) + soff, 0, 0); } while (0)
#define G2_T4(ob, w0, w1, w2, w3, cq_) do { const unsigned a_ = __builtin_amdgcn_perm(w1, w0, 0x05010400u), b_ = __builtin_amdgcn_perm(w1, w0, 0x07030602u), c_ = __builtin_amdgcn_perm(w3, w2, 0x05010400u), d_ = __builtin_amdgcn_perm(w3, w2, 0x07030602u); \
    const unsigned y0_ = __builtin_amdgcn_perm(c_, a_, 0x05040100u), y1_ = __builtin_amdgcn_perm(c_, a_, 0x07060302u), y2_ = __builtin_amdgcn_perm(d_, b_, 0x05040100u), y3_ = __builtin_amdgcn_perm(d_, b_, 0x07060302u); \
    o[(ob)] = __builtin_amdgcn_sdot4((int)(y0_ & 0x0F0F0F0Fu), cq_, o[(ob)], false); o[(ob) + 4] = __builtin_amdgcn_sdot4((int)((y0_ >> 4) & 0x0F0F0F0Fu), cq_, o[(ob) + 4], false); \
    o[(ob) + 1] = __builtin_amdgcn_sdot4((int)(y1_ & 0x0F0F0F0Fu), cq_, o[(ob) + 1], false); o[(ob) + 5] = __builtin_amdgcn_sdot4((int)((y1_ >> 4) & 0x0F0F0F0Fu), cq_, o[(ob) + 5], false); \
    o[(ob) + 2] = __builtin_amdgcn_sdot4((int)(y2_ & 0x0F0F0F0Fu), cq_, o[(ob) + 2], false); o[(ob) + 6] = __builtin_amdgcn_sdot4((int)((y2_ >> 4) & 0x0F0F0F0Fu), cq_, o[(ob) + 6], false); \
    o[(ob) + 3] = __builtin_amdgcn_sdot4((int)(y3_ & 0x0F0F0F0Fu), cq_, o[(ob) + 3], false); o[(ob) + 7] = __builtin_amdgcn_sdot4((int)((y3_ >> 4) & 0x0F0F0F0Fu), cq_, o[(ob) + 7], false); } while (0)
#define G2_REDI(N, S) do { const bool up_ = (lane & (S)) != 0; _Pragma("unroll") for (int j_ = 0; j_ < (N); ++j_) { const int a_ = o[j_], b_ = o[j_ + (N)]; const int send_ = up_ ? a_ : b_, keep_ = up_ ? b_ : a_; o[j_] = keep_ + shxi(send_, lane, (S)); } } while (0)
#define G2_COMP(R_, C_, it_) do { int o[32]; _Pragma("unroll") for (int k_ = 0; k_ < 32; ++k_) o[k_] = 0; \
    G2_T4(0, R_[0].x, R_[1].x, R_[2].x, R_[3].x, (int)C_.x); G2_T4(8, R_[0].y, R_[1].y, R_[2].y, R_[3].y, (int)C_.x); G2_T4(16, R_[0].z, R_[1].z, R_[2].z, R_[3].z, (int)C_.x); G2_T4(24, R_[0].w, R_[1].w, R_[2].w, R_[3].w, (int)C_.x); \
    G2_T4(0, R_[4].x, R_[5].x, R_[6].x, R_[7].x, (int)C_.y); G2_T4(8, R_[4].y, R_[5].y, R_[6].y, R_[7].y, (int)C_.y); G2_T4(16, R_[4].z, R_[5].z, R_[6].z, R_[7].z, (int)C_.y); G2_T4(24, R_[4].w, R_[5].w, R_[6].w, R_[7].w, (int)C_.y); \
    G2_REDI(16, 8); G2_REDI(8, 16); G2_REDI(4, 32); \
    const int tt_ = t0 + ((it_) >> 1); const float sc_ = SCT[tt_], corr_ = ((it_) & 1) ? 0.f : 7.5f * CS[tt_]; f32x4* xp_ = (f32x4*)(X + (size_t)tt_ * 1024 + ocol); f32x4 xv_ = *xp_; \
    xv_.x += sc_ * ((float)o[0] - corr_); xv_.y += sc_ * ((float)o[1] - corr_); xv_.z += sc_ * ((float)o[2] - corr_); xv_.w += sc_ * ((float)o[3] - corr_); *xp_ = xv_; } while (0)
__device__ __forceinline__ void peer_g2_phase(const int wv, int vcu, const int* EXPERTS, const unsigned char* COEFQ, const float* SCT, const float* CS, const unsigned char* Vtab, float* X) {
    int ln_; asm volatile("v_mbcnt_lo_u32_b32 %0, -1, 0\n\tv_mbcnt_hi_u32_b32 %0, -1, %0" : "=v"(ln_)); const int lane = ln_, oct = lane >> 3, q8 = lane & 7;
    const int s = vcu >> 6;
    const __amdgpu_buffer_rsrc_t rs_V = __builtin_amdgcn_make_buffer_rsrc((void*)Vtab, (short)0, 16384 * 512, 0x00020000);
    const int soff = 128 * s + 16 * q8;
    const int ocol = 256 * s + 32 * q8 + 16 * ((lane >> 3) & 1) + 8 * ((lane >> 4) & 1) + 4 * ((lane >> 5) & 1);
    const int t0 = 512 * (vcu & 63) + 64 * wv;
    int eA[8], eB[8]; u32x2 cA, cB, cC; v4u rA[8], rB[8];
    G2_IDS(eA, cA, 0); G2_ROWS(rA, eA); G2_IDS(eB, cB, 1);
#pragma unroll 1
    for (int i = 0; i < 128; i += 2) {
        G2_ROWS(rB, eB); __builtin_amdgcn_sched_barrier(0);
        G2_IDS(eA, cC, (i + 2) & 127); __builtin_amdgcn_sched_barrier(0);
        G2_COMP(rA, cA, i); __builtin_amdgcn_sched_barrier(0);
        G2_ROWS(rA, eA); cA = cC; __builtin_amdgcn_sched_barrier(0);
        G2_IDS(eB, cC, (i + 3) & 127); __builtin_amdgcn_sched_barrier(0);
        G2_COMP(rB, cB, i + 1); __builtin_amdgcn_sched_barrier(0);
        cB = cC;
    }
}

__device__ __forceinline__ void qknorm_rope_pass(bf16* Q1, bf16* K1, const float* qg, const float* kg, const float* rope, size_t gtid, size_t gthreads) {
    const size_t NROWS = (size_t)2 * 64 * 2 * 4096;
    const int lane = (int)(gtid & 63);
    for (size_t id = gtid; id < NROWS * 8; id += gthreads) {
        const size_t rowg = id >> 3; const int part = (int)(id & 7);
        const bool isk = rowg >= NROWS / 2; const size_t row = isk ? rowg - NROWS / 2 : rowg;
        bf16* ptr = (isk ? K1 : Q1) + row * 64 + part * 8; const float* g = (isk ? kg : qg) + part * 8;
        const int s = (int)(row & 4095); const int bh = (int)(row >> 13); const int bidx = bh >> 3; const size_t mtok = (size_t)bidx * 4096 + s;
        const v4u raw = *(const v4u*)ptr;
        float x[8];
#pragma unroll
        for (int i = 0; i < 4; ++i) { x[2 * i] = bf_lo(raw[i]); x[2 * i + 1] = bf_hi(raw[i]); }
        float ss = 0.f;
#pragma unroll
        for (int i = 0; i < 8; ++i) ss += x[i] * x[i];
        ss += shx(ss, lane, 1); ss += shx(ss, lane, 2); ss += shx(ss, lane, 4);
        const float rstd = rsqrtf(ss * (1.f / 64.f) + EPS);
        float y[8], other[8];
#pragma unroll
        for (int i = 0; i < 8; ++i) y[i] = x[i] * rstd * g[i];
#pragma unroll
        for (int i = 0; i < 8; ++i) other[i] = shx(y[i], lane, 1);
        if (part < 2) { const float* cs = rope + mtok * 16;
#pragma unroll
            for (int i = 0; i < 8; ++i) { const float co = cs[i], si = cs[8 + i]; y[i] = (part == 0) ? (y[i] * co - other[i] * si) : (y[i] * co + other[i] * si); } }
        const float sc = isk ? 1.f : (0.125f * 1.44269504089f);
        v4u o;
#pragma unroll
        for (int i = 0; i < 4; ++i) o[i] = pk2(y[2 * i] * sc, y[2 * i + 1] * sc);
        *(v4u*)ptr = o;
    }
}

__device__ __forceinline__ void glds16(const void* gsrc, unsigned lds_dst) { unsigned keep;
    asm volatile("s_mov_b32 %0, m0\n\ts_mov_b32 m0, %2\n\ts_nop 0\n\tglobal_load_lds_dwordx4 %1, off\n\ts_mov_b32 m0, %0" : "=&s"(keep) : "v"(gsrc), "s"(lds_dst) : "memory"); }
#define AT_WAIT_BAR() asm volatile("s_waitcnt vmcnt(0) lgkmcnt(0)\n\ts_barrier" ::: "memory")
#define AT_DMA(kt_, slot_) do { \
    _Pragma("unroll") for (int i_ = 0; i_ < 2; ++i_) { const int row_ = 8 * w + (lane >> 3), ch_ = (lane & 7) ^ ((row_ >> 1) & 7); \
        glds16(K1 + ((size_t)((bh * 2 + i_) * 4096 + (kt_) * 64 + row_)) * 64 + ch_ * 8, (unsigned)__builtin_amdgcn_readfirstlane((int)(ldsb + (slot_) * 32768 + i_ * 8192 + w * 1024))); } \
    _Pragma("unroll") for (int i_ = 0; i_ < 2; ++i_) { const int row_ = 8 * w + 4 * i_ + (lane >> 4), ch_ = (lane & 15) ^ ((row_ & 3) << 2); \
        glds16(V1 + ((size_t)(bh * 4096 + (kt_) * 64 + row_)) * 128 + ch_ * 8, (unsigned)__builtin_amdgcn_readfirstlane((int)(ldsb + (slot_) * 32768 + 16384 + w * 2048 + i_ * 1024))); } } while (0)
typedef short v4i16_t __attribute__((ext_vector_type(4)));
__device__ __forceinline__ bf16x8 vtr8(const LAS bf16* p) {
    const v4i16_t lo = __builtin_amdgcn_ds_read_tr16_b64_v4i16((LAS v4i16_t*)p), hi = __builtin_amdgcn_ds_read_tr16_b64_v4i16((LAS v4i16_t*)(p + 8 * 128));
    return (bf16x8){lo[0], lo[1], lo[2], lo[3], hi[0], hi[1], hi[2], hi[3]};
}
template <bool OFFS>
__device__ __forceinline__ void attn_units(const int wv, LAS unsigned char* lds, int vcu, const bf16* Q1, const bf16* K1, const bf16* V1, bf16* O, const float* subln, float lam, float offs) {
    int ln_; asm volatile("v_mbcnt_lo_u32_b32 %0, -1, 0\n\tv_mbcnt_hi_u32_b32 %0, -1, %0" : "=v"(ln_)); const int tid = wv * 64 + ln_, lane = tid & 63, w = wv, r32 = lane & 31, hi = lane >> 5, qt = w & 3, c = w >> 2;
    LAS float* lbuf = (LAS float*)(lds + 135168 + w * 128);
    LAS float* Obuf = (LAS float*)lds;
    const unsigned ldsb = (unsigned)(uintptr_t)lds;
#pragma unroll 1
    for (int ui = 0; ui < 8; ++ui) {
        const int bh = (vcu >> 5) * 8 + ui, qb = vcu & 31, b = bh >> 3, h = bh & 7;
        bf16x8 bq[4];
#pragma unroll
        for (int ks = 0; ks < 4; ++ks) bq[ks] = *(const bf16x8*)(Q1 + ((size_t)((bh * 2 + c) * 4096 + qb * 128 + qt * 32 + r32)) * 64 + ks * 16 + 8 * hi);
        f32x16 Oa[4];
#pragma unroll
        for (int db = 0; db < 4; ++db)
#pragma unroll
            for (int r = 0; r < 16; ++r) Oa[db][r] = 0.f;
        float lsum = 0.f;
        AT_DMA(0, 0); AT_DMA(1, 1);
        AT_WAIT_BAR();
        const int kx0 = (r32 >> 1) & 7, kx1 = ((32 + r32) >> 1) & 7;
        const int vrow = 4 * hi + ((lane >> 2) & 3), vg = (lane >> 4) & 1, vp = lane & 3;
        f32x16 s0, s1;
        { const LAS unsigned char* Kc = lds + c * 8192;
#pragma unroll
          for (int r = 0; r < 16; ++r) { s0[r] = 0.f; s1[r] = 0.f; }
#pragma unroll
          for (int ks = 0; ks < 4; ++ks) { const bf16x8 a0 = *(const LAS bf16x8*)(Kc + r32 * 128 + (((2 * ks + hi) ^ kx0) << 4)), a1 = *(const LAS bf16x8*)(Kc + (32 + r32) * 128 + (((2 * ks + hi) ^ kx1) << 4));
              s0 = mfma32(a0, bq[ks], s0); s1 = mfma32(a1, bq[ks], s1); } }
        int b0 = 0, b1 = 1, b2 = 2;
#pragma unroll 1
        for (int kt = 0; kt < 64; ++kt) {
            if (kt + 2 < 64) AT_DMA(kt + 2, b2);
            const LAS unsigned char* Kc = lds + b1 * 32768 + c * 8192;
            const LAS unsigned char* Vb = lds + b0 * 32768 + 16384 + vrow * 256 + 8 * (vp & 1);
            f32x16 n0, n1;
#pragma unroll
            for (int r = 0; r < 16; ++r) { n0[r] = 0.f; n1[r] = 0.f; }
            bf16x8 ka[8];
#define AT_KLD(ks_) do { ka[2 * (ks_)] = *(const LAS bf16x8*)(Kc + r32 * 128 + (((2 * (ks_) + hi) ^ kx0) << 4)); ka[2 * (ks_) + 1] = *(const LAS bf16x8*)(Kc + (32 + r32) * 128 + (((2 * (ks_) + hi) ^ kx1) << 4)); } while (0)
            AT_KLD(0); AT_KLD(1);
            __builtin_amdgcn_sched_barrier(0);
#pragma unroll
            for (int ks = 0; ks < 4; ++ks) {
                n0 = mfma32(ka[2 * ks], bq[ks], n0);
#pragma unroll
                for (int r = 0; r < 4; ++r) s0[4 * ks + r] = __builtin_amdgcn_exp2f(OFFS ? s0[4 * ks + r] - offs : s0[4 * ks + r]);
                __builtin_amdgcn_sched_barrier(0);
                n1 = mfma32(ka[2 * ks + 1], bq[ks], n1);
                if (ks < 2) AT_KLD(ks + 2);
#pragma unroll
                for (int r = 0; r < 4; ++r) s1[4 * ks + r] = __builtin_amdgcn_exp2f(OFFS ? s1[4 * ks + r] - offs : s1[4 * ks + r]);
                __builtin_amdgcn_sched_barrier(0);
            }
#undef AT_KLD
            bf16x8 pa[4]; bf16x8 vf[4], vn[4];
#pragma unroll
            for (int db = 0; db < 4; ++db) vf[db] = vtr8((const LAS bf16*)(Vb + (((4 * db + 2 * vg + (vp >> 1)) ^ ((vrow & 3) << 2)) << 4)));
            float ls = 0.f;
            { v4u t0;
#pragma unroll
              for (int k = 0; k < 4; ++k) { t0[k] = pk2(s0[2 * k], s0[2 * k + 1]); ls += s0[2 * k] + s0[2 * k + 1]; }
              pa[0] = __builtin_bit_cast(bf16x8, t0); }
            __builtin_amdgcn_sched_barrier(0);
#pragma unroll
            for (int sp_ = 0; sp_ < 4; ++sp_) {
                if (sp_ < 3) {
#pragma unroll
                    for (int db = 0; db < 4; ++db) vn[db] = vtr8((const LAS bf16*)(Vb + (16 * (sp_ + 1)) * 256 + (((4 * db + 2 * vg + (vp >> 1)) ^ ((vrow & 3) << 2)) << 4)));
                }
#pragma unroll
                for (int db = 0; db < 4; ++db) Oa[db] = mfma32(pa[sp_], vf[db], Oa[db]);
                if (sp_ < 3) { v4u t0;
#pragma unroll
                    for (int k = 0; k < 4; ++k) { const float x0 = (sp_ == 0) ? s0[8 + 2 * k] : (sp_ == 1 ? s1[2 * k] : s1[8 + 2 * k]), x1 = (sp_ == 0) ? s0[9 + 2 * k] : (sp_ == 1 ? s1[2 * k + 1] : s1[9 + 2 * k]); t0[k] = pk2(x0, x1); ls += x0 + x1; }
                    pa[sp_ + 1] = __builtin_bit_cast(bf16x8, t0); }
                __builtin_amdgcn_sched_barrier(0);
                if (sp_ < 3) {
#pragma unroll
                    for (int db = 0; db < 4; ++db) vf[db] = vn[db];
                }
            }
            lsum += ls;
            s0 = n0; s1 = n1;
            { const int tb = b0; b0 = b1; b1 = b2; b2 = tb; }
            AT_WAIT_BAR();
        }
        lsum += shx(lsum, lane, 32);
        lbuf[r32] = lsum;
#pragma unroll
        for (int r = 0; r < 16; ++r) { const int qrow = (r & 3) + 8 * (r >> 2) + 4 * hi; const float inv = 1.f / lbuf[qrow];
#pragma unroll
            for (int db = 0; db < 4; ++db) Obuf[(c * 128 + qt * 32 + qrow) * 132 + 32 * db + r32] = Oa[db][r] * inv; }
        __syncthreads();
        { const int row = tid >> 2, qd = tid & 3;
          float dv[32]; float ss = 0.f;
#pragma unroll
          for (int k = 0; k < 8; ++k) { const f32x4 o0 = *(const LAS f32x4*)(Obuf + row * 132 + qd * 32 + 4 * k), o1 = *(const LAS f32x4*)(Obuf + (128 + row) * 132 + qd * 32 + 4 * k);
#pragma unroll
              for (int e = 0; e < 4; ++e) { const float d = o0[e] - lam * o1[e]; dv[4 * k + e] = d; ss += d * d; } }
          ss += shx(ss, lane, 1); ss += shx(ss, lane, 2);
          const float rstd = rsqrtf(ss * (1.f / 128.f) + EPS) * (1.f - LAMBDA_INIT);
          bf16* op = O + ((size_t)b * 4096 + qb * 128 + row) * 1024 + h * 128 + qd * 32;
#pragma unroll
          for (int k = 0; k < 4; ++k) { v4u o;
#pragma unroll
              for (int e = 0; e < 4; ++e) o[e] = pk2(dv[8 * k + 2 * e] * rstd * subln[qd * 32 + 8 * k + 2 * e], dv[8 * k + 2 * e + 1] * rstd * subln[qd * 32 + 8 * k + 2 * e + 1]);
              *(v4u*)(op + 8 * k) = o; } }
        __syncthreads();
    }
}
__device__ __forceinline__ void attn_phase(const int wv, LAS unsigned char* lds, int vcu, const bf16* Q1, const bf16* K1, const bf16* V1, bf16* O, const float* qg, const float* kg,
                                           const float* lq1, const float* lk1, const float* lq2, const float* lk2, const float* subln) {
    float s1 = 0.f, s2 = 0.f, mq = 0.f, mk = 0.f;
    for (int i = 0; i < 64; ++i) { s1 += lq1[i] * lk1[i]; s2 += lq2[i] * lk2[i]; mq = fmaxf(mq, fabsf(qg[i])); mk = fmaxf(mk, fabsf(kg[i])); }
    const float lam = expf(s1) - expf(s2) + LAMBDA_INIT;
    const float offs = 8.f * mq * mk * 1.44269504089f * 1.02f + 0.25f;
    if (offs < 24.f) attn_units<false>(wv, lds, vcu, Q1, K1, V1, O, subln, lam, 0.f);
    else attn_units<true>(wv, lds, vcu, Q1, K1, V1, O, subln, lam, offs);
}
#undef AT_LOAD
#undef AT_WRITE
struct Args { const void* in[27]; float* out; unsigned char* ws; };
#define KARG(i) ({ GAS const void* p_; asm volatile("s_load_dwordx2 %0, %1, %2\n\ts_waitcnt lgkmcnt(0)" : "=s"(p_) : "s"(__builtin_amdgcn_kernarg_segment_ptr()), "i"(8 * (i))); (const void*)p_; })
#define KIN(i) ((const float*)KARG(i))
#define KOUT() ((float*)KARG(27))
#define KWS() ((unsigned char*)KARG(28))
#define WSP(T_, off) ((T_*)(KWS() + (off)))
__global__ void __launch_bounds__(NWAVES * 64, 2) mk_fwd(Args args) {
    extern __shared__ __attribute__((aligned(16))) unsigned char lds_raw[];
    LAS unsigned char* lds = (LAS unsigned char*)lds_raw;
    const int G = gridDim.x, bx = blockIdx.x;
    const int wv = __builtin_amdgcn_readfirstlane((int)(threadIdx.x >> 6));
    const int vcu = (G % 8 == 0) ? (bx % 8) * (G / 8) + bx / 8 : bx;
#define PH_IDS() int ln_; asm volatile("v_mbcnt_lo_u32_b32 %0, -1, 0\n\tv_mbcnt_hi_u32_b32 %0, -1, %0" : "=v"(ln_)); const int lane = ln_, wave = wv, tid = wv * 64 + ln_; \
    const int gw = vcu * NWAVES + wave, NGW = G * NWAVES; const size_t gtid = (size_t)vcu * (NWAVES * 64) + tid, gthreads = (size_t)G * (NWAVES * 64); (void)lane; (void)gw; (void)NGW; (void)gtid; (void)gthreads
    if (threadIdx.x < 32) ((LAS unsigned*)(lds + MISC_OFF))[threadIdx.x] = 0u;
    __syncthreads();
    (void)xcd_barrier_post((unsigned*)(WSP(gu32, WS_CTL) + CW_BAR), (volatile LAS unsigned*)(lds + MISC_OFF) + 8);
#define STAMP() do {} while (0)
#ifndef PROBE_DUP
#define PROBE_DUP 0
#endif
#define REPS(bit) _Pragma("unroll 1") for (int rep_ = 0; rep_ < 1 + ((PROBE_DUP >> (bit)) & 1); ++rep_)
#define GRID_BAR1() do { XcdBarrier b_; b_.bar = (unsigned*)(WSP(gu32, WS_CTL) + CW_BAR); b_.x = xb_xcc_id(); b_.st = (volatile LAS unsigned*)(lds + MISC_OFF) + 8; xcd_barrier(b_); } while (0)
#define GRID_BAR() do { GRID_BAR1(); if ((PROBE_DUP >> 9) & 1) GRID_BAR1(); } while (0)

    REPS(5) {
        PH_IDS();
        LAS float* scr = (LAS float*)(lds + wave * 16384);
        constexpr int I0 = 16 * 97, I1 = 16 * 32, I2 = 16 * 64, I3 = 16 * 96, I4 = 16 * 32, I5 = 16 * 64, NITEMS = I0 + I1 + I2 + I3 + I4 + I5;
        for (int it = gw; it < NITEMS; it += NGW) {
            int r = it;
            if (r < I0) { p0_transpose_item(KIN(3), 1024, 3104, WSP(bf16, WS_WIN), scr, r, lane); continue; } r -= I0;
            if (r < I1) { p0_transpose_item(KIN(6), 1024, 1024, WSP(bf16, WS_WO0), scr, r, lane); continue; } r -= I1;
            if (r < I2) { p0_transpose_item(KIN(8), 1024, 2048, WSP(bf16, WS_WQ0), scr, r, lane); continue; } r -= I2;
            if (r < I3) { p0_transpose_item(KIN(13), 1024, 3072, WSP(bf16, WS_WQKV), scr, r, lane); continue; } r -= I3;
            if (r < I4) { p0_transpose_item(KIN(21), 1024, 1024, WSP(bf16, WS_WO1), scr, r, lane); continue; } r -= I4;
            p0_transpose_item(KIN(23), 1024, 2048, WSP(bf16, WS_WQ1), scr, r, lane);
        }
        { bf16* WIN = WSP(bf16, WS_WIN); for (size_t i = gtid * 8; i < (size_t)224 * 1024; i += gthreads * 8) *(v4u*)(WIN + (size_t)3104 * 1024 + i) = (v4u){0u, 0u, 0u, 0u}; }
        cvt_range(KIN(9), WSP(bf16, WS_KEY0), (size_t)262144, gtid, gthreads);
        cvt_range(KIN(24), WSP(bf16, WS_KEY1), (size_t)262144, gtid, gthreads);
        quant4_rows(KIN(10), WSP(unsigned char, WS_U0), WSP(float, WS_SC), 16384, gw, NGW, lane);
        quant4_rows(KIN(11), WSP(unsigned char, WS_V0T), WSP(float, WS_SC + 65536), 16384, gw, NGW, lane);
        quant4_rows(KIN(25), WSP(unsigned char, WS_U1), WSP(float, WS_SC + 2 * 65536), 16384, gw, NGW, lane);
        quant4_rows(KIN(26), WSP(unsigned char, WS_V1T), WSP(float, WS_SC + 3 * 65536), 16384, gw, NGW, lane);
        rms_pass(KIN(0), KIN(2), WSP(bf16, WS_B0), gw, NGW, lane);
        { const int* positions = (const int*)KARG(1); float* ROPE = WSP(float, WS_ROPE);
          for (size_t id = gtid; id < (size_t)T * 8; id += gthreads) { const size_t mtok = id >> 3; const int i = (int)(id & 7);
            const float inv = powf(500000.0f, -(float)i * 2.0f / 16.0f); const float ang = (float)positions[mtok] * inv;
            float sn, cs; sincosf(ang, &sn, &cs); ROPE[mtok * 16 + i] = cs; ROPE[mtok * 16 + 8 + i] = sn; } }
    }
    GRID_BAR();
    REPS(3) {
        unsigned char* ws = KWS();
        pg8::Gemm g{(const bf16*)(ws + WS_B0), (const bf16*)(ws + WS_WIN), T, 3328, 1024}; pg8::StaticOrder S; S.init(T, 3328, G, bx);
        pg8::EpiInProj E{(bf16*)(ws + WS_R1), (bf16*)(ws + WS_R1 + 32 * MiB), (bf16*)(ws + WS_R2), (bf16*)(ws + WS_R3), (float*)(ws + WS_GATES), KIN(4)};
        pg8::gemm_phase<pg8::EpiInProj, pg8::StaticOrder, true, true>(lds, g, S, E, wv);
    }
    GRID_BAR();
    REPS(2) { unsigned char* ws = KWS(); mlstm_phase(wv, lds, (const bf16*)(ws + WS_R1), (const bf16*)(ws + WS_R1 + 32 * MiB), (const bf16*)(ws + WS_R2), (const float*)(ws + WS_GATES), (bf16*)(ws + WS_R4), (bf16*)(ws + WS_R5)); }
    GRID_BAR();
    REPS(6) { PH_IDS(); unsigned char* ws = KWS(); hs_pass((const bf16*)(ws + WS_R4), (const bf16*)(ws + WS_R5), (const bf16*)(ws + WS_R3), KIN(5), (bf16*)(ws + WS_B0), gw, NGW, lane); }
    GRID_BAR();
#pragma unroll 1
    for (int L = 0; L < 2; ++L) {
        if (L == 1) {
            REPS(3) {
                unsigned char* ws = KWS();
                pg8::Gemm g{(const bf16*)(ws + WS_B0), (const bf16*)(ws + WS_WQKV), T, 3072, 1024}; pg8::StaticOrder S; S.init(T, 3072, G, bx);
                pg8::EpiQKV E{(bf16*)(ws + WS_R2), (bf16*)(ws + WS_R3), (bf16*)(ws + WS_R4)};
                pg8::gemm_phase<pg8::EpiQKV, pg8::StaticOrder, true, true>(lds, g, S, E, wv);
            }
            GRID_BAR();
            { PH_IDS(); unsigned char* ws = KWS(); qknorm_rope_pass((bf16*)(ws + WS_R2), (bf16*)(ws + WS_R3), KIN(14), KIN(15), (const float*)(ws + WS_ROPE), gtid, gthreads); }
            GRID_BAR();
            REPS(0) { unsigned char* ws = KWS(); attn_phase(wv, lds, vcu, (const bf16*)(ws + WS_R2), (const bf16*)(ws + WS_R3), (const bf16*)(ws + WS_R4), (bf16*)(ws + WS_B0), KIN(14), KIN(15), KIN(16), KIN(17), KIN(18), KIN(19), KIN(20)); }
            GRID_BAR();
        }
        _Pragma("unroll 1") for (int rep_ = 0; rep_ < 1 + ((L == 0) ? ((PROBE_DUP >> 3) & 1) : 0); ++rep_) {
            unsigned char* ws = KWS(); float* out = KOUT();
            pg8::Gemm g{(const bf16*)(ws + WS_B0), (const bf16*)(ws + (L ? WS_WO1 : WS_WO0)), T, 1024, 1024}; pg8::StaticOrder S; S.init(T, 1024, G, bx);
            pg8::EpiRes E{L ? (const float*)out : KIN(0), out};
            pg8::gemm_phase<pg8::EpiRes, pg8::StaticOrder, true, true>(lds, g, S, E, wv);
        }
        GRID_BAR();
        REPS(7) { PH_IDS(); unsigned char* ws = KWS(); rms_quant_pass(KOUT(), L ? KIN(22) : KIN(7), (bf16*)(ws + WS_B0), ws + WS_R5, (float*)(ws + WS_SC + 4 * 65536), (float*)(ws + WS_SC + 6 * 65536), gw, NGW, lane); }
        GRID_BAR();
        REPS(3) {
            unsigned char* ws = KWS();
            pg8::Gemm g{(const bf16*)(ws + WS_B0), (const bf16*)(ws + (L ? WS_WQ1 : WS_WQ0)), T, 2048, 1024}; pg8::StaticOrder S; S.init(T, 2048, G, bx);
            pg8::EpiPlain E{(bf16*)(ws + WS_R2), 2048};
            pg8::gemm_phase<pg8::EpiPlain, pg8::StaticOrder, true, true>(lds, g, S, E, wv);
        }
        GRID_BAR();
        REPS(4) { unsigned char* ws = KWS(); peer_topk_phase(wv, vcu, (const bf16*)(ws + WS_R2), (const bf16*)(ws + (L ? WS_KEY1 : WS_KEY0)), (int*)(ws + WS_R4), (float*)(ws + WS_R4 + 16 * MiB)); }
        GRID_BAR();
        REPS(1) { unsigned char* ws = KWS(); peer_g1_phase(wv, vcu, ws + WS_R5, (const int*)(ws + WS_R4), ws + (L ? WS_U1 : WS_U0), (int*)(ws + WS_R2)); }
        GRID_BAR();
        { PH_IDS(); unsigned char* ws = KWS(); const size_t so = L ? 2 * 65536 : 0;
          peer_g1b_phase((const int*)(ws + WS_R2), (const int*)(ws + WS_R4), (const float*)(ws + WS_R4 + 16 * MiB), (const float*)(ws + WS_SC + so), (const float*)(ws + WS_SC + so + 65536),
                         (const float*)(ws + WS_SC + 4 * 65536), (const float*)(ws + WS_SC + 6 * 65536), ws + WS_R4 + 32 * MiB, (float*)(ws + WS_SC + 10 * 65536), (float*)(ws + WS_SC + 8 * 65536), gw, NGW, lane); }
        GRID_BAR();
        { unsigned char* ws = KWS(); peer_g2_phase(wv, vcu, (const int*)(ws + WS_R4), ws + WS_R4 + 32 * MiB, (const float*)(ws + WS_SC + 10 * 65536), (const float*)(ws + WS_SC + 8 * 65536), ws + (L ? WS_V1T : WS_V0T), KOUT()); }
        if (L == 0) { GRID_BAR(); { PH_IDS(); rms_pass(KOUT(), KIN(12), WSP(bf16, WS_B0), gw, NGW, lane); } GRID_BAR(); }
    }
#undef GRID_BAR
}

extern "C" void kernel_launch(void* const* d_in, const int* in_sizes, int n_in, void* d_out, int out_size, void* d_ws, size_t ws_size, hipStream_t stream) {
    static int ready = 0;
    if (ready == 0) {
        if (n_in != 27 || out_size != T * D || ws_size < WS_END) { fprintf(stderr, "kernel_launch: unexpected problem (n_in %d, out %d, ws %zu)\n", n_in, out_size, ws_size); ready = -1; return; }
        if (hipFuncSetAttribute((const void*)mk_fwd, hipFuncAttributeMaxDynamicSharedMemorySize, LDS_BYTES) != hipSuccess) { fprintf(stderr, "kernel_launch: hipFuncSetAttribute failed\n"); ready = -1; return; }
        (void)hipGetLastError();
        ready = 1;
    }
    if (ready < 0) return;
    if (hipMemsetAsync((char*)d_ws + WS_CTL, 0, CTL_ZERO_BYTES, stream) != hipSuccess) { fprintf(stderr, "kernel_launch: memset failed\n"); return; }
    Args a{};
    for (int i = 0; i < 27; ++i) a.in[i] = d_in[i];
    a.out = (float*)d_out; a.ws = (unsigned char*)d_ws;
    hipLaunchKernelGGL(mk_fwd, dim3(256), dim3(NWAVES * 64), LDS_BYTES, stream, a);
}
```

```cpp
#include <hip/hip_runtime.h>
#include <hip/hip_bf16.h>
#include <cstdio>
#include <cstdint>
#include <cmath>
namespace pg8 {
#define PG8_LAS __attribute__((address_space(3)))
typedef unsigned short bf16_t;
typedef short bf16x8 __attribute__((ext_vector_type(8)));
typedef float f32x4 __attribute__((ext_vector_type(4)));
typedef unsigned u32x4 __attribute__((ext_vector_type(4)));
constexpr int BM = 256, BK = 64, HALF = 128, HTB = HALF * BK * 2  , STAGE_BYTES = 8 * HTB, NXCD = 8, WGM = 8;

__host__ __device__ __forceinline__ int lds_byte(int r, int c) { const int st = (r >> 4) * 2 + (c >> 5), rr = r & 15, cc = c & 31, ob = rr * 64 + cc * 2; return st * 1024 + (ob ^ (((ob >> 9) & 1) << 5)); }
__host__ __device__ __forceinline__ void stage_rc(int b, int& R, int& C) { const int st = b / 1024, sb = b % 1024, swz = sb ^ (((sb >> 9) & 1) << 5); R = (st >> 1) * 16 + swz / 64; C = (st & 1) * 32 + (swz % 64) / 2; }
__host__ __device__ __forceinline__ int perm32(int rho) { const int n = rho >> 4, i = rho & 15; return 8 * (i >> 2) + 4 * n + (i & 3); }

struct Unit { int pm, pn; };
struct Gemm { const bf16_t* A; const bf16_t* Bt; int M, N, K; };

struct StaticOrder {
    int nM, nN, nwg, G, c;
    __host__ __device__ void init(int M, int N, int G_, int c_) { nM = M / BM; nN = N / BM; nwg = nM * nN; G = G_; c = c_; }
    __host__ __device__ bool next(int i, Unit& u) const {
        const long L = (long)i * G + c; if (L >= nwg) return false;
        int wgid = (int)L; { const int q = nwg / NXCD, r = nwg % NXCD, xcd = wgid % NXCD, off = wgid / NXCD; wgid = (xcd < r ? xcd * (q + 1) : r * (q + 1) + (xcd - r) * q) + off; }
        const int nig = WGM * nN, gid = wgid / nig, fm = gid * WGM, gsz = (nM - fm) < WGM ? (nM - fm) : WGM;
        u.pm = fm + ((wgid % nig) % gsz); u.pn = (wgid % nig) / gsz; return true;
    }
    __device__ __forceinline__ void a_ready(const Unit&) const {}
    __device__ __forceinline__ void done(const Unit&) const {}
};
__device__ __forceinline__ unsigned cvt_pk_bf16(float lo, float hi) { unsigned r; asm volatile("v_cvt_pk_bf16_f32 %0, %1, %2" : "=v"(r) : "v"(lo), "v"(hi)); return r; }
typedef float f32x2 __attribute__((ext_vector_type(2)));
typedef unsigned u32x2 __attribute__((ext_vector_type(2)));
__device__ __forceinline__ u32x4 pack8(const f32x4 v0, const f32x4 v1) { u32x4 w; w.x = cvt_pk_bf16(v0[0], v0[1]); w.y = cvt_pk_bf16(v0[2], v0[3]); w.z = cvt_pk_bf16(v1[0], v1[1]); w.w = cvt_pk_bf16(v1[2], v1[3]); return w; }
struct EpiPlain {
    static constexpr bool PERM = true, AFTER_DRAIN = false;
    bf16_t* O; int ldc;
    __device__ __forceinline__ void operator()(const f32x4 (&acc)[2][2][4][2], const Unit& u, int wr, int wc, int fr, int fq) const {
        const int row0 = u.pm * BM + wr * 64 + fr, col0 = u.pn * BM + wc * 32 + 8 * fq;
#pragma unroll
        for (int ai = 0; ai < 2; ++ai)
#pragma unroll
            for (int m = 0; m < 4; ++m) { bf16_t* rowp = O + (size_t)(row0 + ai * HALF + m * 16) * ldc + col0;
#pragma unroll
                for (int bj = 0; bj < 2; ++bj) *(u32x4*)(rowp + bj * HALF) = pack8(acc[ai][bj][m][0], acc[ai][bj][m][1]); }
    }
};
struct EpiRes {
    static constexpr bool PERM = false, AFTER_DRAIN = false;
    const float* base; float* out;
    __device__ __forceinline__ void operator()(const f32x4 (&acc)[2][2][4][2], const Unit& u, int wr, int wc, int fr, int fq) const {
        const int col0 = u.pn * BM + wc * 32 + 4 * fq;
#pragma unroll
        for (int ai = 0; ai < 2; ++ai)
#pragma unroll
            for (int m = 0; m < 4; ++m) { const size_t off = (size_t)(u.pm * BM + ai * HALF + wr * 64 + m * 16 + fr) * 1024 + col0;
#pragma unroll
                for (int bj = 0; bj < 2; ++bj)
#pragma unroll
                    for (int n = 0; n < 2; ++n) { const f32x4 bs = *(const f32x4*)(base + off + bj * HALF + n * 16); *(f32x4*)(out + off + bj * HALF + n * 16) = bs + acc[ai][bj][m][n]; } }
    }
};
struct EpiInProj {
    static constexpr bool PERM = true, AFTER_DRAIN = false;
    bf16_t *Q, *Kk, *V, *OG; float* gates; const float* bg;
    __device__ __forceinline__ void operator()(const f32x4 (&acc)[2][2][4][2], const Unit& u, int wr, int wc, int fr, int fq) const {
        const int colt = u.pn * BM;
#pragma unroll
        for (int ai = 0; ai < 2; ++ai)
#pragma unroll
            for (int m = 0; m < 4; ++m) { const int row = u.pm * BM + ai * HALF + wr * 64 + m * 16 + fr, b = row >> 12, s = row & 4095;
#pragma unroll
                for (int bj = 0; bj < 2; ++bj) { const int cb = colt + bj * HALF + wc * 32 + 8 * fq; f32x4 v0 = acc[ai][bj][m][0], v1 = acc[ai][bj][m][1];
                    if (colt < 1024) { const bool isq = colt < 512; bf16_t* base = isq ? Q : Kk; const int c2 = cb & 511, head = c2 >> 6, d = c2 & 63;
                        if (isq) { v0 = v0 * 0.125f; v1 = v1 * 0.125f; }
                        *(u32x4*)(base + ((size_t)((b * 8 + head) * 4096 + s)) * 64 + d) = pack8(v0, v1); }
                    else if (colt < 2048) { const int c2 = cb - 1024, head = c2 >> 7, dv = c2 & 127; *(u32x4*)(V + ((size_t)((b * 8 + head) * 4096 + s)) * 128 + dv) = pack8(v0, v1); }
                    else if (colt < 3072) { *(u32x4*)(OG + (size_t)row * 1024 + (cb - 2048)) = pack8(v0, v1); }
                    else if (cb < 3104) { const int gi = cb - 3072; float* g = gates + (size_t)row * 32 + gi;
                        *(f32x4*)g = v0 + *(const f32x4*)(bg + gi); *(f32x4*)(g + 4) = v1 + *(const f32x4*)(bg + gi + 4); } } }
    }
};
struct EpiQKV {
    static constexpr bool PERM = true, AFTER_DRAIN = false;
    bf16_t *Q, *Kk, *V; const float* SS;
    __device__ __forceinline__ void operator()(const f32x4 (&acc)[2][2][4][2], const Unit& u, int wr, int wc, int fr, int fq) const {
        const int colt = u.pn * BM;
#pragma unroll
        for (int ai = 0; ai < 2; ++ai)
#pragma unroll
            for (int m = 0; m < 4; ++m) { const int row = u.pm * BM + ai * HALF + wr * 64 + m * 16 + fr, b = row >> 12, s = row & 4095;
                const float rs = __builtin_amdgcn_rsqf(((SS[row] + SS[32768 + row]) + (SS[2 * 32768 + row] + SS[3 * 32768 + row])) * (1.f / 1024.f) + 1e-6f);
#pragma unroll
                for (int bj = 0; bj < 2; ++bj) { const int cb = colt + bj * HALF + wc * 32 + 8 * fq; const u32x4 w = pack8(acc[ai][bj][m][0] * rs, acc[ai][bj][m][1] * rs);
                    if (colt < 2048) { bf16_t* base = colt < 1024 ? Q : Kk; const int c2 = cb & 1023, head = c2 >> 7, c = (c2 >> 6) & 1, d = c2 & 63;
                        *(u32x4*)(base + ((size_t)(((b * 8 + head) * 2 + c) * 4096 + s)) * 64 + d) = w; }
                    else { const int c2 = cb - 2048, head = c2 >> 7, dv = c2 & 127; *(u32x4*)(V + ((size_t)((b * 8 + head) * 4096 + s)) * 128 + dv) = w; } } }
    }
};
template <class Epi, class Sched, bool ALIGN_EPI = false, bool SP2 = false>
__device__ __forceinline__ void gemm_phase(PG8_LAS unsigned char* lds, const Gemm g, const Sched& S, const Epi& E, const int wv) {
    int ln_; asm volatile("v_mbcnt_lo_u32_b32 %0, -1, 0\n\tv_mbcnt_hi_u32_b32 %0, -1, %0" : "=v"(ln_)); const int tid = wv * 64 + ln_, wid = wv, lane = tid & 63, wr = wid >> 2, wc = wid & 3, fr = lane & 15, fq = lane >> 4;
    const int K = g.K, nt = K / BK;
    unsigned voffA[2], voffB[2];
#pragma unroll
    for (int i = 0; i < 2; ++i) { int R, C; stage_rc(tid * 16 + i * 8192, R, C); const int Rb = Epi::PERM ? ((R & ~31) + perm32(R & 31)) : R;
        voffA[i] = (unsigned)(R * K + C) * 2u; voffB[i] = (unsigned)(Rb * K + C) * 2u; }
    const size_t kstep = (size_t)(BK * 2);
    const size_t hstep = (size_t)HALF * K * 2;
    const size_t tstep = 2 * hstep;
    const unsigned ldsw = (unsigned)wid * 1024u;
    const int aoff = lds_byte(wr * 64 + fr, fq * 8), boff = lds_byte(wc * 32 + fr, fq * 8);
#define PG8_SA(b, h) (((b) * 2 + (h)) * HTB)
#define PG8_SB(b, h) ((4 + (b) * 2 + (h)) * HTB)
#define PG8_STAGE(bufoff, gbase, voff) do { _Pragma("unroll") for (int _i = 0; _i < 2; ++_i) \
        __builtin_amdgcn_global_load_lds((const unsigned*)((const char*)(gbase) + (voff)[_i]), (PG8_LAS unsigned*)(lds + (bufoff) + ldsw + _i * 8192), 16, 0, 0); } while (0)
#define PG8_LDA(dst, b, h) do { _Pragma("unroll") for (int m = 0; m < 4; ++m) _Pragma("unroll") for (int k = 0; k < 2; ++k) dst[m][k] = *(const PG8_LAS bf16x8*)(lds + PG8_SA(b, h) + aoff + m * 2048 + k * 1024); } while (0)
#define PG8_LDB(dst, b, h) do { _Pragma("unroll") for (int n = 0; n < 2; ++n) _Pragma("unroll") for (int k = 0; k < 2; ++k) dst[n][k] = *(const PG8_LAS bf16x8*)(lds + PG8_SB(b, h) + boff + n * 2048 + k * 1024); } while (0)
#define PG8_MMA(ai, bj, At, Bt) do { __builtin_amdgcn_s_setprio(1); _Pragma("unroll") for (int m = 0; m < 4; ++m) _Pragma("unroll") for (int n = 0; n < 2; ++n) _Pragma("unroll") for (int k = 0; k < 2; ++k) \
        acc[ai][bj][m][n] = __builtin_amdgcn_mfma_f32_16x16x32_bf16(Bt[n][k], At[m][k], acc[ai][bj][m][n], 0, 0, 0); __builtin_amdgcn_s_setprio(0); } while (0)
#define PG8_WAIT_V(n) asm volatile("s_waitcnt vmcnt(" #n ")" ::: "memory")
#define PG8_WAIT_L(n) asm volatile("s_waitcnt lgkmcnt(" #n ")" ::: "memory")
#define PG8_BAR __builtin_amdgcn_s_barrier()
#define PG8_SCHED __builtin_amdgcn_sched_barrier(0)
    Unit cur, nxt; int ui = 0;
    if (!S.next(0, cur)) return;
    f32x4 acc[2][2][4][2];
#pragma unroll
    for (int a = 0; a < 2; ++a)
#pragma unroll
        for (int b = 0; b < 2; ++b)
#pragma unroll
            for (int m = 0; m < 4; ++m)
#pragma unroll
                for (int n = 0; n < 2; ++n) acc[a][b][m][n] = (f32x4){0.f, 0.f, 0.f, 0.f};
    bf16x8 At[4][2], B0[2][2], B1[2][2];
    const char* cA = (const char*)g.A + (size_t)cur.pm * tstep; const char* cB = (const char*)g.Bt + (size_t)cur.pn * tstep;
    S.a_ready(cur);
    if constexpr (SP2) {
        PG8_STAGE(PG8_SB(0, 0), cB, voffB); PG8_STAGE(PG8_SB(0, 1), cB + hstep, voffB); PG8_STAGE(PG8_SA(0, 0), cA, voffA); PG8_STAGE(PG8_SA(0, 1), cA + hstep, voffA);
        if (wr == 1) PG8_BAR;
        PG8_WAIT_V(2); PG8_BAR;
        PG8_STAGE(PG8_SB(1, 0), cB + kstep, voffB); PG8_STAGE(PG8_SA(1, 0), cA + kstep, voffA); PG8_STAGE(PG8_SB(1, 1), cB + hstep + kstep, voffB);
        PG8_WAIT_V(6); PG8_BAR;
    } else {
        PG8_STAGE(PG8_SB(0, 0), cB, voffB); PG8_STAGE(PG8_SA(0, 0), cA, voffA); PG8_STAGE(PG8_SB(0, 1), cB + hstep, voffB); PG8_STAGE(PG8_SA(0, 1), cA + hstep, voffA);
        if (wr == 1) PG8_BAR;
        PG8_WAIT_V(4); PG8_BAR;
        PG8_STAGE(PG8_SB(1, 0), cB + kstep, voffB); PG8_STAGE(PG8_SA(1, 0), cA + kstep, voffA); PG8_STAGE(PG8_SB(1, 1), cB + hstep + kstep, voffB);
        PG8_WAIT_V(6); PG8_BAR;
    }
    for (;;) {
        const bool has_next = S.next(ui + 1, nxt);
        const char* nA = has_next ? (const char*)g.A + (size_t)nxt.pm * tstep : cA; const char* nB = has_next ? (const char*)g.Bt + (size_t)nxt.pn * tstep : cB;
        for (int t = 0; t < nt; t += 2) {
            const bool last = (t == nt - 2);
            const char* a1 = cA + (size_t)(t + 1) * kstep;
            const char* a2 = last ? nA : cA + (size_t)(t + 2) * kstep; const char* b2 = last ? nB : cB + (size_t)(t + 2) * kstep;
            const char* a3 = a2 + kstep; const char* b3 = b2 + kstep;
            if (last && has_next) S.a_ready(nxt);
            if constexpr (SP2) {
            PG8_LDB(B0, 0, 0); PG8_LDB(B1, 0, 1); PG8_SCHED; PG8_LDA(At, 0, 0); PG8_STAGE(PG8_SA(1, 1), a1 + hstep, voffA);
            PG8_WAIT_V(8); PG8_WAIT_L(0); PG8_BAR; PG8_MMA(0, 0, At, B0); PG8_MMA(0, 1, At, B1); PG8_BAR; PG8_SCHED;
            PG8_LDA(At, 0, 1); PG8_STAGE(PG8_SB(0, 0), b2, voffB); PG8_STAGE(PG8_SB(0, 1), b2 + hstep, voffB); PG8_STAGE(PG8_SA(0, 0), a2, voffA);
            PG8_WAIT_V(8); PG8_WAIT_L(0); PG8_BAR; PG8_MMA(1, 0, At, B0); PG8_MMA(1, 1, At, B1); PG8_BAR; PG8_SCHED;
            PG8_LDB(B0, 1, 0); PG8_LDB(B1, 1, 1); PG8_SCHED; PG8_LDA(At, 1, 0); PG8_STAGE(PG8_SA(0, 1), a2 + hstep, voffA);
            PG8_WAIT_V(8); PG8_WAIT_L(0); PG8_BAR; PG8_MMA(0, 0, At, B0); PG8_MMA(0, 1, At, B1); PG8_BAR; PG8_SCHED;
            PG8_LDA(At, 1, 1); PG8_STAGE(PG8_SB(1, 0), b3, voffB); PG8_STAGE(PG8_SB(1, 1), b3 + hstep, voffB); PG8_STAGE(PG8_SA(1, 0), a3, voffA);
            PG8_WAIT_V(8); PG8_WAIT_L(0); PG8_BAR; PG8_MMA(1, 0, At, B0); PG8_MMA(1, 1, At, B1); PG8_BAR; PG8_SCHED;
            } else {
            PG8_LDB(B0, 0, 0); PG8_SCHED; PG8_LDA(At, 0, 0); PG8_STAGE(PG8_SA(1, 1), a1 + hstep, voffA);
            PG8_WAIT_L(8); PG8_BAR; PG8_WAIT_L(0); PG8_MMA(0, 0, At, B0); PG8_BAR; PG8_SCHED;
            PG8_LDB(B1, 0, 1); PG8_STAGE(PG8_SB(0, 0), b2, voffB);
            PG8_BAR; PG8_WAIT_L(0); PG8_MMA(0, 1, At, B1); PG8_BAR;
            PG8_LDA(At, 0, 1); PG8_STAGE(PG8_SA(0, 0), a2, voffA);
            PG8_BAR; PG8_WAIT_L(0); PG8_MMA(1, 0, At, B0); PG8_BAR; PG8_SCHED;
            PG8_STAGE(PG8_SB(0, 1), b2 + hstep, voffB);
            PG8_WAIT_V(6); PG8_BAR; PG8_MMA(1, 1, At, B1); PG8_BAR;
            PG8_LDB(B0, 1, 0); PG8_SCHED; PG8_LDA(At, 1, 0); PG8_STAGE(PG8_SA(0, 1), a2 + hstep, voffA);
            PG8_WAIT_L(8); PG8_BAR; PG8_WAIT_L(0); PG8_MMA(0, 0, At, B0); PG8_BAR; PG8_SCHED;
            PG8_LDB(B1, 1, 1); PG8_STAGE(PG8_SB(1, 0), b3, voffB);
            PG8_BAR; PG8_WAIT_L(0); PG8_MMA(0, 1, At, B1); PG8_BAR;
            PG8_LDA(At, 1, 1); PG8_STAGE(PG8_SA(1, 0), a3, voffA);
            PG8_BAR; PG8_WAIT_L(0); PG8_MMA(1, 0, At, B0); PG8_BAR; PG8_SCHED;
            PG8_STAGE(PG8_SB(1, 1), b3 + hstep, voffB);
            PG8_WAIT_V(6); PG8_BAR; PG8_MMA(1, 1, At, B1); PG8_BAR;
            }
        }
        if constexpr (ALIGN_EPI) { if (wr == 0) PG8_BAR; }
        if constexpr (!Epi::AFTER_DRAIN) { E(acc, cur, wr, wc, fr, fq); S.done(cur); }
        if (!has_next) break;
#pragma unroll
        for (int a = 0; a < 2; ++a)
#pragma unroll
            for (int b = 0; b < 2; ++b)
#pragma unroll
                for (int m = 0; m < 4; ++m)
#pragma unroll
                    for (int n = 0; n < 2; ++n) acc[a][b][m][n] = (f32x4){0.f, 0.f, 0.f, 0.f};
        cur = nxt; cA = nA; cB = nB; ++ui;
        if constexpr (ALIGN_EPI) { if (wr == 1) PG8_BAR; }
    }
    PG8_WAIT_V(0);
    if constexpr (!ALIGN_EPI) { if (wr == 0) PG8_BAR; }
    PG8_BAR;
    if constexpr (Epi::AFTER_DRAIN) { E.fused(acc, cur, wr, wc, fr, fq, lds, wid, lane); S.done(cur); }
#undef PG8_SA
#undef PG8_SB
#undef PG8_STAGE
#undef PG8_LDA
#undef PG8_LDB
#undef PG8_MMA
#undef PG8_WAIT_V
#undef PG8_WAIT_L
#undef PG8_BAR
#undef PG8_SCHED
}
}
#define GAS __attribute__((address_space(1)))
#define LAS __attribute__((address_space(3)))
typedef unsigned short bf16;
typedef unsigned v4u __attribute__((ext_vector_type(4)));
typedef float f32x4 __attribute__((ext_vector_type(4)));
typedef short bf16x8 __attribute__((ext_vector_type(8)));
typedef GAS unsigned gu32;
typedef GAS unsigned long long gu64;
#define RLX_AGENT __ATOMIC_RELAXED, __HIP_MEMORY_SCOPE_AGENT
#define LDS_WAIT() asm volatile("s_waitcnt lgkmcnt(0)" ::: "memory")
#define VM_WAIT() asm volatile("s_waitcnt vmcnt(0)" ::: "memory")
__device__ __forceinline__ unsigned long long rt() { return __builtin_amdgcn_s_memrealtime(); }
typedef float f32x2_cv __attribute__((ext_vector_type(2))); typedef __bf16 bf16x2_cv __attribute__((ext_vector_type(2)));
__device__ __forceinline__ unsigned pk2(float lo, float hi) { const f32x2_cv v = {lo, hi}; const bf16x2_cv b = __builtin_convertvector(v, bf16x2_cv); return __builtin_bit_cast(unsigned, b); }
__device__ __forceinline__ unsigned f2bf(float f) { return pk2(f, 0.f) & 0xffffu; }

#define XB_TMO      128
#define XB_XCNT(j)  (256  + 64 * (j))
#define XB_XSUB(j)  (1280 + 64 * (j))
#define XB_XGEN(j)  (2304 + 64 * (j))
#define XB_TOP      3328
#define XB_TOPGEN   3392
#define XCD_BAR_WORDS 3456
#define XB_SPIN_CAP (1u << 18)

__device__ __forceinline__ unsigned xb_ld(unsigned* p)              { return __hip_atomic_load(p, __ATOMIC_RELAXED, __HIP_MEMORY_SCOPE_AGENT); }
__device__ __forceinline__ unsigned xb_add(unsigned* p, unsigned v) { return __hip_atomic_fetch_add(p, v, __ATOMIC_RELAXED, __HIP_MEMORY_SCOPE_AGENT); }
__device__ __forceinline__ unsigned xb_xcc_id() { return (unsigned)__builtin_amdgcn_s_getreg((3 << 11) | 20) & 0xFu; }
#define XB_SPIN(cond, bar) do { unsigned _sp = 0; while (cond) { __builtin_amdgcn_s_sleep(1); \
    if ((++_sp & 255u) == 0u) { if (xb_ld(&(bar)[XB_TMO])) break; if (_sp > XB_SPIN_CAP) { atomicAdd(&(bar)[XB_TMO], 1u); break; } } } } while (0)

struct XcdBarrier {
    unsigned* bar; unsigned x;
    volatile LAS unsigned* st;
};

__device__ __forceinline__ XcdBarrier xcd_barrier_post(unsigned* bar, volatile LAS unsigned* st) {
    XcdBarrier b; b.bar = bar; b.x = xb_xcc_id(); b.st = st;
    if (threadIdx.x == 0) (void)xb_add(&bar[XB_XCNT(b.x)], 1u);
    return b;
}
__device__ __forceinline__ void xcd_barrier_complete(unsigned* bar, unsigned x, unsigned& nloc, unsigned& nx) {
    const unsigned G = gridDim.x * gridDim.y * gridDim.z;
    unsigned sum, cnt, mine, sp = 0u;
    for (;;) {
        sum = 0u; cnt = 0u; mine = 0u;
#pragma unroll
        for (unsigned j = 0; j < 16; ++j) { const unsigned c = xb_ld(&bar[XB_XCNT(j)]); sum += c; cnt += (c > 0u) ? 1u : 0u; mine = (j == x) ? c : mine; }
        if (sum == G) break;
        __builtin_amdgcn_s_sleep(1);
        if ((++sp & 255u) == 0u) { if (xb_ld(&bar[XB_TMO])) break; if (sp > XB_SPIN_CAP) { atomicAdd(&bar[XB_TMO], 1u); break; } }
    }
    nloc = mine > 0u ? mine : 1u; nx = cnt > 0u ? cnt : 1u;
}

__device__ __forceinline__ void xcd_barrier(const XcdBarrier& b) {
    asm volatile("s_waitcnt vmcnt(0)" ::: "memory");
    __syncthreads();
    if (threadIdx.x == 0) {
        unsigned* bar = b.bar;
        __builtin_amdgcn_s_waitcnt(0);
        unsigned nloc = b.st[0], nx = b.st[1];
        if (nloc == 0u) { xcd_barrier_complete(bar, b.x, nloc, nx); b.st[0] = nloc; b.st[1] = nx; }
        const unsigned old = xb_add(&bar[XB_XSUB(b.x)], 1u);
        const unsigned gen = old / nloc;
        if (old + 1u == (gen + 1u) * nloc) {
            __builtin_amdgcn_fence(__ATOMIC_RELEASE, "agent");
            asm volatile("s_waitcnt vmcnt(0)" ::: "memory");
            const unsigned og = xb_add(&bar[XB_TOP], 1u);
            const unsigned tg = og / nx;
            if (og + 1u == (tg + 1u) * nx) xb_add(&bar[XB_TOPGEN], 1u);
            else XB_SPIN(xb_ld(&bar[XB_TOPGEN]) == tg, bar);
            __builtin_amdgcn_fence(__ATOMIC_ACQUIRE, "agent");
            xb_add(&bar[XB_XGEN(b.x)], 1u);
            asm volatile("s_waitcnt vmcnt(0)" ::: "memory");
        } else {
            XB_SPIN(xb_ld(&bar[XB_XGEN(b.x)]) == gen, bar);
            __builtin_amdgcn_fence(__ATOMIC_ACQUIRE, "agent");
            asm volatile("s_waitcnt vmcnt(0)" ::: "memory");
        }
    }
    __syncthreads();
}
constexpr int NWAVES = 8;
constexpr int T = 32768, D = 1024, SEQ = 4096;
constexpr float EPS = 1e-6f;
constexpr float LAMBDA_INIT = 0.35550906759f;
constexpr size_t MiB = 1u << 20;
constexpr size_t WS_CTL = 0, CTL_ZERO_BYTES = 1 * MiB;
constexpr size_t WS_ROPE = 1 * MiB;
constexpr size_t WS_WIN = 4 * MiB;
constexpr size_t WS_WO0 = 11 * MiB, WS_WQ0 = 13 * MiB, WS_KEY0 = 17 * MiB, WS_WQKV = 18 * MiB, WS_WO1 = 24 * MiB, WS_WQ1 = 26 * MiB, WS_KEY1 = 30 * MiB;
constexpr size_t WS_SC = 31 * MiB;
constexpr size_t WS_U0 = 32 * MiB, WS_V0T = 48 * MiB, WS_U1 = 64 * MiB, WS_V1T = 80 * MiB;
constexpr size_t WS_B0 = 96 * MiB;
constexpr size_t WS_R1 = 160 * MiB, WS_R2 = 224 * MiB, WS_R3 = 288 * MiB, WS_R4 = 352 * MiB, WS_R5 = 416 * MiB, WS_GATES = 480 * MiB;
constexpr size_t WS_END = 484 * MiB;
constexpr int CW_BAR = 4096;
constexpr int LDS_BYTES = 147456, MISC_OFF = LDS_BYTES - 128;

typedef float f32x16 __attribute__((ext_vector_type(16)));
typedef unsigned u32x2 __attribute__((ext_vector_type(2)));
typedef __bf16 bf16x2_t __attribute__((ext_vector_type(2)));
__device__ __forceinline__ float bf_lo(unsigned w) { return __uint_as_float(w << 16); }
__device__ __forceinline__ float bf_hi(unsigned w) { return __uint_as_float(w & 0xffff0000u); }
__device__ __forceinline__ float dot2(unsigned a, unsigned b, float c) { return __builtin_amdgcn_fdot2_f32_bf16(__builtin_bit_cast(bf16x2_t, a), __builtin_bit_cast(bf16x2_t, b), c, false); }
__device__ __forceinline__ float shx(float v, int lane, int m) { return __uint_as_float((unsigned)__builtin_amdgcn_ds_bpermute((lane ^ m) << 2, (int)__float_as_uint(v))); }
__device__ __forceinline__ int shxi(int v, int lane, int m) { return __builtin_amdgcn_ds_bpermute((lane ^ m) << 2, v); }
__device__ __forceinline__ float wave_sum(float v, int lane) {
#pragma unroll
    for (int o = 1; o < 64; o <<= 1) v += shx(v, lane, o);
    return v;
}
__device__ __forceinline__ f32x4 mfma16(bf16x8 a, bf16x8 b, f32x4 c) { return __builtin_amdgcn_mfma_f32_16x16x32_bf16(a, b, c, 0, 0, 0); }
__device__ __forceinline__ f32x16 mfma32(bf16x8 a, bf16x8 b, f32x16 c) { return __builtin_amdgcn_mfma_f32_32x32x16_bf16(a, b, c, 0, 0, 0); }
__device__ __forceinline__ u32x2 pack4(float a, float b, float c, float d) { u32x2 r; r.x = pk2(a, b); r.y = pk2(c, d); return r; }

__device__ __forceinline__ void p0_transpose_item(const float* W, int K, int N, bf16* WT, LAS float* scr, int item, int lane, const float* kscale = nullptr) {
    const int nblk = N / 32, kb = item / nblk, nb = item % nblk, k0 = 64 * kb, n0 = 32 * nb;
#pragma unroll 8
    for (int i = 0; i < 32; ++i) { const int kk = 2 * i + (lane >> 5); const float sc = kscale ? kscale[k0 + kk] : 1.f; scr[kk * 33 + (lane & 31)] = W[(size_t)(k0 + kk) * N + n0 + (lane & 31)] * sc; }
    LDS_WAIT(); asm volatile("" ::: "memory");
    const int c = lane & 7;
#pragma unroll
    for (int j = 0; j < 4; ++j) { const int n = (lane >> 3) + 8 * j; const LAS float* s = scr + (8 * c) * 33 + n;
        v4u o; o.x = pk2(s[0 * 33], s[1 * 33]); o.y = pk2(s[2 * 33], s[3 * 33]); o.z = pk2(s[4 * 33], s[5 * 33]); o.w = pk2(s[6 * 33], s[7 * 33]);
        *(v4u*)(WT + (size_t)(n0 + n) * K + k0 + 8 * c) = o; }
    LDS_WAIT(); asm volatile("" ::: "memory");
}
__device__ __forceinline__ void cvt_range(const float* src, bf16* dst, size_t n, size_t gtid, size_t gthreads) {
    for (size_t i = gtid * 8; i < n; i += gthreads * 8) {
        const f32x4 a = *(const f32x4*)(src + i), b = *(const f32x4*)(src + i + 4);
        v4u o; o.x = pk2(a.x, a.y); o.y = pk2(a.z, a.w); o.z = pk2(b.x, b.y); o.w = pk2(b.z, b.w);
        *(v4u*)(dst + i) = o; }
}
__device__ __forceinline__ void rms_row_to_bf16(const float* xrow, const float* g, bf16* orow, int lane) {
    const f32x4* xr = (const f32x4*)xrow + lane; const f32x4* gr = (const f32x4*)g + lane;
    f32x4 v[4]; float s = 0.f;
#pragma unroll
    for (int j = 0; j < 4; ++j) { v[j] = xr[64 * j]; s += (v[j].x * v[j].x + v[j].y * v[j].y) + (v[j].z * v[j].z + v[j].w * v[j].w); }
    const float rstd = rsqrtf(wave_sum(s, lane) * (1.f / 1024.f) + EPS);
    unsigned long long* o8 = (unsigned long long*)orow + lane;
#pragma unroll
    for (int j = 0; j < 4; ++j) { const f32x4 gg = gr[64 * j];
        o8[64 * j] = (unsigned long long)pk2(v[j].x * rstd * gg.x, v[j].y * rstd * gg.y) | ((unsigned long long)pk2(v[j].z * rstd * gg.z, v[j].w * rstd * gg.w) << 32); }
}
__device__ __forceinline__ void rms_pass(const float* X, const float* g, bf16* XN, int gw, int NGW, int lane) {
    for (int m = gw; m < T; m += NGW) rms_row_to_bf16(X + (size_t)m * D, g, XN + (size_t)m * D, lane);
}

__device__ __forceinline__ float logsigmoid_f(float f) { return fminf(f, 0.f) - log1pf(__expf(-fabsf(f))); }
#define ML_LOAD(ci_) do { const size_t r_ = rowbase + (size_t)(ci_) * 64 + lane; \
    rq = *(const v4u*)(Q0 + r_ * 64 + 8 * w); rk = *(const v4u*)(K0 + r_ * 64 + 8 * w); rv0 = *(const v4u*)(V0 + r_ * 128 + 16 * w); rv1 = *(const v4u*)(V0 + r_ * 128 + 16 * w + 8); \
    const size_t gm_ = ((size_t)b * 4096 + (size_t)(ci_) * 64 + jr) * 32; rli = GATES[gm_ + (dir ? 16 : 0) + h]; rf = GATES[gm_ + (dir ? 24 : 8) + h]; } while (0)
__device__ __forceinline__ void mlstm_phase(const int wv, LAS unsigned char* lds, const bf16* Q0, const bf16* K0, const bf16* V0, const float* GATES, bf16* HF, bf16* HB) {
    const int bx = blockIdx.x;
    if ((bx >> 3) & 1) return;
    const int seq = (bx >> 4) * 8 + (bx & 7);
    const int dir = seq & 1, bh = seq >> 1, b = bh >> 3, h = bh & 7;
    int ln_; asm volatile("v_mbcnt_lo_u32_b32 %0, -1, 0\n\tv_mbcnt_hi_u32_b32 %0, -1, %0" : "=v"(ln_)); const int tid = wv * 64 + ln_, lane = tid & 63, w = wv, fr = lane & 15, fq = lane >> 4;
    LAS bf16* Qs = (LAS bf16*)(lds); LAS bf16* Ks = (LAS bf16*)(lds + 9216); LAS bf16* Kwt = (LAS bf16*)(lds + 18432); LAS bf16* Ps = (LAS bf16*)(lds + 27648);
    LAS bf16* Vt = (LAS bf16*)(lds + 36864 + w * 2304); LAS bf16* Cs = (LAS bf16*)(lds + 55296 + w * 2304); LAS bf16* nb = (LAS bf16*)(lds + 73728 + w * 128);
    LAS float* gc = (LAS float*)(lds + 74752 + w * 1280); LAS float* gM = gc + 64; LAS float* gI = gc + 128; LAS float* gE = gc + 192; LAS float* gW = gc + 256;
    for (int i = lane; i < 2304 / 4; i += 64) ((LAS unsigned*)Cs)[i] = 0u;
    if (lane < 32) ((LAS unsigned*)nb)[lane] = 0u;
    f32x4 Cacc[4], Nacc[4];
#pragma unroll
    for (int i = 0; i < 4; ++i) { Cacc[i] = (f32x4){0.f, 0.f, 0.f, 0.f}; Nacc[i] = (f32x4){0.f, 0.f, 0.f, 0.f}; }
    float m = -1e30f;
    bf16* Hout = dir ? HB : HF;
    const size_t rowbase = (size_t)bh * 4096;
    const int jr = dir ? 63 - lane : lane;
    v4u rq, rk, rv0, rv1; float rli, rf;
    ML_LOAD(dir ? 63 : 0);
    const bf16x8 ones = (bf16x8){0x3F80, 0x3F80, 0x3F80, 0x3F80, 0x3F80, 0x3F80, 0x3F80, 0x3F80};
    const f32x4 z4 = (f32x4){0.f, 0.f, 0.f, 0.f};
#pragma unroll 1
    for (int step = 0; step < 64; ++step) {
        const int ci = dir ? 63 - step : step;
        const float lf = logsigmoid_f(rf);
        float bcs = lf;
#pragma unroll
        for (int d = 1; d < 64; d <<= 1) { const float t = __uint_as_float((unsigned)__builtin_amdgcn_ds_bpermute((lane - d) << 2, (int)__float_as_uint(bcs))); if (lane >= d) bcs += t; }
        const float c = rli - bcs;
        float pm = c;
#pragma unroll
        for (int d = 1; d < 64; d <<= 1) { const float t = __uint_as_float((unsigned)__builtin_amdgcn_ds_bpermute((lane - d) << 2, (int)__float_as_uint(pm))); if (lane >= d) pm = fmaxf(pm, t); }
        const float M = fmaxf(m, pm);
        const float bL = __uint_as_float((unsigned)__builtin_amdgcn_readlane((int)__float_as_uint(bcs), 63)), Mlast = __uint_as_float((unsigned)__builtin_amdgcn_readlane((int)__float_as_uint(M), 63));
        gc[jr] = c; gM[jr] = M; gI[jr] = __expf(m - M); gE[jr] = __expf(-(bcs + M)); gW[jr] = __expf(c - Mlast);
        const float sp = __expf(m - Mlast), m_new = bL + Mlast;
        const float wr_ = gW[lane];
        *(LAS v4u*)(Qs + lane * 72 + 8 * w) = rq; *(LAS v4u*)(Ks + lane * 72 + 8 * w) = rk;
#pragma unroll
        for (int i = 0; i < 4; ++i) { const unsigned kw = rk[i]; Kwt[(8 * w + 2 * i) * 72 + lane] = (bf16)f2bf(bf_lo(kw) * wr_); Kwt[(8 * w + 2 * i + 1) * 72 + lane] = (bf16)f2bf(bf_hi(kw) * wr_); }
#pragma unroll
        for (int i = 0; i < 4; ++i) { Vt[(2 * i) * 72 + lane] = (bf16)(rv0[i] & 0xffffu); Vt[(2 * i + 1) * 72 + lane] = (bf16)(rv0[i] >> 16);
                                      Vt[(8 + 2 * i) * 72 + lane] = (bf16)(rv1[i] & 0xffffu); Vt[(9 + 2 * i) * 72 + lane] = (bf16)(rv1[i] >> 16); }
        __syncthreads();
        if (step < 63) ML_LOAD(dir ? 62 - step : step + 1);
        {
            const int st = w >> 1;
            const bf16x8 a0 = *(const LAS bf16x8*)(Ks + (16 * st + fr) * 72 + 8 * fq), a1 = *(const LAS bf16x8*)(Ks + (16 * st + fr) * 72 + 32 + 8 * fq);
#pragma unroll
            for (int u = 0; u < 2; ++u) { const int tt = 2 * (w & 1) + u;
                const bf16x8 b0 = *(const LAS bf16x8*)(Qs + (16 * tt + fr) * 72 + 8 * fq), b1 = *(const LAS bf16x8*)(Qs + (16 * tt + fr) * 72 + 32 + 8 * fq);
                f32x4 acc = mfma16(a0, b0, z4); acc = mfma16(a1, b1, acc);
                const int t = 16 * tt + fr; const float Mt = gM[t]; float pv[4];
#pragma unroll
                for (int i = 0; i < 4; ++i) { const int s = 16 * st + 4 * fq + i; const bool valid = dir ? (s >= t) : (s <= t); const float e = __expf(gc[s] - Mt); pv[i] = valid ? acc[i] * e : 0.f; }
                *(LAS u32x2*)(Ps + t * 72 + 16 * st + 4 * fq) = pack4(pv[0], pv[1], pv[2], pv[3]); }
        }
        __syncthreads();
        const bf16x8 aV0 = *(const LAS bf16x8*)(Vt + fr * 72 + 8 * fq), aV1 = *(const LAS bf16x8*)(Vt + fr * 72 + 32 + 8 * fq);
        {
            const bf16x8 aC0 = *(const LAS bf16x8*)(Cs + fr * 72 + 8 * fq), aC1 = *(const LAS bf16x8*)(Cs + fr * 72 + 32 + 8 * fq);
            const bf16x8 aN0 = *(const LAS bf16x8*)(nb + 8 * fq), aN1 = *(const LAS bf16x8*)(nb + 32 + 8 * fq);
#pragma unroll
            for (int tt = 0; tt < 4; ++tt) {
                const bf16x8 bP0 = *(const LAS bf16x8*)(Ps + (16 * tt + fr) * 72 + 8 * fq), bP1 = *(const LAS bf16x8*)(Ps + (16 * tt + fr) * 72 + 32 + 8 * fq);
                const bf16x8 bQ0 = *(const LAS bf16x8*)(Qs + (16 * tt + fr) * 72 + 8 * fq), bQ1 = *(const LAS bf16x8*)(Qs + (16 * tt + fr) * 72 + 32 + 8 * fq);
                f32x4 acc1 = mfma16(aV0, bP0, z4); acc1 = mfma16(aV1, bP1, acc1);
                f32x4 acc2 = mfma16(aC0, bQ0, z4); acc2 = mfma16(aC1, bQ1, acc2);
                f32x4 d1 = mfma16(ones, bP0, z4); d1 = mfma16(ones, bP1, d1);
                f32x4 d2 = mfma16(aN0, bQ0, z4); d2 = mfma16(aN1, bQ1, d2);
                const int t = 16 * tt + fr; const float it = gI[t], en = gE[t];
                const float den = d1[0] + it * d2[0]; const float inv = 1.f / fmaxf(fabsf(den), en);
                *(u32x2*)(Hout + ((size_t)b * 4096 + (size_t)ci * 64 + t) * 1024 + h * 128 + 16 * w + 4 * fq) =
                    pack4((acc1[0] + it * acc2[0]) * inv, (acc1[1] + it * acc2[1]) * inv, (acc1[2] + it * acc2[2]) * inv, (acc1[3] + it * acc2[3]) * inv);
            }
        }
#pragma unroll
        for (int dt = 0; dt < 4; ++dt) { Cacc[dt] = Cacc[dt] * sp; Nacc[dt] = Nacc[dt] * sp;
            const bf16x8 aK0 = *(const LAS bf16x8*)(Kwt + (16 * dt + fr) * 72 + 8 * fq), aK1 = *(const LAS bf16x8*)(Kwt + (16 * dt + fr) * 72 + 32 + 8 * fq);
            Cacc[dt] = mfma16(aK0, aV0, Cacc[dt]); Cacc[dt] = mfma16(aK1, aV1, Cacc[dt]);
            Nacc[dt] = mfma16(aK0, ones, Nacc[dt]); Nacc[dt] = mfma16(aK1, ones, Nacc[dt]); }
#pragma unroll
        for (int dt = 0; dt < 4; ++dt) { *(LAS u32x2*)(Cs + fr * 72 + 16 * dt + 4 * fq) = pack4(Cacc[dt][0], Cacc[dt][1], Cacc[dt][2], Cacc[dt][3]);
                                         *(LAS u32x2*)(nb + 16 * dt + 4 * fq) = pack4(Nacc[dt][0], Nacc[dt][1], Nacc[dt][2], Nacc[dt][3]); }
        m = m_new;
        __syncthreads();
    }
}
#undef ML_LOAD

__device__ __forceinline__ void hs_pass(const bf16* HF, const bf16* HB, const bf16* OG, const float* hg, bf16* HS, int gw, int NGW, int lane) {
    for (int m = gw; m < T; m += NGW) {
        const size_t off = (size_t)m * 1024 + 16 * lane;
        const v4u f0 = *(const v4u*)(HF + off), f1 = *(const v4u*)(HF + off + 8), b0 = *(const v4u*)(HB + off), b1 = *(const v4u*)(HB + off + 8), o0 = *(const v4u*)(OG + off), o1 = *(const v4u*)(OG + off + 8);
        float x[16], og[16];
#pragma unroll
        for (int i = 0; i < 4; ++i) { x[2 * i] = bf_lo(f0[i]) + bf_lo(b0[i]); x[2 * i + 1] = bf_hi(f0[i]) + bf_hi(b0[i]); x[8 + 2 * i] = bf_lo(f1[i]) + bf_lo(b1[i]); x[9 + 2 * i] = bf_hi(f1[i]) + bf_hi(b1[i]);
                                      og[2 * i] = bf_lo(o0[i]); og[2 * i + 1] = bf_hi(o0[i]); og[8 + 2 * i] = bf_lo(o1[i]); og[9 + 2 * i] = bf_hi(o1[i]); }
        float ss = 0.f;
#pragma unroll
        for (int i = 0; i < 16; ++i) ss += x[i] * x[i];
        ss += shx(ss, lane, 1); ss += shx(ss, lane, 2); ss += shx(ss, lane, 4);
        const float rstd = rsqrtf(ss * (1.f / 128.f) + EPS);
        float y[16];
#pragma unroll
        for (int i = 0; i < 16; ++i) y[i] = x[i] * rstd * hg[16 * lane + i] * (1.f / (1.f + __expf(-og[i])));
        v4u w0, w1;
#pragma unroll
        for (int i = 0; i < 4; ++i) { w0[i] = pk2(y[2 * i], y[2 * i + 1]); w1[i] = pk2(y[8 + 2 * i], y[9 + 2 * i]); }
        *(v4u*)(HS + off) = w0; *(v4u*)(HS + off + 8) = w1;
    }
}

#define TK_CE(a, b) do { const float h_ = fmaxf(a, b), l_ = fminf(a, b); a = h_; b = l_; } while (0)
#define BITONIC_MERGE16(x) do { _Pragma("unroll") for (int d_ = 8; d_ >= 1; d_ >>= 1) { _Pragma("unroll") for (int i_ = 0; i_ < 16; ++i_) if ((i_ & d_) == 0) TK_CE(x[i_], x[i_ + d_]); } } while (0)
#define BITONIC_SORT16(x) do { _Pragma("unroll") for (int k_ = 2; k_ <= 16; k_ <<= 1) { _Pragma("unroll") for (int d_ = k_ >> 1; d_ >= 1; d_ >>= 1) { _Pragma("unroll") for (int i_ = 0; i_ < 16; ++i_) { const int l_i = i_ ^ d_; \
    if (l_i > i_) { if ((i_ & k_) == 0 || k_ == 16) TK_CE(x[i_], x[l_i]); else TK_CE(x[l_i], x[i_]); } } } } } while (0)
#define TK_INSERT(v, x) do { float c_ = (x); _Pragma("unroll") for (int j_ = 0; j_ < 16; ++j_) { const float h_ = fmaxf(v[j_], c_); c_ = fminf(v[j_], c_); v[j_] = h_; } } while (0)
__device__ __forceinline__ void peer_topk_phase(const int wv, int vcu, const bf16* PQ, const bf16* KEYS, int* EXPERTS, float* GATESP) {
    int ln_; asm volatile("v_mbcnt_lo_u32_b32 %0, -1, 0\n\tv_mbcnt_hi_u32_b32 %0, -1, %0" : "=v"(ln_)); const int tid = wv * 64 + ln_, lane = tid & 63, w = wv, r32 = lane & 31, hi = lane >> 5;
    const int t = vcu * 128 + (w & 3) * 32 + r32, hg = w >> 2;
    const float NINF = -INFINITY;
#pragma unroll 1
    for (int hh = 0; hh < 4; ++hh) {
        const int head = hg * 4 + hh;
        float L0[16], L1[16];
#pragma unroll
        for (int j = 0; j < 16; ++j) { L0[j] = 0.f; L1[j] = 0.f; }
#pragma unroll 1
        for (int p = 0; p < 2; ++p) {
            const int hp = head * 2 + p;
            bf16x8 bq[8];
#pragma unroll
            for (int ks = 0; ks < 8; ++ks) bq[ks] = *(const bf16x8*)(PQ + (size_t)t * 2048 + head * 256 + p * 128 + ks * 16 + 8 * hi);
            f32x16 acc[4];
#pragma unroll
            for (int nt = 0; nt < 4; ++nt) {
#pragma unroll
                for (int r = 0; r < 16; ++r) acc[nt][r] = 0.f;
#pragma unroll
                for (int ks = 0; ks < 8; ++ks) { const bf16x8 a = *(const bf16x8*)(KEYS + ((size_t)(hp * 128 + nt * 32 + r32)) * 128 + ks * 16 + 8 * hi); acc[nt] = mfma32(a, bq[ks], acc[nt]); }
            }
            float v[16];
            {
                float blk[4][16];
#pragma unroll
                for (int nt = 0; nt < 4; ++nt)
#pragma unroll
                    for (int r = 0; r < 16; ++r) { const int n = nt * 32 + (r & 3) + 8 * (r >> 2) + 4 * hi; blk[nt][r] = __uint_as_float((__float_as_uint(acc[nt][r]) & ~0x7Fu) | (unsigned)(127 - n)); }
#pragma unroll
                for (int nt = 0; nt < 4; ++nt) BITONIC_SORT16(blk[nt]);
#pragma unroll
                for (int i = 0; i < 16; ++i) { blk[0][i] = fmaxf(blk[0][i], blk[1][15 - i]); blk[2][i] = fmaxf(blk[2][i], blk[3][15 - i]); }
                BITONIC_MERGE16(blk[0]); BITONIC_MERGE16(blk[2]);
#pragma unroll
                for (int i = 0; i < 16; ++i) v[i] = fmaxf(blk[0][i], blk[2][15 - i]);
                BITONIC_MERGE16(v);
            }
            {
                float wv_[16];
#pragma unroll
                for (int j = 0; j < 16; ++j) wv_[j] = shx(v[15 - j], lane, 32);
#pragma unroll
                for (int j = 0; j < 16; ++j) v[j] = fmaxf(v[j], wv_[j]);
                BITONIC_MERGE16(v);
            }
            if (p == 0) {
#pragma unroll
                for (int j = 0; j < 16; ++j) L0[j] = v[j];
            } else {
#pragma unroll
                for (int j = 0; j < 16; ++j) L1[j] = v[j];
            }
        }
        float tv[16];
        unsigned IA[4] = {0u, 0u, 0u, 0u}, IB[4] = {0u, 0u, 0u, 0u};
#pragma unroll
        for (int i = 0; i < 16; ++i) { IA[i >> 2] |= (127u - (__float_as_uint(L0[i]) & 0x7Fu)) << (8 * (i & 3)); IB[i >> 2] |= (127u - (__float_as_uint(L1[i]) & 0x7Fu)) << (8 * (i & 3)); }
        {
            float cb[4][16]; int cn = 0;
#pragma unroll
            for (int i = 0; i < 16; ++i) {
                const float va = __uint_as_float(__float_as_uint(L0[i]) & ~0x7Fu);
#pragma unroll
                for (int j = 0; j < 16; ++j) if ((i + 1) * (j + 1) <= 16) {
                    const float vb = __uint_as_float(__float_as_uint(L1[j]) & ~0x7Fu);
                    cb[cn >> 4][cn & 15] = __uint_as_float((__float_as_uint(va + vb) & ~0xFFu) | (unsigned)(255 - (i * 16 + j)));
                    ++cn;
                }
            }
#pragma unroll
            for (int c = 50; c < 64; ++c) cb[c >> 4][c & 15] = NINF;
#pragma unroll
            for (int nt = 0; nt < 4; ++nt) BITONIC_SORT16(cb[nt]);
#pragma unroll
            for (int i = 0; i < 16; ++i) { cb[0][i] = fmaxf(cb[0][i], cb[1][15 - i]); cb[2][i] = fmaxf(cb[2][i], cb[3][15 - i]); }
            BITONIC_MERGE16(cb[0]); BITONIC_MERGE16(cb[2]);
#pragma unroll
            for (int i = 0; i < 16; ++i) tv[i] = fmaxf(cb[0][i], cb[2][15 - i]);
            BITONIC_MERGE16(tv);
        }
        int ti[16];
#pragma unroll
        for (int j = 0; j < 16; ++j) { const unsigned kb = __float_as_uint(tv[j]); const unsigned flat = 255u - (kb & 0xFFu); const unsigned fi = flat >> 4, fj = flat & 15u;
            const unsigned ra = (fi < 8u) ? ((fi < 4u) ? IA[0] : IA[1]) : ((fi < 12u) ? IA[2] : IA[3]);
            const unsigned rb = (fj < 8u) ? ((fj < 4u) ? IB[0] : IB[1]) : ((fj < 12u) ? IB[2] : IB[3]);
            ti[j] = (int)(((ra >> (8u * (fi & 3u))) & 0xFFu) * 128u + ((rb >> (8u * (fj & 3u))) & 0xFFu));
            tv[j] = __uint_as_float(kb & ~0xFFu); }
        float e[16], sum = 0.f;
#pragma unroll
        for (int j = 0; j < 16; ++j) { e[j] = __expf(tv[j] - tv[0]); sum += e[j]; }
        const float inv = 1.f / sum;
        if (hi == 0) { int* ep = EXPERTS + (size_t)t * 128 + head * 16;
#pragma unroll
            for (int j = 0; j < 4; ++j) *(v4u*)(ep + 4 * j) = (v4u){(unsigned)ti[4 * j], (unsigned)ti[4 * j + 1], (unsigned)ti[4 * j + 2], (unsigned)ti[4 * j + 3]}; }
        else { float* gp = GATESP + (size_t)t * 128 + head * 16;
#pragma unroll
            for (int j = 0; j < 4; ++j) *(f32x4*)(gp + 4 * j) = (f32x4){e[4 * j] * inv, e[4 * j + 1] * inv, e[4 * j + 2] * inv, e[4 * j + 3] * inv}; }
    }
}

__device__ __forceinline__ float cvt_ub0(unsigned x) { float r; asm("v_cvt_f32_ubyte0 %0, %1" : "=v"(r) : "v"(x)); return r; }
__device__ __forceinline__ float cvt_ub1(unsigned x) { float r; asm("v_cvt_f32_ubyte1 %0, %1" : "=v"(r) : "v"(x)); return r; }
__device__ __forceinline__ float cvt_ub2(unsigned x) { float r; asm("v_cvt_f32_ubyte2 %0, %1" : "=v"(r) : "v"(x)); return r; }
__device__ __forceinline__ float cvt_ub3(unsigned x) { float r; asm("v_cvt_f32_ubyte3 %0, %1" : "=v"(r) : "v"(x)); return r; }
__device__ __forceinline__ void quant4_rows(const float* src, unsigned char* dst, float* scale, int nrows, int gw, int NGW, int lane) {
    for (int r = gw; r < nrows; r += NGW) {
        const f32x4* sp = (const f32x4*)(src + (size_t)r * 1024) + 4 * lane;
        f32x4 v[4]; float am = 0.f, ss = 0.f;
#pragma unroll
        for (int j = 0; j < 4; ++j) { v[j] = sp[j]; am = fmaxf(am, fmaxf(fmaxf(fabsf(v[j].x), fabsf(v[j].y)), fmaxf(fabsf(v[j].z), fabsf(v[j].w)))); ss += (v[j].x * v[j].x + v[j].y * v[j].y) + (v[j].z * v[j].z + v[j].w * v[j].w); }
#pragma unroll
        for (int o = 1; o < 64; o <<= 1) { am = fmaxf(am, shx(am, lane, o)); ss += shx(ss, lane, o); }
        const float step = fminf(am * (1.f / 7.5f), 0.3352f * sqrtf(ss * (1.f / 1024.f)));
        const float inv = step > 0.f ? 1.f / step : 0.f;
        unsigned q[16];
#pragma unroll
        for (int j = 0; j < 4; ++j) { q[4 * j] = (unsigned)fminf(fmaxf(rintf(v[j].x * inv + 7.5f), 0.f), 15.f); q[4 * j + 1] = (unsigned)fminf(fmaxf(rintf(v[j].y * inv + 7.5f), 0.f), 15.f);
                                      q[4 * j + 2] = (unsigned)fminf(fmaxf(rintf(v[j].z * inv + 7.5f), 0.f), 15.f); q[4 * j + 3] = (unsigned)fminf(fmaxf(rintf(v[j].w * inv + 7.5f), 0.f), 15.f); }
        u32x2 w;
        w.x = (q[0] | (q[4] << 4)) | ((q[1] | (q[5] << 4)) << 8) | ((q[2] | (q[6] << 4)) << 16) | ((q[3] | (q[7] << 4)) << 24);
        w.y = (q[8] | (q[12] << 4)) | ((q[9] | (q[13] << 4)) << 8) | ((q[10] | (q[14] << 4)) << 16) | ((q[11] | (q[15] << 4)) << 24);
        *(u32x2*)(dst + (size_t)r * 512 + 8 * lane) = w;
        if (lane == 0) scale[r] = step;
    }
}

#define RED_STEP(N, S) do { const bool up_ = (lane & (S)) != 0; _Pragma("unroll") for (int j_ = 0; j_ < (N); ++j_) { const int a_ = p[j_], b_ = p[j_ + (N)]; const int send_ = up_ ? a_ : b_, keep_ = up_ ? b_ : a_; p[j_] = keep_ + shxi(send_, lane, (S)); } } while (0)
#define RED16(dst) do { RED_STEP(8, 8); RED_STEP(4, 4); RED_STEP(2, 2); RED_STEP(1, 1); int s_ = p[0]; s_ += shxi(s_, lane, 16); s_ += shxi(s_, lane, 32); dst = s_; } while (0)
#define G_SB() __builtin_amdgcn_sched_barrier(0)
#define G_LOAD(buf, tab, evec, jb) do { _Pragma("unroll") for (int jj_ = 0; jj_ < 16; ++jj_) { const int e_ = __builtin_amdgcn_readlane(evec, (jb) + jj_); buf[jj_] = __builtin_amdgcn_raw_buffer_load_b64(rs_##tab, (int)voff, e_ << 9, 0); } } while (0)
#define U_COMP(buf) do { _Pragma("unroll") for (int jj_ = 0; jj_ < 16; ++jj_) { const unsigned w0_ = buf[jj_].x, w1_ = buf[jj_].y; \
    int d_ = __builtin_amdgcn_sdot4((int)(w0_ & 0x0F0F0F0Fu), hq[0], 0, false); d_ = __builtin_amdgcn_sdot4((int)((w0_ >> 4) & 0x0F0F0F0Fu), hq[1], d_, false); \
    d_ = __builtin_amdgcn_sdot4((int)(w1_ & 0x0F0F0F0Fu), hq[2], d_, false); d_ = __builtin_amdgcn_sdot4((int)((w1_ >> 4) & 0x0F0F0F0Fu), hq[3], d_, false); p[jj_] = d_; } } while (0)
#define V_DW(o0, o1, o2, o3, wd, cs) do { float t0_, t1_, t2_, t3_; asm volatile("v_cvt_f32_ubyte0 %4, %8\n\tv_cvt_f32_ubyte1 %5, %8\n\tv_cvt_f32_ubyte2 %6, %8\n\tv_cvt_f32_ubyte3 %7, %8\n\tv_fmac_f32 %0, %9, %4\n\tv_fmac_f32 %1, %9, %5\n\tv_fmac_f32 %2, %9, %6\n\tv_fmac_f32 %3, %9, %7" \
    : "+v"(o0), "+v"(o1), "+v"(o2), "+v"(o3), "=&v"(t0_), "=&v"(t1_), "=&v"(t2_), "=&v"(t3_) : "v"(wd), "s"(cs)); } while (0)
#define V_COMP(buf, cvec, jb) do { _Pragma("unroll") for (int jj_ = 0; jj_ < 16; ++jj_) { const float c_ = __uint_as_float(__builtin_amdgcn_readlane(__float_as_uint(cvec), (jb) + jj_)); const unsigned w0_ = buf[jj_].x, w1_ = buf[jj_].y; \
    V_DW(o[0], o[1], o[2], o[3], w0_ & 0x0F0F0F0Fu, c_); V_DW(o[4], o[5], o[6], o[7], (w0_ >> 4) & 0x0F0F0F0Fu, c_); V_DW(o[8], o[9], o[10], o[11], w1_ & 0x0F0F0F0Fu, c_); V_DW(o[12], o[13], o[14], o[15], (w1_ >> 4) & 0x0F0F0F0Fu, c_); } } while (0)
template <bool NEXT_NORM>
__device__ __forceinline__ void peer_gather_phase(const int wv, bool dry, int vcu, const bf16* HN, const int* EXPERTS, const float* GATESP, const unsigned char* U, const float* SU, const unsigned char* Vtab, const float* SV,
                                                  float* X, const float* gnext, bf16* XN) {
    int ln_; asm volatile("v_mbcnt_lo_u32_b32 %0, -1, 0\n\tv_mbcnt_hi_u32_b32 %0, -1, %0" : "=v"(ln_)); const int tid = wv * 64 + ln_, lane = tid & 63, w = wv;
    const __amdgpu_buffer_rsrc_t rs_U = __builtin_amdgcn_make_buffer_rsrc((void*)U, (short)0, 16384 * 512, 0x00020000), rs_Vtab = __builtin_amdgcn_make_buffer_rsrc((void*)Vtab, (short)0, 16384 * 512, 0x00020000);
    const unsigned voff = (unsigned)lane * 8u;
    const int lg = lane >> 4;
#pragma unroll 1
    for (int i = 0; i < 16; ++i) {
        const int t = vcu * 128 + w * 16 + i;
        const int ev0 = EXPERTS[(size_t)t * 128 + lane], ev1 = EXPERTS[(size_t)t * 128 + 64 + lane];
        const float gv0 = GATESP[(size_t)t * 128 + lane], gv1 = GATESP[(size_t)t * 128 + 64 + lane];
        const v4u h0 = *(const v4u*)(HN + (size_t)t * 1024 + 16 * lane), h1 = *(const v4u*)(HN + (size_t)t * 1024 + 16 * lane + 8);
        float hf[16]; float am = 0.f;
#pragma unroll
        for (int k = 0; k < 4; ++k) { hf[2 * k] = bf_lo(h0[k]); hf[2 * k + 1] = bf_hi(h0[k]); hf[8 + 2 * k] = bf_lo(h1[k]); hf[9 + 2 * k] = bf_hi(h1[k]); }
#pragma unroll
        for (int k = 0; k < 16; ++k) am = fmaxf(am, fabsf(hf[k]));
#pragma unroll
        for (int o = 1; o < 64; o <<= 1) am = fmaxf(am, shx(am, lane, o));
        const float hinv = am > 0.f ? 127.f / am : 0.f, sh = am * (1.f / 127.f);
        int hq[4]; int hs = 0;
#pragma unroll
        for (int k = 0; k < 4; ++k) { const int q0 = (int)rintf(hf[4 * k] * hinv), q1 = (int)rintf(hf[4 * k + 1] * hinv), q2 = (int)rintf(hf[4 * k + 2] * hinv), q3 = (int)rintf(hf[4 * k + 3] * hinv); hs += (q0 + q1) + (q2 + q3);
            hq[k] = (int)(((unsigned)(q0 & 0xff)) | ((unsigned)(q1 & 0xff) << 8) | ((unsigned)(q2 & 0xff) << 16) | ((unsigned)(q3 & 0xff) << 24)); }
#pragma unroll
        for (int o = 1; o < 64; o <<= 1) hs += shxi(hs, lane, o);
        const float hoff = 7.5f * (float)hs;
        const float su0 = SU[ev0], su1 = SU[ev1], sv0 = SV[ev0], sv1 = SV[ev1];
        float o[16];
#pragma unroll
        for (int k = 0; k < 16; ++k) o[k] = 0.f;
        int p[16], r0, r1, r2, r3, r4, r5, r6, r7;
        u32x2 A[16], B[16], C[16];
        G_LOAD(A, U, ev0, 0); G_LOAD(B, U, ev0, 16); G_SB();
        G_LOAD(C, U, ev0, 32); G_SB(); U_COMP(A); RED16(r0); G_SB();
        G_LOAD(A, U, ev0, 48); G_SB(); U_COMP(B); RED16(r1); G_SB();
        G_LOAD(B, U, ev1, 0); G_SB(); U_COMP(C); RED16(r2); G_SB();
        G_LOAD(C, U, ev1, 16); G_SB(); U_COMP(A); RED16(r3); G_SB();
        G_LOAD(A, U, ev1, 32); G_SB(); U_COMP(B); RED16(r4); G_SB();
        G_LOAD(B, U, ev1, 48); G_SB(); U_COMP(C); RED16(r5); G_SB();
        G_LOAD(C, Vtab, ev0, 0); G_SB(); U_COMP(A); RED16(r6); G_SB();
        G_LOAD(A, Vtab, ev0, 16); G_SB(); U_COMP(B); RED16(r7); G_SB();
        const int d0 = lg == 0 ? r0 : (lg == 1 ? r1 : (lg == 2 ? r2 : r3)), d1 = lg == 0 ? r4 : (lg == 1 ? r5 : (lg == 2 ? r6 : r7));
        float act0 = ((float)d0 - hoff) * (sh * su0), act1 = ((float)d1 - hoff) * (sh * su1);
#ifdef PROBE_NOFFN
        const float coef0 = 0.f * act0, coef1 = 0.f * act1;
#else
        const float coef0 = gv0 * (0.5f * act0 * (1.f + erff(act0 * 0.70710678118f))) * sv0, coef1 = gv1 * (0.5f * act1 * (1.f + erff(act1 * 0.70710678118f))) * sv1;
#endif
        G_SB();
        G_LOAD(B, Vtab, ev0, 32); G_SB(); V_COMP(C, coef0, 0); G_SB();
        G_LOAD(C, Vtab, ev0, 48); G_SB(); V_COMP(A, coef0, 16); G_SB();
        G_LOAD(A, Vtab, ev1, 0); G_SB(); V_COMP(B, coef0, 32); G_SB();
        G_LOAD(B, Vtab, ev1, 16); G_SB(); V_COMP(C, coef0, 48); G_SB();
        G_LOAD(C, Vtab, ev1, 32); G_SB(); V_COMP(A, coef1, 0); G_SB();
        G_LOAD(A, Vtab, ev1, 48); G_SB(); V_COMP(B, coef1, 16); G_SB();
        V_COMP(C, coef1, 32); G_SB(); V_COMP(A, coef1, 48); G_SB();
        const float corr = 7.5f * wave_sum(coef0 + coef1, lane);
        float* xr = X + (size_t)t * 1024 + 16 * lane;
        f32x4 xv[4];
#pragma unroll
        for (int k = 0; k < 4; ++k) { xv[k] = *(const f32x4*)(xr + 4 * k); xv[k] += (f32x4){o[4 * k] - corr, o[4 * k + 1] - corr, o[4 * k + 2] - corr, o[4 * k + 3] - corr}; }
        if (!dry) {
#pragma unroll
            for (int k = 0; k < 4; ++k) *(f32x4*)(xr + 4 * k) = xv[k]; }
        if (NEXT_NORM && !dry) {
            float ss = 0.f;
#pragma unroll
            for (int k = 0; k < 4; ++k) ss += (xv[k].x * xv[k].x + xv[k].y * xv[k].y) + (xv[k].z * xv[k].z + xv[k].w * xv[k].w);
            const float rstd = rsqrtf(wave_sum(ss, lane) * (1.f / 1024.f) + EPS);
            v4u wa, wb;
#pragma unroll
            for (int k = 0; k < 4; ++k) { const f32x4 g = *(const f32x4*)(gnext + 16 * lane + 4 * k); const unsigned lo = pk2(xv[k].x * rstd * g.x, xv[k].y * rstd * g.y), hi2 = pk2(xv[k].z * rstd * g.z, xv[k].w * rstd * g.w);
                if (k < 2) { wa[2 * k] = lo; wa[2 * k + 1] = hi2; } else { wb[2 * (k - 2)] = lo; wb[2 * (k - 2) + 1] = hi2; } }
            *(v4u*)(XN + (size_t)t * 1024 + 16 * lane) = wa; *(v4u*)(XN + (size_t)t * 1024 + 16 * lane + 8) = wb;
        }
    }
}

__device__ __forceinline__ void rms_quant_pass(const float* X, const float* g, bf16* XN, unsigned char* HQ, float* SH, float* HS, int gw, int NGW, int lane) {
    for (int m = gw; m < T; m += NGW) {
        const f32x4* xr = (const f32x4*)(X + (size_t)m * D) + lane; const f32x4* gr = (const f32x4*)g + lane;
        f32x4 v[4]; float s = 0.f;
#pragma unroll
        for (int j = 0; j < 4; ++j) { v[j] = xr[64 * j]; s += (v[j].x * v[j].x + v[j].y * v[j].y) + (v[j].z * v[j].z + v[j].w * v[j].w); }
        const float rstd = rsqrtf(wave_sum(s, lane) * (1.f / 1024.f) + EPS);
        unsigned long long* o8 = (unsigned long long*)(XN + (size_t)m * D) + lane;
        float am = 0.f;
#pragma unroll
        for (int j = 0; j < 4; ++j) { const f32x4 gg = gr[64 * j]; v[j].x = v[j].x * rstd * gg.x; v[j].y = v[j].y * rstd * gg.y; v[j].z = v[j].z * rstd * gg.z; v[j].w = v[j].w * rstd * gg.w;
            o8[64 * j] = (unsigned long long)pk2(v[j].x, v[j].y) | ((unsigned long long)pk2(v[j].z, v[j].w) << 32);
            am = fmaxf(am, fmaxf(fmaxf(fabsf(v[j].x), fabsf(v[j].y)), fmaxf(fabsf(v[j].z), fabsf(v[j].w)))); }
#pragma unroll
        for (int o = 1; o < 64; o <<= 1) am = fmaxf(am, shx(am, lane, o));
        const float hinv = am > 0.f ? 127.f / am : 0.f;
        int hs = 0;
        unsigned* q4 = (unsigned*)(HQ + (size_t)m * D) + lane;
#pragma unroll
        for (int j = 0; j < 4; ++j) { const int q0 = (int)rintf(v[j].x * hinv), q1 = (int)rintf(v[j].y * hinv), q2 = (int)rintf(v[j].z * hinv), q3 = (int)rintf(v[j].w * hinv); hs += (q0 + q1) + (q2 + q3);
            q4[64 * j] = ((unsigned)(q0 & 0xff)) | ((unsigned)(q1 & 0xff) << 8) | ((unsigned)(q2 & 0xff) << 16) | ((unsigned)(q3 & 0xff) << 24); }
#pragma unroll
        for (int o = 1; o < 64; o <<= 1) hs += shxi(hs, lane, o);
        if (lane == 0) { SH[m] = am * (1.f / 127.f); HS[m] = (float)hs; }
    }
}
__device__ __forceinline__ int dpp_add_quad(int d) {
    d += __builtin_amdgcn_update_dpp(0, d, 0xB1, 0xF, 0xF, true);
    d += __builtin_amdgcn_update_dpp(0, d, 0x4E, 0xF, 0xF, true);
    return d;
}
__device__ __forceinline__ int dpp_add_oct(int d) {
    d += __builtin_amdgcn_update_dpp(0, d, 0xB1, 0xF, 0xF, true);
    d += __builtin_amdgcn_update_dpp(0, d, 0x4E, 0xF, 0xF, true);
    d += __builtin_amdgcn_update_dpp(0, d, 0x141, 0xF, 0xF, true);
    return d;
}
#define G1_IDS(E_, H0_, H1_, it_) do { const int t_ = t0 + ((it_) >> 1), hf_ = (it_) & 1; const v4u* ep_ = (const v4u*)(EXPERTS + (size_t)t_ * 128 + 16 * oct + 8 * hf_); const v4u ea_ = ep_[0], eb_ = ep_[1]; \
    E_[0] = (int)ea_.x; E_[1] = (int)ea_.y; E_[2] = (int)ea_.z; E_[3] = (int)ea_.w; E_[4] = (int)eb_.x; E_[5] = (int)eb_.y; E_[6] = (int)eb_.z; E_[7] = (int)eb_.w; \
    H0_ = *(const v4u*)(HQ + (size_t)t_ * 1024 + 256 * s + 32 * q8); H1_ = *(const v4u*)(HQ + (size_t)t_ * 1024 + 256 * s + 32 * q8 + 16); } while (0)
#define G1_ROWS(R_, E_) do { _Pragma("unroll") for (int j_ = 0; j_ < 8; ++j_) R_[j_] = __builtin_amdgcn_raw_buffer_load_b128(rs_U, (E_[j_] << 9) + soff, 0, 0); } while (0)
#define G1_COMP(R_, H0_, H1_, it_) do { int dd_[8]; _Pragma("unroll") for (int j_ = 0; j_ < 8; ++j_) { \
    int d_ = __builtin_amdgcn_sdot4((int)(R_[j_].x & 0x0F0F0F0Fu), (int)H0_.x, 0, false); d_ = __builtin_amdgcn_sdot4((int)((R_[j_].x >> 4) & 0x0F0F0F0Fu), (int)H0_.y, d_, false); \
    d_ = __builtin_amdgcn_sdot4((int)(R_[j_].y & 0x0F0F0F0Fu), (int)H0_.z, d_, false); d_ = __builtin_amdgcn_sdot4((int)((R_[j_].y >> 4) & 0x0F0F0F0Fu), (int)H0_.w, d_, false); \
    d_ = __builtin_amdgcn_sdot4((int)(R_[j_].z & 0x0F0F0F0Fu), (int)H1_.x, d_, false); d_ = __builtin_amdgcn_sdot4((int)((R_[j_].z >> 4) & 0x0F0F0F0Fu), (int)H1_.y, d_, false); \
    d_ = __builtin_amdgcn_sdot4((int)(R_[j_].w & 0x0F0F0F0Fu), (int)H1_.z, d_, false); d_ = __builtin_amdgcn_sdot4((int)((R_[j_].w >> 4) & 0x0F0F0F0Fu), (int)H1_.w, d_, false); \
    dd_[j_] = dpp_add_oct(d_); } \
    if (q8 == 0) { v4u* pp_ = (v4u*)(PART + ((size_t)s * T + t0 + ((it_) >> 1)) * 128 + 16 * oct + 8 * ((it_) & 1)); pp_[0] = (v4u){(unsigned)dd_[0], (unsigned)dd_[1], (unsigned)dd_[2], (unsigned)dd_[3]}; pp_[1] = (v4u){(unsigned)dd_[4], (unsigned)dd_[5], (unsigned)dd_[6], (unsigned)dd_[7]}; } } while (0)
__device__ __forceinline__ void peer_g1_phase(const int wv, int vcu, const unsigned char* HQ, const int* EXPERTS, const unsigned char* U, int* PART) {
    int ln_; asm volatile("v_mbcnt_lo_u32_b32 %0, -1, 0\n\tv_mbcnt_hi_u32_b32 %0, -1, %0" : "=v"(ln_)); const int lane = ln_, oct = lane >> 3, q8 = lane & 7;
    const int s = vcu >> 6;
    const __amdgpu_buffer_rsrc_t rs_U = __builtin_amdgcn_make_buffer_rsrc((void*)U, (short)0, 16384 * 512, 0x00020000);
    const int soff = 128 * s + 16 * q8;
    const int t0 = 512 * (vcu & 63) + 64 * wv;
    int eA[8], eB[8]; v4u rA[8], rB[8], hA0, hA1, hB0, hB1, hC0, hC1;
    G1_IDS(eA, hA0, hA1, 0); G1_ROWS(rA, eA); G1_IDS(eB, hB0, hB1, 1);
#pragma unroll 1
    for (int i = 0; i < 128; i += 2) {
        G1_ROWS(rB, eB); __builtin_amdgcn_sched_barrier(0);
        G1_IDS(eA, hC0, hC1, (i + 2) & 127); __builtin_amdgcn_sched_barrier(0);
        G1_COMP(rA, hA0, hA1, i); __builtin_amdgcn_sched_barrier(0);
        G1_ROWS(rA, eA); hA0 = hC0; hA1 = hC1; __builtin_amdgcn_sched_barrier(0);
        G1_IDS(eB, hC0, hC1, (i + 3) & 127); __builtin_amdgcn_sched_barrier(0);
        G1_COMP(rB, hB0, hB1, i + 1); __builtin_amdgcn_sched_barrier(0);
        hB0 = hC0; hB1 = hC1;
    }
}
__device__ __forceinline__ void peer_g1b_phase(const int* PART, const int* EXPERTS, const float* GATESP, const float* SU, const float* SV, const float* SH, const float* HS, unsigned char* COEFQ, float* SCT, float* CS, int gw, int NGW, int lane) {
    for (int t = gw; t < T; t += NGW) {
        const float sh = SH[t], hoff = 7.5f * HS[t];
        float cf[2]; float am = 0.f;
#pragma unroll
        for (int h2 = 0; h2 < 2; ++h2) {
            const size_t idx = (size_t)t * 128 + 64 * h2 + lane;
            int d = 0;
#pragma unroll
            for (int x = 0; x < 4; ++x) d += PART[(size_t)x * T * 128 + idx];
            const int ev = EXPERTS[idx];
            const float act = ((float)d - hoff) * (sh * SU[ev]);
            cf[h2] = GATESP[idx] * (0.5f * act * (1.f + erff(act * 0.70710678118f))) * SV[ev];
            am = fmaxf(am, fabsf(cf[h2]));
        }
#pragma unroll
        for (int o = 1; o < 64; o <<= 1) am = fmaxf(am, shx(am, lane, o));
        const float inv = am > 0.f ? 127.f / am : 0.f;
        const int q0 = (int)rintf(cf[0] * inv), q1 = (int)rintf(cf[1] * inv);
        COEFQ[(size_t)t * 128 + lane] = (unsigned char)(q0 & 0xff); COEFQ[(size_t)t * 128 + 64 + lane] = (unsigned char)(q1 & 0xff);
        int cs = q0 + q1;
#pragma unroll
        for (int o = 1; o < 64; o <<= 1) cs += shxi(cs, lane, o);
        if (lane == 0) { SCT[t] = am * (1.f / 127.f); CS[t] = (float)cs; }
    }
}
#define G2_IDS(E_, C_, it_) do { const int t_ = t0 + ((it_) >> 1), hf_ = (it_) & 1; const v4u* ep_ = (const v4u*)(EXPERTS + (size_t)t_ * 128 + 16 * oct + 8 * hf_); const v4u ea_ = ep_[0], eb_ = ep_[1]; \
    E_[0] = (int)ea_.x; E_[1] = (int)ea_.y; E_[2] = (int)ea_.z; E_[3] = (int)ea_.w; E_[4] = (int)eb_.x; E_[5] = (int)eb_.y; E_[6] = (int)eb_.z; E_[7] = (int)eb_.w; \
    C_ = *(const u32x2*)(COEFQ + (size_t)t_ * 128 + 16 * oct + 8 * hf_); } while (0)
#define G2_ROWS(R_, E_) do { _Pragma("unroll") for (int j_ = 0; j_ < 8; ++j_) R_[j_] = __builtin_amdgcn_raw_buffer_load_b128(rs_V, (E_[j_] << 9) + soff, 0, 0); } while (0)
#define G2_T4(ob, w0, w1, w2, w3, cq_) do { const unsigned a_ = __builtin_amdgcn_perm(w1, w0, 0x05010400u), b_ = __builtin_amdgcn_perm(w1, w0, 0x07030602u), c_ = __builtin_amdgcn_perm(w3, w2, 0x05010400u), d_ = __builtin_amdgcn_perm(w3, w2, 0x07030602u); \
    const unsigned y0_ = __builtin_amdgcn_perm(c_, a_, 0x05040100u), y1_ = __builtin_amdgcn_perm(c_, a_, 0x07060302u), y2_ = __builtin_amdgcn_perm(d_, b_, 0x05040100u), y3_ = __builtin_amdgcn_perm(d_, b_, 0x07060302u); \
    o[(ob)] = __builtin_amdgcn_sdot4((int)(y0_ & 0x0F0F0F0Fu), cq_, o[(ob)], false); o[(ob) + 4] = __builtin_amdgcn_sdot4((int)((y0_ >> 4) & 0x0F0F0F0Fu), cq_, o[(ob) + 4], false); \
    o[(ob) + 1] = __builtin_amdgcn_sdot4((int)(y1_ & 0x0F0F0F0Fu), cq_, o[(ob) + 1], false); o[(ob) + 5] = __builtin_amdgcn_sdot4((int)((y1_ >> 4) & 0x0F0F0F0Fu), cq_, o[(ob) + 5], false); \
    o[(ob) + 2] = __builtin_amdgcn_sdot4((int)(y2_ & 0x0F0F0F0Fu), cq_, o[(ob) + 2], false); o[(ob) + 6] = __builtin_amdgcn_sdot4((int)((y2_ >> 4) & 0x0F0F0F0Fu), cq_, o[(ob) + 6], false); \
    o[(ob) + 3] = __builtin_amdgcn_sdot4((int)(y3_ & 0x0F0F0F0Fu), cq_, o[(ob) + 3], false); o[(ob) + 7] = __builtin_amdgcn_sdot4((int)((y3_ >> 4) & 0x0F0F0F0Fu), cq_, o[(ob) + 7], false); } while (0)
#define G2_REDI(N, S) do { const bool up_ = (lane & (S)) != 0; _Pragma("unroll") for (int j_ = 0; j_ < (N); ++j_) { const int a_ = o[j_], b_ = o[j_ + (N)]; const int send_ = up_ ? a_ : b_, keep_ = up_ ? b_ : a_; o[j_] = keep_ + shxi(send_, lane, (S)); } } while (0)
#define G2_COMP(R_, C_, it_) do { int o[32]; _Pragma("unroll") for (int k_ = 0; k_ < 32; ++k_) o[k_] = 0; \
    G2_T4(0, R_[0].x, R_[1].x, R_[2].x, R_[3].x, (int)C_.x); G2_T4(8, R_[0].y, R_[1].y, R_[2].y, R_[3].y, (int)C_.x); G2_T4(16, R_[0].z, R_[1].z, R_[2].z, R_[3].z, (int)C_.x); G2_T4(24, R_[0].w, R_[1].w, R_[2].w, R_[3].w, (int)C_.x); \
    G2_T4(0, R_[4].x, R_[5].x, R_[6].x, R_[7].x, (int)C_.y); G2_T4(8, R_[4].y, R_[5].y, R_[6].y, R_[7].y, (int)C_.y); G2_T4(16, R_[4].z, R_[5].z, R_[6].z, R_[7].z, (int)C_.y); G2_T4(24, R_[4].w, R_[5].w, R_[6].w, R_[7].w, (int)C_.y); \
    G2_REDI(16, 8); G2_REDI(8, 16); G2_REDI(4, 32); \
    const int tt_ = t0 + ((it_) >> 1); const float sc_ = SCT[tt_], corr_ = ((it_) & 1) ? 0.f : 7.5f * CS[tt_]; f32x4* xp_ = (f32x4*)(X + (size_t)tt_ * 1024 + ocol); f32x4 xv_ = *xp_; \
    xv_.x += sc_ * ((float)o[0] - corr_); xv_.y += sc_ * ((float)o[1] - corr_); xv_.z += sc_ * ((float)o[2] - corr_); xv_.w += sc_ * ((float)o[3] - corr_); *xp_ = xv_; \
    if (NEXT && ((it_) & 1)) { *(u32x2*)(XB + (size_t)tt_ * 1024 + ocol) = (u32x2){pk2(xv_.x, xv_.y), pk2(xv_.z, xv_.w)}; \
        const float ss_ = wave_sum((xv_.x * xv_.x + xv_.y * xv_.y) + (xv_.z * xv_.z + xv_.w * xv_.w), lane); if (lane == 0) SS[(size_t)s * T + tt_] = ss_; } } while (0)
template <bool NEXT>
__device__ __forceinline__ void peer_g2_phase(const int wv, int vcu, const int* EXPERTS, const unsigned char* COEFQ, const float* SCT, const float* CS, const unsigned char* Vtab, float* X, bf16* XB, float* SS) {
    int ln_; asm volatile("v_mbcnt_lo_u32_b32 %0, -1, 0\n\tv_mbcnt_hi_u32_b32 %0, -1, %0" : "=v"(ln_)); const int lane = ln_, oct = lane >> 3, q8 = lane & 7;
    const int s = vcu >> 6;
    const __amdgpu_buffer_rsrc_t rs_V = __builtin_amdgcn_make_buffer_rsrc((void*)Vtab, (short)0, 16384 * 512, 0x00020000);
    const int soff = 128 * s + 16 * q8;
    const int ocol = 256 * s + 32 * q8 + 16 * ((lane >> 3) & 1) + 8 * ((lane >> 4) & 1) + 4 * ((lane >> 5) & 1);
    const int t0 = 512 * (vcu & 63) + 64 * wv;
    int eA[8], eB[8]; u32x2 cA, cB, cC; v4u rA[8], rB[8];
    G2_IDS(eA, cA, 0); G2_ROWS(rA, eA); G2_IDS(eB, cB, 1);
#pragma unroll 1
    for (int i = 0; i < 128; i += 2) {
        G2_ROWS(rB, eB); __builtin_amdgcn_sched_barrier(0);
        G2_IDS(eA, cC, (i + 2) & 127); __builtin_amdgcn_sched_barrier(0);
        G2_COMP(rA, cA, i); __builtin_amdgcn_sched_barrier(0);
        G2_ROWS(rA, eA); cA = cC; __builtin_amdgcn_sched_barrier(0);
        G2_IDS(eB, cC, (i + 3) & 127); __builtin_amdgcn_sched_barrier(0);
        G2_COMP(rB, cB, i + 1); __builtin_amdgcn_sched_barrier(0);
        cB = cC;
    }
}

__device__ __forceinline__ void qknorm_rope_pass(bf16* Q1, bf16* K1, const float* qg, const float* kg, const float* rope, size_t gtid, size_t gthreads) {
    const size_t NROWS = (size_t)2 * 64 * 2 * 4096;
    const int lane = (int)(gtid & 63);
    for (size_t id = gtid; id < NROWS * 8; id += gthreads) {
        const size_t rowg = id >> 3; const int part = (int)(id & 7);
        const bool isk = rowg >= NROWS / 2; const size_t row = isk ? rowg - NROWS / 2 : rowg;
        bf16* ptr = (isk ? K1 : Q1) + row * 64 + part * 8; const float* g = (isk ? kg : qg) + part * 8;
        const int s = (int)(row & 4095); const int bh = (int)(row >> 13); const int bidx = bh >> 3; const size_t mtok = (size_t)bidx * 4096 + s;
        const v4u raw = *(const v4u*)ptr;
        float x[8];
#pragma unroll
        for (int i = 0; i < 4; ++i) { x[2 * i] = bf_lo(raw[i]); x[2 * i + 1] = bf_hi(raw[i]); }
        float ss = 0.f;
#pragma unroll
        for (int i = 0; i < 8; ++i) ss += x[i] * x[i];
        ss += shx(ss, lane, 1); ss += shx(ss, lane, 2); ss += shx(ss, lane, 4);
        const float rstd = rsqrtf(ss * (1.f / 64.f) + EPS);
        float y[8], other[8];
#pragma unroll
        for (int i = 0; i < 8; ++i) y[i] = x[i] * rstd * g[i];
#pragma unroll
        for (int i = 0; i < 8; ++i) other[i] = shx(y[i], lane, 1);
        if (part < 2) { const float* cs = rope + mtok * 16;
#pragma unroll
            for (int i = 0; i < 8; ++i) { const float co = cs[i], si = cs[8 + i]; y[i] = (part == 0) ? (y[i] * co - other[i] * si) : (y[i] * co + other[i] * si); } }
        const float sc = isk ? 1.f : (0.125f * 1.44269504089f);
        v4u o;
#pragma unroll
        for (int i = 0; i < 4; ++i) o[i] = pk2(y[2 * i] * sc, y[2 * i + 1] * sc);
        *(v4u*)ptr = o;
    }
}

__device__ __forceinline__ void glds16(const void* gsrc, unsigned lds_dst) { unsigned keep;
    asm volatile("s_mov_b32 %0, m0\n\ts_mov_b32 m0, %2\n\ts_nop 0\n\tglobal_load_lds_dwordx4 %1, off\n\ts_mov_b32 m0, %0" : "=&s"(keep) : "v"(gsrc), "s"(lds_dst) : "memory"); }
#define AT_WAIT_BAR() asm volatile("s_waitcnt vmcnt(0) lgkmcnt(0)\n\ts_barrier" ::: "memory")
#define AT_DMA(kt_, slot_) do { \
    _Pragma("unroll") for (int i_ = 0; i_ < 2; ++i_) { const int row_ = 8 * w + (lane >> 3), ch_ = (lane & 7) ^ ((row_ >> 1) & 7); \
        glds16(K1 + ((size_t)((bh * 2 + i_) * 4096 + (kt_) * 64 + row_)) * 64 + ch_ * 8, (unsigned)__builtin_amdgcn_readfirstlane((int)(ldsb + (slot_) * 32768 + i_ * 8192 + w * 1024))); } \
    _Pragma("unroll") for (int i_ = 0; i_ < 2; ++i_) { const int row_ = 8 * w + 4 * i_ + (lane >> 4), ch_ = (lane & 15) ^ ((row_ & 3) << 2); \
        glds16(V1 + ((size_t)(bh * 4096 + (kt_) * 64 + row_)) * 128 + ch_ * 8, (unsigned)__builtin_amdgcn_readfirstlane((int)(ldsb + (slot_) * 32768 + 16384 + w * 2048 + i_ * 1024))); } } while (0)
typedef short v4i16_t __attribute__((ext_vector_type(4)));
__device__ __forceinline__ bf16x8 vtr8(const LAS bf16* p) {
    const v4i16_t lo = __builtin_amdgcn_ds_read_tr16_b64_v4i16((LAS v4i16_t*)p), hi = __builtin_amdgcn_ds_read_tr16_b64_v4i16((LAS v4i16_t*)(p + 8 * 128));
    return (bf16x8){lo[0], lo[1], lo[2], lo[3], hi[0], hi[1], hi[2], hi[3]};
}
template <bool OFFS>
__device__ __forceinline__ void attn_units(const int wv, LAS unsigned char* lds, int vcu, const bf16* Q1, const bf16* K1, const bf16* V1, bf16* O, const float* subln, float lam, float offs) {
    int ln_; asm volatile("v_mbcnt_lo_u32_b32 %0, -1, 0\n\tv_mbcnt_hi_u32_b32 %0, -1, %0" : "=v"(ln_)); const int tid = wv * 64 + ln_, lane = tid & 63, w = wv, r32 = lane & 31, hi = lane >> 5, qt = w & 3, c = w >> 2;
    LAS float* lbuf = (LAS float*)(lds + 135168 + w * 128);
    LAS float* Obuf = (LAS float*)lds;
    const unsigned ldsb = (unsigned)(uintptr_t)lds;
#pragma unroll 1
    for (int ui = 0; ui < 8; ++ui) {
        const int bh = (vcu >> 5) * 8 + ui, qb = vcu & 31, b = bh >> 3, h = bh & 7;
        bf16x8 bq[4];
#pragma unroll
        for (int ks = 0; ks < 4; ++ks) bq[ks] = *(const bf16x8*)(Q1 + ((size_t)((bh * 2 + c) * 4096 + qb * 128 + qt * 32 + r32)) * 64 + ks * 16 + 8 * hi);
        f32x16 Oa[4];
#pragma unroll
        for (int db = 0; db < 4; ++db)
#pragma unroll
            for (int r = 0; r < 16; ++r) Oa[db][r] = 0.f;
        float lsum = 0.f;
        AT_DMA(0, 0); AT_DMA(1, 1);
        AT_WAIT_BAR();
        const int kx0 = (r32 >> 1) & 7, kx1 = ((32 + r32) >> 1) & 7;
        const int vrow = 4 * hi + ((lane >> 2) & 3), vg = (lane >> 4) & 1, vp = lane & 3;
        f32x16 s0, s1;
        { const LAS unsigned char* Kc = lds + c * 8192;
#pragma unroll
          for (int r = 0; r < 16; ++r) { s0[r] = 0.f; s1[r] = 0.f; }
#pragma unroll
          for (int ks = 0; ks < 4; ++ks) { const bf16x8 a0 = *(const LAS bf16x8*)(Kc + r32 * 128 + (((2 * ks + hi) ^ kx0) << 4)), a1 = *(const LAS bf16x8*)(Kc + (32 + r32) * 128 + (((2 * ks + hi) ^ kx1) << 4));
              s0 = mfma32(a0, bq[ks], s0); s1 = mfma32(a1, bq[ks], s1); } }
        int b0 = 0, b1 = 1, b2 = 2;
#pragma unroll 1
        for (int kt = 0; kt < 64; ++kt) {
            if (kt + 2 < 64) AT_DMA(kt + 2, b2);
            const LAS unsigned char* Kc = lds + b1 * 32768 + c * 8192;
            const LAS unsigned char* Vb = lds + b0 * 32768 + 16384 + vrow * 256 + 8 * (vp & 1);
            f32x16 n0, n1;
#pragma unroll
            for (int r = 0; r < 16; ++r) { n0[r] = 0.f; n1[r] = 0.f; }
            bf16x8 ka[8];
#define AT_KLD(ks_) do { ka[2 * (ks_)] = *(const LAS bf16x8*)(Kc + r32 * 128 + (((2 * (ks_) + hi) ^ kx0) << 4)); ka[2 * (ks_) + 1] = *(const LAS bf16x8*)(Kc + (32 + r32) * 128 + (((2 * (ks_) + hi) ^ kx1) << 4)); } while (0)
            AT_KLD(0); AT_KLD(1);
            __builtin_amdgcn_sched_barrier(0);
#pragma unroll
            for (int ks = 0; ks < 4; ++ks) {
                n0 = mfma32(ka[2 * ks], bq[ks], n0);
#pragma unroll
                for (int r = 0; r < 4; ++r) s0[4 * ks + r] = __builtin_amdgcn_exp2f(OFFS ? s0[4 * ks + r] - offs : s0[4 * ks + r]);
                __builtin_amdgcn_sched_barrier(0);
                n1 = mfma32(ka[2 * ks + 1], bq[ks], n1);
                if (ks < 2) AT_KLD(ks + 2);
#pragma unroll
                for (int r = 0; r < 4; ++r) s1[4 * ks + r] = __builtin_amdgcn_exp2f(OFFS ? s1[4 * ks + r] - offs : s1[4 * ks + r]);
                __builtin_amdgcn_sched_barrier(0);
            }
#undef AT_KLD
            bf16x8 pa[4]; bf16x8 vf[4], vn[4];
#pragma unroll
            for (int db = 0; db < 4; ++db) vf[db] = vtr8((const LAS bf16*)(Vb + (((4 * db + 2 * vg + (vp >> 1)) ^ ((vrow & 3) << 2)) << 4)));
            float ls = 0.f;
            { v4u t0;
#pragma unroll
              for (int k = 0; k < 4; ++k) { t0[k] = pk2(s0[2 * k], s0[2 * k + 1]); ls += s0[2 * k] + s0[2 * k + 1]; }
              pa[0] = __builtin_bit_cast(bf16x8, t0); }
            __builtin_amdgcn_sched_barrier(0);
#pragma unroll
            for (int sp_ = 0; sp_ < 4; ++sp_) {
                if (sp_ < 3) {
#pragma unroll
                    for (int db = 0; db < 4; ++db) vn[db] = vtr8((const LAS bf16*)(Vb + (16 * (sp_ + 1)) * 256 + (((4 * db + 2 * vg + (vp >> 1)) ^ ((vrow & 3) << 2)) << 4)));
                }
#pragma unroll
                for (int db = 0; db < 4; ++db) Oa[db] = mfma32(pa[sp_], vf[db], Oa[db]);
                if (sp_ < 3) { v4u t0;
#pragma unroll
                    for (int k = 0; k < 4; ++k) { const float x0 = (sp_ == 0) ? s0[8 + 2 * k] : (sp_ == 1 ? s1[2 * k] : s1[8 + 2 * k]), x1 = (sp_ == 0) ? s0[9 + 2 * k] : (sp_ == 1 ? s1[2 * k + 1] : s1[9 + 2 * k]); t0[k] = pk2(x0, x1); ls += x0 + x1; }
                    pa[sp_ + 1] = __builtin_bit_cast(bf16x8, t0); }
                __builtin_amdgcn_sched_barrier(0);
                if (sp_ < 3) {
#pragma unroll
                    for (int db = 0; db < 4; ++db) vf[db] = vn[db];
                }
            }
            lsum += ls;
            s0 = n0; s1 = n1;
            { const int tb = b0; b0 = b1; b1 = b2; b2 = tb; }
            AT_WAIT_BAR();
        }
        lsum += shx(lsum, lane, 32);
        lbuf[r32] = lsum;
#pragma unroll
        for (int r = 0; r < 16; ++r) { const int qrow = (r & 3) + 8 * (r >> 2) + 4 * hi; const float inv = 1.f / lbuf[qrow];
#pragma unroll
            for (int db = 0; db < 4; ++db) Obuf[(c * 128 + qt * 32 + qrow) * 132 + 32 * db + r32] = Oa[db][r] * inv; }
        __syncthreads();
        { const int row = tid >> 2, qd = tid & 3;
          float dv[32]; float ss = 0.f;
#pragma unroll
          for (int k = 0; k < 8; ++k) { const f32x4 o0 = *(const LAS f32x4*)(Obuf + row * 132 + qd * 32 + 4 * k), o1 = *(const LAS f32x4*)(Obuf + (128 + row) * 132 + qd * 32 + 4 * k);
#pragma unroll
              for (int e = 0; e < 4; ++e) { const float d = o0[e] - lam * o1[e]; dv[4 * k + e] = d; ss += d * d; } }
          ss += shx(ss, lane, 1); ss += shx(ss, lane, 2);
          const float rstd = rsqrtf(ss * (1.f / 128.f) + EPS) * (1.f - LAMBDA_INIT);
          bf16* op = O + ((size_t)b * 4096 + qb * 128 + row) * 1024 + h * 128 + qd * 32;
#pragma unroll
          for (int k = 0; k < 4; ++k) { v4u o;
#pragma unroll
              for (int e = 0; e < 4; ++e) o[e] = pk2(dv[8 * k + 2 * e] * rstd * subln[qd * 32 + 8 * k + 2 * e], dv[8 * k + 2 * e + 1] * rstd * subln[qd * 32 + 8 * k + 2 * e + 1]);
              *(v4u*)(op + 8 * k) = o; } }
        __syncthreads();
    }
}
__device__ __forceinline__ void attn_phase(const int wv, LAS unsigned char* lds, int vcu, const bf16* Q1, const bf16* K1, const bf16* V1, bf16* O, const float* qg, const float* kg,
                                           const float* lq1, const float* lk1, const float* lq2, const float* lk2, const float* subln) {
    float s1 = 0.f, s2 = 0.f, mq = 0.f, mk = 0.f;
    for (int i = 0; i < 64; ++i) { s1 += lq1[i] * lk1[i]; s2 += lq2[i] * lk2[i]; mq = fmaxf(mq, fabsf(qg[i])); mk = fmaxf(mk, fabsf(kg[i])); }
    const float lam = expf(s1) - expf(s2) + LAMBDA_INIT;
    const float offs = 8.f * mq * mk * 1.44269504089f * 1.02f + 0.25f;
    if (offs < 24.f) attn_units<false>(wv, lds, vcu, Q1, K1, V1, O, subln, lam, 0.f);
    else attn_units<true>(wv, lds, vcu, Q1, K1, V1, O, subln, lam, offs);
}
#undef AT_LOAD
#undef AT_WRITE
struct Args { const void* in[27]; float* out; unsigned char* ws; };
#define KARG(i) ({ GAS const void* p_; asm volatile("s_load_dwordx2 %0, %1, %2\n\ts_waitcnt lgkmcnt(0)" : "=s"(p_) : "s"(__builtin_amdgcn_kernarg_segment_ptr()), "i"(8 * (i))); (const void*)p_; })
#define KIN(i) ((const float*)KARG(i))
#define KOUT() ((float*)KARG(27))
#define KWS() ((unsigned char*)KARG(28))
#define WSP(T_, off) ((T_*)(KWS() + (off)))
__global__ void __launch_bounds__(NWAVES * 64, 2) mk_fwd(Args args) {
    extern __shared__ __attribute__((aligned(16))) unsigned char lds_raw[];
    LAS unsigned char* lds = (LAS unsigned char*)lds_raw;
    const int G = gridDim.x, bx = blockIdx.x;
    const int wv = __builtin_amdgcn_readfirstlane((int)(threadIdx.x >> 6));
    const int vcu = (G % 8 == 0) ? (bx % 8) * (G / 8) + bx / 8 : bx;
#define PH_IDS() int ln_; asm volatile("v_mbcnt_lo_u32_b32 %0, -1, 0\n\tv_mbcnt_hi_u32_b32 %0, -1, %0" : "=v"(ln_)); const int lane = ln_, wave = wv, tid = wv * 64 + ln_; \
    const int gw = vcu * NWAVES + wave, NGW = G * NWAVES; const size_t gtid = (size_t)vcu * (NWAVES * 64) + tid, gthreads = (size_t)G * (NWAVES * 64); (void)lane; (void)gw; (void)NGW; (void)gtid; (void)gthreads
    if (threadIdx.x < 32) ((LAS unsigned*)(lds + MISC_OFF))[threadIdx.x] = 0u;
    __syncthreads();
    (void)xcd_barrier_post((unsigned*)(WSP(gu32, WS_CTL) + CW_BAR), (volatile LAS unsigned*)(lds + MISC_OFF) + 8);
#define STAMP() do {} while (0)
#ifndef PROBE_DUP
#define PROBE_DUP 0
#endif
#define REPS(bit) _Pragma("unroll 1") for (int rep_ = 0; rep_ < 1 + ((PROBE_DUP >> (bit)) & 1); ++rep_)
#define GRID_BAR1() do { XcdBarrier b_; b_.bar = (unsigned*)(WSP(gu32, WS_CTL) + CW_BAR); b_.x = xb_xcc_id(); b_.st = (volatile LAS unsigned*)(lds + MISC_OFF) + 8; xcd_barrier(b_); } while (0)
#define GRID_BAR() do { GRID_BAR1(); if ((PROBE_DUP >> 9) & 1) GRID_BAR1(); } while (0)

    REPS(5) {
        PH_IDS();
        LAS float* scr = (LAS float*)(lds + wave * 16384);
        constexpr int I0 = 16 * 97, I1 = 16 * 32, I2 = 16 * 64, I3 = 16 * 96, I4 = 16 * 32, I5 = 16 * 64, NITEMS = I0 + I1 + I2 + I3 + I4 + I5;
        for (int it = gw; it < NITEMS; it += NGW) {
            int r = it;
            if (r < I0) { p0_transpose_item(KIN(3), 1024, 3104, WSP(bf16, WS_WIN), scr, r, lane); continue; } r -= I0;
            if (r < I1) { p0_transpose_item(KIN(6), 1024, 1024, WSP(bf16, WS_WO0), scr, r, lane); continue; } r -= I1;
            if (r < I2) { p0_transpose_item(KIN(8), 1024, 2048, WSP(bf16, WS_WQ0), scr, r, lane); continue; } r -= I2;
            if (r < I3) { p0_transpose_item(KIN(13), 1024, 3072, WSP(bf16, WS_WQKV), scr, r, lane, KIN(12)); continue; } r -= I3;
            if (r < I4) { p0_transpose_item(KIN(21), 1024, 1024, WSP(bf16, WS_WO1), scr, r, lane); continue; } r -= I4;
            p0_transpose_item(KIN(23), 1024, 2048, WSP(bf16, WS_WQ1), scr, r, lane);
        }
        { bf16* WIN = WSP(bf16, WS_WIN); for (size_t i = gtid * 8; i < (size_t)224 * 1024; i += gthreads * 8) *(v4u*)(WIN + (size_t)3104 * 1024 + i) = (v4u){0u, 0u, 0u, 0u}; }
        cvt_range(KIN(9), WSP(bf16, WS_KEY0), (size_t)262144, gtid, gthreads);
        cvt_range(KIN(24), WSP(bf16, WS_KEY1), (size_t)262144, gtid, gthreads);
        rms_pass(KIN(0), KIN(2), WSP(bf16, WS_B0), gw, NGW, lane);
        { const int* positions = (const int*)KARG(1); float* ROPE = WSP(float, WS_ROPE);
          for (size_t id = gtid; id < (size_t)T * 8; id += gthreads) { const size_t mtok = id >> 3; const int i = (int)(id & 7);
            const float inv = powf(500000.0f, -(float)i * 2.0f / 16.0f); const float ang = (float)positions[mtok] * inv;
            float sn, cs; sincosf(ang, &sn, &cs); ROPE[mtok * 16 + i] = cs; ROPE[mtok * 16 + 8 + i] = sn; } }
    }
    GRID_BAR();
    REPS(3) {
        unsigned char* ws = KWS();
        pg8::Gemm g{(const bf16*)(ws + WS_B0), (const bf16*)(ws + WS_WIN), T, 3328, 1024}; pg8::StaticOrder S; S.init(T, 3328, G, bx);
        pg8::EpiInProj E{(bf16*)(ws + WS_R1), (bf16*)(ws + WS_R1 + 32 * MiB), (bf16*)(ws + WS_R2), (bf16*)(ws + WS_R3), (float*)(ws + WS_GATES), KIN(4)};
        pg8::gemm_phase<pg8::EpiInProj, pg8::StaticOrder, true, true>(lds, g, S, E, wv);
    }
    GRID_BAR();
    if ((bx >> 3) & 1) { PH_IDS(); const int gwi = ((bx >> 4) * 8 + (bx & 7)) * NWAVES + wave, NGWI = 128 * NWAVES; (void)gw; (void)NGW;
        quant4_rows(KIN(10), WSP(unsigned char, WS_U0), WSP(float, WS_SC), 16384, gwi, NGWI, lane);
        quant4_rows(KIN(11), WSP(unsigned char, WS_V0T), WSP(float, WS_SC + 65536), 16384, gwi, NGWI, lane);
        quant4_rows(KIN(25), WSP(unsigned char, WS_U1), WSP(float, WS_SC + 2 * 65536), 16384, gwi, NGWI, lane);
        quant4_rows(KIN(26), WSP(unsigned char, WS_V1T), WSP(float, WS_SC + 3 * 65536), 16384, gwi, NGWI, lane); }
    REPS(2) { unsigned char* ws = KWS(); mlstm_phase(wv, lds, (const bf16*)(ws + WS_R1), (const bf16*)(ws + WS_R1 + 32 * MiB), (const bf16*)(ws + WS_R2), (const float*)(ws + WS_GATES), (bf16*)(ws + WS_R4), (bf16*)(ws + WS_R5)); }
    GRID_BAR();
    REPS(6) { PH_IDS(); unsigned char* ws = KWS(); hs_pass((const bf16*)(ws + WS_R4), (const bf16*)(ws + WS_R5), (const bf16*)(ws + WS_R3), KIN(5), (bf16*)(ws + WS_B0), gw, NGW, lane); }
    GRID_BAR();
#pragma unroll 1
    for (int L = 0; L < 2; ++L) {
        if (L == 1) {
            REPS(3) {
                unsigned char* ws = KWS();
                pg8::Gemm g{(const bf16*)(ws + WS_B0), (const bf16*)(ws + WS_WQKV), T, 3072, 1024}; pg8::StaticOrder S; S.init(T, 3072, G, bx);
                pg8::EpiQKV E{(bf16*)(ws + WS_R2), (bf16*)(ws + WS_R3), (bf16*)(ws + WS_R4), (const float*)(ws + 3 * MiB)};
                pg8::gemm_phase<pg8::EpiQKV, pg8::StaticOrder, true, true>(lds, g, S, E, wv);
            }
            GRID_BAR();
            { PH_IDS(); unsigned char* ws = KWS(); qknorm_rope_pass((bf16*)(ws + WS_R2), (bf16*)(ws + WS_R3), KIN(14), KIN(15), (const float*)(ws + WS_ROPE), gtid, gthreads); }
            GRID_BAR();
            REPS(0) { unsigned char* ws = KWS(); attn_phase(wv, lds, vcu, (const bf16*)(ws + WS_R2), (const bf16*)(ws + WS_R3), (const bf16*)(ws + WS_R4), (bf16*)(ws + WS_B0), KIN(14), KIN(15), KIN(16), KIN(17), KIN(18), KIN(19), KIN(20)); }
            GRID_BAR();
        }
        _Pragma("unroll 1") for (int rep_ = 0; rep_ < 1 + ((L == 0) ? ((PROBE_DUP >> 3) & 1) : 0); ++rep_) {
            unsigned char* ws = KWS(); float* out = KOUT();
            pg8::Gemm g{(const bf16*)(ws + WS_B0), (const bf16*)(ws + (L ? WS_WO1 : WS_WO0)), T, 1024, 1024}; pg8::StaticOrder S; S.init(T, 1024, G, bx);
            pg8::EpiRes E{L ? (const float*)out : KIN(0), out};
            pg8::gemm_phase<pg8::EpiRes, pg8::StaticOrder, true, true>(lds, g, S, E, wv);
        }
        GRID_BAR();
        REPS(7) { PH_IDS(); unsigned char* ws = KWS(); rms_quant_pass(KOUT(), L ? KIN(22) : KIN(7), (bf16*)(ws + WS_B0), ws + WS_R5, (float*)(ws + WS_SC + 4 * 65536), (float*)(ws + WS_SC + 6 * 65536), gw, NGW, lane); }
        GRID_BAR();
        REPS(3) {
            unsigned char* ws = KWS();
            pg8::Gemm g{(const bf16*)(ws + WS_B0), (const bf16*)(ws + (L ? WS_WQ1 : WS_WQ0)), T, 2048, 1024}; pg8::StaticOrder S; S.init(T, 2048, G, bx);
            pg8::EpiPlain E{(bf16*)(ws + WS_R2), 2048};
            pg8::gemm_phase<pg8::EpiPlain, pg8::StaticOrder, true, true>(lds, g, S, E, wv);
        }
        GRID_BAR();
        REPS(4) { unsigned char* ws = KWS(); peer_topk_phase(wv, vcu, (const bf16*)(ws + WS_R2), (const bf16*)(ws + (L ? WS_KEY1 : WS_KEY0)), (int*)(ws + WS_R4), (float*)(ws + WS_R4 + 16 * MiB)); }
        GRID_BAR();
        REPS(1) { unsigned char* ws = KWS(); peer_g1_phase(wv, vcu, ws + WS_R5, (const int*)(ws + WS_R4), ws + (L ? WS_U1 : WS_U0), (int*)(ws + WS_R2)); }
        GRID_BAR();
        { PH_IDS(); unsigned char* ws = KWS(); const size_t so = L ? 2 * 65536 : 0;
          peer_g1b_phase((const int*)(ws + WS_R2), (const int*)(ws + WS_R4), (const float*)(ws + WS_R4 + 16 * MiB), (const float*)(ws + WS_SC + so), (const float*)(ws + WS_SC + so + 65536),
                         (const float*)(ws + WS_SC + 4 * 65536), (const float*)(ws + WS_SC + 6 * 65536), ws + WS_R4 + 32 * MiB, (float*)(ws + WS_SC + 10 * 65536), (float*)(ws + WS_SC + 8 * 65536), gw, NGW, lane); }
        GRID_BAR();
        if (L == 0) { unsigned char* ws = KWS(); peer_g2_phase<true>(wv, vcu, (const int*)(ws + WS_R4), ws + WS_R4 + 32 * MiB, (const float*)(ws + WS_SC + 10 * 65536), (const float*)(ws + WS_SC + 8 * 65536), ws + WS_V0T, KOUT(), (bf16*)(ws + WS_B0), (float*)(ws + 3 * MiB)); GRID_BAR(); }
        else { unsigned char* ws = KWS(); peer_g2_phase<false>(wv, vcu, (const int*)(ws + WS_R4), ws + WS_R4 + 32 * MiB, (const float*)(ws + WS_SC + 10 * 65536), (const float*)(ws + WS_SC + 8 * 65536), ws + WS_V1T, KOUT(), nullptr, nullptr); }
    }
#undef GRID_BAR
}

extern "C" void kernel_launch(void* const* d_in, const int* in_sizes, int n_in, void* d_out, int out_size, void* d_ws, size_t ws_size, hipStream_t stream) {
    static int ready = 0;
    if (ready == 0) {
        if (n_in != 27 || out_size != T * D || ws_size < WS_END) { fprintf(stderr, "kernel_launch: unexpected problem (n_in %d, out %d, ws %zu)\n", n_in, out_size, ws_size); ready = -1; return; }
        if (hipFuncSetAttribute((const void*)mk_fwd, hipFuncAttributeMaxDynamicSharedMemorySize, LDS_BYTES) != hipSuccess) { fprintf(stderr, "kernel_launch: hipFuncSetAttribute failed\n"); ready = -1; return; }
        (void)hipGetLastError();
        ready = 1;
    }
    if (ready < 0) return;
    if (hipMemsetAsync((char*)d_ws + WS_CTL, 0, CTL_ZERO_BYTES, stream) != hipSuccess) { fprintf(stderr, "kernel_launch: memset failed\n"); return; }
    Args a{};
    for (int i = 0; i < 27; ++i) a.in[i] = d_in[i];
    a.out = (float*)d_out; a.ws = (unsigned char*)d_ws;
    hipLaunchKernelGGL(mk_fwd, dim3(256), dim3(NWAVES * 64), LDS_BYTES, stream, a);
}
```

```cpp
#include <hip/hip_runtime.h>
#include <hip/hip_bf16.h>
#include <cstdio>
#include <cstdint>
#include <cmath>
namespace pg8 {
#define PG8_LAS __attribute__((address_space(3)))
typedef unsigned short bf16_t;
typedef short bf16x8 __attribute__((ext_vector_type(8)));
typedef float f32x4 __attribute__((ext_vector_type(4)));
typedef unsigned u32x4 __attribute__((ext_vector_type(4)));
constexpr int BM = 256, BK = 64, HALF = 128, HTB = HALF * BK * 2  , STAGE_BYTES = 8 * HTB, NXCD = 8, WGM = 8;

__host__ __device__ __forceinline__ int lds_byte(int r, int c) { const int st = (r >> 4) * 2 + (c >> 5), rr = r & 15, cc = c & 31, ob = rr * 64 + cc * 2; return st * 1024 + (ob ^ (((ob >> 9) & 1) << 5)); }
__host__ __device__ __forceinline__ void stage_rc(int b, int& R, int& C) { const int st = b / 1024, sb = b % 1024, swz = sb ^ (((sb >> 9) & 1) << 5); R = (st >> 1) * 16 + swz / 64; C = (st & 1) * 32 + (swz % 64) / 2; }
__host__ __device__ __forceinline__ int perm32(int rho) { const int n = rho >> 4, i = rho & 15; return 8 * (i >> 2) + 4 * n + (i & 3); }

struct Unit { int pm, pn; };
struct Gemm { const bf16_t* A; const bf16_t* Bt; int M, N, K; };

struct StaticOrder {
    int nM, nN, nwg, G, c;
    __host__ __device__ void init(int M, int N, int G_, int c_) { nM = M / BM; nN = N / BM; nwg = nM * nN; G = G_; c = c_; }
    __host__ __device__ bool next(int i, Unit& u) const {
        const long L = (long)i * G + c; if (L >= nwg) return false;
        int wgid = (int)L; { const int q = nwg / NXCD, r = nwg % NXCD, xcd = wgid % NXCD, off = wgid / NXCD; wgid = (xcd < r ? xcd * (q + 1) : r * (q + 1) + (xcd - r) * q) + off; }
        const int nig = WGM * nN, gid = wgid / nig, fm = gid * WGM, gsz = (nM - fm) < WGM ? (nM - fm) : WGM;
        u.pm = fm + ((wgid % nig) % gsz); u.pn = (wgid % nig) / gsz; return true;
    }
    __device__ __forceinline__ void a_ready(const Unit&) const {}
    __device__ __forceinline__ void done(const Unit&) const {}
};
__device__ __forceinline__ unsigned cvt_pk_bf16(float lo, float hi) { unsigned r; asm volatile("v_cvt_pk_bf16_f32 %0, %1, %2" : "=v"(r) : "v"(lo), "v"(hi)); return r; }
typedef float f32x2 __attribute__((ext_vector_type(2)));
typedef unsigned u32x2 __attribute__((ext_vector_type(2)));
__device__ __forceinline__ u32x4 pack8(const f32x4 v0, const f32x4 v1) { u32x4 w; w.x = cvt_pk_bf16(v0[0], v0[1]); w.y = cvt_pk_bf16(v0[2], v0[3]); w.z = cvt_pk_bf16(v1[0], v1[1]); w.w = cvt_pk_bf16(v1[2], v1[3]); return w; }
struct EpiPlain {
    static constexpr bool PERM = true, AFTER_DRAIN = false;
    bf16_t* O; int ldc;
    __device__ __forceinline__ void operator()(const f32x4 (&acc)[2][2][4][2], const Unit& u, int wr, int wc, int fr, int fq) const {
        const int row0 = u.pm * BM + wr * 64 + fr, col0 = u.pn * BM + wc * 32 + 8 * fq;
#pragma unroll
        for (int ai = 0; ai < 2; ++ai)
#pragma unroll
            for (int m = 0; m < 4; ++m) { bf16_t* rowp = O + (size_t)(row0 + ai * HALF + m * 16) * ldc + col0;
#pragma unroll
                for (int bj = 0; bj < 2; ++bj) *(u32x4*)(rowp + bj * HALF) = pack8(acc[ai][bj][m][0], acc[ai][bj][m][1]); }
    }
};
struct EpiRes {
    static constexpr bool PERM = false, AFTER_DRAIN = false;
    const float* base; float* out;
    __device__ __forceinline__ void operator()(const f32x4 (&acc)[2][2][4][2], const Unit& u, int wr, int wc, int fr, int fq) const {
        const int col0 = u.pn * BM + wc * 32 + 4 * fq;
#pragma unroll
        for (int ai = 0; ai < 2; ++ai)
#pragma unroll
            for (int m = 0; m < 4; ++m) { const size_t off = (size_t)(u.pm * BM + ai * HALF + wr * 64 + m * 16 + fr) * 1024 + col0;
#pragma unroll
                for (int bj = 0; bj < 2; ++bj)
#pragma unroll
                    for (int n = 0; n < 2; ++n) { const f32x4 bs = *(const f32x4*)(base + off + bj * HALF + n * 16); *(f32x4*)(out + off + bj * HALF + n * 16) = bs + acc[ai][bj][m][n]; } }
    }
};
struct EpiInProj {
    static constexpr bool PERM = true, AFTER_DRAIN = false;
    bf16_t *Q, *Kk, *V, *OG; float* gates; const float* bg;
    __device__ __forceinline__ void operator()(const f32x4 (&acc)[2][2][4][2], const Unit& u, int wr, int wc, int fr, int fq) const {
        const int colt = u.pn * BM;
#pragma unroll
        for (int ai = 0; ai < 2; ++ai)
#pragma unroll
            for (int m = 0; m < 4; ++m) { const int row = u.pm * BM + ai * HALF + wr * 64 + m * 16 + fr, b = row >> 12, s = row & 4095;
#pragma unroll
                for (int bj = 0; bj < 2; ++bj) { const int cb = colt + bj * HALF + wc * 32 + 8 * fq; f32x4 v0 = acc[ai][bj][m][0], v1 = acc[ai][bj][m][1];
                    if (colt < 1024) { const bool isq = colt < 512; bf16_t* base = isq ? Q : Kk; const int c2 = cb & 511, head = c2 >> 6, d = c2 & 63;
                        if (isq) { v0 = v0 * 0.125f; v1 = v1 * 0.125f; }
                        *(u32x4*)(base + ((size_t)((b * 8 + head) * 4096 + s)) * 64 + d) = pack8(v0, v1); }
                    else if (colt < 2048) { const int c2 = cb - 1024, head = c2 >> 7, dv = c2 & 127; *(u32x4*)(V + ((size_t)((b * 8 + head) * 4096 + s)) * 128 + dv) = pack8(v0, v1); }
                    else if (colt < 3072) { *(u32x4*)(OG + (size_t)row * 1024 + (cb - 2048)) = pack8(v0, v1); }
                    else if (cb < 3104) { const int gi = cb - 3072; float* g = gates + (size_t)row * 32 + gi;
                        *(f32x4*)g = v0 + *(const f32x4*)(bg + gi); *(f32x4*)(g + 4) = v1 + *(const f32x4*)(bg + gi + 4); } } }
    }
};
struct EpiQKV {
    static constexpr bool PERM = true, AFTER_DRAIN = false;
    bf16_t *Q, *Kk, *V; const float* SS; const float* qg; const float* kg; const float* rope; PG8_LAS float* xch;
    __device__ __forceinline__ void operator()(const f32x4 (&acc)[2][2][4][2], const Unit& u, int wr, int wc, int fr_, int fq_) const {
        int fr = fr_, fq = fq_; asm volatile("" : "+v"(fr), "+v"(fq));
        const int colt = u.pn * BM, lane = fq * 16 + fr, wave = wr * 4 + wc;
        float rsr[2][4];
#pragma unroll
        for (int ai = 0; ai < 2; ++ai)
#pragma unroll
            for (int m = 0; m < 4; ++m) { const int row = u.pm * BM + ai * HALF + wr * 64 + m * 16 + fr;
                rsr[ai][m] = __builtin_amdgcn_rsqf(((SS[row] + SS[32768 + row]) + (SS[2 * 32768 + row] + SS[3 * 32768 + row])) * (1.f / 1024.f) + 1e-6f); }
        if (colt >= 2048) {
#pragma unroll
            for (int ai = 0; ai < 2; ++ai)
#pragma unroll
                for (int m = 0; m < 4; ++m) { const int row = u.pm * BM + ai * HALF + wr * 64 + m * 16 + fr, b = row >> 12, s = row & 4095; const float rs = rsr[ai][m];
#pragma unroll
                    for (int bj = 0; bj < 2; ++bj) { const int cb = colt + bj * HALF + wc * 32 + 8 * fq; const int c2 = cb - 2048, head = c2 >> 7, dv = c2 & 127;
                        *(u32x4*)(V + ((size_t)((b * 8 + head) * 4096 + s)) * 128 + dv) = pack8(acc[ai][bj][m][0] * rs, acc[ai][bj][m][1] * rs); } }
            return;
        }
#pragma unroll
        for (int ai = 0; ai < 2; ++ai)
#pragma unroll
            for (int m = 0; m < 4; ++m)
#pragma unroll
                for (int bj = 0; bj < 2; ++bj) { const f32x4 a = acc[ai][bj][m][0] * rsr[ai][m], c = acc[ai][bj][m][1] * rsr[ai][m];
                    float ss = ((a[0] * a[0] + a[1] * a[1]) + (a[2] * a[2] + a[3] * a[3])) + ((c[0] * c[0] + c[1] * c[1]) + (c[2] * c[2] + c[3] * c[3]));
                    ss += __uint_as_float((unsigned)__builtin_amdgcn_ds_bpermute((lane ^ 16) << 2, (int)__float_as_uint(ss)));
                    ss += __uint_as_float((unsigned)__builtin_amdgcn_ds_bpermute((lane ^ 32) << 2, (int)__float_as_uint(ss)));
                    if (fq == 0) xch[(((wave * 2 + ai) * 4 + m) * 2 + bj) * 16 + fr] = ss; }
        __syncthreads();
        const bool isq = colt < 1024; bf16_t* base = isq ? Q : Kk; const float* gn = isq ? qg : kg; const float osc = isq ? (0.125f * 1.44269504089f) : 1.f;
        const int d0 = 32 * (wc & 1) + 8 * fq;
        const f32x4 g0 = *(const f32x4*)(gn + d0), g1 = *(const f32x4*)(gn + d0 + 4);
        const bool rot = ((wc & 1) == 0) && (fq < 2);
#pragma unroll
        for (int ai = 0; ai < 2; ++ai)
#pragma unroll
            for (int m = 0; m < 4; ++m) { const int row = u.pm * BM + ai * HALF + wr * 64 + m * 16 + fr, b = row >> 12, s = row & 4095;
                f32x4 co0 = {0.f, 0.f, 0.f, 0.f}, co1 = co0, si0 = co0, si1 = co0;
                if (rot) { const float* cs = rope + (size_t)row * 16; co0 = *(const f32x4*)cs; co1 = *(const f32x4*)(cs + 4); si0 = *(const f32x4*)(cs + 8); si1 = *(const f32x4*)(cs + 12); }
#pragma unroll
                for (int bj = 0; bj < 2; ++bj) { const float tot = xch[(((wave * 2 + ai) * 4 + m) * 2 + bj) * 16 + fr] + xch[((((wave ^ 1) * 2 + ai) * 4 + m) * 2 + bj) * 16 + fr];
                    const float rn = __builtin_amdgcn_rsqf(tot * (1.f / 64.f) + 1e-6f) * rsr[ai][m];
                    f32x4 y0 = acc[ai][bj][m][0] * rn * g0, y1 = acc[ai][bj][m][1] * rn * g1;
                    f32x4 p0, p1;
#pragma unroll
                    for (int i = 0; i < 4; ++i) { p0[i] = __uint_as_float((unsigned)__builtin_amdgcn_ds_bpermute((lane ^ 16) << 2, (int)__float_as_uint(y0[i]))); p1[i] = __uint_as_float((unsigned)__builtin_amdgcn_ds_bpermute((lane ^ 16) << 2, (int)__float_as_uint(y1[i]))); }
                    if (rot) { const float sg = (fq == 0) ? -1.f : 1.f; y0 = y0 * co0 + p0 * si0 * sg; y1 = y1 * co1 + p1 * si1 * sg; }
                    const int cb = colt + bj * HALF + wc * 32 + 8 * fq; const int c2 = cb & 1023, head = c2 >> 7, c = (c2 >> 6) & 1, d = c2 & 63;
                    *(u32x4*)(base + ((size_t)(((b * 8 + head) * 2 + c) * 4096 + s)) * 64 + d) = pack8(y0 * osc, y1 * osc); } }
    }
};
template <class Epi, class Sched, bool ALIGN_EPI = false, bool SP2 = false>
__device__ __forceinline__ void gemm_phase(PG8_LAS unsigned char* lds, const Gemm g, const Sched& S, const Epi& E, const int wv) {
    int ln_; asm volatile("v_mbcnt_lo_u32_b32 %0, -1, 0\n\tv_mbcnt_hi_u32_b32 %0, -1, %0" : "=v"(ln_)); const int tid = wv * 64 + ln_, wid = wv, lane = tid & 63, wr = wid >> 2, wc = wid & 3, fr = lane & 15, fq = lane >> 4;
    const int K = g.K, nt = K / BK;
    unsigned voffA[2], voffB[2];
#pragma unroll
    for (int i = 0; i < 2; ++i) { int R, C; stage_rc(tid * 16 + i * 8192, R, C); const int Rb = Epi::PERM ? ((R & ~31) + perm32(R & 31)) : R;
        voffA[i] = (unsigned)(R * K + C) * 2u; voffB[i] = (unsigned)(Rb * K + C) * 2u; }
    const size_t kstep = (size_t)(BK * 2);
    const size_t hstep = (size_t)HALF * K * 2;
    const size_t tstep = 2 * hstep;
    const unsigned ldsw = (unsigned)wid * 1024u;
    const int aoff = lds_byte(wr * 64 + fr, fq * 8), boff = lds_byte(wc * 32 + fr, fq * 8);
#define PG8_SA(b, h) (((b) * 2 + (h)) * HTB)
#define PG8_SB(b, h) ((4 + (b) * 2 + (h)) * HTB)
#define PG8_STAGE(bufoff, gbase, voff) do { _Pragma("unroll") for (int _i = 0; _i < 2; ++_i) \
        __builtin_amdgcn_global_load_lds((const unsigned*)((const char*)(gbase) + (voff)[_i]), (PG8_LAS unsigned*)(lds + (bufoff) + ldsw + _i * 8192), 16, 0, 0); } while (0)
#define PG8_LDA(dst, b, h) do { _Pragma("unroll") for (int m = 0; m < 4; ++m) _Pragma("unroll") for (int k = 0; k < 2; ++k) dst[m][k] = *(const PG8_LAS bf16x8*)(lds + PG8_SA(b, h) + aoff + m * 2048 + k * 1024); } while (0)
#define PG8_LDB(dst, b, h) do { _Pragma("unroll") for (int n = 0; n < 2; ++n) _Pragma("unroll") for (int k = 0; k < 2; ++k) dst[n][k] = *(const PG8_LAS bf16x8*)(lds + PG8_SB(b, h) + boff + n * 2048 + k * 1024); } while (0)
#define PG8_MMA(ai, bj, At, Bt) do { __builtin_amdgcn_s_setprio(1); _Pragma("unroll") for (int m = 0; m < 4; ++m) _Pragma("unroll") for (int n = 0; n < 2; ++n) _Pragma("unroll") for (int k = 0; k < 2; ++k) \
        acc[ai][bj][m][n] = __builtin_amdgcn_mfma_f32_16x16x32_bf16(Bt[n][k], At[m][k], acc[ai][bj][m][n], 0, 0, 0); __builtin_amdgcn_s_setprio(0); } while (0)
#define PG8_WAIT_V(n) asm volatile("s_waitcnt vmcnt(" #n ")" ::: "memory")
#define PG8_WAIT_L(n) asm volatile("s_waitcnt lgkmcnt(" #n ")" ::: "memory")
#define PG8_BAR __builtin_amdgcn_s_barrier()
#define PG8_SCHED __builtin_amdgcn_sched_barrier(0)
    Unit cur, nxt; int ui = 0;
    if (!S.next(0, cur)) return;
    f32x4 acc[2][2][4][2];
#pragma unroll
    for (int a = 0; a < 2; ++a)
#pragma unroll
        for (int b = 0; b < 2; ++b)
#pragma unroll
            for (int m = 0; m < 4; ++m)
#pragma unroll
                for (int n = 0; n < 2; ++n) acc[a][b][m][n] = (f32x4){0.f, 0.f, 0.f, 0.f};
    bf16x8 At[4][2], B0[2][2], B1[2][2];
    const char* cA = (const char*)g.A + (size_t)cur.pm * tstep; const char* cB = (const char*)g.Bt + (size_t)cur.pn * tstep;
    S.a_ready(cur);
    if constexpr (SP2) {
        PG8_STAGE(PG8_SB(0, 0), cB, voffB); PG8_STAGE(PG8_SB(0, 1), cB + hstep, voffB); PG8_STAGE(PG8_SA(0, 0), cA, voffA); PG8_STAGE(PG8_SA(0, 1), cA + hstep, voffA);
        if (wr == 1) PG8_BAR;
        PG8_WAIT_V(2); PG8_BAR;
        PG8_STAGE(PG8_SB(1, 0), cB + kstep, voffB); PG8_STAGE(PG8_SA(1, 0), cA + kstep, voffA); PG8_STAGE(PG8_SB(1, 1), cB + hstep + kstep, voffB);
        PG8_WAIT_V(6); PG8_BAR;
    } else {
        PG8_STAGE(PG8_SB(0, 0), cB, voffB); PG8_STAGE(PG8_SA(0, 0), cA, voffA); PG8_STAGE(PG8_SB(0, 1), cB + hstep, voffB); PG8_STAGE(PG8_SA(0, 1), cA + hstep, voffA);
        if (wr == 1) PG8_BAR;
        PG8_WAIT_V(4); PG8_BAR;
        PG8_STAGE(PG8_SB(1, 0), cB + kstep, voffB); PG8_STAGE(PG8_SA(1, 0), cA + kstep, voffA); PG8_STAGE(PG8_SB(1, 1), cB + hstep + kstep, voffB);
        PG8_WAIT_V(6); PG8_BAR;
    }
    for (;;) {
        const bool has_next = S.next(ui + 1, nxt);
        const char* nA = has_next ? (const char*)g.A + (size_t)nxt.pm * tstep : cA; const char* nB = has_next ? (const char*)g.Bt + (size_t)nxt.pn * tstep : cB;
        for (int t = 0; t < nt; t += 2) {
            const bool last = (t == nt - 2);
            const char* a1 = cA + (size_t)(t + 1) * kstep;
            const char* a2 = last ? nA : cA + (size_t)(t + 2) * kstep; const char* b2 = last ? nB : cB + (size_t)(t + 2) * kstep;
            const char* a3 = a2 + kstep; const char* b3 = b2 + kstep;
            if (last && has_next) S.a_ready(nxt);
            if constexpr (SP2) {
            PG8_LDB(B0, 0, 0); PG8_LDB(B1, 0, 1); PG8_SCHED; PG8_LDA(At, 0, 0); PG8_STAGE(PG8_SA(1, 1), a1 + hstep, voffA);
            PG8_WAIT_V(8); PG8_WAIT_L(0); PG8_BAR; PG8_MMA(0, 0, At, B0); PG8_MMA(0, 1, At, B1); PG8_BAR; PG8_SCHED;
            PG8_LDA(At, 0, 1); PG8_STAGE(PG8_SB(0, 0), b2, voffB); PG8_STAGE(PG8_SB(0, 1), b2 + hstep, voffB); PG8_STAGE(PG8_SA(0, 0), a2, voffA);
            PG8_WAIT_V(8); PG8_WAIT_L(0); PG8_BAR; PG8_MMA(1, 0, At, B0); PG8_MMA(1, 1, At, B1); PG8_BAR; PG8_SCHED;
            PG8_LDB(B0, 1, 0); PG8_LDB(B1, 1, 1); PG8_SCHED; PG8_LDA(At, 1, 0); PG8_STAGE(PG8_SA(0, 1), a2 + hstep, voffA);
            PG8_WAIT_V(8); PG8_WAIT_L(0); PG8_BAR; PG8_MMA(0, 0, At, B0); PG8_MMA(0, 1, At, B1); PG8_BAR; PG8_SCHED;
            PG8_LDA(At, 1, 1); PG8_STAGE(PG8_SB(1, 0), b3, voffB); PG8_STAGE(PG8_SB(1, 1), b3 + hstep, voffB); PG8_STAGE(PG8_SA(1, 0), a3, voffA);
            PG8_WAIT_V(8); PG8_WAIT_L(0); PG8_BAR; PG8_MMA(1, 0, At, B0); PG8_MMA(1, 1, At, B1); PG8_BAR; PG8_SCHED;
            } else {
            PG8_LDB(B0, 0, 0); PG8_SCHED; PG8_LDA(At, 0, 0); PG8_STAGE(PG8_SA(1, 1), a1 + hstep, voffA);
            PG8_WAIT_L(8); PG8_BAR; PG8_WAIT_L(0); PG8_MMA(0, 0, At, B0); PG8_BAR; PG8_SCHED;
            PG8_LDB(B1, 0, 1); PG8_STAGE(PG8_SB(0, 0), b2, voffB);
            PG8_BAR; PG8_WAIT_L(0); PG8_MMA(0, 1, At, B1); PG8_BAR;
            PG8_LDA(At, 0, 1); PG8_STAGE(PG8_SA(0, 0), a2, voffA);
            PG8_BAR; PG8_WAIT_L(0); PG8_MMA(1, 0, At, B0); PG8_BAR; PG8_SCHED;
            PG8_STAGE(PG8_SB(0, 1), b2 + hstep, voffB);
            PG8_WAIT_V(6); PG8_BAR; PG8_MMA(1, 1, At, B1); PG8_BAR;
            PG8_LDB(B0, 1, 0); PG8_SCHED; PG8_LDA(At, 1, 0); PG8_STAGE(PG8_SA(0, 1), a2 + hstep, voffA);
            PG8_WAIT_L(8); PG8_BAR; PG8_WAIT_L(0); PG8_MMA(0, 0, At, B0); PG8_BAR; PG8_SCHED;
            PG8_LDB(B1, 1, 1); PG8_STAGE(PG8_SB(1, 0), b3, voffB);
            PG8_BAR; PG8_WAIT_L(0); PG8_MMA(0, 1, At, B1); PG8_BAR;
            PG8_LDA(At, 1, 1); PG8_STAGE(PG8_SA(1, 0), a3, voffA);
            PG8_BAR; PG8_WAIT_L(0); PG8_MMA(1, 0, At, B0); PG8_BAR; PG8_SCHED;
            PG8_STAGE(PG8_SB(1, 1), b3 + hstep, voffB);
            PG8_WAIT_V(6); PG8_BAR; PG8_MMA(1, 1, At, B1); PG8_BAR;
            }
        }
        if constexpr (ALIGN_EPI) { if (wr == 0) PG8_BAR; }
        if constexpr (!Epi::AFTER_DRAIN) { E(acc, cur, wr, wc, fr, fq); S.done(cur); }
        if (!has_next) break;
#pragma unroll
        for (int a = 0; a < 2; ++a)
#pragma unroll
            for (int b = 0; b < 2; ++b)
#pragma unroll
                for (int m = 0; m < 4; ++m)
#pragma unroll
                    for (int n = 0; n < 2; ++n) acc[a][b][m][n] = (f32x4){0.f, 0.f, 0.f, 0.f};
        cur = nxt; cA = nA; cB = nB; ++ui;
        if constexpr (ALIGN_EPI) { if (wr == 1) PG8_BAR; }
    }
    PG8_WAIT_V(0);
    if constexpr (!ALIGN_EPI) { if (wr == 0) PG8_BAR; }
    PG8_BAR;
    if constexpr (Epi::AFTER_DRAIN) { E.fused(acc, cur, wr, wc, fr, fq, lds, wid, lane); S.done(cur); }
#undef PG8_SA
#undef PG8_SB
#undef PG8_STAGE
#undef PG8_LDA
#undef PG8_LDB
#undef PG8_MMA
#undef PG8_WAIT_V
#undef PG8_WAIT_L
#undef PG8_BAR
#undef PG8_SCHED
}
}
#define GAS __attribute__((address_space(1)))
#define LAS __attribute__((address_space(3)))
typedef unsigned short bf16;
typedef unsigned v4u __attribute__((ext_vector_type(4)));
typedef float f32x4 __attribute__((ext_vector_type(4)));
typedef short bf16x8 __attribute__((ext_vector_type(8)));
typedef GAS unsigned gu32;
typedef GAS unsigned long long gu64;
#define RLX_AGENT __ATOMIC_RELAXED, __HIP_MEMORY_SCOPE_AGENT
#define LDS_WAIT() asm volatile("s_waitcnt lgkmcnt(0)" ::: "memory")
#define VM_WAIT() asm volatile("s_waitcnt vmcnt(0)" ::: "memory")
__device__ __forceinline__ unsigned long long rt() { return __builtin_amdgcn_s_memrealtime(); }
typedef float f32x2_cv __attribute__((ext_vector_type(2))); typedef __bf16 bf16x2_cv __attribute__((ext_vector_type(2)));
__device__ __forceinline__ unsigned pk2(float lo, float hi) { const f32x2_cv v = {lo, hi}; const bf16x2_cv b = __builtin_convertvector(v, bf16x2_cv); return __builtin_bit_cast(unsigned, b); }
__device__ __forceinline__ unsigned f2bf(float f) { return pk2(f, 0.f) & 0xffffu; }

#define XB_TMO      128
#define XB_XCNT(j)  (256  + 64 * (j))
#define XB_XSUB(j)  (1280 + 64 * (j))
#define XB_XGEN(j)  (2304 + 64 * (j))
#define XB_TOP      3328
#define XB_TOPGEN   3392
#define XCD_BAR_WORDS 3456
#define XB_SPIN_CAP (1u << 18)

__device__ __forceinline__ unsigned xb_ld(unsigned* p)              { return __hip_atomic_load(p, __ATOMIC_RELAXED, __HIP_MEMORY_SCOPE_AGENT); }
__device__ __forceinline__ unsigned xb_add(unsigned* p, unsigned v) { return __hip_atomic_fetch_add(p, v, __ATOMIC_RELAXED, __HIP_MEMORY_SCOPE_AGENT); }
__device__ __forceinline__ unsigned xb_xcc_id() { return (unsigned)__builtin_amdgcn_s_getreg((3 << 11) | 20) & 0xFu; }
#define XB_SPIN(cond, bar) do { unsigned _sp = 0; while (cond) { __builtin_amdgcn_s_sleep(1); \
    if ((++_sp & 255u) == 0u) { if (xb_ld(&(bar)[XB_TMO])) break; if (_sp > XB_SPIN_CAP) { atomicAdd(&(bar)[XB_TMO], 1u); break; } } } } while (0)

struct XcdBarrier {
    unsigned* bar; unsigned x;
    volatile LAS unsigned* st;
};

__device__ __forceinline__ XcdBarrier xcd_barrier_post(unsigned* bar, volatile LAS unsigned* st) {
    XcdBarrier b; b.bar = bar; b.x = xb_xcc_id(); b.st = st;
    if (threadIdx.x == 0) (void)xb_add(&bar[XB_XCNT(b.x)], 1u);
    return b;
}
__device__ __forceinline__ void xcd_barrier_complete(unsigned* bar, unsigned x, unsigned& nloc, unsigned& nx) {
    const unsigned G = gridDim.x * gridDim.y * gridDim.z;
    unsigned sum, cnt, mine, sp = 0u;
    for (;;) {
        sum = 0u; cnt = 0u; mine = 0u;
#pragma unroll
        for (unsigned j = 0; j < 16; ++j) { const unsigned c = xb_ld(&bar[XB_XCNT(j)]); sum += c; cnt += (c > 0u) ? 1u : 0u; mine = (j == x) ? c : mine; }
        if (sum == G) break;
        __builtin_amdgcn_s_sleep(1);
        if ((++sp & 255u) == 0u) { if (xb_ld(&bar[XB_TMO])) break; if (sp > XB_SPIN_CAP) { atomicAdd(&bar[XB_TMO], 1u); break; } }
    }
    nloc = mine > 0u ? mine : 1u; nx = cnt > 0u ? cnt : 1u;
}

__device__ __forceinline__ void xcd_barrier(const XcdBarrier& b) {
    asm volatile("s_waitcnt vmcnt(0)" ::: "memory");
    __syncthreads();
    if (threadIdx.x == 0) {
        unsigned* bar = b.bar;
        __builtin_amdgcn_s_waitcnt(0);
        unsigned nloc = b.st[0], nx = b.st[1];
        if (nloc == 0u) { xcd_barrier_complete(bar, b.x, nloc, nx); b.st[0] = nloc; b.st[1] = nx; }
        const unsigned old = xb_add(&bar[XB_XSUB(b.x)], 1u);
        const unsigned gen = old / nloc;
        if (old + 1u == (gen + 1u) * nloc) {
            __builtin_amdgcn_fence(__ATOMIC_RELEASE, "agent");
            asm volatile("s_waitcnt vmcnt(0)" ::: "memory");
            const unsigned og = xb_add(&bar[XB_TOP], 1u);
            const unsigned tg = og / nx;
            if (og + 1u == (tg + 1u) * nx) xb_add(&bar[XB_TOPGEN], 1u);
            else XB_SPIN(xb_ld(&bar[XB_TOPGEN]) == tg, bar);
            __builtin_amdgcn_fence(__ATOMIC_ACQUIRE, "agent");
            xb_add(&bar[XB_XGEN(b.x)], 1u);
            asm volatile("s_waitcnt vmcnt(0)" ::: "memory");
        } else {
            XB_SPIN(xb_ld(&bar[XB_XGEN(b.x)]) == gen, bar);
            __builtin_amdgcn_fence(__ATOMIC_ACQUIRE, "agent");
            asm volatile("s_waitcnt vmcnt(0)" ::: "memory");
        }
    }
    __syncthreads();
}
constexpr int NWAVES = 8;
constexpr int T = 32768, D = 1024, SEQ = 4096;
constexpr float EPS = 1e-6f;
constexpr float LAMBDA_INIT = 0.35550906759f;
constexpr size_t MiB = 1u << 20;
constexpr size_t WS_CTL = 0, CTL_ZERO_BYTES = 1 * MiB;
constexpr size_t WS_ROPE = 1 * MiB;
constexpr size_t WS_WIN = 4 * MiB;
constexpr size_t WS_WO0 = 11 * MiB, WS_WQ0 = 13 * MiB, WS_KEY0 = 17 * MiB, WS_WQKV = 18 * MiB, WS_WO1 = 24 * MiB, WS_WQ1 = 26 * MiB, WS_KEY1 = 30 * MiB;
constexpr size_t WS_SC = 31 * MiB;
constexpr size_t WS_U0 = 32 * MiB, WS_V0T = 48 * MiB, WS_U1 = 64 * MiB, WS_V1T = 80 * MiB;
constexpr size_t WS_B0 = 96 * MiB;
constexpr size_t WS_R1 = 160 * MiB, WS_R2 = 224 * MiB, WS_R3 = 288 * MiB, WS_R4 = 352 * MiB, WS_R5 = 416 * MiB, WS_GATES = 480 * MiB;
constexpr size_t WS_END = 484 * MiB;
constexpr int CW_BAR = 4096;
constexpr int LDS_BYTES = 147456, MISC_OFF = LDS_BYTES - 128;

typedef float f32x16 __attribute__((ext_vector_type(16)));
typedef unsigned u32x2 __attribute__((ext_vector_type(2)));
typedef __bf16 bf16x2_t __attribute__((ext_vector_type(2)));
__device__ __forceinline__ float bf_lo(unsigned w) { return __uint_as_float(w << 16); }
__device__ __forceinline__ float bf_hi(unsigned w) { return __uint_as_float(w & 0xffff0000u); }
__device__ __forceinline__ float dot2(unsigned a, unsigned b, float c) { return __builtin_amdgcn_fdot2_f32_bf16(__builtin_bit_cast(bf16x2_t, a), __builtin_bit_cast(bf16x2_t, b), c, false); }
__device__ __forceinline__ float shx(float v, int lane, int m) { return __uint_as_float((unsigned)__builtin_amdgcn_ds_bpermute((lane ^ m) << 2, (int)__float_as_uint(v))); }
__device__ __forceinline__ int shxi(int v, int lane, int m) { return __builtin_amdgcn_ds_bpermute((lane ^ m) << 2, v); }
__device__ __forceinline__ float wave_sum(float v, int lane) {
#pragma unroll
    for (int o = 1; o < 64; o <<= 1) v += shx(v, lane, o);
    return v;
}
__device__ __forceinline__ f32x4 mfma16(bf16x8 a, bf16x8 b, f32x4 c) { return __builtin_amdgcn_mfma_f32_16x16x32_bf16(a, b, c, 0, 0, 0); }
__device__ __forceinline__ f32x16 mfma32(bf16x8 a, bf16x8 b, f32x16 c) { return __builtin_amdgcn_mfma_f32_32x32x16_bf16(a, b, c, 0, 0, 0); }
__device__ __forceinline__ u32x2 pack4(float a, float b, float c, float d) { u32x2 r; r.x = pk2(a, b); r.y = pk2(c, d); return r; }

__device__ __forceinline__ void p0_transpose_item(const float* W, int K, int N, bf16* WT, LAS float* scr, int item, int lane, const float* kscale = nullptr) {
    const int nblk = N / 32, kb = item / nblk, nb = item % nblk, k0 = 64 * kb, n0 = 32 * nb;
#pragma unroll 8
    for (int i = 0; i < 32; ++i) { const int kk = 2 * i + (lane >> 5); const float sc = kscale ? kscale[k0 + kk] : 1.f; scr[kk * 33 + (lane & 31)] = W[(size_t)(k0 + kk) * N + n0 + (lane & 31)] * sc; }
    LDS_WAIT(); asm volatile("" ::: "memory");
    const int c = lane & 7;
#pragma unroll
    for (int j = 0; j < 4; ++j) { const int n = (lane >> 3) + 8 * j; const LAS float* s = scr + (8 * c) * 33 + n;
        v4u o; o.x = pk2(s[0 * 33], s[1 * 33]); o.y = pk2(s[2 * 33], s[3 * 33]); o.z = pk2(s[4 * 33], s[5 * 33]); o.w = pk2(s[6 * 33], s[7 * 33]);
        *(v4u*)(WT + (size_t)(n0 + n) * K + k0 + 8 * c) = o; }
    LDS_WAIT(); asm volatile("" ::: "memory");
}
__device__ __forceinline__ void cvt_range(const float* src, bf16* dst, size_t n, size_t gtid, size_t gthreads) {
    for (size_t i = gtid * 8; i < n; i += gthreads * 8) {
        const f32x4 a = *(const f32x4*)(src + i), b = *(const f32x4*)(src + i + 4);
        v4u o; o.x = pk2(a.x, a.y); o.y = pk2(a.z, a.w); o.z = pk2(b.x, b.y); o.w = pk2(b.z, b.w);
        *(v4u*)(dst + i) = o; }
}
__device__ __forceinline__ void rms_row_to_bf16(const float* xrow, const float* g, bf16* orow, int lane) {
    const f32x4* xr = (const f32x4*)xrow + lane; const f32x4* gr = (const f32x4*)g + lane;
    f32x4 v[4]; float s = 0.f;
#pragma unroll
    for (int j = 0; j < 4; ++j) { v[j] = xr[64 * j]; s += (v[j].x * v[j].x + v[j].y * v[j].y) + (v[j].z * v[j].z + v[j].w * v[j].w); }
    const float rstd = rsqrtf(wave_sum(s, lane) * (1.f / 1024.f) + EPS);
    unsigned long long* o8 = (unsigned long long*)orow + lane;
#pragma unroll
    for (int j = 0; j < 4; ++j) { const f32x4 gg = gr[64 * j];
        o8[64 * j] = (unsigned long long)pk2(v[j].x * rstd * gg.x, v[j].y * rstd * gg.y) | ((unsigned long long)pk2(v[j].z * rstd * gg.z, v[j].w * rstd * gg.w) << 32); }
}
__device__ __forceinline__ void rms_pass(const float* X, const float* g, bf16* XN, int gw, int NGW, int lane) {
    for (int m = gw; m < T; m += NGW) rms_row_to_bf16(X + (size_t)m * D, g, XN + (size_t)m * D, lane);
}

__device__ __forceinline__ float logsigmoid_f(float f) { return fminf(f, 0.f) - log1pf(__expf(-fabsf(f))); }
#define ML_LOAD(ci_) do { const size_t r_ = rowbase + (size_t)(ci_) * 64 + lane; \
    rq = *(const v4u*)(Q0 + r_ * 64 + 8 * w); rk = *(const v4u*)(K0 + r_ * 64 + 8 * w); rv0 = *(const v4u*)(V0 + r_ * 128 + 16 * w); rv1 = *(const v4u*)(V0 + r_ * 128 + 16 * w + 8); \
    const size_t gm_ = ((size_t)b * 4096 + (size_t)(ci_) * 64 + jr) * 32; rli = GATES[gm_ + (dir ? 16 : 0) + h]; rf = GATES[gm_ + (dir ? 24 : 8) + h]; } while (0)
__device__ __forceinline__ void mlstm_phase(const int wv, LAS unsigned char* lds, const bf16* Q0, const bf16* K0, const bf16* V0, const float* GATES, bf16* HF, bf16* HB) {
    const int bx = blockIdx.x;
    if ((bx >> 3) & 1) return;
    const int seq = (bx >> 4) * 8 + (bx & 7);
    const int dir = seq & 1, bh = seq >> 1, b = bh >> 3, h = bh & 7;
    int ln_; asm volatile("v_mbcnt_lo_u32_b32 %0, -1, 0\n\tv_mbcnt_hi_u32_b32 %0, -1, %0" : "=v"(ln_)); const int tid = wv * 64 + ln_, lane = tid & 63, w = wv, fr = lane & 15, fq = lane >> 4;
    LAS bf16* Qs = (LAS bf16*)(lds); LAS bf16* Ks = (LAS bf16*)(lds + 9216); LAS bf16* Kwt = (LAS bf16*)(lds + 18432); LAS bf16* Ps = (LAS bf16*)(lds + 27648);
    LAS bf16* Vt = (LAS bf16*)(lds + 36864 + w * 2304); LAS bf16* Cs = (LAS bf16*)(lds + 55296 + w * 2304); LAS bf16* nb = (LAS bf16*)(lds + 73728 + w * 128);
    LAS float* gc = (LAS float*)(lds + 74752 + w * 1280); LAS float* gM = gc + 64; LAS float* gI = gc + 128; LAS float* gE = gc + 192; LAS float* gW = gc + 256;
    for (int i = lane; i < 2304 / 4; i += 64) ((LAS unsigned*)Cs)[i] = 0u;
    if (lane < 32) ((LAS unsigned*)nb)[lane] = 0u;
    f32x4 Cacc[4], Nacc[4];
#pragma unroll
    for (int i = 0; i < 4; ++i) { Cacc[i] = (f32x4){0.f, 0.f, 0.f, 0.f}; Nacc[i] = (f32x4){0.f, 0.f, 0.f, 0.f}; }
    float m = -1e30f;
    bf16* Hout = dir ? HB : HF;
    const size_t rowbase = (size_t)bh * 4096;
    const int jr = dir ? 63 - lane : lane;
    v4u rq, rk, rv0, rv1; float rli, rf;
    ML_LOAD(dir ? 63 : 0);
    const bf16x8 ones = (bf16x8){0x3F80, 0x3F80, 0x3F80, 0x3F80, 0x3F80, 0x3F80, 0x3F80, 0x3F80};
    const f32x4 z4 = (f32x4){0.f, 0.f, 0.f, 0.f};
#pragma unroll 1
    for (int step = 0; step < 64; ++step) {
        const int ci = dir ? 63 - step : step;
        const float lf = logsigmoid_f(rf);
        float bcs = lf;
        bcs += __uint_as_float((unsigned)__builtin_amdgcn_update_dpp(0, (int)__float_as_uint(bcs), 0x111, 0xF, 0xF, false));
        bcs += __uint_as_float((unsigned)__builtin_amdgcn_update_dpp(0, (int)__float_as_uint(bcs), 0x112, 0xF, 0xF, false));
        bcs += __uint_as_float((unsigned)__builtin_amdgcn_update_dpp(0, (int)__float_as_uint(bcs), 0x114, 0xF, 0xF, false));
        bcs += __uint_as_float((unsigned)__builtin_amdgcn_update_dpp(0, (int)__float_as_uint(bcs), 0x118, 0xF, 0xF, false));
        bcs += __uint_as_float((unsigned)__builtin_amdgcn_update_dpp(0, (int)__float_as_uint(bcs), 0x142, 0xA, 0xF, false));
        bcs += __uint_as_float((unsigned)__builtin_amdgcn_update_dpp(0, (int)__float_as_uint(bcs), 0x143, 0xC, 0xF, false));
        const float c = rli - bcs;
        float pm = c;
        const int NINFI = (int)0xFF800000u;
        pm = fmaxf(pm, __uint_as_float((unsigned)__builtin_amdgcn_update_dpp(NINFI, (int)__float_as_uint(pm), 0x111, 0xF, 0xF, false)));
        pm = fmaxf(pm, __uint_as_float((unsigned)__builtin_amdgcn_update_dpp(NINFI, (int)__float_as_uint(pm), 0x112, 0xF, 0xF, false)));
        pm = fmaxf(pm, __uint_as_float((unsigned)__builtin_amdgcn_update_dpp(NINFI, (int)__float_as_uint(pm), 0x114, 0xF, 0xF, false)));
        pm = fmaxf(pm, __uint_as_float((unsigned)__builtin_amdgcn_update_dpp(NINFI, (int)__float_as_uint(pm), 0x118, 0xF, 0xF, false)));
        pm = fmaxf(pm, __uint_as_float((unsigned)__builtin_amdgcn_update_dpp(NINFI, (int)__float_as_uint(pm), 0x142, 0xA, 0xF, false)));
        pm = fmaxf(pm, __uint_as_float((unsigned)__builtin_amdgcn_update_dpp(NINFI, (int)__float_as_uint(pm), 0x143, 0xC, 0xF, false)));
        const float M = fmaxf(m, pm);
        const float bL = __uint_as_float((unsigned)__builtin_amdgcn_readlane((int)__float_as_uint(bcs), 63)), Mlast = __uint_as_float((unsigned)__builtin_amdgcn_readlane((int)__float_as_uint(M), 63));
        gc[jr] = c; gM[jr] = M; gI[jr] = __expf(m - M); gE[jr] = __expf(-(bcs + M)); gW[jr] = __expf(c - Mlast);
        const float sp = __expf(m - Mlast), m_new = bL + Mlast;
        const float wr_ = gW[lane];
        *(LAS v4u*)(Qs + lane * 72 + 8 * w) = rq; *(LAS v4u*)(Ks + lane * 72 + 8 * w) = rk;
#pragma unroll
        for (int i = 0; i < 4; ++i) { const unsigned kw = rk[i]; Kwt[(8 * w + 2 * i) * 72 + lane] = (bf16)f2bf(bf_lo(kw) * wr_); Kwt[(8 * w + 2 * i + 1) * 72 + lane] = (bf16)f2bf(bf_hi(kw) * wr_); }
#pragma unroll
        for (int i = 0; i < 4; ++i) { Vt[(2 * i) * 72 + lane] = (bf16)(rv0[i] & 0xffffu); Vt[(2 * i + 1) * 72 + lane] = (bf16)(rv0[i] >> 16);
                                      Vt[(8 + 2 * i) * 72 + lane] = (bf16)(rv1[i] & 0xffffu); Vt[(9 + 2 * i) * 72 + lane] = (bf16)(rv1[i] >> 16); }
        __syncthreads();
        if (step < 63) ML_LOAD(dir ? 62 - step : step + 1);
        {
            const int st = w >> 1;
            const bf16x8 a0 = *(const LAS bf16x8*)(Ks + (16 * st + fr) * 72 + 8 * fq), a1 = *(const LAS bf16x8*)(Ks + (16 * st + fr) * 72 + 32 + 8 * fq);
#pragma unroll
            for (int u = 0; u < 2; ++u) { const int tt = 2 * (w & 1) + u;
                const bf16x8 b0 = *(const LAS bf16x8*)(Qs + (16 * tt + fr) * 72 + 8 * fq), b1 = *(const LAS bf16x8*)(Qs + (16 * tt + fr) * 72 + 32 + 8 * fq);
                f32x4 acc = mfma16(a0, b0, z4); acc = mfma16(a1, b1, acc);
                const int t = 16 * tt + fr; const float Mt = gM[t]; float pv[4];
#pragma unroll
                for (int i = 0; i < 4; ++i) { const int s = 16 * st + 4 * fq + i; const bool valid = dir ? (s >= t) : (s <= t); const float e = __expf(gc[s] - Mt); pv[i] = valid ? acc[i] * e : 0.f; }
                *(LAS u32x2*)(Ps + t * 72 + 16 * st + 4 * fq) = pack4(pv[0], pv[1], pv[2], pv[3]); }
        }
        __syncthreads();
        const bf16x8 aV0 = *(const LAS bf16x8*)(Vt + fr * 72 + 8 * fq), aV1 = *(const LAS bf16x8*)(Vt + fr * 72 + 32 + 8 * fq);
        {
            const bf16x8 aC0 = *(const LAS bf16x8*)(Cs + fr * 72 + 8 * fq), aC1 = *(const LAS bf16x8*)(Cs + fr * 72 + 32 + 8 * fq);
            const bf16x8 aN0 = *(const LAS bf16x8*)(nb + 8 * fq), aN1 = *(const LAS bf16x8*)(nb + 32 + 8 * fq);
#pragma unroll
            for (int tt = 0; tt < 4; ++tt) {
                const bf16x8 bP0 = *(const LAS bf16x8*)(Ps + (16 * tt + fr) * 72 + 8 * fq), bP1 = *(const LAS bf16x8*)(Ps + (16 * tt + fr) * 72 + 32 + 8 * fq);
                const bf16x8 bQ0 = *(const LAS bf16x8*)(Qs + (16 * tt + fr) * 72 + 8 * fq), bQ1 = *(const LAS bf16x8*)(Qs + (16 * tt + fr) * 72 + 32 + 8 * fq);
                f32x4 acc1 = mfma16(aV0, bP0, z4); acc1 = mfma16(aV1, bP1, acc1);
                f32x4 acc2 = mfma16(aC0, bQ0, z4); acc2 = mfma16(aC1, bQ1, acc2);
                f32x4 d1 = mfma16(ones, bP0, z4); d1 = mfma16(ones, bP1, d1);
                f32x4 d2 = mfma16(aN0, bQ0, z4); d2 = mfma16(aN1, bQ1, d2);
                const int t = 16 * tt + fr; const float it = gI[t], en = gE[t];
                const float den = d1[0] + it * d2[0]; const float inv = 1.f / fmaxf(fabsf(den), en);
                *(u32x2*)(Hout + ((size_t)b * 4096 + (size_t)ci * 64 + t) * 1024 + h * 128 + 16 * w + 4 * fq) =
                    pack4((acc1[0] + it * acc2[0]) * inv, (acc1[1] + it * acc2[1]) * inv, (acc1[2] + it * acc2[2]) * inv, (acc1[3] + it * acc2[3]) * inv);
            }
        }
#pragma unroll
        for (int dt = 0; dt < 4; ++dt) { Cacc[dt] = Cacc[dt] * sp; Nacc[dt] = Nacc[dt] * sp;
            const bf16x8 aK0 = *(const LAS bf16x8*)(Kwt + (16 * dt + fr) * 72 + 8 * fq), aK1 = *(const LAS bf16x8*)(Kwt + (16 * dt + fr) * 72 + 32 + 8 * fq);
            Cacc[dt] = mfma16(aK0, aV0, Cacc[dt]); Cacc[dt] = mfma16(aK1, aV1, Cacc[dt]);
            Nacc[dt] = mfma16(aK0, ones, Nacc[dt]); Nacc[dt] = mfma16(aK1, ones, Nacc[dt]); }
#pragma unroll
        for (int dt = 0; dt < 4; ++dt) { *(LAS u32x2*)(Cs + fr * 72 + 16 * dt + 4 * fq) = pack4(Cacc[dt][0], Cacc[dt][1], Cacc[dt][2], Cacc[dt][3]);
                                         *(LAS u32x2*)(nb + 16 * dt + 4 * fq) = pack4(Nacc[dt][0], Nacc[dt][1], Nacc[dt][2], Nacc[dt][3]); }
        m = m_new;
        __syncthreads();
    }
}
#undef ML_LOAD

__device__ __forceinline__ void hs_pass(const bf16* HF, const bf16* HB, const bf16* OG, const float* hg, bf16* HS, int gw, int NGW, int lane) {
    for (int m = gw; m < T; m += NGW) {
        const size_t off = (size_t)m * 1024 + 16 * lane;
        const v4u f0 = *(const v4u*)(HF + off), f1 = *(const v4u*)(HF + off + 8), b0 = *(const v4u*)(HB + off), b1 = *(const v4u*)(HB + off + 8), o0 = *(const v4u*)(OG + off), o1 = *(const v4u*)(OG + off + 8);
        float x[16], og[16];
#pragma unroll
        for (int i = 0; i < 4; ++i) { x[2 * i] = bf_lo(f0[i]) + bf_lo(b0[i]); x[2 * i + 1] = bf_hi(f0[i]) + bf_hi(b0[i]); x[8 + 2 * i] = bf_lo(f1[i]) + bf_lo(b1[i]); x[9 + 2 * i] = bf_hi(f1[i]) + bf_hi(b1[i]);
                                      og[2 * i] = bf_lo(o0[i]); og[2 * i + 1] = bf_hi(o0[i]); og[8 + 2 * i] = bf_lo(o1[i]); og[9 + 2 * i] = bf_hi(o1[i]); }
        float ss = 0.f;
#pragma unroll
        for (int i = 0; i < 16; ++i) ss += x[i] * x[i];
        ss += shx(ss, lane, 1); ss += shx(ss, lane, 2); ss += shx(ss, lane, 4);
        const float rstd = rsqrtf(ss * (1.f / 128.f) + EPS);
        float y[16];
#pragma unroll
        for (int i = 0; i < 16; ++i) y[i] = x[i] * rstd * hg[16 * lane + i] * (1.f / (1.f + __expf(-og[i])));
        v4u w0, w1;
#pragma unroll
        for (int i = 0; i < 4; ++i) { w0[i] = pk2(y[2 * i], y[2 * i + 1]); w1[i] = pk2(y[8 + 2 * i], y[9 + 2 * i]); }
        *(v4u*)(HS + off) = w0; *(v4u*)(HS + off + 8) = w1;
    }
}

__device__ __forceinline__ void glds16(const void* gsrc, unsigned lds_dst) { unsigned keep;
    asm volatile("s_mov_b32 %0, m0\n\ts_mov_b32 m0, %2\n\ts_nop 0\n\tglobal_load_lds_dwordx4 %1, off\n\ts_mov_b32 m0, %0" : "=&s"(keep) : "v"(gsrc), "s"(lds_dst) : "memory"); }
#define AT_WAIT_BAR() asm volatile("s_waitcnt vmcnt(0) lgkmcnt(0)\n\ts_barrier" ::: "memory")

#define TK_CE(a, b) do { const float h_ = fmaxf(a, b), l_ = fminf(a, b); a = h_; b = l_; } while (0)
#define BITONIC_MERGE16(x) do { _Pragma("unroll") for (int d_ = 8; d_ >= 1; d_ >>= 1) { _Pragma("unroll") for (int i_ = 0; i_ < 16; ++i_) if ((i_ & d_) == 0) TK_CE(x[i_], x[i_ + d_]); } } while (0)
#define BITONIC_SORT16(x) do { _Pragma("unroll") for (int k_ = 2; k_ <= 16; k_ <<= 1) { _Pragma("unroll") for (int d_ = k_ >> 1; d_ >= 1; d_ >>= 1) { _Pragma("unroll") for (int i_ = 0; i_ < 16; ++i_) { const int l_i = i_ ^ d_; \
    if (l_i > i_) { if ((i_ & k_) == 0 || k_ == 16) TK_CE(x[i_], x[l_i]); else TK_CE(x[l_i], x[i_]); } } } } } while (0)
#define TK_INSERT(v, x) do { float c_ = (x); _Pragma("unroll") for (int j_ = 0; j_ < 16; ++j_) { const float h_ = fmaxf(v[j_], c_); c_ = fminf(v[j_], c_); v[j_] = h_; } } while (0)
#define TK_DMA(st_, b_) do { _Pragma("unroll") for (int g_ = 0; g_ < 2; ++g_) { const int hp_ = ((g_ * 4 + ((st_) >> 1)) * 2 + ((st_) & 1)); \
    _Pragma("unroll") for (int i_ = 0; i_ < 4; ++i_) { const int q_ = w * 4 + i_, row_ = 4 * q_ + (lane >> 4), ch_ = (lane & 15) ^ (row_ & 15); \
        glds16(KEYS + ((size_t)(hp_ * 128 + row_)) * 128 + ch_ * 8, (unsigned)__builtin_amdgcn_readfirstlane((int)(ldsb + ((b_) * 2 + g_) * 32768 + q_ * 1024))); } } } while (0)
__device__ __forceinline__ void peer_topk_phase(const int wv, LAS unsigned char* lds, int vcu, const bf16* PQ, const bf16* KEYS, int* EXPERTS, float* GATESP) {
    int ln_; asm volatile("v_mbcnt_lo_u32_b32 %0, -1, 0\n\tv_mbcnt_hi_u32_b32 %0, -1, %0" : "=v"(ln_)); const int tid = wv * 64 + ln_, lane = tid & 63, w = wv, r32 = lane & 31, hi = lane >> 5;
    const int t = vcu * 128 + (w & 3) * 32 + r32, hg = w >> 2;
    const float NINF = -INFINITY;
    const unsigned ldsb = (unsigned)(uintptr_t)lds;
    TK_DMA(0, 0);
    AT_WAIT_BAR();
#pragma unroll 1
    for (int hh = 0; hh < 4; ++hh) {
        const int head = hg * 4 + hh;
        float L0[16], L1[16];
#pragma unroll
        for (int j = 0; j < 16; ++j) { L0[j] = 0.f; L1[j] = 0.f; }
#pragma unroll 1
        for (int p = 0; p < 2; ++p) {
            const int st = hh * 2 + p, buf = st & 1;
            if (st < 7) TK_DMA(st + 1, buf ^ 1);
            bf16x8 bq[8];
#pragma unroll
            for (int ks = 0; ks < 8; ++ks) bq[ks] = *(const bf16x8*)(PQ + (size_t)t * 2048 + head * 256 + p * 128 + ks * 16 + 8 * hi);
            const LAS unsigned char* kb = lds + (buf * 2 + hg) * 32768 + r32 * 256;
            f32x16 acc[4];
#pragma unroll
            for (int nt = 0; nt < 4; ++nt) {
#pragma unroll
                for (int r = 0; r < 16; ++r) acc[nt][r] = 0.f;
#pragma unroll
                for (int ks = 0; ks < 8; ++ks) { const bf16x8 a = *(const LAS bf16x8*)(kb + nt * 8192 + (((2 * ks + hi) ^ (r32 & 15)) << 4)); acc[nt] = mfma32(a, bq[ks], acc[nt]); }
            }
            float v[16];
            {
                float blk[4][16];
#pragma unroll
                for (int nt = 0; nt < 4; ++nt)
#pragma unroll
                    for (int r = 0; r < 16; ++r) { const int n = nt * 32 + (r & 3) + 8 * (r >> 2) + 4 * hi; blk[nt][r] = __uint_as_float((__float_as_uint(acc[nt][r]) & ~0x7Fu) | (unsigned)(127 - n)); }
#pragma unroll
                for (int nt = 0; nt < 4; ++nt) BITONIC_SORT16(blk[nt]);
#pragma unroll
                for (int i = 0; i < 16; ++i) { blk[0][i] = fmaxf(blk[0][i], blk[1][15 - i]); blk[2][i] = fmaxf(blk[2][i], blk[3][15 - i]); }
                BITONIC_MERGE16(blk[0]); BITONIC_MERGE16(blk[2]);
#pragma unroll
                for (int i = 0; i < 16; ++i) v[i] = fmaxf(blk[0][i], blk[2][15 - i]);
                BITONIC_MERGE16(v);
            }
            {
                float wv_[16];
#pragma unroll
                for (int j = 0; j < 16; ++j) wv_[j] = shx(v[15 - j], lane, 32);
#pragma unroll
                for (int j = 0; j < 16; ++j) v[j] = fmaxf(v[j], wv_[j]);
                BITONIC_MERGE16(v);
            }
            if (p == 0) {
#pragma unroll
                for (int j = 0; j < 16; ++j) L0[j] = v[j];
            } else {
#pragma unroll
                for (int j = 0; j < 16; ++j) L1[j] = v[j];
            }            AT_WAIT_BAR();
        }
        float tv[16];
        unsigned IA[4] = {0u, 0u, 0u, 0u}, IB[4] = {0u, 0u, 0u, 0u};
#pragma unroll
        for (int i = 0; i < 16; ++i) { IA[i >> 2] |= (127u - (__float_as_uint(L0[i]) & 0x7Fu)) << (8 * (i & 3)); IB[i >> 2] |= (127u - (__float_as_uint(L1[i]) & 0x7Fu)) << (8 * (i & 3)); }
        {
            float cb[4][16]; int cn = 0;
#pragma unroll
            for (int i = 0; i < 16; ++i) {
                const float va = __uint_as_float(__float_as_uint(L0[i]) & ~0x7Fu);
#pragma unroll
                for (int j = 0; j < 16; ++j) if ((i + 1) * (j + 1) <= 16) {
                    const float vb = __uint_as_float(__float_as_uint(L1[j]) & ~0x7Fu);
                    cb[cn >> 4][cn & 15] = __uint_as_float((__float_as_uint(va + vb) & ~0xFFu) | (unsigned)(255 - (i * 16 + j)));
                    ++cn;
                }
            }
#pragma unroll
            for (int c = 50; c < 64; ++c) cb[c >> 4][c & 15] = NINF;
#pragma unroll
            for (int nt = 0; nt < 4; ++nt) BITONIC_SORT16(cb[nt]);
#pragma unroll
            for (int i = 0; i < 16; ++i) { cb[0][i] = fmaxf(cb[0][i], cb[1][15 - i]); cb[2][i] = fmaxf(cb[2][i], cb[3][15 - i]); }
            BITONIC_MERGE16(cb[0]); BITONIC_MERGE16(cb[2]);
#pragma unroll
            for (int i = 0; i < 16; ++i) tv[i] = fmaxf(cb[0][i], cb[2][15 - i]);
            BITONIC_MERGE16(tv);
        }
        int ti[16];
#pragma unroll
        for (int j = 0; j < 16; ++j) { const unsigned kb = __float_as_uint(tv[j]); const unsigned flat = 255u - (kb & 0xFFu); const unsigned fi = flat >> 4, fj = flat & 15u;
            const unsigned ra = (fi < 8u) ? ((fi < 4u) ? IA[0] : IA[1]) : ((fi < 12u) ? IA[2] : IA[3]);
            const unsigned rb = (fj < 8u) ? ((fj < 4u) ? IB[0] : IB[1]) : ((fj < 12u) ? IB[2] : IB[3]);
            ti[j] = (int)(((ra >> (8u * (fi & 3u))) & 0xFFu) * 128u + ((rb >> (8u * (fj & 3u))) & 0xFFu));
            tv[j] = __uint_as_float(kb & ~0xFFu); }
        float e[16], sum = 0.f;
#pragma unroll
        for (int j = 0; j < 16; ++j) { e[j] = __expf(tv[j] - tv[0]); sum += e[j]; }
        const float inv = 1.f / sum;
        if (hi == 0) { int* ep = EXPERTS + (size_t)t * 128 + head * 16;
#pragma unroll
            for (int j = 0; j < 4; ++j) *(v4u*)(ep + 4 * j) = (v4u){(unsigned)ti[4 * j], (unsigned)ti[4 * j + 1], (unsigned)ti[4 * j + 2], (unsigned)ti[4 * j + 3]}; }
        else { float* gp = GATESP + (size_t)t * 128 + head * 16;
#pragma unroll
            for (int j = 0; j < 4; ++j) *(f32x4*)(gp + 4 * j) = (f32x4){e[4 * j] * inv, e[4 * j + 1] * inv, e[4 * j + 2] * inv, e[4 * j + 3] * inv}; }
    }
}

__device__ __forceinline__ float cvt_ub0(unsigned x) { float r; asm("v_cvt_f32_ubyte0 %0, %1" : "=v"(r) : "v"(x)); return r; }
__device__ __forceinline__ float cvt_ub1(unsigned x) { float r; asm("v_cvt_f32_ubyte1 %0, %1" : "=v"(r) : "v"(x)); return r; }
__device__ __forceinline__ float cvt_ub2(unsigned x) { float r; asm("v_cvt_f32_ubyte2 %0, %1" : "=v"(r) : "v"(x)); return r; }
__device__ __forceinline__ float cvt_ub3(unsigned x) { float r; asm("v_cvt_f32_ubyte3 %0, %1" : "=v"(r) : "v"(x)); return r; }
__device__ __forceinline__ void quant4_rows(const float* src, unsigned char* dst, float* scale, int nrows, int gw, int NGW, int lane) {
    for (int r = gw; r < nrows; r += NGW) {
        const f32x4* sp = (const f32x4*)(src + (size_t)r * 1024) + 4 * lane;
        f32x4 v[4]; float am = 0.f, ss = 0.f;
#pragma unroll
        for (int j = 0; j < 4; ++j) { v[j] = sp[j]; am = fmaxf(am, fmaxf(fmaxf(fabsf(v[j].x), fabsf(v[j].y)), fmaxf(fabsf(v[j].z), fabsf(v[j].w)))); ss += (v[j].x * v[j].x + v[j].y * v[j].y) + (v[j].z * v[j].z + v[j].w * v[j].w); }
#pragma unroll
        for (int o = 1; o < 64; o <<= 1) { am = fmaxf(am, shx(am, lane, o)); ss += shx(ss, lane, o); }
        const float step = fminf(am * (1.f / 7.5f), 0.3352f * sqrtf(ss * (1.f / 1024.f)));
        const float inv = step > 0.f ? 1.f / step : 0.f;
        unsigned q[16];
#pragma unroll
        for (int j = 0; j < 4; ++j) { q[4 * j] = (unsigned)fminf(fmaxf(rintf(v[j].x * inv + 7.5f), 0.f), 15.f); q[4 * j + 1] = (unsigned)fminf(fmaxf(rintf(v[j].y * inv + 7.5f), 0.f), 15.f);
                                      q[4 * j + 2] = (unsigned)fminf(fmaxf(rintf(v[j].z * inv + 7.5f), 0.f), 15.f); q[4 * j + 3] = (unsigned)fminf(fmaxf(rintf(v[j].w * inv + 7.5f), 0.f), 15.f); }
        u32x2 w;
        w.x = (q[0] | (q[4] << 4)) | ((q[1] | (q[5] << 4)) << 8) | ((q[2] | (q[6] << 4)) << 16) | ((q[3] | (q[7] << 4)) << 24);
        w.y = (q[8] | (q[12] << 4)) | ((q[9] | (q[13] << 4)) << 8) | ((q[10] | (q[14] << 4)) << 16) | ((q[11] | (q[15] << 4)) << 24);
        *(u32x2*)(dst + (size_t)r * 512 + 8 * lane) = w;
        if (lane == 0) scale[r] = step;
    }
}

#define RED_STEP(N, S) do { const bool up_ = (lane & (S)) != 0; _Pragma("unroll") for (int j_ = 0; j_ < (N); ++j_) { const int a_ = p[j_], b_ = p[j_ + (N)]; const int send_ = up_ ? a_ : b_, keep_ = up_ ? b_ : a_; p[j_] = keep_ + shxi(send_, lane, (S)); } } while (0)
#define RED16(dst) do { RED_STEP(8, 8); RED_STEP(4, 4); RED_STEP(2, 2); RED_STEP(1, 1); int s_ = p[0]; s_ += shxi(s_, lane, 16); s_ += shxi(s_, lane, 32); dst = s_; } while (0)
#define G_SB() __builtin_amdgcn_sched_barrier(0)
#define G_LOAD(buf, tab, evec, jb) do { _Pragma("unroll") for (int jj_ = 0; jj_ < 16; ++jj_) { const int e_ = __builtin_amdgcn_readlane(evec, (jb) + jj_); buf[jj_] = __builtin_amdgcn_raw_buffer_load_b64(rs_##tab, (int)voff, e_ << 9, 0); } } while (0)
#define U_COMP(buf) do { _Pragma("unroll") for (int jj_ = 0; jj_ < 16; ++jj_) { const unsigned w0_ = buf[jj_].x, w1_ = buf[jj_].y; \
    int d_ = __builtin_amdgcn_sdot4((int)(w0_ & 0x0F0F0F0Fu), hq[0], 0, false); d_ = __builtin_amdgcn_sdot4((int)((w0_ >> 4) & 0x0F0F0F0Fu), hq[1], d_, false); \
    d_ = __builtin_amdgcn_sdot4((int)(w1_ & 0x0F0F0F0Fu), hq[2], d_, false); d_ = __builtin_amdgcn_sdot4((int)((w1_ >> 4) & 0x0F0F0F0Fu), hq[3], d_, false); p[jj_] = d_; } } while (0)
#define V_DW(o0, o1, o2, o3, wd, cs) do { float t0_, t1_, t2_, t3_; asm volatile("v_cvt_f32_ubyte0 %4, %8\n\tv_cvt_f32_ubyte1 %5, %8\n\tv_cvt_f32_ubyte2 %6, %8\n\tv_cvt_f32_ubyte3 %7, %8\n\tv_fmac_f32 %0, %9, %4\n\tv_fmac_f32 %1, %9, %5\n\tv_fmac_f32 %2, %9, %6\n\tv_fmac_f32 %3, %9, %7" \
    : "+v"(o0), "+v"(o1), "+v"(o2), "+v"(o3), "=&v"(t0_), "=&v"(t1_), "=&v"(t2_), "=&v"(t3_) : "v"(wd), "s"(cs)); } while (0)
#define V_COMP(buf, cvec, jb) do { _Pragma("unroll") for (int jj_ = 0; jj_ < 16; ++jj_) { const float c_ = __uint_as_float(__builtin_amdgcn_readlane(__float_as_uint(cvec), (jb) + jj_)); const unsigned w0_ = buf[jj_].x, w1_ = buf[jj_].y; \
    V_DW(o[0], o[1], o[2], o[3], w0_ & 0x0F0F0F0Fu, c_); V_DW(o[4], o[5], o[6], o[7], (w0_ >> 4) & 0x0F0F0F0Fu, c_); V_DW(o[8], o[9], o[10], o[11], w1_ & 0x0F0F0F0Fu, c_); V_DW(o[12], o[13], o[14], o[15], (w1_ >> 4) & 0x0F0F0F0Fu, c_); } } while (0)
template <bool NEXT_NORM>
__device__ __forceinline__ void peer_gather_phase(const int wv, bool dry, int vcu, const bf16* HN, const int* EXPERTS, const float* GATESP, const unsigned char* U, const float* SU, const unsigned char* Vtab, const float* SV,
                                                  float* X, const float* gnext, bf16* XN) {
    int ln_; asm volatile("v_mbcnt_lo_u32_b32 %0, -1, 0\n\tv_mbcnt_hi_u32_b32 %0, -1, %0" : "=v"(ln_)); const int tid = wv * 64 + ln_, lane = tid & 63, w = wv;
    const __amdgpu_buffer_rsrc_t rs_U = __builtin_amdgcn_make_buffer_rsrc((void*)U, (short)0, 16384 * 512, 0x00020000), rs_Vtab = __builtin_amdgcn_make_buffer_rsrc((void*)Vtab, (short)0, 16384 * 512, 0x00020000);
    const unsigned voff = (unsigned)lane * 8u;
    const int lg = lane >> 4;
#pragma unroll 1
    for (int i = 0; i < 16; ++i) {
        const int t = vcu * 128 + w * 16 + i;
        const int ev0 = EXPERTS[(size_t)t * 128 + lane], ev1 = EXPERTS[(size_t)t * 128 + 64 + lane];
        const float gv0 = GATESP[(size_t)t * 128 + lane], gv1 = GATESP[(size_t)t * 128 + 64 + lane];
        const v4u h0 = *(const v4u*)(HN + (size_t)t * 1024 + 16 * lane), h1 = *(const v4u*)(HN + (size_t)t * 1024 + 16 * lane + 8);
        float hf[16]; float am = 0.f;
#pragma unroll
        for (int k = 0; k < 4; ++k) { hf[2 * k] = bf_lo(h0[k]); hf[2 * k + 1] = bf_hi(h0[k]); hf[8 + 2 * k] = bf_lo(h1[k]); hf[9 + 2 * k] = bf_hi(h1[k]); }
#pragma unroll
        for (int k = 0; k < 16; ++k) am = fmaxf(am, fabsf(hf[k]));
#pragma unroll
        for (int o = 1; o < 64; o <<= 1) am = fmaxf(am, shx(am, lane, o));
        const float hinv = am > 0.f ? 127.f / am : 0.f, sh = am * (1.f / 127.f);
        int hq[4]; int hs = 0;
#pragma unroll
        for (int k = 0; k < 4; ++k) { const int q0 = (int)rintf(hf[4 * k] * hinv), q1 = (int)rintf(hf[4 * k + 1] * hinv), q2 = (int)rintf(hf[4 * k + 2] * hinv), q3 = (int)rintf(hf[4 * k + 3] * hinv); hs += (q0 + q1) + (q2 + q3);
            hq[k] = (int)(((unsigned)(q0 & 0xff)) | ((unsigned)(q1 & 0xff) << 8) | ((unsigned)(q2 & 0xff) << 16) | ((unsigned)(q3 & 0xff) << 24)); }
#pragma unroll
        for (int o = 1; o < 64; o <<= 1) hs += shxi(hs, lane, o);
        const float hoff = 7.5f * (float)hs;
        const float su0 = SU[ev0], su1 = SU[ev1], sv0 = SV[ev0], sv1 = SV[ev1];
        float o[16];
#pragma unroll
        for (int k = 0; k < 16; ++k) o[k] = 0.f;
        int p[16], r0, r1, r2, r3, r4, r5, r6, r7;
        u32x2 A[16], B[16], C[16];
        G_LOAD(A, U, ev0, 0); G_LOAD(B, U, ev0, 16); G_SB();
        G_LOAD(C, U, ev0, 32); G_SB(); U_COMP(A); RED16(r0); G_SB();
        G_LOAD(A, U, ev0, 48); G_SB(); U_COMP(B); RED16(r1); G_SB();
        G_LOAD(B, U, ev1, 0); G_SB(); U_COMP(C); RED16(r2); G_SB();
        G_LOAD(C, U, ev1, 16); G_SB(); U_COMP(A); RED16(r3); G_SB();
        G_LOAD(A, U, ev1, 32); G_SB(); U_COMP(B); RED16(r4); G_SB();
        G_LOAD(B, U, ev1, 48); G_SB(); U_COMP(C); RED16(r5); G_SB();
        G_LOAD(C, Vtab, ev0, 0); G_SB(); U_COMP(A); RED16(r6); G_SB();
        G_LOAD(A, Vtab, ev0, 16); G_SB(); U_COMP(B); RED16(r7); G_SB();
        const int d0 = lg == 0 ? r0 : (lg == 1 ? r1 : (lg == 2 ? r2 : r3)), d1 = lg == 0 ? r4 : (lg == 1 ? r5 : (lg == 2 ? r6 : r7));
        float act0 = ((float)d0 - hoff) * (sh * su0), act1 = ((float)d1 - hoff) * (sh * su1);
#ifdef PROBE_NOFFN
        const float coef0 = 0.f * act0, coef1 = 0.f * act1;
#else
        const float coef0 = gv0 * (0.5f * act0 * (1.f + erff(act0 * 0.70710678118f))) * sv0, coef1 = gv1 * (0.5f * act1 * (1.f + erff(act1 * 0.70710678118f))) * sv1;
#endif
        G_SB();
        G_LOAD(B, Vtab, ev0, 32); G_SB(); V_COMP(C, coef0, 0); G_SB();
        G_LOAD(C, Vtab, ev0, 48); G_SB(); V_COMP(A, coef0, 16); G_SB();
        G_LOAD(A, Vtab, ev1, 0); G_SB(); V_COMP(B, coef0, 32); G_SB();
        G_LOAD(B, Vtab, ev1, 16); G_SB(); V_COMP(C, coef0, 48); G_SB();
        G_LOAD(C, Vtab, ev1, 32); G_SB(); V_COMP(A, coef1, 0); G_SB();
        G_LOAD(A, Vtab, ev1, 48); G_SB(); V_COMP(B, coef1, 16); G_SB();
        V_COMP(C, coef1, 32); G_SB(); V_COMP(A, coef1, 48); G_SB();
        const float corr = 7.5f * wave_sum(coef0 + coef1, lane);
        float* xr = X + (size_t)t * 1024 + 16 * lane;
        f32x4 xv[4];
#pragma unroll
        for (int k = 0; k < 4; ++k) { xv[k] = *(const f32x4*)(xr + 4 * k); xv[k] += (f32x4){o[4 * k] - corr, o[4 * k + 1] - corr, o[4 * k + 2] - corr, o[4 * k + 3] - corr}; }
        if (!dry) {
#pragma unroll
            for (int k = 0; k < 4; ++k) *(f32x4*)(xr + 4 * k) = xv[k]; }
        if (NEXT_NORM && !dry) {
            float ss = 0.f;
#pragma unroll
            for (int k = 0; k < 4; ++k) ss += (xv[k].x * xv[k].x + xv[k].y * xv[k].y) + (xv[k].z * xv[k].z + xv[k].w * xv[k].w);
            const float rstd = rsqrtf(wave_sum(ss, lane) * (1.f / 1024.f) + EPS);
            v4u wa, wb;
#pragma unroll
            for (int k = 0; k < 4; ++k) { const f32x4 g = *(const f32x4*)(gnext + 16 * lane + 4 * k); const unsigned lo = pk2(xv[k].x * rstd * g.x, xv[k].y * rstd * g.y), hi2 = pk2(xv[k].z * rstd * g.z, xv[k].w * rstd * g.w);
                if (k < 2) { wa[2 * k] = lo; wa[2 * k + 1] = hi2; } else { wb[2 * (k - 2)] = lo; wb[2 * (k - 2) + 1] = hi2; } }
            *(v4u*)(XN + (size_t)t * 1024 + 16 * lane) = wa; *(v4u*)(XN + (size_t)t * 1024 + 16 * lane + 8) = wb;
        }
    }
}

__device__ __forceinline__ void rms_quant_pass(const float* X, const float* g, bf16* XN, unsigned char* HQ, float* SH, float* HS, int gw, int NGW, int lane) {
    for (int m = gw; m < T; m += NGW) {
        const f32x4* xr = (const f32x4*)(X + (size_t)m * D) + lane; const f32x4* gr = (const f32x4*)g + lane;
        f32x4 v[4]; float s = 0.f;
#pragma unroll
        for (int j = 0; j < 4; ++j) { v[j] = xr[64 * j]; s += (v[j].x * v[j].x + v[j].y * v[j].y) + (v[j].z * v[j].z + v[j].w * v[j].w); }
        const float rstd = rsqrtf(wave_sum(s, lane) * (1.f / 1024.f) + EPS);
        unsigned long long* o8 = (unsigned long long*)(XN + (size_t)m * D) + lane;
        float am = 0.f;
#pragma unroll
        for (int j = 0; j < 4; ++j) { const f32x4 gg = gr[64 * j]; v[j].x = v[j].x * rstd * gg.x; v[j].y = v[j].y * rstd * gg.y; v[j].z = v[j].z * rstd * gg.z; v[j].w = v[j].w * rstd * gg.w;
            o8[64 * j] = (unsigned long long)pk2(v[j].x, v[j].y) | ((unsigned long long)pk2(v[j].z, v[j].w) << 32);
            am = fmaxf(am, fmaxf(fmaxf(fabsf(v[j].x), fabsf(v[j].y)), fmaxf(fabsf(v[j].z), fabsf(v[j].w)))); }
#pragma unroll
        for (int o = 1; o < 64; o <<= 1) am = fmaxf(am, shx(am, lane, o));
        const float hinv = am > 0.f ? 127.f / am : 0.f;
        int hs = 0;
        unsigned* q4 = (unsigned*)(HQ + (size_t)m * D) + lane;
#pragma unroll
        for (int j = 0; j < 4; ++j) { const int q0 = (int)rintf(v[j].x * hinv), q1 = (int)rintf(v[j].y * hinv), q2 = (int)rintf(v[j].z * hinv), q3 = (int)rintf(v[j].w * hinv); hs += (q0 + q1) + (q2 + q3);
            q4[64 * j] = ((unsigned)(q0 & 0xff)) | ((unsigned)(q1 & 0xff) << 8) | ((unsigned)(q2 & 0xff) << 16) | ((unsigned)(q3 & 0xff) << 24); }
#pragma unroll
        for (int o = 1; o < 64; o <<= 1) hs += shxi(hs, lane, o);
        if (lane == 0) { SH[m] = am * (1.f / 127.f); HS[m] = (float)hs; }
    }
}
__device__ __forceinline__ int dpp_add_quad(int d) {
    d += __builtin_amdgcn_update_dpp(0, d, 0xB1, 0xF, 0xF, true);
    d += __builtin_amdgcn_update_dpp(0, d, 0x4E, 0xF, 0xF, true);
    return d;
}
__device__ __forceinline__ int dpp_add_oct(int d) {
    d += __builtin_amdgcn_update_dpp(0, d, 0xB1, 0xF, 0xF, true);
    d += __builtin_amdgcn_update_dpp(0, d, 0x4E, 0xF, 0xF, true);
    d += __builtin_amdgcn_update_dpp(0, d, 0x141, 0xF, 0xF, true);
    return d;
}
#define G1_IDS(E_, H0_, H1_, it_) do { const int t_ = t0 + ((it_) >> 1), hf_ = (it_) & 1; const v4u* ep_ = (const v4u*)(EXPERTS + (size_t)t_ * 128 + 16 * oct + 8 * hf_); const v4u ea_ = ep_[0], eb_ = ep_[1]; \
    E_[0] = (int)ea_.x; E_[1] = (int)ea_.y; E_[2] = (int)ea_.z; E_[3] = (int)ea_.w; E_[4] = (int)eb_.x; E_[5] = (int)eb_.y; E_[6] = (int)eb_.z; E_[7] = (int)eb_.w; \
    H0_ = *(const v4u*)(HQ + (size_t)t_ * 1024 + 256 * s + 32 * q8); H1_ = *(const v4u*)(HQ + (size_t)t_ * 1024 + 256 * s + 32 * q8 + 16); } while (0)
#define G1_ROWS(R_, E_) do { _Pragma("unroll") for (int j_ = 0; j_ < 8; ++j_) R_[j_] = __builtin_amdgcn_raw_buffer_load_b128(rs_U, (E_[j_] << 9) + soff, 0, 0); } while (0)
#define G1_COMP(R_, H0_, H1_, it_) do { int dd_[8]; _Pragma("unroll") for (int j_ = 0; j_ < 8; ++j_) { \
    int d_ = __builtin_amdgcn_sdot4((int)(R_[j_].x & 0x0F0F0F0Fu), (int)H0_.x, 0, false); d_ = __builtin_amdgcn_sdot4((int)((R_[j_].x >> 4) & 0x0F0F0F0Fu), (int)H0_.y, d_, false); \
    d_ = __builtin_amdgcn_sdot4((int)(R_[j_].y & 0x0F0F0F0Fu), (int)H0_.z, d_, false); d_ = __builtin_amdgcn_sdot4((int)((R_[j_].y >> 4) & 0x0F0F0F0Fu), (int)H0_.w, d_, false); \
    d_ = __builtin_amdgcn_sdot4((int)(R_[j_].z & 0x0F0F0F0Fu), (int)H1_.x, d_, false); d_ = __builtin_amdgcn_sdot4((int)((R_[j_].z >> 4) & 0x0F0F0F0Fu), (int)H1_.y, d_, false); \
    d_ = __builtin_amdgcn_sdot4((int)(R_[j_].w & 0x0F0F0F0Fu), (int)H1_.z, d_, false); d_ = __builtin_amdgcn_sdot4((int)((R_[j_].w >> 4) & 0x0F0F0F0Fu), (int)H1_.w, d_, false); \
    dd_[j_] = dpp_add_oct(d_); } \
    if (q8 == 0) { v4u* pp_ = (v4u*)(PART + ((size_t)s * T + t0 + ((it_) >> 1)) * 128 + 16 * oct + 8 * ((it_) & 1)); pp_[0] = (v4u){(unsigned)dd_[0], (unsigned)dd_[1], (unsigned)dd_[2], (unsigned)dd_[3]}; pp_[1] = (v4u){(unsigned)dd_[4], (unsigned)dd_[5], (unsigned)dd_[6], (unsigned)dd_[7]}; } } while (0)
__device__ __forceinline__ void peer_g1_phase(const int wv, int vcu, const unsigned char* HQ, const int* EXPERTS, const unsigned char* U, int* PART) {
    int ln_; asm volatile("v_mbcnt_lo_u32_b32 %0, -1, 0\n\tv_mbcnt_hi_u32_b32 %0, -1, %0" : "=v"(ln_)); const int lane = ln_, oct = lane >> 3, q8 = lane & 7;
    const int s = vcu >> 6;
    const __amdgpu_buffer_rsrc_t rs_U = __builtin_amdgcn_make_buffer_rsrc((void*)U, (short)0, 16384 * 512, 0x00020000);
    const int soff = 128 * s + 16 * q8;
    const int t0 = 512 * (vcu & 63) + 64 * wv;
    int eA[8], eB[8]; v4u rA[8], rB[8], hA0, hA1, hB0, hB1, hC0, hC1;
    G1_IDS(eA, hA0, hA1, 0); G1_ROWS(rA, eA); G1_IDS(eB, hB0, hB1, 1);
#pragma unroll 1
    for (int i = 0; i < 128; i += 2) {
        G1_ROWS(rB, eB); __builtin_amdgcn_sched_barrier(0);
        G1_IDS(eA, hC0, hC1, (i + 2) & 127); __builtin_amdgcn_sched_barrier(0);
        G1_COMP(rA, hA0, hA1, i); __builtin_amdgcn_sched_barrier(0);
        G1_ROWS(rA, eA); hA0 = hC0; hA1 = hC1; __builtin_amdgcn_sched_barrier(0);
        G1_IDS(eB, hC0, hC1, (i + 3) & 127); __builtin_amdgcn_sched_barrier(0);
        G1_COMP(rB, hB0, hB1, i + 1); __builtin_amdgcn_sched_barrier(0);
        hB0 = hC0; hB1 = hC1;
    }
}
__device__ __forceinline__ void peer_g1b_phase(const int* PART, const int* EXPERTS, const float* GATESP, const float* SU, const float* SV, const float* SH, const float* HS, unsigned char* COEFQ, float* SCT, float* CS, int gw, int NGW, int lane) {
    for (int t = gw; t < T; t += NGW) {
        const float sh = SH[t], hoff = 7.5f * HS[t];
        float cf[2]; float am = 0.f;
#pragma unroll
        for (int h2 = 0; h2 < 2; ++h2) {
            const size_t idx = (size_t)t * 128 + 64 * h2 + lane;
            int d = 0;
#pragma unroll
            for (int x = 0; x < 4; ++x) d += PART[(size_t)x * T * 128 + idx];
            const int ev = EXPERTS[idx];
            const float act = ((float)d - hoff) * (sh * SU[ev]);
            cf[h2] = GATESP[idx] * (0.5f * act * (1.f + erff(act * 0.70710678118f))) * SV[ev];
            am = fmaxf(am, fabsf(cf[h2]));
        }
#pragma unroll
        for (int o = 1; o < 64; o <<= 1) am = fmaxf(am, shx(am, lane, o));
        const float inv = am > 0.f ? 127.f / am : 0.f;
        const int q0 = (int)rintf(cf[0] * inv), q1 = (int)rintf(cf[1] * inv);
        COEFQ[(size_t)t * 128 + lane] = (unsigned char)(q0 & 0xff); COEFQ[(size_t)t * 128 + 64 + lane] = (unsigned char)(q1 & 0xff);
        int cs = q0 + q1;
#pragma unroll
        for (int o = 1; o < 64; o <<= 1) cs += shxi(cs, lane, o);
        if (lane == 0) { SCT[t] = am * (1.f / 127.f); CS[t] = (float)cs; }
    }
}
#define G2_IDS(E_, C_, it_) do { const int t_ = t0 + ((it_) >> 1), hf_ = (it_) & 1; const v4u* ep_ = (const v4u*)(EXPERTS + (size_t)t_ * 128 + 16 * oct + 8 * hf_); const v4u ea_ = ep_[0], eb_ = ep_[1]; \
    E_[0] = (int)ea_.x; E_[1] = (int)ea_.y; E_[2] = (int)ea_.z; E_[3] = (int)ea_.w; E_[4] = (int)eb_.x; E_[5] = (int)eb_.y; E_[6] = (int)eb_.z; E_[7] = (int)eb_.w; \
    C_ = *(const u32x2*)(COEFQ + (size_t)t_ * 128 + 16 * oct + 8 * hf_); } while (0)
#define G2_ROWS(R_, E_) do { _Pragma("unroll") for (int j_ = 0; j_ < 8; ++j_) R_[j_] = __builtin_amdgcn_raw_buffer_load_b128(rs_V, (E_[j_] << 9) + soff, 0, 0); } while (0)
#define G2_T4(ob, w0, w1, w2, w3, cq_) do { const unsigned a_ = __builtin_amdgcn_perm(w1, w0, 0x05010400u), b_ = __builtin_amdgcn_perm(w1, w0, 0x07030602u), c_ = __builtin_amdgcn_perm(w3, w2, 0x05010400u), d_ = __builtin_amdgcn_perm(w3, w2, 0x07030602u); \
    const unsigned y0_ = __builtin_amdgcn_perm(c_, a_, 0x05040100u), y1_ = __builtin_amdgcn_perm(c_, a_, 0x07060302u), y2_ = __builtin_amdgcn_perm(d_, b_, 0x05040100u), y3_ = __builtin_amdgcn_perm(d_, b_, 0x07060302u); \
    o[(ob)] = __builtin_amdgcn_sdot4((int)(y0_ & 0x0F0F0F0Fu), cq_, o[(ob)], false); o[(ob) + 4] = __builtin_amdgcn_sdot4((int)((y0_ >> 4) & 0x0F0F0F0Fu), cq_, o[(ob) + 4], false); \
    o[(ob) + 1] = __builtin_amdgcn_sdot4((int)(y1_ & 0x0F0F0F0Fu), cq_, o[(ob) + 1], false); o[(ob) + 5] = __builtin_amdgcn_sdot4((int)((y1_ >> 4) & 0x0F0F0F0Fu), cq_, o[(ob) + 5], false); \
    o[(ob) + 2] = __builtin_amdgcn_sdot4((int)(y2_ & 0x0F0F0F0Fu), cq_, o[(ob) + 2], false); o[(ob) + 6] = __builtin_amdgcn_sdot4((int)((y2_ >> 4) & 0x0F0F0F0Fu), cq_, o[(ob) + 6], false); \
    o[(ob) + 3] = __builtin_amdgcn_sdot4((int)(y3_ & 0x0F0F0F0Fu), cq_, o[(ob) + 3], false); o[(ob) + 7] = __builtin_amdgcn_sdot4((int)((y3_ >> 4) & 0x0F0F0F0Fu), cq_, o[(ob) + 7], false); } while (0)
#define G2_REDI(N, S) do { const bool up_ = (lane & (S)) != 0; _Pragma("unroll") for (int j_ = 0; j_ < (N); ++j_) { const int a_ = o[j_], b_ = o[j_ + (N)]; const int send_ = up_ ? a_ : b_, keep_ = up_ ? b_ : a_; o[j_] = keep_ + shxi(send_, lane, (S)); } } while (0)
#define G2_COMP(R_, C_, it_) do { int o[32]; _Pragma("unroll") for (int k_ = 0; k_ < 32; ++k_) o[k_] = 0; \
    G2_T4(0, R_[0].x, R_[1].x, R_[2].x, R_[3].x, (int)C_.x); G2_T4(8, R_[0].y, R_[1].y, R_[2].y, R_[3].y, (int)C_.x); G2_T4(16, R_[0].z, R_[1].z, R_[2].z, R_[3].z, (int)C_.x); G2_T4(24, R_[0].w, R_[1].w, R_[2].w, R_[3].w, (int)C_.x); \
    G2_T4(0, R_[4].x, R_[5].x, R_[6].x, R_[7].x, (int)C_.y); G2_T4(8, R_[4].y, R_[5].y, R_[6].y, R_[7].y, (int)C_.y); G2_T4(16, R_[4].z, R_[5].z, R_[6].z, R_[7].z, (int)C_.y); G2_T4(24, R_[4].w, R_[5].w, R_[6].w, R_[7].w, (int)C_.y); \
    G2_REDI(16, 8); G2_REDI(8, 16); G2_REDI(4, 32); \
    const int tt_ = t0 + ((it_) >> 1); const float sc_ = SCT[tt_], corr_ = ((it_) & 1) ? 0.f : 7.5f * CS[tt_]; f32x4* xp_ = (f32x4*)(X + (size_t)tt_ * 1024 + ocol); f32x4 xv_ = *xp_; \
    xv_.x += sc_ * ((float)o[0] - corr_); xv_.y += sc_ * ((float)o[1] - corr_); xv_.z += sc_ * ((float)o[2] - corr_); xv_.w += sc_ * ((float)o[3] - corr_); *xp_ = xv_; \
    if (NEXT && ((it_) & 1)) { *(u32x2*)(XB + (size_t)tt_ * 1024 + ocol) = (u32x2){pk2(xv_.x, xv_.y), pk2(xv_.z, xv_.w)}; \
        const float ss_ = wave_sum((xv_.x * xv_.x + xv_.y * xv_.y) + (xv_.z * xv_.z + xv_.w * xv_.w), lane); if (lane == 0) SS[(size_t)s * T + tt_] = ss_; } } while (0)
template <bool NEXT>
__device__ __forceinline__ void peer_g2_phase(const int wv, int vcu, const int* EXPERTS, const unsigned char* COEFQ, const float* SCT, const float* CS, const unsigned char* Vtab, float* X, bf16* XB, float* SS) {
    int ln_; asm volatile("v_mbcnt_lo_u32_b32 %0, -1, 0\n\tv_mbcnt_hi_u32_b32 %0, -1, %0" : "=v"(ln_)); const int lane = ln_, oct = lane >> 3, q8 = lane & 7;
    const int s = vcu >> 6;
    const __amdgpu_buffer_rsrc_t rs_V = __builtin_amdgcn_make_buffer_rsrc((void*)Vtab, (short)0, 16384 * 512, 0x00020000);
    const int soff = 128 * s + 16 * q8;
    const int ocol = 256 * s + 32 * q8 + 16 * ((lane >> 3) & 1) + 8 * ((lane >> 4) & 1) + 4 * ((lane >> 5) & 1);
    const int t0 = 512 * (vcu & 63) + 64 * wv;
    int eA[8], eB[8]; u32x2 cA, cB, cC; v4u rA[8], rB[8];
    G2_IDS(eA, cA, 0); G2_ROWS(rA, eA); G2_IDS(eB, cB, 1);
#pragma unroll 1
    for (int i = 0; i < 128; i += 2) {
        G2_ROWS(rB, eB); __builtin_amdgcn_sched_barrier(0);
        G2_IDS(eA, cC, (i + 2) & 127); __builtin_amdgcn_sched_barrier(0);
        G2_COMP(rA, cA, i); __builtin_amdgcn_sched_barrier(0);
        G2_ROWS(rA, eA); cA = cC; __builtin_amdgcn_sched_barrier(0);
        G2_IDS(eB, cC, (i + 3) & 127); __builtin_amdgcn_sched_barrier(0);
        G2_COMP(rB, cB, i + 1); __builtin_amdgcn_sched_barrier(0);
        cB = cC;
    }
}

__device__ __forceinline__ void qknorm_rope_pass(bf16* Q1, bf16* K1, const float* qg, const float* kg, const float* rope, size_t gtid, size_t gthreads) {
    const size_t NROWS = (size_t)2 * 64 * 2 * 4096;
    const int lane = (int)(gtid & 63);
    for (size_t id = gtid; id < NROWS * 8; id += gthreads) {
        const size_t rowg = id >> 3; const int part = (int)(id & 7);
        const bool isk = rowg >= NROWS / 2; const size_t row = isk ? rowg - NROWS / 2 : rowg;
        bf16* ptr = (isk ? K1 : Q1) + row * 64 + part * 8; const float* g = (isk ? kg : qg) + part * 8;
        const int s = (int)(row & 4095); const int bh = (int)(row >> 13); const int bidx = bh >> 3; const size_t mtok = (size_t)bidx * 4096 + s;
        const v4u raw = *(const v4u*)ptr;
        float x[8];
#pragma unroll
        for (int i = 0; i < 4; ++i) { x[2 * i] = bf_lo(raw[i]); x[2 * i + 1] = bf_hi(raw[i]); }
        float ss = 0.f;
#pragma unroll
        for (int i = 0; i < 8; ++i) ss += x[i] * x[i];
        ss += shx(ss, lane, 1); ss += shx(ss, lane, 2); ss += shx(ss, lane, 4);
        const float rstd = rsqrtf(ss * (1.f / 64.f) + EPS);
        float y[8], other[8];
#pragma unroll
        for (int i = 0; i < 8; ++i) y[i] = x[i] * rstd * g[i];
#pragma unroll
        for (int i = 0; i < 8; ++i) other[i] = shx(y[i], lane, 1);
        if (part < 2) { const float* cs = rope + mtok * 16;
#pragma unroll
            for (int i = 0; i < 8; ++i) { const float co = cs[i], si = cs[8 + i]; y[i] = (part == 0) ? (y[i] * co - other[i] * si) : (y[i] * co + other[i] * si); } }
        const float sc = isk ? 1.f : (0.125f * 1.44269504089f);
        v4u o;
#pragma unroll
        for (int i = 0; i < 4; ++i) o[i] = pk2(y[2 * i] * sc, y[2 * i + 1] * sc);
        *(v4u*)ptr = o;
    }
}

#define AT_DMA(kt_, slot_) do { \
    _Pragma("unroll") for (int i_ = 0; i_ < 2; ++i_) { const int row_ = 8 * w + (lane >> 3), ch_ = (lane & 7) ^ ((row_ >> 1) & 7); \
        glds16(K1 + ((size_t)((bh * 2 + i_) * 4096 + (kt_) * 64 + row_)) * 64 + ch_ * 8, (unsigned)__builtin_amdgcn_readfirstlane((int)(ldsb + (slot_) * 32768 + i_ * 8192 + w * 1024))); } \
    _Pragma("unroll") for (int i_ = 0; i_ < 2; ++i_) { const int row_ = 8 * w + 4 * i_ + (lane >> 4), ch_ = (lane & 15) ^ ((row_ & 3) << 2); \
        glds16(V1 + ((size_t)(bh * 4096 + (kt_) * 64 + row_)) * 128 + ch_ * 8, (unsigned)__builtin_amdgcn_readfirstlane((int)(ldsb + (slot_) * 32768 + 16384 + w * 2048 + i_ * 1024))); } } while (0)
typedef short v4i16_t __attribute__((ext_vector_type(4)));
__device__ __forceinline__ bf16x8 vtr8(const LAS bf16* p) {
    const v4i16_t lo = __builtin_amdgcn_ds_read_tr16_b64_v4i16((LAS v4i16_t*)p), hi = __builtin_amdgcn_ds_read_tr16_b64_v4i16((LAS v4i16_t*)(p + 8 * 128));
    return (bf16x8){lo[0], lo[1], lo[2], lo[3], hi[0], hi[1], hi[2], hi[3]};
}
template <bool OFFS>
__device__ __forceinline__ void attn_units(const int wv, LAS unsigned char* lds, int vcu, const bf16* Q1, const bf16* K1, const bf16* V1, bf16* O, const float* subln, float lam, float offs) {
    int ln_; asm volatile("v_mbcnt_lo_u32_b32 %0, -1, 0\n\tv_mbcnt_hi_u32_b32 %0, -1, %0" : "=v"(ln_)); const int tid = wv * 64 + ln_, lane = tid & 63, w = wv, r32 = lane & 31, hi = lane >> 5, qt = w & 3, c = w >> 2;
    LAS float* lbuf = (LAS float*)(lds + 135168 + w * 128);
    LAS float* Obuf = (LAS float*)lds;
    if (wv >= 4) __builtin_amdgcn_s_setprio(1);
    const unsigned ldsb = (unsigned)(uintptr_t)lds;
#pragma unroll 1
    for (int ui = 0; ui < 8; ++ui) {
        const int bh = (vcu >> 5) * 8 + ui, qb = vcu & 31, b = bh >> 3, h = bh & 7;
        bf16x8 bq[4];
#pragma unroll
        for (int ks = 0; ks < 4; ++ks) bq[ks] = *(const bf16x8*)(Q1 + ((size_t)((bh * 2 + c) * 4096 + qb * 128 + qt * 32 + r32)) * 64 + ks * 16 + 8 * hi);
        f32x16 Oa[4];
#pragma unroll
        for (int db = 0; db < 4; ++db)
#pragma unroll
            for (int r = 0; r < 16; ++r) Oa[db][r] = 0.f;
        float lsum = 0.f;
        AT_DMA(0, 0); AT_DMA(1, 1);
        AT_WAIT_BAR();
        const int kx0 = (r32 >> 1) & 7, kx1 = ((32 + r32) >> 1) & 7;
        const int vrow = 4 * hi + ((lane >> 2) & 3), vg = (lane >> 4) & 1, vp = lane & 3;
        f32x16 s0, s1;
        { const LAS unsigned char* Kc = lds + c * 8192;
#pragma unroll
          for (int r = 0; r < 16; ++r) { s0[r] = 0.f; s1[r] = 0.f; }
#pragma unroll
          for (int ks = 0; ks < 4; ++ks) { const bf16x8 a0 = *(const LAS bf16x8*)(Kc + r32 * 128 + (((2 * ks + hi) ^ kx0) << 4)), a1 = *(const LAS bf16x8*)(Kc + (32 + r32) * 128 + (((2 * ks + hi) ^ kx1) << 4));
              s0 = mfma32(a0, bq[ks], s0); s1 = mfma32(a1, bq[ks], s1); } }
        int b0 = 0, b1 = 1, b2 = 2;
#pragma unroll 1
        for (int kt = 0; kt < 64; ++kt) {
            if (kt + 2 < 64) AT_DMA(kt + 2, b2);
            const LAS unsigned char* Kc = lds + b1 * 32768 + c * 8192;
            const LAS unsigned char* Vb = lds + b0 * 32768 + 16384 + vrow * 256 + 8 * (vp & 1);
            f32x16 n0, n1;
#pragma unroll
            for (int r = 0; r < 16; ++r) { n0[r] = 0.f; n1[r] = 0.f; }
            bf16x8 ka[8];
#define AT_KLD(ks_) do { ka[2 * (ks_)] = *(const LAS bf16x8*)(Kc + r32 * 128 + (((2 * (ks_) + hi) ^ kx0) << 4)); ka[2 * (ks_) + 1] = *(const LAS bf16x8*)(Kc + (32 + r32) * 128 + (((2 * (ks_) + hi) ^ kx1) << 4)); } while (0)
            AT_KLD(0); AT_KLD(1);
            __builtin_amdgcn_sched_barrier(0);
#pragma unroll
            for (int ks = 0; ks < 4; ++ks) {
                n0 = mfma32(ka[2 * ks], bq[ks], n0);
#pragma unroll
                for (int r = 0; r < 4; ++r) s0[4 * ks + r] = __builtin_amdgcn_exp2f(OFFS ? s0[4 * ks + r] - offs : s0[4 * ks + r]);
                __builtin_amdgcn_sched_barrier(0);
                n1 = mfma32(ka[2 * ks + 1], bq[ks], n1);
                if (ks < 2) AT_KLD(ks + 2);
#pragma unroll
                for (int r = 0; r < 4; ++r) s1[4 * ks + r] = __builtin_amdgcn_exp2f(OFFS ? s1[4 * ks + r] - offs : s1[4 * ks + r]);
                __builtin_amdgcn_sched_barrier(0);
            }
#undef AT_KLD
            bf16x8 pa[4]; bf16x8 vf[4], vn[4];
#pragma unroll
            for (int db = 0; db < 4; ++db) vf[db] = vtr8((const LAS bf16*)(Vb + (((4 * db + 2 * vg + (vp >> 1)) ^ ((vrow & 3) << 2)) << 4)));
            float ls = 0.f;
            { v4u t0;
#pragma unroll
              for (int k = 0; k < 4; ++k) { t0[k] = pk2(s0[2 * k], s0[2 * k + 1]); ls += s0[2 * k] + s0[2 * k + 1]; }
              pa[0] = __builtin_bit_cast(bf16x8, t0); }
            __builtin_amdgcn_sched_barrier(0);
#pragma unroll
            for (int sp_ = 0; sp_ < 4; ++sp_) {
                if (sp_ < 3) {
#pragma unroll
                    for (int db = 0; db < 4; ++db) vn[db] = vtr8((const LAS bf16*)(Vb + (16 * (sp_ + 1)) * 256 + (((4 * db + 2 * vg + (vp >> 1)) ^ ((vrow & 3) << 2)) << 4)));
                }
#pragma unroll
                for (int db = 0; db < 4; ++db) Oa[db] = mfma32(pa[sp_], vf[db], Oa[db]);
                if (sp_ < 3) { v4u t0;
#pragma unroll
                    for (int k = 0; k < 4; ++k) { const float x0 = (sp_ == 0) ? s0[8 + 2 * k] : (sp_ == 1 ? s1[2 * k] : s1[8 + 2 * k]), x1 = (sp_ == 0) ? s0[9 + 2 * k] : (sp_ == 1 ? s1[2 * k + 1] : s1[9 + 2 * k]); t0[k] = pk2(x0, x1); ls += x0 + x1; }
                    pa[sp_ + 1] = __builtin_bit_cast(bf16x8, t0); }
                __builtin_amdgcn_sched_barrier(0);
                if (sp_ < 3) {
#pragma unroll
                    for (int db = 0; db < 4; ++db) vf[db] = vn[db];
                }
            }
            lsum += ls;
            s0 = n0; s1 = n1;
            { const int tb = b0; b0 = b1; b1 = b2; b2 = tb; }
            AT_WAIT_BAR();
        }
        lsum += shx(lsum, lane, 32);
        lbuf[r32] = lsum;
#pragma unroll
        for (int r = 0; r < 16; ++r) { const int qrow = (r & 3) + 8 * (r >> 2) + 4 * hi; const float inv = 1.f / lbuf[qrow];
#pragma unroll
            for (int db = 0; db < 4; ++db) Obuf[(c * 128 + qt * 32 + qrow) * 132 + 32 * db + r32] = Oa[db][r] * inv; }
        __syncthreads();
        { const int row = tid >> 2, qd = tid & 3;
          float dv[32]; float ss = 0.f;
#pragma unroll
          for (int k = 0; k < 8; ++k) { const f32x4 o0 = *(const LAS f32x4*)(Obuf + row * 132 + qd * 32 + 4 * k), o1 = *(const LAS f32x4*)(Obuf + (128 + row) * 132 + qd * 32 + 4 * k);
#pragma unroll
              for (int e = 0; e < 4; ++e) { const float d = o0[e] - lam * o1[e]; dv[4 * k + e] = d; ss += d * d; } }
          ss += shx(ss, lane, 1); ss += shx(ss, lane, 2);
          const float rstd = rsqrtf(ss * (1.f / 128.f) + EPS) * (1.f - LAMBDA_INIT);
          bf16* op = O + ((size_t)b * 4096 + qb * 128 + row) * 1024 + h * 128 + qd * 32;
#pragma unroll
          for (int k = 0; k < 4; ++k) { v4u o;
#pragma unroll
              for (int e = 0; e < 4; ++e) o[e] = pk2(dv[8 * k + 2 * e] * rstd * subln[qd * 32 + 8 * k + 2 * e], dv[8 * k + 2 * e + 1] * rstd * subln[qd * 32 + 8 * k + 2 * e + 1]);
              *(v4u*)(op + 8 * k) = o; } }
        __syncthreads();
    }
    __builtin_amdgcn_s_setprio(0);
}
__device__ __forceinline__ void attn_phase(const int wv, LAS unsigned char* lds, int vcu, const bf16* Q1, const bf16* K1, const bf16* V1, bf16* O, const float* qg, const float* kg,
                                           const float* lq1, const float* lk1, const float* lq2, const float* lk2, const float* subln) {
    float s1 = 0.f, s2 = 0.f, mq = 0.f, mk = 0.f;
    for (int i = 0; i < 64; ++i) { s1 += lq1[i] * lk1[i]; s2 += lq2[i] * lk2[i]; mq = fmaxf(mq, fabsf(qg[i])); mk = fmaxf(mk, fabsf(kg[i])); }
    const float lam = expf(s1) - expf(s2) + LAMBDA_INIT;
    const float offs = 8.f * mq * mk * 1.44269504089f * 1.02f + 0.25f;
    if (offs < 24.f) attn_units<false>(wv, lds, vcu, Q1, K1, V1, O, subln, lam, 0.f);
    else attn_units<true>(wv, lds, vcu, Q1, K1, V1, O, subln, lam, offs);
}
#undef AT_LOAD
#undef AT_WRITE
struct Args { const void* in[27]; float* out; unsigned char* ws; };
#define KARG(i) ({ GAS const void* p_; asm volatile("s_load_dwordx2 %0, %1, %2\n\ts_waitcnt lgkmcnt(0)" : "=s"(p_) : "s"(__builtin_amdgcn_kernarg_segment_ptr()), "i"(8 * (i))); (const void*)p_; })
#define KIN(i) ((const float*)KARG(i))
#define KOUT() ((float*)KARG(27))
#define KWS() ((unsigned char*)KARG(28))
#define WSP(T_, off) ((T_*)(KWS() + (off)))
__global__ void __launch_bounds__(NWAVES * 64, 2) mk_fwd(Args args) {
    extern __shared__ __attribute__((aligned(16))) unsigned char lds_raw[];
    LAS unsigned char* lds = (LAS unsigned char*)lds_raw;
    const int G = gridDim.x, bx = blockIdx.x;
    const int wv = __builtin_amdgcn_readfirstlane((int)(threadIdx.x >> 6));
    const int vcu = (G % 8 == 0) ? (bx % 8) * (G / 8) + bx / 8 : bx;
#define PH_IDS() int ln_; asm volatile("v_mbcnt_lo_u32_b32 %0, -1, 0\n\tv_mbcnt_hi_u32_b32 %0, -1, %0" : "=v"(ln_)); const int lane = ln_, wave = wv, tid = wv * 64 + ln_; \
    const int gw = vcu * NWAVES + wave, NGW = G * NWAVES; const size_t gtid = (size_t)vcu * (NWAVES * 64) + tid, gthreads = (size_t)G * (NWAVES * 64); (void)lane; (void)gw; (void)NGW; (void)gtid; (void)gthreads
    if (threadIdx.x < 32) ((LAS unsigned*)(lds + MISC_OFF))[threadIdx.x] = 0u;
    __syncthreads();
    (void)xcd_barrier_post((unsigned*)(WSP(gu32, WS_CTL) + CW_BAR), (volatile LAS unsigned*)(lds + MISC_OFF) + 8);
#define STAMP() do {} while (0)
#ifndef PROBE_DUP
#define PROBE_DUP 0
#endif
#define REPS(bit) _Pragma("unroll 1") for (int rep_ = 0; rep_ < 1 + ((PROBE_DUP >> (bit)) & 1); ++rep_)
#define GRID_BAR1() do { XcdBarrier b_; b_.bar = (unsigned*)(WSP(gu32, WS_CTL) + CW_BAR); b_.x = xb_xcc_id(); b_.st = (volatile LAS unsigned*)(lds + MISC_OFF) + 8; xcd_barrier(b_); } while (0)
#define GRID_BAR() do { GRID_BAR1(); if ((PROBE_DUP >> 9) & 1) GRID_BAR1(); } while (0)

    REPS(5) {
        PH_IDS();
        LAS float* scr = (LAS float*)(lds + wave * 16384);
        constexpr int I0 = 16 * 97, I1 = 16 * 32, I2 = 16 * 64, I3 = 16 * 96, I4 = 16 * 32, I5 = 16 * 64, NITEMS = I0 + I1 + I2 + I3 + I4 + I5;
        for (int it = gw; it < NITEMS; it += NGW) {
            int r = it;
            if (r < I0) { p0_transpose_item(KIN(3), 1024, 3104, WSP(bf16, WS_WIN), scr, r, lane); continue; } r -= I0;
            if (r < I1) { p0_transpose_item(KIN(6), 1024, 1024, WSP(bf16, WS_WO0), scr, r, lane); continue; } r -= I1;
            if (r < I2) { p0_transpose_item(KIN(8), 1024, 2048, WSP(bf16, WS_WQ0), scr, r, lane); continue; } r -= I2;
            if (r < I3) { p0_transpose_item(KIN(13), 1024, 3072, WSP(bf16, WS_WQKV), scr, r, lane, KIN(12)); continue; } r -= I3;
            if (r < I4) { p0_transpose_item(KIN(21), 1024, 1024, WSP(bf16, WS_WO1), scr, r, lane); continue; } r -= I4;
            p0_transpose_item(KIN(23), 1024, 2048, WSP(bf16, WS_WQ1), scr, r, lane);
        }
        { bf16* WIN = WSP(bf16, WS_WIN); for (size_t i = gtid * 8; i < (size_t)224 * 1024; i += gthreads * 8) *(v4u*)(WIN + (size_t)3104 * 1024 + i) = (v4u){0u, 0u, 0u, 0u}; }
        cvt_range(KIN(9), WSP(bf16, WS_KEY0), (size_t)262144, gtid, gthreads);
        cvt_range(KIN(24), WSP(bf16, WS_KEY1), (size_t)262144, gtid, gthreads);
        rms_pass(KIN(0), KIN(2), WSP(bf16, WS_B0), gw, NGW, lane);
        { const int* positions = (const int*)KARG(1); float* ROPE = WSP(float, WS_ROPE);
          for (size_t id = gtid; id < (size_t)T * 8; id += gthreads) { const size_t mtok = id >> 3; const int i = (int)(id & 7);
            const float inv = powf(500000.0f, -(float)i * 2.0f / 16.0f); const float ang = (float)positions[mtok] * inv;
            float sn, cs; sincosf(ang, &sn, &cs); ROPE[mtok * 16 + i] = cs; ROPE[mtok * 16 + 8 + i] = sn; } }
    }
    GRID_BAR();
    REPS(3) {
        unsigned char* ws = KWS();
        pg8::Gemm g{(const bf16*)(ws + WS_B0), (const bf16*)(ws + WS_WIN), T, 3328, 1024}; pg8::StaticOrder S; S.init(T, 3328, G, bx);
        pg8::EpiInProj E{(bf16*)(ws + WS_R1), (bf16*)(ws + WS_R1 + 32 * MiB), (bf16*)(ws + WS_R2), (bf16*)(ws + WS_R3), (float*)(ws + WS_GATES), KIN(4)};
        pg8::gemm_phase<pg8::EpiInProj, pg8::StaticOrder, true, true>(lds, g, S, E, wv);
    }
    GRID_BAR();
    if ((bx >> 3) & 1) { PH_IDS(); const int gwi = ((bx >> 4) * 8 + (bx & 7)) * NWAVES + wave, NGWI = 128 * NWAVES; (void)gw; (void)NGW;
        quant4_rows(KIN(10), WSP(unsigned char, WS_U0), WSP(float, WS_SC), 16384, gwi, NGWI, lane);
        quant4_rows(KIN(11), WSP(unsigned char, WS_V0T), WSP(float, WS_SC + 65536), 16384, gwi, NGWI, lane);
        quant4_rows(KIN(25), WSP(unsigned char, WS_U1), WSP(float, WS_SC + 2 * 65536), 16384, gwi, NGWI, lane);
        quant4_rows(KIN(26), WSP(unsigned char, WS_V1T), WSP(float, WS_SC + 3 * 65536), 16384, gwi, NGWI, lane); }
    REPS(2) { unsigned char* ws = KWS(); mlstm_phase(wv, lds, (const bf16*)(ws + WS_R1), (const bf16*)(ws + WS_R1 + 32 * MiB), (const bf16*)(ws + WS_R2), (const float*)(ws + WS_GATES), (bf16*)(ws + WS_R4), (bf16*)(ws + WS_R5)); }
    GRID_BAR();
    REPS(6) { PH_IDS(); unsigned char* ws = KWS(); hs_pass((const bf16*)(ws + WS_R4), (const bf16*)(ws + WS_R5), (const bf16*)(ws + WS_R3), KIN(5), (bf16*)(ws + WS_B0), gw, NGW, lane); }
    GRID_BAR();
#pragma unroll 1
    for (int L = 0; L < 2; ++L) {
        if (L == 1) {
            REPS(3) {
                unsigned char* ws = KWS();
                pg8::Gemm g{(const bf16*)(ws + WS_B0), (const bf16*)(ws + WS_WQKV), T, 3072, 1024}; pg8::StaticOrder S; S.init(T, 3072, G, bx);
                pg8::EpiQKV E{(bf16*)(ws + WS_R2), (bf16*)(ws + WS_R3), (bf16*)(ws + WS_R4), (const float*)(ws + 3 * MiB), KIN(14), KIN(15), (const float*)(ws + WS_ROPE), (LAS float*)(lds + 131072)};
                pg8::gemm_phase<pg8::EpiQKV, pg8::StaticOrder, true, true>(lds, g, S, E, wv);
            }
            GRID_BAR();
            REPS(0) { unsigned char* ws = KWS(); attn_phase(wv, lds, vcu, (const bf16*)(ws + WS_R2), (const bf16*)(ws + WS_R3), (const bf16*)(ws + WS_R4), (bf16*)(ws + WS_B0), KIN(14), KIN(15), KIN(16), KIN(17), KIN(18), KIN(19), KIN(20)); }
            GRID_BAR();
        }
        _Pragma("unroll 1") for (int rep_ = 0; rep_ < 1 + ((L == 0) ? ((PROBE_DUP >> 3) & 1) : 0); ++rep_) {
            unsigned char* ws = KWS(); float* out = KOUT();
            pg8::Gemm g{(const bf16*)(ws + WS_B0), (const bf16*)(ws + (L ? WS_WO1 : WS_WO0)), T, 1024, 1024}; pg8::StaticOrder S; S.init(T, 1024, G, bx);
            pg8::EpiRes E{L ? (const float*)out : KIN(0), out};
            pg8::gemm_phase<pg8::EpiRes, pg8::StaticOrder, true, true>(lds, g, S, E, wv);
        }
        GRID_BAR();
        REPS(7) { PH_IDS(); unsigned char* ws = KWS(); rms_quant_pass(KOUT(), L ? KIN(22) : KIN(7), (bf16*)(ws + WS_B0), ws + WS_R5, (float*)(ws + WS_SC + 4 * 65536), (float*)(ws + WS_SC + 6 * 65536), gw, NGW, lane); }
        GRID_BAR();
        REPS(3) {
            unsigned char* ws = KWS();
            pg8::Gemm g{(const bf16*)(ws + WS_B0), (const bf16*)(ws + (L ? WS_WQ1 : WS_WQ0)), T, 2048, 1024}; pg8::StaticOrder S; S.init(T, 2048, G, bx);
            pg8::EpiPlain E{(bf16*)(ws + WS_R2), 2048};
            pg8::gemm_phase<pg8::EpiPlain, pg8::StaticOrder, true, true>(lds, g, S, E, wv);
        }
        GRID_BAR();
        REPS(4) { unsigned char* ws = KWS(); peer_topk_phase(wv, lds, vcu, (const bf16*)(ws + WS_R2), (const bf16*)(ws + (L ? WS_KEY1 : WS_KEY0)), (int*)(ws + WS_R4), (float*)(ws + WS_R4 + 16 * MiB)); }
        GRID_BAR();
        REPS(1) { unsigned char* ws = KWS(); peer_g1_phase(wv, vcu, ws + WS_R5, (const int*)(ws + WS_R4), ws + (L ? WS_U1 : WS_U0), (int*)(ws + WS_R2)); }
        GRID_BAR();
        { PH_IDS(); unsigned char* ws = KWS(); const size_t so = L ? 2 * 65536 : 0;
          peer_g1b_phase((const int*)(ws + WS_R2), (const int*)(ws + WS_R4), (const float*)(ws + WS_R4 + 16 * MiB), (const float*)(ws + WS_SC + so), (const float*)(ws + WS_SC + so + 65536),
                         (const float*)(ws + WS_SC + 4 * 65536), (const float*)(ws + WS_SC + 6 * 65536), ws + WS_R4 + 32 * MiB, (float*)(ws + WS_SC + 10 * 65536), (float*)(ws + WS_SC + 8 * 65536), gw, NGW, lane); }
        GRID_BAR();
        if (L == 0) { unsigned char* ws = KWS(); peer_g2_phase<true>(wv, vcu, (const int*)(ws + WS_R4), ws + WS_R4 + 32 * MiB, (const float*)(ws + WS_SC + 10 * 65536), (const float*)(ws + WS_SC + 8 * 65536), ws + WS_V0T, KOUT(), (bf16*)(ws + WS_B0), (float*)(ws + 3 * MiB)); GRID_BAR(); }
        else { unsigned char* ws = KWS(); peer_g2_phase<false>(wv, vcu, (const int*)(ws + WS_R4), ws + WS_R4 + 32 * MiB, (const float*)(ws + WS_SC + 10 * 65536), (const float*)(ws + WS_SC + 8 * 65536), ws + WS_V1T, KOUT(), nullptr, nullptr); }
    }
#undef GRID_BAR
}

extern "C" void kernel_launch(void* const* d_in, const int* in_sizes, int n_in, void* d_out, int out_size, void* d_ws, size_t ws_size, hipStream_t stream) {
    static int ready = 0;
    if (ready == 0) {
        if (n_in != 27 || out_size != T * D || ws_size < WS_END) { fprintf(stderr, "kernel_launch: unexpected problem (n_in %d, out %d, ws %zu)\n", n_in, out_size, ws_size); ready = -1; return; }
        if (hipFuncSetAttribute((const void*)mk_fwd, hipFuncAttributeMaxDynamicSharedMemorySize, LDS_BYTES) != hipSuccess) { fprintf(stderr, "kernel_launch: hipFuncSetAttribute failed\n"); ready = -1; return; }
        (void)hipGetLastError();
        ready = 1;
    }
    if (ready < 0) return;
    if (hipMemsetAsync((char*)d_ws + WS_CTL, 0, CTL_ZERO_BYTES, stream) != hipSuccess) { fprintf(stderr, "kernel_launch: memset failed\n"); return; }
    Args a{};
    for (int i = 0; i < 27; ++i) a.in[i] = d_in[i];
    a.out = (float*)d_out; a.ws = (unsigned char*)d_ws;
    hipLaunchKernelGGL(mk_fwd, dim3(256), dim3(NWAVES * 64), LDS_BYTES, stream, a);
}
```

```cpp
#include <hip/hip_runtime.h>
#include <hip/hip_bf16.h>
#include <cstdio>
#include <cstdint>
#include <cmath>
namespace pg8 {
#define PG8_LAS __attribute__((address_space(3)))
typedef unsigned short bf16_t;
typedef short bf16x8 __attribute__((ext_vector_type(8)));
typedef float f32x4 __attribute__((ext_vector_type(4)));
typedef unsigned u32x4 __attribute__((ext_vector_type(4)));
constexpr int BM = 256, BK = 64, HALF = 128, HTB = HALF * BK * 2  , STAGE_BYTES = 8 * HTB, NXCD = 8, WGM = 8;

__host__ __device__ __forceinline__ int lds_byte(int r, int c) { const int st = (r >> 4) * 2 + (c >> 5), rr = r & 15, cc = c & 31, ob = rr * 64 + cc * 2; return st * 1024 + (ob ^ (((ob >> 9) & 1) << 5)); }
__host__ __device__ __forceinline__ void stage_rc(int b, int& R, int& C) { const int st = b / 1024, sb = b % 1024, swz = sb ^ (((sb >> 9) & 1) << 5); R = (st >> 1) * 16 + swz / 64; C = (st & 1) * 32 + (swz % 64) / 2; }
__host__ __device__ __forceinline__ int perm32(int rho) { const int n = rho >> 4, i = rho & 15; return 8 * (i >> 2) + 4 * n + (i & 3); }

struct Unit { int pm, pn; };
struct Gemm { const bf16_t* A; const bf16_t* Bt; int M, N, K; };

struct StaticOrder {
    int nM, nN, nwg, G, c;
    __host__ __device__ void init(int M, int N, int G_, int c_) { nM = M / BM; nN = N / BM; nwg = nM * nN; G = G_; c = c_; }
    __host__ __device__ bool next(int i, Unit& u) const {
        const long L = (long)i * G + c; if (L >= nwg) return false;
        int wgid = (int)L; { const int q = nwg / NXCD, r = nwg % NXCD, xcd = wgid % NXCD, off = wgid / NXCD; wgid = (xcd < r ? xcd * (q + 1) : r * (q + 1) + (xcd - r) * q) + off; }
        const int nig = WGM * nN, gid = wgid / nig, fm = gid * WGM, gsz = (nM - fm) < WGM ? (nM - fm) : WGM;
        u.pm = fm + ((wgid % nig) % gsz); u.pn = (wgid % nig) / gsz; return true;
    }
    __device__ __forceinline__ void a_ready(const Unit&) const {}
    __device__ __forceinline__ void done(const Unit&) const {}
};
__device__ __forceinline__ unsigned cvt_pk_bf16(float lo, float hi) { unsigned r; asm volatile("v_cvt_pk_bf16_f32 %0, %1, %2" : "=v"(r) : "v"(lo), "v"(hi)); return r; }
typedef float f32x2 __attribute__((ext_vector_type(2)));
typedef unsigned u32x2 __attribute__((ext_vector_type(2)));
__device__ __forceinline__ u32x4 pack8(const f32x4 v0, const f32x4 v1) { u32x4 w; w.x = cvt_pk_bf16(v0[0], v0[1]); w.y = cvt_pk_bf16(v0[2], v0[3]); w.z = cvt_pk_bf16(v1[0], v1[1]); w.w = cvt_pk_bf16(v1[2], v1[3]); return w; }
struct EpiPlain {
    static constexpr bool PERM = true, AFTER_DRAIN = false;
    bf16_t* O; int ldc;
    __device__ __forceinline__ void operator()(const f32x4 (&acc)[2][2][4][2], const Unit& u, int wr, int wc, int fr, int fq) const {
        const int row0 = u.pm * BM + wr * 64 + fr, col0 = u.pn * BM + wc * 32 + 8 * fq;
#pragma unroll
        for (int ai = 0; ai < 2; ++ai)
#pragma unroll
            for (int m = 0; m < 4; ++m) { bf16_t* rowp = O + (size_t)(row0 + ai * HALF + m * 16) * ldc + col0;
#pragma unroll
                for (int bj = 0; bj < 2; ++bj) *(u32x4*)(rowp + bj * HALF) = pack8(acc[ai][bj][m][0], acc[ai][bj][m][1]); }
    }
};
template <bool BASE_BF16> struct EpiRes {
    static constexpr bool PERM = true, AFTER_DRAIN = false;
    const void* base; bf16_t* out;
    __device__ __forceinline__ void operator()(const f32x4 (&acc)[2][2][4][2], const Unit& u, int wr, int wc, int fr, int fq) const {
        const int col0 = u.pn * BM + wc * 32 + 8 * fq;
#pragma unroll
        for (int ai = 0; ai < 2; ++ai)
#pragma unroll
            for (int m = 0; m < 4; ++m) { const size_t off = (size_t)(u.pm * BM + ai * HALF + wr * 64 + m * 16 + fr) * 1024 + col0;
#pragma unroll
                for (int bj = 0; bj < 2; ++bj) { f32x4 b0, b1;
                    if (BASE_BF16) { const u32x4 w = *(const u32x4*)((const bf16_t*)base + off + bj * HALF);
                        b0 = (f32x4){__uint_as_float(w.x << 16), __uint_as_float(w.x & 0xffff0000u), __uint_as_float(w.y << 16), __uint_as_float(w.y & 0xffff0000u)};
                        b1 = (f32x4){__uint_as_float(w.z << 16), __uint_as_float(w.z & 0xffff0000u), __uint_as_float(w.w << 16), __uint_as_float(w.w & 0xffff0000u)}; }
                    else { b0 = *(const f32x4*)((const float*)base + off + bj * HALF); b1 = *(const f32x4*)((const float*)base + off + bj * HALF + 4); }
                    *(u32x4*)(out + off + bj * HALF) = pack8(b0 + acc[ai][bj][m][0], b1 + acc[ai][bj][m][1]); } }
    }
};
struct EpiInProj {
    static constexpr bool PERM = true, AFTER_DRAIN = false;
    bf16_t *Q, *Kk, *V, *OG; float* gates; const float* bg;
    __device__ __forceinline__ void operator()(const f32x4 (&acc)[2][2][4][2], const Unit& u, int wr, int wc, int fr, int fq) const {
        const int colt = u.pn * BM;
#pragma unroll
        for (int ai = 0; ai < 2; ++ai)
#pragma unroll
            for (int m = 0; m < 4; ++m) { const int row = u.pm * BM + ai * HALF + wr * 64 + m * 16 + fr, b = row >> 12, s = row & 4095;
#pragma unroll
                for (int bj = 0; bj < 2; ++bj) { const int cb = colt + bj * HALF + wc * 32 + 8 * fq; f32x4 v0 = acc[ai][bj][m][0], v1 = acc[ai][bj][m][1];
                    if (colt < 1024) { const bool isq = colt < 512; bf16_t* base = isq ? Q : Kk; const int c2 = cb & 511, head = c2 >> 6, d = c2 & 63;
                        if (isq) { v0 = v0 * 0.125f; v1 = v1 * 0.125f; }
                        *(u32x4*)(base + ((size_t)((b * 8 + head) * 4096 + s)) * 64 + d) = pack8(v0, v1); }
                    else if (colt < 2048) { const int c2 = cb - 1024, head = c2 >> 7, dv = c2 & 127; *(u32x4*)(V + ((size_t)((b * 8 + head) * 4096 + s)) * 128 + dv) = pack8(v0, v1); }
                    else if (colt < 3072) { *(u32x4*)(OG + (size_t)row * 1024 + (cb - 2048)) = pack8(v0, v1); }
                    else if (cb < 3104) { const int gi = cb - 3072; float* g = gates + (size_t)row * 32 + gi;
                        *(f32x4*)g = v0 + *(const f32x4*)(bg + gi); *(f32x4*)(g + 4) = v1 + *(const f32x4*)(bg + gi + 4); } } }
    }
};
struct EpiQKV {
    static constexpr bool PERM = true, AFTER_DRAIN = false;
    bf16_t *Q, *Kk, *V; const float* SS; const float* qg; const float* kg; const float* rope; PG8_LAS float* xch;
    __device__ __forceinline__ void operator()(const f32x4 (&acc)[2][2][4][2], const Unit& u, int wr, int wc, int fr_, int fq_) const {
        int fr = fr_, fq = fq_; asm volatile("" : "+v"(fr), "+v"(fq));
        const int colt = u.pn * BM, lane = fq * 16 + fr, wave = wr * 4 + wc;
        float rsr[2][4];
#pragma unroll
        for (int ai = 0; ai < 2; ++ai)
#pragma unroll
            for (int m = 0; m < 4; ++m) { const int row = u.pm * BM + ai * HALF + wr * 64 + m * 16 + fr;
                rsr[ai][m] = __builtin_amdgcn_rsqf(((SS[row] + SS[32768 + row]) + (SS[2 * 32768 + row] + SS[3 * 32768 + row])) * (1.f / 1024.f) + 1e-6f); }
        if (colt >= 2048) {
#pragma unroll
            for (int ai = 0; ai < 2; ++ai)
#pragma unroll
                for (int m = 0; m < 4; ++m) { const int row = u.pm * BM + ai * HALF + wr * 64 + m * 16 + fr, b = row >> 12, s = row & 4095; const float rs = rsr[ai][m];
#pragma unroll
                    for (int bj = 0; bj < 2; ++bj) { const int cb = colt + bj * HALF + wc * 32 + 8 * fq; const int c2 = cb - 2048, head = c2 >> 7, dv = c2 & 127;
                        *(u32x4*)(V + ((size_t)((b * 8 + head) * 4096 + s)) * 128 + dv) = pack8(acc[ai][bj][m][0] * rs, acc[ai][bj][m][1] * rs); } }
            return;
        }
#pragma unroll
        for (int ai = 0; ai < 2; ++ai)
#pragma unroll
            for (int m = 0; m < 4; ++m)
#pragma unroll
                for (int bj = 0; bj < 2; ++bj) { const f32x4 a = acc[ai][bj][m][0] * rsr[ai][m], c = acc[ai][bj][m][1] * rsr[ai][m];
                    float ss = ((a[0] * a[0] + a[1] * a[1]) + (a[2] * a[2] + a[3] * a[3])) + ((c[0] * c[0] + c[1] * c[1]) + (c[2] * c[2] + c[3] * c[3]));
                    ss += __uint_as_float((unsigned)__builtin_amdgcn_ds_bpermute((lane ^ 16) << 2, (int)__float_as_uint(ss)));
                    ss += __uint_as_float((unsigned)__builtin_amdgcn_ds_bpermute((lane ^ 32) << 2, (int)__float_as_uint(ss)));
                    if (fq == 0) xch[(((wave * 2 + ai) * 4 + m) * 2 + bj) * 16 + fr] = ss; }
        __syncthreads();
        const bool isq = colt < 1024; bf16_t* base = isq ? Q : Kk; const float* gn = isq ? qg : kg; const float osc = isq ? (0.125f * 1.44269504089f) : 1.f;
        const int d0 = 32 * (wc & 1) + 8 * fq;
        const f32x4 g0 = *(const f32x4*)(gn + d0), g1 = *(const f32x4*)(gn + d0 + 4);
        const bool rot = ((wc & 1) == 0) && (fq < 2);
#pragma unroll
        for (int ai = 0; ai < 2; ++ai)
#pragma unroll
            for (int m = 0; m < 4; ++m) { const int row = u.pm * BM + ai * HALF + wr * 64 + m * 16 + fr, b = row >> 12, s = row & 4095;
                f32x4 co0 = {0.f, 0.f, 0.f, 0.f}, co1 = co0, si0 = co0, si1 = co0;
                if (rot) { const float* cs = rope + (size_t)row * 16; co0 = *(const f32x4*)cs; co1 = *(const f32x4*)(cs + 4); si0 = *(const f32x4*)(cs + 8); si1 = *(const f32x4*)(cs + 12); }
#pragma unroll
                for (int bj = 0; bj < 2; ++bj) { const float tot = xch[(((wave * 2 + ai) * 4 + m) * 2 + bj) * 16 + fr] + xch[((((wave ^ 1) * 2 + ai) * 4 + m) * 2 + bj) * 16 + fr];
                    const float rn = __builtin_amdgcn_rsqf(tot * (1.f / 64.f) + 1e-6f) * rsr[ai][m];
                    f32x4 y0 = acc[ai][bj][m][0] * rn * g0, y1 = acc[ai][bj][m][1] * rn * g1;
                    f32x4 p0, p1;
#pragma unroll
                    for (int i = 0; i < 4; ++i) { p0[i] = __uint_as_float((unsigned)__builtin_amdgcn_ds_bpermute((lane ^ 16) << 2, (int)__float_as_uint(y0[i]))); p1[i] = __uint_as_float((unsigned)__builtin_amdgcn_ds_bpermute((lane ^ 16) << 2, (int)__float_as_uint(y1[i]))); }
                    if (rot) { const float sg = (fq == 0) ? -1.f : 1.f; y0 = y0 * co0 + p0 * si0 * sg; y1 = y1 * co1 + p1 * si1 * sg; }
                    const int cb = colt + bj * HALF + wc * 32 + 8 * fq; const int c2 = cb & 1023, head = c2 >> 7, c = (c2 >> 6) & 1, d = c2 & 63;
                    *(u32x4*)(base + ((size_t)(((b * 8 + head) * 2 + c) * 4096 + s)) * 64 + d) = pack8(y0 * osc, y1 * osc); } }
    }
};
template <class Epi, class Sched, bool ALIGN_EPI = false, bool SP2 = false>
__device__ __forceinline__ void gemm_phase(PG8_LAS unsigned char* lds, const Gemm g, const Sched& S, const Epi& E, const int wv) {
    int ln_; asm volatile("v_mbcnt_lo_u32_b32 %0, -1, 0\n\tv_mbcnt_hi_u32_b32 %0, -1, %0" : "=v"(ln_)); const int tid = wv * 64 + ln_, wid = wv, lane = tid & 63, wr = wid >> 2, wc = wid & 3, fr = lane & 15, fq = lane >> 4;
    const int K = g.K, nt = K / BK;
    unsigned voffA[2], voffB[2];
#pragma unroll
    for (int i = 0; i < 2; ++i) { int R, C; stage_rc(tid * 16 + i * 8192, R, C); const int Rb = Epi::PERM ? ((R & ~31) + perm32(R & 31)) : R;
        voffA[i] = (unsigned)(R * K + C) * 2u; voffB[i] = (unsigned)(Rb * K + C) * 2u; }
    const size_t kstep = (size_t)(BK * 2);
    const size_t hstep = (size_t)HALF * K * 2;
    const size_t tstep = 2 * hstep;
    const unsigned ldsw = (unsigned)wid * 1024u;
    const int aoff = lds_byte(wr * 64 + fr, fq * 8), boff = lds_byte(wc * 32 + fr, fq * 8);
#define PG8_SA(b, h) (((b) * 2 + (h)) * HTB)
#define PG8_SB(b, h) ((4 + (b) * 2 + (h)) * HTB)
#define PG8_STAGE(bufoff, gbase, voff) do { _Pragma("unroll") for (int _i = 0; _i < 2; ++_i) \
        __builtin_amdgcn_global_load_lds((const unsigned*)((const char*)(gbase) + (voff)[_i]), (PG8_LAS unsigned*)(lds + (bufoff) + ldsw + _i * 8192), 16, 0, 0); } while (0)
#define PG8_LDA(dst, b, h) do { _Pragma("unroll") for (int m = 0; m < 4; ++m) _Pragma("unroll") for (int k = 0; k < 2; ++k) dst[m][k] = *(const PG8_LAS bf16x8*)(lds + PG8_SA(b, h) + aoff + m * 2048 + k * 1024); } while (0)
#define PG8_LDB(dst, b, h) do { _Pragma("unroll") for (int n = 0; n < 2; ++n) _Pragma("unroll") for (int k = 0; k < 2; ++k) dst[n][k] = *(const PG8_LAS bf16x8*)(lds + PG8_SB(b, h) + boff + n * 2048 + k * 1024); } while (0)
#define PG8_MMA(ai, bj, At, Bt) do { __builtin_amdgcn_s_setprio(1); _Pragma("unroll") for (int m = 0; m < 4; ++m) _Pragma("unroll") for (int n = 0; n < 2; ++n) _Pragma("unroll") for (int k = 0; k < 2; ++k) \
        acc[ai][bj][m][n] = __builtin_amdgcn_mfma_f32_16x16x32_bf16(Bt[n][k], At[m][k], acc[ai][bj][m][n], 0, 0, 0); __builtin_amdgcn_s_setprio(0); } while (0)
#define PG8_WAIT_V(n) asm volatile("s_waitcnt vmcnt(" #n ")" ::: "memory")
#define PG8_WAIT_L(n) asm volatile("s_waitcnt lgkmcnt(" #n ")" ::: "memory")
#define PG8_BAR __builtin_amdgcn_s_barrier()
#define PG8_SCHED __builtin_amdgcn_sched_barrier(0)
    Unit cur, nxt; int ui = 0;
    if (!S.next(0, cur)) return;
    f32x4 acc[2][2][4][2];
#pragma unroll
    for (int a = 0; a < 2; ++a)
#pragma unroll
        for (int b = 0; b < 2; ++b)
#pragma unroll
            for (int m = 0; m < 4; ++m)
#pragma unroll
                for (int n = 0; n < 2; ++n) acc[a][b][m][n] = (f32x4){0.f, 0.f, 0.f, 0.f};
    bf16x8 At[4][2], B0[2][2], B1[2][2];
    const char* cA = (const char*)g.A + (size_t)cur.pm * tstep; const char* cB = (const char*)g.Bt + (size_t)cur.pn * tstep;
    S.a_ready(cur);
    if constexpr (SP2) {
        PG8_STAGE(PG8_SB(0, 0), cB, voffB); PG8_STAGE(PG8_SB(0, 1), cB + hstep, voffB); PG8_STAGE(PG8_SA(0, 0), cA, voffA); PG8_STAGE(PG8_SA(0, 1), cA + hstep, voffA);
        if (wr == 1) PG8_BAR;
        PG8_WAIT_V(2); PG8_BAR;
        PG8_STAGE(PG8_SB(1, 0), cB + kstep, voffB); PG8_STAGE(PG8_SA(1, 0), cA + kstep, voffA); PG8_STAGE(PG8_SB(1, 1), cB + hstep + kstep, voffB);
        PG8_WAIT_V(6); PG8_BAR;
    } else {
        PG8_STAGE(PG8_SB(0, 0), cB, voffB); PG8_STAGE(PG8_SA(0, 0), cA, voffA); PG8_STAGE(PG8_SB(0, 1), cB + hstep, voffB); PG8_STAGE(PG8_SA(0, 1), cA + hstep, voffA);
        if (wr == 1) PG8_BAR;
        PG8_WAIT_V(4); PG8_BAR;
        PG8_STAGE(PG8_SB(1, 0), cB + kstep, voffB); PG8_STAGE(PG8_SA(1, 0), cA + kstep, voffA); PG8_STAGE(PG8_SB(1, 1), cB + hstep + kstep, voffB);
        PG8_WAIT_V(6); PG8_BAR;
    }
    for (;;) {
        const bool has_next = S.next(ui + 1, nxt);
        const char* nA = has_next ? (const char*)g.A + (size_t)nxt.pm * tstep : cA; const char* nB = has_next ? (const char*)g.Bt + (size_t)nxt.pn * tstep : cB;
        for (int t = 0; t < nt; t += 2) {
            const bool last = (t == nt - 2);
            const char* a1 = cA + (size_t)(t + 1) * kstep;
            const char* a2 = last ? nA : cA + (size_t)(t + 2) * kstep; const char* b2 = last ? nB : cB + (size_t)(t + 2) * kstep;
            const char* a3 = a2 + kstep; const char* b3 = b2 + kstep;
            if (last && has_next) S.a_ready(nxt);
            if constexpr (SP2) {
            PG8_LDB(B0, 0, 0); PG8_LDB(B1, 0, 1); PG8_SCHED; PG8_LDA(At, 0, 0); PG8_STAGE(PG8_SA(1, 1), a1 + hstep, voffA);
            PG8_WAIT_V(8); PG8_WAIT_L(0); PG8_BAR; PG8_MMA(0, 0, At, B0); PG8_MMA(0, 1, At, B1); PG8_BAR; PG8_SCHED;
            PG8_LDA(At, 0, 1); PG8_STAGE(PG8_SB(0, 0), b2, voffB); PG8_STAGE(PG8_SB(0, 1), b2 + hstep, voffB); PG8_STAGE(PG8_SA(0, 0), a2, voffA);
            PG8_WAIT_V(8); PG8_WAIT_L(0); PG8_BAR; PG8_MMA(1, 0, At, B0); PG8_MMA(1, 1, At, B1); PG8_BAR; PG8_SCHED;
            PG8_LDB(B0, 1, 0); PG8_LDB(B1, 1, 1); PG8_SCHED; PG8_LDA(At, 1, 0); PG8_STAGE(PG8_SA(0, 1), a2 + hstep, voffA);
            PG8_WAIT_V(8); PG8_WAIT_L(0); PG8_BAR; PG8_MMA(0, 0, At, B0); PG8_MMA(0, 1, At, B1); PG8_BAR; PG8_SCHED;
            PG8_LDA(At, 1, 1); PG8_STAGE(PG8_SB(1, 0), b3, voffB); PG8_STAGE(PG8_SB(1, 1), b3 + hstep, voffB); PG8_STAGE(PG8_SA(1, 0), a3, voffA);
            PG8_WAIT_V(8); PG8_WAIT_L(0); PG8_BAR; PG8_MMA(1, 0, At, B0); PG8_MMA(1, 1, At, B1); PG8_BAR; PG8_SCHED;
            } else {
            PG8_LDB(B0, 0, 0); PG8_SCHED; PG8_LDA(At, 0, 0); PG8_STAGE(PG8_SA(1, 1), a1 + hstep, voffA);
            PG8_WAIT_L(8); PG8_BAR; PG8_WAIT_L(0); PG8_MMA(0, 0, At, B0); PG8_BAR; PG8_SCHED;
            PG8_LDB(B1, 0, 1); PG8_STAGE(PG8_SB(0, 0), b2, voffB);
            PG8_BAR; PG8_WAIT_L(0); PG8_MMA(0, 1, At, B1); PG8_BAR;
            PG8_LDA(At, 0, 1); PG8_STAGE(PG8_SA(0, 0), a2, voffA);
            PG8_BAR; PG8_WAIT_L(0); PG8_MMA(1, 0, At, B0); PG8_BAR; PG8_SCHED;
            PG8_STAGE(PG8_SB(0, 1), b2 + hstep, voffB);
            PG8_WAIT_V(6); PG8_BAR; PG8_MMA(1, 1, At, B1); PG8_BAR;
            PG8_LDB(B0, 1, 0); PG8_SCHED; PG8_LDA(At, 1, 0); PG8_STAGE(PG8_SA(0, 1), a2 + hstep, voffA);
            PG8_WAIT_L(8); PG8_BAR; PG8_WAIT_L(0); PG8_MMA(0, 0, At, B0); PG8_BAR; PG8_SCHED;
            PG8_LDB(B1, 1, 1); PG8_STAGE(PG8_SB(1, 0), b3, voffB);
            PG8_BAR; PG8_WAIT_L(0); PG8_MMA(0, 1, At, B1); PG8_BAR;
            PG8_LDA(At, 1, 1); PG8_STAGE(PG8_SA(1, 0), a3, voffA);
            PG8_BAR; PG8_WAIT_L(0); PG8_MMA(1, 0, At, B0); PG8_BAR; PG8_SCHED;
            PG8_STAGE(PG8_SB(1, 1), b3 + hstep, voffB);
            PG8_WAIT_V(6); PG8_BAR; PG8_MMA(1, 1, At, B1); PG8_BAR;
            }
        }
        if constexpr (ALIGN_EPI) { if (wr == 0) PG8_BAR; }
        if constexpr (!Epi::AFTER_DRAIN) { E(acc, cur, wr, wc, fr, fq); S.done(cur); }
        if (!has_next) break;
#pragma unroll
        for (int a = 0; a < 2; ++a)
#pragma unroll
            for (int b = 0; b < 2; ++b)
#pragma unroll
                for (int m = 0; m < 4; ++m)
#pragma unroll
                    for (int n = 0; n < 2; ++n) acc[a][b][m][n] = (f32x4){0.f, 0.f, 0.f, 0.f};
        cur = nxt; cA = nA; cB = nB; ++ui;
        if constexpr (ALIGN_EPI) { if (wr == 1) PG8_BAR; }
    }
    PG8_WAIT_V(0);
    if constexpr (!ALIGN_EPI) { if (wr == 0) PG8_BAR; }
    PG8_BAR;
    if constexpr (Epi::AFTER_DRAIN) { E.fused(acc, cur, wr, wc, fr, fq, lds, wid, lane); S.done(cur); }
#undef PG8_SA
#undef PG8_SB
#undef PG8_STAGE
#undef PG8_LDA
#undef PG8_LDB
#undef PG8_MMA
#undef PG8_WAIT_V
#undef PG8_WAIT_L
#undef PG8_BAR
#undef PG8_SCHED
}
}
#define GAS __attribute__((address_space(1)))
#define LAS __attribute__((address_space(3)))
typedef unsigned short bf16;
typedef unsigned v4u __attribute__((ext_vector_type(4)));
typedef float f32x4 __attribute__((ext_vector_type(4)));
typedef short bf16x8 __attribute__((ext_vector_type(8)));
typedef GAS unsigned gu32;
typedef GAS unsigned long long gu64;
#define RLX_AGENT __ATOMIC_RELAXED, __HIP_MEMORY_SCOPE_AGENT
#define LDS_WAIT() asm volatile("s_waitcnt lgkmcnt(0)" ::: "memory")
#define VM_WAIT() asm volatile("s_waitcnt vmcnt(0)" ::: "memory")
__device__ __forceinline__ unsigned long long rt() { return __builtin_amdgcn_s_memrealtime(); }
typedef float f32x2_cv __attribute__((ext_vector_type(2))); typedef __bf16 bf16x2_cv __attribute__((ext_vector_type(2)));
__device__ __forceinline__ unsigned pk2(float lo, float hi) { const f32x2_cv v = {lo, hi}; const bf16x2_cv b = __builtin_convertvector(v, bf16x2_cv); return __builtin_bit_cast(unsigned, b); }
__device__ __forceinline__ unsigned f2bf(float f) { return pk2(f, 0.f) & 0xffffu; }

#define XB_TMO      128
#define XB_XCNT(j)  (256  + 64 * (j))
#define XB_XSUB(j)  (1280 + 64 * (j))
#define XB_XGEN(j)  (2304 + 64 * (j))
#define XB_TOP      3328
#define XB_TOPGEN   3392
#define XCD_BAR_WORDS 3456
#define XB_SPIN_CAP (1u << 18)

__device__ __forceinline__ unsigned xb_ld(unsigned* p)              { return __hip_atomic_load(p, __ATOMIC_RELAXED, __HIP_MEMORY_SCOPE_AGENT); }
__device__ __forceinline__ unsigned xb_add(unsigned* p, unsigned v) { return __hip_atomic_fetch_add(p, v, __ATOMIC_RELAXED, __HIP_MEMORY_SCOPE_AGENT); }
__device__ __forceinline__ unsigned xb_xcc_id() { return (unsigned)__builtin_amdgcn_s_getreg((3 << 11) | 20) & 0xFu; }
#define XB_SPIN(cond, bar) do { unsigned _sp = 0; while (cond) { __builtin_amdgcn_s_sleep(1); \
    if ((++_sp & 255u) == 0u) { if (xb_ld(&(bar)[XB_TMO])) break; if (_sp > XB_SPIN_CAP) { atomicAdd(&(bar)[XB_TMO], 1u); break; } } } } while (0)

struct XcdBarrier {
    unsigned* bar; unsigned x;
    volatile LAS unsigned* st;
};

__device__ __forceinline__ XcdBarrier xcd_barrier_post(unsigned* bar, volatile LAS unsigned* st) {
    XcdBarrier b; b.bar = bar; b.x = xb_xcc_id(); b.st = st;
    if (threadIdx.x == 0) (void)xb_add(&bar[XB_XCNT(b.x)], 1u);
    return b;
}
__device__ __forceinline__ void xcd_barrier_complete(unsigned* bar, unsigned x, unsigned& nloc, unsigned& nx) {
    const unsigned G = gridDim.x * gridDim.y * gridDim.z;
    unsigned sum, cnt, mine, sp = 0u;
    for (;;) {
        sum = 0u; cnt = 0u; mine = 0u;
#pragma unroll
        for (unsigned j = 0; j < 16; ++j) { const unsigned c = xb_ld(&bar[XB_XCNT(j)]); sum += c; cnt += (c > 0u) ? 1u : 0u; mine = (j == x) ? c : mine; }
        if (sum == G) break;
        __builtin_amdgcn_s_sleep(1);
        if ((++sp & 255u) == 0u) { if (xb_ld(&bar[XB_TMO])) break; if (sp > XB_SPIN_CAP) { atomicAdd(&bar[XB_TMO], 1u); break; } }
    }
    nloc = mine > 0u ? mine : 1u; nx = cnt > 0u ? cnt : 1u;
}

__device__ __forceinline__ void xcd_barrier(const XcdBarrier& b) {
    asm volatile("s_waitcnt vmcnt(0)" ::: "memory");
    __syncthreads();
    if (threadIdx.x == 0) {
        unsigned* bar = b.bar;
        __builtin_amdgcn_s_waitcnt(0);
        unsigned nloc = b.st[0], nx = b.st[1];
        if (nloc == 0u) { xcd_barrier_complete(bar, b.x, nloc, nx); b.st[0] = nloc; b.st[1] = nx; }
        const unsigned old = xb_add(&bar[XB_XSUB(b.x)], 1u);
        const unsigned gen = old / nloc;
        if (old + 1u == (gen + 1u) * nloc) {
            __builtin_amdgcn_fence(__ATOMIC_RELEASE, "agent");
            asm volatile("s_waitcnt vmcnt(0)" ::: "memory");
            const unsigned og = xb_add(&bar[XB_TOP], 1u);
            const unsigned tg = og / nx;
            if (og + 1u == (tg + 1u) * nx) xb_add(&bar[XB_TOPGEN], 1u);
            else XB_SPIN(xb_ld(&bar[XB_TOPGEN]) == tg, bar);
            __builtin_amdgcn_fence(__ATOMIC_ACQUIRE, "agent");
            xb_add(&bar[XB_XGEN(b.x)], 1u);
            asm volatile("s_waitcnt vmcnt(0)" ::: "memory");
        } else {
            XB_SPIN(xb_ld(&bar[XB_XGEN(b.x)]) == gen, bar);
            __builtin_amdgcn_fence(__ATOMIC_ACQUIRE, "agent");
            asm volatile("s_waitcnt vmcnt(0)" ::: "memory");
        }
    }
    __syncthreads();
}
constexpr int NWAVES = 8;
constexpr int T = 32768, D = 1024, SEQ = 4096;
constexpr float EPS = 1e-6f;
constexpr float LAMBDA_INIT = 0.35550906759f;
constexpr size_t MiB = 1u << 20;
constexpr size_t WS_CTL = 0, CTL_ZERO_BYTES = 1 * MiB;
constexpr size_t WS_ROPE = 1 * MiB;
constexpr size_t WS_WIN = 4 * MiB;
constexpr size_t WS_WO0 = 11 * MiB, WS_WQ0 = 13 * MiB, WS_KEY0 = 17 * MiB, WS_WQKV = 18 * MiB, WS_WO1 = 24 * MiB, WS_WQ1 = 26 * MiB, WS_KEY1 = 30 * MiB;
constexpr size_t WS_SC = 31 * MiB;
constexpr size_t WS_U0 = 32 * MiB, WS_V0T = 48 * MiB, WS_U1 = 64 * MiB, WS_V1T = 80 * MiB;
constexpr size_t WS_B0 = 96 * MiB;
constexpr size_t WS_R1 = 160 * MiB, WS_R2 = 224 * MiB, WS_R3 = 288 * MiB, WS_R4 = 352 * MiB, WS_R5 = 416 * MiB, WS_GATES = 480 * MiB;
constexpr size_t WS_END = 484 * MiB;
constexpr int CW_BAR = 4096;
constexpr int LDS_BYTES = 147456, MISC_OFF = LDS_BYTES - 128;

typedef float f32x16 __attribute__((ext_vector_type(16)));
typedef unsigned u32x2 __attribute__((ext_vector_type(2)));
typedef __bf16 bf16x2_t __attribute__((ext_vector_type(2)));
__device__ __forceinline__ float bf_lo(unsigned w) { return __uint_as_float(w << 16); }
__device__ __forceinline__ float bf_hi(unsigned w) { return __uint_as_float(w & 0xffff0000u); }
__device__ __forceinline__ float dot2(unsigned a, unsigned b, float c) { return __builtin_amdgcn_fdot2_f32_bf16(__builtin_bit_cast(bf16x2_t, a), __builtin_bit_cast(bf16x2_t, b), c, false); }
__device__ __forceinline__ float shx(float v, int lane, int m) { return __uint_as_float((unsigned)__builtin_amdgcn_ds_bpermute((lane ^ m) << 2, (int)__float_as_uint(v))); }
__device__ __forceinline__ int shxi(int v, int lane, int m) { return __builtin_amdgcn_ds_bpermute((lane ^ m) << 2, v); }
__device__ __forceinline__ float wave_sum(float v, int lane) {
#pragma unroll
    for (int o = 1; o < 64; o <<= 1) v += shx(v, lane, o);
    return v;
}
__device__ __forceinline__ f32x4 mfma16(bf16x8 a, bf16x8 b, f32x4 c) { return __builtin_amdgcn_mfma_f32_16x16x32_bf16(a, b, c, 0, 0, 0); }
__device__ __forceinline__ f32x16 mfma32(bf16x8 a, bf16x8 b, f32x16 c) { return __builtin_amdgcn_mfma_f32_32x32x16_bf16(a, b, c, 0, 0, 0); }
__device__ __forceinline__ u32x2 pack4(float a, float b, float c, float d) { u32x2 r; r.x = pk2(a, b); r.y = pk2(c, d); return r; }

__device__ __forceinline__ void p0_transpose_item(const float* W, int K, int N, bf16* WT, LAS float* scr, int item, int lane, const float* kscale = nullptr) {
    const int nblk = N / 32, kb = item / nblk, nb = item % nblk, k0 = 64 * kb, n0 = 32 * nb;
#pragma unroll 8
    for (int i = 0; i < 32; ++i) { const int kk = 2 * i + (lane >> 5); const float sc = kscale ? kscale[k0 + kk] : 1.f; scr[kk * 33 + (lane & 31)] = W[(size_t)(k0 + kk) * N + n0 + (lane & 31)] * sc; }
    LDS_WAIT(); asm volatile("" ::: "memory");
    const int c = lane & 7;
#pragma unroll
    for (int j = 0; j < 4; ++j) { const int n = (lane >> 3) + 8 * j; const LAS float* s = scr + (8 * c) * 33 + n;
        v4u o; o.x = pk2(s[0 * 33], s[1 * 33]); o.y = pk2(s[2 * 33], s[3 * 33]); o.z = pk2(s[4 * 33], s[5 * 33]); o.w = pk2(s[6 * 33], s[7 * 33]);
        *(v4u*)(WT + (size_t)(n0 + n) * K + k0 + 8 * c) = o; }
    LDS_WAIT(); asm volatile("" ::: "memory");
}
__device__ __forceinline__ void cvt_range(const float* src, bf16* dst, size_t n, size_t gtid, size_t gthreads) {
    for (size_t i = gtid * 8; i < n; i += gthreads * 8) {
        const f32x4 a = *(const f32x4*)(src + i), b = *(const f32x4*)(src + i + 4);
        v4u o; o.x = pk2(a.x, a.y); o.y = pk2(a.z, a.w); o.z = pk2(b.x, b.y); o.w = pk2(b.z, b.w);
        *(v4u*)(dst + i) = o; }
}
__device__ __forceinline__ void rms_row_to_bf16(const float* xrow, const float* g, bf16* orow, int lane) {
    const f32x4* xr = (const f32x4*)xrow + lane; const f32x4* gr = (const f32x4*)g + lane;
    f32x4 v[4]; float s = 0.f;
#pragma unroll
    for (int j = 0; j < 4; ++j) { v[j] = xr[64 * j]; s += (v[j].x * v[j].x + v[j].y * v[j].y) + (v[j].z * v[j].z + v[j].w * v[j].w); }
    const float rstd = rsqrtf(wave_sum(s, lane) * (1.f / 1024.f) + EPS);
    unsigned long long* o8 = (unsigned long long*)orow + lane;
#pragma unroll
    for (int j = 0; j < 4; ++j) { const f32x4 gg = gr[64 * j];
        o8[64 * j] = (unsigned long long)pk2(v[j].x * rstd * gg.x, v[j].y * rstd * gg.y) | ((unsigned long long)pk2(v[j].z * rstd * gg.z, v[j].w * rstd * gg.w) << 32); }
}
__device__ __forceinline__ void rms_pass(const float* X, const float* g, bf16* XN, int gw, int NGW, int lane) {
    for (int m = gw; m < T; m += NGW) rms_row_to_bf16(X + (size_t)m * D, g, XN + (size_t)m * D, lane);
}

__device__ __forceinline__ float logsigmoid_f(float f) { return fminf(f, 0.f) - log1pf(__expf(-fabsf(f))); }
#define ML_LOAD(ci_) do { const size_t r_ = rowbase + (size_t)(ci_) * 64 + lane; \
    rq = *(const v4u*)(Q0 + r_ * 64 + 8 * w); rk = *(const v4u*)(K0 + r_ * 64 + 8 * w); rv0 = *(const v4u*)(V0 + r_ * 128 + 16 * w); rv1 = *(const v4u*)(V0 + r_ * 128 + 16 * w + 8); \
    const size_t gm_ = ((size_t)b * 4096 + (size_t)(ci_) * 64 + jr) * 32; rli = GATES[gm_ + (dir ? 16 : 0) + h]; rf = GATES[gm_ + (dir ? 24 : 8) + h]; } while (0)
__device__ __forceinline__ void mlstm_phase(const int wv, LAS unsigned char* lds, const bf16* Q0, const bf16* K0, const bf16* V0, const float* GATES, bf16* HF, bf16* HB) {
    const int bx = blockIdx.x;
    if ((bx >> 3) & 1) return;
    const int seq = (bx >> 4) * 8 + (bx & 7);
    const int dir = seq & 1, bh = seq >> 1, b = bh >> 3, h = bh & 7;
    int ln_; asm volatile("v_mbcnt_lo_u32_b32 %0, -1, 0\n\tv_mbcnt_hi_u32_b32 %0, -1, %0" : "=v"(ln_)); const int tid = wv * 64 + ln_, lane = tid & 63, w = wv, fr = lane & 15, fq = lane >> 4;
    LAS bf16* Qs = (LAS bf16*)(lds); LAS bf16* Ks = (LAS bf16*)(lds + 9216); LAS bf16* Kwt = (LAS bf16*)(lds + 18432); LAS bf16* Ps = (LAS bf16*)(lds + 27648);
    LAS bf16* Vt = (LAS bf16*)(lds + 36864 + w * 2304); LAS bf16* Cs = (LAS bf16*)(lds + 55296 + w * 2304); LAS bf16* nb = (LAS bf16*)(lds + 73728 + w * 128);
    LAS float* gc = (LAS float*)(lds + 74752 + w * 1280); LAS float* gM = gc + 64; LAS float* gI = gc + 128; LAS float* gE = gc + 192; LAS float* gW = gc + 256;
    for (int i = lane; i < 2304 / 4; i += 64) ((LAS unsigned*)Cs)[i] = 0u;
    if (lane < 32) ((LAS unsigned*)nb)[lane] = 0u;
    f32x4 Cacc[4], Nacc[4];
#pragma unroll
    for (int i = 0; i < 4; ++i) { Cacc[i] = (f32x4){0.f, 0.f, 0.f, 0.f}; Nacc[i] = (f32x4){0.f, 0.f, 0.f, 0.f}; }
    float m = -1e30f;
    bf16* Hout = dir ? HB : HF;
    const size_t rowbase = (size_t)bh * 4096;
    const int jr = dir ? 63 - lane : lane;
    v4u rq, rk, rv0, rv1; float rli, rf;
    ML_LOAD(dir ? 63 : 0);
    const bf16x8 ones = (bf16x8){0x3F80, 0x3F80, 0x3F80, 0x3F80, 0x3F80, 0x3F80, 0x3F80, 0x3F80};
    const f32x4 z4 = (f32x4){0.f, 0.f, 0.f, 0.f};
#pragma unroll 1
    for (int step = 0; step < 64; ++step) {
        const int ci = dir ? 63 - step : step;
        const float lf = logsigmoid_f(rf);
        float bcs = lf;
        bcs += __uint_as_float((unsigned)__builtin_amdgcn_update_dpp(0, (int)__float_as_uint(bcs), 0x111, 0xF, 0xF, false));
        bcs += __uint_as_float((unsigned)__builtin_amdgcn_update_dpp(0, (int)__float_as_uint(bcs), 0x112, 0xF, 0xF, false));
        bcs += __uint_as_float((unsigned)__builtin_amdgcn_update_dpp(0, (int)__float_as_uint(bcs), 0x114, 0xF, 0xF, false));
        bcs += __uint_as_float((unsigned)__builtin_amdgcn_update_dpp(0, (int)__float_as_uint(bcs), 0x118, 0xF, 0xF, false));
        bcs += __uint_as_float((unsigned)__builtin_amdgcn_update_dpp(0, (int)__float_as_uint(bcs), 0x142, 0xA, 0xF, false));
        bcs += __uint_as_float((unsigned)__builtin_amdgcn_update_dpp(0, (int)__float_as_uint(bcs), 0x143, 0xC, 0xF, false));
        const float c = rli - bcs;
        float pm = c;
        const int NINFI = (int)0xFF800000u;
        pm = fmaxf(pm, __uint_as_float((unsigned)__builtin_amdgcn_update_dpp(NINFI, (int)__float_as_uint(pm), 0x111, 0xF, 0xF, false)));
        pm = fmaxf(pm, __uint_as_float((unsigned)__builtin_amdgcn_update_dpp(NINFI, (int)__float_as_uint(pm), 0x112, 0xF, 0xF, false)));
        pm = fmaxf(pm, __uint_as_float((unsigned)__builtin_amdgcn_update_dpp(NINFI, (int)__float_as_uint(pm), 0x114, 0xF, 0xF, false)));
        pm = fmaxf(pm, __uint_as_float((unsigned)__builtin_amdgcn_update_dpp(NINFI, (int)__float_as_uint(pm), 0x118, 0xF, 0xF, false)));
        pm = fmaxf(pm, __uint_as_float((unsigned)__builtin_amdgcn_update_dpp(NINFI, (int)__float_as_uint(pm), 0x142, 0xA, 0xF, false)));
        pm = fmaxf(pm, __uint_as_float((unsigned)__builtin_amdgcn_update_dpp(NINFI, (int)__float_as_uint(pm), 0x143, 0xC, 0xF, false)));
        const float M = fmaxf(m, pm);
        const float bL = __uint_as_float((unsigned)__builtin_amdgcn_readlane((int)__float_as_uint(bcs), 63)), Mlast = __uint_as_float((unsigned)__builtin_amdgcn_readlane((int)__float_as_uint(M), 63));
        gc[jr] = c; gM[jr] = M; gI[jr] = __expf(m - M); gE[jr] = __expf(-(bcs + M)); gW[jr] = __expf(c - Mlast);
        const float sp = __expf(m - Mlast), m_new = bL + Mlast;
        const float wr_ = gW[lane];
        *(LAS v4u*)(Qs + lane * 72 + 8 * w) = rq; *(LAS v4u*)(Ks + lane * 72 + 8 * w) = rk;
#pragma unroll
        for (int i = 0; i < 4; ++i) { const unsigned kw = rk[i]; Kwt[(8 * w + 2 * i) * 72 + lane] = (bf16)f2bf(bf_lo(kw) * wr_); Kwt[(8 * w + 2 * i + 1) * 72 + lane] = (bf16)f2bf(bf_hi(kw) * wr_); }
#pragma unroll
        for (int i = 0; i < 4; ++i) { Vt[(2 * i) * 72 + lane] = (bf16)(rv0[i] & 0xffffu); Vt[(2 * i + 1) * 72 + lane] = (bf16)(rv0[i] >> 16);
                                      Vt[(8 + 2 * i) * 72 + lane] = (bf16)(rv1[i] & 0xffffu); Vt[(9 + 2 * i) * 72 + lane] = (bf16)(rv1[i] >> 16); }
        __syncthreads();
        if (step < 63) ML_LOAD(dir ? 62 - step : step + 1);
        {
            const int st = w >> 1;
            const bf16x8 a0 = *(const LAS bf16x8*)(Ks + (16 * st + fr) * 72 + 8 * fq), a1 = *(const LAS bf16x8*)(Ks + (16 * st + fr) * 72 + 32 + 8 * fq);
#pragma unroll
            for (int u = 0; u < 2; ++u) { const int tt = 2 * (w & 1) + u;
                const bf16x8 b0 = *(const LAS bf16x8*)(Qs + (16 * tt + fr) * 72 + 8 * fq), b1 = *(const LAS bf16x8*)(Qs + (16 * tt + fr) * 72 + 32 + 8 * fq);
                f32x4 acc = mfma16(a0, b0, z4); acc = mfma16(a1, b1, acc);
                const int t = 16 * tt + fr; const float Mt = gM[t]; float pv[4];
#pragma unroll
                for (int i = 0; i < 4; ++i) { const int s = 16 * st + 4 * fq + i; const bool valid = dir ? (s >= t) : (s <= t); const float e = __expf(gc[s] - Mt); pv[i] = valid ? acc[i] * e : 0.f; }
                *(LAS u32x2*)(Ps + t * 72 + 16 * st + 4 * fq) = pack4(pv[0], pv[1], pv[2], pv[3]); }
        }
        __syncthreads();
        const bf16x8 aV0 = *(const LAS bf16x8*)(Vt + fr * 72 + 8 * fq), aV1 = *(const LAS bf16x8*)(Vt + fr * 72 + 32 + 8 * fq);
        {
            const bf16x8 aC0 = *(const LAS bf16x8*)(Cs + fr * 72 + 8 * fq), aC1 = *(const LAS bf16x8*)(Cs + fr * 72 + 32 + 8 * fq);
            const bf16x8 aN0 = *(const LAS bf16x8*)(nb + 8 * fq), aN1 = *(const LAS bf16x8*)(nb + 32 + 8 * fq);
#pragma unroll
            for (int tt = 0; tt < 4; ++tt) {
                const bf16x8 bP0 = *(const LAS bf16x8*)(Ps + (16 * tt + fr) * 72 + 8 * fq), bP1 = *(const LAS bf16x8*)(Ps + (16 * tt + fr) * 72 + 32 + 8 * fq);
                const bf16x8 bQ0 = *(const LAS bf16x8*)(Qs + (16 * tt + fr) * 72 + 8 * fq), bQ1 = *(const LAS bf16x8*)(Qs + (16 * tt + fr) * 72 + 32 + 8 * fq);
                f32x4 acc1 = mfma16(aV0, bP0, z4); acc1 = mfma16(aV1, bP1, acc1);
                f32x4 acc2 = mfma16(aC0, bQ0, z4); acc2 = mfma16(aC1, bQ1, acc2);
                f32x4 d1 = mfma16(ones, bP0, z4); d1 = mfma16(ones, bP1, d1);
                f32x4 d2 = mfma16(aN0, bQ0, z4); d2 = mfma16(aN1, bQ1, d2);
                const int t = 16 * tt + fr; const float it = gI[t], en = gE[t];
                const float den = d1[0] + it * d2[0]; const float inv = 1.f / fmaxf(fabsf(den), en);
                *(u32x2*)(Hout + ((size_t)b * 4096 + (size_t)ci * 64 + t) * 1024 + h * 128 + 16 * w + 4 * fq) =
                    pack4((acc1[0] + it * acc2[0]) * inv, (acc1[1] + it * acc2[1]) * inv, (acc1[2] + it * acc2[2]) * inv, (acc1[3] + it * acc2[3]) * inv);
            }
        }
#pragma unroll
        for (int dt = 0; dt < 4; ++dt) { Cacc[dt] = Cacc[dt] * sp; Nacc[dt] = Nacc[dt] * sp;
            const bf16x8 aK0 = *(const LAS bf16x8*)(Kwt + (16 * dt + fr) * 72 + 8 * fq), aK1 = *(const LAS bf16x8*)(Kwt + (16 * dt + fr) * 72 + 32 + 8 * fq);
            Cacc[dt] = mfma16(aK0, aV0, Cacc[dt]); Cacc[dt] = mfma16(aK1, aV1, Cacc[dt]);
            Nacc[dt] = mfma16(aK0, ones, Nacc[dt]); Nacc[dt] = mfma16(aK1, ones, Nacc[dt]); }
#pragma unroll
        for (int dt = 0; dt < 4; ++dt) { *(LAS u32x2*)(Cs + fr * 72 + 16 * dt + 4 * fq) = pack4(Cacc[dt][0], Cacc[dt][1], Cacc[dt][2], Cacc[dt][3]);
                                         *(LAS u32x2*)(nb + 16 * dt + 4 * fq) = pack4(Nacc[dt][0], Nacc[dt][1], Nacc[dt][2], Nacc[dt][3]); }
        m = m_new;
        __syncthreads();
    }
}
#undef ML_LOAD

__device__ __forceinline__ void hs_pass(const bf16* HF, const bf16* HB, const bf16* OG, const float* hg, bf16* HS, int gw, int NGW, int lane) {
    for (int m = gw; m < T; m += NGW) {
        const size_t off = (size_t)m * 1024 + 16 * lane;
        const v4u f0 = *(const v4u*)(HF + off), f1 = *(const v4u*)(HF + off + 8), b0 = *(const v4u*)(HB + off), b1 = *(const v4u*)(HB + off + 8), o0 = *(const v4u*)(OG + off), o1 = *(const v4u*)(OG + off + 8);
        float x[16], og[16];
#pragma unroll
        for (int i = 0; i < 4; ++i) { x[2 * i] = bf_lo(f0[i]) + bf_lo(b0[i]); x[2 * i + 1] = bf_hi(f0[i]) + bf_hi(b0[i]); x[8 + 2 * i] = bf_lo(f1[i]) + bf_lo(b1[i]); x[9 + 2 * i] = bf_hi(f1[i]) + bf_hi(b1[i]);
                                      og[2 * i] = bf_lo(o0[i]); og[2 * i + 1] = bf_hi(o0[i]); og[8 + 2 * i] = bf_lo(o1[i]); og[9 + 2 * i] = bf_hi(o1[i]); }
        float ss = 0.f;
#pragma unroll
        for (int i = 0; i < 16; ++i) ss += x[i] * x[i];
        ss += shx(ss, lane, 1); ss += shx(ss, lane, 2); ss += shx(ss, lane, 4);
        const float rstd = rsqrtf(ss * (1.f / 128.f) + EPS);
        float y[16];
#pragma unroll
        for (int i = 0; i < 16; ++i) y[i] = x[i] * rstd * hg[16 * lane + i] * (1.f / (1.f + __expf(-og[i])));
        v4u w0, w1;
#pragma unroll
        for (int i = 0; i < 4; ++i) { w0[i] = pk2(y[2 * i], y[2 * i + 1]); w1[i] = pk2(y[8 + 2 * i], y[9 + 2 * i]); }
        *(v4u*)(HS + off) = w0; *(v4u*)(HS + off + 8) = w1;
    }
}

__device__ __forceinline__ void glds16(const void* gsrc, unsigned lds_dst) { unsigned keep;
    asm volatile("s_mov_b32 %0, m0\n\ts_mov_b32 m0, %2\n\ts_nop 0\n\tglobal_load_lds_dwordx4 %1, off\n\ts_mov_b32 m0, %0" : "=&s"(keep) : "v"(gsrc), "s"(lds_dst) : "memory"); }
#define AT_WAIT_BAR() asm volatile("s_waitcnt vmcnt(0) lgkmcnt(0)\n\ts_barrier" ::: "memory")

#define TK_CE(a, b) do { const float h_ = fmaxf(a, b), l_ = fminf(a, b); a = h_; b = l_; } while (0)
#define BITONIC_MERGE16(x) do { _Pragma("unroll") for (int d_ = 8; d_ >= 1; d_ >>= 1) { _Pragma("unroll") for (int i_ = 0; i_ < 16; ++i_) if ((i_ & d_) == 0) TK_CE(x[i_], x[i_ + d_]); } } while (0)
#define BITONIC_SORT16(x) do { _Pragma("unroll") for (int k_ = 2; k_ <= 16; k_ <<= 1) { _Pragma("unroll") for (int d_ = k_ >> 1; d_ >= 1; d_ >>= 1) { _Pragma("unroll") for (int i_ = 0; i_ < 16; ++i_) { const int l_i = i_ ^ d_; \
    if (l_i > i_) { if ((i_ & k_) == 0 || k_ == 16) TK_CE(x[i_], x[l_i]); else TK_CE(x[l_i], x[i_]); } } } } } while (0)
#define TK_INSERT(v, x) do { float c_ = (x); _Pragma("unroll") for (int j_ = 0; j_ < 16; ++j_) { const float h_ = fmaxf(v[j_], c_); c_ = fminf(v[j_], c_); v[j_] = h_; } } while (0)
#define TK_DMA(st_, b_) do { _Pragma("unroll") for (int g_ = 0; g_ < 2; ++g_) { const int hp_ = ((g_ * 4 + ((st_) >> 1)) * 2 + ((st_) & 1)); \
    _Pragma("unroll") for (int i_ = 0; i_ < 4; ++i_) { const int q_ = w * 4 + i_, row_ = 4 * q_ + (lane >> 4), ch_ = (lane & 15) ^ (row_ & 15); \
        glds16(KEYS + ((size_t)(hp_ * 128 + row_)) * 128 + ch_ * 8, (unsigned)__builtin_amdgcn_readfirstlane((int)(ldsb + ((b_) * 2 + g_) * 32768 + q_ * 1024))); } } } while (0)
__device__ __forceinline__ void peer_topk_phase(const int wv, LAS unsigned char* lds, int vcu, const bf16* PQ, const bf16* KEYS, int* EXPERTS, float* GATESP) {
    int ln_; asm volatile("v_mbcnt_lo_u32_b32 %0, -1, 0\n\tv_mbcnt_hi_u32_b32 %0, -1, %0" : "=v"(ln_)); const int tid = wv * 64 + ln_, lane = tid & 63, w = wv, r32 = lane & 31, hi = lane >> 5;
    const int t = vcu * 128 + (w & 3) * 32 + r32, hg = w >> 2;
    const float NINF = -INFINITY;
    const unsigned ldsb = (unsigned)(uintptr_t)lds;
    TK_DMA(0, 0);
    AT_WAIT_BAR();
#pragma unroll 1
    for (int hh = 0; hh < 4; ++hh) {
        const int head = hg * 4 + hh;
        float L0[16], L1[16];
#pragma unroll
        for (int j = 0; j < 16; ++j) { L0[j] = 0.f; L1[j] = 0.f; }
#pragma unroll 1
        for (int p = 0; p < 2; ++p) {
            const int st = hh * 2 + p, buf = st & 1;
            if (st < 7) TK_DMA(st + 1, buf ^ 1);
            bf16x8 bq[8];
#pragma unroll
            for (int ks = 0; ks < 8; ++ks) bq[ks] = *(const bf16x8*)(PQ + (size_t)t * 2048 + head * 256 + p * 128 + ks * 16 + 8 * hi);
            const LAS unsigned char* kb = lds + (buf * 2 + hg) * 32768 + r32 * 256;
            f32x16 acc[4];
#pragma unroll
            for (int nt = 0; nt < 4; ++nt) {
#pragma unroll
                for (int r = 0; r < 16; ++r) acc[nt][r] = 0.f;
#pragma unroll
                for (int ks = 0; ks < 8; ++ks) { const bf16x8 a = *(const LAS bf16x8*)(kb + nt * 8192 + (((2 * ks + hi) ^ (r32 & 15)) << 4)); acc[nt] = mfma32(a, bq[ks], acc[nt]); }
            }
            float v[16];
            {
                float blk[4][16];
#pragma unroll
                for (int nt = 0; nt < 4; ++nt)
#pragma unroll
                    for (int r = 0; r < 16; ++r) { const int n = nt * 32 + (r & 3) + 8 * (r >> 2) + 4 * hi; blk[nt][r] = __uint_as_float((__float_as_uint(acc[nt][r]) & ~0x7Fu) | (unsigned)(127 - n)); }
#pragma unroll
                for (int nt = 0; nt < 4; ++nt) BITONIC_SORT16(blk[nt]);
#pragma unroll
                for (int i = 0; i < 16; ++i) { blk[0][i] = fmaxf(blk[0][i], blk[1][15 - i]); blk[2][i] = fmaxf(blk[2][i], blk[3][15 - i]); }
                BITONIC_MERGE16(blk[0]); BITONIC_MERGE16(blk[2]);
#pragma unroll
                for (int i = 0; i < 16; ++i) v[i] = fmaxf(blk[0][i], blk[2][15 - i]);
                BITONIC_MERGE16(v);
            }
            {
                float wv_[16];
#pragma unroll
                for (int j = 0; j < 16; ++j) wv_[j] = shx(v[15 - j], lane, 32);
#pragma unroll
                for (int j = 0; j < 16; ++j) v[j] = fmaxf(v[j], wv_[j]);
                BITONIC_MERGE16(v);
            }
            if (p == 0) {
#pragma unroll
                for (int j = 0; j < 16; ++j) L0[j] = v[j];
            } else {
#pragma unroll
                for (int j = 0; j < 16; ++j) L1[j] = v[j];
            }            AT_WAIT_BAR();
        }
        float tv[16];
        unsigned IA[4] = {0u, 0u, 0u, 0u}, IB[4] = {0u, 0u, 0u, 0u};
#pragma unroll
        for (int i = 0; i < 16; ++i) { IA[i >> 2] |= (127u - (__float_as_uint(L0[i]) & 0x7Fu)) << (8 * (i & 3)); IB[i >> 2] |= (127u - (__float_as_uint(L1[i]) & 0x7Fu)) << (8 * (i & 3)); }
        {
            float cb[4][16]; int cn = 0;
#pragma unroll
            for (int i = 0; i < 16; ++i) {
                const float va = __uint_as_float(__float_as_uint(L0[i]) & ~0x7Fu);
#pragma unroll
                for (int j = 0; j < 16; ++j) if ((i + 1) * (j + 1) <= 16) {
                    const float vb = __uint_as_float(__float_as_uint(L1[j]) & ~0x7Fu);
                    cb[cn >> 4][cn & 15] = __uint_as_float((__float_as_uint(va + vb) & ~0xFFu) | (unsigned)(255 - (i * 16 + j)));
                    ++cn;
                }
            }
#pragma unroll
            for (int c = 50; c < 64; ++c) cb[c >> 4][c & 15] = NINF;
#pragma unroll
            for (int nt = 0; nt < 4; ++nt) BITONIC_SORT16(cb[nt]);
#pragma unroll
            for (int i = 0; i < 16; ++i) { cb[0][i] = fmaxf(cb[0][i], cb[1][15 - i]); cb[2][i] = fmaxf(cb[2][i], cb[3][15 - i]); }
            BITONIC_MERGE16(cb[0]); BITONIC_MERGE16(cb[2]);
#pragma unroll
            for (int i = 0; i < 16; ++i) tv[i] = fmaxf(cb[0][i], cb[2][15 - i]);
            BITONIC_MERGE16(tv);
        }
        int ti[16];
#pragma unroll
        for (int j = 0; j < 16; ++j) { const unsigned kb = __float_as_uint(tv[j]); const unsigned flat = 255u - (kb & 0xFFu); const unsigned fi = flat >> 4, fj = flat & 15u;
            const unsigned ra = (fi < 8u) ? ((fi < 4u) ? IA[0] : IA[1]) : ((fi < 12u) ? IA[2] : IA[3]);
            const unsigned rb = (fj < 8u) ? ((fj < 4u) ? IB[0] : IB[1]) : ((fj < 12u) ? IB[2] : IB[3]);
            ti[j] = (int)(((ra >> (8u * (fi & 3u))) & 0xFFu) * 128u + ((rb >> (8u * (fj & 3u))) & 0xFFu));
            tv[j] = __uint_as_float(kb & ~0xFFu); }
        float e[16], sum = 0.f;
#pragma unroll
        for (int j = 0; j < 16; ++j) { e[j] = __expf(tv[j] - tv[0]); sum += e[j]; }
        const float inv = 1.f / sum;
        if (hi == 0) { int* ep = EXPERTS + (size_t)t * 128 + head * 16;
#pragma unroll
            for (int j = 0; j < 4; ++j) *(v4u*)(ep + 4 * j) = (v4u){(unsigned)ti[4 * j], (unsigned)ti[4 * j + 1], (unsigned)ti[4 * j + 2], (unsigned)ti[4 * j + 3]}; }
        else { float* gp = GATESP + (size_t)t * 128 + head * 16;
#pragma unroll
            for (int j = 0; j < 4; ++j) *(f32x4*)(gp + 4 * j) = (f32x4){e[4 * j] * inv, e[4 * j + 1] * inv, e[4 * j + 2] * inv, e[4 * j + 3] * inv}; }
    }
}

__device__ __forceinline__ float cvt_ub0(unsigned x) { float r; asm("v_cvt_f32_ubyte0 %0, %1" : "=v"(r) : "v"(x)); return r; }
__device__ __forceinline__ float cvt_ub1(unsigned x) { float r; asm("v_cvt_f32_ubyte1 %0, %1" : "=v"(r) : "v"(x)); return r; }
__device__ __forceinline__ float cvt_ub2(unsigned x) { float r; asm("v_cvt_f32_ubyte2 %0, %1" : "=v"(r) : "v"(x)); return r; }
__device__ __forceinline__ float cvt_ub3(unsigned x) { float r; asm("v_cvt_f32_ubyte3 %0, %1" : "=v"(r) : "v"(x)); return r; }
__device__ __forceinline__ void quant4_rows(const float* src, unsigned char* dst, float* scale, int nrows, int gw, int NGW, int lane) {
    for (int r = gw; r < nrows; r += NGW) {
        const f32x4* sp = (const f32x4*)(src + (size_t)r * 1024) + 4 * lane;
        f32x4 v[4]; float am = 0.f, ss = 0.f;
#pragma unroll
        for (int j = 0; j < 4; ++j) { v[j] = sp[j]; am = fmaxf(am, fmaxf(fmaxf(fabsf(v[j].x), fabsf(v[j].y)), fmaxf(fabsf(v[j].z), fabsf(v[j].w)))); ss += (v[j].x * v[j].x + v[j].y * v[j].y) + (v[j].z * v[j].z + v[j].w * v[j].w); }
#pragma unroll
        for (int o = 1; o < 64; o <<= 1) { am = fmaxf(am, shx(am, lane, o)); ss += shx(ss, lane, o); }
        const float step = fminf(am * (1.f / 7.5f), 0.3352f * sqrtf(ss * (1.f / 1024.f)));
        const float inv = step > 0.f ? 1.f / step : 0.f;
        unsigned q[16];
#pragma unroll
        for (int j = 0; j < 4; ++j) { q[4 * j] = (unsigned)fminf(fmaxf(rintf(v[j].x * inv + 7.5f), 0.f), 15.f); q[4 * j + 1] = (unsigned)fminf(fmaxf(rintf(v[j].y * inv + 7.5f), 0.f), 15.f);
                                      q[4 * j + 2] = (unsigned)fminf(fmaxf(rintf(v[j].z * inv + 7.5f), 0.f), 15.f); q[4 * j + 3] = (unsigned)fminf(fmaxf(rintf(v[j].w * inv + 7.5f), 0.f), 15.f); }
        u32x2 w;
        w.x = (q[0] | (q[4] << 4)) | ((q[1] | (q[5] << 4)) << 8) | ((q[2] | (q[6] << 4)) << 16) | ((q[3] | (q[7] << 4)) << 24);
        w.y = (q[8] | (q[12] << 4)) | ((q[9] | (q[13] << 4)) << 8) | ((q[10] | (q[14] << 4)) << 16) | ((q[11] | (q[15] << 4)) << 24);
        *(u32x2*)(dst + (size_t)r * 512 + 8 * lane) = w;
        if (lane == 0) scale[r] = step;
    }
}

#define RED_STEP(N, S) do { const bool up_ = (lane & (S)) != 0; _Pragma("unroll") for (int j_ = 0; j_ < (N); ++j_) { const int a_ = p[j_], b_ = p[j_ + (N)]; const int send_ = up_ ? a_ : b_, keep_ = up_ ? b_ : a_; p[j_] = keep_ + shxi(send_, lane, (S)); } } while (0)
#define RED16(dst) do { RED_STEP(8, 8); RED_STEP(4, 4); RED_STEP(2, 2); RED_STEP(1, 1); int s_ = p[0]; s_ += shxi(s_, lane, 16); s_ += shxi(s_, lane, 32); dst = s_; } while (0)
#define G_SB() __builtin_amdgcn_sched_barrier(0)
#define G_LOAD(buf, tab, evec, jb) do { _Pragma("unroll") for (int jj_ = 0; jj_ < 16; ++jj_) { const int e_ = __builtin_amdgcn_readlane(evec, (jb) + jj_); buf[jj_] = __builtin_amdgcn_raw_buffer_load_b64(rs_##tab, (int)voff, e_ << 9, 0); } } while (0)
#define U_COMP(buf) do { _Pragma("unroll") for (int jj_ = 0; jj_ < 16; ++jj_) { const unsigned w0_ = buf[jj_].x, w1_ = buf[jj_].y; \
    int d_ = __builtin_amdgcn_sdot4((int)(w0_ & 0x0F0F0F0Fu), hq[0], 0, false); d_ = __builtin_amdgcn_sdot4((int)((w0_ >> 4) & 0x0F0F0F0Fu), hq[1], d_, false); \
    d_ = __builtin_amdgcn_sdot4((int)(w1_ & 0x0F0F0F0Fu), hq[2], d_, false); d_ = __builtin_amdgcn_sdot4((int)((w1_ >> 4) & 0x0F0F0F0Fu), hq[3], d_, false); p[jj_] = d_; } } while (0)
#define V_DW(o0, o1, o2, o3, wd, cs) do { float t0_, t1_, t2_, t3_; asm volatile("v_cvt_f32_ubyte0 %4, %8\n\tv_cvt_f32_ubyte1 %5, %8\n\tv_cvt_f32_ubyte2 %6, %8\n\tv_cvt_f32_ubyte3 %7, %8\n\tv_fmac_f32 %0, %9, %4\n\tv_fmac_f32 %1, %9, %5\n\tv_fmac_f32 %2, %9, %6\n\tv_fmac_f32 %3, %9, %7" \
    : "+v"(o0), "+v"(o1), "+v"(o2), "+v"(o3), "=&v"(t0_), "=&v"(t1_), "=&v"(t2_), "=&v"(t3_) : "v"(wd), "s"(cs)); } while (0)
#define V_COMP(buf, cvec, jb) do { _Pragma("unroll") for (int jj_ = 0; jj_ < 16; ++jj_) { const float c_ = __uint_as_float(__builtin_amdgcn_readlane(__float_as_uint(cvec), (jb) + jj_)); const unsigned w0_ = buf[jj_].x, w1_ = buf[jj_].y; \
    V_DW(o[0], o[1], o[2], o[3], w0_ & 0x0F0F0F0Fu, c_); V_DW(o[4], o[5], o[6], o[7], (w0_ >> 4) & 0x0F0F0F0Fu, c_); V_DW(o[8], o[9], o[10], o[11], w1_ & 0x0F0F0F0Fu, c_); V_DW(o[12], o[13], o[14], o[15], (w1_ >> 4) & 0x0F0F0F0Fu, c_); } } while (0)
template <bool NEXT_NORM>
__device__ __forceinline__ void peer_gather_phase(const int wv, bool dry, int vcu, const bf16* HN, const int* EXPERTS, const float* GATESP, const unsigned char* U, const float* SU, const unsigned char* Vtab, const float* SV,
                                                  float* X, const float* gnext, bf16* XN) {
    int ln_; asm volatile("v_mbcnt_lo_u32_b32 %0, -1, 0\n\tv_mbcnt_hi_u32_b32 %0, -1, %0" : "=v"(ln_)); const int tid = wv * 64 + ln_, lane = tid & 63, w = wv;
    const __amdgpu_buffer_rsrc_t rs_U = __builtin_amdgcn_make_buffer_rsrc((void*)U, (short)0, 16384 * 512, 0x00020000), rs_Vtab = __builtin_amdgcn_make_buffer_rsrc((void*)Vtab, (short)0, 16384 * 512, 0x00020000);
    const unsigned voff = (unsigned)lane * 8u;
    const int lg = lane >> 4;
#pragma unroll 1
    for (int i = 0; i < 16; ++i) {
        const int t = vcu * 128 + w * 16 + i;
        const int ev0 = EXPERTS[(size_t)t * 128 + lane], ev1 = EXPERTS[(size_t)t * 128 + 64 + lane];
        const float gv0 = GATESP[(size_t)t * 128 + lane], gv1 = GATESP[(size_t)t * 128 + 64 + lane];
        const v4u h0 = *(const v4u*)(HN + (size_t)t * 1024 + 16 * lane), h1 = *(const v4u*)(HN + (size_t)t * 1024 + 16 * lane + 8);
        float hf[16]; float am = 0.f;
#pragma unroll
        for (int k = 0; k < 4; ++k) { hf[2 * k] = bf_lo(h0[k]); hf[2 * k + 1] = bf_hi(h0[k]); hf[8 + 2 * k] = bf_lo(h1[k]); hf[9 + 2 * k] = bf_hi(h1[k]); }
#pragma unroll
        for (int k = 0; k < 16; ++k) am = fmaxf(am, fabsf(hf[k]));
#pragma unroll
        for (int o = 1; o < 64; o <<= 1) am = fmaxf(am, shx(am, lane, o));
        const float hinv = am > 0.f ? 127.f / am : 0.f, sh = am * (1.f / 127.f);
        int hq[4]; int hs = 0;
#pragma unroll
        for (int k = 0; k < 4; ++k) { const int q0 = (int)rintf(hf[4 * k] * hinv), q1 = (int)rintf(hf[4 * k + 1] * hinv), q2 = (int)rintf(hf[4 * k + 2] * hinv), q3 = (int)rintf(hf[4 * k + 3] * hinv); hs += (q0 + q1) + (q2 + q3);
            hq[k] = (int)(((unsigned)(q0 & 0xff)) | ((unsigned)(q1 & 0xff) << 8) | ((unsigned)(q2 & 0xff) << 16) | ((unsigned)(q3 & 0xff) << 24)); }
#pragma unroll
        for (int o = 1; o < 64; o <<= 1) hs += shxi(hs, lane, o);
        const float hoff = 7.5f * (float)hs;
        const float su0 = SU[ev0], su1 = SU[ev1], sv0 = SV[ev0], sv1 = SV[ev1];
        float o[16];
#pragma unroll
        for (int k = 0; k < 16; ++k) o[k] = 0.f;
        int p[16], r0, r1, r2, r3, r4, r5, r6, r7;
        u32x2 A[16], B[16], C[16];
        G_LOAD(A, U, ev0, 0); G_LOAD(B, U, ev0, 16); G_SB();
        G_LOAD(C, U, ev0, 32); G_SB(); U_COMP(A); RED16(r0); G_SB();
        G_LOAD(A, U, ev0, 48); G_SB(); U_COMP(B); RED16(r1); G_SB();
        G_LOAD(B, U, ev1, 0); G_SB(); U_COMP(C); RED16(r2); G_SB();
        G_LOAD(C, U, ev1, 16); G_SB(); U_COMP(A); RED16(r3); G_SB();
        G_LOAD(A, U, ev1, 32); G_SB(); U_COMP(B); RED16(r4); G_SB();
        G_LOAD(B, U, ev1, 48); G_SB(); U_COMP(C); RED16(r5); G_SB();
        G_LOAD(C, Vtab, ev0, 0); G_SB(); U_COMP(A); RED16(r6); G_SB();
        G_LOAD(A, Vtab, ev0, 16); G_SB(); U_COMP(B); RED16(r7); G_SB();
        const int d0 = lg == 0 ? r0 : (lg == 1 ? r1 : (lg == 2 ? r2 : r3)), d1 = lg == 0 ? r4 : (lg == 1 ? r5 : (lg == 2 ? r6 : r7));
        float act0 = ((float)d0 - hoff) * (sh * su0), act1 = ((float)d1 - hoff) * (sh * su1);
#ifdef PROBE_NOFFN
        const float coef0 = 0.f * act0, coef1 = 0.f * act1;
#else
        const float coef0 = gv0 * (0.5f * act0 * (1.f + erff(act0 * 0.70710678118f))) * sv0, coef1 = gv1 * (0.5f * act1 * (1.f + erff(act1 * 0.70710678118f))) * sv1;
#endif
        G_SB();
        G_LOAD(B, Vtab, ev0, 32); G_SB(); V_COMP(C, coef0, 0); G_SB();
        G_LOAD(C, Vtab, ev0, 48); G_SB(); V_COMP(A, coef0, 16); G_SB();
        G_LOAD(A, Vtab, ev1, 0); G_SB(); V_COMP(B, coef0, 32); G_SB();
        G_LOAD(B, Vtab, ev1, 16); G_SB(); V_COMP(C, coef0, 48); G_SB();
        G_LOAD(C, Vtab, ev1, 32); G_SB(); V_COMP(A, coef1, 0); G_SB();
        G_LOAD(A, Vtab, ev1, 48); G_SB(); V_COMP(B, coef1, 16); G_SB();
        V_COMP(C, coef1, 32); G_SB(); V_COMP(A, coef1, 48); G_SB();
        const float corr = 7.5f * wave_sum(coef0 + coef1, lane);
        float* xr = X + (size_t)t * 1024 + 16 * lane;
        f32x4 xv[4];
#pragma unroll
        for (int k = 0; k < 4; ++k) { xv[k] = *(const f32x4*)(xr + 4 * k); xv[k] += (f32x4){o[4 * k] - corr, o[4 * k + 1] - corr, o[4 * k + 2] - corr, o[4 * k + 3] - corr}; }
        if (!dry) {
#pragma unroll
            for (int k = 0; k < 4; ++k) *(f32x4*)(xr + 4 * k) = xv[k]; }
        if (NEXT_NORM && !dry) {
            float ss = 0.f;
#pragma unroll
            for (int k = 0; k < 4; ++k) ss += (xv[k].x * xv[k].x + xv[k].y * xv[k].y) + (xv[k].z * xv[k].z + xv[k].w * xv[k].w);
            const float rstd = rsqrtf(wave_sum(ss, lane) * (1.f / 1024.f) + EPS);
            v4u wa, wb;
#pragma unroll
            for (int k = 0; k < 4; ++k) { const f32x4 g = *(const f32x4*)(gnext + 16 * lane + 4 * k); const unsigned lo = pk2(xv[k].x * rstd * g.x, xv[k].y * rstd * g.y), hi2 = pk2(xv[k].z * rstd * g.z, xv[k].w * rstd * g.w);
                if (k < 2) { wa[2 * k] = lo; wa[2 * k + 1] = hi2; } else { wb[2 * (k - 2)] = lo; wb[2 * (k - 2) + 1] = hi2; } }
            *(v4u*)(XN + (size_t)t * 1024 + 16 * lane) = wa; *(v4u*)(XN + (size_t)t * 1024 + 16 * lane + 8) = wb;
        }
    }
}

__device__ __forceinline__ void rms_quant_pass(const bf16* X, const float* g, bf16* XN, unsigned char* HQ, float* SH, float* HS, int gw, int NGW, int lane) {
    for (int m = gw; m < T; m += NGW) {
        const u32x2* xr = (const u32x2*)(X + (size_t)m * D) + lane; const f32x4* gr = (const f32x4*)g + lane;
        f32x4 v[4]; float s = 0.f;
#pragma unroll
        for (int j = 0; j < 4; ++j) { const u32x2 w = xr[64 * j]; v[j] = (f32x4){bf_lo(w.x), bf_hi(w.x), bf_lo(w.y), bf_hi(w.y)}; s += (v[j].x * v[j].x + v[j].y * v[j].y) + (v[j].z * v[j].z + v[j].w * v[j].w); }
        const float rstd = rsqrtf(wave_sum(s, lane) * (1.f / 1024.f) + EPS);
        unsigned long long* o8 = (unsigned long long*)(XN + (size_t)m * D) + lane;
        float am = 0.f;
#pragma unroll
        for (int j = 0; j < 4; ++j) { const f32x4 gg = gr[64 * j]; v[j].x = v[j].x * rstd * gg.x; v[j].y = v[j].y * rstd * gg.y; v[j].z = v[j].z * rstd * gg.z; v[j].w = v[j].w * rstd * gg.w;
            o8[64 * j] = (unsigned long long)pk2(v[j].x, v[j].y) | ((unsigned long long)pk2(v[j].z, v[j].w) << 32);
            am = fmaxf(am, fmaxf(fmaxf(fabsf(v[j].x), fabsf(v[j].y)), fmaxf(fabsf(v[j].z), fabsf(v[j].w)))); }
#pragma unroll
        for (int o = 1; o < 64; o <<= 1) am = fmaxf(am, shx(am, lane, o));
        const float hinv = am > 0.f ? 127.f / am : 0.f;
        int hs = 0;
        unsigned* q4 = (unsigned*)(HQ + (size_t)m * D) + lane;
#pragma unroll
        for (int j = 0; j < 4; ++j) { const int q0 = (int)rintf(v[j].x * hinv), q1 = (int)rintf(v[j].y * hinv), q2 = (int)rintf(v[j].z * hinv), q3 = (int)rintf(v[j].w * hinv); hs += (q0 + q1) + (q2 + q3);
            q4[64 * j] = ((unsigned)(q0 & 0xff)) | ((unsigned)(q1 & 0xff) << 8) | ((unsigned)(q2 & 0xff) << 16) | ((unsigned)(q3 & 0xff) << 24); }
#pragma unroll
        for (int o = 1; o < 64; o <<= 1) hs += shxi(hs, lane, o);
        if (lane == 0) { SH[m] = am * (1.f / 127.f); HS[m] = (float)hs; }
    }
}
__device__ __forceinline__ int dpp_add_quad(int d) {
    d += __builtin_amdgcn_update_dpp(0, d, 0xB1, 0xF, 0xF, true);
    d += __builtin_amdgcn_update_dpp(0, d, 0x4E, 0xF, 0xF, true);
    return d;
}
__device__ __forceinline__ int dpp_add_oct(int d) {
    d += __builtin_amdgcn_update_dpp(0, d, 0xB1, 0xF, 0xF, true);
    d += __builtin_amdgcn_update_dpp(0, d, 0x4E, 0xF, 0xF, true);
    d += __builtin_amdgcn_update_dpp(0, d, 0x141, 0xF, 0xF, true);
    return d;
}
#define G1_IDS(E_, H0_, H1_, it_) do { const int t_ = t0 + ((it_) >> 1), hf_ = (it_) & 1; const v4u* ep_ = (const v4u*)(EXPERTS + (size_t)t_ * 128 + 16 * oct + 8 * hf_); const v4u ea_ = ep_[0], eb_ = ep_[1]; \
    E_[0] = (int)ea_.x; E_[1] = (int)ea_.y; E_[2] = (int)ea_.z; E_[3] = (int)ea_.w; E_[4] = (int)eb_.x; E_[5] = (int)eb_.y; E_[6] = (int)eb_.z; E_[7] = (int)eb_.w; \
    H0_ = *(const v4u*)(HQ + (size_t)t_ * 1024 + 256 * s + 32 * q8); H1_ = *(const v4u*)(HQ + (size_t)t_ * 1024 + 256 * s + 32 * q8 + 16); } while (0)
#define G1_ROWS(R_, E_) do { _Pragma("unroll") for (int j_ = 0; j_ < 8; ++j_) R_[j_] = __builtin_amdgcn_raw_buffer_load_b128(rs_U, (E_[j_] << 9) + soff, 0, 0); } while (0)
#define G1_COMP(R_, H0_, H1_, it_) do { int dd_[8]; _Pragma("unroll") for (int j_ = 0; j_ < 8; ++j_) { \
    int d_ = __builtin_amdgcn_sdot4((int)(R_[j_].x & 0x0F0F0F0Fu), (int)H0_.x, 0, false); d_ = __builtin_amdgcn_sdot4((int)((R_[j_].x >> 4) & 0x0F0F0F0Fu), (int)H0_.y, d_, false); \
    d_ = __builtin_amdgcn_sdot4((int)(R_[j_].y & 0x0F0F0F0Fu), (int)H0_.z, d_, false); d_ = __builtin_amdgcn_sdot4((int)((R_[j_].y >> 4) & 0x0F0F0F0Fu), (int)H0_.w, d_, false); \
    d_ = __builtin_amdgcn_sdot4((int)(R_[j_].z & 0x0F0F0F0Fu), (int)H1_.x, d_, false); d_ = __builtin_amdgcn_sdot4((int)((R_[j_].z >> 4) & 0x0F0F0F0Fu), (int)H1_.y, d_, false); \
    d_ = __builtin_amdgcn_sdot4((int)(R_[j_].w & 0x0F0F0F0Fu), (int)H1_.z, d_, false); d_ = __builtin_amdgcn_sdot4((int)((R_[j_].w >> 4) & 0x0F0F0F0Fu), (int)H1_.w, d_, false); \
    dd_[j_] = dpp_add_oct(d_); } \
    if (q8 == 0) { v4u* pp_ = (v4u*)(PART + ((size_t)s * T + t0 + ((it_) >> 1)) * 128 + 16 * oct + 8 * ((it_) & 1)); pp_[0] = (v4u){(unsigned)dd_[0], (unsigned)dd_[1], (unsigned)dd_[2], (unsigned)dd_[3]}; pp_[1] = (v4u){(unsigned)dd_[4], (unsigned)dd_[5], (unsigned)dd_[6], (unsigned)dd_[7]}; } } while (0)
__device__ __forceinline__ void peer_g1_phase(const int wv, int vcu, const unsigned char* HQ, const int* EXPERTS, const unsigned char* U, int* PART) {
    int ln_; asm volatile("v_mbcnt_lo_u32_b32 %0, -1, 0\n\tv_mbcnt_hi_u32_b32 %0, -1, %0" : "=v"(ln_)); const int lane = ln_, oct = lane >> 3, q8 = lane & 7;
    const int s = vcu >> 6;
    const __amdgpu_buffer_rsrc_t rs_U = __builtin_amdgcn_make_buffer_rsrc((void*)U, (short)0, 16384 * 512, 0x00020000);
    const int soff = 128 * s + 16 * q8;
    const int t0 = 512 * (vcu & 63) + 64 * wv;
    int eA[8], eB[8]; v4u rA[8], rB[8], hA0, hA1, hB0, hB1, hC0, hC1;
    G1_IDS(eA, hA0, hA1, 0); G1_ROWS(rA, eA); G1_IDS(eB, hB0, hB1, 1);
#pragma unroll 1
    for (int i = 0; i < 128; i += 2) {
        G1_ROWS(rB, eB); __builtin_amdgcn_sched_barrier(0);
        G1_IDS(eA, hC0, hC1, (i + 2) & 127); __builtin_amdgcn_sched_barrier(0);
        G1_COMP(rA, hA0, hA1, i); __builtin_amdgcn_sched_barrier(0);
        G1_ROWS(rA, eA); hA0 = hC0; hA1 = hC1; __builtin_amdgcn_sched_barrier(0);
        G1_IDS(eB, hC0, hC1, (i + 3) & 127); __builtin_amdgcn_sched_barrier(0);
        G1_COMP(rB, hB0, hB1, i + 1); __builtin_amdgcn_sched_barrier(0);
        hB0 = hC0; hB1 = hC1;
    }
}
__device__ __forceinline__ void peer_g1b_phase(const int* PART, const int* EXPERTS, const float* GATESP, const float* SU, const float* SV, const float* SH, const float* HS, unsigned char* COEFQ, float* SCT, float* CS, int gw, int NGW, int lane) {
    for (int t = gw; t < T; t += NGW) {
        const float sh = SH[t], hoff = 7.5f * HS[t];
        float cf[2]; float am = 0.f;
#pragma unroll
        for (int h2 = 0; h2 < 2; ++h2) {
            const size_t idx = (size_t)t * 128 + 64 * h2 + lane;
            int d = 0;
#pragma unroll
            for (int x = 0; x < 4; ++x) d += PART[(size_t)x * T * 128 + idx];
            const int ev = EXPERTS[idx];
            const float act = ((float)d - hoff) * (sh * SU[ev]);
            cf[h2] = GATESP[idx] * (0.5f * act * (1.f + erff(act * 0.70710678118f))) * SV[ev];
            am = fmaxf(am, fabsf(cf[h2]));
        }
#pragma unroll
        for (int o = 1; o < 64; o <<= 1) am = fmaxf(am, shx(am, lane, o));
        const float inv = am > 0.f ? 127.f / am : 0.f;
        const int q0 = (int)rintf(cf[0] * inv), q1 = (int)rintf(cf[1] * inv);
        COEFQ[(size_t)t * 128 + lane] = (unsigned char)(q0 & 0xff); COEFQ[(size_t)t * 128 + 64 + lane] = (unsigned char)(q1 & 0xff);
        int cs = q0 + q1;
#pragma unroll
        for (int o = 1; o < 64; o <<= 1) cs += shxi(cs, lane, o);
        if (lane == 0) { SCT[t] = am * (1.f / 127.f); CS[t] = (float)cs; }
    }
}
#define G2_IDS(E_, C_, it_) do { const int t_ = t0 + ((it_) >> 1), hf_ = (it_) & 1; const v4u* ep_ = (const v4u*)(EXPERTS + (size_t)t_ * 128 + 16 * oct + 8 * hf_); const v4u ea_ = ep_[0], eb_ = ep_[1]; \
    E_[0] = (int)ea_.x; E_[1] = (int)ea_.y; E_[2] = (int)ea_.z; E_[3] = (int)ea_.w; E_[4] = (int)eb_.x; E_[5] = (int)eb_.y; E_[6] = (int)eb_.z; E_[7] = (int)eb_.w; \
    C_ = *(const u32x2*)(COEFQ + (size_t)t_ * 128 + 16 * oct + 8 * hf_); } while (0)
#define G2_ROWS(R_, E_) do { _Pragma("unroll") for (int j_ = 0; j_ < 8; ++j_) R_[j_] = __builtin_amdgcn_raw_buffer_load_b128(rs_V, (E_[j_] << 9) + soff, 0, 0); } while (0)
#define G2_T4(ob, w0, w1, w2, w3, cq_) do { const unsigned a_ = __builtin_amdgcn_perm(w1, w0, 0x05010400u), b_ = __builtin_amdgcn_perm(w1, w0, 0x07030602u), c_ = __builtin_amdgcn_perm(w3, w2, 0x05010400u), d_ = __builtin_amdgcn_perm(w3, w2, 0x07030602u); \
    const unsigned y0_ = __builtin_amdgcn_perm(c_, a_, 0x05040100u), y1_ = __builtin_amdgcn_perm(c_, a_, 0x07060302u), y2_ = __builtin_amdgcn_perm(d_, b_, 0x05040100u), y3_ = __builtin_amdgcn_perm(d_, b_, 0x07060302u); \
    o[(ob)] = __builtin_amdgcn_sdot4((int)(y0_ & 0x0F0F0F0Fu), cq_, o[(ob)], false); o[(ob) + 4] = __builtin_amdgcn_sdot4((int)((y0_ >> 4) & 0x0F0F0F0Fu), cq_, o[(ob) + 4], false); \
    o[(ob) + 1] = __builtin_amdgcn_sdot4((int)(y1_ & 0x0F0F0F0Fu), cq_, o[(ob) + 1], false); o[(ob) + 5] = __builtin_amdgcn_sdot4((int)((y1_ >> 4) & 0x0F0F0F0Fu), cq_, o[(ob) + 5], false); \
    o[(ob) + 2] = __builtin_amdgcn_sdot4((int)(y2_ & 0x0F0F0F0Fu), cq_, o[(ob) + 2], false); o[(ob) + 6] = __builtin_amdgcn_sdot4((int)((y2_ >> 4) & 0x0F0F0F0Fu), cq_, o[(ob) + 6], false); \
    o[(ob) + 3] = __builtin_amdgcn_sdot4((int)(y3_ & 0x0F0F0F0Fu), cq_, o[(ob) + 3], false); o[(ob) + 7] = __builtin_amdgcn_sdot4((int)((y3_ >> 4) & 0x0F0F0F0Fu), cq_, o[(ob) + 7], false); } while (0)
#define G2_REDI(N, S) do { const bool up_ = (lane & (S)) != 0; _Pragma("unroll") for (int j_ = 0; j_ < (N); ++j_) { const int a_ = o[j_], b_ = o[j_ + (N)]; const int send_ = up_ ? a_ : b_, keep_ = up_ ? b_ : a_; o[j_] = keep_ + shxi(send_, lane, (S)); } } while (0)
#define G2_COMP(R_, C_, it_) do { int o[32]; _Pragma("unroll") for (int k_ = 0; k_ < 32; ++k_) o[k_] = 0; \
    G2_T4(0, R_[0].x, R_[1].x, R_[2].x, R_[3].x, (int)C_.x); G2_T4(8, R_[0].y, R_[1].y, R_[2].y, R_[3].y, (int)C_.x); G2_T4(16, R_[0].z, R_[1].z, R_[2].z, R_[3].z, (int)C_.x); G2_T4(24, R_[0].w, R_[1].w, R_[2].w, R_[3].w, (int)C_.x); \
    G2_T4(0, R_[4].x, R_[5].x, R_[6].x, R_[7].x, (int)C_.y); G2_T4(8, R_[4].y, R_[5].y, R_[6].y, R_[7].y, (int)C_.y); G2_T4(16, R_[4].z, R_[5].z, R_[6].z, R_[7].z, (int)C_.y); G2_T4(24, R_[4].w, R_[5].w, R_[6].w, R_[7].w, (int)C_.y); \
    G2_REDI(16, 8); G2_REDI(8, 16); G2_REDI(4, 32); \
    const int tt_ = t0 + ((it_) >> 1); const float sc_ = SCT[tt_], corr_ = ((it_) & 1) ? 0.f : 7.5f * CS[tt_]; u32x2* xp_ = (u32x2*)(XR + (size_t)tt_ * 1024 + ocol); const u32x2 xw_ = *xp_; \
    f32x4 xv_ = (f32x4){bf_lo(xw_.x), bf_hi(xw_.x), bf_lo(xw_.y), bf_hi(xw_.y)}; \
    xv_.x += sc_ * ((float)o[0] - corr_); xv_.y += sc_ * ((float)o[1] - corr_); xv_.z += sc_ * ((float)o[2] - corr_); xv_.w += sc_ * ((float)o[3] - corr_); \
    if (!NEXT && ((it_) & 1)) { *(f32x4*)(OUT + (size_t)tt_ * 1024 + ocol) = xv_; } else { *xp_ = (u32x2){pk2(xv_.x, xv_.y), pk2(xv_.z, xv_.w)}; } \
    if (NEXT && ((it_) & 1)) { const float y0_ = bf_lo(pk2(xv_.x, 0.f)), y1_ = bf_lo(pk2(xv_.y, 0.f)), y2_ = bf_lo(pk2(xv_.z, 0.f)), y3_ = bf_lo(pk2(xv_.w, 0.f)); \
        const float ss_ = wave_sum((y0_ * y0_ + y1_ * y1_) + (y2_ * y2_ + y3_ * y3_), lane); if (lane == 0) SS[(size_t)s * T + tt_] = ss_; } } while (0)
template <bool NEXT>
__device__ __forceinline__ void peer_g2_phase(const int wv, int vcu, const int* EXPERTS, const unsigned char* COEFQ, const float* SCT, const float* CS, const unsigned char* Vtab, bf16* XR, float* OUT, float* SS) {
    int ln_; asm volatile("v_mbcnt_lo_u32_b32 %0, -1, 0\n\tv_mbcnt_hi_u32_b32 %0, -1, %0" : "=v"(ln_)); const int lane = ln_, oct = lane >> 3, q8 = lane & 7;
    const int s = vcu >> 6;
    const __amdgpu_buffer_rsrc_t rs_V = __builtin_amdgcn_make_buffer_rsrc((void*)Vtab, (short)0, 16384 * 512, 0x00020000);
    const int soff = 128 * s + 16 * q8;
    const int ocol = 256 * s + 32 * q8 + 16 * ((lane >> 3) & 1) + 8 * ((lane >> 4) & 1) + 4 * ((lane >> 5) & 1);
    const int t0 = 512 * (vcu & 63) + 64 * wv;
    int eA[8], eB[8]; u32x2 cA, cB, cC; v4u rA[8], rB[8];
    G2_IDS(eA, cA, 0); G2_ROWS(rA, eA); G2_IDS(eB, cB, 1);
#pragma unroll 1
    for (int i = 0; i < 128; i += 2) {
        G2_ROWS(rB, eB); __builtin_amdgcn_sched_barrier(0);
        G2_IDS(eA, cC, (i + 2) & 127); __builtin_amdgcn_sched_barrier(0);
        G2_COMP(rA, cA, i); __builtin_amdgcn_sched_barrier(0);
        G2_ROWS(rA, eA); cA = cC; __builtin_amdgcn_sched_barrier(0);
        G2_IDS(eB, cC, (i + 3) & 127); __builtin_amdgcn_sched_barrier(0);
        G2_COMP(rB, cB, i + 1); __builtin_amdgcn_sched_barrier(0);
        cB = cC;
    }
}

__device__ __forceinline__ void qknorm_rope_pass(bf16* Q1, bf16* K1, const float* qg, const float* kg, const float* rope, size_t gtid, size_t gthreads) {
    const size_t NROWS = (size_t)2 * 64 * 2 * 4096;
    const int lane = (int)(gtid & 63);
    for (size_t id = gtid; id < NROWS * 8; id += gthreads) {
        const size_t rowg = id >> 3; const int part = (int)(id & 7);
        const bool isk = rowg >= NROWS / 2; const size_t row = isk ? rowg - NROWS / 2 : rowg;
        bf16* ptr = (isk ? K1 : Q1) + row * 64 + part * 8; const float* g = (isk ? kg : qg) + part * 8;
        const int s = (int)(row & 4095); const int bh = (int)(row >> 13); const int bidx = bh >> 3; const size_t mtok = (size_t)bidx * 4096 + s;
        const v4u raw = *(const v4u*)ptr;
        float x[8];
#pragma unroll
        for (int i = 0; i < 4; ++i) { x[2 * i] = bf_lo(raw[i]); x[2 * i + 1] = bf_hi(raw[i]); }
        float ss = 0.f;
#pragma unroll
        for (int i = 0; i < 8; ++i) ss += x[i] * x[i];
        ss += shx(ss, lane, 1); ss += shx(ss, lane, 2); ss += shx(ss, lane, 4);
        const float rstd = rsqrtf(ss * (1.f / 64.f) + EPS);
        float y[8], other[8];
#pragma unroll
        for (int i = 0; i < 8; ++i) y[i] = x[i] * rstd * g[i];
#pragma unroll
        for (int i = 0; i < 8; ++i) other[i] = shx(y[i], lane, 1);
        if (part < 2) { const float* cs = rope + mtok * 16;
#pragma unroll
            for (int i = 0; i < 8; ++i) { const float co = cs[i], si = cs[8 + i]; y[i] = (part == 0) ? (y[i] * co - other[i] * si) : (y[i] * co + other[i] * si); } }
        const float sc = isk ? 1.f : (0.125f * 1.44269504089f);
        v4u o;
#pragma unroll
        for (int i = 0; i < 4; ++i) o[i] = pk2(y[2 * i] * sc, y[2 * i + 1] * sc);
        *(v4u*)ptr = o;
    }
}

#define AT_DMA(kt_, slot_) do { \
    _Pragma("unroll") for (int i_ = 0; i_ < 2; ++i_) { const int row_ = 8 * w + (lane >> 3), ch_ = (lane & 7) ^ ((row_ >> 1) & 7); \
        glds16(K1 + ((size_t)((bh * 2 + i_) * 4096 + (kt_) * 64 + row_)) * 64 + ch_ * 8, (unsigned)__builtin_amdgcn_readfirstlane((int)(ldsb + (slot_) * 32768 + i_ * 8192 + w * 1024))); } \
    _Pragma("unroll") for (int i_ = 0; i_ < 2; ++i_) { const int row_ = 8 * w + 4 * i_ + (lane >> 4), ch_ = (lane & 15) ^ ((row_ & 3) << 2); \
        glds16(V1 + ((size_t)(bh * 4096 + (kt_) * 64 + row_)) * 128 + ch_ * 8, (unsigned)__builtin_amdgcn_readfirstlane((int)(ldsb + (slot_) * 32768 + 16384 + w * 2048 + i_ * 1024))); } } while (0)
typedef short v4i16_t __attribute__((ext_vector_type(4)));
__device__ __forceinline__ bf16x8 vtr8(const LAS bf16* p) {
    const v4i16_t lo = __builtin_amdgcn_ds_read_tr16_b64_v4i16((LAS v4i16_t*)p), hi = __builtin_amdgcn_ds_read_tr16_b64_v4i16((LAS v4i16_t*)(p + 8 * 128));
    return (bf16x8){lo[0], lo[1], lo[2], lo[3], hi[0], hi[1], hi[2], hi[3]};
}
template <bool OFFS>
__device__ __forceinline__ void attn_units(const int wv, LAS unsigned char* lds, int vcu, const bf16* Q1, const bf16* K1, const bf16* V1, bf16* O, const float* subln, float lam, float offs) {
    int ln_; asm volatile("v_mbcnt_lo_u32_b32 %0, -1, 0\n\tv_mbcnt_hi_u32_b32 %0, -1, %0" : "=v"(ln_)); const int tid = wv * 64 + ln_, lane = tid & 63, w = wv, r32 = lane & 31, hi = lane >> 5, qt = w & 3, c = w >> 2;
    LAS float* lbuf = (LAS float*)(lds + 135168 + w * 128);
    LAS float* Obuf = (LAS float*)lds;
    if (wv >= 4) __builtin_amdgcn_s_setprio(1);
    const unsigned ldsb = (unsigned)(uintptr_t)lds;
#pragma unroll 1
    for (int ui = 0; ui < 8; ++ui) {
        const int bh = (vcu >> 5) * 8 + ui, qb = vcu & 31, b = bh >> 3, h = bh & 7;
        bf16x8 bq[4];
#pragma unroll
        for (int ks = 0; ks < 4; ++ks) bq[ks] = *(const bf16x8*)(Q1 + ((size_t)((bh * 2 + c) * 4096 + qb * 128 + qt * 32 + r32)) * 64 + ks * 16 + 8 * hi);
        f32x16 Oa[4];
#pragma unroll
        for (int db = 0; db < 4; ++db)
#pragma unroll
            for (int r = 0; r < 16; ++r) Oa[db][r] = 0.f;
        float lsum = 0.f;
        AT_DMA(0, 0); AT_DMA(1, 1);
        AT_WAIT_BAR();
        const int kx0 = (r32 >> 1) & 7, kx1 = ((32 + r32) >> 1) & 7;
        const int vrow = 4 * hi + ((lane >> 2) & 3), vg = (lane >> 4) & 1, vp = lane & 3;
        f32x16 s0, s1;
        { const LAS unsigned char* Kc = lds + c * 8192;
#pragma unroll
          for (int r = 0; r < 16; ++r) { s0[r] = 0.f; s1[r] = 0.f; }
#pragma unroll
          for (int ks = 0; ks < 4; ++ks) { const bf16x8 a0 = *(const LAS bf16x8*)(Kc + r32 * 128 + (((2 * ks + hi) ^ kx0) << 4)), a1 = *(const LAS bf16x8*)(Kc + (32 + r32) * 128 + (((2 * ks + hi) ^ kx1) << 4));
              s0 = mfma32(a0, bq[ks], s0); s1 = mfma32(a1, bq[ks], s1); } }
        int b0 = 0, b1 = 1, b2 = 2;
#pragma unroll 1
        for (int kt = 0; kt < 64; ++kt) {
            if (kt + 2 < 64) AT_DMA(kt + 2, b2);
            const LAS unsigned char* Kc = lds + b1 * 32768 + c * 8192;
            const LAS unsigned char* Vb = lds + b0 * 32768 + 16384 + vrow * 256 + 8 * (vp & 1);
            f32x16 n0, n1;
#pragma unroll
            for (int r = 0; r < 16; ++r) { n0[r] = 0.f; n1[r] = 0.f; }
            bf16x8 ka[8];
#define AT_KLD(ks_) do { ka[2 * (ks_)] = *(const LAS bf16x8*)(Kc + r32 * 128 + (((2 * (ks_) + hi) ^ kx0) << 4)); ka[2 * (ks_) + 1] = *(const LAS bf16x8*)(Kc + (32 + r32) * 128 + (((2 * (ks_) + hi) ^ kx1) << 4)); } while (0)
            AT_KLD(0); AT_KLD(1);
            __builtin_amdgcn_sched_barrier(0);
#pragma unroll
            for (int ks = 0; ks < 4; ++ks) {
                n0 = mfma32(ka[2 * ks], bq[ks], n0);
#pragma unroll
                for (int r = 0; r < 4; ++r) s0[4 * ks + r] = __builtin_amdgcn_exp2f(OFFS ? s0[4 * ks + r] - offs : s0[4 * ks + r]);
                __builtin_amdgcn_sched_barrier(0);
                n1 = mfma32(ka[2 * ks + 1], bq[ks], n1);
                if (ks < 2) AT_KLD(ks + 2);
#pragma unroll
                for (int r = 0; r < 4; ++r) s1[4 * ks + r] = __builtin_amdgcn_exp2f(OFFS ? s1[4 * ks + r] - offs : s1[4 * ks + r]);
                __builtin_amdgcn_sched_barrier(0);
            }
#undef AT_KLD
            bf16x8 pa[4]; bf16x8 vf[4], vn[4];
#pragma unroll
            for (int db = 0; db < 4; ++db) vf[db] = vtr8((const LAS bf16*)(Vb + (((4 * db + 2 * vg + (vp >> 1)) ^ ((vrow & 3) << 2)) << 4)));
            float ls = 0.f;
            { v4u t0;
#pragma unroll
              for (int k = 0; k < 4; ++k) { t0[k] = pk2(s0[2 * k], s0[2 * k + 1]); ls += s0[2 * k] + s0[2 * k + 1]; }
              pa[0] = __builtin_bit_cast(bf16x8, t0); }
            __builtin_amdgcn_sched_barrier(0);
#pragma unroll
            for (int sp_ = 0; sp_ < 4; ++sp_) {
                if (sp_ < 3) {
#pragma unroll
                    for (int db = 0; db < 4; ++db) vn[db] = vtr8((const LAS bf16*)(Vb + (16 * (sp_ + 1)) * 256 + (((4 * db + 2 * vg + (vp >> 1)) ^ ((vrow & 3) << 2)) << 4)));
                }
#pragma unroll
                for (int db = 0; db < 4; ++db) Oa[db] = mfma32(pa[sp_], vf[db], Oa[db]);
                if (sp_ < 3) { v4u t0;
#pragma unroll
                    for (int k = 0; k < 4; ++k) { const float x0 = (sp_ == 0) ? s0[8 + 2 * k] : (sp_ == 1 ? s1[2 * k] : s1[8 + 2 * k]), x1 = (sp_ == 0) ? s0[9 + 2 * k] : (sp_ == 1 ? s1[2 * k + 1] : s1[9 + 2 * k]); t0[k] = pk2(x0, x1); ls += x0 + x1; }
                    pa[sp_ + 1] = __builtin_bit_cast(bf16x8, t0); }
                __builtin_amdgcn_sched_barrier(0);
                if (sp_ < 3) {
#pragma unroll
                    for (int db = 0; db < 4; ++db) vf[db] = vn[db];
                }
            }
            lsum += ls;
            s0 = n0; s1 = n1;
            { const int tb = b0; b0 = b1; b1 = b2; b2 = tb; }
            AT_WAIT_BAR();
        }
        lsum += shx(lsum, lane, 32);
        lbuf[r32] = lsum;
#pragma unroll
        for (int r = 0; r < 16; ++r) { const int qrow = (r & 3) + 8 * (r >> 2) + 4 * hi; const float inv = 1.f / lbuf[qrow];
#pragma unroll
            for (int db = 0; db < 4; ++db) Obuf[(c * 128 + qt * 32 + qrow) * 132 + 32 * db + r32] = Oa[db][r] * inv; }
        __syncthreads();
        { const int row = tid >> 2, qd = tid & 3;
          float dv[32]; float ss = 0.f;
#pragma unroll
          for (int k = 0; k < 8; ++k) { const f32x4 o0 = *(const LAS f32x4*)(Obuf + row * 132 + qd * 32 + 4 * k), o1 = *(const LAS f32x4*)(Obuf + (128 + row) * 132 + qd * 32 + 4 * k);
#pragma unroll
              for (int e = 0; e < 4; ++e) { const float d = o0[e] - lam * o1[e]; dv[4 * k + e] = d; ss += d * d; } }
          ss += shx(ss, lane, 1); ss += shx(ss, lane, 2);
          const float rstd = rsqrtf(ss * (1.f / 128.f) + EPS) * (1.f - LAMBDA_INIT);
          bf16* op = O + ((size_t)b * 4096 + qb * 128 + row) * 1024 + h * 128 + qd * 32;
#pragma unroll
          for (int k = 0; k < 4; ++k) { v4u o;
#pragma unroll
              for (int e = 0; e < 4; ++e) o[e] = pk2(dv[8 * k + 2 * e] * rstd * subln[qd * 32 + 8 * k + 2 * e], dv[8 * k + 2 * e + 1] * rstd * subln[qd * 32 + 8 * k + 2 * e + 1]);
              *(v4u*)(op + 8 * k) = o; } }
        __syncthreads();
    }
    __builtin_amdgcn_s_setprio(0);
}
__device__ __forceinline__ void attn_phase(const int wv, LAS unsigned char* lds, int vcu, const bf16* Q1, const bf16* K1, const bf16* V1, bf16* O, const float* qg, const float* kg,
                                           const float* lq1, const float* lk1, const float* lq2, const float* lk2, const float* subln) {
    float s1 = 0.f, s2 = 0.f, mq = 0.f, mk = 0.f;
    for (int i = 0; i < 64; ++i) { s1 += lq1[i] * lk1[i]; s2 += lq2[i] * lk2[i]; mq = fmaxf(mq, fabsf(qg[i])); mk = fmaxf(mk, fabsf(kg[i])); }
    const float lam = expf(s1) - expf(s2) + LAMBDA_INIT;
    const float offs = 8.f * mq * mk * 1.44269504089f * 1.02f + 0.25f;
    if (offs < 24.f) attn_units<false>(wv, lds, vcu, Q1, K1, V1, O, subln, lam, 0.f);
    else attn_units<true>(wv, lds, vcu, Q1, K1, V1, O, subln, lam, offs);
}
#undef AT_LOAD
#undef AT_WRITE
struct Args { const void* in[27]; float* out; unsigned char* ws; };
#define KARG(i) ({ GAS const void* p_; asm volatile("s_load_dwordx2 %0, %1, %2\n\ts_waitcnt lgkmcnt(0)" : "=s"(p_) : "s"(__builtin_amdgcn_kernarg_segment_ptr()), "i"(8 * (i))); (const void*)p_; })
#define KIN(i) ((const float*)KARG(i))
#define KOUT() ((float*)KARG(27))
#define KWS() ((unsigned char*)KARG(28))
#define WSP(T_, off) ((T_*)(KWS() + (off)))
__global__ void __launch_bounds__(NWAVES * 64, 2) mk_fwd(Args args) {
    extern __shared__ __attribute__((aligned(16))) unsigned char lds_raw[];
    LAS unsigned char* lds = (LAS unsigned char*)lds_raw;
    const int G = gridDim.x, bx = blockIdx.x;
    const int wv = __builtin_amdgcn_readfirstlane((int)(threadIdx.x >> 6));
    const int vcu = (G % 8 == 0) ? (bx % 8) * (G / 8) + bx / 8 : bx;
#define PH_IDS() int ln_; asm volatile("v_mbcnt_lo_u32_b32 %0, -1, 0\n\tv_mbcnt_hi_u32_b32 %0, -1, %0" : "=v"(ln_)); const int lane = ln_, wave = wv, tid = wv * 64 + ln_; \
    const int gw = vcu * NWAVES + wave, NGW = G * NWAVES; const size_t gtid = (size_t)vcu * (NWAVES * 64) + tid, gthreads = (size_t)G * (NWAVES * 64); (void)lane; (void)gw; (void)NGW; (void)gtid; (void)gthreads
    if (threadIdx.x < 32) ((LAS unsigned*)(lds + MISC_OFF))[threadIdx.x] = 0u;
    __syncthreads();
    (void)xcd_barrier_post((unsigned*)(WSP(gu32, WS_CTL) + CW_BAR), (volatile LAS unsigned*)(lds + MISC_OFF) + 8);
#define STAMP() do {} while (0)
#ifndef PROBE_DUP
#define PROBE_DUP 0
#endif
#define REPS(bit) _Pragma("unroll 1") for (int rep_ = 0; rep_ < 1 + ((PROBE_DUP >> (bit)) & 1); ++rep_)
#define GRID_BAR1() do { XcdBarrier b_; b_.bar = (unsigned*)(WSP(gu32, WS_CTL) + CW_BAR); b_.x = xb_xcc_id(); b_.st = (volatile LAS unsigned*)(lds + MISC_OFF) + 8; xcd_barrier(b_); } while (0)
#define GRID_BAR() do { GRID_BAR1(); if ((PROBE_DUP >> 9) & 1) GRID_BAR1(); } while (0)

    REPS(5) {
        PH_IDS();
        LAS float* scr = (LAS float*)(lds + wave * 16384);
        constexpr int I0 = 16 * 97, I1 = 16 * 32, I2 = 16 * 64, I3 = 16 * 96, I4 = 16 * 32, I5 = 16 * 64, NITEMS = I0 + I1 + I2 + I3 + I4 + I5;
        for (int it = gw; it < NITEMS; it += NGW) {
            int r = it;
            if (r < I0) { p0_transpose_item(KIN(3), 1024, 3104, WSP(bf16, WS_WIN), scr, r, lane); continue; } r -= I0;
            if (r < I1) { p0_transpose_item(KIN(6), 1024, 1024, WSP(bf16, WS_WO0), scr, r, lane); continue; } r -= I1;
            if (r < I2) { p0_transpose_item(KIN(8), 1024, 2048, WSP(bf16, WS_WQ0), scr, r, lane); continue; } r -= I2;
            if (r < I3) { p0_transpose_item(KIN(13), 1024, 3072, WSP(bf16, WS_WQKV), scr, r, lane, KIN(12)); continue; } r -= I3;
            if (r < I4) { p0_transpose_item(KIN(21), 1024, 1024, WSP(bf16, WS_WO1), scr, r, lane); continue; } r -= I4;
            p0_transpose_item(KIN(23), 1024, 2048, WSP(bf16, WS_WQ1), scr, r, lane);
        }
        { bf16* WIN = WSP(bf16, WS_WIN); for (size_t i = gtid * 8; i < (size_t)224 * 1024; i += gthreads * 8) *(v4u*)(WIN + (size_t)3104 * 1024 + i) = (v4u){0u, 0u, 0u, 0u}; }
        cvt_range(KIN(9), WSP(bf16, WS_KEY0), (size_t)262144, gtid, gthreads);
        cvt_range(KIN(24), WSP(bf16, WS_KEY1), (size_t)262144, gtid, gthreads);
        rms_pass(KIN(0), KIN(2), WSP(bf16, WS_B0), gw, NGW, lane);
        { const int* positions = (const int*)KARG(1); float* ROPE = WSP(float, WS_ROPE);
          for (size_t id = gtid; id < (size_t)T * 8; id += gthreads) { const size_t mtok = id >> 3; const int i = (int)(id & 7);
            const float inv = powf(500000.0f, -(float)i * 2.0f / 16.0f); const float ang = (float)positions[mtok] * inv;
            float sn, cs; sincosf(ang, &sn, &cs); ROPE[mtok * 16 + i] = cs; ROPE[mtok * 16 + 8 + i] = sn; } }
    }
    GRID_BAR();
    REPS(3) {
        unsigned char* ws = KWS();
        pg8::Gemm g{(const bf16*)(ws + WS_B0), (const bf16*)(ws + WS_WIN), T, 3328, 1024}; pg8::StaticOrder S; S.init(T, 3328, G, bx);
        pg8::EpiInProj E{(bf16*)(ws + WS_R1), (bf16*)(ws + WS_R1 + 32 * MiB), (bf16*)(ws + WS_R2), (bf16*)(ws + WS_R3), (float*)(ws + WS_GATES), KIN(4)};
        pg8::gemm_phase<pg8::EpiInProj, pg8::StaticOrder, true, true>(lds, g, S, E, wv);
    }
    GRID_BAR();
    if ((bx >> 3) & 1) { PH_IDS(); const int gwi = ((bx >> 4) * 8 + (bx & 7)) * NWAVES + wave, NGWI = 128 * NWAVES; (void)gw; (void)NGW;
        quant4_rows(KIN(10), WSP(unsigned char, WS_U0), WSP(float, WS_SC), 16384, gwi, NGWI, lane);
        quant4_rows(KIN(11), WSP(unsigned char, WS_V0T), WSP(float, WS_SC + 65536), 16384, gwi, NGWI, lane);
        quant4_rows(KIN(25), WSP(unsigned char, WS_U1), WSP(float, WS_SC + 2 * 65536), 16384, gwi, NGWI, lane);
        quant4_rows(KIN(26), WSP(unsigned char, WS_V1T), WSP(float, WS_SC + 3 * 65536), 16384, gwi, NGWI, lane); }
    REPS(2) { unsigned char* ws = KWS(); mlstm_phase(wv, lds, (const bf16*)(ws + WS_R1), (const bf16*)(ws + WS_R1 + 32 * MiB), (const bf16*)(ws + WS_R2), (const float*)(ws + WS_GATES), (bf16*)(ws + WS_R4), (bf16*)(ws + WS_R5)); }
    GRID_BAR();
    REPS(6) { PH_IDS(); unsigned char* ws = KWS(); hs_pass((const bf16*)(ws + WS_R4), (const bf16*)(ws + WS_R5), (const bf16*)(ws + WS_R3), KIN(5), (bf16*)(ws + WS_B0), gw, NGW, lane); }
    GRID_BAR();
#pragma unroll 1
    for (int L = 0; L < 2; ++L) {
        if (L == 1) {
            REPS(3) {
                unsigned char* ws = KWS();
                pg8::Gemm g{(const bf16*)(ws + WS_R1), (const bf16*)(ws + WS_WQKV), T, 3072, 1024}; pg8::StaticOrder S; S.init(T, 3072, G, bx);
                pg8::EpiQKV E{(bf16*)(ws + WS_R2), (bf16*)(ws + WS_R3), (bf16*)(ws + WS_R4), (const float*)(ws + 3 * MiB), KIN(14), KIN(15), (const float*)(ws + WS_ROPE), (LAS float*)(lds + 131072)};
                pg8::gemm_phase<pg8::EpiQKV, pg8::StaticOrder, true, true>(lds, g, S, E, wv);
            }
            GRID_BAR();
            REPS(0) { unsigned char* ws = KWS(); attn_phase(wv, lds, vcu, (const bf16*)(ws + WS_R2), (const bf16*)(ws + WS_R3), (const bf16*)(ws + WS_R4), (bf16*)(ws + WS_B0), KIN(14), KIN(15), KIN(16), KIN(17), KIN(18), KIN(19), KIN(20)); }
            GRID_BAR();
        }
        _Pragma("unroll 1") for (int rep_ = 0; rep_ < 1 + ((L == 0) ? ((PROBE_DUP >> 3) & 1) : 0); ++rep_) {
            unsigned char* ws = KWS();
            pg8::Gemm g{(const bf16*)(ws + WS_B0), (const bf16*)(ws + (L ? WS_WO1 : WS_WO0)), T, 1024, 1024}; pg8::StaticOrder S; S.init(T, 1024, G, bx);
            if (L == 0) { pg8::EpiRes<false> E{KIN(0), (bf16*)(ws + WS_R1)}; pg8::gemm_phase<pg8::EpiRes<false>, pg8::StaticOrder, true, true>(lds, g, S, E, wv); }
            else { pg8::EpiRes<true> E{ws + WS_R1, (bf16*)(ws + WS_R1)}; pg8::gemm_phase<pg8::EpiRes<true>, pg8::StaticOrder, true, true>(lds, g, S, E, wv); }
        }
        GRID_BAR();
        REPS(7) { PH_IDS(); unsigned char* ws = KWS(); rms_quant_pass((const bf16*)(ws + WS_R1), L ? KIN(22) : KIN(7), (bf16*)(ws + WS_B0), ws + WS_R5, (float*)(ws + WS_SC + 4 * 65536), (float*)(ws + WS_SC + 6 * 65536), gw, NGW, lane); }
        GRID_BAR();
        REPS(3) {
            unsigned char* ws = KWS();
            pg8::Gemm g{(const bf16*)(ws + WS_B0), (const bf16*)(ws + (L ? WS_WQ1 : WS_WQ0)), T, 2048, 1024}; pg8::StaticOrder S; S.init(T, 2048, G, bx);
            pg8::EpiPlain E{(bf16*)(ws + WS_R2), 2048};
            pg8::gemm_phase<pg8::EpiPlain, pg8::StaticOrder, true, true>(lds, g, S, E, wv);
        }
        GRID_BAR();
        REPS(4) { unsigned char* ws = KWS(); peer_topk_phase(wv, lds, vcu, (const bf16*)(ws + WS_R2), (const bf16*)(ws + (L ? WS_KEY1 : WS_KEY0)), (int*)(ws + WS_R4), (float*)(ws + WS_R4 + 16 * MiB)); }
        GRID_BAR();
        REPS(1) { unsigned char* ws = KWS(); peer_g1_phase(wv, vcu, ws + WS_R5, (const int*)(ws + WS_R4), ws + (L ? WS_U1 : WS_U0), (int*)(ws + WS_R2)); }
        GRID_BAR();
        { PH_IDS(); unsigned char* ws = KWS(); const size_t so = L ? 2 * 65536 : 0;
          peer_g1b_phase((const int*)(ws + WS_R2), (const int*)(ws + WS_R4), (const float*)(ws + WS_R4 + 16 * MiB), (const float*)(ws + WS_SC + so), (const float*)(ws + WS_SC + so + 65536),
                         (const float*)(ws + WS_SC + 4 * 65536), (const float*)(ws + WS_SC + 6 * 65536), ws + WS_R4 + 32 * MiB, (float*)(ws + WS_SC + 10 * 65536), (float*)(ws + WS_SC + 8 * 65536), gw, NGW, lane); }
        GRID_BAR();
        if (L == 0) { unsigned char* ws = KWS(); peer_g2_phase<true>(wv, vcu, (const int*)(ws + WS_R4), ws + WS_R4 + 32 * MiB, (const float*)(ws + WS_SC + 10 * 65536), (const float*)(ws + WS_SC + 8 * 65536), ws + WS_V0T, (bf16*)(ws + WS_R1), nullptr, (float*)(ws + 3 * MiB)); GRID_BAR(); }
        else { unsigned char* ws = KWS(); peer_g2_phase<false>(wv, vcu, (const int*)(ws + WS_R4), ws + WS_R4 + 32 * MiB, (const float*)(ws + WS_SC + 10 * 65536), (const float*)(ws + WS_SC + 8 * 65536), ws + WS_V1T, (bf16*)(ws + WS_R1), KOUT(), nullptr); }
    }
#undef GRID_BAR
}

extern "C" void kernel_launch(void* const* d_in, const int* in_sizes, int n_in, void* d_out, int out_size, void* d_ws, size_t ws_size, hipStream_t stream) {
    static int ready = 0;
    if (ready == 0) {
        if (n_in != 27 || out_size != T * D || ws_size < WS_END) { fprintf(stderr, "kernel_launch: unexpected problem (n_in %d, out %d, ws %zu)\n", n_in, out_size, ws_size); ready = -1; return; }
        if (hipFuncSetAttribute((const void*)mk_fwd, hipFuncAttributeMaxDynamicSharedMemorySize, LDS_BYTES) != hipSuccess) { fprintf(stderr, "kernel_launch: hipFuncSetAttribute failed\n"); ready = -1; return; }
        (void)hipGetLastError();
        ready = 1;
    }
    if (ready < 0) return;
    if (hipMemsetAsync((char*)d_ws + WS_CTL, 0, CTL_ZERO_BYTES, stream) != hipSuccess) { fprintf(stderr, "kernel_launch: memset failed\n"); return; }
    Args a{};
    for (int i = 0; i < 27; ++i) a.in[i] = d_in[i];
    a.out = (float*)d_out; a.ws = (unsigned char*)d_ws;
    hipLaunchKernelGGL(mk_fwd, dim3(256), dim3(NWAVES * 64), LDS_BYTES, stream, a);
}
```

```cpp
#include <hip/hip_runtime.h>
#include <hip/hip_bf16.h>
#include <cstdio>
#include <cstdint>
#include <cmath>
namespace pg8 {
#define PG8_LAS __attribute__((address_space(3)))
typedef unsigned short bf16_t;
typedef short bf16x8 __attribute__((ext_vector_type(8)));
typedef float f32x4 __attribute__((ext_vector_type(4)));
typedef unsigned u32x4 __attribute__((ext_vector_type(4)));
constexpr int BM = 256, BK = 64, HALF = 128, HTB = HALF * BK * 2  , STAGE_BYTES = 8 * HTB, NXCD = 8, WGM = 8;

__host__ __device__ __forceinline__ int lds_byte(int r, int c) { const int st = (r >> 4) * 2 + (c >> 5), rr = r & 15, cc = c & 31, ob = rr * 64 + cc * 2; return st * 1024 + (ob ^ (((ob >> 9) & 1) << 5)); }
__host__ __device__ __forceinline__ void stage_rc(int b, int& R, int& C) { const int st = b / 1024, sb = b % 1024, swz = sb ^ (((sb >> 9) & 1) << 5); R = (st >> 1) * 16 + swz / 64; C = (st & 1) * 32 + (swz % 64) / 2; }
__host__ __device__ __forceinline__ int perm32(int rho) { const int n = rho >> 4, i = rho & 15; return 8 * (i >> 2) + 4 * n + (i & 3); }

struct Unit { int pm, pn; };
struct Gemm { const bf16_t* A; const bf16_t* Bt; int M, N, K; };

struct StaticOrder {
    int nM, nN, nwg, G, c;
    __host__ __device__ void init(int M, int N, int G_, int c_) { nM = M / BM; nN = N / BM; nwg = nM * nN; G = G_; c = c_; }
    __host__ __device__ bool next(int i, Unit& u) const {
        const long L = (long)i * G + c; if (L >= nwg) return false;
        int wgid = (int)L; { const int q = nwg / NXCD, r = nwg % NXCD, xcd = wgid % NXCD, off = wgid / NXCD; wgid = (xcd < r ? xcd * (q + 1) : r * (q + 1) + (xcd - r) * q) + off; }
        const int nig = WGM * nN, gid = wgid / nig, fm = gid * WGM, gsz = (nM - fm) < WGM ? (nM - fm) : WGM;
        u.pm = fm + ((wgid % nig) % gsz); u.pn = (wgid % nig) / gsz; return true;
    }
    __device__ __forceinline__ void a_ready(const Unit&) const {}
    __device__ __forceinline__ void done(const Unit&) const {}
};
__device__ __forceinline__ unsigned cvt_pk_bf16(float lo, float hi) { unsigned r; asm volatile("v_cvt_pk_bf16_f32 %0, %1, %2" : "=v"(r) : "v"(lo), "v"(hi)); return r; }
typedef float f32x2 __attribute__((ext_vector_type(2)));
typedef unsigned u32x2 __attribute__((ext_vector_type(2)));
typedef int i32x4 __attribute__((ext_vector_type(4)));
__device__ __forceinline__ u32x4 pack8(const f32x4 v0, const f32x4 v1) { u32x4 w; w.x = cvt_pk_bf16(v0[0], v0[1]); w.y = cvt_pk_bf16(v0[2], v0[3]); w.z = cvt_pk_bf16(v1[0], v1[1]); w.w = cvt_pk_bf16(v1[2], v1[3]); return w; }
struct EpiPlain {
    static constexpr bool PERM = true, AFTER_DRAIN = false, I8 = false;
    bf16_t* O; int ldc;
    __device__ __forceinline__ void operator()(const f32x4 (&acc)[2][2][4][2], const Unit& u, int wr, int wc, int fr, int fq) const {
        const int row0 = u.pm * BM + wr * 64 + fr, col0 = u.pn * BM + wc * 32 + 8 * fq;
#pragma unroll
        for (int ai = 0; ai < 2; ++ai)
#pragma unroll
            for (int m = 0; m < 4; ++m) { bf16_t* rowp = O + (size_t)(row0 + ai * HALF + m * 16) * ldc + col0;
#pragma unroll
                for (int bj = 0; bj < 2; ++bj) *(u32x4*)(rowp + bj * HALF) = pack8(acc[ai][bj][m][0], acc[ai][bj][m][1]); }
    }
};
struct EpiPlainI8 {
    static constexpr bool PERM = true, AFTER_DRAIN = false, I8 = true;
    bf16_t* O; int ldc; const float* rs; const float* cs;
    __device__ __forceinline__ void operator()(const f32x4 (&acc)[2][2][4][2], const Unit& u, int wr, int wc, int fr, int fq) const {
        const int row0 = u.pm * BM + wr * 64 + fr, col0 = u.pn * BM + wc * 32 + 8 * fq;
        f32x4 c0[2], c1[2];
#pragma unroll
        for (int bj = 0; bj < 2; ++bj) { c0[bj] = *(const f32x4*)(cs + col0 + bj * HALF); c1[bj] = *(const f32x4*)(cs + col0 + bj * HALF + 4); }
#pragma unroll
        for (int ai = 0; ai < 2; ++ai)
#pragma unroll
            for (int m = 0; m < 4; ++m) { const int row = row0 + ai * HALF + m * 16; const float r = rs[row]; bf16_t* rowp = O + (size_t)row * ldc + col0;
#pragma unroll
                for (int bj = 0; bj < 2; ++bj) { const i32x4 a0 = __builtin_bit_cast(i32x4, acc[ai][bj][m][0]), a1 = __builtin_bit_cast(i32x4, acc[ai][bj][m][1]);
                    const f32x4 v0 = (f32x4){(float)a0[0], (float)a0[1], (float)a0[2], (float)a0[3]} * r * c0[bj], v1 = (f32x4){(float)a1[0], (float)a1[1], (float)a1[2], (float)a1[3]} * r * c1[bj];
                    *(u32x4*)(rowp + bj * HALF) = pack8(v0, v1); } }
    }
};
template <bool BASE_BF16> struct EpiRes {
    static constexpr bool PERM = true, AFTER_DRAIN = false, I8 = false;
    const void* base; bf16_t* out;
    __device__ __forceinline__ void operator()(const f32x4 (&acc)[2][2][4][2], const Unit& u, int wr, int wc, int fr, int fq) const {
        const int col0 = u.pn * BM + wc * 32 + 8 * fq;
#pragma unroll
        for (int ai = 0; ai < 2; ++ai)
#pragma unroll
            for (int m = 0; m < 4; ++m) { const size_t off = (size_t)(u.pm * BM + ai * HALF + wr * 64 + m * 16 + fr) * 1024 + col0;
#pragma unroll
                for (int bj = 0; bj < 2; ++bj) { f32x4 b0, b1;
                    if (BASE_BF16) { const u32x4 w = *(const u32x4*)((const bf16_t*)base + off + bj * HALF);
                        b0 = (f32x4){__uint_as_float(w.x << 16), __uint_as_float(w.x & 0xffff0000u), __uint_as_float(w.y << 16), __uint_as_float(w.y & 0xffff0000u)};
                        b1 = (f32x4){__uint_as_float(w.z << 16), __uint_as_float(w.z & 0xffff0000u), __uint_as_float(w.w << 16), __uint_as_float(w.w & 0xffff0000u)}; }
                    else { b0 = *(const f32x4*)((const float*)base + off + bj * HALF); b1 = *(const f32x4*)((const float*)base + off + bj * HALF + 4); }
                    *(u32x4*)(out + off + bj * HALF) = pack8(b0 + acc[ai][bj][m][0], b1 + acc[ai][bj][m][1]); } }
    }
};
struct EpiInProj {
    static constexpr bool PERM = true, AFTER_DRAIN = false, I8 = false;
    bf16_t *Q, *Kk, *V, *OG; float* gates; const float* bg;
    __device__ __forceinline__ void operator()(const f32x4 (&acc)[2][2][4][2], const Unit& u, int wr, int wc, int fr, int fq) const {
        const int colt = u.pn * BM;
#pragma unroll
        for (int ai = 0; ai < 2; ++ai)
#pragma unroll
            for (int m = 0; m < 4; ++m) { const int row = u.pm * BM + ai * HALF + wr * 64 + m * 16 + fr, b = row >> 12, s = row & 4095;
#pragma unroll
                for (int bj = 0; bj < 2; ++bj) { const int cb = colt + bj * HALF + wc * 32 + 8 * fq; f32x4 v0 = acc[ai][bj][m][0], v1 = acc[ai][bj][m][1];
                    if (colt < 1024) { const bool isq = colt < 512; bf16_t* base = isq ? Q : Kk; const int c2 = cb & 511, head = c2 >> 6, d = c2 & 63;
                        if (isq) { v0 = v0 * 0.125f; v1 = v1 * 0.125f; }
                        *(u32x4*)(base + ((size_t)((b * 8 + head) * 4096 + s)) * 64 + d) = pack8(v0, v1); }
                    else if (colt < 2048) { const int c2 = cb - 1024, head = c2 >> 7, dv = c2 & 127; *(u32x4*)(V + ((size_t)((b * 8 + head) * 4096 + s)) * 128 + dv) = pack8(v0, v1); }
                    else if (colt < 3072) { *(u32x4*)(OG + (size_t)row * 1024 + (cb - 2048)) = pack8(v0, v1); }
                    else if (cb < 3104) { const int gi = cb - 3072; float* g = gates + (size_t)row * 32 + gi;
                        *(f32x4*)g = v0 + *(const f32x4*)(bg + gi); *(f32x4*)(g + 4) = v1 + *(const f32x4*)(bg + gi + 4); } } }
    }
};
struct EpiQKV {
    static constexpr bool PERM = true, AFTER_DRAIN = false, I8 = false;
    bf16_t *Q, *Kk, *V; const float* SS; const float* qg; const float* kg; const float* rope; PG8_LAS float* xch;
    __device__ __forceinline__ void operator()(const f32x4 (&acc)[2][2][4][2], const Unit& u, int wr, int wc, int fr_, int fq_) const {
        int fr = fr_, fq = fq_; asm volatile("" : "+v"(fr), "+v"(fq));
        const int colt = u.pn * BM, lane = fq * 16 + fr, wave = wr * 4 + wc;
        float rsr[2][4];
#pragma unroll
        for (int ai = 0; ai < 2; ++ai)
#pragma unroll
            for (int m = 0; m < 4; ++m) { const int row = u.pm * BM + ai * HALF + wr * 64 + m * 16 + fr;
                rsr[ai][m] = __builtin_amdgcn_rsqf(((SS[row] + SS[32768 + row]) + (SS[2 * 32768 + row] + SS[3 * 32768 + row])) * (1.f / 1024.f) + 1e-6f); }
        if (colt >= 2048) {
#pragma unroll
            for (int ai = 0; ai < 2; ++ai)
#pragma unroll
                for (int m = 0; m < 4; ++m) { const int row = u.pm * BM + ai * HALF + wr * 64 + m * 16 + fr, b = row >> 12, s = row & 4095; const float rs = rsr[ai][m];
#pragma unroll
                    for (int bj = 0; bj < 2; ++bj) { const int cb = colt + bj * HALF + wc * 32 + 8 * fq; const int c2 = cb - 2048, head = c2 >> 7, dv = c2 & 127;
                        *(u32x4*)(V + ((size_t)((b * 8 + head) * 4096 + s)) * 128 + dv) = pack8(acc[ai][bj][m][0] * rs, acc[ai][bj][m][1] * rs); } }
            return;
        }
#pragma unroll
        for (int ai = 0; ai < 2; ++ai)
#pragma unroll
            for (int m = 0; m < 4; ++m)
#pragma unroll
                for (int bj = 0; bj < 2; ++bj) { const f32x4 a = acc[ai][bj][m][0] * rsr[ai][m], c = acc[ai][bj][m][1] * rsr[ai][m];
                    float ss = ((a[0] * a[0] + a[1] * a[1]) + (a[2] * a[2] + a[3] * a[3])) + ((c[0] * c[0] + c[1] * c[1]) + (c[2] * c[2] + c[3] * c[3]));
                    ss += __uint_as_float((unsigned)__builtin_amdgcn_ds_bpermute((lane ^ 16) << 2, (int)__float_as_uint(ss)));
                    ss += __uint_as_float((unsigned)__builtin_amdgcn_ds_bpermute((lane ^ 32) << 2, (int)__float_as_uint(ss)));
                    if (fq == 0) xch[(((wave * 2 + ai) * 4 + m) * 2 + bj) * 16 + fr] = ss; }
        __syncthreads();
        const bool isq = colt < 1024; bf16_t* base = isq ? Q : Kk; const float* gn = isq ? qg : kg; const float osc = isq ? (0.125f * 1.44269504089f) : 1.f;
        const int d0 = 32 * (wc & 1) + 8 * fq;
        const f32x4 g0 = *(const f32x4*)(gn + d0), g1 = *(const f32x4*)(gn + d0 + 4);
        const bool rot = ((wc & 1) == 0) && (fq < 2);
#pragma unroll
        for (int ai = 0; ai < 2; ++ai)
#pragma unroll
            for (int m = 0; m < 4; ++m) { const int row = u.pm * BM + ai * HALF + wr * 64 + m * 16 + fr, b = row >> 12, s = row & 4095;
                f32x4 co0 = {0.f, 0.f, 0.f, 0.f}, co1 = co0, si0 = co0, si1 = co0;
                if (rot) { const float* cs = rope + (size_t)row * 16; co0 = *(const f32x4*)cs; co1 = *(const f32x4*)(cs + 4); si0 = *(const f32x4*)(cs + 8); si1 = *(const f32x4*)(cs + 12); }
#pragma unroll
                for (int bj = 0; bj < 2; ++bj) { const float tot = xch[(((wave * 2 + ai) * 4 + m) * 2 + bj) * 16 + fr] + xch[((((wave ^ 1) * 2 + ai) * 4 + m) * 2 + bj) * 16 + fr];
                    const float rn = __builtin_amdgcn_rsqf(tot * (1.f / 64.f) + 1e-6f) * rsr[ai][m];
                    f32x4 y0 = acc[ai][bj][m][0] * rn * g0, y1 = acc[ai][bj][m][1] * rn * g1;
                    f32x4 p0, p1;
#pragma unroll
                    for (int i = 0; i < 4; ++i) { p0[i] = __uint_as_float((unsigned)__builtin_amdgcn_ds_bpermute((lane ^ 16) << 2, (int)__float_as_uint(y0[i]))); p1[i] = __uint_as_float((unsigned)__builtin_amdgcn_ds_bpermute((lane ^ 16) << 2, (int)__float_as_uint(y1[i]))); }
                    if (rot) { const float sg = (fq == 0) ? -1.f : 1.f; y0 = y0 * co0 + p0 * si0 * sg; y1 = y1 * co1 + p1 * si1 * sg; }
                    const int cb = colt + bj * HALF + wc * 32 + 8 * fq; const int c2 = cb & 1023, head = c2 >> 7, c = (c2 >> 6) & 1, d = c2 & 63;
                    *(u32x4*)(base + ((size_t)(((b * 8 + head) * 2 + c) * 4096 + s)) * 64 + d) = pack8(y0 * osc, y1 * osc); } }
    }
};

template <bool I8> __device__ __forceinline__ f32x4 mma_sel(bf16x8 a, bf16x8 b, f32x4 c) {
    if constexpr (I8) return __builtin_bit_cast(f32x4, __builtin_amdgcn_mfma_i32_16x16x64_i8(__builtin_bit_cast(i32x4, a), __builtin_bit_cast(i32x4, b), __builtin_bit_cast(i32x4, c), 0, 0, 0));
    else return __builtin_amdgcn_mfma_f32_16x16x32_bf16(a, b, c, 0, 0, 0);
}
template <class Epi, class Sched, bool ALIGN_EPI = false, bool SP2 = false>
__device__ __forceinline__ void gemm_phase(PG8_LAS unsigned char* lds, const Gemm g, const Sched& S, const Epi& E, const int wv) {
    int ln_; asm volatile("v_mbcnt_lo_u32_b32 %0, -1, 0\n\tv_mbcnt_hi_u32_b32 %0, -1, %0" : "=v"(ln_)); const int tid = wv * 64 + ln_, wid = wv, lane = tid & 63, wr = wid >> 2, wc = wid & 3, fr = lane & 15, fq = lane >> 4;
    const int K = g.K, nt = K / BK;
    unsigned voffA[2], voffB[2];
#pragma unroll
    for (int i = 0; i < 2; ++i) { int R, C; stage_rc(tid * 16 + i * 8192, R, C); const int Rb = Epi::PERM ? ((R & ~31) + perm32(R & 31)) : R;
        voffA[i] = (unsigned)(R * K + C) * 2u; voffB[i] = (unsigned)(Rb * K + C) * 2u; }
    const size_t kstep = (size_t)(BK * 2);
    const size_t hstep = (size_t)HALF * K * 2;
    const size_t tstep = 2 * hstep;
    const unsigned ldsw = (unsigned)wid * 1024u;
    const int aoff = lds_byte(wr * 64 + fr, fq * 8), boff = lds_byte(wc * 32 + fr, fq * 8);
#define PG8_SA(b, h) (((b) * 2 + (h)) * HTB)
#define PG8_SB(b, h) ((4 + (b) * 2 + (h)) * HTB)
#define PG8_STAGE(bufoff, gbase, voff) do { _Pragma("unroll") for (int _i = 0; _i < 2; ++_i) \
        __builtin_amdgcn_global_load_lds((const unsigned*)((const char*)(gbase) + (voff)[_i]), (PG8_LAS unsigned*)(lds + (bufoff) + ldsw + _i * 8192), 16, 0, 0); } while (0)
#define PG8_LDA(dst, b, h) do { _Pragma("unroll") for (int m = 0; m < 4; ++m) _Pragma("unroll") for (int k = 0; k < 2; ++k) dst[m][k] = *(const PG8_LAS bf16x8*)(lds + PG8_SA(b, h) + aoff + m * 2048 + k * 1024); } while (0)
#define PG8_LDB(dst, b, h) do { _Pragma("unroll") for (int n = 0; n < 2; ++n) _Pragma("unroll") for (int k = 0; k < 2; ++k) dst[n][k] = *(const PG8_LAS bf16x8*)(lds + PG8_SB(b, h) + boff + n * 2048 + k * 1024); } while (0)
#define PG8_MMA(ai, bj, At, Bt) do { __builtin_amdgcn_s_setprio(1); _Pragma("unroll") for (int m = 0; m < 4; ++m) _Pragma("unroll") for (int n = 0; n < 2; ++n) _Pragma("unroll") for (int k = 0; k < 2; ++k) \
        acc[ai][bj][m][n] = mma_sel<Epi::I8>(Bt[n][k], At[m][k], acc[ai][bj][m][n]); __builtin_amdgcn_s_setprio(0); } while (0)
#define PG8_WAIT_V(n) asm volatile("s_waitcnt vmcnt(" #n ")" ::: "memory")
#define PG8_WAIT_L(n) asm volatile("s_waitcnt lgkmcnt(" #n ")" ::: "memory")
#define PG8_BAR __builtin_amdgcn_s_barrier()
#define PG8_SCHED __builtin_amdgcn_sched_barrier(0)
    Unit cur, nxt; int ui = 0;
    if (!S.next(0, cur)) return;
    f32x4 acc[2][2][4][2];
#pragma unroll
    for (int a = 0; a < 2; ++a)
#pragma unroll
        for (int b = 0; b < 2; ++b)
#pragma unroll
            for (int m = 0; m < 4; ++m)
#pragma unroll
                for (int n = 0; n < 2; ++n) acc[a][b][m][n] = (f32x4){0.f, 0.f, 0.f, 0.f};
    bf16x8 At[4][2], B0[2][2], B1[2][2];
    const char* cA = (const char*)g.A + (size_t)cur.pm * tstep; const char* cB = (const char*)g.Bt + (size_t)cur.pn * tstep;
    S.a_ready(cur);
    if constexpr (SP2) {
        PG8_STAGE(PG8_SB(0, 0), cB, voffB); PG8_STAGE(PG8_SB(0, 1), cB + hstep, voffB); PG8_STAGE(PG8_SA(0, 0), cA, voffA); PG8_STAGE(PG8_SA(0, 1), cA + hstep, voffA);
        if (wr == 1) PG8_BAR;
        PG8_WAIT_V(2); PG8_BAR;
        PG8_STAGE(PG8_SB(1, 0), cB + kstep, voffB); PG8_STAGE(PG8_SA(1, 0), cA + kstep, voffA); PG8_STAGE(PG8_SB(1, 1), cB + hstep + kstep, voffB);
        PG8_WAIT_V(6); PG8_BAR;
    } else {
        PG8_STAGE(PG8_SB(0, 0), cB, voffB); PG8_STAGE(PG8_SA(0, 0), cA, voffA); PG8_STAGE(PG8_SB(0, 1), cB + hstep, voffB); PG8_STAGE(PG8_SA(0, 1), cA + hstep, voffA);
        if (wr == 1) PG8_BAR;
        PG8_WAIT_V(4); PG8_BAR;
        PG8_STAGE(PG8_SB(1, 0), cB + kstep, voffB); PG8_STAGE(PG8_SA(1, 0), cA + kstep, voffA); PG8_STAGE(PG8_SB(1, 1), cB + hstep + kstep, voffB);
        PG8_WAIT_V(6); PG8_BAR;
    }
    for (;;) {
        const bool has_next = S.next(ui + 1, nxt);
        const char* nA = has_next ? (const char*)g.A + (size_t)nxt.pm * tstep : cA; const char* nB = has_next ? (const char*)g.Bt + (size_t)nxt.pn * tstep : cB;
        for (int t = 0; t < nt; t += 2) {
            const bool last = (t == nt - 2);
            const char* a1 = cA + (size_t)(t + 1) * kstep;
            const char* a2 = last ? nA : cA + (size_t)(t + 2) * kstep; const char* b2 = last ? nB : cB + (size_t)(t + 2) * kstep;
            const char* a3 = a2 + kstep; const char* b3 = b2 + kstep;
            if (last && has_next) S.a_ready(nxt);
            if constexpr (SP2) {
            PG8_LDB(B0, 0, 0); PG8_LDB(B1, 0, 1); PG8_SCHED; PG8_LDA(At, 0, 0); PG8_STAGE(PG8_SA(1, 1), a1 + hstep, voffA);
            PG8_WAIT_V(8); PG8_WAIT_L(0); PG8_BAR; PG8_MMA(0, 0, At, B0); PG8_MMA(0, 1, At, B1); PG8_BAR; PG8_SCHED;
            PG8_LDA(At, 0, 1); PG8_STAGE(PG8_SB(0, 0), b2, voffB); PG8_STAGE(PG8_SB(0, 1), b2 + hstep, voffB); PG8_STAGE(PG8_SA(0, 0), a2, voffA);
            PG8_WAIT_V(8); PG8_WAIT_L(0); PG8_BAR; PG8_MMA(1, 0, At, B0); PG8_MMA(1, 1, At, B1); PG8_BAR; PG8_SCHED;
            PG8_LDB(B0, 1, 0); PG8_LDB(B1, 1, 1); PG8_SCHED; PG8_LDA(At, 1, 0); PG8_STAGE(PG8_SA(0, 1), a2 + hstep, voffA);
            PG8_WAIT_V(8); PG8_WAIT_L(0); PG8_BAR; PG8_MMA(0, 0, At, B0); PG8_MMA(0, 1, At, B1); PG8_BAR; PG8_SCHED;
            PG8_LDA(At, 1, 1); PG8_STAGE(PG8_SB(1, 0), b3, voffB); PG8_STAGE(PG8_SB(1, 1), b3 + hstep, voffB); PG8_STAGE(PG8_SA(1, 0), a3, voffA);
            PG8_WAIT_V(8); PG8_WAIT_L(0); PG8_BAR; PG8_MMA(1, 0, At, B0); PG8_MMA(1, 1, At, B1); PG8_BAR; PG8_SCHED;
            } else {
            PG8_LDB(B0, 0, 0); PG8_SCHED; PG8_LDA(At, 0, 0); PG8_STAGE(PG8_SA(1, 1), a1 + hstep, voffA);
            PG8_WAIT_L(8); PG8_BAR; PG8_WAIT_L(0); PG8_MMA(0, 0, At, B0); PG8_BAR; PG8_SCHED;
            PG8_LDB(B1, 0, 1); PG8_STAGE(PG8_SB(0, 0), b2, voffB);
            PG8_BAR; PG8_WAIT_L(0); PG8_MMA(0, 1, At, B1); PG8_BAR;
            PG8_LDA(At, 0, 1); PG8_STAGE(PG8_SA(0, 0), a2, voffA);
            PG8_BAR; PG8_WAIT_L(0); PG8_MMA(1, 0, At, B0); PG8_BAR; PG8_SCHED;
            PG8_STAGE(PG8_SB(0, 1), b2 + hstep, voffB);
            PG8_WAIT_V(6); PG8_BAR; PG8_MMA(1, 1, At, B1); PG8_BAR;
            PG8_LDB(B0, 1, 0); PG8_SCHED; PG8_LDA(At, 1, 0); PG8_STAGE(PG8_SA(0, 1), a2 + hstep, voffA);
            PG8_WAIT_L(8); PG8_BAR; PG8_WAIT_L(0); PG8_MMA(0, 0, At, B0); PG8_BAR; PG8_SCHED;
            PG8_LDB(B1, 1, 1); PG8_STAGE(PG8_SB(1, 0), b3, voffB);
            PG8_BAR; PG8_WAIT_L(0); PG8_MMA(0, 1, At, B1); PG8_BAR;
            PG8_LDA(At, 1, 1); PG8_STAGE(PG8_SA(1, 0), a3, voffA);
            PG8_BAR; PG8_WAIT_L(0); PG8_MMA(1, 0, At, B0); PG8_BAR; PG8_SCHED;
            PG8_STAGE(PG8_SB(1, 1), b3 + hstep, voffB);
            PG8_WAIT_V(6); PG8_BAR; PG8_MMA(1, 1, At, B1); PG8_BAR;
            }
        }
        if constexpr (ALIGN_EPI) { if (wr == 0) PG8_BAR; }
        if constexpr (!Epi::AFTER_DRAIN) { E(acc, cur, wr, wc, fr, fq); S.done(cur); }
        if (!has_next) break;
#pragma unroll
        for (int a = 0; a < 2; ++a)
#pragma unroll
            for (int b = 0; b < 2; ++b)
#pragma unroll
                for (int m = 0; m < 4; ++m)
#pragma unroll
                    for (int n = 0; n < 2; ++n) acc[a][b][m][n] = (f32x4){0.f, 0.f, 0.f, 0.f};
        cur = nxt; cA = nA; cB = nB; ++ui;
        if constexpr (ALIGN_EPI) { if (wr == 1) PG8_BAR; }
    }
    PG8_WAIT_V(0);
    if constexpr (!ALIGN_EPI) { if (wr == 0) PG8_BAR; }
    PG8_BAR;
    if constexpr (Epi::AFTER_DRAIN) { E.fused(acc, cur, wr, wc, fr, fq, lds, wid, lane); S.done(cur); }
#undef PG8_SA
#undef PG8_SB
#undef PG8_STAGE
#undef PG8_LDA
#undef PG8_LDB
#undef PG8_MMA
#undef PG8_WAIT_V
#undef PG8_WAIT_L
#undef PG8_BAR
#undef PG8_SCHED
}
}
#define GAS __attribute__((address_space(1)))
#define LAS __attribute__((address_space(3)))
typedef unsigned short bf16;
typedef unsigned v4u __attribute__((ext_vector_type(4)));
typedef float f32x4 __attribute__((ext_vector_type(4)));
typedef short bf16x8 __attribute__((ext_vector_type(8)));
typedef GAS unsigned gu32;
typedef GAS unsigned long long gu64;
#define RLX_AGENT __ATOMIC_RELAXED, __HIP_MEMORY_SCOPE_AGENT
#define LDS_WAIT() asm volatile("s_waitcnt lgkmcnt(0)" ::: "memory")
#define VM_WAIT() asm volatile("s_waitcnt vmcnt(0)" ::: "memory")
__device__ __forceinline__ unsigned long long rt() { return __builtin_amdgcn_s_memrealtime(); }
typedef float f32x2_cv __attribute__((ext_vector_type(2))); typedef __bf16 bf16x2_cv __attribute__((ext_vector_type(2)));
__device__ __forceinline__ unsigned pk2(float lo, float hi) { const f32x2_cv v = {lo, hi}; const bf16x2_cv b = __builtin_convertvector(v, bf16x2_cv); return __builtin_bit_cast(unsigned, b); }
__device__ __forceinline__ unsigned f2bf(float f) { return pk2(f, 0.f) & 0xffffu; }

#define XB_TMO      128
#define XB_XCNT(j)  (256  + 64 * (j))
#define XB_XSUB(j)  (1280 + 64 * (j))
#define XB_XGEN(j)  (2304 + 64 * (j))
#define XB_TOP      3328
#define XB_TOPGEN   3392
#define XCD_BAR_WORDS 3456
#define XB_SPIN_CAP (1u << 18)

__device__ __forceinline__ unsigned xb_ld(unsigned* p)              { return __hip_atomic_load(p, __ATOMIC_RELAXED, __HIP_MEMORY_SCOPE_AGENT); }
__device__ __forceinline__ unsigned xb_add(unsigned* p, unsigned v) { return __hip_atomic_fetch_add(p, v, __ATOMIC_RELAXED, __HIP_MEMORY_SCOPE_AGENT); }
__device__ __forceinline__ unsigned xb_xcc_id() { return (unsigned)__builtin_amdgcn_s_getreg((3 << 11) | 20) & 0xFu; }
#define XB_SPIN(cond, bar) do { unsigned _sp = 0; while (cond) { __builtin_amdgcn_s_sleep(1); \
    if ((++_sp & 255u) == 0u) { if (xb_ld(&(bar)[XB_TMO])) break; if (_sp > XB_SPIN_CAP) { atomicAdd(&(bar)[XB_TMO], 1u); break; } } } } while (0)

struct XcdBarrier {
    unsigned* bar; unsigned x;
    volatile LAS unsigned* st;
};

__device__ __forceinline__ XcdBarrier xcd_barrier_post(unsigned* bar, volatile LAS unsigned* st) {
    XcdBarrier b; b.bar = bar; b.x = xb_xcc_id(); b.st = st;
    if (threadIdx.x == 0) (void)xb_add(&bar[XB_XCNT(b.x)], 1u);
    return b;
}
__device__ __forceinline__ void xcd_barrier_complete(unsigned* bar, unsigned x, unsigned& nloc, unsigned& nx) {
    const unsigned G = gridDim.x * gridDim.y * gridDim.z;
    unsigned sum, cnt, mine, sp = 0u;
    for (;;) {
        sum = 0u; cnt = 0u; mine = 0u;
#pragma unroll
        for (unsigned j = 0; j < 16; ++j) { const unsigned c = xb_ld(&bar[XB_XCNT(j)]); sum += c; cnt += (c > 0u) ? 1u : 0u; mine = (j == x) ? c : mine; }
        if (sum == G) break;
        __builtin_amdgcn_s_sleep(1);
        if ((++sp & 255u) == 0u) { if (xb_ld(&bar[XB_TMO])) break; if (sp > XB_SPIN_CAP) { atomicAdd(&bar[XB_TMO], 1u); break; } }
    }
    nloc = mine > 0u ? mine : 1u; nx = cnt > 0u ? cnt : 1u;
}

__device__ __forceinline__ void xcd_barrier(const XcdBarrier& b) {
    asm volatile("s_waitcnt vmcnt(0)" ::: "memory");
    __syncthreads();
    if (threadIdx.x == 0) {
        unsigned* bar = b.bar;
        __builtin_amdgcn_s_waitcnt(0);
        unsigned nloc = b.st[0], nx = b.st[1];
        if (nloc == 0u) { xcd_barrier_complete(bar, b.x, nloc, nx); b.st[0] = nloc; b.st[1] = nx; }
        const unsigned old = xb_add(&bar[XB_XSUB(b.x)], 1u);
        const unsigned gen = old / nloc;
        if (old + 1u == (gen + 1u) * nloc) {
            __builtin_amdgcn_fence(__ATOMIC_RELEASE, "agent");
            asm volatile("s_waitcnt vmcnt(0)" ::: "memory");
            const unsigned og = xb_add(&bar[XB_TOP], 1u);
            const unsigned tg = og / nx;
            if (og + 1u == (tg + 1u) * nx) xb_add(&bar[XB_TOPGEN], 1u);
            else XB_SPIN(xb_ld(&bar[XB_TOPGEN]) == tg, bar);
            __builtin_amdgcn_fence(__ATOMIC_ACQUIRE, "agent");
            xb_add(&bar[XB_XGEN(b.x)], 1u);
            asm volatile("s_waitcnt vmcnt(0)" ::: "memory");
        } else {
            XB_SPIN(xb_ld(&bar[XB_XGEN(b.x)]) == gen, bar);
            __builtin_amdgcn_fence(__ATOMIC_ACQUIRE, "agent");
            asm volatile("s_waitcnt vmcnt(0)" ::: "memory");
        }
    }
    __syncthreads();
}
constexpr int NWAVES = 8;
constexpr int T = 32768, D = 1024, SEQ = 4096;
constexpr float EPS = 1e-6f;
constexpr float LAMBDA_INIT = 0.35550906759f;
constexpr size_t MiB = 1u << 20;
constexpr size_t WS_CTL = 0, CTL_ZERO_BYTES = 1 * MiB;
constexpr size_t WS_ROPE = 1 * MiB;
constexpr size_t WS_WIN = 4 * MiB;
constexpr size_t WS_WO0 = 11 * MiB, WS_WQ0 = 13 * MiB, WS_KEY0 = 17 * MiB, WS_WQKV = 18 * MiB, WS_WO1 = 24 * MiB, WS_WQ1 = 26 * MiB, WS_KEY1 = 30 * MiB;
constexpr size_t WS_SC = 31 * MiB;
constexpr size_t WS_U0 = 32 * MiB, WS_V0T = 48 * MiB, WS_U1 = 64 * MiB, WS_V1T = 80 * MiB;
constexpr size_t WS_B0 = 96 * MiB;
constexpr size_t WS_R1 = 160 * MiB, WS_R2 = 224 * MiB, WS_R3 = 288 * MiB, WS_R4 = 352 * MiB, WS_R5 = 416 * MiB, WS_GATES = 480 * MiB;
constexpr size_t WS_I8 = 484 * MiB;
constexpr size_t WS_END = 492 * MiB;
constexpr int CW_BAR = 4096;
constexpr int LDS_BYTES = 147456, MISC_OFF = LDS_BYTES - 128;

typedef float f32x16 __attribute__((ext_vector_type(16)));
typedef unsigned u32x2 __attribute__((ext_vector_type(2)));
typedef __bf16 bf16x2_t __attribute__((ext_vector_type(2)));
__device__ __forceinline__ float bf_lo(unsigned w) { return __uint_as_float(w << 16); }
__device__ __forceinline__ float bf_hi(unsigned w) { return __uint_as_float(w & 0xffff0000u); }
__device__ __forceinline__ float dot2(unsigned a, unsigned b, float c) { return __builtin_amdgcn_fdot2_f32_bf16(__builtin_bit_cast(bf16x2_t, a), __builtin_bit_cast(bf16x2_t, b), c, false); }
__device__ __forceinline__ float shx(float v, int lane, int m) { return __uint_as_float((unsigned)__builtin_amdgcn_ds_bpermute((lane ^ m) << 2, (int)__float_as_uint(v))); }
__device__ __forceinline__ int shxi(int v, int lane, int m) { return __builtin_amdgcn_ds_bpermute((lane ^ m) << 2, v); }
__device__ __forceinline__ float wave_sum(float v, int lane) {
#pragma unroll
    for (int o = 1; o < 64; o <<= 1) v += shx(v, lane, o);
    return v;
}
__device__ __forceinline__ f32x4 mfma16(bf16x8 a, bf16x8 b, f32x4 c) { return __builtin_amdgcn_mfma_f32_16x16x32_bf16(a, b, c, 0, 0, 0); }
__device__ __forceinline__ f32x16 mfma32(bf16x8 a, bf16x8 b, f32x16 c) { return __builtin_amdgcn_mfma_f32_32x32x16_bf16(a, b, c, 0, 0, 0); }
__device__ __forceinline__ u32x2 pack4(float a, float b, float c, float d) { u32x2 r; r.x = pk2(a, b); r.y = pk2(c, d); return r; }

__device__ __forceinline__ void p0_transpose_item(const float* W, int K, int N, bf16* WT, LAS float* scr, int item, int lane, const float* kscale = nullptr) {
    const int nblk = N / 32, kb = item / nblk, nb = item % nblk, k0 = 64 * kb, n0 = 32 * nb;
#pragma unroll 8
    for (int i = 0; i < 32; ++i) { const int kk = 2 * i + (lane >> 5); const float sc = kscale ? kscale[k0 + kk] : 1.f; scr[kk * 33 + (lane & 31)] = W[(size_t)(k0 + kk) * N + n0 + (lane & 31)] * sc; }
    LDS_WAIT(); asm volatile("" ::: "memory");
    const int c = lane & 7;
#pragma unroll
    for (int j = 0; j < 4; ++j) { const int n = (lane >> 3) + 8 * j; const LAS float* s = scr + (8 * c) * 33 + n;
        v4u o; o.x = pk2(s[0 * 33], s[1 * 33]); o.y = pk2(s[2 * 33], s[3 * 33]); o.z = pk2(s[4 * 33], s[5 * 33]); o.w = pk2(s[6 * 33], s[7 * 33]);
        *(v4u*)(WT + (size_t)(n0 + n) * K + k0 + 8 * c) = o; }
    LDS_WAIT(); asm volatile("" ::: "memory");
}
__device__ __forceinline__ void cvt_range(const float* src, bf16* dst, size_t n, size_t gtid, size_t gthreads) {
    for (size_t i = gtid * 8; i < n; i += gthreads * 8) {
        const f32x4 a = *(const f32x4*)(src + i), b = *(const f32x4*)(src + i + 4);
        v4u o; o.x = pk2(a.x, a.y); o.y = pk2(a.z, a.w); o.z = pk2(b.x, b.y); o.w = pk2(b.z, b.w);
        *(v4u*)(dst + i) = o; }
}
__device__ __forceinline__ void rms_row_to_bf16(const float* xrow, const float* g, bf16* orow, int lane) {
    const f32x4* xr = (const f32x4*)xrow + lane; const f32x4* gr = (const f32x4*)g + lane;
    f32x4 v[4]; float s = 0.f;
#pragma unroll
    for (int j = 0; j < 4; ++j) { v[j] = xr[64 * j]; s += (v[j].x * v[j].x + v[j].y * v[j].y) + (v[j].z * v[j].z + v[j].w * v[j].w); }
    const float rstd = rsqrtf(wave_sum(s, lane) * (1.f / 1024.f) + EPS);
    unsigned long long* o8 = (unsigned long long*)orow + lane;
#pragma unroll
    for (int j = 0; j < 4; ++j) { const f32x4 gg = gr[64 * j];
        o8[64 * j] = (unsigned long long)pk2(v[j].x * rstd * gg.x, v[j].y * rstd * gg.y) | ((unsigned long long)pk2(v[j].z * rstd * gg.z, v[j].w * rstd * gg.w) << 32); }
}
__device__ __forceinline__ void rms_pass(const float* X, const float* g, bf16* XN, int gw, int NGW, int lane) {
    for (int m = gw; m < T; m += NGW) rms_row_to_bf16(X + (size_t)m * D, g, XN + (size_t)m * D, lane);
}

__device__ __forceinline__ float logsigmoid_f(float f) { return fminf(f, 0.f) - log1pf(__expf(-fabsf(f))); }
#define ML_LOAD(ci_) do { const size_t r_ = rowbase + (size_t)(ci_) * 64 + lane; \
    rq = *(const v4u*)(Q0 + r_ * 64 + 8 * w); rk = *(const v4u*)(K0 + r_ * 64 + 8 * w); rv0 = *(const v4u*)(V0 + r_ * 128 + 16 * w); rv1 = *(const v4u*)(V0 + r_ * 128 + 16 * w + 8); \
    const size_t gm_ = ((size_t)b * 4096 + (size_t)(ci_) * 64 + jr) * 32; rli = GATES[gm_ + (dir ? 16 : 0) + h]; rf = GATES[gm_ + (dir ? 24 : 8) + h]; } while (0)
__device__ __forceinline__ void mlstm_phase(const int wv, LAS unsigned char* lds, const bf16* Q0, const bf16* K0, const bf16* V0, const float* GATES, bf16* HF, bf16* HB) {
    const int bx = blockIdx.x;
    if ((bx >> 3) & 1) return;
    const int seq = (bx >> 4) * 8 + (bx & 7);
    const int dir = seq & 1, bh = seq >> 1, b = bh >> 3, h = bh & 7;
    int ln_; asm volatile("v_mbcnt_lo_u32_b32 %0, -1, 0\n\tv_mbcnt_hi_u32_b32 %0, -1, %0" : "=v"(ln_)); const int tid = wv * 64 + ln_, lane = tid & 63, w = wv, fr = lane & 15, fq = lane >> 4;
    LAS bf16* Qs = (LAS bf16*)(lds); LAS bf16* Ks = (LAS bf16*)(lds + 9216); LAS bf16* Kwt = (LAS bf16*)(lds + 18432); LAS bf16* Ps = (LAS bf16*)(lds + 27648);
    LAS bf16* Vt = (LAS bf16*)(lds + 36864 + w * 2304); LAS bf16* Cs = (LAS bf16*)(lds + 55296 + w * 2304); LAS bf16* nb = (LAS bf16*)(lds + 73728 + w * 128);
    LAS float* gc = (LAS float*)(lds + 74752 + w * 1280); LAS float* gM = gc + 64; LAS float* gI = gc + 128; LAS float* gE = gc + 192; LAS float* gW = gc + 256;
    for (int i = lane; i < 2304 / 4; i += 64) ((LAS unsigned*)Cs)[i] = 0u;
    if (lane < 32) ((LAS unsigned*)nb)[lane] = 0u;
    f32x4 Cacc[4], Nacc[4];
#pragma unroll
    for (int i = 0; i < 4; ++i) { Cacc[i] = (f32x4){0.f, 0.f, 0.f, 0.f}; Nacc[i] = (f32x4){0.f, 0.f, 0.f, 0.f}; }
    float m = -1e30f;
    bf16* Hout = dir ? HB : HF;
    const size_t rowbase = (size_t)bh * 4096;
    const int jr = dir ? 63 - lane : lane;
    v4u rq, rk, rv0, rv1; float rli, rf;
    ML_LOAD(dir ? 63 : 0);
    const bf16x8 ones = (bf16x8){0x3F80, 0x3F80, 0x3F80, 0x3F80, 0x3F80, 0x3F80, 0x3F80, 0x3F80};
    const f32x4 z4 = (f32x4){0.f, 0.f, 0.f, 0.f};
#pragma unroll 1
    for (int step = 0; step < 64; ++step) {
        const int ci = dir ? 63 - step : step;
        const float lf = logsigmoid_f(rf);
        float bcs = lf;
        bcs += __uint_as_float((unsigned)__builtin_amdgcn_update_dpp(0, (int)__float_as_uint(bcs), 0x111, 0xF, 0xF, false));
        bcs += __uint_as_float((unsigned)__builtin_amdgcn_update_dpp(0, (int)__float_as_uint(bcs), 0x112, 0xF, 0xF, false));
        bcs += __uint_as_float((unsigned)__builtin_amdgcn_update_dpp(0, (int)__float_as_uint(bcs), 0x114, 0xF, 0xF, false));
        bcs += __uint_as_float((unsigned)__builtin_amdgcn_update_dpp(0, (int)__float_as_uint(bcs), 0x118, 0xF, 0xF, false));
        bcs += __uint_as_float((unsigned)__builtin_amdgcn_update_dpp(0, (int)__float_as_uint(bcs), 0x142, 0xA, 0xF, false));
        bcs += __uint_as_float((unsigned)__builtin_amdgcn_update_dpp(0, (int)__float_as_uint(bcs), 0x143, 0xC, 0xF, false));
        const float c = rli - bcs;
        float pm = c;
        const int NINFI = (int)0xFF800000u;
        pm = fmaxf(pm, __uint_as_float((unsigned)__builtin_amdgcn_update_dpp(NINFI, (int)__float_as_uint(pm), 0x111, 0xF, 0xF, false)));
        pm = fmaxf(pm, __uint_as_float((unsigned)__builtin_amdgcn_update_dpp(NINFI, (int)__float_as_uint(pm), 0x112, 0xF, 0xF, false)));
        pm = fmaxf(pm, __uint_as_float((unsigned)__builtin_amdgcn_update_dpp(NINFI, (int)__float_as_uint(pm), 0x114, 0xF, 0xF, false)));
        pm = fmaxf(pm, __uint_as_float((unsigned)__builtin_amdgcn_update_dpp(NINFI, (int)__float_as_uint(pm), 0x118, 0xF, 0xF, false)));
        pm = fmaxf(pm, __uint_as_float((unsigned)__builtin_amdgcn_update_dpp(NINFI, (int)__float_as_uint(pm), 0x142, 0xA, 0xF, false)));
        pm = fmaxf(pm, __uint_as_float((unsigned)__builtin_amdgcn_update_dpp(NINFI, (int)__float_as_uint(pm), 0x143, 0xC, 0xF, false)));
        const float M = fmaxf(m, pm);
        const float bL = __uint_as_float((unsigned)__builtin_amdgcn_readlane((int)__float_as_uint(bcs), 63)), Mlast = __uint_as_float((unsigned)__builtin_amdgcn_readlane((int)__float_as_uint(M), 63));
        gc[jr] = c; gM[jr] = M; gI[jr] = __expf(m - M); gE[jr] = __expf(-(bcs + M)); gW[jr] = __expf(c - Mlast);
        const float sp = __expf(m - Mlast), m_new = bL + Mlast;
        const float wr_ = gW[lane];
        *(LAS v4u*)(Qs + lane * 72 + 8 * w) = rq; *(LAS v4u*)(Ks + lane * 72 + 8 * w) = rk;
#pragma unroll
        for (int i = 0; i < 4; ++i) { const unsigned kw = rk[i]; Kwt[(8 * w + 2 * i) * 72 + lane] = (bf16)f2bf(bf_lo(kw) * wr_); Kwt[(8 * w + 2 * i + 1) * 72 + lane] = (bf16)f2bf(bf_hi(kw) * wr_); }
#pragma unroll
        for (int i = 0; i < 4; ++i) { Vt[(2 * i) * 72 + lane] = (bf16)(rv0[i] & 0xffffu); Vt[(2 * i + 1) * 72 + lane] = (bf16)(rv0[i] >> 16);
                                      Vt[(8 + 2 * i) * 72 + lane] = (bf16)(rv1[i] & 0xffffu); Vt[(9 + 2 * i) * 72 + lane] = (bf16)(rv1[i] >> 16); }
        __syncthreads();
        if (step < 63) ML_LOAD(dir ? 62 - step : step + 1);
        {
            const int st = w >> 1;
            const bf16x8 a0 = *(const LAS bf16x8*)(Ks + (16 * st + fr) * 72 + 8 * fq), a1 = *(const LAS bf16x8*)(Ks + (16 * st + fr) * 72 + 32 + 8 * fq);
#pragma unroll
            for (int u = 0; u < 2; ++u) { const int tt = 2 * (w & 1) + u;
                const bf16x8 b0 = *(const LAS bf16x8*)(Qs + (16 * tt + fr) * 72 + 8 * fq), b1 = *(const LAS bf16x8*)(Qs + (16 * tt + fr) * 72 + 32 + 8 * fq);
                f32x4 acc = mfma16(a0, b0, z4); acc = mfma16(a1, b1, acc);
                const int t = 16 * tt + fr; const float Mt = gM[t]; float pv[4];
#pragma unroll
                for (int i = 0; i < 4; ++i) { const int s = 16 * st + 4 * fq + i; const bool valid = dir ? (s >= t) : (s <= t); const float e = __expf(gc[s] - Mt); pv[i] = valid ? acc[i] * e : 0.f; }
                *(LAS u32x2*)(Ps + t * 72 + 16 * st + 4 * fq) = pack4(pv[0], pv[1], pv[2], pv[3]); }
        }
        __syncthreads();
        const bf16x8 aV0 = *(const LAS bf16x8*)(Vt + fr * 72 + 8 * fq), aV1 = *(const LAS bf16x8*)(Vt + fr * 72 + 32 + 8 * fq);
        {
            const bf16x8 aC0 = *(const LAS bf16x8*)(Cs + fr * 72 + 8 * fq), aC1 = *(const LAS bf16x8*)(Cs + fr * 72 + 32 + 8 * fq);
            const bf16x8 aN0 = *(const LAS bf16x8*)(nb + 8 * fq), aN1 = *(const LAS bf16x8*)(nb + 32 + 8 * fq);
#pragma unroll
            for (int tt = 0; tt < 4; ++tt) {
                const bf16x8 bP0 = *(const LAS bf16x8*)(Ps + (16 * tt + fr) * 72 + 8 * fq), bP1 = *(const LAS bf16x8*)(Ps + (16 * tt + fr) * 72 + 32 + 8 * fq);
                const bf16x8 bQ0 = *(const LAS bf16x8*)(Qs + (16 * tt + fr) * 72 + 8 * fq), bQ1 = *(const LAS bf16x8*)(Qs + (16 * tt + fr) * 72 + 32 + 8 * fq);
                f32x4 acc1 = mfma16(aV0, bP0, z4); acc1 = mfma16(aV1, bP1, acc1);
                f32x4 acc2 = mfma16(aC0, bQ0, z4); acc2 = mfma16(aC1, bQ1, acc2);
                f32x4 d1 = mfma16(ones, bP0, z4); d1 = mfma16(ones, bP1, d1);
                f32x4 d2 = mfma16(aN0, bQ0, z4); d2 = mfma16(aN1, bQ1, d2);
                const int t = 16 * tt + fr; const float it = gI[t], en = gE[t];
                const float den = d1[0] + it * d2[0]; const float inv = 1.f / fmaxf(fabsf(den), en);
                *(u32x2*)(Hout + ((size_t)b * 4096 + (size_t)ci * 64 + t) * 1024 + h * 128 + 16 * w + 4 * fq) =
                    pack4((acc1[0] + it * acc2[0]) * inv, (acc1[1] + it * acc2[1]) * inv, (acc1[2] + it * acc2[2]) * inv, (acc1[3] + it * acc2[3]) * inv);
            }
        }
#pragma unroll
        for (int dt = 0; dt < 4; ++dt) { Cacc[dt] = Cacc[dt] * sp; Nacc[dt] = Nacc[dt] * sp;
            const bf16x8 aK0 = *(const LAS bf16x8*)(Kwt + (16 * dt + fr) * 72 + 8 * fq), aK1 = *(const LAS bf16x8*)(Kwt + (16 * dt + fr) * 72 + 32 + 8 * fq);
            Cacc[dt] = mfma16(aK0, aV0, Cacc[dt]); Cacc[dt] = mfma16(aK1, aV1, Cacc[dt]);
            Nacc[dt] = mfma16(aK0, ones, Nacc[dt]); Nacc[dt] = mfma16(aK1, ones, Nacc[dt]); }
#pragma unroll
        for (int dt = 0; dt < 4; ++dt) { *(LAS u32x2*)(Cs + fr * 72 + 16 * dt + 4 * fq) = pack4(Cacc[dt][0], Cacc[dt][1], Cacc[dt][2], Cacc[dt][3]);
                                         *(LAS u32x2*)(nb + 16 * dt + 4 * fq) = pack4(Nacc[dt][0], Nacc[dt][1], Nacc[dt][2], Nacc[dt][3]); }
        m = m_new;
        __syncthreads();
    }
}
#undef ML_LOAD

__device__ __forceinline__ void hs_pass(const bf16* HF, const bf16* HB, const bf16* OG, const float* hg, bf16* HS, int gw, int NGW, int lane) {
    for (int m = gw; m < T; m += NGW) {
        const size_t off = (size_t)m * 1024 + 16 * lane;
        const v4u f0 = *(const v4u*)(HF + off), f1 = *(const v4u*)(HF + off + 8), b0 = *(const v4u*)(HB + off), b1 = *(const v4u*)(HB + off + 8), o0 = *(const v4u*)(OG + off), o1 = *(const v4u*)(OG + off + 8);
        float x[16], og[16];
#pragma unroll
        for (int i = 0; i < 4; ++i) { x[2 * i] = bf_lo(f0[i]) + bf_lo(b0[i]); x[2 * i + 1] = bf_hi(f0[i]) + bf_hi(b0[i]); x[8 + 2 * i] = bf_lo(f1[i]) + bf_lo(b1[i]); x[9 + 2 * i] = bf_hi(f1[i]) + bf_hi(b1[i]);
                                      og[2 * i] = bf_lo(o0[i]); og[2 * i + 1] = bf_hi(o0[i]); og[8 + 2 * i] = bf_lo(o1[i]); og[9 + 2 * i] = bf_hi(o1[i]); }
        float ss = 0.f;
#pragma unroll
        for (int i = 0; i < 16; ++i) ss += x[i] * x[i];
        ss += shx(ss, lane, 1); ss += shx(ss, lane, 2); ss += shx(ss, lane, 4);
        const float rstd = rsqrtf(ss * (1.f / 128.f) + EPS);
        float y[16];
#pragma unroll
        for (int i = 0; i < 16; ++i) y[i] = x[i] * rstd * hg[16 * lane + i] * (1.f / (1.f + __expf(-og[i])));
        v4u w0, w1;
#pragma unroll
        for (int i = 0; i < 4; ++i) { w0[i] = pk2(y[2 * i], y[2 * i + 1]); w1[i] = pk2(y[8 + 2 * i], y[9 + 2 * i]); }
        *(v4u*)(HS + off) = w0; *(v4u*)(HS + off + 8) = w1;
    }
}

__device__ __forceinline__ void glds16(const void* gsrc, unsigned lds_dst) { unsigned keep;
    asm volatile("s_mov_b32 %0, m0\n\ts_mov_b32 m0, %2\n\ts_nop 0\n\tglobal_load_lds_dwordx4 %1, off\n\ts_mov_b32 m0, %0" : "=&s"(keep) : "v"(gsrc), "s"(lds_dst) : "memory"); }
#define AT_WAIT_BAR() asm volatile("s_waitcnt vmcnt(0) lgkmcnt(0)\n\ts_barrier" ::: "memory")

#define TK_CE(a, b) do { const float h_ = fmaxf(a, b), l_ = fminf(a, b); a = h_; b = l_; } while (0)
#define BITONIC_MERGE16(x) do { _Pragma("unroll") for (int d_ = 8; d_ >= 1; d_ >>= 1) { _Pragma("unroll") for (int i_ = 0; i_ < 16; ++i_) if ((i_ & d_) == 0) TK_CE(x[i_], x[i_ + d_]); } } while (0)
#define BITONIC_SORT16(x) do { _Pragma("unroll") for (int k_ = 2; k_ <= 16; k_ <<= 1) { _Pragma("unroll") for (int d_ = k_ >> 1; d_ >= 1; d_ >>= 1) { _Pragma("unroll") for (int i_ = 0; i_ < 16; ++i_) { const int l_i = i_ ^ d_; \
    if (l_i > i_) { if ((i_ & k_) == 0 || k_ == 16) TK_CE(x[i_], x[l_i]); else TK_CE(x[l_i], x[i_]); } } } } } while (0)
#define TK_INSERT(v, x) do { float c_ = (x); _Pragma("unroll") for (int j_ = 0; j_ < 16; ++j_) { const float h_ = fmaxf(v[j_], c_); c_ = fminf(v[j_], c_); v[j_] = h_; } } while (0)
#define TK_DMA(st_, b_) do { _Pragma("unroll") for (int g_ = 0; g_ < 2; ++g_) { const int hp_ = ((g_ * 4 + ((st_) >> 1)) * 2 + ((st_) & 1)); \
    _Pragma("unroll") for (int i_ = 0; i_ < 4; ++i_) { const int q_ = w * 4 + i_, row_ = 4 * q_ + (lane >> 4), ch_ = (lane & 15) ^ (row_ & 15); \
        glds16(KEYS + ((size_t)(hp_ * 128 + row_)) * 128 + ch_ * 8, (unsigned)__builtin_amdgcn_readfirstlane((int)(ldsb + ((b_) * 2 + g_) * 32768 + q_ * 1024))); } } } while (0)
__device__ __forceinline__ void peer_topk_phase(const int wv, LAS unsigned char* lds, int vcu, const bf16* PQ, const bf16* KEYS, int* EXPERTS, float* GATESP) {
    int ln_; asm volatile("v_mbcnt_lo_u32_b32 %0, -1, 0\n\tv_mbcnt_hi_u32_b32 %0, -1, %0" : "=v"(ln_)); const int tid = wv * 64 + ln_, lane = tid & 63, w = wv, r32 = lane & 31, hi = lane >> 5;
    const int t = vcu * 128 + (w & 3) * 32 + r32, hg = w >> 2;
    const float NINF = -INFINITY;
    const unsigned ldsb = (unsigned)(uintptr_t)lds;
    TK_DMA(0, 0);
    AT_WAIT_BAR();
#pragma unroll 1
    for (int hh = 0; hh < 4; ++hh) {
        const int head = hg * 4 + hh;
        float L0[16], L1[16];
#pragma unroll
        for (int j = 0; j < 16; ++j) { L0[j] = 0.f; L1[j] = 0.f; }
#pragma unroll 1
        for (int p = 0; p < 2; ++p) {
            const int st = hh * 2 + p, buf = st & 1;
            if (st < 7) TK_DMA(st + 1, buf ^ 1);
            bf16x8 bq[8];
#pragma unroll
            for (int ks = 0; ks < 8; ++ks) bq[ks] = *(const bf16x8*)(PQ + (size_t)t * 2048 + head * 256 + p * 128 + ks * 16 + 8 * hi);
            const LAS unsigned char* kb = lds + (buf * 2 + hg) * 32768 + r32 * 256;
            f32x16 acc[4];
#pragma unroll
            for (int nt = 0; nt < 4; ++nt) {
#pragma unroll
                for (int r = 0; r < 16; ++r) acc[nt][r] = 0.f;
#pragma unroll
                for (int ks = 0; ks < 8; ++ks) { const bf16x8 a = *(const LAS bf16x8*)(kb + nt * 8192 + (((2 * ks + hi) ^ (r32 & 15)) << 4)); acc[nt] = mfma32(a, bq[ks], acc[nt]); }
            }
            float v[16];
            {
                float blk[4][16];
#pragma unroll
                for (int nt = 0; nt < 4; ++nt)
#pragma unroll
                    for (int r = 0; r < 16; ++r) { const int n = nt * 32 + (r & 3) + 8 * (r >> 2) + 4 * hi; blk[nt][r] = __uint_as_float((__float_as_uint(acc[nt][r]) & ~0x7Fu) | (unsigned)(127 - n)); }
#pragma unroll
                for (int nt = 0; nt < 4; ++nt) BITONIC_SORT16(blk[nt]);
#pragma unroll
                for (int i = 0; i < 16; ++i) { blk[0][i] = fmaxf(blk[0][i], blk[1][15 - i]); blk[2][i] = fmaxf(blk[2][i], blk[3][15 - i]); }
                BITONIC_MERGE16(blk[0]); BITONIC_MERGE16(blk[2]);
#pragma unroll
                for (int i = 0; i < 16; ++i) v[i] = fmaxf(blk[0][i], blk[2][15 - i]);
                BITONIC_MERGE16(v);
            }
            {
                float wv_[16];
#pragma unroll
                for (int j = 0; j < 16; ++j) wv_[j] = shx(v[15 - j], lane, 32);
#pragma unroll
                for (int j = 0; j < 16; ++j) v[j] = fmaxf(v[j], wv_[j]);
                BITONIC_MERGE16(v);
            }
            if (p == 0) {
#pragma unroll
                for (int j = 0; j < 16; ++j) L0[j] = v[j];
            } else {
#pragma unroll
                for (int j = 0; j < 16; ++j) L1[j] = v[j];
            }            AT_WAIT_BAR();
        }
        float tv[16];
        unsigned IA[4] = {0u, 0u, 0u, 0u}, IB[4] = {0u, 0u, 0u, 0u};
#pragma unroll
        for (int i = 0; i < 16; ++i) { IA[i >> 2] |= (127u - (__float_as_uint(L0[i]) & 0x7Fu)) << (8 * (i & 3)); IB[i >> 2] |= (127u - (__float_as_uint(L1[i]) & 0x7Fu)) << (8 * (i & 3)); }
        {
            float cb[4][16]; int cn = 0;
#pragma unroll
            for (int i = 0; i < 16; ++i) {
                const float va = __uint_as_float(__float_as_uint(L0[i]) & ~0x7Fu);
#pragma unroll
                for (int j = 0; j < 16; ++j) if ((i + 1) * (j + 1) <= 16) {
                    const float vb = __uint_as_float(__float_as_uint(L1[j]) & ~0x7Fu);
                    cb[cn >> 4][cn & 15] = __uint_as_float((__float_as_uint(va + vb) & ~0xFFu) | (unsigned)(255 - (i * 16 + j)));
                    ++cn;
                }
            }
#pragma unroll
            for (int c = 50; c < 64; ++c) cb[c >> 4][c & 15] = NINF;
#pragma unroll
            for (int nt = 0; nt < 4; ++nt) BITONIC_SORT16(cb[nt]);
#pragma unroll
            for (int i = 0; i < 16; ++i) { cb[0][i] = fmaxf(cb[0][i], cb[1][15 - i]); cb[2][i] = fmaxf(cb[2][i], cb[3][15 - i]); }
            BITONIC_MERGE16(cb[0]); BITONIC_MERGE16(cb[2]);
#pragma unroll
            for (int i = 0; i < 16; ++i) tv[i] = fmaxf(cb[0][i], cb[2][15 - i]);
            BITONIC_MERGE16(tv);
        }
        int ti[16];
#pragma unroll
        for (int j = 0; j < 16; ++j) { const unsigned kb = __float_as_uint(tv[j]); const unsigned flat = 255u - (kb & 0xFFu); const unsigned fi = flat >> 4, fj = flat & 15u;
            const unsigned ra = (fi < 8u) ? ((fi < 4u) ? IA[0] : IA[1]) : ((fi < 12u) ? IA[2] : IA[3]);
            const unsigned rb = (fj < 8u) ? ((fj < 4u) ? IB[0] : IB[1]) : ((fj < 12u) ? IB[2] : IB[3]);
            ti[j] = (int)(((ra >> (8u * (fi & 3u))) & 0xFFu) * 128u + ((rb >> (8u * (fj & 3u))) & 0xFFu));
            tv[j] = __uint_as_float(kb & ~0xFFu); }
        float e[16], sum = 0.f;
#pragma unroll
        for (int j = 0; j < 16; ++j) { e[j] = __expf(tv[j] - tv[0]); sum += e[j]; }
        const float inv = 1.f / sum;
        if (hi == 0) { int* ep = EXPERTS + (size_t)t * 128 + head * 16;
#pragma unroll
            for (int j = 0; j < 4; ++j) *(v4u*)(ep + 4 * j) = (v4u){(unsigned)ti[4 * j], (unsigned)ti[4 * j + 1], (unsigned)ti[4 * j + 2], (unsigned)ti[4 * j + 3]}; }
        else { float* gp = GATESP + (size_t)t * 128 + head * 16;
#pragma unroll
            for (int j = 0; j < 4; ++j) *(f32x4*)(gp + 4 * j) = (f32x4){e[4 * j] * inv, e[4 * j + 1] * inv, e[4 * j + 2] * inv, e[4 * j + 3] * inv}; }
    }
}

__device__ __forceinline__ float cvt_ub0(unsigned x) { float r; asm("v_cvt_f32_ubyte0 %0, %1" : "=v"(r) : "v"(x)); return r; }
__device__ __forceinline__ float cvt_ub1(unsigned x) { float r; asm("v_cvt_f32_ubyte1 %0, %1" : "=v"(r) : "v"(x)); return r; }
__device__ __forceinline__ float cvt_ub2(unsigned x) { float r; asm("v_cvt_f32_ubyte2 %0, %1" : "=v"(r) : "v"(x)); return r; }
__device__ __forceinline__ float cvt_ub3(unsigned x) { float r; asm("v_cvt_f32_ubyte3 %0, %1" : "=v"(r) : "v"(x)); return r; }
__device__ __forceinline__ void quant8_rows_bf16(const bf16* src, unsigned char* dst, float* scale, int nrows, int gw, int NGW, int lane) {
    for (int r = gw; r < nrows; r += NGW) {
        const v4u a = *(const v4u*)(src + (size_t)r * 1024 + 16 * lane), b = *(const v4u*)(src + (size_t)r * 1024 + 16 * lane + 8);
        float x[16]; float am = 0.f;
#pragma unroll
        for (int k = 0; k < 4; ++k) { x[2 * k] = bf_lo(a[k]); x[2 * k + 1] = bf_hi(a[k]); x[8 + 2 * k] = bf_lo(b[k]); x[9 + 2 * k] = bf_hi(b[k]); }
#pragma unroll
        for (int k = 0; k < 16; ++k) am = fmaxf(am, fabsf(x[k]));
#pragma unroll
        for (int o = 1; o < 64; o <<= 1) am = fmaxf(am, shx(am, lane, o));
        const float inv = am > 0.f ? 127.f / am : 0.f;
        v4u w;
#pragma unroll
        for (int k = 0; k < 4; ++k) w[k] = ((unsigned)((int)rintf(x[4 * k] * inv) & 0xff)) | ((unsigned)((int)rintf(x[4 * k + 1] * inv) & 0xff) << 8) | ((unsigned)((int)rintf(x[4 * k + 2] * inv) & 0xff) << 16) | ((unsigned)((int)rintf(x[4 * k + 3] * inv) & 0xff) << 24);
        *(v4u*)(dst + (size_t)r * 1024 + 16 * lane) = w;
        if (lane == 0) scale[r] = am * (1.f / 127.f);
    }
}
__device__ __forceinline__ void quant4_rows(const float* src, unsigned char* dst, float* scale, int nrows, int gw, int NGW, int lane) {
    for (int r = gw; r < nrows; r += NGW) {
        const f32x4* sp = (const f32x4*)(src + (size_t)r * 1024) + 4 * lane;
        f32x4 v[4]; float am = 0.f, ss = 0.f;
#pragma unroll
        for (int j = 0; j < 4; ++j) { v[j] = sp[j]; am = fmaxf(am, fmaxf(fmaxf(fabsf(v[j].x), fabsf(v[j].y)), fmaxf(fabsf(v[j].z), fabsf(v[j].w)))); ss += (v[j].x * v[j].x + v[j].y * v[j].y) + (v[j].z * v[j].z + v[j].w * v[j].w); }
#pragma unroll
        for (int o = 1; o < 64; o <<= 1) { am = fmaxf(am, shx(am, lane, o)); ss += shx(ss, lane, o); }
        const float step = fminf(am * (1.f / 7.5f), 0.3352f * sqrtf(ss * (1.f / 1024.f)));
        const float inv = step > 0.f ? 1.f / step : 0.f;
        unsigned q[16];
#pragma unroll
        for (int j = 0; j < 4; ++j) { q[4 * j] = (unsigned)fminf(fmaxf(rintf(v[j].x * inv + 7.5f), 0.f), 15.f); q[4 * j + 1] = (unsigned)fminf(fmaxf(rintf(v[j].y * inv + 7.5f), 0.f), 15.f);
                                      q[4 * j + 2] = (unsigned)fminf(fmaxf(rintf(v[j].z * inv + 7.5f), 0.f), 15.f); q[4 * j + 3] = (unsigned)fminf(fmaxf(rintf(v[j].w * inv + 7.5f), 0.f), 15.f); }
        u32x2 w;
        w.x = (q[0] | (q[4] << 4)) | ((q[1] | (q[5] << 4)) << 8) | ((q[2] | (q[6] << 4)) << 16) | ((q[3] | (q[7] << 4)) << 24);
        w.y = (q[8] | (q[12] << 4)) | ((q[9] | (q[13] << 4)) << 8) | ((q[10] | (q[14] << 4)) << 16) | ((q[11] | (q[15] << 4)) << 24);
        *(u32x2*)(dst + (size_t)r * 512 + 8 * lane) = w;
        if (lane == 0) scale[r] = step;
    }
}

#define RED_STEP(N, S) do { const bool up_ = (lane & (S)) != 0; _Pragma("unroll") for (int j_ = 0; j_ < (N); ++j_) { const int a_ = p[j_], b_ = p[j_ + (N)]; const int send_ = up_ ? a_ : b_, keep_ = up_ ? b_ : a_; p[j_] = keep_ + shxi(send_, lane, (S)); } } while (0)
#define RED16(dst) do { RED_STEP(8, 8); RED_STEP(4, 4); RED_STEP(2, 2); RED_STEP(1, 1); int s_ = p[0]; s_ += shxi(s_, lane, 16); s_ += shxi(s_, lane, 32); dst = s_; } while (0)
#define G_SB() __builtin_amdgcn_sched_barrier(0)
#define G_LOAD(buf, tab, evec, jb) do { _Pragma("unroll") for (int jj_ = 0; jj_ < 16; ++jj_) { const int e_ = __builtin_amdgcn_readlane(evec, (jb) + jj_); buf[jj_] = __builtin_amdgcn_raw_buffer_load_b64(rs_##tab, (int)voff, e_ << 9, 0); } } while (0)
#define U_COMP(buf) do { _Pragma("unroll") for (int jj_ = 0; jj_ < 16; ++jj_) { const unsigned w0_ = buf[jj_].x, w1_ = buf[jj_].y; \
    int d_ = __builtin_amdgcn_sdot4((int)(w0_ & 0x0F0F0F0Fu), hq[0], 0, false); d_ = __builtin_amdgcn_sdot4((int)((w0_ >> 4) & 0x0F0F0F0Fu), hq[1], d_, false); \
    d_ = __builtin_amdgcn_sdot4((int)(w1_ & 0x0F0F0F0Fu), hq[2], d_, false); d_ = __builtin_amdgcn_sdot4((int)((w1_ >> 4) & 0x0F0F0F0Fu), hq[3], d_, false); p[jj_] = d_; } } while (0)
#define V_DW(o0, o1, o2, o3, wd, cs) do { float t0_, t1_, t2_, t3_; asm volatile("v_cvt_f32_ubyte0 %4, %8\n\tv_cvt_f32_ubyte1 %5, %8\n\tv_cvt_f32_ubyte2 %6, %8\n\tv_cvt_f32_ubyte3 %7, %8\n\tv_fmac_f32 %0, %9, %4\n\tv_fmac_f32 %1, %9, %5\n\tv_fmac_f32 %2, %9, %6\n\tv_fmac_f32 %3, %9, %7" \
    : "+v"(o0), "+v"(o1), "+v"(o2), "+v"(o3), "=&v"(t0_), "=&v"(t1_), "=&v"(t2_), "=&v"(t3_) : "v"(wd), "s"(cs)); } while (0)
#define V_COMP(buf, cvec, jb) do { _Pragma("unroll") for (int jj_ = 0; jj_ < 16; ++jj_) { const float c_ = __uint_as_float(__builtin_amdgcn_readlane(__float_as_uint(cvec), (jb) + jj_)); const unsigned w0_ = buf[jj_].x, w1_ = buf[jj_].y; \
    V_DW(o[0], o[1], o[2], o[3], w0_ & 0x0F0F0F0Fu, c_); V_DW(o[4], o[5], o[6], o[7], (w0_ >> 4) & 0x0F0F0F0Fu, c_); V_DW(o[8], o[9], o[10], o[11], w1_ & 0x0F0F0F0Fu, c_); V_DW(o[12], o[13], o[14], o[15], (w1_ >> 4) & 0x0F0F0F0Fu, c_); } } while (0)
template <bool NEXT_NORM>
__device__ __forceinline__ void peer_gather_phase(const int wv, bool dry, int vcu, const bf16* HN, const int* EXPERTS, const float* GATESP, const unsigned char* U, const float* SU, const unsigned char* Vtab, const float* SV,
                                                  float* X, const float* gnext, bf16* XN) {
    int ln_; asm volatile("v_mbcnt_lo_u32_b32 %0, -1, 0\n\tv_mbcnt_hi_u32_b32 %0, -1, %0" : "=v"(ln_)); const int tid = wv * 64 + ln_, lane = tid & 63, w = wv;
    const __amdgpu_buffer_rsrc_t rs_U = __builtin_amdgcn_make_buffer_rsrc((void*)U, (short)0, 16384 * 512, 0x00020000), rs_Vtab = __builtin_amdgcn_make_buffer_rsrc((void*)Vtab, (short)0, 16384 * 512, 0x00020000);
    const unsigned voff = (unsigned)lane * 8u;
    const int lg = lane >> 4;
#pragma unroll 1
    for (int i = 0; i < 16; ++i) {
        const int t = vcu * 128 + w * 16 + i;
        const int ev0 = EXPERTS[(size_t)t * 128 + lane], ev1 = EXPERTS[(size_t)t * 128 + 64 + lane];
        const float gv0 = GATESP[(size_t)t * 128 + lane], gv1 = GATESP[(size_t)t * 128 + 64 + lane];
        const v4u h0 = *(const v4u*)(HN + (size_t)t * 1024 + 16 * lane), h1 = *(const v4u*)(HN + (size_t)t * 1024 + 16 * lane + 8);
        float hf[16]; float am = 0.f;
#pragma unroll
        for (int k = 0; k < 4; ++k) { hf[2 * k] = bf_lo(h0[k]); hf[2 * k + 1] = bf_hi(h0[k]); hf[8 + 2 * k] = bf_lo(h1[k]); hf[9 + 2 * k] = bf_hi(h1[k]); }
#pragma unroll
        for (int k = 0; k < 16; ++k) am = fmaxf(am, fabsf(hf[k]));
#pragma unroll
        for (int o = 1; o < 64; o <<= 1) am = fmaxf(am, shx(am, lane, o));
        const float hinv = am > 0.f ? 127.f / am : 0.f, sh = am * (1.f / 127.f);
        int hq[4]; int hs = 0;
#pragma unroll
        for (int k = 0; k < 4; ++k) { const int q0 = (int)rintf(hf[4 * k] * hinv), q1 = (int)rintf(hf[4 * k + 1] * hinv), q2 = (int)rintf(hf[4 * k + 2] * hinv), q3 = (int)rintf(hf[4 * k + 3] * hinv); hs += (q0 + q1) + (q2 + q3);
            hq[k] = (int)(((unsigned)(q0 & 0xff)) | ((unsigned)(q1 & 0xff) << 8) | ((unsigned)(q2 & 0xff) << 16) | ((unsigned)(q3 & 0xff) << 24)); }
#pragma unroll
        for (int o = 1; o < 64; o <<= 1) hs += shxi(hs, lane, o);
        const float hoff = 7.5f * (float)hs;
        const float su0 = SU[ev0], su1 = SU[ev1], sv0 = SV[ev0], sv1 = SV[ev1];
        float o[16];
#pragma unroll
        for (int k = 0; k < 16; ++k) o[k] = 0.f;
        int p[16], r0, r1, r2, r3, r4, r5, r6, r7;
        u32x2 A[16], B[16], C[16];
        G_LOAD(A, U, ev0, 0); G_LOAD(B, U, ev0, 16); G_SB();
        G_LOAD(C, U, ev0, 32); G_SB(); U_COMP(A); RED16(r0); G_SB();
        G_LOAD(A, U, ev0, 48); G_SB(); U_COMP(B); RED16(r1); G_SB();
        G_LOAD(B, U, ev1, 0); G_SB(); U_COMP(C); RED16(r2); G_SB();
        G_LOAD(C, U, ev1, 16); G_SB(); U_COMP(A); RED16(r3); G_SB();
        G_LOAD(A, U, ev1, 32); G_SB(); U_COMP(B); RED16(r4); G_SB();
        G_LOAD(B, U, ev1, 48); G_SB(); U_COMP(C); RED16(r5); G_SB();
        G_LOAD(C, Vtab, ev0, 0); G_SB(); U_COMP(A); RED16(r6); G_SB();
        G_LOAD(A, Vtab, ev0, 16); G_SB(); U_COMP(B); RED16(r7); G_SB();
        const int d0 = lg == 0 ? r0 : (lg == 1 ? r1 : (lg == 2 ? r2 : r3)), d1 = lg == 0 ? r4 : (lg == 1 ? r5 : (lg == 2 ? r6 : r7));
        float act0 = ((float)d0 - hoff) * (sh * su0), act1 = ((float)d1 - hoff) * (sh * su1);
#ifdef PROBE_NOFFN
        const float coef0 = 0.f * act0, coef1 = 0.f * act1;
#else
        const float coef0 = gv0 * (0.5f * act0 * (1.f + erff(act0 * 0.70710678118f))) * sv0, coef1 = gv1 * (0.5f * act1 * (1.f + erff(act1 * 0.70710678118f))) * sv1;
#endif
        G_SB();
        G_LOAD(B, Vtab, ev0, 32); G_SB(); V_COMP(C, coef0, 0); G_SB();
        G_LOAD(C, Vtab, ev0, 48); G_SB(); V_COMP(A, coef0, 16); G_SB();
        G_LOAD(A, Vtab, ev1, 0); G_SB(); V_COMP(B, coef0, 32); G_SB();
        G_LOAD(B, Vtab, ev1, 16); G_SB(); V_COMP(C, coef0, 48); G_SB();
        G_LOAD(C, Vtab, ev1, 32); G_SB(); V_COMP(A, coef1, 0); G_SB();
        G_LOAD(A, Vtab, ev1, 48); G_SB(); V_COMP(B, coef1, 16); G_SB();
        V_COMP(C, coef1, 32); G_SB(); V_COMP(A, coef1, 48); G_SB();
        const float corr = 7.5f * wave_sum(coef0 + coef1, lane);
        float* xr = X + (size_t)t * 1024 + 16 * lane;
        f32x4 xv[4];
#pragma unroll
        for (int k = 0; k < 4; ++k) { xv[k] = *(const f32x4*)(xr + 4 * k); xv[k] += (f32x4){o[4 * k] - corr, o[4 * k + 1] - corr, o[4 * k + 2] - corr, o[4 * k + 3] - corr}; }
        if (!dry) {
#pragma unroll
            for (int k = 0; k < 4; ++k) *(f32x4*)(xr + 4 * k) = xv[k]; }
        if (NEXT_NORM && !dry) {
            float ss = 0.f;
#pragma unroll
            for (int k = 0; k < 4; ++k) ss += (xv[k].x * xv[k].x + xv[k].y * xv[k].y) + (xv[k].z * xv[k].z + xv[k].w * xv[k].w);
            const float rstd = rsqrtf(wave_sum(ss, lane) * (1.f / 1024.f) + EPS);
            v4u wa, wb;
#pragma unroll
            for (int k = 0; k < 4; ++k) { const f32x4 g = *(const f32x4*)(gnext + 16 * lane + 4 * k); const unsigned lo = pk2(xv[k].x * rstd * g.x, xv[k].y * rstd * g.y), hi2 = pk2(xv[k].z * rstd * g.z, xv[k].w * rstd * g.w);
                if (k < 2) { wa[2 * k] = lo; wa[2 * k + 1] = hi2; } else { wb[2 * (k - 2)] = lo; wb[2 * (k - 2) + 1] = hi2; } }
            *(v4u*)(XN + (size_t)t * 1024 + 16 * lane) = wa; *(v4u*)(XN + (size_t)t * 1024 + 16 * lane + 8) = wb;
        }
    }
}

__device__ __forceinline__ void rms_quant_pass(const bf16* X, const float* g, bf16* XN, unsigned char* HQ, float* SH, float* HS, int gw, int NGW, int lane) {
    for (int m = gw; m < T; m += NGW) {
        const u32x2* xr = (const u32x2*)(X + (size_t)m * D) + lane; const f32x4* gr = (const f32x4*)g + lane;
        f32x4 v[4]; float s = 0.f;
#pragma unroll
        for (int j = 0; j < 4; ++j) { const u32x2 w = xr[64 * j]; v[j] = (f32x4){bf_lo(w.x), bf_hi(w.x), bf_lo(w.y), bf_hi(w.y)}; s += (v[j].x * v[j].x + v[j].y * v[j].y) + (v[j].z * v[j].z + v[j].w * v[j].w); }
        const float rstd = rsqrtf(wave_sum(s, lane) * (1.f / 1024.f) + EPS);
        float am = 0.f;
#pragma unroll
        for (int j = 0; j < 4; ++j) { const f32x4 gg = gr[64 * j]; v[j].x = v[j].x * rstd * gg.x; v[j].y = v[j].y * rstd * gg.y; v[j].z = v[j].z * rstd * gg.z; v[j].w = v[j].w * rstd * gg.w;
            am = fmaxf(am, fmaxf(fmaxf(fabsf(v[j].x), fabsf(v[j].y)), fmaxf(fabsf(v[j].z), fabsf(v[j].w)))); }
#pragma unroll
        for (int o = 1; o < 64; o <<= 1) am = fmaxf(am, shx(am, lane, o));
        const float hinv = am > 0.f ? 127.f / am : 0.f;
        int hs = 0;
        unsigned* q4 = (unsigned*)(HQ + (size_t)m * D) + lane;
#pragma unroll
        for (int j = 0; j < 4; ++j) { const int q0 = (int)rintf(v[j].x * hinv), q1 = (int)rintf(v[j].y * hinv), q2 = (int)rintf(v[j].z * hinv), q3 = (int)rintf(v[j].w * hinv); hs += (q0 + q1) + (q2 + q3);
            q4[64 * j] = ((unsigned)(q0 & 0xff)) | ((unsigned)(q1 & 0xff) << 8) | ((unsigned)(q2 & 0xff) << 16) | ((unsigned)(q3 & 0xff) << 24); }
#pragma unroll
        for (int o = 1; o < 64; o <<= 1) hs += shxi(hs, lane, o);
        if (lane == 0) { SH[m] = am * (1.f / 127.f); HS[m] = (float)hs; }
    }
}
__device__ __forceinline__ int dpp_add_quad(int d) {
    d += __builtin_amdgcn_update_dpp(0, d, 0xB1, 0xF, 0xF, true);
    d += __builtin_amdgcn_update_dpp(0, d, 0x4E, 0xF, 0xF, true);
    return d;
}
__device__ __forceinline__ int dpp_add_oct(int d) {
    d += __builtin_amdgcn_update_dpp(0, d, 0xB1, 0xF, 0xF, true);
    d += __builtin_amdgcn_update_dpp(0, d, 0x4E, 0xF, 0xF, true);
    d += __builtin_amdgcn_update_dpp(0, d, 0x141, 0xF, 0xF, true);
    return d;
}
#define G1_IDS(E_, H0_, H1_, it_) do { const int t_ = t0 + ((it_) >> 1), hf_ = (it_) & 1; const v4u* ep_ = (const v4u*)(EXPERTS + (size_t)t_ * 128 + 16 * oct + 8 * hf_); const v4u ea_ = ep_[0], eb_ = ep_[1]; \
    E_[0] = (int)ea_.x; E_[1] = (int)ea_.y; E_[2] = (int)ea_.z; E_[3] = (int)ea_.w; E_[4] = (int)eb_.x; E_[5] = (int)eb_.y; E_[6] = (int)eb_.z; E_[7] = (int)eb_.w; \
    H0_ = *(const v4u*)(HQ + (size_t)t_ * 1024 + 256 * s + 32 * q8); H1_ = *(const v4u*)(HQ + (size_t)t_ * 1024 + 256 * s + 32 * q8 + 16); } while (0)
#define G1_ROWS(R_, E_) do { _Pragma("unroll") for (int j_ = 0; j_ < 8; ++j_) R_[j_] = __builtin_amdgcn_raw_buffer_load_b128(rs_U, (E_[j_] << 9) + soff, 0, 0); } while (0)
#define G1_COMP(R_, H0_, H1_, it_) do { int dd_[8]; _Pragma("unroll") for (int j_ = 0; j_ < 8; ++j_) { \
    int d_ = __builtin_amdgcn_sdot4((int)(R_[j_].x & 0x0F0F0F0Fu), (int)H0_.x, 0, false); d_ = __builtin_amdgcn_sdot4((int)((R_[j_].x >> 4) & 0x0F0F0F0Fu), (int)H0_.y, d_, false); \
    d_ = __builtin_amdgcn_sdot4((int)(R_[j_].y & 0x0F0F0F0Fu), (int)H0_.z, d_, false); d_ = __builtin_amdgcn_sdot4((int)((R_[j_].y >> 4) & 0x0F0F0F0Fu), (int)H0_.w, d_, false); \
    d_ = __builtin_amdgcn_sdot4((int)(R_[j_].z & 0x0F0F0F0Fu), (int)H1_.x, d_, false); d_ = __builtin_amdgcn_sdot4((int)((R_[j_].z >> 4) & 0x0F0F0F0Fu), (int)H1_.y, d_, false); \
    d_ = __builtin_amdgcn_sdot4((int)(R_[j_].w & 0x0F0F0F0Fu), (int)H1_.z, d_, false); d_ = __builtin_amdgcn_sdot4((int)((R_[j_].w >> 4) & 0x0F0F0F0Fu), (int)H1_.w, d_, false); \
    dd_[j_] = dpp_add_oct(d_); } \
    if (q8 == 0) { v4u* pp_ = (v4u*)(PART + ((size_t)s * T + t0 + ((it_) >> 1)) * 128 + 16 * oct + 8 * ((it_) & 1)); pp_[0] = (v4u){(unsigned)dd_[0], (unsigned)dd_[1], (unsigned)dd_[2], (unsigned)dd_[3]}; pp_[1] = (v4u){(unsigned)dd_[4], (unsigned)dd_[5], (unsigned)dd_[6], (unsigned)dd_[7]}; } } while (0)
__device__ __forceinline__ void peer_g1_phase(const int wv, int vcu, const unsigned char* HQ, const int* EXPERTS, const unsigned char* U, int* PART) {
    int ln_; asm volatile("v_mbcnt_lo_u32_b32 %0, -1, 0\n\tv_mbcnt_hi_u32_b32 %0, -1, %0" : "=v"(ln_)); const int lane = ln_, oct = lane >> 3, q8 = lane & 7;
    const int s = vcu >> 6;
    const __amdgpu_buffer_rsrc_t rs_U = __builtin_amdgcn_make_buffer_rsrc((void*)U, (short)0, 16384 * 512, 0x00020000);
    const int soff = 128 * s + 16 * q8;
    const int t0 = 512 * (vcu & 63) + 64 * wv;
    int eA[8], eB[8]; v4u rA[8], rB[8], hA0, hA1, hB0, hB1, hC0, hC1;
    G1_IDS(eA, hA0, hA1, 0); G1_ROWS(rA, eA); G1_IDS(eB, hB0, hB1, 1);
#pragma unroll 1
    for (int i = 0; i < 128; i += 2) {
        G1_ROWS(rB, eB); __builtin_amdgcn_sched_barrier(0);
        G1_IDS(eA, hC0, hC1, (i + 2) & 127); __builtin_amdgcn_sched_barrier(0);
        G1_COMP(rA, hA0, hA1, i); __builtin_amdgcn_sched_barrier(0);
        G1_ROWS(rA, eA); hA0 = hC0; hA1 = hC1; __builtin_amdgcn_sched_barrier(0);
        G1_IDS(eB, hC0, hC1, (i + 3) & 127); __builtin_amdgcn_sched_barrier(0);
        G1_COMP(rB, hB0, hB1, i + 1); __builtin_amdgcn_sched_barrier(0);
        hB0 = hC0; hB1 = hC1;
    }
}
__device__ __forceinline__ void peer_g1b_phase(const int* PART, const int* EXPERTS, const float* GATESP, const float* SU, const float* SV, const float* SH, const float* HS, unsigned char* COEFQ, float* SCT, float* CS, int gw, int NGW, int lane) {
    for (int t = gw; t < T; t += NGW) {
        const float sh = SH[t], hoff = 7.5f * HS[t];
        float cf[2]; float am = 0.f;
#pragma unroll
        for (int h2 = 0; h2 < 2; ++h2) {
            const size_t idx = (size_t)t * 128 + 64 * h2 + lane;
            int d = 0;
#pragma unroll
            for (int x = 0; x < 4; ++x) d += PART[(size_t)x * T * 128 + idx];
            const int ev = EXPERTS[idx];
            const float act = ((float)d - hoff) * (sh * SU[ev]);
            cf[h2] = GATESP[idx] * (0.5f * act * (1.f + erff(act * 0.70710678118f))) * SV[ev];
            am = fmaxf(am, fabsf(cf[h2]));
        }
#pragma unroll
        for (int o = 1; o < 64; o <<= 1) am = fmaxf(am, shx(am, lane, o));
        const float inv = am > 0.f ? 127.f / am : 0.f;
        const int q0 = (int)rintf(cf[0] * inv), q1 = (int)rintf(cf[1] * inv);
        COEFQ[(size_t)t * 128 + lane] = (unsigned char)(q0 & 0xff); COEFQ[(size_t)t * 128 + 64 + lane] = (unsigned char)(q1 & 0xff);
        int cs = q0 + q1;
#pragma unroll
        for (int o = 1; o < 64; o <<= 1) cs += shxi(cs, lane, o);
        if (lane == 0) { SCT[t] = am * (1.f / 127.f); CS[t] = (float)cs; }
    }
}
#define G2_IDS(E_, C_, it_) do { const int t_ = t0 + ((it_) >> 1), hf_ = (it_) & 1; const v4u* ep_ = (const v4u*)(EXPERTS + (size_t)t_ * 128 + 16 * oct + 8 * hf_); const v4u ea_ = ep_[0], eb_ = ep_[1]; \
    E_[0] = (int)ea_.x; E_[1] = (int)ea_.y; E_[2] = (int)ea_.z; E_[3] = (int)ea_.w; E_[4] = (int)eb_.x; E_[5] = (int)eb_.y; E_[6] = (int)eb_.z; E_[7] = (int)eb_.w; \
    C_ = *(const u32x2*)(COEFQ + (size_t)t_ * 128 + 16 * oct + 8 * hf_); } while (0)
#define G2_ROWS(R_, E_) do { _Pragma("unroll") for (int j_ = 0; j_ < 8; ++j_) R_[j_] = __builtin_amdgcn_raw_buffer_load_b128(rs_V, (E_[j_] << 9) + soff, 0, 0); } while (0)
#define G2_T4(ob, w0, w1, w2, w3, cq_) do { const unsigned a_ = __builtin_amdgcn_perm(w1, w0, 0x05010400u), b_ = __builtin_amdgcn_perm(w1, w0, 0x07030602u), c_ = __builtin_amdgcn_perm(w3, w2, 0x05010400u), d_ = __builtin_amdgcn_perm(w3, w2, 0x07030602u); \
    const unsigned y0_ = __builtin_amdgcn_perm(c_, a_, 0x05040100u), y1_ = __builtin_amdgcn_perm(c_, a_, 0x07060302u), y2_ = __builtin_amdgcn_perm(d_, b_, 0x05040100u), y3_ = __builtin_amdgcn_perm(d_, b_, 0x07060302u); \
    o[(ob)] = __builtin_amdgcn_sdot4((int)(y0_ & 0x0F0F0F0Fu), cq_, o[(ob)], false); o[(ob) + 4] = __builtin_amdgcn_sdot4((int)((y0_ >> 4) & 0x0F0F0F0Fu), cq_, o[(ob) + 4], false); \
    o[(ob) + 1] = __builtin_amdgcn_sdot4((int)(y1_ & 0x0F0F0F0Fu), cq_, o[(ob) + 1], false); o[(ob) + 5] = __builtin_amdgcn_sdot4((int)((y1_ >> 4) & 0x0F0F0F0Fu), cq_, o[(ob) + 5], false); \
    o[(ob) + 2] = __builtin_amdgcn_sdot4((int)(y2_ & 0x0F0F0F0Fu), cq_, o[(ob) + 2], false); o[(ob) + 6] = __builtin_amdgcn_sdot4((int)((y2_ >> 4) & 0x0F0F0F0Fu), cq_, o[(ob) + 6], false); \
    o[(ob) + 3] = __builtin_amdgcn_sdot4((int)(y3_ & 0x0F0F0F0Fu), cq_, o[(ob) + 3], false); o[(ob) + 7] = __builtin_amdgcn_sdot4((int)((y3_ >> 4) & 0x0F0F0F0Fu), cq_, o[(ob) + 7], false); } while (0)
#define G2_REDI(N, S) do { const bool up_ = (lane & (S)) != 0; _Pragma("unroll") for (int j_ = 0; j_ < (N); ++j_) { const int a_ = o[j_], b_ = o[j_ + (N)]; const int send_ = up_ ? a_ : b_, keep_ = up_ ? b_ : a_; o[j_] = keep_ + shxi(send_, lane, (S)); } } while (0)
#define G2_COMP(R_, C_, it_) do { int o[32]; _Pragma("unroll") for (int k_ = 0; k_ < 32; ++k_) o[k_] = 0; \
    G2_T4(0, R_[0].x, R_[1].x, R_[2].x, R_[3].x, (int)C_.x); G2_T4(8, R_[0].y, R_[1].y, R_[2].y, R_[3].y, (int)C_.x); G2_T4(16, R_[0].z, R_[1].z, R_[2].z, R_[3].z, (int)C_.x); G2_T4(24, R_[0].w, R_[1].w, R_[2].w, R_[3].w, (int)C_.x); \
    G2_T4(0, R_[4].x, R_[5].x, R_[6].x, R_[7].x, (int)C_.y); G2_T4(8, R_[4].y, R_[5].y, R_[6].y, R_[7].y, (int)C_.y); G2_T4(16, R_[4].z, R_[5].z, R_[6].z, R_[7].z, (int)C_.y); G2_T4(24, R_[4].w, R_[5].w, R_[6].w, R_[7].w, (int)C_.y); \
    G2_REDI(16, 8); G2_REDI(8, 16); G2_REDI(4, 32); \
    const int tt_ = t0 + ((it_) >> 1); const float sc_ = SCT[tt_], corr_ = ((it_) & 1) ? 0.f : 7.5f * CS[tt_]; u32x2* xp_ = (u32x2*)(XR + (size_t)tt_ * 1024 + ocol); const u32x2 xw_ = *xp_; \
    f32x4 xv_ = (f32x4){bf_lo(xw_.x), bf_hi(xw_.x), bf_lo(xw_.y), bf_hi(xw_.y)}; \
    xv_.x += sc_ * ((float)o[0] - corr_); xv_.y += sc_ * ((float)o[1] - corr_); xv_.z += sc_ * ((float)o[2] - corr_); xv_.w += sc_ * ((float)o[3] - corr_); \
    if (!NEXT && ((it_) & 1)) { *(f32x4*)(OUT + (size_t)tt_ * 1024 + ocol) = xv_; } else { *xp_ = (u32x2){pk2(xv_.x, xv_.y), pk2(xv_.z, xv_.w)}; } \
    if (NEXT && ((it_) & 1)) { const float y0_ = bf_lo(pk2(xv_.x, 0.f)), y1_ = bf_lo(pk2(xv_.y, 0.f)), y2_ = bf_lo(pk2(xv_.z, 0.f)), y3_ = bf_lo(pk2(xv_.w, 0.f)); \
        const float ss_ = wave_sum((y0_ * y0_ + y1_ * y1_) + (y2_ * y2_ + y3_ * y3_), lane); if (lane == 0) SS[(size_t)s * T + tt_] = ss_; } } while (0)
template <bool NEXT>
__device__ __forceinline__ void peer_g2_phase(const int wv, int vcu, const int* EXPERTS, const unsigned char* COEFQ, const float* SCT, const float* CS, const unsigned char* Vtab, bf16* XR, float* OUT, float* SS) {
    int ln_; asm volatile("v_mbcnt_lo_u32_b32 %0, -1, 0\n\tv_mbcnt_hi_u32_b32 %0, -1, %0" : "=v"(ln_)); const int lane = ln_, oct = lane >> 3, q8 = lane & 7;
    const int s = vcu >> 6;
    const __amdgpu_buffer_rsrc_t rs_V = __builtin_amdgcn_make_buffer_rsrc((void*)Vtab, (short)0, 16384 * 512, 0x00020000);
    const int soff = 128 * s + 16 * q8;
    const int ocol = 256 * s + 32 * q8 + 16 * ((lane >> 3) & 1) + 8 * ((lane >> 4) & 1) + 4 * ((lane >> 5) & 1);
    const int t0 = 512 * (vcu & 63) + 64 * wv;
    int eA[8], eB[8]; u32x2 cA, cB, cC; v4u rA[8], rB[8];
    G2_IDS(eA, cA, 0); G2_ROWS(rA, eA); G2_IDS(eB, cB, 1);
#pragma unroll 1
    for (int i = 0; i < 128; i += 2) {
        G2_ROWS(rB, eB); __builtin_amdgcn_sched_barrier(0);
        G2_IDS(eA, cC, (i + 2) & 127); __builtin_amdgcn_sched_barrier(0);
        G2_COMP(rA, cA, i); __builtin_amdgcn_sched_barrier(0);
        G2_ROWS(rA, eA); cA = cC; __builtin_amdgcn_sched_barrier(0);
        G2_IDS(eB, cC, (i + 3) & 127); __builtin_amdgcn_sched_barrier(0);
        G2_COMP(rB, cB, i + 1); __builtin_amdgcn_sched_barrier(0);
        cB = cC;
    }
}

__device__ __forceinline__ void qknorm_rope_pass(bf16* Q1, bf16* K1, const float* qg, const float* kg, const float* rope, size_t gtid, size_t gthreads) {
    const size_t NROWS = (size_t)2 * 64 * 2 * 4096;
    const int lane = (int)(gtid & 63);
    for (size_t id = gtid; id < NROWS * 8; id += gthreads) {
        const size_t rowg = id >> 3; const int part = (int)(id & 7);
        const bool isk = rowg >= NROWS / 2; const size_t row = isk ? rowg - NROWS / 2 : rowg;
        bf16* ptr = (isk ? K1 : Q1) + row * 64 + part * 8; const float* g = (isk ? kg : qg) + part * 8;
        const int s = (int)(row & 4095); const int bh = (int)(row >> 13); const int bidx = bh >> 3; const size_t mtok = (size_t)bidx * 4096 + s;
        const v4u raw = *(const v4u*)ptr;
        float x[8];
#pragma unroll
        for (int i = 0; i < 4; ++i) { x[2 * i] = bf_lo(raw[i]); x[2 * i + 1] = bf_hi(raw[i]); }
        float ss = 0.f;
#pragma unroll
        for (int i = 0; i < 8; ++i) ss += x[i] * x[i];
        ss += shx(ss, lane, 1); ss += shx(ss, lane, 2); ss += shx(ss, lane, 4);
        const float rstd = rsqrtf(ss * (1.f / 64.f) + EPS);
        float y[8], other[8];
#pragma unroll
        for (int i = 0; i < 8; ++i) y[i] = x[i] * rstd * g[i];
#pragma unroll
        for (int i = 0; i < 8; ++i) other[i] = shx(y[i], lane, 1);
        if (part < 2) { const float* cs = rope + mtok * 16;
#pragma unroll
            for (int i = 0; i < 8; ++i) { const float co = cs[i], si = cs[8 + i]; y[i] = (part == 0) ? (y[i] * co - other[i] * si) : (y[i] * co + other[i] * si); } }
        const float sc = isk ? 1.f : (0.125f * 1.44269504089f);
        v4u o;
#pragma unroll
        for (int i = 0; i < 4; ++i) o[i] = pk2(y[2 * i] * sc, y[2 * i + 1] * sc);
        *(v4u*)ptr = o;
    }
}

#define AT_DMA(kt_, slot_) do { \
    _Pragma("unroll") for (int i_ = 0; i_ < 2; ++i_) { const int row_ = 8 * w + (lane >> 3), ch_ = (lane & 7) ^ ((row_ >> 1) & 7); \
        glds16(K1 + ((size_t)((bh * 2 + i_) * 4096 + (kt_) * 64 + row_)) * 64 + ch_ * 8, (unsigned)__builtin_amdgcn_readfirstlane((int)(ldsb + (slot_) * 32768 + i_ * 8192 + w * 1024))); } \
    _Pragma("unroll") for (int i_ = 0; i_ < 2; ++i_) { const int row_ = 8 * w + 4 * i_ + (lane >> 4), ch_ = (lane & 15) ^ ((row_ & 3) << 2); \
        glds16(V1 + ((size_t)(bh * 4096 + (kt_) * 64 + row_)) * 128 + ch_ * 8, (unsigned)__builtin_amdgcn_readfirstlane((int)(ldsb + (slot_) * 32768 + 16384 + w * 2048 + i_ * 1024))); } } while (0)
typedef short v4i16_t __attribute__((ext_vector_type(4)));
__device__ __forceinline__ bf16x8 vtr8(const LAS bf16* p) {
    const v4i16_t lo = __builtin_amdgcn_ds_read_tr16_b64_v4i16((LAS v4i16_t*)p), hi = __builtin_amdgcn_ds_read_tr16_b64_v4i16((LAS v4i16_t*)(p + 8 * 128));
    return (bf16x8){lo[0], lo[1], lo[2], lo[3], hi[0], hi[1], hi[2], hi[3]};
}
template <bool OFFS>
__device__ __forceinline__ void attn_units(const int wv, LAS unsigned char* lds, int vcu, const bf16* Q1, const bf16* K1, const bf16* V1, bf16* O, const float* subln, float lam, float offs) {
    int ln_; asm volatile("v_mbcnt_lo_u32_b32 %0, -1, 0\n\tv_mbcnt_hi_u32_b32 %0, -1, %0" : "=v"(ln_)); const int tid = wv * 64 + ln_, lane = tid & 63, w = wv, r32 = lane & 31, hi = lane >> 5, qt = w & 3, c = w >> 2;
    LAS float* lbuf = (LAS float*)(lds + 135168 + w * 128);
    LAS float* Obuf = (LAS float*)lds;
    if (wv >= 4) __builtin_amdgcn_s_setprio(1);
    const unsigned ldsb = (unsigned)(uintptr_t)lds;
#pragma unroll 1
    for (int ui = 0; ui < 8; ++ui) {
        const int bh = (vcu >> 5) * 8 + ui, qb = vcu & 31, b = bh >> 3, h = bh & 7;
        bf16x8 bq[4];
#pragma unroll
        for (int ks = 0; ks < 4; ++ks) bq[ks] = *(const bf16x8*)(Q1 + ((size_t)((bh * 2 + c) * 4096 + qb * 128 + qt * 32 + r32)) * 64 + ks * 16 + 8 * hi);
        f32x16 Oa[4];
#pragma unroll
        for (int db = 0; db < 4; ++db)
#pragma unroll
            for (int r = 0; r < 16; ++r) Oa[db][r] = 0.f;
        float lsum = 0.f;
        AT_DMA(0, 0); AT_DMA(1, 1);
        AT_WAIT_BAR();
        const int kx0 = (r32 >> 1) & 7, kx1 = ((32 + r32) >> 1) & 7;
        const int vrow = 4 * hi + ((lane >> 2) & 3), vg = (lane >> 4) & 1, vp = lane & 3;
        f32x16 s0, s1;
        { const LAS unsigned char* Kc = lds + c * 8192;
#pragma unroll
          for (int r = 0; r < 16; ++r) { s0[r] = 0.f; s1[r] = 0.f; }
#pragma unroll
          for (int ks = 0; ks < 4; ++ks) { const bf16x8 a0 = *(const LAS bf16x8*)(Kc + r32 * 128 + (((2 * ks + hi) ^ kx0) << 4)), a1 = *(const LAS bf16x8*)(Kc + (32 + r32) * 128 + (((2 * ks + hi) ^ kx1) << 4));
              s0 = mfma32(a0, bq[ks], s0); s1 = mfma32(a1, bq[ks], s1); } }
        int b0 = 0, b1 = 1, b2 = 2;
#pragma unroll 1
        for (int kt = 0; kt < 64; ++kt) {
            if (kt + 2 < 64) AT_DMA(kt + 2, b2);
            const LAS unsigned char* Kc = lds + b1 * 32768 + c * 8192;
            const LAS unsigned char* Vb = lds + b0 * 32768 + 16384 + vrow * 256 + 8 * (vp & 1);
            f32x16 n0, n1;
#pragma unroll
            for (int r = 0; r < 16; ++r) { n0[r] = 0.f; n1[r] = 0.f; }
            bf16x8 ka[8];
#define AT_KLD(ks_) do { ka[2 * (ks_)] = *(const LAS bf16x8*)(Kc + r32 * 128 + (((2 * (ks_) + hi) ^ kx0) << 4)); ka[2 * (ks_) + 1] = *(const LAS bf16x8*)(Kc + (32 + r32) * 128 + (((2 * (ks_) + hi) ^ kx1) << 4)); } while (0)
            AT_KLD(0); AT_KLD(1);
            __builtin_amdgcn_sched_barrier(0);
#pragma unroll
            for (int ks = 0; ks < 4; ++ks) {
                n0 = mfma32(ka[2 * ks], bq[ks], n0);
#pragma unroll
                for (int r = 0; r < 4; ++r) s0[4 * ks + r] = __builtin_amdgcn_exp2f(OFFS ? s0[4 * ks + r] - offs : s0[4 * ks + r]);
                __builtin_amdgcn_sched_barrier(0);
                n1 = mfma32(ka[2 * ks + 1], bq[ks], n1);
                if (ks < 2) AT_KLD(ks + 2);
#pragma unroll
                for (int r = 0; r < 4; ++r) s1[4 * ks + r] = __builtin_amdgcn_exp2f(OFFS ? s1[4 * ks + r] - offs : s1[4 * ks + r]);
                __builtin_amdgcn_sched_barrier(0);
            }
#undef AT_KLD
            bf16x8 pa[4]; bf16x8 vf[4], vn[4];
#pragma unroll
            for (int db = 0; db < 4; ++db) vf[db] = vtr8((const LAS bf16*)(Vb + (((4 * db + 2 * vg + (vp >> 1)) ^ ((vrow & 3) << 2)) << 4)));
            float ls = 0.f;
            { v4u t0;
#pragma unroll
              for (int k = 0; k < 4; ++k) { t0[k] = pk2(s0[2 * k], s0[2 * k + 1]); ls += s0[2 * k] + s0[2 * k + 1]; }
              pa[0] = __builtin_bit_cast(bf16x8, t0); }
            __builtin_amdgcn_sched_barrier(0);
#pragma unroll
            for (int sp_ = 0; sp_ < 4; ++sp_) {
                if (sp_ < 3) {
#pragma unroll
                    for (int db = 0; db < 4; ++db) vn[db] = vtr8((const LAS bf16*)(Vb + (16 * (sp_ + 1)) * 256 + (((4 * db + 2 * vg + (vp >> 1)) ^ ((vrow & 3) << 2)) << 4)));
                }
#pragma unroll
                for (int db = 0; db < 4; ++db) Oa[db] = mfma32(pa[sp_], vf[db], Oa[db]);
                if (sp_ < 3) { v4u t0;
#pragma unroll
                    for (int k = 0; k < 4; ++k) { const float x0 = (sp_ == 0) ? s0[8 + 2 * k] : (sp_ == 1 ? s1[2 * k] : s1[8 + 2 * k]), x1 = (sp_ == 0) ? s0[9 + 2 * k] : (sp_ == 1 ? s1[2 * k + 1] : s1[9 + 2 * k]); t0[k] = pk2(x0, x1); ls += x0 + x1; }
                    pa[sp_ + 1] = __builtin_bit_cast(bf16x8, t0); }
                __builtin_amdgcn_sched_barrier(0);
                if (sp_ < 3) {
#pragma unroll
                    for (int db = 0; db < 4; ++db) vf[db] = vn[db];
                }
            }
            lsum += ls;
            s0 = n0; s1 = n1;
            { const int tb = b0; b0 = b1; b1 = b2; b2 = tb; }
            AT_WAIT_BAR();
        }
        lsum += shx(lsum, lane, 32);
        lbuf[r32] = lsum;
#pragma unroll
        for (int r = 0; r < 16; ++r) { const int qrow = (r & 3) + 8 * (r >> 2) + 4 * hi; const float inv = 1.f / lbuf[qrow];
#pragma unroll
            for (int db = 0; db < 4; ++db) Obuf[(c * 128 + qt * 32 + qrow) * 132 + 32 * db + r32] = Oa[db][r] * inv; }
        __syncthreads();
        { const int row = tid >> 2, qd = tid & 3;
          float dv[32]; float ss = 0.f;
#pragma unroll
          for (int k = 0; k < 8; ++k) { const f32x4 o0 = *(const LAS f32x4*)(Obuf + row * 132 + qd * 32 + 4 * k), o1 = *(const LAS f32x4*)(Obuf + (128 + row) * 132 + qd * 32 + 4 * k);
#pragma unroll
              for (int e = 0; e < 4; ++e) { const float d = o0[e] - lam * o1[e]; dv[4 * k + e] = d; ss += d * d; } }
          ss += shx(ss, lane, 1); ss += shx(ss, lane, 2);
          const float rstd = rsqrtf(ss * (1.f / 128.f) + EPS) * (1.f - LAMBDA_INIT);
          bf16* op = O + ((size_t)b * 4096 + qb * 128 + row) * 1024 + h * 128 + qd * 32;
#pragma unroll
          for (int k = 0; k < 4; ++k) { v4u o;
#pragma unroll
              for (int e = 0; e < 4; ++e) o[e] = pk2(dv[8 * k + 2 * e] * rstd * subln[qd * 32 + 8 * k + 2 * e], dv[8 * k + 2 * e + 1] * rstd * subln[qd * 32 + 8 * k + 2 * e + 1]);
              *(v4u*)(op + 8 * k) = o; } }
        __syncthreads();
    }
    __builtin_amdgcn_s_setprio(0);
}
__device__ __forceinline__ void attn_phase(const int wv, LAS unsigned char* lds, int vcu, const bf16* Q1, const bf16* K1, const bf16* V1, bf16* O, const float* qg, const float* kg,
                                           const float* lq1, const float* lk1, const float* lq2, const float* lk2, const float* subln) {
    float s1 = 0.f, s2 = 0.f, mq = 0.f, mk = 0.f;
    for (int i = 0; i < 64; ++i) { s1 += lq1[i] * lk1[i]; s2 += lq2[i] * lk2[i]; mq = fmaxf(mq, fabsf(qg[i])); mk = fmaxf(mk, fabsf(kg[i])); }
    const float lam = expf(s1) - expf(s2) + LAMBDA_INIT;
    const float offs = 8.f * mq * mk * 1.44269504089f * 1.02f + 0.25f;
    if (offs < 24.f) attn_units<false>(wv, lds, vcu, Q1, K1, V1, O, subln, lam, 0.f);
    else attn_units<true>(wv, lds, vcu, Q1, K1, V1, O, subln, lam, offs);
}
#undef AT_LOAD
#undef AT_WRITE
struct Args { const void* in[27]; float* out; unsigned char* ws; };
#define KARG(i) ({ GAS const void* p_; asm volatile("s_load_dwordx2 %0, %1, %2\n\ts_waitcnt lgkmcnt(0)" : "=s"(p_) : "s"(__builtin_amdgcn_kernarg_segment_ptr()), "i"(8 * (i))); (const void*)p_; })
#define KIN(i) ((const float*)KARG(i))
#define KOUT() ((float*)KARG(27))
#define KWS() ((unsigned char*)KARG(28))
#define WSP(T_, off) ((T_*)(KWS() + (off)))
__global__ void __launch_bounds__(NWAVES * 64, 2) mk_fwd(Args args) {
    extern __shared__ __attribute__((aligned(16))) unsigned char lds_raw[];
    LAS unsigned char* lds = (LAS unsigned char*)lds_raw;
    const int G = gridDim.x, bx = blockIdx.x;
    const int wv = __builtin_amdgcn_readfirstlane((int)(threadIdx.x >> 6));
    const int vcu = (G % 8 == 0) ? (bx % 8) * (G / 8) + bx / 8 : bx;
#define PH_IDS() int ln_; asm volatile("v_mbcnt_lo_u32_b32 %0, -1, 0\n\tv_mbcnt_hi_u32_b32 %0, -1, %0" : "=v"(ln_)); const int lane = ln_, wave = wv, tid = wv * 64 + ln_; \
    const int gw = vcu * NWAVES + wave, NGW = G * NWAVES; const size_t gtid = (size_t)vcu * (NWAVES * 64) + tid, gthreads = (size_t)G * (NWAVES * 64); (void)lane; (void)gw; (void)NGW; (void)gtid; (void)gthreads
    if (threadIdx.x < 32) ((LAS unsigned*)(lds + MISC_OFF))[threadIdx.x] = 0u;
    __syncthreads();
    (void)xcd_barrier_post((unsigned*)(WSP(gu32, WS_CTL) + CW_BAR), (volatile LAS unsigned*)(lds + MISC_OFF) + 8);
#define STAMP() do {} while (0)
#ifndef PROBE_DUP
#define PROBE_DUP 0
#endif
#define REPS(bit) _Pragma("unroll 1") for (int rep_ = 0; rep_ < 1 + ((PROBE_DUP >> (bit)) & 1); ++rep_)
#define GRID_BAR1() do { XcdBarrier b_; b_.bar = (unsigned*)(WSP(gu32, WS_CTL) + CW_BAR); b_.x = xb_xcc_id(); b_.st = (volatile LAS unsigned*)(lds + MISC_OFF) + 8; xcd_barrier(b_); } while (0)
#define GRID_BAR() do { GRID_BAR1(); if ((PROBE_DUP >> 9) & 1) GRID_BAR1(); } while (0)

    REPS(5) {
        PH_IDS();
        LAS float* scr = (LAS float*)(lds + wave * 16384);
        constexpr int I0 = 16 * 97, I1 = 16 * 32, I2 = 16 * 64, I3 = 16 * 96, I4 = 16 * 32, I5 = 16 * 64, NITEMS = I0 + I1 + I2 + I3 + I4 + I5;
        for (int it = gw; it < NITEMS; it += NGW) {
            int r = it;
            if (r < I0) { p0_transpose_item(KIN(3), 1024, 3104, WSP(bf16, WS_WIN), scr, r, lane); continue; } r -= I0;
            if (r < I1) { p0_transpose_item(KIN(6), 1024, 1024, WSP(bf16, WS_WO0), scr, r, lane); continue; } r -= I1;
            if (r < I2) { p0_transpose_item(KIN(8), 1024, 2048, WSP(bf16, WS_WQ0), scr, r, lane); continue; } r -= I2;
            if (r < I3) { p0_transpose_item(KIN(13), 1024, 3072, WSP(bf16, WS_WQKV), scr, r, lane, KIN(12)); continue; } r -= I3;
            if (r < I4) { p0_transpose_item(KIN(21), 1024, 1024, WSP(bf16, WS_WO1), scr, r, lane); continue; } r -= I4;
            p0_transpose_item(KIN(23), 1024, 2048, WSP(bf16, WS_WQ1), scr, r, lane);
        }
        { bf16* WIN = WSP(bf16, WS_WIN); for (size_t i = gtid * 8; i < (size_t)224 * 1024; i += gthreads * 8) *(v4u*)(WIN + (size_t)3104 * 1024 + i) = (v4u){0u, 0u, 0u, 0u}; }
        cvt_range(KIN(9), WSP(bf16, WS_KEY0), (size_t)262144, gtid, gthreads);
        cvt_range(KIN(24), WSP(bf16, WS_KEY1), (size_t)262144, gtid, gthreads);
        rms_pass(KIN(0), KIN(2), WSP(bf16, WS_B0), gw, NGW, lane);
        { const int* positions = (const int*)KARG(1); float* ROPE = WSP(float, WS_ROPE);
          for (size_t id = gtid; id < (size_t)T * 8; id += gthreads) { const size_t mtok = id >> 3; const int i = (int)(id & 7);
            const float inv = powf(500000.0f, -(float)i * 2.0f / 16.0f); const float ang = (float)positions[mtok] * inv;
            float sn, cs; sincosf(ang, &sn, &cs); ROPE[mtok * 16 + i] = cs; ROPE[mtok * 16 + 8 + i] = sn; } }
    }
    GRID_BAR();
    REPS(3) {
        unsigned char* ws = KWS();
        pg8::Gemm g{(const bf16*)(ws + WS_B0), (const bf16*)(ws + WS_WIN), T, 3328, 1024}; pg8::StaticOrder S; S.init(T, 3328, G, bx);
        pg8::EpiInProj E{(bf16*)(ws + WS_R1), (bf16*)(ws + WS_R1 + 32 * MiB), (bf16*)(ws + WS_R2), (bf16*)(ws + WS_R3), (float*)(ws + WS_GATES), KIN(4)};
        pg8::gemm_phase<pg8::EpiInProj, pg8::StaticOrder, true, true>(lds, g, S, E, wv);
    }
    GRID_BAR();
    if ((bx >> 3) & 1) { PH_IDS(); const int gwi = ((bx >> 4) * 8 + (bx & 7)) * NWAVES + wave, NGWI = 128 * NWAVES; (void)gw; (void)NGW;
        quant4_rows(KIN(10), WSP(unsigned char, WS_U0), WSP(float, WS_SC), 16384, gwi, NGWI, lane);
        quant4_rows(KIN(11), WSP(unsigned char, WS_V0T), WSP(float, WS_SC + 65536), 16384, gwi, NGWI, lane);
        quant4_rows(KIN(25), WSP(unsigned char, WS_U1), WSP(float, WS_SC + 2 * 65536), 16384, gwi, NGWI, lane);
        quant4_rows(KIN(26), WSP(unsigned char, WS_V1T), WSP(float, WS_SC + 3 * 65536), 16384, gwi, NGWI, lane);
        quant8_rows_bf16(WSP(bf16, WS_WQ0), WSP(unsigned char, WS_I8), WSP(float, WS_I8 + 4 * MiB), 2048, gwi, NGWI, lane);
        quant8_rows_bf16(WSP(bf16, WS_WQ1), WSP(unsigned char, WS_I8 + 2 * MiB), WSP(float, WS_I8 + 4 * MiB + 8192), 2048, gwi, NGWI, lane); }
    REPS(2) { unsigned char* ws = KWS(); mlstm_phase(wv, lds, (const bf16*)(ws + WS_R1), (const bf16*)(ws + WS_R1 + 32 * MiB), (const bf16*)(ws + WS_R2), (const float*)(ws + WS_GATES), (bf16*)(ws + WS_R4), (bf16*)(ws + WS_R5)); }
    GRID_BAR();
    REPS(6) { PH_IDS(); unsigned char* ws = KWS(); hs_pass((const bf16*)(ws + WS_R4), (const bf16*)(ws + WS_R5), (const bf16*)(ws + WS_R3), KIN(5), (bf16*)(ws + WS_B0), gw, NGW, lane); }
    GRID_BAR();
#pragma unroll 1
    for (int L = 0; L < 2; ++L) {
        if (L == 1) {
            REPS(3) {
                unsigned char* ws = KWS();
                pg8::Gemm g{(const bf16*)(ws + WS_R1), (const bf16*)(ws + WS_WQKV), T, 3072, 1024}; pg8::StaticOrder S; S.init(T, 3072, G, bx);
                pg8::EpiQKV E{(bf16*)(ws + WS_R2), (bf16*)(ws + WS_R3), (bf16*)(ws + WS_R4), (const float*)(ws + 3 * MiB), KIN(14), KIN(15), (const float*)(ws + WS_ROPE), (LAS float*)(lds + 131072)};
                pg8::gemm_phase<pg8::EpiQKV, pg8::StaticOrder, true, true>(lds, g, S, E, wv);
            }
            GRID_BAR();
            REPS(0) { unsigned char* ws = KWS(); attn_phase(wv, lds, vcu, (const bf16*)(ws + WS_R2), (const bf16*)(ws + WS_R3), (const bf16*)(ws + WS_R4), (bf16*)(ws + WS_B0), KIN(14), KIN(15), KIN(16), KIN(17), KIN(18), KIN(19), KIN(20)); }
            GRID_BAR();
        }
        _Pragma("unroll 1") for (int rep_ = 0; rep_ < 1 + ((L == 0) ? ((PROBE_DUP >> 3) & 1) : 0); ++rep_) {
            unsigned char* ws = KWS();
            pg8::Gemm g{(const bf16*)(ws + WS_B0), (const bf16*)(ws + (L ? WS_WO1 : WS_WO0)), T, 1024, 1024}; pg8::StaticOrder S; S.init(T, 1024, G, bx);
            if (L == 0) { pg8::EpiRes<false> E{KIN(0), (bf16*)(ws + WS_R1)}; pg8::gemm_phase<pg8::EpiRes<false>, pg8::StaticOrder, true, true>(lds, g, S, E, wv); }
            else { pg8::EpiRes<true> E{ws + WS_R1, (bf16*)(ws + WS_R1)}; pg8::gemm_phase<pg8::EpiRes<true>, pg8::StaticOrder, true, true>(lds, g, S, E, wv); }
        }
        GRID_BAR();
        REPS(7) { PH_IDS(); unsigned char* ws = KWS(); rms_quant_pass((const bf16*)(ws + WS_R1), L ? KIN(22) : KIN(7), (bf16*)(ws + WS_B0), ws + WS_R5, (float*)(ws + WS_SC + 4 * 65536), (float*)(ws + WS_SC + 6 * 65536), gw, NGW, lane); }
        GRID_BAR();
        REPS(3) {
            unsigned char* ws = KWS();
            pg8::Gemm g{(const bf16*)(ws + WS_R5), (const bf16*)(ws + WS_I8 + (L ? 2 : 0) * MiB), T, 2048, 512}; pg8::StaticOrder S; S.init(T, 2048, G, bx);
            pg8::EpiPlainI8 E{(bf16*)(ws + WS_R2), 2048, (const float*)(ws + WS_SC + 4 * 65536), (const float*)(ws + WS_I8 + 4 * MiB + (L ? 8192 : 0))};
            pg8::gemm_phase<pg8::EpiPlainI8, pg8::StaticOrder, true, true>(lds, g, S, E, wv);
        }
        GRID_BAR();
        REPS(4) { unsigned char* ws = KWS(); peer_topk_phase(wv, lds, vcu, (const bf16*)(ws + WS_R2), (const bf16*)(ws + (L ? WS_KEY1 : WS_KEY0)), (int*)(ws + WS_R4), (float*)(ws + WS_R4 + 16 * MiB)); }
        GRID_BAR();
        REPS(1) { unsigned char* ws = KWS(); peer_g1_phase(wv, vcu, ws + WS_R5, (const int*)(ws + WS_R4), ws + (L ? WS_U1 : WS_U0), (int*)(ws + WS_R2)); }
        GRID_BAR();
        { PH_IDS(); unsigned char* ws = KWS(); const size_t so = L ? 2 * 65536 : 0;
          peer_g1b_phase((const int*)(ws + WS_R2), (const int*)(ws + WS_R4), (const float*)(ws + WS_R4 + 16 * MiB), (const float*)(ws + WS_SC + so), (const float*)(ws + WS_SC + so + 65536),
                         (const float*)(ws + WS_SC + 4 * 65536), (const float*)(ws + WS_SC + 6 * 65536), ws + WS_R4 + 32 * MiB, (float*)(ws + WS_SC + 10 * 65536), (float*)(ws + WS_SC + 8 * 65536), gw, NGW, lane); }
        GRID_BAR();
        if (L == 0) { unsigned char* ws = KWS(); peer_g2_phase<true>(wv, vcu, (const int*)(ws + WS_R4), ws + WS_R4 + 32 * MiB, (const float*)(ws + WS_SC + 10 * 65536), (const float*)(ws + WS_SC + 8 * 65536), ws + WS_V0T, (bf16*)(ws + WS_R1), nullptr, (float*)(ws + 3 * MiB)); GRID_BAR(); }
        else { unsigned char* ws = KWS(); peer_g2_phase<false>(wv, vcu, (const int*)(ws + WS_R4), ws + WS_R4 + 32 * MiB, (const float*)(ws + WS_SC + 10 * 65536), (const float*)(ws + WS_SC + 8 * 65536), ws + WS_V1T, (bf16*)(ws + WS_R1), KOUT(), nullptr); }
    }
#undef GRID_BAR
}

extern "C" void kernel_launch(void* const* d_in, const int* in_sizes, int n_in, void* d_out, int out_size, void* d_ws, size_t ws_size, hipStream_t stream) {
    static int ready = 0;
    if (ready == 0) {
        if (n_in != 27 || out_size != T * D || ws_size < WS_END) { fprintf(stderr, "kernel_launch: unexpected problem (n_in %d, out %d, ws %zu)\n", n_in, out_size, ws_size); ready = -1; return; }
        if (hipFuncSetAttribute((const void*)mk_fwd, hipFuncAttributeMaxDynamicSharedMemorySize, LDS_BYTES) != hipSuccess) { fprintf(stderr, "kernel_launch: hipFuncSetAttribute failed\n"); ready = -1; return; }
        (void)hipGetLastError();
        ready = 1;
    }
    if (ready < 0) return;
    if (hipMemsetAsync((char*)d_ws + WS_CTL, 0, CTL_ZERO_BYTES, stream) != hipSuccess) { fprintf(stderr, "kernel_launch: memset failed\n"); return; }
    Args a{};
    for (int i = 0; i < 27; ++i) a.in[i] = d_in[i];
    a.out = (float*)d_out; a.ws = (unsigned char*)d_ws;
    hipLaunchKernelGGL(mk_fwd, dim3(256), dim3(NWAVES * 64), LDS_BYTES, stream, a);
}
```

```cpp
#include <hip/hip_runtime.h>
#include <hip/hip_bf16.h>
#include <cstdio>
#include <cstdint>
#include <cmath>
namespace pg8 {
#define PG8_LAS __attribute__((address_space(3)))
typedef unsigned short bf16_t;
typedef short bf16x8 __attribute__((ext_vector_type(8)));
typedef float f32x4 __attribute__((ext_vector_type(4)));
typedef unsigned u32x4 __attribute__((ext_vector_type(4)));
constexpr int BM = 256, BK = 64, HALF = 128, HTB = HALF * BK * 2  , STAGE_BYTES = 8 * HTB, NXCD = 8, WGM = 8;

__host__ __device__ __forceinline__ int lds_byte(int r, int c) { const int st = (r >> 4) * 2 + (c >> 5), rr = r & 15, cc = c & 31, ob = rr * 64 + cc * 2; return st * 1024 + (ob ^ (((ob >> 9) & 1) << 5)); }
__host__ __device__ __forceinline__ void stage_rc(int b, int& R, int& C) { const int st = b / 1024, sb = b % 1024, swz = sb ^ (((sb >> 9) & 1) << 5); R = (st >> 1) * 16 + swz / 64; C = (st & 1) * 32 + (swz % 64) / 2; }
__host__ __device__ __forceinline__ int perm32(int rho) { const int n = rho >> 4, i = rho & 15; return 8 * (i >> 2) + 4 * n + (i & 3); }

struct Unit { int pm, pn; };
struct Gemm { const bf16_t* A; const bf16_t* Bt; int M, N, K; };

struct StaticOrder {
    int nM, nN, nwg, G, c;
    __host__ __device__ void init(int M, int N, int G_, int c_) { nM = M / BM; nN = N / BM; nwg = nM * nN; G = G_; c = c_; }
    __host__ __device__ bool next(int i, Unit& u) const {
        const long L = (long)i * G + c; if (L >= nwg) return false;
        int wgid = (int)L; { const int q = nwg / NXCD, r = nwg % NXCD, xcd = wgid % NXCD, off = wgid / NXCD; wgid = (xcd < r ? xcd * (q + 1) : r * (q + 1) + (xcd - r) * q) + off; }
        const int nig = WGM * nN, gid = wgid / nig, fm = gid * WGM, gsz = (nM - fm) < WGM ? (nM - fm) : WGM;
        u.pm = fm + ((wgid % nig) % gsz); u.pn = (wgid % nig) / gsz; return true;
    }
    __device__ __forceinline__ void a_ready(const Unit&) const {}
    __device__ __forceinline__ void done(const Unit&) const {}
};
__device__ __forceinline__ unsigned cvt_pk_bf16(float lo, float hi) { unsigned r; asm volatile("v_cvt_pk_bf16_f32 %0, %1, %2" : "=v"(r) : "v"(lo), "v"(hi)); return r; }
typedef float f32x2 __attribute__((ext_vector_type(2)));
typedef unsigned u32x2 __attribute__((ext_vector_type(2)));
typedef int i32x4 __attribute__((ext_vector_type(4)));
__device__ __forceinline__ u32x4 pack8(const f32x4 v0, const f32x4 v1) { u32x4 w; w.x = cvt_pk_bf16(v0[0], v0[1]); w.y = cvt_pk_bf16(v0[2], v0[3]); w.z = cvt_pk_bf16(v1[0], v1[1]); w.w = cvt_pk_bf16(v1[2], v1[3]); return w; }
struct EpiPlain {
    static constexpr bool PERM = true, AFTER_DRAIN = false, I8 = false;
    bf16_t* O; int ldc;
    __device__ __forceinline__ void operator()(const f32x4 (&acc)[2][2][4][2], const Unit& u, int wr, int wc, int fr, int fq) const {
        const int row0 = u.pm * BM + wr * 64 + fr, col0 = u.pn * BM + wc * 32 + 8 * fq;
#pragma unroll
        for (int ai = 0; ai < 2; ++ai)
#pragma unroll
            for (int m = 0; m < 4; ++m) { bf16_t* rowp = O + (size_t)(row0 + ai * HALF + m * 16) * ldc + col0;
#pragma unroll
                for (int bj = 0; bj < 2; ++bj) *(u32x4*)(rowp + bj * HALF) = pack8(acc[ai][bj][m][0], acc[ai][bj][m][1]); }
    }
};
struct EpiPlainI8 {
    static constexpr bool PERM = true, AFTER_DRAIN = false, I8 = true;
    bf16_t* O; int ldc; const float* rs; const float* cs;
    __device__ __forceinline__ void operator()(const f32x4 (&acc)[2][2][4][2], const Unit& u, int wr, int wc, int fr, int fq) const {
        const int row0 = u.pm * BM + wr * 64 + fr, col0 = u.pn * BM + wc * 32 + 8 * fq;
        f32x4 c0[2], c1[2];
#pragma unroll
        for (int bj = 0; bj < 2; ++bj) { c0[bj] = *(const f32x4*)(cs + col0 + bj * HALF); c1[bj] = *(const f32x4*)(cs + col0 + bj * HALF + 4); }
#pragma unroll
        for (int ai = 0; ai < 2; ++ai)
#pragma unroll
            for (int m = 0; m < 4; ++m) { const int row = row0 + ai * HALF + m * 16; const float r = rs[row]; bf16_t* rowp = O + (size_t)row * ldc + col0;
#pragma unroll
                for (int bj = 0; bj < 2; ++bj) { const i32x4 a0 = __builtin_bit_cast(i32x4, acc[ai][bj][m][0]), a1 = __builtin_bit_cast(i32x4, acc[ai][bj][m][1]);
                    const f32x4 v0 = (f32x4){(float)a0[0], (float)a0[1], (float)a0[2], (float)a0[3]} * r * c0[bj], v1 = (f32x4){(float)a1[0], (float)a1[1], (float)a1[2], (float)a1[3]} * r * c1[bj];
                    *(u32x4*)(rowp + bj * HALF) = pack8(v0, v1); } }
    }
};
template <bool BASE_BF16> struct EpiRes {
    static constexpr bool PERM = true, AFTER_DRAIN = false, I8 = false;
    const void* base; bf16_t* out;
    __device__ __forceinline__ void operator()(const f32x4 (&acc)[2][2][4][2], const Unit& u, int wr, int wc, int fr, int fq) const {
        const int col0 = u.pn * BM + wc * 32 + 8 * fq;
#pragma unroll
        for (int ai = 0; ai < 2; ++ai)
#pragma unroll
            for (int m = 0; m < 4; ++m) { const size_t off = (size_t)(u.pm * BM + ai * HALF + wr * 64 + m * 16 + fr) * 1024 + col0;
#pragma unroll
                for (int bj = 0; bj < 2; ++bj) { f32x4 b0, b1;
                    if (BASE_BF16) { const u32x4 w = *(const u32x4*)((const bf16_t*)base + off + bj * HALF);
                        b0 = (f32x4){__uint_as_float(w.x << 16), __uint_as_float(w.x & 0xffff0000u), __uint_as_float(w.y << 16), __uint_as_float(w.y & 0xffff0000u)};
                        b1 = (f32x4){__uint_as_float(w.z << 16), __uint_as_float(w.z & 0xffff0000u), __uint_as_float(w.w << 16), __uint_as_float(w.w & 0xffff0000u)}; }
                    else { b0 = *(const f32x4*)((const float*)base + off + bj * HALF); b1 = *(const f32x4*)((const float*)base + off + bj * HALF + 4); }
                    *(u32x4*)(out + off + bj * HALF) = pack8(b0 + acc[ai][bj][m][0], b1 + acc[ai][bj][m][1]); } }
    }
};
struct EpiInProj {
    static constexpr bool PERM = true, AFTER_DRAIN = false, I8 = true;
    bf16_t *Q, *Kk, *V, *OG; float* gates; const float* bg; const float* rs; const float* cs;
    __device__ __forceinline__ void operator()(const f32x4 (&acc)[2][2][4][2], const Unit& u, int wr, int wc, int fr, int fq) const {
        const int colt = u.pn * BM;
        f32x4 c0[2], c1[2];
#pragma unroll
        for (int bj = 0; bj < 2; ++bj) { const int cb = colt + bj * HALF + wc * 32 + 8 * fq; c0[bj] = *(const f32x4*)(cs + cb); c1[bj] = *(const f32x4*)(cs + cb + 4); }
#pragma unroll
        for (int ai = 0; ai < 2; ++ai)
#pragma unroll
            for (int m = 0; m < 4; ++m) { const int row = u.pm * BM + ai * HALF + wr * 64 + m * 16 + fr, b = row >> 12, s = row & 4095; const float r = rs[row];
#pragma unroll
                for (int bj = 0; bj < 2; ++bj) { const int cb = colt + bj * HALF + wc * 32 + 8 * fq;
                    const i32x4 a0 = __builtin_bit_cast(i32x4, acc[ai][bj][m][0]), a1 = __builtin_bit_cast(i32x4, acc[ai][bj][m][1]);
                    f32x4 v0 = (f32x4){(float)a0[0], (float)a0[1], (float)a0[2], (float)a0[3]} * r * c0[bj], v1 = (f32x4){(float)a1[0], (float)a1[1], (float)a1[2], (float)a1[3]} * r * c1[bj];
                    if (colt < 1024) { const bool isq = colt < 512; bf16_t* base = isq ? Q : Kk; const int c2 = cb & 511, head = c2 >> 6, d = c2 & 63;
                        if (isq) { v0 = v0 * 0.125f; v1 = v1 * 0.125f; }
                        *(u32x4*)(base + ((size_t)((b * 8 + head) * 4096 + s)) * 64 + d) = pack8(v0, v1); }
                    else if (colt < 2048) { const int c2 = cb - 1024, head = c2 >> 7, dv = c2 & 127; *(u32x4*)(V + ((size_t)((b * 8 + head) * 4096 + s)) * 128 + dv) = pack8(v0, v1); }
                    else if (colt < 3072) { *(u32x4*)(OG + (size_t)row * 1024 + (cb - 2048)) = pack8(v0, v1); }
                    else if (cb < 3104) { const int gi = cb - 3072; float* g = gates + (size_t)row * 32 + gi;
                        *(f32x4*)g = v0 + *(const f32x4*)(bg + gi); *(f32x4*)(g + 4) = v1 + *(const f32x4*)(bg + gi + 4); } } }
    }
};
struct EpiQKV {
    static constexpr bool PERM = true, AFTER_DRAIN = false, I8 = false;
    bf16_t *Q, *Kk, *V; const float* SS; const float* qg; const float* kg; const float* rope; PG8_LAS float* xch;
    __device__ __forceinline__ void operator()(const f32x4 (&acc)[2][2][4][2], const Unit& u, int wr, int wc, int fr_, int fq_) const {
        int fr = fr_, fq = fq_; asm volatile("" : "+v"(fr), "+v"(fq));
        const int colt = u.pn * BM, lane = fq * 16 + fr, wave = wr * 4 + wc;
        float rsr[2][4];
#pragma unroll
        for (int ai = 0; ai < 2; ++ai)
#pragma unroll
            for (int m = 0; m < 4; ++m) { const int row = u.pm * BM + ai * HALF + wr * 64 + m * 16 + fr;
                rsr[ai][m] = __builtin_amdgcn_rsqf(((SS[row] + SS[32768 + row]) + (SS[2 * 32768 + row] + SS[3 * 32768 + row])) * (1.f / 1024.f) + 1e-6f); }
        if (colt >= 2048) {
#pragma unroll
            for (int ai = 0; ai < 2; ++ai)
#pragma unroll
                for (int m = 0; m < 4; ++m) { const int row = u.pm * BM + ai * HALF + wr * 64 + m * 16 + fr, b = row >> 12, s = row & 4095; const float rs = rsr[ai][m];
#pragma unroll
                    for (int bj = 0; bj < 2; ++bj) { const int cb = colt + bj * HALF + wc * 32 + 8 * fq; const int c2 = cb - 2048, head = c2 >> 7, dv = c2 & 127;
                        *(u32x4*)(V + ((size_t)((b * 8 + head) * 4096 + s)) * 128 + dv) = pack8(acc[ai][bj][m][0] * rs, acc[ai][bj][m][1] * rs); } }
            return;
        }
#pragma unroll
        for (int ai = 0; ai < 2; ++ai)
#pragma unroll
            for (int m = 0; m < 4; ++m)
#pragma unroll
                for (int bj = 0; bj < 2; ++bj) { const f32x4 a = acc[ai][bj][m][0] * rsr[ai][m], c = acc[ai][bj][m][1] * rsr[ai][m];
                    float ss = ((a[0] * a[0] + a[1] * a[1]) + (a[2] * a[2] + a[3] * a[3])) + ((c[0] * c[0] + c[1] * c[1]) + (c[2] * c[2] + c[3] * c[3]));
                    ss += __uint_as_float((unsigned)__builtin_amdgcn_ds_bpermute((lane ^ 16) << 2, (int)__float_as_uint(ss)));
                    ss += __uint_as_float((unsigned)__builtin_amdgcn_ds_bpermute((lane ^ 32) << 2, (int)__float_as_uint(ss)));
                    if (fq == 0) xch[(((wave * 2 + ai) * 4 + m) * 2 + bj) * 16 + fr] = ss; }
        __syncthreads();
        const bool isq = colt < 1024; bf16_t* base = isq ? Q : Kk; const float* gn = isq ? qg : kg; const float osc = isq ? (0.125f * 1.44269504089f) : 1.f;
        const int d0 = 32 * (wc & 1) + 8 * fq;
        const f32x4 g0 = *(const f32x4*)(gn + d0), g1 = *(const f32x4*)(gn + d0 + 4);
        const bool rot = ((wc & 1) == 0) && (fq < 2);
#pragma unroll
        for (int ai = 0; ai < 2; ++ai)
#pragma unroll
            for (int m = 0; m < 4; ++m) { const int row = u.pm * BM + ai * HALF + wr * 64 + m * 16 + fr, b = row >> 12, s = row & 4095;
                f32x4 co0 = {0.f, 0.f, 0.f, 0.f}, co1 = co0, si0 = co0, si1 = co0;
                if (rot) { const float* cs = rope + (size_t)row * 16; co0 = *(const f32x4*)cs; co1 = *(const f32x4*)(cs + 4); si0 = *(const f32x4*)(cs + 8); si1 = *(const f32x4*)(cs + 12); }
#pragma unroll
                for (int bj = 0; bj < 2; ++bj) { const float tot = xch[(((wave * 2 + ai) * 4 + m) * 2 + bj) * 16 + fr] + xch[((((wave ^ 1) * 2 + ai) * 4 + m) * 2 + bj) * 16 + fr];
                    const float rn = __builtin_amdgcn_rsqf(tot * (1.f / 64.f) + 1e-6f) * rsr[ai][m];
                    f32x4 y0 = acc[ai][bj][m][0] * rn * g0, y1 = acc[ai][bj][m][1] * rn * g1;
                    f32x4 p0, p1;
#pragma unroll
                    for (int i = 0; i < 4; ++i) { p0[i] = __uint_as_float((unsigned)__builtin_amdgcn_ds_bpermute((lane ^ 16) << 2, (int)__float_as_uint(y0[i]))); p1[i] = __uint_as_float((unsigned)__builtin_amdgcn_ds_bpermute((lane ^ 16) << 2, (int)__float_as_uint(y1[i]))); }
                    if (rot) { const float sg = (fq == 0) ? -1.f : 1.f; y0 = y0 * co0 + p0 * si0 * sg; y1 = y1 * co1 + p1 * si1 * sg; }
                    const int cb = colt + bj * HALF + wc * 32 + 8 * fq; const int c2 = cb & 1023, head = c2 >> 7, c = (c2 >> 6) & 1, d = c2 & 63;
                    *(u32x4*)(base + ((size_t)(((b * 8 + head) * 2 + c) * 4096 + s)) * 64 + d) = pack8(y0 * osc, y1 * osc); } }
    }
};

template <bool I8> __device__ __forceinline__ f32x4 mma_sel(bf16x8 a, bf16x8 b, f32x4 c) {
    if constexpr (I8) return __builtin_bit_cast(f32x4, __builtin_amdgcn_mfma_i32_16x16x64_i8(__builtin_bit_cast(i32x4, a), __builtin_bit_cast(i32x4, b), __builtin_bit_cast(i32x4, c), 0, 0, 0));
    else return __builtin_amdgcn_mfma_f32_16x16x32_bf16(a, b, c, 0, 0, 0);
}
template <class Epi, class Sched, bool ALIGN_EPI = false, bool SP2 = false>
__device__ __forceinline__ void gemm_phase(PG8_LAS unsigned char* lds, const Gemm g, const Sched& S, const Epi& E, const int wv) {
    int ln_; asm volatile("v_mbcnt_lo_u32_b32 %0, -1, 0\n\tv_mbcnt_hi_u32_b32 %0, -1, %0" : "=v"(ln_)); const int tid = wv * 64 + ln_, wid = wv, lane = tid & 63, wr = wid >> 2, wc = wid & 3, fr = lane & 15, fq = lane >> 4;
    const int K = g.K, nt = K / BK;
    unsigned voffA[2], voffB[2];
#pragma unroll
    for (int i = 0; i < 2; ++i) { int R, C; stage_rc(tid * 16 + i * 8192, R, C); const int Rb = Epi::PERM ? ((R & ~31) + perm32(R & 31)) : R;
        voffA[i] = (unsigned)(R * K + C) * 2u; voffB[i] = (unsigned)(Rb * K + C) * 2u; }
    const size_t kstep = (size_t)(BK * 2);
    const size_t hstep = (size_t)HALF * K * 2;
    const size_t tstep = 2 * hstep;
    const unsigned ldsw = (unsigned)wid * 1024u;
    const int aoff = lds_byte(wr * 64 + fr, fq * 8), boff = lds_byte(wc * 32 + fr, fq * 8);
#define PG8_SA(b, h) (((b) * 2 + (h)) * HTB)
#define PG8_SB(b, h) ((4 + (b) * 2 + (h)) * HTB)
#define PG8_STAGE(bufoff, gbase, voff) do { _Pragma("unroll") for (int _i = 0; _i < 2; ++_i) \
        __builtin_amdgcn_global_load_lds((const unsigned*)((const char*)(gbase) + (voff)[_i]), (PG8_LAS unsigned*)(lds + (bufoff) + ldsw + _i * 8192), 16, 0, 0); } while (0)
#define PG8_LDA(dst, b, h) do { _Pragma("unroll") for (int m = 0; m < 4; ++m) _Pragma("unroll") for (int k = 0; k < 2; ++k) dst[m][k] = *(const PG8_LAS bf16x8*)(lds + PG8_SA(b, h) + aoff + m * 2048 + k * 1024); } while (0)
#define PG8_LDB(dst, b, h) do { _Pragma("unroll") for (int n = 0; n < 2; ++n) _Pragma("unroll") for (int k = 0; k < 2; ++k) dst[n][k] = *(const PG8_LAS bf16x8*)(lds + PG8_SB(b, h) + boff + n * 2048 + k * 1024); } while (0)
#define PG8_MMA(ai, bj, At, Bt) do { __builtin_amdgcn_s_setprio(1); _Pragma("unroll") for (int m = 0; m < 4; ++m) _Pragma("unroll") for (int n = 0; n < 2; ++n) _Pragma("unroll") for (int k = 0; k < 2; ++k) \
        acc[ai][bj][m][n] = mma_sel<Epi::I8>(Bt[n][k], At[m][k], acc[ai][bj][m][n]); __builtin_amdgcn_s_setprio(0); } while (0)
#define PG8_WAIT_V(n) asm volatile("s_waitcnt vmcnt(" #n ")" ::: "memory")
#define PG8_WAIT_L(n) asm volatile("s_waitcnt lgkmcnt(" #n ")" ::: "memory")
#define PG8_BAR __builtin_amdgcn_s_barrier()
#define PG8_SCHED __builtin_amdgcn_sched_barrier(0)
    Unit cur, nxt; int ui = 0;
    if (!S.next(0, cur)) return;
    f32x4 acc[2][2][4][2];
#pragma unroll
    for (int a = 0; a < 2; ++a)
#pragma unroll
        for (int b = 0; b < 2; ++b)
#pragma unroll
            for (int m = 0; m < 4; ++m)
#pragma unroll
                for (int n = 0; n < 2; ++n) acc[a][b][m][n] = (f32x4){0.f, 0.f, 0.f, 0.f};
    bf16x8 At[4][2], B0[2][2], B1[2][2];
    const char* cA = (const char*)g.A + (size_t)cur.pm * tstep; const char* cB = (const char*)g.Bt + (size_t)cur.pn * tstep;
    S.a_ready(cur);
    if constexpr (SP2) {
        PG8_STAGE(PG8_SB(0, 0), cB, voffB); PG8_STAGE(PG8_SB(0, 1), cB + hstep, voffB); PG8_STAGE(PG8_SA(0, 0), cA, voffA); PG8_STAGE(PG8_SA(0, 1), cA + hstep, voffA);
        if (wr == 1) PG8_BAR;
        PG8_WAIT_V(2); PG8_BAR;
        PG8_STAGE(PG8_SB(1, 0), cB + kstep, voffB); PG8_STAGE(PG8_SA(1, 0), cA + kstep, voffA); PG8_STAGE(PG8_SB(1, 1), cB + hstep + kstep, voffB);
        PG8_WAIT_V(6); PG8_BAR;
    } else {
        PG8_STAGE(PG8_SB(0, 0), cB, voffB); PG8_STAGE(PG8_SA(0, 0), cA, voffA); PG8_STAGE(PG8_SB(0, 1), cB + hstep, voffB); PG8_STAGE(PG8_SA(0, 1), cA + hstep, voffA);
        if (wr == 1) PG8_BAR;
        PG8_WAIT_V(4); PG8_BAR;
        PG8_STAGE(PG8_SB(1, 0), cB + kstep, voffB); PG8_STAGE(PG8_SA(1, 0), cA + kstep, voffA); PG8_STAGE(PG8_SB(1, 1), cB + hstep + kstep, voffB);
        PG8_WAIT_V(6); PG8_BAR;
    }
    for (;;) {
        const bool has_next = S.next(ui + 1, nxt);
        const char* nA = has_next ? (const char*)g.A + (size_t)nxt.pm * tstep : cA; const char* nB = has_next ? (const char*)g.Bt + (size_t)nxt.pn * tstep : cB;
        for (int t = 0; t < nt; t += 2) {
            const bool last = (t == nt - 2);
            const char* a1 = cA + (size_t)(t + 1) * kstep;
            const char* a2 = last ? nA : cA + (size_t)(t + 2) * kstep; const char* b2 = last ? nB : cB + (size_t)(t + 2) * kstep;
            const char* a3 = a2 + kstep; const char* b3 = b2 + kstep;
            if (last && has_next) S.a_ready(nxt);
            if constexpr (SP2) {
            PG8_LDB(B0, 0, 0); PG8_LDB(B1, 0, 1); PG8_SCHED; PG8_LDA(At, 0, 0); PG8_STAGE(PG8_SA(1, 1), a1 + hstep, voffA);
            PG8_WAIT_V(8); PG8_WAIT_L(0); PG8_BAR; PG8_MMA(0, 0, At, B0); PG8_MMA(0, 1, At, B1); PG8_BAR; PG8_SCHED;
            PG8_LDA(At, 0, 1); PG8_STAGE(PG8_SB(0, 0), b2, voffB); PG8_STAGE(PG8_SB(0, 1), b2 + hstep, voffB); PG8_STAGE(PG8_SA(0, 0), a2, voffA);
            PG8_WAIT_V(8); PG8_WAIT_L(0); PG8_BAR; PG8_MMA(1, 0, At, B0); PG8_MMA(1, 1, At, B1); PG8_BAR; PG8_SCHED;
            PG8_LDB(B0, 1, 0); PG8_LDB(B1, 1, 1); PG8_SCHED; PG8_LDA(At, 1, 0); PG8_STAGE(PG8_SA(0, 1), a2 + hstep, voffA);
            PG8_WAIT_V(8); PG8_WAIT_L(0); PG8_BAR; PG8_MMA(0, 0, At, B0); PG8_MMA(0, 1, At, B1); PG8_BAR; PG8_SCHED;
            PG8_LDA(At, 1, 1); PG8_STAGE(PG8_SB(1, 0), b3, voffB); PG8_STAGE(PG8_SB(1, 1), b3 + hstep, voffB); PG8_STAGE(PG8_SA(1, 0), a3, voffA);
            PG8_WAIT_V(8); PG8_WAIT_L(0); PG8_BAR; PG8_MMA(1, 0, At, B0); PG8_MMA(1, 1, At, B1); PG8_BAR; PG8_SCHED;
            } else {
            PG8_LDB(B0, 0, 0); PG8_SCHED; PG8_LDA(At, 0, 0); PG8_STAGE(PG8_SA(1, 1), a1 + hstep, voffA);
            PG8_WAIT_L(8); PG8_BAR; PG8_WAIT_L(0); PG8_MMA(0, 0, At, B0); PG8_BAR; PG8_SCHED;
            PG8_LDB(B1, 0, 1); PG8_STAGE(PG8_SB(0, 0), b2, voffB);
            PG8_BAR; PG8_WAIT_L(0); PG8_MMA(0, 1, At, B1); PG8_BAR;
            PG8_LDA(At, 0, 1); PG8_STAGE(PG8_SA(0, 0), a2, voffA);
            PG8_BAR; PG8_WAIT_L(0); PG8_MMA(1, 0, At, B0); PG8_BAR; PG8_SCHED;
            PG8_STAGE(PG8_SB(0, 1), b2 + hstep, voffB);
            PG8_WAIT_V(6); PG8_BAR; PG8_MMA(1, 1, At, B1); PG8_BAR;
            PG8_LDB(B0, 1, 0); PG8_SCHED; PG8_LDA(At, 1, 0); PG8_STAGE(PG8_SA(0, 1), a2 + hstep, voffA);
            PG8_WAIT_L(8); PG8_BAR; PG8_WAIT_L(0); PG8_MMA(0, 0, At, B0); PG8_BAR; PG8_SCHED;
            PG8_LDB(B1, 1, 1); PG8_STAGE(PG8_SB(1, 0), b3, voffB);
            PG8_BAR; PG8_WAIT_L(0); PG8_MMA(0, 1, At, B1); PG8_BAR;
            PG8_LDA(At, 1, 1); PG8_STAGE(PG8_SA(1, 0), a3, voffA);
            PG8_BAR; PG8_WAIT_L(0); PG8_MMA(1, 0, At, B0); PG8_BAR; PG8_SCHED;
            PG8_STAGE(PG8_SB(1, 1), b3 + hstep, voffB);
            PG8_WAIT_V(6); PG8_BAR; PG8_MMA(1, 1, At, B1); PG8_BAR;
            }
        }
        if constexpr (ALIGN_EPI) { if (wr == 0) PG8_BAR; }
        if constexpr (!Epi::AFTER_DRAIN) { E(acc, cur, wr, wc, fr, fq); S.done(cur); }
        if (!has_next) break;
#pragma unroll
        for (int a = 0; a < 2; ++a)
#pragma unroll
            for (int b = 0; b < 2; ++b)
#pragma unroll
                for (int m = 0; m < 4; ++m)
#pragma unroll
                    for (int n = 0; n < 2; ++n) acc[a][b][m][n] = (f32x4){0.f, 0.f, 0.f, 0.f};
        cur = nxt; cA = nA; cB = nB; ++ui;
        if constexpr (ALIGN_EPI) { if (wr == 1) PG8_BAR; }
    }
    PG8_WAIT_V(0);
    if constexpr (!ALIGN_EPI) { if (wr == 0) PG8_BAR; }
    PG8_BAR;
    if constexpr (Epi::AFTER_DRAIN) { E.fused(acc, cur, wr, wc, fr, fq, lds, wid, lane); S.done(cur); }
#undef PG8_SA
#undef PG8_SB
#undef PG8_STAGE
#undef PG8_LDA
#undef PG8_LDB
#undef PG8_MMA
#undef PG8_WAIT_V
#undef PG8_WAIT_L
#undef PG8_BAR
#undef PG8_SCHED
}
}
#define GAS __attribute__((address_space(1)))
#define LAS __attribute__((address_space(3)))
typedef unsigned short bf16;
typedef unsigned v4u __attribute__((ext_vector_type(4)));
typedef float f32x4 __attribute__((ext_vector_type(4)));
typedef short bf16x8 __attribute__((ext_vector_type(8)));
typedef GAS unsigned gu32;
typedef GAS unsigned long long gu64;
#define RLX_AGENT __ATOMIC_RELAXED, __HIP_MEMORY_SCOPE_AGENT
#define LDS_WAIT() asm volatile("s_waitcnt lgkmcnt(0)" ::: "memory")
#define VM_WAIT() asm volatile("s_waitcnt vmcnt(0)" ::: "memory")
__device__ __forceinline__ unsigned long long rt() { return __builtin_amdgcn_s_memrealtime(); }
typedef float f32x2_cv __attribute__((ext_vector_type(2))); typedef __bf16 bf16x2_cv __attribute__((ext_vector_type(2)));
__device__ __forceinline__ unsigned pk2(float lo, float hi) { const f32x2_cv v = {lo, hi}; const bf16x2_cv b = __builtin_convertvector(v, bf16x2_cv); return __builtin_bit_cast(unsigned, b); }
__device__ __forceinline__ unsigned f2bf(float f) { return pk2(f, 0.f) & 0xffffu; }

#define XB_TMO      128
#define XB_XCNT(j)  (256  + 64 * (j))
#define XB_XSUB(j)  (1280 + 64 * (j))
#define XB_XGEN(j)  (2304 + 64 * (j))
#define XB_TOP      3328
#define XB_TOPGEN   3392
#define XCD_BAR_WORDS 3456
#define XB_SPIN_CAP (1u << 18)

__device__ __forceinline__ unsigned xb_ld(unsigned* p)              { return __hip_atomic_load(p, __ATOMIC_RELAXED, __HIP_MEMORY_SCOPE_AGENT); }
__device__ __forceinline__ unsigned xb_add(unsigned* p, unsigned v) { return __hip_atomic_fetch_add(p, v, __ATOMIC_RELAXED, __HIP_MEMORY_SCOPE_AGENT); }
__device__ __forceinline__ unsigned xb_xcc_id() { return (unsigned)__builtin_amdgcn_s_getreg((3 << 11) | 20) & 0xFu; }
#define XB_SPIN(cond, bar) do { unsigned _sp = 0; while (cond) { __builtin_amdgcn_s_sleep(1); \
    if ((++_sp & 255u) == 0u) { if (xb_ld(&(bar)[XB_TMO])) break; if (_sp > XB_SPIN_CAP) { atomicAdd(&(bar)[XB_TMO], 1u); break; } } } } while (0)

struct XcdBarrier {
    unsigned* bar; unsigned x;
    volatile LAS unsigned* st;
};

__device__ __forceinline__ XcdBarrier xcd_barrier_post(unsigned* bar, volatile LAS unsigned* st) {
    XcdBarrier b; b.bar = bar; b.x = xb_xcc_id(); b.st = st;
    if (threadIdx.x == 0) (void)xb_add(&bar[XB_XCNT(b.x)], 1u);
    return b;
}
__device__ __forceinline__ void xcd_barrier_complete(unsigned* bar, unsigned x, unsigned& nloc, unsigned& nx) {
    const unsigned G = gridDim.x * gridDim.y * gridDim.z;
    unsigned sum, cnt, mine, sp = 0u;
    for (;;) {
        sum = 0u; cnt = 0u; mine = 0u;
#pragma unroll
        for (unsigned j = 0; j < 16; ++j) { const unsigned c = xb_ld(&bar[XB_XCNT(j)]); sum += c; cnt += (c > 0u) ? 1u : 0u; mine = (j == x) ? c : mine; }
        if (sum == G) break;
        __builtin_amdgcn_s_sleep(1);
        if ((++sp & 255u) == 0u) { if (xb_ld(&bar[XB_TMO])) break; if (sp > XB_SPIN_CAP) { atomicAdd(&bar[XB_TMO], 1u); break; } }
    }
    nloc = mine > 0u ? mine : 1u; nx = cnt > 0u ? cnt : 1u;
}

__device__ __forceinline__ void xcd_barrier(const XcdBarrier& b) {
    asm volatile("s_waitcnt vmcnt(0)" ::: "memory");
    __syncthreads();
    if (threadIdx.x == 0) {
        unsigned* bar = b.bar;
        __builtin_amdgcn_s_waitcnt(0);
        unsigned nloc = b.st[0], nx = b.st[1];
        if (nloc == 0u) { xcd_barrier_complete(bar, b.x, nloc, nx); b.st[0] = nloc; b.st[1] = nx; }
        const unsigned old = xb_add(&bar[XB_XSUB(b.x)], 1u);
        const unsigned gen = old / nloc;
        if (old + 1u == (gen + 1u) * nloc) {
            __builtin_amdgcn_fence(__ATOMIC_RELEASE, "agent");
            asm volatile("s_waitcnt vmcnt(0)" ::: "memory");
            const unsigned og = xb_add(&bar[XB_TOP], 1u);
            const unsigned tg = og / nx;
            if (og + 1u == (tg + 1u) * nx) xb_add(&bar[XB_TOPGEN], 1u);
            else XB_SPIN(xb_ld(&bar[XB_TOPGEN]) == tg, bar);
            __builtin_amdgcn_fence(__ATOMIC_ACQUIRE, "agent");
            xb_add(&bar[XB_XGEN(b.x)], 1u);
            asm volatile("s_waitcnt vmcnt(0)" ::: "memory");
        } else {
            XB_SPIN(xb_ld(&bar[XB_XGEN(b.x)]) == gen, bar);
            __builtin_amdgcn_fence(__ATOMIC_ACQUIRE, "agent");
            asm volatile("s_waitcnt vmcnt(0)" ::: "memory");
        }
    }
    __syncthreads();
}
constexpr int NWAVES = 8;
constexpr int T = 32768, D = 1024, SEQ = 4096;
constexpr float EPS = 1e-6f;
constexpr float LAMBDA_INIT = 0.35550906759f;
constexpr size_t MiB = 1u << 20;
constexpr size_t WS_CTL = 0, CTL_ZERO_BYTES = 1 * MiB;
constexpr size_t WS_ROPE = 1 * MiB;
constexpr size_t WS_WIN = 4 * MiB;
constexpr size_t WS_WO0 = 11 * MiB, WS_WQ0 = 13 * MiB, WS_KEY0 = 17 * MiB, WS_WQKV = 18 * MiB, WS_WO1 = 24 * MiB, WS_WQ1 = 26 * MiB, WS_KEY1 = 30 * MiB;
constexpr size_t WS_SC = 31 * MiB;
constexpr size_t WS_U0 = 32 * MiB, WS_V0T = 48 * MiB, WS_U1 = 64 * MiB, WS_V1T = 80 * MiB;
constexpr size_t WS_B0 = 96 * MiB;
constexpr size_t WS_R1 = 160 * MiB, WS_R2 = 224 * MiB, WS_R3 = 288 * MiB, WS_R4 = 352 * MiB, WS_R5 = 416 * MiB, WS_GATES = 480 * MiB;
constexpr size_t WS_I8 = 484 * MiB;
constexpr size_t WS_END = 498 * MiB;
constexpr int CW_BAR = 4096;
constexpr int LDS_BYTES = 147456, MISC_OFF = LDS_BYTES - 128;

typedef float f32x16 __attribute__((ext_vector_type(16)));
typedef unsigned u32x2 __attribute__((ext_vector_type(2)));
typedef __bf16 bf16x2_t __attribute__((ext_vector_type(2)));
__device__ __forceinline__ float bf_lo(unsigned w) { return __uint_as_float(w << 16); }
__device__ __forceinline__ float bf_hi(unsigned w) { return __uint_as_float(w & 0xffff0000u); }
__device__ __forceinline__ float dot2(unsigned a, unsigned b, float c) { return __builtin_amdgcn_fdot2_f32_bf16(__builtin_bit_cast(bf16x2_t, a), __builtin_bit_cast(bf16x2_t, b), c, false); }
__device__ __forceinline__ float shx(float v, int lane, int m) { return __uint_as_float((unsigned)__builtin_amdgcn_ds_bpermute((lane ^ m) << 2, (int)__float_as_uint(v))); }
__device__ __forceinline__ int shxi(int v, int lane, int m) { return __builtin_amdgcn_ds_bpermute((lane ^ m) << 2, v); }
__device__ __forceinline__ float wave_sum(float v, int lane) {
#pragma unroll
    for (int o = 1; o < 64; o <<= 1) v += shx(v, lane, o);
    return v;
}
__device__ __forceinline__ f32x4 mfma16(bf16x8 a, bf16x8 b, f32x4 c) { return __builtin_amdgcn_mfma_f32_16x16x32_bf16(a, b, c, 0, 0, 0); }
__device__ __forceinline__ f32x16 mfma32(bf16x8 a, bf16x8 b, f32x16 c) { return __builtin_amdgcn_mfma_f32_32x32x16_bf16(a, b, c, 0, 0, 0); }
__device__ __forceinline__ u32x2 pack4(float a, float b, float c, float d) { u32x2 r; r.x = pk2(a, b); r.y = pk2(c, d); return r; }

__device__ __forceinline__ void p0_transpose_item(const float* W, int K, int N, bf16* WT, LAS float* scr, int item, int lane, const float* kscale = nullptr) {
    const int nblk = N / 32, kb = item / nblk, nb = item % nblk, k0 = 64 * kb, n0 = 32 * nb;
#pragma unroll 8
    for (int i = 0; i < 32; ++i) { const int kk = 2 * i + (lane >> 5); const float sc = kscale ? kscale[k0 + kk] : 1.f; scr[kk * 33 + (lane & 31)] = W[(size_t)(k0 + kk) * N + n0 + (lane & 31)] * sc; }
    LDS_WAIT(); asm volatile("" ::: "memory");
    const int c = lane & 7;
#pragma unroll
    for (int j = 0; j < 4; ++j) { const int n = (lane >> 3) + 8 * j; const LAS float* s = scr + (8 * c) * 33 + n;
        v4u o; o.x = pk2(s[0 * 33], s[1 * 33]); o.y = pk2(s[2 * 33], s[3 * 33]); o.z = pk2(s[4 * 33], s[5 * 33]); o.w = pk2(s[6 * 33], s[7 * 33]);
        *(v4u*)(WT + (size_t)(n0 + n) * K + k0 + 8 * c) = o; }
    LDS_WAIT(); asm volatile("" ::: "memory");
}
__device__ __forceinline__ void cvt_range(const float* src, bf16* dst, size_t n, size_t gtid, size_t gthreads) {
    for (size_t i = gtid * 8; i < n; i += gthreads * 8) {
        const f32x4 a = *(const f32x4*)(src + i), b = *(const f32x4*)(src + i + 4);
        v4u o; o.x = pk2(a.x, a.y); o.y = pk2(a.z, a.w); o.z = pk2(b.x, b.y); o.w = pk2(b.z, b.w);
        *(v4u*)(dst + i) = o; }
}
__device__ __forceinline__ void rms_row_to_bf16(const float* xrow, const float* g, bf16* orow, int lane) {
    const f32x4* xr = (const f32x4*)xrow + lane; const f32x4* gr = (const f32x4*)g + lane;
    f32x4 v[4]; float s = 0.f;
#pragma unroll
    for (int j = 0; j < 4; ++j) { v[j] = xr[64 * j]; s += (v[j].x * v[j].x + v[j].y * v[j].y) + (v[j].z * v[j].z + v[j].w * v[j].w); }
    const float rstd = rsqrtf(wave_sum(s, lane) * (1.f / 1024.f) + EPS);
    unsigned long long* o8 = (unsigned long long*)orow + lane;
#pragma unroll
    for (int j = 0; j < 4; ++j) { const f32x4 gg = gr[64 * j];
        o8[64 * j] = (unsigned long long)pk2(v[j].x * rstd * gg.x, v[j].y * rstd * gg.y) | ((unsigned long long)pk2(v[j].z * rstd * gg.z, v[j].w * rstd * gg.w) << 32); }
}
__device__ __forceinline__ void rms_q8_pass(const float* X, const float* g, unsigned char* XQ, float* SX, int gw, int NGW, int lane) {
    for (int m = gw; m < T; m += NGW) {
        const f32x4* xr = (const f32x4*)(X + (size_t)m * D) + lane; const f32x4* gr = (const f32x4*)g + lane;
        f32x4 v[4]; float s = 0.f;
#pragma unroll
        for (int j = 0; j < 4; ++j) { v[j] = xr[64 * j]; s += (v[j].x * v[j].x + v[j].y * v[j].y) + (v[j].z * v[j].z + v[j].w * v[j].w); }
        const float rstd = rsqrtf(wave_sum(s, lane) * (1.f / 1024.f) + EPS);
        float am = 0.f;
#pragma unroll
        for (int j = 0; j < 4; ++j) { const f32x4 gg = gr[64 * j]; v[j].x = v[j].x * rstd * gg.x; v[j].y = v[j].y * rstd * gg.y; v[j].z = v[j].z * rstd * gg.z; v[j].w = v[j].w * rstd * gg.w;
            am = fmaxf(am, fmaxf(fmaxf(fabsf(v[j].x), fabsf(v[j].y)), fmaxf(fabsf(v[j].z), fabsf(v[j].w)))); }
#pragma unroll
        for (int o = 1; o < 64; o <<= 1) am = fmaxf(am, shx(am, lane, o));
        const float hinv = am > 0.f ? 127.f / am : 0.f;
        unsigned* q4 = (unsigned*)(XQ + (size_t)m * D) + lane;
#pragma unroll
        for (int j = 0; j < 4; ++j) q4[64 * j] = ((unsigned)((int)rintf(v[j].x * hinv) & 0xff)) | ((unsigned)((int)rintf(v[j].y * hinv) & 0xff) << 8) | ((unsigned)((int)rintf(v[j].z * hinv) & 0xff) << 16) | ((unsigned)((int)rintf(v[j].w * hinv) & 0xff) << 24);
        if (lane == 0) SX[m] = am * (1.f / 127.f);
    }
}
__device__ __forceinline__ void rms_pass(const float* X, const float* g, bf16* XN, int gw, int NGW, int lane) {
    for (int m = gw; m < T; m += NGW) rms_row_to_bf16(X + (size_t)m * D, g, XN + (size_t)m * D, lane);
}

__device__ __forceinline__ float logsigmoid_f(float f) { return fminf(f, 0.f) - log1pf(__expf(-fabsf(f))); }
#define ML_LOAD(ci_) do { const size_t r_ = rowbase + (size_t)(ci_) * 64 + lane; \
    rq = *(const v4u*)(Q0 + r_ * 64 + 8 * w); rk = *(const v4u*)(K0 + r_ * 64 + 8 * w); rv0 = *(const v4u*)(V0 + r_ * 128 + 16 * w); rv1 = *(const v4u*)(V0 + r_ * 128 + 16 * w + 8); \
    const size_t gm_ = ((size_t)b * 4096 + (size_t)(ci_) * 64 + jr) * 32; rli = GATES[gm_ + (dir ? 16 : 0) + h]; rf = GATES[gm_ + (dir ? 24 : 8) + h]; } while (0)
__device__ __forceinline__ void mlstm_phase(const int wv, LAS unsigned char* lds, const bf16* Q0, const bf16* K0, const bf16* V0, const float* GATES, bf16* HF, bf16* HB) {
    const int bx = blockIdx.x;
    if ((bx >> 3) & 1) return;
    const int seq = (bx >> 4) * 8 + (bx & 7);
    const int dir = seq & 1, bh = seq >> 1, b = bh >> 3, h = bh & 7;
    int ln_; asm volatile("v_mbcnt_lo_u32_b32 %0, -1, 0\n\tv_mbcnt_hi_u32_b32 %0, -1, %0" : "=v"(ln_)); const int tid = wv * 64 + ln_, lane = tid & 63, w = wv, fr = lane & 15, fq = lane >> 4;
    LAS bf16* Qs = (LAS bf16*)(lds); LAS bf16* Ks = (LAS bf16*)(lds + 9216); LAS bf16* Kwt = (LAS bf16*)(lds + 18432); LAS bf16* Ps = (LAS bf16*)(lds + 27648);
    LAS bf16* Vt = (LAS bf16*)(lds + 36864 + w * 2304); LAS bf16* Cs = (LAS bf16*)(lds + 55296 + w * 2304); LAS bf16* nb = (LAS bf16*)(lds + 73728 + w * 128);
    LAS float* gc = (LAS float*)(lds + 74752 + w * 1280); LAS float* gM = gc + 64; LAS float* gI = gc + 128; LAS float* gE = gc + 192; LAS float* gW = gc + 256;
    for (int i = lane; i < 2304 / 4; i += 64) ((LAS unsigned*)Cs)[i] = 0u;
    if (lane < 32) ((LAS unsigned*)nb)[lane] = 0u;
    f32x4 Cacc[4], Nacc[4];
#pragma unroll
    for (int i = 0; i < 4; ++i) { Cacc[i] = (f32x4){0.f, 0.f, 0.f, 0.f}; Nacc[i] = (f32x4){0.f, 0.f, 0.f, 0.f}; }
    float m = -1e30f;
    bf16* Hout = dir ? HB : HF;
    const size_t rowbase = (size_t)bh * 4096;
    const int jr = dir ? 63 - lane : lane;
    v4u rq, rk, rv0, rv1; float rli, rf;
    ML_LOAD(dir ? 63 : 0);
    const bf16x8 ones = (bf16x8){0x3F80, 0x3F80, 0x3F80, 0x3F80, 0x3F80, 0x3F80, 0x3F80, 0x3F80};
    const f32x4 z4 = (f32x4){0.f, 0.f, 0.f, 0.f};
#pragma unroll 1
    for (int step = 0; step < 64; ++step) {
        const int ci = dir ? 63 - step : step;
        const float lf = logsigmoid_f(rf);
        float bcs = lf;
        bcs += __uint_as_float((unsigned)__builtin_amdgcn_update_dpp(0, (int)__float_as_uint(bcs), 0x111, 0xF, 0xF, false));
        bcs += __uint_as_float((unsigned)__builtin_amdgcn_update_dpp(0, (int)__float_as_uint(bcs), 0x112, 0xF, 0xF, false));
        bcs += __uint_as_float((unsigned)__builtin_amdgcn_update_dpp(0, (int)__float_as_uint(bcs), 0x114, 0xF, 0xF, false));
        bcs += __uint_as_float((unsigned)__builtin_amdgcn_update_dpp(0, (int)__float_as_uint(bcs), 0x118, 0xF, 0xF, false));
        bcs += __uint_as_float((unsigned)__builtin_amdgcn_update_dpp(0, (int)__float_as_uint(bcs), 0x142, 0xA, 0xF, false));
        bcs += __uint_as_float((unsigned)__builtin_amdgcn_update_dpp(0, (int)__float_as_uint(bcs), 0x143, 0xC, 0xF, false));
        const float c = rli - bcs;
        float pm = c;
        const int NINFI = (int)0xFF800000u;
        pm = fmaxf(pm, __uint_as_float((unsigned)__builtin_amdgcn_update_dpp(NINFI, (int)__float_as_uint(pm), 0x111, 0xF, 0xF, false)));
        pm = fmaxf(pm, __uint_as_float((unsigned)__builtin_amdgcn_update_dpp(NINFI, (int)__float_as_uint(pm), 0x112, 0xF, 0xF, false)));
        pm = fmaxf(pm, __uint_as_float((unsigned)__builtin_amdgcn_update_dpp(NINFI, (int)__float_as_uint(pm), 0x114, 0xF, 0xF, false)));
        pm = fmaxf(pm, __uint_as_float((unsigned)__builtin_amdgcn_update_dpp(NINFI, (int)__float_as_uint(pm), 0x118, 0xF, 0xF, false)));
        pm = fmaxf(pm, __uint_as_float((unsigned)__builtin_amdgcn_update_dpp(NINFI, (int)__float_as_uint(pm), 0x142, 0xA, 0xF, false)));
        pm = fmaxf(pm, __uint_as_float((unsigned)__builtin_amdgcn_update_dpp(NINFI, (int)__float_as_uint(pm), 0x143, 0xC, 0xF, false)));
        const float M = fmaxf(m, pm);
        const float bL = __uint_as_float((unsigned)__builtin_amdgcn_readlane((int)__float_as_uint(bcs), 63)), Mlast = __uint_as_float((unsigned)__builtin_amdgcn_readlane((int)__float_as_uint(M), 63));
        gc[jr] = c; gM[jr] = M; gI[jr] = __expf(m - M); gE[jr] = __expf(-(bcs + M)); gW[jr] = __expf(c - Mlast);
        const float sp = __expf(m - Mlast), m_new = bL + Mlast;
        const float wr_ = gW[lane];
        *(LAS v4u*)(Qs + lane * 72 + 8 * w) = rq; *(LAS v4u*)(Ks + lane * 72 + 8 * w) = rk;
#pragma unroll
        for (int i = 0; i < 4; ++i) { const unsigned kw = rk[i]; Kwt[(8 * w + 2 * i) * 72 + lane] = (bf16)f2bf(bf_lo(kw) * wr_); Kwt[(8 * w + 2 * i + 1) * 72 + lane] = (bf16)f2bf(bf_hi(kw) * wr_); }
#pragma unroll
        for (int i = 0; i < 4; ++i) { Vt[(2 * i) * 72 + lane] = (bf16)(rv0[i] & 0xffffu); Vt[(2 * i + 1) * 72 + lane] = (bf16)(rv0[i] >> 16);
                                      Vt[(8 + 2 * i) * 72 + lane] = (bf16)(rv1[i] & 0xffffu); Vt[(9 + 2 * i) * 72 + lane] = (bf16)(rv1[i] >> 16); }
        __syncthreads();
        if (step < 63) ML_LOAD(dir ? 62 - step : step + 1);
        {
            const int st = w >> 1;
            const bf16x8 a0 = *(const LAS bf16x8*)(Ks + (16 * st + fr) * 72 + 8 * fq), a1 = *(const LAS bf16x8*)(Ks + (16 * st + fr) * 72 + 32 + 8 * fq);
#pragma unroll
            for (int u = 0; u < 2; ++u) { const int tt = 2 * (w & 1) + u;
                const bf16x8 b0 = *(const LAS bf16x8*)(Qs + (16 * tt + fr) * 72 + 8 * fq), b1 = *(const LAS bf16x8*)(Qs + (16 * tt + fr) * 72 + 32 + 8 * fq);
                f32x4 acc = mfma16(a0, b0, z4); acc = mfma16(a1, b1, acc);
                const int t = 16 * tt + fr; const float Mt = gM[t]; float pv[4];
#pragma unroll
                for (int i = 0; i < 4; ++i) { const int s = 16 * st + 4 * fq + i; const bool valid = dir ? (s >= t) : (s <= t); const float e = __expf(gc[s] - Mt); pv[i] = valid ? acc[i] * e : 0.f; }
                *(LAS u32x2*)(Ps + t * 72 + 16 * st + 4 * fq) = pack4(pv[0], pv[1], pv[2], pv[3]); }
        }
        __syncthreads();
        const bf16x8 aV0 = *(const LAS bf16x8*)(Vt + fr * 72 + 8 * fq), aV1 = *(const LAS bf16x8*)(Vt + fr * 72 + 32 + 8 * fq);
        {
            const bf16x8 aC0 = *(const LAS bf16x8*)(Cs + fr * 72 + 8 * fq), aC1 = *(const LAS bf16x8*)(Cs + fr * 72 + 32 + 8 * fq);
            const bf16x8 aN0 = *(const LAS bf16x8*)(nb + 8 * fq), aN1 = *(const LAS bf16x8*)(nb + 32 + 8 * fq);
#pragma unroll
            for (int tt = 0; tt < 4; ++tt) {
                const bf16x8 bP0 = *(const LAS bf16x8*)(Ps + (16 * tt + fr) * 72 + 8 * fq), bP1 = *(const LAS bf16x8*)(Ps + (16 * tt + fr) * 72 + 32 + 8 * fq);
                const bf16x8 bQ0 = *(const LAS bf16x8*)(Qs + (16 * tt + fr) * 72 + 8 * fq), bQ1 = *(const LAS bf16x8*)(Qs + (16 * tt + fr) * 72 + 32 + 8 * fq);
                f32x4 acc1 = mfma16(aV0, bP0, z4); acc1 = mfma16(aV1, bP1, acc1);
                f32x4 acc2 = mfma16(aC0, bQ0, z4); acc2 = mfma16(aC1, bQ1, acc2);
                f32x4 d1 = mfma16(ones, bP0, z4); d1 = mfma16(ones, bP1, d1);
                f32x4 d2 = mfma16(aN0, bQ0, z4); d2 = mfma16(aN1, bQ1, d2);
                const int t = 16 * tt + fr; const float it = gI[t], en = gE[t];
                const float den = d1[0] + it * d2[0]; const float inv = 1.f / fmaxf(fabsf(den), en);
                *(u32x2*)(Hout + ((size_t)b * 4096 + (size_t)ci * 64 + t) * 1024 + h * 128 + 16 * w + 4 * fq) =
                    pack4((acc1[0] + it * acc2[0]) * inv, (acc1[1] + it * acc2[1]) * inv, (acc1[2] + it * acc2[2]) * inv, (acc1[3] + it * acc2[3]) * inv);
            }
        }
#pragma unroll
        for (int dt = 0; dt < 4; ++dt) { Cacc[dt] = Cacc[dt] * sp; Nacc[dt] = Nacc[dt] * sp;
            const bf16x8 aK0 = *(const LAS bf16x8*)(Kwt + (16 * dt + fr) * 72 + 8 * fq), aK1 = *(const LAS bf16x8*)(Kwt + (16 * dt + fr) * 72 + 32 + 8 * fq);
            Cacc[dt] = mfma16(aK0, aV0, Cacc[dt]); Cacc[dt] = mfma16(aK1, aV1, Cacc[dt]);
            Nacc[dt] = mfma16(aK0, ones, Nacc[dt]); Nacc[dt] = mfma16(aK1, ones, Nacc[dt]); }
#pragma unroll
        for (int dt = 0; dt < 4; ++dt) { *(LAS u32x2*)(Cs + fr * 72 + 16 * dt + 4 * fq) = pack4(Cacc[dt][0], Cacc[dt][1], Cacc[dt][2], Cacc[dt][3]);
                                         *(LAS u32x2*)(nb + 16 * dt + 4 * fq) = pack4(Nacc[dt][0], Nacc[dt][1], Nacc[dt][2], Nacc[dt][3]); }
        m = m_new;
        __syncthreads();
    }
}
#undef ML_LOAD

__device__ __forceinline__ void hs_pass(const bf16* HF, const bf16* HB, const bf16* OG, const float* hg, bf16* HS, int gw, int NGW, int lane) {
    for (int m = gw; m < T; m += NGW) {
        const size_t off = (size_t)m * 1024 + 16 * lane;
        const v4u f0 = *(const v4u*)(HF + off), f1 = *(const v4u*)(HF + off + 8), b0 = *(const v4u*)(HB + off), b1 = *(const v4u*)(HB + off + 8), o0 = *(const v4u*)(OG + off), o1 = *(const v4u*)(OG + off + 8);
        float x[16], og[16];
#pragma unroll
        for (int i = 0; i < 4; ++i) { x[2 * i] = bf_lo(f0[i]) + bf_lo(b0[i]); x[2 * i + 1] = bf_hi(f0[i]) + bf_hi(b0[i]); x[8 + 2 * i] = bf_lo(f1[i]) + bf_lo(b1[i]); x[9 + 2 * i] = bf_hi(f1[i]) + bf_hi(b1[i]);
                                      og[2 * i] = bf_lo(o0[i]); og[2 * i + 1] = bf_hi(o0[i]); og[8 + 2 * i] = bf_lo(o1[i]); og[9 + 2 * i] = bf_hi(o1[i]); }
        float ss = 0.f;
#pragma unroll
        for (int i = 0; i < 16; ++i) ss += x[i] * x[i];
        ss += shx(ss, lane, 1); ss += shx(ss, lane, 2); ss += shx(ss, lane, 4);
        const float rstd = rsqrtf(ss * (1.f / 128.f) + EPS);
        float y[16];
#pragma unroll
        for (int i = 0; i < 16; ++i) y[i] = x[i] * rstd * hg[16 * lane + i] * (1.f / (1.f + __expf(-og[i])));
        v4u w0, w1;
#pragma unroll
        for (int i = 0; i < 4; ++i) { w0[i] = pk2(y[2 * i], y[2 * i + 1]); w1[i] = pk2(y[8 + 2 * i], y[9 + 2 * i]); }
        *(v4u*)(HS + off) = w0; *(v4u*)(HS + off + 8) = w1;
    }
}

__device__ __forceinline__ void glds16(const void* gsrc, unsigned lds_dst) { unsigned keep;
    asm volatile("s_mov_b32 %0, m0\n\ts_mov_b32 m0, %2\n\ts_nop 0\n\tglobal_load_lds_dwordx4 %1, off\n\ts_mov_b32 m0, %0" : "=&s"(keep) : "v"(gsrc), "s"(lds_dst) : "memory"); }
#define AT_WAIT_BAR() asm volatile("s_waitcnt vmcnt(0) lgkmcnt(0)\n\ts_barrier" ::: "memory")

#define TK_CE(a, b) do { const float h_ = fmaxf(a, b), l_ = fminf(a, b); a = h_; b = l_; } while (0)
#define BITONIC_MERGE16(x) do { _Pragma("unroll") for (int d_ = 8; d_ >= 1; d_ >>= 1) { _Pragma("unroll") for (int i_ = 0; i_ < 16; ++i_) if ((i_ & d_) == 0) TK_CE(x[i_], x[i_ + d_]); } } while (0)
#define BITONIC_SORT16(x) do { _Pragma("unroll") for (int k_ = 2; k_ <= 16; k_ <<= 1) { _Pragma("unroll") for (int d_ = k_ >> 1; d_ >= 1; d_ >>= 1) { _Pragma("unroll") for (int i_ = 0; i_ < 16; ++i_) { const int l_i = i_ ^ d_; \
    if (l_i > i_) { if ((i_ & k_) == 0 || k_ == 16) TK_CE(x[i_], x[l_i]); else TK_CE(x[l_i], x[i_]); } } } } } while (0)
#define TK_INSERT(v, x) do { float c_ = (x); _Pragma("unroll") for (int j_ = 0; j_ < 16; ++j_) { const float h_ = fmaxf(v[j_], c_); c_ = fminf(v[j_], c_); v[j_] = h_; } } while (0)
#define TK_DMA(st_, b_) do { _Pragma("unroll") for (int g_ = 0; g_ < 2; ++g_) { const int hp_ = ((g_ * 4 + ((st_) >> 1)) * 2 + ((st_) & 1)); \
    _Pragma("unroll") for (int i_ = 0; i_ < 4; ++i_) { const int q_ = w * 4 + i_, row_ = 4 * q_ + (lane >> 4), ch_ = (lane & 15) ^ (row_ & 15); \
        glds16(KEYS + ((size_t)(hp_ * 128 + row_)) * 128 + ch_ * 8, (unsigned)__builtin_amdgcn_readfirstlane((int)(ldsb + ((b_) * 2 + g_) * 32768 + q_ * 1024))); } } } while (0)
__device__ __forceinline__ void peer_topk_phase(const int wv, LAS unsigned char* lds, int vcu, const bf16* PQ, const bf16* KEYS, int* EXPERTS, float* GATESP) {
    int ln_; asm volatile("v_mbcnt_lo_u32_b32 %0, -1, 0\n\tv_mbcnt_hi_u32_b32 %0, -1, %0" : "=v"(ln_)); const int tid = wv * 64 + ln_, lane = tid & 63, w = wv, r32 = lane & 31, hi = lane >> 5;
    const int t = vcu * 128 + (w & 3) * 32 + r32, hg = w >> 2;
    const float NINF = -INFINITY;
    const unsigned ldsb = (unsigned)(uintptr_t)lds;
    TK_DMA(0, 0);
    AT_WAIT_BAR();
#pragma unroll 1
    for (int hh = 0; hh < 4; ++hh) {
        const int head = hg * 4 + hh;
        float L0[16], L1[16];
#pragma unroll
        for (int j = 0; j < 16; ++j) { L0[j] = 0.f; L1[j] = 0.f; }
#pragma unroll 1
        for (int p = 0; p < 2; ++p) {
            const int st = hh * 2 + p, buf = st & 1;
            if (st < 7) TK_DMA(st + 1, buf ^ 1);
            bf16x8 bq[8];
#pragma unroll
            for (int ks = 0; ks < 8; ++ks) bq[ks] = *(const bf16x8*)(PQ + (size_t)t * 2048 + head * 256 + p * 128 + ks * 16 + 8 * hi);
            const LAS unsigned char* kb = lds + (buf * 2 + hg) * 32768 + r32 * 256;
            f32x16 acc[4];
#pragma unroll
            for (int nt = 0; nt < 4; ++nt) {
#pragma unroll
                for (int r = 0; r < 16; ++r) acc[nt][r] = 0.f;
#pragma unroll
                for (int ks = 0; ks < 8; ++ks) { const bf16x8 a = *(const LAS bf16x8*)(kb + nt * 8192 + (((2 * ks + hi) ^ (r32 & 15)) << 4)); acc[nt] = mfma32(a, bq[ks], acc[nt]); }
            }
            float v[16];
            {
                float blk[4][16];
#pragma unroll
                for (int nt = 0; nt < 4; ++nt)
#pragma unroll
                    for (int r = 0; r < 16; ++r) { const int n = nt * 32 + (r & 3) + 8 * (r >> 2) + 4 * hi; blk[nt][r] = __uint_as_float((__float_as_uint(acc[nt][r]) & ~0x7Fu) | (unsigned)(127 - n)); }
#pragma unroll
                for (int nt = 0; nt < 4; ++nt) BITONIC_SORT16(blk[nt]);
#pragma unroll
                for (int i = 0; i < 16; ++i) { blk[0][i] = fmaxf(blk[0][i], blk[1][15 - i]); blk[2][i] = fmaxf(blk[2][i], blk[3][15 - i]); }
                BITONIC_MERGE16(blk[0]); BITONIC_MERGE16(blk[2]);
#pragma unroll
                for (int i = 0; i < 16; ++i) v[i] = fmaxf(blk[0][i], blk[2][15 - i]);
                BITONIC_MERGE16(v);
            }
            {
                float wv_[16];
#pragma unroll
                for (int j = 0; j < 16; ++j) wv_[j] = shx(v[15 - j], lane, 32);
#pragma unroll
                for (int j = 0; j < 16; ++j) v[j] = fmaxf(v[j], wv_[j]);
                BITONIC_MERGE16(v);
            }
            if (p == 0) {
#pragma unroll
                for (int j = 0; j < 16; ++j) L0[j] = v[j];
            } else {
#pragma unroll
                for (int j = 0; j < 16; ++j) L1[j] = v[j];
            }            AT_WAIT_BAR();
        }
        float tv[16];
        unsigned IA[4] = {0u, 0u, 0u, 0u}, IB[4] = {0u, 0u, 0u, 0u};
#pragma unroll
        for (int i = 0; i < 16; ++i) { IA[i >> 2] |= (127u - (__float_as_uint(L0[i]) & 0x7Fu)) << (8 * (i & 3)); IB[i >> 2] |= (127u - (__float_as_uint(L1[i]) & 0x7Fu)) << (8 * (i & 3)); }
        {
            float cb[4][16]; int cn = 0;
#pragma unroll
            for (int i = 0; i < 16; ++i) {
                const float va = __uint_as_float(__float_as_uint(L0[i]) & ~0x7Fu);
#pragma unroll
                for (int j = 0; j < 16; ++j) if ((i + 1) * (j + 1) <= 16) {
                    const float vb = __uint_as_float(__float_as_uint(L1[j]) & ~0x7Fu);
                    cb[cn >> 4][cn & 15] = __uint_as_float((__float_as_uint(va + vb) & ~0xFFu) | (unsigned)(255 - (i * 16 + j)));
                    ++cn;
                }
            }
#pragma unroll
            for (int c = 50; c < 64; ++c) cb[c >> 4][c & 15] = NINF;
#pragma unroll
            for (int nt = 0; nt < 4; ++nt) BITONIC_SORT16(cb[nt]);
#pragma unroll
            for (int i = 0; i < 16; ++i) { cb[0][i] = fmaxf(cb[0][i], cb[1][15 - i]); cb[2][i] = fmaxf(cb[2][i], cb[3][15 - i]); }
            BITONIC_MERGE16(cb[0]); BITONIC_MERGE16(cb[2]);
#pragma unroll
            for (int i = 0; i < 16; ++i) tv[i] = fmaxf(cb[0][i], cb[2][15 - i]);
            BITONIC_MERGE16(tv);
        }
        int ti[16];
#pragma unroll
        for (int j = 0; j < 16; ++j) { const unsigned kb = __float_as_uint(tv[j]); const unsigned flat = 255u - (kb & 0xFFu); const unsigned fi = flat >> 4, fj = flat & 15u;
            const unsigned ra = (fi < 8u) ? ((fi < 4u) ? IA[0] : IA[1]) : ((fi < 12u) ? IA[2] : IA[3]);
            const unsigned rb = (fj < 8u) ? ((fj < 4u) ? IB[0] : IB[1]) : ((fj < 12u) ? IB[2] : IB[3]);
            ti[j] = (int)(((ra >> (8u * (fi & 3u))) & 0xFFu) * 128u + ((rb >> (8u * (fj & 3u))) & 0xFFu));
            tv[j] = __uint_as_float(kb & ~0xFFu); }
        float e[16], sum = 0.f;
#pragma unroll
        for (int j = 0; j < 16; ++j) { e[j] = __expf(tv[j] - tv[0]); sum += e[j]; }
        const float inv = 1.f / sum;
        if (hi == 0) { int* ep = EXPERTS + (size_t)t * 128 + head * 16;
#pragma unroll
            for (int j = 0; j < 4; ++j) *(v4u*)(ep + 4 * j) = (v4u){(unsigned)ti[4 * j], (unsigned)ti[4 * j + 1], (unsigned)ti[4 * j + 2], (unsigned)ti[4 * j + 3]}; }
        else { float* gp = GATESP + (size_t)t * 128 + head * 16;
#pragma unroll
            for (int j = 0; j < 4; ++j) *(f32x4*)(gp + 4 * j) = (f32x4){e[4 * j] * inv, e[4 * j + 1] * inv, e[4 * j + 2] * inv, e[4 * j + 3] * inv}; }
    }
}

__device__ __forceinline__ float cvt_ub0(unsigned x) { float r; asm("v_cvt_f32_ubyte0 %0, %1" : "=v"(r) : "v"(x)); return r; }
__device__ __forceinline__ float cvt_ub1(unsigned x) { float r; asm("v_cvt_f32_ubyte1 %0, %1" : "=v"(r) : "v"(x)); return r; }
__device__ __forceinline__ float cvt_ub2(unsigned x) { float r; asm("v_cvt_f32_ubyte2 %0, %1" : "=v"(r) : "v"(x)); return r; }
__device__ __forceinline__ float cvt_ub3(unsigned x) { float r; asm("v_cvt_f32_ubyte3 %0, %1" : "=v"(r) : "v"(x)); return r; }
__device__ __forceinline__ void quant8_rows_bf16(const bf16* src, unsigned char* dst, float* scale, int nrows, int gw, int NGW, int lane) {
    for (int r = gw; r < nrows; r += NGW) {
        const v4u a = *(const v4u*)(src + (size_t)r * 1024 + 16 * lane), b = *(const v4u*)(src + (size_t)r * 1024 + 16 * lane + 8);
        float x[16]; float am = 0.f;
#pragma unroll
        for (int k = 0; k < 4; ++k) { x[2 * k] = bf_lo(a[k]); x[2 * k + 1] = bf_hi(a[k]); x[8 + 2 * k] = bf_lo(b[k]); x[9 + 2 * k] = bf_hi(b[k]); }
#pragma unroll
        for (int k = 0; k < 16; ++k) am = fmaxf(am, fabsf(x[k]));
#pragma unroll
        for (int o = 1; o < 64; o <<= 1) am = fmaxf(am, shx(am, lane, o));
        const float inv = am > 0.f ? 127.f / am : 0.f;
        v4u w;
#pragma unroll
        for (int k = 0; k < 4; ++k) w[k] = ((unsigned)((int)rintf(x[4 * k] * inv) & 0xff)) | ((unsigned)((int)rintf(x[4 * k + 1] * inv) & 0xff) << 8) | ((unsigned)((int)rintf(x[4 * k + 2] * inv) & 0xff) << 16) | ((unsigned)((int)rintf(x[4 * k + 3] * inv) & 0xff) << 24);
        *(v4u*)(dst + (size_t)r * 1024 + 16 * lane) = w;
        if (lane == 0) scale[r] = am * (1.f / 127.f);
    }
}
__device__ __forceinline__ void quant4_rows(const float* src, unsigned char* dst, float* scale, int nrows, int gw, int NGW, int lane) {
    for (int r = gw; r < nrows; r += NGW) {
        const f32x4* sp = (const f32x4*)(src + (size_t)r * 1024) + 4 * lane;
        f32x4 v[4]; float am = 0.f, ss = 0.f;
#pragma unroll
        for (int j = 0; j < 4; ++j) { v[j] = sp[j]; am = fmaxf(am, fmaxf(fmaxf(fabsf(v[j].x), fabsf(v[j].y)), fmaxf(fabsf(v[j].z), fabsf(v[j].w)))); ss += (v[j].x * v[j].x + v[j].y * v[j].y) + (v[j].z * v[j].z + v[j].w * v[j].w); }
#pragma unroll
        for (int o = 1; o < 64; o <<= 1) { am = fmaxf(am, shx(am, lane, o)); ss += shx(ss, lane, o); }
        const float step = fminf(am * (1.f / 7.5f), 0.3352f * sqrtf(ss * (1.f / 1024.f)));
        const float inv = step > 0.f ? 1.f / step : 0.f;
        unsigned q[16];
#pragma unroll
        for (int j = 0; j < 4; ++j) { q[4 * j] = (unsigned)fminf(fmaxf(rintf(v[j].x * inv + 7.5f), 0.f), 15.f); q[4 * j + 1] = (unsigned)fminf(fmaxf(rintf(v[j].y * inv + 7.5f), 0.f), 15.f);
                                      q[4 * j + 2] = (unsigned)fminf(fmaxf(rintf(v[j].z * inv + 7.5f), 0.f), 15.f); q[4 * j + 3] = (unsigned)fminf(fmaxf(rintf(v[j].w * inv + 7.5f), 0.f), 15.f); }
        u32x2 w;
        w.x = (q[0] | (q[4] << 4)) | ((q[1] | (q[5] << 4)) << 8) | ((q[2] | (q[6] << 4)) << 16) | ((q[3] | (q[7] << 4)) << 24);
        w.y = (q[8] | (q[12] << 4)) | ((q[9] | (q[13] << 4)) << 8) | ((q[10] | (q[14] << 4)) << 16) | ((q[11] | (q[15] << 4)) << 24);
        *(u32x2*)(dst + (size_t)r * 512 + 8 * lane) = w;
        if (lane == 0) scale[r] = step;
    }
}

#define RED_STEP(N, S) do { const bool up_ = (lane & (S)) != 0; _Pragma("unroll") for (int j_ = 0; j_ < (N); ++j_) { const int a_ = p[j_], b_ = p[j_ + (N)]; const int send_ = up_ ? a_ : b_, keep_ = up_ ? b_ : a_; p[j_] = keep_ + shxi(send_, lane, (S)); } } while (0)
#define RED16(dst) do { RED_STEP(8, 8); RED_STEP(4, 4); RED_STEP(2, 2); RED_STEP(1, 1); int s_ = p[0]; s_ += shxi(s_, lane, 16); s_ += shxi(s_, lane, 32); dst = s_; } while (0)
#define G_SB() __builtin_amdgcn_sched_barrier(0)
#define G_LOAD(buf, tab, evec, jb) do { _Pragma("unroll") for (int jj_ = 0; jj_ < 16; ++jj_) { const int e_ = __builtin_amdgcn_readlane(evec, (jb) + jj_); buf[jj_] = __builtin_amdgcn_raw_buffer_load_b64(rs_##tab, (int)voff, e_ << 9, 0); } } while (0)
#define U_COMP(buf) do { _Pragma("unroll") for (int jj_ = 0; jj_ < 16; ++jj_) { const unsigned w0_ = buf[jj_].x, w1_ = buf[jj_].y; \
    int d_ = __builtin_amdgcn_sdot4((int)(w0_ & 0x0F0F0F0Fu), hq[0], 0, false); d_ = __builtin_amdgcn_sdot4((int)((w0_ >> 4) & 0x0F0F0F0Fu), hq[1], d_, false); \
    d_ = __builtin_amdgcn_sdot4((int)(w1_ & 0x0F0F0F0Fu), hq[2], d_, false); d_ = __builtin_amdgcn_sdot4((int)((w1_ >> 4) & 0x0F0F0F0Fu), hq[3], d_, false); p[jj_] = d_; } } while (0)
#define V_DW(o0, o1, o2, o3, wd, cs) do { float t0_, t1_, t2_, t3_; asm volatile("v_cvt_f32_ubyte0 %4, %8\n\tv_cvt_f32_ubyte1 %5, %8\n\tv_cvt_f32_ubyte2 %6, %8\n\tv_cvt_f32_ubyte3 %7, %8\n\tv_fmac_f32 %0, %9, %4\n\tv_fmac_f32 %1, %9, %5\n\tv_fmac_f32 %2, %9, %6\n\tv_fmac_f32 %3, %9, %7" \
    : "+v"(o0), "+v"(o1), "+v"(o2), "+v"(o3), "=&v"(t0_), "=&v"(t1_), "=&v"(t2_), "=&v"(t3_) : "v"(wd), "s"(cs)); } while (0)
#define V_COMP(buf, cvec, jb) do { _Pragma("unroll") for (int jj_ = 0; jj_ < 16; ++jj_) { const float c_ = __uint_as_float(__builtin_amdgcn_readlane(__float_as_uint(cvec), (jb) + jj_)); const unsigned w0_ = buf[jj_].x, w1_ = buf[jj_].y; \
    V_DW(o[0], o[1], o[2], o[3], w0_ & 0x0F0F0F0Fu, c_); V_DW(o[4], o[5], o[6], o[7], (w0_ >> 4) & 0x0F0F0F0Fu, c_); V_DW(o[8], o[9], o[10], o[11], w1_ & 0x0F0F0F0Fu, c_); V_DW(o[12], o[13], o[14], o[15], (w1_ >> 4) & 0x0F0F0F0Fu, c_); } } while (0)
template <bool NEXT_NORM>
__device__ __forceinline__ void peer_gather_phase(const int wv, bool dry, int vcu, const bf16* HN, const int* EXPERTS, const float* GATESP, const unsigned char* U, const float* SU, const unsigned char* Vtab, const float* SV,
                                                  float* X, const float* gnext, bf16* XN) {
    int ln_; asm volatile("v_mbcnt_lo_u32_b32 %0, -1, 0\n\tv_mbcnt_hi_u32_b32 %0, -1, %0" : "=v"(ln_)); const int tid = wv * 64 + ln_, lane = tid & 63, w = wv;
    const __amdgpu_buffer_rsrc_t rs_U = __builtin_amdgcn_make_buffer_rsrc((void*)U, (short)0, 16384 * 512, 0x00020000), rs_Vtab = __builtin_amdgcn_make_buffer_rsrc((void*)Vtab, (short)0, 16384 * 512, 0x00020000);
    const unsigned voff = (unsigned)lane * 8u;
    const int lg = lane >> 4;
#pragma unroll 1
    for (int i = 0; i < 16; ++i) {
        const int t = vcu * 128 + w * 16 + i;
        const int ev0 = EXPERTS[(size_t)t * 128 + lane], ev1 = EXPERTS[(size_t)t * 128 + 64 + lane];
        const float gv0 = GATESP[(size_t)t * 128 + lane], gv1 = GATESP[(size_t)t * 128 + 64 + lane];
        const v4u h0 = *(const v4u*)(HN + (size_t)t * 1024 + 16 * lane), h1 = *(const v4u*)(HN + (size_t)t * 1024 + 16 * lane + 8);
        float hf[16]; float am = 0.f;
#pragma unroll
        for (int k = 0; k < 4; ++k) { hf[2 * k] = bf_lo(h0[k]); hf[2 * k + 1] = bf_hi(h0[k]); hf[8 + 2 * k] = bf_lo(h1[k]); hf[9 + 2 * k] = bf_hi(h1[k]); }
#pragma unroll
        for (int k = 0; k < 16; ++k) am = fmaxf(am, fabsf(hf[k]));
#pragma unroll
        for (int o = 1; o < 64; o <<= 1) am = fmaxf(am, shx(am, lane, o));
        const float hinv = am > 0.f ? 127.f / am : 0.f, sh = am * (1.f / 127.f);
        int hq[4]; int hs = 0;
#pragma unroll
        for (int k = 0; k < 4; ++k) { const int q0 = (int)rintf(hf[4 * k] * hinv), q1 = (int)rintf(hf[4 * k + 1] * hinv), q2 = (int)rintf(hf[4 * k + 2] * hinv), q3 = (int)rintf(hf[4 * k + 3] * hinv); hs += (q0 + q1) + (q2 + q3);
            hq[k] = (int)(((unsigned)(q0 & 0xff)) | ((unsigned)(q1 & 0xff) << 8) | ((unsigned)(q2 & 0xff) << 16) | ((unsigned)(q3 & 0xff) << 24)); }
#pragma unroll
        for (int o = 1; o < 64; o <<= 1) hs += shxi(hs, lane, o);
        const float hoff = 7.5f * (float)hs;
        const float su0 = SU[ev0], su1 = SU[ev1], sv0 = SV[ev0], sv1 = SV[ev1];
        float o[16];
#pragma unroll
        for (int k = 0; k < 16; ++k) o[k] = 0.f;
        int p[16], r0, r1, r2, r3, r4, r5, r6, r7;
        u32x2 A[16], B[16], C[16];
        G_LOAD(A, U, ev0, 0); G_LOAD(B, U, ev0, 16); G_SB();
        G_LOAD(C, U, ev0, 32); G_SB(); U_COMP(A); RED16(r0); G_SB();
        G_LOAD(A, U, ev0, 48); G_SB(); U_COMP(B); RED16(r1); G_SB();
        G_LOAD(B, U, ev1, 0); G_SB(); U_COMP(C); RED16(r2); G_SB();
        G_LOAD(C, U, ev1, 16); G_SB(); U_COMP(A); RED16(r3); G_SB();
        G_LOAD(A, U, ev1, 32); G_SB(); U_COMP(B); RED16(r4); G_SB();
        G_LOAD(B, U, ev1, 48); G_SB(); U_COMP(C); RED16(r5); G_SB();
        G_LOAD(C, Vtab, ev0, 0); G_SB(); U_COMP(A); RED16(r6); G_SB();
        G_LOAD(A, Vtab, ev0, 16); G_SB(); U_COMP(B); RED16(r7); G_SB();
        const int d0 = lg == 0 ? r0 : (lg == 1 ? r1 : (lg == 2 ? r2 : r3)), d1 = lg == 0 ? r4 : (lg == 1 ? r5 : (lg == 2 ? r6 : r7));
        float act0 = ((float)d0 - hoff) * (sh * su0), act1 = ((float)d1 - hoff) * (sh * su1);
#ifdef PROBE_NOFFN
        const float coef0 = 0.f * act0, coef1 = 0.f * act1;
#else
        const float coef0 = gv0 * (0.5f * act0 * (1.f + erff(act0 * 0.70710678118f))) * sv0, coef1 = gv1 * (0.5f * act1 * (1.f + erff(act1 * 0.70710678118f))) * sv1;
#endif
        G_SB();
        G_LOAD(B, Vtab, ev0, 32); G_SB(); V_COMP(C, coef0, 0); G_SB();
        G_LOAD(C, Vtab, ev0, 48); G_SB(); V_COMP(A, coef0, 16); G_SB();
        G_LOAD(A, Vtab, ev1, 0); G_SB(); V_COMP(B, coef0, 32); G_SB();
        G_LOAD(B, Vtab, ev1, 16); G_SB(); V_COMP(C, coef0, 48); G_SB();
        G_LOAD(C, Vtab, ev1, 32); G_SB(); V_COMP(A, coef1, 0); G_SB();
        G_LOAD(A, Vtab, ev1, 48); G_SB(); V_COMP(B, coef1, 16); G_SB();
        V_COMP(C, coef1, 32); G_SB(); V_COMP(A, coef1, 48); G_SB();
        const float corr = 7.5f * wave_sum(coef0 + coef1, lane);
        float* xr = X + (size_t)t * 1024 + 16 * lane;
        f32x4 xv[4];
#pragma unroll
        for (int k = 0; k < 4; ++k) { xv[k] = *(const f32x4*)(xr + 4 * k); xv[k] += (f32x4){o[4 * k] - corr, o[4 * k + 1] - corr, o[4 * k + 2] - corr, o[4 * k + 3] - corr}; }
        if (!dry) {
#pragma unroll
            for (int k = 0; k < 4; ++k) *(f32x4*)(xr + 4 * k) = xv[k]; }
        if (NEXT_NORM && !dry) {
            float ss = 0.f;
#pragma unroll
            for (int k = 0; k < 4; ++k) ss += (xv[k].x * xv[k].x + xv[k].y * xv[k].y) + (xv[k].z * xv[k].z + xv[k].w * xv[k].w);
            const float rstd = rsqrtf(wave_sum(ss, lane) * (1.f / 1024.f) + EPS);
            v4u wa, wb;
#pragma unroll
            for (int k = 0; k < 4; ++k) { const f32x4 g = *(const f32x4*)(gnext + 16 * lane + 4 * k); const unsigned lo = pk2(xv[k].x * rstd * g.x, xv[k].y * rstd * g.y), hi2 = pk2(xv[k].z * rstd * g.z, xv[k].w * rstd * g.w);
                if (k < 2) { wa[2 * k] = lo; wa[2 * k + 1] = hi2; } else { wb[2 * (k - 2)] = lo; wb[2 * (k - 2) + 1] = hi2; } }
            *(v4u*)(XN + (size_t)t * 1024 + 16 * lane) = wa; *(v4u*)(XN + (size_t)t * 1024 + 16 * lane + 8) = wb;
        }
    }
}

__device__ __forceinline__ void rms_quant_pass(const bf16* X, const float* g, bf16* XN, unsigned char* HQ, float* SH, float* HS, int gw, int NGW, int lane) {
    for (int m = gw; m < T; m += NGW) {
        const u32x2* xr = (const u32x2*)(X + (size_t)m * D) + lane; const f32x4* gr = (const f32x4*)g + lane;
        f32x4 v[4]; float s = 0.f;
#pragma unroll
        for (int j = 0; j < 4; ++j) { const u32x2 w = xr[64 * j]; v[j] = (f32x4){bf_lo(w.x), bf_hi(w.x), bf_lo(w.y), bf_hi(w.y)}; s += (v[j].x * v[j].x + v[j].y * v[j].y) + (v[j].z * v[j].z + v[j].w * v[j].w); }
        const float rstd = rsqrtf(wave_sum(s, lane) * (1.f / 1024.f) + EPS);
        float am = 0.f;
#pragma unroll
        for (int j = 0; j < 4; ++j) { const f32x4 gg = gr[64 * j]; v[j].x = v[j].x * rstd * gg.x; v[j].y = v[j].y * rstd * gg.y; v[j].z = v[j].z * rstd * gg.z; v[j].w = v[j].w * rstd * gg.w;
            am = fmaxf(am, fmaxf(fmaxf(fabsf(v[j].x), fabsf(v[j].y)), fmaxf(fabsf(v[j].z), fabsf(v[j].w)))); }
#pragma unroll
        for (int o = 1; o < 64; o <<= 1) am = fmaxf(am, shx(am, lane, o));
        const float hinv = am > 0.f ? 127.f / am : 0.f;
        int hs = 0;
        unsigned* q4 = (unsigned*)(HQ + (size_t)m * D) + lane;
#pragma unroll
        for (int j = 0; j < 4; ++j) { const int q0 = (int)rintf(v[j].x * hinv), q1 = (int)rintf(v[j].y * hinv), q2 = (int)rintf(v[j].z * hinv), q3 = (int)rintf(v[j].w * hinv); hs += (q0 + q1) + (q2 + q3);
            q4[64 * j] = ((unsigned)(q0 & 0xff)) | ((unsigned)(q1 & 0xff) << 8) | ((unsigned)(q2 & 0xff) << 16) | ((unsigned)(q3 & 0xff) << 24); }
#pragma unroll
        for (int o = 1; o < 64; o <<= 1) hs += shxi(hs, lane, o);
        if (lane == 0) { SH[m] = am * (1.f / 127.f); HS[m] = (float)hs; }
    }
}
__device__ __forceinline__ int dpp_add_quad(int d) {
    d += __builtin_amdgcn_update_dpp(0, d, 0xB1, 0xF, 0xF, true);
    d += __builtin_amdgcn_update_dpp(0, d, 0x4E, 0xF, 0xF, true);
    return d;
}
__device__ __forceinline__ int dpp_add_oct(int d) {
    d += __builtin_amdgcn_update_dpp(0, d, 0xB1, 0xF, 0xF, true);
    d += __builtin_amdgcn_update_dpp(0, d, 0x4E, 0xF, 0xF, true);
    d += __builtin_amdgcn_update_dpp(0, d, 0x141, 0xF, 0xF, true);
    return d;
}
#define G1_IDS(E_, H0_, H1_, it_) do { const int t_ = t0 + ((it_) >> 1), hf_ = (it_) & 1; const v4u* ep_ = (const v4u*)(EXPERTS + (size_t)t_ * 128 + 16 * oct + 8 * hf_); const v4u ea_ = ep_[0], eb_ = ep_[1]; \
    E_[0] = (int)ea_.x; E_[1] = (int)ea_.y; E_[2] = (int)ea_.z; E_[3] = (int)ea_.w; E_[4] = (int)eb_.x; E_[5] = (int)eb_.y; E_[6] = (int)eb_.z; E_[7] = (int)eb_.w; \
    H0_ = *(const v4u*)(HQ + (size_t)t_ * 1024 + 256 * s + 32 * q8); H1_ = *(const v4u*)(HQ + (size_t)t_ * 1024 + 256 * s + 32 * q8 + 16); } while (0)
#define G1_ROWS(R_, E_) do { _Pragma("unroll") for (int j_ = 0; j_ < 8; ++j_) R_[j_] = __builtin_amdgcn_raw_buffer_load_b128(rs_U, (E_[j_] << 9) + soff, 0, 0); } while (0)
#define G1_COMP(R_, H0_, H1_, it_) do { int dd_[8]; _Pragma("unroll") for (int j_ = 0; j_ < 8; ++j_) { \
    int d_ = __builtin_amdgcn_sdot4((int)(R_[j_].x & 0x0F0F0F0Fu), (int)H0_.x, 0, false); d_ = __builtin_amdgcn_sdot4((int)((R_[j_].x >> 4) & 0x0F0F0F0Fu), (int)H0_.y, d_, false); \
    d_ = __builtin_amdgcn_sdot4((int)(R_[j_].y & 0x0F0F0F0Fu), (int)H0_.z, d_, false); d_ = __builtin_amdgcn_sdot4((int)((R_[j_].y >> 4) & 0x0F0F0F0Fu), (int)H0_.w, d_, false); \
    d_ = __builtin_amdgcn_sdot4((int)(R_[j_].z & 0x0F0F0F0Fu), (int)H1_.x, d_, false); d_ = __builtin_amdgcn_sdot4((int)((R_[j_].z >> 4) & 0x0F0F0F0Fu), (int)H1_.y, d_, false); \
    d_ = __builtin_amdgcn_sdot4((int)(R_[j_].w & 0x0F0F0F0Fu), (int)H1_.z, d_, false); d_ = __builtin_amdgcn_sdot4((int)((R_[j_].w >> 4) & 0x0F0F0F0Fu), (int)H1_.w, d_, false); \
    dd_[j_] = dpp_add_oct(d_); } \
    if (q8 == 0) { v4u* pp_ = (v4u*)(PART + ((size_t)s * T + t0 + ((it_) >> 1)) * 128 + 16 * oct + 8 * ((it_) & 1)); pp_[0] = (v4u){(unsigned)dd_[0], (unsigned)dd_[1], (unsigned)dd_[2], (unsigned)dd_[3]}; pp_[1] = (v4u){(unsigned)dd_[4], (unsigned)dd_[5], (unsigned)dd_[6], (unsigned)dd_[7]}; } } while (0)
__device__ __forceinline__ void peer_g1_phase(const int wv, int vcu, const unsigned char* HQ, const int* EXPERTS, const unsigned char* U, int* PART) {
    int ln_; asm volatile("v_mbcnt_lo_u32_b32 %0, -1, 0\n\tv_mbcnt_hi_u32_b32 %0, -1, %0" : "=v"(ln_)); const int lane = ln_, oct = lane >> 3, q8 = lane & 7;
    const int s = vcu >> 6;
    const __amdgpu_buffer_rsrc_t rs_U = __builtin_amdgcn_make_buffer_rsrc((void*)U, (short)0, 16384 * 512, 0x00020000);
    const int soff = 128 * s + 16 * q8;
    const int t0 = 512 * (vcu & 63) + 64 * wv;
    int eA[8], eB[8]; v4u rA[8], rB[8], hA0, hA1, hB0, hB1, hC0, hC1;
    G1_IDS(eA, hA0, hA1, 0); G1_ROWS(rA, eA); G1_IDS(eB, hB0, hB1, 1);
#pragma unroll 1
    for (int i = 0; i < 128; i += 2) {
        G1_ROWS(rB, eB); __builtin_amdgcn_sched_barrier(0);
        G1_IDS(eA, hC0, hC1, (i + 2) & 127); __builtin_amdgcn_sched_barrier(0);
        G1_COMP(rA, hA0, hA1, i); __builtin_amdgcn_sched_barrier(0);
        G1_ROWS(rA, eA); hA0 = hC0; hA1 = hC1; __builtin_amdgcn_sched_barrier(0);
        G1_IDS(eB, hC0, hC1, (i + 3) & 127); __builtin_amdgcn_sched_barrier(0);
        G1_COMP(rB, hB0, hB1, i + 1); __builtin_amdgcn_sched_barrier(0);
        hB0 = hC0; hB1 = hC1;
    }
}
__device__ __forceinline__ void peer_g1b_phase(const int* PART, const int* EXPERTS, const float* GATESP, const float* SU, const float* SV, const float* SH, const float* HS, unsigned char* COEFQ, float* SCT, float* CS, int gw, int NGW, int lane) {
    for (int t = gw; t < T; t += NGW) {
        const float sh = SH[t], hoff = 7.5f * HS[t];
        float cf[2]; float am = 0.f;
#pragma unroll
        for (int h2 = 0; h2 < 2; ++h2) {
            const size_t idx = (size_t)t * 128 + 64 * h2 + lane;
            int d = 0;
#pragma unroll
            for (int x = 0; x < 4; ++x) d += PART[(size_t)x * T * 128 + idx];
            const int ev = EXPERTS[idx];
            const float act = ((float)d - hoff) * (sh * SU[ev]);
            cf[h2] = GATESP[idx] * (0.5f * act * (1.f + erff(act * 0.70710678118f))) * SV[ev];
            am = fmaxf(am, fabsf(cf[h2]));
        }
#pragma unroll
        for (int o = 1; o < 64; o <<= 1) am = fmaxf(am, shx(am, lane, o));
        const float inv = am > 0.f ? 127.f / am : 0.f;
        const int q0 = (int)rintf(cf[0] * inv), q1 = (int)rintf(cf[1] * inv);
        COEFQ[(size_t)t * 128 + lane] = (unsigned char)(q0 & 0xff); COEFQ[(size_t)t * 128 + 64 + lane] = (unsigned char)(q1 & 0xff);
        int cs = q0 + q1;
#pragma unroll
        for (int o = 1; o < 64; o <<= 1) cs += shxi(cs, lane, o);
        if (lane == 0) { SCT[t] = am * (1.f / 127.f); CS[t] = (float)cs; }
    }
}
#define G2_IDS(E_, C_, it_) do { const int t_ = t0 + ((it_) >> 1), hf_ = (it_) & 1; const v4u* ep_ = (const v4u*)(EXPERTS + (size_t)t_ * 128 + 16 * oct + 8 * hf_); const v4u ea_ = ep_[0], eb_ = ep_[1]; \
    E_[0] = (int)ea_.x; E_[1] = (int)ea_.y; E_[2] = (int)ea_.z; E_[3] = (int)ea_.w; E_[4] = (int)eb_.x; E_[5] = (int)eb_.y; E_[6] = (int)eb_.z; E_[7] = (int)eb_.w; \
    C_ = *(const u32x2*)(COEFQ + (size_t)t_ * 128 + 16 * oct + 8 * hf_); } while (0)
#define G2_ROWS(R_, E_) do { _Pragma("unroll") for (int j_ = 0; j_ < 8; ++j_) R_[j_] = __builtin_amdgcn_raw_buffer_load_b128(rs_V, (E_[j_] << 9) + soff, 0, 0); } while (0)
#define G2_T4(ob, w0, w1, w2, w3, cq_) do { const unsigned a_ = __builtin_amdgcn_perm(w1, w0, 0x05010400u), b_ = __builtin_amdgcn_perm(w1, w0, 0x07030602u), c_ = __builtin_amdgcn_perm(w3, w2, 0x05010400u), d_ = __builtin_amdgcn_perm(w3, w2, 0x07030602u); \
    const unsigned y0_ = __builtin_amdgcn_perm(c_, a_, 0x05040100u), y1_ = __builtin_amdgcn_perm(c_, a_, 0x07060302u), y2_ = __builtin_amdgcn_perm(d_, b_, 0x05040100u), y3_ = __builtin_amdgcn_perm(d_, b_, 0x07060302u); \
    o[(ob)] = __builtin_amdgcn_sdot4((int)(y0_ & 0x0F0F0F0Fu), cq_, o[(ob)], false); o[(ob) + 4] = __builtin_amdgcn_sdot4((int)((y0_ >> 4) & 0x0F0F0F0Fu), cq_, o[(ob) + 4], false); \
    o[(ob) + 1] = __builtin_amdgcn_sdot4((int)(y1_ & 0x0F0F0F0Fu), cq_, o[(ob) + 1], false); o[(ob) + 5] = __builtin_amdgcn_sdot4((int)((y1_ >> 4) & 0x0F0F0F0Fu), cq_, o[(ob) + 5], false); \
    o[(ob) + 2] = __builtin_amdgcn_sdot4((int)(y2_ & 0x0F0F0F0Fu), cq_, o[(ob) + 2], false); o[(ob) + 6] = __builtin_amdgcn_sdot4((int)((y2_ >> 4) & 0x0F0F0F0Fu), cq_, o[(ob) + 6], false); \
    o[(ob) + 3] = __builtin_amdgcn_sdot4((int)(y3_ & 0x0F0F0F0Fu), cq_, o[(ob) + 3], false); o[(ob) + 7] = __builtin_amdgcn_sdot4((int)((y3_ >> 4) & 0x0F0F0F0Fu), cq_, o[(ob) + 7], false); } while (0)
#define G2_REDI(N, S) do { const bool up_ = (lane & (S)) != 0; _Pragma("unroll") for (int j_ = 0; j_ < (N); ++j_) { const int a_ = o[j_], b_ = o[j_ + (N)]; const int send_ = up_ ? a_ : b_, keep_ = up_ ? b_ : a_; o[j_] = keep_ + shxi(send_, lane, (S)); } } while (0)
#define G2_COMP(R_, C_, it_) do { int o[32]; _Pragma("unroll") for (int k_ = 0; k_ < 32; ++k_) o[k_] = 0; \
    G2_T4(0, R_[0].x, R_[1].x, R_[2].x, R_[3].x, (int)C_.x); G2_T4(8, R_[0].y, R_[1].y, R_[2].y, R_[3].y, (int)C_.x); G2_T4(16, R_[0].z, R_[1].z, R_[2].z, R_[3].z, (int)C_.x); G2_T4(24, R_[0].w, R_[1].w, R_[2].w, R_[3].w, (int)C_.x); \
    G2_T4(0, R_[4].x, R_[5].x, R_[6].x, R_[7].x, (int)C_.y); G2_T4(8, R_[4].y, R_[5].y, R_[6].y, R_[7].y, (int)C_.y); G2_T4(16, R_[4].z, R_[5].z, R_[6].z, R_[7].z, (int)C_.y); G2_T4(24, R_[4].w, R_[5].w, R_[6].w, R_[7].w, (int)C_.y); \
    G2_REDI(16, 8); G2_REDI(8, 16); G2_REDI(4, 32); \
    const int tt_ = t0 + ((it_) >> 1); const float sc_ = SCT[tt_], corr_ = ((it_) & 1) ? 0.f : 7.5f * CS[tt_]; u32x2* xp_ = (u32x2*)(XR + (size_t)tt_ * 1024 + ocol); const u32x2 xw_ = *xp_; \
    f32x4 xv_ = (f32x4){bf_lo(xw_.x), bf_hi(xw_.x), bf_lo(xw_.y), bf_hi(xw_.y)}; \
    xv_.x += sc_ * ((float)o[0] - corr_); xv_.y += sc_ * ((float)o[1] - corr_); xv_.z += sc_ * ((float)o[2] - corr_); xv_.w += sc_ * ((float)o[3] - corr_); \
    if (!NEXT && ((it_) & 1)) { *(f32x4*)(OUT + (size_t)tt_ * 1024 + ocol) = xv_; } else { *xp_ = (u32x2){pk2(xv_.x, xv_.y), pk2(xv_.z, xv_.w)}; } \
    if (NEXT && ((it_) & 1)) { const float y0_ = bf_lo(pk2(xv_.x, 0.f)), y1_ = bf_lo(pk2(xv_.y, 0.f)), y2_ = bf_lo(pk2(xv_.z, 0.f)), y3_ = bf_lo(pk2(xv_.w, 0.f)); \
        const float ss_ = wave_sum((y0_ * y0_ + y1_ * y1_) + (y2_ * y2_ + y3_ * y3_), lane); if (lane == 0) SS[(size_t)s * T + tt_] = ss_; } } while (0)
template <bool NEXT>
__device__ __forceinline__ void peer_g2_phase(const int wv, int vcu, const int* EXPERTS, const unsigned char* COEFQ, const float* SCT, const float* CS, const unsigned char* Vtab, bf16* XR, float* OUT, float* SS) {
    int ln_; asm volatile("v_mbcnt_lo_u32_b32 %0, -1, 0\n\tv_mbcnt_hi_u32_b32 %0, -1, %0" : "=v"(ln_)); const int lane = ln_, oct = lane >> 3, q8 = lane & 7;
    const int s = vcu >> 6;
    const __amdgpu_buffer_rsrc_t rs_V = __builtin_amdgcn_make_buffer_rsrc((void*)Vtab, (short)0, 16384 * 512, 0x00020000);
    const int soff = 128 * s + 16 * q8;
    const int ocol = 256 * s + 32 * q8 + 16 * ((lane >> 3) & 1) + 8 * ((lane >> 4) & 1) + 4 * ((lane >> 5) & 1);
    const int t0 = 512 * (vcu & 63) + 64 * wv;
    int eA[8], eB[8]; u32x2 cA, cB, cC; v4u rA[8], rB[8];
    G2_IDS(eA, cA, 0); G2_ROWS(rA, eA); G2_IDS(eB, cB, 1);
#pragma unroll 1
    for (int i = 0; i < 128; i += 2) {
        G2_ROWS(rB, eB); __builtin_amdgcn_sched_barrier(0);
        G2_IDS(eA, cC, (i + 2) & 127); __builtin_amdgcn_sched_barrier(0);
        G2_COMP(rA, cA, i); __builtin_amdgcn_sched_barrier(0);
        G2_ROWS(rA, eA); cA = cC; __builtin_amdgcn_sched_barrier(0);
        G2_IDS(eB, cC, (i + 3) & 127); __builtin_amdgcn_sched_barrier(0);
        G2_COMP(rB, cB, i + 1); __builtin_amdgcn_sched_barrier(0);
        cB = cC;
    }
}

__device__ __forceinline__ void qknorm_rope_pass(bf16* Q1, bf16* K1, const float* qg, const float* kg, const float* rope, size_t gtid, size_t gthreads) {
    const size_t NROWS = (size_t)2 * 64 * 2 * 4096;
    const int lane = (int)(gtid & 63);
    for (size_t id = gtid; id < NROWS * 8; id += gthreads) {
        const size_t rowg = id >> 3; const int part = (int)(id & 7);
        const bool isk = rowg >= NROWS / 2; const size_t row = isk ? rowg - NROWS / 2 : rowg;
        bf16* ptr = (isk ? K1 : Q1) + row * 64 + part * 8; const float* g = (isk ? kg : qg) + part * 8;
        const int s = (int)(row & 4095); const int bh = (int)(row >> 13); const int bidx = bh >> 3; const size_t mtok = (size_t)bidx * 4096 + s;
        const v4u raw = *(const v4u*)ptr;
        float x[8];
#pragma unroll
        for (int i = 0; i < 4; ++i) { x[2 * i] = bf_lo(raw[i]); x[2 * i + 1] = bf_hi(raw[i]); }
        float ss = 0.f;
#pragma unroll
        for (int i = 0; i < 8; ++i) ss += x[i] * x[i];
        ss += shx(ss, lane, 1); ss += shx(ss, lane, 2); ss += shx(ss, lane, 4);
        const float rstd = rsqrtf(ss * (1.f / 64.f) + EPS);
        float y[8], other[8];
#pragma unroll
        for (int i = 0; i < 8; ++i) y[i] = x[i] * rstd * g[i];
#pragma unroll
        for (int i = 0; i < 8; ++i) other[i] = shx(y[i], lane, 1);
        if (part < 2) { const float* cs = rope + mtok * 16;
#pragma unroll
            for (int i = 0; i < 8; ++i) { const float co = cs[i], si = cs[8 + i]; y[i] = (part == 0) ? (y[i] * co - other[i] * si) : (y[i] * co + other[i] * si); } }
        const float sc = isk ? 1.f : (0.125f * 1.44269504089f);
        v4u o;
#pragma unroll
        for (int i = 0; i < 4; ++i) o[i] = pk2(y[2 * i] * sc, y[2 * i + 1] * sc);
        *(v4u*)ptr = o;
    }
}

#define AT_DMA(kt_, slot_) do { \
    _Pragma("unroll") for (int i_ = 0; i_ < 2; ++i_) { const int row_ = 8 * w + (lane >> 3), ch_ = (lane & 7) ^ ((row_ >> 1) & 7); \
        glds16(K1 + ((size_t)((bh * 2 + i_) * 4096 + (kt_) * 64 + row_)) * 64 + ch_ * 8, (unsigned)__builtin_amdgcn_readfirstlane((int)(ldsb + (slot_) * 32768 + i_ * 8192 + w * 1024))); } \
    _Pragma("unroll") for (int i_ = 0; i_ < 2; ++i_) { const int row_ = 8 * w + 4 * i_ + (lane >> 4), ch_ = (lane & 15) ^ ((row_ & 3) << 2); \
        glds16(V1 + ((size_t)(bh * 4096 + (kt_) * 64 + row_)) * 128 + ch_ * 8, (unsigned)__builtin_amdgcn_readfirstlane((int)(ldsb + (slot_) * 32768 + 16384 + w * 2048 + i_ * 1024))); } } while (0)
typedef short v4i16_t __attribute__((ext_vector_type(4)));
__device__ __forceinline__ bf16x8 vtr8(const LAS bf16* p) {
    const v4i16_t lo = __builtin_amdgcn_ds_read_tr16_b64_v4i16((LAS v4i16_t*)p), hi = __builtin_amdgcn_ds_read_tr16_b64_v4i16((LAS v4i16_t*)(p + 8 * 128));
    return (bf16x8){lo[0], lo[1], lo[2], lo[3], hi[0], hi[1], hi[2], hi[3]};
}
template <bool OFFS>
__device__ __forceinline__ void attn_units(const int wv, LAS unsigned char* lds, int vcu, const bf16* Q1, const bf16* K1, const bf16* V1, bf16* O, const float* subln, float lam, float offs) {
    int ln_; asm volatile("v_mbcnt_lo_u32_b32 %0, -1, 0\n\tv_mbcnt_hi_u32_b32 %0, -1, %0" : "=v"(ln_)); const int tid = wv * 64 + ln_, lane = tid & 63, w = wv, r32 = lane & 31, hi = lane >> 5, qt = w & 3, c = w >> 2;
    LAS float* lbuf = (LAS float*)(lds + 135168 + w * 128);
    LAS float* Obuf = (LAS float*)lds;
    if (wv >= 4) __builtin_amdgcn_s_setprio(1);
    const unsigned ldsb = (unsigned)(uintptr_t)lds;
#pragma unroll 1
    for (int ui = 0; ui < 8; ++ui) {
        const int bh = (vcu >> 5) * 8 + ui, qb = vcu & 31, b = bh >> 3, h = bh & 7;
        bf16x8 bq[4];
#pragma unroll
        for (int ks = 0; ks < 4; ++ks) bq[ks] = *(const bf16x8*)(Q1 + ((size_t)((bh * 2 + c) * 4096 + qb * 128 + qt * 32 + r32)) * 64 + ks * 16 + 8 * hi);
        f32x16 Oa[4];
#pragma unroll
        for (int db = 0; db < 4; ++db)
#pragma unroll
            for (int r = 0; r < 16; ++r) Oa[db][r] = 0.f;
        float lsum = 0.f;
        AT_DMA(0, 0); AT_DMA(1, 1);
        AT_WAIT_BAR();
        const int kx0 = (r32 >> 1) & 7, kx1 = ((32 + r32) >> 1) & 7;
        const int vrow = 4 * hi + ((lane >> 2) & 3), vg = (lane >> 4) & 1, vp = lane & 3;
        f32x16 s0, s1;
        { const LAS unsigned char* Kc = lds + c * 8192;
#pragma unroll
          for (int r = 0; r < 16; ++r) { s0[r] = 0.f; s1[r] = 0.f; }
#pragma unroll
          for (int ks = 0; ks < 4; ++ks) { const bf16x8 a0 = *(const LAS bf16x8*)(Kc + r32 * 128 + (((2 * ks + hi) ^ kx0) << 4)), a1 = *(const LAS bf16x8*)(Kc + (32 + r32) * 128 + (((2 * ks + hi) ^ kx1) << 4));
              s0 = mfma32(a0, bq[ks], s0); s1 = mfma32(a1, bq[ks], s1); } }
        int b0 = 0, b1 = 1, b2 = 2;
#pragma unroll 1
        for (int kt = 0; kt < 64; ++kt) {
            if (kt + 2 < 64) AT_DMA(kt + 2, b2);
            const LAS unsigned char* Kc = lds + b1 * 32768 + c * 8192;
            const LAS unsigned char* Vb = lds + b0 * 32768 + 16384 + vrow * 256 + 8 * (vp & 1);
            f32x16 n0, n1;
#pragma unroll
            for (int r = 0; r < 16; ++r) { n0[r] = 0.f; n1[r] = 0.f; }
            bf16x8 ka[8];
#define AT_KLD(ks_) do { ka[2 * (ks_)] = *(const LAS bf16x8*)(Kc + r32 * 128 + (((2 * (ks_) + hi) ^ kx0) << 4)); ka[2 * (ks_) + 1] = *(const LAS bf16x8*)(Kc + (32 + r32) * 128 + (((2 * (ks_) + hi) ^ kx1) << 4)); } while (0)
            AT_KLD(0); AT_KLD(1);
            __builtin_amdgcn_sched_barrier(0);
#pragma unroll
            for (int ks = 0; ks < 4; ++ks) {
                n0 = mfma32(ka[2 * ks], bq[ks], n0);
#pragma unroll
                for (int r = 0; r < 4; ++r) s0[4 * ks + r] = __builtin_amdgcn_exp2f(OFFS ? s0[4 * ks + r] - offs : s0[4 * ks + r]);
                __builtin_amdgcn_sched_barrier(0);
                n1 = mfma32(ka[2 * ks + 1], bq[ks], n1);
                if (ks < 2) AT_KLD(ks + 2);
#pragma unroll
                for (int r = 0; r < 4; ++r) s1[4 * ks + r] = __builtin_amdgcn_exp2f(OFFS ? s1[4 * ks + r] - offs : s1[4 * ks + r]);
                __builtin_amdgcn_sched_barrier(0);
            }
#undef AT_KLD
            bf16x8 pa[4]; bf16x8 vf[4], vn[4];
#pragma unroll
            for (int db = 0; db < 4; ++db) vf[db] = vtr8((const LAS bf16*)(Vb + (((4 * db + 2 * vg + (vp >> 1)) ^ ((vrow & 3) << 2)) << 4)));
            float ls = 0.f;
            { v4u t0;
#pragma unroll
              for (int k = 0; k < 4; ++k) { t0[k] = pk2(s0[2 * k], s0[2 * k + 1]); ls += s0[2 * k] + s0[2 * k + 1]; }
              pa[0] = __builtin_bit_cast(bf16x8, t0); }
            __builtin_amdgcn_sched_barrier(0);
#pragma unroll
            for (int sp_ = 0; sp_ < 4; ++sp_) {
                if (sp_ < 3) {
#pragma unroll
                    for (int db = 0; db < 4; ++db) vn[db] = vtr8((const LAS bf16*)(Vb + (16 * (sp_ + 1)) * 256 + (((4 * db + 2 * vg + (vp >> 1)) ^ ((vrow & 3) << 2)) << 4)));
                }
#pragma unroll
                for (int db = 0; db < 4; ++db) Oa[db] = mfma32(pa[sp_], vf[db], Oa[db]);
                if (sp_ < 3) { v4u t0;
#pragma unroll
                    for (int k = 0; k < 4; ++k) { const float x0 = (sp_ == 0) ? s0[8 + 2 * k] : (sp_ == 1 ? s1[2 * k] : s1[8 + 2 * k]), x1 = (sp_ == 0) ? s0[9 + 2 * k] : (sp_ == 1 ? s1[2 * k + 1] : s1[9 + 2 * k]); t0[k] = pk2(x0, x1); ls += x0 + x1; }
                    pa[sp_ + 1] = __builtin_bit_cast(bf16x8, t0); }
                __builtin_amdgcn_sched_barrier(0);
                if (sp_ < 3) {
#pragma unroll
                    for (int db = 0; db < 4; ++db) vf[db] = vn[db];
                }
            }
            lsum += ls;
            s0 = n0; s1 = n1;
            { const int tb = b0; b0 = b1; b1 = b2; b2 = tb; }
            AT_WAIT_BAR();
        }
        lsum += shx(lsum, lane, 32);
        lbuf[r32] = lsum;
#pragma unroll
        for (int r = 0; r < 16; ++r) { const int qrow = (r & 3) + 8 * (r >> 2) + 4 * hi; const float inv = 1.f / lbuf[qrow];
#pragma unroll
            for (int db = 0; db < 4; ++db) Obuf[(c * 128 + qt * 32 + qrow) * 132 + 32 * db + r32] = Oa[db][r] * inv; }
        __syncthreads();
        { const int row = tid >> 2, qd = tid & 3;
          float dv[32]; float ss = 0.f;
#pragma unroll
          for (int k = 0; k < 8; ++k) { const f32x4 o0 = *(const LAS f32x4*)(Obuf + row * 132 + qd * 32 + 4 * k), o1 = *(const LAS f32x4*)(Obuf + (128 + row) * 132 + qd * 32 + 4 * k);
#pragma unroll
              for (int e = 0; e < 4; ++e) { const float d = o0[e] - lam * o1[e]; dv[4 * k + e] = d; ss += d * d; } }
          ss += shx(ss, lane, 1); ss += shx(ss, lane, 2);
          const float rstd = rsqrtf(ss * (1.f / 128.f) + EPS) * (1.f - LAMBDA_INIT);
          bf16* op = O + ((size_t)b * 4096 + qb * 128 + row) * 1024 + h * 128 + qd * 32;
#pragma unroll
          for (int k = 0; k < 4; ++k) { v4u o;
#pragma unroll
              for (int e = 0; e < 4; ++e) o[e] = pk2(dv[8 * k + 2 * e] * rstd * subln[qd * 32 + 8 * k + 2 * e], dv[8 * k + 2 * e + 1] * rstd * subln[qd * 32 + 8 * k + 2 * e + 1]);
              *(v4u*)(op + 8 * k) = o; } }
        __syncthreads();
    }
    __builtin_amdgcn_s_setprio(0);
}
__device__ __forceinline__ void attn_phase(const int wv, LAS unsigned char* lds, int vcu, const bf16* Q1, const bf16* K1, const bf16* V1, bf16* O, const float* qg, const float* kg,
                                           const float* lq1, const float* lk1, const float* lq2, const float* lk2, const float* subln) {
    float s1 = 0.f, s2 = 0.f, mq = 0.f, mk = 0.f;
    for (int i = 0; i < 64; ++i) { s1 += lq1[i] * lk1[i]; s2 += lq2[i] * lk2[i]; mq = fmaxf(mq, fabsf(qg[i])); mk = fmaxf(mk, fabsf(kg[i])); }
    const float lam = expf(s1) - expf(s2) + LAMBDA_INIT;
    const float offs = 8.f * mq * mk * 1.44269504089f * 1.02f + 0.25f;
    if (offs < 24.f) attn_units<false>(wv, lds, vcu, Q1, K1, V1, O, subln, lam, 0.f);
    else attn_units<true>(wv, lds, vcu, Q1, K1, V1, O, subln, lam, offs);
}
#undef AT_LOAD
#undef AT_WRITE
struct Args { const void* in[27]; float* out; unsigned char* ws; };
#define KARG(i) ({ GAS const void* p_; asm volatile("s_load_dwordx2 %0, %1, %2\n\ts_waitcnt lgkmcnt(0)" : "=s"(p_) : "s"(__builtin_amdgcn_kernarg_segment_ptr()), "i"(8 * (i))); (const void*)p_; })
#define KIN(i) ((const float*)KARG(i))
#define KOUT() ((float*)KARG(27))
#define KWS() ((unsigned char*)KARG(28))
#define WSP(T_, off) ((T_*)(KWS() + (off)))
__global__ void __launch_bounds__(NWAVES * 64, 2) mk_fwd(Args args) {
    extern __shared__ __attribute__((aligned(16))) unsigned char lds_raw[];
    LAS unsigned char* lds = (LAS unsigned char*)lds_raw;
    const int G = gridDim.x, bx = blockIdx.x;
    const int wv = __builtin_amdgcn_readfirstlane((int)(threadIdx.x >> 6));
    const int vcu = (G % 8 == 0) ? (bx % 8) * (G / 8) + bx / 8 : bx;
#define PH_IDS() int ln_; asm volatile("v_mbcnt_lo_u32_b32 %0, -1, 0\n\tv_mbcnt_hi_u32_b32 %0, -1, %0" : "=v"(ln_)); const int lane = ln_, wave = wv, tid = wv * 64 + ln_; \
    const int gw = vcu * NWAVES + wave, NGW = G * NWAVES; const size_t gtid = (size_t)vcu * (NWAVES * 64) + tid, gthreads = (size_t)G * (NWAVES * 64); (void)lane; (void)gw; (void)NGW; (void)gtid; (void)gthreads
    if (threadIdx.x < 32) ((LAS unsigned*)(lds + MISC_OFF))[threadIdx.x] = 0u;
    __syncthreads();
    (void)xcd_barrier_post((unsigned*)(WSP(gu32, WS_CTL) + CW_BAR), (volatile LAS unsigned*)(lds + MISC_OFF) + 8);
#define STAMP() do {} while (0)
#ifndef PROBE_DUP
#define PROBE_DUP 0
#endif
#define REPS(bit) _Pragma("unroll 1") for (int rep_ = 0; rep_ < 1 + ((PROBE_DUP >> (bit)) & 1); ++rep_)
#define GRID_BAR1() do { XcdBarrier b_; b_.bar = (unsigned*)(WSP(gu32, WS_CTL) + CW_BAR); b_.x = xb_xcc_id(); b_.st = (volatile LAS unsigned*)(lds + MISC_OFF) + 8; xcd_barrier(b_); } while (0)
#define GRID_BAR() do { GRID_BAR1(); if ((PROBE_DUP >> 9) & 1) GRID_BAR1(); } while (0)

    REPS(5) {
        PH_IDS();
        LAS float* scr = (LAS float*)(lds + wave * 16384);
        constexpr int I0 = 16 * 97, I1 = 16 * 32, I2 = 16 * 64, I3 = 16 * 96, I4 = 16 * 32, I5 = 16 * 64, NITEMS = I0 + I1 + I2 + I3 + I4 + I5;
        for (int it = gw; it < NITEMS; it += NGW) {
            int r = it;
            if (r < I0) { p0_transpose_item(KIN(3), 1024, 3104, WSP(bf16, WS_WIN), scr, r, lane); continue; } r -= I0;
            if (r < I1) { p0_transpose_item(KIN(6), 1024, 1024, WSP(bf16, WS_WO0), scr, r, lane); continue; } r -= I1;
            if (r < I2) { p0_transpose_item(KIN(8), 1024, 2048, WSP(bf16, WS_WQ0), scr, r, lane); continue; } r -= I2;
            if (r < I3) { p0_transpose_item(KIN(13), 1024, 3072, WSP(bf16, WS_WQKV), scr, r, lane, KIN(12)); continue; } r -= I3;
            if (r < I4) { p0_transpose_item(KIN(21), 1024, 1024, WSP(bf16, WS_WO1), scr, r, lane); continue; } r -= I4;
            p0_transpose_item(KIN(23), 1024, 2048, WSP(bf16, WS_WQ1), scr, r, lane);
        }
        { bf16* WIN = WSP(bf16, WS_WIN); for (size_t i = gtid * 8; i < (size_t)224 * 1024; i += gthreads * 8) *(v4u*)(WIN + (size_t)3104 * 1024 + i) = (v4u){0u, 0u, 0u, 0u}; }
        cvt_range(KIN(9), WSP(bf16, WS_KEY0), (size_t)262144, gtid, gthreads);
        cvt_range(KIN(24), WSP(bf16, WS_KEY1), (size_t)262144, gtid, gthreads);
        rms_q8_pass(KIN(0), KIN(2), WSP(unsigned char, WS_B0), WSP(float, WS_I8 + 13 * MiB), gw, NGW, lane);
        { const int* positions = (const int*)KARG(1); float* ROPE = WSP(float, WS_ROPE);
          for (size_t id = gtid; id < (size_t)T * 8; id += gthreads) { const size_t mtok = id >> 3; const int i = (int)(id & 7);
            const float inv = powf(500000.0f, -(float)i * 2.0f / 16.0f); const float ang = (float)positions[mtok] * inv;
            float sn, cs; sincosf(ang, &sn, &cs); ROPE[mtok * 16 + i] = cs; ROPE[mtok * 16 + 8 + i] = sn; } }
    }
    GRID_BAR();
    { PH_IDS(); quant8_rows_bf16(WSP(bf16, WS_WIN), WSP(unsigned char, WS_I8 + 8 * MiB), WSP(float, WS_I8 + 12 * MiB), 3328, gw, NGW, lane); }
    GRID_BAR();
    REPS(3) {
        unsigned char* ws = KWS();
        pg8::Gemm g{(const bf16*)(ws + WS_B0), (const bf16*)(ws + WS_I8 + 8 * MiB), T, 3328, 512}; pg8::StaticOrder S; S.init(T, 3328, G, bx);
        pg8::EpiInProj E{(bf16*)(ws + WS_R1), (bf16*)(ws + WS_R1 + 32 * MiB), (bf16*)(ws + WS_R2), (bf16*)(ws + WS_R3), (float*)(ws + WS_GATES), KIN(4), (const float*)(ws + WS_I8 + 13 * MiB), (const float*)(ws + WS_I8 + 12 * MiB)};
        pg8::gemm_phase<pg8::EpiInProj, pg8::StaticOrder, true, true>(lds, g, S, E, wv);
    }
    GRID_BAR();
    if ((bx >> 3) & 1) { PH_IDS(); const int gwi = ((bx >> 4) * 8 + (bx & 7)) * NWAVES + wave, NGWI = 128 * NWAVES; (void)gw; (void)NGW;
        quant4_rows(KIN(10), WSP(unsigned char, WS_U0), WSP(float, WS_SC), 16384, gwi, NGWI, lane);
        quant4_rows(KIN(11), WSP(unsigned char, WS_V0T), WSP(float, WS_SC + 65536), 16384, gwi, NGWI, lane);
        quant4_rows(KIN(25), WSP(unsigned char, WS_U1), WSP(float, WS_SC + 2 * 65536), 16384, gwi, NGWI, lane);
        quant4_rows(KIN(26), WSP(unsigned char, WS_V1T), WSP(float, WS_SC + 3 * 65536), 16384, gwi, NGWI, lane);
        quant8_rows_bf16(WSP(bf16, WS_WQ0), WSP(unsigned char, WS_I8), WSP(float, WS_I8 + 4 * MiB), 2048, gwi, NGWI, lane);
        quant8_rows_bf16(WSP(bf16, WS_WQ1), WSP(unsigned char, WS_I8 + 2 * MiB), WSP(float, WS_I8 + 4 * MiB + 8192), 2048, gwi, NGWI, lane); }
    REPS(2) { unsigned char* ws = KWS(); mlstm_phase(wv, lds, (const bf16*)(ws + WS_R1), (const bf16*)(ws + WS_R1 + 32 * MiB), (const bf16*)(ws + WS_R2), (const float*)(ws + WS_GATES), (bf16*)(ws + WS_R4), (bf16*)(ws + WS_R5)); }
    GRID_BAR();
    REPS(6) { PH_IDS(); unsigned char* ws = KWS(); hs_pass((const bf16*)(ws + WS_R4), (const bf16*)(ws + WS_R5), (const bf16*)(ws + WS_R3), KIN(5), (bf16*)(ws + WS_B0), gw, NGW, lane); }
    GRID_BAR();
#pragma unroll 1
    for (int L = 0; L < 2; ++L) {
        if (L == 1) {
            REPS(3) {
                unsigned char* ws = KWS();
                pg8::Gemm g{(const bf16*)(ws + WS_R1), (const bf16*)(ws + WS_WQKV), T, 3072, 1024}; pg8::StaticOrder S; S.init(T, 3072, G, bx);
                pg8::EpiQKV E{(bf16*)(ws + WS_R2), (bf16*)(ws + WS_R3), (bf16*)(ws + WS_R4), (const float*)(ws + 3 * MiB), KIN(14), KIN(15), (const float*)(ws + WS_ROPE), (LAS float*)(lds + 131072)};
                pg8::gemm_phase<pg8::EpiQKV, pg8::StaticOrder, true, true>(lds, g, S, E, wv);
            }
            GRID_BAR();
            REPS(0) { unsigned char* ws = KWS(); attn_phase(wv, lds, vcu, (const bf16*)(ws + WS_R2), (const bf16*)(ws + WS_R3), (const bf16*)(ws + WS_R4), (bf16*)(ws + WS_B0), KIN(14), KIN(15), KIN(16), KIN(17), KIN(18), KIN(19), KIN(20)); }
            GRID_BAR();
        }
        _Pragma("unroll 1") for (int rep_ = 0; rep_ < 1 + ((L == 0) ? ((PROBE_DUP >> 3) & 1) : 0); ++rep_) {
            unsigned char* ws = KWS();
            pg8::Gemm g{(const bf16*)(ws + WS_B0), (const bf16*)(ws + (L ? WS_WO1 : WS_WO0)), T, 1024, 1024}; pg8::StaticOrder S; S.init(T, 1024, G, bx);
            if (L == 0) { pg8::EpiRes<false> E{KIN(0), (bf16*)(ws + WS_R1)}; pg8::gemm_phase<pg8::EpiRes<false>, pg8::StaticOrder, true, true>(lds, g, S, E, wv); }
            else { pg8::EpiRes<true> E{ws + WS_R1, (bf16*)(ws + WS_R1)}; pg8::gemm_phase<pg8::EpiRes<true>, pg8::StaticOrder, true, true>(lds, g, S, E, wv); }
        }
        GRID_BAR();
        REPS(7) { PH_IDS(); unsigned char* ws = KWS(); rms_quant_pass((const bf16*)(ws + WS_R1), L ? KIN(22) : KIN(7), (bf16*)(ws + WS_B0), ws + WS_R5, (float*)(ws + WS_SC + 4 * 65536), (float*)(ws + WS_SC + 6 * 65536), gw, NGW, lane); }
        GRID_BAR();
        REPS(3) {
            unsigned char* ws = KWS();
            pg8::Gemm g{(const bf16*)(ws + WS_R5), (const bf16*)(ws + WS_I8 + (L ? 2 : 0) * MiB), T, 2048, 512}; pg8::StaticOrder S; S.init(T, 2048, G, bx);
            pg8::EpiPlainI8 E{(bf16*)(ws + WS_R2), 2048, (const float*)(ws + WS_SC + 4 * 65536), (const float*)(ws + WS_I8 + 4 * MiB + (L ? 8192 : 0))};
            pg8::gemm_phase<pg8::EpiPlainI8, pg8::StaticOrder, true, true>(lds, g, S, E, wv);
        }
        GRID_BAR();
        REPS(4) { unsigned char* ws = KWS(); peer_topk_phase(wv, lds, vcu, (const bf16*)(ws + WS_R2), (const bf16*)(ws + (L ? WS_KEY1 : WS_KEY0)), (int*)(ws + WS_R4), (float*)(ws + WS_R4 + 16 * MiB)); }
        GRID_BAR();
        REPS(1) { unsigned char* ws = KWS(); peer_g1_phase(wv, vcu, ws + WS_R5, (const int*)(ws + WS_R4), ws + (L ? WS_U1 : WS_U0), (int*)(ws + WS_R2)); }
        GRID_BAR();
        { PH_IDS(); unsigned char* ws = KWS(); const size_t so = L ? 2 * 65536 : 0;
          peer_g1b_phase((const int*)(ws + WS_R2), (const int*)(ws + WS_R4), (const float*)(ws + WS_R4 + 16 * MiB), (const float*)(ws + WS_SC + so), (const float*)(ws + WS_SC + so + 65536),
                         (const float*)(ws + WS_SC + 4 * 65536), (const float*)(ws + WS_SC + 6 * 65536), ws + WS_R4 + 32 * MiB, (float*)(ws + WS_SC + 10 * 65536), (float*)(ws + WS_SC + 8 * 65536), gw, NGW, lane); }
        GRID_BAR();
        if (L == 0) { unsigned char* ws = KWS(); peer_g2_phase<true>(wv, vcu, (const int*)(ws + WS_R4), ws + WS_R4 + 32 * MiB, (const float*)(ws + WS_SC + 10 * 65536), (const float*)(ws + WS_SC + 8 * 65536), ws + WS_V0T, (bf16*)(ws + WS_R1), nullptr, (float*)(ws + 3 * MiB)); GRID_BAR(); }
        else { unsigned char* ws = KWS(); peer_g2_phase<false>(wv, vcu, (const int*)(ws + WS_R4), ws + WS_R4 + 32 * MiB, (const float*)(ws + WS_SC + 10 * 65536), (const float*)(ws + WS_SC + 8 * 65536), ws + WS_V1T, (bf16*)(ws + WS_R1), KOUT(), nullptr); }
    }
#undef GRID_BAR
}

extern "C" void kernel_launch(void* const* d_in, const int* in_sizes, int n_in, void* d_out, int out_size, void* d_ws, size_t ws_size, hipStream_t stream) {
    static int ready = 0;
    if (ready == 0) {
        if (n_in != 27 || out_size != T * D || ws_size < WS_END) { fprintf(stderr, "kernel_launch: unexpected problem (n_in %d, out %d, ws %zu)\n", n_in, out_size, ws_size); ready = -1; return; }
        if (hipFuncSetAttribute((const void*)mk_fwd, hipFuncAttributeMaxDynamicSharedMemorySize, LDS_BYTES) != hipSuccess) { fprintf(stderr, "kernel_launch: hipFuncSetAttribute failed\n"); ready = -1; return; }
        (void)hipGetLastError();
        ready = 1;
    }
    if (ready < 0) return;
    if (hipMemsetAsync((char*)d_ws + WS_CTL, 0, CTL_ZERO_BYTES, stream) != hipSuccess) { fprintf(stderr, "kernel_launch: memset failed\n"); return; }
    Args a{};
    for (int i = 0; i < 27; ++i) a.in[i] = d_in[i];
    a.out = (float*)d_out; a.ws = (unsigned char*)d_ws;
    hipLaunchKernelGGL(mk_fwd, dim3(256), dim3(NWAVES * 64), LDS_BYTES, stream, a);
}
```

```cpp
#include <hip/hip_runtime.h>
#include <hip/hip_bf16.h>
#include <cstdio>
#include <cstdint>
#include <cmath>
namespace pg8 {
#define PG8_LAS __attribute__((address_space(3)))
typedef unsigned short bf16_t;
typedef short bf16x8 __attribute__((ext_vector_type(8)));
typedef float f32x4 __attribute__((ext_vector_type(4)));
typedef unsigned u32x4 __attribute__((ext_vector_type(4)));
constexpr int BM = 256, BK = 64, HALF = 128, HTB = HALF * BK * 2  , STAGE_BYTES = 8 * HTB, NXCD = 8, WGM = 8;

__host__ __device__ __forceinline__ int lds_byte(int r, int c) { const int st = (r >> 4) * 2 + (c >> 5), rr = r & 15, cc = c & 31, ob = rr * 64 + cc * 2; return st * 1024 + (ob ^ (((ob >> 9) & 1) << 5)); }
__host__ __device__ __forceinline__ void stage_rc(int b, int& R, int& C) { const int st = b / 1024, sb = b % 1024, swz = sb ^ (((sb >> 9) & 1) << 5); R = (st >> 1) * 16 + swz / 64; C = (st & 1) * 32 + (swz % 64) / 2; }
__host__ __device__ __forceinline__ int perm32(int rho) { const int n = rho >> 4, i = rho & 15; return 8 * (i >> 2) + 4 * n + (i & 3); }

struct Unit { int pm, pn; };
struct Gemm { const bf16_t* A; const bf16_t* Bt; int M, N, K; };

struct StaticOrder {
    int nM, nN, nwg, G, c;
    __host__ __device__ void init(int M, int N, int G_, int c_) { nM = M / BM; nN = N / BM; nwg = nM * nN; G = G_; c = c_; }
    __host__ __device__ bool next(int i, Unit& u) const {
        const long L = (long)i * G + c; if (L >= nwg) return false;
        int wgid = (int)L; { const int q = nwg / NXCD, r = nwg % NXCD, xcd = wgid % NXCD, off = wgid / NXCD; wgid = (xcd < r ? xcd * (q + 1) : r * (q + 1) + (xcd - r) * q) + off; }
        const int nig = WGM * nN, gid = wgid / nig, fm = gid * WGM, gsz = (nM - fm) < WGM ? (nM - fm) : WGM;
        u.pm = fm + ((wgid % nig) % gsz); u.pn = (wgid % nig) / gsz; return true;
    }
    __device__ __forceinline__ void a_ready(const Unit&) const {}
    __device__ __forceinline__ void done(const Unit&) const {}
};
__device__ __forceinline__ unsigned cvt_pk_bf16(float lo, float hi) { unsigned r; asm volatile("v_cvt_pk_bf16_f32 %0, %1, %2" : "=v"(r) : "v"(lo), "v"(hi)); return r; }
typedef float f32x2 __attribute__((ext_vector_type(2)));
typedef unsigned u32x2 __attribute__((ext_vector_type(2)));
typedef int i32x4 __attribute__((ext_vector_type(4)));
__device__ __forceinline__ u32x4 pack8(const f32x4 v0, const f32x4 v1) { u32x4 w; w.x = cvt_pk_bf16(v0[0], v0[1]); w.y = cvt_pk_bf16(v0[2], v0[3]); w.z = cvt_pk_bf16(v1[0], v1[1]); w.w = cvt_pk_bf16(v1[2], v1[3]); return w; }
struct EpiPlain {
    static constexpr bool PERM = true, AFTER_DRAIN = false, I8 = false;
    bf16_t* O; int ldc;
    __device__ __forceinline__ void operator()(const f32x4 (&acc)[2][2][4][2], const Unit& u, int wr, int wc, int fr, int fq) const {
        const int row0 = u.pm * BM + wr * 64 + fr, col0 = u.pn * BM + wc * 32 + 8 * fq;
#pragma unroll
        for (int ai = 0; ai < 2; ++ai)
#pragma unroll
            for (int m = 0; m < 4; ++m) { bf16_t* rowp = O + (size_t)(row0 + ai * HALF + m * 16) * ldc + col0;
#pragma unroll
                for (int bj = 0; bj < 2; ++bj) *(u32x4*)(rowp + bj * HALF) = pack8(acc[ai][bj][m][0], acc[ai][bj][m][1]); }
    }
};
struct EpiPlainI8 {
    static constexpr bool PERM = true, AFTER_DRAIN = false, I8 = true;
    bf16_t* O; int ldc; const float* rs; const float* cs;
    __device__ __forceinline__ void operator()(const f32x4 (&acc)[2][2][4][2], const Unit& u, int wr, int wc, int fr, int fq) const {
        const int row0 = u.pm * BM + wr * 64 + fr, col0 = u.pn * BM + wc * 32 + 8 * fq;
        f32x4 c0[2], c1[2];
#pragma unroll
        for (int bj = 0; bj < 2; ++bj) { c0[bj] = *(const f32x4*)(cs + col0 + bj * HALF); c1[bj] = *(const f32x4*)(cs + col0 + bj * HALF + 4); }
#pragma unroll
        for (int ai = 0; ai < 2; ++ai)
#pragma unroll
            for (int m = 0; m < 4; ++m) { const int row = row0 + ai * HALF + m * 16; const float r = rs[row]; bf16_t* rowp = O + (size_t)row * ldc + col0;
#pragma unroll
                for (int bj = 0; bj < 2; ++bj) { const i32x4 a0 = __builtin_bit_cast(i32x4, acc[ai][bj][m][0]), a1 = __builtin_bit_cast(i32x4, acc[ai][bj][m][1]);
                    const f32x4 v0 = (f32x4){(float)a0[0], (float)a0[1], (float)a0[2], (float)a0[3]} * r * c0[bj], v1 = (f32x4){(float)a1[0], (float)a1[1], (float)a1[2], (float)a1[3]} * r * c1[bj];
                    *(u32x4*)(rowp + bj * HALF) = pack8(v0, v1); } }
    }
};
template <bool BASE_BF16> struct EpiRes {
    static constexpr bool PERM = true, AFTER_DRAIN = false, I8 = false;
    const void* base; bf16_t* out;
    __device__ __forceinline__ void operator()(const f32x4 (&acc)[2][2][4][2], const Unit& u, int wr, int wc, int fr, int fq) const {
        const int col0 = u.pn * BM + wc * 32 + 8 * fq;
#pragma unroll
        for (int ai = 0; ai < 2; ++ai)
#pragma unroll
            for (int m = 0; m < 4; ++m) { const size_t off = (size_t)(u.pm * BM + ai * HALF + wr * 64 + m * 16 + fr) * 1024 + col0;
#pragma unroll
                for (int bj = 0; bj < 2; ++bj) { f32x4 b0, b1;
                    if (BASE_BF16) { const u32x4 w = *(const u32x4*)((const bf16_t*)base + off + bj * HALF);
                        b0 = (f32x4){__uint_as_float(w.x << 16), __uint_as_float(w.x & 0xffff0000u), __uint_as_float(w.y << 16), __uint_as_float(w.y & 0xffff0000u)};
                        b1 = (f32x4){__uint_as_float(w.z << 16), __uint_as_float(w.z & 0xffff0000u), __uint_as_float(w.w << 16), __uint_as_float(w.w & 0xffff0000u)}; }
                    else { b0 = *(const f32x4*)((const float*)base + off + bj * HALF); b1 = *(const f32x4*)((const float*)base + off + bj * HALF + 4); }
                    *(u32x4*)(out + off + bj * HALF) = pack8(b0 + acc[ai][bj][m][0], b1 + acc[ai][bj][m][1]); } }
    }
};
struct EpiInProj {
    static constexpr bool PERM = true, AFTER_DRAIN = false, I8 = false;
    bf16_t *Q, *Kk, *V, *OG; float* gates; const float* bg;
    __device__ __forceinline__ void operator()(const f32x4 (&acc)[2][2][4][2], const Unit& u, int wr, int wc, int fr, int fq) const {
        const int colt = u.pn * BM;
#pragma unroll
        for (int ai = 0; ai < 2; ++ai)
#pragma unroll
            for (int m = 0; m < 4; ++m) { const int row = u.pm * BM + ai * HALF + wr * 64 + m * 16 + fr, b = row >> 12, s = row & 4095;
#pragma unroll
                for (int bj = 0; bj < 2; ++bj) { const int cb = colt + bj * HALF + wc * 32 + 8 * fq; f32x4 v0 = acc[ai][bj][m][0], v1 = acc[ai][bj][m][1];
                    if (colt < 1024) { const bool isq = colt < 512; bf16_t* base = isq ? Q : Kk; const int c2 = cb & 511, head = c2 >> 6, d = c2 & 63;
                        if (isq) { v0 = v0 * 0.125f; v1 = v1 * 0.125f; }
                        *(u32x4*)(base + ((size_t)((b * 8 + head) * 4096 + s)) * 64 + d) = pack8(v0, v1); }
                    else if (colt < 2048) { const int c2 = cb - 1024, head = c2 >> 7, dv = c2 & 127; *(u32x4*)(V + ((size_t)((b * 8 + head) * 4096 + s)) * 128 + dv) = pack8(v0, v1); }
                    else if (colt < 3072) { *(u32x4*)(OG + (size_t)row * 1024 + (cb - 2048)) = pack8(v0, v1); }
                    else if (cb < 3104) { const int gi = cb - 3072; float* g = gates + (size_t)row * 32 + gi;
                        *(f32x4*)g = v0 + *(const f32x4*)(bg + gi); *(f32x4*)(g + 4) = v1 + *(const f32x4*)(bg + gi + 4); } } }
    }
};
struct EpiQKV {
    static constexpr bool PERM = true, AFTER_DRAIN = false, I8 = false;
    bf16_t *Q, *Kk, *V; const float* SS; const float* qg; const float* kg; const float* rope; PG8_LAS float* xch;
    __device__ __forceinline__ void operator()(const f32x4 (&acc)[2][2][4][2], const Unit& u, int wr, int wc, int fr_, int fq_) const {
        int fr = fr_, fq = fq_; asm volatile("" : "+v"(fr), "+v"(fq));
        const int colt = u.pn * BM, lane = fq * 16 + fr, wave = wr * 4 + wc;
        float rsr[2][4];
#pragma unroll
        for (int ai = 0; ai < 2; ++ai)
#pragma unroll
            for (int m = 0; m < 4; ++m) { const int row = u.pm * BM + ai * HALF + wr * 64 + m * 16 + fr;
                rsr[ai][m] = __builtin_amdgcn_rsqf(((SS[row] + SS[32768 + row]) + (SS[2 * 32768 + row] + SS[3 * 32768 + row])) * (1.f / 1024.f) + 1e-6f); }
        if (colt >= 2048) {
#pragma unroll
            for (int ai = 0; ai < 2; ++ai)
#pragma unroll
                for (int m = 0; m < 4; ++m) { const int row = u.pm * BM + ai * HALF + wr * 64 + m * 16 + fr, b = row >> 12, s = row & 4095; const float rs = rsr[ai][m];
#pragma unroll
                    for (int bj = 0; bj < 2; ++bj) { const int cb = colt + bj * HALF + wc * 32 + 8 * fq; const int c2 = cb - 2048, head = c2 >> 7, dv = c2 & 127;
                        *(u32x4*)(V + ((size_t)((b * 8 + head) * 4096 + s)) * 128 + dv) = pack8(acc[ai][bj][m][0] * rs, acc[ai][bj][m][1] * rs); } }
            return;
        }
#pragma unroll
        for (int ai = 0; ai < 2; ++ai)
#pragma unroll
            for (int m = 0; m < 4; ++m)
#pragma unroll
                for (int bj = 0; bj < 2; ++bj) { const f32x4 a = acc[ai][bj][m][0] * rsr[ai][m], c = acc[ai][bj][m][1] * rsr[ai][m];
                    float ss = ((a[0] * a[0] + a[1] * a[1]) + (a[2] * a[2] + a[3] * a[3])) + ((c[0] * c[0] + c[1] * c[1]) + (c[2] * c[2] + c[3] * c[3]));
                    ss += __uint_as_float((unsigned)__builtin_amdgcn_ds_bpermute((lane ^ 16) << 2, (int)__float_as_uint(ss)));
                    ss += __uint_as_float((unsigned)__builtin_amdgcn_ds_bpermute((lane ^ 32) << 2, (int)__float_as_uint(ss)));
                    if (fq == 0) xch[(((wave * 2 + ai) * 4 + m) * 2 + bj) * 16 + fr] = ss; }
        __syncthreads();
        const bool isq = colt < 1024; bf16_t* base = isq ? Q : Kk; const float* gn = isq ? qg : kg; const float osc = isq ? (0.125f * 1.44269504089f) : 1.f;
        const int d0 = 32 * (wc & 1) + 8 * fq;
        const f32x4 g0 = *(const f32x4*)(gn + d0), g1 = *(const f32x4*)(gn + d0 + 4);
        const bool rot = ((wc & 1) == 0) && (fq < 2);
#pragma unroll
        for (int ai = 0; ai < 2; ++ai)
#pragma unroll
            for (int m = 0; m < 4; ++m) { const int row = u.pm * BM + ai * HALF + wr * 64 + m * 16 + fr, b = row >> 12, s = row & 4095;
                f32x4 co0 = {0.f, 0.f, 0.f, 0.f}, co1 = co0, si0 = co0, si1 = co0;
                if (rot) { const float* cs = rope + (size_t)row * 16; co0 = *(const f32x4*)cs; co1 = *(const f32x4*)(cs + 4); si0 = *(const f32x4*)(cs + 8); si1 = *(const f32x4*)(cs + 12); }
#pragma unroll
                for (int bj = 0; bj < 2; ++bj) { const float tot = xch[(((wave * 2 + ai) * 4 + m) * 2 + bj) * 16 + fr] + xch[((((wave ^ 1) * 2 + ai) * 4 + m) * 2 + bj) * 16 + fr];
                    const float rn = __builtin_amdgcn_rsqf(tot * (1.f / 64.f) + 1e-6f) * rsr[ai][m];
                    f32x4 y0 = acc[ai][bj][m][0] * rn * g0, y1 = acc[ai][bj][m][1] * rn * g1;
                    f32x4 p0, p1;
#pragma unroll
                    for (int i = 0; i < 4; ++i) { p0[i] = __uint_as_float((unsigned)__builtin_amdgcn_ds_bpermute((lane ^ 16) << 2, (int)__float_as_uint(y0[i]))); p1[i] = __uint_as_float((unsigned)__builtin_amdgcn_ds_bpermute((lane ^ 16) << 2, (int)__float_as_uint(y1[i]))); }
                    if (rot) { const float sg = (fq == 0) ? -1.f : 1.f; y0 = y0 * co0 + p0 * si0 * sg; y1 = y1 * co1 + p1 * si1 * sg; }
                    const int cb = colt + bj * HALF + wc * 32 + 8 * fq; const int c2 = cb & 1023, head = c2 >> 7, c = (c2 >> 6) & 1, d = c2 & 63;
                    *(u32x4*)(base + ((size_t)(((b * 8 + head) * 2 + c) * 4096 + s)) * 64 + d) = pack8(y0 * osc, y1 * osc); } }
    }
};

template <bool I8> __device__ __forceinline__ f32x4 mma_sel(bf16x8 a, bf16x8 b, f32x4 c) {
    if constexpr (I8) return __builtin_bit_cast(f32x4, __builtin_amdgcn_mfma_i32_16x16x64_i8(__builtin_bit_cast(i32x4, a), __builtin_bit_cast(i32x4, b), __builtin_bit_cast(i32x4, c), 0, 0, 0));
    else return __builtin_amdgcn_mfma_f32_16x16x32_bf16(a, b, c, 0, 0, 0);
}
template <class Epi, class Sched, bool ALIGN_EPI = false, bool SP2 = false>
__device__ __forceinline__ void gemm_phase(PG8_LAS unsigned char* lds, const Gemm g, const Sched& S, const Epi& E, const int wv) {
    int ln_; asm volatile("v_mbcnt_lo_u32_b32 %0, -1, 0\n\tv_mbcnt_hi_u32_b32 %0, -1, %0" : "=v"(ln_)); const int tid = wv * 64 + ln_, wid = wv, lane = tid & 63, wr = wid >> 2, wc = wid & 3, fr = lane & 15, fq = lane >> 4;
    const int K = g.K, nt = K / BK;
    unsigned voffA[2], voffB[2];
#pragma unroll
    for (int i = 0; i < 2; ++i) { int R, C; stage_rc(tid * 16 + i * 8192, R, C); const int Rb = Epi::PERM ? ((R & ~31) + perm32(R & 31)) : R;
        voffA[i] = (unsigned)(R * K + C) * 2u; voffB[i] = (unsigned)(Rb * K + C) * 2u; }
    const size_t kstep = (size_t)(BK * 2);
    const size_t hstep = (size_t)HALF * K * 2;
    const size_t tstep = 2 * hstep;
    const unsigned ldsw = (unsigned)wid * 1024u;
    const int aoff = lds_byte(wr * 64 + fr, fq * 8), boff = lds_byte(wc * 32 + fr, fq * 8);
#define PG8_SA(b, h) (((b) * 2 + (h)) * HTB)
#define PG8_SB(b, h) ((4 + (b) * 2 + (h)) * HTB)
#define PG8_STAGE(bufoff, gbase, voff) do { _Pragma("unroll") for (int _i = 0; _i < 2; ++_i) \
        __builtin_amdgcn_global_load_lds((const unsigned*)((const char*)(gbase) + (voff)[_i]), (PG8_LAS unsigned*)(lds + (bufoff) + ldsw + _i * 8192), 16, 0, 0); } while (0)
#define PG8_LDA(dst, b, h) do { _Pragma("unroll") for (int m = 0; m < 4; ++m) _Pragma("unroll") for (int k = 0; k < 2; ++k) dst[m][k] = *(const PG8_LAS bf16x8*)(lds + PG8_SA(b, h) + aoff + m * 2048 + k * 1024); } while (0)
#define PG8_LDB(dst, b, h) do { _Pragma("unroll") for (int n = 0; n < 2; ++n) _Pragma("unroll") for (int k = 0; k < 2; ++k) dst[n][k] = *(const PG8_LAS bf16x8*)(lds + PG8_SB(b, h) + boff + n * 2048 + k * 1024); } while (0)
#define PG8_MMA(ai, bj, At, Bt) do { __builtin_amdgcn_s_setprio(1); _Pragma("unroll") for (int m = 0; m < 4; ++m) _Pragma("unroll") for (int n = 0; n < 2; ++n) _Pragma("unroll") for (int k = 0; k < 2; ++k) \
        acc[ai][bj][m][n] = mma_sel<Epi::I8>(Bt[n][k], At[m][k], acc[ai][bj][m][n]); __builtin_amdgcn_s_setprio(0); } while (0)
#define PG8_WAIT_V(n) asm volatile("s_waitcnt vmcnt(" #n ")" ::: "memory")
#define PG8_WAIT_L(n) asm volatile("s_waitcnt lgkmcnt(" #n ")" ::: "memory")
#define PG8_BAR __builtin_amdgcn_s_barrier()
#define PG8_SCHED __builtin_amdgcn_sched_barrier(0)
    Unit cur, nxt; int ui = 0;
    if (!S.next(0, cur)) return;
    f32x4 acc[2][2][4][2];
#pragma unroll
    for (int a = 0; a < 2; ++a)
#pragma unroll
        for (int b = 0; b < 2; ++b)
#pragma unroll
            for (int m = 0; m < 4; ++m)
#pragma unroll
                for (int n = 0; n < 2; ++n) acc[a][b][m][n] = (f32x4){0.f, 0.f, 0.f, 0.f};
    bf16x8 At[4][2], B0[2][2], B1[2][2];
    const char* cA = (const char*)g.A + (size_t)cur.pm * tstep; const char* cB = (const char*)g.Bt + (size_t)cur.pn * tstep;
    S.a_ready(cur);
    if constexpr (SP2) {
        PG8_STAGE(PG8_SB(0, 0), cB, voffB); PG8_STAGE(PG8_SB(0, 1), cB + hstep, voffB); PG8_STAGE(PG8_SA(0, 0), cA, voffA); PG8_STAGE(PG8_SA(0, 1), cA + hstep, voffA);
        if (wr == 1) PG8_BAR;
        PG8_WAIT_V(2); PG8_BAR;
        PG8_STAGE(PG8_SB(1, 0), cB + kstep, voffB); PG8_STAGE(PG8_SA(1, 0), cA + kstep, voffA); PG8_STAGE(PG8_SB(1, 1), cB + hstep + kstep, voffB);
        PG8_WAIT_V(6); PG8_BAR;
    } else {
        PG8_STAGE(PG8_SB(0, 0), cB, voffB); PG8_STAGE(PG8_SA(0, 0), cA, voffA); PG8_STAGE(PG8_SB(0, 1), cB + hstep, voffB); PG8_STAGE(PG8_SA(0, 1), cA + hstep, voffA);
        if (wr == 1) PG8_BAR;
        PG8_WAIT_V(4); PG8_BAR;
        PG8_STAGE(PG8_SB(1, 0), cB + kstep, voffB); PG8_STAGE(PG8_SA(1, 0), cA + kstep, voffA); PG8_STAGE(PG8_SB(1, 1), cB + hstep + kstep, voffB);
        PG8_WAIT_V(6); PG8_BAR;
    }
    for (;;) {
        const bool has_next = S.next(ui + 1, nxt);
        const char* nA = has_next ? (const char*)g.A + (size_t)nxt.pm * tstep : cA; const char* nB = has_next ? (const char*)g.Bt + (size_t)nxt.pn * tstep : cB;
        for (int t = 0; t < nt; t += 2) {
            const bool last = (t == nt - 2);
            const char* a1 = cA + (size_t)(t + 1) * kstep;
            const char* a2 = last ? nA : cA + (size_t)(t + 2) * kstep; const char* b2 = last ? nB : cB + (size_t)(t + 2) * kstep;
            const char* a3 = a2 + kstep; const char* b3 = b2 + kstep;
            if (last && has_next) S.a_ready(nxt);
            if constexpr (SP2) {
            PG8_LDB(B0, 0, 0); PG8_LDB(B1, 0, 1); PG8_SCHED; PG8_LDA(At, 0, 0); PG8_STAGE(PG8_SA(1, 1), a1 + hstep, voffA);
            PG8_WAIT_V(8); PG8_WAIT_L(0); PG8_BAR; PG8_MMA(0, 0, At, B0); PG8_MMA(0, 1, At, B1); PG8_BAR; PG8_SCHED;
            PG8_LDA(At, 0, 1); PG8_STAGE(PG8_SB(0, 0), b2, voffB); PG8_STAGE(PG8_SB(0, 1), b2 + hstep, voffB); PG8_STAGE(PG8_SA(0, 0), a2, voffA);
            PG8_WAIT_V(8); PG8_WAIT_L(0); PG8_BAR; PG8_MMA(1, 0, At, B0); PG8_MMA(1, 1, At, B1); PG8_BAR; PG8_SCHED;
            PG8_LDB(B0, 1, 0); PG8_LDB(B1, 1, 1); PG8_SCHED; PG8_LDA(At, 1, 0); PG8_STAGE(PG8_SA(0, 1), a2 + hstep, voffA);
            PG8_WAIT_V(8); PG8_WAIT_L(0); PG8_BAR; PG8_MMA(0, 0, At, B0); PG8_MMA(0, 1, At, B1); PG8_BAR; PG8_SCHED;
            PG8_LDA(At, 1, 1); PG8_STAGE(PG8_SB(1, 0), b3, voffB); PG8_STAGE(PG8_SB(1, 1), b3 + hstep, voffB); PG8_STAGE(PG8_SA(1, 0), a3, voffA);
            PG8_WAIT_V(8); PG8_WAIT_L(0); PG8_BAR; PG8_MMA(1, 0, At, B0); PG8_MMA(1, 1, At, B1); PG8_BAR; PG8_SCHED;
            } else {
            PG8_LDB(B0, 0, 0); PG8_SCHED; PG8_LDA(At, 0, 0); PG8_STAGE(PG8_SA(1, 1), a1 + hstep, voffA);
            PG8_WAIT_L(8); PG8_BAR; PG8_WAIT_L(0); PG8_MMA(0, 0, At, B0); PG8_BAR; PG8_SCHED;
            PG8_LDB(B1, 0, 1); PG8_STAGE(PG8_SB(0, 0), b2, voffB);
            PG8_BAR; PG8_WAIT_L(0); PG8_MMA(0, 1, At, B1); PG8_BAR;
            PG8_LDA(At, 0, 1); PG8_STAGE(PG8_SA(0, 0), a2, voffA);
            PG8_BAR; PG8_WAIT_L(0); PG8_MMA(1, 0, At, B0); PG8_BAR; PG8_SCHED;
            PG8_STAGE(PG8_SB(0, 1), b2 + hstep, voffB);
            PG8_WAIT_V(6); PG8_BAR; PG8_MMA(1, 1, At, B1); PG8_BAR;
            PG8_LDB(B0, 1, 0); PG8_SCHED; PG8_LDA(At, 1, 0); PG8_STAGE(PG8_SA(0, 1), a2 + hstep, voffA);
            PG8_WAIT_L(8); PG8_BAR; PG8_WAIT_L(0); PG8_MMA(0, 0, At, B0); PG8_BAR; PG8_SCHED;
            PG8_LDB(B1, 1, 1); PG8_STAGE(PG8_SB(1, 0), b3, voffB);
            PG8_BAR; PG8_WAIT_L(0); PG8_MMA(0, 1, At, B1); PG8_BAR;
            PG8_LDA(At, 1, 1); PG8_STAGE(PG8_SA(1, 0), a3, voffA);
            PG8_BAR; PG8_WAIT_L(0); PG8_MMA(1, 0, At, B0); PG8_BAR; PG8_SCHED;
            PG8_STAGE(PG8_SB(1, 1), b3 + hstep, voffB);
            PG8_WAIT_V(6); PG8_BAR; PG8_MMA(1, 1, At, B1); PG8_BAR;
            }
        }
        if constexpr (ALIGN_EPI) { if (wr == 0) PG8_BAR; }
        if constexpr (!Epi::AFTER_DRAIN) { E(acc, cur, wr, wc, fr, fq); S.done(cur); }
        if (!has_next) break;
#pragma unroll
        for (int a = 0; a < 2; ++a)
#pragma unroll
            for (int b = 0; b < 2; ++b)
#pragma unroll
                for (int m = 0; m < 4; ++m)
#pragma unroll
                    for (int n = 0; n < 2; ++n) acc[a][b][m][n] = (f32x4){0.f, 0.f, 0.f, 0.f};
        cur = nxt; cA = nA; cB = nB; ++ui;
        if constexpr (ALIGN_EPI) { if (wr == 1) PG8_BAR; }
    }
    PG8_WAIT_V(0);
    if constexpr (!ALIGN_EPI) { if (wr == 0) PG8_BAR; }
    PG8_BAR;
    if constexpr (Epi::AFTER_DRAIN) { E.fused(acc, cur, wr, wc, fr, fq, lds, wid, lane); S.done(cur); }
#undef PG8_SA
#undef PG8_SB
#undef PG8_STAGE
#undef PG8_LDA
#undef PG8_LDB
#undef PG8_MMA
#undef PG8_WAIT_V
#undef PG8_WAIT_L
#undef PG8_BAR
#undef PG8_SCHED
}
}
#define GAS __attribute__((address_space(1)))
#define LAS __attribute__((address_space(3)))
typedef unsigned short bf16;
typedef unsigned v4u __attribute__((ext_vector_type(4)));
typedef float f32x4 __attribute__((ext_vector_type(4)));
typedef short bf16x8 __attribute__((ext_vector_type(8)));
typedef GAS unsigned gu32;
typedef GAS unsigned long long gu64;
#define RLX_AGENT __ATOMIC_RELAXED, __HIP_MEMORY_SCOPE_AGENT
#define LDS_WAIT() asm volatile("s_waitcnt lgkmcnt(0)" ::: "memory")
#define VM_WAIT() asm volatile("s_waitcnt vmcnt(0)" ::: "memory")
__device__ __forceinline__ unsigned long long rt() { return __builtin_amdgcn_s_memrealtime(); }
typedef float f32x2_cv __attribute__((ext_vector_type(2))); typedef __bf16 bf16x2_cv __attribute__((ext_vector_type(2)));
__device__ __forceinline__ unsigned pk2(float lo, float hi) { const f32x2_cv v = {lo, hi}; const bf16x2_cv b = __builtin_convertvector(v, bf16x2_cv); return __builtin_bit_cast(unsigned, b); }
__device__ __forceinline__ unsigned f2bf(float f) { return pk2(f, 0.f) & 0xffffu; }

#define XB_TMO      128
#define XB_XCNT(j)  (256  + 64 * (j))
#define XB_XSUB(j)  (1280 + 64 * (j))
#define XB_XGEN(j)  (2304 + 64 * (j))
#define XB_TOP      3328
#define XB_TOPGEN   3392
#define XCD_BAR_WORDS 3456
#define XB_SPIN_CAP (1u << 18)

__device__ __forceinline__ unsigned xb_ld(unsigned* p)              { return __hip_atomic_load(p, __ATOMIC_RELAXED, __HIP_MEMORY_SCOPE_AGENT); }
__device__ __forceinline__ unsigned xb_add(unsigned* p, unsigned v) { return __hip_atomic_fetch_add(p, v, __ATOMIC_RELAXED, __HIP_MEMORY_SCOPE_AGENT); }
__device__ __forceinline__ unsigned xb_xcc_id() { return (unsigned)__builtin_amdgcn_s_getreg((3 << 11) | 20) & 0xFu; }
#define XB_SPIN(cond, bar) do { unsigned _sp = 0; while (cond) { __builtin_amdgcn_s_sleep(1); \
    if ((++_sp & 255u) == 0u) { if (xb_ld(&(bar)[XB_TMO])) break; if (_sp > XB_SPIN_CAP) { atomicAdd(&(bar)[XB_TMO], 1u); break; } } } } while (0)

struct XcdBarrier {
    unsigned* bar; unsigned x;
    volatile LAS unsigned* st;
};

__device__ __forceinline__ XcdBarrier xcd_barrier_post(unsigned* bar, volatile LAS unsigned* st) {
    XcdBarrier b; b.bar = bar; b.x = xb_xcc_id(); b.st = st;
    if (threadIdx.x == 0) (void)xb_add(&bar[XB_XCNT(b.x)], 1u);
    return b;
}
__device__ __forceinline__ void xcd_barrier_complete(unsigned* bar, unsigned x, unsigned& nloc, unsigned& nx) {
    const unsigned G = gridDim.x * gridDim.y * gridDim.z;
    unsigned sum, cnt, mine, sp = 0u;
    for (;;) {
        sum = 0u; cnt = 0u; mine = 0u;
#pragma unroll
        for (unsigned j = 0; j < 16; ++j) { const unsigned c = xb_ld(&bar[XB_XCNT(j)]); sum += c; cnt += (c > 0u) ? 1u : 0u; mine = (j == x) ? c : mine; }
        if (sum == G) break;
        __builtin_amdgcn_s_sleep(1);
        if ((++sp & 255u) == 0u) { if (xb_ld(&bar[XB_TMO])) break; if (sp > XB_SPIN_CAP) { atomicAdd(&bar[XB_TMO], 1u); break; } }
    }
    nloc = mine > 0u ? mine : 1u; nx = cnt > 0u ? cnt : 1u;
}

__device__ __forceinline__ void xcd_barrier(const XcdBarrier& b) {
    asm volatile("s_waitcnt vmcnt(0)" ::: "memory");
    __syncthreads();
    if (threadIdx.x == 0) {
        unsigned* bar = b.bar;
        __builtin_amdgcn_s_waitcnt(0);
        unsigned nloc = b.st[0], nx = b.st[1];
        if (nloc == 0u) { xcd_barrier_complete(bar, b.x, nloc, nx); b.st[0] = nloc; b.st[1] = nx; }
        const unsigned old = xb_add(&bar[XB_XSUB(b.x)], 1u);
        const unsigned gen = old / nloc;
        if (old + 1u == (gen + 1u) * nloc) {
            __builtin_amdgcn_fence(__ATOMIC_RELEASE, "agent");
            asm volatile("s_waitcnt vmcnt(0)" ::: "memory");
            const unsigned og = xb_add(&bar[XB_TOP], 1u);
            const unsigned tg = og / nx;
            if (og + 1u == (tg + 1u) * nx) xb_add(&bar[XB_TOPGEN], 1u);
            else XB_SPIN(xb_ld(&bar[XB_TOPGEN]) == tg, bar);
            __builtin_amdgcn_fence(__ATOMIC_ACQUIRE, "agent");
            xb_add(&bar[XB_XGEN(b.x)], 1u);
            asm volatile("s_waitcnt vmcnt(0)" ::: "memory");
        } else {
            XB_SPIN(xb_ld(&bar[XB_XGEN(b.x)]) == gen, bar);
            __builtin_amdgcn_fence(__ATOMIC_ACQUIRE, "agent");
            asm volatile("s_waitcnt vmcnt(0)" ::: "memory");
        }
    }
    __syncthreads();
}
constexpr int NWAVES = 8;
constexpr int T = 32768, D = 1024, SEQ = 4096;
constexpr float EPS = 1e-6f;
constexpr float LAMBDA_INIT = 0.35550906759f;
constexpr size_t MiB = 1u << 20;
constexpr size_t WS_CTL = 0, CTL_ZERO_BYTES = 1 * MiB;
constexpr size_t WS_ROPE = 1 * MiB;
constexpr size_t WS_WIN = 4 * MiB;
constexpr size_t WS_WO0 = 11 * MiB, WS_WQ0 = 13 * MiB, WS_KEY0 = 17 * MiB, WS_WQKV = 18 * MiB, WS_WO1 = 24 * MiB, WS_WQ1 = 26 * MiB, WS_KEY1 = 30 * MiB;
constexpr size_t WS_SC = 31 * MiB;
constexpr size_t WS_U0 = 32 * MiB, WS_V0T = 48 * MiB, WS_U1 = 64 * MiB, WS_V1T = 80 * MiB;
constexpr size_t WS_B0 = 96 * MiB;
constexpr size_t WS_R1 = 160 * MiB, WS_R2 = 224 * MiB, WS_R3 = 288 * MiB, WS_R4 = 352 * MiB, WS_R5 = 416 * MiB, WS_GATES = 480 * MiB;
constexpr size_t WS_I8 = 484 * MiB;
constexpr size_t WS_END = 492 * MiB;
constexpr int CW_BAR = 4096;
constexpr int LDS_BYTES = 147456, MISC_OFF = LDS_BYTES - 128;

typedef float f32x16 __attribute__((ext_vector_type(16)));
typedef unsigned u32x2 __attribute__((ext_vector_type(2)));
typedef __bf16 bf16x2_t __attribute__((ext_vector_type(2)));
__device__ __forceinline__ float bf_lo(unsigned w) { return __uint_as_float(w << 16); }
__device__ __forceinline__ float bf_hi(unsigned w) { return __uint_as_float(w & 0xffff0000u); }
__device__ __forceinline__ float dot2(unsigned a, unsigned b, float c) { return __builtin_amdgcn_fdot2_f32_bf16(__builtin_bit_cast(bf16x2_t, a), __builtin_bit_cast(bf16x2_t, b), c, false); }
__device__ __forceinline__ float shx(float v, int lane, int m) { return __uint_as_float((unsigned)__builtin_amdgcn_ds_bpermute((lane ^ m) << 2, (int)__float_as_uint(v))); }
__device__ __forceinline__ int shxi(int v, int lane, int m) { return __builtin_amdgcn_ds_bpermute((lane ^ m) << 2, v); }
__device__ __forceinline__ float wave_sum(float v, int lane) {
#pragma unroll
    for (int o = 1; o < 64; o <<= 1) v += shx(v, lane, o);
    return v;
}
__device__ __forceinline__ f32x4 mfma16(bf16x8 a, bf16x8 b, f32x4 c) { return __builtin_amdgcn_mfma_f32_16x16x32_bf16(a, b, c, 0, 0, 0); }
__device__ __forceinline__ f32x16 mfma32(bf16x8 a, bf16x8 b, f32x16 c) { return __builtin_amdgcn_mfma_f32_32x32x16_bf16(a, b, c, 0, 0, 0); }
__device__ __forceinline__ u32x2 pack4(float a, float b, float c, float d) { u32x2 r; r.x = pk2(a, b); r.y = pk2(c, d); return r; }

__device__ __forceinline__ void p0_transpose_item(const float* W, int K, int N, bf16* WT, LAS float* scr, int item, int lane, const float* kscale = nullptr) {
    const int nblk = N / 32, kb = item / nblk, nb = item % nblk, k0 = 64 * kb, n0 = 32 * nb;
#pragma unroll 8
    for (int i = 0; i < 32; ++i) { const int kk = 2 * i + (lane >> 5); const float sc = kscale ? kscale[k0 + kk] : 1.f; scr[kk * 33 + (lane & 31)] = W[(size_t)(k0 + kk) * N + n0 + (lane & 31)] * sc; }
    LDS_WAIT(); asm volatile("" ::: "memory");
    const int c = lane & 7;
#pragma unroll
    for (int j = 0; j < 4; ++j) { const int n = (lane >> 3) + 8 * j; const LAS float* s = scr + (8 * c) * 33 + n;
        v4u o; o.x = pk2(s[0 * 33], s[1 * 33]); o.y = pk2(s[2 * 33], s[3 * 33]); o.z = pk2(s[4 * 33], s[5 * 33]); o.w = pk2(s[6 * 33], s[7 * 33]);
        *(v4u*)(WT + (size_t)(n0 + n) * K + k0 + 8 * c) = o; }
    LDS_WAIT(); asm volatile("" ::: "memory");
}
__device__ __forceinline__ void cvt_range(const float* src, bf16* dst, size_t n, size_t gtid, size_t gthreads) {
    for (size_t i = gtid * 8; i < n; i += gthreads * 8) {
        const f32x4 a = *(const f32x4*)(src + i), b = *(const f32x4*)(src + i + 4);
        v4u o; o.x = pk2(a.x, a.y); o.y = pk2(a.z, a.w); o.z = pk2(b.x, b.y); o.w = pk2(b.z, b.w);
        *(v4u*)(dst + i) = o; }
}
__device__ __forceinline__ void rms_pass(const float* X, const float* g, bf16* XN, int gw, int NGW, int lane) {
    const f32x4* gr = (const f32x4*)g + lane;
    f32x4 gg[4];
#pragma unroll
    for (int j = 0; j < 4; ++j) gg[j] = gr[64 * j];
    f32x4 v[4], nx[4];
    if (gw < T) {
#pragma unroll
        for (int j = 0; j < 4; ++j) v[j] = ((const f32x4*)(X + (size_t)gw * D) + lane)[64 * j]; }
    for (int m = gw; m < T; m += NGW) {
        const int mn = m + NGW < T ? m + NGW : m;
#pragma unroll
        for (int j = 0; j < 4; ++j) nx[j] = ((const f32x4*)(X + (size_t)mn * D) + lane)[64 * j];
        float s = 0.f;
#pragma unroll
        for (int j = 0; j < 4; ++j) s += (v[j].x * v[j].x + v[j].y * v[j].y) + (v[j].z * v[j].z + v[j].w * v[j].w);
        const float rstd = rsqrtf(wave_sum(s, lane) * (1.f / 1024.f) + EPS);
        unsigned long long* o8 = (unsigned long long*)(XN + (size_t)m * D) + lane;
#pragma unroll
        for (int j = 0; j < 4; ++j) o8[64 * j] = (unsigned long long)pk2(v[j].x * rstd * gg[j].x, v[j].y * rstd * gg[j].y) | ((unsigned long long)pk2(v[j].z * rstd * gg[j].z, v[j].w * rstd * gg[j].w) << 32);
#pragma unroll
        for (int j = 0; j < 4; ++j) v[j] = nx[j];
    }
}

__device__ __forceinline__ float logsigmoid_f(float f) { return fminf(f, 0.f) - log1pf(__expf(-fabsf(f))); }
#define ML_LOAD(ci_) do { const size_t r_ = rowbase + (size_t)(ci_) * 64 + lane; \
    rq = *(const v4u*)(Q0 + r_ * 64 + 8 * w); rk = *(const v4u*)(K0 + r_ * 64 + 8 * w); rv0 = *(const v4u*)(V0 + r_ * 128 + 16 * w); rv1 = *(const v4u*)(V0 + r_ * 128 + 16 * w + 8); \
    const size_t gm_ = ((size_t)b * 4096 + (size_t)(ci_) * 64 + jr) * 32; rli = GATES[gm_ + (dir ? 16 : 0) + h]; rf = GATES[gm_ + (dir ? 24 : 8) + h]; } while (0)
__device__ __forceinline__ void mlstm_phase(const int wv, LAS unsigned char* lds, const bf16* Q0, const bf16* K0, const bf16* V0, const float* GATES, bf16* HF, bf16* HB) {
    const int bx = blockIdx.x;
    if ((bx >> 3) & 1) return;
    const int seq = (bx >> 4) * 8 + (bx & 7);
    const int dir = seq & 1, bh = seq >> 1, b = bh >> 3, h = bh & 7;
    int ln_; asm volatile("v_mbcnt_lo_u32_b32 %0, -1, 0\n\tv_mbcnt_hi_u32_b32 %0, -1, %0" : "=v"(ln_)); const int tid = wv * 64 + ln_, lane = tid & 63, w = wv, fr = lane & 15, fq = lane >> 4;
    LAS bf16* Qs = (LAS bf16*)(lds); LAS bf16* Ks = (LAS bf16*)(lds + 9216); LAS bf16* Kwt = (LAS bf16*)(lds + 18432); LAS bf16* Ps = (LAS bf16*)(lds + 27648);
    LAS bf16* Vt = (LAS bf16*)(lds + 36864 + w * 2304); LAS bf16* Cs = (LAS bf16*)(lds + 55296 + w * 2304); LAS bf16* nb = (LAS bf16*)(lds + 73728 + w * 128);
    LAS float* gc = (LAS float*)(lds + 74752 + w * 1280); LAS float* gM = gc + 64; LAS float* gI = gc + 128; LAS float* gE = gc + 192; LAS float* gW = gc + 256;
    for (int i = lane; i < 2304 / 4; i += 64) ((LAS unsigned*)Cs)[i] = 0u;
    if (lane < 32) ((LAS unsigned*)nb)[lane] = 0u;
    f32x4 Cacc[4], Nacc[4];
#pragma unroll
    for (int i = 0; i < 4; ++i) { Cacc[i] = (f32x4){0.f, 0.f, 0.f, 0.f}; Nacc[i] = (f32x4){0.f, 0.f, 0.f, 0.f}; }
    float m = -1e30f;
    bf16* Hout = dir ? HB : HF;
    const size_t rowbase = (size_t)bh * 4096;
    const int jr = dir ? 63 - lane : lane;
    v4u rq, rk, rv0, rv1; float rli, rf;
    ML_LOAD(dir ? 63 : 0);
    const bf16x8 ones = (bf16x8){0x3F80, 0x3F80, 0x3F80, 0x3F80, 0x3F80, 0x3F80, 0x3F80, 0x3F80};
    const f32x4 z4 = (f32x4){0.f, 0.f, 0.f, 0.f};
#pragma unroll 1
    for (int step = 0; step < 64; ++step) {
        const int ci = dir ? 63 - step : step;
        const float lf = logsigmoid_f(rf);
        float bcs = lf;
        bcs += __uint_as_float((unsigned)__builtin_amdgcn_update_dpp(0, (int)__float_as_uint(bcs), 0x111, 0xF, 0xF, false));
        bcs += __uint_as_float((unsigned)__builtin_amdgcn_update_dpp(0, (int)__float_as_uint(bcs), 0x112, 0xF, 0xF, false));
        bcs += __uint_as_float((unsigned)__builtin_amdgcn_update_dpp(0, (int)__float_as_uint(bcs), 0x114, 0xF, 0xF, false));
        bcs += __uint_as_float((unsigned)__builtin_amdgcn_update_dpp(0, (int)__float_as_uint(bcs), 0x118, 0xF, 0xF, false));
        bcs += __uint_as_float((unsigned)__builtin_amdgcn_update_dpp(0, (int)__float_as_uint(bcs), 0x142, 0xA, 0xF, false));
        bcs += __uint_as_float((unsigned)__builtin_amdgcn_update_dpp(0, (int)__float_as_uint(bcs), 0x143, 0xC, 0xF, false));
        const float c = rli - bcs;
        float pm = c;
        const int NINFI = (int)0xFF800000u;
        pm = fmaxf(pm, __uint_as_float((unsigned)__builtin_amdgcn_update_dpp(NINFI, (int)__float_as_uint(pm), 0x111, 0xF, 0xF, false)));
        pm = fmaxf(pm, __uint_as_float((unsigned)__builtin_amdgcn_update_dpp(NINFI, (int)__float_as_uint(pm), 0x112, 0xF, 0xF, false)));
        pm = fmaxf(pm, __uint_as_float((unsigned)__builtin_amdgcn_update_dpp(NINFI, (int)__float_as_uint(pm), 0x114, 0xF, 0xF, false)));
        pm = fmaxf(pm, __uint_as_float((unsigned)__builtin_amdgcn_update_dpp(NINFI, (int)__float_as_uint(pm), 0x118, 0xF, 0xF, false)));
        pm = fmaxf(pm, __uint_as_float((unsigned)__builtin_amdgcn_update_dpp(NINFI, (int)__float_as_uint(pm), 0x142, 0xA, 0xF, false)));
        pm = fmaxf(pm, __uint_as_float((unsigned)__builtin_amdgcn_update_dpp(NINFI, (int)__float_as_uint(pm), 0x143, 0xC, 0xF, false)));
        const float M = fmaxf(m, pm);
        const float bL = __uint_as_float((unsigned)__builtin_amdgcn_readlane((int)__float_as_uint(bcs), 63)), Mlast = __uint_as_float((unsigned)__builtin_amdgcn_readlane((int)__float_as_uint(M), 63));
        gc[jr] = c; gM[jr] = M; gI[jr] = __expf(m - M); gE[jr] = __expf(-(bcs + M)); gW[jr] = __expf(c - Mlast);
        const float sp = __expf(m - Mlast), m_new = bL + Mlast;
        const float wr_ = gW[lane];
        *(LAS v4u*)(Qs + lane * 72 + 8 * w) = rq; *(LAS v4u*)(Ks + lane * 72 + 8 * w) = rk;
#pragma unroll
        for (int i = 0; i < 4; ++i) { const unsigned kw = rk[i]; Kwt[(8 * w + 2 * i) * 72 + lane] = (bf16)f2bf(bf_lo(kw) * wr_); Kwt[(8 * w + 2 * i + 1) * 72 + lane] = (bf16)f2bf(bf_hi(kw) * wr_); }
#pragma unroll
        for (int i = 0; i < 4; ++i) { Vt[(2 * i) * 72 + lane] = (bf16)(rv0[i] & 0xffffu); Vt[(2 * i + 1) * 72 + lane] = (bf16)(rv0[i] >> 16);
                                      Vt[(8 + 2 * i) * 72 + lane] = (bf16)(rv1[i] & 0xffffu); Vt[(9 + 2 * i) * 72 + lane] = (bf16)(rv1[i] >> 16); }
        __syncthreads();
        if (step < 63) ML_LOAD(dir ? 62 - step : step + 1);
        {
            const int st = w >> 1;
            const bf16x8 a0 = *(const LAS bf16x8*)(Ks + (16 * st + fr) * 72 + 8 * fq), a1 = *(const LAS bf16x8*)(Ks + (16 * st + fr) * 72 + 32 + 8 * fq);
#pragma unroll
            for (int u = 0; u < 2; ++u) { const int tt = 2 * (w & 1) + u;
                const bf16x8 b0 = *(const LAS bf16x8*)(Qs + (16 * tt + fr) * 72 + 8 * fq), b1 = *(const LAS bf16x8*)(Qs + (16 * tt + fr) * 72 + 32 + 8 * fq);
                f32x4 acc = mfma16(a0, b0, z4); acc = mfma16(a1, b1, acc);
                const int t = 16 * tt + fr; const float Mt = gM[t]; float pv[4];
#pragma unroll
                for (int i = 0; i < 4; ++i) { const int s = 16 * st + 4 * fq + i; const bool valid = dir ? (s >= t) : (s <= t); const float e = __expf(gc[s] - Mt); pv[i] = valid ? acc[i] * e : 0.f; }
                *(LAS u32x2*)(Ps + t * 72 + 16 * st + 4 * fq) = pack4(pv[0], pv[1], pv[2], pv[3]); }
        }
        __syncthreads();
        const bf16x8 aV0 = *(const LAS bf16x8*)(Vt + fr * 72 + 8 * fq), aV1 = *(const LAS bf16x8*)(Vt + fr * 72 + 32 + 8 * fq);
        {
            const bf16x8 aC0 = *(const LAS bf16x8*)(Cs + fr * 72 + 8 * fq), aC1 = *(const LAS bf16x8*)(Cs + fr * 72 + 32 + 8 * fq);
            const bf16x8 aN0 = *(const LAS bf16x8*)(nb + 8 * fq), aN1 = *(const LAS bf16x8*)(nb + 32 + 8 * fq);
#pragma unroll
            for (int tt = 0; tt < 4; ++tt) {
                const bf16x8 bP0 = *(const LAS bf16x8*)(Ps + (16 * tt + fr) * 72 + 8 * fq), bP1 = *(const LAS bf16x8*)(Ps + (16 * tt + fr) * 72 + 32 + 8 * fq);
                const bf16x8 bQ0 = *(const LAS bf16x8*)(Qs + (16 * tt + fr) * 72 + 8 * fq), bQ1 = *(const LAS bf16x8*)(Qs + (16 * tt + fr) * 72 + 32 + 8 * fq);
                f32x4 acc1 = mfma16(aV0, bP0, z4); acc1 = mfma16(aV1, bP1, acc1);
                f32x4 acc2 = mfma16(aC0, bQ0, z4); acc2 = mfma16(aC1, bQ1, acc2);
                f32x4 d1 = mfma16(ones, bP0, z4); d1 = mfma16(ones, bP1, d1);
                f32x4 d2 = mfma16(aN0, bQ0, z4); d2 = mfma16(aN1, bQ1, d2);
                const int t = 16 * tt + fr; const float it = gI[t], en = gE[t];
                const float den = d1[0] + it * d2[0]; const float inv = 1.f / fmaxf(fabsf(den), en);
                *(u32x2*)(Hout + ((size_t)b * 4096 + (size_t)ci * 64 + t) * 1024 + h * 128 + 16 * w + 4 * fq) =
                    pack4((acc1[0] + it * acc2[0]) * inv, (acc1[1] + it * acc2[1]) * inv, (acc1[2] + it * acc2[2]) * inv, (acc1[3] + it * acc2[3]) * inv);
            }
        }
#pragma unroll
        for (int dt = 0; dt < 4; ++dt) { Cacc[dt] = Cacc[dt] * sp; Nacc[dt] = Nacc[dt] * sp;
            const bf16x8 aK0 = *(const LAS bf16x8*)(Kwt + (16 * dt + fr) * 72 + 8 * fq), aK1 = *(const LAS bf16x8*)(Kwt + (16 * dt + fr) * 72 + 32 + 8 * fq);
            Cacc[dt] = mfma16(aK0, aV0, Cacc[dt]); Cacc[dt] = mfma16(aK1, aV1, Cacc[dt]);
            Nacc[dt] = mfma16(aK0, ones, Nacc[dt]); Nacc[dt] = mfma16(aK1, ones, Nacc[dt]); }
#pragma unroll
        for (int dt = 0; dt < 4; ++dt) { *(LAS u32x2*)(Cs + fr * 72 + 16 * dt + 4 * fq) = pack4(Cacc[dt][0], Cacc[dt][1], Cacc[dt][2], Cacc[dt][3]);
                                         *(LAS u32x2*)(nb + 16 * dt + 4 * fq) = pack4(Nacc[dt][0], Nacc[dt][1], Nacc[dt][2], Nacc[dt][3]); }
        m = m_new;
        __syncthreads();
    }
}
#undef ML_LOAD

__device__ __forceinline__ void hs_pass(const bf16* HF, const bf16* HB, const bf16* OG, const float* hg, bf16* HS, int gw, int NGW, int lane) {
    v4u f0, f1, b0, b1, o0, o1, nf0, nf1, nb0, nb1, no0, no1;
    if (gw < T) { const size_t off = (size_t)gw * 1024 + 16 * lane;
        f0 = *(const v4u*)(HF + off); f1 = *(const v4u*)(HF + off + 8); b0 = *(const v4u*)(HB + off); b1 = *(const v4u*)(HB + off + 8); o0 = *(const v4u*)(OG + off); o1 = *(const v4u*)(OG + off + 8); }
    for (int m = gw; m < T; m += NGW) {
        const size_t off = (size_t)m * 1024 + 16 * lane;
        { const int mn = m + NGW < T ? m + NGW : m; const size_t offn = (size_t)mn * 1024 + 16 * lane;
          nf0 = *(const v4u*)(HF + offn); nf1 = *(const v4u*)(HF + offn + 8); nb0 = *(const v4u*)(HB + offn); nb1 = *(const v4u*)(HB + offn + 8); no0 = *(const v4u*)(OG + offn); no1 = *(const v4u*)(OG + offn + 8); }
        float x[16], og[16];
#pragma unroll
        for (int i = 0; i < 4; ++i) { x[2 * i] = bf_lo(f0[i]) + bf_lo(b0[i]); x[2 * i + 1] = bf_hi(f0[i]) + bf_hi(b0[i]); x[8 + 2 * i] = bf_lo(f1[i]) + bf_lo(b1[i]); x[9 + 2 * i] = bf_hi(f1[i]) + bf_hi(b1[i]);
                                      og[2 * i] = bf_lo(o0[i]); og[2 * i + 1] = bf_hi(o0[i]); og[8 + 2 * i] = bf_lo(o1[i]); og[9 + 2 * i] = bf_hi(o1[i]); }
        float ss = 0.f;
#pragma unroll
        for (int i = 0; i < 16; ++i) ss += x[i] * x[i];
        ss += shx(ss, lane, 1); ss += shx(ss, lane, 2); ss += shx(ss, lane, 4);
        const float rstd = rsqrtf(ss * (1.f / 128.f) + EPS);
        float y[16];
#pragma unroll
        for (int i = 0; i < 16; ++i) y[i] = x[i] * rstd * hg[16 * lane + i] * (1.f / (1.f + __expf(-og[i])));
        v4u w0, w1;
#pragma unroll
        for (int i = 0; i < 4; ++i) { w0[i] = pk2(y[2 * i], y[2 * i + 1]); w1[i] = pk2(y[8 + 2 * i], y[9 + 2 * i]); }
        *(v4u*)(HS + off) = w0; *(v4u*)(HS + off + 8) = w1;
        f0 = nf0; f1 = nf1; b0 = nb0; b1 = nb1; o0 = no0; o1 = no1;
    }
}

__device__ __forceinline__ void glds16(const void* gsrc, unsigned lds_dst) { unsigned keep;
    asm volatile("s_mov_b32 %0, m0\n\ts_mov_b32 m0, %2\n\ts_nop 0\n\tglobal_load_lds_dwordx4 %1, off\n\ts_mov_b32 m0, %0" : "=&s"(keep) : "v"(gsrc), "s"(lds_dst) : "memory"); }
#define AT_WAIT_BAR() asm volatile("s_waitcnt vmcnt(0) lgkmcnt(0)\n\ts_barrier" ::: "memory")

#define TK_CE(a, b) do { const float h_ = fmaxf(a, b), l_ = fminf(a, b); a = h_; b = l_; } while (0)
#define BITONIC_MERGE16(x) do { _Pragma("unroll") for (int d_ = 8; d_ >= 1; d_ >>= 1) { _Pragma("unroll") for (int i_ = 0; i_ < 16; ++i_) if ((i_ & d_) == 0) TK_CE(x[i_], x[i_ + d_]); } } while (0)
#define BITONIC_SORT16(x) do { _Pragma("unroll") for (int k_ = 2; k_ <= 16; k_ <<= 1) { _Pragma("unroll") for (int d_ = k_ >> 1; d_ >= 1; d_ >>= 1) { _Pragma("unroll") for (int i_ = 0; i_ < 16; ++i_) { const int l_i = i_ ^ d_; \
    if (l_i > i_) { if ((i_ & k_) == 0 || k_ == 16) TK_CE(x[i_], x[l_i]); else TK_CE(x[l_i], x[i_]); } } } } } while (0)
#define TK_INSERT(v, x) do { float c_ = (x); _Pragma("unroll") for (int j_ = 0; j_ < 16; ++j_) { const float h_ = fmaxf(v[j_], c_); c_ = fminf(v[j_], c_); v[j_] = h_; } } while (0)
#define TK_DMA(st_, b_) do { _Pragma("unroll") for (int g_ = 0; g_ < 2; ++g_) { const int hp_ = ((g_ * 4 + ((st_) >> 1)) * 2 + ((st_) & 1)); \
    _Pragma("unroll") for (int i_ = 0; i_ < 4; ++i_) { const int q_ = w * 4 + i_, row_ = 4 * q_ + (lane >> 4), ch_ = (lane & 15) ^ (row_ & 15); \
        glds16(KEYS + ((size_t)(hp_ * 128 + row_)) * 128 + ch_ * 8, (unsigned)__builtin_amdgcn_readfirstlane((int)(ldsb + ((b_) * 2 + g_) * 32768 + q_ * 1024))); } } } while (0)
__device__ __forceinline__ void peer_topk_phase(const int wv, LAS unsigned char* lds, int vcu, const bf16* PQ, const bf16* KEYS, int* EXPERTS, float* GATESP) {
    int ln_; asm volatile("v_mbcnt_lo_u32_b32 %0, -1, 0\n\tv_mbcnt_hi_u32_b32 %0, -1, %0" : "=v"(ln_)); const int tid = wv * 64 + ln_, lane = tid & 63, w = wv, r32 = lane & 31, hi = lane >> 5;
    const int t = vcu * 128 + (w & 3) * 32 + r32, hg = w >> 2;
    const float NINF = -INFINITY;
    const unsigned ldsb = (unsigned)(uintptr_t)lds;
    TK_DMA(0, 0);
    AT_WAIT_BAR();
#pragma unroll 1
    for (int hh = 0; hh < 4; ++hh) {
        const int head = hg * 4 + hh;
        float L0[16], L1[16];
#pragma unroll
        for (int j = 0; j < 16; ++j) { L0[j] = 0.f; L1[j] = 0.f; }
#pragma unroll 1
        for (int p = 0; p < 2; ++p) {
            const int st = hh * 2 + p, buf = st & 1;
            if (st < 7) TK_DMA(st + 1, buf ^ 1);
            bf16x8 bq[8];
#pragma unroll
            for (int ks = 0; ks < 8; ++ks) bq[ks] = *(const bf16x8*)(PQ + (size_t)t * 2048 + head * 256 + p * 128 + ks * 16 + 8 * hi);
            const LAS unsigned char* kb = lds + (buf * 2 + hg) * 32768 + r32 * 256;
            f32x16 acc[4];
#pragma unroll
            for (int nt = 0; nt < 4; ++nt) {
#pragma unroll
                for (int r = 0; r < 16; ++r) acc[nt][r] = 0.f;
#pragma unroll
                for (int ks = 0; ks < 8; ++ks) { const bf16x8 a = *(const LAS bf16x8*)(kb + nt * 8192 + (((2 * ks + hi) ^ (r32 & 15)) << 4)); acc[nt] = mfma32(a, bq[ks], acc[nt]); }
            }
            float v[16];
            {
                float blk[4][16];
#pragma unroll
                for (int nt = 0; nt < 4; ++nt)
#pragma unroll
                    for (int r = 0; r < 16; ++r) { const int n = nt * 32 + (r & 3) + 8 * (r >> 2) + 4 * hi; blk[nt][r] = __uint_as_float((__float_as_uint(acc[nt][r]) & ~0x7Fu) | (unsigned)(127 - n)); }
#pragma unroll
                for (int nt = 0; nt < 4; ++nt) BITONIC_SORT16(blk[nt]);
#pragma unroll
                for (int i = 0; i < 16; ++i) { blk[0][i] = fmaxf(blk[0][i], blk[1][15 - i]); blk[2][i] = fmaxf(blk[2][i], blk[3][15 - i]); }
                BITONIC_MERGE16(blk[0]); BITONIC_MERGE16(blk[2]);
#pragma unroll
                for (int i = 0; i < 16; ++i) v[i] = fmaxf(blk[0][i], blk[2][15 - i]);
                BITONIC_MERGE16(v);
            }
            {
                float wv_[16];
#pragma unroll
                for (int j = 0; j < 16; ++j) wv_[j] = shx(v[15 - j], lane, 32);
#pragma unroll
                for (int j = 0; j < 16; ++j) v[j] = fmaxf(v[j], wv_[j]);
                BITONIC_MERGE16(v);
            }
            if (p == 0) {
#pragma unroll
                for (int j = 0; j < 16; ++j) L0[j] = v[j];
            } else {
#pragma unroll
                for (int j = 0; j < 16; ++j) L1[j] = v[j];
            }            AT_WAIT_BAR();
        }
        float tv[16];
        unsigned IA[4] = {0u, 0u, 0u, 0u}, IB[4] = {0u, 0u, 0u, 0u};
#pragma unroll
        for (int i = 0; i < 16; ++i) { IA[i >> 2] |= (127u - (__float_as_uint(L0[i]) & 0x7Fu)) << (8 * (i & 3)); IB[i >> 2] |= (127u - (__float_as_uint(L1[i]) & 0x7Fu)) << (8 * (i & 3)); }
        {
            float cb[4][16]; int cn = 0;
#pragma unroll
            for (int i = 0; i < 16; ++i) {
                const float va = __uint_as_float(__float_as_uint(L0[i]) & ~0x7Fu);
#pragma unroll
                for (int j = 0; j < 16; ++j) if ((i + 1) * (j + 1) <= 16) {
                    const float vb = __uint_as_float(__float_as_uint(L1[j]) & ~0x7Fu);
                    cb[cn >> 4][cn & 15] = __uint_as_float((__float_as_uint(va + vb) & ~0xFFu) | (unsigned)(255 - (i * 16 + j)));
                    ++cn;
                }
            }
#pragma unroll
            for (int c = 50; c < 64; ++c) cb[c >> 4][c & 15] = NINF;
#pragma unroll
            for (int nt = 0; nt < 4; ++nt) BITONIC_SORT16(cb[nt]);
#pragma unroll
            for (int i = 0; i < 16; ++i) { cb[0][i] = fmaxf(cb[0][i], cb[1][15 - i]); cb[2][i] = fmaxf(cb[2][i], cb[3][15 - i]); }
            BITONIC_MERGE16(cb[0]); BITONIC_MERGE16(cb[2]);
#pragma unroll
            for (int i = 0; i < 16; ++i) tv[i] = fmaxf(cb[0][i], cb[2][15 - i]);
            BITONIC_MERGE16(tv);
        }
        int ti[16];
#pragma unroll
        for (int j = 0; j < 16; ++j) { const unsigned kb = __float_as_uint(tv[j]); const unsigned flat = 255u - (kb & 0xFFu); const unsigned fi = flat >> 4, fj = flat & 15u;
            const unsigned ra = (fi < 8u) ? ((fi < 4u) ? IA[0] : IA[1]) : ((fi < 12u) ? IA[2] : IA[3]);
            const unsigned rb = (fj < 8u) ? ((fj < 4u) ? IB[0] : IB[1]) : ((fj < 12u) ? IB[2] : IB[3]);
            ti[j] = (int)(((ra >> (8u * (fi & 3u))) & 0xFFu) * 128u + ((rb >> (8u * (fj & 3u))) & 0xFFu));
            tv[j] = __uint_as_float(kb & ~0xFFu); }
        float e[16], sum = 0.f;
#pragma unroll
        for (int j = 0; j < 16; ++j) { e[j] = __expf(tv[j] - tv[0]); sum += e[j]; }
        const float inv = 1.f / sum;
        if (hi == 0) { int* ep = EXPERTS + (size_t)t * 128 + head * 16;
#pragma unroll
            for (int j = 0; j < 4; ++j) *(v4u*)(ep + 4 * j) = (v4u){(unsigned)ti[4 * j], (unsigned)ti[4 * j + 1], (unsigned)ti[4 * j + 2], (unsigned)ti[4 * j + 3]}; }
        else { float* gp = GATESP + (size_t)t * 128 + head * 16;
#pragma unroll
            for (int j = 0; j < 4; ++j) *(f32x4*)(gp + 4 * j) = (f32x4){e[4 * j] * inv, e[4 * j + 1] * inv, e[4 * j + 2] * inv, e[4 * j + 3] * inv}; }
    }
}

__device__ __forceinline__ float cvt_ub0(unsigned x) { float r; asm("v_cvt_f32_ubyte0 %0, %1" : "=v"(r) : "v"(x)); return r; }
__device__ __forceinline__ float cvt_ub1(unsigned x) { float r; asm("v_cvt_f32_ubyte1 %0, %1" : "=v"(r) : "v"(x)); return r; }
__device__ __forceinline__ float cvt_ub2(unsigned x) { float r; asm("v_cvt_f32_ubyte2 %0, %1" : "=v"(r) : "v"(x)); return r; }
__device__ __forceinline__ float cvt_ub3(unsigned x) { float r; asm("v_cvt_f32_ubyte3 %0, %1" : "=v"(r) : "v"(x)); return r; }
__device__ __forceinline__ void quant8_rows_bf16(const bf16* src, unsigned char* dst, float* scale, int nrows, int gw, int NGW, int lane) {
    for (int r = gw; r < nrows; r += NGW) {
        const v4u a = *(const v4u*)(src + (size_t)r * 1024 + 16 * lane), b = *(const v4u*)(src + (size_t)r * 1024 + 16 * lane + 8);
        float x[16]; float am = 0.f;
#pragma unroll
        for (int k = 0; k < 4; ++k) { x[2 * k] = bf_lo(a[k]); x[2 * k + 1] = bf_hi(a[k]); x[8 + 2 * k] = bf_lo(b[k]); x[9 + 2 * k] = bf_hi(b[k]); }
#pragma unroll
        for (int k = 0; k < 16; ++k) am = fmaxf(am, fabsf(x[k]));
#pragma unroll
        for (int o = 1; o < 64; o <<= 1) am = fmaxf(am, shx(am, lane, o));
        const float inv = am > 0.f ? 127.f / am : 0.f;
        v4u w;
#pragma unroll
        for (int k = 0; k < 4; ++k) w[k] = ((unsigned)((int)rintf(x[4 * k] * inv) & 0xff)) | ((unsigned)((int)rintf(x[4 * k + 1] * inv) & 0xff) << 8) | ((unsigned)((int)rintf(x[4 * k + 2] * inv) & 0xff) << 16) | ((unsigned)((int)rintf(x[4 * k + 3] * inv) & 0xff) << 24);
        *(v4u*)(dst + (size_t)r * 1024 + 16 * lane) = w;
        if (lane == 0) scale[r] = am * (1.f / 127.f);
    }
}
__device__ __forceinline__ void quant4_rows(const float* src, unsigned char* dst, float* scale, int nrows, int gw, int NGW, int lane) {
    for (int r = gw; r < nrows; r += NGW) {
        const f32x4* sp = (const f32x4*)(src + (size_t)r * 1024) + 4 * lane;
        f32x4 v[4]; float am = 0.f, ss = 0.f;
#pragma unroll
        for (int j = 0; j < 4; ++j) { v[j] = sp[j]; am = fmaxf(am, fmaxf(fmaxf(fabsf(v[j].x), fabsf(v[j].y)), fmaxf(fabsf(v[j].z), fabsf(v[j].w)))); ss += (v[j].x * v[j].x + v[j].y * v[j].y) + (v[j].z * v[j].z + v[j].w * v[j].w); }
#pragma unroll
        for (int o = 1; o < 64; o <<= 1) { am = fmaxf(am, shx(am, lane, o)); ss += shx(ss, lane, o); }
        const float step = fminf(am * (1.f / 7.5f), 0.3352f * sqrtf(ss * (1.f / 1024.f)));
        const float inv = step > 0.f ? 1.f / step : 0.f;
        unsigned q[16];
#pragma unroll
        for (int j = 0; j < 4; ++j) { q[4 * j] = (unsigned)fminf(fmaxf(rintf(v[j].x * inv + 7.5f), 0.f), 15.f); q[4 * j + 1] = (unsigned)fminf(fmaxf(rintf(v[j].y * inv + 7.5f), 0.f), 15.f);
                                      q[4 * j + 2] = (unsigned)fminf(fmaxf(rintf(v[j].z * inv + 7.5f), 0.f), 15.f); q[4 * j + 3] = (unsigned)fminf(fmaxf(rintf(v[j].w * inv + 7.5f), 0.f), 15.f); }
        u32x2 w;
        w.x = (q[0] | (q[4] << 4)) | ((q[1] | (q[5] << 4)) << 8) | ((q[2] | (q[6] << 4)) << 16) | ((q[3] | (q[7] << 4)) << 24);
        w.y = (q[8] | (q[12] << 4)) | ((q[9] | (q[13] << 4)) << 8) | ((q[10] | (q[14] << 4)) << 16) | ((q[11] | (q[15] << 4)) << 24);
        *(u32x2*)(dst + (size_t)r * 512 + 8 * lane) = w;
        if (lane == 0) scale[r] = step;
    }
}

#define RED_STEP(N, S) do { const bool up_ = (lane & (S)) != 0; _Pragma("unroll") for (int j_ = 0; j_ < (N); ++j_) { const int a_ = p[j_], b_ = p[j_ + (N)]; const int send_ = up_ ? a_ : b_, keep_ = up_ ? b_ : a_; p[j_] = keep_ + shxi(send_, lane, (S)); } } while (0)
#define RED16(dst) do { RED_STEP(8, 8); RED_STEP(4, 4); RED_STEP(2, 2); RED_STEP(1, 1); int s_ = p[0]; s_ += shxi(s_, lane, 16); s_ += shxi(s_, lane, 32); dst = s_; } while (0)
#define G_SB() __builtin_amdgcn_sched_barrier(0)
#define G_LOAD(buf, tab, evec, jb) do { _Pragma("unroll") for (int jj_ = 0; jj_ < 16; ++jj_) { const int e_ = __builtin_amdgcn_readlane(evec, (jb) + jj_); buf[jj_] = __builtin_amdgcn_raw_buffer_load_b64(rs_##tab, (int)voff, e_ << 9, 0); } } while (0)
#define U_COMP(buf) do { _Pragma("unroll") for (int jj_ = 0; jj_ < 16; ++jj_) { const unsigned w0_ = buf[jj_].x, w1_ = buf[jj_].y; \
    int d_ = __builtin_amdgcn_sdot4((int)(w0_ & 0x0F0F0F0Fu), hq[0], 0, false); d_ = __builtin_amdgcn_sdot4((int)((w0_ >> 4) & 0x0F0F0F0Fu), hq[1], d_, false); \
    d_ = __builtin_amdgcn_sdot4((int)(w1_ & 0x0F0F0F0Fu), hq[2], d_, false); d_ = __builtin_amdgcn_sdot4((int)((w1_ >> 4) & 0x0F0F0F0Fu), hq[3], d_, false); p[jj_] = d_; } } while (0)
#define V_DW(o0, o1, o2, o3, wd, cs) do { float t0_, t1_, t2_, t3_; asm volatile("v_cvt_f32_ubyte0 %4, %8\n\tv_cvt_f32_ubyte1 %5, %8\n\tv_cvt_f32_ubyte2 %6, %8\n\tv_cvt_f32_ubyte3 %7, %8\n\tv_fmac_f32 %0, %9, %4\n\tv_fmac_f32 %1, %9, %5\n\tv_fmac_f32 %2, %9, %6\n\tv_fmac_f32 %3, %9, %7" \
    : "+v"(o0), "+v"(o1), "+v"(o2), "+v"(o3), "=&v"(t0_), "=&v"(t1_), "=&v"(t2_), "=&v"(t3_) : "v"(wd), "s"(cs)); } while (0)
#define V_COMP(buf, cvec, jb) do { _Pragma("unroll") for (int jj_ = 0; jj_ < 16; ++jj_) { const float c_ = __uint_as_float(__builtin_amdgcn_readlane(__float_as_uint(cvec), (jb) + jj_)); const unsigned w0_ = buf[jj_].x, w1_ = buf[jj_].y; \
    V_DW(o[0], o[1], o[2], o[3], w0_ & 0x0F0F0F0Fu, c_); V_DW(o[4], o[5], o[6], o[7], (w0_ >> 4) & 0x0F0F0F0Fu, c_); V_DW(o[8], o[9], o[10], o[11], w1_ & 0x0F0F0F0Fu, c_); V_DW(o[12], o[13], o[14], o[15], (w1_ >> 4) & 0x0F0F0F0Fu, c_); } } while (0)
template <bool NEXT_NORM>
__device__ __forceinline__ void peer_gather_phase(const int wv, bool dry, int vcu, const bf16* HN, const int* EXPERTS, const float* GATESP, const unsigned char* U, const float* SU, const unsigned char* Vtab, const float* SV,
                                                  float* X, const float* gnext, bf16* XN) {
    int ln_; asm volatile("v_mbcnt_lo_u32_b32 %0, -1, 0\n\tv_mbcnt_hi_u32_b32 %0, -1, %0" : "=v"(ln_)); const int tid = wv * 64 + ln_, lane = tid & 63, w = wv;
    const __amdgpu_buffer_rsrc_t rs_U = __builtin_amdgcn_make_buffer_rsrc((void*)U, (short)0, 16384 * 512, 0x00020000), rs_Vtab = __builtin_amdgcn_make_buffer_rsrc((void*)Vtab, (short)0, 16384 * 512, 0x00020000);
    const unsigned voff = (unsigned)lane * 8u;
    const int lg = lane >> 4;
#pragma unroll 1
    for (int i = 0; i < 16; ++i) {
        const int t = vcu * 128 + w * 16 + i;
        const int ev0 = EXPERTS[(size_t)t * 128 + lane], ev1 = EXPERTS[(size_t)t * 128 + 64 + lane];
        const float gv0 = GATESP[(size_t)t * 128 + lane], gv1 = GATESP[(size_t)t * 128 + 64 + lane];
        const v4u h0 = *(const v4u*)(HN + (size_t)t * 1024 + 16 * lane), h1 = *(const v4u*)(HN + (size_t)t * 1024 + 16 * lane + 8);
        float hf[16]; float am = 0.f;
#pragma unroll
        for (int k = 0; k < 4; ++k) { hf[2 * k] = bf_lo(h0[k]); hf[2 * k + 1] = bf_hi(h0[k]); hf[8 + 2 * k] = bf_lo(h1[k]); hf[9 + 2 * k] = bf_hi(h1[k]); }
#pragma unroll
        for (int k = 0; k < 16; ++k) am = fmaxf(am, fabsf(hf[k]));
#pragma unroll
        for (int o = 1; o < 64; o <<= 1) am = fmaxf(am, shx(am, lane, o));
        const float hinv = am > 0.f ? 127.f / am : 0.f, sh = am * (1.f / 127.f);
        int hq[4]; int hs = 0;
#pragma unroll
        for (int k = 0; k < 4; ++k) { const int q0 = (int)rintf(hf[4 * k] * hinv), q1 = (int)rintf(hf[4 * k + 1] * hinv), q2 = (int)rintf(hf[4 * k + 2] * hinv), q3 = (int)rintf(hf[4 * k + 3] * hinv); hs += (q0 + q1) + (q2 + q3);
            hq[k] = (int)(((unsigned)(q0 & 0xff)) | ((unsigned)(q1 & 0xff) << 8) | ((unsigned)(q2 & 0xff) << 16) | ((unsigned)(q3 & 0xff) << 24)); }
#pragma unroll
        for (int o = 1; o < 64; o <<= 1) hs += shxi(hs, lane, o);
        const float hoff = 7.5f * (float)hs;
        const float su0 = SU[ev0], su1 = SU[ev1], sv0 = SV[ev0], sv1 = SV[ev1];
        float o[16];
#pragma unroll
        for (int k = 0; k < 16; ++k) o[k] = 0.f;
        int p[16], r0, r1, r2, r3, r4, r5, r6, r7;
        u32x2 A[16], B[16], C[16];
        G_LOAD(A, U, ev0, 0); G_LOAD(B, U, ev0, 16); G_SB();
        G_LOAD(C, U, ev0, 32); G_SB(); U_COMP(A); RED16(r0); G_SB();
        G_LOAD(A, U, ev0, 48); G_SB(); U_COMP(B); RED16(r1); G_SB();
        G_LOAD(B, U, ev1, 0); G_SB(); U_COMP(C); RED16(r2); G_SB();
        G_LOAD(C, U, ev1, 16); G_SB(); U_COMP(A); RED16(r3); G_SB();
        G_LOAD(A, U, ev1, 32); G_SB(); U_COMP(B); RED16(r4); G_SB();
        G_LOAD(B, U, ev1, 48); G_SB(); U_COMP(C); RED16(r5); G_SB();
        G_LOAD(C, Vtab, ev0, 0); G_SB(); U_COMP(A); RED16(r6); G_SB();
        G_LOAD(A, Vtab, ev0, 16); G_SB(); U_COMP(B); RED16(r7); G_SB();
        const int d0 = lg == 0 ? r0 : (lg == 1 ? r1 : (lg == 2 ? r2 : r3)), d1 = lg == 0 ? r4 : (lg == 1 ? r5 : (lg == 2 ? r6 : r7));
        float act0 = ((float)d0 - hoff) * (sh * su0), act1 = ((float)d1 - hoff) * (sh * su1);
#ifdef PROBE_NOFFN
        const float coef0 = 0.f * act0, coef1 = 0.f * act1;
#else
        const float coef0 = gv0 * (0.5f * act0 * (1.f + erff(act0 * 0.70710678118f))) * sv0, coef1 = gv1 * (0.5f * act1 * (1.f + erff(act1 * 0.70710678118f))) * sv1;
#endif
        G_SB();
        G_LOAD(B, Vtab, ev0, 32); G_SB(); V_COMP(C, coef0, 0); G_SB();
        G_LOAD(C, Vtab, ev0, 48); G_SB(); V_COMP(A, coef0, 16); G_SB();
        G_LOAD(A, Vtab, ev1, 0); G_SB(); V_COMP(B, coef0, 32); G_SB();
        G_LOAD(B, Vtab, ev1, 16); G_SB(); V_COMP(C, coef0, 48); G_SB();
        G_LOAD(C, Vtab, ev1, 32); G_SB(); V_COMP(A, coef1, 0); G_SB();
        G_LOAD(A, Vtab, ev1, 48); G_SB(); V_COMP(B, coef1, 16); G_SB();
        V_COMP(C, coef1, 32); G_SB(); V_COMP(A, coef1, 48); G_SB();
        const float corr = 7.5f * wave_sum(coef0 + coef1, lane);
        float* xr = X + (size_t)t * 1024 + 16 * lane;
        f32x4 xv[4];
#pragma unroll
        for (int k = 0; k < 4; ++k) { xv[k] = *(const f32x4*)(xr + 4 * k); xv[k] += (f32x4){o[4 * k] - corr, o[4 * k + 1] - corr, o[4 * k + 2] - corr, o[4 * k + 3] - corr}; }
        if (!dry) {
#pragma unroll
            for (int k = 0; k < 4; ++k) *(f32x4*)(xr + 4 * k) = xv[k]; }
        if (NEXT_NORM && !dry) {
            float ss = 0.f;
#pragma unroll
            for (int k = 0; k < 4; ++k) ss += (xv[k].x * xv[k].x + xv[k].y * xv[k].y) + (xv[k].z * xv[k].z + xv[k].w * xv[k].w);
            const float rstd = rsqrtf(wave_sum(ss, lane) * (1.f / 1024.f) + EPS);
            v4u wa, wb;
#pragma unroll
            for (int k = 0; k < 4; ++k) { const f32x4 g = *(const f32x4*)(gnext + 16 * lane + 4 * k); const unsigned lo = pk2(xv[k].x * rstd * g.x, xv[k].y * rstd * g.y), hi2 = pk2(xv[k].z * rstd * g.z, xv[k].w * rstd * g.w);
                if (k < 2) { wa[2 * k] = lo; wa[2 * k + 1] = hi2; } else { wb[2 * (k - 2)] = lo; wb[2 * (k - 2) + 1] = hi2; } }
            *(v4u*)(XN + (size_t)t * 1024 + 16 * lane) = wa; *(v4u*)(XN + (size_t)t * 1024 + 16 * lane + 8) = wb;
        }
    }
}

__device__ __forceinline__ void rms_quant_pass(const bf16* X, const float* g, bf16* XN, unsigned char* HQ, float* SH, float* HS, int gw, int NGW, int lane) {
    const f32x4* gr = (const f32x4*)g + lane;
    u32x2 w4[4], n4[4];
    if (gw < T) {
#pragma unroll
        for (int j = 0; j < 4; ++j) w4[j] = ((const u32x2*)(X + (size_t)gw * D) + lane)[64 * j]; }
    for (int m = gw; m < T; m += NGW) {
        { const int mn = m + NGW < T ? m + NGW : m;
#pragma unroll
          for (int j = 0; j < 4; ++j) n4[j] = ((const u32x2*)(X + (size_t)mn * D) + lane)[64 * j]; }
        f32x4 v[4]; float s = 0.f;
#pragma unroll
        for (int j = 0; j < 4; ++j) { const u32x2 w = w4[j]; v[j] = (f32x4){bf_lo(w.x), bf_hi(w.x), bf_lo(w.y), bf_hi(w.y)}; s += (v[j].x * v[j].x + v[j].y * v[j].y) + (v[j].z * v[j].z + v[j].w * v[j].w); }
#pragma unroll
        for (int j = 0; j < 4; ++j) w4[j] = n4[j];
        const float rstd = rsqrtf(wave_sum(s, lane) * (1.f / 1024.f) + EPS);
        float am = 0.f;
#pragma unroll
        for (int j = 0; j < 4; ++j) { const f32x4 gg = gr[64 * j]; v[j].x = v[j].x * rstd * gg.x; v[j].y = v[j].y * rstd * gg.y; v[j].z = v[j].z * rstd * gg.z; v[j].w = v[j].w * rstd * gg.w;
            am = fmaxf(am, fmaxf(fmaxf(fabsf(v[j].x), fabsf(v[j].y)), fmaxf(fabsf(v[j].z), fabsf(v[j].w)))); }
#pragma unroll
        for (int o = 1; o < 64; o <<= 1) am = fmaxf(am, shx(am, lane, o));
        const float hinv = am > 0.f ? 127.f / am : 0.f;
        int hs = 0;
        unsigned* q4 = (unsigned*)(HQ + (size_t)m * D) + lane;
#pragma unroll
        for (int j = 0; j < 4; ++j) { const int q0 = (int)rintf(v[j].x * hinv), q1 = (int)rintf(v[j].y * hinv), q2 = (int)rintf(v[j].z * hinv), q3 = (int)rintf(v[j].w * hinv); hs += (q0 + q1) + (q2 + q3);
            q4[64 * j] = ((unsigned)(q0 & 0xff)) | ((unsigned)(q1 & 0xff) << 8) | ((unsigned)(q2 & 0xff) << 16) | ((unsigned)(q3 & 0xff) << 24); }
#pragma unroll
        for (int o = 1; o < 64; o <<= 1) hs += shxi(hs, lane, o);
        if (lane == 0) { SH[m] = am * (1.f / 127.f); HS[m] = (float)hs; }
    }
}
__device__ __forceinline__ int dpp_add_quad(int d) {
    d += __builtin_amdgcn_update_dpp(0, d, 0xB1, 0xF, 0xF, true);
    d += __builtin_amdgcn_update_dpp(0, d, 0x4E, 0xF, 0xF, true);
    return d;
}
__device__ __forceinline__ int dpp_add_oct(int d) {
    d += __builtin_amdgcn_update_dpp(0, d, 0xB1, 0xF, 0xF, true);
    d += __builtin_amdgcn_update_dpp(0, d, 0x4E, 0xF, 0xF, true);
    d += __builtin_amdgcn_update_dpp(0, d, 0x141, 0xF, 0xF, true);
    return d;
}
#define G1_IDS(E_, H0_, H1_, it_) do { const int t_ = t0 + ((it_) >> 1), hf_ = (it_) & 1; const v4u* ep_ = (const v4u*)(EXPERTS + (size_t)t_ * 128 + 16 * oct + 8 * hf_); const v4u ea_ = ep_[0], eb_ = ep_[1]; \
    E_[0] = (int)ea_.x; E_[1] = (int)ea_.y; E_[2] = (int)ea_.z; E_[3] = (int)ea_.w; E_[4] = (int)eb_.x; E_[5] = (int)eb_.y; E_[6] = (int)eb_.z; E_[7] = (int)eb_.w; \
    H0_ = *(const v4u*)(HQ + (size_t)t_ * 1024 + 256 * s + 32 * q8); H1_ = *(const v4u*)(HQ + (size_t)t_ * 1024 + 256 * s + 32 * q8 + 16); } while (0)
#define G1_ROWS(R_, E_) do { _Pragma("unroll") for (int j_ = 0; j_ < 8; ++j_) R_[j_] = __builtin_amdgcn_raw_buffer_load_b128(rs_U, (E_[j_] << 9) + soff, 0, 0); } while (0)
#define G1_COMP(R_, H0_, H1_, it_) do { int dd_[8]; _Pragma("unroll") for (int j_ = 0; j_ < 8; ++j_) { \
    int d_ = __builtin_amdgcn_sdot4((int)(R_[j_].x & 0x0F0F0F0Fu), (int)H0_.x, 0, false); d_ = __builtin_amdgcn_sdot4((int)((R_[j_].x >> 4) & 0x0F0F0F0Fu), (int)H0_.y, d_, false); \
    d_ = __builtin_amdgcn_sdot4((int)(R_[j_].y & 0x0F0F0F0Fu), (int)H0_.z, d_, false); d_ = __builtin_amdgcn_sdot4((int)((R_[j_].y >> 4) & 0x0F0F0F0Fu), (int)H0_.w, d_, false); \
    d_ = __builtin_amdgcn_sdot4((int)(R_[j_].z & 0x0F0F0F0Fu), (int)H1_.x, d_, false); d_ = __builtin_amdgcn_sdot4((int)((R_[j_].z >> 4) & 0x0F0F0F0Fu), (int)H1_.y, d_, false); \
    d_ = __builtin_amdgcn_sdot4((int)(R_[j_].w & 0x0F0F0F0Fu), (int)H1_.z, d_, false); d_ = __builtin_amdgcn_sdot4((int)((R_[j_].w >> 4) & 0x0F0F0F0Fu), (int)H1_.w, d_, false); \
    dd_[j_] = dpp_add_oct(d_); } \
    if (q8 == 0) { v4u* pp_ = (v4u*)(PART + ((size_t)s * T + t0 + ((it_) >> 1)) * 128 + 16 * oct + 8 * ((it_) & 1)); pp_[0] = (v4u){(unsigned)dd_[0], (unsigned)dd_[1], (unsigned)dd_[2], (unsigned)dd_[3]}; pp_[1] = (v4u){(unsigned)dd_[4], (unsigned)dd_[5], (unsigned)dd_[6], (unsigned)dd_[7]}; } } while (0)
__device__ __forceinline__ void peer_g1_phase(const int wv, int vcu, const unsigned char* HQ, const int* EXPERTS, const unsigned char* U, int* PART) {
    int ln_; asm volatile("v_mbcnt_lo_u32_b32 %0, -1, 0\n\tv_mbcnt_hi_u32_b32 %0, -1, %0" : "=v"(ln_)); const int lane = ln_, oct = lane >> 3, q8 = lane & 7;
    const int s = vcu >> 6;
    const __amdgpu_buffer_rsrc_t rs_U = __builtin_amdgcn_make_buffer_rsrc((void*)U, (short)0, 16384 * 512, 0x00020000);
    const int soff = 128 * s + 16 * q8;
    const int t0 = 512 * (vcu & 63) + 64 * wv;
    int eA[8], eB[8]; v4u rA[8], rB[8], hA0, hA1, hB0, hB1, hC0, hC1;
    G1_IDS(eA, hA0, hA1, 0); G1_ROWS(rA, eA); G1_IDS(eB, hB0, hB1, 1);
#pragma unroll 1
    for (int i = 0; i < 128; i += 2) {
        G1_ROWS(rB, eB); __builtin_amdgcn_sched_barrier(0);
        G1_IDS(eA, hC0, hC1, (i + 2) & 127); __builtin_amdgcn_sched_barrier(0);
        G1_COMP(rA, hA0, hA1, i); __builtin_amdgcn_sched_barrier(0);
        G1_ROWS(rA, eA); hA0 = hC0; hA1 = hC1; __builtin_amdgcn_sched_barrier(0);
        G1_IDS(eB, hC0, hC1, (i + 3) & 127); __builtin_amdgcn_sched_barrier(0);
        G1_COMP(rB, hB0, hB1, i + 1); __builtin_amdgcn_sched_barrier(0);
        hB0 = hC0; hB1 = hC1;
    }
}
__device__ __forceinline__ void peer_g1b_phase(const int* PART, const int* EXPERTS, const float* GATESP, const float* SU, const float* SV, const float* SH, const float* HS, unsigned char* COEFQ, float* SCT, float* CS, int gw, int NGW, int lane) {
    for (int t = gw; t < T; t += NGW) {
        const float sh = SH[t], hoff = 7.5f * HS[t];
        float cf[2]; float am = 0.f;
#pragma unroll
        for (int h2 = 0; h2 < 2; ++h2) {
            const size_t idx = (size_t)t * 128 + 64 * h2 + lane;
            int d = 0;
#pragma unroll
            for (int x = 0; x < 4; ++x) d += PART[(size_t)x * T * 128 + idx];
            const int ev = EXPERTS[idx];
            const float act = ((float)d - hoff) * (sh * SU[ev]);
            cf[h2] = GATESP[idx] * (0.5f * act * (1.f + erff(act * 0.70710678118f))) * SV[ev];
            am = fmaxf(am, fabsf(cf[h2]));
        }
#pragma unroll
        for (int o = 1; o < 64; o <<= 1) am = fmaxf(am, shx(am, lane, o));
        const float inv = am > 0.f ? 127.f / am : 0.f;
        const int q0 = (int)rintf(cf[0] * inv), q1 = (int)rintf(cf[1] * inv);
        COEFQ[(size_t)t * 128 + lane] = (unsigned char)(q0 & 0xff); COEFQ[(size_t)t * 128 + 64 + lane] = (unsigned char)(q1 & 0xff);
        int cs = q0 + q1;
#pragma unroll
        for (int o = 1; o < 64; o <<= 1) cs += shxi(cs, lane, o);
        if (lane == 0) { SCT[t] = am * (1.f / 127.f); CS[t] = (float)cs; }
    }
}
#define G2_IDS(E_, C_, it_) do { const int t_ = t0 + ((it_) >> 1), hf_ = (it_) & 1; const v4u* ep_ = (const v4u*)(EXPERTS + (size_t)t_ * 128 + 16 * oct + 8 * hf_); const v4u ea_ = ep_[0], eb_ = ep_[1]; \
    E_[0] = (int)ea_.x; E_[1] = (int)ea_.y; E_[2] = (int)ea_.z; E_[3] = (int)ea_.w; E_[4] = (int)eb_.x; E_[5] = (int)eb_.y; E_[6] = (int)eb_.z; E_[7] = (int)eb_.w; \
    C_ = *(const u32x2*)(COEFQ + (size_t)t_ * 128 + 16 * oct + 8 * hf_); } while (0)
#define G2_ROWS(R_, E_) do { _Pragma("unroll") for (int j_ = 0; j_ < 8; ++j_) R_[j_] = __builtin_amdgcn_raw_buffer_load_b128(rs_V, (E_[j_] << 9) + soff, 0, 0); } while (0)
#define G2_T4(ob, w0, w1, w2, w3, cq_) do { const unsigned a_ = __builtin_amdgcn_perm(w1, w0, 0x05010400u), b_ = __builtin_amdgcn_perm(w1, w0, 0x07030602u), c_ = __builtin_amdgcn_perm(w3, w2, 0x05010400u), d_ = __builtin_amdgcn_perm(w3, w2, 0x07030602u); \
    const unsigned y0_ = __builtin_amdgcn_perm(c_, a_, 0x05040100u), y1_ = __builtin_amdgcn_perm(c_, a_, 0x07060302u), y2_ = __builtin_amdgcn_perm(d_, b_, 0x05040100u), y3_ = __builtin_amdgcn_perm(d_, b_, 0x07060302u); \
    o[(ob)] = __builtin_amdgcn_sdot4((int)(y0_ & 0x0F0F0F0Fu), cq_, o[(ob)], false); o[(ob) + 4] = __builtin_amdgcn_sdot4((int)((y0_ >> 4) & 0x0F0F0F0Fu), cq_, o[(ob) + 4], false); \
    o[(ob) + 1] = __builtin_amdgcn_sdot4((int)(y1_ & 0x0F0F0F0Fu), cq_, o[(ob) + 1], false); o[(ob) + 5] = __builtin_amdgcn_sdot4((int)((y1_ >> 4) & 0x0F0F0F0Fu), cq_, o[(ob) + 5], false); \
    o[(ob) + 2] = __builtin_amdgcn_sdot4((int)(y2_ & 0x0F0F0F0Fu), cq_, o[(ob) + 2], false); o[(ob) + 6] = __builtin_amdgcn_sdot4((int)((y2_ >> 4) & 0x0F0F0F0Fu), cq_, o[(ob) + 6], false); \
    o[(ob) + 3] = __builtin_amdgcn_sdot4((int)(y3_ & 0x0F0F0F0Fu), cq_, o[(ob) + 3], false); o[(ob) + 7] = __builtin_amdgcn_sdot4((int)((y3_ >> 4) & 0x0F0F0F0Fu), cq_, o[(ob) + 7], false); } while (0)
#define G2_REDI(N, S) do { const bool up_ = (lane & (S)) != 0; _Pragma("unroll") for (int j_ = 0; j_ < (N); ++j_) { const int a_ = o[j_], b_ = o[j_ + (N)]; const int send_ = up_ ? a_ : b_, keep_ = up_ ? b_ : a_; o[j_] = keep_ + shxi(send_, lane, (S)); } } while (0)
#define G2_COMP(R_, C_, it_) do { int o[32]; _Pragma("unroll") for (int k_ = 0; k_ < 32; ++k_) o[k_] = 0; \
    G2_T4(0, R_[0].x, R_[1].x, R_[2].x, R_[3].x, (int)C_.x); G2_T4(8, R_[0].y, R_[1].y, R_[2].y, R_[3].y, (int)C_.x); G2_T4(16, R_[0].z, R_[1].z, R_[2].z, R_[3].z, (int)C_.x); G2_T4(24, R_[0].w, R_[1].w, R_[2].w, R_[3].w, (int)C_.x); \
    G2_T4(0, R_[4].x, R_[5].x, R_[6].x, R_[7].x, (int)C_.y); G2_T4(8, R_[4].y, R_[5].y, R_[6].y, R_[7].y, (int)C_.y); G2_T4(16, R_[4].z, R_[5].z, R_[6].z, R_[7].z, (int)C_.y); G2_T4(24, R_[4].w, R_[5].w, R_[6].w, R_[7].w, (int)C_.y); \
    G2_REDI(16, 8); G2_REDI(8, 16); G2_REDI(4, 32); \
    const int tt_ = t0 + ((it_) >> 1); const float sc_ = SCT[tt_], corr_ = ((it_) & 1) ? 0.f : 7.5f * CS[tt_]; u32x2* xp_ = (u32x2*)(XR + (size_t)tt_ * 1024 + ocol); const u32x2 xw_ = *xp_; \
    f32x4 xv_ = (f32x4){bf_lo(xw_.x), bf_hi(xw_.x), bf_lo(xw_.y), bf_hi(xw_.y)}; \
    xv_.x += sc_ * ((float)o[0] - corr_); xv_.y += sc_ * ((float)o[1] - corr_); xv_.z += sc_ * ((float)o[2] - corr_); xv_.w += sc_ * ((float)o[3] - corr_); \
    if (!NEXT && ((it_) & 1)) { *(f32x4*)(OUT + (size_t)tt_ * 1024 + ocol) = xv_; } else { *xp_ = (u32x2){pk2(xv_.x, xv_.y), pk2(xv_.z, xv_.w)}; } \
    if (NEXT && ((it_) & 1)) { const float y0_ = bf_lo(pk2(xv_.x, 0.f)), y1_ = bf_lo(pk2(xv_.y, 0.f)), y2_ = bf_lo(pk2(xv_.z, 0.f)), y3_ = bf_lo(pk2(xv_.w, 0.f)); \
        const float ss_ = wave_sum((y0_ * y0_ + y1_ * y1_) + (y2_ * y2_ + y3_ * y3_), lane); if (lane == 0) SS[(size_t)s * T + tt_] = ss_; } } while (0)
template <bool NEXT>
__device__ __forceinline__ void peer_g2_phase(const int wv, int vcu, const int* EXPERTS, const unsigned char* COEFQ, const float* SCT, const float* CS, const unsigned char* Vtab, bf16* XR, float* OUT, float* SS) {
    int ln_; asm volatile("v_mbcnt_lo_u32_b32 %0, -1, 0\n\tv_mbcnt_hi_u32_b32 %0, -1, %0" : "=v"(ln_)); const int lane = ln_, oct = lane >> 3, q8 = lane & 7;
    const int s = vcu >> 6;
    const __amdgpu_buffer_rsrc_t rs_V = __builtin_amdgcn_make_buffer_rsrc((void*)Vtab, (short)0, 16384 * 512, 0x00020000);
    const int soff = 128 * s + 16 * q8;
    const int ocol = 256 * s + 32 * q8 + 16 * ((lane >> 3) & 1) + 8 * ((lane >> 4) & 1) + 4 * ((lane >> 5) & 1);
    const int t0 = 512 * (vcu & 63) + 64 * wv;
    int eA[8], eB[8]; u32x2 cA, cB, cC; v4u rA[8], rB[8];
    G2_IDS(eA, cA, 0); G2_ROWS(rA, eA); G2_IDS(eB, cB, 1);
#pragma unroll 1
    for (int i = 0; i < 128; i += 2) {
        G2_ROWS(rB, eB); __builtin_amdgcn_sched_barrier(0);
        G2_IDS(eA, cC, (i + 2) & 127); __builtin_amdgcn_sched_barrier(0);
        G2_COMP(rA, cA, i); __builtin_amdgcn_sched_barrier(0);
        G2_ROWS(rA, eA); cA = cC; __builtin_amdgcn_sched_barrier(0);
        G2_IDS(eB, cC, (i + 3) & 127); __builtin_amdgcn_sched_barrier(0);
        G2_COMP(rB, cB, i + 1); __builtin_amdgcn_sched_barrier(0);
        cB = cC;
    }
}

__device__ __forceinline__ void qknorm_rope_pass(bf16* Q1, bf16* K1, const float* qg, const float* kg, const float* rope, size_t gtid, size_t gthreads) {
    const size_t NROWS = (size_t)2 * 64 * 2 * 4096;
    const int lane = (int)(gtid & 63);
    for (size_t id = gtid; id < NROWS * 8; id += gthreads) {
        const size_t rowg = id >> 3; const int part = (int)(id & 7);
        const bool isk = rowg >= NROWS / 2; const size_t row = isk ? rowg - NROWS / 2 : rowg;
        bf16* ptr = (isk ? K1 : Q1) + row * 64 + part * 8; const float* g = (isk ? kg : qg) + part * 8;
        const int s = (int)(row & 4095); const int bh = (int)(row >> 13); const int bidx = bh >> 3; const size_t mtok = (size_t)bidx * 4096 + s;
        const v4u raw = *(const v4u*)ptr;
        float x[8];
#pragma unroll
        for (int i = 0; i < 4; ++i) { x[2 * i] = bf_lo(raw[i]); x[2 * i + 1] = bf_hi(raw[i]); }
        float ss = 0.f;
#pragma unroll
        for (int i = 0; i < 8; ++i) ss += x[i] * x[i];
        ss += shx(ss, lane, 1); ss += shx(ss, lane, 2); ss += shx(ss, lane, 4);
        const float rstd = rsqrtf(ss * (1.f / 64.f) + EPS);
        float y[8], other[8];
#pragma unroll
        for (int i = 0; i < 8; ++i) y[i] = x[i] * rstd * g[i];
#pragma unroll
        for (int i = 0; i < 8; ++i) other[i] = shx(y[i], lane, 1);
        if (part < 2) { const float* cs = rope + mtok * 16;
#pragma unroll
            for (int i = 0; i < 8; ++i) { const float co = cs[i], si = cs[8 + i]; y[i] = (part == 0) ? (y[i] * co - other[i] * si) : (y[i] * co + other[i] * si); } }
        const float sc = isk ? 1.f : (0.125f * 1.44269504089f);
        v4u o;
#pragma unroll
        for (int i = 0; i < 4; ++i) o[i] = pk2(y[2 * i] * sc, y[2 * i + 1] * sc);
        *(v4u*)ptr = o;
    }
}

#define AT_DMA(kt_, slot_) do { \
    _Pragma("unroll") for (int i_ = 0; i_ < 2; ++i_) { const int row_ = 8 * w + (lane >> 3), ch_ = (lane & 7) ^ ((row_ >> 1) & 7); \
        glds16(K1 + ((size_t)((bh * 2 + i_) * 4096 + (kt_) * 64 + row_)) * 64 + ch_ * 8, (unsigned)__builtin_amdgcn_readfirstlane((int)(ldsb + (slot_) * 32768 + i_ * 8192 + w * 1024))); } \
    _Pragma("unroll") for (int i_ = 0; i_ < 2; ++i_) { const int row_ = 8 * w + 4 * i_ + (lane >> 4), ch_ = (lane & 15) ^ ((row_ & 3) << 2); \
        glds16(V1 + ((size_t)(bh * 4096 + (kt_) * 64 + row_)) * 128 + ch_ * 8, (unsigned)__builtin_amdgcn_readfirstlane((int)(ldsb + (slot_) * 32768 + 16384 + w * 2048 + i_ * 1024))); } } while (0)
typedef short v4i16_t __attribute__((ext_vector_type(4)));
__device__ __forceinline__ bf16x8 vtr8(const LAS bf16* p) {
    const v4i16_t lo = __builtin_amdgcn_ds_read_tr16_b64_v4i16((LAS v4i16_t*)p), hi = __builtin_amdgcn_ds_read_tr16_b64_v4i16((LAS v4i16_t*)(p + 8 * 128));
    return (bf16x8){lo[0], lo[1], lo[2], lo[3], hi[0], hi[1], hi[2], hi[3]};
}
template <bool OFFS>
__device__ __forceinline__ void attn_units(const int wv, LAS unsigned char* lds, int vcu, const bf16* Q1, const bf16* K1, const bf16* V1, bf16* O, const float* subln, float lam, float offs) {
    int ln_; asm volatile("v_mbcnt_lo_u32_b32 %0, -1, 0\n\tv_mbcnt_hi_u32_b32 %0, -1, %0" : "=v"(ln_)); const int tid = wv * 64 + ln_, lane = tid & 63, w = wv, r32 = lane & 31, hi = lane >> 5, qt = w & 3, c = w >> 2;
    LAS float* lbuf = (LAS float*)(lds + 135168 + w * 128);
    LAS float* Obuf = (LAS float*)lds;
    if (wv >= 4) __builtin_amdgcn_s_setprio(1);
    const unsigned ldsb = (unsigned)(uintptr_t)lds;
#pragma unroll 1
    for (int ui = 0; ui < 8; ++ui) {
        const int bh = (vcu >> 5) * 8 + ui, qb = vcu & 31, b = bh >> 3, h = bh & 7;
        bf16x8 bq[4];
#pragma unroll
        for (int ks = 0; ks < 4; ++ks) bq[ks] = *(const bf16x8*)(Q1 + ((size_t)((bh * 2 + c) * 4096 + qb * 128 + qt * 32 + r32)) * 64 + ks * 16 + 8 * hi);
        f32x16 Oa[4];
#pragma unroll
        for (int db = 0; db < 4; ++db)
#pragma unroll
            for (int r = 0; r < 16; ++r) Oa[db][r] = 0.f;
        float lsum = 0.f;
        AT_DMA(0, 0); AT_DMA(1, 1);
        AT_WAIT_BAR();
        const int kx0 = (r32 >> 1) & 7, kx1 = ((32 + r32) >> 1) & 7;
        const int vrow = 4 * hi + ((lane >> 2) & 3), vg = (lane >> 4) & 1, vp = lane & 3;
        f32x16 s0, s1;
        { const LAS unsigned char* Kc = lds + c * 8192;
#pragma unroll
          for (int r = 0; r < 16; ++r) { s0[r] = 0.f; s1[r] = 0.f; }
#pragma unroll
          for (int ks = 0; ks < 4; ++ks) { const bf16x8 a0 = *(const LAS bf16x8*)(Kc + r32 * 128 + (((2 * ks + hi) ^ kx0) << 4)), a1 = *(const LAS bf16x8*)(Kc + (32 + r32) * 128 + (((2 * ks + hi) ^ kx1) << 4));
              s0 = mfma32(a0, bq[ks], s0); s1 = mfma32(a1, bq[ks], s1); } }
        int b0 = 0, b1 = 1, b2 = 2;
#pragma unroll 1
        for (int kt = 0; kt < 64; ++kt) {
            if (kt + 2 < 64) AT_DMA(kt + 2, b2);
            const LAS unsigned char* Kc = lds + b1 * 32768 + c * 8192;
            const LAS unsigned char* Vb = lds + b0 * 32768 + 16384 + vrow * 256 + 8 * (vp & 1);
            f32x16 n0, n1;
#pragma unroll
            for (int r = 0; r < 16; ++r) { n0[r] = 0.f; n1[r] = 0.f; }
            bf16x8 ka[8];
#define AT_KLD(ks_) do { ka[2 * (ks_)] = *(const LAS bf16x8*)(Kc + r32 * 128 + (((2 * (ks_) + hi) ^ kx0) << 4)); ka[2 * (ks_) + 1] = *(const LAS bf16x8*)(Kc + (32 + r32) * 128 + (((2 * (ks_) + hi) ^ kx1) << 4)); } while (0)
            AT_KLD(0); AT_KLD(1);
            __builtin_amdgcn_sched_barrier(0);
#pragma unroll
            for (int ks = 0; ks < 4; ++ks) {
                n0 = mfma32(ka[2 * ks], bq[ks], n0);
#pragma unroll
                for (int r = 0; r < 4; ++r) s0[4 * ks + r] = __builtin_amdgcn_exp2f(OFFS ? s0[4 * ks + r] - offs : s0[4 * ks + r]);
                __builtin_amdgcn_sched_barrier(0);
                n1 = mfma32(ka[2 * ks + 1], bq[ks], n1);
                if (ks < 2) AT_KLD(ks + 2);
#pragma unroll
                for (int r = 0; r < 4; ++r) s1[4 * ks + r] = __builtin_amdgcn_exp2f(OFFS ? s1[4 * ks + r] - offs : s1[4 * ks + r]);
                __builtin_amdgcn_sched_barrier(0);
            }
#undef AT_KLD
            bf16x8 pa[4]; bf16x8 vf[4], vn[4];
#pragma unroll
            for (int db = 0; db < 4; ++db) vf[db] = vtr8((const LAS bf16*)(Vb + (((4 * db + 2 * vg + (vp >> 1)) ^ ((vrow & 3) << 2)) << 4)));
            float ls = 0.f;
            { v4u t0;
#pragma unroll
              for (int k = 0; k < 4; ++k) { t0[k] = pk2(s0[2 * k], s0[2 * k + 1]); ls += s0[2 * k] + s0[2 * k + 1]; }
              pa[0] = __builtin_bit_cast(bf16x8, t0); }
            __builtin_amdgcn_sched_barrier(0);
#pragma unroll
            for (int sp_ = 0; sp_ < 4; ++sp_) {
                if (sp_ < 3) {
#pragma unroll
                    for (int db = 0; db < 4; ++db) vn[db] = vtr8((const LAS bf16*)(Vb + (16 * (sp_ + 1)) * 256 + (((4 * db + 2 * vg + (vp >> 1)) ^ ((vrow & 3) << 2)) << 4)));
                }
#pragma unroll
                for (int db = 0; db < 4; ++db) Oa[db] = mfma32(pa[sp_], vf[db], Oa[db]);
                if (sp_ < 3) { v4u t0;
#pragma unroll
                    for (int k = 0; k < 4; ++k) { const float x0 = (sp_ == 0) ? s0[8 + 2 * k] : (sp_ == 1 ? s1[2 * k] : s1[8 + 2 * k]), x1 = (sp_ == 0) ? s0[9 + 2 * k] : (sp_ == 1 ? s1[2 * k + 1] : s1[9 + 2 * k]); t0[k] = pk2(x0, x1); ls += x0 + x1; }
                    pa[sp_ + 1] = __builtin_bit_cast(bf16x8, t0); }
                __builtin_amdgcn_sched_barrier(0);
                if (sp_ < 3) {
#pragma unroll
                    for (int db = 0; db < 4; ++db) vf[db] = vn[db];
                }
            }
            lsum += ls;
            s0 = n0; s1 = n1;
            { const int tb = b0; b0 = b1; b1 = b2; b2 = tb; }
            AT_WAIT_BAR();
        }
        lsum += shx(lsum, lane, 32);
        lbuf[r32] = lsum;
#pragma unroll
        for (int r = 0; r < 16; ++r) { const int qrow = (r & 3) + 8 * (r >> 2) + 4 * hi; const float inv = 1.f / lbuf[qrow];
#pragma unroll
            for (int db = 0; db < 4; ++db) Obuf[(c * 128 + qt * 32 + qrow) * 132 + 32 * db + r32] = Oa[db][r] * inv; }
        __syncthreads();
        { const int row = tid >> 2, qd = tid & 3;
          float dv[32]; float ss = 0.f;
#pragma unroll
          for (int k = 0; k < 8; ++k) { const f32x4 o0 = *(const LAS f32x4*)(Obuf + row * 132 + qd * 32 + 4 * k), o1 = *(const LAS f32x4*)(Obuf + (128 + row) * 132 + qd * 32 + 4 * k);
#pragma unroll
              for (int e = 0; e < 4; ++e) { const float d = o0[e] - lam * o1[e]; dv[4 * k + e] = d; ss += d * d; } }
          ss += shx(ss, lane, 1); ss += shx(ss, lane, 2);
          const float rstd = rsqrtf(ss * (1.f / 128.f) + EPS) * (1.f - LAMBDA_INIT);
          bf16* op = O + ((size_t)b * 4096 + qb * 128 + row) * 1024 + h * 128 + qd * 32;
#pragma unroll
          for (int k = 0; k < 4; ++k) { v4u o;
#pragma unroll
              for (int e = 0; e < 4; ++e) o[e] = pk2(dv[8 * k + 2 * e] * rstd * subln[qd * 32 + 8 * k + 2 * e], dv[8 * k + 2 * e + 1] * rstd * subln[qd * 32 + 8 * k + 2 * e + 1]);
              *(v4u*)(op + 8 * k) = o; } }
        __syncthreads();
    }
    __builtin_amdgcn_s_setprio(0);
}
__device__ __forceinline__ void attn_phase(const int wv, LAS unsigned char* lds, int vcu, const bf16* Q1, const bf16* K1, const bf16* V1, bf16* O, const float* qg, const float* kg,
                                           const float* lq1, const float* lk1, const float* lq2, const float* lk2, const float* subln) {
    float s1 = 0.f, s2 = 0.f, mq = 0.f, mk = 0.f;
    for (int i = 0; i < 64; ++i) { s1 += lq1[i] * lk1[i]; s2 += lq2[i] * lk2[i]; mq = fmaxf(mq, fabsf(qg[i])); mk = fmaxf(mk, fabsf(kg[i])); }
    const float lam = expf(s1) - expf(s2) + LAMBDA_INIT;
    const float offs = 8.f * mq * mk * 1.44269504089f * 1.02f + 0.25f;
    if (offs < 24.f) attn_units<false>(wv, lds, vcu, Q1, K1, V1, O, subln, lam, 0.f);
    else attn_units<true>(wv, lds, vcu, Q1, K1, V1, O, subln, lam, offs);
}
#undef AT_LOAD
#undef AT_WRITE
struct Args { const void* in[27]; float* out; unsigned char* ws; };
#define KARG(i) ({ GAS const void* p_; asm volatile("s_load_dwordx2 %0, %1, %2\n\ts_waitcnt lgkmcnt(0)" : "=s"(p_) : "s"(__builtin_amdgcn_kernarg_segment_ptr()), "i"(8 * (i))); (const void*)p_; })
#define KIN(i) ((const float*)KARG(i))
#define KOUT() ((float*)KARG(27))
#define KWS() ((unsigned char*)KARG(28))
#define WSP(T_, off) ((T_*)(KWS() + (off)))
__global__ void __launch_bounds__(NWAVES * 64, 2) mk_fwd(Args args) {
    extern __shared__ __attribute__((aligned(16))) unsigned char lds_raw[];
    LAS unsigned char* lds = (LAS unsigned char*)lds_raw;
    const int G = gridDim.x, bx = blockIdx.x;
    const int wv = __builtin_amdgcn_readfirstlane((int)(threadIdx.x >> 6));
    const int vcu = (G % 8 == 0) ? (bx % 8) * (G / 8) + bx / 8 : bx;
#define PH_IDS() int ln_; asm volatile("v_mbcnt_lo_u32_b32 %0, -1, 0\n\tv_mbcnt_hi_u32_b32 %0, -1, %0" : "=v"(ln_)); const int lane = ln_, wave = wv, tid = wv * 64 + ln_; \
    const int gw = vcu * NWAVES + wave, NGW = G * NWAVES; const size_t gtid = (size_t)vcu * (NWAVES * 64) + tid, gthreads = (size_t)G * (NWAVES * 64); (void)lane; (void)gw; (void)NGW; (void)gtid; (void)gthreads
    if (threadIdx.x < 32) ((LAS unsigned*)(lds + MISC_OFF))[threadIdx.x] = 0u;
    __syncthreads();
    (void)xcd_barrier_post((unsigned*)(WSP(gu32, WS_CTL) + CW_BAR), (volatile LAS unsigned*)(lds + MISC_OFF) + 8);
#define STAMP() do {} while (0)
#ifndef PROBE_DUP
#define PROBE_DUP 0
#endif
#define REPS(bit) _Pragma("unroll 1") for (int rep_ = 0; rep_ < 1 + ((PROBE_DUP >> (bit)) & 1); ++rep_)
#define GRID_BAR1() do { XcdBarrier b_; b_.bar = (unsigned*)(WSP(gu32, WS_CTL) + CW_BAR); b_.x = xb_xcc_id(); b_.st = (volatile LAS unsigned*)(lds + MISC_OFF) + 8; xcd_barrier(b_); } while (0)
#define GRID_BAR() do { GRID_BAR1(); if ((PROBE_DUP >> 9) & 1) GRID_BAR1(); } while (0)

    REPS(5) {
        PH_IDS();
        LAS float* scr = (LAS float*)(lds + wave * 16384);
        constexpr int I0 = 16 * 97, I1 = 16 * 32, I2 = 16 * 64, I3 = 16 * 96, I4 = 16 * 32, I5 = 16 * 64, NITEMS = I0 + I1 + I2 + I3 + I4 + I5;
        for (int it = gw; it < NITEMS; it += NGW) {
            int r = it;
            if (r < I0) { p0_transpose_item(KIN(3), 1024, 3104, WSP(bf16, WS_WIN), scr, r, lane); continue; } r -= I0;
            if (r < I1) { p0_transpose_item(KIN(6), 1024, 1024, WSP(bf16, WS_WO0), scr, r, lane); continue; } r -= I1;
            if (r < I2) { p0_transpose_item(KIN(8), 1024, 2048, WSP(bf16, WS_WQ0), scr, r, lane); continue; } r -= I2;
            if (r < I3) { p0_transpose_item(KIN(13), 1024, 3072, WSP(bf16, WS_WQKV), scr, r, lane, KIN(12)); continue; } r -= I3;
            if (r < I4) { p0_transpose_item(KIN(21), 1024, 1024, WSP(bf16, WS_WO1), scr, r, lane); continue; } r -= I4;
            p0_transpose_item(KIN(23), 1024, 2048, WSP(bf16, WS_WQ1), scr, r, lane);
        }
        { bf16* WIN = WSP(bf16, WS_WIN); for (size_t i = gtid * 8; i < (size_t)224 * 1024; i += gthreads * 8) *(v4u*)(WIN + (size_t)3104 * 1024 + i) = (v4u){0u, 0u, 0u, 0u}; }
        cvt_range(KIN(9), WSP(bf16, WS_KEY0), (size_t)262144, gtid, gthreads);
        cvt_range(KIN(24), WSP(bf16, WS_KEY1), (size_t)262144, gtid, gthreads);
        rms_pass(KIN(0), KIN(2), WSP(bf16, WS_B0), gw, NGW, lane);
        { const int* positions = (const int*)KARG(1); float* ROPE = WSP(float, WS_ROPE);
          for (size_t id = gtid; id < (size_t)T * 8; id += gthreads) { const size_t mtok = id >> 3; const int i = (int)(id & 7);
            const float inv = powf(500000.0f, -(float)i * 2.0f / 16.0f); const float ang = (float)positions[mtok] * inv;
            float sn, cs; sincosf(ang, &sn, &cs); ROPE[mtok * 16 + i] = cs; ROPE[mtok * 16 + 8 + i] = sn; } }
    }
    GRID_BAR();
    REPS(3) {
        unsigned char* ws = KWS();
        pg8::Gemm g{(const bf16*)(ws + WS_B0), (const bf16*)(ws + WS_WIN), T, 3328, 1024}; pg8::StaticOrder S; S.init(T, 3328, G, bx);
        pg8::EpiInProj E{(bf16*)(ws + WS_R1), (bf16*)(ws + WS_R1 + 32 * MiB), (bf16*)(ws + WS_R2), (bf16*)(ws + WS_R3), (float*)(ws + WS_GATES), KIN(4)};
        pg8::gemm_phase<pg8::EpiInProj, pg8::StaticOrder, true, true>(lds, g, S, E, wv);
    }
    GRID_BAR();
    if ((bx >> 3) & 1) { PH_IDS(); const int gwi = ((bx >> 4) * 8 + (bx & 7)) * NWAVES + wave, NGWI = 128 * NWAVES; (void)gw; (void)NGW;
        quant4_rows(KIN(10), WSP(unsigned char, WS_U0), WSP(float, WS_SC), 16384, gwi, NGWI, lane);
        quant4_rows(KIN(11), WSP(unsigned char, WS_V0T), WSP(float, WS_SC + 65536), 16384, gwi, NGWI, lane);
        quant4_rows(KIN(25), WSP(unsigned char, WS_U1), WSP(float, WS_SC + 2 * 65536), 16384, gwi, NGWI, lane);
        quant4_rows(KIN(26), WSP(unsigned char, WS_V1T), WSP(float, WS_SC + 3 * 65536), 16384, gwi, NGWI, lane);
        quant8_rows_bf16(WSP(bf16, WS_WQ0), WSP(unsigned char, WS_I8), WSP(float, WS_I8 + 4 * MiB), 2048, gwi, NGWI, lane);
        quant8_rows_bf16(WSP(bf16, WS_WQ1), WSP(unsigned char, WS_I8 + 2 * MiB), WSP(float, WS_I8 + 4 * MiB + 8192), 2048, gwi, NGWI, lane); }
    REPS(2) { unsigned char* ws = KWS(); mlstm_phase(wv, lds, (const bf16*)(ws + WS_R1), (const bf16*)(ws + WS_R1 + 32 * MiB), (const bf16*)(ws + WS_R2), (const float*)(ws + WS_GATES), (bf16*)(ws + WS_R4), (bf16*)(ws + WS_R5)); }
    GRID_BAR();
    REPS(6) { PH_IDS(); unsigned char* ws = KWS(); hs_pass((const bf16*)(ws + WS_R4), (const bf16*)(ws + WS_R5), (const bf16*)(ws + WS_R3), KIN(5), (bf16*)(ws + WS_B0), gw, NGW, lane); }
    GRID_BAR();
#pragma unroll 1
    for (int L = 0; L < 2; ++L) {
        if (L == 1) {
            REPS(3) {
                unsigned char* ws = KWS();
                pg8::Gemm g{(const bf16*)(ws + WS_R1), (const bf16*)(ws + WS_WQKV), T, 3072, 1024}; pg8::StaticOrder S; S.init(T, 3072, G, bx);
                pg8::EpiQKV E{(bf16*)(ws + WS_R2), (bf16*)(ws + WS_R3), (bf16*)(ws + WS_R4), (const float*)(ws + 3 * MiB), KIN(14), KIN(15), (const float*)(ws + WS_ROPE), (LAS float*)(lds + 131072)};
                pg8::gemm_phase<pg8::EpiQKV, pg8::StaticOrder, true, true>(lds, g, S, E, wv);
            }
            GRID_BAR();
            REPS(0) { unsigned char* ws = KWS(); attn_phase(wv, lds, vcu, (const bf16*)(ws + WS_R2), (const bf16*)(ws + WS_R3), (const bf16*)(ws + WS_R4), (bf16*)(ws + WS_B0), KIN(14), KIN(15), KIN(16), KIN(17), KIN(18), KIN(19), KIN(20)); }
            GRID_BAR();
        }
        _Pragma("unroll 1") for (int rep_ = 0; rep_ < 1 + ((L == 0) ? ((PROBE_DUP >> 3) & 1) : 0); ++rep_) {
            unsigned char* ws = KWS();
            pg8::Gemm g{(const bf16*)(ws + WS_B0), (const bf16*)(ws + (L ? WS_WO1 : WS_WO0)), T, 1024, 1024}; pg8::StaticOrder S; S.init(T, 1024, G, bx);
            if (L == 0) { pg8::EpiRes<false> E{KIN(0), (bf16*)(ws + WS_R1)}; pg8::gemm_phase<pg8::EpiRes<false>, pg8::StaticOrder, true, true>(lds, g, S, E, wv); }
            else { pg8::EpiRes<true> E{ws + WS_R1, (bf16*)(ws + WS_R1)}; pg8::gemm_phase<pg8::EpiRes<true>, pg8::StaticOrder, true, true>(lds, g, S, E, wv); }
        }
        GRID_BAR();
        REPS(7) { PH_IDS(); unsigned char* ws = KWS(); rms_quant_pass((const bf16*)(ws + WS_R1), L ? KIN(22) : KIN(7), (bf16*)(ws + WS_B0), ws + WS_R5, (float*)(ws + WS_SC + 4 * 65536), (float*)(ws + WS_SC + 6 * 65536), gw, NGW, lane); }
        GRID_BAR();
        REPS(3) {
            unsigned char* ws = KWS();
            pg8::Gemm g{(const bf16*)(ws + WS_R5), (const bf16*)(ws + WS_I8 + (L ? 2 : 0) * MiB), T, 2048, 512}; pg8::StaticOrder S; S.init(T, 2048, G, bx);
            pg8::EpiPlainI8 E{(bf16*)(ws + WS_R2), 2048, (const float*)(ws + WS_SC + 4 * 65536), (const float*)(ws + WS_I8 + 4 * MiB + (L ? 8192 : 0))};
            pg8::gemm_phase<pg8::EpiPlainI8, pg8::StaticOrder, true, true>(lds, g, S, E, wv);
        }
        GRID_BAR();
        REPS(4) { unsigned char* ws = KWS(); peer_topk_phase(wv, lds, vcu, (const bf16*)(ws + WS_R2), (const bf16*)(ws + (L ? WS_KEY1 : WS_KEY0)), (int*)(ws + WS_R4), (float*)(ws + WS_R4 + 16 * MiB)); }
        GRID_BAR();
        REPS(1) { unsigned char* ws = KWS(); peer_g1_phase(wv, vcu, ws + WS_R5, (const int*)(ws + WS_R4), ws + (L ? WS_U1 : WS_U0), (int*)(ws + WS_R2)); }
        GRID_BAR();
        { PH_IDS(); unsigned char* ws = KWS(); const size_t so = L ? 2 * 65536 : 0;
          peer_g1b_phase((const int*)(ws + WS_R2), (const int*)(ws + WS_R4), (const float*)(ws + WS_R4 + 16 * MiB), (const float*)(ws + WS_SC + so), (const float*)(ws + WS_SC + so + 65536),
                         (const float*)(ws + WS_SC + 4 * 65536), (const float*)(ws + WS_SC + 6 * 65536), ws + WS_R4 + 32 * MiB, (float*)(ws + WS_SC + 10 * 65536), (float*)(ws + WS_SC + 8 * 65536), gw, NGW, lane); }
        GRID_BAR();
        if (L == 0) { unsigned char* ws = KWS(); peer_g2_phase<true>(wv, vcu, (const int*)(ws + WS_R4), ws + WS_R4 + 32 * MiB, (const float*)(ws + WS_SC + 10 * 65536), (const float*)(ws + WS_SC + 8 * 65536), ws + WS_V0T, (bf16*)(ws + WS_R1), nullptr, (float*)(ws + 3 * MiB)); GRID_BAR(); }
        else { unsigned char* ws = KWS(); peer_g2_phase<false>(wv, vcu, (const int*)(ws + WS_R4), ws + WS_R4 + 32 * MiB, (const float*)(ws + WS_SC + 10 * 65536), (const float*)(ws + WS_SC + 8 * 65536), ws + WS_V1T, (bf16*)(ws + WS_R1), KOUT(), nullptr); }
    }
#undef GRID_BAR
}

extern "C" void kernel_launch(void* const* d_in, const int* in_sizes, int n_in, void* d_out, int out_size, void* d_ws, size_t ws_size, hipStream_t stream) {
    static int ready = 0;
    if (ready == 0) {
        if (n_in != 27 || out_size != T * D || ws_size < WS_END) { fprintf(stderr, "kernel_launch: unexpected problem (n_in %d, out %d, ws %zu)\n", n_in, out_size, ws_size); ready = -1; return; }
        if (hipFuncSetAttribute((const void*)mk_fwd, hipFuncAttributeMaxDynamicSharedMemorySize, LDS_BYTES) != hipSuccess) { fprintf(stderr, "kernel_launch: hipFuncSetAttribute failed\n"); ready = -1; return; }
        (void)hipGetLastError();
        ready = 1;
    }
    if (ready < 0) return;
    if (hipMemsetAsync((char*)d_ws + WS_CTL, 0, CTL_ZERO_BYTES, stream) != hipSuccess) { fprintf(stderr, "kernel_launch: memset failed\n"); return; }
    Args a{};
    for (int i = 0; i < 27; ++i) a.in[i] = d_in[i];
    a.out = (float*)d_out; a.ws = (unsigned char*)d_ws;
    hipLaunchKernelGGL(mk_fwd, dim3(256), dim3(NWAVES * 64), LDS_BYTES, stream, a);
}
```

```cpp
#include <hip/hip_runtime.h>
#include <hip/hip_bf16.h>
#include <cstdio>
#include <cstdint>
#include <cmath>
namespace pg8 {
#define PG8_LAS __attribute__((address_space(3)))
typedef unsigned short bf16_t;
typedef short bf16x8 __attribute__((ext_vector_type(8)));
typedef float f32x4 __attribute__((ext_vector_type(4)));
typedef unsigned u32x4 __attribute__((ext_vector_type(4)));
constexpr int BM = 256, BK = 64, HALF = 128, HTB = HALF * BK * 2  , STAGE_BYTES = 8 * HTB, NXCD = 8, WGM = 8;

__host__ __device__ __forceinline__ int lds_byte(int r, int c) { const int st = (r >> 4) * 2 + (c >> 5), rr = r & 15, cc = c & 31, ob = rr * 64 + cc * 2; return st * 1024 + (ob ^ (((ob >> 9) & 1) << 5)); }
__host__ __device__ __forceinline__ void stage_rc(int b, int& R, int& C) { const int st = b / 1024, sb = b % 1024, swz = sb ^ (((sb >> 9) & 1) << 5); R = (st >> 1) * 16 + swz / 64; C = (st & 1) * 32 + (swz % 64) / 2; }
__host__ __device__ __forceinline__ int perm32(int rho) { const int n = rho >> 4, i = rho & 15; return 8 * (i >> 2) + 4 * n + (i & 3); }

struct Unit { int pm, pn; };
struct Gemm { const bf16_t* A; const bf16_t* Bt; int M, N, K; };

struct StaticOrder {
    int nM, nN, nwg, G, c;
    __host__ __device__ void init(int M, int N, int G_, int c_) { nM = M / BM; nN = N / BM; nwg = nM * nN; G = G_; c = c_; }
    __host__ __device__ bool next(int i, Unit& u) const {
        const long L = (long)i * G + c; if (L >= nwg) return false;
        int wgid = (int)L; { const int q = nwg / NXCD, r = nwg % NXCD, xcd = wgid % NXCD, off = wgid / NXCD; wgid = (xcd < r ? xcd * (q + 1) : r * (q + 1) + (xcd - r) * q) + off; }
        const int nig = WGM * nN, gid = wgid / nig, fm = gid * WGM, gsz = (nM - fm) < WGM ? (nM - fm) : WGM;
        u.pm = fm + ((wgid % nig) % gsz); u.pn = (wgid % nig) / gsz; return true;
    }
    __device__ __forceinline__ void a_ready(const Unit&) const {}
    __device__ __forceinline__ void done(const Unit&) const {}
};
__device__ __forceinline__ unsigned cvt_pk_bf16(float lo, float hi) { unsigned r; asm volatile("v_cvt_pk_bf16_f32 %0, %1, %2" : "=v"(r) : "v"(lo), "v"(hi)); return r; }
typedef float f32x2 __attribute__((ext_vector_type(2)));
typedef unsigned u32x2 __attribute__((ext_vector_type(2)));
typedef int i32x4 __attribute__((ext_vector_type(4)));
__device__ __forceinline__ u32x4 pack8(const f32x4 v0, const f32x4 v1) { u32x4 w; w.x = cvt_pk_bf16(v0[0], v0[1]); w.y = cvt_pk_bf16(v0[2], v0[3]); w.z = cvt_pk_bf16(v1[0], v1[1]); w.w = cvt_pk_bf16(v1[2], v1[3]); return w; }
struct EpiPlain {
    static constexpr bool PERM = true, AFTER_DRAIN = false, I8 = false;
    bf16_t* O; int ldc;
    __device__ __forceinline__ void operator()(const f32x4 (&acc)[2][2][4][2], const Unit& u, int wr, int wc, int fr, int fq) const {
        const int row0 = u.pm * BM + wr * 64 + fr, col0 = u.pn * BM + wc * 32 + 8 * fq;
#pragma unroll
        for (int ai = 0; ai < 2; ++ai)
#pragma unroll
            for (int m = 0; m < 4; ++m) { bf16_t* rowp = O + (size_t)(row0 + ai * HALF + m * 16) * ldc + col0;
#pragma unroll
                for (int bj = 0; bj < 2; ++bj) *(u32x4*)(rowp + bj * HALF) = pack8(acc[ai][bj][m][0], acc[ai][bj][m][1]); }
    }
};
struct EpiPlainI8 {
    static constexpr bool PERM = true, AFTER_DRAIN = false, I8 = true;
    bf16_t* O; int ldc; const float* rs; const float* cs;
    __device__ __forceinline__ void operator()(const f32x4 (&acc)[2][2][4][2], const Unit& u, int wr, int wc, int fr, int fq) const {
        const int row0 = u.pm * BM + wr * 64 + fr, col0 = u.pn * BM + wc * 32 + 8 * fq;
        f32x4 c0[2], c1[2];
#pragma unroll
        for (int bj = 0; bj < 2; ++bj) { c0[bj] = *(const f32x4*)(cs + col0 + bj * HALF); c1[bj] = *(const f32x4*)(cs + col0 + bj * HALF + 4); }
#pragma unroll
        for (int ai = 0; ai < 2; ++ai)
#pragma unroll
            for (int m = 0; m < 4; ++m) { const int row = row0 + ai * HALF + m * 16; const float r = rs[row]; bf16_t* rowp = O + (size_t)row * ldc + col0;
#pragma unroll
                for (int bj = 0; bj < 2; ++bj) { const i32x4 a0 = __builtin_bit_cast(i32x4, acc[ai][bj][m][0]), a1 = __builtin_bit_cast(i32x4, acc[ai][bj][m][1]);
                    const f32x4 v0 = (f32x4){(float)a0[0], (float)a0[1], (float)a0[2], (float)a0[3]} * r * c0[bj], v1 = (f32x4){(float)a1[0], (float)a1[1], (float)a1[2], (float)a1[3]} * r * c1[bj];
                    *(u32x4*)(rowp + bj * HALF) = pack8(v0, v1); } }
    }
};
template <bool BASE_BF16> struct EpiRes {
    static constexpr bool PERM = true, AFTER_DRAIN = false, I8 = false;
    const void* base; bf16_t* out;
    __device__ __forceinline__ void operator()(const f32x4 (&acc)[2][2][4][2], const Unit& u, int wr, int wc, int fr, int fq) const {
        const int col0 = u.pn * BM + wc * 32 + 8 * fq;
#pragma unroll
        for (int ai = 0; ai < 2; ++ai)
#pragma unroll
            for (int m = 0; m < 4; ++m) { const size_t off = (size_t)(u.pm * BM + ai * HALF + wr * 64 + m * 16 + fr) * 1024 + col0;
#pragma unroll
                for (int bj = 0; bj < 2; ++bj) { f32x4 b0, b1;
                    if (BASE_BF16) { const u32x4 w = *(const u32x4*)((const bf16_t*)base + off + bj * HALF);
                        b0 = (f32x4){__uint_as_float(w.x << 16), __uint_as_float(w.x & 0xffff0000u), __uint_as_float(w.y << 16), __uint_as_float(w.y & 0xffff0000u)};
                        b1 = (f32x4){__uint_as_float(w.z << 16), __uint_as_float(w.z & 0xffff0000u), __uint_as_float(w.w << 16), __uint_as_float(w.w & 0xffff0000u)}; }
                    else { b0 = *(const f32x4*)((const float*)base + off + bj * HALF); b1 = *(const f32x4*)((const float*)base + off + bj * HALF + 4); }
                    *(u32x4*)(out + off + bj * HALF) = pack8(b0 + acc[ai][bj][m][0], b1 + acc[ai][bj][m][1]); } }
    }
};
struct EpiInProj {
    static constexpr bool PERM = true, AFTER_DRAIN = false, I8 = true;
    bf16_t *Q, *Kk, *V, *OG; const float* rs; const float* cs;
    __device__ __forceinline__ void operator()(const f32x4 (&acc)[2][2][4][2], const Unit& u, int wr, int wc, int fr, int fq) const {
        const int colt = u.pn * BM;
#pragma unroll
        for (int ai = 0; ai < 2; ++ai)
#pragma unroll
            for (int m = 0; m < 4; ++m) { const int row = u.pm * BM + ai * HALF + wr * 64 + m * 16 + fr, b = row >> 12, s = row & 4095; const float rsc = rs[row];
#pragma unroll
                for (int bj = 0; bj < 2; ++bj) { const int cb = colt + bj * HALF + wc * 32 + 8 * fq; const i32x4 a0 = __builtin_bit_cast(i32x4, acc[ai][bj][m][0]), a1 = __builtin_bit_cast(i32x4, acc[ai][bj][m][1]);
                    f32x4 v0 = (f32x4){(float)a0[0], (float)a0[1], (float)a0[2], (float)a0[3]} * rsc * *(const f32x4*)(cs + cb), v1 = (f32x4){(float)a1[0], (float)a1[1], (float)a1[2], (float)a1[3]} * rsc * *(const f32x4*)(cs + cb + 4);
                    if (colt < 1024) { const bool isq = colt < 512; bf16_t* base = isq ? Q : Kk; const int c2 = cb & 511, head = c2 >> 6, d = c2 & 63;
                        if (isq) { v0 = v0 * 0.125f; v1 = v1 * 0.125f; }
                        *(u32x4*)(base + ((size_t)((b * 8 + head) * 4096 + s)) * 64 + d) = pack8(v0, v1); }
                    else if (colt < 2048) { const int c2 = cb - 1024, head = c2 >> 7, dv = c2 & 127; *(u32x4*)(V + ((size_t)((b * 8 + head) * 4096 + s)) * 128 + dv) = pack8(v0, v1); }
                    else if (colt < 3072) { *(u32x4*)(OG + (size_t)row * 1024 + (cb - 2048)) = pack8(v0, v1); } } }
    }
};
struct EpiQKV {
    static constexpr bool PERM = true, AFTER_DRAIN = false, I8 = false;
    bf16_t *Q, *Kk, *V; const float* SS; const float* qg; const float* kg; const float* rope; PG8_LAS float* xch;
    __device__ __forceinline__ void operator()(const f32x4 (&acc)[2][2][4][2], const Unit& u, int wr, int wc, int fr_, int fq_) const {
        int fr = fr_, fq = fq_; asm volatile("" : "+v"(fr), "+v"(fq));
        const int colt = u.pn * BM, lane = fq * 16 + fr, wave = wr * 4 + wc;
        if (colt >= 2048) {
            float rsr[2][4];
#pragma unroll
            for (int ai = 0; ai < 2; ++ai)
#pragma unroll
                for (int m = 0; m < 4; ++m) { const int row = u.pm * BM + ai * HALF + wr * 64 + m * 16 + fr;
                    rsr[ai][m] = __builtin_amdgcn_rsqf(((SS[row] + SS[32768 + row]) + (SS[2 * 32768 + row] + SS[3 * 32768 + row])) * (1.f / 1024.f) + 1e-6f); }
#pragma unroll
            for (int ai = 0; ai < 2; ++ai)
#pragma unroll
                for (int m = 0; m < 4; ++m) { const int row = u.pm * BM + ai * HALF + wr * 64 + m * 16 + fr, b = row >> 12, s = row & 4095; const float rs = rsr[ai][m];
#pragma unroll
                    for (int bj = 0; bj < 2; ++bj) { const int cb = colt + bj * HALF + wc * 32 + 8 * fq; const int c2 = cb - 2048, head = c2 >> 7, dv = c2 & 127;
                        *(u32x4*)(V + ((size_t)((b * 8 + head) * 4096 + s)) * 128 + dv) = pack8(acc[ai][bj][m][0] * rs, acc[ai][bj][m][1] * rs); } }
            return;
        }
        PG8_LAS float* const ropeL = xch + 2048; PG8_LAS float* const rsrL = xch + 2048 + 256 * 20;
        const int tid = wave * 64 + lane;
        const float* const rsrc = rope + ((size_t)(u.pm * BM + (tid >> 1))) * 16 + (tid & 1) * 8;
        const f32x4 st0 = *(const f32x4*)rsrc, st1 = *(const f32x4*)(rsrc + 4);
        float sq0 = 0.f, sq1 = 0.f, sq2 = 0.f, sq3 = 0.f;
        if (tid < 256) { const int row = u.pm * BM + tid; sq0 = SS[row]; sq1 = SS[32768 + row]; sq2 = SS[2 * 32768 + row]; sq3 = SS[3 * 32768 + row]; }
        {
            float sv[16];
#pragma unroll
            for (int ai = 0; ai < 2; ++ai)
#pragma unroll
                for (int m = 0; m < 4; ++m)
#pragma unroll
                    for (int bj = 0; bj < 2; ++bj) { const f32x4 a = acc[ai][bj][m][0], c = acc[ai][bj][m][1];
                        sv[(ai * 4 + m) * 2 + bj] = ((a[0] * a[0] + a[1] * a[1]) + (a[2] * a[2] + a[3] * a[3])) + ((c[0] * c[0] + c[1] * c[1]) + (c[2] * c[2] + c[3] * c[3])); }
#pragma unroll
            for (int k = 0; k < 8; ++k) { const auto r = __builtin_amdgcn_permlane16_swap(__float_as_uint(sv[k]), __float_as_uint(sv[k + 8]), false, false); sv[k] = __uint_as_float(r[0]) + __uint_as_float(r[1]); }
#pragma unroll
            for (int k = 0; k < 4; ++k) { const auto r = __builtin_amdgcn_permlane32_swap(__float_as_uint(sv[k]), __float_as_uint(sv[k + 4]), false, false); sv[k] = __uint_as_float(r[0]) + __uint_as_float(r[1]); }
#pragma unroll
            for (int k = 0; k < 4; ++k) xch[(wave * 16 + k + 8 * (fq & 1) + 4 * (fq >> 1)) * 16 + fr] = sv[k];
        }
        *(PG8_LAS f32x4*)(ropeL + (tid >> 1) * 20 + (tid & 1) * 8) = st0; *(PG8_LAS f32x4*)(ropeL + (tid >> 1) * 20 + (tid & 1) * 8 + 4) = st1;
        if (tid < 256) rsrL[tid] = __builtin_amdgcn_rsqf(((sq0 + sq1) + (sq2 + sq3)) * (1.f / 1024.f) + 1e-6f);
        __syncthreads();
        const bool isq = colt < 1024; bf16_t* base = isq ? Q : Kk; const float* gn = isq ? qg : kg; const float osc = isq ? (0.125f * 1.44269504089f) : 1.f;
        const int d0 = 32 * (wc & 1) + 8 * fq;
        const bool rot = ((wc & 1) == 0) && (fq < 2);
        const f32x4 g0 = *(const f32x4*)(gn + (rot ? 4 * fq : d0)), g1 = *(const f32x4*)(gn + (rot ? 8 + 4 * fq : d0 + 4));
#pragma unroll
        for (int ai = 0; ai < 2; ++ai)
#pragma unroll
            for (int m = 0; m < 4; ++m) { const int lrow = ai * HALF + wr * 64 + m * 16 + fr, row = u.pm * BM + lrow, b = row >> 12, s = row & 4095;
                const float rs = rsrL[lrow];
                f32x4 co = {1.f, 1.f, 1.f, 1.f}, si = {0.f, 0.f, 0.f, 0.f};
                if (rot) { const PG8_LAS float* cs = ropeL + lrow * 20 + 4 * fq; co = *(const PG8_LAS f32x4*)cs; si = *(const PG8_LAS f32x4*)(cs + 8); }
#pragma unroll
                for (int bj = 0; bj < 2; ++bj) { const float tot = xch[(((wave * 2 + ai) * 4 + m) * 2 + bj) * 16 + fr] + xch[((((wave ^ 1) * 2 + ai) * 4 + m) * 2 + bj) * 16 + fr];
                    const float rn = __builtin_amdgcn_rsqf(tot * (rs * rs) * (1.f / 64.f) + 1e-6f) * rs;
                    const f32x4 x0 = acc[ai][bj][m][0] * rn * g0, x1 = acc[ai][bj][m][1] * rn * g1;
                    const f32x4 y0 = x0 * co - x1 * si, y1 = x1 * co + x0 * si;
                    const int cb = colt + bj * HALF + wc * 32 + 8 * fq; const int c2 = cb & 1023, head = c2 >> 7, c = (c2 >> 6) & 1, d = c2 & 63;
                    *(u32x4*)(base + ((size_t)(((b * 8 + head) * 2 + c) * 4096 + s)) * 64 + d) = pack8(y0 * osc, y1 * osc); } }
    }
};

template <bool I8> __device__ __forceinline__ f32x4 mma_sel(bf16x8 a, bf16x8 b, f32x4 c) {
    if constexpr (I8) return __builtin_bit_cast(f32x4, __builtin_amdgcn_mfma_i32_16x16x64_i8(__builtin_bit_cast(i32x4, a), __builtin_bit_cast(i32x4, b), __builtin_bit_cast(i32x4, c), 0, 0, 0));
    else return __builtin_amdgcn_mfma_f32_16x16x32_bf16(a, b, c, 0, 0, 0);
}
template <class Epi, class Sched, bool ALIGN_EPI = false, bool SP2 = false>
__device__ __forceinline__ void gemm_phase(PG8_LAS unsigned char* lds, const Gemm g, const Sched& S, const Epi& E, const int wv) {
    int ln_; asm volatile("v_mbcnt_lo_u32_b32 %0, -1, 0\n\tv_mbcnt_hi_u32_b32 %0, -1, %0" : "=v"(ln_)); const int tid = wv * 64 + ln_, wid = wv, lane = tid & 63, wr = wid >> 2, wc = wid & 3, fr = lane & 15, fq = lane >> 4;
    const int K = g.K, nt = K / BK;
    unsigned voffA[2], voffB[2];
#pragma unroll
    for (int i = 0; i < 2; ++i) { int R, C; stage_rc(tid * 16 + i * 8192, R, C); const int Rb = Epi::PERM ? ((R & ~31) + perm32(R & 31)) : R;
        voffA[i] = (unsigned)(R * K + C) * 2u; voffB[i] = (unsigned)(Rb * K + C) * 2u; }
    const size_t kstep = (size_t)(BK * 2);
    const size_t hstep = (size_t)HALF * K * 2;
    const size_t tstep = 2 * hstep;
    const unsigned ldsw = (unsigned)wid * 1024u;
    const int aoff = lds_byte(wr * 64 + fr, fq * 8), boff = lds_byte(wc * 32 + fr, fq * 8);
#define PG8_SA(b, h) (((b) * 2 + (h)) * HTB)
#define PG8_SB(b, h) ((4 + (b) * 2 + (h)) * HTB)
#define PG8_STAGE(bufoff, gbase, voff) do { _Pragma("unroll") for (int _i = 0; _i < 2; ++_i) \
        __builtin_amdgcn_global_load_lds((const unsigned*)((const char*)(gbase) + (voff)[_i]), (PG8_LAS unsigned*)(lds + (bufoff) + ldsw + _i * 8192), 16, 0, 0); } while (0)
#define PG8_LDA(dst, b, h) do { _Pragma("unroll") for (int m = 0; m < 4; ++m) _Pragma("unroll") for (int k = 0; k < 2; ++k) dst[m][k] = *(const PG8_LAS bf16x8*)(lds + PG8_SA(b, h) + aoff + m * 2048 + k * 1024); } while (0)
#define PG8_LDB(dst, b, h) do { _Pragma("unroll") for (int n = 0; n < 2; ++n) _Pragma("unroll") for (int k = 0; k < 2; ++k) dst[n][k] = *(const PG8_LAS bf16x8*)(lds + PG8_SB(b, h) + boff + n * 2048 + k * 1024); } while (0)
#define PG8_MMA(ai, bj, At, Bt) do { __builtin_amdgcn_s_setprio(1); _Pragma("unroll") for (int m = 0; m < 4; ++m) _Pragma("unroll") for (int n = 0; n < 2; ++n) _Pragma("unroll") for (int k = 0; k < 2; ++k) \
        acc[ai][bj][m][n] = mma_sel<Epi::I8>(Bt[n][k], At[m][k], acc[ai][bj][m][n]); __builtin_amdgcn_s_setprio(0); } while (0)
#define PG8_WAIT_V(n) asm volatile("s_waitcnt vmcnt(" #n ")" ::: "memory")
#define PG8_WAIT_L(n) asm volatile("s_waitcnt lgkmcnt(" #n ")" ::: "memory")
#define PG8_BAR __builtin_amdgcn_s_barrier()
#define PG8_SCHED __builtin_amdgcn_sched_barrier(0)
    Unit cur, nxt; int ui = 0;
    if (!S.next(0, cur)) return;
    f32x4 acc[2][2][4][2];
#pragma unroll
    for (int a = 0; a < 2; ++a)
#pragma unroll
        for (int b = 0; b < 2; ++b)
#pragma unroll
            for (int m = 0; m < 4; ++m)
#pragma unroll
                for (int n = 0; n < 2; ++n) acc[a][b][m][n] = (f32x4){0.f, 0.f, 0.f, 0.f};
    bf16x8 At[4][2], B0[2][2], B1[2][2];
    const char* cA = (const char*)g.A + (size_t)cur.pm * tstep; const char* cB = (const char*)g.Bt + (size_t)cur.pn * tstep;
    S.a_ready(cur);
    if constexpr (SP2) {
        PG8_STAGE(PG8_SB(0, 0), cB, voffB); PG8_STAGE(PG8_SB(0, 1), cB + hstep, voffB); PG8_STAGE(PG8_SA(0, 0), cA, voffA); PG8_STAGE(PG8_SA(0, 1), cA + hstep, voffA);
        if (wr == 1) PG8_BAR;
        PG8_WAIT_V(2); PG8_BAR;
        PG8_STAGE(PG8_SB(1, 0), cB + kstep, voffB); PG8_STAGE(PG8_SA(1, 0), cA + kstep, voffA); PG8_STAGE(PG8_SB(1, 1), cB + hstep + kstep, voffB);
        PG8_WAIT_V(6); PG8_BAR;
    } else {
        PG8_STAGE(PG8_SB(0, 0), cB, voffB); PG8_STAGE(PG8_SA(0, 0), cA, voffA); PG8_STAGE(PG8_SB(0, 1), cB + hstep, voffB); PG8_STAGE(PG8_SA(0, 1), cA + hstep, voffA);
        if (wr == 1) PG8_BAR;
        PG8_WAIT_V(4); PG8_BAR;
        PG8_STAGE(PG8_SB(1, 0), cB + kstep, voffB); PG8_STAGE(PG8_SA(1, 0), cA + kstep, voffA); PG8_STAGE(PG8_SB(1, 1), cB + hstep + kstep, voffB);
        PG8_WAIT_V(6); PG8_BAR;
    }
    for (;;) {
        const bool has_next = S.next(ui + 1, nxt);
        const char* nA = has_next ? (const char*)g.A + (size_t)nxt.pm * tstep : cA; const char* nB = has_next ? (const char*)g.Bt + (size_t)nxt.pn * tstep : cB;
        for (int t = 0; t < nt; t += 2) {
            const bool last = (t == nt - 2);
            const char* a1 = cA + (size_t)(t + 1) * kstep;
            const char* a2 = last ? nA : cA + (size_t)(t + 2) * kstep; const char* b2 = last ? nB : cB + (size_t)(t + 2) * kstep;
            const char* a3 = a2 + kstep; const char* b3 = b2 + kstep;
            if (last && has_next) S.a_ready(nxt);
            if constexpr (SP2) {
            PG8_LDB(B0, 0, 0); PG8_LDB(B1, 0, 1); PG8_SCHED; PG8_LDA(At, 0, 0); PG8_STAGE(PG8_SA(1, 1), a1 + hstep, voffA);
            PG8_WAIT_V(8); PG8_WAIT_L(0); PG8_BAR; PG8_MMA(0, 0, At, B0); PG8_MMA(0, 1, At, B1); PG8_BAR; PG8_SCHED;
            PG8_LDA(At, 0, 1); PG8_STAGE(PG8_SB(0, 0), b2, voffB); PG8_STAGE(PG8_SB(0, 1), b2 + hstep, voffB); PG8_STAGE(PG8_SA(0, 0), a2, voffA);
            PG8_WAIT_V(8); PG8_WAIT_L(0); PG8_BAR; PG8_MMA(1, 0, At, B0); PG8_MMA(1, 1, At, B1); PG8_BAR; PG8_SCHED;
            PG8_LDB(B0, 1, 0); PG8_LDB(B1, 1, 1); PG8_SCHED; PG8_LDA(At, 1, 0); PG8_STAGE(PG8_SA(0, 1), a2 + hstep, voffA);
            PG8_WAIT_V(8); PG8_WAIT_L(0); PG8_BAR; PG8_MMA(0, 0, At, B0); PG8_MMA(0, 1, At, B1); PG8_BAR; PG8_SCHED;
            PG8_LDA(At, 1, 1); PG8_STAGE(PG8_SB(1, 0), b3, voffB); PG8_STAGE(PG8_SB(1, 1), b3 + hstep, voffB); PG8_STAGE(PG8_SA(1, 0), a3, voffA);
            PG8_WAIT_V(8); PG8_WAIT_L(0); PG8_BAR; PG8_MMA(1, 0, At, B0); PG8_MMA(1, 1, At, B1); PG8_BAR; PG8_SCHED;
            } else {
            PG8_LDB(B0, 0, 0); PG8_SCHED; PG8_LDA(At, 0, 0); PG8_STAGE(PG8_SA(1, 1), a1 + hstep, voffA);
            PG8_WAIT_L(8); PG8_BAR; PG8_WAIT_L(0); PG8_MMA(0, 0, At, B0); PG8_BAR; PG8_SCHED;
            PG8_LDB(B1, 0, 1); PG8_STAGE(PG8_SB(0, 0), b2, voffB);
            PG8_BAR; PG8_WAIT_L(0); PG8_MMA(0, 1, At, B1); PG8_BAR;
            PG8_LDA(At, 0, 1); PG8_STAGE(PG8_SA(0, 0), a2, voffA);
            PG8_BAR; PG8_WAIT_L(0); PG8_MMA(1, 0, At, B0); PG8_BAR; PG8_SCHED;
            PG8_STAGE(PG8_SB(0, 1), b2 + hstep, voffB);
            PG8_WAIT_V(6); PG8_BAR; PG8_MMA(1, 1, At, B1); PG8_BAR;
            PG8_LDB(B0, 1, 0); PG8_SCHED; PG8_LDA(At, 1, 0); PG8_STAGE(PG8_SA(0, 1), a2 + hstep, voffA);
            PG8_WAIT_L(8); PG8_BAR; PG8_WAIT_L(0); PG8_MMA(0, 0, At, B0); PG8_BAR; PG8_SCHED;
            PG8_LDB(B1, 1, 1); PG8_STAGE(PG8_SB(1, 0), b3, voffB);
            PG8_BAR; PG8_WAIT_L(0); PG8_MMA(0, 1, At, B1); PG8_BAR;
            PG8_LDA(At, 1, 1); PG8_STAGE(PG8_SA(1, 0), a3, voffA);
            PG8_BAR; PG8_WAIT_L(0); PG8_MMA(1, 0, At, B0); PG8_BAR; PG8_SCHED;
            PG8_STAGE(PG8_SB(1, 1), b3 + hstep, voffB);
            PG8_WAIT_V(6); PG8_BAR; PG8_MMA(1, 1, At, B1); PG8_BAR;
            }
        }
        if constexpr (ALIGN_EPI) { if (wr == 0) PG8_BAR; }
        if constexpr (!Epi::AFTER_DRAIN) { E(acc, cur, wr, wc, fr, fq); S.done(cur); }
        if (!has_next) break;
#pragma unroll
        for (int a = 0; a < 2; ++a)
#pragma unroll
            for (int b = 0; b < 2; ++b)
#pragma unroll
                for (int m = 0; m < 4; ++m)
#pragma unroll
                    for (int n = 0; n < 2; ++n) acc[a][b][m][n] = (f32x4){0.f, 0.f, 0.f, 0.f};
        cur = nxt; cA = nA; cB = nB; ++ui;
        if constexpr (ALIGN_EPI) { if (wr == 1) PG8_BAR; }
    }
    PG8_WAIT_V(0);
    if constexpr (!ALIGN_EPI) { if (wr == 0) PG8_BAR; }
    PG8_BAR;
    if constexpr (Epi::AFTER_DRAIN) { E.fused(acc, cur, wr, wc, fr, fq, lds, wid, lane); S.done(cur); }
#undef PG8_SA
#undef PG8_SB
#undef PG8_STAGE
#undef PG8_LDA
#undef PG8_LDB
#undef PG8_MMA
#undef PG8_WAIT_V
#undef PG8_WAIT_L
#undef PG8_BAR
#undef PG8_SCHED
}
}
#define GAS __attribute__((address_space(1)))
#define LAS __attribute__((address_space(3)))
typedef unsigned short bf16;
typedef unsigned v4u __attribute__((ext_vector_type(4)));
typedef float f32x4 __attribute__((ext_vector_type(4)));
typedef short bf16x8 __attribute__((ext_vector_type(8)));
typedef GAS unsigned gu32;
typedef GAS unsigned long long gu64;
#define RLX_AGENT __ATOMIC_RELAXED, __HIP_MEMORY_SCOPE_AGENT
#define LDS_WAIT() asm volatile("s_waitcnt lgkmcnt(0)" ::: "memory")
#define VM_WAIT() asm volatile("s_waitcnt vmcnt(0)" ::: "memory")
__device__ __forceinline__ unsigned long long rt() { return __builtin_amdgcn_s_memrealtime(); }
typedef float f32x2_cv __attribute__((ext_vector_type(2))); typedef __bf16 bf16x2_cv __attribute__((ext_vector_type(2)));
__device__ __forceinline__ unsigned pk2(float lo, float hi) { const f32x2_cv v = {lo, hi}; const bf16x2_cv b = __builtin_convertvector(v, bf16x2_cv); return __builtin_bit_cast(unsigned, b); }
__device__ __forceinline__ unsigned f2bf(float f) { return pk2(f, 0.f) & 0xffffu; }

#define XB_TMO      128
#define XB_XCNT(j)  (256  + 64 * (j))
#define XB_XSUB(j)  (1280 + 64 * (j))
#define XB_XGEN(j)  (2304 + 64 * (j))
#define XB_TOP      3328
#define XB_TOPGEN   3392
#define XCD_BAR_WORDS 3456
#define XB_SPIN_CAP (1u << 18)

__device__ __forceinline__ unsigned xb_ld(unsigned* p)              { return __hip_atomic_load(p, __ATOMIC_RELAXED, __HIP_MEMORY_SCOPE_AGENT); }
__device__ __forceinline__ unsigned xb_add(unsigned* p, unsigned v) { return __hip_atomic_fetch_add(p, v, __ATOMIC_RELAXED, __HIP_MEMORY_SCOPE_AGENT); }
__device__ __forceinline__ unsigned xb_xcc_id() { return (unsigned)__builtin_amdgcn_s_getreg((3 << 11) | 20) & 0xFu; }
#define XB_SPIN(cond, bar) do { unsigned _sp = 0; while (cond) { __builtin_amdgcn_s_sleep(1); \
    if ((++_sp & 255u) == 0u) { if (xb_ld(&(bar)[XB_TMO])) break; if (_sp > XB_SPIN_CAP) { atomicAdd(&(bar)[XB_TMO], 1u); break; } } } } while (0)

struct XcdBarrier {
    unsigned* bar; unsigned x;
    volatile LAS unsigned* st;
};

__device__ __forceinline__ XcdBarrier xcd_barrier_post(unsigned* bar, volatile LAS unsigned* st) {
    XcdBarrier b; b.bar = bar; b.x = xb_xcc_id(); b.st = st;
    if (threadIdx.x == 0) (void)xb_add(&bar[XB_XCNT(b.x)], 1u);
    return b;
}
__device__ __forceinline__ void xcd_barrier_complete(unsigned* bar, unsigned x, unsigned& nloc, unsigned& nx) {
    const unsigned G = gridDim.x * gridDim.y * gridDim.z;
    unsigned sum, cnt, mine, sp = 0u;
    for (;;) {
        sum = 0u; cnt = 0u; mine = 0u;
#pragma unroll
        for (unsigned j = 0; j < 16; ++j) { const unsigned c = xb_ld(&bar[XB_XCNT(j)]); sum += c; cnt += (c > 0u) ? 1u : 0u; mine = (j == x) ? c : mine; }
        if (sum == G) break;
        __builtin_amdgcn_s_sleep(1);
        if ((++sp & 255u) == 0u) { if (xb_ld(&bar[XB_TMO])) break; if (sp > XB_SPIN_CAP) { atomicAdd(&bar[XB_TMO], 1u); break; } }
    }
    nloc = mine > 0u ? mine : 1u; nx = cnt > 0u ? cnt : 1u;
}

__device__ __forceinline__ void xcd_barrier(const XcdBarrier& b) {
    asm volatile("s_waitcnt vmcnt(0)" ::: "memory");
    __syncthreads();
    if (threadIdx.x == 0) {
        unsigned* bar = b.bar;
        __builtin_amdgcn_s_waitcnt(0);
        unsigned nloc = b.st[0], nx = b.st[1];
        if (nloc == 0u) { xcd_barrier_complete(bar, b.x, nloc, nx); b.st[0] = nloc; b.st[1] = nx; }
        const unsigned old = xb_add(&bar[XB_XSUB(b.x)], 1u);
        const unsigned gen = old / nloc;
        if (old + 1u == (gen + 1u) * nloc) {
            __builtin_amdgcn_fence(__ATOMIC_RELEASE, "agent");
            asm volatile("s_waitcnt vmcnt(0)" ::: "memory");
            const unsigned og = xb_add(&bar[XB_TOP], 1u);
            const unsigned tg = og / nx;
            if (og + 1u == (tg + 1u) * nx) xb_add(&bar[XB_TOPGEN], 1u);
            else XB_SPIN(xb_ld(&bar[XB_TOPGEN]) == tg, bar);
            __builtin_amdgcn_fence(__ATOMIC_ACQUIRE, "agent");
            xb_add(&bar[XB_XGEN(b.x)], 1u);
            asm volatile("s_waitcnt vmcnt(0)" ::: "memory");
        } else {
            XB_SPIN(xb_ld(&bar[XB_XGEN(b.x)]) == gen, bar);
            __builtin_amdgcn_fence(__ATOMIC_ACQUIRE, "agent");
            asm volatile("s_waitcnt vmcnt(0)" ::: "memory");
        }
    }
    __syncthreads();
}
constexpr int NWAVES = 8;
constexpr int T = 32768, D = 1024, SEQ = 4096;
constexpr float EPS = 1e-6f;
constexpr float LAMBDA_INIT = 0.35550906759f;
constexpr size_t MiB = 1u << 20;
constexpr size_t WS_CTL = 0, CTL_ZERO_BYTES = 1 * MiB;
constexpr size_t WS_ROPE = 1 * MiB;
constexpr size_t WS_WIN = 4 * MiB;
constexpr size_t WS_WO0 = 11 * MiB, WS_WQ0 = 13 * MiB, WS_KEY0 = 17 * MiB, WS_WQKV = 18 * MiB, WS_WO1 = 24 * MiB, WS_WQ1 = 26 * MiB, WS_KEY1 = 30 * MiB;
constexpr size_t WS_SC = 31 * MiB;
constexpr size_t WS_U0 = 32 * MiB, WS_V0T = 48 * MiB, WS_U1 = 64 * MiB, WS_V1T = 80 * MiB;
constexpr size_t WS_B0 = 96 * MiB;
constexpr size_t WS_R1 = 160 * MiB, WS_R2 = 224 * MiB, WS_R3 = 288 * MiB, WS_R4 = 352 * MiB, WS_R5 = 416 * MiB, WS_GATES = 480 * MiB;
constexpr size_t WS_I8 = 484 * MiB;
constexpr size_t WS_END = 492 * MiB;
constexpr int CW_BAR = 4096;
constexpr int LDS_BYTES = 163840, MISC_OFF = LDS_BYTES - 128;

typedef float f32x16 __attribute__((ext_vector_type(16)));
typedef unsigned u32x2 __attribute__((ext_vector_type(2)));
typedef __bf16 bf16x2_t __attribute__((ext_vector_type(2)));
__device__ __forceinline__ float bf_lo(unsigned w) { return __uint_as_float(w << 16); }
__device__ __forceinline__ float bf_hi(unsigned w) { return __uint_as_float(w & 0xffff0000u); }
__device__ __forceinline__ float dot2(unsigned a, unsigned b, float c) { return __builtin_amdgcn_fdot2_f32_bf16(__builtin_bit_cast(bf16x2_t, a), __builtin_bit_cast(bf16x2_t, b), c, false); }
__device__ __forceinline__ float shx(float v, int lane, int m) { return __uint_as_float((unsigned)__builtin_amdgcn_ds_bpermute((lane ^ m) << 2, (int)__float_as_uint(v))); }
__device__ __forceinline__ int shxi(int v, int lane, int m) { return __builtin_amdgcn_ds_bpermute((lane ^ m) << 2, v); }
#define DPP_STEP_F(v, op, ctrl, rmask, ident) v = op(v, __uint_as_float((unsigned)__builtin_amdgcn_update_dpp((int)__float_as_uint(ident), (int)__float_as_uint(v), ctrl, rmask, 0xF, false)))
__device__ __forceinline__ float fadd_(float a, float b) { return a + b; }
__device__ __forceinline__ float wave_sum(float v, int lane) { (void)lane;
    DPP_STEP_F(v, fadd_, 0x111, 0xF, 0.f); DPP_STEP_F(v, fadd_, 0x112, 0xF, 0.f); DPP_STEP_F(v, fadd_, 0x114, 0xF, 0.f); DPP_STEP_F(v, fadd_, 0x118, 0xF, 0.f);
    DPP_STEP_F(v, fadd_, 0x142, 0xA, 0.f); DPP_STEP_F(v, fadd_, 0x143, 0xC, 0.f);
    return __uint_as_float((unsigned)__builtin_amdgcn_readlane((int)__float_as_uint(v), 63));
}
__device__ __forceinline__ float wave_max0(float v) {
    DPP_STEP_F(v, fmaxf, 0x111, 0xF, 0.f); DPP_STEP_F(v, fmaxf, 0x112, 0xF, 0.f); DPP_STEP_F(v, fmaxf, 0x114, 0xF, 0.f); DPP_STEP_F(v, fmaxf, 0x118, 0xF, 0.f);
    DPP_STEP_F(v, fmaxf, 0x142, 0xA, 0.f); DPP_STEP_F(v, fmaxf, 0x143, 0xC, 0.f);
    return __uint_as_float((unsigned)__builtin_amdgcn_readlane((int)__float_as_uint(v), 63));
}
__device__ __forceinline__ int wave_sumi(int v) {
#define DPP_STEP_I(ctrl, rmask) v += __builtin_amdgcn_update_dpp(0, v, ctrl, rmask, 0xF, false)
    DPP_STEP_I(0x111, 0xF); DPP_STEP_I(0x112, 0xF); DPP_STEP_I(0x114, 0xF); DPP_STEP_I(0x118, 0xF); DPP_STEP_I(0x142, 0xA); DPP_STEP_I(0x143, 0xC);
#undef DPP_STEP_I
    return __builtin_amdgcn_readlane(v, 63);
}
__device__ __forceinline__ f32x4 mfma16(bf16x8 a, bf16x8 b, f32x4 c) { return __builtin_amdgcn_mfma_f32_16x16x32_bf16(a, b, c, 0, 0, 0); }
__device__ __forceinline__ f32x16 mfma32(bf16x8 a, bf16x8 b, f32x16 c) { return __builtin_amdgcn_mfma_f32_32x32x16_bf16(a, b, c, 0, 0, 0); }
__device__ __forceinline__ u32x2 pack4(float a, float b, float c, float d) { u32x2 r; r.x = pk2(a, b); r.y = pk2(c, d); return r; }

__device__ __forceinline__ void p0_transpose_item(const float* W, int K, int N, bf16* WT, LAS float* scr, int item, int lane, const float* kscale = nullptr, bool permqk = false) {
    const int nblk = N / 32, kb = item / nblk, nb = item % nblk, k0 = 64 * kb, n0 = 32 * nb;
#pragma unroll 8
    for (int i = 0; i < 32; ++i) { const int kk = 2 * i + (lane >> 5); const float sc = kscale ? kscale[k0 + kk] : 1.f; scr[kk * 33 + (lane & 31)] = W[(size_t)(k0 + kk) * N + n0 + (lane & 31)] * sc; }
    LDS_WAIT(); asm volatile("" ::: "memory");
    const int c = lane & 7;
#pragma unroll
    for (int j = 0; j < 4; ++j) { const int n = (lane >> 3) + 8 * j; const LAS float* s = scr + (8 * c) * 33 + n;
        v4u o; o.x = pk2(s[0 * 33], s[1 * 33]); o.y = pk2(s[2 * 33], s[3 * 33]); o.z = pk2(s[4 * 33], s[5 * 33]); o.w = pk2(s[6 * 33], s[7 * 33]);
        int nd = n0 + n; if (permqk && nd < 2048 && (nd & 63) < 16 && ((nd & 15) >> 2) != 0 && ((nd & 15) >> 2) != 3) nd ^= 12;
        *(v4u*)(WT + (size_t)nd * K + k0 + 8 * c) = o; }
    LDS_WAIT(); asm volatile("" ::: "memory");
}
__device__ __forceinline__ void cvt_range(const float* src, bf16* dst, size_t n, size_t gtid, size_t gthreads) {
    for (size_t i = gtid * 8; i < n; i += gthreads * 8) {
        const f32x4 a = *(const f32x4*)(src + i), b = *(const f32x4*)(src + i + 4);
        v4u o; o.x = pk2(a.x, a.y); o.y = pk2(a.z, a.w); o.z = pk2(b.x, b.y); o.w = pk2(b.z, b.w);
        *(v4u*)(dst + i) = o; }
}
__device__ __forceinline__ void rms_pass(const float* X, const float* g, bf16* XN, unsigned char* HQ, float* SH, int gw, int NGW, int lane) {
    const f32x4* gr = (const f32x4*)g + lane;
    f32x4 gg[4];
#pragma unroll
    for (int j = 0; j < 4; ++j) gg[j] = gr[64 * j];
    f32x4 v[2][4], nx[2][4];
#pragma unroll
    for (int r = 0; r < 2; ++r)
#pragma unroll
        for (int j = 0; j < 4; ++j) v[r][j] = ((const f32x4*)(X + (size_t)(2 * gw + r) * D) + lane)[64 * j];
    for (int mb = gw; mb < T / 2; mb += NGW) {
        const int mn = mb + NGW < T / 2 ? mb + NGW : mb;
#pragma unroll
        for (int r = 0; r < 2; ++r)
#pragma unroll
            for (int j = 0; j < 4; ++j) nx[r][j] = ((const f32x4*)(X + (size_t)(2 * mn + r) * D) + lane)[64 * j];
        float s[2] = {0.f, 0.f}, rstd[2], am[2] = {0.f, 0.f};
#pragma unroll
        for (int r = 0; r < 2; ++r)
#pragma unroll
            for (int j = 0; j < 4; ++j) s[r] += (v[r][j].x * v[r][j].x + v[r][j].y * v[r][j].y) + (v[r][j].z * v[r][j].z + v[r][j].w * v[r][j].w);
#pragma unroll
        for (int r = 0; r < 2; ++r) rstd[r] = rsqrtf(wave_sum(s[r], lane) * (1.f / 1024.f) + EPS);
#pragma unroll
        for (int r = 0; r < 2; ++r)
#pragma unroll
            for (int j = 0; j < 4; ++j) { v[r][j].x = v[r][j].x * rstd[r] * gg[j].x; v[r][j].y = v[r][j].y * rstd[r] * gg[j].y; v[r][j].z = v[r][j].z * rstd[r] * gg[j].z; v[r][j].w = v[r][j].w * rstd[r] * gg[j].w;
                am[r] = fmaxf(am[r], fmaxf(fmaxf(fabsf(v[r][j].x), fabsf(v[r][j].y)), fmaxf(fabsf(v[r][j].z), fabsf(v[r][j].w)))); }
#pragma unroll
        for (int r = 0; r < 2; ++r) { unsigned long long* o8 = (unsigned long long*)(XN + (size_t)(2 * mb + r) * D) + lane;
#pragma unroll
            for (int j = 0; j < 4; ++j) o8[64 * j] = (unsigned long long)pk2(v[r][j].x, v[r][j].y) | ((unsigned long long)pk2(v[r][j].z, v[r][j].w) << 32); }
#pragma unroll
        for (int r = 0; r < 2; ++r) am[r] = wave_max0(am[r]);
#pragma unroll
        for (int r = 0; r < 2; ++r) { const int m = 2 * mb + r;
            const float hinv = am[r] > 0.f ? 127.f / am[r] : 0.f;
            unsigned* q4 = (unsigned*)(HQ + (size_t)m * D) + lane;
#pragma unroll
            for (int j = 0; j < 4; ++j) { const int q0 = (int)rintf(v[r][j].x * hinv), q1 = (int)rintf(v[r][j].y * hinv), q2 = (int)rintf(v[r][j].z * hinv), q3 = (int)rintf(v[r][j].w * hinv);
                q4[64 * j] = ((unsigned)(q0 & 0xff)) | ((unsigned)(q1 & 0xff) << 8) | ((unsigned)(q2 & 0xff) << 16) | ((unsigned)(q3 & 0xff) << 24); }
            if (lane == 0) SH[m] = am[r] * (1.f / 127.f); }
#pragma unroll
        for (int r = 0; r < 2; ++r)
#pragma unroll
            for (int j = 0; j < 4; ++j) v[r][j] = nx[r][j];
    }
}

__device__ __forceinline__ float addf_np(float a, float b) { float r; asm("v_add_f32 %0, %1, %2" : "=v"(r) : "v"(a), "v"(b)); return r; }

__device__ __forceinline__ void gates_rows_mfma(const bf16* XN, const bf16* WG, const float* bias, float* GATES, int gw, int lane) {
    const int mi = lane & 15, kg = lane >> 4;
    const bf16* arow = XN + (size_t)(16 * gw + mi) * 1024 + 8 * kg;
    const bf16* b0 = WG + (size_t)mi * 1024 + 8 * kg; const bf16* b1 = b0 + 16 * 1024;
    f32x4 acc0 = {0.f, 0.f, 0.f, 0.f}, acc1 = acc0;
#pragma unroll 16
    for (int ks = 0; ks < 32; ++ks) { const bf16x8 a = *(const bf16x8*)(arow + 32 * ks);
        acc0 = mfma16(a, *(const bf16x8*)(b0 + 32 * ks), acc0); acc1 = mfma16(a, *(const bf16x8*)(b1 + 32 * ks), acc1); }
    const float bi0 = bias[mi], bi1 = bias[16 + mi];
#pragma unroll
    for (int r = 0; r < 4; ++r) { float* g = GATES + (size_t)(16 * gw + 4 * kg + r) * 32; g[mi] = acc0[r] + bi0; g[16 + mi] = acc1[r] + bi1; }
}

__device__ __forceinline__ float logsigmoid_f(float f) { return fminf(f, 0.f) - __logf(1.f + __expf(-fabsf(f))); }
#define ML_LOAD(ci_) do { const size_t r_ = rowbase + (size_t)(ci_) * 64 + lane; \
    rq = *(const v4u*)(Q0 + r_ * 64 + 8 * w); rk = *(const v4u*)(K0 + r_ * 64 + 8 * w); rv0 = *(const v4u*)(V0 + r_ * 128 + 16 * w); rv1 = *(const v4u*)(V0 + r_ * 128 + 16 * w + 8); \
    const size_t gm_ = ((size_t)b * 4096 + (size_t)(ci_) * 64 + jr) * 32; rli = GATES[gm_ + (dir ? 16 : 0) + h]; rf = GATES[gm_ + (dir ? 24 : 8) + h]; } while (0)
__device__ __forceinline__ void mlstm_phase(const int wv, LAS unsigned char* lds, const bf16* Q0, const bf16* K0, const bf16* V0, const float* GATES, bf16* HF, bf16* HB) {
    const int bx = blockIdx.x;
    if ((bx >> 3) & 1) return;
    const int seq = (bx >> 4) * 8 + (bx & 7);
    const int dir = seq & 1, bh = seq >> 1, b = bh >> 3, h = bh & 7;
    int ln_; asm volatile("v_mbcnt_lo_u32_b32 %0, -1, 0\n\tv_mbcnt_hi_u32_b32 %0, -1, %0" : "=v"(ln_)); const int tid = wv * 64 + ln_, lane = tid & 63, w = wv, fr = lane & 15, fq = lane >> 4;
    LAS bf16* Qs = (LAS bf16*)(lds); LAS bf16* Ks = (LAS bf16*)(lds + 9216); LAS bf16* Kwt = (LAS bf16*)(lds + 18432); LAS bf16* Ps = (LAS bf16*)(lds + 27648);
    LAS bf16* Vt = (LAS bf16*)(lds + 36864 + w * 2304); LAS bf16* Cs = (LAS bf16*)(lds + 55296 + w * 2304); LAS bf16* nb = (LAS bf16*)(lds + 73728 + w * 128);
    LAS float* gc = (LAS float*)(lds + 74752 + w * 1280); LAS float* gM = gc + 64; LAS float* gI = gc + 128; LAS float* gE = gc + 192; LAS float* gW = gc + 256;
    for (int i = lane; i < 2304 / 4; i += 64) ((LAS unsigned*)Cs)[i] = 0u;
    if (lane < 32) ((LAS unsigned*)nb)[lane] = 0u;
    f32x4 Cacc[4], Nacc[4];
#pragma unroll
    for (int i = 0; i < 4; ++i) { Cacc[i] = (f32x4){0.f, 0.f, 0.f, 0.f}; Nacc[i] = (f32x4){0.f, 0.f, 0.f, 0.f}; }
    float m = -1e30f;
    bf16* Hout = dir ? HB : HF;
    const size_t rowbase = (size_t)bh * 4096;
    const int jr = dir ? 63 - lane : lane;
    v4u rq, rk, rv0, rv1; float rli, rf;
    ML_LOAD(dir ? 63 : 0);
    const bf16x8 ones = (bf16x8){0x3F80, 0x3F80, 0x3F80, 0x3F80, 0x3F80, 0x3F80, 0x3F80, 0x3F80};
    const f32x4 z4 = (f32x4){0.f, 0.f, 0.f, 0.f};
#pragma unroll 1
    for (int step = 0; step < 64; ++step) {
        const int ci = dir ? 63 - step : step;
        const float lf = logsigmoid_f(rf);
        float bcs = lf;
        bcs += __uint_as_float((unsigned)__builtin_amdgcn_update_dpp(0, (int)__float_as_uint(bcs), 0x111, 0xF, 0xF, false));
        bcs += __uint_as_float((unsigned)__builtin_amdgcn_update_dpp(0, (int)__float_as_uint(bcs), 0x112, 0xF, 0xF, false));
        bcs += __uint_as_float((unsigned)__builtin_amdgcn_update_dpp(0, (int)__float_as_uint(bcs), 0x114, 0xF, 0xF, false));
        bcs += __uint_as_float((unsigned)__builtin_amdgcn_update_dpp(0, (int)__float_as_uint(bcs), 0x118, 0xF, 0xF, false));
        bcs += __uint_as_float((unsigned)__builtin_amdgcn_update_dpp(0, (int)__float_as_uint(bcs), 0x142, 0xA, 0xF, false));
        bcs += __uint_as_float((unsigned)__builtin_amdgcn_update_dpp(0, (int)__float_as_uint(bcs), 0x143, 0xC, 0xF, false));
        const float c = rli - bcs;
        float pm = c;
        const int NINFI = (int)0xFF800000u;
        pm = fmaxf(pm, __uint_as_float((unsigned)__builtin_amdgcn_update_dpp(NINFI, (int)__float_as_uint(pm), 0x111, 0xF, 0xF, false)));
        pm = fmaxf(pm, __uint_as_float((unsigned)__builtin_amdgcn_update_dpp(NINFI, (int)__float_as_uint(pm), 0x112, 0xF, 0xF, false)));
        pm = fmaxf(pm, __uint_as_float((unsigned)__builtin_amdgcn_update_dpp(NINFI, (int)__float_as_uint(pm), 0x114, 0xF, 0xF, false)));
        pm = fmaxf(pm, __uint_as_float((unsigned)__builtin_amdgcn_update_dpp(NINFI, (int)__float_as_uint(pm), 0x118, 0xF, 0xF, false)));
        pm = fmaxf(pm, __uint_as_float((unsigned)__builtin_amdgcn_update_dpp(NINFI, (int)__float_as_uint(pm), 0x142, 0xA, 0xF, false)));
        pm = fmaxf(pm, __uint_as_float((unsigned)__builtin_amdgcn_update_dpp(NINFI, (int)__float_as_uint(pm), 0x143, 0xC, 0xF, false)));
        const float M = fmaxf(m, pm);
        const float bL = __uint_as_float((unsigned)__builtin_amdgcn_readlane((int)__float_as_uint(bcs), 63)), Mlast = __uint_as_float((unsigned)__builtin_amdgcn_readlane((int)__float_as_uint(M), 63));
        gc[jr] = c; gM[jr] = M; gI[jr] = __expf(m - M); gE[jr] = __expf(-(bcs + M)); gW[jr] = __expf(c - Mlast);
        const float sp = __expf(m - Mlast), m_new = bL + Mlast;
        const float wr_ = gW[lane];
        *(LAS v4u*)(Qs + lane * 72 + 8 * w) = rq; *(LAS v4u*)(Ks + lane * 72 + 8 * w) = rk;
#pragma unroll
        for (int i = 0; i < 4; ++i) { const unsigned kw = rk[i]; Kwt[(8 * w + 2 * i) * 72 + lane] = (bf16)f2bf(bf_lo(kw) * wr_); Kwt[(8 * w + 2 * i + 1) * 72 + lane] = (bf16)f2bf(bf_hi(kw) * wr_); }
#pragma unroll
        for (int i = 0; i < 4; ++i) { Vt[(2 * i) * 72 + lane] = (bf16)(rv0[i] & 0xffffu); Vt[(2 * i + 1) * 72 + lane] = (bf16)(rv0[i] >> 16);
                                      Vt[(8 + 2 * i) * 72 + lane] = (bf16)(rv1[i] & 0xffffu); Vt[(9 + 2 * i) * 72 + lane] = (bf16)(rv1[i] >> 16); }
        __syncthreads();
        if (step < 63) ML_LOAD(dir ? 62 - step : step + 1);
        {
            const int st = w >> 1;
            const bf16x8 a0 = *(const LAS bf16x8*)(Ks + (16 * st + fr) * 72 + 8 * fq), a1 = *(const LAS bf16x8*)(Ks + (16 * st + fr) * 72 + 32 + 8 * fq);
#pragma unroll
            for (int u = 0; u < 2; ++u) { const int tt = 2 * (w & 1) + u;
                const bf16x8 b0 = *(const LAS bf16x8*)(Qs + (16 * tt + fr) * 72 + 8 * fq), b1 = *(const LAS bf16x8*)(Qs + (16 * tt + fr) * 72 + 32 + 8 * fq);
                f32x4 acc = mfma16(a0, b0, z4); acc = mfma16(a1, b1, acc);
                const int t = 16 * tt + fr; const float Mt = gM[t]; float pv[4];
#pragma unroll
                for (int i = 0; i < 4; ++i) { const int s = 16 * st + 4 * fq + i; const bool valid = dir ? (s >= t) : (s <= t); const float e = __expf(gc[s] - Mt); pv[i] = valid ? acc[i] * e : 0.f; }
                *(LAS u32x2*)(Ps + t * 72 + 16 * st + 4 * fq) = pack4(pv[0], pv[1], pv[2], pv[3]); }
        }
        __syncthreads();
        const bf16x8 aV0 = *(const LAS bf16x8*)(Vt + fr * 72 + 8 * fq), aV1 = *(const LAS bf16x8*)(Vt + fr * 72 + 32 + 8 * fq);
        {
            const bf16x8 aC0 = *(const LAS bf16x8*)(Cs + fr * 72 + 8 * fq), aC1 = *(const LAS bf16x8*)(Cs + fr * 72 + 32 + 8 * fq);
            const bf16x8 aN0 = *(const LAS bf16x8*)(nb + 8 * fq), aN1 = *(const LAS bf16x8*)(nb + 32 + 8 * fq);
#pragma unroll
            for (int tt = 0; tt < 4; ++tt) {
                const bf16x8 bP0 = *(const LAS bf16x8*)(Ps + (16 * tt + fr) * 72 + 8 * fq), bP1 = *(const LAS bf16x8*)(Ps + (16 * tt + fr) * 72 + 32 + 8 * fq);
                const bf16x8 bQ0 = *(const LAS bf16x8*)(Qs + (16 * tt + fr) * 72 + 8 * fq), bQ1 = *(const LAS bf16x8*)(Qs + (16 * tt + fr) * 72 + 32 + 8 * fq);
                f32x4 acc1 = mfma16(aV0, bP0, z4); acc1 = mfma16(aV1, bP1, acc1);
                f32x4 acc2 = mfma16(aC0, bQ0, z4); acc2 = mfma16(aC1, bQ1, acc2);
                f32x4 d1 = mfma16(ones, bP0, z4); d1 = mfma16(ones, bP1, d1);
                f32x4 d2 = mfma16(aN0, bQ0, z4); d2 = mfma16(aN1, bQ1, d2);
                const int t = 16 * tt + fr; const float it = gI[t], en = gE[t];
                const float den = d1[0] + it * d2[0]; const float inv = __builtin_amdgcn_rcpf(fmaxf(fabsf(den), en));
                *(u32x2*)(Hout + ((size_t)b * 4096 + (size_t)ci * 64 + t) * 1024 + h * 128 + 16 * w + 4 * fq) =
                    pack4((acc1[0] + it * acc2[0]) * inv, (acc1[1] + it * acc2[1]) * inv, (acc1[2] + it * acc2[2]) * inv, (acc1[3] + it * acc2[3]) * inv);
            }
        }
#pragma unroll
        for (int dt = 0; dt < 4; ++dt) { Cacc[dt] = Cacc[dt] * sp; Nacc[dt] = Nacc[dt] * sp;
            const bf16x8 aK0 = *(const LAS bf16x8*)(Kwt + (16 * dt + fr) * 72 + 8 * fq), aK1 = *(const LAS bf16x8*)(Kwt + (16 * dt + fr) * 72 + 32 + 8 * fq);
            Cacc[dt] = mfma16(aK0, aV0, Cacc[dt]); Cacc[dt] = mfma16(aK1, aV1, Cacc[dt]);
            Nacc[dt] = mfma16(aK0, ones, Nacc[dt]); Nacc[dt] = mfma16(aK1, ones, Nacc[dt]); }
#pragma unroll
        for (int dt = 0; dt < 4; ++dt) { *(LAS u32x2*)(Cs + fr * 72 + 16 * dt + 4 * fq) = pack4(Cacc[dt][0], Cacc[dt][1], Cacc[dt][2], Cacc[dt][3]);
                                         *(LAS u32x2*)(nb + 16 * dt + 4 * fq) = pack4(Nacc[dt][0], Nacc[dt][1], Nacc[dt][2], Nacc[dt][3]); }
        m = m_new;
        __syncthreads();
    }
}

#define ML_LOADQK(ci_) do { const size_t r_ = rowbase + (size_t)(ci_) * 64; const bf16* const qrow_ = Q0 + r_ * 64 + 8 * w; const bf16* const krow_ = K0 + r_ * 64 + 8 * w; \
    rq = *(const v4u*)(qrow_ + lane * 64u); rk = *(const v4u*)(krow_ + lane * 64u); \
    const float* const grow_ = GATES + ((size_t)b * 4096 + (size_t)(ci_) * 64) * 32 + h; rli = grow_[jr * 32u + (dir ? 16u : 0u)]; rf = grow_[jr * 32u + (dir ? 24u : 8u)]; } while (0)
#define ML_LOADV(ci_) do { const bf16* const vrow_ = V0 + (rowbase + (size_t)(ci_) * 64) * 128 + 16 * w; rv0 = *(const v4u*)(vrow_ + lane * 128u); rv1 = *(const v4u*)(vrow_ + lane * 128u + 8u); } while (0)
#define ML_PMAX(ctrl_) asm("s_nop 1\n\tv_max_f32_dpp %0, %0, %0 " ctrl_ : "+v"(pm))
#define ML_OUT(i_) ((acc1[i_] + gi * acc2[i_]) * inv)
#define ML2_BODY(GS_, GW_, GB_, GL_) do { \
        const int par = it & 1; \
        float sp2 = 0.f, wrn = 0.f; \
        if (GS_) { \
              \
            const float lf = 1.44269504089f * fminf(rf, 0.f) - __builtin_amdgcn_logf(1.f + __builtin_amdgcn_exp2f(-1.44269504089f * fabsf(rf))); \
            float bcs = lf; \
            bcs += __uint_as_float((unsigned)__builtin_amdgcn_update_dpp(0, (int)__float_as_uint(bcs), 0x111, 0xF, 0xF, false)); \
            bcs += __uint_as_float((unsigned)__builtin_amdgcn_update_dpp(0, (int)__float_as_uint(bcs), 0x112, 0xF, 0xF, false)); \
            bcs += __uint_as_float((unsigned)__builtin_amdgcn_update_dpp(0, (int)__float_as_uint(bcs), 0x114, 0xF, 0xF, false)); \
            bcs += __uint_as_float((unsigned)__builtin_amdgcn_update_dpp(0, (int)__float_as_uint(bcs), 0x118, 0xF, 0xF, false)); \
            bcs += __uint_as_float((unsigned)__builtin_amdgcn_update_dpp(0, (int)__float_as_uint(bcs), 0x142, 0xA, 0xF, false)); \
            bcs += __uint_as_float((unsigned)__builtin_amdgcn_update_dpp(0, (int)__float_as_uint(bcs), 0x143, 0xC, 0xF, false)); \
            const float c = 1.44269504089f * rli - bcs; \
            float pm = c; \
              \
            ML_PMAX("row_shr:1 row_mask:0xf bank_mask:0xf"); ML_PMAX("row_shr:2 row_mask:0xf bank_mask:0xf"); ML_PMAX("row_shr:4 row_mask:0xf bank_mask:0xf"); ML_PMAX("row_shr:8 row_mask:0xf bank_mask:0xf"); \
            ML_PMAX("row_bcast:15 row_mask:0xa bank_mask:0xf"); ML_PMAX("row_bcast:31 row_mask:0xc bank_mask:0xf"); \
            const float M = fmaxf(m, pm); \
            const float bL = __uint_as_float((unsigned)__builtin_amdgcn_readlane((int)__float_as_uint(bcs), 63)), Mlast = __uint_as_float((unsigned)__builtin_amdgcn_readlane((int)__float_as_uint(M), 63)); \
            gcB[par * 64 + jr] = c; gMB[par * 64 + jr] = M; gIB[qS * 64 + jr] = __builtin_amdgcn_exp2f(m - M); gEB[qS * 64 + jr] = __builtin_amdgcn_exp2f(-(bcs + M)); gW[jr] = __builtin_amdgcn_exp2f(c - Mlast); \
            sp2 = __builtin_amdgcn_exp2f(m - Mlast); m = bL + Mlast; \
            wrn = gW[lane]; \
            *(LAS v4u*)(Qs + qS * 4608 + lane * 72 + 8 * w) = rq; *(LAS v4u*)(Ks + par * 4608 + lane * 72 + 8 * w) = rk; \
        } \
        if (GW_) { \
            LAS bf16* const Kw = Kwt + (par ^ 1) * 4608; \
_Pragma("unroll") \
            for (int i = 0; i < 4; ++i) { const unsigned kw = rkh[i]; const unsigned kp = pk2(bf_lo(kw) * wrh, bf_hi(kw) * wrh); Kw[(8 * w + 2 * i) * 72 + lane] = (bf16)(kp & 0xffffu); Kw[(8 * w + 2 * i + 1) * 72 + lane] = (bf16)(kp >> 16); } \
            const LAS bf16* const Kr = Ks + (par ^ 1) * 4608; const LAS bf16* const Qr = Qs + qW * 4608; LAS bf16* const Pw = Ps + (par ^ 1) * 4608; \
            const LAS float* const gc = gcB + (par ^ 1) * 64; const LAS float* const gM = gMB + (par ^ 1) * 64; \
            const int st = w >> 1; \
            const bf16x8 a0 = *(const LAS bf16x8*)(Kr + (16 * st + fr) * 72 + 8 * fq), a1 = *(const LAS bf16x8*)(Kr + (16 * st + fr) * 72 + 32 + 8 * fq); \
_Pragma("unroll") \
            for (int u = 0; u < 2; ++u) { const int tt = 2 * (w & 1) + u; \
                const bf16x8 b0 = *(const LAS bf16x8*)(Qr + (16 * tt + fr) * 72 + 8 * fq), b1 = *(const LAS bf16x8*)(Qr + (16 * tt + fr) * 72 + 32 + 8 * fq); \
                f32x4 acc = mfma16(a0, b0, z4); acc = mfma16(a1, b1, acc); \
                const int t = 16 * tt + fr; const float Mt = gM[t]; float pv[4]; \
_Pragma("unroll") \
                for (int i = 0; i < 4; ++i) { const int s = 16 * st + 4 * fq + i; const bool valid = dir ? (s >= t) : (s <= t); const float e = __builtin_amdgcn_exp2f(gc[s] - Mt); pv[i] = valid ? acc[i] * e : 0.f; } \
                *(LAS u32x2*)(Pw + t * 72 + 16 * st + 4 * fq) = pack4(pv[0], pv[1], pv[2], pv[3]); } \
        } \
        rkh = rk; wrh = wrn; \
        if (GL_) ML_LOADQK(dir ? 60 - it : it + 3); \
        if (GB_) { \
            const int ci = dir ? 63 - it : it; bf16* const hrow = Hout + ((size_t)b * 4096 + (size_t)ci * 64) * 1024 + h * 128 + 16 * w; const unsigned hoff = fr * 1024u + 4u * fq; \
_Pragma("unroll") \
            for (int i = 0; i < 4; ++i) { Vt[(2 * i) * 72 + lane] = (bf16)(rv0[i] & 0xffffu); Vt[(2 * i + 1) * 72 + lane] = (bf16)(rv0[i] >> 16); \
                                          Vt[(8 + 2 * i) * 72 + lane] = (bf16)(rv1[i] & 0xffffu); Vt[(9 + 2 * i) * 72 + lane] = (bf16)(rv1[i] >> 16); } \
            const LAS bf16* const Pr = Ps + par * 4608; const LAS bf16* const Qr = Qs + qB * 4608; const LAS bf16* const Kw = Kwt + par * 4608; \
            const LAS float* const gI = gIB + qB * 64; const LAS float* const gE = gEB + qB * 64; \
            const bf16x8 aV0 = *(const LAS bf16x8*)(Vt + fr * 72 + 8 * fq), aV1 = *(const LAS bf16x8*)(Vt + fr * 72 + 32 + 8 * fq); \
            { \
                const bf16x8 aC0 = *(const LAS bf16x8*)(Cs + fr * 72 + 8 * fq), aC1 = *(const LAS bf16x8*)(Cs + fr * 72 + 32 + 8 * fq); \
                const bf16x8 aN0 = *(const LAS bf16x8*)(nb + 8 * fq), aN1 = *(const LAS bf16x8*)(nb + 32 + 8 * fq); \
_Pragma("unroll") \
                for (int tt = 0; tt < 4; ++tt) { \
                    const bf16x8 bP0 = *(const LAS bf16x8*)(Pr + (16 * tt + fr) * 72 + 8 * fq), bP1 = *(const LAS bf16x8*)(Pr + (16 * tt + fr) * 72 + 32 + 8 * fq); \
                    const bf16x8 bQ0 = *(const LAS bf16x8*)(Qr + (16 * tt + fr) * 72 + 8 * fq), bQ1 = *(const LAS bf16x8*)(Qr + (16 * tt + fr) * 72 + 32 + 8 * fq); \
                    f32x4 acc1 = mfma16(aV0, bP0, z4); acc1 = mfma16(aV1, bP1, acc1); \
                    f32x4 acc2 = mfma16(aC0, bQ0, z4); acc2 = mfma16(aC1, bQ1, acc2); \
                    f32x4 d1 = mfma16(ones, bP0, z4); d1 = mfma16(ones, bP1, d1); \
                    f32x4 d2 = mfma16(aN0, bQ0, z4); d2 = mfma16(aN1, bQ1, d2); \
                    const int t = 16 * tt + fr; const float gi = gI[t], en = gE[t]; \
                    const float den = d1[0] + gi * d2[0]; const float inv = __builtin_amdgcn_rcpf(fmaxf(fabsf(den), en)); \
                    *(u32x2*)(hrow + (hoff + tt * 16384u)) = \
                        pack4(ML_OUT(0), ML_OUT(1), ML_OUT(2), ML_OUT(3)); \
                } \
            } \
_Pragma("unroll") \
            for (int dt = 0; dt < 4; ++dt) { Cacc[dt] = Cacc[dt] * sp0; Nacc[dt] = Nacc[dt] * sp0; \
                const bf16x8 aK0 = *(const LAS bf16x8*)(Kw + (16 * dt + fr) * 72 + 8 * fq), aK1 = *(const LAS bf16x8*)(Kw + (16 * dt + fr) * 72 + 32 + 8 * fq); \
                Cacc[dt] = mfma16(aK0, aV0, Cacc[dt]); Cacc[dt] = mfma16(aK1, aV1, Cacc[dt]); \
                Nacc[dt] = mfma16(aK0, ones, Nacc[dt]); Nacc[dt] = mfma16(aK1, ones, Nacc[dt]); } \
_Pragma("unroll") \
            for (int dt = 0; dt < 4; ++dt) { *(LAS u32x2*)(Cs + fr * 72 + 16 * dt + 4 * fq) = pack4(Cacc[dt][0], Cacc[dt][1], Cacc[dt][2], Cacc[dt][3]); \
                                             *(LAS u32x2*)(nb + 16 * dt + 4 * fq) = pack4(Nacc[dt][0], Nacc[dt][1], Nacc[dt][2], Nacc[dt][3]); } \
        } \
        if (GW_) ML_LOADV(dir ? 62 - it : it + 1); \
        sp0 = sp1; sp1 = sp2; \
        { const int t_ = qB; qB = qW; qW = qS; qS = t_; } \
        __syncthreads(); } while (0)
__device__ __forceinline__ void mlstm_phase2(const int wv, LAS unsigned char* lds, const bf16* Q0, const bf16* K0, const bf16* V0, const float* GATES, bf16* HF, bf16* HB) {
    const int bx = blockIdx.x;
    if ((bx >> 3) & 1) return;
    const int seq = (bx >> 4) * 8 + (bx & 7);
    const int dir = seq & 1, bh = seq >> 1, b = bh >> 3, h = bh & 7;
    int ln_; asm volatile("v_mbcnt_lo_u32_b32 %0, -1, 0\n\tv_mbcnt_hi_u32_b32 %0, -1, %0" : "=v"(ln_)); const int lane = ln_, w = wv, fr = lane & 15, fq = lane >> 4;
    LAS bf16* const Qs = (LAS bf16*)(lds); LAS bf16* const Ks = (LAS bf16*)(lds + 27648); LAS bf16* const Kwt = (LAS bf16*)(lds + 46080); LAS bf16* const Ps = (LAS bf16*)(lds + 64512);
    LAS bf16* const Vt = (LAS bf16*)(lds + 82944 + w * 2304); LAS bf16* const Cs = (LAS bf16*)(lds + 101376 + w * 2304); LAS bf16* const nb = (LAS bf16*)(lds + 119808 + w * 128);
    LAS float* const gbase = (LAS float*)(lds + 120832 + w * 2816);
    LAS float* const gcB = gbase; LAS float* const gMB = gbase + 128; LAS float* const gIB = gbase + 256; LAS float* const gEB = gbase + 448; LAS float* const gW = gbase + 640;
    for (int i = lane; i < 2304 / 4; i += 64) ((LAS unsigned*)Cs)[i] = 0u;
    if (lane < 32) ((LAS unsigned*)nb)[lane] = 0u;
    f32x4 Cacc[4], Nacc[4];
#pragma unroll
    for (int i = 0; i < 4; ++i) { Cacc[i] = (f32x4){0.f, 0.f, 0.f, 0.f}; Nacc[i] = (f32x4){0.f, 0.f, 0.f, 0.f}; }
    float m = -1e30f;
    bf16* Hout = dir ? HB : HF;
    const size_t rowbase = (size_t)bh * 4096;
    const int jr = dir ? 63 - lane : lane;
    v4u rq, rk, rkh, rv0, rv1; float rli, rf, wrh = 0.f, sp0 = 0.f, sp1 = 0.f;
    rkh = (v4u){0u, 0u, 0u, 0u}; rv0 = rkh; rv1 = rkh;
    ML_LOADQK(dir ? 63 : 0);
    const bf16x8 ones = (bf16x8){0x3F80, 0x3F80, 0x3F80, 0x3F80, 0x3F80, 0x3F80, 0x3F80, 0x3F80};
    const f32x4 z4 = (f32x4){0.f, 0.f, 0.f, 0.f};
    int qS = 0, qW = 2, qB = 1;
#pragma unroll 1
    for (int it = -2; it < 64; ++it) {
        if (it >= 0 && it <= 60) ML2_BODY(true, true, true, true);
        else ML2_BODY(it + 2 < 64, it + 1 >= 0 && it + 1 < 64, it >= 0, it + 3 < 64);
    }
}
#undef ML_LOAD

__device__ __forceinline__ void hs_pass(const bf16* HF, const bf16* HB, const bf16* OG, const float* hg, bf16* HS, int gw, int NGW, int lane) {
    v4u f0, f1, b0, b1, o0, o1, nf0, nf1, nb0, nb1, no0, no1;
    if (gw < T) { const size_t off = (size_t)gw * 1024 + 16 * lane;
        f0 = *(const v4u*)(HF + off); f1 = *(const v4u*)(HF + off + 8); b0 = *(const v4u*)(HB + off); b1 = *(const v4u*)(HB + off + 8); o0 = *(const v4u*)(OG + off); o1 = *(const v4u*)(OG + off + 8); }
    for (int m = gw; m < T; m += NGW) {
        const size_t off = (size_t)m * 1024 + 16 * lane;
        { const int mn = m + NGW < T ? m + NGW : m; const size_t offn = (size_t)mn * 1024 + 16 * lane;
          nf0 = *(const v4u*)(HF + offn); nf1 = *(const v4u*)(HF + offn + 8); nb0 = *(const v4u*)(HB + offn); nb1 = *(const v4u*)(HB + offn + 8); no0 = *(const v4u*)(OG + offn); no1 = *(const v4u*)(OG + offn + 8); }
        float x[16], og[16];
#pragma unroll
        for (int i = 0; i < 4; ++i) { x[2 * i] = bf_lo(f0[i]) + bf_lo(b0[i]); x[2 * i + 1] = bf_hi(f0[i]) + bf_hi(b0[i]); x[8 + 2 * i] = bf_lo(f1[i]) + bf_lo(b1[i]); x[9 + 2 * i] = bf_hi(f1[i]) + bf_hi(b1[i]);
                                      og[2 * i] = bf_lo(o0[i]); og[2 * i + 1] = bf_hi(o0[i]); og[8 + 2 * i] = bf_lo(o1[i]); og[9 + 2 * i] = bf_hi(o1[i]); }
        float ss = 0.f;
#pragma unroll
        for (int i = 0; i < 16; ++i) ss += x[i] * x[i];
        ss += shx(ss, lane, 1); ss += shx(ss, lane, 2); ss += shx(ss, lane, 4);
        const float rstd = rsqrtf(ss * (1.f / 128.f) + EPS);
        float y[16];
#pragma unroll
        for (int i = 0; i < 16; ++i) y[i] = x[i] * rstd * hg[16 * lane + i] * (1.f / (1.f + __expf(-og[i])));
        v4u w0, w1;
#pragma unroll
        for (int i = 0; i < 4; ++i) { w0[i] = pk2(y[2 * i], y[2 * i + 1]); w1[i] = pk2(y[8 + 2 * i], y[9 + 2 * i]); }
        *(v4u*)(HS + off) = w0; *(v4u*)(HS + off + 8) = w1;
        f0 = nf0; f1 = nf1; b0 = nb0; b1 = nb1; o0 = no0; o1 = no1;
    }
}

__device__ __forceinline__ void glds16(const void* gsrc, unsigned lds_dst) { unsigned keep;
    asm volatile("s_mov_b32 %0, m0\n\ts_mov_b32 m0, %2\n\ts_nop 0\n\tglobal_load_lds_dwordx4 %1, off\n\ts_mov_b32 m0, %0" : "=&s"(keep) : "v"(gsrc), "s"(lds_dst) : "memory"); }
__device__ __forceinline__ void glds16s(const void* sbase, unsigned voff, unsigned lds_dst) { unsigned keep;
    asm volatile("s_mov_b32 %0, m0\n\ts_mov_b32 m0, %3\n\ts_nop 0\n\tglobal_load_lds_dwordx4 %1, %2\n\ts_mov_b32 m0, %0" : "=&s"(keep) : "v"(voff), "s"(sbase), "s"(lds_dst) : "memory"); }
#define AT_WAIT_BAR() asm volatile("s_waitcnt vmcnt(0) lgkmcnt(0)\n\ts_barrier" ::: "memory")

#define TK_CE(a, b) do { const float h_ = fmaxf(a, b), l_ = fminf(a, b); a = h_; b = l_; } while (0)
#define BITONIC_MERGE16(x) do { _Pragma("unroll") for (int d_ = 8; d_ >= 1; d_ >>= 1) { _Pragma("unroll") for (int i_ = 0; i_ < 16; ++i_) if ((i_ & d_) == 0) TK_CE(x[i_], x[i_ + d_]); } } while (0)
#define BITONIC_SORT16(x) do { _Pragma("unroll") for (int k_ = 2; k_ <= 16; k_ <<= 1) { _Pragma("unroll") for (int d_ = k_ >> 1; d_ >= 1; d_ >>= 1) { _Pragma("unroll") for (int i_ = 0; i_ < 16; ++i_) { const int l_i = i_ ^ d_; \
    if (l_i > i_) { if ((i_ & k_) == 0 || k_ == 16) TK_CE(x[i_], x[l_i]); else TK_CE(x[l_i], x[i_]); } } } } } while (0)
#define SORT16_60(x) do { \
    TK_CE(x[0], x[13]); TK_CE(x[1], x[12]); TK_CE(x[2], x[15]); TK_CE(x[3], x[14]); TK_CE(x[4], x[8]); TK_CE(x[5], x[6]); TK_CE(x[7], x[11]); TK_CE(x[9], x[10]); \
    TK_CE(x[0], x[5]); TK_CE(x[1], x[7]); TK_CE(x[2], x[9]); TK_CE(x[3], x[4]); TK_CE(x[6], x[13]); TK_CE(x[8], x[14]); TK_CE(x[10], x[15]); TK_CE(x[11], x[12]); \
    TK_CE(x[0], x[1]); TK_CE(x[2], x[3]); TK_CE(x[4], x[5]); TK_CE(x[6], x[8]); TK_CE(x[7], x[9]); TK_CE(x[10], x[11]); TK_CE(x[12], x[13]); TK_CE(x[14], x[15]); \
    TK_CE(x[0], x[2]); TK_CE(x[1], x[3]); TK_CE(x[4], x[10]); TK_CE(x[5], x[11]); TK_CE(x[6], x[7]); TK_CE(x[8], x[9]); TK_CE(x[12], x[14]); TK_CE(x[13], x[15]); \
    TK_CE(x[1], x[2]); TK_CE(x[3], x[12]); TK_CE(x[4], x[6]); TK_CE(x[5], x[7]); TK_CE(x[8], x[10]); TK_CE(x[9], x[11]); TK_CE(x[13], x[14]); \
    TK_CE(x[1], x[4]); TK_CE(x[2], x[6]); TK_CE(x[5], x[8]); TK_CE(x[7], x[10]); TK_CE(x[9], x[13]); TK_CE(x[11], x[14]); \
    TK_CE(x[2], x[4]); TK_CE(x[3], x[6]); TK_CE(x[9], x[12]); TK_CE(x[11], x[13]); \
    TK_CE(x[3], x[5]); TK_CE(x[6], x[8]); TK_CE(x[7], x[9]); TK_CE(x[10], x[12]); \
    TK_CE(x[3], x[4]); TK_CE(x[5], x[6]); TK_CE(x[7], x[8]); TK_CE(x[9], x[10]); TK_CE(x[11], x[12]); \
    TK_CE(x[6], x[7]); TK_CE(x[8], x[9]); } while (0)
#define TK_INSERT(v, x) do { float c_ = (x); _Pragma("unroll") for (int j_ = 0; j_ < 16; ++j_) { const float h_ = fmaxf(v[j_], c_); c_ = fminf(v[j_], c_); v[j_] = h_; } } while (0)
#define TK_DMA(st_, b_) do { _Pragma("unroll") for (int g_ = 0; g_ < 2; ++g_) { const int hp_ = ((g_ * 4 + ((st_) >> 1)) * 2 + ((st_) & 1)); \
    _Pragma("unroll") for (int i_ = 0; i_ < 4; ++i_) { const int q_ = w * 4 + i_, row_ = 4 * q_ + (lane >> 4), ch_ = (lane & 15) ^ (row_ & 15); \
        glds16(KEYS + ((size_t)(hp_ * 128 + row_)) * 128 + ch_ * 8, (unsigned)__builtin_amdgcn_readfirstlane((int)(ldsb + ((b_) * 2 + g_) * 32768 + q_ * 1024))); } } } while (0)
template <int VAR>
__device__ __forceinline__ void peer_topk_phase(const int wv, LAS unsigned char* lds, int vcu, const bf16* PQ, const bf16* KEYS, int* EXPERTS, float* GATESP) {
    int ln_; asm volatile("v_mbcnt_lo_u32_b32 %0, -1, 0\n\tv_mbcnt_hi_u32_b32 %0, -1, %0" : "=v"(ln_)); const int tid = wv * 64 + ln_, lane = tid & 63, w = wv, r32 = lane & 31, hi = lane >> 5;
    const int t = vcu * 128 + (w & 3) * 32 + r32, hg = w >> 2;
    const float NINF = -INFINITY;
    const unsigned ldsb = (unsigned)(uintptr_t)lds;
    TK_DMA(0, 0);
    bf16x8 bq[8];
#pragma unroll
    for (int ks = 0; ks < 8; ++ks) bq[ks] = *(const bf16x8*)(PQ + (size_t)t * 2048 + (hg * 4) * 256 + ks * 16 + 8 * hi);
    AT_WAIT_BAR();
#pragma unroll 1
    for (int hh = 0; hh < 4; ++hh) {
        const int head = hg * 4 + hh;
        float L0[16], L1[16];
#pragma unroll
        for (int j = 0; j < 16; ++j) { L0[j] = 0.f; L1[j] = 0.f; }
#pragma unroll 1
        for (int p = 0; p < 2; ++p) {
            const int st = hh * 2 + p, buf = st & 1;
            if (st < 7) TK_DMA(st + 1, buf ^ 1);
            const LAS unsigned char* kb = lds + (buf * 2 + hg) * 32768 + r32 * 256;
            f32x16 acc[4];
#pragma unroll
            for (int nt = 0; nt < 4; ++nt) {
#pragma unroll
                for (int r = 0; r < 16; ++r) acc[nt][r] = 0.f;
#pragma unroll
                for (int ks = 0; ks < 8; ++ks) { const bf16x8 a = *(const LAS bf16x8*)(kb + nt * 8192 + (((2 * ks + hi) ^ (r32 & 15)) << 4)); if (VAR != 2) acc[nt] = mfma32(a, bq[ks], acc[nt]); else acc[nt][ks] += (float)a[0] + (float)bq[ks][0]; }
            }
            if (st < 7) {
#pragma unroll
                for (int ks = 0; ks < 8; ++ks) bq[ks] = *(const bf16x8*)(PQ + (size_t)t * 2048 + (hg * 4 + ((st + 1) >> 1)) * 256 + ((st + 1) & 1) * 128 + ks * 16 + 8 * hi);
            }
            float v[16];
            {
                float blk[4][16];
#pragma unroll
                for (int nt = 0; nt < 4; ++nt)
#pragma unroll
                    for (int r = 0; r < 16; ++r) { const int n = nt * 32 + (r & 3) + 8 * (r >> 2) + 4 * hi; blk[nt][r] = __uint_as_float((__float_as_uint(acc[nt][r]) & ~0x7Fu) | (unsigned)(127 - n)); }
#pragma unroll
                for (int nt = 0; nt < 4; ++nt) do { if (VAR != 1) { SORT16_60(blk[nt]); } } while (0);
#pragma unroll
                for (int i = 0; i < 16; ++i) { blk[0][i] = fmaxf(blk[0][i], blk[1][15 - i]); blk[2][i] = fmaxf(blk[2][i], blk[3][15 - i]); }
                do { if (VAR != 1) { BITONIC_MERGE16(blk[0]); } } while (0); do { if (VAR != 1) { BITONIC_MERGE16(blk[2]); } } while (0);
#pragma unroll
                for (int i = 0; i < 16; ++i) v[i] = fmaxf(blk[0][i], blk[2][15 - i]);
                do { if (VAR != 1) { BITONIC_MERGE16(v); } } while (0);
            }
            {
                float wv_[16];
#pragma unroll
                for (int j = 0; j < 16; ++j) wv_[j] = shx(v[15 - j], lane, 32);
#pragma unroll
                for (int j = 0; j < 16; ++j) v[j] = fmaxf(v[j], wv_[j]);
                do { if (VAR != 1) { BITONIC_MERGE16(v); } } while (0);
            }
            if (p == 0) {
#pragma unroll
                for (int j = 0; j < 16; ++j) L0[j] = v[j];
            } else {
#pragma unroll
                for (int j = 0; j < 16; ++j) L1[j] = v[j];
            }            AT_WAIT_BAR();
        }
        float tv[16];
        unsigned IA[4] = {0u, 0u, 0u, 0u}, IB[4] = {0u, 0u, 0u, 0u};
#pragma unroll
        for (int i = 0; i < 16; ++i) { IA[i >> 2] |= (127u - (__float_as_uint(L0[i]) & 0x7Fu)) << (8 * (i & 3)); IB[i >> 2] |= (127u - (__float_as_uint(L1[i]) & 0x7Fu)) << (8 * (i & 3)); }
        {
            float cb[4][16]; int cn = 0;
#pragma unroll
            for (int i = 0; i < 16; ++i) {
                const float va = __uint_as_float(__float_as_uint(L0[i]) & ~0x7Fu);
#pragma unroll
                for (int j = 0; j < 16; ++j) if ((i + 1) * (j + 1) <= 16) {
                    const float vb = __uint_as_float(__float_as_uint(L1[j]) & ~0x7Fu);
                    cb[cn >> 4][cn & 15] = __uint_as_float((__float_as_uint(va + vb) & ~0xFFu) | (unsigned)(255 - (i * 16 + j)));
                    ++cn;
                }
            }
#pragma unroll
            for (int c = 50; c < 64; ++c) cb[c >> 4][c & 15] = NINF;
#pragma unroll
            for (int nt = 1; nt < 4; ++nt) do { if (VAR != 1) { SORT16_60(cb[nt]); } } while (0);
#pragma unroll
            for (int i = 0; i < 16; ++i) { cb[0][i] = fmaxf(cb[0][i], cb[1][15 - i]); cb[2][i] = fmaxf(cb[2][i], cb[3][15 - i]); }
            do { if (VAR != 1) { BITONIC_MERGE16(cb[0]); } } while (0); do { if (VAR != 1) { BITONIC_MERGE16(cb[2]); } } while (0);
#pragma unroll
            for (int i = 0; i < 16; ++i) tv[i] = fmaxf(cb[0][i], cb[2][15 - i]);
            do { if (VAR != 1) { BITONIC_MERGE16(tv); } } while (0);
        }
        int ti[16];
#pragma unroll
        for (int j = 0; j < 16; ++j) { const unsigned kb = __float_as_uint(tv[j]); const unsigned flat = 255u - (kb & 0xFFu); const unsigned fi = flat >> 4, fj = flat & 15u;
            const unsigned ra = (fi < 8u) ? ((fi < 4u) ? IA[0] : IA[1]) : ((fi < 12u) ? IA[2] : IA[3]);
            const unsigned rb = (fj < 8u) ? ((fj < 4u) ? IB[0] : IB[1]) : ((fj < 12u) ? IB[2] : IB[3]);
            ti[j] = (int)(((ra >> (8u * (fi & 3u))) & 0xFFu) * 128u + ((rb >> (8u * (fj & 3u))) & 0xFFu));
            tv[j] = __uint_as_float(kb & ~0xFFu); }
        float e[16], sum = 0.f;
#pragma unroll
        for (int j = 0; j < 16; ++j) { e[j] = __expf(tv[j] - tv[0]); sum += e[j]; }
        const float inv = 1.f / sum;
        if (hi == 0) { int* ep = EXPERTS + (size_t)t * 128 + head * 16;
#pragma unroll
            for (int j = 0; j < 4; ++j) *(v4u*)(ep + 4 * j) = (v4u){(unsigned)ti[4 * j], (unsigned)ti[4 * j + 1], (unsigned)ti[4 * j + 2], (unsigned)ti[4 * j + 3]}; }
        else { float* gp = GATESP + (size_t)t * 128 + head * 16;
#pragma unroll
            for (int j = 0; j < 4; ++j) *(f32x4*)(gp + 4 * j) = (f32x4){e[4 * j] * inv, e[4 * j + 1] * inv, e[4 * j + 2] * inv, e[4 * j + 3] * inv}; }
    }
}

__device__ __forceinline__ float cvt_ub0(unsigned x) { float r; asm("v_cvt_f32_ubyte0 %0, %1" : "=v"(r) : "v"(x)); return r; }
__device__ __forceinline__ float cvt_ub1(unsigned x) { float r; asm("v_cvt_f32_ubyte1 %0, %1" : "=v"(r) : "v"(x)); return r; }
__device__ __forceinline__ float cvt_ub2(unsigned x) { float r; asm("v_cvt_f32_ubyte2 %0, %1" : "=v"(r) : "v"(x)); return r; }
__device__ __forceinline__ float cvt_ub3(unsigned x) { float r; asm("v_cvt_f32_ubyte3 %0, %1" : "=v"(r) : "v"(x)); return r; }
__device__ __forceinline__ void quant8_rows_bf16(const bf16* src, unsigned char* dst, float* scale, int nrows, int gw, int NGW, int lane) {
    for (int r = gw; r < nrows; r += NGW) {
        const v4u a = *(const v4u*)(src + (size_t)r * 1024 + 16 * lane), b = *(const v4u*)(src + (size_t)r * 1024 + 16 * lane + 8);
        float x[16]; float am = 0.f;
#pragma unroll
        for (int k = 0; k < 4; ++k) { x[2 * k] = bf_lo(a[k]); x[2 * k + 1] = bf_hi(a[k]); x[8 + 2 * k] = bf_lo(b[k]); x[9 + 2 * k] = bf_hi(b[k]); }
#pragma unroll
        for (int k = 0; k < 16; ++k) am = fmaxf(am, fabsf(x[k]));
        am = wave_max0(am);
        const float inv = am > 0.f ? 127.f / am : 0.f;
        v4u w;
#pragma unroll
        for (int k = 0; k < 4; ++k) w[k] = ((unsigned)((int)rintf(x[4 * k] * inv) & 0xff)) | ((unsigned)((int)rintf(x[4 * k + 1] * inv) & 0xff) << 8) | ((unsigned)((int)rintf(x[4 * k + 2] * inv) & 0xff) << 16) | ((unsigned)((int)rintf(x[4 * k + 3] * inv) & 0xff) << 24);
        *(v4u*)(dst + (size_t)r * 1024 + 16 * lane) = w;
        if (lane == 0) scale[r] = am * (1.f / 127.f);
    }
}
__device__ __forceinline__ void quant4_rows(const float* src, unsigned char* dst, float* scale, int nrows, int gw, int NGW, int lane) {
    for (int r = gw; r < nrows; r += NGW) {
        const f32x4* sp = (const f32x4*)(src + (size_t)r * 1024) + 4 * lane;
        f32x4 v[4]; float am = 0.f, ss = 0.f;
#pragma unroll
        for (int j = 0; j < 4; ++j) { v[j] = sp[j]; am = fmaxf(am, fmaxf(fmaxf(fabsf(v[j].x), fabsf(v[j].y)), fmaxf(fabsf(v[j].z), fabsf(v[j].w)))); ss += (v[j].x * v[j].x + v[j].y * v[j].y) + (v[j].z * v[j].z + v[j].w * v[j].w); }
        am = wave_max0(am); ss = wave_sum(ss, lane);
        const float step = fminf(am * (1.f / 7.5f), 0.3352f * sqrtf(ss * (1.f / 1024.f)));
        const float inv = step > 0.f ? 1.f / step : 0.f;
        unsigned q[16];
#pragma unroll
        for (int j = 0; j < 4; ++j) { q[4 * j] = (unsigned)fminf(fmaxf(rintf(v[j].x * inv + 7.5f), 0.f), 15.f); q[4 * j + 1] = (unsigned)fminf(fmaxf(rintf(v[j].y * inv + 7.5f), 0.f), 15.f);
                                      q[4 * j + 2] = (unsigned)fminf(fmaxf(rintf(v[j].z * inv + 7.5f), 0.f), 15.f); q[4 * j + 3] = (unsigned)fminf(fmaxf(rintf(v[j].w * inv + 7.5f), 0.f), 15.f); }
        u32x2 w;
        w.x = (q[0] | (q[4] << 4)) | ((q[1] | (q[5] << 4)) << 8) | ((q[2] | (q[6] << 4)) << 16) | ((q[3] | (q[7] << 4)) << 24);
        w.y = (q[8] | (q[12] << 4)) | ((q[9] | (q[13] << 4)) << 8) | ((q[10] | (q[14] << 4)) << 16) | ((q[11] | (q[15] << 4)) << 24);
        w.x ^= 0x80808080u; w.y ^= 0x80808080u;
        *(u32x2*)(dst + (size_t)r * 512 + 8 * lane) = w;
        if (lane == 0) scale[r] = step;
    }
}

#define RED_STEP(N, S) do { const bool up_ = (lane & (S)) != 0; _Pragma("unroll") for (int j_ = 0; j_ < (N); ++j_) { const int a_ = p[j_], b_ = p[j_ + (N)]; const int send_ = up_ ? a_ : b_, keep_ = up_ ? b_ : a_; p[j_] = keep_ + shxi(send_, lane, (S)); } } while (0)
#define RED16(dst) do { RED_STEP(8, 8); RED_STEP(4, 4); RED_STEP(2, 2); RED_STEP(1, 1); int s_ = p[0]; s_ += shxi(s_, lane, 16); s_ += shxi(s_, lane, 32); dst = s_; } while (0)
#define G_SB() __builtin_amdgcn_sched_barrier(0)
#define G_LOAD(buf, tab, evec, jb) do { _Pragma("unroll") for (int jj_ = 0; jj_ < 16; ++jj_) { const int e_ = __builtin_amdgcn_readlane(evec, (jb) + jj_); buf[jj_] = __builtin_amdgcn_raw_buffer_load_b64(rs_##tab, (int)voff, e_ << 9, 0); } } while (0)
#define U_COMP(buf) do { _Pragma("unroll") for (int jj_ = 0; jj_ < 16; ++jj_) { const unsigned w0_ = buf[jj_].x, w1_ = buf[jj_].y; \
    int d_ = __builtin_amdgcn_sdot4((int)(w0_ & 0x0F0F0F0Fu), hq[0], 0, false); d_ = __builtin_amdgcn_sdot4((int)((w0_ >> 4) & 0x0F0F0F0Fu), hq[1], d_, false); \
    d_ = __builtin_amdgcn_sdot4((int)(w1_ & 0x0F0F0F0Fu), hq[2], d_, false); d_ = __builtin_amdgcn_sdot4((int)((w1_ >> 4) & 0x0F0F0F0Fu), hq[3], d_, false); p[jj_] = d_; } } while (0)
#define V_DW(o0, o1, o2, o3, wd, cs) do { float t0_, t1_, t2_, t3_; asm volatile("v_cvt_f32_ubyte0 %4, %8\n\tv_cvt_f32_ubyte1 %5, %8\n\tv_cvt_f32_ubyte2 %6, %8\n\tv_cvt_f32_ubyte3 %7, %8\n\tv_fmac_f32 %0, %9, %4\n\tv_fmac_f32 %1, %9, %5\n\tv_fmac_f32 %2, %9, %6\n\tv_fmac_f32 %3, %9, %7" \
    : "+v"(o0), "+v"(o1), "+v"(o2), "+v"(o3), "=&v"(t0_), "=&v"(t1_), "=&v"(t2_), "=&v"(t3_) : "v"(wd), "s"(cs)); } while (0)
#define V_COMP(buf, cvec, jb) do { _Pragma("unroll") for (int jj_ = 0; jj_ < 16; ++jj_) { const float c_ = __uint_as_float(__builtin_amdgcn_readlane(__float_as_uint(cvec), (jb) + jj_)); const unsigned w0_ = buf[jj_].x, w1_ = buf[jj_].y; \
    V_DW(o[0], o[1], o[2], o[3], w0_ & 0x0F0F0F0Fu, c_); V_DW(o[4], o[5], o[6], o[7], (w0_ >> 4) & 0x0F0F0F0Fu, c_); V_DW(o[8], o[9], o[10], o[11], w1_ & 0x0F0F0F0Fu, c_); V_DW(o[12], o[13], o[14], o[15], (w1_ >> 4) & 0x0F0F0F0Fu, c_); } } while (0)
template <bool NEXT_NORM>
__device__ __forceinline__ void peer_gather_phase(const int wv, bool dry, int vcu, const bf16* HN, const int* EXPERTS, const float* GATESP, const unsigned char* U, const float* SU, const unsigned char* Vtab, const float* SV,
                                                  float* X, const float* gnext, bf16* XN) {
    int ln_; asm volatile("v_mbcnt_lo_u32_b32 %0, -1, 0\n\tv_mbcnt_hi_u32_b32 %0, -1, %0" : "=v"(ln_)); const int tid = wv * 64 + ln_, lane = tid & 63, w = wv;
    const __amdgpu_buffer_rsrc_t rs_U = __builtin_amdgcn_make_buffer_rsrc((void*)U, (short)0, 16384 * 512, 0x00020000), rs_Vtab = __builtin_amdgcn_make_buffer_rsrc((void*)Vtab, (short)0, 16384 * 512, 0x00020000);
    const unsigned voff = (unsigned)lane * 8u;
    const int lg = lane >> 4;
#pragma unroll 1
    for (int i = 0; i < 16; ++i) {
        const int t = vcu * 128 + w * 16 + i;
        const int ev0 = EXPERTS[(size_t)t * 128 + lane], ev1 = EXPERTS[(size_t)t * 128 + 64 + lane];
        const float gv0 = GATESP[(size_t)t * 128 + lane], gv1 = GATESP[(size_t)t * 128 + 64 + lane];
        const v4u h0 = *(const v4u*)(HN + (size_t)t * 1024 + 16 * lane), h1 = *(const v4u*)(HN + (size_t)t * 1024 + 16 * lane + 8);
        float hf[16]; float am = 0.f;
#pragma unroll
        for (int k = 0; k < 4; ++k) { hf[2 * k] = bf_lo(h0[k]); hf[2 * k + 1] = bf_hi(h0[k]); hf[8 + 2 * k] = bf_lo(h1[k]); hf[9 + 2 * k] = bf_hi(h1[k]); }
#pragma unroll
        for (int k = 0; k < 16; ++k) am = fmaxf(am, fabsf(hf[k]));
        am = wave_max0(am);
        const float hinv = am > 0.f ? 127.f / am : 0.f, sh = am * (1.f / 127.f);
        int hq[4]; int hs = 0;
#pragma unroll
        for (int k = 0; k < 4; ++k) { const int q0 = (int)rintf(hf[4 * k] * hinv), q1 = (int)rintf(hf[4 * k + 1] * hinv), q2 = (int)rintf(hf[4 * k + 2] * hinv), q3 = (int)rintf(hf[4 * k + 3] * hinv); hs += (q0 + q1) + (q2 + q3);
            hq[k] = (int)(((unsigned)(q0 & 0xff)) | ((unsigned)(q1 & 0xff) << 8) | ((unsigned)(q2 & 0xff) << 16) | ((unsigned)(q3 & 0xff) << 24)); }
        hs = wave_sumi(hs);
        const float hoff = 7.5f * (float)hs;
        const float su0 = SU[ev0], su1 = SU[ev1], sv0 = SV[ev0], sv1 = SV[ev1];
        float o[16];
#pragma unroll
        for (int k = 0; k < 16; ++k) o[k] = 0.f;
        int p[16], r0, r1, r2, r3, r4, r5, r6, r7;
        u32x2 A[16], B[16], C[16];
        G_LOAD(A, U, ev0, 0); G_LOAD(B, U, ev0, 16); G_SB();
        G_LOAD(C, U, ev0, 32); G_SB(); U_COMP(A); RED16(r0); G_SB();
        G_LOAD(A, U, ev0, 48); G_SB(); U_COMP(B); RED16(r1); G_SB();
        G_LOAD(B, U, ev1, 0); G_SB(); U_COMP(C); RED16(r2); G_SB();
        G_LOAD(C, U, ev1, 16); G_SB(); U_COMP(A); RED16(r3); G_SB();
        G_LOAD(A, U, ev1, 32); G_SB(); U_COMP(B); RED16(r4); G_SB();
        G_LOAD(B, U, ev1, 48); G_SB(); U_COMP(C); RED16(r5); G_SB();
        G_LOAD(C, Vtab, ev0, 0); G_SB(); U_COMP(A); RED16(r6); G_SB();
        G_LOAD(A, Vtab, ev0, 16); G_SB(); U_COMP(B); RED16(r7); G_SB();
        const int d0 = lg == 0 ? r0 : (lg == 1 ? r1 : (lg == 2 ? r2 : r3)), d1 = lg == 0 ? r4 : (lg == 1 ? r5 : (lg == 2 ? r6 : r7));
        float act0 = ((float)d0 - hoff) * (sh * su0), act1 = ((float)d1 - hoff) * (sh * su1);
#ifdef PROBE_NOFFN
        const float coef0 = 0.f * act0, coef1 = 0.f * act1;
#else
        const float coef0 = gv0 * (0.5f * act0 * (1.f + erff(act0 * 0.70710678118f))) * sv0, coef1 = gv1 * (0.5f * act1 * (1.f + erff(act1 * 0.70710678118f))) * sv1;
#endif
        G_SB();
        G_LOAD(B, Vtab, ev0, 32); G_SB(); V_COMP(C, coef0, 0); G_SB();
        G_LOAD(C, Vtab, ev0, 48); G_SB(); V_COMP(A, coef0, 16); G_SB();
        G_LOAD(A, Vtab, ev1, 0); G_SB(); V_COMP(B, coef0, 32); G_SB();
        G_LOAD(B, Vtab, ev1, 16); G_SB(); V_COMP(C, coef0, 48); G_SB();
        G_LOAD(C, Vtab, ev1, 32); G_SB(); V_COMP(A, coef1, 0); G_SB();
        G_LOAD(A, Vtab, ev1, 48); G_SB(); V_COMP(B, coef1, 16); G_SB();
        V_COMP(C, coef1, 32); G_SB(); V_COMP(A, coef1, 48); G_SB();
        const float corr = 7.5f * wave_sum(coef0 + coef1, lane);
        float* xr = X + (size_t)t * 1024 + 16 * lane;
        f32x4 xv[4];
#pragma unroll
        for (int k = 0; k < 4; ++k) { xv[k] = *(const f32x4*)(xr + 4 * k); xv[k] += (f32x4){o[4 * k] - corr, o[4 * k + 1] - corr, o[4 * k + 2] - corr, o[4 * k + 3] - corr}; }
        if (!dry) {
#pragma unroll
            for (int k = 0; k < 4; ++k) *(f32x4*)(xr + 4 * k) = xv[k]; }
        if (NEXT_NORM && !dry) {
            float ss = 0.f;
#pragma unroll
            for (int k = 0; k < 4; ++k) ss += (xv[k].x * xv[k].x + xv[k].y * xv[k].y) + (xv[k].z * xv[k].z + xv[k].w * xv[k].w);
            const float rstd = rsqrtf(wave_sum(ss, lane) * (1.f / 1024.f) + EPS);
            v4u wa, wb;
#pragma unroll
            for (int k = 0; k < 4; ++k) { const f32x4 g = *(const f32x4*)(gnext + 16 * lane + 4 * k); const unsigned lo = pk2(xv[k].x * rstd * g.x, xv[k].y * rstd * g.y), hi2 = pk2(xv[k].z * rstd * g.z, xv[k].w * rstd * g.w);
                if (k < 2) { wa[2 * k] = lo; wa[2 * k + 1] = hi2; } else { wb[2 * (k - 2)] = lo; wb[2 * (k - 2) + 1] = hi2; } }
            *(v4u*)(XN + (size_t)t * 1024 + 16 * lane) = wa; *(v4u*)(XN + (size_t)t * 1024 + 16 * lane + 8) = wb;
        }
    }
}

__device__ __forceinline__ void rms_quant_pass(const bf16* X, const float* g, bf16* XN, unsigned char* HQ, float* SH, float* HS, int gw, int NGW, int lane) {
    const f32x4* gr = (const f32x4*)g + lane;
    u32x2 w4[2][4], n4[2][4];
#pragma unroll
    for (int r = 0; r < 2; ++r)
#pragma unroll
        for (int j = 0; j < 4; ++j) w4[r][j] = ((const u32x2*)(X + (size_t)(2 * gw + r) * D) + lane)[64 * j];
    for (int mb = gw; mb < T / 2; mb += NGW) {
        { const int mn = mb + NGW < T / 2 ? mb + NGW : mb;
#pragma unroll
          for (int r = 0; r < 2; ++r)
#pragma unroll
              for (int j = 0; j < 4; ++j) n4[r][j] = ((const u32x2*)(X + (size_t)(2 * mn + r) * D) + lane)[64 * j]; }
        f32x4 v[2][4]; float s[2] = {0.f, 0.f};
#pragma unroll
        for (int r = 0; r < 2; ++r)
#pragma unroll
            for (int j = 0; j < 4; ++j) { const u32x2 w = w4[r][j]; v[r][j] = (f32x4){bf_lo(w.x), bf_hi(w.x), bf_lo(w.y), bf_hi(w.y)}; s[r] += (v[r][j].x * v[r][j].x + v[r][j].y * v[r][j].y) + (v[r][j].z * v[r][j].z + v[r][j].w * v[r][j].w); }
#pragma unroll
        for (int r = 0; r < 2; ++r)
#pragma unroll
            for (int j = 0; j < 4; ++j) w4[r][j] = n4[r][j];
        float rstd[2], am[2] = {0.f, 0.f};
#pragma unroll
        for (int r = 0; r < 2; ++r) rstd[r] = rsqrtf(wave_sum(s[r], lane) * (1.f / 1024.f) + EPS);
#pragma unroll
        for (int j = 0; j < 4; ++j) { const f32x4 gg = gr[64 * j];
#pragma unroll
            for (int r = 0; r < 2; ++r) { v[r][j].x = v[r][j].x * rstd[r] * gg.x; v[r][j].y = v[r][j].y * rstd[r] * gg.y; v[r][j].z = v[r][j].z * rstd[r] * gg.z; v[r][j].w = v[r][j].w * rstd[r] * gg.w;
                am[r] = fmaxf(am[r], fmaxf(fmaxf(fabsf(v[r][j].x), fabsf(v[r][j].y)), fmaxf(fabsf(v[r][j].z), fabsf(v[r][j].w)))); } }
#pragma unroll
        for (int r = 0; r < 2; ++r) am[r] = wave_max0(am[r]);
#pragma unroll
        for (int r = 0; r < 2; ++r) {
            const int m = 2 * mb + r;
            const float hinv = am[r] > 0.f ? 127.f / am[r] : 0.f;
            int hs = 0;
            unsigned* q4 = (unsigned*)(HQ + (size_t)m * D) + lane;
#pragma unroll
            for (int j = 0; j < 4; ++j) { const int q0 = (int)rintf(v[r][j].x * hinv), q1 = (int)rintf(v[r][j].y * hinv), q2 = (int)rintf(v[r][j].z * hinv), q3 = (int)rintf(v[r][j].w * hinv); hs += (q0 + q1) + (q2 + q3);
                q4[64 * j] = ((unsigned)(q0 & 0xff)) | ((unsigned)(q1 & 0xff) << 8) | ((unsigned)(q2 & 0xff) << 16) | ((unsigned)(q3 & 0xff) << 24); }
            const float hsw = wave_sum((float)hs * ((lane & 1) ? -0.5f : 7.5f), lane);
            if (lane == 0) { SH[m] = am[r] * (1.f / 127.f); HS[m] = hsw; }
        }
    }
}
__device__ __forceinline__ int dpp_add_quad(int d) {
    d += __builtin_amdgcn_update_dpp(0, d, 0xB1, 0xF, 0xF, true);
    d += __builtin_amdgcn_update_dpp(0, d, 0x4E, 0xF, 0xF, true);
    return d;
}
__device__ __forceinline__ int dpp_add_oct(int d) {
    d += __builtin_amdgcn_update_dpp(0, d, 0xB1, 0xF, 0xF, true);
    d += __builtin_amdgcn_update_dpp(0, d, 0x4E, 0xF, 0xF, true);
    d += __builtin_amdgcn_update_dpp(0, d, 0x141, 0xF, 0xF, true);
    return d;
}
__device__ __forceinline__ int sdot4z(int a, int b) { int r; asm("v_dot4_i32_i8 %0, %1, %2, 0" : "=v"(r) : "v"(a), "v"(b)); return r; }
#define G1_IDS(E_, it_) do { const int t_ = t0 + ((it_) >> 1), hf_ = (it_) & 1; const v4u* ep_ = (const v4u*)(EXPERTS + (size_t)t_ * 128 + 16 * oct + 8 * hf_); const v4u ea_ = ep_[0], eb_ = ep_[1]; \
    E_[0] = (int)ea_.x; E_[1] = (int)ea_.y; E_[2] = (int)ea_.z; E_[3] = (int)ea_.w; E_[4] = (int)eb_.x; E_[5] = (int)eb_.y; E_[6] = (int)eb_.z; E_[7] = (int)eb_.w; } while (0)
#define G1_HLD(H0_, H1_, tok_) do { const int t_ = t0 + (tok_); H0_ = *(const v4u*)(HQ + (size_t)t_ * 1024 + 256 * s + 32 * q8); H1_ = *(const v4u*)(HQ + (size_t)t_ * 1024 + 256 * s + 32 * q8 + 16); } while (0)
#define G1_ROWS(R_, E_) do { _Pragma("unroll") for (int j_ = 0; j_ < 8; ++j_) R_[j_] = __builtin_amdgcn_raw_buffer_load_b128(rs_U, (E_[j_] << 9) + soff, 0, 0); } while (0)
#define G1_COMP(R_, H0_, H1_, it_) do { int dd_[8]; _Pragma("unroll") for (int j_ = 0; j_ < 8; ++j_) { \
    int d_ = sdot4z((int)(R_[j_].x & 0x0F0F0F0Fu), (int)H0_.x), e_ = sdot4z((int)(R_[j_].x & 0xF0F0F0F0u), (int)H0_.y); \
    d_ = __builtin_amdgcn_sdot4((int)(R_[j_].y & 0x0F0F0F0Fu), (int)H0_.z, d_, false); e_ = __builtin_amdgcn_sdot4((int)(R_[j_].y & 0xF0F0F0F0u), (int)H0_.w, e_, false); \
    d_ = __builtin_amdgcn_sdot4((int)(R_[j_].z & 0x0F0F0F0Fu), (int)H1_.x, d_, false); e_ = __builtin_amdgcn_sdot4((int)(R_[j_].z & 0xF0F0F0F0u), (int)H1_.y, e_, false); \
    d_ = __builtin_amdgcn_sdot4((int)(R_[j_].w & 0x0F0F0F0Fu), (int)H1_.z, d_, false); e_ = __builtin_amdgcn_sdot4((int)(R_[j_].w & 0xF0F0F0F0u), (int)H1_.w, e_, false); \
    d_ = (d_ << 4) + e_; \
    dd_[j_] = dpp_add_oct(d_); } \
    if (q8 == 0) { v4u* pp_ = (v4u*)(PART + ((size_t)s * T + t0 + ((it_) >> 1)) * 128 + 16 * oct + 8 * ((it_) & 1)); pp_[0] = (v4u){(unsigned)dd_[0], (unsigned)dd_[1], (unsigned)dd_[2], (unsigned)dd_[3]}; pp_[1] = (v4u){(unsigned)dd_[4], (unsigned)dd_[5], (unsigned)dd_[6], (unsigned)dd_[7]}; } } while (0)
__device__ __forceinline__ void peer_g1_phase(const int wv, int vcu, const unsigned char* HQ, const int* EXPERTS, const unsigned char* U, int* PART) {
    int ln_; asm volatile("v_mbcnt_lo_u32_b32 %0, -1, 0\n\tv_mbcnt_hi_u32_b32 %0, -1, %0" : "=v"(ln_)); const int lane = ln_, oct = lane >> 3, q8 = lane & 7;
    const int s = vcu >> 6;
    const __amdgpu_buffer_rsrc_t rs_U = __builtin_amdgcn_make_buffer_rsrc((void*)U, (short)0, 16384 * 512, 0x00020000);
    const int soff = 128 * s + 16 * q8;
    const int t0 = 512 * (vcu & 63) + 64 * wv;
    int eA[8], eB[8]; v4u rA[8], rB[8], h0, h1, n0, n1;
    G1_IDS(eA, 0); G1_HLD(h0, h1, 0); G1_ROWS(rA, eA); G1_IDS(eB, 1);
#pragma unroll 1
    for (int i = 0; i < 128; i += 2) {
        G1_ROWS(rB, eB); __builtin_amdgcn_sched_barrier(0);
        G1_IDS(eA, (i + 2) & 127); G1_HLD(n0, n1, ((i + 2) & 127) >> 1); __builtin_amdgcn_sched_barrier(0);
        G1_COMP(rA, h0, h1, i); __builtin_amdgcn_sched_barrier(0);
        G1_ROWS(rA, eA); __builtin_amdgcn_sched_barrier(0);
        G1_IDS(eB, (i + 3) & 127); __builtin_amdgcn_sched_barrier(0);
        G1_COMP(rB, h0, h1, i + 1); __builtin_amdgcn_sched_barrier(0);
        h0 = n0; h1 = n1;
    }
}
__device__ __forceinline__ void peer_g1b_phase(const int* PART, const int* EXPERTS, const float* GATESP, const float* SU, const float* SV, const float* SH, const float* HS, unsigned char* COEFQ, float* SCT, float* CS, int gw, int NGW, int lane) {
    for (int tb = gw; tb < T / 4; tb += NGW) {
        int pr[4][2][4], ev[4][2]; float gt[4][2], su[4][2], sv[4][2], sh[4], hoff[4];
#pragma unroll
        for (int k = 0; k < 4; ++k)
#pragma unroll
            for (int h2 = 0; h2 < 2; ++h2) { const size_t idx = (size_t)(4 * tb + k) * 128 + 64 * h2 + lane;
#pragma unroll
                for (int x = 0; x < 4; ++x) pr[k][h2][x] = PART[(size_t)x * T * 128 + idx];
                ev[k][h2] = EXPERTS[idx]; gt[k][h2] = GATESP[idx]; }
#pragma unroll
        for (int k = 0; k < 4; ++k) { sh[k] = SH[4 * tb + k]; hoff[k] = HS[4 * tb + k]; }
#pragma unroll
        for (int k = 0; k < 4; ++k)
#pragma unroll
            for (int h2 = 0; h2 < 2; ++h2) { su[k][h2] = SU[ev[k][h2]]; sv[k][h2] = SV[ev[k][h2]]; }
#pragma unroll
        for (int k = 0; k < 4; ++k) {
            const int t = 4 * tb + k;
            float cf[2]; float am = 0.f;
#pragma unroll
            for (int h2 = 0; h2 < 2; ++h2) {
                const int d = (pr[k][h2][0] + pr[k][h2][1]) + (pr[k][h2][2] + pr[k][h2][3]);
                const float act = ((float)d * 0.0625f - hoff[k]) * (sh[k] * su[k][h2]);
                cf[h2] = gt[k][h2] * (0.5f * act * (1.f + erff(act * 0.70710678118f))) * sv[k][h2];
                am = fmaxf(am, fabsf(cf[h2]));
            }
            am = wave_max0(am);
            const float inv = am > 0.f ? 127.f / am : 0.f;
            const int q0 = (int)rintf(cf[0] * inv), q1 = (int)rintf(cf[1] * inv);
            COEFQ[(size_t)t * 128 + lane] = (unsigned char)(q0 & 0xff); COEFQ[(size_t)t * 128 + 64 + lane] = (unsigned char)(q1 & 0xff);
            int cs = q0 + q1;
            cs = wave_sumi(cs);
            if (lane == 0) { SCT[t] = am * (1.f / 127.f); CS[t] = (float)cs; }
        }
    }
}
#define G2_IDS(E_, C_, it_) do { const int t_ = t0 + ((it_) >> 1), hf_ = (it_) & 1; const v4u* ep_ = (const v4u*)(EXPERTS + (size_t)t_ * 128 + 16 * oct + 8 * hf_); const v4u ea_ = ep_[0], eb_ = ep_[1]; \
    E_[0] = (int)ea_.x; E_[1] = (int)ea_.y; E_[2] = (int)ea_.z; E_[3] = (int)ea_.w; E_[4] = (int)eb_.x; E_[5] = (int)eb_.y; E_[6] = (int)eb_.z; E_[7] = (int)eb_.w; \
    C_ = *(const u32x2*)(COEFQ + (size_t)t_ * 128 + 16 * oct + 8 * hf_); } while (0)
#define G2_ROWS(R_, E_) do { _Pragma("unroll") for (int j_ = 0; j_ < 8; ++j_) R_[j_] = __builtin_amdgcn_raw_buffer_load_b128(rs_V, (E_[j_] << 9) + soff, 0, 0); } while (0)
#define G2_T4(ob, w0, w1, w2, w3, cq_) do { const unsigned a_ = __builtin_amdgcn_perm(w1, w0, 0x05010400u), b_ = __builtin_amdgcn_perm(w1, w0, 0x07030602u), c_ = __builtin_amdgcn_perm(w3, w2, 0x05010400u), d_ = __builtin_amdgcn_perm(w3, w2, 0x07030602u); \
    const unsigned y0_ = __builtin_amdgcn_perm(c_, a_, 0x05040100u), y1_ = __builtin_amdgcn_perm(c_, a_, 0x07060302u), y2_ = __builtin_amdgcn_perm(d_, b_, 0x05040100u), y3_ = __builtin_amdgcn_perm(d_, b_, 0x07060302u); \
    o[(ob)] = __builtin_amdgcn_sdot4((int)(y0_ & 0x0F0F0F0Fu), cq_, o[(ob)], false); o[(ob) + 4] = __builtin_amdgcn_sdot4((int)y0_, cq_, o[(ob) + 4], false); \
    o[(ob) + 1] = __builtin_amdgcn_sdot4((int)(y1_ & 0x0F0F0F0Fu), cq_, o[(ob) + 1], false); o[(ob) + 5] = __builtin_amdgcn_sdot4((int)y1_, cq_, o[(ob) + 5], false); \
    o[(ob) + 2] = __builtin_amdgcn_sdot4((int)(y2_ & 0x0F0F0F0Fu), cq_, o[(ob) + 2], false); o[(ob) + 6] = __builtin_amdgcn_sdot4((int)y2_, cq_, o[(ob) + 6], false); \
    o[(ob) + 3] = __builtin_amdgcn_sdot4((int)(y3_ & 0x0F0F0F0Fu), cq_, o[(ob) + 3], false); o[(ob) + 7] = __builtin_amdgcn_sdot4((int)y3_, cq_, o[(ob) + 7], false); } while (0)
#define G2_T4Z(ob, w0, w1, w2, w3, cq_) do { const unsigned a_ = __builtin_amdgcn_perm(w1, w0, 0x05010400u), b_ = __builtin_amdgcn_perm(w1, w0, 0x07030602u), c_ = __builtin_amdgcn_perm(w3, w2, 0x05010400u), d_ = __builtin_amdgcn_perm(w3, w2, 0x07030602u); \
    const unsigned y0_ = __builtin_amdgcn_perm(c_, a_, 0x05040100u), y1_ = __builtin_amdgcn_perm(c_, a_, 0x07060302u), y2_ = __builtin_amdgcn_perm(d_, b_, 0x05040100u), y3_ = __builtin_amdgcn_perm(d_, b_, 0x07060302u); \
    o[(ob)] = sdot4z((int)(y0_ & 0x0F0F0F0Fu), cq_); o[(ob) + 4] = sdot4z((int)y0_, cq_); \
    o[(ob) + 1] = sdot4z((int)(y1_ & 0x0F0F0F0Fu), cq_); o[(ob) + 5] = sdot4z((int)y1_, cq_); \
    o[(ob) + 2] = sdot4z((int)(y2_ & 0x0F0F0F0Fu), cq_); o[(ob) + 6] = sdot4z((int)y2_, cq_); \
    o[(ob) + 3] = sdot4z((int)(y3_ & 0x0F0F0F0Fu), cq_); o[(ob) + 7] = sdot4z((int)y3_, cq_); } while (0)
#define G2_REDI(N, S) do { const bool up_ = (lane & (S)) != 0; _Pragma("unroll") for (int j_ = 0; j_ < (N); ++j_) { const int a_ = o[j_], b_ = o[j_ + (N)]; const int send_ = up_ ? a_ : b_, keep_ = up_ ? b_ : a_; o[j_] = keep_ + shxi(send_, lane, (S)); } } while (0)
#define G2_ACC(R_, C_) do { \
    G2_T4(0, R_[0].x, R_[1].x, R_[2].x, R_[3].x, (int)C_.x); G2_T4(8, R_[0].y, R_[1].y, R_[2].y, R_[3].y, (int)C_.x); G2_T4(16, R_[0].z, R_[1].z, R_[2].z, R_[3].z, (int)C_.x); G2_T4(24, R_[0].w, R_[1].w, R_[2].w, R_[3].w, (int)C_.x); \
    G2_T4(0, R_[4].x, R_[5].x, R_[6].x, R_[7].x, (int)C_.y); G2_T4(8, R_[4].y, R_[5].y, R_[6].y, R_[7].y, (int)C_.y); G2_T4(16, R_[4].z, R_[5].z, R_[6].z, R_[7].z, (int)C_.y); G2_T4(24, R_[4].w, R_[5].w, R_[6].w, R_[7].w, (int)C_.y); } while (0)
#define G2_ACCZ(R_, C_) do { \
    G2_T4Z(0, R_[0].x, R_[1].x, R_[2].x, R_[3].x, (int)C_.x); G2_T4Z(8, R_[0].y, R_[1].y, R_[2].y, R_[3].y, (int)C_.x); G2_T4Z(16, R_[0].z, R_[1].z, R_[2].z, R_[3].z, (int)C_.x); G2_T4Z(24, R_[0].w, R_[1].w, R_[2].w, R_[3].w, (int)C_.x); \
    G2_T4(0, R_[4].x, R_[5].x, R_[6].x, R_[7].x, (int)C_.y); G2_T4(8, R_[4].y, R_[5].y, R_[6].y, R_[7].y, (int)C_.y); G2_T4(16, R_[4].z, R_[5].z, R_[6].z, R_[7].z, (int)C_.y); G2_T4(24, R_[4].w, R_[5].w, R_[6].w, R_[7].w, (int)C_.y); } while (0)
#define G2_RED8(N) do { _Pragma("unroll") for (int j_ = 0; j_ < (N); ++j_) \
    asm("s_nop 1\n\tv_add_u32_dpp %0, %0, %0 row_ror:8 row_mask:0xf bank_mask:0x3\n\tv_add_u32_dpp %0, %1, %1 row_ror:8 row_mask:0xf bank_mask:0xc" : "+v"(o[j_]) : "v"(o[j_ + (N)])); } while (0)
#define G2_RED16(N) do { _Pragma("unroll") for (int j_ = 0; j_ < (N); ++j_) { const auto r_ = __builtin_amdgcn_permlane16_swap((unsigned)o[j_], (unsigned)o[j_ + (N)], false, false); o[j_] = (int)r_[0] + (int)r_[1]; } } while (0)
#define G2_RED32(N) do { _Pragma("unroll") for (int j_ = 0; j_ < (N); ++j_) { const auto r_ = __builtin_amdgcn_permlane32_swap((unsigned)o[j_], (unsigned)o[j_ + (N)], false, false); o[j_] = (int)r_[0] + (int)r_[1]; } } while (0)
#define G2_FIN(tt_, xw_) do { G2_RED8(16); G2_RED16(8); \
      \
    o[4] -= o[0]; o[5] -= o[1]; o[6] -= o[2]; o[7] -= o[3]; G2_RED32(4); \
    const float sc_ = SCT[tt_] * omul, corr_ = ocor * CS[tt_]; \
    f32x4 xv_ = (f32x4){bf_lo(xw_.x), bf_hi(xw_.x), bf_lo(xw_.y), bf_hi(xw_.y)}; \
    xv_.x += sc_ * ((float)o[0] - corr_); xv_.y += sc_ * ((float)o[1] - corr_); xv_.z += sc_ * ((float)o[2] - corr_); xv_.w += sc_ * ((float)o[3] - corr_); \
    if (!NEXT) { *(f32x4*)(OUT + (size_t)(tt_) * 1024 + ocol) = xv_; } else { const u32x2 yw_ = (u32x2){pk2(xv_.x, xv_.y), pk2(xv_.z, xv_.w)}; *(u32x2*)(XR + (size_t)(tt_) * 1024 + ocol) = yw_; \
        const float y0_ = bf_lo(yw_.x), y1_ = bf_hi(yw_.x), y2_ = bf_lo(yw_.y), y3_ = bf_hi(yw_.y); \
        const float ss_ = wave_sum((y0_ * y0_ + y1_ * y1_) + (y2_ * y2_ + y3_ * y3_), lane); if (lane == 0) SS[(size_t)s * T + (tt_)] = ss_; } } while (0)
template <bool NEXT>
__device__ __forceinline__ void peer_g2_phase(const int wv, int vcu, const int* EXPERTS, const unsigned char* COEFQ, const float* SCT, const float* CS, const unsigned char* Vtab, bf16* XR, float* OUT, float* SS) {
    int ln_; asm volatile("v_mbcnt_lo_u32_b32 %0, -1, 0\n\tv_mbcnt_hi_u32_b32 %0, -1, %0" : "=v"(ln_)); const int lane = ln_, oct = lane >> 3, q8 = lane & 7;
    const int s = vcu >> 6;
    const __amdgpu_buffer_rsrc_t rs_V = __builtin_amdgcn_make_buffer_rsrc((void*)Vtab, (short)0, 16384 * 512, 0x00020000);
    const int soff = 128 * s + 16 * q8;
    const int ocol = 256 * s + 32 * q8 + 16 * ((lane >> 3) & 1) + 8 * ((lane >> 4) & 1) + 4 * ((lane >> 5) & 1);
    const float omul = (lane & 32) ? 0.0625f : 1.f, ocor = (lane & 32) ? -8.f : 7.5f;
    const int t0 = 512 * (vcu & 63) + 64 * wv;
    int eA[8], eB[8]; u32x2 cA, cB, cC; v4u rA[8], rB[8];
    G2_IDS(eA, cA, 0); G2_ROWS(rA, eA); G2_IDS(eB, cB, 1);
#pragma unroll 1
    for (int i = 0; i < 128; i += 2) {
        const int tt = t0 + (i >> 1);
        const u32x2 xw = *(const u32x2*)(XR + (size_t)tt * 1024 + ocol);
        int o[32];
        G2_ROWS(rB, eB); __builtin_amdgcn_sched_barrier(0);
        G2_IDS(eA, cC, (i + 2) & 127); __builtin_amdgcn_sched_barrier(0);
        G2_ACCZ(rA, cA); __builtin_amdgcn_sched_barrier(0);
        G2_ROWS(rA, eA); cA = cC; __builtin_amdgcn_sched_barrier(0);
        G2_IDS(eB, cC, (i + 3) & 127); __builtin_amdgcn_sched_barrier(0);
        G2_ACC(rB, cB); __builtin_amdgcn_sched_barrier(0);
        G2_FIN(tt, xw);
        cB = cC;
    }
}

__device__ __forceinline__ void qknorm_rope_pass(bf16* Q1, bf16* K1, const float* qg, const float* kg, const float* rope, size_t gtid, size_t gthreads) {
    const size_t NROWS = (size_t)2 * 64 * 2 * 4096;
    const int lane = (int)(gtid & 63);
    for (size_t id = gtid; id < NROWS * 8; id += gthreads) {
        const size_t rowg = id >> 3; const int part = (int)(id & 7);
        const bool isk = rowg >= NROWS / 2; const size_t row = isk ? rowg - NROWS / 2 : rowg;
        bf16* ptr = (isk ? K1 : Q1) + row * 64 + part * 8; const float* g = (isk ? kg : qg) + part * 8;
        const int s = (int)(row & 4095); const int bh = (int)(row >> 13); const int bidx = bh >> 3; const size_t mtok = (size_t)bidx * 4096 + s;
        const v4u raw = *(const v4u*)ptr;
        float x[8];
#pragma unroll
        for (int i = 0; i < 4; ++i) { x[2 * i] = bf_lo(raw[i]); x[2 * i + 1] = bf_hi(raw[i]); }
        float ss = 0.f;
#pragma unroll
        for (int i = 0; i < 8; ++i) ss += x[i] * x[i];
        ss += shx(ss, lane, 1); ss += shx(ss, lane, 2); ss += shx(ss, lane, 4);
        const float rstd = rsqrtf(ss * (1.f / 64.f) + EPS);
        float y[8], other[8];
#pragma unroll
        for (int i = 0; i < 8; ++i) y[i] = x[i] * rstd * g[i];
#pragma unroll
        for (int i = 0; i < 8; ++i) other[i] = shx(y[i], lane, 1);
        if (part < 2) { const float* cs = rope + mtok * 16;
#pragma unroll
            for (int i = 0; i < 8; ++i) { const float co = cs[i], si = cs[8 + i]; y[i] = (part == 0) ? (y[i] * co - other[i] * si) : (y[i] * co + other[i] * si); } }
        const float sc = isk ? 1.f : (0.125f * 1.44269504089f);
        v4u o;
#pragma unroll
        for (int i = 0; i < 4; ++i) o[i] = pk2(y[2 * i] * sc, y[2 * i + 1] * sc);
        *(v4u*)ptr = o;
    }
}

#define AT_DMA(kt_, slot_) do { \
    _Pragma("unroll") for (int i_ = 0; i_ < 2; ++i_) \
        glds16s(K1 + ((size_t)((bh * 2 + i_) * 4096 + (kt_) * 64)) * 64, dkoff, (unsigned)__builtin_amdgcn_readfirstlane((int)(ldsb + (slot_) * 32768 + i_ * 8192 + w * 1024))); \
    _Pragma("unroll") for (int i_ = 0; i_ < 2; ++i_) \
        glds16s(V1 + ((size_t)(bh * 4096 + (kt_) * 64 + 4 * i_)) * 128, dvoff, (unsigned)__builtin_amdgcn_readfirstlane((int)(ldsb + (slot_) * 32768 + 16384 + w * 2048 + i_ * 1024))); } while (0)
typedef short v4i16_t __attribute__((ext_vector_type(4)));
__device__ __forceinline__ bf16x8 vtr8(const LAS bf16* p) {
    const v4i16_t lo = __builtin_amdgcn_ds_read_tr16_b64_v4i16((LAS v4i16_t*)p), hi = __builtin_amdgcn_ds_read_tr16_b64_v4i16((LAS v4i16_t*)(p + 8 * 128));
    return (bf16x8){lo[0], lo[1], lo[2], lo[3], hi[0], hi[1], hi[2], hi[3]};
}
#define AT_KLD(ks_) do { ka[2 * (ks_)] = *(const LAS bf16x8*)(Kc + r32 * 128 + (((2 * (ks_) + hi) ^ kx0) << 4)); ka[2 * (ks_) + 1] = *(const LAS bf16x8*)(Kc + (32 + r32) * 128 + (((2 * (ks_) + hi) ^ kx1) << 4)); } while (0)
#define AT_TILE(SA0_, SA1_, SN0_, SN1_, KT_) do { \
            if ((KT_) + 2 < 64) AT_DMA((KT_) + 2, b2); \
            const LAS unsigned char* Kc = lds + b1 * 32768 + c * 8192; \
            const LAS unsigned char* Vb = lds + b0 * 32768 + 16384 + vrow * 256 + 8 * (vp & 1); \
_Pragma("unroll") \
            for (int r = 0; r < 16; ++r) { SN0_[r] = 0.f; SN1_[r] = 0.f; } \
            bf16x8 ka[8]; \
            AT_KLD(0); AT_KLD(1); \
            __builtin_amdgcn_sched_barrier(0); \
_Pragma("unroll") \
            for (int ks = 0; ks < 4; ++ks) { \
                SN0_ = mfma32(ka[2 * ks], bq[ks], SN0_); \
_Pragma("unroll") \
                for (int r = 0; r < 4; ++r) SA0_[4 * ks + r] = __builtin_amdgcn_exp2f(OFFS ? SA0_[4 * ks + r] - offs : SA0_[4 * ks + r]); \
                __builtin_amdgcn_sched_barrier(0); \
                SN1_ = mfma32(ka[2 * ks + 1], bq[ks], SN1_); \
                if (ks < 2) AT_KLD(ks + 2); \
_Pragma("unroll") \
                for (int r = 0; r < 4; ++r) SA1_[4 * ks + r] = __builtin_amdgcn_exp2f(OFFS ? SA1_[4 * ks + r] - offs : SA1_[4 * ks + r]); \
                __builtin_amdgcn_sched_barrier(0); \
            } \
            bf16x8 pa[4]; bf16x8 vf[4], vn[4]; \
_Pragma("unroll") \
            for (int db = 0; db < 4; ++db) vf[db] = vtr8((const LAS bf16*)(Vb + (((4 * db + 2 * vg + (vp >> 1)) ^ ((vrow & 3) << 2)) << 4))); \
            float ls = 0.f; \
            { v4u t0; \
_Pragma("unroll") \
              for (int k = 0; k < 4; ++k) { t0[k] = pk2(SA0_[2 * k], SA0_[2 * k + 1]); ls = addf_np(ls, addf_np(SA0_[2 * k], SA0_[2 * k + 1])); } \
              pa[0] = __builtin_bit_cast(bf16x8, t0); } \
            __builtin_amdgcn_sched_barrier(0); \
_Pragma("unroll") \
            for (int sp_ = 0; sp_ < 4; ++sp_) { \
                if (sp_ < 3) { \
_Pragma("unroll") \
                    for (int db = 0; db < 4; ++db) vn[db] = vtr8((const LAS bf16*)(Vb + (16 * (sp_ + 1)) * 256 + (((4 * db + 2 * vg + (vp >> 1)) ^ ((vrow & 3) << 2)) << 4))); \
                } \
_Pragma("unroll") \
                for (int db = 0; db < 4; ++db) Oa[db] = mfma32(pa[sp_], vf[db], Oa[db]); \
                if (sp_ < 3) { v4u t0; \
_Pragma("unroll") \
                    for (int k = 0; k < 4; ++k) { const float x0 = (sp_ == 0) ? SA0_[8 + 2 * k] : (sp_ == 1 ? SA1_[2 * k] : SA1_[8 + 2 * k]), x1 = (sp_ == 0) ? SA0_[9 + 2 * k] : (sp_ == 1 ? SA1_[2 * k + 1] : SA1_[9 + 2 * k]); t0[k] = pk2(x0, x1); ls = addf_np(ls, addf_np(x0, x1)); } \
                    pa[sp_ + 1] = __builtin_bit_cast(bf16x8, t0); } \
                __builtin_amdgcn_sched_barrier(0); \
                if (sp_ < 3) { \
_Pragma("unroll") \
                    for (int db = 0; db < 4; ++db) vf[db] = vn[db]; \
                } \
            } \
            lsum += ls; \
            { const int tb = b0; b0 = b1; b1 = b2; b2 = tb; } \
            AT_WAIT_BAR(); } while (0)
template <bool OFFS>
__device__ __forceinline__ void attn_units(const int wv, LAS unsigned char* lds, int vcu, const bf16* Q1, const bf16* K1, const bf16* V1, bf16* O, const float* subln, float lam, float offs) {
    int ln_; asm volatile("v_mbcnt_lo_u32_b32 %0, -1, 0\n\tv_mbcnt_hi_u32_b32 %0, -1, %0" : "=v"(ln_)); const int tid = wv * 64 + ln_, lane = tid & 63, w = wv, r32 = lane & 31, hi = lane >> 5, qt = w & 3, c = w >> 2;
    LAS float* lbuf = (LAS float*)(lds + 135168 + w * 128);
    LAS float* Obuf = (LAS float*)lds;
    if (wv >= 4) __builtin_amdgcn_s_setprio(1);
    const unsigned ldsb = (unsigned)(uintptr_t)lds;
    const unsigned dkoff = (unsigned)(((8 * w + (lane >> 3)) * 64 + (((lane & 7) ^ (((8 * w + (lane >> 3)) >> 1) & 7)) * 8)) * 2);
    const unsigned dvoff = (unsigned)(((8 * w + (lane >> 4)) * 128 + (((lane & 15) ^ (((8 * w + (lane >> 4)) & 3) << 2)) * 8)) * 2);
    bf16x8 bq[4];
#pragma unroll
    for (int ks = 0; ks < 4; ++ks) bq[ks] = *(const bf16x8*)(Q1 + ((size_t)((((vcu >> 5) * 8) * 2 + c) * 4096 + (vcu & 31) * 128 + qt * 32 + r32)) * 64 + ks * 16 + 8 * hi);
#pragma unroll 1
    for (int ui = 0; ui < 8; ++ui) {
        const int bh = (vcu >> 5) * 8 + ui, qb = vcu & 31, b = bh >> 3, h = bh & 7;
        f32x16 Oa[4];
#pragma unroll
        for (int db = 0; db < 4; ++db)
#pragma unroll
            for (int r = 0; r < 16; ++r) Oa[db][r] = 0.f;
        float lsum = 0.f;
        AT_DMA(0, 0); AT_DMA(1, 1);
        AT_WAIT_BAR();
        const int kx0 = (r32 >> 1) & 7, kx1 = ((32 + r32) >> 1) & 7;
        const int vrow = 4 * hi + ((lane >> 2) & 3), vg = (lane >> 4) & 1, vp = lane & 3;
        f32x16 s0, s1;
        { const LAS unsigned char* Kc = lds + c * 8192;
#pragma unroll
          for (int r = 0; r < 16; ++r) { s0[r] = 0.f; s1[r] = 0.f; }
#pragma unroll
          for (int ks = 0; ks < 4; ++ks) { const bf16x8 a0 = *(const LAS bf16x8*)(Kc + r32 * 128 + (((2 * ks + hi) ^ kx0) << 4)), a1 = *(const LAS bf16x8*)(Kc + (32 + r32) * 128 + (((2 * ks + hi) ^ kx1) << 4));
              s0 = mfma32(a0, bq[ks], s0); s1 = mfma32(a1, bq[ks], s1); } }
        int b0 = 0, b1 = 1, b2 = 2;
        f32x16 n0, n1;
#pragma unroll 1
        for (int kt = 0; kt < 64; kt += 2) {
            AT_TILE(s0, s1, n0, n1, kt);
            AT_TILE(n0, n1, s0, s1, kt + 1);
        }
        if (ui < 7) {
#pragma unroll
            for (int ks = 0; ks < 4; ++ks) bq[ks] = *(const bf16x8*)(Q1 + ((size_t)(((bh + 1) * 2 + c) * 4096 + qb * 128 + qt * 32 + r32)) * 64 + ks * 16 + 8 * hi);
        }
        lsum += shx(lsum, lane, 32);
        lbuf[r32] = lsum;
#pragma unroll
        for (int r = 0; r < 16; ++r) { const int qrow = (r & 3) + 8 * (r >> 2) + 4 * hi; const float inv = 1.f / lbuf[qrow];
#pragma unroll
            for (int db = 0; db < 4; ++db) Obuf[(c * 128 + qt * 32 + qrow) * 132 + 32 * db + r32] = Oa[db][r] * inv; }
        __syncthreads();
        { const int row = tid >> 2, qd = tid & 3;
          float dv[32]; float ss = 0.f;
#pragma unroll
          for (int k = 0; k < 8; ++k) { const f32x4 o0 = *(const LAS f32x4*)(Obuf + row * 132 + qd * 32 + 4 * k), o1 = *(const LAS f32x4*)(Obuf + (128 + row) * 132 + qd * 32 + 4 * k);
#pragma unroll
              for (int e = 0; e < 4; ++e) { const float d = o0[e] - lam * o1[e]; dv[4 * k + e] = d; ss += d * d; } }
          ss += shx(ss, lane, 1); ss += shx(ss, lane, 2);
          const float rstd = rsqrtf(ss * (1.f / 128.f) + EPS) * (1.f - LAMBDA_INIT);
          bf16* op = O + ((size_t)b * 4096 + qb * 128 + row) * 1024 + h * 128 + qd * 32;
#pragma unroll
          for (int k = 0; k < 4; ++k) { v4u o;
#pragma unroll
              for (int e = 0; e < 4; ++e) o[e] = pk2(dv[8 * k + 2 * e] * rstd * subln[qd * 32 + 8 * k + 2 * e], dv[8 * k + 2 * e + 1] * rstd * subln[qd * 32 + 8 * k + 2 * e + 1]);
              *(v4u*)(op + 8 * k) = o; } }
        __syncthreads();
    }
    __builtin_amdgcn_s_setprio(0);
}
__device__ __forceinline__ void attn_phase(const int wv, LAS unsigned char* lds, int vcu, const bf16* Q1, const bf16* K1, const bf16* V1, bf16* O, const float* qg, const float* kg,
                                           const float* lq1, const float* lk1, const float* lq2, const float* lk2, const float* subln) {
    float s1 = 0.f, s2 = 0.f, mq = 0.f, mk = 0.f;
    for (int i = 0; i < 64; ++i) { s1 += lq1[i] * lk1[i]; s2 += lq2[i] * lk2[i]; mq = fmaxf(mq, fabsf(qg[i])); mk = fmaxf(mk, fabsf(kg[i])); }
    const float lam = expf(s1) - expf(s2) + LAMBDA_INIT;
    const float offs = 8.f * mq * mk * 1.44269504089f * 1.02f + 0.25f;
    if (offs < 24.f) attn_units<false>(wv, lds, vcu, Q1, K1, V1, O, subln, lam, 0.f);
    else attn_units<true>(wv, lds, vcu, Q1, K1, V1, O, subln, lam, offs);
}
#undef AT_LOAD
#undef AT_WRITE
struct Args { const void* in[27]; float* out; unsigned char* ws; };
#define KARG(i) ({ GAS const void* p_; asm volatile("s_load_dwordx2 %0, %1, %2\n\ts_waitcnt lgkmcnt(0)" : "=s"(p_) : "s"(__builtin_amdgcn_kernarg_segment_ptr()), "i"(8 * (i))); (const void*)p_; })
#define KIN(i) ((const float*)KARG(i))
#define KOUT() ((float*)KARG(27))
#define KWS() ((unsigned char*)KARG(28))
#define WSP(T_, off) ((T_*)(KWS() + (off)))
__global__ void __launch_bounds__(NWAVES * 64, 2) mk_fwd(Args args) {
    extern __shared__ __attribute__((aligned(16))) unsigned char lds_raw[];
    LAS unsigned char* lds = (LAS unsigned char*)lds_raw;
    const int G = gridDim.x, bx = blockIdx.x;
    const int wv = __builtin_amdgcn_readfirstlane((int)(threadIdx.x >> 6));
    const int vcu = (G % 8 == 0) ? (bx % 8) * (G / 8) + bx / 8 : bx;
#define PH_IDS() int ln_; asm volatile("v_mbcnt_lo_u32_b32 %0, -1, 0\n\tv_mbcnt_hi_u32_b32 %0, -1, %0" : "=v"(ln_)); const int lane = ln_, wave = wv, tid = wv * 64 + ln_; \
    const int gw = vcu * NWAVES + wave, NGW = G * NWAVES; const size_t gtid = (size_t)vcu * (NWAVES * 64) + tid, gthreads = (size_t)G * (NWAVES * 64); (void)lane; (void)gw; (void)NGW; (void)gtid; (void)gthreads
    if (threadIdx.x < 32) ((LAS unsigned*)(lds + MISC_OFF))[threadIdx.x] = 0u;
    __syncthreads();
    (void)xcd_barrier_post((unsigned*)(WSP(gu32, WS_CTL) + CW_BAR), (volatile LAS unsigned*)(lds + MISC_OFF) + 8);
#define STAMP() do {} while (0)
#ifndef PROBE_DUP
#define PROBE_DUP 0
#endif
#ifndef PROBE_VAR
#define PROBE_VAR 0
#endif
#ifndef PROBE_MULT
#define PROBE_MULT 1
#endif
#define REPS(bit) _Pragma("unroll 1") for (int rep_ = 0; rep_ < 1 + PROBE_MULT * ((PROBE_DUP >> (bit)) & 1); ++rep_)
#define GRID_BAR1() do { XcdBarrier b_; b_.bar = (unsigned*)(WSP(gu32, WS_CTL) + CW_BAR); b_.x = xb_xcc_id(); b_.st = (volatile LAS unsigned*)(lds + MISC_OFF) + 8; xcd_barrier(b_); } while (0)
#define GRID_BAR() do { GRID_BAR1(); if ((PROBE_DUP >> 9) & 1) GRID_BAR1(); } while (0)

    REPS(5) {
        PH_IDS();
        LAS float* scr = (LAS float*)(lds + wave * 16384);
        constexpr int I0 = 16 * 97, I1 = 16 * 32, I2 = 16 * 64, I3 = 16 * 96, I4 = 16 * 32, I5 = 16 * 64, NITEMS = I0 + I1 + I2 + I3 + I4 + I5;
        for (int it = gw; it < NITEMS - I3 - I4; it += NGW) {
            int r = it;
            if (r < I0) { p0_transpose_item(KIN(3), 1024, 3104, WSP(bf16, WS_WIN), scr, r, lane); continue; } r -= I0;
            if (r < I1) { p0_transpose_item(KIN(6), 1024, 1024, WSP(bf16, WS_WO0), scr, r, lane); continue; } r -= I1;
            if (r < I2) { p0_transpose_item(KIN(8), 1024, 2048, WSP(bf16, WS_WQ0), scr, r, lane); continue; } r -= I2;
            p0_transpose_item(KIN(23), 1024, 2048, WSP(bf16, WS_WQ1), scr, r, lane);
        }
        cvt_range(KIN(9), WSP(bf16, WS_KEY0), (size_t)262144, gtid, gthreads);
        cvt_range(KIN(24), WSP(bf16, WS_KEY1), (size_t)262144, gtid, gthreads);
        rms_pass(KIN(0), KIN(2), WSP(bf16, WS_B0), WSP(unsigned char, WS_R5), WSP(float, WS_SC + 4 * 65536), gw, NGW, lane);
        { const int* positions = (const int*)KARG(1); float* ROPE = WSP(float, WS_ROPE);
          for (size_t id = gtid; id < (size_t)T * 8; id += gthreads) { const size_t mtok = id >> 3; const int i = (int)(id & 7);
            const float inv = powf(500000.0f, -(float)i * 2.0f / 16.0f); const float ang = (float)positions[mtok] * inv;
            float sn, cs; sincosf(ang, &sn, &cs); ROPE[mtok * 16 + i] = cs; ROPE[mtok * 16 + 8 + i] = sn; } }
    }
    GRID_BAR();
    REPS(13) { PH_IDS();
        quant8_rows_bf16(WSP(bf16, WS_WIN), WSP(unsigned char, WS_I8 + 4 * MiB + 512 * 1024), WSP(float, WS_I8 + 4 * MiB + 16384), 3072, gw, NGW, lane);
        gates_rows_mfma(WSP(bf16, WS_B0), WSP(bf16, WS_WIN) + (size_t)3072 * 1024, KIN(4), WSP(float, WS_GATES), gw, lane); }
    GRID_BAR();
    REPS(3) {
        unsigned char* ws = KWS();
        pg8::Gemm g{(const bf16*)(ws + WS_R5), (const bf16*)(ws + WS_I8 + 4 * MiB + 512 * 1024), T, 3072, 512}; pg8::StaticOrder S; S.init(T, 3072, G, bx);
        pg8::EpiInProj E{(bf16*)(ws + WS_R1), (bf16*)(ws + WS_R1 + 32 * MiB), (bf16*)(ws + WS_R2), (bf16*)(ws + WS_R3), (const float*)(ws + WS_SC + 4 * 65536), (const float*)(ws + WS_I8 + 4 * MiB + 16384)};
        pg8::gemm_phase<pg8::EpiInProj, pg8::StaticOrder, true, true>(lds, g, S, E, wv);
    }
    GRID_BAR();
    if ((bx >> 3) & 1) REPS(20) { PH_IDS(); const int gwi = ((bx >> 4) * 8 + (bx & 7)) * NWAVES + wave, NGWI = 128 * NWAVES; (void)gw; (void)NGW;
        { LAS float* scr = (LAS float*)(lds + wave * 16384);
          for (int it = gwi; it < 16 * 96 + 16 * 32; it += NGWI) { if (it < 16 * 96) p0_transpose_item(KIN(13), 1024, 3072, WSP(bf16, WS_WQKV), scr, it, lane, KIN(12), true); else p0_transpose_item(KIN(21), 1024, 1024, WSP(bf16, WS_WO1), scr, it - 16 * 96, lane); } }
        quant4_rows(KIN(10), WSP(unsigned char, WS_U0), WSP(float, WS_SC), 16384, gwi, NGWI, lane);
        quant4_rows(KIN(11), WSP(unsigned char, WS_V0T), WSP(float, WS_SC + 65536), 16384, gwi, NGWI, lane);
        quant4_rows(KIN(25), WSP(unsigned char, WS_U1), WSP(float, WS_SC + 2 * 65536), 16384, gwi, NGWI, lane);
        quant4_rows(KIN(26), WSP(unsigned char, WS_V1T), WSP(float, WS_SC + 3 * 65536), 16384, gwi, NGWI, lane);
        quant8_rows_bf16(WSP(bf16, WS_WQ0), WSP(unsigned char, WS_I8), WSP(float, WS_I8 + 4 * MiB), 2048, gwi, NGWI, lane);
        quant8_rows_bf16(WSP(bf16, WS_WQ1), WSP(unsigned char, WS_I8 + 2 * MiB), WSP(float, WS_I8 + 4 * MiB + 8192), 2048, gwi, NGWI, lane); }
    REPS(2) { unsigned char* ws = KWS(); mlstm_phase2(wv, lds, (const bf16*)(ws + WS_R1), (const bf16*)(ws + WS_R1 + 32 * MiB), (const bf16*)(ws + WS_R2), (const float*)(ws + WS_GATES), (bf16*)(ws + WS_R4), (bf16*)(ws + WS_R5)); }
    GRID_BAR();
    REPS(6) { PH_IDS(); unsigned char* ws = KWS(); hs_pass((const bf16*)(ws + WS_R4), (const bf16*)(ws + WS_R5), (const bf16*)(ws + WS_R3), KIN(5), (bf16*)(ws + WS_B0), gw, NGW, lane); }
    GRID_BAR();
#pragma unroll 1
    for (int L = 0; L < 2; ++L) {
        if (L == 1) {
            REPS(10) {
                unsigned char* ws = KWS();
                pg8::Gemm g{(const bf16*)(ws + WS_R1), (const bf16*)(ws + WS_WQKV), T, 3072, 1024}; pg8::StaticOrder S; S.init(T, 3072, G, bx);
                pg8::EpiQKV E{(bf16*)(ws + WS_R2), (bf16*)(ws + WS_R3), (bf16*)(ws + WS_R4), (const float*)(ws + 3 * MiB), KIN(14), KIN(15), (const float*)(ws + WS_ROPE), (LAS float*)(lds + 131072)};
                pg8::gemm_phase<pg8::EpiQKV, pg8::StaticOrder, true, true>(lds, g, S, E, wv);
            }
            GRID_BAR();
            REPS(0) { unsigned char* ws = KWS(); attn_phase(wv, lds, vcu, (const bf16*)(ws + WS_R2), (const bf16*)(ws + WS_R3), (const bf16*)(ws + WS_R4), (bf16*)(ws + WS_B0), KIN(14), KIN(15), KIN(16), KIN(17), KIN(18), KIN(19), KIN(20)); }
            GRID_BAR();
        }
        _Pragma("unroll 1") for (int rep_ = 0; rep_ < 1 + ((L == 0) ? PROBE_MULT * ((PROBE_DUP >> 12) & 1) : 0); ++rep_) {
            unsigned char* ws = KWS();
            pg8::Gemm g{(const bf16*)(ws + WS_B0), (const bf16*)(ws + (L ? WS_WO1 : WS_WO0)), T, 1024, 1024}; pg8::StaticOrder S; S.init(T, 1024, G, bx);
            if (L == 0) { pg8::EpiRes<false> E{KIN(0), (bf16*)(ws + WS_R1)}; pg8::gemm_phase<pg8::EpiRes<false>, pg8::StaticOrder, true, true>(lds, g, S, E, wv); }
            else { pg8::EpiRes<true> E{ws + WS_R1, (bf16*)(ws + WS_R1)}; pg8::gemm_phase<pg8::EpiRes<true>, pg8::StaticOrder, true, true>(lds, g, S, E, wv); }
        }
        GRID_BAR();
        REPS(7) { PH_IDS(); unsigned char* ws = KWS(); rms_quant_pass((const bf16*)(ws + WS_R1), L ? KIN(22) : KIN(7), (bf16*)(ws + WS_B0), ws + WS_R5, (float*)(ws + WS_SC + 4 * 65536), (float*)(ws + WS_SC + 6 * 65536), gw, NGW, lane); }
        GRID_BAR();
        REPS(11) {
            unsigned char* ws = KWS();
            pg8::Gemm g{(const bf16*)(ws + WS_R5), (const bf16*)(ws + WS_I8 + (L ? 2 : 0) * MiB), T, 2048, 512}; pg8::StaticOrder S; S.init(T, 2048, G, bx);
            pg8::EpiPlainI8 E{(bf16*)(ws + WS_R2), 2048, (const float*)(ws + WS_SC + 4 * 65536), (const float*)(ws + WS_I8 + 4 * MiB + (L ? 8192 : 0))};
            pg8::gemm_phase<pg8::EpiPlainI8, pg8::StaticOrder, true, true>(lds, g, S, E, wv);
        }
        GRID_BAR();
        REPS(4) { unsigned char* ws = KWS(); if (rep_ < PROBE_MULT * ((PROBE_DUP >> 4) & 1)) peer_topk_phase<PROBE_VAR>(wv, lds, vcu, (const bf16*)(ws + WS_R2), (const bf16*)(ws + (L ? WS_KEY1 : WS_KEY0)), (int*)(ws + WS_R4), (float*)(ws + WS_R4 + 16 * MiB)); else peer_topk_phase<0>(wv, lds, vcu, (const bf16*)(ws + WS_R2), (const bf16*)(ws + (L ? WS_KEY1 : WS_KEY0)), (int*)(ws + WS_R4), (float*)(ws + WS_R4 + 16 * MiB)); }
        GRID_BAR();
        REPS(1) { unsigned char* ws = KWS(); peer_g1_phase(wv, vcu, ws + WS_R5, (const int*)(ws + WS_R4), ws + (L ? WS_U1 : WS_U0), (int*)(ws + WS_R2)); }
        GRID_BAR();
        REPS(8) { PH_IDS(); unsigned char* ws = KWS(); const size_t so = L ? 2 * 65536 : 0;
          peer_g1b_phase((const int*)(ws + WS_R2), (const int*)(ws + WS_R4), (const float*)(ws + WS_R4 + 16 * MiB), (const float*)(ws + WS_SC + so), (const float*)(ws + WS_SC + so + 65536),
                         (const float*)(ws + WS_SC + 4 * 65536), (const float*)(ws + WS_SC + 6 * 65536), ws + WS_R4 + 32 * MiB, (float*)(ws + WS_SC + 10 * 65536), (float*)(ws + WS_SC + 8 * 65536), gw, NGW, lane); }
        GRID_BAR();
        if (L == 0) { unsigned char* ws = KWS(); peer_g2_phase<true>(wv, vcu, (const int*)(ws + WS_R4), ws + WS_R4 + 32 * MiB, (const float*)(ws + WS_SC + 10 * 65536), (const float*)(ws + WS_SC + 8 * 65536), ws + WS_V0T, (bf16*)(ws + WS_R1), nullptr, (float*)(ws + 3 * MiB)); GRID_BAR(); }
        else { unsigned char* ws = KWS(); peer_g2_phase<false>(wv, vcu, (const int*)(ws + WS_R4), ws + WS_R4 + 32 * MiB, (const float*)(ws + WS_SC + 10 * 65536), (const float*)(ws + WS_SC + 8 * 65536), ws + WS_V1T, (bf16*)(ws + WS_R1), KOUT(), nullptr); }
    }
#undef GRID_BAR
}

extern "C" void kernel_launch(void* const* d_in, const int* in_sizes, int n_in, void* d_out, int out_size, void* d_ws, size_t ws_size, hipStream_t stream) {
    static int ready = 0;
    if (ready == 0) {
        if (n_in != 27 || out_size != T * D || ws_size < WS_END) { fprintf(stderr, "kernel_launch: unexpected problem (n_in %d, out %d, ws %zu)\n", n_in, out_size, ws_size); ready = -1; return; }
        if (hipFuncSetAttribute((const void*)mk_fwd, hipFuncAttributeMaxDynamicSharedMemorySize, LDS_BYTES) != hipSuccess) { fprintf(stderr, "kernel_launch: hipFuncSetAttribute failed\n"); ready = -1; return; }
        (void)hipGetLastError();
        ready = 1;
    }
    if (ready < 0) return;
    if (hipMemsetAsync((char*)d_ws + WS_CTL, 0, CTL_ZERO_BYTES, stream) != hipSuccess) { fprintf(stderr, "kernel_launch: memset failed\n"); return; }
    Args a{};
    for (int i = 0; i < 27; ++i) a.in[i] = d_in[i];
    a.out = (float*)d_out; a.ws = (unsigned char*)d_ws;
    hipLaunchKernelGGL(mk_fwd, dim3(256), dim3(NWAVES * 64), LDS_BYTES, stream, a);
}
```

```cpp
#include <hip/hip_runtime.h>
#include <hip/hip_bf16.h>
#include <cstdio>
#include <cstdint>
#include <cmath>
namespace pg8 {
#define PG8_LAS __attribute__((address_space(3)))
typedef unsigned short bf16_t;
typedef short bf16x8 __attribute__((ext_vector_type(8)));
typedef float f32x4 __attribute__((ext_vector_type(4)));
typedef unsigned u32x4 __attribute__((ext_vector_type(4)));
constexpr int BM = 256, BK = 64, HALF = 128, HTB = HALF * BK * 2  , STAGE_BYTES = 8 * HTB, NXCD = 8, WGM = 8;

__host__ __device__ __forceinline__ int lds_byte(int r, int c) { const int st = (r >> 4) * 2 + (c >> 5), rr = r & 15, cc = c & 31, ob = rr * 64 + cc * 2; return st * 1024 + (ob ^ (((ob >> 9) & 1) << 5)); }
__host__ __device__ __forceinline__ void stage_rc(int b, int& R, int& C) { const int st = b / 1024, sb = b % 1024, swz = sb ^ (((sb >> 9) & 1) << 5); R = (st >> 1) * 16 + swz / 64; C = (st & 1) * 32 + (swz % 64) / 2; }
__host__ __device__ __forceinline__ int perm32(int rho) { const int n = rho >> 4, i = rho & 15; return 8 * (i >> 2) + 4 * n + (i & 3); }

struct Unit { int pm, pn; };
struct Gemm { const bf16_t* A; const bf16_t* Bt; int M, N, K; };

struct StaticOrder {
    int nM, nN, nwg, G, c;
    __host__ __device__ void init(int M, int N, int G_, int c_) { nM = M / BM; nN = N / BM; nwg = nM * nN; G = G_; c = c_; }
    __host__ __device__ bool next(int i, Unit& u) const {
        const long L = (long)i * G + c; if (L >= nwg) return false;
        int wgid = (int)L; { const int q = nwg / NXCD, r = nwg % NXCD, xcd = wgid % NXCD, off = wgid / NXCD; wgid = (xcd < r ? xcd * (q + 1) : r * (q + 1) + (xcd - r) * q) + off; }
        const int nig = WGM * nN, gid = wgid / nig, fm = gid * WGM, gsz = (nM - fm) < WGM ? (nM - fm) : WGM;
        u.pm = fm + ((wgid % nig) % gsz); u.pn = (wgid % nig) / gsz; return true;
    }
    __device__ __forceinline__ void a_ready(const Unit&) const {}
    __device__ __forceinline__ void done(const Unit&) const {}
};
__device__ __forceinline__ unsigned cvt_pk_bf16(float lo, float hi) { unsigned r; asm volatile("v_cvt_pk_bf16_f32 %0, %1, %2" : "=v"(r) : "v"(lo), "v"(hi)); return r; }
typedef float f32x2 __attribute__((ext_vector_type(2)));
typedef unsigned u32x2 __attribute__((ext_vector_type(2)));
typedef int i32x4 __attribute__((ext_vector_type(4)));
__device__ __forceinline__ u32x4 pack8(const f32x4 v0, const f32x4 v1) { u32x4 w; w.x = cvt_pk_bf16(v0[0], v0[1]); w.y = cvt_pk_bf16(v0[2], v0[3]); w.z = cvt_pk_bf16(v1[0], v1[1]); w.w = cvt_pk_bf16(v1[2], v1[3]); return w; }
struct EpiPlain {
    static constexpr bool PERM = true, AFTER_DRAIN = false, I8 = false;
    bf16_t* O; int ldc;
    __device__ __forceinline__ void operator()(const f32x4 (&acc)[2][2][4][2], const Unit& u, int wr, int wc, int fr, int fq) const {
        const int row0 = u.pm * BM + wr * 64 + fr, col0 = u.pn * BM + wc * 32 + 8 * fq;
#pragma unroll
        for (int ai = 0; ai < 2; ++ai)
#pragma unroll
            for (int m = 0; m < 4; ++m) { bf16_t* rowp = O + (size_t)(row0 + ai * HALF + m * 16) * ldc + col0;
#pragma unroll
                for (int bj = 0; bj < 2; ++bj) *(u32x4*)(rowp + bj * HALF) = pack8(acc[ai][bj][m][0], acc[ai][bj][m][1]); }
    }
};
struct EpiPlainI8 {
    static constexpr bool PERM = true, AFTER_DRAIN = false, I8 = true;
    bf16_t* O; int ldc; const float* rs; const float* cs;
    __device__ __forceinline__ void operator()(const f32x4 (&acc)[2][2][4][2], const Unit& u, int wr, int wc, int fr, int fq) const {
        const int row0 = u.pm * BM + wr * 64 + fr, col0 = u.pn * BM + wc * 32 + 8 * fq;
        f32x4 c0[2], c1[2];
#pragma unroll
        for (int bj = 0; bj < 2; ++bj) { c0[bj] = *(const f32x4*)(cs + col0 + bj * HALF); c1[bj] = *(const f32x4*)(cs + col0 + bj * HALF + 4); }
#pragma unroll
        for (int ai = 0; ai < 2; ++ai)
#pragma unroll
            for (int m = 0; m < 4; ++m) { const int row = row0 + ai * HALF + m * 16; const float r = rs[row]; bf16_t* rowp = O + (size_t)row * ldc + col0;
#pragma unroll
                for (int bj = 0; bj < 2; ++bj) { const i32x4 a0 = __builtin_bit_cast(i32x4, acc[ai][bj][m][0]), a1 = __builtin_bit_cast(i32x4, acc[ai][bj][m][1]);
                    const f32x4 v0 = (f32x4){(float)a0[0], (float)a0[1], (float)a0[2], (float)a0[3]} * r * c0[bj], v1 = (f32x4){(float)a1[0], (float)a1[1], (float)a1[2], (float)a1[3]} * r * c1[bj];
                    *(u32x4*)(rowp + bj * HALF) = pack8(v0, v1); } }
    }
};
struct EpiResI8 {
    static constexpr bool PERM = true, AFTER_DRAIN = false, I8 = true;
    const float* base; bf16_t* out; const float* rs; const float* cs;
    __device__ __forceinline__ void operator()(const f32x4 (&acc)[2][2][4][2], const Unit& u, int wr, int wc, int fr, int fq) const {
        const int col0 = u.pn * BM + wc * 32 + 8 * fq;
        f32x4 c0[2], c1[2];
#pragma unroll
        for (int bj = 0; bj < 2; ++bj) { c0[bj] = *(const f32x4*)(cs + col0 + bj * HALF); c1[bj] = *(const f32x4*)(cs + col0 + bj * HALF + 4); }
#pragma unroll
        for (int ai = 0; ai < 2; ++ai)
#pragma unroll
            for (int m = 0; m < 4; ++m) { const int row = u.pm * BM + ai * HALF + wr * 64 + m * 16 + fr; const size_t off = (size_t)row * 1024 + col0; const float r = rs[row];
#pragma unroll
                for (int bj = 0; bj < 2; ++bj) { const i32x4 a0 = __builtin_bit_cast(i32x4, acc[ai][bj][m][0]), a1 = __builtin_bit_cast(i32x4, acc[ai][bj][m][1]);
                    const f32x4 b0 = *(const f32x4*)(base + off + bj * HALF), b1 = *(const f32x4*)(base + off + bj * HALF + 4);
                    const f32x4 v0 = (f32x4){(float)a0[0], (float)a0[1], (float)a0[2], (float)a0[3]} * r * c0[bj] + b0, v1 = (f32x4){(float)a1[0], (float)a1[1], (float)a1[2], (float)a1[3]} * r * c1[bj] + b1;
                    *(u32x4*)(out + off + bj * HALF) = pack8(v0, v1); } }
    }
};
struct EpiRes1I8 {
    static constexpr bool PERM = true, AFTER_DRAIN = false, I8 = true;
    bf16_t* xr; const float* cs;
    __device__ __forceinline__ void operator()(const f32x4 (&acc)[2][2][4][2], const Unit& u, int wr, int wc, int fr, int fq) const {
        const int col0 = u.pn * BM + wc * 32 + 8 * fq;
        f32x4 c0[2], c1[2];
#pragma unroll
        for (int bj = 0; bj < 2; ++bj) { c0[bj] = *(const f32x4*)(cs + col0 + bj * HALF); c1[bj] = *(const f32x4*)(cs + col0 + bj * HALF + 4); }
#pragma unroll
        for (int ai = 0; ai < 2; ++ai)
#pragma unroll
            for (int m = 0; m < 4; ++m) { const size_t off = (size_t)(u.pm * BM + ai * HALF + wr * 64 + m * 16 + fr) * 1024 + col0;
#pragma unroll
                for (int bj = 0; bj < 2; ++bj) { const i32x4 a0 = __builtin_bit_cast(i32x4, acc[ai][bj][m][0]), a1 = __builtin_bit_cast(i32x4, acc[ai][bj][m][1]);
                    const u32x4 w = *(const u32x4*)(xr + off + bj * HALF);
                    const f32x4 b0 = (f32x4){__uint_as_float(w.x << 16), __uint_as_float(w.x & 0xffff0000u), __uint_as_float(w.y << 16), __uint_as_float(w.y & 0xffff0000u)};
                    const f32x4 b1 = (f32x4){__uint_as_float(w.z << 16), __uint_as_float(w.z & 0xffff0000u), __uint_as_float(w.w << 16), __uint_as_float(w.w & 0xffff0000u)};
                    const f32x4 v0 = (f32x4){(float)a0[0], (float)a0[1], (float)a0[2], (float)a0[3]} * c0[bj] + b0, v1 = (f32x4){(float)a1[0], (float)a1[1], (float)a1[2], (float)a1[3]} * c1[bj] + b1;
                    *(u32x4*)(xr + off + bj * HALF) = pack8(v0, v1); } }
    }
};
template <bool BASE_BF16> struct EpiRes {
    static constexpr bool PERM = true, AFTER_DRAIN = false, I8 = false;
    const void* base; bf16_t* out;
    __device__ __forceinline__ void operator()(const f32x4 (&acc)[2][2][4][2], const Unit& u, int wr, int wc, int fr, int fq) const {
        const int col0 = u.pn * BM + wc * 32 + 8 * fq;
#pragma unroll
        for (int ai = 0; ai < 2; ++ai)
#pragma unroll
            for (int m = 0; m < 4; ++m) { const size_t off = (size_t)(u.pm * BM + ai * HALF + wr * 64 + m * 16 + fr) * 1024 + col0;
#pragma unroll
                for (int bj = 0; bj < 2; ++bj) { f32x4 b0, b1;
                    if (BASE_BF16) { const u32x4 w = *(const u32x4*)((const bf16_t*)base + off + bj * HALF);
                        b0 = (f32x4){__uint_as_float(w.x << 16), __uint_as_float(w.x & 0xffff0000u), __uint_as_float(w.y << 16), __uint_as_float(w.y & 0xffff0000u)};
                        b1 = (f32x4){__uint_as_float(w.z << 16), __uint_as_float(w.z & 0xffff0000u), __uint_as_float(w.w << 16), __uint_as_float(w.w & 0xffff0000u)}; }
                    else { b0 = *(const f32x4*)((const float*)base + off + bj * HALF); b1 = *(const f32x4*)((const float*)base + off + bj * HALF + 4); }
                    *(u32x4*)(out + off + bj * HALF) = pack8(b0 + acc[ai][bj][m][0], b1 + acc[ai][bj][m][1]); } }
    }
};
struct EpiInProj {
    static constexpr bool PERM = true, AFTER_DRAIN = false, I8 = true;
    bf16_t *Q, *Kk, *V, *OG; const float* rs; const float* cs;
    __device__ __forceinline__ void operator()(const f32x4 (&acc)[2][2][4][2], const Unit& u, int wr, int wc, int fr, int fq) const {
        const int colt = u.pn * BM;
#pragma unroll
        for (int ai = 0; ai < 2; ++ai)
#pragma unroll
            for (int m = 0; m < 4; ++m) { const int row = u.pm * BM + ai * HALF + wr * 64 + m * 16 + fr, b = row >> 12, s = row & 4095; const float rsc = rs[row];
#pragma unroll
                for (int bj = 0; bj < 2; ++bj) { const int cb = colt + bj * HALF + wc * 32 + 8 * fq; const i32x4 a0 = __builtin_bit_cast(i32x4, acc[ai][bj][m][0]), a1 = __builtin_bit_cast(i32x4, acc[ai][bj][m][1]);
                    f32x4 v0 = (f32x4){(float)a0[0], (float)a0[1], (float)a0[2], (float)a0[3]} * rsc * *(const f32x4*)(cs + cb), v1 = (f32x4){(float)a1[0], (float)a1[1], (float)a1[2], (float)a1[3]} * rsc * *(const f32x4*)(cs + cb + 4);
                    if (colt < 1024) { const bool isq = colt < 512; bf16_t* base = isq ? Q : Kk; const int c2 = cb & 511, head = c2 >> 6, d = c2 & 63;
                        if (isq) { v0 = v0 * 0.125f; v1 = v1 * 0.125f; }
                        *(u32x4*)(base + ((size_t)((b * 8 + head) * 4096 + s)) * 64 + d) = pack8(v0, v1); }
                    else if (colt < 2048) { const int c2 = cb - 1024, head = c2 >> 7, dv = c2 & 127; *(u32x4*)(V + ((size_t)((b * 8 + head) * 4096 + s)) * 128 + dv) = pack8(v0, v1); }
                    else if (colt < 3072) { *(u32x4*)(OG + (size_t)row * 1024 + (cb - 2048)) = pack8(v0, v1); } } }
    }
};
struct EpiQKV {
    static constexpr bool PERM = true, AFTER_DRAIN = false, I8 = false;
    bf16_t *Q, *Kk, *V; const float* SS; const float* qg; const float* kg; const float* rope; PG8_LAS float* xch;
    __device__ __forceinline__ void operator()(const f32x4 (&acc)[2][2][4][2], const Unit& u, int wr, int wc, int fr_, int fq_) const {
        int fr = fr_, fq = fq_; asm volatile("" : "+v"(fr), "+v"(fq));
        const int colt = u.pn * BM, lane = fq * 16 + fr, wave = wr * 4 + wc;
        if (colt >= 2048) {
            float rsr[2][4];
#pragma unroll
            for (int ai = 0; ai < 2; ++ai)
#pragma unroll
                for (int m = 0; m < 4; ++m) { const int row = u.pm * BM + ai * HALF + wr * 64 + m * 16 + fr;
                    rsr[ai][m] = __builtin_amdgcn_rsqf(((SS[row] + SS[32768 + row]) + (SS[2 * 32768 + row] + SS[3 * 32768 + row])) * (1.f / 1024.f) + 1e-6f); }
#pragma unroll
            for (int ai = 0; ai < 2; ++ai)
#pragma unroll
                for (int m = 0; m < 4; ++m) { const int row = u.pm * BM + ai * HALF + wr * 64 + m * 16 + fr, b = row >> 12, s = row & 4095; const float rs = rsr[ai][m];
#pragma unroll
                    for (int bj = 0; bj < 2; ++bj) { const int cb = colt + bj * HALF + wc * 32 + 8 * fq; const int c2 = cb - 2048, head = c2 >> 7, dv = c2 & 127;
                        *(u32x4*)(V + ((size_t)((b * 8 + head) * 4096 + s)) * 128 + dv) = pack8(acc[ai][bj][m][0] * rs, acc[ai][bj][m][1] * rs); } }
            return;
        }
        PG8_LAS float* const ropeL = xch + 2048; PG8_LAS float* const rsrL = xch + 2048 + 256 * 20;
        const int tid = wave * 64 + lane;
        const float* const rsrc = rope + ((size_t)(u.pm * BM + (tid >> 1))) * 16 + (tid & 1) * 8;
        const f32x4 st0 = *(const f32x4*)rsrc, st1 = *(const f32x4*)(rsrc + 4);
        float sq0 = 0.f, sq1 = 0.f, sq2 = 0.f, sq3 = 0.f;
        if (tid < 256) { const int row = u.pm * BM + tid; sq0 = SS[row]; sq1 = SS[32768 + row]; sq2 = SS[2 * 32768 + row]; sq3 = SS[3 * 32768 + row]; }
        {
            float sv[16];
#pragma unroll
            for (int ai = 0; ai < 2; ++ai)
#pragma unroll
                for (int m = 0; m < 4; ++m)
#pragma unroll
                    for (int bj = 0; bj < 2; ++bj) { const f32x4 a = acc[ai][bj][m][0], c = acc[ai][bj][m][1];
                        sv[(ai * 4 + m) * 2 + bj] = ((a[0] * a[0] + a[1] * a[1]) + (a[2] * a[2] + a[3] * a[3])) + ((c[0] * c[0] + c[1] * c[1]) + (c[2] * c[2] + c[3] * c[3])); }
#pragma unroll
            for (int k = 0; k < 8; ++k) { const auto r = __builtin_amdgcn_permlane16_swap(__float_as_uint(sv[k]), __float_as_uint(sv[k + 8]), false, false); sv[k] = __uint_as_float(r[0]) + __uint_as_float(r[1]); }
#pragma unroll
            for (int k = 0; k < 4; ++k) { const auto r = __builtin_amdgcn_permlane32_swap(__float_as_uint(sv[k]), __float_as_uint(sv[k + 4]), false, false); sv[k] = __uint_as_float(r[0]) + __uint_as_float(r[1]); }
#pragma unroll
            for (int k = 0; k < 4; ++k) xch[(wave * 16 + k + 8 * (fq & 1) + 4 * (fq >> 1)) * 16 + fr] = sv[k];
        }
        *(PG8_LAS f32x4*)(ropeL + (tid >> 1) * 20 + (tid & 1) * 8) = st0; *(PG8_LAS f32x4*)(ropeL + (tid >> 1) * 20 + (tid & 1) * 8 + 4) = st1;
        if (tid < 256) rsrL[tid] = __builtin_amdgcn_rsqf(((sq0 + sq1) + (sq2 + sq3)) * (1.f / 1024.f) + 1e-6f);
        __syncthreads();
        const bool isq = colt < 1024; bf16_t* base = isq ? Q : Kk; const float* gn = isq ? qg : kg; const float osc = isq ? (0.125f * 1.44269504089f) : 1.f;
        const int d0 = 32 * (wc & 1) + 8 * fq;
        const bool rot = ((wc & 1) == 0) && (fq < 2);
        const f32x4 g0 = *(const f32x4*)(gn + (rot ? 4 * fq : d0)), g1 = *(const f32x4*)(gn + (rot ? 8 + 4 * fq : d0 + 4));
#pragma unroll
        for (int ai = 0; ai < 2; ++ai)
#pragma unroll
            for (int m = 0; m < 4; ++m) { const int lrow = ai * HALF + wr * 64 + m * 16 + fr, row = u.pm * BM + lrow, b = row >> 12, s = row & 4095;
                const float rs = rsrL[lrow];
                f32x4 co = {1.f, 1.f, 1.f, 1.f}, si = {0.f, 0.f, 0.f, 0.f};
                if (rot) { const PG8_LAS float* cs = ropeL + lrow * 20 + 4 * fq; co = *(const PG8_LAS f32x4*)cs; si = *(const PG8_LAS f32x4*)(cs + 8); }
#pragma unroll
                for (int bj = 0; bj < 2; ++bj) { const float tot = xch[(((wave * 2 + ai) * 4 + m) * 2 + bj) * 16 + fr] + xch[((((wave ^ 1) * 2 + ai) * 4 + m) * 2 + bj) * 16 + fr];
                    const float rn = __builtin_amdgcn_rsqf(tot * (rs * rs) * (1.f / 64.f) + 1e-6f) * rs;
                    const f32x4 x0 = acc[ai][bj][m][0] * rn * g0, x1 = acc[ai][bj][m][1] * rn * g1;
                    const f32x4 y0 = x0 * co - x1 * si, y1 = x1 * co + x0 * si;
                    const int cb = colt + bj * HALF + wc * 32 + 8 * fq; const int c2 = cb & 1023, head = c2 >> 7, c = (c2 >> 6) & 1, d = c2 & 63;
                    *(u32x4*)(base + ((size_t)(((b * 8 + head) * 2 + c) * 4096 + s)) * 64 + d) = pack8(y0 * osc, y1 * osc); } }
    }
};

template <bool I8> __device__ __forceinline__ f32x4 mma_sel(bf16x8 a, bf16x8 b, f32x4 c) {
    if constexpr (I8) return __builtin_bit_cast(f32x4, __builtin_amdgcn_mfma_i32_16x16x64_i8(__builtin_bit_cast(i32x4, a), __builtin_bit_cast(i32x4, b), __builtin_bit_cast(i32x4, c), 0, 0, 0));
    else return __builtin_amdgcn_mfma_f32_16x16x32_bf16(a, b, c, 0, 0, 0);
}
template <class Epi, class Sched, bool ALIGN_EPI = false, bool SP2 = false>
__device__ __forceinline__ void gemm_phase(PG8_LAS unsigned char* lds, const Gemm g, const Sched& S, const Epi& E, const int wv) {
    int ln_; asm volatile("v_mbcnt_lo_u32_b32 %0, -1, 0\n\tv_mbcnt_hi_u32_b32 %0, -1, %0" : "=v"(ln_)); const int tid = wv * 64 + ln_, wid = wv, lane = tid & 63, wr = wid >> 2, wc = wid & 3, fr = lane & 15, fq = lane >> 4;
    const int K = g.K, nt = K / BK;
    unsigned voffA[2], voffB[2];
#pragma unroll
    for (int i = 0; i < 2; ++i) { int R, C; stage_rc(tid * 16 + i * 8192, R, C); const int Rb = Epi::PERM ? ((R & ~31) + perm32(R & 31)) : R;
        voffA[i] = (unsigned)(R * K + C) * 2u; voffB[i] = (unsigned)(Rb * K + C) * 2u; }
    const size_t kstep = (size_t)(BK * 2);
    const size_t hstep = (size_t)HALF * K * 2;
    const size_t tstep = 2 * hstep;
    const unsigned ldsw = (unsigned)wid * 1024u;
    const int aoff = lds_byte(wr * 64 + fr, fq * 8), boff = lds_byte(wc * 32 + fr, fq * 8);
#define PG8_SA(b, h) (((b) * 2 + (h)) * HTB)
#define PG8_SB(b, h) ((4 + (b) * 2 + (h)) * HTB)
#define PG8_STAGE(bufoff, gbase, voff) do { _Pragma("unroll") for (int _i = 0; _i < 2; ++_i) \
        __builtin_amdgcn_global_load_lds((const unsigned*)((const char*)(gbase) + (voff)[_i]), (PG8_LAS unsigned*)(lds + (bufoff) + ldsw + _i * 8192), 16, 0, 0); } while (0)
#define PG8_LDA(dst, b, h) do { _Pragma("unroll") for (int m = 0; m < 4; ++m) _Pragma("unroll") for (int k = 0; k < 2; ++k) dst[m][k] = *(const PG8_LAS bf16x8*)(lds + PG8_SA(b, h) + aoff + m * 2048 + k * 1024); } while (0)
#define PG8_LDB(dst, b, h) do { _Pragma("unroll") for (int n = 0; n < 2; ++n) _Pragma("unroll") for (int k = 0; k < 2; ++k) dst[n][k] = *(const PG8_LAS bf16x8*)(lds + PG8_SB(b, h) + boff + n * 2048 + k * 1024); } while (0)
#define PG8_MMA(ai, bj, At, Bt) do { __builtin_amdgcn_s_setprio(1); _Pragma("unroll") for (int m = 0; m < 4; ++m) _Pragma("unroll") for (int n = 0; n < 2; ++n) _Pragma("unroll") for (int k = 0; k < 2; ++k) \
        acc[ai][bj][m][n] = mma_sel<Epi::I8>(Bt[n][k], At[m][k], acc[ai][bj][m][n]); __builtin_amdgcn_s_setprio(0); } while (0)
#define PG8_WAIT_V(n) asm volatile("s_waitcnt vmcnt(" #n ")" ::: "memory")
#define PG8_WAIT_L(n) asm volatile("s_waitcnt lgkmcnt(" #n ")" ::: "memory")
#define PG8_BAR __builtin_amdgcn_s_barrier()
#define PG8_SCHED __builtin_amdgcn_sched_barrier(0)
    Unit cur, nxt; int ui = 0;
    if (!S.next(0, cur)) return;
    f32x4 acc[2][2][4][2];
#pragma unroll
    for (int a = 0; a < 2; ++a)
#pragma unroll
        for (int b = 0; b < 2; ++b)
#pragma unroll
            for (int m = 0; m < 4; ++m)
#pragma unroll
                for (int n = 0; n < 2; ++n) acc[a][b][m][n] = (f32x4){0.f, 0.f, 0.f, 0.f};
    bf16x8 At[4][2], B0[2][2], B1[2][2];
    const char* cA = (const char*)g.A + (size_t)cur.pm * tstep; const char* cB = (const char*)g.Bt + (size_t)cur.pn * tstep;
    S.a_ready(cur);
    if constexpr (SP2) {
        PG8_STAGE(PG8_SB(0, 0), cB, voffB); PG8_STAGE(PG8_SB(0, 1), cB + hstep, voffB); PG8_STAGE(PG8_SA(0, 0), cA, voffA); PG8_STAGE(PG8_SA(0, 1), cA + hstep, voffA);
        if (wr == 1) PG8_BAR;
        PG8_WAIT_V(2); PG8_BAR;
        PG8_STAGE(PG8_SB(1, 0), cB + kstep, voffB); PG8_STAGE(PG8_SA(1, 0), cA + kstep, voffA); PG8_STAGE(PG8_SB(1, 1), cB + hstep + kstep, voffB);
        PG8_WAIT_V(6); PG8_BAR;
    } else {
        PG8_STAGE(PG8_SB(0, 0), cB, voffB); PG8_STAGE(PG8_SA(0, 0), cA, voffA); PG8_STAGE(PG8_SB(0, 1), cB + hstep, voffB); PG8_STAGE(PG8_SA(0, 1), cA + hstep, voffA);
        if (wr == 1) PG8_BAR;
        PG8_WAIT_V(4); PG8_BAR;
        PG8_STAGE(PG8_SB(1, 0), cB + kstep, voffB); PG8_STAGE(PG8_SA(1, 0), cA + kstep, voffA); PG8_STAGE(PG8_SB(1, 1), cB + hstep + kstep, voffB);
        PG8_WAIT_V(6); PG8_BAR;
    }
    for (;;) {
        const bool has_next = S.next(ui + 1, nxt);
        const char* nA = has_next ? (const char*)g.A + (size_t)nxt.pm * tstep : cA; const char* nB = has_next ? (const char*)g.Bt + (size_t)nxt.pn * tstep : cB;
        for (int t = 0; t < nt; t += 2) {
            const bool last = (t == nt - 2);
            const char* a1 = cA + (size_t)(t + 1) * kstep;
            const char* a2 = last ? nA : cA + (size_t)(t + 2) * kstep; const char* b2 = last ? nB : cB + (size_t)(t + 2) * kstep;
            const char* a3 = a2 + kstep; const char* b3 = b2 + kstep;
            if (last && has_next) S.a_ready(nxt);
            if constexpr (SP2) {
            PG8_LDB(B0, 0, 0); PG8_LDB(B1, 0, 1); PG8_SCHED; PG8_LDA(At, 0, 0); PG8_STAGE(PG8_SA(1, 1), a1 + hstep, voffA);
            PG8_WAIT_V(8); PG8_WAIT_L(0); PG8_BAR; PG8_MMA(0, 0, At, B0); PG8_MMA(0, 1, At, B1); PG8_BAR; PG8_SCHED;
            PG8_LDA(At, 0, 1); PG8_STAGE(PG8_SB(0, 0), b2, voffB); PG8_STAGE(PG8_SB(0, 1), b2 + hstep, voffB); PG8_STAGE(PG8_SA(0, 0), a2, voffA);
            PG8_WAIT_V(8); PG8_WAIT_L(0); PG8_BAR; PG8_MMA(1, 0, At, B0); PG8_MMA(1, 1, At, B1); PG8_BAR; PG8_SCHED;
            PG8_LDB(B0, 1, 0); PG8_LDB(B1, 1, 1); PG8_SCHED; PG8_LDA(At, 1, 0); PG8_STAGE(PG8_SA(0, 1), a2 + hstep, voffA);
            PG8_WAIT_V(8); PG8_WAIT_L(0); PG8_BAR; PG8_MMA(0, 0, At, B0); PG8_MMA(0, 1, At, B1); PG8_BAR; PG8_SCHED;
            PG8_LDA(At, 1, 1); PG8_STAGE(PG8_SB(1, 0), b3, voffB); PG8_STAGE(PG8_SB(1, 1), b3 + hstep, voffB); PG8_STAGE(PG8_SA(1, 0), a3, voffA);
            PG8_WAIT_V(8); PG8_WAIT_L(0); PG8_BAR; PG8_MMA(1, 0, At, B0); PG8_MMA(1, 1, At, B1); PG8_BAR; PG8_SCHED;
            } else {
            PG8_LDB(B0, 0, 0); PG8_SCHED; PG8_LDA(At, 0, 0); PG8_STAGE(PG8_SA(1, 1), a1 + hstep, voffA);
            PG8_WAIT_L(8); PG8_BAR; PG8_WAIT_L(0); PG8_MMA(0, 0, At, B0); PG8_BAR; PG8_SCHED;
            PG8_LDB(B1, 0, 1); PG8_STAGE(PG8_SB(0, 0), b2, voffB);
            PG8_BAR; PG8_WAIT_L(0); PG8_MMA(0, 1, At, B1); PG8_BAR;
            PG8_LDA(At, 0, 1); PG8_STAGE(PG8_SA(0, 0), a2, voffA);
            PG8_BAR; PG8_WAIT_L(0); PG8_MMA(1, 0, At, B0); PG8_BAR; PG8_SCHED;
            PG8_STAGE(PG8_SB(0, 1), b2 + hstep, voffB);
            PG8_WAIT_V(6); PG8_BAR; PG8_MMA(1, 1, At, B1); PG8_BAR;
            PG8_LDB(B0, 1, 0); PG8_SCHED; PG8_LDA(At, 1, 0); PG8_STAGE(PG8_SA(0, 1), a2 + hstep, voffA);
            PG8_WAIT_L(8); PG8_BAR; PG8_WAIT_L(0); PG8_MMA(0, 0, At, B0); PG8_BAR; PG8_SCHED;
            PG8_LDB(B1, 1, 1); PG8_STAGE(PG8_SB(1, 0), b3, voffB);
            PG8_BAR; PG8_WAIT_L(0); PG8_MMA(0, 1, At, B1); PG8_BAR;
            PG8_LDA(At, 1, 1); PG8_STAGE(PG8_SA(1, 0), a3, voffA);
            PG8_BAR; PG8_WAIT_L(0); PG8_MMA(1, 0, At, B0); PG8_BAR; PG8_SCHED;
            PG8_STAGE(PG8_SB(1, 1), b3 + hstep, voffB);
            PG8_WAIT_V(6); PG8_BAR; PG8_MMA(1, 1, At, B1); PG8_BAR;
            }
        }
        if constexpr (ALIGN_EPI) { if (wr == 0) PG8_BAR; }
        if constexpr (!Epi::AFTER_DRAIN) { E(acc, cur, wr, wc, fr, fq); S.done(cur); }
        if (!has_next) break;
#pragma unroll
        for (int a = 0; a < 2; ++a)
#pragma unroll
            for (int b = 0; b < 2; ++b)
#pragma unroll
                for (int m = 0; m < 4; ++m)
#pragma unroll
                    for (int n = 0; n < 2; ++n) acc[a][b][m][n] = (f32x4){0.f, 0.f, 0.f, 0.f};
        cur = nxt; cA = nA; cB = nB; ++ui;
        if constexpr (ALIGN_EPI) { if (wr == 1) PG8_BAR; }
    }
    PG8_WAIT_V(0);
    if constexpr (!ALIGN_EPI) { if (wr == 0) PG8_BAR; }
    PG8_BAR;
    if constexpr (Epi::AFTER_DRAIN) { E.fused(acc, cur, wr, wc, fr, fq, lds, wid, lane); S.done(cur); }
#undef PG8_SA
#undef PG8_SB
#undef PG8_STAGE
#undef PG8_LDA
#undef PG8_LDB
#undef PG8_MMA
#undef PG8_WAIT_V
#undef PG8_WAIT_L
#undef PG8_BAR
#undef PG8_SCHED
}
}
#define GAS __attribute__((address_space(1)))
#define LAS __attribute__((address_space(3)))
typedef unsigned short bf16;
typedef unsigned v4u __attribute__((ext_vector_type(4)));
typedef float f32x4 __attribute__((ext_vector_type(4)));
typedef short bf16x8 __attribute__((ext_vector_type(8)));
typedef GAS unsigned gu32;
typedef GAS unsigned long long gu64;
#define RLX_AGENT __ATOMIC_RELAXED, __HIP_MEMORY_SCOPE_AGENT
#define LDS_WAIT() asm volatile("s_waitcnt lgkmcnt(0)" ::: "memory")
#define VM_WAIT() asm volatile("s_waitcnt vmcnt(0)" ::: "memory")
__device__ __forceinline__ unsigned long long rt() { return __builtin_amdgcn_s_memrealtime(); }
typedef float f32x2_cv __attribute__((ext_vector_type(2))); typedef __bf16 bf16x2_cv __attribute__((ext_vector_type(2)));
__device__ __forceinline__ unsigned pk2(float lo, float hi) { const f32x2_cv v = {lo, hi}; const bf16x2_cv b = __builtin_convertvector(v, bf16x2_cv); return __builtin_bit_cast(unsigned, b); }
__device__ __forceinline__ unsigned f2bf(float f) { return pk2(f, 0.f) & 0xffffu; }

#define XB_TMO      128
#define XB_XCNT(j)  (256  + 64 * (j))
#define XB_XSUB(j)  (1280 + 64 * (j))
#define XB_XGEN(j)  (2304 + 64 * (j))
#define XB_TOP      3328
#define XB_TOPGEN   3392
#define XCD_BAR_WORDS 3456
#define XB_SPIN_CAP (1u << 18)

__device__ __forceinline__ unsigned xb_ld(unsigned* p)              { return __hip_atomic_load(p, __ATOMIC_RELAXED, __HIP_MEMORY_SCOPE_AGENT); }
__device__ __forceinline__ unsigned xb_add(unsigned* p, unsigned v) { return __hip_atomic_fetch_add(p, v, __ATOMIC_RELAXED, __HIP_MEMORY_SCOPE_AGENT); }
__device__ __forceinline__ unsigned xb_xcc_id() { return (unsigned)__builtin_amdgcn_s_getreg((3 << 11) | 20) & 0xFu; }
#define XB_SPIN(cond, bar) do { unsigned _sp = 0; while (cond) { __builtin_amdgcn_s_sleep(1); \
    if ((++_sp & 255u) == 0u) { if (xb_ld(&(bar)[XB_TMO])) break; if (_sp > XB_SPIN_CAP) { atomicAdd(&(bar)[XB_TMO], 1u); break; } } } } while (0)

struct XcdBarrier {
    unsigned* bar; unsigned x;
    volatile LAS unsigned* st;
};

__device__ __forceinline__ XcdBarrier xcd_barrier_post(unsigned* bar, volatile LAS unsigned* st) {
    XcdBarrier b; b.bar = bar; b.x = xb_xcc_id(); b.st = st;
    if (threadIdx.x == 0) (void)xb_add(&bar[XB_XCNT(b.x)], 1u);
    return b;
}
__device__ __forceinline__ void xcd_barrier_complete(unsigned* bar, unsigned x, unsigned& nloc, unsigned& nx) {
    const unsigned G = gridDim.x * gridDim.y * gridDim.z;
    unsigned sum, cnt, mine, sp = 0u;
    for (;;) {
        sum = 0u; cnt = 0u; mine = 0u;
#pragma unroll
        for (unsigned j = 0; j < 16; ++j) { const unsigned c = xb_ld(&bar[XB_XCNT(j)]); sum += c; cnt += (c > 0u) ? 1u : 0u; mine = (j == x) ? c : mine; }
        if (sum == G) break;
        __builtin_amdgcn_s_sleep(1);
        if ((++sp & 255u) == 0u) { if (xb_ld(&bar[XB_TMO])) break; if (sp > XB_SPIN_CAP) { atomicAdd(&bar[XB_TMO], 1u); break; } }
    }
    nloc = mine > 0u ? mine : 1u; nx = cnt > 0u ? cnt : 1u;
}

__device__ __forceinline__ void xcd_barrier(const XcdBarrier& b) {
    asm volatile("s_waitcnt vmcnt(0)" ::: "memory");
    __syncthreads();
    if (threadIdx.x == 0) {
        unsigned* bar = b.bar;
        __builtin_amdgcn_s_waitcnt(0);
        unsigned nloc = b.st[0], nx = b.st[1];
        if (nloc == 0u) { xcd_barrier_complete(bar, b.x, nloc, nx); b.st[0] = nloc; b.st[1] = nx; }
        const unsigned old = xb_add(&bar[XB_XSUB(b.x)], 1u);
        const unsigned gen = old / nloc;
        asm volatile("buffer_inv sc1" ::: "memory");
        if (old + 1u == (gen + 1u) * nloc) {
            __builtin_amdgcn_fence(__ATOMIC_RELEASE, "agent");
            asm volatile("s_waitcnt vmcnt(0)" ::: "memory");
            const unsigned og = xb_add(&bar[XB_TOP], 1u);
            const unsigned tg = og / nx;
            if (og + 1u == (tg + 1u) * nx) xb_add(&bar[XB_TOPGEN], 1u);
            else XB_SPIN(xb_ld(&bar[XB_TOPGEN]) == tg, bar);
            xb_add(&bar[XB_XGEN(b.x)], 1u);
            asm volatile("s_waitcnt vmcnt(0)" ::: "memory");
        } else {
            XB_SPIN(xb_ld(&bar[XB_XGEN(b.x)]) == gen, bar);
            asm volatile("s_waitcnt vmcnt(0)" ::: "memory");
        }
    }
    __syncthreads();
}
constexpr int NWAVES = 8;
constexpr int T = 32768, D = 1024, SEQ = 4096;
constexpr float EPS = 1e-6f;
constexpr float LAMBDA_INIT = 0.35550906759f;
constexpr size_t MiB = 1u << 20;
constexpr size_t WS_CTL = 0, CTL_ZERO_BYTES = 64 * 1024;
constexpr size_t WS_ROPE = 1 * MiB;
constexpr size_t WS_WIN = 4 * MiB;
constexpr size_t WS_WO0 = 11 * MiB, WS_WQ0 = 13 * MiB, WS_KEY0 = 17 * MiB, WS_WQKV = 18 * MiB, WS_WO1 = 24 * MiB, WS_WQ1 = 26 * MiB, WS_KEY1 = 30 * MiB;
constexpr size_t WS_SC = 31 * MiB;
constexpr size_t WS_U0 = 32 * MiB, WS_V0T = 48 * MiB, WS_U1 = 64 * MiB, WS_V1T = 80 * MiB;
constexpr size_t WS_B0 = 96 * MiB;
constexpr size_t WS_R1 = 160 * MiB, WS_R2 = 224 * MiB, WS_R3 = 288 * MiB, WS_R4 = 352 * MiB, WS_R5 = 416 * MiB, WS_GATES = 480 * MiB;
constexpr size_t WS_I8 = 484 * MiB;
constexpr size_t WS_END = 492 * MiB;
constexpr int CW_BAR = 4096;
constexpr int LDS_BYTES = 163840, MISC_OFF = LDS_BYTES - 128;

typedef float f32x16 __attribute__((ext_vector_type(16)));
typedef unsigned u32x2 __attribute__((ext_vector_type(2)));
typedef __bf16 bf16x2_t __attribute__((ext_vector_type(2)));
__device__ __forceinline__ float bf_lo(unsigned w) { return __uint_as_float(w << 16); }
__device__ __forceinline__ float bf_hi(unsigned w) { return __uint_as_float(w & 0xffff0000u); }
__device__ __forceinline__ float dot2(unsigned a, unsigned b, float c) { return __builtin_amdgcn_fdot2_f32_bf16(__builtin_bit_cast(bf16x2_t, a), __builtin_bit_cast(bf16x2_t, b), c, false); }
__device__ __forceinline__ float shx(float v, int lane, int m) { return __uint_as_float((unsigned)__builtin_amdgcn_ds_bpermute((lane ^ m) << 2, (int)__float_as_uint(v))); }
__device__ __forceinline__ int shxi(int v, int lane, int m) { return __builtin_amdgcn_ds_bpermute((lane ^ m) << 2, v); }
#define DPP_STEP_F(v, op, ctrl, rmask, ident) v = op(v, __uint_as_float((unsigned)__builtin_amdgcn_update_dpp((int)__float_as_uint(ident), (int)__float_as_uint(v), ctrl, rmask, 0xF, false)))
__device__ __forceinline__ float fadd_(float a, float b) { return a + b; }
__device__ __forceinline__ float wave_sum(float v, int lane) { (void)lane;
    DPP_STEP_F(v, fadd_, 0x111, 0xF, 0.f); DPP_STEP_F(v, fadd_, 0x112, 0xF, 0.f); DPP_STEP_F(v, fadd_, 0x114, 0xF, 0.f); DPP_STEP_F(v, fadd_, 0x118, 0xF, 0.f);
    DPP_STEP_F(v, fadd_, 0x142, 0xA, 0.f); DPP_STEP_F(v, fadd_, 0x143, 0xC, 0.f);
    return __uint_as_float((unsigned)__builtin_amdgcn_readlane((int)__float_as_uint(v), 63));
}
__device__ __forceinline__ float wave_max0(float v) {
    DPP_STEP_F(v, fmaxf, 0x111, 0xF, 0.f); DPP_STEP_F(v, fmaxf, 0x112, 0xF, 0.f); DPP_STEP_F(v, fmaxf, 0x114, 0xF, 0.f); DPP_STEP_F(v, fmaxf, 0x118, 0xF, 0.f);
    DPP_STEP_F(v, fmaxf, 0x142, 0xA, 0.f); DPP_STEP_F(v, fmaxf, 0x143, 0xC, 0.f);
    return __uint_as_float((unsigned)__builtin_amdgcn_readlane((int)__float_as_uint(v), 63));
}
__device__ __forceinline__ int wave_sumi(int v) {
#define DPP_STEP_I(ctrl, rmask) v += __builtin_amdgcn_update_dpp(0, v, ctrl, rmask, 0xF, false)
    DPP_STEP_I(0x111, 0xF); DPP_STEP_I(0x112, 0xF); DPP_STEP_I(0x114, 0xF); DPP_STEP_I(0x118, 0xF); DPP_STEP_I(0x142, 0xA); DPP_STEP_I(0x143, 0xC);
#undef DPP_STEP_I
    return __builtin_amdgcn_readlane(v, 63);
}
__device__ __forceinline__ f32x4 mfma16(bf16x8 a, bf16x8 b, f32x4 c) { return __builtin_amdgcn_mfma_f32_16x16x32_bf16(a, b, c, 0, 0, 0); }
__device__ __forceinline__ f32x16 mfma32(bf16x8 a, bf16x8 b, f32x16 c) { return __builtin_amdgcn_mfma_f32_32x32x16_bf16(a, b, c, 0, 0, 0); }
__device__ __forceinline__ u32x2 pack4(float a, float b, float c, float d) { u32x2 r; r.x = pk2(a, b); r.y = pk2(c, d); return r; }

__device__ __forceinline__ void p0_transpose_item(const float* W, int K, int N, bf16* WT, LAS float* scr, int item, int lane, const float* kscale = nullptr, bool permqk = false) {
    const int nblk = N / 32, kb = item / nblk, nb = item % nblk, k0 = 64 * kb, n0 = 32 * nb;
#pragma unroll 8
    for (int i = 0; i < 32; ++i) { const int kk = 2 * i + (lane >> 5); const float sc = kscale ? kscale[k0 + kk] : 1.f; scr[kk * 33 + (lane & 31)] = W[(size_t)(k0 + kk) * N + n0 + (lane & 31)] * sc; }
    LDS_WAIT(); asm volatile("" ::: "memory");
    const int c = lane & 7;
#pragma unroll
    for (int j = 0; j < 4; ++j) { const int n = (lane >> 3) + 8 * j; const LAS float* s = scr + (8 * c) * 33 + n;
        v4u o; o.x = pk2(s[0 * 33], s[1 * 33]); o.y = pk2(s[2 * 33], s[3 * 33]); o.z = pk2(s[4 * 33], s[5 * 33]); o.w = pk2(s[6 * 33], s[7 * 33]);
        int nd = n0 + n; if (permqk && nd < 2048 && (nd & 63) < 16 && ((nd & 15) >> 2) != 0 && ((nd & 15) >> 2) != 3) nd ^= 12;
        *(v4u*)(WT + (size_t)nd * K + k0 + 8 * c) = o; }
    LDS_WAIT(); asm volatile("" ::: "memory");
}
__device__ __forceinline__ void cvt_range(const float* src, bf16* dst, size_t n, size_t gtid, size_t gthreads) {
    for (size_t i = gtid * 8; i < n; i += gthreads * 8) {
        const f32x4 a = *(const f32x4*)(src + i), b = *(const f32x4*)(src + i + 4);
        v4u o; o.x = pk2(a.x, a.y); o.y = pk2(a.z, a.w); o.z = pk2(b.x, b.y); o.w = pk2(b.z, b.w);
        *(v4u*)(dst + i) = o; }
}
__device__ __forceinline__ void rms_pass(const float* X, const float* g, bf16* XN, unsigned char* HQ, float* SH, int gw, int NGW, int lane) {
    const f32x4* gr = (const f32x4*)g + lane;
    f32x4 gg[4];
#pragma unroll
    for (int j = 0; j < 4; ++j) gg[j] = gr[64 * j];
    f32x4 v[2][4], nx[2][4];
#pragma unroll
    for (int r = 0; r < 2; ++r)
#pragma unroll
        for (int j = 0; j < 4; ++j) v[r][j] = ((const f32x4*)(X + (size_t)(2 * gw + r) * D) + lane)[64 * j];
    for (int mb = gw; mb < T / 2; mb += NGW) {
        const int mn = mb + NGW < T / 2 ? mb + NGW : mb;
#pragma unroll
        for (int r = 0; r < 2; ++r)
#pragma unroll
            for (int j = 0; j < 4; ++j) nx[r][j] = ((const f32x4*)(X + (size_t)(2 * mn + r) * D) + lane)[64 * j];
        float s[2] = {0.f, 0.f}, rstd[2], am[2] = {0.f, 0.f};
#pragma unroll
        for (int r = 0; r < 2; ++r)
#pragma unroll
            for (int j = 0; j < 4; ++j) s[r] += (v[r][j].x * v[r][j].x + v[r][j].y * v[r][j].y) + (v[r][j].z * v[r][j].z + v[r][j].w * v[r][j].w);
#pragma unroll
        for (int r = 0; r < 2; ++r) rstd[r] = rsqrtf(wave_sum(s[r], lane) * (1.f / 1024.f) + EPS);
#pragma unroll
        for (int r = 0; r < 2; ++r)
#pragma unroll
            for (int j = 0; j < 4; ++j) { v[r][j].x = v[r][j].x * rstd[r] * gg[j].x; v[r][j].y = v[r][j].y * rstd[r] * gg[j].y; v[r][j].z = v[r][j].z * rstd[r] * gg[j].z; v[r][j].w = v[r][j].w * rstd[r] * gg[j].w;
                am[r] = fmaxf(am[r], fmaxf(fmaxf(fabsf(v[r][j].x), fabsf(v[r][j].y)), fmaxf(fabsf(v[r][j].z), fabsf(v[r][j].w)))); }
        (void)XN;
#pragma unroll
        for (int r = 0; r < 2; ++r) am[r] = wave_max0(am[r]);
#pragma unroll
        for (int r = 0; r < 2; ++r) { const int m = 2 * mb + r;
            const float hinv = am[r] > 0.f ? 127.f / am[r] : 0.f;
            unsigned* q4 = (unsigned*)(HQ + (size_t)m * D) + lane;
#pragma unroll
            for (int j = 0; j < 4; ++j) { const int q0 = (int)rintf(v[r][j].x * hinv), q1 = (int)rintf(v[r][j].y * hinv), q2 = (int)rintf(v[r][j].z * hinv), q3 = (int)rintf(v[r][j].w * hinv);
                q4[64 * j] = ((unsigned)(q0 & 0xff)) | ((unsigned)(q1 & 0xff) << 8) | ((unsigned)(q2 & 0xff) << 16) | ((unsigned)(q3 & 0xff) << 24); }
            if (lane == 0) SH[m] = am[r] * (1.f / 127.f); }
#pragma unroll
        for (int r = 0; r < 2; ++r)
#pragma unroll
            for (int j = 0; j < 4; ++j) v[r][j] = nx[r][j];
    }
}

__device__ __forceinline__ float addf_np(float a, float b) { float r; asm("v_add_f32 %0, %1, %2" : "=v"(r) : "v"(a), "v"(b)); return r; }

__device__ __forceinline__ void gates_rows_mfma(const unsigned char* HQ, const float* SH, const bf16* WG, const float* bias, float* GATES, int gw, int lane) {
    const int mi = lane & 15, kg = lane >> 4;
    const unsigned char* arow = HQ + (size_t)(16 * gw + mi) * 1024 + 8 * kg;
    const bf16* b0 = WG + (size_t)mi * 1024 + 8 * kg; const bf16* b1 = b0 + 16 * 1024;
    f32x4 acc0 = {0.f, 0.f, 0.f, 0.f}, acc1 = acc0;
#pragma unroll 16
    for (int ks = 0; ks < 32; ++ks) { const u32x2 d = *(const u32x2*)(arow + 32 * ks);
        v4u t; t[0] = pk2((float)((int)(d.x << 24) >> 24), (float)((int)(d.x << 16) >> 24)); t[1] = pk2((float)((int)(d.x << 8) >> 24), (float)((int)d.x >> 24));
        t[2] = pk2((float)((int)(d.y << 24) >> 24), (float)((int)(d.y << 16) >> 24)); t[3] = pk2((float)((int)(d.y << 8) >> 24), (float)((int)d.y >> 24));
        const bf16x8 a = __builtin_bit_cast(bf16x8, t);
        acc0 = mfma16(a, *(const bf16x8*)(b0 + 32 * ks), acc0); acc1 = mfma16(a, *(const bf16x8*)(b1 + 32 * ks), acc1); }
    const float bi0 = bias[mi], bi1 = bias[16 + mi];
#pragma unroll
    for (int r = 0; r < 4; ++r) { const int row = 16 * gw + 4 * kg + r; const float sh = SH[row]; float* g = GATES + ((size_t)(row >> 12) * 32) * 4096 + (row & 4095); g[(size_t)mi * 4096] = acc0[r] * sh + bi0; g[(size_t)(16 + mi) * 4096] = acc1[r] * sh + bi1; }
}

__device__ __forceinline__ float logsigmoid_f(float f) { return fminf(f, 0.f) - __logf(1.f + __expf(-fabsf(f))); }
#define ML_LOAD(ci_) do { const size_t r_ = rowbase + (size_t)(ci_) * 64 + lane; \
    rq = *(const v4u*)(Q0 + r_ * 64 + 8 * w); rk = *(const v4u*)(K0 + r_ * 64 + 8 * w); rv0 = *(const v4u*)(V0 + r_ * 128 + 16 * w); rv1 = *(const v4u*)(V0 + r_ * 128 + 16 * w + 8); \
    const size_t gm_ = (size_t)(ci_) * 64 + jr; rli = GATES[((size_t)b * 32 + (dir ? 16 : 0) + h) * 4096 + gm_]; rf = GATES[((size_t)b * 32 + (dir ? 24 : 8) + h) * 4096 + gm_]; } while (0)
__device__ __forceinline__ void mlstm_phase(const int wv, LAS unsigned char* lds, const bf16* Q0, const bf16* K0, const bf16* V0, const float* GATES, bf16* HF, bf16* HB) {
    const int bx = blockIdx.x;
    if ((bx >> 3) & 1) return;
    const int seq = (bx >> 4) * 8 + (bx & 7);
    const int dir = seq & 1, bh = seq >> 1, b = bh >> 3, h = bh & 7;
    int ln_; asm volatile("v_mbcnt_lo_u32_b32 %0, -1, 0\n\tv_mbcnt_hi_u32_b32 %0, -1, %0" : "=v"(ln_)); const int tid = wv * 64 + ln_, lane = tid & 63, w = wv, fr = lane & 15, fq = lane >> 4;
    LAS bf16* Qs = (LAS bf16*)(lds); LAS bf16* Ks = (LAS bf16*)(lds + 9216); LAS bf16* Kwt = (LAS bf16*)(lds + 18432); LAS bf16* Ps = (LAS bf16*)(lds + 27648);
    LAS bf16* Vt = (LAS bf16*)(lds + 36864 + w * 2304); LAS bf16* Cs = (LAS bf16*)(lds + 55296 + w * 2304); LAS bf16* nb = (LAS bf16*)(lds + 73728 + w * 128);
    LAS float* gc = (LAS float*)(lds + 74752 + w * 1280); LAS float* gM = gc + 64; LAS float* gI = gc + 128; LAS float* gE = gc + 192; LAS float* gW = gc + 256;
    for (int i = lane; i < 2304 / 4; i += 64) ((LAS unsigned*)Cs)[i] = 0u;
    if (lane < 32) ((LAS unsigned*)nb)[lane] = 0u;
    f32x4 Cacc[4], Nacc[4];
#pragma unroll
    for (int i = 0; i < 4; ++i) { Cacc[i] = (f32x4){0.f, 0.f, 0.f, 0.f}; Nacc[i] = (f32x4){0.f, 0.f, 0.f, 0.f}; }
    float m = -1e30f;
    bf16* Hout = dir ? HB : HF;
    const size_t rowbase = (size_t)bh * 4096;
    const int jr = dir ? 63 - lane : lane;
    v4u rq, rk, rv0, rv1; float rli, rf;
    ML_LOAD(dir ? 63 : 0);
    const bf16x8 ones = (bf16x8){0x3F80, 0x3F80, 0x3F80, 0x3F80, 0x3F80, 0x3F80, 0x3F80, 0x3F80};
    const f32x4 z4 = (f32x4){0.f, 0.f, 0.f, 0.f};
#pragma unroll 1
    for (int step = 0; step < 64; ++step) {
        const int ci = dir ? 63 - step : step;
        const float lf = logsigmoid_f(rf);
        float bcs = lf;
        bcs += __uint_as_float((unsigned)__builtin_amdgcn_update_dpp(0, (int)__float_as_uint(bcs), 0x111, 0xF, 0xF, false));
        bcs += __uint_as_float((unsigned)__builtin_amdgcn_update_dpp(0, (int)__float_as_uint(bcs), 0x112, 0xF, 0xF, false));
        bcs += __uint_as_float((unsigned)__builtin_amdgcn_update_dpp(0, (int)__float_as_uint(bcs), 0x114, 0xF, 0xF, false));
        bcs += __uint_as_float((unsigned)__builtin_amdgcn_update_dpp(0, (int)__float_as_uint(bcs), 0x118, 0xF, 0xF, false));
        bcs += __uint_as_float((unsigned)__builtin_amdgcn_update_dpp(0, (int)__float_as_uint(bcs), 0x142, 0xA, 0xF, false));
        bcs += __uint_as_float((unsigned)__builtin_amdgcn_update_dpp(0, (int)__float_as_uint(bcs), 0x143, 0xC, 0xF, false));
        const float c = rli - bcs;
        float pm = c;
        const int NINFI = (int)0xFF800000u;
        pm = fmaxf(pm, __uint_as_float((unsigned)__builtin_amdgcn_update_dpp(NINFI, (int)__float_as_uint(pm), 0x111, 0xF, 0xF, false)));
        pm = fmaxf(pm, __uint_as_float((unsigned)__builtin_amdgcn_update_dpp(NINFI, (int)__float_as_uint(pm), 0x112, 0xF, 0xF, false)));
        pm = fmaxf(pm, __uint_as_float((unsigned)__builtin_amdgcn_update_dpp(NINFI, (int)__float_as_uint(pm), 0x114, 0xF, 0xF, false)));
        pm = fmaxf(pm, __uint_as_float((unsigned)__builtin_amdgcn_update_dpp(NINFI, (int)__float_as_uint(pm), 0x118, 0xF, 0xF, false)));
        pm = fmaxf(pm, __uint_as_float((unsigned)__builtin_amdgcn_update_dpp(NINFI, (int)__float_as_uint(pm), 0x142, 0xA, 0xF, false)));
        pm = fmaxf(pm, __uint_as_float((unsigned)__builtin_amdgcn_update_dpp(NINFI, (int)__float_as_uint(pm), 0x143, 0xC, 0xF, false)));
        const float M = fmaxf(m, pm);
        const float bL = __uint_as_float((unsigned)__builtin_amdgcn_readlane((int)__float_as_uint(bcs), 63)), Mlast = __uint_as_float((unsigned)__builtin_amdgcn_readlane((int)__float_as_uint(M), 63));
        gc[jr] = c; gM[jr] = M; gI[jr] = __expf(m - M); gE[jr] = __expf(-(bcs + M)); gW[jr] = __expf(c - Mlast);
        const float sp = __expf(m - Mlast), m_new = bL + Mlast;
        const float wr_ = gW[lane];
        *(LAS v4u*)(Qs + lane * 72 + 8 * w) = rq; *(LAS v4u*)(Ks + lane * 72 + 8 * w) = rk;
#pragma unroll
        for (int i = 0; i < 4; ++i) { const unsigned kw = rk[i]; Kwt[(8 * w + 2 * i) * 72 + lane] = (bf16)f2bf(bf_lo(kw) * wr_); Kwt[(8 * w + 2 * i + 1) * 72 + lane] = (bf16)f2bf(bf_hi(kw) * wr_); }
#pragma unroll
        for (int i = 0; i < 4; ++i) { Vt[(2 * i) * 72 + lane] = (bf16)(rv0[i] & 0xffffu); Vt[(2 * i + 1) * 72 + lane] = (bf16)(rv0[i] >> 16);
                                      Vt[(8 + 2 * i) * 72 + lane] = (bf16)(rv1[i] & 0xffffu); Vt[(9 + 2 * i) * 72 + lane] = (bf16)(rv1[i] >> 16); }
        __syncthreads();
        if (step < 63) ML_LOAD(dir ? 62 - step : step + 1);
        {
            const int st = w >> 1;
            const bf16x8 a0 = *(const LAS bf16x8*)(Ks + (16 * st + fr) * 72 + 8 * fq), a1 = *(const LAS bf16x8*)(Ks + (16 * st + fr) * 72 + 32 + 8 * fq);
#pragma unroll
            for (int u = 0; u < 2; ++u) { const int tt = 2 * (w & 1) + u;
                const bf16x8 b0 = *(const LAS bf16x8*)(Qs + (16 * tt + fr) * 72 + 8 * fq), b1 = *(const LAS bf16x8*)(Qs + (16 * tt + fr) * 72 + 32 + 8 * fq);
                f32x4 acc = mfma16(a0, b0, z4); acc = mfma16(a1, b1, acc);
                const int t = 16 * tt + fr; const float Mt = gM[t]; float pv[4];
#pragma unroll
                for (int i = 0; i < 4; ++i) { const int s = 16 * st + 4 * fq + i; const bool valid = dir ? (s >= t) : (s <= t); const float e = __expf(gc[s] - Mt); pv[i] = valid ? acc[i] * e : 0.f; }
                *(LAS u32x2*)(Ps + t * 72 + 16 * st + 4 * fq) = pack4(pv[0], pv[1], pv[2], pv[3]); }
        }
        __syncthreads();
        const bf16x8 aV0 = *(const LAS bf16x8*)(Vt + fr * 72 + 8 * fq), aV1 = *(const LAS bf16x8*)(Vt + fr * 72 + 32 + 8 * fq);
        {
            const bf16x8 aC0 = *(const LAS bf16x8*)(Cs + fr * 72 + 8 * fq), aC1 = *(const LAS bf16x8*)(Cs + fr * 72 + 32 + 8 * fq);
            const bf16x8 aN0 = *(const LAS bf16x8*)(nb + 8 * fq), aN1 = *(const LAS bf16x8*)(nb + 32 + 8 * fq);
#pragma unroll
            for (int tt = 0; tt < 4; ++tt) {
                const bf16x8 bP0 = *(const LAS bf16x8*)(Ps + (16 * tt + fr) * 72 + 8 * fq), bP1 = *(const LAS bf16x8*)(Ps + (16 * tt + fr) * 72 + 32 + 8 * fq);
                const bf16x8 bQ0 = *(const LAS bf16x8*)(Qs + (16 * tt + fr) * 72 + 8 * fq), bQ1 = *(const LAS bf16x8*)(Qs + (16 * tt + fr) * 72 + 32 + 8 * fq);
                f32x4 acc1 = mfma16(aV0, bP0, z4); acc1 = mfma16(aV1, bP1, acc1);
                f32x4 acc2 = mfma16(aC0, bQ0, z4); acc2 = mfma16(aC1, bQ1, acc2);
                f32x4 d1 = mfma16(ones, bP0, z4); d1 = mfma16(ones, bP1, d1);
                f32x4 d2 = mfma16(aN0, bQ0, z4); d2 = mfma16(aN1, bQ1, d2);
                const int t = 16 * tt + fr; const float it = gI[t], en = gE[t];
                const float den = d1[0] + it * d2[0]; const float inv = __builtin_amdgcn_rcpf(fmaxf(fabsf(den), en));
                *(u32x2*)(Hout + ((size_t)b * 4096 + (size_t)ci * 64 + t) * 1024 + h * 128 + 16 * w + 4 * fq) =
                    pack4((acc1[0] + it * acc2[0]) * inv, (acc1[1] + it * acc2[1]) * inv, (acc1[2] + it * acc2[2]) * inv, (acc1[3] + it * acc2[3]) * inv);
            }
        }
#pragma unroll
        for (int dt = 0; dt < 4; ++dt) { Cacc[dt] = Cacc[dt] * sp; Nacc[dt] = Nacc[dt] * sp;
            const bf16x8 aK0 = *(const LAS bf16x8*)(Kwt + (16 * dt + fr) * 72 + 8 * fq), aK1 = *(const LAS bf16x8*)(Kwt + (16 * dt + fr) * 72 + 32 + 8 * fq);
            Cacc[dt] = mfma16(aK0, aV0, Cacc[dt]); Cacc[dt] = mfma16(aK1, aV1, Cacc[dt]);
            Nacc[dt] = mfma16(aK0, ones, Nacc[dt]); Nacc[dt] = mfma16(aK1, ones, Nacc[dt]); }
#pragma unroll
        for (int dt = 0; dt < 4; ++dt) { *(LAS u32x2*)(Cs + fr * 72 + 16 * dt + 4 * fq) = pack4(Cacc[dt][0], Cacc[dt][1], Cacc[dt][2], Cacc[dt][3]);
                                         *(LAS u32x2*)(nb + 16 * dt + 4 * fq) = pack4(Nacc[dt][0], Nacc[dt][1], Nacc[dt][2], Nacc[dt][3]); }
        m = m_new;
        __syncthreads();
    }
}

#define ML_LOADQK(ci_) do { const size_t r_ = rowbase + (size_t)(ci_) * 64; const bf16* const qrow_ = Q0 + r_ * 64 + 8 * w; const bf16* const krow_ = K0 + r_ * 64 + 8 * w; \
    rq = *(const v4u*)(qrow_ + lane * 64u); rk = *(const v4u*)(krow_ + lane * 64u); \
    const float* const grow_ = GATES + ((size_t)b * 32 + h) * 4096 + (size_t)(ci_) * 64; rli = grow_[(dir ? 16u * 4096u : 0u) + jr]; rf = grow_[(dir ? 24u * 4096u : 8u * 4096u) + jr]; } while (0)
#define ML_LOADV(ci_) do { const bf16* const vrow_ = V0 + (rowbase + (size_t)(ci_) * 64) * 128 + 16 * w; rv0 = *(const v4u*)(vrow_ + lane * 128u); rv1 = *(const v4u*)(vrow_ + lane * 128u + 8u); } while (0)
#define ML_PMAX(ctrl_) asm("s_nop 1\n\tv_max_f32_dpp %0, %0, %0 " ctrl_ : "+v"(pm))
typedef short v4s16_m __attribute__((ext_vector_type(4)));
__device__ __forceinline__ bf16x8 ml_tr8(const LAS bf16* p) {
    const v4s16_m lo = __builtin_amdgcn_ds_read_tr16_b64_v4i16((LAS v4s16_m*)p), hi = __builtin_amdgcn_ds_read_tr16_b64_v4i16((LAS v4s16_m*)(p + 4 * 16));
    return (bf16x8){lo[0], lo[1], lo[2], lo[3], hi[0], hi[1], hi[2], hi[3]};
}
#define ML_OUT(i_) ((acc1[i_] + gi * acc2[i_]) * inv)
#define ML2_BODY(GS_, GW_, GB_, GL_) do { \
        const int par = it & 1; \
        float sp2 = 0.f, wrn = 0.f; \
        if (GS_) { \
              \
            const float lf = 1.44269504089f * fminf(rf, 0.f) - __builtin_amdgcn_logf(1.f + __builtin_amdgcn_exp2f(-1.44269504089f * fabsf(rf))); \
            float bcs = lf; \
            bcs += __uint_as_float((unsigned)__builtin_amdgcn_update_dpp(0, (int)__float_as_uint(bcs), 0x111, 0xF, 0xF, false)); \
            bcs += __uint_as_float((unsigned)__builtin_amdgcn_update_dpp(0, (int)__float_as_uint(bcs), 0x112, 0xF, 0xF, false)); \
            bcs += __uint_as_float((unsigned)__builtin_amdgcn_update_dpp(0, (int)__float_as_uint(bcs), 0x114, 0xF, 0xF, false)); \
            bcs += __uint_as_float((unsigned)__builtin_amdgcn_update_dpp(0, (int)__float_as_uint(bcs), 0x118, 0xF, 0xF, false)); \
            bcs += __uint_as_float((unsigned)__builtin_amdgcn_update_dpp(0, (int)__float_as_uint(bcs), 0x142, 0xA, 0xF, false)); \
            bcs += __uint_as_float((unsigned)__builtin_amdgcn_update_dpp(0, (int)__float_as_uint(bcs), 0x143, 0xC, 0xF, false)); \
            const float c = 1.44269504089f * rli - bcs; \
            float pm = c; \
              \
            ML_PMAX("row_shr:1 row_mask:0xf bank_mask:0xf"); ML_PMAX("row_shr:2 row_mask:0xf bank_mask:0xf"); ML_PMAX("row_shr:4 row_mask:0xf bank_mask:0xf"); ML_PMAX("row_shr:8 row_mask:0xf bank_mask:0xf"); \
            ML_PMAX("row_bcast:15 row_mask:0xa bank_mask:0xf"); ML_PMAX("row_bcast:31 row_mask:0xc bank_mask:0xf"); \
            const float M = fmaxf(m, pm); \
            const float bL = __uint_as_float((unsigned)__builtin_amdgcn_readlane((int)__float_as_uint(bcs), 63)), Mlast = __uint_as_float((unsigned)__builtin_amdgcn_readlane((int)__float_as_uint(M), 63)); \
            gcB[par * 64 + jr] = c; gMB[par * 64 + jr] = M; gIB[qS * 64 + jr] = __builtin_amdgcn_exp2f(m - M); gEB[qS * 64 + jr] = __builtin_amdgcn_exp2f(-(bcs + M)); gW[jr] = __builtin_amdgcn_exp2f(c - Mlast); \
            sp2 = __builtin_amdgcn_exp2f(m - Mlast); m = bL + Mlast; \
            wrn = gW[lane]; \
            *(LAS v4u*)(Qs + qS * 4608 + lane * 72 + 8 * w) = rq; *(LAS v4u*)(Ks + par * 4608 + lane * 72 + 8 * w) = rk; \
        } \
        if (GW_) { \
            LAS bf16* const Kw = Kwt + (par ^ 1) * 4608; \
_Pragma("unroll") \
            for (int i = 0; i < 4; ++i) { const unsigned kw = rkh[i]; const unsigned kp = pk2(bf_lo(kw) * wrh, bf_hi(kw) * wrh); Kw[(8 * w + 2 * i) * 72 + lane] = (bf16)(kp & 0xffffu); Kw[(8 * w + 2 * i + 1) * 72 + lane] = (bf16)(kp >> 16); } \
            const LAS bf16* const Kr = Ks + (par ^ 1) * 4608; const LAS bf16* const Qr = Qs + qW * 4608; LAS bf16* const Pw = Ps + (par ^ 1) * 4608; \
            const LAS float* const gc = gcB + (par ^ 1) * 64; const LAS float* const gM = gMB + (par ^ 1) * 64; \
            const int st = w >> 1; \
            const bf16x8 a0 = *(const LAS bf16x8*)(Kr + (16 * st + fr) * 72 + 8 * fq), a1 = *(const LAS bf16x8*)(Kr + (16 * st + fr) * 72 + 32 + 8 * fq); \
_Pragma("unroll") \
            for (int u = 0; u < 2; ++u) { const int tt = 2 * (w & 1) + u; \
                const bf16x8 b0 = *(const LAS bf16x8*)(Qr + (16 * tt + fr) * 72 + 8 * fq), b1 = *(const LAS bf16x8*)(Qr + (16 * tt + fr) * 72 + 32 + 8 * fq); \
                f32x4 acc = mfma16(a0, b0, z4); acc = mfma16(a1, b1, acc); \
                const int t = 16 * tt + fr; const float Mt = gM[t]; float pv[4]; \
_Pragma("unroll") \
                for (int i = 0; i < 4; ++i) { const int s = 16 * st + 4 * fq + i; const bool valid = dir ? (s >= t) : (s <= t); const float e = __builtin_amdgcn_exp2f(gc[s] - Mt); pv[i] = valid ? acc[i] * e : 0.f; } \
                *(LAS u32x2*)(Pw + t * 72 + 16 * st + 4 * fq) = pack4(pv[0], pv[1], pv[2], pv[3]); } \
        } \
        rkh = rk; wrh = wrn; \
        if (GL_) ML_LOADQK(dir ? 60 - it : it + 3); \
        if (GB_) { \
            const int ci = dir ? 63 - it : it; bf16* const hrow = Hout + ((size_t)b * 4096 + (size_t)ci * 64) * 1024 + h * 128 + 16 * w; const unsigned hoff = fr * 1024u + 4u * fq; \
            *(LAS v4u*)(Vt + lane * 16) = rv0; *(LAS v4u*)(Vt + lane * 16 + 8) = rv1;        \
            const LAS bf16* const Pr = Ps + par * 4608; const LAS bf16* const Qr = Qs + qB * 4608; const LAS bf16* const Kw = Kwt + par * 4608; \
            const LAS float* const gI = gIB + qB * 64; const LAS float* const gE = gEB + qB * 64; \
            const bf16x8 aV0 = ml_tr8(Vt + (8 * fq + (fr >> 2)) * 16 + 4 * (fr & 3)), aV1 = ml_tr8(Vt + (32 + 8 * fq + (fr >> 2)) * 16 + 4 * (fr & 3)); \
            { \
                const bf16x8 aC0 = *(const LAS bf16x8*)(Cs + fr * 72 + 8 * fq), aC1 = *(const LAS bf16x8*)(Cs + fr * 72 + 32 + 8 * fq); \
                const bf16x8 aN0 = *(const LAS bf16x8*)(nb + 8 * fq), aN1 = *(const LAS bf16x8*)(nb + 32 + 8 * fq); \
                u32x2 hout[4]; \
_Pragma("unroll") \
                for (int tt = 0; tt < 4; ++tt) { \
                    const bf16x8 bP0 = *(const LAS bf16x8*)(Pr + (16 * tt + fr) * 72 + 8 * fq), bP1 = *(const LAS bf16x8*)(Pr + (16 * tt + fr) * 72 + 32 + 8 * fq); \
                    const bf16x8 bQ0 = *(const LAS bf16x8*)(Qr + (16 * tt + fr) * 72 + 8 * fq), bQ1 = *(const LAS bf16x8*)(Qr + (16 * tt + fr) * 72 + 32 + 8 * fq); \
                    f32x4 acc1 = mfma16(aV0, bP0, z4); acc1 = mfma16(aV1, bP1, acc1); \
                    f32x4 acc2 = mfma16(aC0, bQ0, z4); acc2 = mfma16(aC1, bQ1, acc2); \
                    f32x4 d1 = mfma16(ones, bP0, z4); d1 = mfma16(ones, bP1, d1); \
                    f32x4 d2 = mfma16(aN0, bQ0, z4); d2 = mfma16(aN1, bQ1, d2); \
                    const int t = 16 * tt + fr; const float gi = gI[t], en = gE[t]; \
                    const float den = d1[0] + gi * d2[0]; const float inv = __builtin_amdgcn_rcpf(fmaxf(fabsf(den), en)); \
                    hout[tt] = pack4(ML_OUT(0), ML_OUT(1), ML_OUT(2), ML_OUT(3)); \
                } \
                  \
                  \
_Pragma("unroll") \
                for (int pp = 0; pp < 2; ++pp) { \
                    const auto sx_ = __builtin_amdgcn_permlane16_swap(hout[2 * pp].x, hout[2 * pp + 1].x, false, false); const auto sy_ = __builtin_amdgcn_permlane16_swap(hout[2 * pp].y, hout[2 * pp + 1].y, false, false); \
                    *(v4u*)(hrow + ((unsigned)(16 * (2 * pp + (fq & 1)) + fr) * 1024u + 8u * (fq >> 1))) = (v4u){sx_[0], sy_[0], sx_[1], sy_[1]}; \
                } \
            } \
_Pragma("unroll") \
            for (int dt = 0; dt < 4; ++dt) { Cacc[dt] = Cacc[dt] * sp0; Nacc[dt] = Nacc[dt] * sp0; \
                const bf16x8 aK0 = *(const LAS bf16x8*)(Kw + (16 * dt + fr) * 72 + 8 * fq), aK1 = *(const LAS bf16x8*)(Kw + (16 * dt + fr) * 72 + 32 + 8 * fq); \
                Cacc[dt] = mfma16(aK0, aV0, Cacc[dt]); Cacc[dt] = mfma16(aK1, aV1, Cacc[dt]); \
                Nacc[dt] = mfma16(aK0, ones, Nacc[dt]); Nacc[dt] = mfma16(aK1, ones, Nacc[dt]); } \
_Pragma("unroll") \
            for (int dt = 0; dt < 4; ++dt) { *(LAS u32x2*)(Cs + fr * 72 + 16 * dt + 4 * fq) = pack4(Cacc[dt][0], Cacc[dt][1], Cacc[dt][2], Cacc[dt][3]); \
                                             *(LAS u32x2*)(nb + 16 * dt + 4 * fq) = pack4(Nacc[dt][0], Nacc[dt][1], Nacc[dt][2], Nacc[dt][3]); } \
        } \
        if (GW_) ML_LOADV(dir ? 62 - it : it + 1); \
        sp0 = sp1; sp1 = sp2; \
        { const int t_ = qB; qB = qW; qW = qS; qS = t_; } \
        __syncthreads(); } while (0)
__device__ __forceinline__ void mlstm_phase2(const int wv, LAS unsigned char* lds, const bf16* Q0, const bf16* K0, const bf16* V0, const float* GATES, bf16* HF, bf16* HB) {
    const int bx = blockIdx.x;
    if ((bx >> 3) & 1) return;
    const int seq = (bx >> 4) * 8 + (bx & 7);
    const int dir = seq & 1, bh = seq >> 1, b = bh >> 3, h = bh & 7;
    int ln_; asm volatile("v_mbcnt_lo_u32_b32 %0, -1, 0\n\tv_mbcnt_hi_u32_b32 %0, -1, %0" : "=v"(ln_)); const int lane = ln_, w = wv, fr = lane & 15, fq = lane >> 4;
    LAS bf16* const Qs = (LAS bf16*)(lds); LAS bf16* const Ks = (LAS bf16*)(lds + 27648); LAS bf16* const Kwt = (LAS bf16*)(lds + 46080); LAS bf16* const Ps = (LAS bf16*)(lds + 64512);
    LAS bf16* const Vt = (LAS bf16*)(lds + 82944 + w * 2304); LAS bf16* const Cs = (LAS bf16*)(lds + 101376 + w * 2304); LAS bf16* const nb = (LAS bf16*)(lds + 119808 + w * 128);
    LAS float* const gbase = (LAS float*)(lds + 120832 + w * 2816);
    LAS float* const gcB = gbase; LAS float* const gMB = gbase + 128; LAS float* const gIB = gbase + 256; LAS float* const gEB = gbase + 448; LAS float* const gW = gbase + 640;
    for (int i = lane; i < 2304 / 4; i += 64) ((LAS unsigned*)Cs)[i] = 0u;
    if (lane < 32) ((LAS unsigned*)nb)[lane] = 0u;
    f32x4 Cacc[4], Nacc[4];
#pragma unroll
    for (int i = 0; i < 4; ++i) { Cacc[i] = (f32x4){0.f, 0.f, 0.f, 0.f}; Nacc[i] = (f32x4){0.f, 0.f, 0.f, 0.f}; }
    float m = -1e30f;
    bf16* Hout = dir ? HB : HF;
    const size_t rowbase = (size_t)bh * 4096;
    const int jr = dir ? 63 - lane : lane;
    v4u rq, rk, rkh, rv0, rv1; float rli, rf, wrh = 0.f, sp0 = 0.f, sp1 = 0.f;
    rkh = (v4u){0u, 0u, 0u, 0u}; rv0 = rkh; rv1 = rkh;
    ML_LOADQK(dir ? 63 : 0);
    const bf16x8 ones = (bf16x8){0x3F80, 0x3F80, 0x3F80, 0x3F80, 0x3F80, 0x3F80, 0x3F80, 0x3F80};
    const f32x4 z4 = (f32x4){0.f, 0.f, 0.f, 0.f};
    int qS = 0, qW = 2, qB = 1;
#pragma unroll 1
    for (int it = -2; it < 64; ++it) {
        if (it >= 0 && it <= 60) ML2_BODY(true, true, true, true);
        else ML2_BODY(it + 2 < 64, it + 1 >= 0 && it + 1 < 64, it >= 0, it + 3 < 64);
    }
}
#undef ML_LOAD

__device__ __forceinline__ void hs_pass(const bf16* HF, const bf16* HB, const bf16* OG, const float* hg, unsigned char* HS8, float* SHO, int gw, int NGW, int lane) {
    v4u f0, f1, b0, b1, o0, o1, nf0, nf1, nb0, nb1, no0, no1;
    if (gw < T) { const size_t off = (size_t)gw * 1024 + 16 * lane;
        f0 = *(const v4u*)(HF + off); f1 = *(const v4u*)(HF + off + 8); b0 = *(const v4u*)(HB + off); b1 = *(const v4u*)(HB + off + 8); o0 = *(const v4u*)(OG + off); o1 = *(const v4u*)(OG + off + 8); }
    for (int m = gw; m < T; m += NGW) {
        const size_t off = (size_t)m * 1024 + 16 * lane;
        { const int mn = m + NGW < T ? m + NGW : m; const size_t offn = (size_t)mn * 1024 + 16 * lane;
          nf0 = *(const v4u*)(HF + offn); nf1 = *(const v4u*)(HF + offn + 8); nb0 = *(const v4u*)(HB + offn); nb1 = *(const v4u*)(HB + offn + 8); no0 = *(const v4u*)(OG + offn); no1 = *(const v4u*)(OG + offn + 8); }
        float x[16], og[16];
#pragma unroll
        for (int i = 0; i < 4; ++i) { x[2 * i] = bf_lo(f0[i]) + bf_lo(b0[i]); x[2 * i + 1] = bf_hi(f0[i]) + bf_hi(b0[i]); x[8 + 2 * i] = bf_lo(f1[i]) + bf_lo(b1[i]); x[9 + 2 * i] = bf_hi(f1[i]) + bf_hi(b1[i]);
                                      og[2 * i] = bf_lo(o0[i]); og[2 * i + 1] = bf_hi(o0[i]); og[8 + 2 * i] = bf_lo(o1[i]); og[9 + 2 * i] = bf_hi(o1[i]); }
        float ss = 0.f;
#pragma unroll
        for (int i = 0; i < 16; ++i) ss += x[i] * x[i];
        ss += shx(ss, lane, 1); ss += shx(ss, lane, 2); ss += shx(ss, lane, 4);
        const float rstd = rsqrtf(ss * (1.f / 128.f) + EPS);
        float y[16];
#pragma unroll
        for (int i = 0; i < 16; ++i) y[i] = x[i] * rstd * hg[16 * lane + i] * (1.f / (1.f + __expf(-og[i])));
        float am = 0.f;
#pragma unroll
        for (int i = 0; i < 16; ++i) am = fmaxf(am, fabsf(y[i]));
        am = wave_max0(am);
        const float hinv = am > 0.f ? 127.f / am : 0.f;
        v4u w8;
#pragma unroll
        for (int i = 0; i < 4; ++i) w8[i] = ((unsigned)((int)rintf(y[4 * i] * hinv) & 0xff)) | ((unsigned)((int)rintf(y[4 * i + 1] * hinv) & 0xff) << 8) | ((unsigned)((int)rintf(y[4 * i + 2] * hinv) & 0xff) << 16) | ((unsigned)((int)rintf(y[4 * i + 3] * hinv) & 0xff) << 24);
        *(v4u*)(HS8 + (size_t)m * 1024 + 16 * lane) = w8;
        if (lane == 0) SHO[m] = am * (1.f / 127.f);
        f0 = nf0; f1 = nf1; b0 = nb0; b1 = nb1; o0 = no0; o1 = no1;
    }
}

__device__ __forceinline__ void glds16(const void* gsrc, unsigned lds_dst) { unsigned keep;
    asm volatile("s_mov_b32 %0, m0\n\ts_mov_b32 m0, %2\n\ts_nop 0\n\tglobal_load_lds_dwordx4 %1, off\n\ts_mov_b32 m0, %0" : "=&s"(keep) : "v"(gsrc), "s"(lds_dst) : "memory"); }
__device__ __forceinline__ void glds16s(const void* sbase, unsigned voff, unsigned lds_dst) { unsigned keep;
    asm volatile("s_mov_b32 %0, m0\n\ts_mov_b32 m0, %3\n\ts_nop 0\n\tglobal_load_lds_dwordx4 %1, %2\n\ts_mov_b32 m0, %0" : "=&s"(keep) : "v"(voff), "s"(sbase), "s"(lds_dst) : "memory"); }
#define AT_WAIT_BAR() asm volatile("s_waitcnt vmcnt(0) lgkmcnt(0)\n\ts_barrier" ::: "memory")

#define TK_CE(a, b) do { const float h_ = fmaxf(a, b), l_ = fminf(a, b); a = h_; b = l_; } while (0)
#define BITONIC_MERGE16(x) do { _Pragma("unroll") for (int d_ = 8; d_ >= 1; d_ >>= 1) { _Pragma("unroll") for (int i_ = 0; i_ < 16; ++i_) if ((i_ & d_) == 0) TK_CE(x[i_], x[i_ + d_]); } } while (0)
#define BITONIC_SORT16(x) do { _Pragma("unroll") for (int k_ = 2; k_ <= 16; k_ <<= 1) { _Pragma("unroll") for (int d_ = k_ >> 1; d_ >= 1; d_ >>= 1) { _Pragma("unroll") for (int i_ = 0; i_ < 16; ++i_) { const int l_i = i_ ^ d_; \
    if (l_i > i_) { if ((i_ & k_) == 0 || k_ == 16) TK_CE(x[i_], x[l_i]); else TK_CE(x[l_i], x[i_]); } } } } } while (0)
#define SORT16_60(x) do { \
    TK_CE(x[0], x[13]); TK_CE(x[1], x[12]); TK_CE(x[2], x[15]); TK_CE(x[3], x[14]); TK_CE(x[4], x[8]); TK_CE(x[5], x[6]); TK_CE(x[7], x[11]); TK_CE(x[9], x[10]); \
    TK_CE(x[0], x[5]); TK_CE(x[1], x[7]); TK_CE(x[2], x[9]); TK_CE(x[3], x[4]); TK_CE(x[6], x[13]); TK_CE(x[8], x[14]); TK_CE(x[10], x[15]); TK_CE(x[11], x[12]); \
    TK_CE(x[0], x[1]); TK_CE(x[2], x[3]); TK_CE(x[4], x[5]); TK_CE(x[6], x[8]); TK_CE(x[7], x[9]); TK_CE(x[10], x[11]); TK_CE(x[12], x[13]); TK_CE(x[14], x[15]); \
    TK_CE(x[0], x[2]); TK_CE(x[1], x[3]); TK_CE(x[4], x[10]); TK_CE(x[5], x[11]); TK_CE(x[6], x[7]); TK_CE(x[8], x[9]); TK_CE(x[12], x[14]); TK_CE(x[13], x[15]); \
    TK_CE(x[1], x[2]); TK_CE(x[3], x[12]); TK_CE(x[4], x[6]); TK_CE(x[5], x[7]); TK_CE(x[8], x[10]); TK_CE(x[9], x[11]); TK_CE(x[13], x[14]); \
    TK_CE(x[1], x[4]); TK_CE(x[2], x[6]); TK_CE(x[5], x[8]); TK_CE(x[7], x[10]); TK_CE(x[9], x[13]); TK_CE(x[11], x[14]); \
    TK_CE(x[2], x[4]); TK_CE(x[3], x[6]); TK_CE(x[9], x[12]); TK_CE(x[11], x[13]); \
    TK_CE(x[3], x[5]); TK_CE(x[6], x[8]); TK_CE(x[7], x[9]); TK_CE(x[10], x[12]); \
    TK_CE(x[3], x[4]); TK_CE(x[5], x[6]); TK_CE(x[7], x[8]); TK_CE(x[9], x[10]); TK_CE(x[11], x[12]); \
    TK_CE(x[6], x[7]); TK_CE(x[8], x[9]); } while (0)
#define TK_INSERT(v, x) do { float c_ = (x); _Pragma("unroll") for (int j_ = 0; j_ < 16; ++j_) { const float h_ = fmaxf(v[j_], c_); c_ = fminf(v[j_], c_); v[j_] = h_; } } while (0)
#define TK_DMA(st_, b_) do { _Pragma("unroll") for (int g_ = 0; g_ < 2; ++g_) { const int hp_ = ((g_ * 4 + ((st_) >> 1)) * 2 + ((st_) & 1)); \
    _Pragma("unroll") for (int i_ = 0; i_ < 4; ++i_) { const int q_ = w * 4 + i_, row_ = 4 * q_ + (lane >> 4), ch_ = (lane & 15) ^ (row_ & 15); \
        glds16(KEYS + ((size_t)(hp_ * 128 + row_)) * 128 + ch_ * 8, (unsigned)__builtin_amdgcn_readfirstlane((int)(ldsb + ((b_) * 2 + g_) * 32768 + q_ * 1024))); } } } while (0)
#define TK_PKH(a_, b_) __builtin_bit_cast(unsigned, __builtin_amdgcn_cvt_pkrtz((a_), (b_)))
template <int VAR>
__device__ __forceinline__ void peer_topk_phase(const int wv, LAS unsigned char* lds, int vcu, const bf16* PQ, const bf16* KEYS, int* EXPERTS, float* GATESP) {
    int ln_; asm volatile("v_mbcnt_lo_u32_b32 %0, -1, 0\n\tv_mbcnt_hi_u32_b32 %0, -1, %0" : "=v"(ln_)); const int tid = wv * 64 + ln_, lane = tid & 63, w = wv, r32 = lane & 31, hi = lane >> 5;
    const int t = vcu * 128 + (w & 3) * 32 + r32, hg = w >> 2;
    const float NINF = -INFINITY;
    const unsigned ldsb = (unsigned)(uintptr_t)lds;
    TK_DMA(0, 0);
    bf16x8 bq[8];
#pragma unroll
    for (int ks = 0; ks < 8; ++ks) bq[ks] = *(const bf16x8*)(PQ + (size_t)t * 2048 + (hg * 4) * 256 + ks * 16 + 8 * hi);
    AT_WAIT_BAR();
#pragma unroll 1
    for (int hh = 0; hh < 4; ++hh) {
        const int head = hg * 4 + hh;
        float L0[16], L1[16];
#pragma unroll
        for (int j = 0; j < 16; ++j) { L0[j] = 0.f; L1[j] = 0.f; }
#pragma unroll 1
        for (int p = 0; p < 2; ++p) {
            const int st = hh * 2 + p, buf = st & 1;
            if (st < 7) TK_DMA(st + 1, buf ^ 1);
            const LAS unsigned char* kb = lds + (buf * 2 + hg) * 32768 + r32 * 256;
            f32x16 acc[4];
#pragma unroll
            for (int nt = 0; nt < 4; ++nt) {
#pragma unroll
                for (int r = 0; r < 16; ++r) acc[nt][r] = 0.f;
#pragma unroll
                for (int ks = 0; ks < 8; ++ks) { const bf16x8 a = *(const LAS bf16x8*)(kb + nt * 8192 + (((2 * ks + hi) ^ (r32 & 15)) << 4)); if (VAR != 2) acc[nt] = mfma32(a, bq[ks], acc[nt]); else acc[nt][ks] += (float)a[0] + (float)bq[ks][0]; }
            }
            if (st < 7) {
#pragma unroll
                for (int ks = 0; ks < 8; ++ks) bq[ks] = *(const bf16x8*)(PQ + (size_t)t * 2048 + (hg * 4 + ((st + 1) >> 1)) * 256 + ((st + 1) & 1) * 128 + ks * 16 + 8 * hi);
            }
            float v[16];
            {
                float blk[4][16];
#pragma unroll
                for (int nt = 0; nt < 4; ++nt)
#pragma unroll
                    for (int r = 0; r < 16; ++r) { const int n = nt * 32 + (r & 3) + 8 * (r >> 2) + 4 * hi; blk[nt][r] = __uint_as_float((__float_as_uint(acc[nt][r]) & ~0x7Fu) | (unsigned)(127 - n)); }
#pragma unroll
                for (int nt = 0; nt < 4; ++nt) do { if (VAR != 1) { SORT16_60(blk[nt]); } } while (0);
#pragma unroll
                for (int i = 0; i < 16; ++i) { blk[0][i] = fmaxf(blk[0][i], blk[1][15 - i]); blk[2][i] = fmaxf(blk[2][i], blk[3][15 - i]); }
                do { if (VAR != 1) { BITONIC_MERGE16(blk[0]); } } while (0); do { if (VAR != 1) { BITONIC_MERGE16(blk[2]); } } while (0);
#pragma unroll
                for (int i = 0; i < 16; ++i) v[i] = fmaxf(blk[0][i], blk[2][15 - i]);
                do { if (VAR != 1) { BITONIC_MERGE16(v); } } while (0);
            }
            {
                float wv_[16];
#pragma unroll
                for (int j = 0; j < 16; ++j) wv_[j] = shx(v[15 - j], lane, 32);
#pragma unroll
                for (int j = 0; j < 16; ++j) v[j] = fmaxf(v[j], wv_[j]);
                do { if (VAR != 1) { BITONIC_MERGE16(v); } } while (0);
            }
            if (p == 0) {
#pragma unroll
                for (int j = 0; j < 16; ++j) L0[j] = v[j];
            } else {
#pragma unroll
                for (int j = 0; j < 16; ++j) L1[j] = v[j];
            }            AT_WAIT_BAR();
        }
        float tv[16];
        unsigned IA[4] = {0u, 0u, 0u, 0u}, IB[4] = {0u, 0u, 0u, 0u};
#pragma unroll
        for (int i = 0; i < 16; ++i) { IA[i >> 2] |= (127u - (__float_as_uint(L0[i]) & 0x7Fu)) << (8 * (i & 3)); IB[i >> 2] |= (127u - (__float_as_uint(L1[i]) & 0x7Fu)) << (8 * (i & 3)); }
        {
            float cb[4][16]; int cn = 0;
#pragma unroll
            for (int i = 0; i < 16; ++i) {
                const float va = __uint_as_float(__float_as_uint(L0[i]) & ~0x7Fu);
#pragma unroll
                for (int j = 0; j < 16; ++j) if ((i + 1) * (j + 1) <= 16) {
                    const float vb = __uint_as_float(__float_as_uint(L1[j]) & ~0x7Fu);
                    cb[cn >> 4][cn & 15] = __uint_as_float((__float_as_uint(va + vb) & ~0xFFu) | (unsigned)(255 - (i * 16 + j)));
                    ++cn;
                }
            }
#pragma unroll
            for (int c = 50; c < 64; ++c) cb[c >> 4][c & 15] = NINF;
#pragma unroll
            for (int nt = 1; nt < 4; ++nt) do { if (VAR != 1) { SORT16_60(cb[nt]); } } while (0);
#pragma unroll
            for (int i = 0; i < 16; ++i) { cb[0][i] = fmaxf(cb[0][i], cb[1][15 - i]); cb[2][i] = fmaxf(cb[2][i], cb[3][15 - i]); }
            do { if (VAR != 1) { BITONIC_MERGE16(cb[0]); } } while (0); do { if (VAR != 1) { BITONIC_MERGE16(cb[2]); } } while (0);
#pragma unroll
            for (int i = 0; i < 16; ++i) tv[i] = fmaxf(cb[0][i], cb[2][15 - i]);
            do { if (VAR != 1) { BITONIC_MERGE16(tv); } } while (0);
        }
        int ti[16];
#pragma unroll
        for (int j = 0; j < 16; ++j) { const unsigned kb = __float_as_uint(tv[j]); const unsigned flat = 255u - (kb & 0xFFu); const unsigned fi = flat >> 4, fj = flat & 15u;
            const unsigned ra = (fi < 8u) ? ((fi < 4u) ? IA[0] : IA[1]) : ((fi < 12u) ? IA[2] : IA[3]);
            const unsigned rb = (fj < 8u) ? ((fj < 4u) ? IB[0] : IB[1]) : ((fj < 12u) ? IB[2] : IB[3]);
            ti[j] = (int)(((ra >> (8u * (fi & 3u))) & 0xFFu) * 128u + ((rb >> (8u * (fj & 3u))) & 0xFFu));
            tv[j] = __uint_as_float(kb & ~0xFFu); }
        float e[16], sum = 0.f;
#pragma unroll
        for (int j = 0; j < 16; ++j) { e[j] = __expf(tv[j] - tv[0]); sum += e[j]; }
        const float inv = 1.f / sum;
        if (hi == 0) { unsigned short* ep = (unsigned short*)EXPERTS + (size_t)t * 128 + head * 16;
#pragma unroll
            for (int j = 0; j < 2; ++j) *(v4u*)(ep + 8 * j) = (v4u){(unsigned)ti[8 * j] | ((unsigned)ti[8 * j + 1] << 16), (unsigned)ti[8 * j + 2] | ((unsigned)ti[8 * j + 3] << 16), (unsigned)ti[8 * j + 4] | ((unsigned)ti[8 * j + 5] << 16), (unsigned)ti[8 * j + 6] | ((unsigned)ti[8 * j + 7] << 16)}; }
        else { unsigned short* gp = (unsigned short*)GATESP + (size_t)t * 128 + head * 16;
#pragma unroll
            for (int j = 0; j < 2; ++j) *(v4u*)(gp + 8 * j) = (v4u){TK_PKH(e[8 * j] * inv, e[8 * j + 1] * inv), TK_PKH(e[8 * j + 2] * inv, e[8 * j + 3] * inv), TK_PKH(e[8 * j + 4] * inv, e[8 * j + 5] * inv), TK_PKH(e[8 * j + 6] * inv, e[8 * j + 7] * inv)}; }
    }
}

__device__ __forceinline__ float cvt_ub0(unsigned x) { float r; asm("v_cvt_f32_ubyte0 %0, %1" : "=v"(r) : "v"(x)); return r; }
__device__ __forceinline__ float cvt_ub1(unsigned x) { float r; asm("v_cvt_f32_ubyte1 %0, %1" : "=v"(r) : "v"(x)); return r; }
__device__ __forceinline__ float cvt_ub2(unsigned x) { float r; asm("v_cvt_f32_ubyte2 %0, %1" : "=v"(r) : "v"(x)); return r; }
__device__ __forceinline__ float cvt_ub3(unsigned x) { float r; asm("v_cvt_f32_ubyte3 %0, %1" : "=v"(r) : "v"(x)); return r; }
__device__ __forceinline__ void quant8_rows_bf16(const bf16* src, unsigned char* dst, float* scale, int nrows, int gw, int NGW, int lane) {
    for (int r = gw; r < nrows; r += NGW) {
        const v4u a = *(const v4u*)(src + (size_t)r * 1024 + 16 * lane), b = *(const v4u*)(src + (size_t)r * 1024 + 16 * lane + 8);
        float x[16]; float am = 0.f;
#pragma unroll
        for (int k = 0; k < 4; ++k) { x[2 * k] = bf_lo(a[k]); x[2 * k + 1] = bf_hi(a[k]); x[8 + 2 * k] = bf_lo(b[k]); x[9 + 2 * k] = bf_hi(b[k]); }
#pragma unroll
        for (int k = 0; k < 16; ++k) am = fmaxf(am, fabsf(x[k]));
        am = wave_max0(am);
        const float inv = am > 0.f ? 127.f / am : 0.f;
        v4u w;
#pragma unroll
        for (int k = 0; k < 4; ++k) w[k] = ((unsigned)((int)rintf(x[4 * k] * inv) & 0xff)) | ((unsigned)((int)rintf(x[4 * k + 1] * inv) & 0xff) << 8) | ((unsigned)((int)rintf(x[4 * k + 2] * inv) & 0xff) << 16) | ((unsigned)((int)rintf(x[4 * k + 3] * inv) & 0xff) << 24);
        *(v4u*)(dst + (size_t)r * 1024 + 16 * lane) = w;
        if (lane == 0) scale[r] = am * (1.f / 127.f);
    }
}
__device__ __forceinline__ void quant8_rows_bf16_kf(const bf16* src, unsigned char* dst, float* scale, int nrows, const float* subln, int gw, int NGW, int lane) {
    float kf[16];
#pragma unroll
    for (int k = 0; k < 16; ++k) kf[k] = subln[(16 * lane + k) & 127] * ((1.f - LAMBDA_INIT) * (6.f / 127.f));
    for (int r = gw; r < nrows; r += NGW) {
        const v4u a = *(const v4u*)(src + (size_t)r * 1024 + 16 * lane), b = *(const v4u*)(src + (size_t)r * 1024 + 16 * lane + 8);
        float x[16]; float am = 0.f;
#pragma unroll
        for (int k = 0; k < 4; ++k) { x[2 * k] = bf_lo(a[k]); x[2 * k + 1] = bf_hi(a[k]); x[8 + 2 * k] = bf_lo(b[k]); x[9 + 2 * k] = bf_hi(b[k]); }
#pragma unroll
        for (int k = 0; k < 16; ++k) { x[k] *= kf[k]; am = fmaxf(am, fabsf(x[k])); }
        am = wave_max0(am);
        const float inv = am > 0.f ? 127.f / am : 0.f;
        v4u w;
#pragma unroll
        for (int k = 0; k < 4; ++k) w[k] = ((unsigned)((int)rintf(x[4 * k] * inv) & 0xff)) | ((unsigned)((int)rintf(x[4 * k + 1] * inv) & 0xff) << 8) | ((unsigned)((int)rintf(x[4 * k + 2] * inv) & 0xff) << 16) | ((unsigned)((int)rintf(x[4 * k + 3] * inv) & 0xff) << 24);
        *(v4u*)(dst + (size_t)r * 1024 + 16 * lane) = w;
        if (lane == 0) scale[r] = am * (1.f / 127.f);
    }
}
__device__ __forceinline__ void quant4_rows(const float* src, unsigned char* dst, float* scale, int nrows, int gw, int NGW, int lane) {
    for (int r = gw; r < nrows; r += NGW) {
        const f32x4* sp = (const f32x4*)(src + (size_t)r * 1024) + 4 * lane;
        f32x4 v[4]; float am = 0.f, ss = 0.f;
#pragma unroll
        for (int j = 0; j < 4; ++j) { v[j] = sp[j]; am = fmaxf(am, fmaxf(fmaxf(fabsf(v[j].x), fabsf(v[j].y)), fmaxf(fabsf(v[j].z), fabsf(v[j].w)))); ss += (v[j].x * v[j].x + v[j].y * v[j].y) + (v[j].z * v[j].z + v[j].w * v[j].w); }
        am = wave_max0(am); ss = wave_sum(ss, lane);
        const float step = fminf(am * (1.f / 7.5f), 0.3352f * sqrtf(ss * (1.f / 1024.f)));
        const float inv = step > 0.f ? 1.f / step : 0.f;
        unsigned q[16];
#pragma unroll
        for (int j = 0; j < 4; ++j) { q[4 * j] = (unsigned)fminf(fmaxf(rintf(v[j].x * inv + 7.5f), 0.f), 15.f); q[4 * j + 1] = (unsigned)fminf(fmaxf(rintf(v[j].y * inv + 7.5f), 0.f), 15.f);
                                      q[4 * j + 2] = (unsigned)fminf(fmaxf(rintf(v[j].z * inv + 7.5f), 0.f), 15.f); q[4 * j + 3] = (unsigned)fminf(fmaxf(rintf(v[j].w * inv + 7.5f), 0.f), 15.f); }
        u32x2 w;
        w.x = (q[0] | (q[4] << 4)) | ((q[1] | (q[5] << 4)) << 8) | ((q[2] | (q[6] << 4)) << 16) | ((q[3] | (q[7] << 4)) << 24);
        w.y = (q[8] | (q[12] << 4)) | ((q[9] | (q[13] << 4)) << 8) | ((q[10] | (q[14] << 4)) << 16) | ((q[11] | (q[15] << 4)) << 24);
        w.x ^= 0x80808080u; w.y ^= 0x80808080u;
        *(u32x2*)(dst + (size_t)r * 512 + 8 * lane) = w;
        if (lane == 0) scale[2 * r] = step;
    }
}

#define RED_STEP(N, S) do { const bool up_ = (lane & (S)) != 0; _Pragma("unroll") for (int j_ = 0; j_ < (N); ++j_) { const int a_ = p[j_], b_ = p[j_ + (N)]; const int send_ = up_ ? a_ : b_, keep_ = up_ ? b_ : a_; p[j_] = keep_ + shxi(send_, lane, (S)); } } while (0)
#define RED16(dst) do { RED_STEP(8, 8); RED_STEP(4, 4); RED_STEP(2, 2); RED_STEP(1, 1); int s_ = p[0]; s_ += shxi(s_, lane, 16); s_ += shxi(s_, lane, 32); dst = s_; } while (0)
#define G_SB() __builtin_amdgcn_sched_barrier(0)
#define G_LOAD(buf, tab, evec, jb) do { _Pragma("unroll") for (int jj_ = 0; jj_ < 16; ++jj_) { const int e_ = __builtin_amdgcn_readlane(evec, (jb) + jj_); buf[jj_] = __builtin_amdgcn_raw_buffer_load_b64(rs_##tab, (int)voff, e_ << 9, 0); } } while (0)
#define U_COMP(buf) do { _Pragma("unroll") for (int jj_ = 0; jj_ < 16; ++jj_) { const unsigned w0_ = buf[jj_].x, w1_ = buf[jj_].y; \
    int d_ = __builtin_amdgcn_sdot4((int)(w0_ & 0x0F0F0F0Fu), hq[0], 0, false); d_ = __builtin_amdgcn_sdot4((int)((w0_ >> 4) & 0x0F0F0F0Fu), hq[1], d_, false); \
    d_ = __builtin_amdgcn_sdot4((int)(w1_ & 0x0F0F0F0Fu), hq[2], d_, false); d_ = __builtin_amdgcn_sdot4((int)((w1_ >> 4) & 0x0F0F0F0Fu), hq[3], d_, false); p[jj_] = d_; } } while (0)
#define V_DW(o0, o1, o2, o3, wd, cs) do { float t0_, t1_, t2_, t3_; asm volatile("v_cvt_f32_ubyte0 %4, %8\n\tv_cvt_f32_ubyte1 %5, %8\n\tv_cvt_f32_ubyte2 %6, %8\n\tv_cvt_f32_ubyte3 %7, %8\n\tv_fmac_f32 %0, %9, %4\n\tv_fmac_f32 %1, %9, %5\n\tv_fmac_f32 %2, %9, %6\n\tv_fmac_f32 %3, %9, %7" \
    : "+v"(o0), "+v"(o1), "+v"(o2), "+v"(o3), "=&v"(t0_), "=&v"(t1_), "=&v"(t2_), "=&v"(t3_) : "v"(wd), "s"(cs)); } while (0)
#define V_COMP(buf, cvec, jb) do { _Pragma("unroll") for (int jj_ = 0; jj_ < 16; ++jj_) { const float c_ = __uint_as_float(__builtin_amdgcn_readlane(__float_as_uint(cvec), (jb) + jj_)); const unsigned w0_ = buf[jj_].x, w1_ = buf[jj_].y; \
    V_DW(o[0], o[1], o[2], o[3], w0_ & 0x0F0F0F0Fu, c_); V_DW(o[4], o[5], o[6], o[7], (w0_ >> 4) & 0x0F0F0F0Fu, c_); V_DW(o[8], o[9], o[10], o[11], w1_ & 0x0F0F0F0Fu, c_); V_DW(o[12], o[13], o[14], o[15], (w1_ >> 4) & 0x0F0F0F0Fu, c_); } } while (0)
template <bool NEXT_NORM>
__device__ __forceinline__ void peer_gather_phase(const int wv, bool dry, int vcu, const bf16* HN, const int* EXPERTS, const float* GATESP, const unsigned char* U, const float* SU, const unsigned char* Vtab, const float* SV,
                                                  float* X, const float* gnext, bf16* XN) {
    int ln_; asm volatile("v_mbcnt_lo_u32_b32 %0, -1, 0\n\tv_mbcnt_hi_u32_b32 %0, -1, %0" : "=v"(ln_)); const int tid = wv * 64 + ln_, lane = tid & 63, w = wv;
    const __amdgpu_buffer_rsrc_t rs_U = __builtin_amdgcn_make_buffer_rsrc((void*)U, (short)0, 16384 * 512, 0x00020000), rs_Vtab = __builtin_amdgcn_make_buffer_rsrc((void*)Vtab, (short)0, 16384 * 512, 0x00020000);
    const unsigned voff = (unsigned)lane * 8u;
    const int lg = lane >> 4;
#pragma unroll 1
    for (int i = 0; i < 16; ++i) {
        const int t = vcu * 128 + w * 16 + i;
        const int ev0 = EXPERTS[(size_t)t * 128 + lane], ev1 = EXPERTS[(size_t)t * 128 + 64 + lane];
        const float gv0 = GATESP[(size_t)t * 128 + lane], gv1 = GATESP[(size_t)t * 128 + 64 + lane];
        const v4u h0 = *(const v4u*)(HN + (size_t)t * 1024 + 16 * lane), h1 = *(const v4u*)(HN + (size_t)t * 1024 + 16 * lane + 8);
        float hf[16]; float am = 0.f;
#pragma unroll
        for (int k = 0; k < 4; ++k) { hf[2 * k] = bf_lo(h0[k]); hf[2 * k + 1] = bf_hi(h0[k]); hf[8 + 2 * k] = bf_lo(h1[k]); hf[9 + 2 * k] = bf_hi(h1[k]); }
#pragma unroll
        for (int k = 0; k < 16; ++k) am = fmaxf(am, fabsf(hf[k]));
        am = wave_max0(am);
        const float hinv = am > 0.f ? 127.f / am : 0.f, sh = am * (1.f / 127.f);
        int hq[4]; int hs = 0;
#pragma unroll
        for (int k = 0; k < 4; ++k) { const int q0 = (int)rintf(hf[4 * k] * hinv), q1 = (int)rintf(hf[4 * k + 1] * hinv), q2 = (int)rintf(hf[4 * k + 2] * hinv), q3 = (int)rintf(hf[4 * k + 3] * hinv); hs += (q0 + q1) + (q2 + q3);
            hq[k] = (int)(((unsigned)(q0 & 0xff)) | ((unsigned)(q1 & 0xff) << 8) | ((unsigned)(q2 & 0xff) << 16) | ((unsigned)(q3 & 0xff) << 24)); }
        hs = wave_sumi(hs);
        const float hoff = 7.5f * (float)hs;
        const float su0 = SU[ev0], su1 = SU[ev1], sv0 = SV[ev0], sv1 = SV[ev1];
        float o[16];
#pragma unroll
        for (int k = 0; k < 16; ++k) o[k] = 0.f;
        int p[16], r0, r1, r2, r3, r4, r5, r6, r7;
        u32x2 A[16], B[16], C[16];
        G_LOAD(A, U, ev0, 0); G_LOAD(B, U, ev0, 16); G_SB();
        G_LOAD(C, U, ev0, 32); G_SB(); U_COMP(A); RED16(r0); G_SB();
        G_LOAD(A, U, ev0, 48); G_SB(); U_COMP(B); RED16(r1); G_SB();
        G_LOAD(B, U, ev1, 0); G_SB(); U_COMP(C); RED16(r2); G_SB();
        G_LOAD(C, U, ev1, 16); G_SB(); U_COMP(A); RED16(r3); G_SB();
        G_LOAD(A, U, ev1, 32); G_SB(); U_COMP(B); RED16(r4); G_SB();
        G_LOAD(B, U, ev1, 48); G_SB(); U_COMP(C); RED16(r5); G_SB();
        G_LOAD(C, Vtab, ev0, 0); G_SB(); U_COMP(A); RED16(r6); G_SB();
        G_LOAD(A, Vtab, ev0, 16); G_SB(); U_COMP(B); RED16(r7); G_SB();
        const int d0 = lg == 0 ? r0 : (lg == 1 ? r1 : (lg == 2 ? r2 : r3)), d1 = lg == 0 ? r4 : (lg == 1 ? r5 : (lg == 2 ? r6 : r7));
        float act0 = ((float)d0 - hoff) * (sh * su0), act1 = ((float)d1 - hoff) * (sh * su1);
#ifdef PROBE_NOFFN
        const float coef0 = 0.f * act0, coef1 = 0.f * act1;
#else
        const float coef0 = gv0 * (0.5f * act0 * (1.f + erff(act0 * 0.70710678118f))) * sv0, coef1 = gv1 * (0.5f * act1 * (1.f + erff(act1 * 0.70710678118f))) * sv1;
#endif
        G_SB();
        G_LOAD(B, Vtab, ev0, 32); G_SB(); V_COMP(C, coef0, 0); G_SB();
        G_LOAD(C, Vtab, ev0, 48); G_SB(); V_COMP(A, coef0, 16); G_SB();
        G_LOAD(A, Vtab, ev1, 0); G_SB(); V_COMP(B, coef0, 32); G_SB();
        G_LOAD(B, Vtab, ev1, 16); G_SB(); V_COMP(C, coef0, 48); G_SB();
        G_LOAD(C, Vtab, ev1, 32); G_SB(); V_COMP(A, coef1, 0); G_SB();
        G_LOAD(A, Vtab, ev1, 48); G_SB(); V_COMP(B, coef1, 16); G_SB();
        V_COMP(C, coef1, 32); G_SB(); V_COMP(A, coef1, 48); G_SB();
        const float corr = 7.5f * wave_sum(coef0 + coef1, lane);
        float* xr = X + (size_t)t * 1024 + 16 * lane;
        f32x4 xv[4];
#pragma unroll
        for (int k = 0; k < 4; ++k) { xv[k] = *(const f32x4*)(xr + 4 * k); xv[k] += (f32x4){o[4 * k] - corr, o[4 * k + 1] - corr, o[4 * k + 2] - corr, o[4 * k + 3] - corr}; }
        if (!dry) {
#pragma unroll
            for (int k = 0; k < 4; ++k) *(f32x4*)(xr + 4 * k) = xv[k]; }
        if (NEXT_NORM && !dry) {
            float ss = 0.f;
#pragma unroll
            for (int k = 0; k < 4; ++k) ss += (xv[k].x * xv[k].x + xv[k].y * xv[k].y) + (xv[k].z * xv[k].z + xv[k].w * xv[k].w);
            const float rstd = rsqrtf(wave_sum(ss, lane) * (1.f / 1024.f) + EPS);
            v4u wa, wb;
#pragma unroll
            for (int k = 0; k < 4; ++k) { const f32x4 g = *(const f32x4*)(gnext + 16 * lane + 4 * k); const unsigned lo = pk2(xv[k].x * rstd * g.x, xv[k].y * rstd * g.y), hi2 = pk2(xv[k].z * rstd * g.z, xv[k].w * rstd * g.w);
                if (k < 2) { wa[2 * k] = lo; wa[2 * k + 1] = hi2; } else { wb[2 * (k - 2)] = lo; wb[2 * (k - 2) + 1] = hi2; } }
            *(v4u*)(XN + (size_t)t * 1024 + 16 * lane) = wa; *(v4u*)(XN + (size_t)t * 1024 + 16 * lane + 8) = wb;
        }
    }
}

__device__ __forceinline__ void rms_quant_pass(const bf16* X, const float* g, bf16* XN, unsigned char* HQ, float* SH, float* HS, int gw, int NGW, int lane) {
    const f32x4* gr = (const f32x4*)g + lane;
    u32x2 w4[2][4], n4[2][4];
#pragma unroll
    for (int r = 0; r < 2; ++r)
#pragma unroll
        for (int j = 0; j < 4; ++j) w4[r][j] = ((const u32x2*)(X + (size_t)(2 * gw + r) * D) + lane)[64 * j];
    for (int mb = gw; mb < T / 2; mb += NGW) {
        { const int mn = mb + NGW < T / 2 ? mb + NGW : mb;
#pragma unroll
          for (int r = 0; r < 2; ++r)
#pragma unroll
              for (int j = 0; j < 4; ++j) n4[r][j] = ((const u32x2*)(X + (size_t)(2 * mn + r) * D) + lane)[64 * j]; }
        f32x4 v[2][4]; float s[2] = {0.f, 0.f};
#pragma unroll
        for (int r = 0; r < 2; ++r)
#pragma unroll
            for (int j = 0; j < 4; ++j) { const u32x2 w = w4[r][j]; v[r][j] = (f32x4){bf_lo(w.x), bf_hi(w.x), bf_lo(w.y), bf_hi(w.y)}; s[r] += (v[r][j].x * v[r][j].x + v[r][j].y * v[r][j].y) + (v[r][j].z * v[r][j].z + v[r][j].w * v[r][j].w); }
#pragma unroll
        for (int r = 0; r < 2; ++r)
#pragma unroll
            for (int j = 0; j < 4; ++j) w4[r][j] = n4[r][j];
        float rstd[2], am[2] = {0.f, 0.f};
#pragma unroll
        for (int r = 0; r < 2; ++r) rstd[r] = rsqrtf(wave_sum(s[r], lane) * (1.f / 1024.f) + EPS);
#pragma unroll
        for (int j = 0; j < 4; ++j) { const f32x4 gg = gr[64 * j];
#pragma unroll
            for (int r = 0; r < 2; ++r) { v[r][j].x = v[r][j].x * rstd[r] * gg.x; v[r][j].y = v[r][j].y * rstd[r] * gg.y; v[r][j].z = v[r][j].z * rstd[r] * gg.z; v[r][j].w = v[r][j].w * rstd[r] * gg.w;
                am[r] = fmaxf(am[r], fmaxf(fmaxf(fabsf(v[r][j].x), fabsf(v[r][j].y)), fmaxf(fabsf(v[r][j].z), fabsf(v[r][j].w)))); } }
#pragma unroll
        for (int r = 0; r < 2; ++r) am[r] = wave_max0(am[r]);
#pragma unroll
        for (int r = 0; r < 2; ++r) {
            const int m = 2 * mb + r;
            const float hinv = am[r] > 0.f ? 127.f / am[r] : 0.f;
            int hs = 0;
            unsigned* q4 = (unsigned*)(HQ + (size_t)m * D) + lane;
#pragma unroll
            for (int j = 0; j < 4; ++j) { const int q0 = (int)rintf(v[r][j].x * hinv), q1 = (int)rintf(v[r][j].y * hinv), q2 = (int)rintf(v[r][j].z * hinv), q3 = (int)rintf(v[r][j].w * hinv); hs += (q0 + q1) + (q2 + q3);
                q4[64 * j] = ((unsigned)(q0 & 0xff)) | ((unsigned)(q1 & 0xff) << 8) | ((unsigned)(q2 & 0xff) << 16) | ((unsigned)(q3 & 0xff) << 24); }
            const float hsw = wave_sum((float)hs * ((lane & 1) ? -0.5f : 7.5f), lane);
            if (lane == 0) { SH[m] = am[r] * (1.f / 127.f); HS[m] = hsw; }
        }
    }
}
__device__ __forceinline__ int dpp_add_quad(int d) {
    d += __builtin_amdgcn_update_dpp(0, d, 0xB1, 0xF, 0xF, true);
    d += __builtin_amdgcn_update_dpp(0, d, 0x4E, 0xF, 0xF, true);
    return d;
}
__device__ __forceinline__ int dpp_add_oct(int d) {
    d += __builtin_amdgcn_update_dpp(0, d, 0xB1, 0xF, 0xF, true);
    d += __builtin_amdgcn_update_dpp(0, d, 0x4E, 0xF, 0xF, true);
    d += __builtin_amdgcn_update_dpp(0, d, 0x141, 0xF, 0xF, true);
    return d;
}
__device__ __forceinline__ int sdot4z(int a, int b) { int r; asm("v_dot4_i32_i8 %0, %1, %2, 0" : "=v"(r) : "v"(a), "v"(b)); return r; }
#define G1_IDS(E_, it_) do { const int t_ = t0 + ((it_) >> 1), hf_ = (it_) & 1; const v4u ea_ = *(const v4u*)((const unsigned short*)EXPERTS + (size_t)t_ * 128 + 16 * oct + 8 * hf_); \
    E_[0] = (int)(ea_.x & 0xffffu); E_[1] = (int)(ea_.x >> 16); E_[2] = (int)(ea_.y & 0xffffu); E_[3] = (int)(ea_.y >> 16); E_[4] = (int)(ea_.z & 0xffffu); E_[5] = (int)(ea_.z >> 16); E_[6] = (int)(ea_.w & 0xffffu); E_[7] = (int)(ea_.w >> 16); } while (0)
#define G1_HLD(H0_, H1_, tok_) do { const int t_ = t0 + (tok_); H0_ = *(const v4u*)(HQ + (size_t)t_ * 1024 + 256 * s + 32 * q8); H1_ = *(const v4u*)(HQ + (size_t)t_ * 1024 + 256 * s + 32 * q8 + 16); } while (0)
#define G1_ROWS(R_, E_) do { _Pragma("unroll") for (int j_ = 0; j_ < 8; ++j_) R_[j_] = __builtin_amdgcn_raw_buffer_load_b128(rs_U, (E_[j_] << 9) + soff, 0, 0); } while (0)
#define G1_PKH(a_, b_) __builtin_bit_cast(unsigned, __builtin_amdgcn_cvt_pkrtz((float)(a_) * 0.0078125f, (float)(b_) * 0.0078125f))
#define G1_COMP(R_, H0_, H1_, it_) do { int dd_[8]; _Pragma("unroll") for (int j_ = 0; j_ < 8; ++j_) { \
    int d_ = sdot4z((int)(R_[j_].x & 0x0F0F0F0Fu), (int)H0_.x), e_ = sdot4z((int)(R_[j_].x & 0xF0F0F0F0u), (int)H0_.y); \
    d_ = __builtin_amdgcn_sdot4((int)(R_[j_].y & 0x0F0F0F0Fu), (int)H0_.z, d_, false); e_ = __builtin_amdgcn_sdot4((int)(R_[j_].y & 0xF0F0F0F0u), (int)H0_.w, e_, false); \
    d_ = __builtin_amdgcn_sdot4((int)(R_[j_].z & 0x0F0F0F0Fu), (int)H1_.x, d_, false); e_ = __builtin_amdgcn_sdot4((int)(R_[j_].z & 0xF0F0F0F0u), (int)H1_.y, e_, false); \
    d_ = __builtin_amdgcn_sdot4((int)(R_[j_].w & 0x0F0F0F0Fu), (int)H1_.z, d_, false); e_ = __builtin_amdgcn_sdot4((int)(R_[j_].w & 0xF0F0F0F0u), (int)H1_.w, e_, false); \
    d_ = (d_ << 4) + e_; \
    dd_[j_] = dpp_add_oct(d_); } \
    if (q8 == 0) {   \
        *(v4u*)((unsigned short*)PART + ((size_t)s * T + t0 + ((it_) >> 1)) * 128 + 16 * oct + 8 * ((it_) & 1)) = (v4u){G1_PKH(dd_[0], dd_[1]), G1_PKH(dd_[2], dd_[3]), G1_PKH(dd_[4], dd_[5]), G1_PKH(dd_[6], dd_[7])}; } } while (0)
__device__ __forceinline__ void peer_g1_phase(const int wv, int vcu, const unsigned char* HQ, const int* EXPERTS, const unsigned char* U, int* PART) {
    int ln_; asm volatile("v_mbcnt_lo_u32_b32 %0, -1, 0\n\tv_mbcnt_hi_u32_b32 %0, -1, %0" : "=v"(ln_)); const int lane = ln_, oct = lane >> 3, q8 = lane & 7;
    const int s = vcu >> 6;
    const __amdgpu_buffer_rsrc_t rs_U = __builtin_amdgcn_make_buffer_rsrc((void*)U, (short)0, 16384 * 512, 0x00020000);
    const int soff = 128 * s + 16 * q8;
    const int t0 = 512 * (vcu & 63) + 64 * wv;
    int eA[8], eB[8]; v4u rA[8], rB[8], h0, h1, n0, n1;
    G1_IDS(eA, 0); G1_HLD(h0, h1, 0); G1_ROWS(rA, eA); G1_IDS(eB, 1);
#pragma unroll 1
    for (int i = 0; i < 128; i += 2) {
        G1_ROWS(rB, eB); __builtin_amdgcn_sched_barrier(0);
        G1_IDS(eA, (i + 2) & 127); G1_HLD(n0, n1, ((i + 2) & 127) >> 1); __builtin_amdgcn_sched_barrier(0);
        G1_COMP(rA, h0, h1, i); __builtin_amdgcn_sched_barrier(0);
        G1_ROWS(rA, eA); __builtin_amdgcn_sched_barrier(0);
        G1_IDS(eB, (i + 3) & 127); __builtin_amdgcn_sched_barrier(0);
        G1_COMP(rB, h0, h1, i + 1); __builtin_amdgcn_sched_barrier(0);
        h0 = n0; h1 = n1;
    }
}
#define G1B_H(w_, j_) ((float)__builtin_bit_cast(_Float16, (unsigned short)(((j_) & 1) ? ((w_)[(j_) >> 1] >> 16) : ((w_)[(j_) >> 1] & 0xffffu))))
__device__ __forceinline__ void peer_g1b_phase(const int* PART, const int* EXPERTS, const float* GATESP, const float* SU, const float* SV, const float* SH, const float* HS, unsigned char* COEFQ, float* SCT, float* CS, int gw, int NGW, int lane) {
    typedef int v4i_l __attribute__((ext_vector_type(4)));
    const int l32 = lane & 31, hf = lane >> 5;
    for (int tb = gw; tb < T / 8; tb += NGW) {
        u32x2 pr[4][4]; v4i_l ev[4]; f32x4 gt[4], su[4], sv[4]; float sh[4], hoff[4];
#pragma unroll
        for (int k = 0; k < 4; ++k) { const int t = 8 * tb + 2 * k + hf; const size_t idx = (size_t)t * 128 + 4 * l32;
#pragma unroll
            for (int x = 0; x < 4; ++x) pr[k][x] = *(const u32x2*)((const unsigned short*)PART + (size_t)x * T * 128 + idx);
            { const u32x2 e2_ = *(const u32x2*)((const unsigned short*)EXPERTS + idx); ev[k] = (v4i_l){(int)(e2_.x & 0xffffu), (int)(e2_.x >> 16), (int)(e2_.y & 0xffffu), (int)(e2_.y >> 16)}; } { const u32x2 g2_ = *(const u32x2*)((const unsigned short*)GATESP + idx); gt[k] = (f32x4){G1B_H(g2_, 0), G1B_H(g2_, 1), G1B_H(g2_, 2), G1B_H(g2_, 3)}; } sh[k] = SH[t]; hoff[k] = HS[t]; }
#pragma unroll
        for (int k = 0; k < 4; ++k)
#pragma unroll
            for (int j = 0; j < 4; ++j) { const u32x2 uv_ = *(const u32x2*)(SU + 2 * ev[k][j]); su[k][j] = __uint_as_float(uv_.x); sv[k][j] = __uint_as_float(uv_.y); }
#pragma unroll
        for (int k = 0; k < 4; ++k) {
            const int t = 8 * tb + 2 * k + hf;
            float cf[4]; float am = 0.f;
#pragma unroll
            for (int j = 0; j < 4; ++j) {
                const float d = (G1B_H(pr[k][0], j) + G1B_H(pr[k][1], j)) + (G1B_H(pr[k][2], j) + G1B_H(pr[k][3], j));
                const float act = (d * 8.f - hoff[k]) * (sh[k] * su[k][j]);
                cf[j] = gt[k][j] * (0.5f * act * (1.f + erff(act * 0.70710678118f))) * sv[k][j];
                am = fmaxf(am, fabsf(cf[j]));
            }
            DPP_STEP_F(am, fmaxf, 0x111, 0xF, 0.f); DPP_STEP_F(am, fmaxf, 0x112, 0xF, 0.f); DPP_STEP_F(am, fmaxf, 0x114, 0xF, 0.f); DPP_STEP_F(am, fmaxf, 0x118, 0xF, 0.f); DPP_STEP_F(am, fmaxf, 0x142, 0xA, 0.f);
            { const float a0 = __uint_as_float((unsigned)__builtin_amdgcn_readlane((int)__float_as_uint(am), 31)), a1 = __uint_as_float((unsigned)__builtin_amdgcn_readlane((int)__float_as_uint(am), 63)); am = hf ? a1 : a0; }
            const float inv = am > 0.f ? 127.f / am : 0.f;
            const int q0 = (int)rintf(cf[0] * inv), q1 = (int)rintf(cf[1] * inv), q2 = (int)rintf(cf[2] * inv), q3 = (int)rintf(cf[3] * inv);
            *(unsigned*)(COEFQ + (size_t)t * 128 + 4 * l32) = ((unsigned)(q0 & 0xff)) | ((unsigned)(q1 & 0xff) << 8) | ((unsigned)(q2 & 0xff) << 16) | ((unsigned)(q3 & 0xff) << 24);
            int cs = (q0 + q1) + (q2 + q3);
#define DPP_STEP_I2(ctrl, rmask) cs += __builtin_amdgcn_update_dpp(0, cs, ctrl, rmask, 0xF, false)
            DPP_STEP_I2(0x111, 0xF); DPP_STEP_I2(0x112, 0xF); DPP_STEP_I2(0x114, 0xF); DPP_STEP_I2(0x118, 0xF); DPP_STEP_I2(0x142, 0xA);
#undef DPP_STEP_I2
            if (l32 == 31) { SCT[t] = am * (1.f / 127.f); CS[t] = (float)cs; }
        }
    }
}
#define G2_IDS0(E_, C_, it_) do { const int t_ = t0 + ((it_) >> 1); const v4u ea_ = *(const v4u*)((const unsigned short*)EXPERTS + (size_t)t_ * 128 + 16 * oct); \
    E_[0] = (int)(ea_.x & 0xffffu); E_[1] = (int)(ea_.x >> 16); E_[2] = (int)(ea_.y & 0xffffu); E_[3] = (int)(ea_.y >> 16); E_[4] = (int)(ea_.z & 0xffffu); E_[5] = (int)(ea_.z >> 16); E_[6] = (int)(ea_.w & 0xffffu); E_[7] = (int)(ea_.w >> 16); \
    cT = *(const v4u*)(COEFQ + (size_t)t_ * 128 + 16 * oct); C_ = (u32x2){cT.x, cT.y}; } while (0)
#define G2_IDS1(E_, C_, it_) do { const int t_ = t0 + ((it_) >> 1); const v4u ea_ = *(const v4u*)((const unsigned short*)EXPERTS + (size_t)t_ * 128 + 16 * oct + 8); \
    E_[0] = (int)(ea_.x & 0xffffu); E_[1] = (int)(ea_.x >> 16); E_[2] = (int)(ea_.y & 0xffffu); E_[3] = (int)(ea_.y >> 16); E_[4] = (int)(ea_.z & 0xffffu); E_[5] = (int)(ea_.z >> 16); E_[6] = (int)(ea_.w & 0xffffu); E_[7] = (int)(ea_.w >> 16); \
    C_ = (u32x2){cT.z, cT.w}; } while (0)
#define G2_ROWS(R_, E_) do { _Pragma("unroll") for (int j_ = 0; j_ < 8; ++j_) R_[j_] = __builtin_amdgcn_raw_buffer_load_b128(rs_V, (E_[j_] << 9) + soff, 0, 0); } while (0)
#define G2_T4(ob, w0, w1, w2, w3, cq_) do { const unsigned a_ = __builtin_amdgcn_perm(w1, w0, 0x05010400u), b_ = __builtin_amdgcn_perm(w1, w0, 0x07030602u), c_ = __builtin_amdgcn_perm(w3, w2, 0x05010400u), d_ = __builtin_amdgcn_perm(w3, w2, 0x07030602u); \
    const unsigned y0_ = __builtin_amdgcn_perm(c_, a_, 0x05040100u), y1_ = __builtin_amdgcn_perm(c_, a_, 0x07060302u), y2_ = __builtin_amdgcn_perm(d_, b_, 0x05040100u), y3_ = __builtin_amdgcn_perm(d_, b_, 0x07060302u); \
    o[(ob)] = __builtin_amdgcn_sdot4((int)(y0_ & 0x0F0F0F0Fu), cq_, o[(ob)], false); o[(ob) + 4] = __builtin_amdgcn_sdot4((int)y0_, cq_, o[(ob) + 4], false); \
    o[(ob) + 1] = __builtin_amdgcn_sdot4((int)(y1_ & 0x0F0F0F0Fu), cq_, o[(ob) + 1], false); o[(ob) + 5] = __builtin_amdgcn_sdot4((int)y1_, cq_, o[(ob) + 5], false); \
    o[(ob) + 2] = __builtin_amdgcn_sdot4((int)(y2_ & 0x0F0F0F0Fu), cq_, o[(ob) + 2], false); o[(ob) + 6] = __builtin_amdgcn_sdot4((int)y2_, cq_, o[(ob) + 6], false); \
    o[(ob) + 3] = __builtin_amdgcn_sdot4((int)(y3_ & 0x0F0F0F0Fu), cq_, o[(ob) + 3], false); o[(ob) + 7] = __builtin_amdgcn_sdot4((int)y3_, cq_, o[(ob) + 7], false); } while (0)
#define G2_T4Z(ob, w0, w1, w2, w3, cq_) do { const unsigned a_ = __builtin_amdgcn_perm(w1, w0, 0x05010400u), b_ = __builtin_amdgcn_perm(w1, w0, 0x07030602u), c_ = __builtin_amdgcn_perm(w3, w2, 0x05010400u), d_ = __builtin_amdgcn_perm(w3, w2, 0x07030602u); \
    const unsigned y0_ = __builtin_amdgcn_perm(c_, a_, 0x05040100u), y1_ = __builtin_amdgcn_perm(c_, a_, 0x07060302u), y2_ = __builtin_amdgcn_perm(d_, b_, 0x05040100u), y3_ = __builtin_amdgcn_perm(d_, b_, 0x07060302u); \
    o[(ob)] = sdot4z((int)(y0_ & 0x0F0F0F0Fu), cq_); o[(ob) + 4] = sdot4z((int)y0_, cq_); \
    o[(ob) + 1] = sdot4z((int)(y1_ & 0x0F0F0F0Fu), cq_); o[(ob) + 5] = sdot4z((int)y1_, cq_); \
    o[(ob) + 2] = sdot4z((int)(y2_ & 0x0F0F0F0Fu), cq_); o[(ob) + 6] = sdot4z((int)y2_, cq_); \
    o[(ob) + 3] = sdot4z((int)(y3_ & 0x0F0F0F0Fu), cq_); o[(ob) + 7] = sdot4z((int)y3_, cq_); } while (0)
#define G2_REDI(N, S) do { const bool up_ = (lane & (S)) != 0; _Pragma("unroll") for (int j_ = 0; j_ < (N); ++j_) { const int a_ = o[j_], b_ = o[j_ + (N)]; const int send_ = up_ ? a_ : b_, keep_ = up_ ? b_ : a_; o[j_] = keep_ + shxi(send_, lane, (S)); } } while (0)
#define G2_ACC(R_, C_) do { \
    G2_T4(0, R_[0].x, R_[1].x, R_[2].x, R_[3].x, (int)C_.x); G2_T4(8, R_[0].y, R_[1].y, R_[2].y, R_[3].y, (int)C_.x); G2_T4(16, R_[0].z, R_[1].z, R_[2].z, R_[3].z, (int)C_.x); G2_T4(24, R_[0].w, R_[1].w, R_[2].w, R_[3].w, (int)C_.x); \
    G2_T4(0, R_[4].x, R_[5].x, R_[6].x, R_[7].x, (int)C_.y); G2_T4(8, R_[4].y, R_[5].y, R_[6].y, R_[7].y, (int)C_.y); G2_T4(16, R_[4].z, R_[5].z, R_[6].z, R_[7].z, (int)C_.y); G2_T4(24, R_[4].w, R_[5].w, R_[6].w, R_[7].w, (int)C_.y); } while (0)
#define G2_ACCZ(R_, C_) do { \
    G2_T4Z(0, R_[0].x, R_[1].x, R_[2].x, R_[3].x, (int)C_.x); G2_T4Z(8, R_[0].y, R_[1].y, R_[2].y, R_[3].y, (int)C_.x); G2_T4Z(16, R_[0].z, R_[1].z, R_[2].z, R_[3].z, (int)C_.x); G2_T4Z(24, R_[0].w, R_[1].w, R_[2].w, R_[3].w, (int)C_.x); \
    G2_T4(0, R_[4].x, R_[5].x, R_[6].x, R_[7].x, (int)C_.y); G2_T4(8, R_[4].y, R_[5].y, R_[6].y, R_[7].y, (int)C_.y); G2_T4(16, R_[4].z, R_[5].z, R_[6].z, R_[7].z, (int)C_.y); G2_T4(24, R_[4].w, R_[5].w, R_[6].w, R_[7].w, (int)C_.y); } while (0)
#define G2_RED8(N) do { _Pragma("unroll") for (int j_ = 0; j_ < (N); ++j_) \
    asm("s_nop 1\n\tv_add_u32_dpp %0, %0, %0 row_ror:8 row_mask:0xf bank_mask:0x3\n\tv_add_u32_dpp %0, %1, %1 row_ror:8 row_mask:0xf bank_mask:0xc" : "+v"(o[j_]) : "v"(o[j_ + (N)])); } while (0)
#define G2_RED16(N) do { _Pragma("unroll") for (int j_ = 0; j_ < (N); ++j_) { const auto r_ = __builtin_amdgcn_permlane16_swap((unsigned)o[j_], (unsigned)o[j_ + (N)], false, false); o[j_] = (int)r_[0] + (int)r_[1]; } } while (0)
#define G2_RED32(N) do { _Pragma("unroll") for (int j_ = 0; j_ < (N); ++j_) { const auto r_ = __builtin_amdgcn_permlane32_swap((unsigned)o[j_], (unsigned)o[j_ + (N)], false, false); o[j_] = (int)r_[0] + (int)r_[1]; } } while (0)
#define G2_FIN(tt_, xw_) do { G2_RED8(16); G2_RED16(8); \
      \
    o[4] -= o[0]; o[5] -= o[1]; o[6] -= o[2]; o[7] -= o[3]; G2_RED32(4); \
    const float sc_ = SCT[tt_] * omul, corr_ = ocor * CS[tt_]; \
    f32x4 xv_ = (f32x4){bf_lo(xw_.x), bf_hi(xw_.x), bf_lo(xw_.y), bf_hi(xw_.y)}; \
    xv_.x += sc_ * ((float)o[0] - corr_); xv_.y += sc_ * ((float)o[1] - corr_); xv_.z += sc_ * ((float)o[2] - corr_); xv_.w += sc_ * ((float)o[3] - corr_); \
    if (!NEXT) { *(f32x4*)(OUT + (size_t)(tt_) * 1024 + ocol) = xv_; } else { const u32x2 yw_ = (u32x2){pk2(xv_.x, xv_.y), pk2(xv_.z, xv_.w)}; *(u32x2*)(XR + (size_t)(tt_) * 1024 + ocol) = yw_; \
        const float y0_ = bf_lo(yw_.x), y1_ = bf_hi(yw_.x), y2_ = bf_lo(yw_.y), y3_ = bf_hi(yw_.y); \
        const float ss_ = wave_sum((y0_ * y0_ + y1_ * y1_) + (y2_ * y2_ + y3_ * y3_), lane); if (lane == 0) SS[(size_t)s * T + (tt_)] = ss_; } } while (0)
template <bool NEXT>
__device__ __forceinline__ void peer_g2_phase(const int wv, int vcu, const int* EXPERTS, const unsigned char* COEFQ, const float* SCT, const float* CS, const unsigned char* Vtab, bf16* XR, float* OUT, float* SS) {
    int ln_; asm volatile("v_mbcnt_lo_u32_b32 %0, -1, 0\n\tv_mbcnt_hi_u32_b32 %0, -1, %0" : "=v"(ln_)); const int lane = ln_, oct = lane >> 3, q8 = lane & 7;
    const int s = vcu >> 6;
    const __amdgpu_buffer_rsrc_t rs_V = __builtin_amdgcn_make_buffer_rsrc((void*)Vtab, (short)0, 16384 * 512, 0x00020000);
    const int soff = 128 * s + 16 * q8;
    const int ocol = 256 * s + 32 * q8 + 16 * ((lane >> 3) & 1) + 8 * ((lane >> 4) & 1) + 4 * ((lane >> 5) & 1);
    const float omul = (lane & 32) ? 0.0625f : 1.f, ocor = (lane & 32) ? -8.f : 7.5f;
    const int t0 = 512 * (vcu & 63) + 64 * wv;
    int eA[8], eB[8]; u32x2 cA, cB, cC; v4u rA[8], rB[8];
    v4u cT;
    G2_IDS0(eA, cA, 0); G2_ROWS(rA, eA); G2_IDS1(eB, cB, 1);
#pragma unroll 1
    for (int i = 0; i < 128; i += 2) {
        const int tt = t0 + (i >> 1);
        const u32x2 xw = *(const u32x2*)(XR + (size_t)tt * 1024 + ocol);
        int o[32];
        G2_ROWS(rB, eB); __builtin_amdgcn_sched_barrier(0);
        G2_IDS0(eA, cC, (i + 2) & 127); __builtin_amdgcn_sched_barrier(0);
        G2_ACCZ(rA, cA); __builtin_amdgcn_sched_barrier(0);
        G2_ROWS(rA, eA); cA = cC; __builtin_amdgcn_sched_barrier(0);
        G2_IDS1(eB, cC, (i + 3) & 127); __builtin_amdgcn_sched_barrier(0);
        G2_ACC(rB, cB); __builtin_amdgcn_sched_barrier(0);
        G2_FIN(tt, xw);
        cB = cC;
    }
}

__device__ __forceinline__ void qknorm_rope_pass(bf16* Q1, bf16* K1, const float* qg, const float* kg, const float* rope, size_t gtid, size_t gthreads) {
    const size_t NROWS = (size_t)2 * 64 * 2 * 4096;
    const int lane = (int)(gtid & 63);
    for (size_t id = gtid; id < NROWS * 8; id += gthreads) {
        const size_t rowg = id >> 3; const int part = (int)(id & 7);
        const bool isk = rowg >= NROWS / 2; const size_t row = isk ? rowg - NROWS / 2 : rowg;
        bf16* ptr = (isk ? K1 : Q1) + row * 64 + part * 8; const float* g = (isk ? kg : qg) + part * 8;
        const int s = (int)(row & 4095); const int bh = (int)(row >> 13); const int bidx = bh >> 3; const size_t mtok = (size_t)bidx * 4096 + s;
        const v4u raw = *(const v4u*)ptr;
        float x[8];
#pragma unroll
        for (int i = 0; i < 4; ++i) { x[2 * i] = bf_lo(raw[i]); x[2 * i + 1] = bf_hi(raw[i]); }
        float ss = 0.f;
#pragma unroll
        for (int i = 0; i < 8; ++i) ss += x[i] * x[i];
        ss += shx(ss, lane, 1); ss += shx(ss, lane, 2); ss += shx(ss, lane, 4);
        const float rstd = rsqrtf(ss * (1.f / 64.f) + EPS);
        float y[8], other[8];
#pragma unroll
        for (int i = 0; i < 8; ++i) y[i] = x[i] * rstd * g[i];
#pragma unroll
        for (int i = 0; i < 8; ++i) other[i] = shx(y[i], lane, 1);
        if (part < 2) { const float* cs = rope + mtok * 16;
#pragma unroll
            for (int i = 0; i < 8; ++i) { const float co = cs[i], si = cs[8 + i]; y[i] = (part == 0) ? (y[i] * co - other[i] * si) : (y[i] * co + other[i] * si); } }
        const float sc = isk ? 1.f : (0.125f * 1.44269504089f);
        v4u o;
#pragma unroll
        for (int i = 0; i < 4; ++i) o[i] = pk2(y[2 * i] * sc, y[2 * i + 1] * sc);
        *(v4u*)ptr = o;
    }
}

#define AT_DMA(kt_, slot_) do { \
    _Pragma("unroll") for (int i_ = 0; i_ < 2; ++i_) \
        glds16s(K1 + ((size_t)((bh * 2 + i_) * 4096 + (kt_) * 64)) * 64, dkoff, (unsigned)__builtin_amdgcn_readfirstlane((int)(ldsb + (slot_) * 32768 + i_ * 8192 + w * 1024))); \
    _Pragma("unroll") for (int i_ = 0; i_ < 2; ++i_) \
        glds16s(V1 + ((size_t)(bh * 4096 + (kt_) * 64 + 4 * i_)) * 128, dvoff, (unsigned)__builtin_amdgcn_readfirstlane((int)(ldsb + (slot_) * 32768 + 16384 + w * 2048 + i_ * 1024))); } while (0)
typedef short v4i16_t __attribute__((ext_vector_type(4)));
__device__ __forceinline__ bf16x8 vtr8(const LAS bf16* p) {
    const v4i16_t lo = __builtin_amdgcn_ds_read_tr16_b64_v4i16((LAS v4i16_t*)p), hi = __builtin_amdgcn_ds_read_tr16_b64_v4i16((LAS v4i16_t*)(p + 8 * 128));
    return (bf16x8){lo[0], lo[1], lo[2], lo[3], hi[0], hi[1], hi[2], hi[3]};
}
#define AT_KLD(ks_) do { ka[2 * (ks_)] = *(const LAS bf16x8*)(Kc + r32 * 128 + (((2 * (ks_) + hi) ^ kx0) << 4)); ka[2 * (ks_) + 1] = *(const LAS bf16x8*)(Kc + (32 + r32) * 128 + (((2 * (ks_) + hi) ^ kx1) << 4)); } while (0)
#define AT_TILE(SA0_, SA1_, SN0_, SN1_, KT_) do { \
            if ((KT_) + 2 < 64) AT_DMA((KT_) + 2, b2); \
            const LAS unsigned char* Kc = lds + b1 * 32768 + c * 8192; \
            const LAS unsigned char* Vb = lds + b0 * 32768 + 16384 + vrow * 256 + 8 * (vp & 1); \
_Pragma("unroll") \
            for (int r = 0; r < 16; ++r) { SN0_[r] = 0.f; SN1_[r] = 0.f; } \
            bf16x8 ka[8]; \
            AT_KLD(0); AT_KLD(1); \
            __builtin_amdgcn_sched_barrier(0); \
_Pragma("unroll") \
            for (int ks = 0; ks < 4; ++ks) { \
_Pragma("unroll") \
                for (int r = 0; r < 3; ++r) SA0_[4 * ks + r] = __builtin_amdgcn_exp2f(OFFS ? SA0_[4 * ks + r] - offs : SA0_[4 * ks + r]); \
                __builtin_amdgcn_sched_barrier(0); \
                SN0_ = mfma32(ka[2 * ks], bq[ks], SN0_); \
_Pragma("unroll") \
                for (int r = 3; r < 4; ++r) SA0_[4 * ks + r] = __builtin_amdgcn_exp2f(OFFS ? SA0_[4 * ks + r] - offs : SA0_[4 * ks + r]); \
_Pragma("unroll") \
                for (int r = 0; r < 3; ++r) SA1_[4 * ks + r] = __builtin_amdgcn_exp2f(OFFS ? SA1_[4 * ks + r] - offs : SA1_[4 * ks + r]); \
                __builtin_amdgcn_sched_barrier(0); \
                SN1_ = mfma32(ka[2 * ks + 1], bq[ks], SN1_); \
                if (ks < 2) AT_KLD(ks + 2); \
_Pragma("unroll") \
                for (int r = 3; r < 4; ++r) SA1_[4 * ks + r] = __builtin_amdgcn_exp2f(OFFS ? SA1_[4 * ks + r] - offs : SA1_[4 * ks + r]); \
                __builtin_amdgcn_sched_barrier(0); \
            } \
            bf16x8 pa[4]; bf16x8 vf[4], vn[4]; \
_Pragma("unroll") \
            for (int db = 0; db < 4; ++db) vf[db] = vtr8((const LAS bf16*)(Vb + (((4 * db + 2 * vg + (vp >> 1)) ^ ((vrow & 3) << 2)) << 4))); \
            float ls = 0.f; \
            { v4u t0; \
_Pragma("unroll") \
              for (int k = 0; k < 4; ++k) { t0[k] = pk2(SA0_[2 * k], SA0_[2 * k + 1]); ls = addf_np(ls, addf_np(SA0_[2 * k], SA0_[2 * k + 1])); } \
              pa[0] = __builtin_bit_cast(bf16x8, t0); } \
            __builtin_amdgcn_sched_barrier(0); \
_Pragma("unroll") \
            for (int sp_ = 0; sp_ < 4; ++sp_) { \
                if (sp_ < 3) { \
_Pragma("unroll") \
                    for (int db = 0; db < 4; ++db) vn[db] = vtr8((const LAS bf16*)(Vb + (16 * (sp_ + 1)) * 256 + (((4 * db + 2 * vg + (vp >> 1)) ^ ((vrow & 3) << 2)) << 4))); \
                } \
_Pragma("unroll") \
                for (int db = 0; db < 4; ++db) Oa[db] = mfma32(pa[sp_], vf[db], Oa[db]); \
                if (sp_ < 3) { v4u t0; \
_Pragma("unroll") \
                    for (int k = 0; k < 4; ++k) { const float x0 = (sp_ == 0) ? SA0_[8 + 2 * k] : (sp_ == 1 ? SA1_[2 * k] : SA1_[8 + 2 * k]), x1 = (sp_ == 0) ? SA0_[9 + 2 * k] : (sp_ == 1 ? SA1_[2 * k + 1] : SA1_[9 + 2 * k]); t0[k] = pk2(x0, x1); ls = addf_np(ls, addf_np(x0, x1)); } \
                    pa[sp_ + 1] = __builtin_bit_cast(bf16x8, t0); } \
                __builtin_amdgcn_sched_barrier(0); \
                if (sp_ < 3) { \
_Pragma("unroll") \
                    for (int db = 0; db < 4; ++db) vf[db] = vn[db]; \
                } \
            } \
            lsum += ls; \
            { const int tb = b0; b0 = b1; b1 = b2; b2 = tb; } \
            AT_WAIT_BAR(); } while (0)
template <bool OFFS>
__device__ __forceinline__ void attn_units(const int wv, LAS unsigned char* lds, int vcu, const bf16* Q1, const bf16* K1, const bf16* V1, bf16* O, const float* subln, float lam, float offs) {
    int ln_; asm volatile("v_mbcnt_lo_u32_b32 %0, -1, 0\n\tv_mbcnt_hi_u32_b32 %0, -1, %0" : "=v"(ln_)); const int tid = wv * 64 + ln_, lane = tid & 63, w = wv, r32 = lane & 31, hi = lane >> 5, qt = w & 3, c = w >> 2;
    LAS float* lbuf = (LAS float*)(lds + 135168 + w * 128);
    LAS float* Obuf = (LAS float*)lds;
    if (wv >= 4) __builtin_amdgcn_s_setprio(1);
    const unsigned ldsb = (unsigned)(uintptr_t)lds;
    const unsigned dkoff = (unsigned)(((8 * w + (lane >> 3)) * 64 + (((lane & 7) ^ (((8 * w + (lane >> 3)) >> 1) & 7)) * 8)) * 2);
    const unsigned dvoff = (unsigned)(((8 * w + (lane >> 4)) * 128 + (((lane & 15) ^ (((8 * w + (lane >> 4)) & 3) << 2)) * 8)) * 2);
    bf16x8 bq[4];
#pragma unroll
    for (int ks = 0; ks < 4; ++ks) bq[ks] = *(const bf16x8*)(Q1 + ((size_t)((((vcu >> 5) * 8) * 2 + c) * 4096 + (vcu & 31) * 128 + qt * 32 + r32)) * 64 + ks * 16 + 8 * hi);
#pragma unroll 1
    for (int ui = 0; ui < 8; ++ui) {
        const int bh = (vcu >> 5) * 8 + ui, qb = vcu & 31, b = bh >> 3, h = bh & 7;
        f32x16 Oa[4];
#pragma unroll
        for (int db = 0; db < 4; ++db)
#pragma unroll
            for (int r = 0; r < 16; ++r) Oa[db][r] = 0.f;
        float lsum = 0.f;
        AT_DMA(0, 0); AT_DMA(1, 1);
        AT_WAIT_BAR();
        const int kx0 = (r32 >> 1) & 7, kx1 = ((32 + r32) >> 1) & 7;
        const int vrow = 4 * hi + ((lane >> 2) & 3), vg = (lane >> 4) & 1, vp = lane & 3;
        f32x16 s0, s1;
        { const LAS unsigned char* Kc = lds + c * 8192;
#pragma unroll
          for (int r = 0; r < 16; ++r) { s0[r] = 0.f; s1[r] = 0.f; }
#pragma unroll
          for (int ks = 0; ks < 4; ++ks) { const bf16x8 a0 = *(const LAS bf16x8*)(Kc + r32 * 128 + (((2 * ks + hi) ^ kx0) << 4)), a1 = *(const LAS bf16x8*)(Kc + (32 + r32) * 128 + (((2 * ks + hi) ^ kx1) << 4));
              s0 = mfma32(a0, bq[ks], s0); s1 = mfma32(a1, bq[ks], s1); } }
        int b0 = 0, b1 = 1, b2 = 2;
        f32x16 n0, n1;
#pragma unroll 1
        for (int kt = 0; kt < 64; kt += 2) {
            AT_TILE(s0, s1, n0, n1, kt);
            AT_TILE(n0, n1, s0, s1, kt + 1);
        }
        if (ui < 7) {
#pragma unroll
            for (int ks = 0; ks < 4; ++ks) bq[ks] = *(const bf16x8*)(Q1 + ((size_t)(((bh + 1) * 2 + c) * 4096 + qb * 128 + qt * 32 + r32)) * 64 + ks * 16 + 8 * hi);
        }
        lsum += shx(lsum, lane, 32);
        lbuf[r32] = lsum;
#pragma unroll
        for (int r = 0; r < 16; ++r) { const int qrow = (r & 3) + 8 * (r >> 2) + 4 * hi; const float inv = 1.f / lbuf[qrow];
#pragma unroll
            for (int db = 0; db < 4; ++db) Obuf[(c * 128 + qt * 32 + qrow) * 132 + 32 * db + r32] = Oa[db][r] * inv; }
        __syncthreads();
        { const int row = tid >> 2, qd = tid & 3;
          float dv[32]; float ss = 0.f;
#pragma unroll
          for (int k = 0; k < 8; ++k) { const f32x4 o0 = *(const LAS f32x4*)(Obuf + row * 132 + qd * 32 + 4 * k), o1 = *(const LAS f32x4*)(Obuf + (128 + row) * 132 + qd * 32 + 4 * k);
#pragma unroll
              for (int e = 0; e < 4; ++e) { const float d = o0[e] - lam * o1[e]; dv[4 * k + e] = d; ss += d * d; } }
          ss += shx(ss, lane, 1); ss += shx(ss, lane, 2);
          const float rstd = rsqrtf(ss * (1.f / 128.f) + EPS) * (127.f / 6.f); (void)subln;
          unsigned char* op = (unsigned char*)O + ((size_t)b * 4096 + qb * 128 + row) * 1024 + h * 128 + qd * 32;
#pragma unroll
          for (int k = 0; k < 2; ++k) { v4u o;
#pragma unroll
              for (int e = 0; e < 4; ++e) { unsigned q = 0u;
#pragma unroll
                  for (int z = 0; z < 4; ++z) q |= ((unsigned)((int)rintf(fminf(fmaxf(dv[16 * k + 4 * e + z] * rstd, -127.f), 127.f)) & 0xff)) << (8 * z);
                  o[e] = q; }
              *(v4u*)(op + 16 * k) = o; } }
        __syncthreads();
    }
    __builtin_amdgcn_s_setprio(0);
}
__device__ __forceinline__ void attn_phase(const int wv, LAS unsigned char* lds, int vcu, const bf16* Q1, const bf16* K1, const bf16* V1, bf16* O, const float* qg, const float* kg,
                                           const float* lq1, const float* lk1, const float* lq2, const float* lk2, const float* subln) {
    float s1 = 0.f, s2 = 0.f, mq = 0.f, mk = 0.f;
    for (int i = 0; i < 64; ++i) { s1 += lq1[i] * lk1[i]; s2 += lq2[i] * lk2[i]; mq = fmaxf(mq, fabsf(qg[i])); mk = fmaxf(mk, fabsf(kg[i])); }
    const float lam = expf(s1) - expf(s2) + LAMBDA_INIT;
    const float offs = 8.f * mq * mk * 1.44269504089f * 1.02f + 0.25f;
    if (offs < 24.f) attn_units<false>(wv, lds, vcu, Q1, K1, V1, O, subln, lam, 0.f);
    else attn_units<true>(wv, lds, vcu, Q1, K1, V1, O, subln, lam, offs);
}
#undef AT_LOAD
#undef AT_WRITE
struct Args { const void* in[27]; float* out; unsigned char* ws; };
#define KARG(i) ({ GAS const void* p_; asm volatile("s_load_dwordx2 %0, %1, %2\n\ts_waitcnt lgkmcnt(0)" : "=s"(p_) : "s"(__builtin_amdgcn_kernarg_segment_ptr()), "i"(8 * (i))); (const void*)p_; })
#define KIN(i) ((const float*)KARG(i))
#define KOUT() ((float*)KARG(27))
#define KWS() ((unsigned char*)KARG(28))
#define WSP(T_, off) ((T_*)(KWS() + (off)))
__global__ void __launch_bounds__(NWAVES * 64, 2) mk_fwd(Args args) {
    extern __shared__ __attribute__((aligned(16))) unsigned char lds_raw[];
    LAS unsigned char* lds = (LAS unsigned char*)lds_raw;
    const int G = gridDim.x, bx = blockIdx.x;
    const int wv = __builtin_amdgcn_readfirstlane((int)(threadIdx.x >> 6));
    const int vcu = (G % 8 == 0) ? (bx % 8) * (G / 8) + bx / 8 : bx;
#define PH_IDS() int ln_; asm volatile("v_mbcnt_lo_u32_b32 %0, -1, 0\n\tv_mbcnt_hi_u32_b32 %0, -1, %0" : "=v"(ln_)); const int lane = ln_, wave = wv, tid = wv * 64 + ln_; \
    const int gw = vcu * NWAVES + wave, NGW = G * NWAVES; const size_t gtid = (size_t)vcu * (NWAVES * 64) + tid, gthreads = (size_t)G * (NWAVES * 64); (void)lane; (void)gw; (void)NGW; (void)gtid; (void)gthreads
    if (threadIdx.x < 32) ((LAS unsigned*)(lds + MISC_OFF))[threadIdx.x] = 0u;
    __syncthreads();
    (void)xcd_barrier_post((unsigned*)(WSP(gu32, WS_CTL) + CW_BAR), (volatile LAS unsigned*)(lds + MISC_OFF) + 8);
#define STAMP() do {} while (0)
#ifndef PROBE_DUP
#define PROBE_DUP 0
#endif
#ifndef PROBE_VAR
#define PROBE_VAR 0
#endif
#ifndef PROBE_MULT
#define PROBE_MULT 1
#endif
#define REPS(bit) _Pragma("unroll 1") for (int rep_ = 0; rep_ < 1 + PROBE_MULT * ((PROBE_DUP >> (bit)) & 1); ++rep_)
#define GRID_BAR1() do { XcdBarrier b_; b_.bar = (unsigned*)(WSP(gu32, WS_CTL) + CW_BAR); b_.x = xb_xcc_id(); b_.st = (volatile LAS unsigned*)(lds + MISC_OFF) + 8; xcd_barrier(b_); } while (0)
#define GRID_BAR() do { GRID_BAR1(); if ((PROBE_DUP >> 9) & 1) GRID_BAR1(); } while (0)

    REPS(5) {
        PH_IDS();
        LAS float* scr = (LAS float*)(lds + wave * 16384);
        constexpr int I0 = 16 * 97, I1 = 16 * 32, I2 = 16 * 64, I3 = 16 * 96, I4 = 16 * 32, I5 = 16 * 64, NITEMS = I0 + I1 + I2 + I3 + I4 + I5;
        for (int it = gw; it < NITEMS - I3 - I4; it += NGW) {
            int r = it;
            if (r < I0) { p0_transpose_item(KIN(3), 1024, 3104, WSP(bf16, WS_WIN), scr, r, lane); continue; } r -= I0;
            if (r < I1) { p0_transpose_item(KIN(6), 1024, 1024, WSP(bf16, WS_WO0), scr, r, lane); continue; } r -= I1;
            if (r < I2) { p0_transpose_item(KIN(8), 1024, 2048, WSP(bf16, WS_WQ0), scr, r, lane); continue; } r -= I2;
            p0_transpose_item(KIN(23), 1024, 2048, WSP(bf16, WS_WQ1), scr, r, lane);
        }
        cvt_range(KIN(9), WSP(bf16, WS_KEY0), (size_t)262144, gtid, gthreads);
        cvt_range(KIN(24), WSP(bf16, WS_KEY1), (size_t)262144, gtid, gthreads);
        rms_pass(KIN(0), KIN(2), WSP(bf16, WS_B0), WSP(unsigned char, WS_R5), WSP(float, WS_SC + 4 * 65536), gw, NGW, lane);
        { const int* positions = (const int*)KARG(1); float* ROPE = WSP(float, WS_ROPE);
          for (size_t id = gtid; id < (size_t)T * 8; id += gthreads) { const size_t mtok = id >> 3; const int i = (int)(id & 7);
            const float inv = powf(500000.0f, -(float)i * 2.0f / 16.0f); const float ang = (float)positions[mtok] * inv;
            float sn, cs; sincosf(ang, &sn, &cs); ROPE[mtok * 16 + i] = cs; ROPE[mtok * 16 + 8 + i] = sn; } }
    }
    GRID_BAR();
    REPS(13) { PH_IDS();
        quant8_rows_bf16(WSP(bf16, WS_WIN), WSP(unsigned char, WS_I8 + 4 * MiB + 512 * 1024), WSP(float, WS_I8 + 4 * MiB + 16384), 3072, gw, NGW, lane);
        gates_rows_mfma(WSP(unsigned char, WS_R5), WSP(float, WS_SC + 4 * 65536), WSP(bf16, WS_WIN) + (size_t)3072 * 1024, KIN(4), WSP(float, WS_GATES), gw, lane); }
    GRID_BAR();
    REPS(3) {
        unsigned char* ws = KWS();
        pg8::Gemm g{(const bf16*)(ws + WS_R5), (const bf16*)(ws + WS_I8 + 4 * MiB + 512 * 1024), T, 3072, 512}; pg8::StaticOrder S; S.init(T, 3072, G, bx);
        pg8::EpiInProj E{(bf16*)(ws + WS_R1), (bf16*)(ws + WS_R1 + 32 * MiB), (bf16*)(ws + WS_R2), (bf16*)(ws + WS_R3), (const float*)(ws + WS_SC + 4 * 65536), (const float*)(ws + WS_I8 + 4 * MiB + 16384)};
        pg8::gemm_phase<pg8::EpiInProj, pg8::StaticOrder, true, true>(lds, g, S, E, wv);
    }
    GRID_BAR();
    if ((bx >> 3) & 1) REPS(20) { PH_IDS(); const int gwi = ((bx >> 4) * 8 + (bx & 7)) * NWAVES + wave, NGWI = 128 * NWAVES; (void)gw; (void)NGW;
        { LAS float* scr = (LAS float*)(lds + wave * 16384);
          for (int it = gwi; it < 16 * 96 + 16 * 32; it += NGWI) { if (it < 16 * 96) p0_transpose_item(KIN(13), 1024, 3072, WSP(bf16, WS_WQKV), scr, it, lane, KIN(12), true); else p0_transpose_item(KIN(21), 1024, 1024, WSP(bf16, WS_WO1), scr, it - 16 * 96, lane); } }
        quant4_rows(KIN(10), WSP(unsigned char, WS_U0), WSP(float, WS_SC), 16384, gwi, NGWI, lane);
        quant4_rows(KIN(11), WSP(unsigned char, WS_V0T), WSP(float, WS_SC + 4), 16384, gwi, NGWI, lane);
        quant4_rows(KIN(25), WSP(unsigned char, WS_U1), WSP(float, WS_SC + 2 * 65536), 16384, gwi, NGWI, lane);
        quant4_rows(KIN(26), WSP(unsigned char, WS_V1T), WSP(float, WS_SC + 2 * 65536 + 4), 16384, gwi, NGWI, lane);
        quant8_rows_bf16(WSP(bf16, WS_WQ0), WSP(unsigned char, WS_I8), WSP(float, WS_I8 + 4 * MiB), 2048, gwi, NGWI, lane);
        quant8_rows_bf16(WSP(bf16, WS_WQ1), WSP(unsigned char, WS_I8 + 2 * MiB), WSP(float, WS_I8 + 4 * MiB + 8192), 2048, gwi, NGWI, lane);
        quant8_rows_bf16(WSP(bf16, WS_WO0), WSP(unsigned char, WS_END), WSP(float, WS_END + 1 * MiB), 1024, gwi, NGWI, lane); }
    REPS(2) { unsigned char* ws = KWS(); mlstm_phase2(wv, lds, (const bf16*)(ws + WS_R1), (const bf16*)(ws + WS_R1 + 32 * MiB), (const bf16*)(ws + WS_R2), (const float*)(ws + WS_GATES), (bf16*)(ws + WS_R4), (bf16*)(ws + WS_R5)); }
    GRID_BAR();
    REPS(6) { PH_IDS(); unsigned char* ws = KWS(); hs_pass((const bf16*)(ws + WS_R4), (const bf16*)(ws + WS_R5), (const bf16*)(ws + WS_R3), KIN(5), ws + WS_B0, (float*)(ws + WS_SC + 12 * 65536), gw, NGW, lane);
        quant8_rows_bf16_kf(WSP(bf16, WS_WO1), WSP(unsigned char, WS_END + 2 * MiB), WSP(float, WS_END + 3 * MiB), 1024, KIN(20), gw, NGW, lane); }
    GRID_BAR();
#pragma unroll 1
    for (int L = 0; L < 2; ++L) {
        if (L == 1) {
            REPS(10) {
                unsigned char* ws = KWS();
                pg8::Gemm g{(const bf16*)(ws + WS_R1), (const bf16*)(ws + WS_WQKV), T, 3072, 1024}; pg8::StaticOrder S; S.init(T, 3072, G, bx);
                pg8::EpiQKV E{(bf16*)(ws + WS_R2), (bf16*)(ws + WS_R3), (bf16*)(ws + WS_R4), (const float*)(ws + 3 * MiB), KIN(14), KIN(15), (const float*)(ws + WS_ROPE), (LAS float*)(lds + 131072)};
                pg8::gemm_phase<pg8::EpiQKV, pg8::StaticOrder, true, true>(lds, g, S, E, wv);
            }
            GRID_BAR();
            REPS(0) { unsigned char* ws = KWS(); attn_phase(wv, lds, vcu, (const bf16*)(ws + WS_R2), (const bf16*)(ws + WS_R3), (const bf16*)(ws + WS_R4), (bf16*)(ws + WS_B0), KIN(14), KIN(15), KIN(16), KIN(17), KIN(18), KIN(19), KIN(20)); }
            GRID_BAR();
        }
        _Pragma("unroll 1") for (int rep_ = 0; rep_ < 1 + ((L == 0) ? PROBE_MULT * ((PROBE_DUP >> 12) & 1) : 0); ++rep_) {
            unsigned char* ws = KWS();
            pg8::Gemm g{(const bf16*)(ws + WS_B0), (const bf16*)(ws + WS_WO1), T, 1024, 1024}; pg8::StaticOrder S; S.init(T, 1024, G, bx);
            if (L == 0) { pg8::Gemm g8{(const bf16*)(ws + WS_B0), (const bf16*)(ws + WS_END), T, 1024, 512};
                pg8::EpiResI8 E{KIN(0), (bf16*)(ws + WS_R1), (const float*)(ws + WS_SC + 12 * 65536), (const float*)(ws + WS_END + 1 * MiB)}; pg8::gemm_phase<pg8::EpiResI8, pg8::StaticOrder, true, true>(lds, g8, S, E, wv); }
            else { pg8::Gemm g8{(const bf16*)(ws + WS_B0), (const bf16*)(ws + WS_END + 2 * MiB), T, 1024, 512};
                pg8::EpiRes1I8 E{(bf16*)(ws + WS_R1), (const float*)(ws + WS_END + 3 * MiB)}; pg8::gemm_phase<pg8::EpiRes1I8, pg8::StaticOrder, true, true>(lds, g8, S, E, wv); }
        }
        GRID_BAR();
        REPS(7) { PH_IDS(); unsigned char* ws = KWS(); rms_quant_pass((const bf16*)(ws + WS_R1), L ? KIN(22) : KIN(7), (bf16*)(ws + WS_B0), ws + WS_R5, (float*)(ws + WS_SC + 4 * 65536), (float*)(ws + WS_SC + 6 * 65536), gw, NGW, lane); }
        GRID_BAR();
        REPS(11) {
            unsigned char* ws = KWS();
            pg8::Gemm g{(const bf16*)(ws + WS_R5), (const bf16*)(ws + WS_I8 + (L ? 2 : 0) * MiB), T, 2048, 512}; pg8::StaticOrder S; S.init(T, 2048, G, bx);
            pg8::EpiPlainI8 E{(bf16*)(ws + WS_R2), 2048, (const float*)(ws + WS_SC + 4 * 65536), (const float*)(ws + WS_I8 + 4 * MiB + (L ? 8192 : 0))};
            pg8::gemm_phase<pg8::EpiPlainI8, pg8::StaticOrder, true, true>(lds, g, S, E, wv);
        }
        GRID_BAR();
        REPS(4) { unsigned char* ws = KWS(); if (rep_ < PROBE_MULT * ((PROBE_DUP >> 4) & 1)) peer_topk_phase<PROBE_VAR>(wv, lds, vcu, (const bf16*)(ws + WS_R2), (const bf16*)(ws + (L ? WS_KEY1 : WS_KEY0)), (int*)(ws + WS_R4), (float*)(ws + WS_R4 + 16 * MiB)); else peer_topk_phase<0>(wv, lds, vcu, (const bf16*)(ws + WS_R2), (const bf16*)(ws + (L ? WS_KEY1 : WS_KEY0)), (int*)(ws + WS_R4), (float*)(ws + WS_R4 + 16 * MiB)); }
        GRID_BAR();
        REPS(1) { unsigned char* ws = KWS(); peer_g1_phase(wv, vcu, ws + WS_R5, (const int*)(ws + WS_R4), ws + (L ? WS_U1 : WS_U0), (int*)(ws + WS_R2)); }
        GRID_BAR();
        REPS(8) { PH_IDS(); unsigned char* ws = KWS(); const size_t so = L ? 2 * 65536 : 0;
          peer_g1b_phase((const int*)(ws + WS_R2), (const int*)(ws + WS_R4), (const float*)(ws + WS_R4 + 16 * MiB), (const float*)(ws + WS_SC + so), (const float*)(ws + WS_SC + so + 65536),
                         (const float*)(ws + WS_SC + 4 * 65536), (const float*)(ws + WS_SC + 6 * 65536), ws + WS_R4 + 32 * MiB, (float*)(ws + WS_SC + 10 * 65536), (float*)(ws + WS_SC + 8 * 65536), gw, NGW, lane); }
        GRID_BAR();
        if (L == 0) { unsigned char* ws = KWS(); peer_g2_phase<true>(wv, vcu, (const int*)(ws + WS_R4), ws + WS_R4 + 32 * MiB, (const float*)(ws + WS_SC + 10 * 65536), (const float*)(ws + WS_SC + 8 * 65536), ws + WS_V0T, (bf16*)(ws + WS_R1), nullptr, (float*)(ws + 3 * MiB)); GRID_BAR(); }
        else { unsigned char* ws = KWS(); peer_g2_phase<false>(wv, vcu, (const int*)(ws + WS_R4), ws + WS_R4 + 32 * MiB, (const float*)(ws + WS_SC + 10 * 65536), (const float*)(ws + WS_SC + 8 * 65536), ws + WS_V1T, (bf16*)(ws + WS_R1), KOUT(), nullptr); }
    }
#undef GRID_BAR
}

extern "C" void kernel_launch(void* const* d_in, const int* in_sizes, int n_in, void* d_out, int out_size, void* d_ws, size_t ws_size, hipStream_t stream) {
    static int ready = 0;
    if (ready == 0) {
        if (n_in != 27 || out_size != T * D || ws_size < WS_END) { fprintf(stderr, "kernel_launch: unexpected problem (n_in %d, out %d, ws %zu)\n", n_in, out_size, ws_size); ready = -1; return; }
        if (hipFuncSetAttribute((const void*)mk_fwd, hipFuncAttributeMaxDynamicSharedMemorySize, LDS_BYTES) != hipSuccess) { fprintf(stderr, "kernel_launch: hipFuncSetAttribute failed\n"); ready = -1; return; }
        (void)hipGetLastError();
        ready = 1;
    }
    if (ready < 0) return;
    if (hipMemsetAsync((char*)d_ws + WS_CTL, 0, CTL_ZERO_BYTES, stream) != hipSuccess) { fprintf(stderr, "kernel_launch: memset failed\n"); return; }
    Args a{};
    for (int i = 0; i < 27; ++i) a.in[i] = d_in[i];
    a.out = (float*)d_out; a.ws = (unsigned char*)d_ws;
    hipLaunchKernelGGL(mk_fwd, dim3(256), dim3(NWAVES * 64), LDS_BYTES, stream, a);
}
```
